# Optimizing an MI355X kernel written in HIP

```python
import jax
import jax.numpy as jnp
from jax import lax
import numpy as np

D_MODEL = 1024
BATCH = 4
SEQ = 4096
DEPTH = 2

NORM_EPS = 1e-6
LN_EPS = 1e-5
N_DIR = 2

CONV_CH = 512
CONV_WIDTH = 31
DN_HEADS = 4
DN_HEAD_DIM = 128
DN_WIDTH = DN_HEADS * DN_HEAD_DIM
DN_CONV_WIDTH = 5
DN_CHUNK = 64
SG_GROUPS = 4
SG_GROUP_DIM = 128
SG_WIDTH = SG_GROUPS * SG_GROUP_DIM
SG_CHUNK = 128
ML_HEADS = 4
ML_QK_DIM = 64
ML_V_DIM = 128
ML_QK_WIDTH = ML_HEADS * ML_QK_DIM
ML_V_WIDTH = ML_HEADS * ML_V_DIM
ML_CHUNK = 64
D_FF = ((8 * D_MODEL + 3 * 256 - 1) // (3 * 256)) * 256

EVEN_IN = 2 * CONV_CH + 4 * DN_WIDTH + 2 * N_DIR * DN_HEADS
EVEN_MIX = CONV_CH + DN_WIDTH
ODD_IN = 2 * SG_WIDTH + 2 * ML_QK_WIDTH + 2 * ML_V_WIDTH + 2 * N_DIR * ML_HEADS
ODD_MIX = SG_WIDTH + ML_V_WIDTH
N_EVEN = (DEPTH + 1) // 2
N_ODD = DEPTH // 2

kernel_name = "bidir_hybrid_conv_deltanet_gmlp_mlstm"


def rms_norm(x, g):
    xf = x.astype(jnp.float32)
    y = xf * lax.rsqrt(jnp.mean(xf * xf, axis=-1, keepdims=True) + NORM_EPS)
    return (y * g.astype(jnp.float32)).astype(x.dtype)


def layer_norm(x, g, b):
    xf = x.astype(jnp.float32)
    mu = jnp.mean(xf, axis=-1, keepdims=True)
    xc = xf - mu
    var = jnp.mean(xc * xc, axis=-1, keepdims=True)
    y = xc * lax.rsqrt(var + LN_EPS) * g.astype(jnp.float32) + b.astype(jnp.float32)
    return y.astype(x.dtype)


def l2_normalize(x):
    xf = x.astype(jnp.float32)
    return (xf * lax.rsqrt(jnp.sum(xf * xf, axis=-1, keepdims=True) + NORM_EPS)).astype(x.dtype)


def depthwise_conv(x, w):
    pad = w.shape[0] // 2
    return lax.conv_general_dilated(
        x, w[:, None, :].astype(x.dtype), window_strides=(1,), padding=[(pad, pad)],
        dimension_numbers=("NWC", "WIO", "NWC"), feature_group_count=x.shape[-1])


def _split(z, sizes):
    idx = [int(i) for i in np.cumsum(sizes)[:-1]]
    return jnp.split(z, idx, axis=-1)


def _chunk(t, size):
    return t.reshape(t.shape[0], t.shape[1], t.shape[2] // size, size, *t.shape[3:])


def _to_scan(t):
    return jnp.moveaxis(t, 2, 0)


def _flip(t):
    return jnp.flip(t, axis=2)


def gated_delta_rule(q, k, v, log_alpha, beta):
    out_dtype = v.dtype
    q, k, v, log_alpha, beta = (t.astype(jnp.float32) for t in (q, k, v, log_alpha, beta))
    bsz, nh, seq, dk = q.shape
    dv = v.shape[-1]
    L = DN_CHUNK
    q = q * (dk ** -0.5)
    q, k, v, log_alpha, beta = (_chunk(t, L) for t in (q, k, v, log_alpha, beta))
    g = jnp.cumsum(log_alpha, axis=-1)
    tri_incl = jnp.tril(jnp.ones((L, L), dtype=bool))
    tri_strict = jnp.tril(jnp.ones((L, L), dtype=bool), -1)
    decay = jnp.exp(jnp.where(tri_incl, g[..., :, None] - g[..., None, :], -jnp.inf))
    k_beta = k * beta[..., None]
    lower = jnp.where(tri_strict, jnp.einsum("bhnid,bhnjd->bhnij", k_beta, k) * decay, 0.0)
    unit_lower = jnp.eye(L, dtype=jnp.float32) + lower
    rhs = jnp.concatenate([v * beta[..., None], k_beta * jnp.exp(g)[..., None]], axis=-1)
    sol = lax.linalg.triangular_solve(unit_lower, rhs, left_side=True, lower=True, unit_diagonal=True)
    u, w = sol[..., :dv], sol[..., dv:]
    attn = jnp.einsum("bhnid,bhnjd->bhnij", q, k) * decay

    def step(state, inp):
        q_c, k_c, u_c, w_c, g_c, a_c = inp
        v_new = u_c - jnp.einsum("bhld,bhdv->bhlv", w_c, state)
        o_c = (jnp.einsum("bhld,bhdv->bhlv", q_c * jnp.exp(g_c)[..., None], state)
               + jnp.einsum("bhij,bhjv->bhiv", a_c, v_new))
        g_last = g_c[..., -1:]
        state = (state * jnp.exp(g_last)[..., None]
                 + jnp.einsum("bhld,bhlv->bhdv", k_c * jnp.exp(g_last - g_c)[..., None], v_new))
        return state, o_c

    state0 = jnp.zeros((bsz, nh, dk, dv), jnp.float32)
    xs = tuple(_to_scan(t) for t in (q, k, u, w, g, attn))
    _, o = lax.scan(step, state0, xs)
    return jnp.moveaxis(o, 0, 2).reshape(bsz, nh, seq, dv).astype(out_dtype)


def mlstm_chunkwise(q, k, v, log_i, log_f):
    out_dtype = v.dtype
    q, k, v, log_i, log_f = (t.astype(jnp.float32) for t in (q, k, v, log_i, log_f))
    bsz, nh, seq, dqk = q.shape
    dv = v.shape[-1]
    L = ML_CHUNK
    q = q * (dqk ** -0.5)
    q, k, v, log_i, log_f = (_chunk(t, L) for t in (q, k, v, log_i, log_f))
    b = jnp.cumsum(log_f, axis=-1)
    tri = jnp.tril(jnp.ones((L, L), dtype=bool))
    d_mat = jnp.where(tri, b[..., :, None] - b[..., None, :] + log_i[..., None, :], -jnp.inf)
    d_max = jnp.max(d_mat, axis=-1)
    w_end = b[..., -1:] - b + log_i
    scores = jnp.einsum("bhntd,bhnsd->bhnts", q, k)

    def step(carry, inp):
        c_st, n_st, m_st = carry
        q_c, k_c, v_c, b_c, dm_c, dmax_c, we_c, sc_c = inp
        inter_log = b_c + m_st[..., None]
        m_t = jnp.maximum(inter_log, dmax_c)
        inter_w = jnp.exp(inter_log - m_t)
        intra_w = jnp.exp(dm_c - m_t[..., None]) * sc_c
        num = (inter_w[..., None] * jnp.einsum("bhld,bhdv->bhlv", q_c, c_st)
               + jnp.einsum("bhts,bhsv->bhtv", intra_w, v_c))
        den = inter_w * jnp.einsum("bhld,bhd->bhl", q_c, n_st) + jnp.sum(intra_w, axis=-1)
        h_c = num / jnp.maximum(jnp.abs(den), jnp.exp(-m_t))[..., None]
        decay_log = b_c[..., -1] + m_st
        m_new = jnp.maximum(decay_log, jnp.max(we_c, axis=-1))
        carry_w = jnp.exp(decay_log - m_new)
        s_w = jnp.exp(we_c - m_new[..., None])
        c_new = carry_w[..., None, None] * c_st + jnp.einsum("bhl,bhld,bhlv->bhdv", s_w, k_c, v_c)
        n_new = carry_w[..., None] * n_st + jnp.einsum("bhl,bhld->bhd", s_w, k_c)
        return (c_new, n_new, m_new), h_c

    carry0 = (jnp.zeros((bsz, nh, dqk, dv), jnp.float32),
              jnp.zeros((bsz, nh, dqk), jnp.float32),
              jnp.zeros((bsz, nh), jnp.float32))
    xs = tuple(_to_scan(t) for t in (q, k, v, b, d_mat, d_max, w_end, scores))
    _, h = lax.scan(step, carry0, xs)
    return jnp.moveaxis(h, 0, 2).reshape(bsz, nh, seq, dv).astype(out_dtype)


def even_mixer(h, w_in, conv_w, conv_b, conv_ln_g, conv_ln_b, dn_conv_w, dn_a_log, dn_dt_bias, dn_norm_g, w_out):
    bsz, seq, _ = h.shape
    z = h @ w_in
    a_val, a_gate, qkv, gate, beta_pre, alpha_pre = _split(
        z, [CONV_CH, CONV_CH, 3 * DN_WIDTH, DN_WIDTH, N_DIR * DN_HEADS, N_DIR * DN_HEADS])
    ya = depthwise_conv(a_val * jax.nn.sigmoid(a_gate), conv_w) + conv_b
    ya = jax.nn.silu(layer_norm(ya, conv_ln_g, conv_ln_b))
    qkv = jax.nn.silu(depthwise_conv(qkv, dn_conv_w))
    heads = lambda t: t.reshape(bsz, seq, DN_HEADS, DN_HEAD_DIM).transpose(0, 2, 1, 3)
    q, k, v = (heads(t) for t in jnp.split(qkv, 3, axis=-1))
    q, k = l2_normalize(q), l2_normalize(k)
    per_dir = lambda t: t.reshape(bsz, seq, N_DIR, DN_HEADS).transpose(2, 0, 3, 1)
    beta = per_dir(jax.nn.sigmoid(beta_pre.astype(jnp.float32)))
    log_alpha = per_dir(-jnp.exp(dn_a_log.reshape(-1).astype(jnp.float32))
                        * jax.nn.softplus((alpha_pre + dn_dt_bias.reshape(-1)).astype(jnp.float32)))
    o_fwd = gated_delta_rule(q, k, v, log_alpha[0], beta[0])
    o_bwd = _flip(gated_delta_rule(_flip(q), _flip(k), _flip(v), _flip(log_alpha[1]), _flip(beta[1])))
    o = (o_fwd + o_bwd).transpose(0, 2, 1, 3)
    o = rms_norm(o, dn_norm_g) * jax.nn.silu(gate.reshape(bsz, seq, DN_HEADS, DN_HEAD_DIM))
    y = jnp.concatenate([ya, o.reshape(bsz, seq, DN_WIDTH)], axis=-1)
    return y @ w_out


def odd_mixer(h, w_in, sg_ln_g, sg_ln_b, sg_w, sg_b, ml_i_bias, ml_f_bias, ml_norm_g, w_out):
    bsz, seq, _ = h.shape
    n_chunks = seq // SG_CHUNK
    z = h @ w_in
    u_pre, v_pre, q, k, v, o_pre, i_pre, f_pre = _split(
        z, [SG_WIDTH, SG_WIDTH, ML_QK_WIDTH, ML_QK_WIDTH, ML_V_WIDTH, ML_V_WIDTH,
            N_DIR * ML_HEADS, N_DIR * ML_HEADS])
    u = jax.nn.gelu(u_pre)
    vv = layer_norm(jax.nn.gelu(v_pre), sg_ln_g, sg_ln_b)
    vv = vv.reshape(bsz, n_chunks, SG_CHUNK, SG_GROUPS, SG_GROUP_DIM)
    mixed = jnp.einsum("gts,bnsgc->bntgc", sg_w, vv) + sg_b.T[None, None, :, :, None]
    yc = u * mixed.reshape(bsz, seq, SG_WIDTH)
    heads = lambda t, d: t.reshape(bsz, seq, ML_HEADS, d).transpose(0, 2, 1, 3)
    q, k, v = heads(q, ML_QK_DIM), heads(k, ML_QK_DIM), heads(v, ML_V_DIM)
    per_dir = lambda t: t.reshape(bsz, seq, N_DIR, ML_HEADS).transpose(2, 0, 3, 1)
    log_i = per_dir((i_pre + ml_i_bias.reshape(-1)).astype(jnp.float32))
    log_f = per_dir(jax.nn.log_sigmoid((f_pre + ml_f_bias.reshape(-1)).astype(jnp.float32)))
    h_fwd = mlstm_chunkwise(q, k, v, log_i[0], log_f[0])
    h_bwd = _flip(mlstm_chunkwise(_flip(q), _flip(k), _flip(v), _flip(log_i[1]), _flip(log_f[1])))
    hd = (h_fwd + h_bwd).transpose(0, 2, 1, 3)
    hd = rms_norm(hd, ml_norm_g) * jax.nn.sigmoid(o_pre.reshape(bsz, seq, ML_HEADS, ML_V_DIM))
    y = jnp.concatenate([yc, hd.reshape(bsz, seq, ML_V_WIDTH)], axis=-1)
    return y @ w_out


def swiglu(h, w1, w3, w2):
    return (jax.nn.silu(h @ w1) * (h @ w3)) @ w2


def setup_inputs(seed: int = 0) -> dict:
    key = jax.random.key(seed)
    ks = iter(jax.random.split(key, 32))
    nrm = lambda shape, scale: jax.random.normal(next(ks), shape, jnp.float32) * scale
    gain = lambda shape: 1.0 + nrm(shape, 0.02)
    x = nrm((BATCH, SEQ, D_MODEL), 1.0)
    mix_norm_g = gain((DEPTH, D_MODEL))
    ev_w_in = nrm((N_EVEN, D_MODEL, EVEN_IN), D_MODEL ** -0.5)
    ev_conv_w = nrm((N_EVEN, CONV_WIDTH, CONV_CH), CONV_WIDTH ** -0.5)
    ev_conv_b = nrm((N_EVEN, CONV_CH), 0.02)
    ev_conv_ln_g = gain((N_EVEN, CONV_CH))
    ev_conv_ln_b = nrm((N_EVEN, CONV_CH), 0.02)
    ev_dn_conv_w = nrm((N_EVEN, DN_CONV_WIDTH, 3 * DN_WIDTH), DN_CONV_WIDTH ** -0.5)
    ev_dn_a_log = jnp.log(jax.random.uniform(next(ks), (N_EVEN, N_DIR, DN_HEADS), jnp.float32, 1.0, 16.0))
    dt = jnp.exp(jax.random.uniform(next(ks), (N_EVEN, N_DIR, DN_HEADS), jnp.float32,
                                    float(np.log(1e-3)), float(np.log(1e-1))))
    ev_dn_dt_bias = dt + jnp.log(-jnp.expm1(-dt))
    ev_dn_norm_g = gain((N_EVEN, DN_HEAD_DIM))
    ev_w_out = nrm((N_EVEN, EVEN_MIX, D_MODEL), EVEN_MIX ** -0.5)
    od_w_in = nrm((N_ODD, D_MODEL, ODD_IN), D_MODEL ** -0.5)
    od_sg_ln_g = gain((N_ODD, SG_WIDTH))
    od_sg_ln_b = nrm((N_ODD, SG_WIDTH), 0.02)
    od_sg_w = nrm((N_ODD, SG_GROUPS, SG_CHUNK, SG_CHUNK), SG_CHUNK ** -0.5)
    od_sg_b = 1.0 + nrm((N_ODD, SG_GROUPS, SG_CHUNK), 0.02)
    od_ml_i_bias = nrm((N_ODD, N_DIR, ML_HEADS), 0.1)
    od_ml_f_bias = 3.0 + 3.0 * jax.random.uniform(next(ks), (N_ODD, N_DIR, ML_HEADS), jnp.float32)
    od_ml_norm_g = gain((N_ODD, ML_V_DIM))
    od_w_out = nrm((N_ODD, ODD_MIX, D_MODEL), ODD_MIX ** -0.5)
    ffn_norm_g = gain((DEPTH, D_MODEL))
    ffn_w1 = nrm((DEPTH, D_MODEL, D_FF), D_MODEL ** -0.5)
    ffn_w3 = nrm((DEPTH, D_MODEL, D_FF), D_MODEL ** -0.5)
    ffn_w2 = nrm((DEPTH, D_FF, D_MODEL), D_FF ** -0.5)
    final_norm_g = gain((D_MODEL,))
    return {
        "x": x, "mix_norm_g": mix_norm_g,
        "ev_w_in": ev_w_in, "ev_conv_w": ev_conv_w, "ev_conv_b": ev_conv_b,
        "ev_conv_ln_g": ev_conv_ln_g, "ev_conv_ln_b": ev_conv_ln_b, "ev_dn_conv_w": ev_dn_conv_w,
        "ev_dn_a_log": ev_dn_a_log, "ev_dn_dt_bias": ev_dn_dt_bias, "ev_dn_norm_g": ev_dn_norm_g,
        "ev_w_out": ev_w_out,
        "od_w_in": od_w_in, "od_sg_ln_g": od_sg_ln_g, "od_sg_ln_b": od_sg_ln_b, "od_sg_w": od_sg_w,
        "od_sg_b": od_sg_b, "od_ml_i_bias": od_ml_i_bias, "od_ml_f_bias": od_ml_f_bias,
        "od_ml_norm_g": od_ml_norm_g, "od_w_out": od_w_out,
        "ffn_norm_g": ffn_norm_g, "ffn_w1": ffn_w1, "ffn_w3": ffn_w3, "ffn_w2": ffn_w2,
        "final_norm_g": final_norm_g,
    }


def reference(x, mix_norm_g, ev_w_in, ev_conv_w, ev_conv_b, ev_conv_ln_g, ev_conv_ln_b, ev_dn_conv_w,
              ev_dn_a_log, ev_dn_dt_bias, ev_dn_norm_g, ev_w_out, od_w_in, od_sg_ln_g, od_sg_ln_b, od_sg_w,
              od_sg_b, od_ml_i_bias, od_ml_f_bias, od_ml_norm_g, od_w_out, ffn_norm_g, ffn_w1, ffn_w3, ffn_w2,
              final_norm_g):
    h = x
    for layer in range(DEPTH):
        j = layer // 2
        hn = rms_norm(h, mix_norm_g[layer])
        if layer % 2 == 0:
            h = h + even_mixer(hn, ev_w_in[j], ev_conv_w[j], ev_conv_b[j], ev_conv_ln_g[j], ev_conv_ln_b[j],
                               ev_dn_conv_w[j], ev_dn_a_log[j], ev_dn_dt_bias[j], ev_dn_norm_g[j], ev_w_out[j])
        else:
            h = h + odd_mixer(hn, od_w_in[j], od_sg_ln_g[j], od_sg_ln_b[j], od_sg_w[j], od_sg_b[j],
                              od_ml_i_bias[j], od_ml_f_bias[j], od_ml_norm_g[j], od_w_out[j])
        h = h + swiglu(rms_norm(h, ffn_norm_g[layer]), ffn_w1[layer], ffn_w3[layer], ffn_w2[layer])
    return rms_norm(h, final_norm_g)
```

```cpp
#define MULTI_LAUNCH 1
#include <hip/hip_runtime.h>
#include <hip/hip_cooperative_groups.h>
#include <cstdio>
namespace cg = cooperative_groups;
namespace pg8 {
#define PG8_LAS __attribute__((address_space(3)))
typedef unsigned short bf16_t;
typedef short bf16x8 __attribute__((ext_vector_type(8)));
typedef float f32x4 __attribute__((ext_vector_type(4)));
typedef unsigned u32x4 __attribute__((ext_vector_type(4)));
constexpr int BM = 256, BK = 64, HALF = 128, HTB = HALF * BK * 2  , STAGE_BYTES = 8 * HTB, NXCD = 8, WGM = 8;

__host__ __device__ __forceinline__ int lds_byte(int r, int c) { const int st = (r >> 4) * 2 + (c >> 5), rr = r & 15, cc = c & 31, ob = rr * 64 + cc * 2; return st * 1024 + (ob ^ (((ob >> 9) & 1) << 5)); }
__host__ __device__ __forceinline__ void stage_rc(int b, int& R, int& C) { const int st = b / 1024, sb = b % 1024, swz = sb ^ (((sb >> 9) & 1) << 5); R = (st >> 1) * 16 + swz / 64; C = (st & 1) * 32 + (swz % 64) / 2; }
__host__ __device__ __forceinline__ int perm32(int rho) { const int n = rho >> 4, i = rho & 15; return 8 * (i >> 2) + 4 * n + (i & 3); }

struct Unit { int pm, pn; };
struct Gemm { const bf16_t* A; const bf16_t* Bt; int M, N, K; };

struct StaticOrder {
    int nM, nN, nwg, G, c;
    __host__ __device__ void init(int M, int N, int G_, int c_) { nM = M / BM; nN = N / BM; nwg = nM * nN; G = G_; c = c_; }
    __host__ __device__ bool next(int i, Unit& u) const {
        const long L = (long)i * G + c; if (L >= nwg) return false;
        int wgid = (int)L; { const int q = nwg / NXCD, r = nwg % NXCD, xcd = wgid % NXCD, off = wgid / NXCD; wgid = (xcd < r ? xcd * (q + 1) : r * (q + 1) + (xcd - r) * q) + off; }
        const int nig = WGM * nN, gid = wgid / nig, fm = gid * WGM, gsz = (nM - fm) < WGM ? (nM - fm) : WGM;
        u.pm = fm + ((wgid % nig) % gsz); u.pn = (wgid % nig) / gsz; return true;
    }
    __device__ __forceinline__ void a_ready(const Unit&) const {}
    __device__ __forceinline__ void done(const Unit&) const {}
};
__device__ __forceinline__ unsigned cvt_pk_bf16(float lo, float hi) { unsigned r; asm volatile("v_cvt_pk_bf16_f32 %0, %1, %2" : "=v"(r) : "v"(lo), "v"(hi)); return r; }
typedef float f32x2 __attribute__((ext_vector_type(2)));
__device__ __forceinline__ f32x2 gelu_pk(f32x2 v) {
    const f32x2 av = __builtin_elementwise_abs(v), d = av * 0.2316418882f + 1.0f;
    f32x2 t; t.x = __builtin_amdgcn_rcpf(d.x); t.y = __builtin_amdgcn_rcpf(d.y);
    f32x2 q = t * 0.5307027145f + (-0.7265760135f); q = q * t + 0.7107068705f; q = q * t + (-0.142248368f); q = q * t + 0.127414796f; q = q * t;
    const f32x2 s = (v * v) * (-0.72134752044f);
    f32x2 e; e.x = __builtin_amdgcn_exp2f(s.x); e.y = __builtin_amdgcn_exp2f(s.y);
    const f32x2 m = v * (q * e), r = v - m;
    f32x2 o; o.x = v.x < 0.f ? m.x : r.x; o.y = v.y < 0.f ? m.y : r.y; return o;
}
template <int ACT  > struct EpiBf16 {
    static constexpr bool PERM = true, AFTER_DRAIN = false;
    bf16_t* O; int ldc; const float* bias; int split_cols; size_t split_stride;
    __device__ __forceinline__ void operator()(const f32x4 (&acc)[2][2][4][2], const Unit& u, int wr, int wc, int fr, int fq) const {
        const int row0 = u.pm * BM + wr * 64 + fr; int colt = u.pn * BM; bf16_t* base = O;
        if (split_cols) { const int t = colt / split_cols; base += (size_t)t * split_stride; colt -= t * split_cols; }
        const int col0 = colt + wc * 32 + 8 * fq, bcol0 = u.pn * BM + wc * 32 + 8 * fq;
        f32x4 bv[2][2];
#pragma unroll
        for (int bj = 0; bj < 2; ++bj)
#pragma unroll
            for (int n = 0; n < 2; ++n) bv[bj][n] = bias ? *(const f32x4*)(bias + bcol0 + bj * HALF + 4 * n) : (f32x4){0.f, 0.f, 0.f, 0.f};
#pragma unroll
        for (int ai = 0; ai < 2; ++ai)
#pragma unroll
            for (int m = 0; m < 4; ++m) { bf16_t* rowp = base + (size_t)(row0 + ai * HALF + m * 16) * ldc + col0;
#pragma unroll
                for (int bj = 0; bj < 2; ++bj) { f32x4 v0 = acc[ai][bj][m][0] + bv[bj][0], v1 = acc[ai][bj][m][1] + bv[bj][1];
                    if (ACT == 1) { f32x2 a = gelu_pk((f32x2){v0[0], v0[1]}), b = gelu_pk((f32x2){v0[2], v0[3]}), c = gelu_pk((f32x2){v1[0], v1[1]}), d = gelu_pk((f32x2){v1[2], v1[3]});
                        v0 = (f32x4){a.x, a.y, b.x, b.y}; v1 = (f32x4){c.x, c.y, d.x, d.y}; }
                    if (ACT == 2) {
#pragma unroll
                        for (int j = 0; j < 4; ++j) { v0[j] = 0.5f * v0[j] * (1.0f + erff(v0[j] * 0.70710678f)); v1[j] = 0.5f * v1[j] * (1.0f + erff(v1[j] * 0.70710678f)); } }
                    u32x4 w; w.x = cvt_pk_bf16(v0[0], v0[1]); w.y = cvt_pk_bf16(v0[2], v0[3]); w.z = cvt_pk_bf16(v1[0], v1[1]); w.w = cvt_pk_bf16(v1[2], v1[3]);
                    *(u32x4*)(rowp + bj * HALF) = w; } }
    }
};
struct EpiAddF32 {
    static constexpr bool PERM = false, AFTER_DRAIN = false;
    float* C; int ldc;
    __device__ __forceinline__ void operator()(const f32x4 (&acc)[2][2][4][2], const Unit& u, int wr, int wc, int fr, int fq) const {
        const int row0 = u.pm * BM + wr * 64 + fr, col0 = u.pn * BM + wc * 32 + 4 * fq;
#pragma unroll
        for (int ai = 0; ai < 2; ++ai)
#pragma unroll
            for (int m = 0; m < 4; ++m) { float* rowp = C + (size_t)(row0 + ai * HALF + m * 16) * ldc + col0;
#pragma unroll
                for (int bj = 0; bj < 2; ++bj)
#pragma unroll
                    for (int n = 0; n < 2; ++n) { f32x4* q = (f32x4*)(rowp + bj * HALF + n * 16); const f32x4 o = *q; *q = o + acc[ai][bj][m][n]; } }
    }
};
struct EpiSwiGLU {
    static constexpr bool PERM = true, AFTER_DRAIN = false;
    bf16_t* H; int ldh;
    __device__ __forceinline__ void operator()(const f32x4 (&acc)[2][2][4][2], const Unit& u, int wr, int wc, int fr, int fq) const {
        typedef unsigned u32x2 __attribute__((ext_vector_type(2)));
        const int row0 = u.pm * BM + wr * 64 + fr;
#pragma unroll
        for (int ai = 0; ai < 2; ++ai)
#pragma unroll
            for (int m = 0; m < 4; ++m) { bf16_t* rowp = H + (size_t)(row0 + ai * HALF + m * 16) * ldh;
#pragma unroll
                for (int bj = 0; bj < 2; ++bj) { const int hcol = ((u.pn * BM + bj * HALF + wc * 32) >> 1) + 4 * fq;
                    const f32x4 a = acc[ai][bj][m][0], b = acc[ai][bj][m][1]; float h[4];
#pragma unroll
                    for (int j = 0; j < 4; ++j) h[j] = a[j] / (1.0f + __expf(-a[j])) * b[j];
                    u32x2 w; w.x = cvt_pk_bf16(h[0], h[1]); w.y = cvt_pk_bf16(h[2], h[3]);
                    *(u32x2*)(rowp + hcol) = w; } }
    }
};
template <class Epi, class Sched, bool STAMP = false>
__device__ __forceinline__ void gemm_phase(PG8_LAS unsigned char* lds, const Gemm g, const Sched& S, const Epi& E, unsigned long long* stamps) {
    const int tid = threadIdx.x, wid = __builtin_amdgcn_readfirstlane(tid >> 6), lane = tid & 63, wr = wid >> 2, wc = wid & 3, fr = lane & 15, fq = lane >> 4;
    const int K = g.K, nt = K / BK;
    int ts_lo = 0, ts_hi = 0, nts = 0; const unsigned long long rt_entry = STAMP ? (unsigned long long)wall_clock64() : 0ull;
#define PG8_STAMP() do { if (STAMP && wid == 0 && nts < 64) { const unsigned long long _c = (unsigned long long)clock64(); \
        ts_lo = (lane == nts) ? (int)(unsigned)_c : ts_lo; ts_hi = (lane == nts) ? (int)(unsigned)(_c >> 32) : ts_hi; ++nts; } } while (0)
    PG8_STAMP();
    unsigned voffA[2], voffB[2];
#pragma unroll
    for (int i = 0; i < 2; ++i) { int R, C; stage_rc(tid * 16 + i * 8192, R, C); const int Rb = Epi::PERM ? ((R & ~31) + perm32(R & 31)) : R;
        voffA[i] = (unsigned)(R * K + C) * 2u; voffB[i] = (unsigned)(Rb * K + C) * 2u; }
    const size_t kstep = (size_t)(BK * 2);
    const size_t hstep = (size_t)HALF * K * 2;
    const size_t tstep = 2 * hstep;
    const unsigned ldsw = (unsigned)wid * 1024u;
    const int aoff = lds_byte(wr * 64 + fr, fq * 8), boff = lds_byte(wc * 32 + fr, fq * 8);
#define PG8_SA(b, h) (((b) * 2 + (h)) * HTB)
#define PG8_SB(b, h) ((4 + (b) * 2 + (h)) * HTB)
#define PG8_STAGE(bufoff, gbase, voff) do { _Pragma("unroll") for (int _i = 0; _i < 2; ++_i) \
        __builtin_amdgcn_global_load_lds((const unsigned*)((const char*)(gbase) + (voff)[_i]), (PG8_LAS unsigned*)(lds + (bufoff) + ldsw + _i * 8192), 16, 0, 0); } while (0)
#define PG8_LDA(dst, b, h) do { _Pragma("unroll") for (int m = 0; m < 4; ++m) _Pragma("unroll") for (int k = 0; k < 2; ++k) dst[m][k] = *(const PG8_LAS bf16x8*)(lds + PG8_SA(b, h) + aoff + m * 2048 + k * 1024); } while (0)
#define PG8_LDB(dst, b, h) do { _Pragma("unroll") for (int n = 0; n < 2; ++n) _Pragma("unroll") for (int k = 0; k < 2; ++k) dst[n][k] = *(const PG8_LAS bf16x8*)(lds + PG8_SB(b, h) + boff + n * 2048 + k * 1024); } while (0)
#define PG8_MMA(ai, bj, At, Bt) do { __builtin_amdgcn_s_setprio(1); _Pragma("unroll") for (int m = 0; m < 4; ++m) _Pragma("unroll") for (int n = 0; n < 2; ++n) _Pragma("unroll") for (int k = 0; k < 2; ++k) \
        acc[ai][bj][m][n] = __builtin_amdgcn_mfma_f32_16x16x32_bf16(Bt[n][k], At[m][k], acc[ai][bj][m][n], 0, 0, 0); __builtin_amdgcn_s_setprio(0); } while (0)
#define PG8_WAIT_V(n) asm volatile("s_waitcnt vmcnt(" #n ")" ::: "memory")
#define PG8_WAIT_L(n) asm volatile("s_waitcnt lgkmcnt(" #n ")" ::: "memory")
#define PG8_BAR __builtin_amdgcn_s_barrier()
#define PG8_SCHED __builtin_amdgcn_sched_barrier(0)
    Unit cur, nxt; int ui = 0;
    if (!S.next(0, cur)) return;
    f32x4 acc[2][2][4][2];
#pragma unroll
    for (int a = 0; a < 2; ++a)
#pragma unroll
        for (int b = 0; b < 2; ++b)
#pragma unroll
            for (int m = 0; m < 4; ++m)
#pragma unroll
                for (int n = 0; n < 2; ++n) acc[a][b][m][n] = (f32x4){0.f, 0.f, 0.f, 0.f};
    bf16x8 At[4][2], B0[2][2], B1[2][2];
    const char* cA = (const char*)g.A + (size_t)cur.pm * tstep; const char* cB = (const char*)g.Bt + (size_t)cur.pn * tstep;
    S.a_ready(cur);
    PG8_STAGE(PG8_SB(0, 0), cB, voffB); PG8_STAGE(PG8_SA(0, 0), cA, voffA); PG8_STAGE(PG8_SB(0, 1), cB + hstep, voffB); PG8_STAGE(PG8_SA(0, 1), cA + hstep, voffA);
    if (wr == 1) PG8_BAR;
    PG8_WAIT_V(4); PG8_BAR;
    PG8_STAGE(PG8_SB(1, 0), cB + kstep, voffB); PG8_STAGE(PG8_SA(1, 0), cA + kstep, voffA); PG8_STAGE(PG8_SB(1, 1), cB + hstep + kstep, voffB);
    PG8_WAIT_V(6); PG8_BAR;
    PG8_STAMP();
    for (;;) {
        const bool has_next = S.next(ui + 1, nxt);
        const char* nA = has_next ? (const char*)g.A + (size_t)nxt.pm * tstep : cA; const char* nB = has_next ? (const char*)g.Bt + (size_t)nxt.pn * tstep : cB;
        for (int t = 0; t < nt; t += 2) {
            const bool last = (t == nt - 2);
            const char* a1 = cA + (size_t)(t + 1) * kstep;
            const char* a2 = last ? nA : cA + (size_t)(t + 2) * kstep; const char* b2 = last ? nB : cB + (size_t)(t + 2) * kstep;
            const char* a3 = a2 + kstep; const char* b3 = b2 + kstep;
            if (last && has_next) S.a_ready(nxt);
            PG8_LDB(B0, 0, 0); PG8_SCHED; PG8_LDA(At, 0, 0); PG8_STAGE(PG8_SA(1, 1), a1 + hstep, voffA);
            PG8_WAIT_L(8); PG8_BAR; PG8_WAIT_L(0); PG8_MMA(0, 0, At, B0); PG8_BAR; PG8_SCHED;
            PG8_LDB(B1, 0, 1); PG8_STAGE(PG8_SB(0, 0), b2, voffB);
            PG8_BAR; PG8_WAIT_L(0); PG8_MMA(0, 1, At, B1); PG8_BAR;
            PG8_LDA(At, 0, 1); PG8_STAGE(PG8_SA(0, 0), a2, voffA);
            PG8_BAR; PG8_WAIT_L(0); PG8_MMA(1, 0, At, B0); PG8_BAR; PG8_SCHED;
            PG8_STAGE(PG8_SB(0, 1), b2 + hstep, voffB);
            PG8_WAIT_V(6); PG8_BAR; PG8_MMA(1, 1, At, B1); PG8_BAR;
            PG8_LDB(B0, 1, 0); PG8_SCHED; PG8_LDA(At, 1, 0); PG8_STAGE(PG8_SA(0, 1), a2 + hstep, voffA);
            PG8_WAIT_L(8); PG8_BAR; PG8_WAIT_L(0); PG8_MMA(0, 0, At, B0); PG8_BAR; PG8_SCHED;
            PG8_LDB(B1, 1, 1); PG8_STAGE(PG8_SB(1, 0), b3, voffB);
            PG8_BAR; PG8_WAIT_L(0); PG8_MMA(0, 1, At, B1); PG8_BAR;
            PG8_LDA(At, 1, 1); PG8_STAGE(PG8_SA(1, 0), a3, voffA);
            PG8_BAR; PG8_WAIT_L(0); PG8_MMA(1, 0, At, B0); PG8_BAR; PG8_SCHED;
            PG8_STAGE(PG8_SB(1, 1), b3 + hstep, voffB);
            PG8_WAIT_V(6); PG8_BAR; PG8_MMA(1, 1, At, B1); PG8_BAR;
        }
        PG8_STAMP();
        if constexpr (!Epi::AFTER_DRAIN) { E(acc, cur, wr, wc, fr, fq); S.done(cur); }
        PG8_STAMP();
        if (!has_next) break;
#pragma unroll
        for (int a = 0; a < 2; ++a)
#pragma unroll
            for (int b = 0; b < 2; ++b)
#pragma unroll
                for (int m = 0; m < 4; ++m)
#pragma unroll
                    for (int n = 0; n < 2; ++n) acc[a][b][m][n] = (f32x4){0.f, 0.f, 0.f, 0.f};
        cur = nxt; cA = nA; cB = nB; ++ui;
    }
    PG8_WAIT_V(0);
    if (wr == 0) PG8_BAR;
    PG8_BAR;
    if constexpr (Epi::AFTER_DRAIN) { E.fused(acc, cur, wr, wc, fr, fq, lds, wid, lane); S.done(cur); }
    PG8_STAMP();
    if (STAMP && wid == 0) { stamps[lane] = lane < nts ? (((unsigned long long)(unsigned)ts_hi << 32) | (unsigned)ts_lo) : 0ull;
        if (lane == 62) stamps[62] = rt_entry; if (lane == 63) stamps[63] = (unsigned long long)wall_clock64(); }
#undef PG8_STAMP
#undef PG8_SA
#undef PG8_SB
#undef PG8_STAGE
#undef PG8_LDA
#undef PG8_LDB
#undef PG8_MMA
#undef PG8_WAIT_V
#undef PG8_WAIT_L
#undef PG8_BAR
#undef PG8_SCHED
}
}
#define LAS __attribute__((address_space(3)))
typedef LAS unsigned char* LDSp;
typedef pg8::bf16_t bf16_t;
typedef unsigned u32x4 __attribute__((ext_vector_type(4)));
typedef unsigned u32x2 __attribute__((ext_vector_type(2)));
typedef float f32x4 __attribute__((ext_vector_type(4)));
typedef float f32x2 __attribute__((ext_vector_type(2)));

#ifndef EVP_SKIP
#define EVP_SKIP 0
#endif
constexpr int T_ = 16384, D_ = 1024, S_ = 4096, NTHR = 512;
constexpr int LDS_BYTES = 147456;
constexpr size_t MiB = 1048576;
constexpr size_t WS_WB = 0, WS_HN = 25 * MiB, WS_Z = 57 * MiB, WS_QKV = 153 * MiB, WS_OF = 201 * MiB, WS_OB = 217 * MiB,
                 WS_GATES = 233 * MiB, WS_BETA = 234 * MiB, WS_LA = 234 * MiB + 524288;
constexpr size_t WB_IN = 0, WB_OUT = 6291456, WB_UP = 8388608, WB_DN = 19922944;
constexpr int DFF = 2816;

struct Params { const float* in[26]; float* out; unsigned char* ws; };

__device__ __forceinline__ float bf2f(unsigned short b) { return __uint_as_float(((unsigned)b) << 16); }
__device__ __forceinline__ float bflo(unsigned u) { return __uint_as_float(u << 16); }
__device__ __forceinline__ float bfhi(unsigned u) { return __uint_as_float(u & 0xffff0000u); }
__device__ __forceinline__ unsigned short f2bf(float f) { unsigned u = __float_as_uint(f); u += 0x7FFFu + ((u >> 16) & 1u); return (unsigned short)(u >> 16); }
__device__ __forceinline__ unsigned pk2(float lo, float hi) { return pg8::cvt_pk_bf16(lo, hi); }
__device__ __forceinline__ float sigm(float x) { return 1.0f / (1.0f + __expf(-x)); }
__device__ __forceinline__ float silu_(float x) { return x * sigm(x); }
__device__ __forceinline__ float gelu_t(float x) { const float u = 0.7978845608028654f * (x + 0.044715f * x * x * x); const float t = 1.0f - 2.0f / (1.0f + __expf(2.0f * u)); return 0.5f * x * (1.0f + t); }
__device__ __forceinline__ float softplus_(float x) { return x > 20.0f ? x : log1pf(expf(x)); }
__device__ __forceinline__ float wave_sum(float v) {
#pragma unroll
    for (int o = 32; o; o >>= 1) v += __shfl_xor(v, o);
    return v; }
template <int CTRL> __device__ __forceinline__ float dppf(float v) { return __int_as_float(__builtin_amdgcn_update_dpp(0, __float_as_int(v), CTRL, 0xf, 0xf, true)); }
__device__ __forceinline__ float row16_sum(float v) { v += dppf<0xB1>(v); v += dppf<0x4E>(v); v += dppf<0x141>(v); v += dppf<0x140>(v); return v; }
__device__ __forceinline__ void unpack8(const u32x4 w, float (&f)[8]) { f[0] = bflo(w.x); f[1] = bfhi(w.x); f[2] = bflo(w.y); f[3] = bfhi(w.y); f[4] = bflo(w.z); f[5] = bfhi(w.z); f[6] = bflo(w.w); f[7] = bfhi(w.w); }

__device__ __forceinline__ void conv_job(LDSp lds, const float* __restrict__ src, int ldn, int K, int col0, int ncols, bf16_t* __restrict__ dst, int mode, int off) {
    LAS float* tl = (LAS float*)lds;
    const int tid = threadIdx.x, nnt = ncols >> 6, ntl = (K >> 6) * nnt;
    for (int tile = blockIdx.x; tile < ntl; tile += gridDim.x) {
        const int kt = tile / nnt, nt = tile - kt * nnt;
        const int r = tid >> 4, c4 = (tid & 15) << 2;
#pragma unroll
        for (int i = 0; i < 2; ++i) { const int k = r + 32 * i; const f32x4 v = *(const f32x4*)(src + (size_t)(kt * 64 + k) * ldn + col0 + nt * 64 + c4);
            tl[k * 65 + c4 + 0] = v.x; tl[k * 65 + c4 + 1] = v.y; tl[k * 65 + c4 + 2] = v.z; tl[k * 65 + c4 + 3] = v.w; }
        __syncthreads();
        const int n = tid >> 3, k8 = (tid & 7) << 3; float f[8];
#pragma unroll
        for (int j = 0; j < 8; ++j) f[j] = tl[(k8 + j) * 65 + n];
        u32x4 w; w.x = pk2(f[0], f[1]); w.y = pk2(f[2], f[3]); w.z = pk2(f[4], f[5]); w.w = pk2(f[6], f[7]);
        const int ncol = nt * 64 + n;
        const int row = mode == 0 ? off + ncol : ((ncol >> 4) << 5) + (((ncol >> 2) & 3) << 3) + (ncol & 3) + off;
        *(u32x4*)(dst + (size_t)row * K + kt * 64 + k8) = w;
        __syncthreads();
    }
}
__device__ __forceinline__ void convert_layer(LDSp lds, const Params& p, int L) {
    bf16_t* wb = (bf16_t*)(p.ws + WS_WB);
    if (L == 0) { conv_job(lds, p.in[2], 3088, 1024, 0, 3072, (bf16_t*)((char*)wb + WB_IN), 0, 0);
                  conv_job(lds, p.in[11], 1024, 1024, 0, 1024, (bf16_t*)((char*)wb + WB_OUT), 0, 0); }
    else        { conv_job(lds, p.in[12], 2576, 1024, 0, 2560, (bf16_t*)((char*)wb + WB_IN), 0, 0);
                  conv_job(lds, p.in[20], 1024, 1024, 0, 1024, (bf16_t*)((char*)wb + WB_OUT), 0, 0); }
    conv_job(lds, p.in[22] + (size_t)L * 1024 * DFF, DFF, 1024, 0, DFF, (bf16_t*)((char*)wb + WB_UP), 1, 0);
    conv_job(lds, p.in[23] + (size_t)L * 1024 * DFF, DFF, 1024, 0, DFF, (bf16_t*)((char*)wb + WB_UP), 1, 4);
    conv_job(lds, p.in[24] + (size_t)L * DFF * 1024, 1024, DFF, 0, 1024, (bf16_t*)((char*)wb + WB_DN), 0, 0);
}

__device__ __forceinline__ void rms_phase(LDSp lds, const float* src, const float* __restrict__ g, bf16_t* hn, float* copy_out, float* final_out,
                                          const float* __restrict__ gw, int gw_ld, int gw_col0, float* gates) {
    LAS float* wg = (LAS float*)lds;
    const int tid = threadIdx.x, lane = tid & 63, wid = tid >> 6;
    if (gw) { for (int idx = tid; idx < 16384; idx += NTHR) { const int k = idx >> 4, j = idx & 15; wg[j * 1024 + k] = gw[(size_t)k * gw_ld + gw_col0 + j]; } __syncthreads(); }
    f32x4 gv[4];
#pragma unroll
    for (int i = 0; i < 4; ++i) gv[i] = *(const f32x4*)(g + 4 * lane + 256 * i);
    for (int row = blockIdx.x * 8 + wid; row < T_; row += gridDim.x * 8) {
        const float* xr = src + (size_t)row * D_;
        f32x4 x[4]; float ss = 0.f;
#pragma unroll
        for (int i = 0; i < 4; ++i) { x[i] = *(const f32x4*)(xr + 4 * lane + 256 * i); ss += x[i].x * x[i].x + x[i].y * x[i].y + x[i].z * x[i].z + x[i].w * x[i].w; }
        if (copy_out) {
#pragma unroll
            for (int i = 0; i < 4; ++i) *(f32x4*)(copy_out + (size_t)row * D_ + 4 * lane + 256 * i) = x[i]; }
        ss = wave_sum(ss);
        const float rstd = rsqrtf(ss * (1.0f / 1024.0f) + 1e-6f);
        f32x4 y[4];
#pragma unroll
        for (int i = 0; i < 4; ++i) y[i] = x[i] * rstd * gv[i];
        if (final_out) {
#pragma unroll
            for (int i = 0; i < 4; ++i) *(f32x4*)(final_out + (size_t)row * D_ + 4 * lane + 256 * i) = y[i];
        } else {
#pragma unroll
            for (int i = 0; i < 4; ++i) { u32x2 w; w.x = pk2(y[i].x, y[i].y); w.y = pk2(y[i].z, y[i].w); *(u32x2*)(hn + (size_t)row * D_ + 4 * lane + 256 * i) = w; }
        }
        if (gw) {
            float s[16];
#pragma unroll
            for (int j = 0; j < 16; ++j) { float a = 0.f;
#pragma unroll
                for (int i = 0; i < 4; ++i) { const f32x4 w = *(const LAS f32x4*)(wg + j * 1024 + 4 * lane + 256 * i); a += y[i].x * w.x + y[i].y * w.y + y[i].z * w.z + y[i].w * w.w; }
                s[j] = wave_sum(a); }
            if (lane == 0) {
#pragma unroll
                for (int q = 0; q < 4; ++q) *(f32x4*)(gates + (size_t)row * 16 + 4 * q) = (f32x4){s[4 * q], s[4 * q + 1], s[4 * q + 2], s[4 * q + 3]}; }
        }
    }
    __syncthreads();
}

__device__ __forceinline__ void even_prep(LDSp lds, const Params& p) {
    const bf16_t* Z = (const bf16_t*)(p.ws + WS_Z); bf16_t* Y = (bf16_t*)(p.ws + WS_HN); bf16_t* QKVN = (bf16_t*)(p.ws + WS_QKV);
    const float* gates = (const float*)(p.ws + WS_GATES); float* BETA = (float*)(p.ws + WS_BETA); float* LA = (float*)(p.ws + WS_LA);
    const float* conv_w = p.in[3]; const float* conv_b = p.in[4]; const float* ln_g = p.in[5]; const float* ln_b = p.in[6];
    const float* dn_w = p.in[7]; const float* a_log = p.in[8]; const float* dt_bias = p.in[9];
    LAS float* glu = (LAS float*)lds;
    const int tid = threadIdx.x, lane = tid & 63, wid = tid >> 6, c = tid;
    for (int tile = blockIdx.x; tile < T_ / 32; tile += gridDim.x) {
        const int t0 = tile * 32, b = t0 >> 12, s0 = t0 & 4095;
#if !(EVP_SKIP & 1)
        for (int it = tid; it < 62 * 64; it += NTHR) { const int r = it >> 6, c8 = (it & 63) << 3, sp = s0 - 15 + r;
            f32x4 o0 = {0.f, 0.f, 0.f, 0.f}, o1 = {0.f, 0.f, 0.f, 0.f};
            if (sp >= 0 && sp < S_) { const size_t tok = (size_t)b * S_ + sp; const u32x4 av = *(const u32x4*)(Z + tok * 3072 + c8); const u32x4 gv = *(const u32x4*)(Z + tok * 3072 + 512 + c8);
                float a[8], g[8]; unpack8(av, a); unpack8(gv, g);
                o0 = (f32x4){a[0] * sigm(g[0]), a[1] * sigm(g[1]), a[2] * sigm(g[2]), a[3] * sigm(g[3])}; o1 = (f32x4){a[4] * sigm(g[4]), a[5] * sigm(g[5]), a[6] * sigm(g[6]), a[7] * sigm(g[7])}; }
            *(LAS f32x4*)(glu + r * 512 + c8) = o0; *(LAS f32x4*)(glu + r * 512 + c8 + 4) = o1; }
        __syncthreads();
        {
            float cw[31];
#pragma unroll
            for (int w = 0; w < 31; ++w) cw[w] = conv_w[w * 512 + c];
            const float cb = conv_b[c];
            f32x4 res[8];
#pragma unroll
            for (int t4 = 0; t4 < 8; ++t4) {
                float x[34];
#pragma unroll
                for (int i = 0; i < 34; ++i) x[i] = glu[(t4 * 4 + i) * 512 + c];
                float a0 = cb, a1 = cb, a2 = cb, a3 = cb;
#pragma unroll
                for (int w = 0; w < 31; ++w) { a0 = fmaf(x[w], cw[w], a0); a1 = fmaf(x[w + 1], cw[w], a1); a2 = fmaf(x[w + 2], cw[w], a2); a3 = fmaf(x[w + 3], cw[w], a3); }
                res[t4] = (f32x4){a0, a1, a2, a3};
            }
            __syncthreads();
#pragma unroll
            for (int t4 = 0; t4 < 8; ++t4) { glu[(t4 * 4 + 0) * 512 + c] = res[t4].x; glu[(t4 * 4 + 1) * 512 + c] = res[t4].y; glu[(t4 * 4 + 2) * 512 + c] = res[t4].z; glu[(t4 * 4 + 3) * 512 + c] = res[t4].w; }
        }
        __syncthreads();
        {
            const f32x4 g0 = *(const f32x4*)(ln_g + 4 * lane), g1 = *(const f32x4*)(ln_g + 256 + 4 * lane), b0 = *(const f32x4*)(ln_b + 4 * lane), b1 = *(const f32x4*)(ln_b + 256 + 4 * lane);
#pragma unroll
            for (int tt = 0; tt < 4; ++tt) { const int t = wid * 4 + tt;
                const f32x4 x0 = *(const LAS f32x4*)(glu + t * 512 + 4 * lane), x1 = *(const LAS f32x4*)(glu + t * 512 + 256 + 4 * lane);
                const float mean = wave_sum((x0.x + x0.y) + (x0.z + x0.w) + (x1.x + x1.y) + (x1.z + x1.w)) * (1.0f / 512.0f);
                const f32x4 d0 = x0 - mean, d1 = x1 - mean;
                const float var = wave_sum(d0.x * d0.x + d0.y * d0.y + d0.z * d0.z + d0.w * d0.w + d1.x * d1.x + d1.y * d1.y + d1.z * d1.z + d1.w * d1.w) * (1.0f / 512.0f);
                const float rstd = rsqrtf(var + 1e-5f);
                const f32x4 y0 = d0 * rstd * g0 + b0, y1 = d1 * rstd * g1 + b1;
                u32x2 w0, w1; w0.x = pk2(silu_(y0.x), silu_(y0.y)); w0.y = pk2(silu_(y0.z), silu_(y0.w)); w1.x = pk2(silu_(y1.x), silu_(y1.y)); w1.y = pk2(silu_(y1.z), silu_(y1.w));
                *(u32x2*)(Y + (size_t)(t0 + t) * 1024 + 4 * lane) = w0; *(u32x2*)(Y + (size_t)(t0 + t) * 1024 + 256 + 4 * lane) = w1; }
        }
        __syncthreads();
#endif
#if !(EVP_SKIP & 2)
#pragma unroll 1
        for (int gi = 0; gi < 3; ++gi) {
            const int col = 1024 + gi * 512 + c;
            float w5[5];
#pragma unroll
            for (int w = 0; w < 5; ++w) w5[w] = dn_w[w * 1536 + gi * 512 + c];
            const bf16_t* zc = Z + (size_t)b * S_ * 3072 + col;
#define ZLD(sp) (((sp) >= 0 && (sp) < S_) ? bf2f(zc[(size_t)(sp) * 3072]) : 0.f)
            float x0 = ZLD(s0 - 2), x1 = ZLD(s0 - 1), x2 = ZLD(s0), x3 = ZLD(s0 + 1);
#pragma unroll 4
            for (int t = 0; t < 32; ++t) { const float x4 = ZLD(s0 + t + 2);
                float v = x0 * w5[0]; v = fmaf(x1, w5[1], v); v = fmaf(x2, w5[2], v); v = fmaf(x3, w5[3], v); v = fmaf(x4, w5[4], v);
                v = silu_(v);
                if (gi == 2) QKVN[(size_t)(t0 + t) * 1536 + 1024 + c] = f2bf(v); else glu[t * 512 + c] = v;
                x0 = x1; x1 = x2; x2 = x3; x3 = x4; }
#undef ZLD
            if (gi < 2) {
                __syncthreads();
                const float qs = gi == 0 ? 0.08838834764831845f : 1.0f;
#pragma unroll 4
                for (int pp = 0; pp < 16; ++pp) { const int pr = wid * 16 + pp, t = pr >> 2, hd = pr & 3;
                    const f32x2 x = *(const LAS f32x2*)(glu + t * 512 + hd * 128 + 2 * lane);
                    const float ss = wave_sum(x.x * x.x + x.y * x.y); const float sc = rsqrtf(ss + 1e-6f) * qs;
                    *(unsigned*)(QKVN + (size_t)(t0 + t) * 1536 + gi * 512 + hd * 128 + 2 * lane) = pk2(x.x * sc, x.y * sc); }
                __syncthreads();
            }
        }
#endif
#if !(EVP_SKIP & 4)
        if (tid < 256) { const int t = tid >> 3, j = tid & 7; const size_t tok = (size_t)(t0 + t);
            const float bp = gates[tok * 16 + j], ap = gates[tok * 16 + 8 + j];
            BETA[tok * 8 + j] = sigm(bp); LA[tok * 8 + j] = -expf(a_log[j]) * softplus_(ap + dt_bias[j]); }
#endif
        __syncthreads();
    }
}

__device__ __forceinline__ void delta_scan(LDSp lds, const Params& p) {
    const bf16_t* QKVN = (const bf16_t*)(p.ws + WS_QKV); const float* BETA = (const float*)(p.ws + WS_BETA); const float* LA = (const float*)(p.ws + WS_LA);
    const int tid = threadIdx.x, jl = tid >> 4, sub = tid & 15;
    constexpr int BUF = 37376;
    LAS float* ost = (LAS float*)(lds + 2 * BUF);
    for (int unit = blockIdx.x; unit < 128; unit += gridDim.x) {
        const int dir = unit >> 6, b = (unit >> 4) & 3, h = (unit >> 2) & 3, sl = unit & 3;
        bf16_t* O = (bf16_t*)(p.ws + (dir ? WS_OB : WS_OF));
        float S[8];
#pragma unroll
        for (int i = 0; i < 8; ++i) S[i] = 0.f;
        u32x4 rq[4]; u32x4 rv = {0u, 0u, 0u, 0u}; float ra = 0.f, rb = 0.f;
#define DS_TOK(n, s) ((size_t)b * S_ + (dir ? (S_ - 1 - ((n) * 64 + (s))) : ((n) * 64 + (s))))
#define DS_LOAD(n) do { _Pragma("unroll") for (int i = 0; i < 4; ++i) { const int pi = tid + NTHR * i, s = pi >> 5, w16 = pi & 31; \
            rq[i] = *(const u32x4*)(QKVN + DS_TOK(n, s) * 1536 + (w16 >> 4) * 512 + h * 128 + (w16 & 15) * 8); } \
        if (tid < 256) { const int s = tid >> 2, c8 = tid & 3; rv = *(const u32x4*)(QKVN + DS_TOK(n, s) * 1536 + 1024 + h * 128 + sl * 32 + c8 * 8); } \
        if (tid < 64) { const size_t tk = DS_TOK(n, tid); ra = expf(LA[tk * 8 + dir * 4 + h]); rb = BETA[tk * 8 + dir * 4 + h]; } } while (0)
#define DS_STORE(bufp) do { _Pragma("unroll") for (int i = 0; i < 4; ++i) { const int pi = tid + NTHR * i; *(LAS u32x4*)((bufp) + pi * 16) = rq[i]; } \
        if (tid < 256) *(LAS u32x4*)((bufp) + 32768 + tid * 16) = rv; \
        if (tid < 64) { *(LAS float*)((bufp) + 36864 + tid * 8) = ra; *(LAS float*)((bufp) + 36864 + tid * 8 + 4) = rb; } } while (0)
        DS_LOAD(0); DS_STORE(lds); __syncthreads();
#pragma unroll 1
        for (int n = 0; n < 64; ++n) {
            LDSp cb = lds + (n & 1) * BUF; LDSp nb = lds + ((n + 1) & 1) * BUF; LAS float* os = ost + (n & 1) * 2048;
            if (n < 63) DS_LOAD(n + 1);
#pragma unroll 4
            for (int s = 0; s < 64; ++s) {
                const u32x4 qq = *(const LAS u32x4*)(cb + s * 512 + sub * 16), kk = *(const LAS u32x4*)(cb + s * 512 + 256 + sub * 16);
                const float vj = bf2f(*(const LAS unsigned short*)(cb + 32768 + s * 64 + jl * 2));
                const float al = *(const LAS float*)(cb + 36864 + s * 8), be = *(const LAS float*)(cb + 36864 + s * 8 + 4);
                float kf[8], qf[8]; unpack8(kk, kf); unpack8(qq, qf);
                float ks = 0.f;
#pragma unroll
                for (int i = 0; i < 8; ++i) ks = fmaf(kf[i], S[i], ks);
                ks = row16_sum(ks);
                const float cc = be * (vj - al * ks);
                float o = 0.f;
#pragma unroll
                for (int i = 0; i < 8; ++i) { S[i] = fmaf(kf[i], cc, al * S[i]); o = fmaf(qf[i], S[i], o); }
                o = row16_sum(o);
                if (sub == 0) os[s * 32 + jl] = o;
            }
            if (n < 63) DS_STORE(nb);
            __syncthreads();
            { const int s = tid >> 3, j4 = (tid & 7) << 2; const f32x4 o4 = *(const LAS f32x4*)(os + s * 32 + j4);
              u32x2 w; w.x = pk2(o4.x, o4.y); w.y = pk2(o4.z, o4.w);
              *(u32x2*)(O + DS_TOK(n, s) * 512 + h * 128 + sl * 32 + j4) = w; }
        }
        __syncthreads();
#undef DS_LOAD
#undef DS_STORE
#undef DS_TOK
    }
}

__device__ __forceinline__ void headnorm_phase(const Params& p, const float* __restrict__ g, int zld, int zcol, int act) {
    const bf16_t* OF = (const bf16_t*)(p.ws + WS_OF); const bf16_t* OB = (const bf16_t*)(p.ws + WS_OB); const bf16_t* Z = (const bf16_t*)(p.ws + WS_Z); bf16_t* Y = (bf16_t*)(p.ws + WS_HN);
    const int tid = threadIdx.x, lane = tid & 63, wid = tid >> 6, c = lane * 8;
    const f32x4 g0 = *(const f32x4*)(g + (c & 127)), g1 = *(const f32x4*)(g + (c & 127) + 4);
    for (int tok = blockIdx.x * 8 + wid; tok < T_; tok += gridDim.x * 8) {
        const u32x4 a = *(const u32x4*)(OF + (size_t)tok * 512 + c), bq = *(const u32x4*)(OB + (size_t)tok * 512 + c), gz = *(const u32x4*)(Z + (size_t)tok * zld + zcol + c);
        float fa[8], fb[8], fg[8], o[8]; unpack8(a, fa); unpack8(bq, fb); unpack8(gz, fg);
        float ss = 0.f;
#pragma unroll
        for (int i = 0; i < 8; ++i) { o[i] = fa[i] + fb[i]; ss = fmaf(o[i], o[i], ss); }
        ss = row16_sum(ss);
        const float rstd = rsqrtf(ss * (1.0f / 128.0f) + 1e-6f);
        const float gg[8] = {g0.x, g0.y, g0.z, g0.w, g1.x, g1.y, g1.z, g1.w};
        float y[8];
#pragma unroll
        for (int i = 0; i < 8; ++i) y[i] = o[i] * rstd * gg[i] * (act == 0 ? silu_(fg[i]) : sigm(fg[i]));
        u32x4 w; w.x = pk2(y[0], y[1]); w.y = pk2(y[2], y[3]); w.z = pk2(y[4], y[5]); w.w = pk2(y[6], y[7]);
        *(u32x4*)(Y + (size_t)tok * 1024 + 512 + c) = w;
    }
}

__device__ __forceinline__ void odd_prep(const Params& p) {
    const bf16_t* Z = (const bf16_t*)(p.ws + WS_Z); bf16_t* VV = (bf16_t*)(p.ws + WS_QKV);
    const float* gates = (const float*)(p.ws + WS_GATES); float* LI = (float*)(p.ws + WS_BETA); float* LF = (float*)(p.ws + WS_LA);
    const float* ln_g = p.in[13]; const float* ln_b = p.in[14]; const float* ib = p.in[17]; const float* fb = p.in[18];
    const int tid = threadIdx.x, lane = tid & 63, wid = tid >> 6, c = lane * 8;
    const f32x4 g0 = *(const f32x4*)(ln_g + c), g1 = *(const f32x4*)(ln_g + c + 4), b0 = *(const f32x4*)(ln_b + c), b1 = *(const f32x4*)(ln_b + c + 4);
    const float gg[8] = {g0.x, g0.y, g0.z, g0.w, g1.x, g1.y, g1.z, g1.w}, bb[8] = {b0.x, b0.y, b0.z, b0.w, b1.x, b1.y, b1.z, b1.w};
    for (int tok = blockIdx.x * 8 + wid; tok < T_; tok += gridDim.x * 8) {
        const u32x4 v = *(const u32x4*)(Z + (size_t)tok * 2560 + 512 + c);
        float x[8]; unpack8(v, x); float sm = 0.f;
#pragma unroll
        for (int i = 0; i < 8; ++i) { x[i] = gelu_t(x[i]); sm += x[i]; }
        const float mean = wave_sum(sm) * (1.0f / 512.0f); float sq = 0.f;
#pragma unroll
        for (int i = 0; i < 8; ++i) { x[i] -= mean; sq = fmaf(x[i], x[i], sq); }
        const float rstd = rsqrtf(wave_sum(sq) * (1.0f / 512.0f) + 1e-5f);
        float y[8];
#pragma unroll
        for (int i = 0; i < 8; ++i) y[i] = x[i] * rstd * gg[i] + bb[i];
        u32x4 w; w.x = pk2(y[0], y[1]); w.y = pk2(y[2], y[3]); w.z = pk2(y[4], y[5]); w.w = pk2(y[6], y[7]);
        *(u32x4*)(VV + (size_t)tok * 512 + c) = w;
        if (lane < 8) { LI[(size_t)tok * 8 + lane] = gates[(size_t)tok * 16 + lane] + ib[lane];
                        LF[(size_t)tok * 8 + lane] = -softplus_(-(gates[(size_t)tok * 16 + 8 + lane] + fb[lane])); }
    }
}

__device__ __forceinline__ void sg_phase(LDSp lds, const Params& p, int sgId, int sgG) {
    typedef short bf16x8 __attribute__((ext_vector_type(8)));
    const bf16_t* Z = (const bf16_t*)(p.ws + WS_Z); const bf16_t* VV = (const bf16_t*)(p.ws + WS_QKV); bf16_t* Y = (bf16_t*)(p.ws + WS_HN);
    const float* sgw = p.in[15]; const float* sgb = p.in[16];
    LAS unsigned short* Wb = (LAS unsigned short*)lds;
    LAS unsigned short* Vt = (LAS unsigned short*)(lds + 34816);
    const int tid = threadIdx.x, lane = tid & 63, wid = tid >> 6;
    for (int unit = sgId; unit < 512; unit += sgG) {
        const int g = unit & 3, n = (unit >> 2) & 31, b = unit >> 7; const size_t tok0 = (size_t)b * S_ + n * 128;
#pragma unroll
        for (int i = 0; i < 8; ++i) { const int i4 = tid + NTHR * i, t = i4 >> 5, s4 = (i4 & 31) << 2; const f32x4 w = *(const f32x4*)(sgw + (size_t)g * 16384 + t * 128 + s4);
            u32x2 o; o.x = pk2(w.x, w.y); o.y = pk2(w.z, w.w); *(LAS u32x2*)(Wb + t * 136 + s4) = o; }
#pragma unroll
        for (int i = 0; i < 4; ++i) { const int pi = tid + NTHR * i, s = pi >> 4, c8 = (pi & 15) << 3; const u32x4 v = *(const u32x4*)(VV + (tok0 + s) * 512 + g * 128 + c8);
            Vt[(c8 + 0) * 136 + s] = (unsigned short)(v.x & 0xffffu); Vt[(c8 + 1) * 136 + s] = (unsigned short)(v.x >> 16);
            Vt[(c8 + 2) * 136 + s] = (unsigned short)(v.y & 0xffffu); Vt[(c8 + 3) * 136 + s] = (unsigned short)(v.y >> 16);
            Vt[(c8 + 4) * 136 + s] = (unsigned short)(v.z & 0xffffu); Vt[(c8 + 5) * 136 + s] = (unsigned short)(v.z >> 16);
            Vt[(c8 + 6) * 136 + s] = (unsigned short)(v.w & 0xffffu); Vt[(c8 + 7) * 136 + s] = (unsigned short)(v.w >> 16); }
        __syncthreads();
        bf16x8 af[4];
#pragma unroll
        for (int ks = 0; ks < 4; ++ks) af[ks] = *(const LAS bf16x8*)(Wb + (16 * wid + (lane & 15)) * 136 + ks * 32 + (lane >> 4) * 8);
#pragma unroll
        for (int nn = 0; nn < 8; ++nn) {
            f32x4 acc = {0.f, 0.f, 0.f, 0.f};
#pragma unroll
            for (int ks = 0; ks < 4; ++ks) { const bf16x8 bfrag = *(const LAS bf16x8*)(Vt + (16 * nn + (lane & 15)) * 136 + ks * 32 + (lane >> 4) * 8);
                acc = __builtin_amdgcn_mfma_f32_16x16x32_bf16(af[ks], bfrag, acc, 0, 0, 0); }
            const int cc = g * 128 + 16 * nn + (lane & 15);
#pragma unroll
            for (int i = 0; i < 4; ++i) { const int t = 16 * wid + (lane >> 4) * 4 + i; const size_t tok = tok0 + t;
                const float u = gelu_t(bf2f(Z[tok * 2560 + cc]));
                Y[tok * 1024 + cc] = f2bf(u * (acc[i] + sgb[g * 128 + t])); }
        }
        __syncthreads();
    }
}

__device__ __forceinline__ void mlstm_scan(LDSp lds, const Params& p) {
    const bf16_t* Z = (const bf16_t*)(p.ws + WS_Z); const float* LI = (const float*)(p.ws + WS_BETA); const float* LF = (const float*)(p.ws + WS_LA);
    const int tid = threadIdx.x, jl = tid >> 4, sub = tid & 15;
    constexpr int BUF = 20992;
    LAS float* ost = (LAS float*)(lds + 2 * BUF);
    for (int unit = blockIdx.x; unit < 128; unit += gridDim.x) {
        const int dir = unit >> 6, b = (unit >> 4) & 3, h = (unit >> 2) & 3, sl = unit & 3;
        bf16_t* O = (bf16_t*)(p.ws + (dir ? WS_OB : WS_OF));
        float C[4], N[4];
#pragma unroll
        for (int i = 0; i < 4; ++i) { C[i] = 0.f; N[i] = 0.f; }
        u32x4 rq, rk, rv = {0u, 0u, 0u, 0u}; float ri = 0.f, rf = 0.f;
#define ML_TOK(n, s) ((size_t)b * S_ + (dir ? (S_ - 1 - ((n) * 64 + (s))) : ((n) * 64 + (s))))
#define ML_LOAD(n) do { { const int s = tid >> 3, c8 = tid & 7; const size_t tk = ML_TOK(n, s); \
            rq = *(const u32x4*)(Z + tk * 2560 + 1024 + h * 64 + c8 * 8); rk = *(const u32x4*)(Z + tk * 2560 + 1280 + h * 64 + c8 * 8); } \
        if (tid < 256) { const int s = tid >> 2, c8 = tid & 3; rv = *(const u32x4*)(Z + ML_TOK(n, s) * 2560 + 1536 + h * 128 + sl * 32 + c8 * 8); } \
        if (tid < 64) { const size_t tk = ML_TOK(n, tid); ri = expf(LI[tk * 8 + dir * 4 + h]); rf = expf(LF[tk * 8 + dir * 4 + h]); } } while (0)
#define ML_STORE(bufp) do { *(LAS u32x4*)((bufp) + tid * 16) = rq; *(LAS u32x4*)((bufp) + 8192 + tid * 16) = rk; \
        if (tid < 256) *(LAS u32x4*)((bufp) + 16384 + tid * 16) = rv; \
        if (tid < 64) { *(LAS float*)((bufp) + 20480 + tid * 8) = ri; *(LAS float*)((bufp) + 20480 + tid * 8 + 4) = rf; } } while (0)
        ML_LOAD(0); ML_STORE(lds); __syncthreads();
#pragma unroll 1
        for (int n = 0; n < 64; ++n) {
            LDSp cb = lds + (n & 1) * BUF; LDSp nb = lds + ((n + 1) & 1) * BUF; LAS float* os = ost + (n & 1) * 2048;
            if (n < 63) ML_LOAD(n + 1);
#pragma unroll 4
            for (int s = 0; s < 64; ++s) {
                const u32x2 qq = *(const LAS u32x2*)(cb + s * 128 + sub * 8), kk = *(const LAS u32x2*)(cb + 8192 + s * 128 + sub * 8);
                const float vj = bf2f(*(const LAS unsigned short*)(cb + 16384 + s * 64 + jl * 2));
                const float ig = *(const LAS float*)(cb + 20480 + s * 8), fg = *(const LAS float*)(cb + 20480 + s * 8 + 4);
                const float qf[4] = {bflo(qq.x), bfhi(qq.x), bflo(qq.y), bfhi(qq.y)}, kf[4] = {bflo(kk.x), bfhi(kk.x), bflo(kk.y), bfhi(kk.y)};
                const float iv = ig * vj; float num = 0.f, den = 0.f;
#pragma unroll
                for (int i = 0; i < 4; ++i) { C[i] = fmaf(iv, kf[i], fg * C[i]); N[i] = fmaf(ig, kf[i], fg * N[i]); num = fmaf(qf[i], C[i], num); den = fmaf(qf[i], N[i], den); }
                num = row16_sum(num); den = row16_sum(den);
                if (sub == 0) os[s * 32 + jl] = 0.125f * num / fmaxf(fabsf(0.125f * den), 1.0f);
            }
            if (n < 63) ML_STORE(nb);
            __syncthreads();
            { const int s = tid >> 3, j4 = (tid & 7) << 2; const f32x4 o4 = *(const LAS f32x4*)(os + s * 32 + j4);
              u32x2 w; w.x = pk2(o4.x, o4.y); w.y = pk2(o4.z, o4.w);
              *(u32x2*)(O + ML_TOK(n, s) * 512 + h * 128 + sl * 32 + j4) = w; }
        }
        __syncthreads();
#undef ML_LOAD
#undef ML_STORE
#undef ML_TOK
    }
}

#ifndef N_PHASES
#define N_PHASES 19
#endif
template <int L, int SUB> __device__ __forceinline__ void run_phase(LDSp lds, const Params& p) {
    unsigned char* ws = p.ws;
    bf16_t* HN = (bf16_t*)(ws + WS_HN); bf16_t* Zb = (bf16_t*)(ws + WS_Z); float* h = p.out; float* gates = (float*)(ws + WS_GATES);
    const bf16_t* W_IN = (const bf16_t*)(ws + WS_WB + WB_IN); const bf16_t* W_OUT = (const bf16_t*)(ws + WS_WB + WB_OUT);
    const bf16_t* W_UP = (const bf16_t*)(ws + WS_WB + WB_UP); const bf16_t* W_DN = (const bf16_t*)(ws + WS_WB + WB_DN);
    const int G = gridDim.x;
    if constexpr (L == 2) { rms_phase(lds, h, p.in[25], nullptr, nullptr, h, nullptr, 0, 0, nullptr); }
    else if constexpr (SUB == 0) {
        convert_layer(lds, p, L);
        if constexpr (L == 0) rms_phase(lds, p.in[0], p.in[1], HN, h, nullptr, p.in[2], 3088, 3072, gates);
        else                  rms_phase(lds, h, p.in[1] + 1024, HN, nullptr, nullptr, p.in[12], 2576, 2560, gates);
    } else if constexpr (SUB == 1) { constexpr int N = L == 0 ? 3072 : 2560;
        pg8::Gemm g{HN, W_IN, T_, N, 1024}; pg8::StaticOrder S; S.init(T_, N, G, (int)blockIdx.x);
        pg8::EpiBf16<0> E{Zb, N, nullptr, 0, 0};
        pg8::gemm_phase<pg8::EpiBf16<0>, pg8::StaticOrder>(lds, g, S, E, nullptr);
    } else if constexpr (SUB == 2) { if constexpr (L == 0) even_prep(lds, p); else odd_prep(p); }
    else if constexpr (SUB == 3) {
        if constexpr (L == 0) delta_scan(lds, p);
        else { if (G > 128) { if ((int)blockIdx.x < 128) mlstm_scan(lds, p); else sg_phase(lds, p, (int)blockIdx.x - 128, G - 128); }
               else { mlstm_scan(lds, p); sg_phase(lds, p, (int)blockIdx.x, G); } }
    } else if constexpr (SUB == 4) { if constexpr (L == 0) headnorm_phase(p, p.in[10], 3072, 2560, 0); else headnorm_phase(p, p.in[19], 2560, 2048, 1); }
    else if constexpr (SUB == 5) { pg8::Gemm g{HN, W_OUT, T_, 1024, 1024}; pg8::StaticOrder S; S.init(T_, 1024, G, (int)blockIdx.x);
        pg8::EpiAddF32 E{h, 1024};
        pg8::gemm_phase<pg8::EpiAddF32, pg8::StaticOrder>(lds, g, S, E, nullptr);
    } else if constexpr (SUB == 6) { rms_phase(lds, h, p.in[21] + L * 1024, HN, nullptr, nullptr, nullptr, 0, 0, nullptr); }
    else if constexpr (SUB == 7) { pg8::Gemm g{HN, W_UP, T_, 2 * DFF, 1024}; pg8::StaticOrder S; S.init(T_, 2 * DFF, G, (int)blockIdx.x);
        pg8::EpiSwiGLU E{Zb, DFF};
        pg8::gemm_phase<pg8::EpiSwiGLU, pg8::StaticOrder>(lds, g, S, E, nullptr);
    } else if constexpr (SUB == 8) { pg8::Gemm g{Zb, W_DN, T_, 1024, DFF}; pg8::StaticOrder S; S.init(T_, 1024, G, (int)blockIdx.x);
        pg8::EpiAddF32 E{h, 1024};
        pg8::gemm_phase<pg8::EpiAddF32, pg8::StaticOrder>(lds, g, S, E, nullptr);
    }
}
__global__ void __launch_bounds__(NTHR, 2) mega(Params p, int ph_lo, int ph_hi) {
    extern __shared__ __attribute__((aligned(16))) unsigned char lds_raw[];
    LDSp lds = (LDSp)lds_raw;
    cg::grid_group grid = cg::this_grid();
#define PH(k, L, SUB) if (ph_lo <= (k) && (k) < ph_hi) { run_phase<L, SUB>(lds, p); if ((k) + 1 < ph_hi) grid.sync(); }
    PH(0, 0, 0) PH(1, 0, 1) PH(2, 0, 2) PH(3, 0, 3) PH(4, 0, 4) PH(5, 0, 5) PH(6, 0, 6) PH(7, 0, 7) PH(8, 0, 8)
    PH(9, 1, 0) PH(10, 1, 1) PH(11, 1, 2) PH(12, 1, 3) PH(13, 1, 4) PH(14, 1, 5) PH(15, 1, 6) PH(16, 1, 7) PH(17, 1, 8)
    PH(18, 2, 0)
#undef PH
}

extern "C" void kernel_launch(void* const* d_in, const int* in_sizes, int n_in, void* d_out, int out_size, void* d_ws, size_t ws_size, hipStream_t stream) {
    static int grid = 0;
    if (grid == 0) {
        int dev = 0, cus = 0, per_cu = 0;
        (void)hipGetDevice(&dev);
        (void)hipDeviceGetAttribute(&cus, hipDeviceAttributeMultiprocessorCount, dev);
        (void)hipFuncSetAttribute((const void*)mega, hipFuncAttributeMaxDynamicSharedMemorySize, LDS_BYTES);
        if (hipOccupancyMaxActiveBlocksPerMultiprocessor(&per_cu, (const void*)mega, NTHR, LDS_BYTES) != hipSuccess || per_cu < 1) per_cu = 1;
        (void)hipGetLastError();
        if (cus <= 0) cus = 256;
        grid = cus * per_cu;
    }
    if (ws_size < 236 * MiB) { fprintf(stderr, "workspace too small: %zu\n", ws_size); return; }
    Params p{};
    for (int i = 0; i < 26; ++i) p.in[i] = (const float*)d_in[i];
    p.out = (float*)d_out; p.ws = (unsigned char*)d_ws;
#if defined(MULTI_LAUNCH)
    for (int ph = 0; ph < N_PHASES; ++ph) hipLaunchKernelGGL(mega, dim3(grid), dim3(NTHR), LDS_BYTES, stream, p, ph, ph + 1);
#else
    int lo = 0, hi = N_PHASES;
    void* args[] = {(void*)&p, (void*)&lo, (void*)&hi};
    hipError_t e = hipLaunchCooperativeKernel((const void*)mega, dim3(grid), dim3(NTHR), args, LDS_BYTES, stream);
    if (e != hipSuccess) fprintf(stderr, "cooperative launch failed: %s (grid %d)\n", hipGetErrorString(e), grid);
#endif
}
```

```cpp
#include <hip/hip_runtime.h>
#include <hip/hip_cooperative_groups.h>
#include <cstdio>
namespace cg = cooperative_groups;
namespace pg8 {
#define PG8_LAS __attribute__((address_space(3)))
typedef unsigned short bf16_t;
typedef short bf16x8 __attribute__((ext_vector_type(8)));
typedef float f32x4 __attribute__((ext_vector_type(4)));
typedef unsigned u32x4 __attribute__((ext_vector_type(4)));
constexpr int BM = 256, BK = 64, HALF = 128, HTB = HALF * BK * 2  , STAGE_BYTES = 8 * HTB, NXCD = 8, WGM = 8;

__host__ __device__ __forceinline__ int lds_byte(int r, int c) { const int st = (r >> 4) * 2 + (c >> 5), rr = r & 15, cc = c & 31, ob = rr * 64 + cc * 2; return st * 1024 + (ob ^ (((ob >> 9) & 1) << 5)); }
__host__ __device__ __forceinline__ void stage_rc(int b, int& R, int& C) { const int st = b / 1024, sb = b % 1024, swz = sb ^ (((sb >> 9) & 1) << 5); R = (st >> 1) * 16 + swz / 64; C = (st & 1) * 32 + (swz % 64) / 2; }
__host__ __device__ __forceinline__ int perm32(int rho) { const int n = rho >> 4, i = rho & 15; return 8 * (i >> 2) + 4 * n + (i & 3); }

struct Unit { int pm, pn; };
struct Gemm { const bf16_t* A; const bf16_t* Bt; int M, N, K; };

struct StaticOrder {
    int nM, nN, nwg, G, c;
    __host__ __device__ void init(int M, int N, int G_, int c_) { nM = M / BM; nN = N / BM; nwg = nM * nN; G = G_; c = c_; }
    __host__ __device__ bool next(int i, Unit& u) const {
        const long L = (long)i * G + c; if (L >= nwg) return false;
        int wgid = (int)L; { const int q = nwg / NXCD, r = nwg % NXCD, xcd = wgid % NXCD, off = wgid / NXCD; wgid = (xcd < r ? xcd * (q + 1) : r * (q + 1) + (xcd - r) * q) + off; }
        const int nig = WGM * nN, gid = wgid / nig, fm = gid * WGM, gsz = (nM - fm) < WGM ? (nM - fm) : WGM;
        u.pm = fm + ((wgid % nig) % gsz); u.pn = (wgid % nig) / gsz; return true;
    }
    __device__ __forceinline__ void a_ready(const Unit&) const {}
    __device__ __forceinline__ void done(const Unit&) const {}
};
__device__ __forceinline__ unsigned cvt_pk_bf16(float lo, float hi) { unsigned r; asm volatile("v_cvt_pk_bf16_f32 %0, %1, %2" : "=v"(r) : "v"(lo), "v"(hi)); return r; }
typedef float f32x2 __attribute__((ext_vector_type(2)));
__device__ __forceinline__ f32x2 gelu_pk(f32x2 v) {
    const f32x2 av = __builtin_elementwise_abs(v), d = av * 0.2316418882f + 1.0f;
    f32x2 t; t.x = __builtin_amdgcn_rcpf(d.x); t.y = __builtin_amdgcn_rcpf(d.y);
    f32x2 q = t * 0.5307027145f + (-0.7265760135f); q = q * t + 0.7107068705f; q = q * t + (-0.142248368f); q = q * t + 0.127414796f; q = q * t;
    const f32x2 s = (v * v) * (-0.72134752044f);
    f32x2 e; e.x = __builtin_amdgcn_exp2f(s.x); e.y = __builtin_amdgcn_exp2f(s.y);
    const f32x2 m = v * (q * e), r = v - m;
    f32x2 o; o.x = v.x < 0.f ? m.x : r.x; o.y = v.y < 0.f ? m.y : r.y; return o;
}
template <int ACT  > struct EpiBf16 {
    static constexpr bool PERM = true, AFTER_DRAIN = false;
    bf16_t* O; int ldc; const float* bias; int split_cols; size_t split_stride;
    __device__ __forceinline__ void operator()(const f32x4 (&acc)[2][2][4][2], const Unit& u, int wr, int wc, int fr, int fq) const {
        const int row0 = u.pm * BM + wr * 64 + fr; int colt = u.pn * BM; bf16_t* base = O;
        if (split_cols) { const int t = colt / split_cols; base += (size_t)t * split_stride; colt -= t * split_cols; }
        const int col0 = colt + wc * 32 + 8 * fq, bcol0 = u.pn * BM + wc * 32 + 8 * fq;
        f32x4 bv[2][2];
#pragma unroll
        for (int bj = 0; bj < 2; ++bj)
#pragma unroll
            for (int n = 0; n < 2; ++n) bv[bj][n] = bias ? *(const f32x4*)(bias + bcol0 + bj * HALF + 4 * n) : (f32x4){0.f, 0.f, 0.f, 0.f};
#pragma unroll
        for (int ai = 0; ai < 2; ++ai)
#pragma unroll
            for (int m = 0; m < 4; ++m) { bf16_t* rowp = base + (size_t)(row0 + ai * HALF + m * 16) * ldc + col0;
#pragma unroll
                for (int bj = 0; bj < 2; ++bj) { f32x4 v0 = acc[ai][bj][m][0] + bv[bj][0], v1 = acc[ai][bj][m][1] + bv[bj][1];
                    if (ACT == 1) { f32x2 a = gelu_pk((f32x2){v0[0], v0[1]}), b = gelu_pk((f32x2){v0[2], v0[3]}), c = gelu_pk((f32x2){v1[0], v1[1]}), d = gelu_pk((f32x2){v1[2], v1[3]});
                        v0 = (f32x4){a.x, a.y, b.x, b.y}; v1 = (f32x4){c.x, c.y, d.x, d.y}; }
                    if (ACT == 2) {
#pragma unroll
                        for (int j = 0; j < 4; ++j) { v0[j] = 0.5f * v0[j] * (1.0f + erff(v0[j] * 0.70710678f)); v1[j] = 0.5f * v1[j] * (1.0f + erff(v1[j] * 0.70710678f)); } }
                    u32x4 w; w.x = cvt_pk_bf16(v0[0], v0[1]); w.y = cvt_pk_bf16(v0[2], v0[3]); w.z = cvt_pk_bf16(v1[0], v1[1]); w.w = cvt_pk_bf16(v1[2], v1[3]);
                    *(u32x4*)(rowp + bj * HALF) = w; } }
    }
};
struct EpiAddF32 {
    static constexpr bool PERM = false, AFTER_DRAIN = false;
    float* C; int ldc;
    __device__ __forceinline__ void operator()(const f32x4 (&acc)[2][2][4][2], const Unit& u, int wr, int wc, int fr, int fq) const {
        const int row0 = u.pm * BM + wr * 64 + fr, col0 = u.pn * BM + wc * 32 + 4 * fq;
#pragma unroll
        for (int ai = 0; ai < 2; ++ai)
#pragma unroll
            for (int m = 0; m < 4; ++m) { float* rowp = C + (size_t)(row0 + ai * HALF + m * 16) * ldc + col0;
#pragma unroll
                for (int bj = 0; bj < 2; ++bj)
#pragma unroll
                    for (int n = 0; n < 2; ++n) { f32x4* q = (f32x4*)(rowp + bj * HALF + n * 16); const f32x4 o = *q; *q = o + acc[ai][bj][m][n]; } }
    }
};
struct EpiSwiGLU {
    static constexpr bool PERM = true, AFTER_DRAIN = false;
    bf16_t* H; int ldh;
    __device__ __forceinline__ void operator()(const f32x4 (&acc)[2][2][4][2], const Unit& u, int wr, int wc, int fr, int fq) const {
        typedef unsigned u32x2 __attribute__((ext_vector_type(2)));
        const int row0 = u.pm * BM + wr * 64 + fr;
#pragma unroll
        for (int ai = 0; ai < 2; ++ai)
#pragma unroll
            for (int m = 0; m < 4; ++m) { bf16_t* rowp = H + (size_t)(row0 + ai * HALF + m * 16) * ldh;
#pragma unroll
                for (int bj = 0; bj < 2; ++bj) { const int hcol = ((u.pn * BM + bj * HALF + wc * 32) >> 1) + 4 * fq;
                    const f32x4 a = acc[ai][bj][m][0], b = acc[ai][bj][m][1]; float h[4];
#pragma unroll
                    for (int j = 0; j < 4; ++j) h[j] = a[j] / (1.0f + __expf(-a[j])) * b[j];
                    u32x2 w; w.x = cvt_pk_bf16(h[0], h[1]); w.y = cvt_pk_bf16(h[2], h[3]);
                    *(u32x2*)(rowp + hcol) = w; } }
    }
};
template <class Epi, class Sched, bool STAMP = false>
__device__ __forceinline__ void gemm_phase(PG8_LAS unsigned char* lds, const Gemm g, const Sched& S, const Epi& E, unsigned long long* stamps) {
    const int tid = threadIdx.x, wid = __builtin_amdgcn_readfirstlane(tid >> 6), lane = tid & 63, wr = wid >> 2, wc = wid & 3, fr = lane & 15, fq = lane >> 4;
    const int K = g.K, nt = K / BK;
    int ts_lo = 0, ts_hi = 0, nts = 0; const unsigned long long rt_entry = STAMP ? (unsigned long long)wall_clock64() : 0ull;
#define PG8_STAMP() do { if (STAMP && wid == 0 && nts < 64) { const unsigned long long _c = (unsigned long long)clock64(); \
        ts_lo = (lane == nts) ? (int)(unsigned)_c : ts_lo; ts_hi = (lane == nts) ? (int)(unsigned)(_c >> 32) : ts_hi; ++nts; } } while (0)
    PG8_STAMP();
    unsigned voffA[2], voffB[2];
#pragma unroll
    for (int i = 0; i < 2; ++i) { int R, C; stage_rc(tid * 16 + i * 8192, R, C); const int Rb = Epi::PERM ? ((R & ~31) + perm32(R & 31)) : R;
        voffA[i] = (unsigned)(R * K + C) * 2u; voffB[i] = (unsigned)(Rb * K + C) * 2u; }
    const size_t kstep = (size_t)(BK * 2);
    const size_t hstep = (size_t)HALF * K * 2;
    const size_t tstep = 2 * hstep;
    const unsigned ldsw = (unsigned)wid * 1024u;
    const int aoff = lds_byte(wr * 64 + fr, fq * 8), boff = lds_byte(wc * 32 + fr, fq * 8);
#define PG8_SA(b, h) (((b) * 2 + (h)) * HTB)
#define PG8_SB(b, h) ((4 + (b) * 2 + (h)) * HTB)
#define PG8_STAGE(bufoff, gbase, voff) do { _Pragma("unroll") for (int _i = 0; _i < 2; ++_i) \
        __builtin_amdgcn_global_load_lds((const unsigned*)((const char*)(gbase) + (voff)[_i]), (PG8_LAS unsigned*)(lds + (bufoff) + ldsw + _i * 8192), 16, 0, 0); } while (0)
#define PG8_LDA(dst, b, h) do { _Pragma("unroll") for (int m = 0; m < 4; ++m) _Pragma("unroll") for (int k = 0; k < 2; ++k) dst[m][k] = *(const PG8_LAS bf16x8*)(lds + PG8_SA(b, h) + aoff + m * 2048 + k * 1024); } while (0)
#define PG8_LDB(dst, b, h) do { _Pragma("unroll") for (int n = 0; n < 2; ++n) _Pragma("unroll") for (int k = 0; k < 2; ++k) dst[n][k] = *(const PG8_LAS bf16x8*)(lds + PG8_SB(b, h) + boff + n * 2048 + k * 1024); } while (0)
#define PG8_MMA(ai, bj, At, Bt) do { __builtin_amdgcn_s_setprio(1); _Pragma("unroll") for (int m = 0; m < 4; ++m) _Pragma("unroll") for (int n = 0; n < 2; ++n) _Pragma("unroll") for (int k = 0; k < 2; ++k) \
        acc[ai][bj][m][n] = __builtin_amdgcn_mfma_f32_16x16x32_bf16(Bt[n][k], At[m][k], acc[ai][bj][m][n], 0, 0, 0); __builtin_amdgcn_s_setprio(0); } while (0)
#define PG8_WAIT_V(n) asm volatile("s_waitcnt vmcnt(" #n ")" ::: "memory")
#define PG8_WAIT_L(n) asm volatile("s_waitcnt lgkmcnt(" #n ")" ::: "memory")
#define PG8_BAR __builtin_amdgcn_s_barrier()
#define PG8_SCHED __builtin_amdgcn_sched_barrier(0)
    Unit cur, nxt; int ui = 0;
    if (!S.next(0, cur)) return;
    f32x4 acc[2][2][4][2];
#pragma unroll
    for (int a = 0; a < 2; ++a)
#pragma unroll
        for (int b = 0; b < 2; ++b)
#pragma unroll
            for (int m = 0; m < 4; ++m)
#pragma unroll
                for (int n = 0; n < 2; ++n) acc[a][b][m][n] = (f32x4){0.f, 0.f, 0.f, 0.f};
    bf16x8 At[4][2], B0[2][2], B1[2][2];
    const char* cA = (const char*)g.A + (size_t)cur.pm * tstep; const char* cB = (const char*)g.Bt + (size_t)cur.pn * tstep;
    S.a_ready(cur);
    PG8_STAGE(PG8_SB(0, 0), cB, voffB); PG8_STAGE(PG8_SA(0, 0), cA, voffA); PG8_STAGE(PG8_SB(0, 1), cB + hstep, voffB); PG8_STAGE(PG8_SA(0, 1), cA + hstep, voffA);
    if (wr == 1) PG8_BAR;
    PG8_WAIT_V(4); PG8_BAR;
    PG8_STAGE(PG8_SB(1, 0), cB + kstep, voffB); PG8_STAGE(PG8_SA(1, 0), cA + kstep, voffA); PG8_STAGE(PG8_SB(1, 1), cB + hstep + kstep, voffB);
    PG8_WAIT_V(6); PG8_BAR;
    PG8_STAMP();
    for (;;) {
        const bool has_next = S.next(ui + 1, nxt);
        const char* nA = has_next ? (const char*)g.A + (size_t)nxt.pm * tstep : cA; const char* nB = has_next ? (const char*)g.Bt + (size_t)nxt.pn * tstep : cB;
        for (int t = 0; t < nt; t += 2) {
            const bool last = (t == nt - 2);
            const char* a1 = cA + (size_t)(t + 1) * kstep;
            const char* a2 = last ? nA : cA + (size_t)(t + 2) * kstep; const char* b2 = last ? nB : cB + (size_t)(t + 2) * kstep;
            const char* a3 = a2 + kstep; const char* b3 = b2 + kstep;
            if (last && has_next) S.a_ready(nxt);
            PG8_LDB(B0, 0, 0); PG8_SCHED; PG8_LDA(At, 0, 0); PG8_STAGE(PG8_SA(1, 1), a1 + hstep, voffA);
            PG8_WAIT_L(8); PG8_BAR; PG8_WAIT_L(0); PG8_MMA(0, 0, At, B0); PG8_BAR; PG8_SCHED;
            PG8_LDB(B1, 0, 1); PG8_STAGE(PG8_SB(0, 0), b2, voffB);
            PG8_BAR; PG8_WAIT_L(0); PG8_MMA(0, 1, At, B1); PG8_BAR;
            PG8_LDA(At, 0, 1); PG8_STAGE(PG8_SA(0, 0), a2, voffA);
            PG8_BAR; PG8_WAIT_L(0); PG8_MMA(1, 0, At, B0); PG8_BAR; PG8_SCHED;
            PG8_STAGE(PG8_SB(0, 1), b2 + hstep, voffB);
            PG8_WAIT_V(6); PG8_BAR; PG8_MMA(1, 1, At, B1); PG8_BAR;
            PG8_LDB(B0, 1, 0); PG8_SCHED; PG8_LDA(At, 1, 0); PG8_STAGE(PG8_SA(0, 1), a2 + hstep, voffA);
            PG8_WAIT_L(8); PG8_BAR; PG8_WAIT_L(0); PG8_MMA(0, 0, At, B0); PG8_BAR; PG8_SCHED;
            PG8_LDB(B1, 1, 1); PG8_STAGE(PG8_SB(1, 0), b3, voffB);
            PG8_BAR; PG8_WAIT_L(0); PG8_MMA(0, 1, At, B1); PG8_BAR;
            PG8_LDA(At, 1, 1); PG8_STAGE(PG8_SA(1, 0), a3, voffA);
            PG8_BAR; PG8_WAIT_L(0); PG8_MMA(1, 0, At, B0); PG8_BAR; PG8_SCHED;
            PG8_STAGE(PG8_SB(1, 1), b3 + hstep, voffB);
            PG8_WAIT_V(6); PG8_BAR; PG8_MMA(1, 1, At, B1); PG8_BAR;
        }
        PG8_STAMP();
        if constexpr (!Epi::AFTER_DRAIN) { E(acc, cur, wr, wc, fr, fq); S.done(cur); }
        PG8_STAMP();
        if (!has_next) break;
#pragma unroll
        for (int a = 0; a < 2; ++a)
#pragma unroll
            for (int b = 0; b < 2; ++b)
#pragma unroll
                for (int m = 0; m < 4; ++m)
#pragma unroll
                    for (int n = 0; n < 2; ++n) acc[a][b][m][n] = (f32x4){0.f, 0.f, 0.f, 0.f};
        cur = nxt; cA = nA; cB = nB; ++ui;
    }
    PG8_WAIT_V(0);
    if (wr == 0) PG8_BAR;
    PG8_BAR;
    if constexpr (Epi::AFTER_DRAIN) { E.fused(acc, cur, wr, wc, fr, fq, lds, wid, lane); S.done(cur); }
    PG8_STAMP();
    if (STAMP && wid == 0) { stamps[lane] = lane < nts ? (((unsigned long long)(unsigned)ts_hi << 32) | (unsigned)ts_lo) : 0ull;
        if (lane == 62) stamps[62] = rt_entry; if (lane == 63) stamps[63] = (unsigned long long)wall_clock64(); }
#undef PG8_STAMP
#undef PG8_SA
#undef PG8_SB
#undef PG8_STAGE
#undef PG8_LDA
#undef PG8_LDB
#undef PG8_MMA
#undef PG8_WAIT_V
#undef PG8_WAIT_L
#undef PG8_BAR
#undef PG8_SCHED
}
}
#define LAS __attribute__((address_space(3)))
typedef LAS unsigned char* LDSp;
typedef pg8::bf16_t bf16_t;
typedef unsigned u32x4 __attribute__((ext_vector_type(4)));
typedef unsigned u32x2 __attribute__((ext_vector_type(2)));
typedef float f32x4 __attribute__((ext_vector_type(4)));
typedef float f32x2 __attribute__((ext_vector_type(2)));

#ifndef EVP_SKIP
#define EVP_SKIP 0
#endif
constexpr int T_ = 16384, D_ = 1024, S_ = 4096, NTHR = 512;
constexpr int LDS_BYTES = 147456;
constexpr size_t MiB = 1048576;
constexpr size_t WS_WB = 0, WS_HN = 25 * MiB, WS_Z = 57 * MiB, WS_QKV = 153 * MiB, WS_OF = 201 * MiB, WS_OB = 217 * MiB,
                 WS_GATES = 233 * MiB, WS_BETA = 234 * MiB, WS_LA = 234 * MiB + 524288;
constexpr size_t WB_IN = 0, WB_OUT = 6291456, WB_UP = 8388608, WB_DN = 19922944;
constexpr int DFF = 2816;

struct Params { const float* in[26]; float* out; unsigned char* ws; };

__device__ __forceinline__ float bf2f(unsigned short b) { return __uint_as_float(((unsigned)b) << 16); }
__device__ __forceinline__ float bflo(unsigned u) { return __uint_as_float(u << 16); }
__device__ __forceinline__ float bfhi(unsigned u) { return __uint_as_float(u & 0xffff0000u); }
__device__ __forceinline__ unsigned short f2bf(float f) { unsigned u = __float_as_uint(f); u += 0x7FFFu + ((u >> 16) & 1u); return (unsigned short)(u >> 16); }
__device__ __forceinline__ unsigned pk2(float lo, float hi) { return pg8::cvt_pk_bf16(lo, hi); }
__device__ __forceinline__ float sigm(float x) { return 1.0f / (1.0f + __expf(-x)); }
__device__ __forceinline__ float silu_(float x) { return x * sigm(x); }
__device__ __forceinline__ float gelu_t(float x) { const float u = 0.7978845608028654f * (x + 0.044715f * x * x * x); const float t = 1.0f - 2.0f / (1.0f + __expf(2.0f * u)); return 0.5f * x * (1.0f + t); }
__device__ __forceinline__ float softplus_(float x) { return x > 20.0f ? x : log1pf(expf(x)); }
__device__ __forceinline__ float wave_sum(float v) {
#pragma unroll
    for (int o = 32; o; o >>= 1) v += __shfl_xor(v, o);
    return v; }
template <int CTRL> __device__ __forceinline__ float dppf(float v) { return __int_as_float(__builtin_amdgcn_update_dpp(0, __float_as_int(v), CTRL, 0xf, 0xf, true)); }
__device__ __forceinline__ float row16_sum(float v) { v += dppf<0xB1>(v); v += dppf<0x4E>(v); v += dppf<0x141>(v); v += dppf<0x140>(v); return v; }
__device__ __forceinline__ void unpack8(const u32x4 w, float (&f)[8]) { f[0] = bflo(w.x); f[1] = bfhi(w.x); f[2] = bflo(w.y); f[3] = bfhi(w.y); f[4] = bflo(w.z); f[5] = bfhi(w.z); f[6] = bflo(w.w); f[7] = bfhi(w.w); }

__device__ __forceinline__ void conv_job(LDSp lds, const float* __restrict__ src, int ldn, int K, int col0, int ncols, bf16_t* __restrict__ dst, int mode, int off) {
    LAS float* tl = (LAS float*)lds;
    const int tid = threadIdx.x, nnt = ncols >> 6, ntl = (K >> 6) * nnt;
    for (int tile = blockIdx.x; tile < ntl; tile += gridDim.x) {
        const int kt = tile / nnt, nt = tile - kt * nnt;
        const int r = tid >> 4, c4 = (tid & 15) << 2;
#pragma unroll
        for (int i = 0; i < 2; ++i) { const int k = r + 32 * i; const f32x4 v = *(const f32x4*)(src + (size_t)(kt * 64 + k) * ldn + col0 + nt * 64 + c4);
            tl[k * 65 + c4 + 0] = v.x; tl[k * 65 + c4 + 1] = v.y; tl[k * 65 + c4 + 2] = v.z; tl[k * 65 + c4 + 3] = v.w; }
        __syncthreads();
        const int n = tid >> 3, k8 = (tid & 7) << 3; float f[8];
#pragma unroll
        for (int j = 0; j < 8; ++j) f[j] = tl[(k8 + j) * 65 + n];
        u32x4 w; w.x = pk2(f[0], f[1]); w.y = pk2(f[2], f[3]); w.z = pk2(f[4], f[5]); w.w = pk2(f[6], f[7]);
        const int ncol = nt * 64 + n;
        const int row = mode == 0 ? off + ncol : ((ncol >> 4) << 5) + (((ncol >> 2) & 3) << 3) + (ncol & 3) + off;
        *(u32x4*)(dst + (size_t)row * K + kt * 64 + k8) = w;
        __syncthreads();
    }
}
__device__ __forceinline__ void convert_layer(LDSp lds, const Params& p, int L) {
    bf16_t* wb = (bf16_t*)(p.ws + WS_WB);
    if (L == 0) { conv_job(lds, p.in[2], 3088, 1024, 0, 3072, (bf16_t*)((char*)wb + WB_IN), 0, 0);
                  conv_job(lds, p.in[11], 1024, 1024, 0, 1024, (bf16_t*)((char*)wb + WB_OUT), 0, 0); }
    else        { conv_job(lds, p.in[12], 2576, 1024, 0, 2560, (bf16_t*)((char*)wb + WB_IN), 0, 0);
                  conv_job(lds, p.in[20], 1024, 1024, 0, 1024, (bf16_t*)((char*)wb + WB_OUT), 0, 0); }
    conv_job(lds, p.in[22] + (size_t)L * 1024 * DFF, DFF, 1024, 0, DFF, (bf16_t*)((char*)wb + WB_UP), 1, 0);
    conv_job(lds, p.in[23] + (size_t)L * 1024 * DFF, DFF, 1024, 0, DFF, (bf16_t*)((char*)wb + WB_UP), 1, 4);
    conv_job(lds, p.in[24] + (size_t)L * DFF * 1024, 1024, DFF, 0, 1024, (bf16_t*)((char*)wb + WB_DN), 0, 0);
}

__device__ __forceinline__ void rms_phase(LDSp lds, const float* src, const float* __restrict__ g, bf16_t* hn, float* copy_out, float* final_out,
                                          const float* __restrict__ gw, int gw_ld, int gw_col0, float* gates) {
    LAS float* wg = (LAS float*)lds;
    const int tid = threadIdx.x, lane = tid & 63, wid = tid >> 6;
    if (gw) { for (int idx = tid; idx < 16384; idx += NTHR) { const int k = idx >> 4, j = idx & 15; wg[j * 1024 + k] = gw[(size_t)k * gw_ld + gw_col0 + j]; } __syncthreads(); }
    f32x4 gv[4];
#pragma unroll
    for (int i = 0; i < 4; ++i) gv[i] = *(const f32x4*)(g + 4 * lane + 256 * i);
    for (int row = blockIdx.x * 8 + wid; row < T_; row += gridDim.x * 8) {
        const float* xr = src + (size_t)row * D_;
        f32x4 x[4]; float ss = 0.f;
#pragma unroll
        for (int i = 0; i < 4; ++i) { x[i] = *(const f32x4*)(xr + 4 * lane + 256 * i); ss += x[i].x * x[i].x + x[i].y * x[i].y + x[i].z * x[i].z + x[i].w * x[i].w; }
        if (copy_out) {
#pragma unroll
            for (int i = 0; i < 4; ++i) *(f32x4*)(copy_out + (size_t)row * D_ + 4 * lane + 256 * i) = x[i]; }
        ss = wave_sum(ss);
        const float rstd = rsqrtf(ss * (1.0f / 1024.0f) + 1e-6f);
        f32x4 y[4];
#pragma unroll
        for (int i = 0; i < 4; ++i) y[i] = x[i] * rstd * gv[i];
        if (final_out) {
#pragma unroll
            for (int i = 0; i < 4; ++i) *(f32x4*)(final_out + (size_t)row * D_ + 4 * lane + 256 * i) = y[i];
        } else {
#pragma unroll
            for (int i = 0; i < 4; ++i) { u32x2 w; w.x = pk2(y[i].x, y[i].y); w.y = pk2(y[i].z, y[i].w); *(u32x2*)(hn + (size_t)row * D_ + 4 * lane + 256 * i) = w; }
        }
        if (gw) {
            float s[16];
#pragma unroll
            for (int j = 0; j < 16; ++j) { float a = 0.f;
#pragma unroll
                for (int i = 0; i < 4; ++i) { const f32x4 w = *(const LAS f32x4*)(wg + j * 1024 + 4 * lane + 256 * i); a += y[i].x * w.x + y[i].y * w.y + y[i].z * w.z + y[i].w * w.w; }
                s[j] = wave_sum(a); }
            if (lane == 0) {
#pragma unroll
                for (int q = 0; q < 4; ++q) *(f32x4*)(gates + (size_t)row * 16 + 4 * q) = (f32x4){s[4 * q], s[4 * q + 1], s[4 * q + 2], s[4 * q + 3]}; }
        }
    }
    __syncthreads();
}

__device__ __forceinline__ void even_prep(LDSp lds, const Params& p) {
    const bf16_t* Z = (const bf16_t*)(p.ws + WS_Z); bf16_t* Y = (bf16_t*)(p.ws + WS_HN); bf16_t* QKVN = (bf16_t*)(p.ws + WS_QKV);
    const float* gates = (const float*)(p.ws + WS_GATES); float* BETA = (float*)(p.ws + WS_BETA); float* LA = (float*)(p.ws + WS_LA);
    const float* conv_w = p.in[3]; const float* conv_b = p.in[4]; const float* ln_g = p.in[5]; const float* ln_b = p.in[6];
    const float* dn_w = p.in[7]; const float* a_log = p.in[8]; const float* dt_bias = p.in[9];
    LAS float* glu = (LAS float*)lds;
    const int tid = threadIdx.x, lane = tid & 63, wid = tid >> 6, c = tid;
    for (int tile = blockIdx.x; tile < T_ / 32; tile += gridDim.x) {
        const int t0 = tile * 32, b = t0 >> 12, s0 = t0 & 4095;
#if !(EVP_SKIP & 1)
        for (int it = tid; it < 62 * 64; it += NTHR) { const int r = it >> 6, c8 = (it & 63) << 3, sp = s0 - 15 + r;
            f32x4 o0 = {0.f, 0.f, 0.f, 0.f}, o1 = {0.f, 0.f, 0.f, 0.f};
            if (sp >= 0 && sp < S_) { const size_t tok = (size_t)b * S_ + sp; const u32x4 av = *(const u32x4*)(Z + tok * 3072 + c8); const u32x4 gv = *(const u32x4*)(Z + tok * 3072 + 512 + c8);
                float a[8], g[8]; unpack8(av, a); unpack8(gv, g);
                o0 = (f32x4){a[0] * sigm(g[0]), a[1] * sigm(g[1]), a[2] * sigm(g[2]), a[3] * sigm(g[3])}; o1 = (f32x4){a[4] * sigm(g[4]), a[5] * sigm(g[5]), a[6] * sigm(g[6]), a[7] * sigm(g[7])}; }
            *(LAS f32x4*)(glu + r * 512 + c8) = o0; *(LAS f32x4*)(glu + r * 512 + c8 + 4) = o1; }
        __syncthreads();
        {
            float cw[31];
#pragma unroll
            for (int w = 0; w < 31; ++w) cw[w] = conv_w[w * 512 + c];
            const float cb = conv_b[c];
            f32x4 res[8];
#pragma unroll
            for (int t4 = 0; t4 < 8; ++t4) {
                float x[34];
#pragma unroll
                for (int i = 0; i < 34; ++i) x[i] = glu[(t4 * 4 + i) * 512 + c];
                float a0 = cb, a1 = cb, a2 = cb, a3 = cb;
#pragma unroll
                for (int w = 0; w < 31; ++w) { a0 = fmaf(x[w], cw[w], a0); a1 = fmaf(x[w + 1], cw[w], a1); a2 = fmaf(x[w + 2], cw[w], a2); a3 = fmaf(x[w + 3], cw[w], a3); }
                res[t4] = (f32x4){a0, a1, a2, a3};
            }
            __syncthreads();
#pragma unroll
            for (int t4 = 0; t4 < 8; ++t4) { glu[(t4 * 4 + 0) * 512 + c] = res[t4].x; glu[(t4 * 4 + 1) * 512 + c] = res[t4].y; glu[(t4 * 4 + 2) * 512 + c] = res[t4].z; glu[(t4 * 4 + 3) * 512 + c] = res[t4].w; }
        }
        __syncthreads();
        {
            const f32x4 g0 = *(const f32x4*)(ln_g + 4 * lane), g1 = *(const f32x4*)(ln_g + 256 + 4 * lane), b0 = *(const f32x4*)(ln_b + 4 * lane), b1 = *(const f32x4*)(ln_b + 256 + 4 * lane);
#pragma unroll
            for (int tt = 0; tt < 4; ++tt) { const int t = wid * 4 + tt;
                const f32x4 x0 = *(const LAS f32x4*)(glu + t * 512 + 4 * lane), x1 = *(const LAS f32x4*)(glu + t * 512 + 256 + 4 * lane);
                const float mean = wave_sum((x0.x + x0.y) + (x0.z + x0.w) + (x1.x + x1.y) + (x1.z + x1.w)) * (1.0f / 512.0f);
                const f32x4 d0 = x0 - mean, d1 = x1 - mean;
                const float var = wave_sum(d0.x * d0.x + d0.y * d0.y + d0.z * d0.z + d0.w * d0.w + d1.x * d1.x + d1.y * d1.y + d1.z * d1.z + d1.w * d1.w) * (1.0f / 512.0f);
                const float rstd = rsqrtf(var + 1e-5f);
                const f32x4 y0 = d0 * rstd * g0 + b0, y1 = d1 * rstd * g1 + b1;
                u32x2 w0, w1; w0.x = pk2(silu_(y0.x), silu_(y0.y)); w0.y = pk2(silu_(y0.z), silu_(y0.w)); w1.x = pk2(silu_(y1.x), silu_(y1.y)); w1.y = pk2(silu_(y1.z), silu_(y1.w));
                *(u32x2*)(Y + (size_t)(t0 + t) * 1024 + 4 * lane) = w0; *(u32x2*)(Y + (size_t)(t0 + t) * 1024 + 256 + 4 * lane) = w1; }
        }
        __syncthreads();
#endif
#if !(EVP_SKIP & 2)
#pragma unroll 1
        for (int gi = 0; gi < 3; ++gi) {
            const int col = 1024 + gi * 512 + c;
            float w5[5];
#pragma unroll
            for (int w = 0; w < 5; ++w) w5[w] = dn_w[w * 1536 + gi * 512 + c];
            const bf16_t* zc = Z + (size_t)b * S_ * 3072 + col;
#define ZLD(sp) (((sp) >= 0 && (sp) < S_) ? bf2f(zc[(size_t)(sp) * 3072]) : 0.f)
            float x0 = ZLD(s0 - 2), x1 = ZLD(s0 - 1), x2 = ZLD(s0), x3 = ZLD(s0 + 1);
#pragma unroll 4
            for (int t = 0; t < 32; ++t) { const float x4 = ZLD(s0 + t + 2);
                float v = x0 * w5[0]; v = fmaf(x1, w5[1], v); v = fmaf(x2, w5[2], v); v = fmaf(x3, w5[3], v); v = fmaf(x4, w5[4], v);
                v = silu_(v);
                if (gi == 2) QKVN[(size_t)(t0 + t) * 1536 + 1024 + c] = f2bf(v); else glu[t * 512 + c] = v;
                x0 = x1; x1 = x2; x2 = x3; x3 = x4; }
#undef ZLD
            if (gi < 2) {
                __syncthreads();
                const float qs = gi == 0 ? 0.08838834764831845f : 1.0f;
#pragma unroll 4
                for (int pp = 0; pp < 16; ++pp) { const int pr = wid * 16 + pp, t = pr >> 2, hd = pr & 3;
                    const f32x2 x = *(const LAS f32x2*)(glu + t * 512 + hd * 128 + 2 * lane);
                    const float ss = wave_sum(x.x * x.x + x.y * x.y); const float sc = rsqrtf(ss + 1e-6f) * qs;
                    *(unsigned*)(QKVN + (size_t)(t0 + t) * 1536 + gi * 512 + hd * 128 + 2 * lane) = pk2(x.x * sc, x.y * sc); }
                __syncthreads();
            }
        }
#endif
#if !(EVP_SKIP & 4)
        if (tid < 256) { const int t = tid >> 3, j = tid & 7; const size_t tok = (size_t)(t0 + t);
            const float bp = gates[tok * 16 + j], ap = gates[tok * 16 + 8 + j];
            BETA[tok * 8 + j] = sigm(bp); LA[tok * 8 + j] = -expf(a_log[j]) * softplus_(ap + dt_bias[j]); }
#endif
        __syncthreads();
    }
}

__device__ __forceinline__ void delta_scan(LDSp lds, const Params& p) {
    const bf16_t* QKVN = (const bf16_t*)(p.ws + WS_QKV); const float* BETA = (const float*)(p.ws + WS_BETA); const float* LA = (const float*)(p.ws + WS_LA);
    const int tid = threadIdx.x, jl = tid >> 4, sub = tid & 15;
    constexpr int BUF = 37376;
    LAS float* ost = (LAS float*)(lds + 2 * BUF);
    for (int unit = blockIdx.x; unit < 128; unit += gridDim.x) {
        const int dir = unit >> 6, b = (unit >> 4) & 3, h = (unit >> 2) & 3, sl = unit & 3;
        bf16_t* O = (bf16_t*)(p.ws + (dir ? WS_OB : WS_OF));
        float S[8];
#pragma unroll
        for (int i = 0; i < 8; ++i) S[i] = 0.f;
        u32x4 rq[4]; u32x4 rv = {0u, 0u, 0u, 0u}; float ra = 0.f, rb = 0.f;
#define DS_TOK(n, s) ((size_t)b * S_ + (dir ? (S_ - 1 - ((n) * 64 + (s))) : ((n) * 64 + (s))))
#define DS_LOAD(n) do { _Pragma("unroll") for (int i = 0; i < 4; ++i) { const int pi = tid + NTHR * i, s = pi >> 5, w16 = pi & 31; \
            rq[i] = *(const u32x4*)(QKVN + DS_TOK(n, s) * 1536 + (w16 >> 4) * 512 + h * 128 + (w16 & 15) * 8); } \
        if (tid < 256) { const int s = tid >> 2, c8 = tid & 3; rv = *(const u32x4*)(QKVN + DS_TOK(n, s) * 1536 + 1024 + h * 128 + sl * 32 + c8 * 8); } \
        if (tid < 64) { const size_t tk = DS_TOK(n, tid); ra = expf(LA[tk * 8 + dir * 4 + h]); rb = BETA[tk * 8 + dir * 4 + h]; } } while (0)
#define DS_STORE(bufp) do { _Pragma("unroll") for (int i = 0; i < 4; ++i) { const int pi = tid + NTHR * i; *(LAS u32x4*)((bufp) + pi * 16) = rq[i]; } \
        if (tid < 256) *(LAS u32x4*)((bufp) + 32768 + tid * 16) = rv; \
        if (tid < 64) { *(LAS float*)((bufp) + 36864 + tid * 8) = ra; *(LAS float*)((bufp) + 36864 + tid * 8 + 4) = rb; } } while (0)
        DS_LOAD(0); DS_STORE(lds); __syncthreads();
#pragma unroll 1
        for (int n = 0; n < 64; ++n) {
            LDSp cb = lds + (n & 1) * BUF; LDSp nb = lds + ((n + 1) & 1) * BUF; LAS float* os = ost + (n & 1) * 2048;
            if (n < 63) DS_LOAD(n + 1);
#pragma unroll 4
            for (int s = 0; s < 64; ++s) {
                const u32x4 qq = *(const LAS u32x4*)(cb + s * 512 + sub * 16), kk = *(const LAS u32x4*)(cb + s * 512 + 256 + sub * 16);
                const float vj = bf2f(*(const LAS unsigned short*)(cb + 32768 + s * 64 + jl * 2));
                const float al = *(const LAS float*)(cb + 36864 + s * 8), be = *(const LAS float*)(cb + 36864 + s * 8 + 4);
                float kf[8], qf[8]; unpack8(kk, kf); unpack8(qq, qf);
                float ks = 0.f;
#pragma unroll
                for (int i = 0; i < 8; ++i) ks = fmaf(kf[i], S[i], ks);
                ks = row16_sum(ks);
                const float cc = be * (vj - al * ks);
                float o = 0.f;
#pragma unroll
                for (int i = 0; i < 8; ++i) { S[i] = fmaf(kf[i], cc, al * S[i]); o = fmaf(qf[i], S[i], o); }
                o = row16_sum(o);
                if (sub == 0) os[s * 32 + jl] = o;
            }
            if (n < 63) DS_STORE(nb);
            __syncthreads();
            { const int s = tid >> 3, j4 = (tid & 7) << 2; const f32x4 o4 = *(const LAS f32x4*)(os + s * 32 + j4);
              u32x2 w; w.x = pk2(o4.x, o4.y); w.y = pk2(o4.z, o4.w);
              *(u32x2*)(O + DS_TOK(n, s) * 512 + h * 128 + sl * 32 + j4) = w; }
        }
        __syncthreads();
#undef DS_LOAD
#undef DS_STORE
#undef DS_TOK
    }
}

__device__ __forceinline__ void headnorm_phase(const Params& p, const float* __restrict__ g, int zld, int zcol, int act) {
    const bf16_t* OF = (const bf16_t*)(p.ws + WS_OF); const bf16_t* OB = (const bf16_t*)(p.ws + WS_OB); const bf16_t* Z = (const bf16_t*)(p.ws + WS_Z); bf16_t* Y = (bf16_t*)(p.ws + WS_HN);
    const int tid = threadIdx.x, lane = tid & 63, wid = tid >> 6, c = lane * 8;
    const f32x4 g0 = *(const f32x4*)(g + (c & 127)), g1 = *(const f32x4*)(g + (c & 127) + 4);
    for (int tok = blockIdx.x * 8 + wid; tok < T_; tok += gridDim.x * 8) {
        const u32x4 a = *(const u32x4*)(OF + (size_t)tok * 512 + c), bq = *(const u32x4*)(OB + (size_t)tok * 512 + c), gz = *(const u32x4*)(Z + (size_t)tok * zld + zcol + c);
        float fa[8], fb[8], fg[8], o[8]; unpack8(a, fa); unpack8(bq, fb); unpack8(gz, fg);
        float ss = 0.f;
#pragma unroll
        for (int i = 0; i < 8; ++i) { o[i] = fa[i] + fb[i]; ss = fmaf(o[i], o[i], ss); }
        ss = row16_sum(ss);
        const float rstd = rsqrtf(ss * (1.0f / 128.0f) + 1e-6f);
        const float gg[8] = {g0.x, g0.y, g0.z, g0.w, g1.x, g1.y, g1.z, g1.w};
        float y[8];
#pragma unroll
        for (int i = 0; i < 8; ++i) y[i] = o[i] * rstd * gg[i] * (act == 0 ? silu_(fg[i]) : sigm(fg[i]));
        u32x4 w; w.x = pk2(y[0], y[1]); w.y = pk2(y[2], y[3]); w.z = pk2(y[4], y[5]); w.w = pk2(y[6], y[7]);
        *(u32x4*)(Y + (size_t)tok * 1024 + 512 + c) = w;
    }
}

__device__ __forceinline__ void odd_prep(const Params& p) {
    const bf16_t* Z = (const bf16_t*)(p.ws + WS_Z); bf16_t* VV = (bf16_t*)(p.ws + WS_QKV);
    const float* gates = (const float*)(p.ws + WS_GATES); float* LI = (float*)(p.ws + WS_BETA); float* LF = (float*)(p.ws + WS_LA);
    const float* ln_g = p.in[13]; const float* ln_b = p.in[14]; const float* ib = p.in[17]; const float* fb = p.in[18];
    const int tid = threadIdx.x, lane = tid & 63, wid = tid >> 6, c = lane * 8;
    const f32x4 g0 = *(const f32x4*)(ln_g + c), g1 = *(const f32x4*)(ln_g + c + 4), b0 = *(const f32x4*)(ln_b + c), b1 = *(const f32x4*)(ln_b + c + 4);
    const float gg[8] = {g0.x, g0.y, g0.z, g0.w, g1.x, g1.y, g1.z, g1.w}, bb[8] = {b0.x, b0.y, b0.z, b0.w, b1.x, b1.y, b1.z, b1.w};
    for (int tok = blockIdx.x * 8 + wid; tok < T_; tok += gridDim.x * 8) {
        const u32x4 v = *(const u32x4*)(Z + (size_t)tok * 2560 + 512 + c);
        float x[8]; unpack8(v, x); float sm = 0.f;
#pragma unroll
        for (int i = 0; i < 8; ++i) { x[i] = gelu_t(x[i]); sm += x[i]; }
        const float mean = wave_sum(sm) * (1.0f / 512.0f); float sq = 0.f;
#pragma unroll
        for (int i = 0; i < 8; ++i) { x[i] -= mean; sq = fmaf(x[i], x[i], sq); }
        const float rstd = rsqrtf(wave_sum(sq) * (1.0f / 512.0f) + 1e-5f);
        float y[8];
#pragma unroll
        for (int i = 0; i < 8; ++i) y[i] = x[i] * rstd * gg[i] + bb[i];
        u32x4 w; w.x = pk2(y[0], y[1]); w.y = pk2(y[2], y[3]); w.z = pk2(y[4], y[5]); w.w = pk2(y[6], y[7]);
        *(u32x4*)(VV + (size_t)tok * 512 + c) = w;
        if (lane < 8) { LI[(size_t)tok * 8 + lane] = gates[(size_t)tok * 16 + lane] + ib[lane];
                        LF[(size_t)tok * 8 + lane] = -softplus_(-(gates[(size_t)tok * 16 + 8 + lane] + fb[lane])); }
    }
}

__device__ __forceinline__ void sg_phase(LDSp lds, const Params& p, int sgId, int sgG) {
    typedef short bf16x8 __attribute__((ext_vector_type(8)));
    const bf16_t* Z = (const bf16_t*)(p.ws + WS_Z); const bf16_t* VV = (const bf16_t*)(p.ws + WS_QKV); bf16_t* Y = (bf16_t*)(p.ws + WS_HN);
    const float* sgw = p.in[15]; const float* sgb = p.in[16];
    LAS unsigned short* Wb = (LAS unsigned short*)lds;
    LAS unsigned short* Vt = (LAS unsigned short*)(lds + 34816);
    const int tid = threadIdx.x, lane = tid & 63, wid = tid >> 6;
    for (int unit = sgId; unit < 512; unit += sgG) {
        const int g = unit & 3, n = (unit >> 2) & 31, b = unit >> 7; const size_t tok0 = (size_t)b * S_ + n * 128;
#pragma unroll
        for (int i = 0; i < 8; ++i) { const int i4 = tid + NTHR * i, t = i4 >> 5, s4 = (i4 & 31) << 2; const f32x4 w = *(const f32x4*)(sgw + (size_t)g * 16384 + t * 128 + s4);
            u32x2 o; o.x = pk2(w.x, w.y); o.y = pk2(w.z, w.w); *(LAS u32x2*)(Wb + t * 136 + s4) = o; }
#pragma unroll
        for (int i = 0; i < 4; ++i) { const int pi = tid + NTHR * i, s = pi >> 4, c8 = (pi & 15) << 3; const u32x4 v = *(const u32x4*)(VV + (tok0 + s) * 512 + g * 128 + c8);
            Vt[(c8 + 0) * 136 + s] = (unsigned short)(v.x & 0xffffu); Vt[(c8 + 1) * 136 + s] = (unsigned short)(v.x >> 16);
            Vt[(c8 + 2) * 136 + s] = (unsigned short)(v.y & 0xffffu); Vt[(c8 + 3) * 136 + s] = (unsigned short)(v.y >> 16);
            Vt[(c8 + 4) * 136 + s] = (unsigned short)(v.z & 0xffffu); Vt[(c8 + 5) * 136 + s] = (unsigned short)(v.z >> 16);
            Vt[(c8 + 6) * 136 + s] = (unsigned short)(v.w & 0xffffu); Vt[(c8 + 7) * 136 + s] = (unsigned short)(v.w >> 16); }
        __syncthreads();
        bf16x8 af[4];
#pragma unroll
        for (int ks = 0; ks < 4; ++ks) af[ks] = *(const LAS bf16x8*)(Wb + (16 * wid + (lane & 15)) * 136 + ks * 32 + (lane >> 4) * 8);
#pragma unroll
        for (int nn = 0; nn < 8; ++nn) {
            f32x4 acc = {0.f, 0.f, 0.f, 0.f};
#pragma unroll
            for (int ks = 0; ks < 4; ++ks) { const bf16x8 bfrag = *(const LAS bf16x8*)(Vt + (16 * nn + (lane & 15)) * 136 + ks * 32 + (lane >> 4) * 8);
                acc = __builtin_amdgcn_mfma_f32_16x16x32_bf16(af[ks], bfrag, acc, 0, 0, 0); }
            const int cc = g * 128 + 16 * nn + (lane & 15);
#pragma unroll
            for (int i = 0; i < 4; ++i) { const int t = 16 * wid + (lane >> 4) * 4 + i; const size_t tok = tok0 + t;
                const float u = gelu_t(bf2f(Z[tok * 2560 + cc]));
                Y[tok * 1024 + cc] = f2bf(u * (acc[i] + sgb[g * 128 + t])); }
        }
        __syncthreads();
    }
}

__device__ __forceinline__ void mlstm_scan(LDSp lds, const Params& p) {
    const bf16_t* Z = (const bf16_t*)(p.ws + WS_Z); const float* LI = (const float*)(p.ws + WS_BETA); const float* LF = (const float*)(p.ws + WS_LA);
    const int tid = threadIdx.x, jl = tid >> 4, sub = tid & 15;
    constexpr int BUF = 20992;
    LAS float* ost = (LAS float*)(lds + 2 * BUF);
    for (int unit = blockIdx.x; unit < 128; unit += gridDim.x) {
        const int dir = unit >> 6, b = (unit >> 4) & 3, h = (unit >> 2) & 3, sl = unit & 3;
        bf16_t* O = (bf16_t*)(p.ws + (dir ? WS_OB : WS_OF));
        float C[4], N[4];
#pragma unroll
        for (int i = 0; i < 4; ++i) { C[i] = 0.f; N[i] = 0.f; }
        u32x4 rq, rk, rv = {0u, 0u, 0u, 0u}; float ri = 0.f, rf = 0.f;
#define ML_TOK(n, s) ((size_t)b * S_ + (dir ? (S_ - 1 - ((n) * 64 + (s))) : ((n) * 64 + (s))))
#define ML_LOAD(n) do { { const int s = tid >> 3, c8 = tid & 7; const size_t tk = ML_TOK(n, s); \
            rq = *(const u32x4*)(Z + tk * 2560 + 1024 + h * 64 + c8 * 8); rk = *(const u32x4*)(Z + tk * 2560 + 1280 + h * 64 + c8 * 8); } \
        if (tid < 256) { const int s = tid >> 2, c8 = tid & 3; rv = *(const u32x4*)(Z + ML_TOK(n, s) * 2560 + 1536 + h * 128 + sl * 32 + c8 * 8); } \
        if (tid < 64) { const size_t tk = ML_TOK(n, tid); ri = expf(LI[tk * 8 + dir * 4 + h]); rf = expf(LF[tk * 8 + dir * 4 + h]); } } while (0)
#define ML_STORE(bufp) do { *(LAS u32x4*)((bufp) + tid * 16) = rq; *(LAS u32x4*)((bufp) + 8192 + tid * 16) = rk; \
        if (tid < 256) *(LAS u32x4*)((bufp) + 16384 + tid * 16) = rv; \
        if (tid < 64) { *(LAS float*)((bufp) + 20480 + tid * 8) = ri; *(LAS float*)((bufp) + 20480 + tid * 8 + 4) = rf; } } while (0)
        ML_LOAD(0); ML_STORE(lds); __syncthreads();
#pragma unroll 1
        for (int n = 0; n < 64; ++n) {
            LDSp cb = lds + (n & 1) * BUF; LDSp nb = lds + ((n + 1) & 1) * BUF; LAS float* os = ost + (n & 1) * 2048;
            if (n < 63) ML_LOAD(n + 1);
#pragma unroll 4
            for (int s = 0; s < 64; ++s) {
                const u32x2 qq = *(const LAS u32x2*)(cb + s * 128 + sub * 8), kk = *(const LAS u32x2*)(cb + 8192 + s * 128 + sub * 8);
                const float vj = bf2f(*(const LAS unsigned short*)(cb + 16384 + s * 64 + jl * 2));
                const float ig = *(const LAS float*)(cb + 20480 + s * 8), fg = *(const LAS float*)(cb + 20480 + s * 8 + 4);
                const float qf[4] = {bflo(qq.x), bfhi(qq.x), bflo(qq.y), bfhi(qq.y)}, kf[4] = {bflo(kk.x), bfhi(kk.x), bflo(kk.y), bfhi(kk.y)};
                const float iv = ig * vj; float num = 0.f, den = 0.f;
#pragma unroll
                for (int i = 0; i < 4; ++i) { C[i] = fmaf(iv, kf[i], fg * C[i]); N[i] = fmaf(ig, kf[i], fg * N[i]); num = fmaf(qf[i], C[i], num); den = fmaf(qf[i], N[i], den); }
                num = row16_sum(num); den = row16_sum(den);
                if (sub == 0) os[s * 32 + jl] = 0.125f * num / fmaxf(fabsf(0.125f * den), 1.0f);
            }
            if (n < 63) ML_STORE(nb);
            __syncthreads();
            { const int s = tid >> 3, j4 = (tid & 7) << 2; const f32x4 o4 = *(const LAS f32x4*)(os + s * 32 + j4);
              u32x2 w; w.x = pk2(o4.x, o4.y); w.y = pk2(o4.z, o4.w);
              *(u32x2*)(O + ML_TOK(n, s) * 512 + h * 128 + sl * 32 + j4) = w; }
        }
        __syncthreads();
#undef ML_LOAD
#undef ML_STORE
#undef ML_TOK
    }
}

#ifndef N_PHASES
#define N_PHASES 19
#endif
template <int L, int SUB> __device__ __forceinline__ void run_phase(LDSp lds, const Params& p) {
    unsigned char* ws = p.ws;
    bf16_t* HN = (bf16_t*)(ws + WS_HN); bf16_t* Zb = (bf16_t*)(ws + WS_Z); float* h = p.out; float* gates = (float*)(ws + WS_GATES);
    const bf16_t* W_IN = (const bf16_t*)(ws + WS_WB + WB_IN); const bf16_t* W_OUT = (const bf16_t*)(ws + WS_WB + WB_OUT);
    const bf16_t* W_UP = (const bf16_t*)(ws + WS_WB + WB_UP); const bf16_t* W_DN = (const bf16_t*)(ws + WS_WB + WB_DN);
    const int G = gridDim.x;
    if constexpr (L == 2) { rms_phase(lds, h, p.in[25], nullptr, nullptr, h, nullptr, 0, 0, nullptr); }
    else if constexpr (SUB == 0) {
        convert_layer(lds, p, L);
        if constexpr (L == 0) rms_phase(lds, p.in[0], p.in[1], HN, h, nullptr, p.in[2], 3088, 3072, gates);
        else                  rms_phase(lds, h, p.in[1] + 1024, HN, nullptr, nullptr, p.in[12], 2576, 2560, gates);
    } else if constexpr (SUB == 1) { constexpr int N = L == 0 ? 3072 : 2560;
        pg8::Gemm g{HN, W_IN, T_, N, 1024}; pg8::StaticOrder S; S.init(T_, N, G, (int)blockIdx.x);
        pg8::EpiBf16<0> E{Zb, N, nullptr, 0, 0};
        pg8::gemm_phase<pg8::EpiBf16<0>, pg8::StaticOrder>(lds, g, S, E, nullptr);
    } else if constexpr (SUB == 2) { if constexpr (L == 0) even_prep(lds, p); else odd_prep(p); }
    else if constexpr (SUB == 3) {
        if constexpr (L == 0) delta_scan(lds, p);
        else { if (G > 128) { if ((int)blockIdx.x < 128) mlstm_scan(lds, p); else sg_phase(lds, p, (int)blockIdx.x - 128, G - 128); }
               else { mlstm_scan(lds, p); sg_phase(lds, p, (int)blockIdx.x, G); } }
    } else if constexpr (SUB == 4) { if constexpr (L == 0) headnorm_phase(p, p.in[10], 3072, 2560, 0); else headnorm_phase(p, p.in[19], 2560, 2048, 1); }
    else if constexpr (SUB == 5) { pg8::Gemm g{HN, W_OUT, T_, 1024, 1024}; pg8::StaticOrder S; S.init(T_, 1024, G, (int)blockIdx.x);
        pg8::EpiAddF32 E{h, 1024};
        pg8::gemm_phase<pg8::EpiAddF32, pg8::StaticOrder>(lds, g, S, E, nullptr);
    } else if constexpr (SUB == 6) { rms_phase(lds, h, p.in[21] + L * 1024, HN, nullptr, nullptr, nullptr, 0, 0, nullptr); }
    else if constexpr (SUB == 7) { pg8::Gemm g{HN, W_UP, T_, 2 * DFF, 1024}; pg8::StaticOrder S; S.init(T_, 2 * DFF, G, (int)blockIdx.x);
        pg8::EpiSwiGLU E{Zb, DFF};
        pg8::gemm_phase<pg8::EpiSwiGLU, pg8::StaticOrder>(lds, g, S, E, nullptr);
    } else if constexpr (SUB == 8) { pg8::Gemm g{Zb, W_DN, T_, 1024, DFF}; pg8::StaticOrder S; S.init(T_, 1024, G, (int)blockIdx.x);
        pg8::EpiAddF32 E{h, 1024};
        pg8::gemm_phase<pg8::EpiAddF32, pg8::StaticOrder>(lds, g, S, E, nullptr);
    }
}
__global__ void __launch_bounds__(NTHR, 2) mega(Params p, int ph_lo, int ph_hi) {
    extern __shared__ __attribute__((aligned(16))) unsigned char lds_raw[];
    LDSp lds = (LDSp)lds_raw;
    cg::grid_group grid = cg::this_grid();
#define PH(k, L, SUB) if (ph_lo <= (k) && (k) < ph_hi) { run_phase<L, SUB>(lds, p); if ((k) + 1 < ph_hi) grid.sync(); }
    PH(0, 0, 0) PH(1, 0, 1) PH(2, 0, 2) PH(3, 0, 3) PH(4, 0, 4) PH(5, 0, 5) PH(6, 0, 6) PH(7, 0, 7) PH(8, 0, 8)
    PH(9, 1, 0) PH(10, 1, 1) PH(11, 1, 2) PH(12, 1, 3) PH(13, 1, 4) PH(14, 1, 5) PH(15, 1, 6) PH(16, 1, 7) PH(17, 1, 8)
    PH(18, 2, 0)
#undef PH
}

extern "C" void kernel_launch(void* const* d_in, const int* in_sizes, int n_in, void* d_out, int out_size, void* d_ws, size_t ws_size, hipStream_t stream) {
    static int grid = 0;
    if (grid == 0) {
        int dev = 0, cus = 0, per_cu = 0;
        (void)hipGetDevice(&dev);
        (void)hipDeviceGetAttribute(&cus, hipDeviceAttributeMultiprocessorCount, dev);
        (void)hipFuncSetAttribute((const void*)mega, hipFuncAttributeMaxDynamicSharedMemorySize, LDS_BYTES);
        if (hipOccupancyMaxActiveBlocksPerMultiprocessor(&per_cu, (const void*)mega, NTHR, LDS_BYTES) != hipSuccess || per_cu < 1) per_cu = 1;
        (void)hipGetLastError();
        if (cus <= 0) cus = 256;
        grid = cus * per_cu;
    }
    if (ws_size < 236 * MiB) { fprintf(stderr, "workspace too small: %zu\n", ws_size); return; }
    Params p{};
    for (int i = 0; i < 26; ++i) p.in[i] = (const float*)d_in[i];
    p.out = (float*)d_out; p.ws = (unsigned char*)d_ws;
#if defined(MULTI_LAUNCH)
    for (int ph = 0; ph < N_PHASES; ++ph) hipLaunchKernelGGL(mega, dim3(grid), dim3(NTHR), LDS_BYTES, stream, p, ph, ph + 1);
#else
    int lo = 0, hi = N_PHASES;
    void* args[] = {(void*)&p, (void*)&lo, (void*)&hi};
    hipError_t e = hipLaunchCooperativeKernel((const void*)mega, dim3(grid), dim3(NTHR), args, LDS_BYTES, stream);
    if (e != hipSuccess) fprintf(stderr, "cooperative launch failed: %s (grid %d)\n", hipGetErrorString(e), grid);
#endif
}
```

```cpp
#include <hip/hip_runtime.h>
#include <hip/hip_cooperative_groups.h>
#include <cstdio>
namespace cg = cooperative_groups;
namespace pg8 {
#define PG8_LAS __attribute__((address_space(3)))
typedef unsigned short bf16_t;
typedef short bf16x8 __attribute__((ext_vector_type(8)));
typedef float f32x4 __attribute__((ext_vector_type(4)));
typedef unsigned u32x4 __attribute__((ext_vector_type(4)));
constexpr int BM = 256, BK = 64, HALF = 128, HTB = HALF * BK * 2  , STAGE_BYTES = 8 * HTB, NXCD = 8, WGM = 8;

__host__ __device__ __forceinline__ int lds_byte(int r, int c) { const int st = (r >> 4) * 2 + (c >> 5), rr = r & 15, cc = c & 31, ob = rr * 64 + cc * 2; return st * 1024 + (ob ^ (((ob >> 9) & 1) << 5)); }
__host__ __device__ __forceinline__ void stage_rc(int b, int& R, int& C) { const int st = b / 1024, sb = b % 1024, swz = sb ^ (((sb >> 9) & 1) << 5); R = (st >> 1) * 16 + swz / 64; C = (st & 1) * 32 + (swz % 64) / 2; }
__host__ __device__ __forceinline__ int perm32(int rho) { const int n = rho >> 4, i = rho & 15; return 8 * (i >> 2) + 4 * n + (i & 3); }

struct Unit { int pm, pn; };
struct Gemm { const bf16_t* A; const bf16_t* Bt; int M, N, K; };

struct StaticOrder {
    int nM, nN, nwg, G, c;
    __host__ __device__ void init(int M, int N, int G_, int c_) { nM = M / BM; nN = N / BM; nwg = nM * nN; G = G_; c = c_; }
    __host__ __device__ bool next(int i, Unit& u) const {
        const long L = (long)i * G + c; if (L >= nwg) return false;
        int wgid = (int)L; { const int q = nwg / NXCD, r = nwg % NXCD, xcd = wgid % NXCD, off = wgid / NXCD; wgid = (xcd < r ? xcd * (q + 1) : r * (q + 1) + (xcd - r) * q) + off; }
        const int nig = WGM * nN, gid = wgid / nig, fm = gid * WGM, gsz = (nM - fm) < WGM ? (nM - fm) : WGM;
        u.pm = fm + ((wgid % nig) % gsz); u.pn = (wgid % nig) / gsz; return true;
    }
    __device__ __forceinline__ void a_ready(const Unit&) const {}
    __device__ __forceinline__ void done(const Unit&) const {}
};
__device__ __forceinline__ unsigned cvt_pk_bf16(float lo, float hi) { unsigned r; asm volatile("v_cvt_pk_bf16_f32 %0, %1, %2" : "=v"(r) : "v"(lo), "v"(hi)); return r; }
typedef float f32x2 __attribute__((ext_vector_type(2)));
__device__ __forceinline__ f32x2 gelu_pk(f32x2 v) {
    const f32x2 av = __builtin_elementwise_abs(v), d = av * 0.2316418882f + 1.0f;
    f32x2 t; t.x = __builtin_amdgcn_rcpf(d.x); t.y = __builtin_amdgcn_rcpf(d.y);
    f32x2 q = t * 0.5307027145f + (-0.7265760135f); q = q * t + 0.7107068705f; q = q * t + (-0.142248368f); q = q * t + 0.127414796f; q = q * t;
    const f32x2 s = (v * v) * (-0.72134752044f);
    f32x2 e; e.x = __builtin_amdgcn_exp2f(s.x); e.y = __builtin_amdgcn_exp2f(s.y);
    const f32x2 m = v * (q * e), r = v - m;
    f32x2 o; o.x = v.x < 0.f ? m.x : r.x; o.y = v.y < 0.f ? m.y : r.y; return o;
}
template <int ACT  > struct EpiBf16 {
    static constexpr bool PERM = true, AFTER_DRAIN = false;
    bf16_t* O; int ldc; const float* bias; int split_cols; size_t split_stride;
    __device__ __forceinline__ void operator()(const f32x4 (&acc)[2][2][4][2], const Unit& u, int wr, int wc, int fr, int fq) const {
        const int row0 = u.pm * BM + wr * 64 + fr; int colt = u.pn * BM; bf16_t* base = O;
        if (split_cols) { const int t = colt / split_cols; base += (size_t)t * split_stride; colt -= t * split_cols; }
        const int col0 = colt + wc * 32 + 8 * fq, bcol0 = u.pn * BM + wc * 32 + 8 * fq;
        f32x4 bv[2][2];
#pragma unroll
        for (int bj = 0; bj < 2; ++bj)
#pragma unroll
            for (int n = 0; n < 2; ++n) bv[bj][n] = bias ? *(const f32x4*)(bias + bcol0 + bj * HALF + 4 * n) : (f32x4){0.f, 0.f, 0.f, 0.f};
#pragma unroll
        for (int ai = 0; ai < 2; ++ai)
#pragma unroll
            for (int m = 0; m < 4; ++m) { bf16_t* rowp = base + (size_t)(row0 + ai * HALF + m * 16) * ldc + col0;
#pragma unroll
                for (int bj = 0; bj < 2; ++bj) { f32x4 v0 = acc[ai][bj][m][0] + bv[bj][0], v1 = acc[ai][bj][m][1] + bv[bj][1];
                    if (ACT == 1) { f32x2 a = gelu_pk((f32x2){v0[0], v0[1]}), b = gelu_pk((f32x2){v0[2], v0[3]}), c = gelu_pk((f32x2){v1[0], v1[1]}), d = gelu_pk((f32x2){v1[2], v1[3]});
                        v0 = (f32x4){a.x, a.y, b.x, b.y}; v1 = (f32x4){c.x, c.y, d.x, d.y}; }
                    if (ACT == 2) {
#pragma unroll
                        for (int j = 0; j < 4; ++j) { v0[j] = 0.5f * v0[j] * (1.0f + erff(v0[j] * 0.70710678f)); v1[j] = 0.5f * v1[j] * (1.0f + erff(v1[j] * 0.70710678f)); } }
                    u32x4 w; w.x = cvt_pk_bf16(v0[0], v0[1]); w.y = cvt_pk_bf16(v0[2], v0[3]); w.z = cvt_pk_bf16(v1[0], v1[1]); w.w = cvt_pk_bf16(v1[2], v1[3]);
                    *(u32x4*)(rowp + bj * HALF) = w; } }
    }
};
struct EpiAddF32 {
    static constexpr bool PERM = false, AFTER_DRAIN = false;
    float* C; int ldc;
    __device__ __forceinline__ void operator()(const f32x4 (&acc)[2][2][4][2], const Unit& u, int wr, int wc, int fr, int fq) const {
        const int row0 = u.pm * BM + wr * 64 + fr, col0 = u.pn * BM + wc * 32 + 4 * fq;
#pragma unroll
        for (int ai = 0; ai < 2; ++ai)
#pragma unroll
            for (int m = 0; m < 4; ++m) { float* rowp = C + (size_t)(row0 + ai * HALF + m * 16) * ldc + col0;
#pragma unroll
                for (int bj = 0; bj < 2; ++bj)
#pragma unroll
                    for (int n = 0; n < 2; ++n) { f32x4* q = (f32x4*)(rowp + bj * HALF + n * 16); const f32x4 o = *q; *q = o + acc[ai][bj][m][n]; } }
    }
};
struct EpiSwiGLU {
    static constexpr bool PERM = true, AFTER_DRAIN = false;
    bf16_t* H; int ldh;
    __device__ __forceinline__ void operator()(const f32x4 (&acc)[2][2][4][2], const Unit& u, int wr, int wc, int fr, int fq) const {
        typedef unsigned u32x2 __attribute__((ext_vector_type(2)));
        const int row0 = u.pm * BM + wr * 64 + fr;
#pragma unroll
        for (int ai = 0; ai < 2; ++ai)
#pragma unroll
            for (int m = 0; m < 4; ++m) { bf16_t* rowp = H + (size_t)(row0 + ai * HALF + m * 16) * ldh;
#pragma unroll
                for (int bj = 0; bj < 2; ++bj) { const int hcol = ((u.pn * BM + bj * HALF + wc * 32) >> 1) + 4 * fq;
                    const f32x4 a = acc[ai][bj][m][0], b = acc[ai][bj][m][1]; float h[4];
#pragma unroll
                    for (int j = 0; j < 4; ++j) h[j] = a[j] / (1.0f + __expf(-a[j])) * b[j];
                    u32x2 w; w.x = cvt_pk_bf16(h[0], h[1]); w.y = cvt_pk_bf16(h[2], h[3]);
                    *(u32x2*)(rowp + hcol) = w; } }
    }
};
template <class Epi, class Sched, bool STAMP = false>
__device__ __forceinline__ void gemm_phase(PG8_LAS unsigned char* lds, const Gemm g, const Sched& S, const Epi& E, unsigned long long* stamps) {
    const int tid = threadIdx.x, wid = __builtin_amdgcn_readfirstlane(tid >> 6), lane = tid & 63, wr = wid >> 2, wc = wid & 3, fr = lane & 15, fq = lane >> 4;
    const int K = g.K, nt = K / BK;
    int ts_lo = 0, ts_hi = 0, nts = 0; const unsigned long long rt_entry = STAMP ? (unsigned long long)wall_clock64() : 0ull;
#define PG8_STAMP() do { if (STAMP && wid == 0 && nts < 64) { const unsigned long long _c = (unsigned long long)clock64(); \
        ts_lo = (lane == nts) ? (int)(unsigned)_c : ts_lo; ts_hi = (lane == nts) ? (int)(unsigned)(_c >> 32) : ts_hi; ++nts; } } while (0)
    PG8_STAMP();
    unsigned voffA[2], voffB[2];
#pragma unroll
    for (int i = 0; i < 2; ++i) { int R, C; stage_rc(tid * 16 + i * 8192, R, C); const int Rb = Epi::PERM ? ((R & ~31) + perm32(R & 31)) : R;
        voffA[i] = (unsigned)(R * K + C) * 2u; voffB[i] = (unsigned)(Rb * K + C) * 2u; }
    const size_t kstep = (size_t)(BK * 2);
    const size_t hstep = (size_t)HALF * K * 2;
    const size_t tstep = 2 * hstep;
    const unsigned ldsw = (unsigned)wid * 1024u;
    const int aoff = lds_byte(wr * 64 + fr, fq * 8), boff = lds_byte(wc * 32 + fr, fq * 8);
#define PG8_SA(b, h) (((b) * 2 + (h)) * HTB)
#define PG8_SB(b, h) ((4 + (b) * 2 + (h)) * HTB)
#define PG8_STAGE(bufoff, gbase, voff) do { _Pragma("unroll") for (int _i = 0; _i < 2; ++_i) \
        __builtin_amdgcn_global_load_lds((const unsigned*)((const char*)(gbase) + (voff)[_i]), (PG8_LAS unsigned*)(lds + (bufoff) + ldsw + _i * 8192), 16, 0, 0); } while (0)
#define PG8_LDA(dst, b, h) do { _Pragma("unroll") for (int m = 0; m < 4; ++m) _Pragma("unroll") for (int k = 0; k < 2; ++k) dst[m][k] = *(const PG8_LAS bf16x8*)(lds + PG8_SA(b, h) + aoff + m * 2048 + k * 1024); } while (0)
#define PG8_LDB(dst, b, h) do { _Pragma("unroll") for (int n = 0; n < 2; ++n) _Pragma("unroll") for (int k = 0; k < 2; ++k) dst[n][k] = *(const PG8_LAS bf16x8*)(lds + PG8_SB(b, h) + boff + n * 2048 + k * 1024); } while (0)
#define PG8_MMA(ai, bj, At, Bt) do { __builtin_amdgcn_s_setprio(1); _Pragma("unroll") for (int m = 0; m < 4; ++m) _Pragma("unroll") for (int n = 0; n < 2; ++n) _Pragma("unroll") for (int k = 0; k < 2; ++k) \
        acc[ai][bj][m][n] = __builtin_amdgcn_mfma_f32_16x16x32_bf16(Bt[n][k], At[m][k], acc[ai][bj][m][n], 0, 0, 0); __builtin_amdgcn_s_setprio(0); } while (0)
#define PG8_WAIT_V(n) asm volatile("s_waitcnt vmcnt(" #n ")" ::: "memory")
#define PG8_WAIT_L(n) asm volatile("s_waitcnt lgkmcnt(" #n ")" ::: "memory")
#define PG8_BAR __builtin_amdgcn_s_barrier()
#define PG8_SCHED __builtin_amdgcn_sched_barrier(0)
    Unit cur, nxt; int ui = 0;
    if (!S.next(0, cur)) return;
    f32x4 acc[2][2][4][2];
#pragma unroll
    for (int a = 0; a < 2; ++a)
#pragma unroll
        for (int b = 0; b < 2; ++b)
#pragma unroll
            for (int m = 0; m < 4; ++m)
#pragma unroll
                for (int n = 0; n < 2; ++n) acc[a][b][m][n] = (f32x4){0.f, 0.f, 0.f, 0.f};
    bf16x8 At[4][2], B0[2][2], B1[2][2];
    const char* cA = (const char*)g.A + (size_t)cur.pm * tstep; const char* cB = (const char*)g.Bt + (size_t)cur.pn * tstep;
    S.a_ready(cur);
    PG8_STAGE(PG8_SB(0, 0), cB, voffB); PG8_STAGE(PG8_SA(0, 0), cA, voffA); PG8_STAGE(PG8_SB(0, 1), cB + hstep, voffB); PG8_STAGE(PG8_SA(0, 1), cA + hstep, voffA);
    if (wr == 1) PG8_BAR;
    PG8_WAIT_V(4); PG8_BAR;
    PG8_STAGE(PG8_SB(1, 0), cB + kstep, voffB); PG8_STAGE(PG8_SA(1, 0), cA + kstep, voffA); PG8_STAGE(PG8_SB(1, 1), cB + hstep + kstep, voffB);
    PG8_WAIT_V(6); PG8_BAR;
    PG8_STAMP();
    for (;;) {
        const bool has_next = S.next(ui + 1, nxt);
        const char* nA = has_next ? (const char*)g.A + (size_t)nxt.pm * tstep : cA; const char* nB = has_next ? (const char*)g.Bt + (size_t)nxt.pn * tstep : cB;
        for (int t = 0; t < nt; t += 2) {
            const bool last = (t == nt - 2);
            const char* a1 = cA + (size_t)(t + 1) * kstep;
            const char* a2 = last ? nA : cA + (size_t)(t + 2) * kstep; const char* b2 = last ? nB : cB + (size_t)(t + 2) * kstep;
            const char* a3 = a2 + kstep; const char* b3 = b2 + kstep;
            if (last && has_next) S.a_ready(nxt);
            PG8_LDB(B0, 0, 0); PG8_SCHED; PG8_LDA(At, 0, 0); PG8_STAGE(PG8_SA(1, 1), a1 + hstep, voffA);
            PG8_WAIT_L(8); PG8_BAR; PG8_WAIT_L(0); PG8_MMA(0, 0, At, B0); PG8_BAR; PG8_SCHED;
            PG8_LDB(B1, 0, 1); PG8_STAGE(PG8_SB(0, 0), b2, voffB);
            PG8_BAR; PG8_WAIT_L(0); PG8_MMA(0, 1, At, B1); PG8_BAR;
            PG8_LDA(At, 0, 1); PG8_STAGE(PG8_SA(0, 0), a2, voffA);
            PG8_BAR; PG8_WAIT_L(0); PG8_MMA(1, 0, At, B0); PG8_BAR; PG8_SCHED;
            PG8_STAGE(PG8_SB(0, 1), b2 + hstep, voffB);
            PG8_WAIT_V(6); PG8_BAR; PG8_MMA(1, 1, At, B1); PG8_BAR;
            PG8_LDB(B0, 1, 0); PG8_SCHED; PG8_LDA(At, 1, 0); PG8_STAGE(PG8_SA(0, 1), a2 + hstep, voffA);
            PG8_WAIT_L(8); PG8_BAR; PG8_WAIT_L(0); PG8_MMA(0, 0, At, B0); PG8_BAR; PG8_SCHED;
            PG8_LDB(B1, 1, 1); PG8_STAGE(PG8_SB(1, 0), b3, voffB);
            PG8_BAR; PG8_WAIT_L(0); PG8_MMA(0, 1, At, B1); PG8_BAR;
            PG8_LDA(At, 1, 1); PG8_STAGE(PG8_SA(1, 0), a3, voffA);
            PG8_BAR; PG8_WAIT_L(0); PG8_MMA(1, 0, At, B0); PG8_BAR; PG8_SCHED;
            PG8_STAGE(PG8_SB(1, 1), b3 + hstep, voffB);
            PG8_WAIT_V(6); PG8_BAR; PG8_MMA(1, 1, At, B1); PG8_BAR;
        }
        PG8_STAMP();
        if constexpr (!Epi::AFTER_DRAIN) { E(acc, cur, wr, wc, fr, fq); S.done(cur); }
        PG8_STAMP();
        if (!has_next) break;
#pragma unroll
        for (int a = 0; a < 2; ++a)
#pragma unroll
            for (int b = 0; b < 2; ++b)
#pragma unroll
                for (int m = 0; m < 4; ++m)
#pragma unroll
                    for (int n = 0; n < 2; ++n) acc[a][b][m][n] = (f32x4){0.f, 0.f, 0.f, 0.f};
        cur = nxt; cA = nA; cB = nB; ++ui;
    }
    PG8_WAIT_V(0);
    if (wr == 0) PG8_BAR;
    PG8_BAR;
    if constexpr (Epi::AFTER_DRAIN) { E.fused(acc, cur, wr, wc, fr, fq, lds, wid, lane); S.done(cur); }
    PG8_STAMP();
    if (STAMP && wid == 0) { stamps[lane] = lane < nts ? (((unsigned long long)(unsigned)ts_hi << 32) | (unsigned)ts_lo) : 0ull;
        if (lane == 62) stamps[62] = rt_entry; if (lane == 63) stamps[63] = (unsigned long long)wall_clock64(); }
#undef PG8_STAMP
#undef PG8_SA
#undef PG8_SB
#undef PG8_STAGE
#undef PG8_LDA
#undef PG8_LDB
#undef PG8_MMA
#undef PG8_WAIT_V
#undef PG8_WAIT_L
#undef PG8_BAR
#undef PG8_SCHED
}
}
#define LAS __attribute__((address_space(3)))
typedef LAS unsigned char* LDSp;
typedef pg8::bf16_t bf16_t;
typedef unsigned u32x4 __attribute__((ext_vector_type(4)));
typedef unsigned u32x2 __attribute__((ext_vector_type(2)));
typedef float f32x4 __attribute__((ext_vector_type(4)));
typedef float f32x2 __attribute__((ext_vector_type(2)));

#ifndef EXPC
#define EXPC 0
#endif
#ifndef EVP_SKIP
#define EVP_SKIP 0
#endif
constexpr int T_ = 16384, D_ = 1024, S_ = 4096, NTHR = 512;
constexpr int LDS_BYTES = 147456;
constexpr size_t MiB = 1048576;
constexpr size_t WS_WB = 0, WS_HN = 25 * MiB, WS_Z = 57 * MiB, WS_QKV = 153 * MiB, WS_OF = 201 * MiB, WS_OB = 217 * MiB,
                 WS_GATES = 233 * MiB, WS_BETA = 234 * MiB, WS_LA = 234 * MiB + 524288;
constexpr size_t WB_IN = 0, WB_OUT = 6291456, WB_UP = 8388608, WB_DN = 19922944;
constexpr int DFF = 2816;

struct Params { const float* in[26]; float* out; unsigned char* ws; };

__device__ __forceinline__ float bf2f(unsigned short b) { return __uint_as_float(((unsigned)b) << 16); }
__device__ __forceinline__ float bflo(unsigned u) { return __uint_as_float(u << 16); }
__device__ __forceinline__ float bfhi(unsigned u) { return __uint_as_float(u & 0xffff0000u); }
__device__ __forceinline__ unsigned short f2bf(float f) { unsigned u = __float_as_uint(f); u += 0x7FFFu + ((u >> 16) & 1u); return (unsigned short)(u >> 16); }
typedef __bf16 bf16x2_v __attribute__((ext_vector_type(2)));
__device__ __forceinline__ unsigned pk2(float lo, float hi) { const f32x2 v = {lo, hi}; const bf16x2_v b = __builtin_convertvector(v, bf16x2_v); return __builtin_bit_cast(unsigned, b); }
__device__ __forceinline__ float sigm(float x) { return 1.0f / (1.0f + __expf(-x)); }
__device__ __forceinline__ float silu_(float x) { return x * sigm(x); }
__device__ __forceinline__ float gelu_t(float x) { const float u = 0.7978845608028654f * (x + 0.044715f * x * x * x); const float t = 1.0f - 2.0f / (1.0f + __expf(2.0f * u)); return 0.5f * x * (1.0f + t); }
__device__ __forceinline__ float softplus_(float x) { return x > 20.0f ? x : log1pf(expf(x)); }
__device__ __forceinline__ float wave_sum(float v) {
#pragma unroll
    for (int o = 32; o; o >>= 1) v += __shfl_xor(v, o);
    return v; }
template <int CTRL> __device__ __forceinline__ float dppf(float v) { return __int_as_float(__builtin_amdgcn_update_dpp(0, __float_as_int(v), CTRL, 0xf, 0xf, true)); }
__device__ __forceinline__ float row16_sum(float v) { v += dppf<0xB1>(v); v += dppf<0x4E>(v); v += dppf<0x141>(v); v += dppf<0x140>(v); return v; }
__device__ __forceinline__ void unpack8(const u32x4 w, float (&f)[8]) { f[0] = bflo(w.x); f[1] = bfhi(w.x); f[2] = bflo(w.y); f[3] = bfhi(w.y); f[4] = bflo(w.z); f[5] = bfhi(w.z); f[6] = bflo(w.w); f[7] = bfhi(w.w); }

__device__ __forceinline__ void conv_job(LDSp lds, const float* __restrict__ src, int ldn, int K, int col0, int ncols, bf16_t* __restrict__ dst, int mode, int off) {
    LAS float* tl = (LAS float*)lds;
    const int tid = threadIdx.x, nnt = ncols >> 6, ntl = (K >> 6) * nnt;
    for (int tile = blockIdx.x; tile < ntl; tile += gridDim.x) {
        const int kt = tile / nnt, nt = tile - kt * nnt;
        const int r = tid >> 4, c4 = (tid & 15) << 2;
#pragma unroll
        for (int i = 0; i < 2; ++i) { const int k = r + 32 * i; const f32x4 v = *(const f32x4*)(src + (size_t)(kt * 64 + k) * ldn + col0 + nt * 64 + c4);
            tl[k * 65 + c4 + 0] = v.x; tl[k * 65 + c4 + 1] = v.y; tl[k * 65 + c4 + 2] = v.z; tl[k * 65 + c4 + 3] = v.w; }
        __syncthreads();
        const int n = tid >> 3, k8 = (tid & 7) << 3; float f[8];
#pragma unroll
        for (int j = 0; j < 8; ++j) f[j] = tl[(k8 + j) * 65 + n];
        u32x4 w; w.x = pk2(f[0], f[1]); w.y = pk2(f[2], f[3]); w.z = pk2(f[4], f[5]); w.w = pk2(f[6], f[7]);
        const int ncol = nt * 64 + n;
        const int row = mode == 0 ? off + ncol : ((ncol >> 4) << 5) + (((ncol >> 2) & 3) << 3) + (ncol & 3) + off;
        *(u32x4*)(dst + (size_t)row * K + kt * 64 + k8) = w;
        __syncthreads();
    }
}
__device__ __forceinline__ void convert_layer(LDSp lds, const Params& p, int L) {
    bf16_t* wb = (bf16_t*)(p.ws + WS_WB);
    if (L == 0) { conv_job(lds, p.in[2], 3088, 1024, 0, 3072, (bf16_t*)((char*)wb + WB_IN), 0, 0);
                  conv_job(lds, p.in[11], 1024, 1024, 0, 1024, (bf16_t*)((char*)wb + WB_OUT), 0, 0); }
    else        { conv_job(lds, p.in[12], 2576, 1024, 0, 2560, (bf16_t*)((char*)wb + WB_IN), 0, 0);
                  conv_job(lds, p.in[20], 1024, 1024, 0, 1024, (bf16_t*)((char*)wb + WB_OUT), 0, 0); }
    conv_job(lds, p.in[22] + (size_t)L * 1024 * DFF, DFF, 1024, 0, DFF, (bf16_t*)((char*)wb + WB_UP), 1, 0);
    conv_job(lds, p.in[23] + (size_t)L * 1024 * DFF, DFF, 1024, 0, DFF, (bf16_t*)((char*)wb + WB_UP), 1, 4);
    conv_job(lds, p.in[24] + (size_t)L * DFF * 1024, 1024, DFF, 0, 1024, (bf16_t*)((char*)wb + WB_DN), 0, 0);
}

__device__ __forceinline__ void rms_phase(LDSp lds, const float* src, const float* __restrict__ g, bf16_t* hn, float* copy_out, float* final_out,
                                          const float* __restrict__ gw, int gw_ld, int gw_col0, float* gates) {
    LAS float* wg = (LAS float*)lds;
    const int tid = threadIdx.x, lane = tid & 63, wid = tid >> 6;
    if (gw) { for (int idx = tid; idx < 16384; idx += NTHR) { const int k = idx >> 4, j = idx & 15; wg[j * 1024 + k] = gw[(size_t)k * gw_ld + gw_col0 + j]; } __syncthreads(); }
    f32x4 gv[4];
#pragma unroll
    for (int i = 0; i < 4; ++i) gv[i] = *(const f32x4*)(g + 4 * lane + 256 * i);
    for (int row = blockIdx.x * 8 + wid; row < T_; row += gridDim.x * 8) {
        const float* xr = src + (size_t)row * D_;
        f32x4 x[4]; float ss = 0.f;
#pragma unroll
        for (int i = 0; i < 4; ++i) { x[i] = *(const f32x4*)(xr + 4 * lane + 256 * i); ss += x[i].x * x[i].x + x[i].y * x[i].y + x[i].z * x[i].z + x[i].w * x[i].w; }
        if (copy_out) {
#pragma unroll
            for (int i = 0; i < 4; ++i) *(f32x4*)(copy_out + (size_t)row * D_ + 4 * lane + 256 * i) = x[i]; }
        ss = wave_sum(ss);
        const float rstd = rsqrtf(ss * (1.0f / 1024.0f) + 1e-6f);
        f32x4 y[4];
#pragma unroll
        for (int i = 0; i < 4; ++i) y[i] = x[i] * rstd * gv[i];
        if (final_out) {
#pragma unroll
            for (int i = 0; i < 4; ++i) *(f32x4*)(final_out + (size_t)row * D_ + 4 * lane + 256 * i) = y[i];
        } else {
#pragma unroll
            for (int i = 0; i < 4; ++i) { u32x2 w; w.x = pk2(y[i].x, y[i].y); w.y = pk2(y[i].z, y[i].w); *(u32x2*)(hn + (size_t)row * D_ + 4 * lane + 256 * i) = w; }
        }
        if (gw) {
            float s[16];
#pragma unroll
            for (int j = 0; j < 16; ++j) { float a = 0.f;
#pragma unroll
                for (int i = 0; i < 4; ++i) { const f32x4 w = *(const LAS f32x4*)(wg + j * 1024 + 4 * lane + 256 * i); a += y[i].x * w.x + y[i].y * w.y + y[i].z * w.z + y[i].w * w.w; }
                s[j] = wave_sum(a); }
            if (lane == 0) {
#pragma unroll
                for (int q = 0; q < 4; ++q) *(f32x4*)(gates + (size_t)row * 16 + 4 * q) = (f32x4){s[4 * q], s[4 * q + 1], s[4 * q + 2], s[4 * q + 3]}; }
        }
    }
    __syncthreads();
}

__device__ __forceinline__ void even_prep(LDSp lds, const Params& p) {
    const bf16_t* Z = (const bf16_t*)(p.ws + WS_Z); bf16_t* Y = (bf16_t*)(p.ws + WS_HN); bf16_t* QKVN = (bf16_t*)(p.ws + WS_QKV);
    const float* gates = (const float*)(p.ws + WS_GATES); float* BETA = (float*)(p.ws + WS_BETA); float* LA = (float*)(p.ws + WS_LA);
    const float* conv_w = p.in[3]; const float* conv_b = p.in[4]; const float* ln_g = p.in[5]; const float* ln_b = p.in[6];
    const float* dn_w = p.in[7]; const float* a_log = p.in[8]; const float* dt_bias = p.in[9];
    LAS float* glu = (LAS float*)lds;
    const int tid = threadIdx.x, lane = tid & 63, wid = tid >> 6, c = tid;
    for (int tile = blockIdx.x; tile < T_ / 32; tile += gridDim.x) {
        const int t0 = tile * 32, b = t0 >> 12, s0 = t0 & 4095;
#if !(EVP_SKIP & 1)
        for (int it = tid; it < 62 * 64; it += NTHR) { const int r = it >> 6, c8 = (it & 63) << 3, sp = s0 - 15 + r;
            f32x4 o0 = {0.f, 0.f, 0.f, 0.f}, o1 = {0.f, 0.f, 0.f, 0.f};
            if (sp >= 0 && sp < S_) { const size_t tok = (size_t)b * S_ + sp; const u32x4 av = *(const u32x4*)(Z + tok * 3072 + c8); const u32x4 gv = *(const u32x4*)(Z + tok * 3072 + 512 + c8);
                float a[8], g[8]; unpack8(av, a); unpack8(gv, g);
                o0 = (f32x4){a[0] * sigm(g[0]), a[1] * sigm(g[1]), a[2] * sigm(g[2]), a[3] * sigm(g[3])}; o1 = (f32x4){a[4] * sigm(g[4]), a[5] * sigm(g[5]), a[6] * sigm(g[6]), a[7] * sigm(g[7])}; }
            *(LAS f32x4*)(glu + r * 512 + c8) = o0; *(LAS f32x4*)(glu + r * 512 + c8 + 4) = o1; }
        __syncthreads();
        {
            float cw[31];
#pragma unroll
            for (int w = 0; w < 31; ++w) cw[w] = conv_w[w * 512 + c];
            const float cb = conv_b[c];
            f32x4 res[8];
#pragma unroll
            for (int t4 = 0; t4 < 8; ++t4) {
                float x[34];
#pragma unroll
                for (int i = 0; i < 34; ++i) x[i] = glu[(t4 * 4 + i) * 512 + c];
                float a0 = cb, a1 = cb, a2 = cb, a3 = cb;
#pragma unroll
                for (int w = 0; w < 31; ++w) { a0 = fmaf(x[w], cw[w], a0); a1 = fmaf(x[w + 1], cw[w], a1); a2 = fmaf(x[w + 2], cw[w], a2); a3 = fmaf(x[w + 3], cw[w], a3); }
                res[t4] = (f32x4){a0, a1, a2, a3};
            }
            __syncthreads();
#pragma unroll
            for (int t4 = 0; t4 < 8; ++t4) { glu[(t4 * 4 + 0) * 512 + c] = res[t4].x; glu[(t4 * 4 + 1) * 512 + c] = res[t4].y; glu[(t4 * 4 + 2) * 512 + c] = res[t4].z; glu[(t4 * 4 + 3) * 512 + c] = res[t4].w; }
        }
        __syncthreads();
        {
            const f32x4 g0 = *(const f32x4*)(ln_g + 4 * lane), g1 = *(const f32x4*)(ln_g + 256 + 4 * lane), b0 = *(const f32x4*)(ln_b + 4 * lane), b1 = *(const f32x4*)(ln_b + 256 + 4 * lane);
#pragma unroll
            for (int tt = 0; tt < 4; ++tt) { const int t = wid * 4 + tt;
                const f32x4 x0 = *(const LAS f32x4*)(glu + t * 512 + 4 * lane), x1 = *(const LAS f32x4*)(glu + t * 512 + 256 + 4 * lane);
                const float mean = wave_sum((x0.x + x0.y) + (x0.z + x0.w) + (x1.x + x1.y) + (x1.z + x1.w)) * (1.0f / 512.0f);
                const f32x4 d0 = x0 - mean, d1 = x1 - mean;
                const float var = wave_sum(d0.x * d0.x + d0.y * d0.y + d0.z * d0.z + d0.w * d0.w + d1.x * d1.x + d1.y * d1.y + d1.z * d1.z + d1.w * d1.w) * (1.0f / 512.0f);
                const float rstd = rsqrtf(var + 1e-5f);
                const f32x4 y0 = d0 * rstd * g0 + b0, y1 = d1 * rstd * g1 + b1;
                u32x2 w0, w1; w0.x = pk2(silu_(y0.x), silu_(y0.y)); w0.y = pk2(silu_(y0.z), silu_(y0.w)); w1.x = pk2(silu_(y1.x), silu_(y1.y)); w1.y = pk2(silu_(y1.z), silu_(y1.w));
                *(u32x2*)(Y + (size_t)(t0 + t) * 1024 + 4 * lane) = w0; *(u32x2*)(Y + (size_t)(t0 + t) * 1024 + 256 + 4 * lane) = w1; }
        }
        __syncthreads();
#endif
#if !(EVP_SKIP & 2)
#pragma unroll 1
        for (int gi = 0; gi < 3; ++gi) {
            const int col = 1024 + gi * 512 + c;
            float w5[5];
#pragma unroll
            for (int w = 0; w < 5; ++w) w5[w] = dn_w[w * 1536 + gi * 512 + c];
            const bf16_t* zc = Z + (size_t)b * S_ * 3072 + col;
#define ZLD(sp) (((sp) >= 0 && (sp) < S_) ? bf2f(zc[(size_t)(sp) * 3072]) : 0.f)
            float x0 = ZLD(s0 - 2), x1 = ZLD(s0 - 1), x2 = ZLD(s0), x3 = ZLD(s0 + 1);
#pragma unroll 4
            for (int t = 0; t < 32; ++t) { const float x4 = ZLD(s0 + t + 2);
                float v = x0 * w5[0]; v = fmaf(x1, w5[1], v); v = fmaf(x2, w5[2], v); v = fmaf(x3, w5[3], v); v = fmaf(x4, w5[4], v);
                v = silu_(v);
                if (gi == 2) QKVN[(size_t)(t0 + t) * 1536 + 1024 + c] = f2bf(v); else glu[t * 512 + c] = v;
                x0 = x1; x1 = x2; x2 = x3; x3 = x4; }
#undef ZLD
            if (gi < 2) {
                __syncthreads();
                const float qs = gi == 0 ? 0.08838834764831845f : 1.0f;
#pragma unroll 4
                for (int pp = 0; pp < 16; ++pp) { const int pr = wid * 16 + pp, t = pr >> 2, hd = pr & 3;
                    const f32x2 x = *(const LAS f32x2*)(glu + t * 512 + hd * 128 + 2 * lane);
                    const float ss = wave_sum(x.x * x.x + x.y * x.y); const float sc = rsqrtf(ss + 1e-6f) * qs;
                    *(unsigned*)(QKVN + (size_t)(t0 + t) * 1536 + gi * 512 + hd * 128 + 2 * lane) = pk2(x.x * sc, x.y * sc); }
                __syncthreads();
            }
        }
#endif
#if !(EVP_SKIP & 4)
        if (tid < 256) { const int t = tid >> 3, j = tid & 7; const size_t tok = (size_t)(t0 + t);
            const float bp = gates[tok * 16 + j], ap = gates[tok * 16 + 8 + j];
            BETA[tok * 8 + j] = sigm(bp); LA[tok * 8 + j] = -expf(a_log[j]) * softplus_(ap + dt_bias[j]); }
#endif
        __syncthreads();
    }
}

__device__ __forceinline__ void delta_scan(LDSp lds, const Params& p) {
    const bf16_t* QKVN = (const bf16_t*)(p.ws + WS_QKV); const float* BETA = (const float*)(p.ws + WS_BETA); const float* LA = (const float*)(p.ws + WS_LA);
    const int tid = threadIdx.x, jl = tid >> 4, sub = tid & 15;
    constexpr int BUF = 37376;
    LAS float* ost = (LAS float*)(lds + 2 * BUF);
    for (int unit = blockIdx.x; unit < 128; unit += gridDim.x) {
        const int dir = unit >> 6, b = (unit >> 4) & 3, h = (unit >> 2) & 3, sl = unit & 3;
        bf16_t* O = (bf16_t*)(p.ws + (dir ? WS_OB : WS_OF));
        float S[8];
#pragma unroll
        for (int i = 0; i < 8; ++i) S[i] = 0.f;
        u32x4 rq[4]; u32x4 rv = {0u, 0u, 0u, 0u}; float ra = 0.f, rb = 0.f;
#define DS_TOK(n, s) ((size_t)b * S_ + (dir ? (S_ - 1 - ((n) * 64 + (s))) : ((n) * 64 + (s))))
#define DS_LOAD(n) do { _Pragma("unroll") for (int i = 0; i < 4; ++i) { const int pi = tid + NTHR * i, s = pi >> 5, w16 = pi & 31; \
            rq[i] = *(const u32x4*)(QKVN + DS_TOK(n, s) * 1536 + (w16 >> 4) * 512 + h * 128 + (w16 & 15) * 8); } \
        if (tid < 256) { const int s = tid >> 2, c8 = tid & 3; rv = *(const u32x4*)(QKVN + DS_TOK(n, s) * 1536 + 1024 + h * 128 + sl * 32 + c8 * 8); } \
        if (tid < 64) { const size_t tk = DS_TOK(n, tid); ra = expf(LA[tk * 8 + dir * 4 + h]); rb = BETA[tk * 8 + dir * 4 + h]; } } while (0)
#define DS_STORE(bufp) do { _Pragma("unroll") for (int i = 0; i < 4; ++i) { const int pi = tid + NTHR * i; *(LAS u32x4*)((bufp) + pi * 16) = rq[i]; } \
        if (tid < 256) *(LAS u32x4*)((bufp) + 32768 + tid * 16) = rv; \
        if (tid < 64) { *(LAS float*)((bufp) + 36864 + tid * 8) = ra; *(LAS float*)((bufp) + 36864 + tid * 8 + 4) = rb; } } while (0)
        DS_LOAD(0); DS_STORE(lds); __syncthreads();
#pragma unroll 1
        for (int n = 0; n < 64; ++n) {
            LDSp cb = lds + (n & 1) * BUF; LDSp nb = lds + ((n + 1) & 1) * BUF; LAS float* os = ost + (n & 1) * 2048;
            if (n < 63) DS_LOAD(n + 1);
#pragma unroll 4
            for (int s = 0; s < 64; ++s) {
                const u32x4 qq = *(const LAS u32x4*)(cb + s * 512 + sub * 16), kk = *(const LAS u32x4*)(cb + s * 512 + 256 + sub * 16);
                const float vj = bf2f(*(const LAS unsigned short*)(cb + 32768 + s * 64 + jl * 2));
                const float al = *(const LAS float*)(cb + 36864 + s * 8), be = *(const LAS float*)(cb + 36864 + s * 8 + 4);
                float kf[8], qf[8]; unpack8(kk, kf); unpack8(qq, qf);
                float ks = 0.f;
#pragma unroll
                for (int i = 0; i < 8; ++i) ks = fmaf(kf[i], S[i], ks);
                ks = row16_sum(ks);
                const float cc = be * (vj - al * ks);
                float o = 0.f;
#pragma unroll
                for (int i = 0; i < 8; ++i) { S[i] = fmaf(kf[i], cc, al * S[i]); o = fmaf(qf[i], S[i], o); }
                o = row16_sum(o);
                if (sub == 0) os[s * 32 + jl] = o;
            }
            if (n < 63) DS_STORE(nb);
            __syncthreads();
            { const int s = tid >> 3, j4 = (tid & 7) << 2; const f32x4 o4 = *(const LAS f32x4*)(os + s * 32 + j4);
              u32x2 w; w.x = pk2(o4.x, o4.y); w.y = pk2(o4.z, o4.w);
              *(u32x2*)(O + DS_TOK(n, s) * 512 + h * 128 + sl * 32 + j4) = w; }
        }
        __syncthreads();
#undef DS_LOAD
#undef DS_STORE
#undef DS_TOK
    }
}

__device__ __forceinline__ void tri_solve64(const LAS float* Am, const LAS unsigned short* col, const LAS float* sc, bf16_t* outp, long rstride) {
    f32x4 a;
    float x0 = sc[0] * bf2f(col[0]);
    outp[0 * rstride] = f2bf(x0);
    float x1 = sc[1] * bf2f(col[136]);
    a = *(const LAS f32x4*)(Am + 68);
    x1 = fmaf(-a.x, x0, x1);
    outp[1 * rstride] = f2bf(x1);
    float x2 = sc[2] * bf2f(col[272]);
    a = *(const LAS f32x4*)(Am + 136);
    x2 = fmaf(-a.x, x0, x2);
    x2 = fmaf(-a.y, x1, x2);
    outp[2 * rstride] = f2bf(x2);
    float x3 = sc[3] * bf2f(col[408]);
    a = *(const LAS f32x4*)(Am + 204);
    x3 = fmaf(-a.x, x0, x3);
    x3 = fmaf(-a.y, x1, x3);
    x3 = fmaf(-a.z, x2, x3);
    outp[3 * rstride] = f2bf(x3);
    float x4 = sc[4] * bf2f(col[544]);
    a = *(const LAS f32x4*)(Am + 272);
    x4 = fmaf(-a.x, x0, x4);
    x4 = fmaf(-a.y, x1, x4);
    x4 = fmaf(-a.z, x2, x4);
    x4 = fmaf(-a.w, x3, x4);
    outp[4 * rstride] = f2bf(x4);
    float x5 = sc[5] * bf2f(col[680]);
    a = *(const LAS f32x4*)(Am + 340);
    x5 = fmaf(-a.x, x0, x5);
    x5 = fmaf(-a.y, x1, x5);
    x5 = fmaf(-a.z, x2, x5);
    x5 = fmaf(-a.w, x3, x5);
    a = *(const LAS f32x4*)(Am + 344);
    x5 = fmaf(-a.x, x4, x5);
    outp[5 * rstride] = f2bf(x5);
    float x6 = sc[6] * bf2f(col[816]);
    a = *(const LAS f32x4*)(Am + 408);
    x6 = fmaf(-a.x, x0, x6);
    x6 = fmaf(-a.y, x1, x6);
    x6 = fmaf(-a.z, x2, x6);
    x6 = fmaf(-a.w, x3, x6);
    a = *(const LAS f32x4*)(Am + 412);
    x6 = fmaf(-a.x, x4, x6);
    x6 = fmaf(-a.y, x5, x6);
    outp[6 * rstride] = f2bf(x6);
    float x7 = sc[7] * bf2f(col[952]);
    a = *(const LAS f32x4*)(Am + 476);
    x7 = fmaf(-a.x, x0, x7);
    x7 = fmaf(-a.y, x1, x7);
    x7 = fmaf(-a.z, x2, x7);
    x7 = fmaf(-a.w, x3, x7);
    a = *(const LAS f32x4*)(Am + 480);
    x7 = fmaf(-a.x, x4, x7);
    x7 = fmaf(-a.y, x5, x7);
    x7 = fmaf(-a.z, x6, x7);
    outp[7 * rstride] = f2bf(x7);
    float x8 = sc[8] * bf2f(col[1088]);
    a = *(const LAS f32x4*)(Am + 544);
    x8 = fmaf(-a.x, x0, x8);
    x8 = fmaf(-a.y, x1, x8);
    x8 = fmaf(-a.z, x2, x8);
    x8 = fmaf(-a.w, x3, x8);
    a = *(const LAS f32x4*)(Am + 548);
    x8 = fmaf(-a.x, x4, x8);
    x8 = fmaf(-a.y, x5, x8);
    x8 = fmaf(-a.z, x6, x8);
    x8 = fmaf(-a.w, x7, x8);
    outp[8 * rstride] = f2bf(x8);
    float x9 = sc[9] * bf2f(col[1224]);
    a = *(const LAS f32x4*)(Am + 612);
    x9 = fmaf(-a.x, x0, x9);
    x9 = fmaf(-a.y, x1, x9);
    x9 = fmaf(-a.z, x2, x9);
    x9 = fmaf(-a.w, x3, x9);
    a = *(const LAS f32x4*)(Am + 616);
    x9 = fmaf(-a.x, x4, x9);
    x9 = fmaf(-a.y, x5, x9);
    x9 = fmaf(-a.z, x6, x9);
    x9 = fmaf(-a.w, x7, x9);
    a = *(const LAS f32x4*)(Am + 620);
    x9 = fmaf(-a.x, x8, x9);
    outp[9 * rstride] = f2bf(x9);
    float x10 = sc[10] * bf2f(col[1360]);
    a = *(const LAS f32x4*)(Am + 680);
    x10 = fmaf(-a.x, x0, x10);
    x10 = fmaf(-a.y, x1, x10);
    x10 = fmaf(-a.z, x2, x10);
    x10 = fmaf(-a.w, x3, x10);
    a = *(const LAS f32x4*)(Am + 684);
    x10 = fmaf(-a.x, x4, x10);
    x10 = fmaf(-a.y, x5, x10);
    x10 = fmaf(-a.z, x6, x10);
    x10 = fmaf(-a.w, x7, x10);
    a = *(const LAS f32x4*)(Am + 688);
    x10 = fmaf(-a.x, x8, x10);
    x10 = fmaf(-a.y, x9, x10);
    outp[10 * rstride] = f2bf(x10);
    float x11 = sc[11] * bf2f(col[1496]);
    a = *(const LAS f32x4*)(Am + 748);
    x11 = fmaf(-a.x, x0, x11);
    x11 = fmaf(-a.y, x1, x11);
    x11 = fmaf(-a.z, x2, x11);
    x11 = fmaf(-a.w, x3, x11);
    a = *(const LAS f32x4*)(Am + 752);
    x11 = fmaf(-a.x, x4, x11);
    x11 = fmaf(-a.y, x5, x11);
    x11 = fmaf(-a.z, x6, x11);
    x11 = fmaf(-a.w, x7, x11);
    a = *(const LAS f32x4*)(Am + 756);
    x11 = fmaf(-a.x, x8, x11);
    x11 = fmaf(-a.y, x9, x11);
    x11 = fmaf(-a.z, x10, x11);
    outp[11 * rstride] = f2bf(x11);
    float x12 = sc[12] * bf2f(col[1632]);
    a = *(const LAS f32x4*)(Am + 816);
    x12 = fmaf(-a.x, x0, x12);
    x12 = fmaf(-a.y, x1, x12);
    x12 = fmaf(-a.z, x2, x12);
    x12 = fmaf(-a.w, x3, x12);
    a = *(const LAS f32x4*)(Am + 820);
    x12 = fmaf(-a.x, x4, x12);
    x12 = fmaf(-a.y, x5, x12);
    x12 = fmaf(-a.z, x6, x12);
    x12 = fmaf(-a.w, x7, x12);
    a = *(const LAS f32x4*)(Am + 824);
    x12 = fmaf(-a.x, x8, x12);
    x12 = fmaf(-a.y, x9, x12);
    x12 = fmaf(-a.z, x10, x12);
    x12 = fmaf(-a.w, x11, x12);
    outp[12 * rstride] = f2bf(x12);
    float x13 = sc[13] * bf2f(col[1768]);
    a = *(const LAS f32x4*)(Am + 884);
    x13 = fmaf(-a.x, x0, x13);
    x13 = fmaf(-a.y, x1, x13);
    x13 = fmaf(-a.z, x2, x13);
    x13 = fmaf(-a.w, x3, x13);
    a = *(const LAS f32x4*)(Am + 888);
    x13 = fmaf(-a.x, x4, x13);
    x13 = fmaf(-a.y, x5, x13);
    x13 = fmaf(-a.z, x6, x13);
    x13 = fmaf(-a.w, x7, x13);
    a = *(const LAS f32x4*)(Am + 892);
    x13 = fmaf(-a.x, x8, x13);
    x13 = fmaf(-a.y, x9, x13);
    x13 = fmaf(-a.z, x10, x13);
    x13 = fmaf(-a.w, x11, x13);
    a = *(const LAS f32x4*)(Am + 896);
    x13 = fmaf(-a.x, x12, x13);
    outp[13 * rstride] = f2bf(x13);
    float x14 = sc[14] * bf2f(col[1904]);
    a = *(const LAS f32x4*)(Am + 952);
    x14 = fmaf(-a.x, x0, x14);
    x14 = fmaf(-a.y, x1, x14);
    x14 = fmaf(-a.z, x2, x14);
    x14 = fmaf(-a.w, x3, x14);
    a = *(const LAS f32x4*)(Am + 956);
    x14 = fmaf(-a.x, x4, x14);
    x14 = fmaf(-a.y, x5, x14);
    x14 = fmaf(-a.z, x6, x14);
    x14 = fmaf(-a.w, x7, x14);
    a = *(const LAS f32x4*)(Am + 960);
    x14 = fmaf(-a.x, x8, x14);
    x14 = fmaf(-a.y, x9, x14);
    x14 = fmaf(-a.z, x10, x14);
    x14 = fmaf(-a.w, x11, x14);
    a = *(const LAS f32x4*)(Am + 964);
    x14 = fmaf(-a.x, x12, x14);
    x14 = fmaf(-a.y, x13, x14);
    outp[14 * rstride] = f2bf(x14);
    float x15 = sc[15] * bf2f(col[2040]);
    a = *(const LAS f32x4*)(Am + 1020);
    x15 = fmaf(-a.x, x0, x15);
    x15 = fmaf(-a.y, x1, x15);
    x15 = fmaf(-a.z, x2, x15);
    x15 = fmaf(-a.w, x3, x15);
    a = *(const LAS f32x4*)(Am + 1024);
    x15 = fmaf(-a.x, x4, x15);
    x15 = fmaf(-a.y, x5, x15);
    x15 = fmaf(-a.z, x6, x15);
    x15 = fmaf(-a.w, x7, x15);
    a = *(const LAS f32x4*)(Am + 1028);
    x15 = fmaf(-a.x, x8, x15);
    x15 = fmaf(-a.y, x9, x15);
    x15 = fmaf(-a.z, x10, x15);
    x15 = fmaf(-a.w, x11, x15);
    a = *(const LAS f32x4*)(Am + 1032);
    x15 = fmaf(-a.x, x12, x15);
    x15 = fmaf(-a.y, x13, x15);
    x15 = fmaf(-a.z, x14, x15);
    outp[15 * rstride] = f2bf(x15);
    float x16 = sc[16] * bf2f(col[2176]);
    a = *(const LAS f32x4*)(Am + 1088);
    x16 = fmaf(-a.x, x0, x16);
    x16 = fmaf(-a.y, x1, x16);
    x16 = fmaf(-a.z, x2, x16);
    x16 = fmaf(-a.w, x3, x16);
    a = *(const LAS f32x4*)(Am + 1092);
    x16 = fmaf(-a.x, x4, x16);
    x16 = fmaf(-a.y, x5, x16);
    x16 = fmaf(-a.z, x6, x16);
    x16 = fmaf(-a.w, x7, x16);
    a = *(const LAS f32x4*)(Am + 1096);
    x16 = fmaf(-a.x, x8, x16);
    x16 = fmaf(-a.y, x9, x16);
    x16 = fmaf(-a.z, x10, x16);
    x16 = fmaf(-a.w, x11, x16);
    a = *(const LAS f32x4*)(Am + 1100);
    x16 = fmaf(-a.x, x12, x16);
    x16 = fmaf(-a.y, x13, x16);
    x16 = fmaf(-a.z, x14, x16);
    x16 = fmaf(-a.w, x15, x16);
    outp[16 * rstride] = f2bf(x16);
    float x17 = sc[17] * bf2f(col[2312]);
    a = *(const LAS f32x4*)(Am + 1156);
    x17 = fmaf(-a.x, x0, x17);
    x17 = fmaf(-a.y, x1, x17);
    x17 = fmaf(-a.z, x2, x17);
    x17 = fmaf(-a.w, x3, x17);
    a = *(const LAS f32x4*)(Am + 1160);
    x17 = fmaf(-a.x, x4, x17);
    x17 = fmaf(-a.y, x5, x17);
    x17 = fmaf(-a.z, x6, x17);
    x17 = fmaf(-a.w, x7, x17);
    a = *(const LAS f32x4*)(Am + 1164);
    x17 = fmaf(-a.x, x8, x17);
    x17 = fmaf(-a.y, x9, x17);
    x17 = fmaf(-a.z, x10, x17);
    x17 = fmaf(-a.w, x11, x17);
    a = *(const LAS f32x4*)(Am + 1168);
    x17 = fmaf(-a.x, x12, x17);
    x17 = fmaf(-a.y, x13, x17);
    x17 = fmaf(-a.z, x14, x17);
    x17 = fmaf(-a.w, x15, x17);
    a = *(const LAS f32x4*)(Am + 1172);
    x17 = fmaf(-a.x, x16, x17);
    outp[17 * rstride] = f2bf(x17);
    float x18 = sc[18] * bf2f(col[2448]);
    a = *(const LAS f32x4*)(Am + 1224);
    x18 = fmaf(-a.x, x0, x18);
    x18 = fmaf(-a.y, x1, x18);
    x18 = fmaf(-a.z, x2, x18);
    x18 = fmaf(-a.w, x3, x18);
    a = *(const LAS f32x4*)(Am + 1228);
    x18 = fmaf(-a.x, x4, x18);
    x18 = fmaf(-a.y, x5, x18);
    x18 = fmaf(-a.z, x6, x18);
    x18 = fmaf(-a.w, x7, x18);
    a = *(const LAS f32x4*)(Am + 1232);
    x18 = fmaf(-a.x, x8, x18);
    x18 = fmaf(-a.y, x9, x18);
    x18 = fmaf(-a.z, x10, x18);
    x18 = fmaf(-a.w, x11, x18);
    a = *(const LAS f32x4*)(Am + 1236);
    x18 = fmaf(-a.x, x12, x18);
    x18 = fmaf(-a.y, x13, x18);
    x18 = fmaf(-a.z, x14, x18);
    x18 = fmaf(-a.w, x15, x18);
    a = *(const LAS f32x4*)(Am + 1240);
    x18 = fmaf(-a.x, x16, x18);
    x18 = fmaf(-a.y, x17, x18);
    outp[18 * rstride] = f2bf(x18);
    float x19 = sc[19] * bf2f(col[2584]);
    a = *(const LAS f32x4*)(Am + 1292);
    x19 = fmaf(-a.x, x0, x19);
    x19 = fmaf(-a.y, x1, x19);
    x19 = fmaf(-a.z, x2, x19);
    x19 = fmaf(-a.w, x3, x19);
    a = *(const LAS f32x4*)(Am + 1296);
    x19 = fmaf(-a.x, x4, x19);
    x19 = fmaf(-a.y, x5, x19);
    x19 = fmaf(-a.z, x6, x19);
    x19 = fmaf(-a.w, x7, x19);
    a = *(const LAS f32x4*)(Am + 1300);
    x19 = fmaf(-a.x, x8, x19);
    x19 = fmaf(-a.y, x9, x19);
    x19 = fmaf(-a.z, x10, x19);
    x19 = fmaf(-a.w, x11, x19);
    a = *(const LAS f32x4*)(Am + 1304);
    x19 = fmaf(-a.x, x12, x19);
    x19 = fmaf(-a.y, x13, x19);
    x19 = fmaf(-a.z, x14, x19);
    x19 = fmaf(-a.w, x15, x19);
    a = *(const LAS f32x4*)(Am + 1308);
    x19 = fmaf(-a.x, x16, x19);
    x19 = fmaf(-a.y, x17, x19);
    x19 = fmaf(-a.z, x18, x19);
    outp[19 * rstride] = f2bf(x19);
    float x20 = sc[20] * bf2f(col[2720]);
    a = *(const LAS f32x4*)(Am + 1360);
    x20 = fmaf(-a.x, x0, x20);
    x20 = fmaf(-a.y, x1, x20);
    x20 = fmaf(-a.z, x2, x20);
    x20 = fmaf(-a.w, x3, x20);
    a = *(const LAS f32x4*)(Am + 1364);
    x20 = fmaf(-a.x, x4, x20);
    x20 = fmaf(-a.y, x5, x20);
    x20 = fmaf(-a.z, x6, x20);
    x20 = fmaf(-a.w, x7, x20);
    a = *(const LAS f32x4*)(Am + 1368);
    x20 = fmaf(-a.x, x8, x20);
    x20 = fmaf(-a.y, x9, x20);
    x20 = fmaf(-a.z, x10, x20);
    x20 = fmaf(-a.w, x11, x20);
    a = *(const LAS f32x4*)(Am + 1372);
    x20 = fmaf(-a.x, x12, x20);
    x20 = fmaf(-a.y, x13, x20);
    x20 = fmaf(-a.z, x14, x20);
    x20 = fmaf(-a.w, x15, x20);
    a = *(const LAS f32x4*)(Am + 1376);
    x20 = fmaf(-a.x, x16, x20);
    x20 = fmaf(-a.y, x17, x20);
    x20 = fmaf(-a.z, x18, x20);
    x20 = fmaf(-a.w, x19, x20);
    outp[20 * rstride] = f2bf(x20);
    float x21 = sc[21] * bf2f(col[2856]);
    a = *(const LAS f32x4*)(Am + 1428);
    x21 = fmaf(-a.x, x0, x21);
    x21 = fmaf(-a.y, x1, x21);
    x21 = fmaf(-a.z, x2, x21);
    x21 = fmaf(-a.w, x3, x21);
    a = *(const LAS f32x4*)(Am + 1432);
    x21 = fmaf(-a.x, x4, x21);
    x21 = fmaf(-a.y, x5, x21);
    x21 = fmaf(-a.z, x6, x21);
    x21 = fmaf(-a.w, x7, x21);
    a = *(const LAS f32x4*)(Am + 1436);
    x21 = fmaf(-a.x, x8, x21);
    x21 = fmaf(-a.y, x9, x21);
    x21 = fmaf(-a.z, x10, x21);
    x21 = fmaf(-a.w, x11, x21);
    a = *(const LAS f32x4*)(Am + 1440);
    x21 = fmaf(-a.x, x12, x21);
    x21 = fmaf(-a.y, x13, x21);
    x21 = fmaf(-a.z, x14, x21);
    x21 = fmaf(-a.w, x15, x21);
    a = *(const LAS f32x4*)(Am + 1444);
    x21 = fmaf(-a.x, x16, x21);
    x21 = fmaf(-a.y, x17, x21);
    x21 = fmaf(-a.z, x18, x21);
    x21 = fmaf(-a.w, x19, x21);
    a = *(const LAS f32x4*)(Am + 1448);
    x21 = fmaf(-a.x, x20, x21);
    outp[21 * rstride] = f2bf(x21);
    float x22 = sc[22] * bf2f(col[2992]);
    a = *(const LAS f32x4*)(Am + 1496);
    x22 = fmaf(-a.x, x0, x22);
    x22 = fmaf(-a.y, x1, x22);
    x22 = fmaf(-a.z, x2, x22);
    x22 = fmaf(-a.w, x3, x22);
    a = *(const LAS f32x4*)(Am + 1500);
    x22 = fmaf(-a.x, x4, x22);
    x22 = fmaf(-a.y, x5, x22);
    x22 = fmaf(-a.z, x6, x22);
    x22 = fmaf(-a.w, x7, x22);
    a = *(const LAS f32x4*)(Am + 1504);
    x22 = fmaf(-a.x, x8, x22);
    x22 = fmaf(-a.y, x9, x22);
    x22 = fmaf(-a.z, x10, x22);
    x22 = fmaf(-a.w, x11, x22);
    a = *(const LAS f32x4*)(Am + 1508);
    x22 = fmaf(-a.x, x12, x22);
    x22 = fmaf(-a.y, x13, x22);
    x22 = fmaf(-a.z, x14, x22);
    x22 = fmaf(-a.w, x15, x22);
    a = *(const LAS f32x4*)(Am + 1512);
    x22 = fmaf(-a.x, x16, x22);
    x22 = fmaf(-a.y, x17, x22);
    x22 = fmaf(-a.z, x18, x22);
    x22 = fmaf(-a.w, x19, x22);
    a = *(const LAS f32x4*)(Am + 1516);
    x22 = fmaf(-a.x, x20, x22);
    x22 = fmaf(-a.y, x21, x22);
    outp[22 * rstride] = f2bf(x22);
    float x23 = sc[23] * bf2f(col[3128]);
    a = *(const LAS f32x4*)(Am + 1564);
    x23 = fmaf(-a.x, x0, x23);
    x23 = fmaf(-a.y, x1, x23);
    x23 = fmaf(-a.z, x2, x23);
    x23 = fmaf(-a.w, x3, x23);
    a = *(const LAS f32x4*)(Am + 1568);
    x23 = fmaf(-a.x, x4, x23);
    x23 = fmaf(-a.y, x5, x23);
    x23 = fmaf(-a.z, x6, x23);
    x23 = fmaf(-a.w, x7, x23);
    a = *(const LAS f32x4*)(Am + 1572);
    x23 = fmaf(-a.x, x8, x23);
    x23 = fmaf(-a.y, x9, x23);
    x23 = fmaf(-a.z, x10, x23);
    x23 = fmaf(-a.w, x11, x23);
    a = *(const LAS f32x4*)(Am + 1576);
    x23 = fmaf(-a.x, x12, x23);
    x23 = fmaf(-a.y, x13, x23);
    x23 = fmaf(-a.z, x14, x23);
    x23 = fmaf(-a.w, x15, x23);
    a = *(const LAS f32x4*)(Am + 1580);
    x23 = fmaf(-a.x, x16, x23);
    x23 = fmaf(-a.y, x17, x23);
    x23 = fmaf(-a.z, x18, x23);
    x23 = fmaf(-a.w, x19, x23);
    a = *(const LAS f32x4*)(Am + 1584);
    x23 = fmaf(-a.x, x20, x23);
    x23 = fmaf(-a.y, x21, x23);
    x23 = fmaf(-a.z, x22, x23);
    outp[23 * rstride] = f2bf(x23);
    float x24 = sc[24] * bf2f(col[3264]);
    a = *(const LAS f32x4*)(Am + 1632);
    x24 = fmaf(-a.x, x0, x24);
    x24 = fmaf(-a.y, x1, x24);
    x24 = fmaf(-a.z, x2, x24);
    x24 = fmaf(-a.w, x3, x24);
    a = *(const LAS f32x4*)(Am + 1636);
    x24 = fmaf(-a.x, x4, x24);
    x24 = fmaf(-a.y, x5, x24);
    x24 = fmaf(-a.z, x6, x24);
    x24 = fmaf(-a.w, x7, x24);
    a = *(const LAS f32x4*)(Am + 1640);
    x24 = fmaf(-a.x, x8, x24);
    x24 = fmaf(-a.y, x9, x24);
    x24 = fmaf(-a.z, x10, x24);
    x24 = fmaf(-a.w, x11, x24);
    a = *(const LAS f32x4*)(Am + 1644);
    x24 = fmaf(-a.x, x12, x24);
    x24 = fmaf(-a.y, x13, x24);
    x24 = fmaf(-a.z, x14, x24);
    x24 = fmaf(-a.w, x15, x24);
    a = *(const LAS f32x4*)(Am + 1648);
    x24 = fmaf(-a.x, x16, x24);
    x24 = fmaf(-a.y, x17, x24);
    x24 = fmaf(-a.z, x18, x24);
    x24 = fmaf(-a.w, x19, x24);
    a = *(const LAS f32x4*)(Am + 1652);
    x24 = fmaf(-a.x, x20, x24);
    x24 = fmaf(-a.y, x21, x24);
    x24 = fmaf(-a.z, x22, x24);
    x24 = fmaf(-a.w, x23, x24);
    outp[24 * rstride] = f2bf(x24);
    float x25 = sc[25] * bf2f(col[3400]);
    a = *(const LAS f32x4*)(Am + 1700);
    x25 = fmaf(-a.x, x0, x25);
    x25 = fmaf(-a.y, x1, x25);
    x25 = fmaf(-a.z, x2, x25);
    x25 = fmaf(-a.w, x3, x25);
    a = *(const LAS f32x4*)(Am + 1704);
    x25 = fmaf(-a.x, x4, x25);
    x25 = fmaf(-a.y, x5, x25);
    x25 = fmaf(-a.z, x6, x25);
    x25 = fmaf(-a.w, x7, x25);
    a = *(const LAS f32x4*)(Am + 1708);
    x25 = fmaf(-a.x, x8, x25);
    x25 = fmaf(-a.y, x9, x25);
    x25 = fmaf(-a.z, x10, x25);
    x25 = fmaf(-a.w, x11, x25);
    a = *(const LAS f32x4*)(Am + 1712);
    x25 = fmaf(-a.x, x12, x25);
    x25 = fmaf(-a.y, x13, x25);
    x25 = fmaf(-a.z, x14, x25);
    x25 = fmaf(-a.w, x15, x25);
    a = *(const LAS f32x4*)(Am + 1716);
    x25 = fmaf(-a.x, x16, x25);
    x25 = fmaf(-a.y, x17, x25);
    x25 = fmaf(-a.z, x18, x25);
    x25 = fmaf(-a.w, x19, x25);
    a = *(const LAS f32x4*)(Am + 1720);
    x25 = fmaf(-a.x, x20, x25);
    x25 = fmaf(-a.y, x21, x25);
    x25 = fmaf(-a.z, x22, x25);
    x25 = fmaf(-a.w, x23, x25);
    a = *(const LAS f32x4*)(Am + 1724);
    x25 = fmaf(-a.x, x24, x25);
    outp[25 * rstride] = f2bf(x25);
    float x26 = sc[26] * bf2f(col[3536]);
    a = *(const LAS f32x4*)(Am + 1768);
    x26 = fmaf(-a.x, x0, x26);
    x26 = fmaf(-a.y, x1, x26);
    x26 = fmaf(-a.z, x2, x26);
    x26 = fmaf(-a.w, x3, x26);
    a = *(const LAS f32x4*)(Am + 1772);
    x26 = fmaf(-a.x, x4, x26);
    x26 = fmaf(-a.y, x5, x26);
    x26 = fmaf(-a.z, x6, x26);
    x26 = fmaf(-a.w, x7, x26);
    a = *(const LAS f32x4*)(Am + 1776);
    x26 = fmaf(-a.x, x8, x26);
    x26 = fmaf(-a.y, x9, x26);
    x26 = fmaf(-a.z, x10, x26);
    x26 = fmaf(-a.w, x11, x26);
    a = *(const LAS f32x4*)(Am + 1780);
    x26 = fmaf(-a.x, x12, x26);
    x26 = fmaf(-a.y, x13, x26);
    x26 = fmaf(-a.z, x14, x26);
    x26 = fmaf(-a.w, x15, x26);
    a = *(const LAS f32x4*)(Am + 1784);
    x26 = fmaf(-a.x, x16, x26);
    x26 = fmaf(-a.y, x17, x26);
    x26 = fmaf(-a.z, x18, x26);
    x26 = fmaf(-a.w, x19, x26);
    a = *(const LAS f32x4*)(Am + 1788);
    x26 = fmaf(-a.x, x20, x26);
    x26 = fmaf(-a.y, x21, x26);
    x26 = fmaf(-a.z, x22, x26);
    x26 = fmaf(-a.w, x23, x26);
    a = *(const LAS f32x4*)(Am + 1792);
    x26 = fmaf(-a.x, x24, x26);
    x26 = fmaf(-a.y, x25, x26);
    outp[26 * rstride] = f2bf(x26);
    float x27 = sc[27] * bf2f(col[3672]);
    a = *(const LAS f32x4*)(Am + 1836);
    x27 = fmaf(-a.x, x0, x27);
    x27 = fmaf(-a.y, x1, x27);
    x27 = fmaf(-a.z, x2, x27);
    x27 = fmaf(-a.w, x3, x27);
    a = *(const LAS f32x4*)(Am + 1840);
    x27 = fmaf(-a.x, x4, x27);
    x27 = fmaf(-a.y, x5, x27);
    x27 = fmaf(-a.z, x6, x27);
    x27 = fmaf(-a.w, x7, x27);
    a = *(const LAS f32x4*)(Am + 1844);
    x27 = fmaf(-a.x, x8, x27);
    x27 = fmaf(-a.y, x9, x27);
    x27 = fmaf(-a.z, x10, x27);
    x27 = fmaf(-a.w, x11, x27);
    a = *(const LAS f32x4*)(Am + 1848);
    x27 = fmaf(-a.x, x12, x27);
    x27 = fmaf(-a.y, x13, x27);
    x27 = fmaf(-a.z, x14, x27);
    x27 = fmaf(-a.w, x15, x27);
    a = *(const LAS f32x4*)(Am + 1852);
    x27 = fmaf(-a.x, x16, x27);
    x27 = fmaf(-a.y, x17, x27);
    x27 = fmaf(-a.z, x18, x27);
    x27 = fmaf(-a.w, x19, x27);
    a = *(const LAS f32x4*)(Am + 1856);
    x27 = fmaf(-a.x, x20, x27);
    x27 = fmaf(-a.y, x21, x27);
    x27 = fmaf(-a.z, x22, x27);
    x27 = fmaf(-a.w, x23, x27);
    a = *(const LAS f32x4*)(Am + 1860);
    x27 = fmaf(-a.x, x24, x27);
    x27 = fmaf(-a.y, x25, x27);
    x27 = fmaf(-a.z, x26, x27);
    outp[27 * rstride] = f2bf(x27);
    float x28 = sc[28] * bf2f(col[3808]);
    a = *(const LAS f32x4*)(Am + 1904);
    x28 = fmaf(-a.x, x0, x28);
    x28 = fmaf(-a.y, x1, x28);
    x28 = fmaf(-a.z, x2, x28);
    x28 = fmaf(-a.w, x3, x28);
    a = *(const LAS f32x4*)(Am + 1908);
    x28 = fmaf(-a.x, x4, x28);
    x28 = fmaf(-a.y, x5, x28);
    x28 = fmaf(-a.z, x6, x28);
    x28 = fmaf(-a.w, x7, x28);
    a = *(const LAS f32x4*)(Am + 1912);
    x28 = fmaf(-a.x, x8, x28);
    x28 = fmaf(-a.y, x9, x28);
    x28 = fmaf(-a.z, x10, x28);
    x28 = fmaf(-a.w, x11, x28);
    a = *(const LAS f32x4*)(Am + 1916);
    x28 = fmaf(-a.x, x12, x28);
    x28 = fmaf(-a.y, x13, x28);
    x28 = fmaf(-a.z, x14, x28);
    x28 = fmaf(-a.w, x15, x28);
    a = *(const LAS f32x4*)(Am + 1920);
    x28 = fmaf(-a.x, x16, x28);
    x28 = fmaf(-a.y, x17, x28);
    x28 = fmaf(-a.z, x18, x28);
    x28 = fmaf(-a.w, x19, x28);
    a = *(const LAS f32x4*)(Am + 1924);
    x28 = fmaf(-a.x, x20, x28);
    x28 = fmaf(-a.y, x21, x28);
    x28 = fmaf(-a.z, x22, x28);
    x28 = fmaf(-a.w, x23, x28);
    a = *(const LAS f32x4*)(Am + 1928);
    x28 = fmaf(-a.x, x24, x28);
    x28 = fmaf(-a.y, x25, x28);
    x28 = fmaf(-a.z, x26, x28);
    x28 = fmaf(-a.w, x27, x28);
    outp[28 * rstride] = f2bf(x28);
    float x29 = sc[29] * bf2f(col[3944]);
    a = *(const LAS f32x4*)(Am + 1972);
    x29 = fmaf(-a.x, x0, x29);
    x29 = fmaf(-a.y, x1, x29);
    x29 = fmaf(-a.z, x2, x29);
    x29 = fmaf(-a.w, x3, x29);
    a = *(const LAS f32x4*)(Am + 1976);
    x29 = fmaf(-a.x, x4, x29);
    x29 = fmaf(-a.y, x5, x29);
    x29 = fmaf(-a.z, x6, x29);
    x29 = fmaf(-a.w, x7, x29);
    a = *(const LAS f32x4*)(Am + 1980);
    x29 = fmaf(-a.x, x8, x29);
    x29 = fmaf(-a.y, x9, x29);
    x29 = fmaf(-a.z, x10, x29);
    x29 = fmaf(-a.w, x11, x29);
    a = *(const LAS f32x4*)(Am + 1984);
    x29 = fmaf(-a.x, x12, x29);
    x29 = fmaf(-a.y, x13, x29);
    x29 = fmaf(-a.z, x14, x29);
    x29 = fmaf(-a.w, x15, x29);
    a = *(const LAS f32x4*)(Am + 1988);
    x29 = fmaf(-a.x, x16, x29);
    x29 = fmaf(-a.y, x17, x29);
    x29 = fmaf(-a.z, x18, x29);
    x29 = fmaf(-a.w, x19, x29);
    a = *(const LAS f32x4*)(Am + 1992);
    x29 = fmaf(-a.x, x20, x29);
    x29 = fmaf(-a.y, x21, x29);
    x29 = fmaf(-a.z, x22, x29);
    x29 = fmaf(-a.w, x23, x29);
    a = *(const LAS f32x4*)(Am + 1996);
    x29 = fmaf(-a.x, x24, x29);
    x29 = fmaf(-a.y, x25, x29);
    x29 = fmaf(-a.z, x26, x29);
    x29 = fmaf(-a.w, x27, x29);
    a = *(const LAS f32x4*)(Am + 2000);
    x29 = fmaf(-a.x, x28, x29);
    outp[29 * rstride] = f2bf(x29);
    float x30 = sc[30] * bf2f(col[4080]);
    a = *(const LAS f32x4*)(Am + 2040);
    x30 = fmaf(-a.x, x0, x30);
    x30 = fmaf(-a.y, x1, x30);
    x30 = fmaf(-a.z, x2, x30);
    x30 = fmaf(-a.w, x3, x30);
    a = *(const LAS f32x4*)(Am + 2044);
    x30 = fmaf(-a.x, x4, x30);
    x30 = fmaf(-a.y, x5, x30);
    x30 = fmaf(-a.z, x6, x30);
    x30 = fmaf(-a.w, x7, x30);
    a = *(const LAS f32x4*)(Am + 2048);
    x30 = fmaf(-a.x, x8, x30);
    x30 = fmaf(-a.y, x9, x30);
    x30 = fmaf(-a.z, x10, x30);
    x30 = fmaf(-a.w, x11, x30);
    a = *(const LAS f32x4*)(Am + 2052);
    x30 = fmaf(-a.x, x12, x30);
    x30 = fmaf(-a.y, x13, x30);
    x30 = fmaf(-a.z, x14, x30);
    x30 = fmaf(-a.w, x15, x30);
    a = *(const LAS f32x4*)(Am + 2056);
    x30 = fmaf(-a.x, x16, x30);
    x30 = fmaf(-a.y, x17, x30);
    x30 = fmaf(-a.z, x18, x30);
    x30 = fmaf(-a.w, x19, x30);
    a = *(const LAS f32x4*)(Am + 2060);
    x30 = fmaf(-a.x, x20, x30);
    x30 = fmaf(-a.y, x21, x30);
    x30 = fmaf(-a.z, x22, x30);
    x30 = fmaf(-a.w, x23, x30);
    a = *(const LAS f32x4*)(Am + 2064);
    x30 = fmaf(-a.x, x24, x30);
    x30 = fmaf(-a.y, x25, x30);
    x30 = fmaf(-a.z, x26, x30);
    x30 = fmaf(-a.w, x27, x30);
    a = *(const LAS f32x4*)(Am + 2068);
    x30 = fmaf(-a.x, x28, x30);
    x30 = fmaf(-a.y, x29, x30);
    outp[30 * rstride] = f2bf(x30);
    float x31 = sc[31] * bf2f(col[4216]);
    a = *(const LAS f32x4*)(Am + 2108);
    x31 = fmaf(-a.x, x0, x31);
    x31 = fmaf(-a.y, x1, x31);
    x31 = fmaf(-a.z, x2, x31);
    x31 = fmaf(-a.w, x3, x31);
    a = *(const LAS f32x4*)(Am + 2112);
    x31 = fmaf(-a.x, x4, x31);
    x31 = fmaf(-a.y, x5, x31);
    x31 = fmaf(-a.z, x6, x31);
    x31 = fmaf(-a.w, x7, x31);
    a = *(const LAS f32x4*)(Am + 2116);
    x31 = fmaf(-a.x, x8, x31);
    x31 = fmaf(-a.y, x9, x31);
    x31 = fmaf(-a.z, x10, x31);
    x31 = fmaf(-a.w, x11, x31);
    a = *(const LAS f32x4*)(Am + 2120);
    x31 = fmaf(-a.x, x12, x31);
    x31 = fmaf(-a.y, x13, x31);
    x31 = fmaf(-a.z, x14, x31);
    x31 = fmaf(-a.w, x15, x31);
    a = *(const LAS f32x4*)(Am + 2124);
    x31 = fmaf(-a.x, x16, x31);
    x31 = fmaf(-a.y, x17, x31);
    x31 = fmaf(-a.z, x18, x31);
    x31 = fmaf(-a.w, x19, x31);
    a = *(const LAS f32x4*)(Am + 2128);
    x31 = fmaf(-a.x, x20, x31);
    x31 = fmaf(-a.y, x21, x31);
    x31 = fmaf(-a.z, x22, x31);
    x31 = fmaf(-a.w, x23, x31);
    a = *(const LAS f32x4*)(Am + 2132);
    x31 = fmaf(-a.x, x24, x31);
    x31 = fmaf(-a.y, x25, x31);
    x31 = fmaf(-a.z, x26, x31);
    x31 = fmaf(-a.w, x27, x31);
    a = *(const LAS f32x4*)(Am + 2136);
    x31 = fmaf(-a.x, x28, x31);
    x31 = fmaf(-a.y, x29, x31);
    x31 = fmaf(-a.z, x30, x31);
    outp[31 * rstride] = f2bf(x31);
    float x32 = sc[32] * bf2f(col[4352]);
    a = *(const LAS f32x4*)(Am + 2176);
    x32 = fmaf(-a.x, x0, x32);
    x32 = fmaf(-a.y, x1, x32);
    x32 = fmaf(-a.z, x2, x32);
    x32 = fmaf(-a.w, x3, x32);
    a = *(const LAS f32x4*)(Am + 2180);
    x32 = fmaf(-a.x, x4, x32);
    x32 = fmaf(-a.y, x5, x32);
    x32 = fmaf(-a.z, x6, x32);
    x32 = fmaf(-a.w, x7, x32);
    a = *(const LAS f32x4*)(Am + 2184);
    x32 = fmaf(-a.x, x8, x32);
    x32 = fmaf(-a.y, x9, x32);
    x32 = fmaf(-a.z, x10, x32);
    x32 = fmaf(-a.w, x11, x32);
    a = *(const LAS f32x4*)(Am + 2188);
    x32 = fmaf(-a.x, x12, x32);
    x32 = fmaf(-a.y, x13, x32);
    x32 = fmaf(-a.z, x14, x32);
    x32 = fmaf(-a.w, x15, x32);
    a = *(const LAS f32x4*)(Am + 2192);
    x32 = fmaf(-a.x, x16, x32);
    x32 = fmaf(-a.y, x17, x32);
    x32 = fmaf(-a.z, x18, x32);
    x32 = fmaf(-a.w, x19, x32);
    a = *(const LAS f32x4*)(Am + 2196);
    x32 = fmaf(-a.x, x20, x32);
    x32 = fmaf(-a.y, x21, x32);
    x32 = fmaf(-a.z, x22, x32);
    x32 = fmaf(-a.w, x23, x32);
    a = *(const LAS f32x4*)(Am + 2200);
    x32 = fmaf(-a.x, x24, x32);
    x32 = fmaf(-a.y, x25, x32);
    x32 = fmaf(-a.z, x26, x32);
    x32 = fmaf(-a.w, x27, x32);
    a = *(const LAS f32x4*)(Am + 2204);
    x32 = fmaf(-a.x, x28, x32);
    x32 = fmaf(-a.y, x29, x32);
    x32 = fmaf(-a.z, x30, x32);
    x32 = fmaf(-a.w, x31, x32);
    outp[32 * rstride] = f2bf(x32);
    float x33 = sc[33] * bf2f(col[4488]);
    a = *(const LAS f32x4*)(Am + 2244);
    x33 = fmaf(-a.x, x0, x33);
    x33 = fmaf(-a.y, x1, x33);
    x33 = fmaf(-a.z, x2, x33);
    x33 = fmaf(-a.w, x3, x33);
    a = *(const LAS f32x4*)(Am + 2248);
    x33 = fmaf(-a.x, x4, x33);
    x33 = fmaf(-a.y, x5, x33);
    x33 = fmaf(-a.z, x6, x33);
    x33 = fmaf(-a.w, x7, x33);
    a = *(const LAS f32x4*)(Am + 2252);
    x33 = fmaf(-a.x, x8, x33);
    x33 = fmaf(-a.y, x9, x33);
    x33 = fmaf(-a.z, x10, x33);
    x33 = fmaf(-a.w, x11, x33);
    a = *(const LAS f32x4*)(Am + 2256);
    x33 = fmaf(-a.x, x12, x33);
    x33 = fmaf(-a.y, x13, x33);
    x33 = fmaf(-a.z, x14, x33);
    x33 = fmaf(-a.w, x15, x33);
    a = *(const LAS f32x4*)(Am + 2260);
    x33 = fmaf(-a.x, x16, x33);
    x33 = fmaf(-a.y, x17, x33);
    x33 = fmaf(-a.z, x18, x33);
    x33 = fmaf(-a.w, x19, x33);
    a = *(const LAS f32x4*)(Am + 2264);
    x33 = fmaf(-a.x, x20, x33);
    x33 = fmaf(-a.y, x21, x33);
    x33 = fmaf(-a.z, x22, x33);
    x33 = fmaf(-a.w, x23, x33);
    a = *(const LAS f32x4*)(Am + 2268);
    x33 = fmaf(-a.x, x24, x33);
    x33 = fmaf(-a.y, x25, x33);
    x33 = fmaf(-a.z, x26, x33);
    x33 = fmaf(-a.w, x27, x33);
    a = *(const LAS f32x4*)(Am + 2272);
    x33 = fmaf(-a.x, x28, x33);
    x33 = fmaf(-a.y, x29, x33);
    x33 = fmaf(-a.z, x30, x33);
    x33 = fmaf(-a.w, x31, x33);
    a = *(const LAS f32x4*)(Am + 2276);
    x33 = fmaf(-a.x, x32, x33);
    outp[33 * rstride] = f2bf(x33);
    float x34 = sc[34] * bf2f(col[4624]);
    a = *(const LAS f32x4*)(Am + 2312);
    x34 = fmaf(-a.x, x0, x34);
    x34 = fmaf(-a.y, x1, x34);
    x34 = fmaf(-a.z, x2, x34);
    x34 = fmaf(-a.w, x3, x34);
    a = *(const LAS f32x4*)(Am + 2316);
    x34 = fmaf(-a.x, x4, x34);
    x34 = fmaf(-a.y, x5, x34);
    x34 = fmaf(-a.z, x6, x34);
    x34 = fmaf(-a.w, x7, x34);
    a = *(const LAS f32x4*)(Am + 2320);
    x34 = fmaf(-a.x, x8, x34);
    x34 = fmaf(-a.y, x9, x34);
    x34 = fmaf(-a.z, x10, x34);
    x34 = fmaf(-a.w, x11, x34);
    a = *(const LAS f32x4*)(Am + 2324);
    x34 = fmaf(-a.x, x12, x34);
    x34 = fmaf(-a.y, x13, x34);
    x34 = fmaf(-a.z, x14, x34);
    x34 = fmaf(-a.w, x15, x34);
    a = *(const LAS f32x4*)(Am + 2328);
    x34 = fmaf(-a.x, x16, x34);
    x34 = fmaf(-a.y, x17, x34);
    x34 = fmaf(-a.z, x18, x34);
    x34 = fmaf(-a.w, x19, x34);
    a = *(const LAS f32x4*)(Am + 2332);
    x34 = fmaf(-a.x, x20, x34);
    x34 = fmaf(-a.y, x21, x34);
    x34 = fmaf(-a.z, x22, x34);
    x34 = fmaf(-a.w, x23, x34);
    a = *(const LAS f32x4*)(Am + 2336);
    x34 = fmaf(-a.x, x24, x34);
    x34 = fmaf(-a.y, x25, x34);
    x34 = fmaf(-a.z, x26, x34);
    x34 = fmaf(-a.w, x27, x34);
    a = *(const LAS f32x4*)(Am + 2340);
    x34 = fmaf(-a.x, x28, x34);
    x34 = fmaf(-a.y, x29, x34);
    x34 = fmaf(-a.z, x30, x34);
    x34 = fmaf(-a.w, x31, x34);
    a = *(const LAS f32x4*)(Am + 2344);
    x34 = fmaf(-a.x, x32, x34);
    x34 = fmaf(-a.y, x33, x34);
    outp[34 * rstride] = f2bf(x34);
    float x35 = sc[35] * bf2f(col[4760]);
    a = *(const LAS f32x4*)(Am + 2380);
    x35 = fmaf(-a.x, x0, x35);
    x35 = fmaf(-a.y, x1, x35);
    x35 = fmaf(-a.z, x2, x35);
    x35 = fmaf(-a.w, x3, x35);
    a = *(const LAS f32x4*)(Am + 2384);
    x35 = fmaf(-a.x, x4, x35);
    x35 = fmaf(-a.y, x5, x35);
    x35 = fmaf(-a.z, x6, x35);
    x35 = fmaf(-a.w, x7, x35);
    a = *(const LAS f32x4*)(Am + 2388);
    x35 = fmaf(-a.x, x8, x35);
    x35 = fmaf(-a.y, x9, x35);
    x35 = fmaf(-a.z, x10, x35);
    x35 = fmaf(-a.w, x11, x35);
    a = *(const LAS f32x4*)(Am + 2392);
    x35 = fmaf(-a.x, x12, x35);
    x35 = fmaf(-a.y, x13, x35);
    x35 = fmaf(-a.z, x14, x35);
    x35 = fmaf(-a.w, x15, x35);
    a = *(const LAS f32x4*)(Am + 2396);
    x35 = fmaf(-a.x, x16, x35);
    x35 = fmaf(-a.y, x17, x35);
    x35 = fmaf(-a.z, x18, x35);
    x35 = fmaf(-a.w, x19, x35);
    a = *(const LAS f32x4*)(Am + 2400);
    x35 = fmaf(-a.x, x20, x35);
    x35 = fmaf(-a.y, x21, x35);
    x35 = fmaf(-a.z, x22, x35);
    x35 = fmaf(-a.w, x23, x35);
    a = *(const LAS f32x4*)(Am + 2404);
    x35 = fmaf(-a.x, x24, x35);
    x35 = fmaf(-a.y, x25, x35);
    x35 = fmaf(-a.z, x26, x35);
    x35 = fmaf(-a.w, x27, x35);
    a = *(const LAS f32x4*)(Am + 2408);
    x35 = fmaf(-a.x, x28, x35);
    x35 = fmaf(-a.y, x29, x35);
    x35 = fmaf(-a.z, x30, x35);
    x35 = fmaf(-a.w, x31, x35);
    a = *(const LAS f32x4*)(Am + 2412);
    x35 = fmaf(-a.x, x32, x35);
    x35 = fmaf(-a.y, x33, x35);
    x35 = fmaf(-a.z, x34, x35);
    outp[35 * rstride] = f2bf(x35);
    float x36 = sc[36] * bf2f(col[4896]);
    a = *(const LAS f32x4*)(Am + 2448);
    x36 = fmaf(-a.x, x0, x36);
    x36 = fmaf(-a.y, x1, x36);
    x36 = fmaf(-a.z, x2, x36);
    x36 = fmaf(-a.w, x3, x36);
    a = *(const LAS f32x4*)(Am + 2452);
    x36 = fmaf(-a.x, x4, x36);
    x36 = fmaf(-a.y, x5, x36);
    x36 = fmaf(-a.z, x6, x36);
    x36 = fmaf(-a.w, x7, x36);
    a = *(const LAS f32x4*)(Am + 2456);
    x36 = fmaf(-a.x, x8, x36);
    x36 = fmaf(-a.y, x9, x36);
    x36 = fmaf(-a.z, x10, x36);
    x36 = fmaf(-a.w, x11, x36);
    a = *(const LAS f32x4*)(Am + 2460);
    x36 = fmaf(-a.x, x12, x36);
    x36 = fmaf(-a.y, x13, x36);
    x36 = fmaf(-a.z, x14, x36);
    x36 = fmaf(-a.w, x15, x36);
    a = *(const LAS f32x4*)(Am + 2464);
    x36 = fmaf(-a.x, x16, x36);
    x36 = fmaf(-a.y, x17, x36);
    x36 = fmaf(-a.z, x18, x36);
    x36 = fmaf(-a.w, x19, x36);
    a = *(const LAS f32x4*)(Am + 2468);
    x36 = fmaf(-a.x, x20, x36);
    x36 = fmaf(-a.y, x21, x36);
    x36 = fmaf(-a.z, x22, x36);
    x36 = fmaf(-a.w, x23, x36);
    a = *(const LAS f32x4*)(Am + 2472);
    x36 = fmaf(-a.x, x24, x36);
    x36 = fmaf(-a.y, x25, x36);
    x36 = fmaf(-a.z, x26, x36);
    x36 = fmaf(-a.w, x27, x36);
    a = *(const LAS f32x4*)(Am + 2476);
    x36 = fmaf(-a.x, x28, x36);
    x36 = fmaf(-a.y, x29, x36);
    x36 = fmaf(-a.z, x30, x36);
    x36 = fmaf(-a.w, x31, x36);
    a = *(const LAS f32x4*)(Am + 2480);
    x36 = fmaf(-a.x, x32, x36);
    x36 = fmaf(-a.y, x33, x36);
    x36 = fmaf(-a.z, x34, x36);
    x36 = fmaf(-a.w, x35, x36);
    outp[36 * rstride] = f2bf(x36);
    float x37 = sc[37] * bf2f(col[5032]);
    a = *(const LAS f32x4*)(Am + 2516);
    x37 = fmaf(-a.x, x0, x37);
    x37 = fmaf(-a.y, x1, x37);
    x37 = fmaf(-a.z, x2, x37);
    x37 = fmaf(-a.w, x3, x37);
    a = *(const LAS f32x4*)(Am + 2520);
    x37 = fmaf(-a.x, x4, x37);
    x37 = fmaf(-a.y, x5, x37);
    x37 = fmaf(-a.z, x6, x37);
    x37 = fmaf(-a.w, x7, x37);
    a = *(const LAS f32x4*)(Am + 2524);
    x37 = fmaf(-a.x, x8, x37);
    x37 = fmaf(-a.y, x9, x37);
    x37 = fmaf(-a.z, x10, x37);
    x37 = fmaf(-a.w, x11, x37);
    a = *(const LAS f32x4*)(Am + 2528);
    x37 = fmaf(-a.x, x12, x37);
    x37 = fmaf(-a.y, x13, x37);
    x37 = fmaf(-a.z, x14, x37);
    x37 = fmaf(-a.w, x15, x37);
    a = *(const LAS f32x4*)(Am + 2532);
    x37 = fmaf(-a.x, x16, x37);
    x37 = fmaf(-a.y, x17, x37);
    x37 = fmaf(-a.z, x18, x37);
    x37 = fmaf(-a.w, x19, x37);
    a = *(const LAS f32x4*)(Am + 2536);
    x37 = fmaf(-a.x, x20, x37);
    x37 = fmaf(-a.y, x21, x37);
    x37 = fmaf(-a.z, x22, x37);
    x37 = fmaf(-a.w, x23, x37);
    a = *(const LAS f32x4*)(Am + 2540);
    x37 = fmaf(-a.x, x24, x37);
    x37 = fmaf(-a.y, x25, x37);
    x37 = fmaf(-a.z, x26, x37);
    x37 = fmaf(-a.w, x27, x37);
    a = *(const LAS f32x4*)(Am + 2544);
    x37 = fmaf(-a.x, x28, x37);
    x37 = fmaf(-a.y, x29, x37);
    x37 = fmaf(-a.z, x30, x37);
    x37 = fmaf(-a.w, x31, x37);
    a = *(const LAS f32x4*)(Am + 2548);
    x37 = fmaf(-a.x, x32, x37);
    x37 = fmaf(-a.y, x33, x37);
    x37 = fmaf(-a.z, x34, x37);
    x37 = fmaf(-a.w, x35, x37);
    a = *(const LAS f32x4*)(Am + 2552);
    x37 = fmaf(-a.x, x36, x37);
    outp[37 * rstride] = f2bf(x37);
    float x38 = sc[38] * bf2f(col[5168]);
    a = *(const LAS f32x4*)(Am + 2584);
    x38 = fmaf(-a.x, x0, x38);
    x38 = fmaf(-a.y, x1, x38);
    x38 = fmaf(-a.z, x2, x38);
    x38 = fmaf(-a.w, x3, x38);
    a = *(const LAS f32x4*)(Am + 2588);
    x38 = fmaf(-a.x, x4, x38);
    x38 = fmaf(-a.y, x5, x38);
    x38 = fmaf(-a.z, x6, x38);
    x38 = fmaf(-a.w, x7, x38);
    a = *(const LAS f32x4*)(Am + 2592);
    x38 = fmaf(-a.x, x8, x38);
    x38 = fmaf(-a.y, x9, x38);
    x38 = fmaf(-a.z, x10, x38);
    x38 = fmaf(-a.w, x11, x38);
    a = *(const LAS f32x4*)(Am + 2596);
    x38 = fmaf(-a.x, x12, x38);
    x38 = fmaf(-a.y, x13, x38);
    x38 = fmaf(-a.z, x14, x38);
    x38 = fmaf(-a.w, x15, x38);
    a = *(const LAS f32x4*)(Am + 2600);
    x38 = fmaf(-a.x, x16, x38);
    x38 = fmaf(-a.y, x17, x38);
    x38 = fmaf(-a.z, x18, x38);
    x38 = fmaf(-a.w, x19, x38);
    a = *(const LAS f32x4*)(Am + 2604);
    x38 = fmaf(-a.x, x20, x38);
    x38 = fmaf(-a.y, x21, x38);
    x38 = fmaf(-a.z, x22, x38);
    x38 = fmaf(-a.w, x23, x38);
    a = *(const LAS f32x4*)(Am + 2608);
    x38 = fmaf(-a.x, x24, x38);
    x38 = fmaf(-a.y, x25, x38);
    x38 = fmaf(-a.z, x26, x38);
    x38 = fmaf(-a.w, x27, x38);
    a = *(const LAS f32x4*)(Am + 2612);
    x38 = fmaf(-a.x, x28, x38);
    x38 = fmaf(-a.y, x29, x38);
    x38 = fmaf(-a.z, x30, x38);
    x38 = fmaf(-a.w, x31, x38);
    a = *(const LAS f32x4*)(Am + 2616);
    x38 = fmaf(-a.x, x32, x38);
    x38 = fmaf(-a.y, x33, x38);
    x38 = fmaf(-a.z, x34, x38);
    x38 = fmaf(-a.w, x35, x38);
    a = *(const LAS f32x4*)(Am + 2620);
    x38 = fmaf(-a.x, x36, x38);
    x38 = fmaf(-a.y, x37, x38);
    outp[38 * rstride] = f2bf(x38);
    float x39 = sc[39] * bf2f(col[5304]);
    a = *(const LAS f32x4*)(Am + 2652);
    x39 = fmaf(-a.x, x0, x39);
    x39 = fmaf(-a.y, x1, x39);
    x39 = fmaf(-a.z, x2, x39);
    x39 = fmaf(-a.w, x3, x39);
    a = *(const LAS f32x4*)(Am + 2656);
    x39 = fmaf(-a.x, x4, x39);
    x39 = fmaf(-a.y, x5, x39);
    x39 = fmaf(-a.z, x6, x39);
    x39 = fmaf(-a.w, x7, x39);
    a = *(const LAS f32x4*)(Am + 2660);
    x39 = fmaf(-a.x, x8, x39);
    x39 = fmaf(-a.y, x9, x39);
    x39 = fmaf(-a.z, x10, x39);
    x39 = fmaf(-a.w, x11, x39);
    a = *(const LAS f32x4*)(Am + 2664);
    x39 = fmaf(-a.x, x12, x39);
    x39 = fmaf(-a.y, x13, x39);
    x39 = fmaf(-a.z, x14, x39);
    x39 = fmaf(-a.w, x15, x39);
    a = *(const LAS f32x4*)(Am + 2668);
    x39 = fmaf(-a.x, x16, x39);
    x39 = fmaf(-a.y, x17, x39);
    x39 = fmaf(-a.z, x18, x39);
    x39 = fmaf(-a.w, x19, x39);
    a = *(const LAS f32x4*)(Am + 2672);
    x39 = fmaf(-a.x, x20, x39);
    x39 = fmaf(-a.y, x21, x39);
    x39 = fmaf(-a.z, x22, x39);
    x39 = fmaf(-a.w, x23, x39);
    a = *(const LAS f32x4*)(Am + 2676);
    x39 = fmaf(-a.x, x24, x39);
    x39 = fmaf(-a.y, x25, x39);
    x39 = fmaf(-a.z, x26, x39);
    x39 = fmaf(-a.w, x27, x39);
    a = *(const LAS f32x4*)(Am + 2680);
    x39 = fmaf(-a.x, x28, x39);
    x39 = fmaf(-a.y, x29, x39);
    x39 = fmaf(-a.z, x30, x39);
    x39 = fmaf(-a.w, x31, x39);
    a = *(const LAS f32x4*)(Am + 2684);
    x39 = fmaf(-a.x, x32, x39);
    x39 = fmaf(-a.y, x33, x39);
    x39 = fmaf(-a.z, x34, x39);
    x39 = fmaf(-a.w, x35, x39);
    a = *(const LAS f32x4*)(Am + 2688);
    x39 = fmaf(-a.x, x36, x39);
    x39 = fmaf(-a.y, x37, x39);
    x39 = fmaf(-a.z, x38, x39);
    outp[39 * rstride] = f2bf(x39);
    float x40 = sc[40] * bf2f(col[5440]);
    a = *(const LAS f32x4*)(Am + 2720);
    x40 = fmaf(-a.x, x0, x40);
    x40 = fmaf(-a.y, x1, x40);
    x40 = fmaf(-a.z, x2, x40);
    x40 = fmaf(-a.w, x3, x40);
    a = *(const LAS f32x4*)(Am + 2724);
    x40 = fmaf(-a.x, x4, x40);
    x40 = fmaf(-a.y, x5, x40);
    x40 = fmaf(-a.z, x6, x40);
    x40 = fmaf(-a.w, x7, x40);
    a = *(const LAS f32x4*)(Am + 2728);
    x40 = fmaf(-a.x, x8, x40);
    x40 = fmaf(-a.y, x9, x40);
    x40 = fmaf(-a.z, x10, x40);
    x40 = fmaf(-a.w, x11, x40);
    a = *(const LAS f32x4*)(Am + 2732);
    x40 = fmaf(-a.x, x12, x40);
    x40 = fmaf(-a.y, x13, x40);
    x40 = fmaf(-a.z, x14, x40);
    x40 = fmaf(-a.w, x15, x40);
    a = *(const LAS f32x4*)(Am + 2736);
    x40 = fmaf(-a.x, x16, x40);
    x40 = fmaf(-a.y, x17, x40);
    x40 = fmaf(-a.z, x18, x40);
    x40 = fmaf(-a.w, x19, x40);
    a = *(const LAS f32x4*)(Am + 2740);
    x40 = fmaf(-a.x, x20, x40);
    x40 = fmaf(-a.y, x21, x40);
    x40 = fmaf(-a.z, x22, x40);
    x40 = fmaf(-a.w, x23, x40);
    a = *(const LAS f32x4*)(Am + 2744);
    x40 = fmaf(-a.x, x24, x40);
    x40 = fmaf(-a.y, x25, x40);
    x40 = fmaf(-a.z, x26, x40);
    x40 = fmaf(-a.w, x27, x40);
    a = *(const LAS f32x4*)(Am + 2748);
    x40 = fmaf(-a.x, x28, x40);
    x40 = fmaf(-a.y, x29, x40);
    x40 = fmaf(-a.z, x30, x40);
    x40 = fmaf(-a.w, x31, x40);
    a = *(const LAS f32x4*)(Am + 2752);
    x40 = fmaf(-a.x, x32, x40);
    x40 = fmaf(-a.y, x33, x40);
    x40 = fmaf(-a.z, x34, x40);
    x40 = fmaf(-a.w, x35, x40);
    a = *(const LAS f32x4*)(Am + 2756);
    x40 = fmaf(-a.x, x36, x40);
    x40 = fmaf(-a.y, x37, x40);
    x40 = fmaf(-a.z, x38, x40);
    x40 = fmaf(-a.w, x39, x40);
    outp[40 * rstride] = f2bf(x40);
    float x41 = sc[41] * bf2f(col[5576]);
    a = *(const LAS f32x4*)(Am + 2788);
    x41 = fmaf(-a.x, x0, x41);
    x41 = fmaf(-a.y, x1, x41);
    x41 = fmaf(-a.z, x2, x41);
    x41 = fmaf(-a.w, x3, x41);
    a = *(const LAS f32x4*)(Am + 2792);
    x41 = fmaf(-a.x, x4, x41);
    x41 = fmaf(-a.y, x5, x41);
    x41 = fmaf(-a.z, x6, x41);
    x41 = fmaf(-a.w, x7, x41);
    a = *(const LAS f32x4*)(Am + 2796);
    x41 = fmaf(-a.x, x8, x41);
    x41 = fmaf(-a.y, x9, x41);
    x41 = fmaf(-a.z, x10, x41);
    x41 = fmaf(-a.w, x11, x41);
    a = *(const LAS f32x4*)(Am + 2800);
    x41 = fmaf(-a.x, x12, x41);
    x41 = fmaf(-a.y, x13, x41);
    x41 = fmaf(-a.z, x14, x41);
    x41 = fmaf(-a.w, x15, x41);
    a = *(const LAS f32x4*)(Am + 2804);
    x41 = fmaf(-a.x, x16, x41);
    x41 = fmaf(-a.y, x17, x41);
    x41 = fmaf(-a.z, x18, x41);
    x41 = fmaf(-a.w, x19, x41);
    a = *(const LAS f32x4*)(Am + 2808);
    x41 = fmaf(-a.x, x20, x41);
    x41 = fmaf(-a.y, x21, x41);
    x41 = fmaf(-a.z, x22, x41);
    x41 = fmaf(-a.w, x23, x41);
    a = *(const LAS f32x4*)(Am + 2812);
    x41 = fmaf(-a.x, x24, x41);
    x41 = fmaf(-a.y, x25, x41);
    x41 = fmaf(-a.z, x26, x41);
    x41 = fmaf(-a.w, x27, x41);
    a = *(const LAS f32x4*)(Am + 2816);
    x41 = fmaf(-a.x, x28, x41);
    x41 = fmaf(-a.y, x29, x41);
    x41 = fmaf(-a.z, x30, x41);
    x41 = fmaf(-a.w, x31, x41);
    a = *(const LAS f32x4*)(Am + 2820);
    x41 = fmaf(-a.x, x32, x41);
    x41 = fmaf(-a.y, x33, x41);
    x41 = fmaf(-a.z, x34, x41);
    x41 = fmaf(-a.w, x35, x41);
    a = *(const LAS f32x4*)(Am + 2824);
    x41 = fmaf(-a.x, x36, x41);
    x41 = fmaf(-a.y, x37, x41);
    x41 = fmaf(-a.z, x38, x41);
    x41 = fmaf(-a.w, x39, x41);
    a = *(const LAS f32x4*)(Am + 2828);
    x41 = fmaf(-a.x, x40, x41);
    outp[41 * rstride] = f2bf(x41);
    float x42 = sc[42] * bf2f(col[5712]);
    a = *(const LAS f32x4*)(Am + 2856);
    x42 = fmaf(-a.x, x0, x42);
    x42 = fmaf(-a.y, x1, x42);
    x42 = fmaf(-a.z, x2, x42);
    x42 = fmaf(-a.w, x3, x42);
    a = *(const LAS f32x4*)(Am + 2860);
    x42 = fmaf(-a.x, x4, x42);
    x42 = fmaf(-a.y, x5, x42);
    x42 = fmaf(-a.z, x6, x42);
    x42 = fmaf(-a.w, x7, x42);
    a = *(const LAS f32x4*)(Am + 2864);
    x42 = fmaf(-a.x, x8, x42);
    x42 = fmaf(-a.y, x9, x42);
    x42 = fmaf(-a.z, x10, x42);
    x42 = fmaf(-a.w, x11, x42);
    a = *(const LAS f32x4*)(Am + 2868);
    x42 = fmaf(-a.x, x12, x42);
    x42 = fmaf(-a.y, x13, x42);
    x42 = fmaf(-a.z, x14, x42);
    x42 = fmaf(-a.w, x15, x42);
    a = *(const LAS f32x4*)(Am + 2872);
    x42 = fmaf(-a.x, x16, x42);
    x42 = fmaf(-a.y, x17, x42);
    x42 = fmaf(-a.z, x18, x42);
    x42 = fmaf(-a.w, x19, x42);
    a = *(const LAS f32x4*)(Am + 2876);
    x42 = fmaf(-a.x, x20, x42);
    x42 = fmaf(-a.y, x21, x42);
    x42 = fmaf(-a.z, x22, x42);
    x42 = fmaf(-a.w, x23, x42);
    a = *(const LAS f32x4*)(Am + 2880);
    x42 = fmaf(-a.x, x24, x42);
    x42 = fmaf(-a.y, x25, x42);
    x42 = fmaf(-a.z, x26, x42);
    x42 = fmaf(-a.w, x27, x42);
    a = *(const LAS f32x4*)(Am + 2884);
    x42 = fmaf(-a.x, x28, x42);
    x42 = fmaf(-a.y, x29, x42);
    x42 = fmaf(-a.z, x30, x42);
    x42 = fmaf(-a.w, x31, x42);
    a = *(const LAS f32x4*)(Am + 2888);
    x42 = fmaf(-a.x, x32, x42);
    x42 = fmaf(-a.y, x33, x42);
    x42 = fmaf(-a.z, x34, x42);
    x42 = fmaf(-a.w, x35, x42);
    a = *(const LAS f32x4*)(Am + 2892);
    x42 = fmaf(-a.x, x36, x42);
    x42 = fmaf(-a.y, x37, x42);
    x42 = fmaf(-a.z, x38, x42);
    x42 = fmaf(-a.w, x39, x42);
    a = *(const LAS f32x4*)(Am + 2896);
    x42 = fmaf(-a.x, x40, x42);
    x42 = fmaf(-a.y, x41, x42);
    outp[42 * rstride] = f2bf(x42);
    float x43 = sc[43] * bf2f(col[5848]);
    a = *(const LAS f32x4*)(Am + 2924);
    x43 = fmaf(-a.x, x0, x43);
    x43 = fmaf(-a.y, x1, x43);
    x43 = fmaf(-a.z, x2, x43);
    x43 = fmaf(-a.w, x3, x43);
    a = *(const LAS f32x4*)(Am + 2928);
    x43 = fmaf(-a.x, x4, x43);
    x43 = fmaf(-a.y, x5, x43);
    x43 = fmaf(-a.z, x6, x43);
    x43 = fmaf(-a.w, x7, x43);
    a = *(const LAS f32x4*)(Am + 2932);
    x43 = fmaf(-a.x, x8, x43);
    x43 = fmaf(-a.y, x9, x43);
    x43 = fmaf(-a.z, x10, x43);
    x43 = fmaf(-a.w, x11, x43);
    a = *(const LAS f32x4*)(Am + 2936);
    x43 = fmaf(-a.x, x12, x43);
    x43 = fmaf(-a.y, x13, x43);
    x43 = fmaf(-a.z, x14, x43);
    x43 = fmaf(-a.w, x15, x43);
    a = *(const LAS f32x4*)(Am + 2940);
    x43 = fmaf(-a.x, x16, x43);
    x43 = fmaf(-a.y, x17, x43);
    x43 = fmaf(-a.z, x18, x43);
    x43 = fmaf(-a.w, x19, x43);
    a = *(const LAS f32x4*)(Am + 2944);
    x43 = fmaf(-a.x, x20, x43);
    x43 = fmaf(-a.y, x21, x43);
    x43 = fmaf(-a.z, x22, x43);
    x43 = fmaf(-a.w, x23, x43);
    a = *(const LAS f32x4*)(Am + 2948);
    x43 = fmaf(-a.x, x24, x43);
    x43 = fmaf(-a.y, x25, x43);
    x43 = fmaf(-a.z, x26, x43);
    x43 = fmaf(-a.w, x27, x43);
    a = *(const LAS f32x4*)(Am + 2952);
    x43 = fmaf(-a.x, x28, x43);
    x43 = fmaf(-a.y, x29, x43);
    x43 = fmaf(-a.z, x30, x43);
    x43 = fmaf(-a.w, x31, x43);
    a = *(const LAS f32x4*)(Am + 2956);
    x43 = fmaf(-a.x, x32, x43);
    x43 = fmaf(-a.y, x33, x43);
    x43 = fmaf(-a.z, x34, x43);
    x43 = fmaf(-a.w, x35, x43);
    a = *(const LAS f32x4*)(Am + 2960);
    x43 = fmaf(-a.x, x36, x43);
    x43 = fmaf(-a.y, x37, x43);
    x43 = fmaf(-a.z, x38, x43);
    x43 = fmaf(-a.w, x39, x43);
    a = *(const LAS f32x4*)(Am + 2964);
    x43 = fmaf(-a.x, x40, x43);
    x43 = fmaf(-a.y, x41, x43);
    x43 = fmaf(-a.z, x42, x43);
    outp[43 * rstride] = f2bf(x43);
    float x44 = sc[44] * bf2f(col[5984]);
    a = *(const LAS f32x4*)(Am + 2992);
    x44 = fmaf(-a.x, x0, x44);
    x44 = fmaf(-a.y, x1, x44);
    x44 = fmaf(-a.z, x2, x44);
    x44 = fmaf(-a.w, x3, x44);
    a = *(const LAS f32x4*)(Am + 2996);
    x44 = fmaf(-a.x, x4, x44);
    x44 = fmaf(-a.y, x5, x44);
    x44 = fmaf(-a.z, x6, x44);
    x44 = fmaf(-a.w, x7, x44);
    a = *(const LAS f32x4*)(Am + 3000);
    x44 = fmaf(-a.x, x8, x44);
    x44 = fmaf(-a.y, x9, x44);
    x44 = fmaf(-a.z, x10, x44);
    x44 = fmaf(-a.w, x11, x44);
    a = *(const LAS f32x4*)(Am + 3004);
    x44 = fmaf(-a.x, x12, x44);
    x44 = fmaf(-a.y, x13, x44);
    x44 = fmaf(-a.z, x14, x44);
    x44 = fmaf(-a.w, x15, x44);
    a = *(const LAS f32x4*)(Am + 3008);
    x44 = fmaf(-a.x, x16, x44);
    x44 = fmaf(-a.y, x17, x44);
    x44 = fmaf(-a.z, x18, x44);
    x44 = fmaf(-a.w, x19, x44);
    a = *(const LAS f32x4*)(Am + 3012);
    x44 = fmaf(-a.x, x20, x44);
    x44 = fmaf(-a.y, x21, x44);
    x44 = fmaf(-a.z, x22, x44);
    x44 = fmaf(-a.w, x23, x44);
    a = *(const LAS f32x4*)(Am + 3016);
    x44 = fmaf(-a.x, x24, x44);
    x44 = fmaf(-a.y, x25, x44);
    x44 = fmaf(-a.z, x26, x44);
    x44 = fmaf(-a.w, x27, x44);
    a = *(const LAS f32x4*)(Am + 3020);
    x44 = fmaf(-a.x, x28, x44);
    x44 = fmaf(-a.y, x29, x44);
    x44 = fmaf(-a.z, x30, x44);
    x44 = fmaf(-a.w, x31, x44);
    a = *(const LAS f32x4*)(Am + 3024);
    x44 = fmaf(-a.x, x32, x44);
    x44 = fmaf(-a.y, x33, x44);
    x44 = fmaf(-a.z, x34, x44);
    x44 = fmaf(-a.w, x35, x44);
    a = *(const LAS f32x4*)(Am + 3028);
    x44 = fmaf(-a.x, x36, x44);
    x44 = fmaf(-a.y, x37, x44);
    x44 = fmaf(-a.z, x38, x44);
    x44 = fmaf(-a.w, x39, x44);
    a = *(const LAS f32x4*)(Am + 3032);
    x44 = fmaf(-a.x, x40, x44);
    x44 = fmaf(-a.y, x41, x44);
    x44 = fmaf(-a.z, x42, x44);
    x44 = fmaf(-a.w, x43, x44);
    outp[44 * rstride] = f2bf(x44);
    float x45 = sc[45] * bf2f(col[6120]);
    a = *(const LAS f32x4*)(Am + 3060);
    x45 = fmaf(-a.x, x0, x45);
    x45 = fmaf(-a.y, x1, x45);
    x45 = fmaf(-a.z, x2, x45);
    x45 = fmaf(-a.w, x3, x45);
    a = *(const LAS f32x4*)(Am + 3064);
    x45 = fmaf(-a.x, x4, x45);
    x45 = fmaf(-a.y, x5, x45);
    x45 = fmaf(-a.z, x6, x45);
    x45 = fmaf(-a.w, x7, x45);
    a = *(const LAS f32x4*)(Am + 3068);
    x45 = fmaf(-a.x, x8, x45);
    x45 = fmaf(-a.y, x9, x45);
    x45 = fmaf(-a.z, x10, x45);
    x45 = fmaf(-a.w, x11, x45);
    a = *(const LAS f32x4*)(Am + 3072);
    x45 = fmaf(-a.x, x12, x45);
    x45 = fmaf(-a.y, x13, x45);
    x45 = fmaf(-a.z, x14, x45);
    x45 = fmaf(-a.w, x15, x45);
    a = *(const LAS f32x4*)(Am + 3076);
    x45 = fmaf(-a.x, x16, x45);
    x45 = fmaf(-a.y, x17, x45);
    x45 = fmaf(-a.z, x18, x45);
    x45 = fmaf(-a.w, x19, x45);
    a = *(const LAS f32x4*)(Am + 3080);
    x45 = fmaf(-a.x, x20, x45);
    x45 = fmaf(-a.y, x21, x45);
    x45 = fmaf(-a.z, x22, x45);
    x45 = fmaf(-a.w, x23, x45);
    a = *(const LAS f32x4*)(Am + 3084);
    x45 = fmaf(-a.x, x24, x45);
    x45 = fmaf(-a.y, x25, x45);
    x45 = fmaf(-a.z, x26, x45);
    x45 = fmaf(-a.w, x27, x45);
    a = *(const LAS f32x4*)(Am + 3088);
    x45 = fmaf(-a.x, x28, x45);
    x45 = fmaf(-a.y, x29, x45);
    x45 = fmaf(-a.z, x30, x45);
    x45 = fmaf(-a.w, x31, x45);
    a = *(const LAS f32x4*)(Am + 3092);
    x45 = fmaf(-a.x, x32, x45);
    x45 = fmaf(-a.y, x33, x45);
    x45 = fmaf(-a.z, x34, x45);
    x45 = fmaf(-a.w, x35, x45);
    a = *(const LAS f32x4*)(Am + 3096);
    x45 = fmaf(-a.x, x36, x45);
    x45 = fmaf(-a.y, x37, x45);
    x45 = fmaf(-a.z, x38, x45);
    x45 = fmaf(-a.w, x39, x45);
    a = *(const LAS f32x4*)(Am + 3100);
    x45 = fmaf(-a.x, x40, x45);
    x45 = fmaf(-a.y, x41, x45);
    x45 = fmaf(-a.z, x42, x45);
    x45 = fmaf(-a.w, x43, x45);
    a = *(const LAS f32x4*)(Am + 3104);
    x45 = fmaf(-a.x, x44, x45);
    outp[45 * rstride] = f2bf(x45);
    float x46 = sc[46] * bf2f(col[6256]);
    a = *(const LAS f32x4*)(Am + 3128);
    x46 = fmaf(-a.x, x0, x46);
    x46 = fmaf(-a.y, x1, x46);
    x46 = fmaf(-a.z, x2, x46);
    x46 = fmaf(-a.w, x3, x46);
    a = *(const LAS f32x4*)(Am + 3132);
    x46 = fmaf(-a.x, x4, x46);
    x46 = fmaf(-a.y, x5, x46);
    x46 = fmaf(-a.z, x6, x46);
    x46 = fmaf(-a.w, x7, x46);
    a = *(const LAS f32x4*)(Am + 3136);
    x46 = fmaf(-a.x, x8, x46);
    x46 = fmaf(-a.y, x9, x46);
    x46 = fmaf(-a.z, x10, x46);
    x46 = fmaf(-a.w, x11, x46);
    a = *(const LAS f32x4*)(Am + 3140);
    x46 = fmaf(-a.x, x12, x46);
    x46 = fmaf(-a.y, x13, x46);
    x46 = fmaf(-a.z, x14, x46);
    x46 = fmaf(-a.w, x15, x46);
    a = *(const LAS f32x4*)(Am + 3144);
    x46 = fmaf(-a.x, x16, x46);
    x46 = fmaf(-a.y, x17, x46);
    x46 = fmaf(-a.z, x18, x46);
    x46 = fmaf(-a.w, x19, x46);
    a = *(const LAS f32x4*)(Am + 3148);
    x46 = fmaf(-a.x, x20, x46);
    x46 = fmaf(-a.y, x21, x46);
    x46 = fmaf(-a.z, x22, x46);
    x46 = fmaf(-a.w, x23, x46);
    a = *(const LAS f32x4*)(Am + 3152);
    x46 = fmaf(-a.x, x24, x46);
    x46 = fmaf(-a.y, x25, x46);
    x46 = fmaf(-a.z, x26, x46);
    x46 = fmaf(-a.w, x27, x46);
    a = *(const LAS f32x4*)(Am + 3156);
    x46 = fmaf(-a.x, x28, x46);
    x46 = fmaf(-a.y, x29, x46);
    x46 = fmaf(-a.z, x30, x46);
    x46 = fmaf(-a.w, x31, x46);
    a = *(const LAS f32x4*)(Am + 3160);
    x46 = fmaf(-a.x, x32, x46);
    x46 = fmaf(-a.y, x33, x46);
    x46 = fmaf(-a.z, x34, x46);
    x46 = fmaf(-a.w, x35, x46);
    a = *(const LAS f32x4*)(Am + 3164);
    x46 = fmaf(-a.x, x36, x46);
    x46 = fmaf(-a.y, x37, x46);
    x46 = fmaf(-a.z, x38, x46);
    x46 = fmaf(-a.w, x39, x46);
    a = *(const LAS f32x4*)(Am + 3168);
    x46 = fmaf(-a.x, x40, x46);
    x46 = fmaf(-a.y, x41, x46);
    x46 = fmaf(-a.z, x42, x46);
    x46 = fmaf(-a.w, x43, x46);
    a = *(const LAS f32x4*)(Am + 3172);
    x46 = fmaf(-a.x, x44, x46);
    x46 = fmaf(-a.y, x45, x46);
    outp[46 * rstride] = f2bf(x46);
    float x47 = sc[47] * bf2f(col[6392]);
    a = *(const LAS f32x4*)(Am + 3196);
    x47 = fmaf(-a.x, x0, x47);
    x47 = fmaf(-a.y, x1, x47);
    x47 = fmaf(-a.z, x2, x47);
    x47 = fmaf(-a.w, x3, x47);
    a = *(const LAS f32x4*)(Am + 3200);
    x47 = fmaf(-a.x, x4, x47);
    x47 = fmaf(-a.y, x5, x47);
    x47 = fmaf(-a.z, x6, x47);
    x47 = fmaf(-a.w, x7, x47);
    a = *(const LAS f32x4*)(Am + 3204);
    x47 = fmaf(-a.x, x8, x47);
    x47 = fmaf(-a.y, x9, x47);
    x47 = fmaf(-a.z, x10, x47);
    x47 = fmaf(-a.w, x11, x47);
    a = *(const LAS f32x4*)(Am + 3208);
    x47 = fmaf(-a.x, x12, x47);
    x47 = fmaf(-a.y, x13, x47);
    x47 = fmaf(-a.z, x14, x47);
    x47 = fmaf(-a.w, x15, x47);
    a = *(const LAS f32x4*)(Am + 3212);
    x47 = fmaf(-a.x, x16, x47);
    x47 = fmaf(-a.y, x17, x47);
    x47 = fmaf(-a.z, x18, x47);
    x47 = fmaf(-a.w, x19, x47);
    a = *(const LAS f32x4*)(Am + 3216);
    x47 = fmaf(-a.x, x20, x47);
    x47 = fmaf(-a.y, x21, x47);
    x47 = fmaf(-a.z, x22, x47);
    x47 = fmaf(-a.w, x23, x47);
    a = *(const LAS f32x4*)(Am + 3220);
    x47 = fmaf(-a.x, x24, x47);
    x47 = fmaf(-a.y, x25, x47);
    x47 = fmaf(-a.z, x26, x47);
    x47 = fmaf(-a.w, x27, x47);
    a = *(const LAS f32x4*)(Am + 3224);
    x47 = fmaf(-a.x, x28, x47);
    x47 = fmaf(-a.y, x29, x47);
    x47 = fmaf(-a.z, x30, x47);
    x47 = fmaf(-a.w, x31, x47);
    a = *(const LAS f32x4*)(Am + 3228);
    x47 = fmaf(-a.x, x32, x47);
    x47 = fmaf(-a.y, x33, x47);
    x47 = fmaf(-a.z, x34, x47);
    x47 = fmaf(-a.w, x35, x47);
    a = *(const LAS f32x4*)(Am + 3232);
    x47 = fmaf(-a.x, x36, x47);
    x47 = fmaf(-a.y, x37, x47);
    x47 = fmaf(-a.z, x38, x47);
    x47 = fmaf(-a.w, x39, x47);
    a = *(const LAS f32x4*)(Am + 3236);
    x47 = fmaf(-a.x, x40, x47);
    x47 = fmaf(-a.y, x41, x47);
    x47 = fmaf(-a.z, x42, x47);
    x47 = fmaf(-a.w, x43, x47);
    a = *(const LAS f32x4*)(Am + 3240);
    x47 = fmaf(-a.x, x44, x47);
    x47 = fmaf(-a.y, x45, x47);
    x47 = fmaf(-a.z, x46, x47);
    outp[47 * rstride] = f2bf(x47);
    float x48 = sc[48] * bf2f(col[6528]);
    a = *(const LAS f32x4*)(Am + 3264);
    x48 = fmaf(-a.x, x0, x48);
    x48 = fmaf(-a.y, x1, x48);
    x48 = fmaf(-a.z, x2, x48);
    x48 = fmaf(-a.w, x3, x48);
    a = *(const LAS f32x4*)(Am + 3268);
    x48 = fmaf(-a.x, x4, x48);
    x48 = fmaf(-a.y, x5, x48);
    x48 = fmaf(-a.z, x6, x48);
    x48 = fmaf(-a.w, x7, x48);
    a = *(const LAS f32x4*)(Am + 3272);
    x48 = fmaf(-a.x, x8, x48);
    x48 = fmaf(-a.y, x9, x48);
    x48 = fmaf(-a.z, x10, x48);
    x48 = fmaf(-a.w, x11, x48);
    a = *(const LAS f32x4*)(Am + 3276);
    x48 = fmaf(-a.x, x12, x48);
    x48 = fmaf(-a.y, x13, x48);
    x48 = fmaf(-a.z, x14, x48);
    x48 = fmaf(-a.w, x15, x48);
    a = *(const LAS f32x4*)(Am + 3280);
    x48 = fmaf(-a.x, x16, x48);
    x48 = fmaf(-a.y, x17, x48);
    x48 = fmaf(-a.z, x18, x48);
    x48 = fmaf(-a.w, x19, x48);
    a = *(const LAS f32x4*)(Am + 3284);
    x48 = fmaf(-a.x, x20, x48);
    x48 = fmaf(-a.y, x21, x48);
    x48 = fmaf(-a.z, x22, x48);
    x48 = fmaf(-a.w, x23, x48);
    a = *(const LAS f32x4*)(Am + 3288);
    x48 = fmaf(-a.x, x24, x48);
    x48 = fmaf(-a.y, x25, x48);
    x48 = fmaf(-a.z, x26, x48);
    x48 = fmaf(-a.w, x27, x48);
    a = *(const LAS f32x4*)(Am + 3292);
    x48 = fmaf(-a.x, x28, x48);
    x48 = fmaf(-a.y, x29, x48);
    x48 = fmaf(-a.z, x30, x48);
    x48 = fmaf(-a.w, x31, x48);
    a = *(const LAS f32x4*)(Am + 3296);
    x48 = fmaf(-a.x, x32, x48);
    x48 = fmaf(-a.y, x33, x48);
    x48 = fmaf(-a.z, x34, x48);
    x48 = fmaf(-a.w, x35, x48);
    a = *(const LAS f32x4*)(Am + 3300);
    x48 = fmaf(-a.x, x36, x48);
    x48 = fmaf(-a.y, x37, x48);
    x48 = fmaf(-a.z, x38, x48);
    x48 = fmaf(-a.w, x39, x48);
    a = *(const LAS f32x4*)(Am + 3304);
    x48 = fmaf(-a.x, x40, x48);
    x48 = fmaf(-a.y, x41, x48);
    x48 = fmaf(-a.z, x42, x48);
    x48 = fmaf(-a.w, x43, x48);
    a = *(const LAS f32x4*)(Am + 3308);
    x48 = fmaf(-a.x, x44, x48);
    x48 = fmaf(-a.y, x45, x48);
    x48 = fmaf(-a.z, x46, x48);
    x48 = fmaf(-a.w, x47, x48);
    outp[48 * rstride] = f2bf(x48);
    float x49 = sc[49] * bf2f(col[6664]);
    a = *(const LAS f32x4*)(Am + 3332);
    x49 = fmaf(-a.x, x0, x49);
    x49 = fmaf(-a.y, x1, x49);
    x49 = fmaf(-a.z, x2, x49);
    x49 = fmaf(-a.w, x3, x49);
    a = *(const LAS f32x4*)(Am + 3336);
    x49 = fmaf(-a.x, x4, x49);
    x49 = fmaf(-a.y, x5, x49);
    x49 = fmaf(-a.z, x6, x49);
    x49 = fmaf(-a.w, x7, x49);
    a = *(const LAS f32x4*)(Am + 3340);
    x49 = fmaf(-a.x, x8, x49);
    x49 = fmaf(-a.y, x9, x49);
    x49 = fmaf(-a.z, x10, x49);
    x49 = fmaf(-a.w, x11, x49);
    a = *(const LAS f32x4*)(Am + 3344);
    x49 = fmaf(-a.x, x12, x49);
    x49 = fmaf(-a.y, x13, x49);
    x49 = fmaf(-a.z, x14, x49);
    x49 = fmaf(-a.w, x15, x49);
    a = *(const LAS f32x4*)(Am + 3348);
    x49 = fmaf(-a.x, x16, x49);
    x49 = fmaf(-a.y, x17, x49);
    x49 = fmaf(-a.z, x18, x49);
    x49 = fmaf(-a.w, x19, x49);
    a = *(const LAS f32x4*)(Am + 3352);
    x49 = fmaf(-a.x, x20, x49);
    x49 = fmaf(-a.y, x21, x49);
    x49 = fmaf(-a.z, x22, x49);
    x49 = fmaf(-a.w, x23, x49);
    a = *(const LAS f32x4*)(Am + 3356);
    x49 = fmaf(-a.x, x24, x49);
    x49 = fmaf(-a.y, x25, x49);
    x49 = fmaf(-a.z, x26, x49);
    x49 = fmaf(-a.w, x27, x49);
    a = *(const LAS f32x4*)(Am + 3360);
    x49 = fmaf(-a.x, x28, x49);
    x49 = fmaf(-a.y, x29, x49);
    x49 = fmaf(-a.z, x30, x49);
    x49 = fmaf(-a.w, x31, x49);
    a = *(const LAS f32x4*)(Am + 3364);
    x49 = fmaf(-a.x, x32, x49);
    x49 = fmaf(-a.y, x33, x49);
    x49 = fmaf(-a.z, x34, x49);
    x49 = fmaf(-a.w, x35, x49);
    a = *(const LAS f32x4*)(Am + 3368);
    x49 = fmaf(-a.x, x36, x49);
    x49 = fmaf(-a.y, x37, x49);
    x49 = fmaf(-a.z, x38, x49);
    x49 = fmaf(-a.w, x39, x49);
    a = *(const LAS f32x4*)(Am + 3372);
    x49 = fmaf(-a.x, x40, x49);
    x49 = fmaf(-a.y, x41, x49);
    x49 = fmaf(-a.z, x42, x49);
    x49 = fmaf(-a.w, x43, x49);
    a = *(const LAS f32x4*)(Am + 3376);
    x49 = fmaf(-a.x, x44, x49);
    x49 = fmaf(-a.y, x45, x49);
    x49 = fmaf(-a.z, x46, x49);
    x49 = fmaf(-a.w, x47, x49);
    a = *(const LAS f32x4*)(Am + 3380);
    x49 = fmaf(-a.x, x48, x49);
    outp[49 * rstride] = f2bf(x49);
    float x50 = sc[50] * bf2f(col[6800]);
    a = *(const LAS f32x4*)(Am + 3400);
    x50 = fmaf(-a.x, x0, x50);
    x50 = fmaf(-a.y, x1, x50);
    x50 = fmaf(-a.z, x2, x50);
    x50 = fmaf(-a.w, x3, x50);
    a = *(const LAS f32x4*)(Am + 3404);
    x50 = fmaf(-a.x, x4, x50);
    x50 = fmaf(-a.y, x5, x50);
    x50 = fmaf(-a.z, x6, x50);
    x50 = fmaf(-a.w, x7, x50);
    a = *(const LAS f32x4*)(Am + 3408);
    x50 = fmaf(-a.x, x8, x50);
    x50 = fmaf(-a.y, x9, x50);
    x50 = fmaf(-a.z, x10, x50);
    x50 = fmaf(-a.w, x11, x50);
    a = *(const LAS f32x4*)(Am + 3412);
    x50 = fmaf(-a.x, x12, x50);
    x50 = fmaf(-a.y, x13, x50);
    x50 = fmaf(-a.z, x14, x50);
    x50 = fmaf(-a.w, x15, x50);
    a = *(const LAS f32x4*)(Am + 3416);
    x50 = fmaf(-a.x, x16, x50);
    x50 = fmaf(-a.y, x17, x50);
    x50 = fmaf(-a.z, x18, x50);
    x50 = fmaf(-a.w, x19, x50);
    a = *(const LAS f32x4*)(Am + 3420);
    x50 = fmaf(-a.x, x20, x50);
    x50 = fmaf(-a.y, x21, x50);
    x50 = fmaf(-a.z, x22, x50);
    x50 = fmaf(-a.w, x23, x50);
    a = *(const LAS f32x4*)(Am + 3424);
    x50 = fmaf(-a.x, x24, x50);
    x50 = fmaf(-a.y, x25, x50);
    x50 = fmaf(-a.z, x26, x50);
    x50 = fmaf(-a.w, x27, x50);
    a = *(const LAS f32x4*)(Am + 3428);
    x50 = fmaf(-a.x, x28, x50);
    x50 = fmaf(-a.y, x29, x50);
    x50 = fmaf(-a.z, x30, x50);
    x50 = fmaf(-a.w, x31, x50);
    a = *(const LAS f32x4*)(Am + 3432);
    x50 = fmaf(-a.x, x32, x50);
    x50 = fmaf(-a.y, x33, x50);
    x50 = fmaf(-a.z, x34, x50);
    x50 = fmaf(-a.w, x35, x50);
    a = *(const LAS f32x4*)(Am + 3436);
    x50 = fmaf(-a.x, x36, x50);
    x50 = fmaf(-a.y, x37, x50);
    x50 = fmaf(-a.z, x38, x50);
    x50 = fmaf(-a.w, x39, x50);
    a = *(const LAS f32x4*)(Am + 3440);
    x50 = fmaf(-a.x, x40, x50);
    x50 = fmaf(-a.y, x41, x50);
    x50 = fmaf(-a.z, x42, x50);
    x50 = fmaf(-a.w, x43, x50);
    a = *(const LAS f32x4*)(Am + 3444);
    x50 = fmaf(-a.x, x44, x50);
    x50 = fmaf(-a.y, x45, x50);
    x50 = fmaf(-a.z, x46, x50);
    x50 = fmaf(-a.w, x47, x50);
    a = *(const LAS f32x4*)(Am + 3448);
    x50 = fmaf(-a.x, x48, x50);
    x50 = fmaf(-a.y, x49, x50);
    outp[50 * rstride] = f2bf(x50);
    float x51 = sc[51] * bf2f(col[6936]);
    a = *(const LAS f32x4*)(Am + 3468);
    x51 = fmaf(-a.x, x0, x51);
    x51 = fmaf(-a.y, x1, x51);
    x51 = fmaf(-a.z, x2, x51);
    x51 = fmaf(-a.w, x3, x51);
    a = *(const LAS f32x4*)(Am + 3472);
    x51 = fmaf(-a.x, x4, x51);
    x51 = fmaf(-a.y, x5, x51);
    x51 = fmaf(-a.z, x6, x51);
    x51 = fmaf(-a.w, x7, x51);
    a = *(const LAS f32x4*)(Am + 3476);
    x51 = fmaf(-a.x, x8, x51);
    x51 = fmaf(-a.y, x9, x51);
    x51 = fmaf(-a.z, x10, x51);
    x51 = fmaf(-a.w, x11, x51);
    a = *(const LAS f32x4*)(Am + 3480);
    x51 = fmaf(-a.x, x12, x51);
    x51 = fmaf(-a.y, x13, x51);
    x51 = fmaf(-a.z, x14, x51);
    x51 = fmaf(-a.w, x15, x51);
    a = *(const LAS f32x4*)(Am + 3484);
    x51 = fmaf(-a.x, x16, x51);
    x51 = fmaf(-a.y, x17, x51);
    x51 = fmaf(-a.z, x18, x51);
    x51 = fmaf(-a.w, x19, x51);
    a = *(const LAS f32x4*)(Am + 3488);
    x51 = fmaf(-a.x, x20, x51);
    x51 = fmaf(-a.y, x21, x51);
    x51 = fmaf(-a.z, x22, x51);
    x51 = fmaf(-a.w, x23, x51);
    a = *(const LAS f32x4*)(Am + 3492);
    x51 = fmaf(-a.x, x24, x51);
    x51 = fmaf(-a.y, x25, x51);
    x51 = fmaf(-a.z, x26, x51);
    x51 = fmaf(-a.w, x27, x51);
    a = *(const LAS f32x4*)(Am + 3496);
    x51 = fmaf(-a.x, x28, x51);
    x51 = fmaf(-a.y, x29, x51);
    x51 = fmaf(-a.z, x30, x51);
    x51 = fmaf(-a.w, x31, x51);
    a = *(const LAS f32x4*)(Am + 3500);
    x51 = fmaf(-a.x, x32, x51);
    x51 = fmaf(-a.y, x33, x51);
    x51 = fmaf(-a.z, x34, x51);
    x51 = fmaf(-a.w, x35, x51);
    a = *(const LAS f32x4*)(Am + 3504);
    x51 = fmaf(-a.x, x36, x51);
    x51 = fmaf(-a.y, x37, x51);
    x51 = fmaf(-a.z, x38, x51);
    x51 = fmaf(-a.w, x39, x51);
    a = *(const LAS f32x4*)(Am + 3508);
    x51 = fmaf(-a.x, x40, x51);
    x51 = fmaf(-a.y, x41, x51);
    x51 = fmaf(-a.z, x42, x51);
    x51 = fmaf(-a.w, x43, x51);
    a = *(const LAS f32x4*)(Am + 3512);
    x51 = fmaf(-a.x, x44, x51);
    x51 = fmaf(-a.y, x45, x51);
    x51 = fmaf(-a.z, x46, x51);
    x51 = fmaf(-a.w, x47, x51);
    a = *(const LAS f32x4*)(Am + 3516);
    x51 = fmaf(-a.x, x48, x51);
    x51 = fmaf(-a.y, x49, x51);
    x51 = fmaf(-a.z, x50, x51);
    outp[51 * rstride] = f2bf(x51);
    float x52 = sc[52] * bf2f(col[7072]);
    a = *(const LAS f32x4*)(Am + 3536);
    x52 = fmaf(-a.x, x0, x52);
    x52 = fmaf(-a.y, x1, x52);
    x52 = fmaf(-a.z, x2, x52);
    x52 = fmaf(-a.w, x3, x52);
    a = *(const LAS f32x4*)(Am + 3540);
    x52 = fmaf(-a.x, x4, x52);
    x52 = fmaf(-a.y, x5, x52);
    x52 = fmaf(-a.z, x6, x52);
    x52 = fmaf(-a.w, x7, x52);
    a = *(const LAS f32x4*)(Am + 3544);
    x52 = fmaf(-a.x, x8, x52);
    x52 = fmaf(-a.y, x9, x52);
    x52 = fmaf(-a.z, x10, x52);
    x52 = fmaf(-a.w, x11, x52);
    a = *(const LAS f32x4*)(Am + 3548);
    x52 = fmaf(-a.x, x12, x52);
    x52 = fmaf(-a.y, x13, x52);
    x52 = fmaf(-a.z, x14, x52);
    x52 = fmaf(-a.w, x15, x52);
    a = *(const LAS f32x4*)(Am + 3552);
    x52 = fmaf(-a.x, x16, x52);
    x52 = fmaf(-a.y, x17, x52);
    x52 = fmaf(-a.z, x18, x52);
    x52 = fmaf(-a.w, x19, x52);
    a = *(const LAS f32x4*)(Am + 3556);
    x52 = fmaf(-a.x, x20, x52);
    x52 = fmaf(-a.y, x21, x52);
    x52 = fmaf(-a.z, x22, x52);
    x52 = fmaf(-a.w, x23, x52);
    a = *(const LAS f32x4*)(Am + 3560);
    x52 = fmaf(-a.x, x24, x52);
    x52 = fmaf(-a.y, x25, x52);
    x52 = fmaf(-a.z, x26, x52);
    x52 = fmaf(-a.w, x27, x52);
    a = *(const LAS f32x4*)(Am + 3564);
    x52 = fmaf(-a.x, x28, x52);
    x52 = fmaf(-a.y, x29, x52);
    x52 = fmaf(-a.z, x30, x52);
    x52 = fmaf(-a.w, x31, x52);
    a = *(const LAS f32x4*)(Am + 3568);
    x52 = fmaf(-a.x, x32, x52);
    x52 = fmaf(-a.y, x33, x52);
    x52 = fmaf(-a.z, x34, x52);
    x52 = fmaf(-a.w, x35, x52);
    a = *(const LAS f32x4*)(Am + 3572);
    x52 = fmaf(-a.x, x36, x52);
    x52 = fmaf(-a.y, x37, x52);
    x52 = fmaf(-a.z, x38, x52);
    x52 = fmaf(-a.w, x39, x52);
    a = *(const LAS f32x4*)(Am + 3576);
    x52 = fmaf(-a.x, x40, x52);
    x52 = fmaf(-a.y, x41, x52);
    x52 = fmaf(-a.z, x42, x52);
    x52 = fmaf(-a.w, x43, x52);
    a = *(const LAS f32x4*)(Am + 3580);
    x52 = fmaf(-a.x, x44, x52);
    x52 = fmaf(-a.y, x45, x52);
    x52 = fmaf(-a.z, x46, x52);
    x52 = fmaf(-a.w, x47, x52);
    a = *(const LAS f32x4*)(Am + 3584);
    x52 = fmaf(-a.x, x48, x52);
    x52 = fmaf(-a.y, x49, x52);
    x52 = fmaf(-a.z, x50, x52);
    x52 = fmaf(-a.w, x51, x52);
    outp[52 * rstride] = f2bf(x52);
    float x53 = sc[53] * bf2f(col[7208]);
    a = *(const LAS f32x4*)(Am + 3604);
    x53 = fmaf(-a.x, x0, x53);
    x53 = fmaf(-a.y, x1, x53);
    x53 = fmaf(-a.z, x2, x53);
    x53 = fmaf(-a.w, x3, x53);
    a = *(const LAS f32x4*)(Am + 3608);
    x53 = fmaf(-a.x, x4, x53);
    x53 = fmaf(-a.y, x5, x53);
    x53 = fmaf(-a.z, x6, x53);
    x53 = fmaf(-a.w, x7, x53);
    a = *(const LAS f32x4*)(Am + 3612);
    x53 = fmaf(-a.x, x8, x53);
    x53 = fmaf(-a.y, x9, x53);
    x53 = fmaf(-a.z, x10, x53);
    x53 = fmaf(-a.w, x11, x53);
    a = *(const LAS f32x4*)(Am + 3616);
    x53 = fmaf(-a.x, x12, x53);
    x53 = fmaf(-a.y, x13, x53);
    x53 = fmaf(-a.z, x14, x53);
    x53 = fmaf(-a.w, x15, x53);
    a = *(const LAS f32x4*)(Am + 3620);
    x53 = fmaf(-a.x, x16, x53);
    x53 = fmaf(-a.y, x17, x53);
    x53 = fmaf(-a.z, x18, x53);
    x53 = fmaf(-a.w, x19, x53);
    a = *(const LAS f32x4*)(Am + 3624);
    x53 = fmaf(-a.x, x20, x53);
    x53 = fmaf(-a.y, x21, x53);
    x53 = fmaf(-a.z, x22, x53);
    x53 = fmaf(-a.w, x23, x53);
    a = *(const LAS f32x4*)(Am + 3628);
    x53 = fmaf(-a.x, x24, x53);
    x53 = fmaf(-a.y, x25, x53);
    x53 = fmaf(-a.z, x26, x53);
    x53 = fmaf(-a.w, x27, x53);
    a = *(const LAS f32x4*)(Am + 3632);
    x53 = fmaf(-a.x, x28, x53);
    x53 = fmaf(-a.y, x29, x53);
    x53 = fmaf(-a.z, x30, x53);
    x53 = fmaf(-a.w, x31, x53);
    a = *(const LAS f32x4*)(Am + 3636);
    x53 = fmaf(-a.x, x32, x53);
    x53 = fmaf(-a.y, x33, x53);
    x53 = fmaf(-a.z, x34, x53);
    x53 = fmaf(-a.w, x35, x53);
    a = *(const LAS f32x4*)(Am + 3640);
    x53 = fmaf(-a.x, x36, x53);
    x53 = fmaf(-a.y, x37, x53);
    x53 = fmaf(-a.z, x38, x53);
    x53 = fmaf(-a.w, x39, x53);
    a = *(const LAS f32x4*)(Am + 3644);
    x53 = fmaf(-a.x, x40, x53);
    x53 = fmaf(-a.y, x41, x53);
    x53 = fmaf(-a.z, x42, x53);
    x53 = fmaf(-a.w, x43, x53);
    a = *(const LAS f32x4*)(Am + 3648);
    x53 = fmaf(-a.x, x44, x53);
    x53 = fmaf(-a.y, x45, x53);
    x53 = fmaf(-a.z, x46, x53);
    x53 = fmaf(-a.w, x47, x53);
    a = *(const LAS f32x4*)(Am + 3652);
    x53 = fmaf(-a.x, x48, x53);
    x53 = fmaf(-a.y, x49, x53);
    x53 = fmaf(-a.z, x50, x53);
    x53 = fmaf(-a.w, x51, x53);
    a = *(const LAS f32x4*)(Am + 3656);
    x53 = fmaf(-a.x, x52, x53);
    outp[53 * rstride] = f2bf(x53);
    float x54 = sc[54] * bf2f(col[7344]);
    a = *(const LAS f32x4*)(Am + 3672);
    x54 = fmaf(-a.x, x0, x54);
    x54 = fmaf(-a.y, x1, x54);
    x54 = fmaf(-a.z, x2, x54);
    x54 = fmaf(-a.w, x3, x54);
    a = *(const LAS f32x4*)(Am + 3676);
    x54 = fmaf(-a.x, x4, x54);
    x54 = fmaf(-a.y, x5, x54);
    x54 = fmaf(-a.z, x6, x54);
    x54 = fmaf(-a.w, x7, x54);
    a = *(const LAS f32x4*)(Am + 3680);
    x54 = fmaf(-a.x, x8, x54);
    x54 = fmaf(-a.y, x9, x54);
    x54 = fmaf(-a.z, x10, x54);
    x54 = fmaf(-a.w, x11, x54);
    a = *(const LAS f32x4*)(Am + 3684);
    x54 = fmaf(-a.x, x12, x54);
    x54 = fmaf(-a.y, x13, x54);
    x54 = fmaf(-a.z, x14, x54);
    x54 = fmaf(-a.w, x15, x54);
    a = *(const LAS f32x4*)(Am + 3688);
    x54 = fmaf(-a.x, x16, x54);
    x54 = fmaf(-a.y, x17, x54);
    x54 = fmaf(-a.z, x18, x54);
    x54 = fmaf(-a.w, x19, x54);
    a = *(const LAS f32x4*)(Am + 3692);
    x54 = fmaf(-a.x, x20, x54);
    x54 = fmaf(-a.y, x21, x54);
    x54 = fmaf(-a.z, x22, x54);
    x54 = fmaf(-a.w, x23, x54);
    a = *(const LAS f32x4*)(Am + 3696);
    x54 = fmaf(-a.x, x24, x54);
    x54 = fmaf(-a.y, x25, x54);
    x54 = fmaf(-a.z, x26, x54);
    x54 = fmaf(-a.w, x27, x54);
    a = *(const LAS f32x4*)(Am + 3700);
    x54 = fmaf(-a.x, x28, x54);
    x54 = fmaf(-a.y, x29, x54);
    x54 = fmaf(-a.z, x30, x54);
    x54 = fmaf(-a.w, x31, x54);
    a = *(const LAS f32x4*)(Am + 3704);
    x54 = fmaf(-a.x, x32, x54);
    x54 = fmaf(-a.y, x33, x54);
    x54 = fmaf(-a.z, x34, x54);
    x54 = fmaf(-a.w, x35, x54);
    a = *(const LAS f32x4*)(Am + 3708);
    x54 = fmaf(-a.x, x36, x54);
    x54 = fmaf(-a.y, x37, x54);
    x54 = fmaf(-a.z, x38, x54);
    x54 = fmaf(-a.w, x39, x54);
    a = *(const LAS f32x4*)(Am + 3712);
    x54 = fmaf(-a.x, x40, x54);
    x54 = fmaf(-a.y, x41, x54);
    x54 = fmaf(-a.z, x42, x54);
    x54 = fmaf(-a.w, x43, x54);
    a = *(const LAS f32x4*)(Am + 3716);
    x54 = fmaf(-a.x, x44, x54);
    x54 = fmaf(-a.y, x45, x54);
    x54 = fmaf(-a.z, x46, x54);
    x54 = fmaf(-a.w, x47, x54);
    a = *(const LAS f32x4*)(Am + 3720);
    x54 = fmaf(-a.x, x48, x54);
    x54 = fmaf(-a.y, x49, x54);
    x54 = fmaf(-a.z, x50, x54);
    x54 = fmaf(-a.w, x51, x54);
    a = *(const LAS f32x4*)(Am + 3724);
    x54 = fmaf(-a.x, x52, x54);
    x54 = fmaf(-a.y, x53, x54);
    outp[54 * rstride] = f2bf(x54);
    float x55 = sc[55] * bf2f(col[7480]);
    a = *(const LAS f32x4*)(Am + 3740);
    x55 = fmaf(-a.x, x0, x55);
    x55 = fmaf(-a.y, x1, x55);
    x55 = fmaf(-a.z, x2, x55);
    x55 = fmaf(-a.w, x3, x55);
    a = *(const LAS f32x4*)(Am + 3744);
    x55 = fmaf(-a.x, x4, x55);
    x55 = fmaf(-a.y, x5, x55);
    x55 = fmaf(-a.z, x6, x55);
    x55 = fmaf(-a.w, x7, x55);
    a = *(const LAS f32x4*)(Am + 3748);
    x55 = fmaf(-a.x, x8, x55);
    x55 = fmaf(-a.y, x9, x55);
    x55 = fmaf(-a.z, x10, x55);
    x55 = fmaf(-a.w, x11, x55);
    a = *(const LAS f32x4*)(Am + 3752);
    x55 = fmaf(-a.x, x12, x55);
    x55 = fmaf(-a.y, x13, x55);
    x55 = fmaf(-a.z, x14, x55);
    x55 = fmaf(-a.w, x15, x55);
    a = *(const LAS f32x4*)(Am + 3756);
    x55 = fmaf(-a.x, x16, x55);
    x55 = fmaf(-a.y, x17, x55);
    x55 = fmaf(-a.z, x18, x55);
    x55 = fmaf(-a.w, x19, x55);
    a = *(const LAS f32x4*)(Am + 3760);
    x55 = fmaf(-a.x, x20, x55);
    x55 = fmaf(-a.y, x21, x55);
    x55 = fmaf(-a.z, x22, x55);
    x55 = fmaf(-a.w, x23, x55);
    a = *(const LAS f32x4*)(Am + 3764);
    x55 = fmaf(-a.x, x24, x55);
    x55 = fmaf(-a.y, x25, x55);
    x55 = fmaf(-a.z, x26, x55);
    x55 = fmaf(-a.w, x27, x55);
    a = *(const LAS f32x4*)(Am + 3768);
    x55 = fmaf(-a.x, x28, x55);
    x55 = fmaf(-a.y, x29, x55);
    x55 = fmaf(-a.z, x30, x55);
    x55 = fmaf(-a.w, x31, x55);
    a = *(const LAS f32x4*)(Am + 3772);
    x55 = fmaf(-a.x, x32, x55);
    x55 = fmaf(-a.y, x33, x55);
    x55 = fmaf(-a.z, x34, x55);
    x55 = fmaf(-a.w, x35, x55);
    a = *(const LAS f32x4*)(Am + 3776);
    x55 = fmaf(-a.x, x36, x55);
    x55 = fmaf(-a.y, x37, x55);
    x55 = fmaf(-a.z, x38, x55);
    x55 = fmaf(-a.w, x39, x55);
    a = *(const LAS f32x4*)(Am + 3780);
    x55 = fmaf(-a.x, x40, x55);
    x55 = fmaf(-a.y, x41, x55);
    x55 = fmaf(-a.z, x42, x55);
    x55 = fmaf(-a.w, x43, x55);
    a = *(const LAS f32x4*)(Am + 3784);
    x55 = fmaf(-a.x, x44, x55);
    x55 = fmaf(-a.y, x45, x55);
    x55 = fmaf(-a.z, x46, x55);
    x55 = fmaf(-a.w, x47, x55);
    a = *(const LAS f32x4*)(Am + 3788);
    x55 = fmaf(-a.x, x48, x55);
    x55 = fmaf(-a.y, x49, x55);
    x55 = fmaf(-a.z, x50, x55);
    x55 = fmaf(-a.w, x51, x55);
    a = *(const LAS f32x4*)(Am + 3792);
    x55 = fmaf(-a.x, x52, x55);
    x55 = fmaf(-a.y, x53, x55);
    x55 = fmaf(-a.z, x54, x55);
    outp[55 * rstride] = f2bf(x55);
    float x56 = sc[56] * bf2f(col[7616]);
    a = *(const LAS f32x4*)(Am + 3808);
    x56 = fmaf(-a.x, x0, x56);
    x56 = fmaf(-a.y, x1, x56);
    x56 = fmaf(-a.z, x2, x56);
    x56 = fmaf(-a.w, x3, x56);
    a = *(const LAS f32x4*)(Am + 3812);
    x56 = fmaf(-a.x, x4, x56);
    x56 = fmaf(-a.y, x5, x56);
    x56 = fmaf(-a.z, x6, x56);
    x56 = fmaf(-a.w, x7, x56);
    a = *(const LAS f32x4*)(Am + 3816);
    x56 = fmaf(-a.x, x8, x56);
    x56 = fmaf(-a.y, x9, x56);
    x56 = fmaf(-a.z, x10, x56);
    x56 = fmaf(-a.w, x11, x56);
    a = *(const LAS f32x4*)(Am + 3820);
    x56 = fmaf(-a.x, x12, x56);
    x56 = fmaf(-a.y, x13, x56);
    x56 = fmaf(-a.z, x14, x56);
    x56 = fmaf(-a.w, x15, x56);
    a = *(const LAS f32x4*)(Am + 3824);
    x56 = fmaf(-a.x, x16, x56);
    x56 = fmaf(-a.y, x17, x56);
    x56 = fmaf(-a.z, x18, x56);
    x56 = fmaf(-a.w, x19, x56);
    a = *(const LAS f32x4*)(Am + 3828);
    x56 = fmaf(-a.x, x20, x56);
    x56 = fmaf(-a.y, x21, x56);
    x56 = fmaf(-a.z, x22, x56);
    x56 = fmaf(-a.w, x23, x56);
    a = *(const LAS f32x4*)(Am + 3832);
    x56 = fmaf(-a.x, x24, x56);
    x56 = fmaf(-a.y, x25, x56);
    x56 = fmaf(-a.z, x26, x56);
    x56 = fmaf(-a.w, x27, x56);
    a = *(const LAS f32x4*)(Am + 3836);
    x56 = fmaf(-a.x, x28, x56);
    x56 = fmaf(-a.y, x29, x56);
    x56 = fmaf(-a.z, x30, x56);
    x56 = fmaf(-a.w, x31, x56);
    a = *(const LAS f32x4*)(Am + 3840);
    x56 = fmaf(-a.x, x32, x56);
    x56 = fmaf(-a.y, x33, x56);
    x56 = fmaf(-a.z, x34, x56);
    x56 = fmaf(-a.w, x35, x56);
    a = *(const LAS f32x4*)(Am + 3844);
    x56 = fmaf(-a.x, x36, x56);
    x56 = fmaf(-a.y, x37, x56);
    x56 = fmaf(-a.z, x38, x56);
    x56 = fmaf(-a.w, x39, x56);
    a = *(const LAS f32x4*)(Am + 3848);
    x56 = fmaf(-a.x, x40, x56);
    x56 = fmaf(-a.y, x41, x56);
    x56 = fmaf(-a.z, x42, x56);
    x56 = fmaf(-a.w, x43, x56);
    a = *(const LAS f32x4*)(Am + 3852);
    x56 = fmaf(-a.x, x44, x56);
    x56 = fmaf(-a.y, x45, x56);
    x56 = fmaf(-a.z, x46, x56);
    x56 = fmaf(-a.w, x47, x56);
    a = *(const LAS f32x4*)(Am + 3856);
    x56 = fmaf(-a.x, x48, x56);
    x56 = fmaf(-a.y, x49, x56);
    x56 = fmaf(-a.z, x50, x56);
    x56 = fmaf(-a.w, x51, x56);
    a = *(const LAS f32x4*)(Am + 3860);
    x56 = fmaf(-a.x, x52, x56);
    x56 = fmaf(-a.y, x53, x56);
    x56 = fmaf(-a.z, x54, x56);
    x56 = fmaf(-a.w, x55, x56);
    outp[56 * rstride] = f2bf(x56);
    float x57 = sc[57] * bf2f(col[7752]);
    a = *(const LAS f32x4*)(Am + 3876);
    x57 = fmaf(-a.x, x0, x57);
    x57 = fmaf(-a.y, x1, x57);
    x57 = fmaf(-a.z, x2, x57);
    x57 = fmaf(-a.w, x3, x57);
    a = *(const LAS f32x4*)(Am + 3880);
    x57 = fmaf(-a.x, x4, x57);
    x57 = fmaf(-a.y, x5, x57);
    x57 = fmaf(-a.z, x6, x57);
    x57 = fmaf(-a.w, x7, x57);
    a = *(const LAS f32x4*)(Am + 3884);
    x57 = fmaf(-a.x, x8, x57);
    x57 = fmaf(-a.y, x9, x57);
    x57 = fmaf(-a.z, x10, x57);
    x57 = fmaf(-a.w, x11, x57);
    a = *(const LAS f32x4*)(Am + 3888);
    x57 = fmaf(-a.x, x12, x57);
    x57 = fmaf(-a.y, x13, x57);
    x57 = fmaf(-a.z, x14, x57);
    x57 = fmaf(-a.w, x15, x57);
    a = *(const LAS f32x4*)(Am + 3892);
    x57 = fmaf(-a.x, x16, x57);
    x57 = fmaf(-a.y, x17, x57);
    x57 = fmaf(-a.z, x18, x57);
    x57 = fmaf(-a.w, x19, x57);
    a = *(const LAS f32x4*)(Am + 3896);
    x57 = fmaf(-a.x, x20, x57);
    x57 = fmaf(-a.y, x21, x57);
    x57 = fmaf(-a.z, x22, x57);
    x57 = fmaf(-a.w, x23, x57);
    a = *(const LAS f32x4*)(Am + 3900);
    x57 = fmaf(-a.x, x24, x57);
    x57 = fmaf(-a.y, x25, x57);
    x57 = fmaf(-a.z, x26, x57);
    x57 = fmaf(-a.w, x27, x57);
    a = *(const LAS f32x4*)(Am + 3904);
    x57 = fmaf(-a.x, x28, x57);
    x57 = fmaf(-a.y, x29, x57);
    x57 = fmaf(-a.z, x30, x57);
    x57 = fmaf(-a.w, x31, x57);
    a = *(const LAS f32x4*)(Am + 3908);
    x57 = fmaf(-a.x, x32, x57);
    x57 = fmaf(-a.y, x33, x57);
    x57 = fmaf(-a.z, x34, x57);
    x57 = fmaf(-a.w, x35, x57);
    a = *(const LAS f32x4*)(Am + 3912);
    x57 = fmaf(-a.x, x36, x57);
    x57 = fmaf(-a.y, x37, x57);
    x57 = fmaf(-a.z, x38, x57);
    x57 = fmaf(-a.w, x39, x57);
    a = *(const LAS f32x4*)(Am + 3916);
    x57 = fmaf(-a.x, x40, x57);
    x57 = fmaf(-a.y, x41, x57);
    x57 = fmaf(-a.z, x42, x57);
    x57 = fmaf(-a.w, x43, x57);
    a = *(const LAS f32x4*)(Am + 3920);
    x57 = fmaf(-a.x, x44, x57);
    x57 = fmaf(-a.y, x45, x57);
    x57 = fmaf(-a.z, x46, x57);
    x57 = fmaf(-a.w, x47, x57);
    a = *(const LAS f32x4*)(Am + 3924);
    x57 = fmaf(-a.x, x48, x57);
    x57 = fmaf(-a.y, x49, x57);
    x57 = fmaf(-a.z, x50, x57);
    x57 = fmaf(-a.w, x51, x57);
    a = *(const LAS f32x4*)(Am + 3928);
    x57 = fmaf(-a.x, x52, x57);
    x57 = fmaf(-a.y, x53, x57);
    x57 = fmaf(-a.z, x54, x57);
    x57 = fmaf(-a.w, x55, x57);
    a = *(const LAS f32x4*)(Am + 3932);
    x57 = fmaf(-a.x, x56, x57);
    outp[57 * rstride] = f2bf(x57);
    float x58 = sc[58] * bf2f(col[7888]);
    a = *(const LAS f32x4*)(Am + 3944);
    x58 = fmaf(-a.x, x0, x58);
    x58 = fmaf(-a.y, x1, x58);
    x58 = fmaf(-a.z, x2, x58);
    x58 = fmaf(-a.w, x3, x58);
    a = *(const LAS f32x4*)(Am + 3948);
    x58 = fmaf(-a.x, x4, x58);
    x58 = fmaf(-a.y, x5, x58);
    x58 = fmaf(-a.z, x6, x58);
    x58 = fmaf(-a.w, x7, x58);
    a = *(const LAS f32x4*)(Am + 3952);
    x58 = fmaf(-a.x, x8, x58);
    x58 = fmaf(-a.y, x9, x58);
    x58 = fmaf(-a.z, x10, x58);
    x58 = fmaf(-a.w, x11, x58);
    a = *(const LAS f32x4*)(Am + 3956);
    x58 = fmaf(-a.x, x12, x58);
    x58 = fmaf(-a.y, x13, x58);
    x58 = fmaf(-a.z, x14, x58);
    x58 = fmaf(-a.w, x15, x58);
    a = *(const LAS f32x4*)(Am + 3960);
    x58 = fmaf(-a.x, x16, x58);
    x58 = fmaf(-a.y, x17, x58);
    x58 = fmaf(-a.z, x18, x58);
    x58 = fmaf(-a.w, x19, x58);
    a = *(const LAS f32x4*)(Am + 3964);
    x58 = fmaf(-a.x, x20, x58);
    x58 = fmaf(-a.y, x21, x58);
    x58 = fmaf(-a.z, x22, x58);
    x58 = fmaf(-a.w, x23, x58);
    a = *(const LAS f32x4*)(Am + 3968);
    x58 = fmaf(-a.x, x24, x58);
    x58 = fmaf(-a.y, x25, x58);
    x58 = fmaf(-a.z, x26, x58);
    x58 = fmaf(-a.w, x27, x58);
    a = *(const LAS f32x4*)(Am + 3972);
    x58 = fmaf(-a.x, x28, x58);
    x58 = fmaf(-a.y, x29, x58);
    x58 = fmaf(-a.z, x30, x58);
    x58 = fmaf(-a.w, x31, x58);
    a = *(const LAS f32x4*)(Am + 3976);
    x58 = fmaf(-a.x, x32, x58);
    x58 = fmaf(-a.y, x33, x58);
    x58 = fmaf(-a.z, x34, x58);
    x58 = fmaf(-a.w, x35, x58);
    a = *(const LAS f32x4*)(Am + 3980);
    x58 = fmaf(-a.x, x36, x58);
    x58 = fmaf(-a.y, x37, x58);
    x58 = fmaf(-a.z, x38, x58);
    x58 = fmaf(-a.w, x39, x58);
    a = *(const LAS f32x4*)(Am + 3984);
    x58 = fmaf(-a.x, x40, x58);
    x58 = fmaf(-a.y, x41, x58);
    x58 = fmaf(-a.z, x42, x58);
    x58 = fmaf(-a.w, x43, x58);
    a = *(const LAS f32x4*)(Am + 3988);
    x58 = fmaf(-a.x, x44, x58);
    x58 = fmaf(-a.y, x45, x58);
    x58 = fmaf(-a.z, x46, x58);
    x58 = fmaf(-a.w, x47, x58);
    a = *(const LAS f32x4*)(Am + 3992);
    x58 = fmaf(-a.x, x48, x58);
    x58 = fmaf(-a.y, x49, x58);
    x58 = fmaf(-a.z, x50, x58);
    x58 = fmaf(-a.w, x51, x58);
    a = *(const LAS f32x4*)(Am + 3996);
    x58 = fmaf(-a.x, x52, x58);
    x58 = fmaf(-a.y, x53, x58);
    x58 = fmaf(-a.z, x54, x58);
    x58 = fmaf(-a.w, x55, x58);
    a = *(const LAS f32x4*)(Am + 4000);
    x58 = fmaf(-a.x, x56, x58);
    x58 = fmaf(-a.y, x57, x58);
    outp[58 * rstride] = f2bf(x58);
    float x59 = sc[59] * bf2f(col[8024]);
    a = *(const LAS f32x4*)(Am + 4012);
    x59 = fmaf(-a.x, x0, x59);
    x59 = fmaf(-a.y, x1, x59);
    x59 = fmaf(-a.z, x2, x59);
    x59 = fmaf(-a.w, x3, x59);
    a = *(const LAS f32x4*)(Am + 4016);
    x59 = fmaf(-a.x, x4, x59);
    x59 = fmaf(-a.y, x5, x59);
    x59 = fmaf(-a.z, x6, x59);
    x59 = fmaf(-a.w, x7, x59);
    a = *(const LAS f32x4*)(Am + 4020);
    x59 = fmaf(-a.x, x8, x59);
    x59 = fmaf(-a.y, x9, x59);
    x59 = fmaf(-a.z, x10, x59);
    x59 = fmaf(-a.w, x11, x59);
    a = *(const LAS f32x4*)(Am + 4024);
    x59 = fmaf(-a.x, x12, x59);
    x59 = fmaf(-a.y, x13, x59);
    x59 = fmaf(-a.z, x14, x59);
    x59 = fmaf(-a.w, x15, x59);
    a = *(const LAS f32x4*)(Am + 4028);
    x59 = fmaf(-a.x, x16, x59);
    x59 = fmaf(-a.y, x17, x59);
    x59 = fmaf(-a.z, x18, x59);
    x59 = fmaf(-a.w, x19, x59);
    a = *(const LAS f32x4*)(Am + 4032);
    x59 = fmaf(-a.x, x20, x59);
    x59 = fmaf(-a.y, x21, x59);
    x59 = fmaf(-a.z, x22, x59);
    x59 = fmaf(-a.w, x23, x59);
    a = *(const LAS f32x4*)(Am + 4036);
    x59 = fmaf(-a.x, x24, x59);
    x59 = fmaf(-a.y, x25, x59);
    x59 = fmaf(-a.z, x26, x59);
    x59 = fmaf(-a.w, x27, x59);
    a = *(const LAS f32x4*)(Am + 4040);
    x59 = fmaf(-a.x, x28, x59);
    x59 = fmaf(-a.y, x29, x59);
    x59 = fmaf(-a.z, x30, x59);
    x59 = fmaf(-a.w, x31, x59);
    a = *(const LAS f32x4*)(Am + 4044);
    x59 = fmaf(-a.x, x32, x59);
    x59 = fmaf(-a.y, x33, x59);
    x59 = fmaf(-a.z, x34, x59);
    x59 = fmaf(-a.w, x35, x59);
    a = *(const LAS f32x4*)(Am + 4048);
    x59 = fmaf(-a.x, x36, x59);
    x59 = fmaf(-a.y, x37, x59);
    x59 = fmaf(-a.z, x38, x59);
    x59 = fmaf(-a.w, x39, x59);
    a = *(const LAS f32x4*)(Am + 4052);
    x59 = fmaf(-a.x, x40, x59);
    x59 = fmaf(-a.y, x41, x59);
    x59 = fmaf(-a.z, x42, x59);
    x59 = fmaf(-a.w, x43, x59);
    a = *(const LAS f32x4*)(Am + 4056);
    x59 = fmaf(-a.x, x44, x59);
    x59 = fmaf(-a.y, x45, x59);
    x59 = fmaf(-a.z, x46, x59);
    x59 = fmaf(-a.w, x47, x59);
    a = *(const LAS f32x4*)(Am + 4060);
    x59 = fmaf(-a.x, x48, x59);
    x59 = fmaf(-a.y, x49, x59);
    x59 = fmaf(-a.z, x50, x59);
    x59 = fmaf(-a.w, x51, x59);
    a = *(const LAS f32x4*)(Am + 4064);
    x59 = fmaf(-a.x, x52, x59);
    x59 = fmaf(-a.y, x53, x59);
    x59 = fmaf(-a.z, x54, x59);
    x59 = fmaf(-a.w, x55, x59);
    a = *(const LAS f32x4*)(Am + 4068);
    x59 = fmaf(-a.x, x56, x59);
    x59 = fmaf(-a.y, x57, x59);
    x59 = fmaf(-a.z, x58, x59);
    outp[59 * rstride] = f2bf(x59);
    float x60 = sc[60] * bf2f(col[8160]);
    a = *(const LAS f32x4*)(Am + 4080);
    x60 = fmaf(-a.x, x0, x60);
    x60 = fmaf(-a.y, x1, x60);
    x60 = fmaf(-a.z, x2, x60);
    x60 = fmaf(-a.w, x3, x60);
    a = *(const LAS f32x4*)(Am + 4084);
    x60 = fmaf(-a.x, x4, x60);
    x60 = fmaf(-a.y, x5, x60);
    x60 = fmaf(-a.z, x6, x60);
    x60 = fmaf(-a.w, x7, x60);
    a = *(const LAS f32x4*)(Am + 4088);
    x60 = fmaf(-a.x, x8, x60);
    x60 = fmaf(-a.y, x9, x60);
    x60 = fmaf(-a.z, x10, x60);
    x60 = fmaf(-a.w, x11, x60);
    a = *(const LAS f32x4*)(Am + 4092);
    x60 = fmaf(-a.x, x12, x60);
    x60 = fmaf(-a.y, x13, x60);
    x60 = fmaf(-a.z, x14, x60);
    x60 = fmaf(-a.w, x15, x60);
    a = *(const LAS f32x4*)(Am + 4096);
    x60 = fmaf(-a.x, x16, x60);
    x60 = fmaf(-a.y, x17, x60);
    x60 = fmaf(-a.z, x18, x60);
    x60 = fmaf(-a.w, x19, x60);
    a = *(const LAS f32x4*)(Am + 4100);
    x60 = fmaf(-a.x, x20, x60);
    x60 = fmaf(-a.y, x21, x60);
    x60 = fmaf(-a.z, x22, x60);
    x60 = fmaf(-a.w, x23, x60);
    a = *(const LAS f32x4*)(Am + 4104);
    x60 = fmaf(-a.x, x24, x60);
    x60 = fmaf(-a.y, x25, x60);
    x60 = fmaf(-a.z, x26, x60);
    x60 = fmaf(-a.w, x27, x60);
    a = *(const LAS f32x4*)(Am + 4108);
    x60 = fmaf(-a.x, x28, x60);
    x60 = fmaf(-a.y, x29, x60);
    x60 = fmaf(-a.z, x30, x60);
    x60 = fmaf(-a.w, x31, x60);
    a = *(const LAS f32x4*)(Am + 4112);
    x60 = fmaf(-a.x, x32, x60);
    x60 = fmaf(-a.y, x33, x60);
    x60 = fmaf(-a.z, x34, x60);
    x60 = fmaf(-a.w, x35, x60);
    a = *(const LAS f32x4*)(Am + 4116);
    x60 = fmaf(-a.x, x36, x60);
    x60 = fmaf(-a.y, x37, x60);
    x60 = fmaf(-a.z, x38, x60);
    x60 = fmaf(-a.w, x39, x60);
    a = *(const LAS f32x4*)(Am + 4120);
    x60 = fmaf(-a.x, x40, x60);
    x60 = fmaf(-a.y, x41, x60);
    x60 = fmaf(-a.z, x42, x60);
    x60 = fmaf(-a.w, x43, x60);
    a = *(const LAS f32x4*)(Am + 4124);
    x60 = fmaf(-a.x, x44, x60);
    x60 = fmaf(-a.y, x45, x60);
    x60 = fmaf(-a.z, x46, x60);
    x60 = fmaf(-a.w, x47, x60);
    a = *(const LAS f32x4*)(Am + 4128);
    x60 = fmaf(-a.x, x48, x60);
    x60 = fmaf(-a.y, x49, x60);
    x60 = fmaf(-a.z, x50, x60);
    x60 = fmaf(-a.w, x51, x60);
    a = *(const LAS f32x4*)(Am + 4132);
    x60 = fmaf(-a.x, x52, x60);
    x60 = fmaf(-a.y, x53, x60);
    x60 = fmaf(-a.z, x54, x60);
    x60 = fmaf(-a.w, x55, x60);
    a = *(const LAS f32x4*)(Am + 4136);
    x60 = fmaf(-a.x, x56, x60);
    x60 = fmaf(-a.y, x57, x60);
    x60 = fmaf(-a.z, x58, x60);
    x60 = fmaf(-a.w, x59, x60);
    outp[60 * rstride] = f2bf(x60);
    float x61 = sc[61] * bf2f(col[8296]);
    a = *(const LAS f32x4*)(Am + 4148);
    x61 = fmaf(-a.x, x0, x61);
    x61 = fmaf(-a.y, x1, x61);
    x61 = fmaf(-a.z, x2, x61);
    x61 = fmaf(-a.w, x3, x61);
    a = *(const LAS f32x4*)(Am + 4152);
    x61 = fmaf(-a.x, x4, x61);
    x61 = fmaf(-a.y, x5, x61);
    x61 = fmaf(-a.z, x6, x61);
    x61 = fmaf(-a.w, x7, x61);
    a = *(const LAS f32x4*)(Am + 4156);
    x61 = fmaf(-a.x, x8, x61);
    x61 = fmaf(-a.y, x9, x61);
    x61 = fmaf(-a.z, x10, x61);
    x61 = fmaf(-a.w, x11, x61);
    a = *(const LAS f32x4*)(Am + 4160);
    x61 = fmaf(-a.x, x12, x61);
    x61 = fmaf(-a.y, x13, x61);
    x61 = fmaf(-a.z, x14, x61);
    x61 = fmaf(-a.w, x15, x61);
    a = *(const LAS f32x4*)(Am + 4164);
    x61 = fmaf(-a.x, x16, x61);
    x61 = fmaf(-a.y, x17, x61);
    x61 = fmaf(-a.z, x18, x61);
    x61 = fmaf(-a.w, x19, x61);
    a = *(const LAS f32x4*)(Am + 4168);
    x61 = fmaf(-a.x, x20, x61);
    x61 = fmaf(-a.y, x21, x61);
    x61 = fmaf(-a.z, x22, x61);
    x61 = fmaf(-a.w, x23, x61);
    a = *(const LAS f32x4*)(Am + 4172);
    x61 = fmaf(-a.x, x24, x61);
    x61 = fmaf(-a.y, x25, x61);
    x61 = fmaf(-a.z, x26, x61);
    x61 = fmaf(-a.w, x27, x61);
    a = *(const LAS f32x4*)(Am + 4176);
    x61 = fmaf(-a.x, x28, x61);
    x61 = fmaf(-a.y, x29, x61);
    x61 = fmaf(-a.z, x30, x61);
    x61 = fmaf(-a.w, x31, x61);
    a = *(const LAS f32x4*)(Am + 4180);
    x61 = fmaf(-a.x, x32, x61);
    x61 = fmaf(-a.y, x33, x61);
    x61 = fmaf(-a.z, x34, x61);
    x61 = fmaf(-a.w, x35, x61);
    a = *(const LAS f32x4*)(Am + 4184);
    x61 = fmaf(-a.x, x36, x61);
    x61 = fmaf(-a.y, x37, x61);
    x61 = fmaf(-a.z, x38, x61);
    x61 = fmaf(-a.w, x39, x61);
    a = *(const LAS f32x4*)(Am + 4188);
    x61 = fmaf(-a.x, x40, x61);
    x61 = fmaf(-a.y, x41, x61);
    x61 = fmaf(-a.z, x42, x61);
    x61 = fmaf(-a.w, x43, x61);
    a = *(const LAS f32x4*)(Am + 4192);
    x61 = fmaf(-a.x, x44, x61);
    x61 = fmaf(-a.y, x45, x61);
    x61 = fmaf(-a.z, x46, x61);
    x61 = fmaf(-a.w, x47, x61);
    a = *(const LAS f32x4*)(Am + 4196);
    x61 = fmaf(-a.x, x48, x61);
    x61 = fmaf(-a.y, x49, x61);
    x61 = fmaf(-a.z, x50, x61);
    x61 = fmaf(-a.w, x51, x61);
    a = *(const LAS f32x4*)(Am + 4200);
    x61 = fmaf(-a.x, x52, x61);
    x61 = fmaf(-a.y, x53, x61);
    x61 = fmaf(-a.z, x54, x61);
    x61 = fmaf(-a.w, x55, x61);
    a = *(const LAS f32x4*)(Am + 4204);
    x61 = fmaf(-a.x, x56, x61);
    x61 = fmaf(-a.y, x57, x61);
    x61 = fmaf(-a.z, x58, x61);
    x61 = fmaf(-a.w, x59, x61);
    a = *(const LAS f32x4*)(Am + 4208);
    x61 = fmaf(-a.x, x60, x61);
    outp[61 * rstride] = f2bf(x61);
    float x62 = sc[62] * bf2f(col[8432]);
    a = *(const LAS f32x4*)(Am + 4216);
    x62 = fmaf(-a.x, x0, x62);
    x62 = fmaf(-a.y, x1, x62);
    x62 = fmaf(-a.z, x2, x62);
    x62 = fmaf(-a.w, x3, x62);
    a = *(const LAS f32x4*)(Am + 4220);
    x62 = fmaf(-a.x, x4, x62);
    x62 = fmaf(-a.y, x5, x62);
    x62 = fmaf(-a.z, x6, x62);
    x62 = fmaf(-a.w, x7, x62);
    a = *(const LAS f32x4*)(Am + 4224);
    x62 = fmaf(-a.x, x8, x62);
    x62 = fmaf(-a.y, x9, x62);
    x62 = fmaf(-a.z, x10, x62);
    x62 = fmaf(-a.w, x11, x62);
    a = *(const LAS f32x4*)(Am + 4228);
    x62 = fmaf(-a.x, x12, x62);
    x62 = fmaf(-a.y, x13, x62);
    x62 = fmaf(-a.z, x14, x62);
    x62 = fmaf(-a.w, x15, x62);
    a = *(const LAS f32x4*)(Am + 4232);
    x62 = fmaf(-a.x, x16, x62);
    x62 = fmaf(-a.y, x17, x62);
    x62 = fmaf(-a.z, x18, x62);
    x62 = fmaf(-a.w, x19, x62);
    a = *(const LAS f32x4*)(Am + 4236);
    x62 = fmaf(-a.x, x20, x62);
    x62 = fmaf(-a.y, x21, x62);
    x62 = fmaf(-a.z, x22, x62);
    x62 = fmaf(-a.w, x23, x62);
    a = *(const LAS f32x4*)(Am + 4240);
    x62 = fmaf(-a.x, x24, x62);
    x62 = fmaf(-a.y, x25, x62);
    x62 = fmaf(-a.z, x26, x62);
    x62 = fmaf(-a.w, x27, x62);
    a = *(const LAS f32x4*)(Am + 4244);
    x62 = fmaf(-a.x, x28, x62);
    x62 = fmaf(-a.y, x29, x62);
    x62 = fmaf(-a.z, x30, x62);
    x62 = fmaf(-a.w, x31, x62);
    a = *(const LAS f32x4*)(Am + 4248);
    x62 = fmaf(-a.x, x32, x62);
    x62 = fmaf(-a.y, x33, x62);
    x62 = fmaf(-a.z, x34, x62);
    x62 = fmaf(-a.w, x35, x62);
    a = *(const LAS f32x4*)(Am + 4252);
    x62 = fmaf(-a.x, x36, x62);
    x62 = fmaf(-a.y, x37, x62);
    x62 = fmaf(-a.z, x38, x62);
    x62 = fmaf(-a.w, x39, x62);
    a = *(const LAS f32x4*)(Am + 4256);
    x62 = fmaf(-a.x, x40, x62);
    x62 = fmaf(-a.y, x41, x62);
    x62 = fmaf(-a.z, x42, x62);
    x62 = fmaf(-a.w, x43, x62);
    a = *(const LAS f32x4*)(Am + 4260);
    x62 = fmaf(-a.x, x44, x62);
    x62 = fmaf(-a.y, x45, x62);
    x62 = fmaf(-a.z, x46, x62);
    x62 = fmaf(-a.w, x47, x62);
    a = *(const LAS f32x4*)(Am + 4264);
    x62 = fmaf(-a.x, x48, x62);
    x62 = fmaf(-a.y, x49, x62);
    x62 = fmaf(-a.z, x50, x62);
    x62 = fmaf(-a.w, x51, x62);
    a = *(const LAS f32x4*)(Am + 4268);
    x62 = fmaf(-a.x, x52, x62);
    x62 = fmaf(-a.y, x53, x62);
    x62 = fmaf(-a.z, x54, x62);
    x62 = fmaf(-a.w, x55, x62);
    a = *(const LAS f32x4*)(Am + 4272);
    x62 = fmaf(-a.x, x56, x62);
    x62 = fmaf(-a.y, x57, x62);
    x62 = fmaf(-a.z, x58, x62);
    x62 = fmaf(-a.w, x59, x62);
    a = *(const LAS f32x4*)(Am + 4276);
    x62 = fmaf(-a.x, x60, x62);
    x62 = fmaf(-a.y, x61, x62);
    outp[62 * rstride] = f2bf(x62);
    float x63 = sc[63] * bf2f(col[8568]);
    a = *(const LAS f32x4*)(Am + 4284);
    x63 = fmaf(-a.x, x0, x63);
    x63 = fmaf(-a.y, x1, x63);
    x63 = fmaf(-a.z, x2, x63);
    x63 = fmaf(-a.w, x3, x63);
    a = *(const LAS f32x4*)(Am + 4288);
    x63 = fmaf(-a.x, x4, x63);
    x63 = fmaf(-a.y, x5, x63);
    x63 = fmaf(-a.z, x6, x63);
    x63 = fmaf(-a.w, x7, x63);
    a = *(const LAS f32x4*)(Am + 4292);
    x63 = fmaf(-a.x, x8, x63);
    x63 = fmaf(-a.y, x9, x63);
    x63 = fmaf(-a.z, x10, x63);
    x63 = fmaf(-a.w, x11, x63);
    a = *(const LAS f32x4*)(Am + 4296);
    x63 = fmaf(-a.x, x12, x63);
    x63 = fmaf(-a.y, x13, x63);
    x63 = fmaf(-a.z, x14, x63);
    x63 = fmaf(-a.w, x15, x63);
    a = *(const LAS f32x4*)(Am + 4300);
    x63 = fmaf(-a.x, x16, x63);
    x63 = fmaf(-a.y, x17, x63);
    x63 = fmaf(-a.z, x18, x63);
    x63 = fmaf(-a.w, x19, x63);
    a = *(const LAS f32x4*)(Am + 4304);
    x63 = fmaf(-a.x, x20, x63);
    x63 = fmaf(-a.y, x21, x63);
    x63 = fmaf(-a.z, x22, x63);
    x63 = fmaf(-a.w, x23, x63);
    a = *(const LAS f32x4*)(Am + 4308);
    x63 = fmaf(-a.x, x24, x63);
    x63 = fmaf(-a.y, x25, x63);
    x63 = fmaf(-a.z, x26, x63);
    x63 = fmaf(-a.w, x27, x63);
    a = *(const LAS f32x4*)(Am + 4312);
    x63 = fmaf(-a.x, x28, x63);
    x63 = fmaf(-a.y, x29, x63);
    x63 = fmaf(-a.z, x30, x63);
    x63 = fmaf(-a.w, x31, x63);
    a = *(const LAS f32x4*)(Am + 4316);
    x63 = fmaf(-a.x, x32, x63);
    x63 = fmaf(-a.y, x33, x63);
    x63 = fmaf(-a.z, x34, x63);
    x63 = fmaf(-a.w, x35, x63);
    a = *(const LAS f32x4*)(Am + 4320);
    x63 = fmaf(-a.x, x36, x63);
    x63 = fmaf(-a.y, x37, x63);
    x63 = fmaf(-a.z, x38, x63);
    x63 = fmaf(-a.w, x39, x63);
    a = *(const LAS f32x4*)(Am + 4324);
    x63 = fmaf(-a.x, x40, x63);
    x63 = fmaf(-a.y, x41, x63);
    x63 = fmaf(-a.z, x42, x63);
    x63 = fmaf(-a.w, x43, x63);
    a = *(const LAS f32x4*)(Am + 4328);
    x63 = fmaf(-a.x, x44, x63);
    x63 = fmaf(-a.y, x45, x63);
    x63 = fmaf(-a.z, x46, x63);
    x63 = fmaf(-a.w, x47, x63);
    a = *(const LAS f32x4*)(Am + 4332);
    x63 = fmaf(-a.x, x48, x63);
    x63 = fmaf(-a.y, x49, x63);
    x63 = fmaf(-a.z, x50, x63);
    x63 = fmaf(-a.w, x51, x63);
    a = *(const LAS f32x4*)(Am + 4336);
    x63 = fmaf(-a.x, x52, x63);
    x63 = fmaf(-a.y, x53, x63);
    x63 = fmaf(-a.z, x54, x63);
    x63 = fmaf(-a.w, x55, x63);
    a = *(const LAS f32x4*)(Am + 4340);
    x63 = fmaf(-a.x, x56, x63);
    x63 = fmaf(-a.y, x57, x63);
    x63 = fmaf(-a.z, x58, x63);
    x63 = fmaf(-a.w, x59, x63);
    a = *(const LAS f32x4*)(Am + 4344);
    x63 = fmaf(-a.x, x60, x63);
    x63 = fmaf(-a.y, x61, x63);
    x63 = fmaf(-a.z, x62, x63);
    outp[63 * rstride] = f2bf(x63);
}
typedef short bf16x8_t __attribute__((ext_vector_type(8)));
template <int K> __device__ __forceinline__ f32x4 mma_tile(const LAS unsigned short* A, int lda, const LAS unsigned short* Bt, int ldb, f32x4 acc) {
    const int lane = threadIdx.x & 63, r = lane & 15, q = lane >> 4;
#pragma unroll
    for (int ks = 0; ks < K / 32; ++ks) {
        const bf16x8_t a = *(const LAS bf16x8_t*)(A + r * lda + ks * 32 + q * 8);
        const bf16x8_t b = *(const LAS bf16x8_t*)(Bt + r * ldb + ks * 32 + q * 8);
        acc = __builtin_amdgcn_mfma_f32_16x16x32_bf16(a, b, acc, 0, 0, 0);
    }
    return acc;
}
constexpr size_t WS_G = 235 * MiB;

__device__ __forceinline__ void delta_prep(LDSp lds, const Params& p) {
    const bf16_t* QKVN = (const bf16_t*)(p.ws + WS_QKV); const float* BETA = (const float*)(p.ws + WS_BETA); const float* LA = (const float*)(p.ws + WS_LA);
    bf16_t* Z = (bf16_t*)(p.ws + WS_Z); float* GB = (float*)(p.ws + WS_G);
    LAS unsigned short* Qb = (LAS unsigned short*)lds;
    LAS unsigned short* Kb = (LAS unsigned short*)(lds + 17408);
    LAS unsigned short* Vb = (LAS unsigned short*)(lds + 34816);
    LAS float* Am = (LAS float*)(lds + 52224);
    LAS float* gl = (LAS float*)(lds + 69632);
    LAS float* be = gl + 64;
    LAS float* beg = gl + 128;
    LAS float* la = gl + 192;
    const int tid = threadIdx.x, lane = tid & 63, wid = tid >> 6, r = lane & 15, q = lane >> 4;
    for (int unit = blockIdx.x; unit < 2048; unit += gridDim.x) {
        const int dir = unit >> 10, b = (unit >> 8) & 3, h = (unit >> 6) & 3, n = unit & 63;
        const long tok0 = (long)b * S_ + (dir ? (S_ - 1 - n * 64) : n * 64); const long tstep = dir ? -1 : 1;
#pragma unroll
        for (int i = 0; i < 6; ++i) { const int pi = tid + NTHR * i, which = pi >> 10, l = (pi >> 4) & 63, c8 = pi & 15;
            const u32x4 v = *(const u32x4*)(QKVN + (tok0 + l * tstep) * 1536 + which * 512 + h * 128 + c8 * 8);
            *(LAS u32x4*)(lds + which * 17408 + l * 272 + c8 * 16) = v; }
        if (tid < 64) { const long tk = tok0 + tid * tstep; la[tid] = LA[tk * 8 + dir * 4 + h]; be[tid] = BETA[tk * 8 + dir * 4 + h]; }
        __syncthreads();
        if (tid < 64) { float g = 0.f; for (int j = 0; j <= tid; ++j) g += la[j]; gl[tid] = g; beg[tid] = be[tid] * __expf(g); GB[((size_t)dir * T_ + (tok0 + tid * tstep)) * 4 + h] = g; }
        __syncthreads();
#pragma unroll
        for (int tt = 0; tt < 2; ++tt) { const int idx = wid * 2 + tt, mt = idx >> 2, nt = idx & 3;
            f32x4 kk = {0.f, 0.f, 0.f, 0.f}, qk = {0.f, 0.f, 0.f, 0.f};
            if (mt >= nt) { kk = mma_tile<128>(Kb + mt * 16 * 136, 136, Kb + nt * 16 * 136, 136, kk); qk = mma_tile<128>(Qb + mt * 16 * 136, 136, Kb + nt * 16 * 136, 136, qk); }
            const int j = nt * 16 + r; const float gj = gl[j];
#pragma unroll
            for (int i4 = 0; i4 < 4; ++i4) { const int i = mt * 16 + q * 4 + i4; const float dec = (i >= j) ? __expf(gl[i] - gj) : 0.f;
                Am[i * 68 + j] = (i > j) ? be[i] * kk[i4] * dec : 0.f;
                Z[(tok0 + i * tstep) * 3072 + 2048 + dir * 256 + h * 64 + j] = f2bf(qk[i4] * dec); }
        }
        __syncthreads();
        if (tid < 256) { const int c = tid;
            tri_solve64(Am, c < 128 ? Vb + c : Kb + (c - 128), c < 128 ? be : beg, Z + tok0 * 3072 + (c < 128 ? 0 : 1024) + dir * 512 + h * 128 + (c & 127), tstep * 3072); }
        __syncthreads();
    }
}

__device__ __forceinline__ void delta_scan2(LDSp lds, const Params& p) {
    const bf16_t* QKVN = (const bf16_t*)(p.ws + WS_QKV); const bf16_t* Z = (const bf16_t*)(p.ws + WS_Z); const float* GB = (const float*)(p.ws + WS_G);
    LAS unsigned short* Wb  = (LAS unsigned short*)lds;
    LAS unsigned short* Qg  = (LAS unsigned short*)(lds + 17408);
    LAS unsigned short* KgT = (LAS unsigned short*)(lds + 34816);
    LAS unsigned short* At  = (LAS unsigned short*)(lds + 53248);
    LAS unsigned short* Ub  = (LAS unsigned short*)(lds + 62464);
    LAS unsigned short* St  = (LAS unsigned short*)(lds + 66560);
    LAS unsigned short* Vt  = (LAS unsigned short*)(lds + 75264);
    const int tid = threadIdx.x, lane = tid & 63, wid = tid >> 6, r = lane & 15, q = lane >> 4;
    for (int unit = blockIdx.x; unit < 128; unit += gridDim.x) {
        const int dir = unit >> 6, b = (unit >> 4) & 3, h = (unit >> 2) & 3, sl = unit & 3;
        bf16_t* O = (bf16_t*)(p.ws + (dir ? WS_OB : WS_OF));
        const long tstep = dir ? -1 : 1;
        f32x4 S0 = {0.f, 0.f, 0.f, 0.f}, S1 = {0.f, 0.f, 0.f, 0.f};
        u32x4 rw[2], rq[2], rk[2], ra, ru = {0u, 0u, 0u, 0u}; float g0 = 0.f, g1 = 0.f, gL = 0.f;
#define D2_TOK0(n) ((long)b * S_ + (dir ? (S_ - 1 - (n) * 64) : (n) * 64))
#define D2_LOAD(n) do { const long t0_ = D2_TOK0(n); \
        _Pragma("unroll") for (int i = 0; i < 2; ++i) { const int pi = tid + NTHR * i, l = pi >> 4, c8 = pi & 15; const long tk = t0_ + l * tstep; \
            rw[i] = *(const u32x4*)(Z + tk * 3072 + 1024 + dir * 512 + h * 128 + c8 * 8); \
            rq[i] = *(const u32x4*)(QKVN + tk * 1536 + h * 128 + c8 * 8); rk[i] = *(const u32x4*)(QKVN + tk * 1536 + 512 + h * 128 + c8 * 8); } \
        { const int l = tid >> 3, c8 = tid & 7; ra = *(const u32x4*)(Z + (t0_ + l * tstep) * 3072 + 2048 + dir * 256 + h * 64 + c8 * 8); } \
        if (tid < 256) { const int l = tid >> 2, c8 = tid & 3; ru = *(const u32x4*)(Z + (t0_ + l * tstep) * 3072 + dir * 512 + h * 128 + sl * 32 + c8 * 8); } \
        g0 = GB[((size_t)dir * T_ + (t0_ + (tid >> 4) * tstep)) * 4 + h]; g1 = GB[((size_t)dir * T_ + (t0_ + ((tid >> 4) + 32) * tstep)) * 4 + h]; \
        gL = GB[((size_t)dir * T_ + (t0_ + 63 * tstep)) * 4 + h]; } while (0)
        D2_LOAD(0);
#pragma unroll 1
        for (int n = 0; n < 64; ++n) {
            const float egL = __expf(gL);
#pragma unroll
            for (int i = 0; i < 2; ++i) { const int pi = tid + NTHR * i, l = pi >> 4, c8 = pi & 15; const float gl_ = i == 0 ? g0 : g1;
                *(LAS u32x4*)(Wb + l * 136 + c8 * 8) = rw[i];
                float f[8]; unpack8(rq[i], f); const float eg = __expf(gl_);
                u32x4 o; o.x = pk2(f[0] * eg, f[1] * eg); o.y = pk2(f[2] * eg, f[3] * eg); o.z = pk2(f[4] * eg, f[5] * eg); o.w = pk2(f[6] * eg, f[7] * eg);
                *(LAS u32x4*)(Qg + l * 136 + c8 * 8) = o;
                unpack8(rk[i], f); const float ek = __expf(gL - gl_);
#pragma unroll
                for (int j = 0; j < 8; ++j) KgT[(c8 * 8 + j) * 72 + l] = f2bf(f[j] * ek); }
            { const int l = tid >> 3, c8 = tid & 7; *(LAS u32x4*)(At + l * 72 + c8 * 8) = ra; }
            if (tid < 256) { const int l = tid >> 2, c8 = tid & 3; *(LAS u32x4*)(Ub + l * 32 + c8 * 8) = ru; }
            { u32x2 w0; w0.x = pk2(S0.x, S0.y); w0.y = pk2(S0.z, S0.w); *(LAS u32x2*)(St + r * 136 + wid * 16 + q * 4) = w0;
              u32x2 w1; w1.x = pk2(S1.x, S1.y); w1.y = pk2(S1.z, S1.w); *(LAS u32x2*)(St + (16 + r) * 136 + wid * 16 + q * 4) = w1; }
            __syncthreads();
            if (n < 63) D2_LOAD(n + 1);
            const int mt = wid >> 1, nt = wid & 1;
            f32x4 p1 = {0.f, 0.f, 0.f, 0.f}, p2 = {0.f, 0.f, 0.f, 0.f};
            p1 = mma_tile<128>(Wb + mt * 16 * 136, 136, St + nt * 16 * 136, 136, p1);
            p2 = mma_tile<128>(Qg + mt * 16 * 136, 136, St + nt * 16 * 136, 136, p2);
            { const int l0 = mt * 16 + q * 4, v = nt * 16 + r; float vn[4];
#pragma unroll
              for (int i = 0; i < 4; ++i) vn[i] = bf2f(Ub[(l0 + i) * 32 + v]) - p1[i];
              u32x2 w; w.x = pk2(vn[0], vn[1]); w.y = pk2(vn[2], vn[3]); *(LAS u32x2*)(Vt + v * 72 + l0) = w; }
            __syncthreads();
            p2 = mma_tile<64>(At + mt * 16 * 72, 72, Vt + nt * 16 * 72, 72, p2);
            { const long t0_ = D2_TOK0(n);
#pragma unroll
              for (int i = 0; i < 4; ++i) O[(t0_ + (mt * 16 + q * 4 + i) * tstep) * 512 + h * 128 + sl * 32 + nt * 16 + r] = f2bf(p2[i]); }
            S0 = S0 * egL; S1 = S1 * egL;
            S0 = mma_tile<64>(KgT + wid * 16 * 72, 72, Vt, 72, S0);
            S1 = mma_tile<64>(KgT + wid * 16 * 72, 72, Vt + 16 * 72, 72, S1);
            __syncthreads();
        }
#undef D2_LOAD
#undef D2_TOK0
    }
}
constexpr size_t WS_CT = WS_OF, WS_NV = 235 * MiB, WS_MS = 235 * MiB + 524288, WS_CT2 = 169 * MiB, WS_NV2 = 236 * MiB;
__device__ __forceinline__ void mlstm_a(LDSp lds, const Params& p) {
    const bf16_t* Z = (const bf16_t*)(p.ws + WS_Z); const float* LI = (const float*)(p.ws + WS_BETA); const float* LF = (const float*)(p.ws + WS_LA);
    bf16_t* CT = (bf16_t*)(p.ws + WS_CT); float* NV = (float*)(p.ws + WS_NV); float* MS = (float*)(p.ws + WS_MS);
    LAS unsigned short* KsT = (LAS unsigned short*)lds;
    LAS unsigned short* Vt = (LAS unsigned short*)(lds + 9216);
    LAS float* lf = (LAS float*)(lds + 27648); LAS float* li = lf + 64; LAS float* sw = lf + 128;
    const int tid = threadIdx.x, lane = tid & 63, wid = tid >> 6, r = lane & 15, q = lane >> 4;
    for (int unit = blockIdx.x; unit < 2048; unit += gridDim.x) {
        const int dir = unit >> 10, b = (unit >> 8) & 3, h = (unit >> 6) & 3, n = unit & 63, pc = dir ? 63 - n : n;
        const size_t tok0 = (size_t)b * S_ + pc * 64;
        if (tid < 64) { lf[tid] = LF[(tok0 + tid) * 8 + dir * 4 + h]; li[tid] = LI[(tok0 + tid) * 8 + dir * 4 + h]; }
        __syncthreads();
        if (tid < 64) { float bc = 0.f, tot = 0.f;
            for (int j = 0; j < 64; ++j) { const float x = lf[j]; tot += x; if (dir ? (j >= tid) : (j <= tid)) bc += x; }
            const float we = tot - bc + li[tid]; float mx = we;
#pragma unroll
            for (int o = 32; o; o >>= 1) mx = fmaxf(mx, __shfl_xor(mx, o));
            sw[tid] = __expf(we - mx);
            if (tid == 0) { MS[unit * 32] = tot; MS[unit * 32 + 1] = mx; } }
        __syncthreads();
        { const int pp = tid >> 3, c8 = tid & 7; const u32x4 kv = *(const u32x4*)(Z + (tok0 + pp) * 2560 + 1280 + h * 64 + c8 * 8); float f[8]; unpack8(kv, f); const float s = sw[pp];
#pragma unroll
          for (int j = 0; j < 8; ++j) KsT[(c8 * 8 + j) * 72 + pp] = f2bf(f[j] * s); }
#pragma unroll
        for (int i = 0; i < 2; ++i) { const int pi = tid + NTHR * i, pp = pi >> 4, c8 = pi & 15; const u32x4 v = *(const u32x4*)(Z + (tok0 + pp) * 2560 + 1536 + h * 128 + c8 * 8);
            Vt[(c8 * 8 + 0) * 72 + pp] = (unsigned short)(v.x & 0xffffu); Vt[(c8 * 8 + 1) * 72 + pp] = (unsigned short)(v.x >> 16);
            Vt[(c8 * 8 + 2) * 72 + pp] = (unsigned short)(v.y & 0xffffu); Vt[(c8 * 8 + 3) * 72 + pp] = (unsigned short)(v.y >> 16);
            Vt[(c8 * 8 + 4) * 72 + pp] = (unsigned short)(v.z & 0xffffu); Vt[(c8 * 8 + 5) * 72 + pp] = (unsigned short)(v.z >> 16);
            Vt[(c8 * 8 + 6) * 72 + pp] = (unsigned short)(v.w & 0xffffu); Vt[(c8 * 8 + 7) * 72 + pp] = (unsigned short)(v.w >> 16); }
        __syncthreads();
#pragma unroll
        for (int dt = 0; dt < 4; ++dt) { f32x4 acc = {0.f, 0.f, 0.f, 0.f};
            acc = mma_tile<64>(KsT + dt * 16 * 72, 72, Vt + wid * 16 * 72, 72, acc);
            u32x2 w; w.x = pk2(acc.x, acc.y); w.y = pk2(acc.z, acc.w);
            *(u32x2*)(CT + (size_t)unit * 8192 + (wid * 16 + r) * 64 + dt * 16 + q * 4) = w; }
        if (tid < 64) { float a = 0.f; for (int j = 0; j < 64; ++j) a += bf2f(KsT[tid * 72 + j]); NV[(size_t)unit * 64 + tid] = a; }
        __syncthreads();
    }
}
__device__ __forceinline__ void mlstm_b(const Params& p) {
    const bf16_t* CT = (const bf16_t*)(p.ws + WS_CT); const float* NV = (const float*)(p.ws + WS_NV); float* MS = (float*)(p.ws + WS_MS); bf16_t* CT2 = (bf16_t*)(p.ws + WS_CT2); float* NV2 = (float*)(p.ws + WS_NV2);
    const int tid = threadIdx.x;
    for (int wgi = blockIdx.x; wgi < 128; wgi += gridDim.x) {
        const int scan = wgi >> 2, part = wgi & 3; const size_t e = (size_t)(part * NTHR + tid) * 4;
        const bool nvw = (part == 0 && tid < 64);
        float m = 0.f, c0 = 0.f, c1 = 0.f, c2 = 0.f, c3 = 0.f, nn = 0.f;
#pragma unroll 1
        for (int hf = 0; hf < 4; ++hf) {
        u32x2 dc[16]; float dn[16];
#pragma unroll
        for (int n = 0; n < 16; ++n) { dc[n] = (EXPC == 2) ? (u32x2){0u, 0u} : *(const u32x2*)(CT + (size_t)(scan * 64 + hf * 16 + n) * 8192 + e); dn[n] = nvw ? NV[(size_t)(scan * 64 + hf * 16 + n) * 64 + tid] : 0.f; }
#pragma unroll
        for (int n = 0; n < 16; ++n) { const int unit = scan * 64 + hf * 16 + n;
            const float bl = MS[unit * 32], ml = MS[unit * 32 + 1];
            u32x2 w; w.x = pk2(c0, c1); w.y = pk2(c2, c3); *(u32x2*)(CT2 + (size_t)unit * 8192 + e) = w;
            if (nvw) NV2[(size_t)unit * 64 + tid] = nn;
            if (part == 0 && tid == 0) MS[65536 + unit] = m;
            const float mn = fmaxf(bl + m, ml), a = __expf(bl + m - mn), bb = __expf(ml - mn);
            c0 = a * c0 + bb * bflo(dc[n].x); c1 = a * c1 + bb * bfhi(dc[n].x); c2 = a * c2 + bb * bflo(dc[n].y); c3 = a * c3 + bb * bfhi(dc[n].y);
            nn = a * nn + bb * dn[n]; m = mn; }
        }
    }
}
__device__ __forceinline__ void mlstm_c(LDSp lds, const Params& p) {
    const bf16_t* Z = (const bf16_t*)(p.ws + WS_Z); const float* LI = (const float*)(p.ws + WS_BETA); const float* LF = (const float*)(p.ws + WS_LA);
    const bf16_t* CT = (const bf16_t*)(p.ws + WS_CT2); const float* NV = (const float*)(p.ws + WS_NV2); const float* MS = (const float*)(p.ws + WS_MS);
    bf16_t* Y = (bf16_t*)(p.ws + WS_HN); const float* gn = p.in[19];
    LAS unsigned short* Qb = (LAS unsigned short*)lds;
    LAS unsigned short* Kb = (LAS unsigned short*)(lds + 9216);
    LAS unsigned short* Vt = (LAS unsigned short*)(lds + 18432);
    LAS unsigned short* Cb = (LAS unsigned short*)(lds + 36864);
    LAS unsigned short* Pb = (LAS unsigned short*)(lds + 55296);
    LAS float* lf = (LAS float*)(lds + 64512); LAS float* li = lf + 64; LAS float* bcs = lf + 128; LAS float* mtv = lf + 192; LAS float* iw = lf + 256;
    LAS float* dn = lf + 320; LAS float* nv = lf + 384; LAS float* emt = lf + 448; LAS float* dnp = lf + 512  ; LAS float* ssp = lf + 768  ;
    const int tid = threadIdx.x, lane = tid & 63, wid = tid >> 6, r = lane & 15, q = lane >> 4;
    for (int unit = blockIdx.x; unit < 1024; unit += gridDim.x) {
        const int b = unit >> 8, h = (unit >> 6) & 3, pc = unit & 63; const size_t tok0 = (size_t)b * S_ + pc * 64;
        { const int pp = tid >> 3, c8 = tid & 7;
          *(LAS u32x4*)(Qb + pp * 72 + c8 * 8) = *(const u32x4*)(Z + (tok0 + pp) * 2560 + 1024 + h * 64 + c8 * 8);
          *(LAS u32x4*)(Kb + pp * 72 + c8 * 8) = *(const u32x4*)(Z + (tok0 + pp) * 2560 + 1280 + h * 64 + c8 * 8); }
#pragma unroll
        for (int i = 0; i < 2; ++i) { const int pi = tid + NTHR * i, pp = pi >> 4, c8 = pi & 15; const u32x4 v = *(const u32x4*)(Z + (tok0 + pp) * 2560 + 1536 + h * 128 + c8 * 8);
            Vt[(c8 * 8 + 0) * 72 + pp] = (unsigned short)(v.x & 0xffffu); Vt[(c8 * 8 + 1) * 72 + pp] = (unsigned short)(v.x >> 16);
            Vt[(c8 * 8 + 2) * 72 + pp] = (unsigned short)(v.y & 0xffffu); Vt[(c8 * 8 + 3) * 72 + pp] = (unsigned short)(v.y >> 16);
            Vt[(c8 * 8 + 4) * 72 + pp] = (unsigned short)(v.z & 0xffffu); Vt[(c8 * 8 + 5) * 72 + pp] = (unsigned short)(v.z >> 16);
            Vt[(c8 * 8 + 6) * 72 + pp] = (unsigned short)(v.w & 0xffffu); Vt[(c8 * 8 + 7) * 72 + pp] = (unsigned short)(v.w >> 16); }
        f32x4 hacc[4];
#pragma unroll
        for (int mt = 0; mt < 4; ++mt) hacc[mt] = (f32x4){0.f, 0.f, 0.f, 0.f};
#pragma unroll 1
        for (int dir = 0; dir < 2; ++dir) {
            const int n = dir ? 63 - pc : pc; const size_t u2 = (size_t)(((dir * 4 + b) * 4 + h) * 64 + n);
#pragma unroll
            for (int i = 0; i < 2; ++i) { const int pi = tid + NTHR * i, v = pi >> 3, c8 = pi & 7; *(LAS u32x4*)(Cb + v * 72 + c8 * 8) = (EXPC == 1) ? (u32x4){0u, 0u, 0u, 0u} : *(const u32x4*)(CT + u2 * 8192 + v * 64 + c8 * 8); }
            if (tid < 64) { lf[tid] = LF[(tok0 + tid) * 8 + dir * 4 + h]; li[tid] = LI[(tok0 + tid) * 8 + dir * 4 + h]; nv[tid] = (EXPC == 1) ? 0.f : NV[u2 * 64 + tid]; }
            const float mst = (EXPC == 1) ? 0.f : MS[65536 + u2];
            __syncthreads();
            if (tid < 64) { float bc = 0.f;
                for (int j = 0; j < 64; ++j) { const float x = lf[j]; if (dir ? (j >= tid) : (j <= tid)) bc += x; }
                bcs[tid] = bc; }
            __syncthreads();
            if (tid < 64) { const float bt = bcs[tid]; float dmax = -3.0e38f;
                for (int j = 0; j < 64; ++j) { const float d = bt - bcs[j] + li[j]; if (dir ? (j >= tid) : (j <= tid)) dmax = fmaxf(dmax, d); }
                const float m = fmaxf(bt + mst, dmax), w = __expf(bt + mst - m);
                float qn = 0.f;
                for (int d = 0; d < 64; ++d) qn = fmaf(bf2f(Qb[tid * 72 + d]), nv[d], qn);
                mtv[tid] = m; iw[tid] = w * 0.125f; emt[tid] = __expf(-m); dn[tid] = w * 0.125f * qn; }
            __syncthreads();
#pragma unroll
            for (int tt = 0; tt < 2; ++tt) { const int idx = wid * 2 + tt, mt = idx >> 2, nt = idx & 3;
                f32x4 sc = {0.f, 0.f, 0.f, 0.f};
                sc = mma_tile<64>(Qb + mt * 16 * 72, 72, Kb + nt * 16 * 72, 72, sc);
                const int s = nt * 16 + r; const float bs = bcs[s] - li[s];
#pragma unroll
                for (int i = 0; i < 4; ++i) { const int t = mt * 16 + q * 4 + i; const bool ok = dir ? (s >= t) : (s <= t);
                    const float pv = ok ? __expf(bcs[t] - bs - mtv[t]) * sc[i] * 0.125f : 0.f;
                    const unsigned short pb = f2bf(pv); Pb[t * 72 + s] = pb;
                    const float rs = row16_sum(bf2f(pb));
                    if (r == 0) dnp[nt * 64 + t] = rs; }
            }
            __syncthreads();
#pragma unroll
            for (int mt = 0; mt < 4; ++mt) { f32x4 a1 = {0.f, 0.f, 0.f, 0.f}, a2 = {0.f, 0.f, 0.f, 0.f};
                a1 = mma_tile<64>(Qb + mt * 16 * 72, 72, Cb + wid * 16 * 72, 72, a1);
                a2 = mma_tile<64>(Pb + mt * 16 * 72, 72, Vt + wid * 16 * 72, 72, a2);
#pragma unroll
                for (int i = 0; i < 4; ++i) { const int t = mt * 16 + q * 4 + i;
                    const float den = dn[t] + ((dnp[t] + dnp[64 + t]) + (dnp[128 + t] + dnp[192 + t]));
                    hacc[mt][i] += (iw[t] * a1[i] + a2[i]) / fmaxf(fabsf(den), emt[t]); }
            }
            __syncthreads();
        }
#pragma unroll
        for (int mt = 0; mt < 4; ++mt)
#pragma unroll
            for (int i = 0; i < 4; ++i) { const float s = row16_sum(hacc[mt][i] * hacc[mt][i]); if (r == 0) ssp[wid * 64 + mt * 16 + q * 4 + i] = s; }
        __syncthreads();
        { const int v = wid * 16 + r; const float g = gn[v];
#pragma unroll
          for (int mt = 0; mt < 4; ++mt)
#pragma unroll
              for (int i = 0; i < 4; ++i) { const int t = mt * 16 + q * 4 + i;
                  float ss = 0.f;
#pragma unroll
                  for (int w = 0; w < 8; ++w) ss += ssp[w * 64 + t];
                  const float rstd = rsqrtf(ss * (1.0f / 128.0f) + 1e-6f);
                  const float og = sigm(bf2f(Z[(tok0 + t) * 2560 + 2048 + h * 128 + v]));
                  Y[(tok0 + t) * 1024 + 512 + h * 128 + v] = f2bf(hacc[mt][i] * rstd * g * og); } }
        __syncthreads();
    }
}
__device__ __forceinline__ void headnorm_phase(const Params& p, const float* __restrict__ g, int zld, int zcol, int act) {
    const bf16_t* OF = (const bf16_t*)(p.ws + WS_OF); const bf16_t* OB = (const bf16_t*)(p.ws + WS_OB); const bf16_t* Z = (const bf16_t*)(p.ws + WS_Z); bf16_t* Y = (bf16_t*)(p.ws + WS_HN);
    const int tid = threadIdx.x, lane = tid & 63, wid = tid >> 6, c = lane * 8;
    const f32x4 g0 = *(const f32x4*)(g + (c & 127)), g1 = *(const f32x4*)(g + (c & 127) + 4);
    for (int tok = blockIdx.x * 8 + wid; tok < T_; tok += gridDim.x * 8) {
        const u32x4 a = *(const u32x4*)(OF + (size_t)tok * 512 + c), bq = *(const u32x4*)(OB + (size_t)tok * 512 + c), gz = *(const u32x4*)(Z + (size_t)tok * zld + zcol + c);
        float fa[8], fb[8], fg[8], o[8]; unpack8(a, fa); unpack8(bq, fb); unpack8(gz, fg);
        float ss = 0.f;
#pragma unroll
        for (int i = 0; i < 8; ++i) { o[i] = fa[i] + fb[i]; ss = fmaf(o[i], o[i], ss); }
        ss = row16_sum(ss);
        const float rstd = rsqrtf(ss * (1.0f / 128.0f) + 1e-6f);
        const float gg[8] = {g0.x, g0.y, g0.z, g0.w, g1.x, g1.y, g1.z, g1.w};
        float y[8];
#pragma unroll
        for (int i = 0; i < 8; ++i) y[i] = o[i] * rstd * gg[i] * (act == 0 ? silu_(fg[i]) : sigm(fg[i]));
        u32x4 w; w.x = pk2(y[0], y[1]); w.y = pk2(y[2], y[3]); w.z = pk2(y[4], y[5]); w.w = pk2(y[6], y[7]);
        *(u32x4*)(Y + (size_t)tok * 1024 + 512 + c) = w;
    }
}

__device__ __forceinline__ void odd_prep(const Params& p) {
    const bf16_t* Z = (const bf16_t*)(p.ws + WS_Z); bf16_t* VV = (bf16_t*)(p.ws + WS_QKV);
    const float* gates = (const float*)(p.ws + WS_GATES); float* LI = (float*)(p.ws + WS_BETA); float* LF = (float*)(p.ws + WS_LA);
    const float* ln_g = p.in[13]; const float* ln_b = p.in[14]; const float* ib = p.in[17]; const float* fb = p.in[18];
    const int tid = threadIdx.x, lane = tid & 63, wid = tid >> 6, c = lane * 8;
    const f32x4 g0 = *(const f32x4*)(ln_g + c), g1 = *(const f32x4*)(ln_g + c + 4), b0 = *(const f32x4*)(ln_b + c), b1 = *(const f32x4*)(ln_b + c + 4);
    const float gg[8] = {g0.x, g0.y, g0.z, g0.w, g1.x, g1.y, g1.z, g1.w}, bb[8] = {b0.x, b0.y, b0.z, b0.w, b1.x, b1.y, b1.z, b1.w};
    for (int tok = blockIdx.x * 8 + wid; tok < T_; tok += gridDim.x * 8) {
        const u32x4 v = *(const u32x4*)(Z + (size_t)tok * 2560 + 512 + c);
        float x[8]; unpack8(v, x); float sm = 0.f;
#pragma unroll
        for (int i = 0; i < 8; ++i) { x[i] = gelu_t(x[i]); sm += x[i]; }
        const float mean = wave_sum(sm) * (1.0f / 512.0f); float sq = 0.f;
#pragma unroll
        for (int i = 0; i < 8; ++i) { x[i] -= mean; sq = fmaf(x[i], x[i], sq); }
        const float rstd = rsqrtf(wave_sum(sq) * (1.0f / 512.0f) + 1e-5f);
        float y[8];
#pragma unroll
        for (int i = 0; i < 8; ++i) y[i] = x[i] * rstd * gg[i] + bb[i];
        u32x4 w; w.x = pk2(y[0], y[1]); w.y = pk2(y[2], y[3]); w.z = pk2(y[4], y[5]); w.w = pk2(y[6], y[7]);
        *(u32x4*)(VV + (size_t)tok * 512 + c) = w;
        if (lane < 8) { LI[(size_t)tok * 8 + lane] = gates[(size_t)tok * 16 + lane] + ib[lane];
                        LF[(size_t)tok * 8 + lane] = -softplus_(-(gates[(size_t)tok * 16 + 8 + lane] + fb[lane])); }
    }
}

__device__ __forceinline__ void sg_phase(LDSp lds, const Params& p, int sgId, int sgG) {
    typedef short bf16x8 __attribute__((ext_vector_type(8)));
    const bf16_t* Z = (const bf16_t*)(p.ws + WS_Z); const bf16_t* VV = (const bf16_t*)(p.ws + WS_QKV); bf16_t* Y = (bf16_t*)(p.ws + WS_HN);
    const float* sgw = p.in[15]; const float* sgb = p.in[16];
    LAS unsigned short* Wb = (LAS unsigned short*)lds;
    LAS unsigned short* Vt = (LAS unsigned short*)(lds + 34816);
    const int tid = threadIdx.x, lane = tid & 63, wid = tid >> 6;
    for (int unit = sgId; unit < 512; unit += sgG) {
        const int g = unit & 3, n = (unit >> 2) & 31, b = unit >> 7; const size_t tok0 = (size_t)b * S_ + n * 128;
#pragma unroll
        for (int i = 0; i < 8; ++i) { const int i4 = tid + NTHR * i, t = i4 >> 5, s4 = (i4 & 31) << 2; const f32x4 w = *(const f32x4*)(sgw + (size_t)g * 16384 + t * 128 + s4);
            u32x2 o; o.x = pk2(w.x, w.y); o.y = pk2(w.z, w.w); *(LAS u32x2*)(Wb + t * 136 + s4) = o; }
#pragma unroll
        for (int i = 0; i < 4; ++i) { const int pi = tid + NTHR * i, s = pi >> 4, c8 = (pi & 15) << 3; const u32x4 v = *(const u32x4*)(VV + (tok0 + s) * 512 + g * 128 + c8);
            Vt[(c8 + 0) * 136 + s] = (unsigned short)(v.x & 0xffffu); Vt[(c8 + 1) * 136 + s] = (unsigned short)(v.x >> 16);
            Vt[(c8 + 2) * 136 + s] = (unsigned short)(v.y & 0xffffu); Vt[(c8 + 3) * 136 + s] = (unsigned short)(v.y >> 16);
            Vt[(c8 + 4) * 136 + s] = (unsigned short)(v.z & 0xffffu); Vt[(c8 + 5) * 136 + s] = (unsigned short)(v.z >> 16);
            Vt[(c8 + 6) * 136 + s] = (unsigned short)(v.w & 0xffffu); Vt[(c8 + 7) * 136 + s] = (unsigned short)(v.w >> 16); }
        __syncthreads();
        bf16x8 af[4];
#pragma unroll
        for (int ks = 0; ks < 4; ++ks) af[ks] = *(const LAS bf16x8*)(Wb + (16 * wid + (lane & 15)) * 136 + ks * 32 + (lane >> 4) * 8);
#pragma unroll
        for (int nn = 0; nn < 8; ++nn) {
            f32x4 acc = {0.f, 0.f, 0.f, 0.f};
#pragma unroll
            for (int ks = 0; ks < 4; ++ks) { const bf16x8 bfrag = *(const LAS bf16x8*)(Vt + (16 * nn + (lane & 15)) * 136 + ks * 32 + (lane >> 4) * 8);
                acc = __builtin_amdgcn_mfma_f32_16x16x32_bf16(af[ks], bfrag, acc, 0, 0, 0); }
            const int cc = g * 128 + 16 * nn + (lane & 15);
#pragma unroll
            for (int i = 0; i < 4; ++i) { const int t = 16 * wid + (lane >> 4) * 4 + i; const size_t tok = tok0 + t;
                const float u = gelu_t(bf2f(Z[tok * 2560 + cc]));
                Y[tok * 1024 + cc] = f2bf(u * (acc[i] + sgb[g * 128 + t])); }
        }
        __syncthreads();
    }
}

__device__ __forceinline__ void mlstm_scan(LDSp lds, const Params& p) {
    const bf16_t* Z = (const bf16_t*)(p.ws + WS_Z); const float* LI = (const float*)(p.ws + WS_BETA); const float* LF = (const float*)(p.ws + WS_LA);
    const int tid = threadIdx.x, jl = tid >> 4, sub = tid & 15;
    constexpr int BUF = 20992;
    LAS float* ost = (LAS float*)(lds + 2 * BUF);
    for (int unit = blockIdx.x; unit < 128; unit += gridDim.x) {
        const int dir = unit >> 6, b = (unit >> 4) & 3, h = (unit >> 2) & 3, sl = unit & 3;
        bf16_t* O = (bf16_t*)(p.ws + (dir ? WS_OB : WS_OF));
        float C[4], N[4];
#pragma unroll
        for (int i = 0; i < 4; ++i) { C[i] = 0.f; N[i] = 0.f; }
        u32x4 rq, rk, rv = {0u, 0u, 0u, 0u}; float ri = 0.f, rf = 0.f;
#define ML_TOK(n, s) ((size_t)b * S_ + (dir ? (S_ - 1 - ((n) * 64 + (s))) : ((n) * 64 + (s))))
#define ML_LOAD(n) do { { const int s = tid >> 3, c8 = tid & 7; const size_t tk = ML_TOK(n, s); \
            rq = *(const u32x4*)(Z + tk * 2560 + 1024 + h * 64 + c8 * 8); rk = *(const u32x4*)(Z + tk * 2560 + 1280 + h * 64 + c8 * 8); } \
        if (tid < 256) { const int s = tid >> 2, c8 = tid & 3; rv = *(const u32x4*)(Z + ML_TOK(n, s) * 2560 + 1536 + h * 128 + sl * 32 + c8 * 8); } \
        if (tid < 64) { const size_t tk = ML_TOK(n, tid); ri = expf(LI[tk * 8 + dir * 4 + h]); rf = expf(LF[tk * 8 + dir * 4 + h]); } } while (0)
#define ML_STORE(bufp) do { *(LAS u32x4*)((bufp) + tid * 16) = rq; *(LAS u32x4*)((bufp) + 8192 + tid * 16) = rk; \
        if (tid < 256) *(LAS u32x4*)((bufp) + 16384 + tid * 16) = rv; \
        if (tid < 64) { *(LAS float*)((bufp) + 20480 + tid * 8) = ri; *(LAS float*)((bufp) + 20480 + tid * 8 + 4) = rf; } } while (0)
        ML_LOAD(0); ML_STORE(lds); __syncthreads();
#pragma unroll 1
        for (int n = 0; n < 64; ++n) {
            LDSp cb = lds + (n & 1) * BUF; LDSp nb = lds + ((n + 1) & 1) * BUF; LAS float* os = ost + (n & 1) * 2048;
            if (n < 63) ML_LOAD(n + 1);
#pragma unroll 4
            for (int s = 0; s < 64; ++s) {
                const u32x2 qq = *(const LAS u32x2*)(cb + s * 128 + sub * 8), kk = *(const LAS u32x2*)(cb + 8192 + s * 128 + sub * 8);
                const float vj = bf2f(*(const LAS unsigned short*)(cb + 16384 + s * 64 + jl * 2));
                const float ig = *(const LAS float*)(cb + 20480 + s * 8), fg = *(const LAS float*)(cb + 20480 + s * 8 + 4);
                const float qf[4] = {bflo(qq.x), bfhi(qq.x), bflo(qq.y), bfhi(qq.y)}, kf[4] = {bflo(kk.x), bfhi(kk.x), bflo(kk.y), bfhi(kk.y)};
                const float iv = ig * vj; float num = 0.f, den = 0.f;
#pragma unroll
                for (int i = 0; i < 4; ++i) { C[i] = fmaf(iv, kf[i], fg * C[i]); N[i] = fmaf(ig, kf[i], fg * N[i]); num = fmaf(qf[i], C[i], num); den = fmaf(qf[i], N[i], den); }
                num = row16_sum(num); den = row16_sum(den);
                if (sub == 0) os[s * 32 + jl] = 0.125f * num / fmaxf(fabsf(0.125f * den), 1.0f);
            }
            if (n < 63) ML_STORE(nb);
            __syncthreads();
            { const int s = tid >> 3, j4 = (tid & 7) << 2; const f32x4 o4 = *(const LAS f32x4*)(os + s * 32 + j4);
              u32x2 w; w.x = pk2(o4.x, o4.y); w.y = pk2(o4.z, o4.w);
              *(u32x2*)(O + ML_TOK(n, s) * 512 + h * 128 + sl * 32 + j4) = w; }
        }
        __syncthreads();
#undef ML_LOAD
#undef ML_STORE
#undef ML_TOK
    }
}

#ifndef N_PHASES
#define N_PHASES 21
#endif
template <int L, int SUB> __device__ __forceinline__ void run_phase(LDSp lds, const Params& p) {
    unsigned char* ws = p.ws;
    bf16_t* HN = (bf16_t*)(ws + WS_HN); bf16_t* Zb = (bf16_t*)(ws + WS_Z); float* h = p.out; float* gates = (float*)(ws + WS_GATES);
    const bf16_t* W_IN = (const bf16_t*)(ws + WS_WB + WB_IN); const bf16_t* W_OUT = (const bf16_t*)(ws + WS_WB + WB_OUT);
    const bf16_t* W_UP = (const bf16_t*)(ws + WS_WB + WB_UP); const bf16_t* W_DN = (const bf16_t*)(ws + WS_WB + WB_DN);
    const int G = gridDim.x;
    if constexpr (L == 2) { rms_phase(lds, h, p.in[25], nullptr, nullptr, h, nullptr, 0, 0, nullptr); }
    else if constexpr (SUB == 0) {
        convert_layer(lds, p, L);
        if constexpr (L == 0) rms_phase(lds, p.in[0], p.in[1], HN, h, nullptr, p.in[2], 3088, 3072, gates);
        else                  rms_phase(lds, h, p.in[1] + 1024, HN, nullptr, nullptr, p.in[12], 2576, 2560, gates);
    } else if constexpr (SUB == 1) { constexpr int N = L == 0 ? 3072 : 2560;
        pg8::Gemm g{HN, W_IN, T_, N, 1024}; pg8::StaticOrder S; S.init(T_, N, G, (int)blockIdx.x);
        pg8::EpiBf16<0> E{Zb, N, nullptr, 0, 0};
        pg8::gemm_phase<pg8::EpiBf16<0>, pg8::StaticOrder>(lds, g, S, E, nullptr);
    } else if constexpr (SUB == 2) { if constexpr (L == 0) even_prep(lds, p); else odd_prep(p); }
    else if constexpr (SUB == 9) { delta_prep(lds, p); }
    else if constexpr (SUB == 10) { mlstm_b(p); }
    else if constexpr (SUB == 11) { mlstm_c(lds, p); }
    else if constexpr (SUB == 12) { mlstm_scan(lds, p); }
    else if constexpr (SUB == 3) {
        if constexpr (L == 0) delta_scan2(lds, p);
        else { mlstm_a(lds, p); sg_phase(lds, p, (int)blockIdx.x, G); }
    } else if constexpr (SUB == 4) { if constexpr (L == 0) headnorm_phase(p, p.in[10], 3072, 2560, 0); else headnorm_phase(p, p.in[19], 2560, 2048, 1); }
    else if constexpr (SUB == 5) { pg8::Gemm g{HN, W_OUT, T_, 1024, 1024}; pg8::StaticOrder S; S.init(T_, 1024, G, (int)blockIdx.x);
        pg8::EpiAddF32 E{h, 1024};
        pg8::gemm_phase<pg8::EpiAddF32, pg8::StaticOrder>(lds, g, S, E, nullptr);
    } else if constexpr (SUB == 6) { rms_phase(lds, h, p.in[21] + L * 1024, HN, nullptr, nullptr, nullptr, 0, 0, nullptr); }
    else if constexpr (SUB == 7) { pg8::Gemm g{HN, W_UP, T_, 2 * DFF, 1024}; pg8::StaticOrder S; S.init(T_, 2 * DFF, G, (int)blockIdx.x);
        pg8::EpiSwiGLU E{Zb, DFF};
        pg8::gemm_phase<pg8::EpiSwiGLU, pg8::StaticOrder>(lds, g, S, E, nullptr);
    } else if constexpr (SUB == 8) { pg8::Gemm g{Zb, W_DN, T_, 1024, DFF}; pg8::StaticOrder S; S.init(T_, 1024, G, (int)blockIdx.x);
        pg8::EpiAddF32 E{h, 1024};
        pg8::gemm_phase<pg8::EpiAddF32, pg8::StaticOrder>(lds, g, S, E, nullptr);
    }
}
__global__ void __launch_bounds__(NTHR, 2) mega(Params p, int ph_lo, int ph_hi) {
    extern __shared__ __attribute__((aligned(16))) unsigned char lds_raw[];
    LDSp lds = (LDSp)lds_raw;
    cg::grid_group grid = cg::this_grid();
#ifndef REP_MASK
#define REP_MASK 0
#endif
#define PH(k, L, SUB) if (ph_lo <= (k) && (k) < ph_hi) { run_phase<L, SUB>(lds, p); if ((REP_MASK >> (k)) & 1) { __syncthreads(); run_phase<L, SUB>(lds, p); } if ((k) + 1 < ph_hi) grid.sync(); }
    PH(0, 0, 0) PH(1, 0, 1) PH(2, 0, 2) PH(3, 0, 9) PH(4, 0, 3) PH(5, 0, 4) PH(6, 0, 5) PH(7, 0, 6) PH(8, 0, 7) PH(9, 0, 8)
    PH(10, 1, 0) PH(11, 1, 1) PH(12, 1, 2) PH(13, 1, 3) PH(14, 1, 10) PH(15, 1, 11)
#ifdef EXP_OLD
    { run_phase<1, 12>(lds, p); grid.sync(); run_phase<1, 4>(lds, p); grid.sync(); }
#endif
    PH(16, 1, 5) PH(17, 1, 6) PH(18, 1, 7) PH(19, 1, 8)
    PH(20, 2, 0)
#undef PH
}

extern "C" void kernel_launch(void* const* d_in, const int* in_sizes, int n_in, void* d_out, int out_size, void* d_ws, size_t ws_size, hipStream_t stream) {
    static int grid = 0;
    if (grid == 0) {
        int dev = 0, cus = 0, per_cu = 0;
        (void)hipGetDevice(&dev);
        (void)hipDeviceGetAttribute(&cus, hipDeviceAttributeMultiprocessorCount, dev);
        (void)hipFuncSetAttribute((const void*)mega, hipFuncAttributeMaxDynamicSharedMemorySize, LDS_BYTES);
        if (hipOccupancyMaxActiveBlocksPerMultiprocessor(&per_cu, (const void*)mega, NTHR, LDS_BYTES) != hipSuccess || per_cu < 1) per_cu = 1;
        (void)hipGetLastError();
        if (cus <= 0) cus = 256;
        grid = cus * per_cu;
    }
    if (ws_size < 237 * MiB) { fprintf(stderr, "workspace too small: %zu\n", ws_size); return; }
    Params p{};
    for (int i = 0; i < 26; ++i) p.in[i] = (const float*)d_in[i];
    p.out = (float*)d_out; p.ws = (unsigned char*)d_ws;
#if defined(MULTI_LAUNCH)
    for (int ph = 0; ph < N_PHASES; ++ph) hipLaunchKernelGGL(mega, dim3(grid), dim3(NTHR), LDS_BYTES, stream, p, ph, ph + 1);
#else
    int lo = 0, hi = N_PHASES;
    void* args[] = {(void*)&p, (void*)&lo, (void*)&hi};
    hipError_t e = hipLaunchCooperativeKernel((const void*)mega, dim3(grid), dim3(NTHR), args, LDS_BYTES, stream);
    if (e != hipSuccess) fprintf(stderr, "cooperative launch failed: %s (grid %d)\n", hipGetErrorString(e), grid);
#endif
}
```

```cpp
#include <hip/hip_runtime.h>
#include <hip/hip_cooperative_groups.h>
#include <cstdio>
namespace cg = cooperative_groups;
namespace pg8 {
#define PG8_LAS __attribute__((address_space(3)))
typedef unsigned short bf16_t;
typedef short bf16x8 __attribute__((ext_vector_type(8)));
typedef float f32x4 __attribute__((ext_vector_type(4)));
typedef unsigned u32x4 __attribute__((ext_vector_type(4)));
constexpr int BM = 256, BK = 64, HALF = 128, HTB = HALF * BK * 2  , STAGE_BYTES = 8 * HTB, NXCD = 8, WGM = 8;

__host__ __device__ __forceinline__ int lds_byte(int r, int c) { const int st = (r >> 4) * 2 + (c >> 5), rr = r & 15, cc = c & 31, ob = rr * 64 + cc * 2; return st * 1024 + (ob ^ (((ob >> 9) & 1) << 5)); }
__host__ __device__ __forceinline__ void stage_rc(int b, int& R, int& C) { const int st = b / 1024, sb = b % 1024, swz = sb ^ (((sb >> 9) & 1) << 5); R = (st >> 1) * 16 + swz / 64; C = (st & 1) * 32 + (swz % 64) / 2; }
__host__ __device__ __forceinline__ int perm32(int rho) { const int n = rho >> 4, i = rho & 15; return 8 * (i >> 2) + 4 * n + (i & 3); }

struct Unit { int pm, pn; };
struct Gemm { const bf16_t* A; const bf16_t* Bt; int M, N, K; };

struct StaticOrder {
    int nM, nN, nwg, G, c;
    __host__ __device__ void init(int M, int N, int G_, int c_) { nM = M / BM; nN = N / BM; nwg = nM * nN; G = G_; c = c_; }
    __host__ __device__ bool next(int i, Unit& u) const {
        const long L = (long)i * G + c; if (L >= nwg) return false;
        int wgid = (int)L; { const int q = nwg / NXCD, r = nwg % NXCD, xcd = wgid % NXCD, off = wgid / NXCD; wgid = (xcd < r ? xcd * (q + 1) : r * (q + 1) + (xcd - r) * q) + off; }
        const int nig = WGM * nN, gid = wgid / nig, fm = gid * WGM, gsz = (nM - fm) < WGM ? (nM - fm) : WGM;
        u.pm = fm + ((wgid % nig) % gsz); u.pn = (wgid % nig) / gsz; return true;
    }
    __device__ __forceinline__ void a_ready(const Unit&) const {}
    __device__ __forceinline__ void done(const Unit&) const {}
};
__device__ __forceinline__ unsigned cvt_pk_bf16(float lo, float hi) { unsigned r; asm volatile("v_cvt_pk_bf16_f32 %0, %1, %2" : "=v"(r) : "v"(lo), "v"(hi)); return r; }
typedef float f32x2 __attribute__((ext_vector_type(2)));
__device__ __forceinline__ f32x2 gelu_pk(f32x2 v) {
    const f32x2 av = __builtin_elementwise_abs(v), d = av * 0.2316418882f + 1.0f;
    f32x2 t; t.x = __builtin_amdgcn_rcpf(d.x); t.y = __builtin_amdgcn_rcpf(d.y);
    f32x2 q = t * 0.5307027145f + (-0.7265760135f); q = q * t + 0.7107068705f; q = q * t + (-0.142248368f); q = q * t + 0.127414796f; q = q * t;
    const f32x2 s = (v * v) * (-0.72134752044f);
    f32x2 e; e.x = __builtin_amdgcn_exp2f(s.x); e.y = __builtin_amdgcn_exp2f(s.y);
    const f32x2 m = v * (q * e), r = v - m;
    f32x2 o; o.x = v.x < 0.f ? m.x : r.x; o.y = v.y < 0.f ? m.y : r.y; return o;
}
template <int ACT  > struct EpiBf16 {
    static constexpr bool PERM = true, AFTER_DRAIN = false;
    bf16_t* O; int ldc; const float* bias; int split_cols; size_t split_stride;
    __device__ __forceinline__ void operator()(const f32x4 (&acc)[2][2][4][2], const Unit& u, int wr, int wc, int fr, int fq) const {
        const int row0 = u.pm * BM + wr * 64 + fr; int colt = u.pn * BM; bf16_t* base = O;
        if (split_cols) { const int t = colt / split_cols; base += (size_t)t * split_stride; colt -= t * split_cols; }
        const int col0 = colt + wc * 32 + 8 * fq, bcol0 = u.pn * BM + wc * 32 + 8 * fq;
        f32x4 bv[2][2];
#pragma unroll
        for (int bj = 0; bj < 2; ++bj)
#pragma unroll
            for (int n = 0; n < 2; ++n) bv[bj][n] = bias ? *(const f32x4*)(bias + bcol0 + bj * HALF + 4 * n) : (f32x4){0.f, 0.f, 0.f, 0.f};
#pragma unroll
        for (int ai = 0; ai < 2; ++ai)
#pragma unroll
            for (int m = 0; m < 4; ++m) { bf16_t* rowp = base + (size_t)(row0 + ai * HALF + m * 16) * ldc + col0;
#pragma unroll
                for (int bj = 0; bj < 2; ++bj) { f32x4 v0 = acc[ai][bj][m][0] + bv[bj][0], v1 = acc[ai][bj][m][1] + bv[bj][1];
                    if (ACT == 1) { f32x2 a = gelu_pk((f32x2){v0[0], v0[1]}), b = gelu_pk((f32x2){v0[2], v0[3]}), c = gelu_pk((f32x2){v1[0], v1[1]}), d = gelu_pk((f32x2){v1[2], v1[3]});
                        v0 = (f32x4){a.x, a.y, b.x, b.y}; v1 = (f32x4){c.x, c.y, d.x, d.y}; }
                    if (ACT == 2) {
#pragma unroll
                        for (int j = 0; j < 4; ++j) { v0[j] = 0.5f * v0[j] * (1.0f + erff(v0[j] * 0.70710678f)); v1[j] = 0.5f * v1[j] * (1.0f + erff(v1[j] * 0.70710678f)); } }
                    u32x4 w; w.x = cvt_pk_bf16(v0[0], v0[1]); w.y = cvt_pk_bf16(v0[2], v0[3]); w.z = cvt_pk_bf16(v1[0], v1[1]); w.w = cvt_pk_bf16(v1[2], v1[3]);
                    *(u32x4*)(rowp + bj * HALF) = w; } }
    }
};
struct EpiAddF32 {
    static constexpr bool PERM = false, AFTER_DRAIN = false;
    float* C; int ldc;
    __device__ __forceinline__ void operator()(const f32x4 (&acc)[2][2][4][2], const Unit& u, int wr, int wc, int fr, int fq) const {
        const int row0 = u.pm * BM + wr * 64 + fr, col0 = u.pn * BM + wc * 32 + 4 * fq;
#pragma unroll
        for (int ai = 0; ai < 2; ++ai)
#pragma unroll
            for (int m = 0; m < 4; ++m) { float* rowp = C + (size_t)(row0 + ai * HALF + m * 16) * ldc + col0;
#pragma unroll
                for (int bj = 0; bj < 2; ++bj)
#pragma unroll
                    for (int n = 0; n < 2; ++n) { f32x4* q = (f32x4*)(rowp + bj * HALF + n * 16); const f32x4 o = *q; *q = o + acc[ai][bj][m][n]; } }
    }
};
struct EpiSwiGLU {
    static constexpr bool PERM = true, AFTER_DRAIN = false;
    bf16_t* H; int ldh;
    __device__ __forceinline__ void operator()(const f32x4 (&acc)[2][2][4][2], const Unit& u, int wr, int wc, int fr, int fq) const {
        typedef unsigned u32x2 __attribute__((ext_vector_type(2)));
        const int row0 = u.pm * BM + wr * 64 + fr;
#pragma unroll
        for (int ai = 0; ai < 2; ++ai)
#pragma unroll
            for (int m = 0; m < 4; ++m) { bf16_t* rowp = H + (size_t)(row0 + ai * HALF + m * 16) * ldh;
#pragma unroll
                for (int bj = 0; bj < 2; ++bj) { const int hcol = ((u.pn * BM + bj * HALF + wc * 32) >> 1) + 4 * fq;
                    const f32x4 a = acc[ai][bj][m][0], b = acc[ai][bj][m][1]; float h[4];
#pragma unroll
                    for (int j = 0; j < 4; ++j) h[j] = a[j] / (1.0f + __expf(-a[j])) * b[j];
                    u32x2 w; w.x = cvt_pk_bf16(h[0], h[1]); w.y = cvt_pk_bf16(h[2], h[3]);
                    *(u32x2*)(rowp + hcol) = w; } }
    }
};
template <class Epi, class Sched, bool STAMP = false>
__device__ __forceinline__ void gemm_phase(PG8_LAS unsigned char* lds, const Gemm g, const Sched& S, const Epi& E, unsigned long long* stamps) {
    const int tid = threadIdx.x, wid = __builtin_amdgcn_readfirstlane(tid >> 6), lane = tid & 63, wr = wid >> 2, wc = wid & 3, fr = lane & 15, fq = lane >> 4;
    const int K = g.K, nt = K / BK;
    int ts_lo = 0, ts_hi = 0, nts = 0; const unsigned long long rt_entry = STAMP ? (unsigned long long)wall_clock64() : 0ull;
#define PG8_STAMP() do { if (STAMP && wid == 0 && nts < 64) { const unsigned long long _c = (unsigned long long)clock64(); \
        ts_lo = (lane == nts) ? (int)(unsigned)_c : ts_lo; ts_hi = (lane == nts) ? (int)(unsigned)(_c >> 32) : ts_hi; ++nts; } } while (0)
    PG8_STAMP();
    unsigned voffA[2], voffB[2];
#pragma unroll
    for (int i = 0; i < 2; ++i) { int R, C; stage_rc(tid * 16 + i * 8192, R, C); const int Rb = Epi::PERM ? ((R & ~31) + perm32(R & 31)) : R;
        voffA[i] = (unsigned)(R * K + C) * 2u; voffB[i] = (unsigned)(Rb * K + C) * 2u; }
    const size_t kstep = (size_t)(BK * 2);
    const size_t hstep = (size_t)HALF * K * 2;
    const size_t tstep = 2 * hstep;
    const unsigned ldsw = (unsigned)wid * 1024u;
    const int aoff = lds_byte(wr * 64 + fr, fq * 8), boff = lds_byte(wc * 32 + fr, fq * 8);
#define PG8_SA(b, h) (((b) * 2 + (h)) * HTB)
#define PG8_SB(b, h) ((4 + (b) * 2 + (h)) * HTB)
#define PG8_STAGE(bufoff, gbase, voff) do { _Pragma("unroll") for (int _i = 0; _i < 2; ++_i) \
        __builtin_amdgcn_global_load_lds((const unsigned*)((const char*)(gbase) + (voff)[_i]), (PG8_LAS unsigned*)(lds + (bufoff) + ldsw + _i * 8192), 16, 0, 0); } while (0)
#define PG8_LDA(dst, b, h) do { _Pragma("unroll") for (int m = 0; m < 4; ++m) _Pragma("unroll") for (int k = 0; k < 2; ++k) dst[m][k] = *(const PG8_LAS bf16x8*)(lds + PG8_SA(b, h) + aoff + m * 2048 + k * 1024); } while (0)
#define PG8_LDB(dst, b, h) do { _Pragma("unroll") for (int n = 0; n < 2; ++n) _Pragma("unroll") for (int k = 0; k < 2; ++k) dst[n][k] = *(const PG8_LAS bf16x8*)(lds + PG8_SB(b, h) + boff + n * 2048 + k * 1024); } while (0)
#define PG8_MMA(ai, bj, At, Bt) do { __builtin_amdgcn_s_setprio(1); _Pragma("unroll") for (int m = 0; m < 4; ++m) _Pragma("unroll") for (int n = 0; n < 2; ++n) _Pragma("unroll") for (int k = 0; k < 2; ++k) \
        acc[ai][bj][m][n] = __builtin_amdgcn_mfma_f32_16x16x32_bf16(Bt[n][k], At[m][k], acc[ai][bj][m][n], 0, 0, 0); __builtin_amdgcn_s_setprio(0); } while (0)
#define PG8_WAIT_V(n) asm volatile("s_waitcnt vmcnt(" #n ")" ::: "memory")
#define PG8_WAIT_L(n) asm volatile("s_waitcnt lgkmcnt(" #n ")" ::: "memory")
#define PG8_BAR __builtin_amdgcn_s_barrier()
#define PG8_SCHED __builtin_amdgcn_sched_barrier(0)
    Unit cur, nxt; int ui = 0;
    if (!S.next(0, cur)) return;
    f32x4 acc[2][2][4][2];
#pragma unroll
    for (int a = 0; a < 2; ++a)
#pragma unroll
        for (int b = 0; b < 2; ++b)
#pragma unroll
            for (int m = 0; m < 4; ++m)
#pragma unroll
                for (int n = 0; n < 2; ++n) acc[a][b][m][n] = (f32x4){0.f, 0.f, 0.f, 0.f};
    bf16x8 At[4][2], B0[2][2], B1[2][2];
    const char* cA = (const char*)g.A + (size_t)cur.pm * tstep; const char* cB = (const char*)g.Bt + (size_t)cur.pn * tstep;
    S.a_ready(cur);
    PG8_STAGE(PG8_SB(0, 0), cB, voffB); PG8_STAGE(PG8_SA(0, 0), cA, voffA); PG8_STAGE(PG8_SB(0, 1), cB + hstep, voffB); PG8_STAGE(PG8_SA(0, 1), cA + hstep, voffA);
    if (wr == 1) PG8_BAR;
    PG8_WAIT_V(4); PG8_BAR;
    PG8_STAGE(PG8_SB(1, 0), cB + kstep, voffB); PG8_STAGE(PG8_SA(1, 0), cA + kstep, voffA); PG8_STAGE(PG8_SB(1, 1), cB + hstep + kstep, voffB);
    PG8_WAIT_V(6); PG8_BAR;
    PG8_STAMP();
    for (;;) {
        const bool has_next = S.next(ui + 1, nxt);
        const char* nA = has_next ? (const char*)g.A + (size_t)nxt.pm * tstep : cA; const char* nB = has_next ? (const char*)g.Bt + (size_t)nxt.pn * tstep : cB;
        for (int t = 0; t < nt; t += 2) {
            const bool last = (t == nt - 2);
            const char* a1 = cA + (size_t)(t + 1) * kstep;
            const char* a2 = last ? nA : cA + (size_t)(t + 2) * kstep; const char* b2 = last ? nB : cB + (size_t)(t + 2) * kstep;
            const char* a3 = a2 + kstep; const char* b3 = b2 + kstep;
            if (last && has_next) S.a_ready(nxt);
            PG8_LDB(B0, 0, 0); PG8_SCHED; PG8_LDA(At, 0, 0); PG8_STAGE(PG8_SA(1, 1), a1 + hstep, voffA);
            PG8_WAIT_L(8); PG8_BAR; PG8_WAIT_L(0); PG8_MMA(0, 0, At, B0); PG8_BAR; PG8_SCHED;
            PG8_LDB(B1, 0, 1); PG8_STAGE(PG8_SB(0, 0), b2, voffB);
            PG8_BAR; PG8_WAIT_L(0); PG8_MMA(0, 1, At, B1); PG8_BAR;
            PG8_LDA(At, 0, 1); PG8_STAGE(PG8_SA(0, 0), a2, voffA);
            PG8_BAR; PG8_WAIT_L(0); PG8_MMA(1, 0, At, B0); PG8_BAR; PG8_SCHED;
            PG8_STAGE(PG8_SB(0, 1), b2 + hstep, voffB);
            PG8_WAIT_V(6); PG8_BAR; PG8_MMA(1, 1, At, B1); PG8_BAR;
            PG8_LDB(B0, 1, 0); PG8_SCHED; PG8_LDA(At, 1, 0); PG8_STAGE(PG8_SA(0, 1), a2 + hstep, voffA);
            PG8_WAIT_L(8); PG8_BAR; PG8_WAIT_L(0); PG8_MMA(0, 0, At, B0); PG8_BAR; PG8_SCHED;
            PG8_LDB(B1, 1, 1); PG8_STAGE(PG8_SB(1, 0), b3, voffB);
            PG8_BAR; PG8_WAIT_L(0); PG8_MMA(0, 1, At, B1); PG8_BAR;
            PG8_LDA(At, 1, 1); PG8_STAGE(PG8_SA(1, 0), a3, voffA);
            PG8_BAR; PG8_WAIT_L(0); PG8_MMA(1, 0, At, B0); PG8_BAR; PG8_SCHED;
            PG8_STAGE(PG8_SB(1, 1), b3 + hstep, voffB);
            PG8_WAIT_V(6); PG8_BAR; PG8_MMA(1, 1, At, B1); PG8_BAR;
        }
        PG8_STAMP();
        if constexpr (!Epi::AFTER_DRAIN) { E(acc, cur, wr, wc, fr, fq); S.done(cur); }
        PG8_STAMP();
        if (!has_next) break;
#pragma unroll
        for (int a = 0; a < 2; ++a)
#pragma unroll
            for (int b = 0; b < 2; ++b)
#pragma unroll
                for (int m = 0; m < 4; ++m)
#pragma unroll
                    for (int n = 0; n < 2; ++n) acc[a][b][m][n] = (f32x4){0.f, 0.f, 0.f, 0.f};
        cur = nxt; cA = nA; cB = nB; ++ui;
    }
    PG8_WAIT_V(0);
    if (wr == 0) PG8_BAR;
    PG8_BAR;
    if constexpr (Epi::AFTER_DRAIN) { E.fused(acc, cur, wr, wc, fr, fq, lds, wid, lane); S.done(cur); }
    PG8_STAMP();
    if (STAMP && wid == 0) { stamps[lane] = lane < nts ? (((unsigned long long)(unsigned)ts_hi << 32) | (unsigned)ts_lo) : 0ull;
        if (lane == 62) stamps[62] = rt_entry; if (lane == 63) stamps[63] = (unsigned long long)wall_clock64(); }
#undef PG8_STAMP
#undef PG8_SA
#undef PG8_SB
#undef PG8_STAGE
#undef PG8_LDA
#undef PG8_LDB
#undef PG8_MMA
#undef PG8_WAIT_V
#undef PG8_WAIT_L
#undef PG8_BAR
#undef PG8_SCHED
}
}
#define LAS __attribute__((address_space(3)))
typedef LAS unsigned char* LDSp;
typedef pg8::bf16_t bf16_t;
typedef unsigned u32x4 __attribute__((ext_vector_type(4)));
typedef unsigned u32x2 __attribute__((ext_vector_type(2)));
typedef float f32x4 __attribute__((ext_vector_type(4)));
typedef float f32x2 __attribute__((ext_vector_type(2)));

#ifndef EXPC
#define EXPC 0
#endif
#ifndef EVP_SKIP
#define EVP_SKIP 0
#endif
constexpr int T_ = 16384, D_ = 1024, S_ = 4096, NTHR = 512;
constexpr int LDS_BYTES = 147456;
constexpr size_t MiB = 1048576;
constexpr size_t WS_WB = 0, WS_HN = 25 * MiB, WS_Z = 57 * MiB, WS_QKV = 153 * MiB, WS_OF = 201 * MiB, WS_OB = 217 * MiB,
                 WS_GATES = 233 * MiB, WS_BETA = 234 * MiB, WS_LA = 234 * MiB + 524288;
constexpr size_t WB_IN = 0, WB_OUT = 6291456, WB_UP = 8388608, WB_DN = 19922944;
constexpr int DFF = 2816;

struct Params { const float* in[26]; float* out; unsigned char* ws; };

__device__ __forceinline__ float bf2f(unsigned short b) { return __uint_as_float(((unsigned)b) << 16); }
__device__ __forceinline__ float bflo(unsigned u) { return __uint_as_float(u << 16); }
__device__ __forceinline__ float bfhi(unsigned u) { return __uint_as_float(u & 0xffff0000u); }
__device__ __forceinline__ unsigned short f2bf(float f) { unsigned u = __float_as_uint(f); u += 0x7FFFu + ((u >> 16) & 1u); return (unsigned short)(u >> 16); }
typedef __bf16 bf16x2_v __attribute__((ext_vector_type(2)));
__device__ __forceinline__ unsigned pk2(float lo, float hi) { const f32x2 v = {lo, hi}; const bf16x2_v b = __builtin_convertvector(v, bf16x2_v); return __builtin_bit_cast(unsigned, b); }
__device__ __forceinline__ float sigm(float x) { return 1.0f / (1.0f + __expf(-x)); }
__device__ __forceinline__ float silu_(float x) { return x * sigm(x); }
__device__ __forceinline__ float gelu_t(float x) { const float u = 0.7978845608028654f * (x + 0.044715f * x * x * x); const float t = 1.0f - 2.0f / (1.0f + __expf(2.0f * u)); return 0.5f * x * (1.0f + t); }
__device__ __forceinline__ float softplus_(float x) { return x > 20.0f ? x : log1pf(expf(x)); }
__device__ __forceinline__ float wave_sum(float v) {
#pragma unroll
    for (int o = 32; o; o >>= 1) v += __shfl_xor(v, o);
    return v; }
template <int CTRL> __device__ __forceinline__ float dppf(float v) { return __int_as_float(__builtin_amdgcn_update_dpp(0, __float_as_int(v), CTRL, 0xf, 0xf, true)); }
__device__ __forceinline__ float row16_sum(float v) { v += dppf<0xB1>(v); v += dppf<0x4E>(v); v += dppf<0x141>(v); v += dppf<0x140>(v); return v; }
__device__ __forceinline__ void unpack8(const u32x4 w, float (&f)[8]) { f[0] = bflo(w.x); f[1] = bfhi(w.x); f[2] = bflo(w.y); f[3] = bfhi(w.y); f[4] = bflo(w.z); f[5] = bfhi(w.z); f[6] = bflo(w.w); f[7] = bfhi(w.w); }

__device__ __forceinline__ void conv_job(LDSp lds, const float* __restrict__ src, int ldn, int K, int col0, int ncols, bf16_t* __restrict__ dst, int mode, int off) {
    LAS float* tl = (LAS float*)lds;
    const int tid = threadIdx.x, nnt = ncols >> 6, ntl = (K >> 6) * nnt;
    for (int tile = blockIdx.x; tile < ntl; tile += gridDim.x) {
        const int kt = tile / nnt, nt = tile - kt * nnt;
        const int r = tid >> 4, c4 = (tid & 15) << 2;
#pragma unroll
        for (int i = 0; i < 2; ++i) { const int k = r + 32 * i; const f32x4 v = *(const f32x4*)(src + (size_t)(kt * 64 + k) * ldn + col0 + nt * 64 + c4);
            tl[k * 65 + c4 + 0] = v.x; tl[k * 65 + c4 + 1] = v.y; tl[k * 65 + c4 + 2] = v.z; tl[k * 65 + c4 + 3] = v.w; }
        __syncthreads();
        const int n = tid >> 3, k8 = (tid & 7) << 3; float f[8];
#pragma unroll
        for (int j = 0; j < 8; ++j) f[j] = tl[(k8 + j) * 65 + n];
        u32x4 w; w.x = pk2(f[0], f[1]); w.y = pk2(f[2], f[3]); w.z = pk2(f[4], f[5]); w.w = pk2(f[6], f[7]);
        const int ncol = nt * 64 + n;
        const int row = mode == 0 ? off + ncol : ((ncol >> 4) << 5) + (((ncol >> 2) & 3) << 3) + (ncol & 3) + off;
        *(u32x4*)(dst + (size_t)row * K + kt * 64 + k8) = w;
        __syncthreads();
    }
}
__device__ __forceinline__ void convert_layer(LDSp lds, const Params& p, int L) {
    bf16_t* wb = (bf16_t*)(p.ws + WS_WB);
    if (L == 0) { conv_job(lds, p.in[2], 3088, 1024, 0, 3072, (bf16_t*)((char*)wb + WB_IN), 0, 0);
                  conv_job(lds, p.in[11], 1024, 1024, 0, 1024, (bf16_t*)((char*)wb + WB_OUT), 0, 0); }
    else        { conv_job(lds, p.in[12], 2576, 1024, 0, 2560, (bf16_t*)((char*)wb + WB_IN), 0, 0);
                  conv_job(lds, p.in[20], 1024, 1024, 0, 1024, (bf16_t*)((char*)wb + WB_OUT), 0, 0); }
    conv_job(lds, p.in[22] + (size_t)L * 1024 * DFF, DFF, 1024, 0, DFF, (bf16_t*)((char*)wb + WB_UP), 1, 0);
    conv_job(lds, p.in[23] + (size_t)L * 1024 * DFF, DFF, 1024, 0, DFF, (bf16_t*)((char*)wb + WB_UP), 1, 4);
    conv_job(lds, p.in[24] + (size_t)L * DFF * 1024, 1024, DFF, 0, 1024, (bf16_t*)((char*)wb + WB_DN), 0, 0);
}

__device__ __forceinline__ void rms_phase(LDSp lds, const float* src, const float* __restrict__ g, bf16_t* hn, float* copy_out, float* final_out,
                                          const float* __restrict__ gw, int gw_ld, int gw_col0, float* gates) {
    LAS float* wg = (LAS float*)lds;
    const int tid = threadIdx.x, lane = tid & 63, wid = tid >> 6;
    if (gw) { for (int idx = tid; idx < 16384; idx += NTHR) { const int k = idx >> 4, j = idx & 15; wg[j * 1024 + k] = gw[(size_t)k * gw_ld + gw_col0 + j]; } __syncthreads(); }
    f32x4 gv[4];
#pragma unroll
    for (int i = 0; i < 4; ++i) gv[i] = *(const f32x4*)(g + 4 * lane + 256 * i);
    for (int row = blockIdx.x * 8 + wid; row < T_; row += gridDim.x * 8) {
        const float* xr = src + (size_t)row * D_;
        f32x4 x[4]; float ss = 0.f;
#pragma unroll
        for (int i = 0; i < 4; ++i) { x[i] = *(const f32x4*)(xr + 4 * lane + 256 * i); ss += x[i].x * x[i].x + x[i].y * x[i].y + x[i].z * x[i].z + x[i].w * x[i].w; }
        if (copy_out) {
#pragma unroll
            for (int i = 0; i < 4; ++i) *(f32x4*)(copy_out + (size_t)row * D_ + 4 * lane + 256 * i) = x[i]; }
        ss = wave_sum(ss);
        const float rstd = rsqrtf(ss * (1.0f / 1024.0f) + 1e-6f);
        f32x4 y[4];
#pragma unroll
        for (int i = 0; i < 4; ++i) y[i] = x[i] * rstd * gv[i];
        if (final_out) {
#pragma unroll
            for (int i = 0; i < 4; ++i) *(f32x4*)(final_out + (size_t)row * D_ + 4 * lane + 256 * i) = y[i];
        } else {
#pragma unroll
            for (int i = 0; i < 4; ++i) { u32x2 w; w.x = pk2(y[i].x, y[i].y); w.y = pk2(y[i].z, y[i].w); *(u32x2*)(hn + (size_t)row * D_ + 4 * lane + 256 * i) = w; }
        }
        if (gw) {
            float s[16];
#pragma unroll
            for (int j = 0; j < 16; ++j) { float a = 0.f;
#pragma unroll
                for (int i = 0; i < 4; ++i) { const f32x4 w = *(const LAS f32x4*)(wg + j * 1024 + 4 * lane + 256 * i); a += y[i].x * w.x + y[i].y * w.y + y[i].z * w.z + y[i].w * w.w; }
                s[j] = wave_sum(a); }
            if (lane == 0) {
#pragma unroll
                for (int q = 0; q < 4; ++q) *(f32x4*)(gates + (size_t)row * 16 + 4 * q) = (f32x4){s[4 * q], s[4 * q + 1], s[4 * q + 2], s[4 * q + 3]}; }
        }
    }
    __syncthreads();
}

__device__ __forceinline__ void even_prep(LDSp lds, const Params& p) {
    const bf16_t* Z = (const bf16_t*)(p.ws + WS_Z); bf16_t* Y = (bf16_t*)(p.ws + WS_HN); bf16_t* QKVN = (bf16_t*)(p.ws + WS_QKV);
    const float* gates = (const float*)(p.ws + WS_GATES); float* BETA = (float*)(p.ws + WS_BETA); float* LA = (float*)(p.ws + WS_LA);
    const float* conv_w = p.in[3]; const float* conv_b = p.in[4]; const float* ln_g = p.in[5]; const float* ln_b = p.in[6];
    const float* dn_w = p.in[7]; const float* a_log = p.in[8]; const float* dt_bias = p.in[9];
    LAS float* glu = (LAS float*)lds;
    const int tid = threadIdx.x, lane = tid & 63, wid = tid >> 6, c = tid;
    for (int tile = blockIdx.x; tile < T_ / 32; tile += gridDim.x) {
        const int t0 = tile * 32, b = t0 >> 12, s0 = t0 & 4095;
#if !(EVP_SKIP & 1)
        for (int it = tid; it < 62 * 64; it += NTHR) { const int r = it >> 6, c8 = (it & 63) << 3, sp = s0 - 15 + r;
            f32x4 o0 = {0.f, 0.f, 0.f, 0.f}, o1 = {0.f, 0.f, 0.f, 0.f};
            if (sp >= 0 && sp < S_) { const size_t tok = (size_t)b * S_ + sp; const u32x4 av = *(const u32x4*)(Z + tok * 3072 + c8); const u32x4 gv = *(const u32x4*)(Z + tok * 3072 + 512 + c8);
                float a[8], g[8]; unpack8(av, a); unpack8(gv, g);
                o0 = (f32x4){a[0] * sigm(g[0]), a[1] * sigm(g[1]), a[2] * sigm(g[2]), a[3] * sigm(g[3])}; o1 = (f32x4){a[4] * sigm(g[4]), a[5] * sigm(g[5]), a[6] * sigm(g[6]), a[7] * sigm(g[7])}; }
            *(LAS f32x4*)(glu + r * 512 + c8) = o0; *(LAS f32x4*)(glu + r * 512 + c8 + 4) = o1; }
        __syncthreads();
        {
            float cw[31];
#pragma unroll
            for (int w = 0; w < 31; ++w) cw[w] = conv_w[w * 512 + c];
            const float cb = conv_b[c];
            f32x4 res[8];
#pragma unroll
            for (int t4 = 0; t4 < 8; ++t4) {
                float x[34];
#pragma unroll
                for (int i = 0; i < 34; ++i) x[i] = glu[(t4 * 4 + i) * 512 + c];
                float a0 = cb, a1 = cb, a2 = cb, a3 = cb;
#pragma unroll
                for (int w = 0; w < 31; ++w) { a0 = fmaf(x[w], cw[w], a0); a1 = fmaf(x[w + 1], cw[w], a1); a2 = fmaf(x[w + 2], cw[w], a2); a3 = fmaf(x[w + 3], cw[w], a3); }
                res[t4] = (f32x4){a0, a1, a2, a3};
            }
            __syncthreads();
#pragma unroll
            for (int t4 = 0; t4 < 8; ++t4) { glu[(t4 * 4 + 0) * 512 + c] = res[t4].x; glu[(t4 * 4 + 1) * 512 + c] = res[t4].y; glu[(t4 * 4 + 2) * 512 + c] = res[t4].z; glu[(t4 * 4 + 3) * 512 + c] = res[t4].w; }
        }
        __syncthreads();
        {
            const f32x4 g0 = *(const f32x4*)(ln_g + 4 * lane), g1 = *(const f32x4*)(ln_g + 256 + 4 * lane), b0 = *(const f32x4*)(ln_b + 4 * lane), b1 = *(const f32x4*)(ln_b + 256 + 4 * lane);
#pragma unroll
            for (int tt = 0; tt < 4; ++tt) { const int t = wid * 4 + tt;
                const f32x4 x0 = *(const LAS f32x4*)(glu + t * 512 + 4 * lane), x1 = *(const LAS f32x4*)(glu + t * 512 + 256 + 4 * lane);
                const float mean = wave_sum((x0.x + x0.y) + (x0.z + x0.w) + (x1.x + x1.y) + (x1.z + x1.w)) * (1.0f / 512.0f);
                const f32x4 d0 = x0 - mean, d1 = x1 - mean;
                const float var = wave_sum(d0.x * d0.x + d0.y * d0.y + d0.z * d0.z + d0.w * d0.w + d1.x * d1.x + d1.y * d1.y + d1.z * d1.z + d1.w * d1.w) * (1.0f / 512.0f);
                const float rstd = rsqrtf(var + 1e-5f);
                const f32x4 y0 = d0 * rstd * g0 + b0, y1 = d1 * rstd * g1 + b1;
                u32x2 w0, w1; w0.x = pk2(silu_(y0.x), silu_(y0.y)); w0.y = pk2(silu_(y0.z), silu_(y0.w)); w1.x = pk2(silu_(y1.x), silu_(y1.y)); w1.y = pk2(silu_(y1.z), silu_(y1.w));
                *(u32x2*)(Y + (size_t)(t0 + t) * 1024 + 4 * lane) = w0; *(u32x2*)(Y + (size_t)(t0 + t) * 1024 + 256 + 4 * lane) = w1; }
        }
        __syncthreads();
#endif
#if !(EVP_SKIP & 2)
#pragma unroll 1
        for (int gi = 0; gi < 3; ++gi) {
            const int col = 1024 + gi * 512 + c;
            float w5[5];
#pragma unroll
            for (int w = 0; w < 5; ++w) w5[w] = dn_w[w * 1536 + gi * 512 + c];
            const bf16_t* zc = Z + (size_t)b * S_ * 3072 + col;
#define ZLD(sp) (((sp) >= 0 && (sp) < S_) ? bf2f(zc[(size_t)(sp) * 3072]) : 0.f)
            float x0 = ZLD(s0 - 2), x1 = ZLD(s0 - 1), x2 = ZLD(s0), x3 = ZLD(s0 + 1);
#pragma unroll 4
            for (int t = 0; t < 32; ++t) { const float x4 = ZLD(s0 + t + 2);
                float v = x0 * w5[0]; v = fmaf(x1, w5[1], v); v = fmaf(x2, w5[2], v); v = fmaf(x3, w5[3], v); v = fmaf(x4, w5[4], v);
                v = silu_(v);
                if (gi == 2) QKVN[(size_t)(t0 + t) * 1536 + 1024 + c] = f2bf(v); else glu[t * 512 + c] = v;
                x0 = x1; x1 = x2; x2 = x3; x3 = x4; }
#undef ZLD
            if (gi < 2) {
                __syncthreads();
                const float qs = gi == 0 ? 0.08838834764831845f : 1.0f;
#pragma unroll 4
                for (int pp = 0; pp < 16; ++pp) { const int pr = wid * 16 + pp, t = pr >> 2, hd = pr & 3;
                    const f32x2 x = *(const LAS f32x2*)(glu + t * 512 + hd * 128 + 2 * lane);
                    const float ss = wave_sum(x.x * x.x + x.y * x.y); const float sc = rsqrtf(ss + 1e-6f) * qs;
                    *(unsigned*)(QKVN + (size_t)(t0 + t) * 1536 + gi * 512 + hd * 128 + 2 * lane) = pk2(x.x * sc, x.y * sc); }
                __syncthreads();
            }
        }
#endif
#if !(EVP_SKIP & 4)
        if (tid < 256) { const int t = tid >> 3, j = tid & 7; const size_t tok = (size_t)(t0 + t);
            const float bp = gates[tok * 16 + j], ap = gates[tok * 16 + 8 + j];
            BETA[tok * 8 + j] = sigm(bp); LA[tok * 8 + j] = -expf(a_log[j]) * softplus_(ap + dt_bias[j]); }
#endif
        __syncthreads();
    }
}

__device__ __forceinline__ void delta_scan(LDSp lds, const Params& p) {
    const bf16_t* QKVN = (const bf16_t*)(p.ws + WS_QKV); const float* BETA = (const float*)(p.ws + WS_BETA); const float* LA = (const float*)(p.ws + WS_LA);
    const int tid = threadIdx.x, jl = tid >> 4, sub = tid & 15;
    constexpr int BUF = 37376;
    LAS float* ost = (LAS float*)(lds + 2 * BUF);
    for (int unit = blockIdx.x; unit < 128; unit += gridDim.x) {
        const int dir = unit >> 6, b = (unit >> 4) & 3, h = (unit >> 2) & 3, sl = unit & 3;
        bf16_t* O = (bf16_t*)(p.ws + (dir ? WS_OB : WS_OF));
        float S[8];
#pragma unroll
        for (int i = 0; i < 8; ++i) S[i] = 0.f;
        u32x4 rq[4]; u32x4 rv = {0u, 0u, 0u, 0u}; float ra = 0.f, rb = 0.f;
#define DS_TOK(n, s) ((size_t)b * S_ + (dir ? (S_ - 1 - ((n) * 64 + (s))) : ((n) * 64 + (s))))
#define DS_LOAD(n) do { _Pragma("unroll") for (int i = 0; i < 4; ++i) { const int pi = tid + NTHR * i, s = pi >> 5, w16 = pi & 31; \
            rq[i] = *(const u32x4*)(QKVN + DS_TOK(n, s) * 1536 + (w16 >> 4) * 512 + h * 128 + (w16 & 15) * 8); } \
        if (tid < 256) { const int s = tid >> 2, c8 = tid & 3; rv = *(const u32x4*)(QKVN + DS_TOK(n, s) * 1536 + 1024 + h * 128 + sl * 32 + c8 * 8); } \
        if (tid < 64) { const size_t tk = DS_TOK(n, tid); ra = expf(LA[tk * 8 + dir * 4 + h]); rb = BETA[tk * 8 + dir * 4 + h]; } } while (0)
#define DS_STORE(bufp) do { _Pragma("unroll") for (int i = 0; i < 4; ++i) { const int pi = tid + NTHR * i; *(LAS u32x4*)((bufp) + pi * 16) = rq[i]; } \
        if (tid < 256) *(LAS u32x4*)((bufp) + 32768 + tid * 16) = rv; \
        if (tid < 64) { *(LAS float*)((bufp) + 36864 + tid * 8) = ra; *(LAS float*)((bufp) + 36864 + tid * 8 + 4) = rb; } } while (0)
        DS_LOAD(0); DS_STORE(lds); __syncthreads();
#pragma unroll 1
        for (int n = 0; n < 64; ++n) {
            LDSp cb = lds + (n & 1) * BUF; LDSp nb = lds + ((n + 1) & 1) * BUF; LAS float* os = ost + (n & 1) * 2048;
            if (n < 63) DS_LOAD(n + 1);
#pragma unroll 4
            for (int s = 0; s < 64; ++s) {
                const u32x4 qq = *(const LAS u32x4*)(cb + s * 512 + sub * 16), kk = *(const LAS u32x4*)(cb + s * 512 + 256 + sub * 16);
                const float vj = bf2f(*(const LAS unsigned short*)(cb + 32768 + s * 64 + jl * 2));
                const float al = *(const LAS float*)(cb + 36864 + s * 8), be = *(const LAS float*)(cb + 36864 + s * 8 + 4);
                float kf[8], qf[8]; unpack8(kk, kf); unpack8(qq, qf);
                float ks = 0.f;
#pragma unroll
                for (int i = 0; i < 8; ++i) ks = fmaf(kf[i], S[i], ks);
                ks = row16_sum(ks);
                const float cc = be * (vj - al * ks);
                float o = 0.f;
#pragma unroll
                for (int i = 0; i < 8; ++i) { S[i] = fmaf(kf[i], cc, al * S[i]); o = fmaf(qf[i], S[i], o); }
                o = row16_sum(o);
                if (sub == 0) os[s * 32 + jl] = o;
            }
            if (n < 63) DS_STORE(nb);
            __syncthreads();
            { const int s = tid >> 3, j4 = (tid & 7) << 2; const f32x4 o4 = *(const LAS f32x4*)(os + s * 32 + j4);
              u32x2 w; w.x = pk2(o4.x, o4.y); w.y = pk2(o4.z, o4.w);
              *(u32x2*)(O + DS_TOK(n, s) * 512 + h * 128 + sl * 32 + j4) = w; }
        }
        __syncthreads();
#undef DS_LOAD
#undef DS_STORE
#undef DS_TOK
    }
}

__device__ __forceinline__ void tri_solve64(const LAS float* Am, const LAS unsigned short* col, const LAS float* sc, bf16_t* outp, long rstride) {
    f32x4 a;
    float x0 = sc[0] * bf2f(col[0]);
    outp[0 * rstride] = f2bf(x0);
    float x1 = sc[1] * bf2f(col[136]);
    a = *(const LAS f32x4*)(Am + 68);
    x1 = fmaf(-a.x, x0, x1);
    outp[1 * rstride] = f2bf(x1);
    float x2 = sc[2] * bf2f(col[272]);
    a = *(const LAS f32x4*)(Am + 136);
    x2 = fmaf(-a.x, x0, x2);
    x2 = fmaf(-a.y, x1, x2);
    outp[2 * rstride] = f2bf(x2);
    float x3 = sc[3] * bf2f(col[408]);
    a = *(const LAS f32x4*)(Am + 204);
    x3 = fmaf(-a.x, x0, x3);
    x3 = fmaf(-a.y, x1, x3);
    x3 = fmaf(-a.z, x2, x3);
    outp[3 * rstride] = f2bf(x3);
    float x4 = sc[4] * bf2f(col[544]);
    a = *(const LAS f32x4*)(Am + 272);
    x4 = fmaf(-a.x, x0, x4);
    x4 = fmaf(-a.y, x1, x4);
    x4 = fmaf(-a.z, x2, x4);
    x4 = fmaf(-a.w, x3, x4);
    outp[4 * rstride] = f2bf(x4);
    float x5 = sc[5] * bf2f(col[680]);
    a = *(const LAS f32x4*)(Am + 340);
    x5 = fmaf(-a.x, x0, x5);
    x5 = fmaf(-a.y, x1, x5);
    x5 = fmaf(-a.z, x2, x5);
    x5 = fmaf(-a.w, x3, x5);
    a = *(const LAS f32x4*)(Am + 344);
    x5 = fmaf(-a.x, x4, x5);
    outp[5 * rstride] = f2bf(x5);
    float x6 = sc[6] * bf2f(col[816]);
    a = *(const LAS f32x4*)(Am + 408);
    x6 = fmaf(-a.x, x0, x6);
    x6 = fmaf(-a.y, x1, x6);
    x6 = fmaf(-a.z, x2, x6);
    x6 = fmaf(-a.w, x3, x6);
    a = *(const LAS f32x4*)(Am + 412);
    x6 = fmaf(-a.x, x4, x6);
    x6 = fmaf(-a.y, x5, x6);
    outp[6 * rstride] = f2bf(x6);
    float x7 = sc[7] * bf2f(col[952]);
    a = *(const LAS f32x4*)(Am + 476);
    x7 = fmaf(-a.x, x0, x7);
    x7 = fmaf(-a.y, x1, x7);
    x7 = fmaf(-a.z, x2, x7);
    x7 = fmaf(-a.w, x3, x7);
    a = *(const LAS f32x4*)(Am + 480);
    x7 = fmaf(-a.x, x4, x7);
    x7 = fmaf(-a.y, x5, x7);
    x7 = fmaf(-a.z, x6, x7);
    outp[7 * rstride] = f2bf(x7);
    float x8 = sc[8] * bf2f(col[1088]);
    a = *(const LAS f32x4*)(Am + 544);
    x8 = fmaf(-a.x, x0, x8);
    x8 = fmaf(-a.y, x1, x8);
    x8 = fmaf(-a.z, x2, x8);
    x8 = fmaf(-a.w, x3, x8);
    a = *(const LAS f32x4*)(Am + 548);
    x8 = fmaf(-a.x, x4, x8);
    x8 = fmaf(-a.y, x5, x8);
    x8 = fmaf(-a.z, x6, x8);
    x8 = fmaf(-a.w, x7, x8);
    outp[8 * rstride] = f2bf(x8);
    float x9 = sc[9] * bf2f(col[1224]);
    a = *(const LAS f32x4*)(Am + 612);
    x9 = fmaf(-a.x, x0, x9);
    x9 = fmaf(-a.y, x1, x9);
    x9 = fmaf(-a.z, x2, x9);
    x9 = fmaf(-a.w, x3, x9);
    a = *(const LAS f32x4*)(Am + 616);
    x9 = fmaf(-a.x, x4, x9);
    x9 = fmaf(-a.y, x5, x9);
    x9 = fmaf(-a.z, x6, x9);
    x9 = fmaf(-a.w, x7, x9);
    a = *(const LAS f32x4*)(Am + 620);
    x9 = fmaf(-a.x, x8, x9);
    outp[9 * rstride] = f2bf(x9);
    float x10 = sc[10] * bf2f(col[1360]);
    a = *(const LAS f32x4*)(Am + 680);
    x10 = fmaf(-a.x, x0, x10);
    x10 = fmaf(-a.y, x1, x10);
    x10 = fmaf(-a.z, x2, x10);
    x10 = fmaf(-a.w, x3, x10);
    a = *(const LAS f32x4*)(Am + 684);
    x10 = fmaf(-a.x, x4, x10);
    x10 = fmaf(-a.y, x5, x10);
    x10 = fmaf(-a.z, x6, x10);
    x10 = fmaf(-a.w, x7, x10);
    a = *(const LAS f32x4*)(Am + 688);
    x10 = fmaf(-a.x, x8, x10);
    x10 = fmaf(-a.y, x9, x10);
    outp[10 * rstride] = f2bf(x10);
    float x11 = sc[11] * bf2f(col[1496]);
    a = *(const LAS f32x4*)(Am + 748);
    x11 = fmaf(-a.x, x0, x11);
    x11 = fmaf(-a.y, x1, x11);
    x11 = fmaf(-a.z, x2, x11);
    x11 = fmaf(-a.w, x3, x11);
    a = *(const LAS f32x4*)(Am + 752);
    x11 = fmaf(-a.x, x4, x11);
    x11 = fmaf(-a.y, x5, x11);
    x11 = fmaf(-a.z, x6, x11);
    x11 = fmaf(-a.w, x7, x11);
    a = *(const LAS f32x4*)(Am + 756);
    x11 = fmaf(-a.x, x8, x11);
    x11 = fmaf(-a.y, x9, x11);
    x11 = fmaf(-a.z, x10, x11);
    outp[11 * rstride] = f2bf(x11);
    float x12 = sc[12] * bf2f(col[1632]);
    a = *(const LAS f32x4*)(Am + 816);
    x12 = fmaf(-a.x, x0, x12);
    x12 = fmaf(-a.y, x1, x12);
    x12 = fmaf(-a.z, x2, x12);
    x12 = fmaf(-a.w, x3, x12);
    a = *(const LAS f32x4*)(Am + 820);
    x12 = fmaf(-a.x, x4, x12);
    x12 = fmaf(-a.y, x5, x12);
    x12 = fmaf(-a.z, x6, x12);
    x12 = fmaf(-a.w, x7, x12);
    a = *(const LAS f32x4*)(Am + 824);
    x12 = fmaf(-a.x, x8, x12);
    x12 = fmaf(-a.y, x9, x12);
    x12 = fmaf(-a.z, x10, x12);
    x12 = fmaf(-a.w, x11, x12);
    outp[12 * rstride] = f2bf(x12);
    float x13 = sc[13] * bf2f(col[1768]);
    a = *(const LAS f32x4*)(Am + 884);
    x13 = fmaf(-a.x, x0, x13);
    x13 = fmaf(-a.y, x1, x13);
    x13 = fmaf(-a.z, x2, x13);
    x13 = fmaf(-a.w, x3, x13);
    a = *(const LAS f32x4*)(Am + 888);
    x13 = fmaf(-a.x, x4, x13);
    x13 = fmaf(-a.y, x5, x13);
    x13 = fmaf(-a.z, x6, x13);
    x13 = fmaf(-a.w, x7, x13);
    a = *(const LAS f32x4*)(Am + 892);
    x13 = fmaf(-a.x, x8, x13);
    x13 = fmaf(-a.y, x9, x13);
    x13 = fmaf(-a.z, x10, x13);
    x13 = fmaf(-a.w, x11, x13);
    a = *(const LAS f32x4*)(Am + 896);
    x13 = fmaf(-a.x, x12, x13);
    outp[13 * rstride] = f2bf(x13);
    float x14 = sc[14] * bf2f(col[1904]);
    a = *(const LAS f32x4*)(Am + 952);
    x14 = fmaf(-a.x, x0, x14);
    x14 = fmaf(-a.y, x1, x14);
    x14 = fmaf(-a.z, x2, x14);
    x14 = fmaf(-a.w, x3, x14);
    a = *(const LAS f32x4*)(Am + 956);
    x14 = fmaf(-a.x, x4, x14);
    x14 = fmaf(-a.y, x5, x14);
    x14 = fmaf(-a.z, x6, x14);
    x14 = fmaf(-a.w, x7, x14);
    a = *(const LAS f32x4*)(Am + 960);
    x14 = fmaf(-a.x, x8, x14);
    x14 = fmaf(-a.y, x9, x14);
    x14 = fmaf(-a.z, x10, x14);
    x14 = fmaf(-a.w, x11, x14);
    a = *(const LAS f32x4*)(Am + 964);
    x14 = fmaf(-a.x, x12, x14);
    x14 = fmaf(-a.y, x13, x14);
    outp[14 * rstride] = f2bf(x14);
    float x15 = sc[15] * bf2f(col[2040]);
    a = *(const LAS f32x4*)(Am + 1020);
    x15 = fmaf(-a.x, x0, x15);
    x15 = fmaf(-a.y, x1, x15);
    x15 = fmaf(-a.z, x2, x15);
    x15 = fmaf(-a.w, x3, x15);
    a = *(const LAS f32x4*)(Am + 1024);
    x15 = fmaf(-a.x, x4, x15);
    x15 = fmaf(-a.y, x5, x15);
    x15 = fmaf(-a.z, x6, x15);
    x15 = fmaf(-a.w, x7, x15);
    a = *(const LAS f32x4*)(Am + 1028);
    x15 = fmaf(-a.x, x8, x15);
    x15 = fmaf(-a.y, x9, x15);
    x15 = fmaf(-a.z, x10, x15);
    x15 = fmaf(-a.w, x11, x15);
    a = *(const LAS f32x4*)(Am + 1032);
    x15 = fmaf(-a.x, x12, x15);
    x15 = fmaf(-a.y, x13, x15);
    x15 = fmaf(-a.z, x14, x15);
    outp[15 * rstride] = f2bf(x15);
    float x16 = sc[16] * bf2f(col[2176]);
    a = *(const LAS f32x4*)(Am + 1088);
    x16 = fmaf(-a.x, x0, x16);
    x16 = fmaf(-a.y, x1, x16);
    x16 = fmaf(-a.z, x2, x16);
    x16 = fmaf(-a.w, x3, x16);
    a = *(const LAS f32x4*)(Am + 1092);
    x16 = fmaf(-a.x, x4, x16);
    x16 = fmaf(-a.y, x5, x16);
    x16 = fmaf(-a.z, x6, x16);
    x16 = fmaf(-a.w, x7, x16);
    a = *(const LAS f32x4*)(Am + 1096);
    x16 = fmaf(-a.x, x8, x16);
    x16 = fmaf(-a.y, x9, x16);
    x16 = fmaf(-a.z, x10, x16);
    x16 = fmaf(-a.w, x11, x16);
    a = *(const LAS f32x4*)(Am + 1100);
    x16 = fmaf(-a.x, x12, x16);
    x16 = fmaf(-a.y, x13, x16);
    x16 = fmaf(-a.z, x14, x16);
    x16 = fmaf(-a.w, x15, x16);
    outp[16 * rstride] = f2bf(x16);
    float x17 = sc[17] * bf2f(col[2312]);
    a = *(const LAS f32x4*)(Am + 1156);
    x17 = fmaf(-a.x, x0, x17);
    x17 = fmaf(-a.y, x1, x17);
    x17 = fmaf(-a.z, x2, x17);
    x17 = fmaf(-a.w, x3, x17);
    a = *(const LAS f32x4*)(Am + 1160);
    x17 = fmaf(-a.x, x4, x17);
    x17 = fmaf(-a.y, x5, x17);
    x17 = fmaf(-a.z, x6, x17);
    x17 = fmaf(-a.w, x7, x17);
    a = *(const LAS f32x4*)(Am + 1164);
    x17 = fmaf(-a.x, x8, x17);
    x17 = fmaf(-a.y, x9, x17);
    x17 = fmaf(-a.z, x10, x17);
    x17 = fmaf(-a.w, x11, x17);
    a = *(const LAS f32x4*)(Am + 1168);
    x17 = fmaf(-a.x, x12, x17);
    x17 = fmaf(-a.y, x13, x17);
    x17 = fmaf(-a.z, x14, x17);
    x17 = fmaf(-a.w, x15, x17);
    a = *(const LAS f32x4*)(Am + 1172);
    x17 = fmaf(-a.x, x16, x17);
    outp[17 * rstride] = f2bf(x17);
    float x18 = sc[18] * bf2f(col[2448]);
    a = *(const LAS f32x4*)(Am + 1224);
    x18 = fmaf(-a.x, x0, x18);
    x18 = fmaf(-a.y, x1, x18);
    x18 = fmaf(-a.z, x2, x18);
    x18 = fmaf(-a.w, x3, x18);
    a = *(const LAS f32x4*)(Am + 1228);
    x18 = fmaf(-a.x, x4, x18);
    x18 = fmaf(-a.y, x5, x18);
    x18 = fmaf(-a.z, x6, x18);
    x18 = fmaf(-a.w, x7, x18);
    a = *(const LAS f32x4*)(Am + 1232);
    x18 = fmaf(-a.x, x8, x18);
    x18 = fmaf(-a.y, x9, x18);
    x18 = fmaf(-a.z, x10, x18);
    x18 = fmaf(-a.w, x11, x18);
    a = *(const LAS f32x4*)(Am + 1236);
    x18 = fmaf(-a.x, x12, x18);
    x18 = fmaf(-a.y, x13, x18);
    x18 = fmaf(-a.z, x14, x18);
    x18 = fmaf(-a.w, x15, x18);
    a = *(const LAS f32x4*)(Am + 1240);
    x18 = fmaf(-a.x, x16, x18);
    x18 = fmaf(-a.y, x17, x18);
    outp[18 * rstride] = f2bf(x18);
    float x19 = sc[19] * bf2f(col[2584]);
    a = *(const LAS f32x4*)(Am + 1292);
    x19 = fmaf(-a.x, x0, x19);
    x19 = fmaf(-a.y, x1, x19);
    x19 = fmaf(-a.z, x2, x19);
    x19 = fmaf(-a.w, x3, x19);
    a = *(const LAS f32x4*)(Am + 1296);
    x19 = fmaf(-a.x, x4, x19);
    x19 = fmaf(-a.y, x5, x19);
    x19 = fmaf(-a.z, x6, x19);
    x19 = fmaf(-a.w, x7, x19);
    a = *(const LAS f32x4*)(Am + 1300);
    x19 = fmaf(-a.x, x8, x19);
    x19 = fmaf(-a.y, x9, x19);
    x19 = fmaf(-a.z, x10, x19);
    x19 = fmaf(-a.w, x11, x19);
    a = *(const LAS f32x4*)(Am + 1304);
    x19 = fmaf(-a.x, x12, x19);
    x19 = fmaf(-a.y, x13, x19);
    x19 = fmaf(-a.z, x14, x19);
    x19 = fmaf(-a.w, x15, x19);
    a = *(const LAS f32x4*)(Am + 1308);
    x19 = fmaf(-a.x, x16, x19);
    x19 = fmaf(-a.y, x17, x19);
    x19 = fmaf(-a.z, x18, x19);
    outp[19 * rstride] = f2bf(x19);
    float x20 = sc[20] * bf2f(col[2720]);
    a = *(const LAS f32x4*)(Am + 1360);
    x20 = fmaf(-a.x, x0, x20);
    x20 = fmaf(-a.y, x1, x20);
    x20 = fmaf(-a.z, x2, x20);
    x20 = fmaf(-a.w, x3, x20);
    a = *(const LAS f32x4*)(Am + 1364);
    x20 = fmaf(-a.x, x4, x20);
    x20 = fmaf(-a.y, x5, x20);
    x20 = fmaf(-a.z, x6, x20);
    x20 = fmaf(-a.w, x7, x20);
    a = *(const LAS f32x4*)(Am + 1368);
    x20 = fmaf(-a.x, x8, x20);
    x20 = fmaf(-a.y, x9, x20);
    x20 = fmaf(-a.z, x10, x20);
    x20 = fmaf(-a.w, x11, x20);
    a = *(const LAS f32x4*)(Am + 1372);
    x20 = fmaf(-a.x, x12, x20);
    x20 = fmaf(-a.y, x13, x20);
    x20 = fmaf(-a.z, x14, x20);
    x20 = fmaf(-a.w, x15, x20);
    a = *(const LAS f32x4*)(Am + 1376);
    x20 = fmaf(-a.x, x16, x20);
    x20 = fmaf(-a.y, x17, x20);
    x20 = fmaf(-a.z, x18, x20);
    x20 = fmaf(-a.w, x19, x20);
    outp[20 * rstride] = f2bf(x20);
    float x21 = sc[21] * bf2f(col[2856]);
    a = *(const LAS f32x4*)(Am + 1428);
    x21 = fmaf(-a.x, x0, x21);
    x21 = fmaf(-a.y, x1, x21);
    x21 = fmaf(-a.z, x2, x21);
    x21 = fmaf(-a.w, x3, x21);
    a = *(const LAS f32x4*)(Am + 1432);
    x21 = fmaf(-a.x, x4, x21);
    x21 = fmaf(-a.y, x5, x21);
    x21 = fmaf(-a.z, x6, x21);
    x21 = fmaf(-a.w, x7, x21);
    a = *(const LAS f32x4*)(Am + 1436);
    x21 = fmaf(-a.x, x8, x21);
    x21 = fmaf(-a.y, x9, x21);
    x21 = fmaf(-a.z, x10, x21);
    x21 = fmaf(-a.w, x11, x21);
    a = *(const LAS f32x4*)(Am + 1440);
    x21 = fmaf(-a.x, x12, x21);
    x21 = fmaf(-a.y, x13, x21);
    x21 = fmaf(-a.z, x14, x21);
    x21 = fmaf(-a.w, x15, x21);
    a = *(const LAS f32x4*)(Am + 1444);
    x21 = fmaf(-a.x, x16, x21);
    x21 = fmaf(-a.y, x17, x21);
    x21 = fmaf(-a.z, x18, x21);
    x21 = fmaf(-a.w, x19, x21);
    a = *(const LAS f32x4*)(Am + 1448);
    x21 = fmaf(-a.x, x20, x21);
    outp[21 * rstride] = f2bf(x21);
    float x22 = sc[22] * bf2f(col[2992]);
    a = *(const LAS f32x4*)(Am + 1496);
    x22 = fmaf(-a.x, x0, x22);
    x22 = fmaf(-a.y, x1, x22);
    x22 = fmaf(-a.z, x2, x22);
    x22 = fmaf(-a.w, x3, x22);
    a = *(const LAS f32x4*)(Am + 1500);
    x22 = fmaf(-a.x, x4, x22);
    x22 = fmaf(-a.y, x5, x22);
    x22 = fmaf(-a.z, x6, x22);
    x22 = fmaf(-a.w, x7, x22);
    a = *(const LAS f32x4*)(Am + 1504);
    x22 = fmaf(-a.x, x8, x22);
    x22 = fmaf(-a.y, x9, x22);
    x22 = fmaf(-a.z, x10, x22);
    x22 = fmaf(-a.w, x11, x22);
    a = *(const LAS f32x4*)(Am + 1508);
    x22 = fmaf(-a.x, x12, x22);
    x22 = fmaf(-a.y, x13, x22);
    x22 = fmaf(-a.z, x14, x22);
    x22 = fmaf(-a.w, x15, x22);
    a = *(const LAS f32x4*)(Am + 1512);
    x22 = fmaf(-a.x, x16, x22);
    x22 = fmaf(-a.y, x17, x22);
    x22 = fmaf(-a.z, x18, x22);
    x22 = fmaf(-a.w, x19, x22);
    a = *(const LAS f32x4*)(Am + 1516);
    x22 = fmaf(-a.x, x20, x22);
    x22 = fmaf(-a.y, x21, x22);
    outp[22 * rstride] = f2bf(x22);
    float x23 = sc[23] * bf2f(col[3128]);
    a = *(const LAS f32x4*)(Am + 1564);
    x23 = fmaf(-a.x, x0, x23);
    x23 = fmaf(-a.y, x1, x23);
    x23 = fmaf(-a.z, x2, x23);
    x23 = fmaf(-a.w, x3, x23);
    a = *(const LAS f32x4*)(Am + 1568);
    x23 = fmaf(-a.x, x4, x23);
    x23 = fmaf(-a.y, x5, x23);
    x23 = fmaf(-a.z, x6, x23);
    x23 = fmaf(-a.w, x7, x23);
    a = *(const LAS f32x4*)(Am + 1572);
    x23 = fmaf(-a.x, x8, x23);
    x23 = fmaf(-a.y, x9, x23);
    x23 = fmaf(-a.z, x10, x23);
    x23 = fmaf(-a.w, x11, x23);
    a = *(const LAS f32x4*)(Am + 1576);
    x23 = fmaf(-a.x, x12, x23);
    x23 = fmaf(-a.y, x13, x23);
    x23 = fmaf(-a.z, x14, x23);
    x23 = fmaf(-a.w, x15, x23);
    a = *(const LAS f32x4*)(Am + 1580);
    x23 = fmaf(-a.x, x16, x23);
    x23 = fmaf(-a.y, x17, x23);
    x23 = fmaf(-a.z, x18, x23);
    x23 = fmaf(-a.w, x19, x23);
    a = *(const LAS f32x4*)(Am + 1584);
    x23 = fmaf(-a.x, x20, x23);
    x23 = fmaf(-a.y, x21, x23);
    x23 = fmaf(-a.z, x22, x23);
    outp[23 * rstride] = f2bf(x23);
    float x24 = sc[24] * bf2f(col[3264]);
    a = *(const LAS f32x4*)(Am + 1632);
    x24 = fmaf(-a.x, x0, x24);
    x24 = fmaf(-a.y, x1, x24);
    x24 = fmaf(-a.z, x2, x24);
    x24 = fmaf(-a.w, x3, x24);
    a = *(const LAS f32x4*)(Am + 1636);
    x24 = fmaf(-a.x, x4, x24);
    x24 = fmaf(-a.y, x5, x24);
    x24 = fmaf(-a.z, x6, x24);
    x24 = fmaf(-a.w, x7, x24);
    a = *(const LAS f32x4*)(Am + 1640);
    x24 = fmaf(-a.x, x8, x24);
    x24 = fmaf(-a.y, x9, x24);
    x24 = fmaf(-a.z, x10, x24);
    x24 = fmaf(-a.w, x11, x24);
    a = *(const LAS f32x4*)(Am + 1644);
    x24 = fmaf(-a.x, x12, x24);
    x24 = fmaf(-a.y, x13, x24);
    x24 = fmaf(-a.z, x14, x24);
    x24 = fmaf(-a.w, x15, x24);
    a = *(const LAS f32x4*)(Am + 1648);
    x24 = fmaf(-a.x, x16, x24);
    x24 = fmaf(-a.y, x17, x24);
    x24 = fmaf(-a.z, x18, x24);
    x24 = fmaf(-a.w, x19, x24);
    a = *(const LAS f32x4*)(Am + 1652);
    x24 = fmaf(-a.x, x20, x24);
    x24 = fmaf(-a.y, x21, x24);
    x24 = fmaf(-a.z, x22, x24);
    x24 = fmaf(-a.w, x23, x24);
    outp[24 * rstride] = f2bf(x24);
    float x25 = sc[25] * bf2f(col[3400]);
    a = *(const LAS f32x4*)(Am + 1700);
    x25 = fmaf(-a.x, x0, x25);
    x25 = fmaf(-a.y, x1, x25);
    x25 = fmaf(-a.z, x2, x25);
    x25 = fmaf(-a.w, x3, x25);
    a = *(const LAS f32x4*)(Am + 1704);
    x25 = fmaf(-a.x, x4, x25);
    x25 = fmaf(-a.y, x5, x25);
    x25 = fmaf(-a.z, x6, x25);
    x25 = fmaf(-a.w, x7, x25);
    a = *(const LAS f32x4*)(Am + 1708);
    x25 = fmaf(-a.x, x8, x25);
    x25 = fmaf(-a.y, x9, x25);
    x25 = fmaf(-a.z, x10, x25);
    x25 = fmaf(-a.w, x11, x25);
    a = *(const LAS f32x4*)(Am + 1712);
    x25 = fmaf(-a.x, x12, x25);
    x25 = fmaf(-a.y, x13, x25);
    x25 = fmaf(-a.z, x14, x25);
    x25 = fmaf(-a.w, x15, x25);
    a = *(const LAS f32x4*)(Am + 1716);
    x25 = fmaf(-a.x, x16, x25);
    x25 = fmaf(-a.y, x17, x25);
    x25 = fmaf(-a.z, x18, x25);
    x25 = fmaf(-a.w, x19, x25);
    a = *(const LAS f32x4*)(Am + 1720);
    x25 = fmaf(-a.x, x20, x25);
    x25 = fmaf(-a.y, x21, x25);
    x25 = fmaf(-a.z, x22, x25);
    x25 = fmaf(-a.w, x23, x25);
    a = *(const LAS f32x4*)(Am + 1724);
    x25 = fmaf(-a.x, x24, x25);
    outp[25 * rstride] = f2bf(x25);
    float x26 = sc[26] * bf2f(col[3536]);
    a = *(const LAS f32x4*)(Am + 1768);
    x26 = fmaf(-a.x, x0, x26);
    x26 = fmaf(-a.y, x1, x26);
    x26 = fmaf(-a.z, x2, x26);
    x26 = fmaf(-a.w, x3, x26);
    a = *(const LAS f32x4*)(Am + 1772);
    x26 = fmaf(-a.x, x4, x26);
    x26 = fmaf(-a.y, x5, x26);
    x26 = fmaf(-a.z, x6, x26);
    x26 = fmaf(-a.w, x7, x26);
    a = *(const LAS f32x4*)(Am + 1776);
    x26 = fmaf(-a.x, x8, x26);
    x26 = fmaf(-a.y, x9, x26);
    x26 = fmaf(-a.z, x10, x26);
    x26 = fmaf(-a.w, x11, x26);
    a = *(const LAS f32x4*)(Am + 1780);
    x26 = fmaf(-a.x, x12, x26);
    x26 = fmaf(-a.y, x13, x26);
    x26 = fmaf(-a.z, x14, x26);
    x26 = fmaf(-a.w, x15, x26);
    a = *(const LAS f32x4*)(Am + 1784);
    x26 = fmaf(-a.x, x16, x26);
    x26 = fmaf(-a.y, x17, x26);
    x26 = fmaf(-a.z, x18, x26);
    x26 = fmaf(-a.w, x19, x26);
    a = *(const LAS f32x4*)(Am + 1788);
    x26 = fmaf(-a.x, x20, x26);
    x26 = fmaf(-a.y, x21, x26);
    x26 = fmaf(-a.z, x22, x26);
    x26 = fmaf(-a.w, x23, x26);
    a = *(const LAS f32x4*)(Am + 1792);
    x26 = fmaf(-a.x, x24, x26);
    x26 = fmaf(-a.y, x25, x26);
    outp[26 * rstride] = f2bf(x26);
    float x27 = sc[27] * bf2f(col[3672]);
    a = *(const LAS f32x4*)(Am + 1836);
    x27 = fmaf(-a.x, x0, x27);
    x27 = fmaf(-a.y, x1, x27);
    x27 = fmaf(-a.z, x2, x27);
    x27 = fmaf(-a.w, x3, x27);
    a = *(const LAS f32x4*)(Am + 1840);
    x27 = fmaf(-a.x, x4, x27);
    x27 = fmaf(-a.y, x5, x27);
    x27 = fmaf(-a.z, x6, x27);
    x27 = fmaf(-a.w, x7, x27);
    a = *(const LAS f32x4*)(Am + 1844);
    x27 = fmaf(-a.x, x8, x27);
    x27 = fmaf(-a.y, x9, x27);
    x27 = fmaf(-a.z, x10, x27);
    x27 = fmaf(-a.w, x11, x27);
    a = *(const LAS f32x4*)(Am + 1848);
    x27 = fmaf(-a.x, x12, x27);
    x27 = fmaf(-a.y, x13, x27);
    x27 = fmaf(-a.z, x14, x27);
    x27 = fmaf(-a.w, x15, x27);
    a = *(const LAS f32x4*)(Am + 1852);
    x27 = fmaf(-a.x, x16, x27);
    x27 = fmaf(-a.y, x17, x27);
    x27 = fmaf(-a.z, x18, x27);
    x27 = fmaf(-a.w, x19, x27);
    a = *(const LAS f32x4*)(Am + 1856);
    x27 = fmaf(-a.x, x20, x27);
    x27 = fmaf(-a.y, x21, x27);
    x27 = fmaf(-a.z, x22, x27);
    x27 = fmaf(-a.w, x23, x27);
    a = *(const LAS f32x4*)(Am + 1860);
    x27 = fmaf(-a.x, x24, x27);
    x27 = fmaf(-a.y, x25, x27);
    x27 = fmaf(-a.z, x26, x27);
    outp[27 * rstride] = f2bf(x27);
    float x28 = sc[28] * bf2f(col[3808]);
    a = *(const LAS f32x4*)(Am + 1904);
    x28 = fmaf(-a.x, x0, x28);
    x28 = fmaf(-a.y, x1, x28);
    x28 = fmaf(-a.z, x2, x28);
    x28 = fmaf(-a.w, x3, x28);
    a = *(const LAS f32x4*)(Am + 1908);
    x28 = fmaf(-a.x, x4, x28);
    x28 = fmaf(-a.y, x5, x28);
    x28 = fmaf(-a.z, x6, x28);
    x28 = fmaf(-a.w, x7, x28);
    a = *(const LAS f32x4*)(Am + 1912);
    x28 = fmaf(-a.x, x8, x28);
    x28 = fmaf(-a.y, x9, x28);
    x28 = fmaf(-a.z, x10, x28);
    x28 = fmaf(-a.w, x11, x28);
    a = *(const LAS f32x4*)(Am + 1916);
    x28 = fmaf(-a.x, x12, x28);
    x28 = fmaf(-a.y, x13, x28);
    x28 = fmaf(-a.z, x14, x28);
    x28 = fmaf(-a.w, x15, x28);
    a = *(const LAS f32x4*)(Am + 1920);
    x28 = fmaf(-a.x, x16, x28);
    x28 = fmaf(-a.y, x17, x28);
    x28 = fmaf(-a.z, x18, x28);
    x28 = fmaf(-a.w, x19, x28);
    a = *(const LAS f32x4*)(Am + 1924);
    x28 = fmaf(-a.x, x20, x28);
    x28 = fmaf(-a.y, x21, x28);
    x28 = fmaf(-a.z, x22, x28);
    x28 = fmaf(-a.w, x23, x28);
    a = *(const LAS f32x4*)(Am + 1928);
    x28 = fmaf(-a.x, x24, x28);
    x28 = fmaf(-a.y, x25, x28);
    x28 = fmaf(-a.z, x26, x28);
    x28 = fmaf(-a.w, x27, x28);
    outp[28 * rstride] = f2bf(x28);
    float x29 = sc[29] * bf2f(col[3944]);
    a = *(const LAS f32x4*)(Am + 1972);
    x29 = fmaf(-a.x, x0, x29);
    x29 = fmaf(-a.y, x1, x29);
    x29 = fmaf(-a.z, x2, x29);
    x29 = fmaf(-a.w, x3, x29);
    a = *(const LAS f32x4*)(Am + 1976);
    x29 = fmaf(-a.x, x4, x29);
    x29 = fmaf(-a.y, x5, x29);
    x29 = fmaf(-a.z, x6, x29);
    x29 = fmaf(-a.w, x7, x29);
    a = *(const LAS f32x4*)(Am + 1980);
    x29 = fmaf(-a.x, x8, x29);
    x29 = fmaf(-a.y, x9, x29);
    x29 = fmaf(-a.z, x10, x29);
    x29 = fmaf(-a.w, x11, x29);
    a = *(const LAS f32x4*)(Am + 1984);
    x29 = fmaf(-a.x, x12, x29);
    x29 = fmaf(-a.y, x13, x29);
    x29 = fmaf(-a.z, x14, x29);
    x29 = fmaf(-a.w, x15, x29);
    a = *(const LAS f32x4*)(Am + 1988);
    x29 = fmaf(-a.x, x16, x29);
    x29 = fmaf(-a.y, x17, x29);
    x29 = fmaf(-a.z, x18, x29);
    x29 = fmaf(-a.w, x19, x29);
    a = *(const LAS f32x4*)(Am + 1992);
    x29 = fmaf(-a.x, x20, x29);
    x29 = fmaf(-a.y, x21, x29);
    x29 = fmaf(-a.z, x22, x29);
    x29 = fmaf(-a.w, x23, x29);
    a = *(const LAS f32x4*)(Am + 1996);
    x29 = fmaf(-a.x, x24, x29);
    x29 = fmaf(-a.y, x25, x29);
    x29 = fmaf(-a.z, x26, x29);
    x29 = fmaf(-a.w, x27, x29);
    a = *(const LAS f32x4*)(Am + 2000);
    x29 = fmaf(-a.x, x28, x29);
    outp[29 * rstride] = f2bf(x29);
    float x30 = sc[30] * bf2f(col[4080]);
    a = *(const LAS f32x4*)(Am + 2040);
    x30 = fmaf(-a.x, x0, x30);
    x30 = fmaf(-a.y, x1, x30);
    x30 = fmaf(-a.z, x2, x30);
    x30 = fmaf(-a.w, x3, x30);
    a = *(const LAS f32x4*)(Am + 2044);
    x30 = fmaf(-a.x, x4, x30);
    x30 = fmaf(-a.y, x5, x30);
    x30 = fmaf(-a.z, x6, x30);
    x30 = fmaf(-a.w, x7, x30);
    a = *(const LAS f32x4*)(Am + 2048);
    x30 = fmaf(-a.x, x8, x30);
    x30 = fmaf(-a.y, x9, x30);
    x30 = fmaf(-a.z, x10, x30);
    x30 = fmaf(-a.w, x11, x30);
    a = *(const LAS f32x4*)(Am + 2052);
    x30 = fmaf(-a.x, x12, x30);
    x30 = fmaf(-a.y, x13, x30);
    x30 = fmaf(-a.z, x14, x30);
    x30 = fmaf(-a.w, x15, x30);
    a = *(const LAS f32x4*)(Am + 2056);
    x30 = fmaf(-a.x, x16, x30);
    x30 = fmaf(-a.y, x17, x30);
    x30 = fmaf(-a.z, x18, x30);
    x30 = fmaf(-a.w, x19, x30);
    a = *(const LAS f32x4*)(Am + 2060);
    x30 = fmaf(-a.x, x20, x30);
    x30 = fmaf(-a.y, x21, x30);
    x30 = fmaf(-a.z, x22, x30);
    x30 = fmaf(-a.w, x23, x30);
    a = *(const LAS f32x4*)(Am + 2064);
    x30 = fmaf(-a.x, x24, x30);
    x30 = fmaf(-a.y, x25, x30);
    x30 = fmaf(-a.z, x26, x30);
    x30 = fmaf(-a.w, x27, x30);
    a = *(const LAS f32x4*)(Am + 2068);
    x30 = fmaf(-a.x, x28, x30);
    x30 = fmaf(-a.y, x29, x30);
    outp[30 * rstride] = f2bf(x30);
    float x31 = sc[31] * bf2f(col[4216]);
    a = *(const LAS f32x4*)(Am + 2108);
    x31 = fmaf(-a.x, x0, x31);
    x31 = fmaf(-a.y, x1, x31);
    x31 = fmaf(-a.z, x2, x31);
    x31 = fmaf(-a.w, x3, x31);
    a = *(const LAS f32x4*)(Am + 2112);
    x31 = fmaf(-a.x, x4, x31);
    x31 = fmaf(-a.y, x5, x31);
    x31 = fmaf(-a.z, x6, x31);
    x31 = fmaf(-a.w, x7, x31);
    a = *(const LAS f32x4*)(Am + 2116);
    x31 = fmaf(-a.x, x8, x31);
    x31 = fmaf(-a.y, x9, x31);
    x31 = fmaf(-a.z, x10, x31);
    x31 = fmaf(-a.w, x11, x31);
    a = *(const LAS f32x4*)(Am + 2120);
    x31 = fmaf(-a.x, x12, x31);
    x31 = fmaf(-a.y, x13, x31);
    x31 = fmaf(-a.z, x14, x31);
    x31 = fmaf(-a.w, x15, x31);
    a = *(const LAS f32x4*)(Am + 2124);
    x31 = fmaf(-a.x, x16, x31);
    x31 = fmaf(-a.y, x17, x31);
    x31 = fmaf(-a.z, x18, x31);
    x31 = fmaf(-a.w, x19, x31);
    a = *(const LAS f32x4*)(Am + 2128);
    x31 = fmaf(-a.x, x20, x31);
    x31 = fmaf(-a.y, x21, x31);
    x31 = fmaf(-a.z, x22, x31);
    x31 = fmaf(-a.w, x23, x31);
    a = *(const LAS f32x4*)(Am + 2132);
    x31 = fmaf(-a.x, x24, x31);
    x31 = fmaf(-a.y, x25, x31);
    x31 = fmaf(-a.z, x26, x31);
    x31 = fmaf(-a.w, x27, x31);
    a = *(const LAS f32x4*)(Am + 2136);
    x31 = fmaf(-a.x, x28, x31);
    x31 = fmaf(-a.y, x29, x31);
    x31 = fmaf(-a.z, x30, x31);
    outp[31 * rstride] = f2bf(x31);
    float x32 = sc[32] * bf2f(col[4352]);
    a = *(const LAS f32x4*)(Am + 2176);
    x32 = fmaf(-a.x, x0, x32);
    x32 = fmaf(-a.y, x1, x32);
    x32 = fmaf(-a.z, x2, x32);
    x32 = fmaf(-a.w, x3, x32);
    a = *(const LAS f32x4*)(Am + 2180);
    x32 = fmaf(-a.x, x4, x32);
    x32 = fmaf(-a.y, x5, x32);
    x32 = fmaf(-a.z, x6, x32);
    x32 = fmaf(-a.w, x7, x32);
    a = *(const LAS f32x4*)(Am + 2184);
    x32 = fmaf(-a.x, x8, x32);
    x32 = fmaf(-a.y, x9, x32);
    x32 = fmaf(-a.z, x10, x32);
    x32 = fmaf(-a.w, x11, x32);
    a = *(const LAS f32x4*)(Am + 2188);
    x32 = fmaf(-a.x, x12, x32);
    x32 = fmaf(-a.y, x13, x32);
    x32 = fmaf(-a.z, x14, x32);
    x32 = fmaf(-a.w, x15, x32);
    a = *(const LAS f32x4*)(Am + 2192);
    x32 = fmaf(-a.x, x16, x32);
    x32 = fmaf(-a.y, x17, x32);
    x32 = fmaf(-a.z, x18, x32);
    x32 = fmaf(-a.w, x19, x32);
    a = *(const LAS f32x4*)(Am + 2196);
    x32 = fmaf(-a.x, x20, x32);
    x32 = fmaf(-a.y, x21, x32);
    x32 = fmaf(-a.z, x22, x32);
    x32 = fmaf(-a.w, x23, x32);
    a = *(const LAS f32x4*)(Am + 2200);
    x32 = fmaf(-a.x, x24, x32);
    x32 = fmaf(-a.y, x25, x32);
    x32 = fmaf(-a.z, x26, x32);
    x32 = fmaf(-a.w, x27, x32);
    a = *(const LAS f32x4*)(Am + 2204);
    x32 = fmaf(-a.x, x28, x32);
    x32 = fmaf(-a.y, x29, x32);
    x32 = fmaf(-a.z, x30, x32);
    x32 = fmaf(-a.w, x31, x32);
    outp[32 * rstride] = f2bf(x32);
    float x33 = sc[33] * bf2f(col[4488]);
    a = *(const LAS f32x4*)(Am + 2244);
    x33 = fmaf(-a.x, x0, x33);
    x33 = fmaf(-a.y, x1, x33);
    x33 = fmaf(-a.z, x2, x33);
    x33 = fmaf(-a.w, x3, x33);
    a = *(const LAS f32x4*)(Am + 2248);
    x33 = fmaf(-a.x, x4, x33);
    x33 = fmaf(-a.y, x5, x33);
    x33 = fmaf(-a.z, x6, x33);
    x33 = fmaf(-a.w, x7, x33);
    a = *(const LAS f32x4*)(Am + 2252);
    x33 = fmaf(-a.x, x8, x33);
    x33 = fmaf(-a.y, x9, x33);
    x33 = fmaf(-a.z, x10, x33);
    x33 = fmaf(-a.w, x11, x33);
    a = *(const LAS f32x4*)(Am + 2256);
    x33 = fmaf(-a.x, x12, x33);
    x33 = fmaf(-a.y, x13, x33);
    x33 = fmaf(-a.z, x14, x33);
    x33 = fmaf(-a.w, x15, x33);
    a = *(const LAS f32x4*)(Am + 2260);
    x33 = fmaf(-a.x, x16, x33);
    x33 = fmaf(-a.y, x17, x33);
    x33 = fmaf(-a.z, x18, x33);
    x33 = fmaf(-a.w, x19, x33);
    a = *(const LAS f32x4*)(Am + 2264);
    x33 = fmaf(-a.x, x20, x33);
    x33 = fmaf(-a.y, x21, x33);
    x33 = fmaf(-a.z, x22, x33);
    x33 = fmaf(-a.w, x23, x33);
    a = *(const LAS f32x4*)(Am + 2268);
    x33 = fmaf(-a.x, x24, x33);
    x33 = fmaf(-a.y, x25, x33);
    x33 = fmaf(-a.z, x26, x33);
    x33 = fmaf(-a.w, x27, x33);
    a = *(const LAS f32x4*)(Am + 2272);
    x33 = fmaf(-a.x, x28, x33);
    x33 = fmaf(-a.y, x29, x33);
    x33 = fmaf(-a.z, x30, x33);
    x33 = fmaf(-a.w, x31, x33);
    a = *(const LAS f32x4*)(Am + 2276);
    x33 = fmaf(-a.x, x32, x33);
    outp[33 * rstride] = f2bf(x33);
    float x34 = sc[34] * bf2f(col[4624]);
    a = *(const LAS f32x4*)(Am + 2312);
    x34 = fmaf(-a.x, x0, x34);
    x34 = fmaf(-a.y, x1, x34);
    x34 = fmaf(-a.z, x2, x34);
    x34 = fmaf(-a.w, x3, x34);
    a = *(const LAS f32x4*)(Am + 2316);
    x34 = fmaf(-a.x, x4, x34);
    x34 = fmaf(-a.y, x5, x34);
    x34 = fmaf(-a.z, x6, x34);
    x34 = fmaf(-a.w, x7, x34);
    a = *(const LAS f32x4*)(Am + 2320);
    x34 = fmaf(-a.x, x8, x34);
    x34 = fmaf(-a.y, x9, x34);
    x34 = fmaf(-a.z, x10, x34);
    x34 = fmaf(-a.w, x11, x34);
    a = *(const LAS f32x4*)(Am + 2324);
    x34 = fmaf(-a.x, x12, x34);
    x34 = fmaf(-a.y, x13, x34);
    x34 = fmaf(-a.z, x14, x34);
    x34 = fmaf(-a.w, x15, x34);
    a = *(const LAS f32x4*)(Am + 2328);
    x34 = fmaf(-a.x, x16, x34);
    x34 = fmaf(-a.y, x17, x34);
    x34 = fmaf(-a.z, x18, x34);
    x34 = fmaf(-a.w, x19, x34);
    a = *(const LAS f32x4*)(Am + 2332);
    x34 = fmaf(-a.x, x20, x34);
    x34 = fmaf(-a.y, x21, x34);
    x34 = fmaf(-a.z, x22, x34);
    x34 = fmaf(-a.w, x23, x34);
    a = *(const LAS f32x4*)(Am + 2336);
    x34 = fmaf(-a.x, x24, x34);
    x34 = fmaf(-a.y, x25, x34);
    x34 = fmaf(-a.z, x26, x34);
    x34 = fmaf(-a.w, x27, x34);
    a = *(const LAS f32x4*)(Am + 2340);
    x34 = fmaf(-a.x, x28, x34);
    x34 = fmaf(-a.y, x29, x34);
    x34 = fmaf(-a.z, x30, x34);
    x34 = fmaf(-a.w, x31, x34);
    a = *(const LAS f32x4*)(Am + 2344);
    x34 = fmaf(-a.x, x32, x34);
    x34 = fmaf(-a.y, x33, x34);
    outp[34 * rstride] = f2bf(x34);
    float x35 = sc[35] * bf2f(col[4760]);
    a = *(const LAS f32x4*)(Am + 2380);
    x35 = fmaf(-a.x, x0, x35);
    x35 = fmaf(-a.y, x1, x35);
    x35 = fmaf(-a.z, x2, x35);
    x35 = fmaf(-a.w, x3, x35);
    a = *(const LAS f32x4*)(Am + 2384);
    x35 = fmaf(-a.x, x4, x35);
    x35 = fmaf(-a.y, x5, x35);
    x35 = fmaf(-a.z, x6, x35);
    x35 = fmaf(-a.w, x7, x35);
    a = *(const LAS f32x4*)(Am + 2388);
    x35 = fmaf(-a.x, x8, x35);
    x35 = fmaf(-a.y, x9, x35);
    x35 = fmaf(-a.z, x10, x35);
    x35 = fmaf(-a.w, x11, x35);
    a = *(const LAS f32x4*)(Am + 2392);
    x35 = fmaf(-a.x, x12, x35);
    x35 = fmaf(-a.y, x13, x35);
    x35 = fmaf(-a.z, x14, x35);
    x35 = fmaf(-a.w, x15, x35);
    a = *(const LAS f32x4*)(Am + 2396);
    x35 = fmaf(-a.x, x16, x35);
    x35 = fmaf(-a.y, x17, x35);
    x35 = fmaf(-a.z, x18, x35);
    x35 = fmaf(-a.w, x19, x35);
    a = *(const LAS f32x4*)(Am + 2400);
    x35 = fmaf(-a.x, x20, x35);
    x35 = fmaf(-a.y, x21, x35);
    x35 = fmaf(-a.z, x22, x35);
    x35 = fmaf(-a.w, x23, x35);
    a = *(const LAS f32x4*)(Am + 2404);
    x35 = fmaf(-a.x, x24, x35);
    x35 = fmaf(-a.y, x25, x35);
    x35 = fmaf(-a.z, x26, x35);
    x35 = fmaf(-a.w, x27, x35);
    a = *(const LAS f32x4*)(Am + 2408);
    x35 = fmaf(-a.x, x28, x35);
    x35 = fmaf(-a.y, x29, x35);
    x35 = fmaf(-a.z, x30, x35);
    x35 = fmaf(-a.w, x31, x35);
    a = *(const LAS f32x4*)(Am + 2412);
    x35 = fmaf(-a.x, x32, x35);
    x35 = fmaf(-a.y, x33, x35);
    x35 = fmaf(-a.z, x34, x35);
    outp[35 * rstride] = f2bf(x35);
    float x36 = sc[36] * bf2f(col[4896]);
    a = *(const LAS f32x4*)(Am + 2448);
    x36 = fmaf(-a.x, x0, x36);
    x36 = fmaf(-a.y, x1, x36);
    x36 = fmaf(-a.z, x2, x36);
    x36 = fmaf(-a.w, x3, x36);
    a = *(const LAS f32x4*)(Am + 2452);
    x36 = fmaf(-a.x, x4, x36);
    x36 = fmaf(-a.y, x5, x36);
    x36 = fmaf(-a.z, x6, x36);
    x36 = fmaf(-a.w, x7, x36);
    a = *(const LAS f32x4*)(Am + 2456);
    x36 = fmaf(-a.x, x8, x36);
    x36 = fmaf(-a.y, x9, x36);
    x36 = fmaf(-a.z, x10, x36);
    x36 = fmaf(-a.w, x11, x36);
    a = *(const LAS f32x4*)(Am + 2460);
    x36 = fmaf(-a.x, x12, x36);
    x36 = fmaf(-a.y, x13, x36);
    x36 = fmaf(-a.z, x14, x36);
    x36 = fmaf(-a.w, x15, x36);
    a = *(const LAS f32x4*)(Am + 2464);
    x36 = fmaf(-a.x, x16, x36);
    x36 = fmaf(-a.y, x17, x36);
    x36 = fmaf(-a.z, x18, x36);
    x36 = fmaf(-a.w, x19, x36);
    a = *(const LAS f32x4*)(Am + 2468);
    x36 = fmaf(-a.x, x20, x36);
    x36 = fmaf(-a.y, x21, x36);
    x36 = fmaf(-a.z, x22, x36);
    x36 = fmaf(-a.w, x23, x36);
    a = *(const LAS f32x4*)(Am + 2472);
    x36 = fmaf(-a.x, x24, x36);
    x36 = fmaf(-a.y, x25, x36);
    x36 = fmaf(-a.z, x26, x36);
    x36 = fmaf(-a.w, x27, x36);
    a = *(const LAS f32x4*)(Am + 2476);
    x36 = fmaf(-a.x, x28, x36);
    x36 = fmaf(-a.y, x29, x36);
    x36 = fmaf(-a.z, x30, x36);
    x36 = fmaf(-a.w, x31, x36);
    a = *(const LAS f32x4*)(Am + 2480);
    x36 = fmaf(-a.x, x32, x36);
    x36 = fmaf(-a.y, x33, x36);
    x36 = fmaf(-a.z, x34, x36);
    x36 = fmaf(-a.w, x35, x36);
    outp[36 * rstride] = f2bf(x36);
    float x37 = sc[37] * bf2f(col[5032]);
    a = *(const LAS f32x4*)(Am + 2516);
    x37 = fmaf(-a.x, x0, x37);
    x37 = fmaf(-a.y, x1, x37);
    x37 = fmaf(-a.z, x2, x37);
    x37 = fmaf(-a.w, x3, x37);
    a = *(const LAS f32x4*)(Am + 2520);
    x37 = fmaf(-a.x, x4, x37);
    x37 = fmaf(-a.y, x5, x37);
    x37 = fmaf(-a.z, x6, x37);
    x37 = fmaf(-a.w, x7, x37);
    a = *(const LAS f32x4*)(Am + 2524);
    x37 = fmaf(-a.x, x8, x37);
    x37 = fmaf(-a.y, x9, x37);
    x37 = fmaf(-a.z, x10, x37);
    x37 = fmaf(-a.w, x11, x37);
    a = *(const LAS f32x4*)(Am + 2528);
    x37 = fmaf(-a.x, x12, x37);
    x37 = fmaf(-a.y, x13, x37);
    x37 = fmaf(-a.z, x14, x37);
    x37 = fmaf(-a.w, x15, x37);
    a = *(const LAS f32x4*)(Am + 2532);
    x37 = fmaf(-a.x, x16, x37);
    x37 = fmaf(-a.y, x17, x37);
    x37 = fmaf(-a.z, x18, x37);
    x37 = fmaf(-a.w, x19, x37);
    a = *(const LAS f32x4*)(Am + 2536);
    x37 = fmaf(-a.x, x20, x37);
    x37 = fmaf(-a.y, x21, x37);
    x37 = fmaf(-a.z, x22, x37);
    x37 = fmaf(-a.w, x23, x37);
    a = *(const LAS f32x4*)(Am + 2540);
    x37 = fmaf(-a.x, x24, x37);
    x37 = fmaf(-a.y, x25, x37);
    x37 = fmaf(-a.z, x26, x37);
    x37 = fmaf(-a.w, x27, x37);
    a = *(const LAS f32x4*)(Am + 2544);
    x37 = fmaf(-a.x, x28, x37);
    x37 = fmaf(-a.y, x29, x37);
    x37 = fmaf(-a.z, x30, x37);
    x37 = fmaf(-a.w, x31, x37);
    a = *(const LAS f32x4*)(Am + 2548);
    x37 = fmaf(-a.x, x32, x37);
    x37 = fmaf(-a.y, x33, x37);
    x37 = fmaf(-a.z, x34, x37);
    x37 = fmaf(-a.w, x35, x37);
    a = *(const LAS f32x4*)(Am + 2552);
    x37 = fmaf(-a.x, x36, x37);
    outp[37 * rstride] = f2bf(x37);
    float x38 = sc[38] * bf2f(col[5168]);
    a = *(const LAS f32x4*)(Am + 2584);
    x38 = fmaf(-a.x, x0, x38);
    x38 = fmaf(-a.y, x1, x38);
    x38 = fmaf(-a.z, x2, x38);
    x38 = fmaf(-a.w, x3, x38);
    a = *(const LAS f32x4*)(Am + 2588);
    x38 = fmaf(-a.x, x4, x38);
    x38 = fmaf(-a.y, x5, x38);
    x38 = fmaf(-a.z, x6, x38);
    x38 = fmaf(-a.w, x7, x38);
    a = *(const LAS f32x4*)(Am + 2592);
    x38 = fmaf(-a.x, x8, x38);
    x38 = fmaf(-a.y, x9, x38);
    x38 = fmaf(-a.z, x10, x38);
    x38 = fmaf(-a.w, x11, x38);
    a = *(const LAS f32x4*)(Am + 2596);
    x38 = fmaf(-a.x, x12, x38);
    x38 = fmaf(-a.y, x13, x38);
    x38 = fmaf(-a.z, x14, x38);
    x38 = fmaf(-a.w, x15, x38);
    a = *(const LAS f32x4*)(Am + 2600);
    x38 = fmaf(-a.x, x16, x38);
    x38 = fmaf(-a.y, x17, x38);
    x38 = fmaf(-a.z, x18, x38);
    x38 = fmaf(-a.w, x19, x38);
    a = *(const LAS f32x4*)(Am + 2604);
    x38 = fmaf(-a.x, x20, x38);
    x38 = fmaf(-a.y, x21, x38);
    x38 = fmaf(-a.z, x22, x38);
    x38 = fmaf(-a.w, x23, x38);
    a = *(const LAS f32x4*)(Am + 2608);
    x38 = fmaf(-a.x, x24, x38);
    x38 = fmaf(-a.y, x25, x38);
    x38 = fmaf(-a.z, x26, x38);
    x38 = fmaf(-a.w, x27, x38);
    a = *(const LAS f32x4*)(Am + 2612);
    x38 = fmaf(-a.x, x28, x38);
    x38 = fmaf(-a.y, x29, x38);
    x38 = fmaf(-a.z, x30, x38);
    x38 = fmaf(-a.w, x31, x38);
    a = *(const LAS f32x4*)(Am + 2616);
    x38 = fmaf(-a.x, x32, x38);
    x38 = fmaf(-a.y, x33, x38);
    x38 = fmaf(-a.z, x34, x38);
    x38 = fmaf(-a.w, x35, x38);
    a = *(const LAS f32x4*)(Am + 2620);
    x38 = fmaf(-a.x, x36, x38);
    x38 = fmaf(-a.y, x37, x38);
    outp[38 * rstride] = f2bf(x38);
    float x39 = sc[39] * bf2f(col[5304]);
    a = *(const LAS f32x4*)(Am + 2652);
    x39 = fmaf(-a.x, x0, x39);
    x39 = fmaf(-a.y, x1, x39);
    x39 = fmaf(-a.z, x2, x39);
    x39 = fmaf(-a.w, x3, x39);
    a = *(const LAS f32x4*)(Am + 2656);
    x39 = fmaf(-a.x, x4, x39);
    x39 = fmaf(-a.y, x5, x39);
    x39 = fmaf(-a.z, x6, x39);
    x39 = fmaf(-a.w, x7, x39);
    a = *(const LAS f32x4*)(Am + 2660);
    x39 = fmaf(-a.x, x8, x39);
    x39 = fmaf(-a.y, x9, x39);
    x39 = fmaf(-a.z, x10, x39);
    x39 = fmaf(-a.w, x11, x39);
    a = *(const LAS f32x4*)(Am + 2664);
    x39 = fmaf(-a.x, x12, x39);
    x39 = fmaf(-a.y, x13, x39);
    x39 = fmaf(-a.z, x14, x39);
    x39 = fmaf(-a.w, x15, x39);
    a = *(const LAS f32x4*)(Am + 2668);
    x39 = fmaf(-a.x, x16, x39);
    x39 = fmaf(-a.y, x17, x39);
    x39 = fmaf(-a.z, x18, x39);
    x39 = fmaf(-a.w, x19, x39);
    a = *(const LAS f32x4*)(Am + 2672);
    x39 = fmaf(-a.x, x20, x39);
    x39 = fmaf(-a.y, x21, x39);
    x39 = fmaf(-a.z, x22, x39);
    x39 = fmaf(-a.w, x23, x39);
    a = *(const LAS f32x4*)(Am + 2676);
    x39 = fmaf(-a.x, x24, x39);
    x39 = fmaf(-a.y, x25, x39);
    x39 = fmaf(-a.z, x26, x39);
    x39 = fmaf(-a.w, x27, x39);
    a = *(const LAS f32x4*)(Am + 2680);
    x39 = fmaf(-a.x, x28, x39);
    x39 = fmaf(-a.y, x29, x39);
    x39 = fmaf(-a.z, x30, x39);
    x39 = fmaf(-a.w, x31, x39);
    a = *(const LAS f32x4*)(Am + 2684);
    x39 = fmaf(-a.x, x32, x39);
    x39 = fmaf(-a.y, x33, x39);
    x39 = fmaf(-a.z, x34, x39);
    x39 = fmaf(-a.w, x35, x39);
    a = *(const LAS f32x4*)(Am + 2688);
    x39 = fmaf(-a.x, x36, x39);
    x39 = fmaf(-a.y, x37, x39);
    x39 = fmaf(-a.z, x38, x39);
    outp[39 * rstride] = f2bf(x39);
    float x40 = sc[40] * bf2f(col[5440]);
    a = *(const LAS f32x4*)(Am + 2720);
    x40 = fmaf(-a.x, x0, x40);
    x40 = fmaf(-a.y, x1, x40);
    x40 = fmaf(-a.z, x2, x40);
    x40 = fmaf(-a.w, x3, x40);
    a = *(const LAS f32x4*)(Am + 2724);
    x40 = fmaf(-a.x, x4, x40);
    x40 = fmaf(-a.y, x5, x40);
    x40 = fmaf(-a.z, x6, x40);
    x40 = fmaf(-a.w, x7, x40);
    a = *(const LAS f32x4*)(Am + 2728);
    x40 = fmaf(-a.x, x8, x40);
    x40 = fmaf(-a.y, x9, x40);
    x40 = fmaf(-a.z, x10, x40);
    x40 = fmaf(-a.w, x11, x40);
    a = *(const LAS f32x4*)(Am + 2732);
    x40 = fmaf(-a.x, x12, x40);
    x40 = fmaf(-a.y, x13, x40);
    x40 = fmaf(-a.z, x14, x40);
    x40 = fmaf(-a.w, x15, x40);
    a = *(const LAS f32x4*)(Am + 2736);
    x40 = fmaf(-a.x, x16, x40);
    x40 = fmaf(-a.y, x17, x40);
    x40 = fmaf(-a.z, x18, x40);
    x40 = fmaf(-a.w, x19, x40);
    a = *(const LAS f32x4*)(Am + 2740);
    x40 = fmaf(-a.x, x20, x40);
    x40 = fmaf(-a.y, x21, x40);
    x40 = fmaf(-a.z, x22, x40);
    x40 = fmaf(-a.w, x23, x40);
    a = *(const LAS f32x4*)(Am + 2744);
    x40 = fmaf(-a.x, x24, x40);
    x40 = fmaf(-a.y, x25, x40);
    x40 = fmaf(-a.z, x26, x40);
    x40 = fmaf(-a.w, x27, x40);
    a = *(const LAS f32x4*)(Am + 2748);
    x40 = fmaf(-a.x, x28, x40);
    x40 = fmaf(-a.y, x29, x40);
    x40 = fmaf(-a.z, x30, x40);
    x40 = fmaf(-a.w, x31, x40);
    a = *(const LAS f32x4*)(Am + 2752);
    x40 = fmaf(-a.x, x32, x40);
    x40 = fmaf(-a.y, x33, x40);
    x40 = fmaf(-a.z, x34, x40);
    x40 = fmaf(-a.w, x35, x40);
    a = *(const LAS f32x4*)(Am + 2756);
    x40 = fmaf(-a.x, x36, x40);
    x40 = fmaf(-a.y, x37, x40);
    x40 = fmaf(-a.z, x38, x40);
    x40 = fmaf(-a.w, x39, x40);
    outp[40 * rstride] = f2bf(x40);
    float x41 = sc[41] * bf2f(col[5576]);
    a = *(const LAS f32x4*)(Am + 2788);
    x41 = fmaf(-a.x, x0, x41);
    x41 = fmaf(-a.y, x1, x41);
    x41 = fmaf(-a.z, x2, x41);
    x41 = fmaf(-a.w, x3, x41);
    a = *(const LAS f32x4*)(Am + 2792);
    x41 = fmaf(-a.x, x4, x41);
    x41 = fmaf(-a.y, x5, x41);
    x41 = fmaf(-a.z, x6, x41);
    x41 = fmaf(-a.w, x7, x41);
    a = *(const LAS f32x4*)(Am + 2796);
    x41 = fmaf(-a.x, x8, x41);
    x41 = fmaf(-a.y, x9, x41);
    x41 = fmaf(-a.z, x10, x41);
    x41 = fmaf(-a.w, x11, x41);
    a = *(const LAS f32x4*)(Am + 2800);
    x41 = fmaf(-a.x, x12, x41);
    x41 = fmaf(-a.y, x13, x41);
    x41 = fmaf(-a.z, x14, x41);
    x41 = fmaf(-a.w, x15, x41);
    a = *(const LAS f32x4*)(Am + 2804);
    x41 = fmaf(-a.x, x16, x41);
    x41 = fmaf(-a.y, x17, x41);
    x41 = fmaf(-a.z, x18, x41);
    x41 = fmaf(-a.w, x19, x41);
    a = *(const LAS f32x4*)(Am + 2808);
    x41 = fmaf(-a.x, x20, x41);
    x41 = fmaf(-a.y, x21, x41);
    x41 = fmaf(-a.z, x22, x41);
    x41 = fmaf(-a.w, x23, x41);
    a = *(const LAS f32x4*)(Am + 2812);
    x41 = fmaf(-a.x, x24, x41);
    x41 = fmaf(-a.y, x25, x41);
    x41 = fmaf(-a.z, x26, x41);
    x41 = fmaf(-a.w, x27, x41);
    a = *(const LAS f32x4*)(Am + 2816);
    x41 = fmaf(-a.x, x28, x41);
    x41 = fmaf(-a.y, x29, x41);
    x41 = fmaf(-a.z, x30, x41);
    x41 = fmaf(-a.w, x31, x41);
    a = *(const LAS f32x4*)(Am + 2820);
    x41 = fmaf(-a.x, x32, x41);
    x41 = fmaf(-a.y, x33, x41);
    x41 = fmaf(-a.z, x34, x41);
    x41 = fmaf(-a.w, x35, x41);
    a = *(const LAS f32x4*)(Am + 2824);
    x41 = fmaf(-a.x, x36, x41);
    x41 = fmaf(-a.y, x37, x41);
    x41 = fmaf(-a.z, x38, x41);
    x41 = fmaf(-a.w, x39, x41);
    a = *(const LAS f32x4*)(Am + 2828);
    x41 = fmaf(-a.x, x40, x41);
    outp[41 * rstride] = f2bf(x41);
    float x42 = sc[42] * bf2f(col[5712]);
    a = *(const LAS f32x4*)(Am + 2856);
    x42 = fmaf(-a.x, x0, x42);
    x42 = fmaf(-a.y, x1, x42);
    x42 = fmaf(-a.z, x2, x42);
    x42 = fmaf(-a.w, x3, x42);
    a = *(const LAS f32x4*)(Am + 2860);
    x42 = fmaf(-a.x, x4, x42);
    x42 = fmaf(-a.y, x5, x42);
    x42 = fmaf(-a.z, x6, x42);
    x42 = fmaf(-a.w, x7, x42);
    a = *(const LAS f32x4*)(Am + 2864);
    x42 = fmaf(-a.x, x8, x42);
    x42 = fmaf(-a.y, x9, x42);
    x42 = fmaf(-a.z, x10, x42);
    x42 = fmaf(-a.w, x11, x42);
    a = *(const LAS f32x4*)(Am + 2868);
    x42 = fmaf(-a.x, x12, x42);
    x42 = fmaf(-a.y, x13, x42);
    x42 = fmaf(-a.z, x14, x42);
    x42 = fmaf(-a.w, x15, x42);
    a = *(const LAS f32x4*)(Am + 2872);
    x42 = fmaf(-a.x, x16, x42);
    x42 = fmaf(-a.y, x17, x42);
    x42 = fmaf(-a.z, x18, x42);
    x42 = fmaf(-a.w, x19, x42);
    a = *(const LAS f32x4*)(Am + 2876);
    x42 = fmaf(-a.x, x20, x42);
    x42 = fmaf(-a.y, x21, x42);
    x42 = fmaf(-a.z, x22, x42);
    x42 = fmaf(-a.w, x23, x42);
    a = *(const LAS f32x4*)(Am + 2880);
    x42 = fmaf(-a.x, x24, x42);
    x42 = fmaf(-a.y, x25, x42);
    x42 = fmaf(-a.z, x26, x42);
    x42 = fmaf(-a.w, x27, x42);
    a = *(const LAS f32x4*)(Am + 2884);
    x42 = fmaf(-a.x, x28, x42);
    x42 = fmaf(-a.y, x29, x42);
    x42 = fmaf(-a.z, x30, x42);
    x42 = fmaf(-a.w, x31, x42);
    a = *(const LAS f32x4*)(Am + 2888);
    x42 = fmaf(-a.x, x32, x42);
    x42 = fmaf(-a.y, x33, x42);
    x42 = fmaf(-a.z, x34, x42);
    x42 = fmaf(-a.w, x35, x42);
    a = *(const LAS f32x4*)(Am + 2892);
    x42 = fmaf(-a.x, x36, x42);
    x42 = fmaf(-a.y, x37, x42);
    x42 = fmaf(-a.z, x38, x42);
    x42 = fmaf(-a.w, x39, x42);
    a = *(const LAS f32x4*)(Am + 2896);
    x42 = fmaf(-a.x, x40, x42);
    x42 = fmaf(-a.y, x41, x42);
    outp[42 * rstride] = f2bf(x42);
    float x43 = sc[43] * bf2f(col[5848]);
    a = *(const LAS f32x4*)(Am + 2924);
    x43 = fmaf(-a.x, x0, x43);
    x43 = fmaf(-a.y, x1, x43);
    x43 = fmaf(-a.z, x2, x43);
    x43 = fmaf(-a.w, x3, x43);
    a = *(const LAS f32x4*)(Am + 2928);
    x43 = fmaf(-a.x, x4, x43);
    x43 = fmaf(-a.y, x5, x43);
    x43 = fmaf(-a.z, x6, x43);
    x43 = fmaf(-a.w, x7, x43);
    a = *(const LAS f32x4*)(Am + 2932);
    x43 = fmaf(-a.x, x8, x43);
    x43 = fmaf(-a.y, x9, x43);
    x43 = fmaf(-a.z, x10, x43);
    x43 = fmaf(-a.w, x11, x43);
    a = *(const LAS f32x4*)(Am + 2936);
    x43 = fmaf(-a.x, x12, x43);
    x43 = fmaf(-a.y, x13, x43);
    x43 = fmaf(-a.z, x14, x43);
    x43 = fmaf(-a.w, x15, x43);
    a = *(const LAS f32x4*)(Am + 2940);
    x43 = fmaf(-a.x, x16, x43);
    x43 = fmaf(-a.y, x17, x43);
    x43 = fmaf(-a.z, x18, x43);
    x43 = fmaf(-a.w, x19, x43);
    a = *(const LAS f32x4*)(Am + 2944);
    x43 = fmaf(-a.x, x20, x43);
    x43 = fmaf(-a.y, x21, x43);
    x43 = fmaf(-a.z, x22, x43);
    x43 = fmaf(-a.w, x23, x43);
    a = *(const LAS f32x4*)(Am + 2948);
    x43 = fmaf(-a.x, x24, x43);
    x43 = fmaf(-a.y, x25, x43);
    x43 = fmaf(-a.z, x26, x43);
    x43 = fmaf(-a.w, x27, x43);
    a = *(const LAS f32x4*)(Am + 2952);
    x43 = fmaf(-a.x, x28, x43);
    x43 = fmaf(-a.y, x29, x43);
    x43 = fmaf(-a.z, x30, x43);
    x43 = fmaf(-a.w, x31, x43);
    a = *(const LAS f32x4*)(Am + 2956);
    x43 = fmaf(-a.x, x32, x43);
    x43 = fmaf(-a.y, x33, x43);
    x43 = fmaf(-a.z, x34, x43);
    x43 = fmaf(-a.w, x35, x43);
    a = *(const LAS f32x4*)(Am + 2960);
    x43 = fmaf(-a.x, x36, x43);
    x43 = fmaf(-a.y, x37, x43);
    x43 = fmaf(-a.z, x38, x43);
    x43 = fmaf(-a.w, x39, x43);
    a = *(const LAS f32x4*)(Am + 2964);
    x43 = fmaf(-a.x, x40, x43);
    x43 = fmaf(-a.y, x41, x43);
    x43 = fmaf(-a.z, x42, x43);
    outp[43 * rstride] = f2bf(x43);
    float x44 = sc[44] * bf2f(col[5984]);
    a = *(const LAS f32x4*)(Am + 2992);
    x44 = fmaf(-a.x, x0, x44);
    x44 = fmaf(-a.y, x1, x44);
    x44 = fmaf(-a.z, x2, x44);
    x44 = fmaf(-a.w, x3, x44);
    a = *(const LAS f32x4*)(Am + 2996);
    x44 = fmaf(-a.x, x4, x44);
    x44 = fmaf(-a.y, x5, x44);
    x44 = fmaf(-a.z, x6, x44);
    x44 = fmaf(-a.w, x7, x44);
    a = *(const LAS f32x4*)(Am + 3000);
    x44 = fmaf(-a.x, x8, x44);
    x44 = fmaf(-a.y, x9, x44);
    x44 = fmaf(-a.z, x10, x44);
    x44 = fmaf(-a.w, x11, x44);
    a = *(const LAS f32x4*)(Am + 3004);
    x44 = fmaf(-a.x, x12, x44);
    x44 = fmaf(-a.y, x13, x44);
    x44 = fmaf(-a.z, x14, x44);
    x44 = fmaf(-a.w, x15, x44);
    a = *(const LAS f32x4*)(Am + 3008);
    x44 = fmaf(-a.x, x16, x44);
    x44 = fmaf(-a.y, x17, x44);
    x44 = fmaf(-a.z, x18, x44);
    x44 = fmaf(-a.w, x19, x44);
    a = *(const LAS f32x4*)(Am + 3012);
    x44 = fmaf(-a.x, x20, x44);
    x44 = fmaf(-a.y, x21, x44);
    x44 = fmaf(-a.z, x22, x44);
    x44 = fmaf(-a.w, x23, x44);
    a = *(const LAS f32x4*)(Am + 3016);
    x44 = fmaf(-a.x, x24, x44);
    x44 = fmaf(-a.y, x25, x44);
    x44 = fmaf(-a.z, x26, x44);
    x44 = fmaf(-a.w, x27, x44);
    a = *(const LAS f32x4*)(Am + 3020);
    x44 = fmaf(-a.x, x28, x44);
    x44 = fmaf(-a.y, x29, x44);
    x44 = fmaf(-a.z, x30, x44);
    x44 = fmaf(-a.w, x31, x44);
    a = *(const LAS f32x4*)(Am + 3024);
    x44 = fmaf(-a.x, x32, x44);
    x44 = fmaf(-a.y, x33, x44);
    x44 = fmaf(-a.z, x34, x44);
    x44 = fmaf(-a.w, x35, x44);
    a = *(const LAS f32x4*)(Am + 3028);
    x44 = fmaf(-a.x, x36, x44);
    x44 = fmaf(-a.y, x37, x44);
    x44 = fmaf(-a.z, x38, x44);
    x44 = fmaf(-a.w, x39, x44);
    a = *(const LAS f32x4*)(Am + 3032);
    x44 = fmaf(-a.x, x40, x44);
    x44 = fmaf(-a.y, x41, x44);
    x44 = fmaf(-a.z, x42, x44);
    x44 = fmaf(-a.w, x43, x44);
    outp[44 * rstride] = f2bf(x44);
    float x45 = sc[45] * bf2f(col[6120]);
    a = *(const LAS f32x4*)(Am + 3060);
    x45 = fmaf(-a.x, x0, x45);
    x45 = fmaf(-a.y, x1, x45);
    x45 = fmaf(-a.z, x2, x45);
    x45 = fmaf(-a.w, x3, x45);
    a = *(const LAS f32x4*)(Am + 3064);
    x45 = fmaf(-a.x, x4, x45);
    x45 = fmaf(-a.y, x5, x45);
    x45 = fmaf(-a.z, x6, x45);
    x45 = fmaf(-a.w, x7, x45);
    a = *(const LAS f32x4*)(Am + 3068);
    x45 = fmaf(-a.x, x8, x45);
    x45 = fmaf(-a.y, x9, x45);
    x45 = fmaf(-a.z, x10, x45);
    x45 = fmaf(-a.w, x11, x45);
    a = *(const LAS f32x4*)(Am + 3072);
    x45 = fmaf(-a.x, x12, x45);
    x45 = fmaf(-a.y, x13, x45);
    x45 = fmaf(-a.z, x14, x45);
    x45 = fmaf(-a.w, x15, x45);
    a = *(const LAS f32x4*)(Am + 3076);
    x45 = fmaf(-a.x, x16, x45);
    x45 = fmaf(-a.y, x17, x45);
    x45 = fmaf(-a.z, x18, x45);
    x45 = fmaf(-a.w, x19, x45);
    a = *(const LAS f32x4*)(Am + 3080);
    x45 = fmaf(-a.x, x20, x45);
    x45 = fmaf(-a.y, x21, x45);
    x45 = fmaf(-a.z, x22, x45);
    x45 = fmaf(-a.w, x23, x45);
    a = *(const LAS f32x4*)(Am + 3084);
    x45 = fmaf(-a.x, x24, x45);
    x45 = fmaf(-a.y, x25, x45);
    x45 = fmaf(-a.z, x26, x45);
    x45 = fmaf(-a.w, x27, x45);
    a = *(const LAS f32x4*)(Am + 3088);
    x45 = fmaf(-a.x, x28, x45);
    x45 = fmaf(-a.y, x29, x45);
    x45 = fmaf(-a.z, x30, x45);
    x45 = fmaf(-a.w, x31, x45);
    a = *(const LAS f32x4*)(Am + 3092);
    x45 = fmaf(-a.x, x32, x45);
    x45 = fmaf(-a.y, x33, x45);
    x45 = fmaf(-a.z, x34, x45);
    x45 = fmaf(-a.w, x35, x45);
    a = *(const LAS f32x4*)(Am + 3096);
    x45 = fmaf(-a.x, x36, x45);
    x45 = fmaf(-a.y, x37, x45);
    x45 = fmaf(-a.z, x38, x45);
    x45 = fmaf(-a.w, x39, x45);
    a = *(const LAS f32x4*)(Am + 3100);
    x45 = fmaf(-a.x, x40, x45);
    x45 = fmaf(-a.y, x41, x45);
    x45 = fmaf(-a.z, x42, x45);
    x45 = fmaf(-a.w, x43, x45);
    a = *(const LAS f32x4*)(Am + 3104);
    x45 = fmaf(-a.x, x44, x45);
    outp[45 * rstride] = f2bf(x45);
    float x46 = sc[46] * bf2f(col[6256]);
    a = *(const LAS f32x4*)(Am + 3128);
    x46 = fmaf(-a.x, x0, x46);
    x46 = fmaf(-a.y, x1, x46);
    x46 = fmaf(-a.z, x2, x46);
    x46 = fmaf(-a.w, x3, x46);
    a = *(const LAS f32x4*)(Am + 3132);
    x46 = fmaf(-a.x, x4, x46);
    x46 = fmaf(-a.y, x5, x46);
    x46 = fmaf(-a.z, x6, x46);
    x46 = fmaf(-a.w, x7, x46);
    a = *(const LAS f32x4*)(Am + 3136);
    x46 = fmaf(-a.x, x8, x46);
    x46 = fmaf(-a.y, x9, x46);
    x46 = fmaf(-a.z, x10, x46);
    x46 = fmaf(-a.w, x11, x46);
    a = *(const LAS f32x4*)(Am + 3140);
    x46 = fmaf(-a.x, x12, x46);
    x46 = fmaf(-a.y, x13, x46);
    x46 = fmaf(-a.z, x14, x46);
    x46 = fmaf(-a.w, x15, x46);
    a = *(const LAS f32x4*)(Am + 3144);
    x46 = fmaf(-a.x, x16, x46);
    x46 = fmaf(-a.y, x17, x46);
    x46 = fmaf(-a.z, x18, x46);
    x46 = fmaf(-a.w, x19, x46);
    a = *(const LAS f32x4*)(Am + 3148);
    x46 = fmaf(-a.x, x20, x46);
    x46 = fmaf(-a.y, x21, x46);
    x46 = fmaf(-a.z, x22, x46);
    x46 = fmaf(-a.w, x23, x46);
    a = *(const LAS f32x4*)(Am + 3152);
    x46 = fmaf(-a.x, x24, x46);
    x46 = fmaf(-a.y, x25, x46);
    x46 = fmaf(-a.z, x26, x46);
    x46 = fmaf(-a.w, x27, x46);
    a = *(const LAS f32x4*)(Am + 3156);
    x46 = fmaf(-a.x, x28, x46);
    x46 = fmaf(-a.y, x29, x46);
    x46 = fmaf(-a.z, x30, x46);
    x46 = fmaf(-a.w, x31, x46);
    a = *(const LAS f32x4*)(Am + 3160);
    x46 = fmaf(-a.x, x32, x46);
    x46 = fmaf(-a.y, x33, x46);
    x46 = fmaf(-a.z, x34, x46);
    x46 = fmaf(-a.w, x35, x46);
    a = *(const LAS f32x4*)(Am + 3164);
    x46 = fmaf(-a.x, x36, x46);
    x46 = fmaf(-a.y, x37, x46);
    x46 = fmaf(-a.z, x38, x46);
    x46 = fmaf(-a.w, x39, x46);
    a = *(const LAS f32x4*)(Am + 3168);
    x46 = fmaf(-a.x, x40, x46);
    x46 = fmaf(-a.y, x41, x46);
    x46 = fmaf(-a.z, x42, x46);
    x46 = fmaf(-a.w, x43, x46);
    a = *(const LAS f32x4*)(Am + 3172);
    x46 = fmaf(-a.x, x44, x46);
    x46 = fmaf(-a.y, x45, x46);
    outp[46 * rstride] = f2bf(x46);
    float x47 = sc[47] * bf2f(col[6392]);
    a = *(const LAS f32x4*)(Am + 3196);
    x47 = fmaf(-a.x, x0, x47);
    x47 = fmaf(-a.y, x1, x47);
    x47 = fmaf(-a.z, x2, x47);
    x47 = fmaf(-a.w, x3, x47);
    a = *(const LAS f32x4*)(Am + 3200);
    x47 = fmaf(-a.x, x4, x47);
    x47 = fmaf(-a.y, x5, x47);
    x47 = fmaf(-a.z, x6, x47);
    x47 = fmaf(-a.w, x7, x47);
    a = *(const LAS f32x4*)(Am + 3204);
    x47 = fmaf(-a.x, x8, x47);
    x47 = fmaf(-a.y, x9, x47);
    x47 = fmaf(-a.z, x10, x47);
    x47 = fmaf(-a.w, x11, x47);
    a = *(const LAS f32x4*)(Am + 3208);
    x47 = fmaf(-a.x, x12, x47);
    x47 = fmaf(-a.y, x13, x47);
    x47 = fmaf(-a.z, x14, x47);
    x47 = fmaf(-a.w, x15, x47);
    a = *(const LAS f32x4*)(Am + 3212);
    x47 = fmaf(-a.x, x16, x47);
    x47 = fmaf(-a.y, x17, x47);
    x47 = fmaf(-a.z, x18, x47);
    x47 = fmaf(-a.w, x19, x47);
    a = *(const LAS f32x4*)(Am + 3216);
    x47 = fmaf(-a.x, x20, x47);
    x47 = fmaf(-a.y, x21, x47);
    x47 = fmaf(-a.z, x22, x47);
    x47 = fmaf(-a.w, x23, x47);
    a = *(const LAS f32x4*)(Am + 3220);
    x47 = fmaf(-a.x, x24, x47);
    x47 = fmaf(-a.y, x25, x47);
    x47 = fmaf(-a.z, x26, x47);
    x47 = fmaf(-a.w, x27, x47);
    a = *(const LAS f32x4*)(Am + 3224);
    x47 = fmaf(-a.x, x28, x47);
    x47 = fmaf(-a.y, x29, x47);
    x47 = fmaf(-a.z, x30, x47);
    x47 = fmaf(-a.w, x31, x47);
    a = *(const LAS f32x4*)(Am + 3228);
    x47 = fmaf(-a.x, x32, x47);
    x47 = fmaf(-a.y, x33, x47);
    x47 = fmaf(-a.z, x34, x47);
    x47 = fmaf(-a.w, x35, x47);
    a = *(const LAS f32x4*)(Am + 3232);
    x47 = fmaf(-a.x, x36, x47);
    x47 = fmaf(-a.y, x37, x47);
    x47 = fmaf(-a.z, x38, x47);
    x47 = fmaf(-a.w, x39, x47);
    a = *(const LAS f32x4*)(Am + 3236);
    x47 = fmaf(-a.x, x40, x47);
    x47 = fmaf(-a.y, x41, x47);
    x47 = fmaf(-a.z, x42, x47);
    x47 = fmaf(-a.w, x43, x47);
    a = *(const LAS f32x4*)(Am + 3240);
    x47 = fmaf(-a.x, x44, x47);
    x47 = fmaf(-a.y, x45, x47);
    x47 = fmaf(-a.z, x46, x47);
    outp[47 * rstride] = f2bf(x47);
    float x48 = sc[48] * bf2f(col[6528]);
    a = *(const LAS f32x4*)(Am + 3264);
    x48 = fmaf(-a.x, x0, x48);
    x48 = fmaf(-a.y, x1, x48);
    x48 = fmaf(-a.z, x2, x48);
    x48 = fmaf(-a.w, x3, x48);
    a = *(const LAS f32x4*)(Am + 3268);
    x48 = fmaf(-a.x, x4, x48);
    x48 = fmaf(-a.y, x5, x48);
    x48 = fmaf(-a.z, x6, x48);
    x48 = fmaf(-a.w, x7, x48);
    a = *(const LAS f32x4*)(Am + 3272);
    x48 = fmaf(-a.x, x8, x48);
    x48 = fmaf(-a.y, x9, x48);
    x48 = fmaf(-a.z, x10, x48);
    x48 = fmaf(-a.w, x11, x48);
    a = *(const LAS f32x4*)(Am + 3276);
    x48 = fmaf(-a.x, x12, x48);
    x48 = fmaf(-a.y, x13, x48);
    x48 = fmaf(-a.z, x14, x48);
    x48 = fmaf(-a.w, x15, x48);
    a = *(const LAS f32x4*)(Am + 3280);
    x48 = fmaf(-a.x, x16, x48);
    x48 = fmaf(-a.y, x17, x48);
    x48 = fmaf(-a.z, x18, x48);
    x48 = fmaf(-a.w, x19, x48);
    a = *(const LAS f32x4*)(Am + 3284);
    x48 = fmaf(-a.x, x20, x48);
    x48 = fmaf(-a.y, x21, x48);
    x48 = fmaf(-a.z, x22, x48);
    x48 = fmaf(-a.w, x23, x48);
    a = *(const LAS f32x4*)(Am + 3288);
    x48 = fmaf(-a.x, x24, x48);
    x48 = fmaf(-a.y, x25, x48);
    x48 = fmaf(-a.z, x26, x48);
    x48 = fmaf(-a.w, x27, x48);
    a = *(const LAS f32x4*)(Am + 3292);
    x48 = fmaf(-a.x, x28, x48);
    x48 = fmaf(-a.y, x29, x48);
    x48 = fmaf(-a.z, x30, x48);
    x48 = fmaf(-a.w, x31, x48);
    a = *(const LAS f32x4*)(Am + 3296);
    x48 = fmaf(-a.x, x32, x48);
    x48 = fmaf(-a.y, x33, x48);
    x48 = fmaf(-a.z, x34, x48);
    x48 = fmaf(-a.w, x35, x48);
    a = *(const LAS f32x4*)(Am + 3300);
    x48 = fmaf(-a.x, x36, x48);
    x48 = fmaf(-a.y, x37, x48);
    x48 = fmaf(-a.z, x38, x48);
    x48 = fmaf(-a.w, x39, x48);
    a = *(const LAS f32x4*)(Am + 3304);
    x48 = fmaf(-a.x, x40, x48);
    x48 = fmaf(-a.y, x41, x48);
    x48 = fmaf(-a.z, x42, x48);
    x48 = fmaf(-a.w, x43, x48);
    a = *(const LAS f32x4*)(Am + 3308);
    x48 = fmaf(-a.x, x44, x48);
    x48 = fmaf(-a.y, x45, x48);
    x48 = fmaf(-a.z, x46, x48);
    x48 = fmaf(-a.w, x47, x48);
    outp[48 * rstride] = f2bf(x48);
    float x49 = sc[49] * bf2f(col[6664]);
    a = *(const LAS f32x4*)(Am + 3332);
    x49 = fmaf(-a.x, x0, x49);
    x49 = fmaf(-a.y, x1, x49);
    x49 = fmaf(-a.z, x2, x49);
    x49 = fmaf(-a.w, x3, x49);
    a = *(const LAS f32x4*)(Am + 3336);
    x49 = fmaf(-a.x, x4, x49);
    x49 = fmaf(-a.y, x5, x49);
    x49 = fmaf(-a.z, x6, x49);
    x49 = fmaf(-a.w, x7, x49);
    a = *(const LAS f32x4*)(Am + 3340);
    x49 = fmaf(-a.x, x8, x49);
    x49 = fmaf(-a.y, x9, x49);
    x49 = fmaf(-a.z, x10, x49);
    x49 = fmaf(-a.w, x11, x49);
    a = *(const LAS f32x4*)(Am + 3344);
    x49 = fmaf(-a.x, x12, x49);
    x49 = fmaf(-a.y, x13, x49);
    x49 = fmaf(-a.z, x14, x49);
    x49 = fmaf(-a.w, x15, x49);
    a = *(const LAS f32x4*)(Am + 3348);
    x49 = fmaf(-a.x, x16, x49);
    x49 = fmaf(-a.y, x17, x49);
    x49 = fmaf(-a.z, x18, x49);
    x49 = fmaf(-a.w, x19, x49);
    a = *(const LAS f32x4*)(Am + 3352);
    x49 = fmaf(-a.x, x20, x49);
    x49 = fmaf(-a.y, x21, x49);
    x49 = fmaf(-a.z, x22, x49);
    x49 = fmaf(-a.w, x23, x49);
    a = *(const LAS f32x4*)(Am + 3356);
    x49 = fmaf(-a.x, x24, x49);
    x49 = fmaf(-a.y, x25, x49);
    x49 = fmaf(-a.z, x26, x49);
    x49 = fmaf(-a.w, x27, x49);
    a = *(const LAS f32x4*)(Am + 3360);
    x49 = fmaf(-a.x, x28, x49);
    x49 = fmaf(-a.y, x29, x49);
    x49 = fmaf(-a.z, x30, x49);
    x49 = fmaf(-a.w, x31, x49);
    a = *(const LAS f32x4*)(Am + 3364);
    x49 = fmaf(-a.x, x32, x49);
    x49 = fmaf(-a.y, x33, x49);
    x49 = fmaf(-a.z, x34, x49);
    x49 = fmaf(-a.w, x35, x49);
    a = *(const LAS f32x4*)(Am + 3368);
    x49 = fmaf(-a.x, x36, x49);
    x49 = fmaf(-a.y, x37, x49);
    x49 = fmaf(-a.z, x38, x49);
    x49 = fmaf(-a.w, x39, x49);
    a = *(const LAS f32x4*)(Am + 3372);
    x49 = fmaf(-a.x, x40, x49);
    x49 = fmaf(-a.y, x41, x49);
    x49 = fmaf(-a.z, x42, x49);
    x49 = fmaf(-a.w, x43, x49);
    a = *(const LAS f32x4*)(Am + 3376);
    x49 = fmaf(-a.x, x44, x49);
    x49 = fmaf(-a.y, x45, x49);
    x49 = fmaf(-a.z, x46, x49);
    x49 = fmaf(-a.w, x47, x49);
    a = *(const LAS f32x4*)(Am + 3380);
    x49 = fmaf(-a.x, x48, x49);
    outp[49 * rstride] = f2bf(x49);
    float x50 = sc[50] * bf2f(col[6800]);
    a = *(const LAS f32x4*)(Am + 3400);
    x50 = fmaf(-a.x, x0, x50);
    x50 = fmaf(-a.y, x1, x50);
    x50 = fmaf(-a.z, x2, x50);
    x50 = fmaf(-a.w, x3, x50);
    a = *(const LAS f32x4*)(Am + 3404);
    x50 = fmaf(-a.x, x4, x50);
    x50 = fmaf(-a.y, x5, x50);
    x50 = fmaf(-a.z, x6, x50);
    x50 = fmaf(-a.w, x7, x50);
    a = *(const LAS f32x4*)(Am + 3408);
    x50 = fmaf(-a.x, x8, x50);
    x50 = fmaf(-a.y, x9, x50);
    x50 = fmaf(-a.z, x10, x50);
    x50 = fmaf(-a.w, x11, x50);
    a = *(const LAS f32x4*)(Am + 3412);
    x50 = fmaf(-a.x, x12, x50);
    x50 = fmaf(-a.y, x13, x50);
    x50 = fmaf(-a.z, x14, x50);
    x50 = fmaf(-a.w, x15, x50);
    a = *(const LAS f32x4*)(Am + 3416);
    x50 = fmaf(-a.x, x16, x50);
    x50 = fmaf(-a.y, x17, x50);
    x50 = fmaf(-a.z, x18, x50);
    x50 = fmaf(-a.w, x19, x50);
    a = *(const LAS f32x4*)(Am + 3420);
    x50 = fmaf(-a.x, x20, x50);
    x50 = fmaf(-a.y, x21, x50);
    x50 = fmaf(-a.z, x22, x50);
    x50 = fmaf(-a.w, x23, x50);
    a = *(const LAS f32x4*)(Am + 3424);
    x50 = fmaf(-a.x, x24, x50);
    x50 = fmaf(-a.y, x25, x50);
    x50 = fmaf(-a.z, x26, x50);
    x50 = fmaf(-a.w, x27, x50);
    a = *(const LAS f32x4*)(Am + 3428);
    x50 = fmaf(-a.x, x28, x50);
    x50 = fmaf(-a.y, x29, x50);
    x50 = fmaf(-a.z, x30, x50);
    x50 = fmaf(-a.w, x31, x50);
    a = *(const LAS f32x4*)(Am + 3432);
    x50 = fmaf(-a.x, x32, x50);
    x50 = fmaf(-a.y, x33, x50);
    x50 = fmaf(-a.z, x34, x50);
    x50 = fmaf(-a.w, x35, x50);
    a = *(const LAS f32x4*)(Am + 3436);
    x50 = fmaf(-a.x, x36, x50);
    x50 = fmaf(-a.y, x37, x50);
    x50 = fmaf(-a.z, x38, x50);
    x50 = fmaf(-a.w, x39, x50);
    a = *(const LAS f32x4*)(Am + 3440);
    x50 = fmaf(-a.x, x40, x50);
    x50 = fmaf(-a.y, x41, x50);
    x50 = fmaf(-a.z, x42, x50);
    x50 = fmaf(-a.w, x43, x50);
    a = *(const LAS f32x4*)(Am + 3444);
    x50 = fmaf(-a.x, x44, x50);
    x50 = fmaf(-a.y, x45, x50);
    x50 = fmaf(-a.z, x46, x50);
    x50 = fmaf(-a.w, x47, x50);
    a = *(const LAS f32x4*)(Am + 3448);
    x50 = fmaf(-a.x, x48, x50);
    x50 = fmaf(-a.y, x49, x50);
    outp[50 * rstride] = f2bf(x50);
    float x51 = sc[51] * bf2f(col[6936]);
    a = *(const LAS f32x4*)(Am + 3468);
    x51 = fmaf(-a.x, x0, x51);
    x51 = fmaf(-a.y, x1, x51);
    x51 = fmaf(-a.z, x2, x51);
    x51 = fmaf(-a.w, x3, x51);
    a = *(const LAS f32x4*)(Am + 3472);
    x51 = fmaf(-a.x, x4, x51);
    x51 = fmaf(-a.y, x5, x51);
    x51 = fmaf(-a.z, x6, x51);
    x51 = fmaf(-a.w, x7, x51);
    a = *(const LAS f32x4*)(Am + 3476);
    x51 = fmaf(-a.x, x8, x51);
    x51 = fmaf(-a.y, x9, x51);
    x51 = fmaf(-a.z, x10, x51);
    x51 = fmaf(-a.w, x11, x51);
    a = *(const LAS f32x4*)(Am + 3480);
    x51 = fmaf(-a.x, x12, x51);
    x51 = fmaf(-a.y, x13, x51);
    x51 = fmaf(-a.z, x14, x51);
    x51 = fmaf(-a.w, x15, x51);
    a = *(const LAS f32x4*)(Am + 3484);
    x51 = fmaf(-a.x, x16, x51);
    x51 = fmaf(-a.y, x17, x51);
    x51 = fmaf(-a.z, x18, x51);
    x51 = fmaf(-a.w, x19, x51);
    a = *(const LAS f32x4*)(Am + 3488);
    x51 = fmaf(-a.x, x20, x51);
    x51 = fmaf(-a.y, x21, x51);
    x51 = fmaf(-a.z, x22, x51);
    x51 = fmaf(-a.w, x23, x51);
    a = *(const LAS f32x4*)(Am + 3492);
    x51 = fmaf(-a.x, x24, x51);
    x51 = fmaf(-a.y, x25, x51);
    x51 = fmaf(-a.z, x26, x51);
    x51 = fmaf(-a.w, x27, x51);
    a = *(const LAS f32x4*)(Am + 3496);
    x51 = fmaf(-a.x, x28, x51);
    x51 = fmaf(-a.y, x29, x51);
    x51 = fmaf(-a.z, x30, x51);
    x51 = fmaf(-a.w, x31, x51);
    a = *(const LAS f32x4*)(Am + 3500);
    x51 = fmaf(-a.x, x32, x51);
    x51 = fmaf(-a.y, x33, x51);
    x51 = fmaf(-a.z, x34, x51);
    x51 = fmaf(-a.w, x35, x51);
    a = *(const LAS f32x4*)(Am + 3504);
    x51 = fmaf(-a.x, x36, x51);
    x51 = fmaf(-a.y, x37, x51);
    x51 = fmaf(-a.z, x38, x51);
    x51 = fmaf(-a.w, x39, x51);
    a = *(const LAS f32x4*)(Am + 3508);
    x51 = fmaf(-a.x, x40, x51);
    x51 = fmaf(-a.y, x41, x51);
    x51 = fmaf(-a.z, x42, x51);
    x51 = fmaf(-a.w, x43, x51);
    a = *(const LAS f32x4*)(Am + 3512);
    x51 = fmaf(-a.x, x44, x51);
    x51 = fmaf(-a.y, x45, x51);
    x51 = fmaf(-a.z, x46, x51);
    x51 = fmaf(-a.w, x47, x51);
    a = *(const LAS f32x4*)(Am + 3516);
    x51 = fmaf(-a.x, x48, x51);
    x51 = fmaf(-a.y, x49, x51);
    x51 = fmaf(-a.z, x50, x51);
    outp[51 * rstride] = f2bf(x51);
    float x52 = sc[52] * bf2f(col[7072]);
    a = *(const LAS f32x4*)(Am + 3536);
    x52 = fmaf(-a.x, x0, x52);
    x52 = fmaf(-a.y, x1, x52);
    x52 = fmaf(-a.z, x2, x52);
    x52 = fmaf(-a.w, x3, x52);
    a = *(const LAS f32x4*)(Am + 3540);
    x52 = fmaf(-a.x, x4, x52);
    x52 = fmaf(-a.y, x5, x52);
    x52 = fmaf(-a.z, x6, x52);
    x52 = fmaf(-a.w, x7, x52);
    a = *(const LAS f32x4*)(Am + 3544);
    x52 = fmaf(-a.x, x8, x52);
    x52 = fmaf(-a.y, x9, x52);
    x52 = fmaf(-a.z, x10, x52);
    x52 = fmaf(-a.w, x11, x52);
    a = *(const LAS f32x4*)(Am + 3548);
    x52 = fmaf(-a.x, x12, x52);
    x52 = fmaf(-a.y, x13, x52);
    x52 = fmaf(-a.z, x14, x52);
    x52 = fmaf(-a.w, x15, x52);
    a = *(const LAS f32x4*)(Am + 3552);
    x52 = fmaf(-a.x, x16, x52);
    x52 = fmaf(-a.y, x17, x52);
    x52 = fmaf(-a.z, x18, x52);
    x52 = fmaf(-a.w, x19, x52);
    a = *(const LAS f32x4*)(Am + 3556);
    x52 = fmaf(-a.x, x20, x52);
    x52 = fmaf(-a.y, x21, x52);
    x52 = fmaf(-a.z, x22, x52);
    x52 = fmaf(-a.w, x23, x52);
    a = *(const LAS f32x4*)(Am + 3560);
    x52 = fmaf(-a.x, x24, x52);
    x52 = fmaf(-a.y, x25, x52);
    x52 = fmaf(-a.z, x26, x52);
    x52 = fmaf(-a.w, x27, x52);
    a = *(const LAS f32x4*)(Am + 3564);
    x52 = fmaf(-a.x, x28, x52);
    x52 = fmaf(-a.y, x29, x52);
    x52 = fmaf(-a.z, x30, x52);
    x52 = fmaf(-a.w, x31, x52);
    a = *(const LAS f32x4*)(Am + 3568);
    x52 = fmaf(-a.x, x32, x52);
    x52 = fmaf(-a.y, x33, x52);
    x52 = fmaf(-a.z, x34, x52);
    x52 = fmaf(-a.w, x35, x52);
    a = *(const LAS f32x4*)(Am + 3572);
    x52 = fmaf(-a.x, x36, x52);
    x52 = fmaf(-a.y, x37, x52);
    x52 = fmaf(-a.z, x38, x52);
    x52 = fmaf(-a.w, x39, x52);
    a = *(const LAS f32x4*)(Am + 3576);
    x52 = fmaf(-a.x, x40, x52);
    x52 = fmaf(-a.y, x41, x52);
    x52 = fmaf(-a.z, x42, x52);
    x52 = fmaf(-a.w, x43, x52);
    a = *(const LAS f32x4*)(Am + 3580);
    x52 = fmaf(-a.x, x44, x52);
    x52 = fmaf(-a.y, x45, x52);
    x52 = fmaf(-a.z, x46, x52);
    x52 = fmaf(-a.w, x47, x52);
    a = *(const LAS f32x4*)(Am + 3584);
    x52 = fmaf(-a.x, x48, x52);
    x52 = fmaf(-a.y, x49, x52);
    x52 = fmaf(-a.z, x50, x52);
    x52 = fmaf(-a.w, x51, x52);
    outp[52 * rstride] = f2bf(x52);
    float x53 = sc[53] * bf2f(col[7208]);
    a = *(const LAS f32x4*)(Am + 3604);
    x53 = fmaf(-a.x, x0, x53);
    x53 = fmaf(-a.y, x1, x53);
    x53 = fmaf(-a.z, x2, x53);
    x53 = fmaf(-a.w, x3, x53);
    a = *(const LAS f32x4*)(Am + 3608);
    x53 = fmaf(-a.x, x4, x53);
    x53 = fmaf(-a.y, x5, x53);
    x53 = fmaf(-a.z, x6, x53);
    x53 = fmaf(-a.w, x7, x53);
    a = *(const LAS f32x4*)(Am + 3612);
    x53 = fmaf(-a.x, x8, x53);
    x53 = fmaf(-a.y, x9, x53);
    x53 = fmaf(-a.z, x10, x53);
    x53 = fmaf(-a.w, x11, x53);
    a = *(const LAS f32x4*)(Am + 3616);
    x53 = fmaf(-a.x, x12, x53);
    x53 = fmaf(-a.y, x13, x53);
    x53 = fmaf(-a.z, x14, x53);
    x53 = fmaf(-a.w, x15, x53);
    a = *(const LAS f32x4*)(Am + 3620);
    x53 = fmaf(-a.x, x16, x53);
    x53 = fmaf(-a.y, x17, x53);
    x53 = fmaf(-a.z, x18, x53);
    x53 = fmaf(-a.w, x19, x53);
    a = *(const LAS f32x4*)(Am + 3624);
    x53 = fmaf(-a.x, x20, x53);
    x53 = fmaf(-a.y, x21, x53);
    x53 = fmaf(-a.z, x22, x53);
    x53 = fmaf(-a.w, x23, x53);
    a = *(const LAS f32x4*)(Am + 3628);
    x53 = fmaf(-a.x, x24, x53);
    x53 = fmaf(-a.y, x25, x53);
    x53 = fmaf(-a.z, x26, x53);
    x53 = fmaf(-a.w, x27, x53);
    a = *(const LAS f32x4*)(Am + 3632);
    x53 = fmaf(-a.x, x28, x53);
    x53 = fmaf(-a.y, x29, x53);
    x53 = fmaf(-a.z, x30, x53);
    x53 = fmaf(-a.w, x31, x53);
    a = *(const LAS f32x4*)(Am + 3636);
    x53 = fmaf(-a.x, x32, x53);
    x53 = fmaf(-a.y, x33, x53);
    x53 = fmaf(-a.z, x34, x53);
    x53 = fmaf(-a.w, x35, x53);
    a = *(const LAS f32x4*)(Am + 3640);
    x53 = fmaf(-a.x, x36, x53);
    x53 = fmaf(-a.y, x37, x53);
    x53 = fmaf(-a.z, x38, x53);
    x53 = fmaf(-a.w, x39, x53);
    a = *(const LAS f32x4*)(Am + 3644);
    x53 = fmaf(-a.x, x40, x53);
    x53 = fmaf(-a.y, x41, x53);
    x53 = fmaf(-a.z, x42, x53);
    x53 = fmaf(-a.w, x43, x53);
    a = *(const LAS f32x4*)(Am + 3648);
    x53 = fmaf(-a.x, x44, x53);
    x53 = fmaf(-a.y, x45, x53);
    x53 = fmaf(-a.z, x46, x53);
    x53 = fmaf(-a.w, x47, x53);
    a = *(const LAS f32x4*)(Am + 3652);
    x53 = fmaf(-a.x, x48, x53);
    x53 = fmaf(-a.y, x49, x53);
    x53 = fmaf(-a.z, x50, x53);
    x53 = fmaf(-a.w, x51, x53);
    a = *(const LAS f32x4*)(Am + 3656);
    x53 = fmaf(-a.x, x52, x53);
    outp[53 * rstride] = f2bf(x53);
    float x54 = sc[54] * bf2f(col[7344]);
    a = *(const LAS f32x4*)(Am + 3672);
    x54 = fmaf(-a.x, x0, x54);
    x54 = fmaf(-a.y, x1, x54);
    x54 = fmaf(-a.z, x2, x54);
    x54 = fmaf(-a.w, x3, x54);
    a = *(const LAS f32x4*)(Am + 3676);
    x54 = fmaf(-a.x, x4, x54);
    x54 = fmaf(-a.y, x5, x54);
    x54 = fmaf(-a.z, x6, x54);
    x54 = fmaf(-a.w, x7, x54);
    a = *(const LAS f32x4*)(Am + 3680);
    x54 = fmaf(-a.x, x8, x54);
    x54 = fmaf(-a.y, x9, x54);
    x54 = fmaf(-a.z, x10, x54);
    x54 = fmaf(-a.w, x11, x54);
    a = *(const LAS f32x4*)(Am + 3684);
    x54 = fmaf(-a.x, x12, x54);
    x54 = fmaf(-a.y, x13, x54);
    x54 = fmaf(-a.z, x14, x54);
    x54 = fmaf(-a.w, x15, x54);
    a = *(const LAS f32x4*)(Am + 3688);
    x54 = fmaf(-a.x, x16, x54);
    x54 = fmaf(-a.y, x17, x54);
    x54 = fmaf(-a.z, x18, x54);
    x54 = fmaf(-a.w, x19, x54);
    a = *(const LAS f32x4*)(Am + 3692);
    x54 = fmaf(-a.x, x20, x54);
    x54 = fmaf(-a.y, x21, x54);
    x54 = fmaf(-a.z, x22, x54);
    x54 = fmaf(-a.w, x23, x54);
    a = *(const LAS f32x4*)(Am + 3696);
    x54 = fmaf(-a.x, x24, x54);
    x54 = fmaf(-a.y, x25, x54);
    x54 = fmaf(-a.z, x26, x54);
    x54 = fmaf(-a.w, x27, x54);
    a = *(const LAS f32x4*)(Am + 3700);
    x54 = fmaf(-a.x, x28, x54);
    x54 = fmaf(-a.y, x29, x54);
    x54 = fmaf(-a.z, x30, x54);
    x54 = fmaf(-a.w, x31, x54);
    a = *(const LAS f32x4*)(Am + 3704);
    x54 = fmaf(-a.x, x32, x54);
    x54 = fmaf(-a.y, x33, x54);
    x54 = fmaf(-a.z, x34, x54);
    x54 = fmaf(-a.w, x35, x54);
    a = *(const LAS f32x4*)(Am + 3708);
    x54 = fmaf(-a.x, x36, x54);
    x54 = fmaf(-a.y, x37, x54);
    x54 = fmaf(-a.z, x38, x54);
    x54 = fmaf(-a.w, x39, x54);
    a = *(const LAS f32x4*)(Am + 3712);
    x54 = fmaf(-a.x, x40, x54);
    x54 = fmaf(-a.y, x41, x54);
    x54 = fmaf(-a.z, x42, x54);
    x54 = fmaf(-a.w, x43, x54);
    a = *(const LAS f32x4*)(Am + 3716);
    x54 = fmaf(-a.x, x44, x54);
    x54 = fmaf(-a.y, x45, x54);
    x54 = fmaf(-a.z, x46, x54);
    x54 = fmaf(-a.w, x47, x54);
    a = *(const LAS f32x4*)(Am + 3720);
    x54 = fmaf(-a.x, x48, x54);
    x54 = fmaf(-a.y, x49, x54);
    x54 = fmaf(-a.z, x50, x54);
    x54 = fmaf(-a.w, x51, x54);
    a = *(const LAS f32x4*)(Am + 3724);
    x54 = fmaf(-a.x, x52, x54);
    x54 = fmaf(-a.y, x53, x54);
    outp[54 * rstride] = f2bf(x54);
    float x55 = sc[55] * bf2f(col[7480]);
    a = *(const LAS f32x4*)(Am + 3740);
    x55 = fmaf(-a.x, x0, x55);
    x55 = fmaf(-a.y, x1, x55);
    x55 = fmaf(-a.z, x2, x55);
    x55 = fmaf(-a.w, x3, x55);
    a = *(const LAS f32x4*)(Am + 3744);
    x55 = fmaf(-a.x, x4, x55);
    x55 = fmaf(-a.y, x5, x55);
    x55 = fmaf(-a.z, x6, x55);
    x55 = fmaf(-a.w, x7, x55);
    a = *(const LAS f32x4*)(Am + 3748);
    x55 = fmaf(-a.x, x8, x55);
    x55 = fmaf(-a.y, x9, x55);
    x55 = fmaf(-a.z, x10, x55);
    x55 = fmaf(-a.w, x11, x55);
    a = *(const LAS f32x4*)(Am + 3752);
    x55 = fmaf(-a.x, x12, x55);
    x55 = fmaf(-a.y, x13, x55);
    x55 = fmaf(-a.z, x14, x55);
    x55 = fmaf(-a.w, x15, x55);
    a = *(const LAS f32x4*)(Am + 3756);
    x55 = fmaf(-a.x, x16, x55);
    x55 = fmaf(-a.y, x17, x55);
    x55 = fmaf(-a.z, x18, x55);
    x55 = fmaf(-a.w, x19, x55);
    a = *(const LAS f32x4*)(Am + 3760);
    x55 = fmaf(-a.x, x20, x55);
    x55 = fmaf(-a.y, x21, x55);
    x55 = fmaf(-a.z, x22, x55);
    x55 = fmaf(-a.w, x23, x55);
    a = *(const LAS f32x4*)(Am + 3764);
    x55 = fmaf(-a.x, x24, x55);
    x55 = fmaf(-a.y, x25, x55);
    x55 = fmaf(-a.z, x26, x55);
    x55 = fmaf(-a.w, x27, x55);
    a = *(const LAS f32x4*)(Am + 3768);
    x55 = fmaf(-a.x, x28, x55);
    x55 = fmaf(-a.y, x29, x55);
    x55 = fmaf(-a.z, x30, x55);
    x55 = fmaf(-a.w, x31, x55);
    a = *(const LAS f32x4*)(Am + 3772);
    x55 = fmaf(-a.x, x32, x55);
    x55 = fmaf(-a.y, x33, x55);
    x55 = fmaf(-a.z, x34, x55);
    x55 = fmaf(-a.w, x35, x55);
    a = *(const LAS f32x4*)(Am + 3776);
    x55 = fmaf(-a.x, x36, x55);
    x55 = fmaf(-a.y, x37, x55);
    x55 = fmaf(-a.z, x38, x55);
    x55 = fmaf(-a.w, x39, x55);
    a = *(const LAS f32x4*)(Am + 3780);
    x55 = fmaf(-a.x, x40, x55);
    x55 = fmaf(-a.y, x41, x55);
    x55 = fmaf(-a.z, x42, x55);
    x55 = fmaf(-a.w, x43, x55);
    a = *(const LAS f32x4*)(Am + 3784);
    x55 = fmaf(-a.x, x44, x55);
    x55 = fmaf(-a.y, x45, x55);
    x55 = fmaf(-a.z, x46, x55);
    x55 = fmaf(-a.w, x47, x55);
    a = *(const LAS f32x4*)(Am + 3788);
    x55 = fmaf(-a.x, x48, x55);
    x55 = fmaf(-a.y, x49, x55);
    x55 = fmaf(-a.z, x50, x55);
    x55 = fmaf(-a.w, x51, x55);
    a = *(const LAS f32x4*)(Am + 3792);
    x55 = fmaf(-a.x, x52, x55);
    x55 = fmaf(-a.y, x53, x55);
    x55 = fmaf(-a.z, x54, x55);
    outp[55 * rstride] = f2bf(x55);
    float x56 = sc[56] * bf2f(col[7616]);
    a = *(const LAS f32x4*)(Am + 3808);
    x56 = fmaf(-a.x, x0, x56);
    x56 = fmaf(-a.y, x1, x56);
    x56 = fmaf(-a.z, x2, x56);
    x56 = fmaf(-a.w, x3, x56);
    a = *(const LAS f32x4*)(Am + 3812);
    x56 = fmaf(-a.x, x4, x56);
    x56 = fmaf(-a.y, x5, x56);
    x56 = fmaf(-a.z, x6, x56);
    x56 = fmaf(-a.w, x7, x56);
    a = *(const LAS f32x4*)(Am + 3816);
    x56 = fmaf(-a.x, x8, x56);
    x56 = fmaf(-a.y, x9, x56);
    x56 = fmaf(-a.z, x10, x56);
    x56 = fmaf(-a.w, x11, x56);
    a = *(const LAS f32x4*)(Am + 3820);
    x56 = fmaf(-a.x, x12, x56);
    x56 = fmaf(-a.y, x13, x56);
    x56 = fmaf(-a.z, x14, x56);
    x56 = fmaf(-a.w, x15, x56);
    a = *(const LAS f32x4*)(Am + 3824);
    x56 = fmaf(-a.x, x16, x56);
    x56 = fmaf(-a.y, x17, x56);
    x56 = fmaf(-a.z, x18, x56);
    x56 = fmaf(-a.w, x19, x56);
    a = *(const LAS f32x4*)(Am + 3828);
    x56 = fmaf(-a.x, x20, x56);
    x56 = fmaf(-a.y, x21, x56);
    x56 = fmaf(-a.z, x22, x56);
    x56 = fmaf(-a.w, x23, x56);
    a = *(const LAS f32x4*)(Am + 3832);
    x56 = fmaf(-a.x, x24, x56);
    x56 = fmaf(-a.y, x25, x56);
    x56 = fmaf(-a.z, x26, x56);
    x56 = fmaf(-a.w, x27, x56);
    a = *(const LAS f32x4*)(Am + 3836);
    x56 = fmaf(-a.x, x28, x56);
    x56 = fmaf(-a.y, x29, x56);
    x56 = fmaf(-a.z, x30, x56);
    x56 = fmaf(-a.w, x31, x56);
    a = *(const LAS f32x4*)(Am + 3840);
    x56 = fmaf(-a.x, x32, x56);
    x56 = fmaf(-a.y, x33, x56);
    x56 = fmaf(-a.z, x34, x56);
    x56 = fmaf(-a.w, x35, x56);
    a = *(const LAS f32x4*)(Am + 3844);
    x56 = fmaf(-a.x, x36, x56);
    x56 = fmaf(-a.y, x37, x56);
    x56 = fmaf(-a.z, x38, x56);
    x56 = fmaf(-a.w, x39, x56);
    a = *(const LAS f32x4*)(Am + 3848);
    x56 = fmaf(-a.x, x40, x56);
    x56 = fmaf(-a.y, x41, x56);
    x56 = fmaf(-a.z, x42, x56);
    x56 = fmaf(-a.w, x43, x56);
    a = *(const LAS f32x4*)(Am + 3852);
    x56 = fmaf(-a.x, x44, x56);
    x56 = fmaf(-a.y, x45, x56);
    x56 = fmaf(-a.z, x46, x56);
    x56 = fmaf(-a.w, x47, x56);
    a = *(const LAS f32x4*)(Am + 3856);
    x56 = fmaf(-a.x, x48, x56);
    x56 = fmaf(-a.y, x49, x56);
    x56 = fmaf(-a.z, x50, x56);
    x56 = fmaf(-a.w, x51, x56);
    a = *(const LAS f32x4*)(Am + 3860);
    x56 = fmaf(-a.x, x52, x56);
    x56 = fmaf(-a.y, x53, x56);
    x56 = fmaf(-a.z, x54, x56);
    x56 = fmaf(-a.w, x55, x56);
    outp[56 * rstride] = f2bf(x56);
    float x57 = sc[57] * bf2f(col[7752]);
    a = *(const LAS f32x4*)(Am + 3876);
    x57 = fmaf(-a.x, x0, x57);
    x57 = fmaf(-a.y, x1, x57);
    x57 = fmaf(-a.z, x2, x57);
    x57 = fmaf(-a.w, x3, x57);
    a = *(const LAS f32x4*)(Am + 3880);
    x57 = fmaf(-a.x, x4, x57);
    x57 = fmaf(-a.y, x5, x57);
    x57 = fmaf(-a.z, x6, x57);
    x57 = fmaf(-a.w, x7, x57);
    a = *(const LAS f32x4*)(Am + 3884);
    x57 = fmaf(-a.x, x8, x57);
    x57 = fmaf(-a.y, x9, x57);
    x57 = fmaf(-a.z, x10, x57);
    x57 = fmaf(-a.w, x11, x57);
    a = *(const LAS f32x4*)(Am + 3888);
    x57 = fmaf(-a.x, x12, x57);
    x57 = fmaf(-a.y, x13, x57);
    x57 = fmaf(-a.z, x14, x57);
    x57 = fmaf(-a.w, x15, x57);
    a = *(const LAS f32x4*)(Am + 3892);
    x57 = fmaf(-a.x, x16, x57);
    x57 = fmaf(-a.y, x17, x57);
    x57 = fmaf(-a.z, x18, x57);
    x57 = fmaf(-a.w, x19, x57);
    a = *(const LAS f32x4*)(Am + 3896);
    x57 = fmaf(-a.x, x20, x57);
    x57 = fmaf(-a.y, x21, x57);
    x57 = fmaf(-a.z, x22, x57);
    x57 = fmaf(-a.w, x23, x57);
    a = *(const LAS f32x4*)(Am + 3900);
    x57 = fmaf(-a.x, x24, x57);
    x57 = fmaf(-a.y, x25, x57);
    x57 = fmaf(-a.z, x26, x57);
    x57 = fmaf(-a.w, x27, x57);
    a = *(const LAS f32x4*)(Am + 3904);
    x57 = fmaf(-a.x, x28, x57);
    x57 = fmaf(-a.y, x29, x57);
    x57 = fmaf(-a.z, x30, x57);
    x57 = fmaf(-a.w, x31, x57);
    a = *(const LAS f32x4*)(Am + 3908);
    x57 = fmaf(-a.x, x32, x57);
    x57 = fmaf(-a.y, x33, x57);
    x57 = fmaf(-a.z, x34, x57);
    x57 = fmaf(-a.w, x35, x57);
    a = *(const LAS f32x4*)(Am + 3912);
    x57 = fmaf(-a.x, x36, x57);
    x57 = fmaf(-a.y, x37, x57);
    x57 = fmaf(-a.z, x38, x57);
    x57 = fmaf(-a.w, x39, x57);
    a = *(const LAS f32x4*)(Am + 3916);
    x57 = fmaf(-a.x, x40, x57);
    x57 = fmaf(-a.y, x41, x57);
    x57 = fmaf(-a.z, x42, x57);
    x57 = fmaf(-a.w, x43, x57);
    a = *(const LAS f32x4*)(Am + 3920);
    x57 = fmaf(-a.x, x44, x57);
    x57 = fmaf(-a.y, x45, x57);
    x57 = fmaf(-a.z, x46, x57);
    x57 = fmaf(-a.w, x47, x57);
    a = *(const LAS f32x4*)(Am + 3924);
    x57 = fmaf(-a.x, x48, x57);
    x57 = fmaf(-a.y, x49, x57);
    x57 = fmaf(-a.z, x50, x57);
    x57 = fmaf(-a.w, x51, x57);
    a = *(const LAS f32x4*)(Am + 3928);
    x57 = fmaf(-a.x, x52, x57);
    x57 = fmaf(-a.y, x53, x57);
    x57 = fmaf(-a.z, x54, x57);
    x57 = fmaf(-a.w, x55, x57);
    a = *(const LAS f32x4*)(Am + 3932);
    x57 = fmaf(-a.x, x56, x57);
    outp[57 * rstride] = f2bf(x57);
    float x58 = sc[58] * bf2f(col[7888]);
    a = *(const LAS f32x4*)(Am + 3944);
    x58 = fmaf(-a.x, x0, x58);
    x58 = fmaf(-a.y, x1, x58);
    x58 = fmaf(-a.z, x2, x58);
    x58 = fmaf(-a.w, x3, x58);
    a = *(const LAS f32x4*)(Am + 3948);
    x58 = fmaf(-a.x, x4, x58);
    x58 = fmaf(-a.y, x5, x58);
    x58 = fmaf(-a.z, x6, x58);
    x58 = fmaf(-a.w, x7, x58);
    a = *(const LAS f32x4*)(Am + 3952);
    x58 = fmaf(-a.x, x8, x58);
    x58 = fmaf(-a.y, x9, x58);
    x58 = fmaf(-a.z, x10, x58);
    x58 = fmaf(-a.w, x11, x58);
    a = *(const LAS f32x4*)(Am + 3956);
    x58 = fmaf(-a.x, x12, x58);
    x58 = fmaf(-a.y, x13, x58);
    x58 = fmaf(-a.z, x14, x58);
    x58 = fmaf(-a.w, x15, x58);
    a = *(const LAS f32x4*)(Am + 3960);
    x58 = fmaf(-a.x, x16, x58);
    x58 = fmaf(-a.y, x17, x58);
    x58 = fmaf(-a.z, x18, x58);
    x58 = fmaf(-a.w, x19, x58);
    a = *(const LAS f32x4*)(Am + 3964);
    x58 = fmaf(-a.x, x20, x58);
    x58 = fmaf(-a.y, x21, x58);
    x58 = fmaf(-a.z, x22, x58);
    x58 = fmaf(-a.w, x23, x58);
    a = *(const LAS f32x4*)(Am + 3968);
    x58 = fmaf(-a.x, x24, x58);
    x58 = fmaf(-a.y, x25, x58);
    x58 = fmaf(-a.z, x26, x58);
    x58 = fmaf(-a.w, x27, x58);
    a = *(const LAS f32x4*)(Am + 3972);
    x58 = fmaf(-a.x, x28, x58);
    x58 = fmaf(-a.y, x29, x58);
    x58 = fmaf(-a.z, x30, x58);
    x58 = fmaf(-a.w, x31, x58);
    a = *(const LAS f32x4*)(Am + 3976);
    x58 = fmaf(-a.x, x32, x58);
    x58 = fmaf(-a.y, x33, x58);
    x58 = fmaf(-a.z, x34, x58);
    x58 = fmaf(-a.w, x35, x58);
    a = *(const LAS f32x4*)(Am + 3980);
    x58 = fmaf(-a.x, x36, x58);
    x58 = fmaf(-a.y, x37, x58);
    x58 = fmaf(-a.z, x38, x58);
    x58 = fmaf(-a.w, x39, x58);
    a = *(const LAS f32x4*)(Am + 3984);
    x58 = fmaf(-a.x, x40, x58);
    x58 = fmaf(-a.y, x41, x58);
    x58 = fmaf(-a.z, x42, x58);
    x58 = fmaf(-a.w, x43, x58);
    a = *(const LAS f32x4*)(Am + 3988);
    x58 = fmaf(-a.x, x44, x58);
    x58 = fmaf(-a.y, x45, x58);
    x58 = fmaf(-a.z, x46, x58);
    x58 = fmaf(-a.w, x47, x58);
    a = *(const LAS f32x4*)(Am + 3992);
    x58 = fmaf(-a.x, x48, x58);
    x58 = fmaf(-a.y, x49, x58);
    x58 = fmaf(-a.z, x50, x58);
    x58 = fmaf(-a.w, x51, x58);
    a = *(const LAS f32x4*)(Am + 3996);
    x58 = fmaf(-a.x, x52, x58);
    x58 = fmaf(-a.y, x53, x58);
    x58 = fmaf(-a.z, x54, x58);
    x58 = fmaf(-a.w, x55, x58);
    a = *(const LAS f32x4*)(Am + 4000);
    x58 = fmaf(-a.x, x56, x58);
    x58 = fmaf(-a.y, x57, x58);
    outp[58 * rstride] = f2bf(x58);
    float x59 = sc[59] * bf2f(col[8024]);
    a = *(const LAS f32x4*)(Am + 4012);
    x59 = fmaf(-a.x, x0, x59);
    x59 = fmaf(-a.y, x1, x59);
    x59 = fmaf(-a.z, x2, x59);
    x59 = fmaf(-a.w, x3, x59);
    a = *(const LAS f32x4*)(Am + 4016);
    x59 = fmaf(-a.x, x4, x59);
    x59 = fmaf(-a.y, x5, x59);
    x59 = fmaf(-a.z, x6, x59);
    x59 = fmaf(-a.w, x7, x59);
    a = *(const LAS f32x4*)(Am + 4020);
    x59 = fmaf(-a.x, x8, x59);
    x59 = fmaf(-a.y, x9, x59);
    x59 = fmaf(-a.z, x10, x59);
    x59 = fmaf(-a.w, x11, x59);
    a = *(const LAS f32x4*)(Am + 4024);
    x59 = fmaf(-a.x, x12, x59);
    x59 = fmaf(-a.y, x13, x59);
    x59 = fmaf(-a.z, x14, x59);
    x59 = fmaf(-a.w, x15, x59);
    a = *(const LAS f32x4*)(Am + 4028);
    x59 = fmaf(-a.x, x16, x59);
    x59 = fmaf(-a.y, x17, x59);
    x59 = fmaf(-a.z, x18, x59);
    x59 = fmaf(-a.w, x19, x59);
    a = *(const LAS f32x4*)(Am + 4032);
    x59 = fmaf(-a.x, x20, x59);
    x59 = fmaf(-a.y, x21, x59);
    x59 = fmaf(-a.z, x22, x59);
    x59 = fmaf(-a.w, x23, x59);
    a = *(const LAS f32x4*)(Am + 4036);
    x59 = fmaf(-a.x, x24, x59);
    x59 = fmaf(-a.y, x25, x59);
    x59 = fmaf(-a.z, x26, x59);
    x59 = fmaf(-a.w, x27, x59);
    a = *(const LAS f32x4*)(Am + 4040);
    x59 = fmaf(-a.x, x28, x59);
    x59 = fmaf(-a.y, x29, x59);
    x59 = fmaf(-a.z, x30, x59);
    x59 = fmaf(-a.w, x31, x59);
    a = *(const LAS f32x4*)(Am + 4044);
    x59 = fmaf(-a.x, x32, x59);
    x59 = fmaf(-a.y, x33, x59);
    x59 = fmaf(-a.z, x34, x59);
    x59 = fmaf(-a.w, x35, x59);
    a = *(const LAS f32x4*)(Am + 4048);
    x59 = fmaf(-a.x, x36, x59);
    x59 = fmaf(-a.y, x37, x59);
    x59 = fmaf(-a.z, x38, x59);
    x59 = fmaf(-a.w, x39, x59);
    a = *(const LAS f32x4*)(Am + 4052);
    x59 = fmaf(-a.x, x40, x59);
    x59 = fmaf(-a.y, x41, x59);
    x59 = fmaf(-a.z, x42, x59);
    x59 = fmaf(-a.w, x43, x59);
    a = *(const LAS f32x4*)(Am + 4056);
    x59 = fmaf(-a.x, x44, x59);
    x59 = fmaf(-a.y, x45, x59);
    x59 = fmaf(-a.z, x46, x59);
    x59 = fmaf(-a.w, x47, x59);
    a = *(const LAS f32x4*)(Am + 4060);
    x59 = fmaf(-a.x, x48, x59);
    x59 = fmaf(-a.y, x49, x59);
    x59 = fmaf(-a.z, x50, x59);
    x59 = fmaf(-a.w, x51, x59);
    a = *(const LAS f32x4*)(Am + 4064);
    x59 = fmaf(-a.x, x52, x59);
    x59 = fmaf(-a.y, x53, x59);
    x59 = fmaf(-a.z, x54, x59);
    x59 = fmaf(-a.w, x55, x59);
    a = *(const LAS f32x4*)(Am + 4068);
    x59 = fmaf(-a.x, x56, x59);
    x59 = fmaf(-a.y, x57, x59);
    x59 = fmaf(-a.z, x58, x59);
    outp[59 * rstride] = f2bf(x59);
    float x60 = sc[60] * bf2f(col[8160]);
    a = *(const LAS f32x4*)(Am + 4080);
    x60 = fmaf(-a.x, x0, x60);
    x60 = fmaf(-a.y, x1, x60);
    x60 = fmaf(-a.z, x2, x60);
    x60 = fmaf(-a.w, x3, x60);
    a = *(const LAS f32x4*)(Am + 4084);
    x60 = fmaf(-a.x, x4, x60);
    x60 = fmaf(-a.y, x5, x60);
    x60 = fmaf(-a.z, x6, x60);
    x60 = fmaf(-a.w, x7, x60);
    a = *(const LAS f32x4*)(Am + 4088);
    x60 = fmaf(-a.x, x8, x60);
    x60 = fmaf(-a.y, x9, x60);
    x60 = fmaf(-a.z, x10, x60);
    x60 = fmaf(-a.w, x11, x60);
    a = *(const LAS f32x4*)(Am + 4092);
    x60 = fmaf(-a.x, x12, x60);
    x60 = fmaf(-a.y, x13, x60);
    x60 = fmaf(-a.z, x14, x60);
    x60 = fmaf(-a.w, x15, x60);
    a = *(const LAS f32x4*)(Am + 4096);
    x60 = fmaf(-a.x, x16, x60);
    x60 = fmaf(-a.y, x17, x60);
    x60 = fmaf(-a.z, x18, x60);
    x60 = fmaf(-a.w, x19, x60);
    a = *(const LAS f32x4*)(Am + 4100);
    x60 = fmaf(-a.x, x20, x60);
    x60 = fmaf(-a.y, x21, x60);
    x60 = fmaf(-a.z, x22, x60);
    x60 = fmaf(-a.w, x23, x60);
    a = *(const LAS f32x4*)(Am + 4104);
    x60 = fmaf(-a.x, x24, x60);
    x60 = fmaf(-a.y, x25, x60);
    x60 = fmaf(-a.z, x26, x60);
    x60 = fmaf(-a.w, x27, x60);
    a = *(const LAS f32x4*)(Am + 4108);
    x60 = fmaf(-a.x, x28, x60);
    x60 = fmaf(-a.y, x29, x60);
    x60 = fmaf(-a.z, x30, x60);
    x60 = fmaf(-a.w, x31, x60);
    a = *(const LAS f32x4*)(Am + 4112);
    x60 = fmaf(-a.x, x32, x60);
    x60 = fmaf(-a.y, x33, x60);
    x60 = fmaf(-a.z, x34, x60);
    x60 = fmaf(-a.w, x35, x60);
    a = *(const LAS f32x4*)(Am + 4116);
    x60 = fmaf(-a.x, x36, x60);
    x60 = fmaf(-a.y, x37, x60);
    x60 = fmaf(-a.z, x38, x60);
    x60 = fmaf(-a.w, x39, x60);
    a = *(const LAS f32x4*)(Am + 4120);
    x60 = fmaf(-a.x, x40, x60);
    x60 = fmaf(-a.y, x41, x60);
    x60 = fmaf(-a.z, x42, x60);
    x60 = fmaf(-a.w, x43, x60);
    a = *(const LAS f32x4*)(Am + 4124);
    x60 = fmaf(-a.x, x44, x60);
    x60 = fmaf(-a.y, x45, x60);
    x60 = fmaf(-a.z, x46, x60);
    x60 = fmaf(-a.w, x47, x60);
    a = *(const LAS f32x4*)(Am + 4128);
    x60 = fmaf(-a.x, x48, x60);
    x60 = fmaf(-a.y, x49, x60);
    x60 = fmaf(-a.z, x50, x60);
    x60 = fmaf(-a.w, x51, x60);
    a = *(const LAS f32x4*)(Am + 4132);
    x60 = fmaf(-a.x, x52, x60);
    x60 = fmaf(-a.y, x53, x60);
    x60 = fmaf(-a.z, x54, x60);
    x60 = fmaf(-a.w, x55, x60);
    a = *(const LAS f32x4*)(Am + 4136);
    x60 = fmaf(-a.x, x56, x60);
    x60 = fmaf(-a.y, x57, x60);
    x60 = fmaf(-a.z, x58, x60);
    x60 = fmaf(-a.w, x59, x60);
    outp[60 * rstride] = f2bf(x60);
    float x61 = sc[61] * bf2f(col[8296]);
    a = *(const LAS f32x4*)(Am + 4148);
    x61 = fmaf(-a.x, x0, x61);
    x61 = fmaf(-a.y, x1, x61);
    x61 = fmaf(-a.z, x2, x61);
    x61 = fmaf(-a.w, x3, x61);
    a = *(const LAS f32x4*)(Am + 4152);
    x61 = fmaf(-a.x, x4, x61);
    x61 = fmaf(-a.y, x5, x61);
    x61 = fmaf(-a.z, x6, x61);
    x61 = fmaf(-a.w, x7, x61);
    a = *(const LAS f32x4*)(Am + 4156);
    x61 = fmaf(-a.x, x8, x61);
    x61 = fmaf(-a.y, x9, x61);
    x61 = fmaf(-a.z, x10, x61);
    x61 = fmaf(-a.w, x11, x61);
    a = *(const LAS f32x4*)(Am + 4160);
    x61 = fmaf(-a.x, x12, x61);
    x61 = fmaf(-a.y, x13, x61);
    x61 = fmaf(-a.z, x14, x61);
    x61 = fmaf(-a.w, x15, x61);
    a = *(const LAS f32x4*)(Am + 4164);
    x61 = fmaf(-a.x, x16, x61);
    x61 = fmaf(-a.y, x17, x61);
    x61 = fmaf(-a.z, x18, x61);
    x61 = fmaf(-a.w, x19, x61);
    a = *(const LAS f32x4*)(Am + 4168);
    x61 = fmaf(-a.x, x20, x61);
    x61 = fmaf(-a.y, x21, x61);
    x61 = fmaf(-a.z, x22, x61);
    x61 = fmaf(-a.w, x23, x61);
    a = *(const LAS f32x4*)(Am + 4172);
    x61 = fmaf(-a.x, x24, x61);
    x61 = fmaf(-a.y, x25, x61);
    x61 = fmaf(-a.z, x26, x61);
    x61 = fmaf(-a.w, x27, x61);
    a = *(const LAS f32x4*)(Am + 4176);
    x61 = fmaf(-a.x, x28, x61);
    x61 = fmaf(-a.y, x29, x61);
    x61 = fmaf(-a.z, x30, x61);
    x61 = fmaf(-a.w, x31, x61);
    a = *(const LAS f32x4*)(Am + 4180);
    x61 = fmaf(-a.x, x32, x61);
    x61 = fmaf(-a.y, x33, x61);
    x61 = fmaf(-a.z, x34, x61);
    x61 = fmaf(-a.w, x35, x61);
    a = *(const LAS f32x4*)(Am + 4184);
    x61 = fmaf(-a.x, x36, x61);
    x61 = fmaf(-a.y, x37, x61);
    x61 = fmaf(-a.z, x38, x61);
    x61 = fmaf(-a.w, x39, x61);
    a = *(const LAS f32x4*)(Am + 4188);
    x61 = fmaf(-a.x, x40, x61);
    x61 = fmaf(-a.y, x41, x61);
    x61 = fmaf(-a.z, x42, x61);
    x61 = fmaf(-a.w, x43, x61);
    a = *(const LAS f32x4*)(Am + 4192);
    x61 = fmaf(-a.x, x44, x61);
    x61 = fmaf(-a.y, x45, x61);
    x61 = fmaf(-a.z, x46, x61);
    x61 = fmaf(-a.w, x47, x61);
    a = *(const LAS f32x4*)(Am + 4196);
    x61 = fmaf(-a.x, x48, x61);
    x61 = fmaf(-a.y, x49, x61);
    x61 = fmaf(-a.z, x50, x61);
    x61 = fmaf(-a.w, x51, x61);
    a = *(const LAS f32x4*)(Am + 4200);
    x61 = fmaf(-a.x, x52, x61);
    x61 = fmaf(-a.y, x53, x61);
    x61 = fmaf(-a.z, x54, x61);
    x61 = fmaf(-a.w, x55, x61);
    a = *(const LAS f32x4*)(Am + 4204);
    x61 = fmaf(-a.x, x56, x61);
    x61 = fmaf(-a.y, x57, x61);
    x61 = fmaf(-a.z, x58, x61);
    x61 = fmaf(-a.w, x59, x61);
    a = *(const LAS f32x4*)(Am + 4208);
    x61 = fmaf(-a.x, x60, x61);
    outp[61 * rstride] = f2bf(x61);
    float x62 = sc[62] * bf2f(col[8432]);
    a = *(const LAS f32x4*)(Am + 4216);
    x62 = fmaf(-a.x, x0, x62);
    x62 = fmaf(-a.y, x1, x62);
    x62 = fmaf(-a.z, x2, x62);
    x62 = fmaf(-a.w, x3, x62);
    a = *(const LAS f32x4*)(Am + 4220);
    x62 = fmaf(-a.x, x4, x62);
    x62 = fmaf(-a.y, x5, x62);
    x62 = fmaf(-a.z, x6, x62);
    x62 = fmaf(-a.w, x7, x62);
    a = *(const LAS f32x4*)(Am + 4224);
    x62 = fmaf(-a.x, x8, x62);
    x62 = fmaf(-a.y, x9, x62);
    x62 = fmaf(-a.z, x10, x62);
    x62 = fmaf(-a.w, x11, x62);
    a = *(const LAS f32x4*)(Am + 4228);
    x62 = fmaf(-a.x, x12, x62);
    x62 = fmaf(-a.y, x13, x62);
    x62 = fmaf(-a.z, x14, x62);
    x62 = fmaf(-a.w, x15, x62);
    a = *(const LAS f32x4*)(Am + 4232);
    x62 = fmaf(-a.x, x16, x62);
    x62 = fmaf(-a.y, x17, x62);
    x62 = fmaf(-a.z, x18, x62);
    x62 = fmaf(-a.w, x19, x62);
    a = *(const LAS f32x4*)(Am + 4236);
    x62 = fmaf(-a.x, x20, x62);
    x62 = fmaf(-a.y, x21, x62);
    x62 = fmaf(-a.z, x22, x62);
    x62 = fmaf(-a.w, x23, x62);
    a = *(const LAS f32x4*)(Am + 4240);
    x62 = fmaf(-a.x, x24, x62);
    x62 = fmaf(-a.y, x25, x62);
    x62 = fmaf(-a.z, x26, x62);
    x62 = fmaf(-a.w, x27, x62);
    a = *(const LAS f32x4*)(Am + 4244);
    x62 = fmaf(-a.x, x28, x62);
    x62 = fmaf(-a.y, x29, x62);
    x62 = fmaf(-a.z, x30, x62);
    x62 = fmaf(-a.w, x31, x62);
    a = *(const LAS f32x4*)(Am + 4248);
    x62 = fmaf(-a.x, x32, x62);
    x62 = fmaf(-a.y, x33, x62);
    x62 = fmaf(-a.z, x34, x62);
    x62 = fmaf(-a.w, x35, x62);
    a = *(const LAS f32x4*)(Am + 4252);
    x62 = fmaf(-a.x, x36, x62);
    x62 = fmaf(-a.y, x37, x62);
    x62 = fmaf(-a.z, x38, x62);
    x62 = fmaf(-a.w, x39, x62);
    a = *(const LAS f32x4*)(Am + 4256);
    x62 = fmaf(-a.x, x40, x62);
    x62 = fmaf(-a.y, x41, x62);
    x62 = fmaf(-a.z, x42, x62);
    x62 = fmaf(-a.w, x43, x62);
    a = *(const LAS f32x4*)(Am + 4260);
    x62 = fmaf(-a.x, x44, x62);
    x62 = fmaf(-a.y, x45, x62);
    x62 = fmaf(-a.z, x46, x62);
    x62 = fmaf(-a.w, x47, x62);
    a = *(const LAS f32x4*)(Am + 4264);
    x62 = fmaf(-a.x, x48, x62);
    x62 = fmaf(-a.y, x49, x62);
    x62 = fmaf(-a.z, x50, x62);
    x62 = fmaf(-a.w, x51, x62);
    a = *(const LAS f32x4*)(Am + 4268);
    x62 = fmaf(-a.x, x52, x62);
    x62 = fmaf(-a.y, x53, x62);
    x62 = fmaf(-a.z, x54, x62);
    x62 = fmaf(-a.w, x55, x62);
    a = *(const LAS f32x4*)(Am + 4272);
    x62 = fmaf(-a.x, x56, x62);
    x62 = fmaf(-a.y, x57, x62);
    x62 = fmaf(-a.z, x58, x62);
    x62 = fmaf(-a.w, x59, x62);
    a = *(const LAS f32x4*)(Am + 4276);
    x62 = fmaf(-a.x, x60, x62);
    x62 = fmaf(-a.y, x61, x62);
    outp[62 * rstride] = f2bf(x62);
    float x63 = sc[63] * bf2f(col[8568]);
    a = *(const LAS f32x4*)(Am + 4284);
    x63 = fmaf(-a.x, x0, x63);
    x63 = fmaf(-a.y, x1, x63);
    x63 = fmaf(-a.z, x2, x63);
    x63 = fmaf(-a.w, x3, x63);
    a = *(const LAS f32x4*)(Am + 4288);
    x63 = fmaf(-a.x, x4, x63);
    x63 = fmaf(-a.y, x5, x63);
    x63 = fmaf(-a.z, x6, x63);
    x63 = fmaf(-a.w, x7, x63);
    a = *(const LAS f32x4*)(Am + 4292);
    x63 = fmaf(-a.x, x8, x63);
    x63 = fmaf(-a.y, x9, x63);
    x63 = fmaf(-a.z, x10, x63);
    x63 = fmaf(-a.w, x11, x63);
    a = *(const LAS f32x4*)(Am + 4296);
    x63 = fmaf(-a.x, x12, x63);
    x63 = fmaf(-a.y, x13, x63);
    x63 = fmaf(-a.z, x14, x63);
    x63 = fmaf(-a.w, x15, x63);
    a = *(const LAS f32x4*)(Am + 4300);
    x63 = fmaf(-a.x, x16, x63);
    x63 = fmaf(-a.y, x17, x63);
    x63 = fmaf(-a.z, x18, x63);
    x63 = fmaf(-a.w, x19, x63);
    a = *(const LAS f32x4*)(Am + 4304);
    x63 = fmaf(-a.x, x20, x63);
    x63 = fmaf(-a.y, x21, x63);
    x63 = fmaf(-a.z, x22, x63);
    x63 = fmaf(-a.w, x23, x63);
    a = *(const LAS f32x4*)(Am + 4308);
    x63 = fmaf(-a.x, x24, x63);
    x63 = fmaf(-a.y, x25, x63);
    x63 = fmaf(-a.z, x26, x63);
    x63 = fmaf(-a.w, x27, x63);
    a = *(const LAS f32x4*)(Am + 4312);
    x63 = fmaf(-a.x, x28, x63);
    x63 = fmaf(-a.y, x29, x63);
    x63 = fmaf(-a.z, x30, x63);
    x63 = fmaf(-a.w, x31, x63);
    a = *(const LAS f32x4*)(Am + 4316);
    x63 = fmaf(-a.x, x32, x63);
    x63 = fmaf(-a.y, x33, x63);
    x63 = fmaf(-a.z, x34, x63);
    x63 = fmaf(-a.w, x35, x63);
    a = *(const LAS f32x4*)(Am + 4320);
    x63 = fmaf(-a.x, x36, x63);
    x63 = fmaf(-a.y, x37, x63);
    x63 = fmaf(-a.z, x38, x63);
    x63 = fmaf(-a.w, x39, x63);
    a = *(const LAS f32x4*)(Am + 4324);
    x63 = fmaf(-a.x, x40, x63);
    x63 = fmaf(-a.y, x41, x63);
    x63 = fmaf(-a.z, x42, x63);
    x63 = fmaf(-a.w, x43, x63);
    a = *(const LAS f32x4*)(Am + 4328);
    x63 = fmaf(-a.x, x44, x63);
    x63 = fmaf(-a.y, x45, x63);
    x63 = fmaf(-a.z, x46, x63);
    x63 = fmaf(-a.w, x47, x63);
    a = *(const LAS f32x4*)(Am + 4332);
    x63 = fmaf(-a.x, x48, x63);
    x63 = fmaf(-a.y, x49, x63);
    x63 = fmaf(-a.z, x50, x63);
    x63 = fmaf(-a.w, x51, x63);
    a = *(const LAS f32x4*)(Am + 4336);
    x63 = fmaf(-a.x, x52, x63);
    x63 = fmaf(-a.y, x53, x63);
    x63 = fmaf(-a.z, x54, x63);
    x63 = fmaf(-a.w, x55, x63);
    a = *(const LAS f32x4*)(Am + 4340);
    x63 = fmaf(-a.x, x56, x63);
    x63 = fmaf(-a.y, x57, x63);
    x63 = fmaf(-a.z, x58, x63);
    x63 = fmaf(-a.w, x59, x63);
    a = *(const LAS f32x4*)(Am + 4344);
    x63 = fmaf(-a.x, x60, x63);
    x63 = fmaf(-a.y, x61, x63);
    x63 = fmaf(-a.z, x62, x63);
    outp[63 * rstride] = f2bf(x63);
}
typedef short bf16x8_t __attribute__((ext_vector_type(8)));
template <int K> __device__ __forceinline__ f32x4 mma_tile(const LAS unsigned short* A, int lda, const LAS unsigned short* Bt, int ldb, f32x4 acc) {
    const int lane = threadIdx.x & 63, r = lane & 15, q = lane >> 4;
#pragma unroll
    for (int ks = 0; ks < K / 32; ++ks) {
        const bf16x8_t a = *(const LAS bf16x8_t*)(A + r * lda + ks * 32 + q * 8);
        const bf16x8_t b = *(const LAS bf16x8_t*)(Bt + r * ldb + ks * 32 + q * 8);
        acc = __builtin_amdgcn_mfma_f32_16x16x32_bf16(a, b, acc, 0, 0, 0);
    }
    return acc;
}
constexpr size_t WS_G = 235 * MiB;

__device__ __forceinline__ void delta_prep(LDSp lds, const Params& p) {
    const bf16_t* QKVN = (const bf16_t*)(p.ws + WS_QKV); const float* BETA = (const float*)(p.ws + WS_BETA); const float* LA = (const float*)(p.ws + WS_LA);
    bf16_t* Z = (bf16_t*)(p.ws + WS_Z); float* GB = (float*)(p.ws + WS_G);
    LAS unsigned short* Qb = (LAS unsigned short*)lds;
    LAS unsigned short* Kb = (LAS unsigned short*)(lds + 17408);
    LAS unsigned short* Vb = (LAS unsigned short*)(lds + 34816);
    LAS float* Am = (LAS float*)(lds + 52224);
    LAS float* gl = (LAS float*)(lds + 69632);
    LAS float* be = gl + 64;
    LAS float* beg = gl + 128;
    LAS float* la = gl + 192;
    const int tid = threadIdx.x, lane = tid & 63, wid = tid >> 6, r = lane & 15, q = lane >> 4;
    for (int unit = blockIdx.x; unit < 2048; unit += gridDim.x) {
        const int dir = unit >> 10, b = (unit >> 8) & 3, h = (unit >> 6) & 3, n = unit & 63;
        const long tok0 = (long)b * S_ + (dir ? (S_ - 1 - n * 64) : n * 64); const long tstep = dir ? -1 : 1;
#pragma unroll
        for (int i = 0; i < 6; ++i) { const int pi = tid + NTHR * i, which = pi >> 10, l = (pi >> 4) & 63, c8 = pi & 15;
            const u32x4 v = *(const u32x4*)(QKVN + (tok0 + l * tstep) * 1536 + which * 512 + h * 128 + c8 * 8);
            *(LAS u32x4*)(lds + which * 17408 + l * 272 + c8 * 16) = v; }
        if (tid < 64) { const long tk = tok0 + tid * tstep; la[tid] = LA[tk * 8 + dir * 4 + h]; be[tid] = BETA[tk * 8 + dir * 4 + h]; }
        __syncthreads();
        if (tid < 64) { float g = 0.f; for (int j = 0; j <= tid; ++j) g += la[j]; gl[tid] = g; beg[tid] = be[tid] * __expf(g); GB[((size_t)dir * T_ + (tok0 + tid * tstep)) * 4 + h] = g; }
        __syncthreads();
#pragma unroll
        for (int tt = 0; tt < 2; ++tt) { const int idx = wid * 2 + tt, mt = idx >> 2, nt = idx & 3;
            f32x4 kk = {0.f, 0.f, 0.f, 0.f}, qk = {0.f, 0.f, 0.f, 0.f};
            if (mt >= nt) { kk = mma_tile<128>(Kb + mt * 16 * 136, 136, Kb + nt * 16 * 136, 136, kk); qk = mma_tile<128>(Qb + mt * 16 * 136, 136, Kb + nt * 16 * 136, 136, qk); }
            const int j = nt * 16 + r; const float gj = gl[j];
#pragma unroll
            for (int i4 = 0; i4 < 4; ++i4) { const int i = mt * 16 + q * 4 + i4; const float dec = (i >= j) ? __expf(gl[i] - gj) : 0.f;
                Am[i * 68 + j] = (i > j) ? be[i] * kk[i4] * dec : 0.f;
                Z[(tok0 + i * tstep) * 3072 + 2048 + dir * 256 + h * 64 + j] = f2bf(qk[i4] * dec); }
        }
        __syncthreads();
        if (tid < 256) { const int c = tid;
            tri_solve64(Am, c < 128 ? Vb + c : Kb + (c - 128), c < 128 ? be : beg, Z + tok0 * 3072 + (c < 128 ? 0 : 1024) + dir * 512 + h * 128 + (c & 127), tstep * 3072); }
        __syncthreads();
    }
}

__device__ __forceinline__ void delta_scan2(LDSp lds, const Params& p) {
    const bf16_t* QKVN = (const bf16_t*)(p.ws + WS_QKV); const bf16_t* Z = (const bf16_t*)(p.ws + WS_Z); const float* GB = (const float*)(p.ws + WS_G);
    LAS unsigned short* Wb  = (LAS unsigned short*)lds;
    LAS unsigned short* Qg  = (LAS unsigned short*)(lds + 17408);
    LAS unsigned short* KgT = (LAS unsigned short*)(lds + 34816);
    LAS unsigned short* At  = (LAS unsigned short*)(lds + 53248);
    LAS unsigned short* Ub  = (LAS unsigned short*)(lds + 62464);
    LAS unsigned short* St  = (LAS unsigned short*)(lds + 66560);
    LAS unsigned short* Vt  = (LAS unsigned short*)(lds + 75264);
    const int tid = threadIdx.x, lane = tid & 63, wid = tid >> 6, r = lane & 15, q = lane >> 4;
    for (int unit = blockIdx.x; unit < 128; unit += gridDim.x) {
        const int dir = unit >> 6, b = (unit >> 4) & 3, h = (unit >> 2) & 3, sl = unit & 3;
        bf16_t* O = (bf16_t*)(p.ws + (dir ? WS_OB : WS_OF));
        const long tstep = dir ? -1 : 1;
        f32x4 S0 = {0.f, 0.f, 0.f, 0.f}, S1 = {0.f, 0.f, 0.f, 0.f};
        u32x4 rw[2], rq[2], rk[2], ra, ru = {0u, 0u, 0u, 0u}; float g0 = 0.f, g1 = 0.f, gL = 0.f;
#define D2_TOK0(n) ((long)b * S_ + (dir ? (S_ - 1 - (n) * 64) : (n) * 64))
#define D2_LOAD(n) do { const long t0_ = D2_TOK0(n); \
        _Pragma("unroll") for (int i = 0; i < 2; ++i) { const int pi = tid + NTHR * i, l = pi >> 4, c8 = pi & 15; const long tk = t0_ + l * tstep; \
            rw[i] = *(const u32x4*)(Z + tk * 3072 + 1024 + dir * 512 + h * 128 + c8 * 8); \
            rq[i] = *(const u32x4*)(QKVN + tk * 1536 + h * 128 + c8 * 8); rk[i] = *(const u32x4*)(QKVN + tk * 1536 + 512 + h * 128 + c8 * 8); } \
        { const int l = tid >> 3, c8 = tid & 7; ra = *(const u32x4*)(Z + (t0_ + l * tstep) * 3072 + 2048 + dir * 256 + h * 64 + c8 * 8); } \
        if (tid < 256) { const int l = tid >> 2, c8 = tid & 3; ru = *(const u32x4*)(Z + (t0_ + l * tstep) * 3072 + dir * 512 + h * 128 + sl * 32 + c8 * 8); } \
        g0 = GB[((size_t)dir * T_ + (t0_ + (tid >> 4) * tstep)) * 4 + h]; g1 = GB[((size_t)dir * T_ + (t0_ + ((tid >> 4) + 32) * tstep)) * 4 + h]; \
        gL = GB[((size_t)dir * T_ + (t0_ + 63 * tstep)) * 4 + h]; } while (0)
        D2_LOAD(0);
#pragma unroll 1
        for (int n = 0; n < 64; ++n) {
            const float egL = __expf(gL);
#pragma unroll
            for (int i = 0; i < 2; ++i) { const int pi = tid + NTHR * i, l = pi >> 4, c8 = pi & 15; const float gl_ = i == 0 ? g0 : g1;
                *(LAS u32x4*)(Wb + l * 136 + c8 * 8) = rw[i];
                float f[8]; unpack8(rq[i], f); const float eg = __expf(gl_);
                u32x4 o; o.x = pk2(f[0] * eg, f[1] * eg); o.y = pk2(f[2] * eg, f[3] * eg); o.z = pk2(f[4] * eg, f[5] * eg); o.w = pk2(f[6] * eg, f[7] * eg);
                *(LAS u32x4*)(Qg + l * 136 + c8 * 8) = o;
                unpack8(rk[i], f); const float ek = __expf(gL - gl_);
#pragma unroll
                for (int j = 0; j < 8; ++j) KgT[(c8 * 8 + j) * 72 + l] = f2bf(f[j] * ek); }
            { const int l = tid >> 3, c8 = tid & 7; *(LAS u32x4*)(At + l * 72 + c8 * 8) = ra; }
            if (tid < 256) { const int l = tid >> 2, c8 = tid & 3; *(LAS u32x4*)(Ub + l * 32 + c8 * 8) = ru; }
            { u32x2 w0; w0.x = pk2(S0.x, S0.y); w0.y = pk2(S0.z, S0.w); *(LAS u32x2*)(St + r * 136 + wid * 16 + q * 4) = w0;
              u32x2 w1; w1.x = pk2(S1.x, S1.y); w1.y = pk2(S1.z, S1.w); *(LAS u32x2*)(St + (16 + r) * 136 + wid * 16 + q * 4) = w1; }
            __syncthreads();
            if (n < 63) D2_LOAD(n + 1);
            const int mt = wid >> 1, nt = wid & 1;
            f32x4 p1 = {0.f, 0.f, 0.f, 0.f}, p2 = {0.f, 0.f, 0.f, 0.f};
            p1 = mma_tile<128>(Wb + mt * 16 * 136, 136, St + nt * 16 * 136, 136, p1);
            p2 = mma_tile<128>(Qg + mt * 16 * 136, 136, St + nt * 16 * 136, 136, p2);
            { const int l0 = mt * 16 + q * 4, v = nt * 16 + r; float vn[4];
#pragma unroll
              for (int i = 0; i < 4; ++i) vn[i] = bf2f(Ub[(l0 + i) * 32 + v]) - p1[i];
              u32x2 w; w.x = pk2(vn[0], vn[1]); w.y = pk2(vn[2], vn[3]); *(LAS u32x2*)(Vt + v * 72 + l0) = w; }
            __syncthreads();
            p2 = mma_tile<64>(At + mt * 16 * 72, 72, Vt + nt * 16 * 72, 72, p2);
            { const long t0_ = D2_TOK0(n);
#pragma unroll
              for (int i = 0; i < 4; ++i) O[(t0_ + (mt * 16 + q * 4 + i) * tstep) * 512 + h * 128 + sl * 32 + nt * 16 + r] = f2bf(p2[i]); }
            S0 = S0 * egL; S1 = S1 * egL;
            S0 = mma_tile<64>(KgT + wid * 16 * 72, 72, Vt, 72, S0);
            S1 = mma_tile<64>(KgT + wid * 16 * 72, 72, Vt + 16 * 72, 72, S1);
            __syncthreads();
        }
#undef D2_LOAD
#undef D2_TOK0
    }
}
constexpr size_t WS_CT = WS_OF, WS_NV = 235 * MiB, WS_MS = 235 * MiB + 524288, WS_CT2 = 169 * MiB, WS_NV2 = 236 * MiB;
__device__ __forceinline__ void mlstm_a(LDSp lds, const Params& p) {
    const bf16_t* Z = (const bf16_t*)(p.ws + WS_Z); const float* LI = (const float*)(p.ws + WS_BETA); const float* LF = (const float*)(p.ws + WS_LA);
    bf16_t* CT = (bf16_t*)(p.ws + WS_CT); float* NV = (float*)(p.ws + WS_NV); float* MS = (float*)(p.ws + WS_MS);
    LAS unsigned short* KsT = (LAS unsigned short*)lds;
    LAS unsigned short* Vt = (LAS unsigned short*)(lds + 9216);
    LAS float* lf = (LAS float*)(lds + 27648); LAS float* li = lf + 64; LAS float* sw = lf + 128;
    const int tid = threadIdx.x, lane = tid & 63, wid = tid >> 6, r = lane & 15, q = lane >> 4;
    for (int unit = blockIdx.x; unit < 2048; unit += gridDim.x) {
        const int dir = unit >> 10, b = (unit >> 8) & 3, h = (unit >> 6) & 3, n = unit & 63, pc = dir ? 63 - n : n;
        const size_t tok0 = (size_t)b * S_ + pc * 64;
        if (tid < 64) { lf[tid] = LF[(tok0 + tid) * 8 + dir * 4 + h]; li[tid] = LI[(tok0 + tid) * 8 + dir * 4 + h]; }
        __syncthreads();
        if (tid < 64) { float bc = 0.f, tot = 0.f;
            for (int j = 0; j < 64; ++j) { const float x = lf[j]; tot += x; if (dir ? (j >= tid) : (j <= tid)) bc += x; }
            const float we = tot - bc + li[tid]; float mx = we;
#pragma unroll
            for (int o = 32; o; o >>= 1) mx = fmaxf(mx, __shfl_xor(mx, o));
            sw[tid] = __expf(we - mx);
            if (tid == 0) { MS[unit * 32] = tot; MS[unit * 32 + 1] = mx; } }
        __syncthreads();
        { const int pp = tid >> 3, c8 = tid & 7; const u32x4 kv = *(const u32x4*)(Z + (tok0 + pp) * 2560 + 1280 + h * 64 + c8 * 8); float f[8]; unpack8(kv, f); const float s = sw[pp];
#pragma unroll
          for (int j = 0; j < 8; ++j) KsT[(c8 * 8 + j) * 72 + pp] = f2bf(f[j] * s); }
#pragma unroll
        for (int i = 0; i < 2; ++i) { const int pi = tid + NTHR * i, pp = pi >> 4, c8 = pi & 15; const u32x4 v = *(const u32x4*)(Z + (tok0 + pp) * 2560 + 1536 + h * 128 + c8 * 8);
            Vt[(c8 * 8 + 0) * 72 + pp] = (unsigned short)(v.x & 0xffffu); Vt[(c8 * 8 + 1) * 72 + pp] = (unsigned short)(v.x >> 16);
            Vt[(c8 * 8 + 2) * 72 + pp] = (unsigned short)(v.y & 0xffffu); Vt[(c8 * 8 + 3) * 72 + pp] = (unsigned short)(v.y >> 16);
            Vt[(c8 * 8 + 4) * 72 + pp] = (unsigned short)(v.z & 0xffffu); Vt[(c8 * 8 + 5) * 72 + pp] = (unsigned short)(v.z >> 16);
            Vt[(c8 * 8 + 6) * 72 + pp] = (unsigned short)(v.w & 0xffffu); Vt[(c8 * 8 + 7) * 72 + pp] = (unsigned short)(v.w >> 16); }
        __syncthreads();
#pragma unroll
        for (int dt = 0; dt < 4; ++dt) { f32x4 acc = {0.f, 0.f, 0.f, 0.f};
            acc = mma_tile<64>(KsT + dt * 16 * 72, 72, Vt + wid * 16 * 72, 72, acc);
            u32x2 w; w.x = pk2(acc.x, acc.y); w.y = pk2(acc.z, acc.w);
            *(u32x2*)(CT + (size_t)unit * 8192 + (wid * 16 + r) * 64 + dt * 16 + q * 4) = w; }
        if (tid < 64) { float a = 0.f; for (int j = 0; j < 64; ++j) a += bf2f(KsT[tid * 72 + j]); NV[(size_t)unit * 64 + tid] = a; }
        __syncthreads();
    }
}
__device__ __forceinline__ void mlstm_b(const Params& p) {
    const bf16_t* CT = (const bf16_t*)(p.ws + WS_CT); const float* NV = (const float*)(p.ws + WS_NV); float* MS = (float*)(p.ws + WS_MS); bf16_t* CT2 = (bf16_t*)(p.ws + WS_CT2); float* NV2 = (float*)(p.ws + WS_NV2);
    const int tid = threadIdx.x;
    for (int wgi = blockIdx.x; wgi < 128; wgi += gridDim.x) {
        const int scan = wgi >> 2, part = wgi & 3; const size_t e = (size_t)(part * NTHR + tid) * 4;
        const bool nvw = (part == 0 && tid < 64);
        float m = 0.f, c0 = 0.f, c1 = 0.f, c2 = 0.f, c3 = 0.f, nn = 0.f;
#pragma unroll 1
        for (int hf = 0; hf < 4; ++hf) {
        u32x2 dc[16]; float dn[16];
#pragma unroll
        for (int n = 0; n < 16; ++n) { dc[n] = (EXPC == 2) ? (u32x2){0u, 0u} : *(const u32x2*)(CT + (size_t)(scan * 64 + hf * 16 + n) * 8192 + e); dn[n] = nvw ? NV[(size_t)(scan * 64 + hf * 16 + n) * 64 + tid] : 0.f; }
#pragma unroll
        for (int n = 0; n < 16; ++n) { const int unit = scan * 64 + hf * 16 + n;
            const float bl = MS[unit * 32], ml = MS[unit * 32 + 1];
            u32x2 w; w.x = pk2(c0, c1); w.y = pk2(c2, c3); *(u32x2*)(CT2 + (size_t)unit * 8192 + e) = w;
            if (nvw) NV2[(size_t)unit * 64 + tid] = nn;
            if (part == 0 && tid == 0) MS[65536 + unit] = m;
            const float mn = fmaxf(bl + m, ml), a = __expf(bl + m - mn), bb = __expf(ml - mn);
            c0 = a * c0 + bb * bflo(dc[n].x); c1 = a * c1 + bb * bfhi(dc[n].x); c2 = a * c2 + bb * bflo(dc[n].y); c3 = a * c3 + bb * bfhi(dc[n].y);
            nn = a * nn + bb * dn[n]; m = mn; }
        }
    }
}
__device__ __forceinline__ void mlstm_c(LDSp lds, const Params& p) {
    const bf16_t* Z = (const bf16_t*)(p.ws + WS_Z); const float* LI = (const float*)(p.ws + WS_BETA); const float* LF = (const float*)(p.ws + WS_LA);
    const bf16_t* CT = (const bf16_t*)(p.ws + WS_CT2); const float* NV = (const float*)(p.ws + WS_NV2); const float* MS = (const float*)(p.ws + WS_MS);
    bf16_t* Y = (bf16_t*)(p.ws + WS_HN); const float* gn = p.in[19];
    LAS unsigned short* Qb = (LAS unsigned short*)lds;
    LAS unsigned short* Kb = (LAS unsigned short*)(lds + 9216);
    LAS unsigned short* Vt = (LAS unsigned short*)(lds + 18432);
    LAS unsigned short* Cb = (LAS unsigned short*)(lds + 36864);
    LAS unsigned short* Pb = (LAS unsigned short*)(lds + 55296);
    LAS float* lf = (LAS float*)(lds + 64512); LAS float* li = lf + 64; LAS float* bcs = lf + 128; LAS float* mtv = lf + 192; LAS float* iw = lf + 256;
    LAS float* dn = lf + 320; LAS float* nv = lf + 384; LAS float* emt = lf + 448; LAS float* dnp = lf + 512  ; LAS float* ssp = lf + 768  ;
    const int tid = threadIdx.x, lane = tid & 63, wid = tid >> 6, r = lane & 15, q = lane >> 4;
    for (int unit = blockIdx.x; unit < 1024; unit += gridDim.x) {
        const int b = unit >> 8, h = (unit >> 6) & 3, pc = unit & 63; const size_t tok0 = (size_t)b * S_ + pc * 64;
        { const int pp = tid >> 3, c8 = tid & 7;
          *(LAS u32x4*)(Qb + pp * 72 + c8 * 8) = *(const u32x4*)(Z + (tok0 + pp) * 2560 + 1024 + h * 64 + c8 * 8);
          *(LAS u32x4*)(Kb + pp * 72 + c8 * 8) = *(const u32x4*)(Z + (tok0 + pp) * 2560 + 1280 + h * 64 + c8 * 8); }
#pragma unroll
        for (int i = 0; i < 2; ++i) { const int pi = tid + NTHR * i, pp = pi >> 4, c8 = pi & 15; const u32x4 v = *(const u32x4*)(Z + (tok0 + pp) * 2560 + 1536 + h * 128 + c8 * 8);
            Vt[(c8 * 8 + 0) * 72 + pp] = (unsigned short)(v.x & 0xffffu); Vt[(c8 * 8 + 1) * 72 + pp] = (unsigned short)(v.x >> 16);
            Vt[(c8 * 8 + 2) * 72 + pp] = (unsigned short)(v.y & 0xffffu); Vt[(c8 * 8 + 3) * 72 + pp] = (unsigned short)(v.y >> 16);
            Vt[(c8 * 8 + 4) * 72 + pp] = (unsigned short)(v.z & 0xffffu); Vt[(c8 * 8 + 5) * 72 + pp] = (unsigned short)(v.z >> 16);
            Vt[(c8 * 8 + 6) * 72 + pp] = (unsigned short)(v.w & 0xffffu); Vt[(c8 * 8 + 7) * 72 + pp] = (unsigned short)(v.w >> 16); }
        f32x4 hacc[4];
#pragma unroll
        for (int mt = 0; mt < 4; ++mt) hacc[mt] = (f32x4){0.f, 0.f, 0.f, 0.f};
#pragma unroll 1
        for (int dir = 0; dir < 2; ++dir) {
            const int n = dir ? 63 - pc : pc; const size_t u2 = (size_t)(((dir * 4 + b) * 4 + h) * 64 + n);
#pragma unroll
            for (int i = 0; i < 2; ++i) { const int pi = tid + NTHR * i, v = pi >> 3, c8 = pi & 7; *(LAS u32x4*)(Cb + v * 72 + c8 * 8) = (EXPC == 1) ? (u32x4){0u, 0u, 0u, 0u} : *(const u32x4*)(CT + u2 * 8192 + v * 64 + c8 * 8); }
            if (tid < 64) { lf[tid] = LF[(tok0 + tid) * 8 + dir * 4 + h]; li[tid] = LI[(tok0 + tid) * 8 + dir * 4 + h]; nv[tid] = (EXPC == 1) ? 0.f : NV[u2 * 64 + tid]; }
            const float mst = (EXPC == 1) ? 0.f : MS[65536 + u2];
            __syncthreads();
            if (tid < 64) { float bc = 0.f;
                for (int j = 0; j < 64; ++j) { const float x = lf[j]; if (dir ? (j >= tid) : (j <= tid)) bc += x; }
                bcs[tid] = bc; }
            __syncthreads();
            if (tid < 64) { const float bt = bcs[tid]; float dmax = -3.0e38f;
                for (int j = 0; j < 64; ++j) { const float d = bt - bcs[j] + li[j]; if (dir ? (j >= tid) : (j <= tid)) dmax = fmaxf(dmax, d); }
                const float m = fmaxf(bt + mst, dmax), w = __expf(bt + mst - m);
                float qn = 0.f;
                for (int d = 0; d < 64; ++d) qn = fmaf(bf2f(Qb[tid * 72 + d]), nv[d], qn);
                mtv[tid] = m; iw[tid] = w * 0.125f; emt[tid] = __expf(-m); dn[tid] = w * 0.125f * qn; }
            __syncthreads();
#pragma unroll
            for (int tt = 0; tt < 2; ++tt) { const int idx = wid * 2 + tt, mt = idx >> 2, nt = idx & 3;
                f32x4 sc = {0.f, 0.f, 0.f, 0.f};
                sc = mma_tile<64>(Qb + mt * 16 * 72, 72, Kb + nt * 16 * 72, 72, sc);
                const int s = nt * 16 + r; const float bs = bcs[s] - li[s];
#pragma unroll
                for (int i = 0; i < 4; ++i) { const int t = mt * 16 + q * 4 + i; const bool ok = dir ? (s >= t) : (s <= t);
                    const float pv = ok ? __expf(bcs[t] - bs - mtv[t]) * sc[i] * 0.125f : 0.f;
                    const unsigned short pb = f2bf(pv); Pb[t * 72 + s] = pb;
                    const float rs = row16_sum(bf2f(pb));
                    if (r == 0) dnp[nt * 64 + t] = rs; }
            }
            __syncthreads();
#pragma unroll
            for (int mt = 0; mt < 4; ++mt) { f32x4 a1 = {0.f, 0.f, 0.f, 0.f}, a2 = {0.f, 0.f, 0.f, 0.f};
                a1 = mma_tile<64>(Qb + mt * 16 * 72, 72, Cb + wid * 16 * 72, 72, a1);
                a2 = mma_tile<64>(Pb + mt * 16 * 72, 72, Vt + wid * 16 * 72, 72, a2);
#pragma unroll
                for (int i = 0; i < 4; ++i) { const int t = mt * 16 + q * 4 + i;
                    const float den = dn[t] + ((dnp[t] + dnp[64 + t]) + (dnp[128 + t] + dnp[192 + t]));
                    hacc[mt][i] += (iw[t] * a1[i] + a2[i]) / fmaxf(fabsf(den), emt[t]); }
            }
            __syncthreads();
        }
#pragma unroll
        for (int mt = 0; mt < 4; ++mt)
#pragma unroll
            for (int i = 0; i < 4; ++i) { const float s = row16_sum(hacc[mt][i] * hacc[mt][i]); if (r == 0) ssp[wid * 64 + mt * 16 + q * 4 + i] = s; }
        __syncthreads();
        { const int v = wid * 16 + r; const float g = gn[v];
#pragma unroll
          for (int mt = 0; mt < 4; ++mt)
#pragma unroll
              for (int i = 0; i < 4; ++i) { const int t = mt * 16 + q * 4 + i;
                  float ss = 0.f;
#pragma unroll
                  for (int w = 0; w < 8; ++w) ss += ssp[w * 64 + t];
                  const float rstd = rsqrtf(ss * (1.0f / 128.0f) + 1e-6f);
                  const float og = sigm(bf2f(Z[(tok0 + t) * 2560 + 2048 + h * 128 + v]));
                  Y[(tok0 + t) * 1024 + 512 + h * 128 + v] = f2bf(hacc[mt][i] * rstd * g * og); } }
        __syncthreads();
    }
}
__device__ __forceinline__ void headnorm_phase(const Params& p, const float* __restrict__ g, int zld, int zcol, int act) {
    const bf16_t* OF = (const bf16_t*)(p.ws + WS_OF); const bf16_t* OB = (const bf16_t*)(p.ws + WS_OB); const bf16_t* Z = (const bf16_t*)(p.ws + WS_Z); bf16_t* Y = (bf16_t*)(p.ws + WS_HN);
    const int tid = threadIdx.x, lane = tid & 63, wid = tid >> 6, c = lane * 8;
    const f32x4 g0 = *(const f32x4*)(g + (c & 127)), g1 = *(const f32x4*)(g + (c & 127) + 4);
    for (int tok = blockIdx.x * 8 + wid; tok < T_; tok += gridDim.x * 8) {
        const u32x4 a = *(const u32x4*)(OF + (size_t)tok * 512 + c), bq = *(const u32x4*)(OB + (size_t)tok * 512 + c), gz = *(const u32x4*)(Z + (size_t)tok * zld + zcol + c);
        float fa[8], fb[8], fg[8], o[8]; unpack8(a, fa); unpack8(bq, fb); unpack8(gz, fg);
        float ss = 0.f;
#pragma unroll
        for (int i = 0; i < 8; ++i) { o[i] = fa[i] + fb[i]; ss = fmaf(o[i], o[i], ss); }
        ss = row16_sum(ss);
        const float rstd = rsqrtf(ss * (1.0f / 128.0f) + 1e-6f);
        const float gg[8] = {g0.x, g0.y, g0.z, g0.w, g1.x, g1.y, g1.z, g1.w};
        float y[8];
#pragma unroll
        for (int i = 0; i < 8; ++i) y[i] = o[i] * rstd * gg[i] * (act == 0 ? silu_(fg[i]) : sigm(fg[i]));
        u32x4 w; w.x = pk2(y[0], y[1]); w.y = pk2(y[2], y[3]); w.z = pk2(y[4], y[5]); w.w = pk2(y[6], y[7]);
        *(u32x4*)(Y + (size_t)tok * 1024 + 512 + c) = w;
    }
}

__device__ __forceinline__ void odd_prep(const Params& p) {
    const bf16_t* Z = (const bf16_t*)(p.ws + WS_Z); bf16_t* VV = (bf16_t*)(p.ws + WS_QKV);
    const float* gates = (const float*)(p.ws + WS_GATES); float* LI = (float*)(p.ws + WS_BETA); float* LF = (float*)(p.ws + WS_LA);
    const float* ln_g = p.in[13]; const float* ln_b = p.in[14]; const float* ib = p.in[17]; const float* fb = p.in[18];
    const int tid = threadIdx.x, lane = tid & 63, wid = tid >> 6, c = lane * 8;
    const f32x4 g0 = *(const f32x4*)(ln_g + c), g1 = *(const f32x4*)(ln_g + c + 4), b0 = *(const f32x4*)(ln_b + c), b1 = *(const f32x4*)(ln_b + c + 4);
    const float gg[8] = {g0.x, g0.y, g0.z, g0.w, g1.x, g1.y, g1.z, g1.w}, bb[8] = {b0.x, b0.y, b0.z, b0.w, b1.x, b1.y, b1.z, b1.w};
    for (int tok = blockIdx.x * 8 + wid; tok < T_; tok += gridDim.x * 8) {
        const u32x4 v = *(const u32x4*)(Z + (size_t)tok * 2560 + 512 + c);
        float x[8]; unpack8(v, x); float sm = 0.f;
#pragma unroll
        for (int i = 0; i < 8; ++i) { x[i] = gelu_t(x[i]); sm += x[i]; }
        const float mean = wave_sum(sm) * (1.0f / 512.0f); float sq = 0.f;
#pragma unroll
        for (int i = 0; i < 8; ++i) { x[i] -= mean; sq = fmaf(x[i], x[i], sq); }
        const float rstd = rsqrtf(wave_sum(sq) * (1.0f / 512.0f) + 1e-5f);
        float y[8];
#pragma unroll
        for (int i = 0; i < 8; ++i) y[i] = x[i] * rstd * gg[i] + bb[i];
        u32x4 w; w.x = pk2(y[0], y[1]); w.y = pk2(y[2], y[3]); w.z = pk2(y[4], y[5]); w.w = pk2(y[6], y[7]);
        *(u32x4*)(VV + (size_t)tok * 512 + c) = w;
        if (lane < 8) { LI[(size_t)tok * 8 + lane] = gates[(size_t)tok * 16 + lane] + ib[lane];
                        LF[(size_t)tok * 8 + lane] = -softplus_(-(gates[(size_t)tok * 16 + 8 + lane] + fb[lane])); }
    }
}

__device__ __forceinline__ void sg_phase(LDSp lds, const Params& p, int sgId, int sgG) {
    typedef short bf16x8 __attribute__((ext_vector_type(8)));
    const bf16_t* Z = (const bf16_t*)(p.ws + WS_Z); const bf16_t* VV = (const bf16_t*)(p.ws + WS_QKV); bf16_t* Y = (bf16_t*)(p.ws + WS_HN);
    const float* sgw = p.in[15]; const float* sgb = p.in[16];
    LAS unsigned short* Wb = (LAS unsigned short*)lds;
    LAS unsigned short* Vt = (LAS unsigned short*)(lds + 34816);
    const int tid = threadIdx.x, lane = tid & 63, wid = tid >> 6;
    for (int unit = sgId; unit < 512; unit += sgG) {
        const int g = unit & 3, n = (unit >> 2) & 31, b = unit >> 7; const size_t tok0 = (size_t)b * S_ + n * 128;
#pragma unroll
        for (int i = 0; i < 8; ++i) { const int i4 = tid + NTHR * i, t = i4 >> 5, s4 = (i4 & 31) << 2; const f32x4 w = *(const f32x4*)(sgw + (size_t)g * 16384 + t * 128 + s4);
            u32x2 o; o.x = pk2(w.x, w.y); o.y = pk2(w.z, w.w); *(LAS u32x2*)(Wb + t * 136 + s4) = o; }
#pragma unroll
        for (int i = 0; i < 4; ++i) { const int pi = tid + NTHR * i, s = pi >> 4, c8 = (pi & 15) << 3; const u32x4 v = *(const u32x4*)(VV + (tok0 + s) * 512 + g * 128 + c8);
            Vt[(c8 + 0) * 136 + s] = (unsigned short)(v.x & 0xffffu); Vt[(c8 + 1) * 136 + s] = (unsigned short)(v.x >> 16);
            Vt[(c8 + 2) * 136 + s] = (unsigned short)(v.y & 0xffffu); Vt[(c8 + 3) * 136 + s] = (unsigned short)(v.y >> 16);
            Vt[(c8 + 4) * 136 + s] = (unsigned short)(v.z & 0xffffu); Vt[(c8 + 5) * 136 + s] = (unsigned short)(v.z >> 16);
            Vt[(c8 + 6) * 136 + s] = (unsigned short)(v.w & 0xffffu); Vt[(c8 + 7) * 136 + s] = (unsigned short)(v.w >> 16); }
        __syncthreads();
        bf16x8 af[4];
#pragma unroll
        for (int ks = 0; ks < 4; ++ks) af[ks] = *(const LAS bf16x8*)(Wb + (16 * wid + (lane & 15)) * 136 + ks * 32 + (lane >> 4) * 8);
#pragma unroll
        for (int nn = 0; nn < 8; ++nn) {
            f32x4 acc = {0.f, 0.f, 0.f, 0.f};
#pragma unroll
            for (int ks = 0; ks < 4; ++ks) { const bf16x8 bfrag = *(const LAS bf16x8*)(Vt + (16 * nn + (lane & 15)) * 136 + ks * 32 + (lane >> 4) * 8);
                acc = __builtin_amdgcn_mfma_f32_16x16x32_bf16(af[ks], bfrag, acc, 0, 0, 0); }
            const int cc = g * 128 + 16 * nn + (lane & 15);
#pragma unroll
            for (int i = 0; i < 4; ++i) { const int t = 16 * wid + (lane >> 4) * 4 + i; const size_t tok = tok0 + t;
                const float u = gelu_t(bf2f(Z[tok * 2560 + cc]));
                Y[tok * 1024 + cc] = f2bf(u * (acc[i] + sgb[g * 128 + t])); }
        }
        __syncthreads();
    }
}

__device__ __forceinline__ void mlstm_scan(LDSp lds, const Params& p) {
    const bf16_t* Z = (const bf16_t*)(p.ws + WS_Z); const float* LI = (const float*)(p.ws + WS_BETA); const float* LF = (const float*)(p.ws + WS_LA);
    const int tid = threadIdx.x, jl = tid >> 4, sub = tid & 15;
    constexpr int BUF = 20992;
    LAS float* ost = (LAS float*)(lds + 2 * BUF);
    for (int unit = blockIdx.x; unit < 128; unit += gridDim.x) {
        const int dir = unit >> 6, b = (unit >> 4) & 3, h = (unit >> 2) & 3, sl = unit & 3;
        bf16_t* O = (bf16_t*)(p.ws + (dir ? WS_OB : WS_OF));
        float C[4], N[4];
#pragma unroll
        for (int i = 0; i < 4; ++i) { C[i] = 0.f; N[i] = 0.f; }
        u32x4 rq, rk, rv = {0u, 0u, 0u, 0u}; float ri = 0.f, rf = 0.f;
#define ML_TOK(n, s) ((size_t)b * S_ + (dir ? (S_ - 1 - ((n) * 64 + (s))) : ((n) * 64 + (s))))
#define ML_LOAD(n) do { { const int s = tid >> 3, c8 = tid & 7; const size_t tk = ML_TOK(n, s); \
            rq = *(const u32x4*)(Z + tk * 2560 + 1024 + h * 64 + c8 * 8); rk = *(const u32x4*)(Z + tk * 2560 + 1280 + h * 64 + c8 * 8); } \
        if (tid < 256) { const int s = tid >> 2, c8 = tid & 3; rv = *(const u32x4*)(Z + ML_TOK(n, s) * 2560 + 1536 + h * 128 + sl * 32 + c8 * 8); } \
        if (tid < 64) { const size_t tk = ML_TOK(n, tid); ri = expf(LI[tk * 8 + dir * 4 + h]); rf = expf(LF[tk * 8 + dir * 4 + h]); } } while (0)
#define ML_STORE(bufp) do { *(LAS u32x4*)((bufp) + tid * 16) = rq; *(LAS u32x4*)((bufp) + 8192 + tid * 16) = rk; \
        if (tid < 256) *(LAS u32x4*)((bufp) + 16384 + tid * 16) = rv; \
        if (tid < 64) { *(LAS float*)((bufp) + 20480 + tid * 8) = ri; *(LAS float*)((bufp) + 20480 + tid * 8 + 4) = rf; } } while (0)
        ML_LOAD(0); ML_STORE(lds); __syncthreads();
#pragma unroll 1
        for (int n = 0; n < 64; ++n) {
            LDSp cb = lds + (n & 1) * BUF; LDSp nb = lds + ((n + 1) & 1) * BUF; LAS float* os = ost + (n & 1) * 2048;
            if (n < 63) ML_LOAD(n + 1);
#pragma unroll 4
            for (int s = 0; s < 64; ++s) {
                const u32x2 qq = *(const LAS u32x2*)(cb + s * 128 + sub * 8), kk = *(const LAS u32x2*)(cb + 8192 + s * 128 + sub * 8);
                const float vj = bf2f(*(const LAS unsigned short*)(cb + 16384 + s * 64 + jl * 2));
                const float ig = *(const LAS float*)(cb + 20480 + s * 8), fg = *(const LAS float*)(cb + 20480 + s * 8 + 4);
                const float qf[4] = {bflo(qq.x), bfhi(qq.x), bflo(qq.y), bfhi(qq.y)}, kf[4] = {bflo(kk.x), bfhi(kk.x), bflo(kk.y), bfhi(kk.y)};
                const float iv = ig * vj; float num = 0.f, den = 0.f;
#pragma unroll
                for (int i = 0; i < 4; ++i) { C[i] = fmaf(iv, kf[i], fg * C[i]); N[i] = fmaf(ig, kf[i], fg * N[i]); num = fmaf(qf[i], C[i], num); den = fmaf(qf[i], N[i], den); }
                num = row16_sum(num); den = row16_sum(den);
                if (sub == 0) os[s * 32 + jl] = 0.125f * num / fmaxf(fabsf(0.125f * den), 1.0f);
            }
            if (n < 63) ML_STORE(nb);
            __syncthreads();
            { const int s = tid >> 3, j4 = (tid & 7) << 2; const f32x4 o4 = *(const LAS f32x4*)(os + s * 32 + j4);
              u32x2 w; w.x = pk2(o4.x, o4.y); w.y = pk2(o4.z, o4.w);
              *(u32x2*)(O + ML_TOK(n, s) * 512 + h * 128 + sl * 32 + j4) = w; }
        }
        __syncthreads();
#undef ML_LOAD
#undef ML_STORE
#undef ML_TOK
    }
}

#define XB_TMO      128
#define XB_XCNT(j)  (256  + 64 * (j))
#define XB_XSUB(j)  (1280 + 64 * (j))
#define XB_XGEN(j)  (2304 + 64 * (j))
#define XB_TOP      3328
#define XB_TOPGEN   3392
#define XCD_BAR_WORDS 3456
#define XB_SPIN_CAP (1u << 18)

__device__ __forceinline__ unsigned xb_ld(unsigned* p)              { return __hip_atomic_load(p, __ATOMIC_RELAXED, __HIP_MEMORY_SCOPE_AGENT); }
__device__ __forceinline__ unsigned xb_add(unsigned* p, unsigned v) { return __hip_atomic_fetch_add(p, v, __ATOMIC_RELAXED, __HIP_MEMORY_SCOPE_AGENT); }
__device__ __forceinline__ unsigned xb_xcc_id() { return (unsigned)__builtin_amdgcn_s_getreg((3 << 11) | 20) & 0xFu; }
#define XB_SPIN(cond, bar) do { unsigned _sp = 0; while (cond) { __builtin_amdgcn_s_sleep(1); \
    if ((++_sp & 255u) == 0u) { if (xb_ld(&(bar)[XB_TMO])) break; if (_sp > XB_SPIN_CAP) { atomicAdd(&(bar)[XB_TMO], 1u); break; } } } } while (0)

struct XcdBarrier {
    unsigned* bar; unsigned x;
    volatile LAS unsigned* st;
};

__device__ __forceinline__ XcdBarrier xcd_barrier_post(unsigned* bar, volatile LAS unsigned* st) {
    XcdBarrier b; b.bar = bar; b.x = xb_xcc_id(); b.st = st;
    if (threadIdx.x == 0) (void)xb_add(&bar[XB_XCNT(b.x)], 1u);
    return b;
}
__device__ __forceinline__ void xcd_barrier_complete(unsigned* bar, unsigned x, unsigned& nloc, unsigned& nx) {
    const unsigned G = gridDim.x * gridDim.y * gridDim.z;
    unsigned sum, cnt, mine, sp = 0u;
    for (;;) {
        sum = 0u; cnt = 0u; mine = 0u;
#pragma unroll
        for (unsigned j = 0; j < 16; ++j) { const unsigned c = xb_ld(&bar[XB_XCNT(j)]); sum += c; cnt += (c > 0u) ? 1u : 0u; mine = (j == x) ? c : mine; }
        if (sum == G) break;
        __builtin_amdgcn_s_sleep(1);
        if ((++sp & 255u) == 0u) { if (xb_ld(&bar[XB_TMO])) break; if (sp > XB_SPIN_CAP) { atomicAdd(&bar[XB_TMO], 1u); break; } }
    }
    nloc = mine > 0u ? mine : 1u; nx = cnt > 0u ? cnt : 1u;
}

__device__ __forceinline__ void xcd_barrier(const XcdBarrier& b) {
    asm volatile("s_waitcnt vmcnt(0)" ::: "memory");
    __syncthreads();
    if (threadIdx.x == 0) {
        unsigned* bar = b.bar;
        __builtin_amdgcn_s_waitcnt(0);
        unsigned nloc = b.st[0], nx = b.st[1];
        if (nloc == 0u) { xcd_barrier_complete(bar, b.x, nloc, nx); b.st[0] = nloc; b.st[1] = nx; }
        const unsigned old = xb_add(&bar[XB_XSUB(b.x)], 1u);
        const unsigned gen = old / nloc;
        if (old + 1u == (gen + 1u) * nloc) {
            __builtin_amdgcn_fence(__ATOMIC_RELEASE, "agent");
            asm volatile("s_waitcnt vmcnt(0)" ::: "memory");
            const unsigned og = xb_add(&bar[XB_TOP], 1u);
            const unsigned tg = og / nx;
            if (og + 1u == (tg + 1u) * nx) xb_add(&bar[XB_TOPGEN], 1u);
            else XB_SPIN(xb_ld(&bar[XB_TOPGEN]) == tg, bar);
            __builtin_amdgcn_fence(__ATOMIC_ACQUIRE, "agent");
            xb_add(&bar[XB_XGEN(b.x)], 1u);
            asm volatile("s_waitcnt vmcnt(0)" ::: "memory");
        } else {
            XB_SPIN(xb_ld(&bar[XB_XGEN(b.x)]) == gen, bar);
            __builtin_amdgcn_fence(__ATOMIC_ACQUIRE, "agent");
            asm volatile("s_waitcnt vmcnt(0)" ::: "memory");
        }
    }
    __syncthreads();
}
constexpr size_t WS_BAR = 238 * MiB;
#ifndef N_PHASES
#define N_PHASES 21
#endif
template <int L, int SUB> __device__ __forceinline__ void run_phase(LDSp lds, const Params& p) {
    unsigned char* ws = p.ws;
    bf16_t* HN = (bf16_t*)(ws + WS_HN); bf16_t* Zb = (bf16_t*)(ws + WS_Z); float* h = p.out; float* gates = (float*)(ws + WS_GATES);
    const bf16_t* W_IN = (const bf16_t*)(ws + WS_WB + WB_IN); const bf16_t* W_OUT = (const bf16_t*)(ws + WS_WB + WB_OUT);
    const bf16_t* W_UP = (const bf16_t*)(ws + WS_WB + WB_UP); const bf16_t* W_DN = (const bf16_t*)(ws + WS_WB + WB_DN);
    const int G = gridDim.x;
    if constexpr (L == 2) { rms_phase(lds, h, p.in[25], nullptr, nullptr, h, nullptr, 0, 0, nullptr); }
    else if constexpr (SUB == 0) {
        convert_layer(lds, p, L);
        if constexpr (L == 0) rms_phase(lds, p.in[0], p.in[1], HN, h, nullptr, p.in[2], 3088, 3072, gates);
        else                  rms_phase(lds, h, p.in[1] + 1024, HN, nullptr, nullptr, p.in[12], 2576, 2560, gates);
    } else if constexpr (SUB == 1) { constexpr int N = L == 0 ? 3072 : 2560;
        pg8::Gemm g{HN, W_IN, T_, N, 1024}; pg8::StaticOrder S; S.init(T_, N, G, (int)blockIdx.x);
        pg8::EpiBf16<0> E{Zb, N, nullptr, 0, 0};
        pg8::gemm_phase<pg8::EpiBf16<0>, pg8::StaticOrder>(lds, g, S, E, nullptr);
    } else if constexpr (SUB == 2) { if constexpr (L == 0) even_prep(lds, p); else odd_prep(p); }
    else if constexpr (SUB == 9) { delta_prep(lds, p); }
    else if constexpr (SUB == 10) { mlstm_b(p); }
    else if constexpr (SUB == 11) { mlstm_c(lds, p); }
    else if constexpr (SUB == 12) { mlstm_scan(lds, p); }
    else if constexpr (SUB == 3) {
        if constexpr (L == 0) delta_scan2(lds, p);
        else { mlstm_a(lds, p); sg_phase(lds, p, (int)blockIdx.x, G); }
    } else if constexpr (SUB == 4) { if constexpr (L == 0) headnorm_phase(p, p.in[10], 3072, 2560, 0); else headnorm_phase(p, p.in[19], 2560, 2048, 1); }
    else if constexpr (SUB == 5) { pg8::Gemm g{HN, W_OUT, T_, 1024, 1024}; pg8::StaticOrder S; S.init(T_, 1024, G, (int)blockIdx.x);
        pg8::EpiAddF32 E{h, 1024};
        pg8::gemm_phase<pg8::EpiAddF32, pg8::StaticOrder>(lds, g, S, E, nullptr);
    } else if constexpr (SUB == 6) { rms_phase(lds, h, p.in[21] + L * 1024, HN, nullptr, nullptr, nullptr, 0, 0, nullptr); }
    else if constexpr (SUB == 7) { pg8::Gemm g{HN, W_UP, T_, 2 * DFF, 1024}; pg8::StaticOrder S; S.init(T_, 2 * DFF, G, (int)blockIdx.x);
        pg8::EpiSwiGLU E{Zb, DFF};
        pg8::gemm_phase<pg8::EpiSwiGLU, pg8::StaticOrder>(lds, g, S, E, nullptr);
    } else if constexpr (SUB == 8) { pg8::Gemm g{Zb, W_DN, T_, 1024, DFF}; pg8::StaticOrder S; S.init(T_, 1024, G, (int)blockIdx.x);
        pg8::EpiAddF32 E{h, 1024};
        pg8::gemm_phase<pg8::EpiAddF32, pg8::StaticOrder>(lds, g, S, E, nullptr);
    }
}
__global__ void __launch_bounds__(NTHR, 2) mega(Params p, int ph_lo, int ph_hi) {
    extern __shared__ __attribute__((aligned(16))) unsigned char lds_raw[];
    LDSp lds = (LDSp)lds_raw;
    cg::grid_group grid = cg::this_grid();
    volatile LAS unsigned* xst = (volatile LAS unsigned*)(lds + LDS_BYTES - 16);
    if (threadIdx.x == 0) { xst[0] = 0u; xst[1] = 0u; }
    __syncthreads();
    XcdBarrier xbar; xbar.bar = (unsigned*)(p.ws + WS_BAR); xbar.x = 0; xbar.st = xst;
    if (ph_hi - ph_lo > 1) xbar = xcd_barrier_post((unsigned*)(p.ws + WS_BAR), xst);
#ifndef REP_MASK
#define REP_MASK 0
#endif
#define PH(k, L, SUB) if (ph_lo <= (k) && (k) < ph_hi) { run_phase<L, SUB>(lds, p); if ((REP_MASK >> (k)) & 1) { __syncthreads(); run_phase<L, SUB>(lds, p); } if ((k) + 1 < ph_hi) { if ((k) == 0) grid.sync(); else xcd_barrier(xbar); } }
    PH(0, 0, 0) PH(1, 0, 1) PH(2, 0, 2) PH(3, 0, 9) PH(4, 0, 3) PH(5, 0, 4) PH(6, 0, 5) PH(7, 0, 6) PH(8, 0, 7) PH(9, 0, 8)
    PH(10, 1, 0) PH(11, 1, 1) PH(12, 1, 2) PH(13, 1, 3) PH(14, 1, 10) PH(15, 1, 11)
#ifdef EXP_OLD
    { run_phase<1, 12>(lds, p); grid.sync(); run_phase<1, 4>(lds, p); grid.sync(); }
#endif
    PH(16, 1, 5) PH(17, 1, 6) PH(18, 1, 7) PH(19, 1, 8)
    PH(20, 2, 0)
#ifdef EXTRA_SYNCS
    for (int i_ = 0; i_ < EXTRA_SYNCS; ++i_) grid.sync();
#endif
#undef PH
}

extern "C" void kernel_launch(void* const* d_in, const int* in_sizes, int n_in, void* d_out, int out_size, void* d_ws, size_t ws_size, hipStream_t stream) {
    static int grid = 0;
    if (grid == 0) {
        int dev = 0, cus = 0, per_cu = 0;
        (void)hipGetDevice(&dev);
        (void)hipDeviceGetAttribute(&cus, hipDeviceAttributeMultiprocessorCount, dev);
        (void)hipFuncSetAttribute((const void*)mega, hipFuncAttributeMaxDynamicSharedMemorySize, LDS_BYTES);
        if (hipOccupancyMaxActiveBlocksPerMultiprocessor(&per_cu, (const void*)mega, NTHR, LDS_BYTES) != hipSuccess || per_cu < 1) per_cu = 1;
        (void)hipGetLastError();
        if (cus <= 0) cus = 256;
        grid = cus * per_cu;
    }
    if (ws_size < 239 * MiB) { fprintf(stderr, "workspace too small: %zu\n", ws_size); return; }
    Params p{};
    for (int i = 0; i < 26; ++i) p.in[i] = (const float*)d_in[i];
    p.out = (float*)d_out; p.ws = (unsigned char*)d_ws;
#if defined(MULTI_LAUNCH)
    for (int ph = 0; ph < N_PHASES; ++ph) hipLaunchKernelGGL(mega, dim3(grid), dim3(NTHR), LDS_BYTES, stream, p, ph, ph + 1);
#else
    (void)hipMemsetAsync((char*)d_ws + WS_BAR, 0, XCD_BAR_WORDS * 4, stream);
    int lo = 0, hi = N_PHASES;
    void* args[] = {(void*)&p, (void*)&lo, (void*)&hi};
    hipError_t e = hipLaunchCooperativeKernel((const void*)mega, dim3(grid), dim3(NTHR), args, LDS_BYTES, stream);
    if (e != hipSuccess) fprintf(stderr, "cooperative launch failed: %s (grid %d)\n", hipGetErrorString(e), grid);
#endif
}
```

```cpp
#include <hip/hip_runtime.h>
#include <hip/hip_cooperative_groups.h>
#include <cstdio>
namespace cg = cooperative_groups;
namespace pg8 {
#define PG8_LAS __attribute__((address_space(3)))
typedef unsigned short bf16_t;
typedef short bf16x8 __attribute__((ext_vector_type(8)));
typedef float f32x4 __attribute__((ext_vector_type(4)));
typedef unsigned u32x4 __attribute__((ext_vector_type(4)));
constexpr int BM = 256, BK = 64, HALF = 128, HTB = HALF * BK * 2  , STAGE_BYTES = 8 * HTB, NXCD = 8, WGM = 8;

__host__ __device__ __forceinline__ int lds_byte(int r, int c) { const int st = (r >> 4) * 2 + (c >> 5), rr = r & 15, cc = c & 31, ob = rr * 64 + cc * 2; return st * 1024 + (ob ^ (((ob >> 9) & 1) << 5)); }
__host__ __device__ __forceinline__ void stage_rc(int b, int& R, int& C) { const int st = b / 1024, sb = b % 1024, swz = sb ^ (((sb >> 9) & 1) << 5); R = (st >> 1) * 16 + swz / 64; C = (st & 1) * 32 + (swz % 64) / 2; }
__host__ __device__ __forceinline__ int perm32(int rho) { const int n = rho >> 4, i = rho & 15; return 8 * (i >> 2) + 4 * n + (i & 3); }

struct Unit { int pm, pn; };
struct Gemm { const bf16_t* A; const bf16_t* Bt; int M, N, K; };

struct StaticOrder {
    int nM, nN, nwg, G, c;
    __host__ __device__ void init(int M, int N, int G_, int c_) { nM = M / BM; nN = N / BM; nwg = nM * nN; G = G_; c = c_; }
    __host__ __device__ bool next(int i, Unit& u) const {
        const long L = (long)i * G + c; if (L >= nwg) return false;
        int wgid = (int)L; { const int q = nwg / NXCD, r = nwg % NXCD, xcd = wgid % NXCD, off = wgid / NXCD; wgid = (xcd < r ? xcd * (q + 1) : r * (q + 1) + (xcd - r) * q) + off; }
        const int nig = WGM * nN, gid = wgid / nig, fm = gid * WGM, gsz = (nM - fm) < WGM ? (nM - fm) : WGM;
        u.pm = fm + ((wgid % nig) % gsz); u.pn = (wgid % nig) / gsz; return true;
    }
    __device__ __forceinline__ void a_ready(const Unit&) const {}
    __device__ __forceinline__ void done(const Unit&) const {}
};
__device__ __forceinline__ unsigned cvt_pk_bf16(float lo, float hi) { unsigned r; asm volatile("v_cvt_pk_bf16_f32 %0, %1, %2" : "=v"(r) : "v"(lo), "v"(hi)); return r; }
typedef float f32x2 __attribute__((ext_vector_type(2)));
__device__ __forceinline__ f32x2 gelu_pk(f32x2 v) {
    const f32x2 av = __builtin_elementwise_abs(v), d = av * 0.2316418882f + 1.0f;
    f32x2 t; t.x = __builtin_amdgcn_rcpf(d.x); t.y = __builtin_amdgcn_rcpf(d.y);
    f32x2 q = t * 0.5307027145f + (-0.7265760135f); q = q * t + 0.7107068705f; q = q * t + (-0.142248368f); q = q * t + 0.127414796f; q = q * t;
    const f32x2 s = (v * v) * (-0.72134752044f);
    f32x2 e; e.x = __builtin_amdgcn_exp2f(s.x); e.y = __builtin_amdgcn_exp2f(s.y);
    const f32x2 m = v * (q * e), r = v - m;
    f32x2 o; o.x = v.x < 0.f ? m.x : r.x; o.y = v.y < 0.f ? m.y : r.y; return o;
}
template <int ACT  > struct EpiBf16 {
    static constexpr bool PERM = true, AFTER_DRAIN = false;
    bf16_t* O; int ldc; const float* bias; int split_cols; size_t split_stride;
    __device__ __forceinline__ void operator()(const f32x4 (&acc)[2][2][4][2], const Unit& u, int wr, int wc, int fr, int fq) const {
        const int row0 = u.pm * BM + wr * 64 + fr; int colt = u.pn * BM; bf16_t* base = O;
        if (split_cols) { const int t = colt / split_cols; base += (size_t)t * split_stride; colt -= t * split_cols; }
        const int col0 = colt + wc * 32 + 8 * fq, bcol0 = u.pn * BM + wc * 32 + 8 * fq;
        f32x4 bv[2][2];
#pragma unroll
        for (int bj = 0; bj < 2; ++bj)
#pragma unroll
            for (int n = 0; n < 2; ++n) bv[bj][n] = bias ? *(const f32x4*)(bias + bcol0 + bj * HALF + 4 * n) : (f32x4){0.f, 0.f, 0.f, 0.f};
#pragma unroll
        for (int ai = 0; ai < 2; ++ai)
#pragma unroll
            for (int m = 0; m < 4; ++m) { bf16_t* rowp = base + (size_t)(row0 + ai * HALF + m * 16) * ldc + col0;
#pragma unroll
                for (int bj = 0; bj < 2; ++bj) { f32x4 v0 = acc[ai][bj][m][0] + bv[bj][0], v1 = acc[ai][bj][m][1] + bv[bj][1];
                    if (ACT == 1) { f32x2 a = gelu_pk((f32x2){v0[0], v0[1]}), b = gelu_pk((f32x2){v0[2], v0[3]}), c = gelu_pk((f32x2){v1[0], v1[1]}), d = gelu_pk((f32x2){v1[2], v1[3]});
                        v0 = (f32x4){a.x, a.y, b.x, b.y}; v1 = (f32x4){c.x, c.y, d.x, d.y}; }
                    if (ACT == 2) {
#pragma unroll
                        for (int j = 0; j < 4; ++j) { v0[j] = 0.5f * v0[j] * (1.0f + erff(v0[j] * 0.70710678f)); v1[j] = 0.5f * v1[j] * (1.0f + erff(v1[j] * 0.70710678f)); } }
                    u32x4 w; w.x = cvt_pk_bf16(v0[0], v0[1]); w.y = cvt_pk_bf16(v0[2], v0[3]); w.z = cvt_pk_bf16(v1[0], v1[1]); w.w = cvt_pk_bf16(v1[2], v1[3]);
                    *(u32x4*)(rowp + bj * HALF) = w; } }
    }
};
struct EpiAddF32 {
    static constexpr bool PERM = false, AFTER_DRAIN = false;
    float* C; int ldc;
    __device__ __forceinline__ void operator()(const f32x4 (&acc)[2][2][4][2], const Unit& u, int wr, int wc, int fr, int fq) const {
        const int row0 = u.pm * BM + wr * 64 + fr, col0 = u.pn * BM + wc * 32 + 4 * fq;
#pragma unroll
        for (int ai = 0; ai < 2; ++ai)
#pragma unroll
            for (int m = 0; m < 4; ++m) { float* rowp = C + (size_t)(row0 + ai * HALF + m * 16) * ldc + col0;
#pragma unroll
                for (int bj = 0; bj < 2; ++bj)
#pragma unroll
                    for (int n = 0; n < 2; ++n) { f32x4* q = (f32x4*)(rowp + bj * HALF + n * 16); const f32x4 o = *q; *q = o + acc[ai][bj][m][n]; } }
    }
};
struct EpiSwiGLU {
    static constexpr bool PERM = true, AFTER_DRAIN = false;
    bf16_t* H; int ldh;
    __device__ __forceinline__ void operator()(const f32x4 (&acc)[2][2][4][2], const Unit& u, int wr, int wc, int fr, int fq) const {
        typedef unsigned u32x2 __attribute__((ext_vector_type(2)));
        const int row0 = u.pm * BM + wr * 64 + fr;
#pragma unroll
        for (int ai = 0; ai < 2; ++ai)
#pragma unroll
            for (int m = 0; m < 4; ++m) { bf16_t* rowp = H + (size_t)(row0 + ai * HALF + m * 16) * ldh;
#pragma unroll
                for (int bj = 0; bj < 2; ++bj) { const int hcol = ((u.pn * BM + bj * HALF + wc * 32) >> 1) + 4 * fq;
                    const f32x4 a = acc[ai][bj][m][0], b = acc[ai][bj][m][1]; float h[4];
#pragma unroll
                    for (int j = 0; j < 4; ++j) h[j] = a[j] * __builtin_amdgcn_rcpf(1.0f + __expf(-a[j])) * b[j];
                    u32x2 w; w.x = cvt_pk_bf16(h[0], h[1]); w.y = cvt_pk_bf16(h[2], h[3]);
                    *(u32x2*)(rowp + hcol) = w; } }
    }
};
template <class Epi, class Sched, bool STAMP = false>
__device__ __forceinline__ void gemm_phase(PG8_LAS unsigned char* lds, const Gemm g, const Sched& S, const Epi& E, unsigned long long* stamps) {
    const int tid = threadIdx.x, wid = __builtin_amdgcn_readfirstlane(tid >> 6), lane = tid & 63, wr = wid >> 2, wc = wid & 3, fr = lane & 15, fq = lane >> 4;
    const int K = g.K, nt = K / BK;
    int ts_lo = 0, ts_hi = 0, nts = 0; const unsigned long long rt_entry = STAMP ? (unsigned long long)wall_clock64() : 0ull;
#define PG8_STAMP() do { if (STAMP && wid == 0 && nts < 64) { const unsigned long long _c = (unsigned long long)clock64(); \
        ts_lo = (lane == nts) ? (int)(unsigned)_c : ts_lo; ts_hi = (lane == nts) ? (int)(unsigned)(_c >> 32) : ts_hi; ++nts; } } while (0)
    PG8_STAMP();
    unsigned voffA[2], voffB[2];
#pragma unroll
    for (int i = 0; i < 2; ++i) { int R, C; stage_rc(tid * 16 + i * 8192, R, C); const int Rb = Epi::PERM ? ((R & ~31) + perm32(R & 31)) : R;
        voffA[i] = (unsigned)(R * K + C) * 2u; voffB[i] = (unsigned)(Rb * K + C) * 2u; }
    const size_t kstep = (size_t)(BK * 2);
    const size_t hstep = (size_t)HALF * K * 2;
    const size_t tstep = 2 * hstep;
    const unsigned ldsw = (unsigned)wid * 1024u;
    const int aoff = lds_byte(wr * 64 + fr, fq * 8), boff = lds_byte(wc * 32 + fr, fq * 8);
#define PG8_SA(b, h) (((b) * 2 + (h)) * HTB)
#define PG8_SB(b, h) ((4 + (b) * 2 + (h)) * HTB)
#define PG8_STAGE(bufoff, gbase, voff) do { _Pragma("unroll") for (int _i = 0; _i < 2; ++_i) \
        __builtin_amdgcn_global_load_lds((const unsigned*)((const char*)(gbase) + (voff)[_i]), (PG8_LAS unsigned*)(lds + (bufoff) + ldsw + _i * 8192), 16, 0, 0); } while (0)
#define PG8_LDA(dst, b, h) do { _Pragma("unroll") for (int m = 0; m < 4; ++m) _Pragma("unroll") for (int k = 0; k < 2; ++k) dst[m][k] = *(const PG8_LAS bf16x8*)(lds + PG8_SA(b, h) + aoff + m * 2048 + k * 1024); } while (0)
#define PG8_LDB(dst, b, h) do { _Pragma("unroll") for (int n = 0; n < 2; ++n) _Pragma("unroll") for (int k = 0; k < 2; ++k) dst[n][k] = *(const PG8_LAS bf16x8*)(lds + PG8_SB(b, h) + boff + n * 2048 + k * 1024); } while (0)
#define PG8_MMA(ai, bj, At, Bt) do { __builtin_amdgcn_s_setprio(1); _Pragma("unroll") for (int m = 0; m < 4; ++m) _Pragma("unroll") for (int n = 0; n < 2; ++n) _Pragma("unroll") for (int k = 0; k < 2; ++k) \
        acc[ai][bj][m][n] = __builtin_amdgcn_mfma_f32_16x16x32_bf16(Bt[n][k], At[m][k], acc[ai][bj][m][n], 0, 0, 0); __builtin_amdgcn_s_setprio(0); } while (0)
#define PG8_WAIT_V(n) asm volatile("s_waitcnt vmcnt(" #n ")" ::: "memory")
#define PG8_WAIT_L(n) asm volatile("s_waitcnt lgkmcnt(" #n ")" ::: "memory")
#define PG8_BAR __builtin_amdgcn_s_barrier()
#define PG8_SCHED __builtin_amdgcn_sched_barrier(0)
    Unit cur, nxt; int ui = 0;
    if (!S.next(0, cur)) return;
    f32x4 acc[2][2][4][2];
#pragma unroll
    for (int a = 0; a < 2; ++a)
#pragma unroll
        for (int b = 0; b < 2; ++b)
#pragma unroll
            for (int m = 0; m < 4; ++m)
#pragma unroll
                for (int n = 0; n < 2; ++n) acc[a][b][m][n] = (f32x4){0.f, 0.f, 0.f, 0.f};
    bf16x8 At[4][2], B0[2][2], B1[2][2];
    const char* cA = (const char*)g.A + (size_t)cur.pm * tstep; const char* cB = (const char*)g.Bt + (size_t)cur.pn * tstep;
    S.a_ready(cur);
    PG8_STAGE(PG8_SB(0, 0), cB, voffB); PG8_STAGE(PG8_SA(0, 0), cA, voffA); PG8_STAGE(PG8_SB(0, 1), cB + hstep, voffB); PG8_STAGE(PG8_SA(0, 1), cA + hstep, voffA);
    if (wr == 1) PG8_BAR;
    PG8_WAIT_V(4); PG8_BAR;
    PG8_STAGE(PG8_SB(1, 0), cB + kstep, voffB); PG8_STAGE(PG8_SA(1, 0), cA + kstep, voffA); PG8_STAGE(PG8_SB(1, 1), cB + hstep + kstep, voffB);
    PG8_WAIT_V(6); PG8_BAR;
    PG8_STAMP();
    for (;;) {
        const bool has_next = S.next(ui + 1, nxt);
        const char* nA = has_next ? (const char*)g.A + (size_t)nxt.pm * tstep : cA; const char* nB = has_next ? (const char*)g.Bt + (size_t)nxt.pn * tstep : cB;
        for (int t = 0; t < nt; t += 2) {
            const bool last = (t == nt - 2);
            const char* a1 = cA + (size_t)(t + 1) * kstep;
            const char* a2 = last ? nA : cA + (size_t)(t + 2) * kstep; const char* b2 = last ? nB : cB + (size_t)(t + 2) * kstep;
            const char* a3 = a2 + kstep; const char* b3 = b2 + kstep;
            if (last && has_next) S.a_ready(nxt);
            PG8_LDB(B0, 0, 0); PG8_SCHED; PG8_LDA(At, 0, 0); PG8_STAGE(PG8_SA(1, 1), a1 + hstep, voffA);
            PG8_WAIT_L(8); PG8_BAR; PG8_WAIT_L(0); PG8_MMA(0, 0, At, B0); PG8_BAR; PG8_SCHED;
            PG8_LDB(B1, 0, 1); PG8_STAGE(PG8_SB(0, 0), b2, voffB);
            PG8_BAR; PG8_WAIT_L(0); PG8_MMA(0, 1, At, B1); PG8_BAR;
            PG8_LDA(At, 0, 1); PG8_STAGE(PG8_SA(0, 0), a2, voffA);
            PG8_BAR; PG8_WAIT_L(0); PG8_MMA(1, 0, At, B0); PG8_BAR; PG8_SCHED;
            PG8_STAGE(PG8_SB(0, 1), b2 + hstep, voffB);
            PG8_WAIT_V(6); PG8_BAR; PG8_MMA(1, 1, At, B1); PG8_BAR;
            PG8_LDB(B0, 1, 0); PG8_SCHED; PG8_LDA(At, 1, 0); PG8_STAGE(PG8_SA(0, 1), a2 + hstep, voffA);
            PG8_WAIT_L(8); PG8_BAR; PG8_WAIT_L(0); PG8_MMA(0, 0, At, B0); PG8_BAR; PG8_SCHED;
            PG8_LDB(B1, 1, 1); PG8_STAGE(PG8_SB(1, 0), b3, voffB);
            PG8_BAR; PG8_WAIT_L(0); PG8_MMA(0, 1, At, B1); PG8_BAR;
            PG8_LDA(At, 1, 1); PG8_STAGE(PG8_SA(1, 0), a3, voffA);
            PG8_BAR; PG8_WAIT_L(0); PG8_MMA(1, 0, At, B0); PG8_BAR; PG8_SCHED;
            PG8_STAGE(PG8_SB(1, 1), b3 + hstep, voffB);
            PG8_WAIT_V(6); PG8_BAR; PG8_MMA(1, 1, At, B1); PG8_BAR;
        }
        PG8_STAMP();
        if constexpr (!Epi::AFTER_DRAIN) { E(acc, cur, wr, wc, fr, fq); S.done(cur); }
        PG8_STAMP();
        if (!has_next) break;
#pragma unroll
        for (int a = 0; a < 2; ++a)
#pragma unroll
            for (int b = 0; b < 2; ++b)
#pragma unroll
                for (int m = 0; m < 4; ++m)
#pragma unroll
                    for (int n = 0; n < 2; ++n) acc[a][b][m][n] = (f32x4){0.f, 0.f, 0.f, 0.f};
        cur = nxt; cA = nA; cB = nB; ++ui;
    }
    PG8_WAIT_V(0);
    if (wr == 0) PG8_BAR;
    PG8_BAR;
    if constexpr (Epi::AFTER_DRAIN) { E.fused(acc, cur, wr, wc, fr, fq, lds, wid, lane); S.done(cur); }
    PG8_STAMP();
    if (STAMP && wid == 0) { stamps[lane] = lane < nts ? (((unsigned long long)(unsigned)ts_hi << 32) | (unsigned)ts_lo) : 0ull;
        if (lane == 62) stamps[62] = rt_entry; if (lane == 63) stamps[63] = (unsigned long long)wall_clock64(); }
#undef PG8_STAMP
#undef PG8_SA
#undef PG8_SB
#undef PG8_STAGE
#undef PG8_LDA
#undef PG8_LDB
#undef PG8_MMA
#undef PG8_WAIT_V
#undef PG8_WAIT_L
#undef PG8_BAR
#undef PG8_SCHED
}
}
#define LAS __attribute__((address_space(3)))
typedef LAS unsigned char* LDSp;
typedef pg8::bf16_t bf16_t;
typedef unsigned u32x4 __attribute__((ext_vector_type(4)));
typedef unsigned u32x2 __attribute__((ext_vector_type(2)));
typedef float f32x4 __attribute__((ext_vector_type(4)));
typedef float f32x2 __attribute__((ext_vector_type(2)));

#ifndef EXPC
#define EXPC 0
#endif
#ifndef EVP_SKIP
#define EVP_SKIP 0
#endif
constexpr int T_ = 16384, D_ = 1024, S_ = 4096, NTHR = 512;
constexpr int LDS_BYTES = 147456;
constexpr size_t MiB = 1048576;
constexpr size_t WS_WB = 0, WS_HN = 25 * MiB, WS_Z = 57 * MiB, WS_QKV = 153 * MiB, WS_OF = 201 * MiB, WS_OB = 217 * MiB,
                 WS_GATES = 233 * MiB, WS_BETA = 234 * MiB, WS_LA = 234 * MiB + 524288;
constexpr size_t WB_IN = 0, WB_OUT = 6291456, WB_UP = 8388608, WB_DN = 19922944;
constexpr int DFF = 2816;

struct Params { const float* in[26]; float* out; unsigned char* ws; };

__device__ __forceinline__ float bf2f(unsigned short b) { return __uint_as_float(((unsigned)b) << 16); }
__device__ __forceinline__ float bflo(unsigned u) { return __uint_as_float(u << 16); }
__device__ __forceinline__ float bfhi(unsigned u) { return __uint_as_float(u & 0xffff0000u); }
__device__ __forceinline__ unsigned short f2bf(float f) { unsigned u = __float_as_uint(f); u += 0x7FFFu + ((u >> 16) & 1u); return (unsigned short)(u >> 16); }
typedef __bf16 bf16x2_v __attribute__((ext_vector_type(2)));
__device__ __forceinline__ unsigned pk2(float lo, float hi) { const f32x2 v = {lo, hi}; const bf16x2_v b = __builtin_convertvector(v, bf16x2_v); return __builtin_bit_cast(unsigned, b); }
__device__ __forceinline__ float sigm(float x) { return 1.0f / (1.0f + __expf(-x)); }
__device__ __forceinline__ float sigm_f(float x) { return __builtin_amdgcn_rcpf(1.0f + __expf(-x)); }
__device__ __forceinline__ float silu_(float x) { return x * sigm(x); }
__device__ __forceinline__ float gelu_t(float x) { const float u = 0.7978845608028654f * (x + 0.044715f * x * x * x); const float t = 1.0f - 2.0f / (1.0f + __expf(2.0f * u)); return 0.5f * x * (1.0f + t); }
__device__ __forceinline__ float softplus_(float x) { return x > 20.0f ? x : log1pf(expf(x)); }
__device__ __forceinline__ float wave_sum(float v) {
#pragma unroll
    for (int o = 32; o; o >>= 1) v += __shfl_xor(v, o);
    return v; }
template <int CTRL> __device__ __forceinline__ float dppf(float v) { return __int_as_float(__builtin_amdgcn_update_dpp(0, __float_as_int(v), CTRL, 0xf, 0xf, true)); }
__device__ __forceinline__ float row16_sum(float v) { v += dppf<0xB1>(v); v += dppf<0x4E>(v); v += dppf<0x141>(v); v += dppf<0x140>(v); return v; }
__device__ __forceinline__ void unpack8(const u32x4 w, float (&f)[8]) { f[0] = bflo(w.x); f[1] = bfhi(w.x); f[2] = bflo(w.y); f[3] = bfhi(w.y); f[4] = bflo(w.z); f[5] = bfhi(w.z); f[6] = bflo(w.w); f[7] = bfhi(w.w); }

__device__ __forceinline__ void conv_job(LDSp lds, const float* __restrict__ src, int ldn, int K, int col0, int ncols, bf16_t* __restrict__ dst, int mode, int off) {
    LAS float* tl = (LAS float*)lds;
    const int tid = threadIdx.x, nnt = ncols >> 6, ntl = (K >> 6) * nnt;
    for (int tile = blockIdx.x; tile < ntl; tile += gridDim.x) {
        const int kt = tile / nnt, nt = tile - kt * nnt;
        const int r = tid >> 4, c4 = (tid & 15) << 2;
#pragma unroll
        for (int i = 0; i < 2; ++i) { const int k = r + 32 * i; const f32x4 v = *(const f32x4*)(src + (size_t)(kt * 64 + k) * ldn + col0 + nt * 64 + c4);
            tl[k * 65 + c4 + 0] = v.x; tl[k * 65 + c4 + 1] = v.y; tl[k * 65 + c4 + 2] = v.z; tl[k * 65 + c4 + 3] = v.w; }
        __syncthreads();
        const int n = tid >> 3, k8 = (tid & 7) << 3; float f[8];
#pragma unroll
        for (int j = 0; j < 8; ++j) f[j] = tl[(k8 + j) * 65 + n];
        u32x4 w; w.x = pk2(f[0], f[1]); w.y = pk2(f[2], f[3]); w.z = pk2(f[4], f[5]); w.w = pk2(f[6], f[7]);
        const int ncol = nt * 64 + n;
        const int row = mode == 0 ? off + ncol : ((ncol >> 4) << 5) + (((ncol >> 2) & 3) << 3) + (ncol & 3) + off;
        *(u32x4*)(dst + (size_t)row * K + kt * 64 + k8) = w;
        __syncthreads();
    }
}
__device__ __forceinline__ void convert_layer(LDSp lds, const Params& p, int L) {
    bf16_t* wb = (bf16_t*)(p.ws + WS_WB);
    if (L == 0) { conv_job(lds, p.in[2], 3088, 1024, 0, 3072, (bf16_t*)((char*)wb + WB_IN), 0, 0);
                  conv_job(lds, p.in[11], 1024, 1024, 0, 1024, (bf16_t*)((char*)wb + WB_OUT), 0, 0); }
    else        { conv_job(lds, p.in[12], 2576, 1024, 0, 2560, (bf16_t*)((char*)wb + WB_IN), 0, 0);
                  conv_job(lds, p.in[20], 1024, 1024, 0, 1024, (bf16_t*)((char*)wb + WB_OUT), 0, 0); }
    conv_job(lds, p.in[22] + (size_t)L * 1024 * DFF, DFF, 1024, 0, DFF, (bf16_t*)((char*)wb + WB_UP), 1, 0);
    conv_job(lds, p.in[23] + (size_t)L * 1024 * DFF, DFF, 1024, 0, DFF, (bf16_t*)((char*)wb + WB_UP), 1, 4);
    conv_job(lds, p.in[24] + (size_t)L * DFF * 1024, 1024, DFF, 0, 1024, (bf16_t*)((char*)wb + WB_DN), 0, 0);
}

__device__ __forceinline__ void rms_phase(LDSp lds, const float* src, const float* __restrict__ g, bf16_t* hn, float* copy_out, float* final_out,
                                          const float* __restrict__ gw, int gw_ld, int gw_col0, float* gates) {
    LAS float* wg = (LAS float*)lds;
    const int tid = threadIdx.x, lane = tid & 63, wid = tid >> 6;
    if (gw) { for (int idx = tid; idx < 16384; idx += NTHR) { const int k = idx >> 4, j = idx & 15; wg[j * 1024 + k] = gw[(size_t)k * gw_ld + gw_col0 + j]; } __syncthreads(); }
    f32x4 gv[4];
#pragma unroll
    for (int i = 0; i < 4; ++i) gv[i] = *(const f32x4*)(g + 4 * lane + 256 * i);
    for (int row = blockIdx.x * 8 + wid; row < T_; row += gridDim.x * 8) {
        const float* xr = src + (size_t)row * D_;
        f32x4 x[4]; float ss = 0.f;
#pragma unroll
        for (int i = 0; i < 4; ++i) { x[i] = *(const f32x4*)(xr + 4 * lane + 256 * i); ss += x[i].x * x[i].x + x[i].y * x[i].y + x[i].z * x[i].z + x[i].w * x[i].w; }
        if (copy_out) {
#pragma unroll
            for (int i = 0; i < 4; ++i) *(f32x4*)(copy_out + (size_t)row * D_ + 4 * lane + 256 * i) = x[i]; }
        ss = wave_sum(ss);
        const float rstd = rsqrtf(ss * (1.0f / 1024.0f) + 1e-6f);
        f32x4 y[4];
#pragma unroll
        for (int i = 0; i < 4; ++i) y[i] = x[i] * rstd * gv[i];
        if (final_out) {
#pragma unroll
            for (int i = 0; i < 4; ++i) *(f32x4*)(final_out + (size_t)row * D_ + 4 * lane + 256 * i) = y[i];
        } else {
#pragma unroll
            for (int i = 0; i < 4; ++i) { u32x2 w; w.x = pk2(y[i].x, y[i].y); w.y = pk2(y[i].z, y[i].w); *(u32x2*)(hn + (size_t)row * D_ + 4 * lane + 256 * i) = w; }
        }
        if (gw) {
            float s[16];
#pragma unroll
            for (int j = 0; j < 16; ++j) { float a = 0.f;
#pragma unroll
                for (int i = 0; i < 4; ++i) { const f32x4 w = *(const LAS f32x4*)(wg + j * 1024 + 4 * lane + 256 * i); a += y[i].x * w.x + y[i].y * w.y + y[i].z * w.z + y[i].w * w.w; }
                s[j] = wave_sum(a); }
            if (lane == 0) {
#pragma unroll
                for (int q = 0; q < 4; ++q) *(f32x4*)(gates + (size_t)row * 16 + 4 * q) = (f32x4){s[4 * q], s[4 * q + 1], s[4 * q + 2], s[4 * q + 3]}; }
        }
    }
    __syncthreads();
}

__device__ __forceinline__ void even_prep(LDSp lds, const Params& p) {
    const bf16_t* Z = (const bf16_t*)(p.ws + WS_Z); bf16_t* Y = (bf16_t*)(p.ws + WS_HN); bf16_t* QKVN = (bf16_t*)(p.ws + WS_QKV);
    const float* gates = (const float*)(p.ws + WS_GATES); float* BETA = (float*)(p.ws + WS_BETA); float* LA = (float*)(p.ws + WS_LA);
    const float* conv_w = p.in[3]; const float* conv_b = p.in[4]; const float* ln_g = p.in[5]; const float* ln_b = p.in[6];
    const float* dn_w = p.in[7]; const float* a_log = p.in[8]; const float* dt_bias = p.in[9];
    LAS float* glu = (LAS float*)lds;
    const int tid = threadIdx.x, lane = tid & 63, wid = tid >> 6, c = tid;
    for (int tile = blockIdx.x; tile < T_ / 32; tile += gridDim.x) {
        const int t0 = tile * 32, b = t0 >> 12, s0 = t0 & 4095;
#if !(EVP_SKIP & 1)
        for (int it = tid; it < 62 * 64; it += NTHR) { const int r = it >> 6, c8 = (it & 63) << 3, sp = s0 - 15 + r;
            f32x4 o0 = {0.f, 0.f, 0.f, 0.f}, o1 = {0.f, 0.f, 0.f, 0.f};
            if (sp >= 0 && sp < S_) { const size_t tok = (size_t)b * S_ + sp; const u32x4 av = *(const u32x4*)(Z + tok * 3072 + c8); const u32x4 gv = *(const u32x4*)(Z + tok * 3072 + 512 + c8);
                float a[8], g[8]; unpack8(av, a); unpack8(gv, g);
                o0 = (f32x4){a[0] * sigm(g[0]), a[1] * sigm(g[1]), a[2] * sigm(g[2]), a[3] * sigm(g[3])}; o1 = (f32x4){a[4] * sigm(g[4]), a[5] * sigm(g[5]), a[6] * sigm(g[6]), a[7] * sigm(g[7])}; }
            *(LAS f32x4*)(glu + r * 512 + c8) = o0; *(LAS f32x4*)(glu + r * 512 + c8 + 4) = o1; }
        __syncthreads();
        {
            float cw[31];
#pragma unroll
            for (int w = 0; w < 31; ++w) cw[w] = conv_w[w * 512 + c];
            const float cb = conv_b[c];
            f32x4 res[8];
#pragma unroll
            for (int t4 = 0; t4 < 8; ++t4) {
                float x[34];
#pragma unroll
                for (int i = 0; i < 34; ++i) x[i] = glu[(t4 * 4 + i) * 512 + c];
                float a0 = cb, a1 = cb, a2 = cb, a3 = cb;
#pragma unroll
                for (int w = 0; w < 31; ++w) { a0 = fmaf(x[w], cw[w], a0); a1 = fmaf(x[w + 1], cw[w], a1); a2 = fmaf(x[w + 2], cw[w], a2); a3 = fmaf(x[w + 3], cw[w], a3); }
                res[t4] = (f32x4){a0, a1, a2, a3};
            }
            __syncthreads();
#pragma unroll
            for (int t4 = 0; t4 < 8; ++t4) { glu[(t4 * 4 + 0) * 512 + c] = res[t4].x; glu[(t4 * 4 + 1) * 512 + c] = res[t4].y; glu[(t4 * 4 + 2) * 512 + c] = res[t4].z; glu[(t4 * 4 + 3) * 512 + c] = res[t4].w; }
        }
        __syncthreads();
        {
            const f32x4 g0 = *(const f32x4*)(ln_g + 4 * lane), g1 = *(const f32x4*)(ln_g + 256 + 4 * lane), b0 = *(const f32x4*)(ln_b + 4 * lane), b1 = *(const f32x4*)(ln_b + 256 + 4 * lane);
#pragma unroll
            for (int tt = 0; tt < 4; ++tt) { const int t = wid * 4 + tt;
                const f32x4 x0 = *(const LAS f32x4*)(glu + t * 512 + 4 * lane), x1 = *(const LAS f32x4*)(glu + t * 512 + 256 + 4 * lane);
                const float mean = wave_sum((x0.x + x0.y) + (x0.z + x0.w) + (x1.x + x1.y) + (x1.z + x1.w)) * (1.0f / 512.0f);
                const f32x4 d0 = x0 - mean, d1 = x1 - mean;
                const float var = wave_sum(d0.x * d0.x + d0.y * d0.y + d0.z * d0.z + d0.w * d0.w + d1.x * d1.x + d1.y * d1.y + d1.z * d1.z + d1.w * d1.w) * (1.0f / 512.0f);
                const float rstd = rsqrtf(var + 1e-5f);
                const f32x4 y0 = d0 * rstd * g0 + b0, y1 = d1 * rstd * g1 + b1;
                u32x2 w0, w1; w0.x = pk2(silu_(y0.x), silu_(y0.y)); w0.y = pk2(silu_(y0.z), silu_(y0.w)); w1.x = pk2(silu_(y1.x), silu_(y1.y)); w1.y = pk2(silu_(y1.z), silu_(y1.w));
                *(u32x2*)(Y + (size_t)(t0 + t) * 1024 + 4 * lane) = w0; *(u32x2*)(Y + (size_t)(t0 + t) * 1024 + 256 + 4 * lane) = w1; }
        }
        __syncthreads();
#endif
#if !(EVP_SKIP & 2)
#pragma unroll 1
        for (int gi = 0; gi < 3; ++gi) {
            const int col = 1024 + gi * 512 + c;
            float w5[5];
#pragma unroll
            for (int w = 0; w < 5; ++w) w5[w] = dn_w[w * 1536 + gi * 512 + c];
            const bf16_t* zc = Z + (size_t)b * S_ * 3072 + col;
#define ZLD(sp) (((sp) >= 0 && (sp) < S_) ? bf2f(zc[(size_t)(sp) * 3072]) : 0.f)
            float x0 = ZLD(s0 - 2), x1 = ZLD(s0 - 1), x2 = ZLD(s0), x3 = ZLD(s0 + 1);
#pragma unroll 16
            for (int t = 0; t < 32; ++t) { const float x4 = ZLD(s0 + t + 2);
                float v = x0 * w5[0]; v = fmaf(x1, w5[1], v); v = fmaf(x2, w5[2], v); v = fmaf(x3, w5[3], v); v = fmaf(x4, w5[4], v);
                v = silu_(v);
                if (gi == 2) QKVN[(size_t)(t0 + t) * 1536 + 1024 + c] = f2bf(v); else glu[t * 512 + c] = v;
                x0 = x1; x1 = x2; x2 = x3; x3 = x4; }
#undef ZLD
            if (gi < 2) {
                __syncthreads();
                const float qs = gi == 0 ? 0.08838834764831845f : 1.0f;
#pragma unroll 4
                for (int pp = 0; pp < 16; ++pp) { const int pr = wid * 16 + pp, t = pr >> 2, hd = pr & 3;
                    const f32x2 x = *(const LAS f32x2*)(glu + t * 512 + hd * 128 + 2 * lane);
                    const float ss = wave_sum(x.x * x.x + x.y * x.y); const float sc = rsqrtf(ss + 1e-6f) * qs;
                    *(unsigned*)(QKVN + (size_t)(t0 + t) * 1536 + gi * 512 + hd * 128 + 2 * lane) = pk2(x.x * sc, x.y * sc); }
                __syncthreads();
            }
        }
#endif
#if !(EVP_SKIP & 4)
        if (tid < 256) { const int t = tid >> 3, j = tid & 7; const size_t tok = (size_t)(t0 + t);
            const float bp = gates[tok * 16 + j], ap = gates[tok * 16 + 8 + j];
            BETA[tok * 8 + j] = sigm(bp); LA[tok * 8 + j] = -expf(a_log[j]) * softplus_(ap + dt_bias[j]); }
#endif
        __syncthreads();
    }
}

__device__ __forceinline__ void delta_scan(LDSp lds, const Params& p) {
    const bf16_t* QKVN = (const bf16_t*)(p.ws + WS_QKV); const float* BETA = (const float*)(p.ws + WS_BETA); const float* LA = (const float*)(p.ws + WS_LA);
    const int tid = threadIdx.x, jl = tid >> 4, sub = tid & 15;
    constexpr int BUF = 37376;
    LAS float* ost = (LAS float*)(lds + 2 * BUF);
    for (int unit = blockIdx.x; unit < 128; unit += gridDim.x) {
        const int dir = unit >> 6, b = (unit >> 4) & 3, h = (unit >> 2) & 3, sl = unit & 3;
        bf16_t* O = (bf16_t*)(p.ws + (dir ? WS_OB : WS_OF));
        float S[8];
#pragma unroll
        for (int i = 0; i < 8; ++i) S[i] = 0.f;
        u32x4 rq[4]; u32x4 rv = {0u, 0u, 0u, 0u}; float ra = 0.f, rb = 0.f;
#define DS_TOK(n, s) ((size_t)b * S_ + (dir ? (S_ - 1 - ((n) * 64 + (s))) : ((n) * 64 + (s))))
#define DS_LOAD(n) do { _Pragma("unroll") for (int i = 0; i < 4; ++i) { const int pi = tid + NTHR * i, s = pi >> 5, w16 = pi & 31; \
            rq[i] = *(const u32x4*)(QKVN + DS_TOK(n, s) * 1536 + (w16 >> 4) * 512 + h * 128 + (w16 & 15) * 8); } \
        if (tid < 256) { const int s = tid >> 2, c8 = tid & 3; rv = *(const u32x4*)(QKVN + DS_TOK(n, s) * 1536 + 1024 + h * 128 + sl * 32 + c8 * 8); } \
        if (tid < 64) { const size_t tk = DS_TOK(n, tid); ra = expf(LA[tk * 8 + dir * 4 + h]); rb = BETA[tk * 8 + dir * 4 + h]; } } while (0)
#define DS_STORE(bufp) do { _Pragma("unroll") for (int i = 0; i < 4; ++i) { const int pi = tid + NTHR * i; *(LAS u32x4*)((bufp) + pi * 16) = rq[i]; } \
        if (tid < 256) *(LAS u32x4*)((bufp) + 32768 + tid * 16) = rv; \
        if (tid < 64) { *(LAS float*)((bufp) + 36864 + tid * 8) = ra; *(LAS float*)((bufp) + 36864 + tid * 8 + 4) = rb; } } while (0)
        DS_LOAD(0); DS_STORE(lds); __syncthreads();
#pragma unroll 1
        for (int n = 0; n < 64; ++n) {
            LDSp cb = lds + (n & 1) * BUF; LDSp nb = lds + ((n + 1) & 1) * BUF; LAS float* os = ost + (n & 1) * 2048;
            if (n < 63) DS_LOAD(n + 1);
#pragma unroll 4
            for (int s = 0; s < 64; ++s) {
                const u32x4 qq = *(const LAS u32x4*)(cb + s * 512 + sub * 16), kk = *(const LAS u32x4*)(cb + s * 512 + 256 + sub * 16);
                const float vj = bf2f(*(const LAS unsigned short*)(cb + 32768 + s * 64 + jl * 2));
                const float al = *(const LAS float*)(cb + 36864 + s * 8), be = *(const LAS float*)(cb + 36864 + s * 8 + 4);
                float kf[8], qf[8]; unpack8(kk, kf); unpack8(qq, qf);
                float ks = 0.f;
#pragma unroll
                for (int i = 0; i < 8; ++i) ks = fmaf(kf[i], S[i], ks);
                ks = row16_sum(ks);
                const float cc = be * (vj - al * ks);
                float o = 0.f;
#pragma unroll
                for (int i = 0; i < 8; ++i) { S[i] = fmaf(kf[i], cc, al * S[i]); o = fmaf(qf[i], S[i], o); }
                o = row16_sum(o);
                if (sub == 0) os[s * 32 + jl] = o;
            }
            if (n < 63) DS_STORE(nb);
            __syncthreads();
            { const int s = tid >> 3, j4 = (tid & 7) << 2; const f32x4 o4 = *(const LAS f32x4*)(os + s * 32 + j4);
              u32x2 w; w.x = pk2(o4.x, o4.y); w.y = pk2(o4.z, o4.w);
              *(u32x2*)(O + DS_TOK(n, s) * 512 + h * 128 + sl * 32 + j4) = w; }
        }
        __syncthreads();
#undef DS_LOAD
#undef DS_STORE
#undef DS_TOK
    }
}

__device__ __forceinline__ void tri_solve64(const LAS float* Am, const LAS unsigned short* col, const LAS float* sc, bf16_t* outp, long rstride) {
    f32x4 a; float s0, s1, s2, s3;
    float x0 = sc[0] * bf2f(col[0]);
    outp[0 * rstride] = f2bf(x0);
    float x1 = sc[1] * bf2f(col[136]);
    s0 = 0.f; s1 = 0.f; s2 = 0.f; s3 = 0.f;
    a = *(const LAS f32x4*)(Am + 68);
    const float al1 = a.x;
    x1 = (x1 - ((s0 + s1) + (s2 + s3))) - al1 * x0;
    outp[1 * rstride] = f2bf(x1);
    float x2 = sc[2] * bf2f(col[272]);
    s0 = 0.f; s1 = 0.f; s2 = 0.f; s3 = 0.f;
    a = *(const LAS f32x4*)(Am + 136);
    s0 = fmaf(a.x, x0, s0);
    const float al2 = a.y;
    x2 = (x2 - ((s0 + s1) + (s2 + s3))) - al2 * x1;
    outp[2 * rstride] = f2bf(x2);
    float x3 = sc[3] * bf2f(col[408]);
    s0 = 0.f; s1 = 0.f; s2 = 0.f; s3 = 0.f;
    a = *(const LAS f32x4*)(Am + 204);
    s0 = fmaf(a.x, x0, s0);
    s1 = fmaf(a.y, x1, s1);
    const float al3 = a.z;
    x3 = (x3 - ((s0 + s1) + (s2 + s3))) - al3 * x2;
    outp[3 * rstride] = f2bf(x3);
    float x4 = sc[4] * bf2f(col[544]);
    s0 = 0.f; s1 = 0.f; s2 = 0.f; s3 = 0.f;
    a = *(const LAS f32x4*)(Am + 272);
    s0 = fmaf(a.x, x0, s0);
    s1 = fmaf(a.y, x1, s1);
    s2 = fmaf(a.z, x2, s2);
    const float al4 = a.w;
    x4 = (x4 - ((s0 + s1) + (s2 + s3))) - al4 * x3;
    outp[4 * rstride] = f2bf(x4);
    float x5 = sc[5] * bf2f(col[680]);
    s0 = 0.f; s1 = 0.f; s2 = 0.f; s3 = 0.f;
    a = *(const LAS f32x4*)(Am + 340);
    s0 = fmaf(a.x, x0, s0);
    s1 = fmaf(a.y, x1, s1);
    s2 = fmaf(a.z, x2, s2);
    s3 = fmaf(a.w, x3, s3);
    a = *(const LAS f32x4*)(Am + 344);
    const float al5 = a.x;
    x5 = (x5 - ((s0 + s1) + (s2 + s3))) - al5 * x4;
    outp[5 * rstride] = f2bf(x5);
    float x6 = sc[6] * bf2f(col[816]);
    s0 = 0.f; s1 = 0.f; s2 = 0.f; s3 = 0.f;
    a = *(const LAS f32x4*)(Am + 408);
    s0 = fmaf(a.x, x0, s0);
    s1 = fmaf(a.y, x1, s1);
    s2 = fmaf(a.z, x2, s2);
    s3 = fmaf(a.w, x3, s3);
    a = *(const LAS f32x4*)(Am + 412);
    s0 = fmaf(a.x, x4, s0);
    const float al6 = a.y;
    x6 = (x6 - ((s0 + s1) + (s2 + s3))) - al6 * x5;
    outp[6 * rstride] = f2bf(x6);
    float x7 = sc[7] * bf2f(col[952]);
    s0 = 0.f; s1 = 0.f; s2 = 0.f; s3 = 0.f;
    a = *(const LAS f32x4*)(Am + 476);
    s0 = fmaf(a.x, x0, s0);
    s1 = fmaf(a.y, x1, s1);
    s2 = fmaf(a.z, x2, s2);
    s3 = fmaf(a.w, x3, s3);
    a = *(const LAS f32x4*)(Am + 480);
    s0 = fmaf(a.x, x4, s0);
    s1 = fmaf(a.y, x5, s1);
    const float al7 = a.z;
    x7 = (x7 - ((s0 + s1) + (s2 + s3))) - al7 * x6;
    outp[7 * rstride] = f2bf(x7);
    float x8 = sc[8] * bf2f(col[1088]);
    s0 = 0.f; s1 = 0.f; s2 = 0.f; s3 = 0.f;
    a = *(const LAS f32x4*)(Am + 544);
    s0 = fmaf(a.x, x0, s0);
    s1 = fmaf(a.y, x1, s1);
    s2 = fmaf(a.z, x2, s2);
    s3 = fmaf(a.w, x3, s3);
    a = *(const LAS f32x4*)(Am + 548);
    s0 = fmaf(a.x, x4, s0);
    s1 = fmaf(a.y, x5, s1);
    s2 = fmaf(a.z, x6, s2);
    const float al8 = a.w;
    x8 = (x8 - ((s0 + s1) + (s2 + s3))) - al8 * x7;
    outp[8 * rstride] = f2bf(x8);
    float x9 = sc[9] * bf2f(col[1224]);
    s0 = 0.f; s1 = 0.f; s2 = 0.f; s3 = 0.f;
    a = *(const LAS f32x4*)(Am + 612);
    s0 = fmaf(a.x, x0, s0);
    s1 = fmaf(a.y, x1, s1);
    s2 = fmaf(a.z, x2, s2);
    s3 = fmaf(a.w, x3, s3);
    a = *(const LAS f32x4*)(Am + 616);
    s0 = fmaf(a.x, x4, s0);
    s1 = fmaf(a.y, x5, s1);
    s2 = fmaf(a.z, x6, s2);
    s3 = fmaf(a.w, x7, s3);
    a = *(const LAS f32x4*)(Am + 620);
    const float al9 = a.x;
    x9 = (x9 - ((s0 + s1) + (s2 + s3))) - al9 * x8;
    outp[9 * rstride] = f2bf(x9);
    float x10 = sc[10] * bf2f(col[1360]);
    s0 = 0.f; s1 = 0.f; s2 = 0.f; s3 = 0.f;
    a = *(const LAS f32x4*)(Am + 680);
    s0 = fmaf(a.x, x0, s0);
    s1 = fmaf(a.y, x1, s1);
    s2 = fmaf(a.z, x2, s2);
    s3 = fmaf(a.w, x3, s3);
    a = *(const LAS f32x4*)(Am + 684);
    s0 = fmaf(a.x, x4, s0);
    s1 = fmaf(a.y, x5, s1);
    s2 = fmaf(a.z, x6, s2);
    s3 = fmaf(a.w, x7, s3);
    a = *(const LAS f32x4*)(Am + 688);
    s0 = fmaf(a.x, x8, s0);
    const float al10 = a.y;
    x10 = (x10 - ((s0 + s1) + (s2 + s3))) - al10 * x9;
    outp[10 * rstride] = f2bf(x10);
    float x11 = sc[11] * bf2f(col[1496]);
    s0 = 0.f; s1 = 0.f; s2 = 0.f; s3 = 0.f;
    a = *(const LAS f32x4*)(Am + 748);
    s0 = fmaf(a.x, x0, s0);
    s1 = fmaf(a.y, x1, s1);
    s2 = fmaf(a.z, x2, s2);
    s3 = fmaf(a.w, x3, s3);
    a = *(const LAS f32x4*)(Am + 752);
    s0 = fmaf(a.x, x4, s0);
    s1 = fmaf(a.y, x5, s1);
    s2 = fmaf(a.z, x6, s2);
    s3 = fmaf(a.w, x7, s3);
    a = *(const LAS f32x4*)(Am + 756);
    s0 = fmaf(a.x, x8, s0);
    s1 = fmaf(a.y, x9, s1);
    const float al11 = a.z;
    x11 = (x11 - ((s0 + s1) + (s2 + s3))) - al11 * x10;
    outp[11 * rstride] = f2bf(x11);
    float x12 = sc[12] * bf2f(col[1632]);
    s0 = 0.f; s1 = 0.f; s2 = 0.f; s3 = 0.f;
    a = *(const LAS f32x4*)(Am + 816);
    s0 = fmaf(a.x, x0, s0);
    s1 = fmaf(a.y, x1, s1);
    s2 = fmaf(a.z, x2, s2);
    s3 = fmaf(a.w, x3, s3);
    a = *(const LAS f32x4*)(Am + 820);
    s0 = fmaf(a.x, x4, s0);
    s1 = fmaf(a.y, x5, s1);
    s2 = fmaf(a.z, x6, s2);
    s3 = fmaf(a.w, x7, s3);
    a = *(const LAS f32x4*)(Am + 824);
    s0 = fmaf(a.x, x8, s0);
    s1 = fmaf(a.y, x9, s1);
    s2 = fmaf(a.z, x10, s2);
    const float al12 = a.w;
    x12 = (x12 - ((s0 + s1) + (s2 + s3))) - al12 * x11;
    outp[12 * rstride] = f2bf(x12);
    float x13 = sc[13] * bf2f(col[1768]);
    s0 = 0.f; s1 = 0.f; s2 = 0.f; s3 = 0.f;
    a = *(const LAS f32x4*)(Am + 884);
    s0 = fmaf(a.x, x0, s0);
    s1 = fmaf(a.y, x1, s1);
    s2 = fmaf(a.z, x2, s2);
    s3 = fmaf(a.w, x3, s3);
    a = *(const LAS f32x4*)(Am + 888);
    s0 = fmaf(a.x, x4, s0);
    s1 = fmaf(a.y, x5, s1);
    s2 = fmaf(a.z, x6, s2);
    s3 = fmaf(a.w, x7, s3);
    a = *(const LAS f32x4*)(Am + 892);
    s0 = fmaf(a.x, x8, s0);
    s1 = fmaf(a.y, x9, s1);
    s2 = fmaf(a.z, x10, s2);
    s3 = fmaf(a.w, x11, s3);
    a = *(const LAS f32x4*)(Am + 896);
    const float al13 = a.x;
    x13 = (x13 - ((s0 + s1) + (s2 + s3))) - al13 * x12;
    outp[13 * rstride] = f2bf(x13);
    float x14 = sc[14] * bf2f(col[1904]);
    s0 = 0.f; s1 = 0.f; s2 = 0.f; s3 = 0.f;
    a = *(const LAS f32x4*)(Am + 952);
    s0 = fmaf(a.x, x0, s0);
    s1 = fmaf(a.y, x1, s1);
    s2 = fmaf(a.z, x2, s2);
    s3 = fmaf(a.w, x3, s3);
    a = *(const LAS f32x4*)(Am + 956);
    s0 = fmaf(a.x, x4, s0);
    s1 = fmaf(a.y, x5, s1);
    s2 = fmaf(a.z, x6, s2);
    s3 = fmaf(a.w, x7, s3);
    a = *(const LAS f32x4*)(Am + 960);
    s0 = fmaf(a.x, x8, s0);
    s1 = fmaf(a.y, x9, s1);
    s2 = fmaf(a.z, x10, s2);
    s3 = fmaf(a.w, x11, s3);
    a = *(const LAS f32x4*)(Am + 964);
    s0 = fmaf(a.x, x12, s0);
    const float al14 = a.y;
    x14 = (x14 - ((s0 + s1) + (s2 + s3))) - al14 * x13;
    outp[14 * rstride] = f2bf(x14);
    float x15 = sc[15] * bf2f(col[2040]);
    s0 = 0.f; s1 = 0.f; s2 = 0.f; s3 = 0.f;
    a = *(const LAS f32x4*)(Am + 1020);
    s0 = fmaf(a.x, x0, s0);
    s1 = fmaf(a.y, x1, s1);
    s2 = fmaf(a.z, x2, s2);
    s3 = fmaf(a.w, x3, s3);
    a = *(const LAS f32x4*)(Am + 1024);
    s0 = fmaf(a.x, x4, s0);
    s1 = fmaf(a.y, x5, s1);
    s2 = fmaf(a.z, x6, s2);
    s3 = fmaf(a.w, x7, s3);
    a = *(const LAS f32x4*)(Am + 1028);
    s0 = fmaf(a.x, x8, s0);
    s1 = fmaf(a.y, x9, s1);
    s2 = fmaf(a.z, x10, s2);
    s3 = fmaf(a.w, x11, s3);
    a = *(const LAS f32x4*)(Am + 1032);
    s0 = fmaf(a.x, x12, s0);
    s1 = fmaf(a.y, x13, s1);
    const float al15 = a.z;
    x15 = (x15 - ((s0 + s1) + (s2 + s3))) - al15 * x14;
    outp[15 * rstride] = f2bf(x15);
    float x16 = sc[16] * bf2f(col[2176]);
    s0 = 0.f; s1 = 0.f; s2 = 0.f; s3 = 0.f;
    a = *(const LAS f32x4*)(Am + 1088);
    s0 = fmaf(a.x, x0, s0);
    s1 = fmaf(a.y, x1, s1);
    s2 = fmaf(a.z, x2, s2);
    s3 = fmaf(a.w, x3, s3);
    a = *(const LAS f32x4*)(Am + 1092);
    s0 = fmaf(a.x, x4, s0);
    s1 = fmaf(a.y, x5, s1);
    s2 = fmaf(a.z, x6, s2);
    s3 = fmaf(a.w, x7, s3);
    a = *(const LAS f32x4*)(Am + 1096);
    s0 = fmaf(a.x, x8, s0);
    s1 = fmaf(a.y, x9, s1);
    s2 = fmaf(a.z, x10, s2);
    s3 = fmaf(a.w, x11, s3);
    a = *(const LAS f32x4*)(Am + 1100);
    s0 = fmaf(a.x, x12, s0);
    s1 = fmaf(a.y, x13, s1);
    s2 = fmaf(a.z, x14, s2);
    const float al16 = a.w;
    x16 = (x16 - ((s0 + s1) + (s2 + s3))) - al16 * x15;
    outp[16 * rstride] = f2bf(x16);
    float x17 = sc[17] * bf2f(col[2312]);
    s0 = 0.f; s1 = 0.f; s2 = 0.f; s3 = 0.f;
    a = *(const LAS f32x4*)(Am + 1156);
    s0 = fmaf(a.x, x0, s0);
    s1 = fmaf(a.y, x1, s1);
    s2 = fmaf(a.z, x2, s2);
    s3 = fmaf(a.w, x3, s3);
    a = *(const LAS f32x4*)(Am + 1160);
    s0 = fmaf(a.x, x4, s0);
    s1 = fmaf(a.y, x5, s1);
    s2 = fmaf(a.z, x6, s2);
    s3 = fmaf(a.w, x7, s3);
    a = *(const LAS f32x4*)(Am + 1164);
    s0 = fmaf(a.x, x8, s0);
    s1 = fmaf(a.y, x9, s1);
    s2 = fmaf(a.z, x10, s2);
    s3 = fmaf(a.w, x11, s3);
    a = *(const LAS f32x4*)(Am + 1168);
    s0 = fmaf(a.x, x12, s0);
    s1 = fmaf(a.y, x13, s1);
    s2 = fmaf(a.z, x14, s2);
    s3 = fmaf(a.w, x15, s3);
    a = *(const LAS f32x4*)(Am + 1172);
    const float al17 = a.x;
    x17 = (x17 - ((s0 + s1) + (s2 + s3))) - al17 * x16;
    outp[17 * rstride] = f2bf(x17);
    float x18 = sc[18] * bf2f(col[2448]);
    s0 = 0.f; s1 = 0.f; s2 = 0.f; s3 = 0.f;
    a = *(const LAS f32x4*)(Am + 1224);
    s0 = fmaf(a.x, x0, s0);
    s1 = fmaf(a.y, x1, s1);
    s2 = fmaf(a.z, x2, s2);
    s3 = fmaf(a.w, x3, s3);
    a = *(const LAS f32x4*)(Am + 1228);
    s0 = fmaf(a.x, x4, s0);
    s1 = fmaf(a.y, x5, s1);
    s2 = fmaf(a.z, x6, s2);
    s3 = fmaf(a.w, x7, s3);
    a = *(const LAS f32x4*)(Am + 1232);
    s0 = fmaf(a.x, x8, s0);
    s1 = fmaf(a.y, x9, s1);
    s2 = fmaf(a.z, x10, s2);
    s3 = fmaf(a.w, x11, s3);
    a = *(const LAS f32x4*)(Am + 1236);
    s0 = fmaf(a.x, x12, s0);
    s1 = fmaf(a.y, x13, s1);
    s2 = fmaf(a.z, x14, s2);
    s3 = fmaf(a.w, x15, s3);
    a = *(const LAS f32x4*)(Am + 1240);
    s0 = fmaf(a.x, x16, s0);
    const float al18 = a.y;
    x18 = (x18 - ((s0 + s1) + (s2 + s3))) - al18 * x17;
    outp[18 * rstride] = f2bf(x18);
    float x19 = sc[19] * bf2f(col[2584]);
    s0 = 0.f; s1 = 0.f; s2 = 0.f; s3 = 0.f;
    a = *(const LAS f32x4*)(Am + 1292);
    s0 = fmaf(a.x, x0, s0);
    s1 = fmaf(a.y, x1, s1);
    s2 = fmaf(a.z, x2, s2);
    s3 = fmaf(a.w, x3, s3);
    a = *(const LAS f32x4*)(Am + 1296);
    s0 = fmaf(a.x, x4, s0);
    s1 = fmaf(a.y, x5, s1);
    s2 = fmaf(a.z, x6, s2);
    s3 = fmaf(a.w, x7, s3);
    a = *(const LAS f32x4*)(Am + 1300);
    s0 = fmaf(a.x, x8, s0);
    s1 = fmaf(a.y, x9, s1);
    s2 = fmaf(a.z, x10, s2);
    s3 = fmaf(a.w, x11, s3);
    a = *(const LAS f32x4*)(Am + 1304);
    s0 = fmaf(a.x, x12, s0);
    s1 = fmaf(a.y, x13, s1);
    s2 = fmaf(a.z, x14, s2);
    s3 = fmaf(a.w, x15, s3);
    a = *(const LAS f32x4*)(Am + 1308);
    s0 = fmaf(a.x, x16, s0);
    s1 = fmaf(a.y, x17, s1);
    const float al19 = a.z;
    x19 = (x19 - ((s0 + s1) + (s2 + s3))) - al19 * x18;
    outp[19 * rstride] = f2bf(x19);
    float x20 = sc[20] * bf2f(col[2720]);
    s0 = 0.f; s1 = 0.f; s2 = 0.f; s3 = 0.f;
    a = *(const LAS f32x4*)(Am + 1360);
    s0 = fmaf(a.x, x0, s0);
    s1 = fmaf(a.y, x1, s1);
    s2 = fmaf(a.z, x2, s2);
    s3 = fmaf(a.w, x3, s3);
    a = *(const LAS f32x4*)(Am + 1364);
    s0 = fmaf(a.x, x4, s0);
    s1 = fmaf(a.y, x5, s1);
    s2 = fmaf(a.z, x6, s2);
    s3 = fmaf(a.w, x7, s3);
    a = *(const LAS f32x4*)(Am + 1368);
    s0 = fmaf(a.x, x8, s0);
    s1 = fmaf(a.y, x9, s1);
    s2 = fmaf(a.z, x10, s2);
    s3 = fmaf(a.w, x11, s3);
    a = *(const LAS f32x4*)(Am + 1372);
    s0 = fmaf(a.x, x12, s0);
    s1 = fmaf(a.y, x13, s1);
    s2 = fmaf(a.z, x14, s2);
    s3 = fmaf(a.w, x15, s3);
    a = *(const LAS f32x4*)(Am + 1376);
    s0 = fmaf(a.x, x16, s0);
    s1 = fmaf(a.y, x17, s1);
    s2 = fmaf(a.z, x18, s2);
    const float al20 = a.w;
    x20 = (x20 - ((s0 + s1) + (s2 + s3))) - al20 * x19;
    outp[20 * rstride] = f2bf(x20);
    float x21 = sc[21] * bf2f(col[2856]);
    s0 = 0.f; s1 = 0.f; s2 = 0.f; s3 = 0.f;
    a = *(const LAS f32x4*)(Am + 1428);
    s0 = fmaf(a.x, x0, s0);
    s1 = fmaf(a.y, x1, s1);
    s2 = fmaf(a.z, x2, s2);
    s3 = fmaf(a.w, x3, s3);
    a = *(const LAS f32x4*)(Am + 1432);
    s0 = fmaf(a.x, x4, s0);
    s1 = fmaf(a.y, x5, s1);
    s2 = fmaf(a.z, x6, s2);
    s3 = fmaf(a.w, x7, s3);
    a = *(const LAS f32x4*)(Am + 1436);
    s0 = fmaf(a.x, x8, s0);
    s1 = fmaf(a.y, x9, s1);
    s2 = fmaf(a.z, x10, s2);
    s3 = fmaf(a.w, x11, s3);
    a = *(const LAS f32x4*)(Am + 1440);
    s0 = fmaf(a.x, x12, s0);
    s1 = fmaf(a.y, x13, s1);
    s2 = fmaf(a.z, x14, s2);
    s3 = fmaf(a.w, x15, s3);
    a = *(const LAS f32x4*)(Am + 1444);
    s0 = fmaf(a.x, x16, s0);
    s1 = fmaf(a.y, x17, s1);
    s2 = fmaf(a.z, x18, s2);
    s3 = fmaf(a.w, x19, s3);
    a = *(const LAS f32x4*)(Am + 1448);
    const float al21 = a.x;
    x21 = (x21 - ((s0 + s1) + (s2 + s3))) - al21 * x20;
    outp[21 * rstride] = f2bf(x21);
    float x22 = sc[22] * bf2f(col[2992]);
    s0 = 0.f; s1 = 0.f; s2 = 0.f; s3 = 0.f;
    a = *(const LAS f32x4*)(Am + 1496);
    s0 = fmaf(a.x, x0, s0);
    s1 = fmaf(a.y, x1, s1);
    s2 = fmaf(a.z, x2, s2);
    s3 = fmaf(a.w, x3, s3);
    a = *(const LAS f32x4*)(Am + 1500);
    s0 = fmaf(a.x, x4, s0);
    s1 = fmaf(a.y, x5, s1);
    s2 = fmaf(a.z, x6, s2);
    s3 = fmaf(a.w, x7, s3);
    a = *(const LAS f32x4*)(Am + 1504);
    s0 = fmaf(a.x, x8, s0);
    s1 = fmaf(a.y, x9, s1);
    s2 = fmaf(a.z, x10, s2);
    s3 = fmaf(a.w, x11, s3);
    a = *(const LAS f32x4*)(Am + 1508);
    s0 = fmaf(a.x, x12, s0);
    s1 = fmaf(a.y, x13, s1);
    s2 = fmaf(a.z, x14, s2);
    s3 = fmaf(a.w, x15, s3);
    a = *(const LAS f32x4*)(Am + 1512);
    s0 = fmaf(a.x, x16, s0);
    s1 = fmaf(a.y, x17, s1);
    s2 = fmaf(a.z, x18, s2);
    s3 = fmaf(a.w, x19, s3);
    a = *(const LAS f32x4*)(Am + 1516);
    s0 = fmaf(a.x, x20, s0);
    const float al22 = a.y;
    x22 = (x22 - ((s0 + s1) + (s2 + s3))) - al22 * x21;
    outp[22 * rstride] = f2bf(x22);
    float x23 = sc[23] * bf2f(col[3128]);
    s0 = 0.f; s1 = 0.f; s2 = 0.f; s3 = 0.f;
    a = *(const LAS f32x4*)(Am + 1564);
    s0 = fmaf(a.x, x0, s0);
    s1 = fmaf(a.y, x1, s1);
    s2 = fmaf(a.z, x2, s2);
    s3 = fmaf(a.w, x3, s3);
    a = *(const LAS f32x4*)(Am + 1568);
    s0 = fmaf(a.x, x4, s0);
    s1 = fmaf(a.y, x5, s1);
    s2 = fmaf(a.z, x6, s2);
    s3 = fmaf(a.w, x7, s3);
    a = *(const LAS f32x4*)(Am + 1572);
    s0 = fmaf(a.x, x8, s0);
    s1 = fmaf(a.y, x9, s1);
    s2 = fmaf(a.z, x10, s2);
    s3 = fmaf(a.w, x11, s3);
    a = *(const LAS f32x4*)(Am + 1576);
    s0 = fmaf(a.x, x12, s0);
    s1 = fmaf(a.y, x13, s1);
    s2 = fmaf(a.z, x14, s2);
    s3 = fmaf(a.w, x15, s3);
    a = *(const LAS f32x4*)(Am + 1580);
    s0 = fmaf(a.x, x16, s0);
    s1 = fmaf(a.y, x17, s1);
    s2 = fmaf(a.z, x18, s2);
    s3 = fmaf(a.w, x19, s3);
    a = *(const LAS f32x4*)(Am + 1584);
    s0 = fmaf(a.x, x20, s0);
    s1 = fmaf(a.y, x21, s1);
    const float al23 = a.z;
    x23 = (x23 - ((s0 + s1) + (s2 + s3))) - al23 * x22;
    outp[23 * rstride] = f2bf(x23);
    float x24 = sc[24] * bf2f(col[3264]);
    s0 = 0.f; s1 = 0.f; s2 = 0.f; s3 = 0.f;
    a = *(const LAS f32x4*)(Am + 1632);
    s0 = fmaf(a.x, x0, s0);
    s1 = fmaf(a.y, x1, s1);
    s2 = fmaf(a.z, x2, s2);
    s3 = fmaf(a.w, x3, s3);
    a = *(const LAS f32x4*)(Am + 1636);
    s0 = fmaf(a.x, x4, s0);
    s1 = fmaf(a.y, x5, s1);
    s2 = fmaf(a.z, x6, s2);
    s3 = fmaf(a.w, x7, s3);
    a = *(const LAS f32x4*)(Am + 1640);
    s0 = fmaf(a.x, x8, s0);
    s1 = fmaf(a.y, x9, s1);
    s2 = fmaf(a.z, x10, s2);
    s3 = fmaf(a.w, x11, s3);
    a = *(const LAS f32x4*)(Am + 1644);
    s0 = fmaf(a.x, x12, s0);
    s1 = fmaf(a.y, x13, s1);
    s2 = fmaf(a.z, x14, s2);
    s3 = fmaf(a.w, x15, s3);
    a = *(const LAS f32x4*)(Am + 1648);
    s0 = fmaf(a.x, x16, s0);
    s1 = fmaf(a.y, x17, s1);
    s2 = fmaf(a.z, x18, s2);
    s3 = fmaf(a.w, x19, s3);
    a = *(const LAS f32x4*)(Am + 1652);
    s0 = fmaf(a.x, x20, s0);
    s1 = fmaf(a.y, x21, s1);
    s2 = fmaf(a.z, x22, s2);
    const float al24 = a.w;
    x24 = (x24 - ((s0 + s1) + (s2 + s3))) - al24 * x23;
    outp[24 * rstride] = f2bf(x24);
    float x25 = sc[25] * bf2f(col[3400]);
    s0 = 0.f; s1 = 0.f; s2 = 0.f; s3 = 0.f;
    a = *(const LAS f32x4*)(Am + 1700);
    s0 = fmaf(a.x, x0, s0);
    s1 = fmaf(a.y, x1, s1);
    s2 = fmaf(a.z, x2, s2);
    s3 = fmaf(a.w, x3, s3);
    a = *(const LAS f32x4*)(Am + 1704);
    s0 = fmaf(a.x, x4, s0);
    s1 = fmaf(a.y, x5, s1);
    s2 = fmaf(a.z, x6, s2);
    s3 = fmaf(a.w, x7, s3);
    a = *(const LAS f32x4*)(Am + 1708);
    s0 = fmaf(a.x, x8, s0);
    s1 = fmaf(a.y, x9, s1);
    s2 = fmaf(a.z, x10, s2);
    s3 = fmaf(a.w, x11, s3);
    a = *(const LAS f32x4*)(Am + 1712);
    s0 = fmaf(a.x, x12, s0);
    s1 = fmaf(a.y, x13, s1);
    s2 = fmaf(a.z, x14, s2);
    s3 = fmaf(a.w, x15, s3);
    a = *(const LAS f32x4*)(Am + 1716);
    s0 = fmaf(a.x, x16, s0);
    s1 = fmaf(a.y, x17, s1);
    s2 = fmaf(a.z, x18, s2);
    s3 = fmaf(a.w, x19, s3);
    a = *(const LAS f32x4*)(Am + 1720);
    s0 = fmaf(a.x, x20, s0);
    s1 = fmaf(a.y, x21, s1);
    s2 = fmaf(a.z, x22, s2);
    s3 = fmaf(a.w, x23, s3);
    a = *(const LAS f32x4*)(Am + 1724);
    const float al25 = a.x;
    x25 = (x25 - ((s0 + s1) + (s2 + s3))) - al25 * x24;
    outp[25 * rstride] = f2bf(x25);
    float x26 = sc[26] * bf2f(col[3536]);
    s0 = 0.f; s1 = 0.f; s2 = 0.f; s3 = 0.f;
    a = *(const LAS f32x4*)(Am + 1768);
    s0 = fmaf(a.x, x0, s0);
    s1 = fmaf(a.y, x1, s1);
    s2 = fmaf(a.z, x2, s2);
    s3 = fmaf(a.w, x3, s3);
    a = *(const LAS f32x4*)(Am + 1772);
    s0 = fmaf(a.x, x4, s0);
    s1 = fmaf(a.y, x5, s1);
    s2 = fmaf(a.z, x6, s2);
    s3 = fmaf(a.w, x7, s3);
    a = *(const LAS f32x4*)(Am + 1776);
    s0 = fmaf(a.x, x8, s0);
    s1 = fmaf(a.y, x9, s1);
    s2 = fmaf(a.z, x10, s2);
    s3 = fmaf(a.w, x11, s3);
    a = *(const LAS f32x4*)(Am + 1780);
    s0 = fmaf(a.x, x12, s0);
    s1 = fmaf(a.y, x13, s1);
    s2 = fmaf(a.z, x14, s2);
    s3 = fmaf(a.w, x15, s3);
    a = *(const LAS f32x4*)(Am + 1784);
    s0 = fmaf(a.x, x16, s0);
    s1 = fmaf(a.y, x17, s1);
    s2 = fmaf(a.z, x18, s2);
    s3 = fmaf(a.w, x19, s3);
    a = *(const LAS f32x4*)(Am + 1788);
    s0 = fmaf(a.x, x20, s0);
    s1 = fmaf(a.y, x21, s1);
    s2 = fmaf(a.z, x22, s2);
    s3 = fmaf(a.w, x23, s3);
    a = *(const LAS f32x4*)(Am + 1792);
    s0 = fmaf(a.x, x24, s0);
    const float al26 = a.y;
    x26 = (x26 - ((s0 + s1) + (s2 + s3))) - al26 * x25;
    outp[26 * rstride] = f2bf(x26);
    float x27 = sc[27] * bf2f(col[3672]);
    s0 = 0.f; s1 = 0.f; s2 = 0.f; s3 = 0.f;
    a = *(const LAS f32x4*)(Am + 1836);
    s0 = fmaf(a.x, x0, s0);
    s1 = fmaf(a.y, x1, s1);
    s2 = fmaf(a.z, x2, s2);
    s3 = fmaf(a.w, x3, s3);
    a = *(const LAS f32x4*)(Am + 1840);
    s0 = fmaf(a.x, x4, s0);
    s1 = fmaf(a.y, x5, s1);
    s2 = fmaf(a.z, x6, s2);
    s3 = fmaf(a.w, x7, s3);
    a = *(const LAS f32x4*)(Am + 1844);
    s0 = fmaf(a.x, x8, s0);
    s1 = fmaf(a.y, x9, s1);
    s2 = fmaf(a.z, x10, s2);
    s3 = fmaf(a.w, x11, s3);
    a = *(const LAS f32x4*)(Am + 1848);
    s0 = fmaf(a.x, x12, s0);
    s1 = fmaf(a.y, x13, s1);
    s2 = fmaf(a.z, x14, s2);
    s3 = fmaf(a.w, x15, s3);
    a = *(const LAS f32x4*)(Am + 1852);
    s0 = fmaf(a.x, x16, s0);
    s1 = fmaf(a.y, x17, s1);
    s2 = fmaf(a.z, x18, s2);
    s3 = fmaf(a.w, x19, s3);
    a = *(const LAS f32x4*)(Am + 1856);
    s0 = fmaf(a.x, x20, s0);
    s1 = fmaf(a.y, x21, s1);
    s2 = fmaf(a.z, x22, s2);
    s3 = fmaf(a.w, x23, s3);
    a = *(const LAS f32x4*)(Am + 1860);
    s0 = fmaf(a.x, x24, s0);
    s1 = fmaf(a.y, x25, s1);
    const float al27 = a.z;
    x27 = (x27 - ((s0 + s1) + (s2 + s3))) - al27 * x26;
    outp[27 * rstride] = f2bf(x27);
    float x28 = sc[28] * bf2f(col[3808]);
    s0 = 0.f; s1 = 0.f; s2 = 0.f; s3 = 0.f;
    a = *(const LAS f32x4*)(Am + 1904);
    s0 = fmaf(a.x, x0, s0);
    s1 = fmaf(a.y, x1, s1);
    s2 = fmaf(a.z, x2, s2);
    s3 = fmaf(a.w, x3, s3);
    a = *(const LAS f32x4*)(Am + 1908);
    s0 = fmaf(a.x, x4, s0);
    s1 = fmaf(a.y, x5, s1);
    s2 = fmaf(a.z, x6, s2);
    s3 = fmaf(a.w, x7, s3);
    a = *(const LAS f32x4*)(Am + 1912);
    s0 = fmaf(a.x, x8, s0);
    s1 = fmaf(a.y, x9, s1);
    s2 = fmaf(a.z, x10, s2);
    s3 = fmaf(a.w, x11, s3);
    a = *(const LAS f32x4*)(Am + 1916);
    s0 = fmaf(a.x, x12, s0);
    s1 = fmaf(a.y, x13, s1);
    s2 = fmaf(a.z, x14, s2);
    s3 = fmaf(a.w, x15, s3);
    a = *(const LAS f32x4*)(Am + 1920);
    s0 = fmaf(a.x, x16, s0);
    s1 = fmaf(a.y, x17, s1);
    s2 = fmaf(a.z, x18, s2);
    s3 = fmaf(a.w, x19, s3);
    a = *(const LAS f32x4*)(Am + 1924);
    s0 = fmaf(a.x, x20, s0);
    s1 = fmaf(a.y, x21, s1);
    s2 = fmaf(a.z, x22, s2);
    s3 = fmaf(a.w, x23, s3);
    a = *(const LAS f32x4*)(Am + 1928);
    s0 = fmaf(a.x, x24, s0);
    s1 = fmaf(a.y, x25, s1);
    s2 = fmaf(a.z, x26, s2);
    const float al28 = a.w;
    x28 = (x28 - ((s0 + s1) + (s2 + s3))) - al28 * x27;
    outp[28 * rstride] = f2bf(x28);
    float x29 = sc[29] * bf2f(col[3944]);
    s0 = 0.f; s1 = 0.f; s2 = 0.f; s3 = 0.f;
    a = *(const LAS f32x4*)(Am + 1972);
    s0 = fmaf(a.x, x0, s0);
    s1 = fmaf(a.y, x1, s1);
    s2 = fmaf(a.z, x2, s2);
    s3 = fmaf(a.w, x3, s3);
    a = *(const LAS f32x4*)(Am + 1976);
    s0 = fmaf(a.x, x4, s0);
    s1 = fmaf(a.y, x5, s1);
    s2 = fmaf(a.z, x6, s2);
    s3 = fmaf(a.w, x7, s3);
    a = *(const LAS f32x4*)(Am + 1980);
    s0 = fmaf(a.x, x8, s0);
    s1 = fmaf(a.y, x9, s1);
    s2 = fmaf(a.z, x10, s2);
    s3 = fmaf(a.w, x11, s3);
    a = *(const LAS f32x4*)(Am + 1984);
    s0 = fmaf(a.x, x12, s0);
    s1 = fmaf(a.y, x13, s1);
    s2 = fmaf(a.z, x14, s2);
    s3 = fmaf(a.w, x15, s3);
    a = *(const LAS f32x4*)(Am + 1988);
    s0 = fmaf(a.x, x16, s0);
    s1 = fmaf(a.y, x17, s1);
    s2 = fmaf(a.z, x18, s2);
    s3 = fmaf(a.w, x19, s3);
    a = *(const LAS f32x4*)(Am + 1992);
    s0 = fmaf(a.x, x20, s0);
    s1 = fmaf(a.y, x21, s1);
    s2 = fmaf(a.z, x22, s2);
    s3 = fmaf(a.w, x23, s3);
    a = *(const LAS f32x4*)(Am + 1996);
    s0 = fmaf(a.x, x24, s0);
    s1 = fmaf(a.y, x25, s1);
    s2 = fmaf(a.z, x26, s2);
    s3 = fmaf(a.w, x27, s3);
    a = *(const LAS f32x4*)(Am + 2000);
    const float al29 = a.x;
    x29 = (x29 - ((s0 + s1) + (s2 + s3))) - al29 * x28;
    outp[29 * rstride] = f2bf(x29);
    float x30 = sc[30] * bf2f(col[4080]);
    s0 = 0.f; s1 = 0.f; s2 = 0.f; s3 = 0.f;
    a = *(const LAS f32x4*)(Am + 2040);
    s0 = fmaf(a.x, x0, s0);
    s1 = fmaf(a.y, x1, s1);
    s2 = fmaf(a.z, x2, s2);
    s3 = fmaf(a.w, x3, s3);
    a = *(const LAS f32x4*)(Am + 2044);
    s0 = fmaf(a.x, x4, s0);
    s1 = fmaf(a.y, x5, s1);
    s2 = fmaf(a.z, x6, s2);
    s3 = fmaf(a.w, x7, s3);
    a = *(const LAS f32x4*)(Am + 2048);
    s0 = fmaf(a.x, x8, s0);
    s1 = fmaf(a.y, x9, s1);
    s2 = fmaf(a.z, x10, s2);
    s3 = fmaf(a.w, x11, s3);
    a = *(const LAS f32x4*)(Am + 2052);
    s0 = fmaf(a.x, x12, s0);
    s1 = fmaf(a.y, x13, s1);
    s2 = fmaf(a.z, x14, s2);
    s3 = fmaf(a.w, x15, s3);
    a = *(const LAS f32x4*)(Am + 2056);
    s0 = fmaf(a.x, x16, s0);
    s1 = fmaf(a.y, x17, s1);
    s2 = fmaf(a.z, x18, s2);
    s3 = fmaf(a.w, x19, s3);
    a = *(const LAS f32x4*)(Am + 2060);
    s0 = fmaf(a.x, x20, s0);
    s1 = fmaf(a.y, x21, s1);
    s2 = fmaf(a.z, x22, s2);
    s3 = fmaf(a.w, x23, s3);
    a = *(const LAS f32x4*)(Am + 2064);
    s0 = fmaf(a.x, x24, s0);
    s1 = fmaf(a.y, x25, s1);
    s2 = fmaf(a.z, x26, s2);
    s3 = fmaf(a.w, x27, s3);
    a = *(const LAS f32x4*)(Am + 2068);
    s0 = fmaf(a.x, x28, s0);
    const float al30 = a.y;
    x30 = (x30 - ((s0 + s1) + (s2 + s3))) - al30 * x29;
    outp[30 * rstride] = f2bf(x30);
    float x31 = sc[31] * bf2f(col[4216]);
    s0 = 0.f; s1 = 0.f; s2 = 0.f; s3 = 0.f;
    a = *(const LAS f32x4*)(Am + 2108);
    s0 = fmaf(a.x, x0, s0);
    s1 = fmaf(a.y, x1, s1);
    s2 = fmaf(a.z, x2, s2);
    s3 = fmaf(a.w, x3, s3);
    a = *(const LAS f32x4*)(Am + 2112);
    s0 = fmaf(a.x, x4, s0);
    s1 = fmaf(a.y, x5, s1);
    s2 = fmaf(a.z, x6, s2);
    s3 = fmaf(a.w, x7, s3);
    a = *(const LAS f32x4*)(Am + 2116);
    s0 = fmaf(a.x, x8, s0);
    s1 = fmaf(a.y, x9, s1);
    s2 = fmaf(a.z, x10, s2);
    s3 = fmaf(a.w, x11, s3);
    a = *(const LAS f32x4*)(Am + 2120);
    s0 = fmaf(a.x, x12, s0);
    s1 = fmaf(a.y, x13, s1);
    s2 = fmaf(a.z, x14, s2);
    s3 = fmaf(a.w, x15, s3);
    a = *(const LAS f32x4*)(Am + 2124);
    s0 = fmaf(a.x, x16, s0);
    s1 = fmaf(a.y, x17, s1);
    s2 = fmaf(a.z, x18, s2);
    s3 = fmaf(a.w, x19, s3);
    a = *(const LAS f32x4*)(Am + 2128);
    s0 = fmaf(a.x, x20, s0);
    s1 = fmaf(a.y, x21, s1);
    s2 = fmaf(a.z, x22, s2);
    s3 = fmaf(a.w, x23, s3);
    a = *(const LAS f32x4*)(Am + 2132);
    s0 = fmaf(a.x, x24, s0);
    s1 = fmaf(a.y, x25, s1);
    s2 = fmaf(a.z, x26, s2);
    s3 = fmaf(a.w, x27, s3);
    a = *(const LAS f32x4*)(Am + 2136);
    s0 = fmaf(a.x, x28, s0);
    s1 = fmaf(a.y, x29, s1);
    const float al31 = a.z;
    x31 = (x31 - ((s0 + s1) + (s2 + s3))) - al31 * x30;
    outp[31 * rstride] = f2bf(x31);
    float x32 = sc[32] * bf2f(col[4352]);
    s0 = 0.f; s1 = 0.f; s2 = 0.f; s3 = 0.f;
    a = *(const LAS f32x4*)(Am + 2176);
    s0 = fmaf(a.x, x0, s0);
    s1 = fmaf(a.y, x1, s1);
    s2 = fmaf(a.z, x2, s2);
    s3 = fmaf(a.w, x3, s3);
    a = *(const LAS f32x4*)(Am + 2180);
    s0 = fmaf(a.x, x4, s0);
    s1 = fmaf(a.y, x5, s1);
    s2 = fmaf(a.z, x6, s2);
    s3 = fmaf(a.w, x7, s3);
    a = *(const LAS f32x4*)(Am + 2184);
    s0 = fmaf(a.x, x8, s0);
    s1 = fmaf(a.y, x9, s1);
    s2 = fmaf(a.z, x10, s2);
    s3 = fmaf(a.w, x11, s3);
    a = *(const LAS f32x4*)(Am + 2188);
    s0 = fmaf(a.x, x12, s0);
    s1 = fmaf(a.y, x13, s1);
    s2 = fmaf(a.z, x14, s2);
    s3 = fmaf(a.w, x15, s3);
    a = *(const LAS f32x4*)(Am + 2192);
    s0 = fmaf(a.x, x16, s0);
    s1 = fmaf(a.y, x17, s1);
    s2 = fmaf(a.z, x18, s2);
    s3 = fmaf(a.w, x19, s3);
    a = *(const LAS f32x4*)(Am + 2196);
    s0 = fmaf(a.x, x20, s0);
    s1 = fmaf(a.y, x21, s1);
    s2 = fmaf(a.z, x22, s2);
    s3 = fmaf(a.w, x23, s3);
    a = *(const LAS f32x4*)(Am + 2200);
    s0 = fmaf(a.x, x24, s0);
    s1 = fmaf(a.y, x25, s1);
    s2 = fmaf(a.z, x26, s2);
    s3 = fmaf(a.w, x27, s3);
    a = *(const LAS f32x4*)(Am + 2204);
    s0 = fmaf(a.x, x28, s0);
    s1 = fmaf(a.y, x29, s1);
    s2 = fmaf(a.z, x30, s2);
    const float al32 = a.w;
    x32 = (x32 - ((s0 + s1) + (s2 + s3))) - al32 * x31;
    outp[32 * rstride] = f2bf(x32);
    float x33 = sc[33] * bf2f(col[4488]);
    s0 = 0.f; s1 = 0.f; s2 = 0.f; s3 = 0.f;
    a = *(const LAS f32x4*)(Am + 2244);
    s0 = fmaf(a.x, x0, s0);
    s1 = fmaf(a.y, x1, s1);
    s2 = fmaf(a.z, x2, s2);
    s3 = fmaf(a.w, x3, s3);
    a = *(const LAS f32x4*)(Am + 2248);
    s0 = fmaf(a.x, x4, s0);
    s1 = fmaf(a.y, x5, s1);
    s2 = fmaf(a.z, x6, s2);
    s3 = fmaf(a.w, x7, s3);
    a = *(const LAS f32x4*)(Am + 2252);
    s0 = fmaf(a.x, x8, s0);
    s1 = fmaf(a.y, x9, s1);
    s2 = fmaf(a.z, x10, s2);
    s3 = fmaf(a.w, x11, s3);
    a = *(const LAS f32x4*)(Am + 2256);
    s0 = fmaf(a.x, x12, s0);
    s1 = fmaf(a.y, x13, s1);
    s2 = fmaf(a.z, x14, s2);
    s3 = fmaf(a.w, x15, s3);
    a = *(const LAS f32x4*)(Am + 2260);
    s0 = fmaf(a.x, x16, s0);
    s1 = fmaf(a.y, x17, s1);
    s2 = fmaf(a.z, x18, s2);
    s3 = fmaf(a.w, x19, s3);
    a = *(const LAS f32x4*)(Am + 2264);
    s0 = fmaf(a.x, x20, s0);
    s1 = fmaf(a.y, x21, s1);
    s2 = fmaf(a.z, x22, s2);
    s3 = fmaf(a.w, x23, s3);
    a = *(const LAS f32x4*)(Am + 2268);
    s0 = fmaf(a.x, x24, s0);
    s1 = fmaf(a.y, x25, s1);
    s2 = fmaf(a.z, x26, s2);
    s3 = fmaf(a.w, x27, s3);
    a = *(const LAS f32x4*)(Am + 2272);
    s0 = fmaf(a.x, x28, s0);
    s1 = fmaf(a.y, x29, s1);
    s2 = fmaf(a.z, x30, s2);
    s3 = fmaf(a.w, x31, s3);
    a = *(const LAS f32x4*)(Am + 2276);
    const float al33 = a.x;
    x33 = (x33 - ((s0 + s1) + (s2 + s3))) - al33 * x32;
    outp[33 * rstride] = f2bf(x33);
    float x34 = sc[34] * bf2f(col[4624]);
    s0 = 0.f; s1 = 0.f; s2 = 0.f; s3 = 0.f;
    a = *(const LAS f32x4*)(Am + 2312);
    s0 = fmaf(a.x, x0, s0);
    s1 = fmaf(a.y, x1, s1);
    s2 = fmaf(a.z, x2, s2);
    s3 = fmaf(a.w, x3, s3);
    a = *(const LAS f32x4*)(Am + 2316);
    s0 = fmaf(a.x, x4, s0);
    s1 = fmaf(a.y, x5, s1);
    s2 = fmaf(a.z, x6, s2);
    s3 = fmaf(a.w, x7, s3);
    a = *(const LAS f32x4*)(Am + 2320);
    s0 = fmaf(a.x, x8, s0);
    s1 = fmaf(a.y, x9, s1);
    s2 = fmaf(a.z, x10, s2);
    s3 = fmaf(a.w, x11, s3);
    a = *(const LAS f32x4*)(Am + 2324);
    s0 = fmaf(a.x, x12, s0);
    s1 = fmaf(a.y, x13, s1);
    s2 = fmaf(a.z, x14, s2);
    s3 = fmaf(a.w, x15, s3);
    a = *(const LAS f32x4*)(Am + 2328);
    s0 = fmaf(a.x, x16, s0);
    s1 = fmaf(a.y, x17, s1);
    s2 = fmaf(a.z, x18, s2);
    s3 = fmaf(a.w, x19, s3);
    a = *(const LAS f32x4*)(Am + 2332);
    s0 = fmaf(a.x, x20, s0);
    s1 = fmaf(a.y, x21, s1);
    s2 = fmaf(a.z, x22, s2);
    s3 = fmaf(a.w, x23, s3);
    a = *(const LAS f32x4*)(Am + 2336);
    s0 = fmaf(a.x, x24, s0);
    s1 = fmaf(a.y, x25, s1);
    s2 = fmaf(a.z, x26, s2);
    s3 = fmaf(a.w, x27, s3);
    a = *(const LAS f32x4*)(Am + 2340);
    s0 = fmaf(a.x, x28, s0);
    s1 = fmaf(a.y, x29, s1);
    s2 = fmaf(a.z, x30, s2);
    s3 = fmaf(a.w, x31, s3);
    a = *(const LAS f32x4*)(Am + 2344);
    s0 = fmaf(a.x, x32, s0);
    const float al34 = a.y;
    x34 = (x34 - ((s0 + s1) + (s2 + s3))) - al34 * x33;
    outp[34 * rstride] = f2bf(x34);
    float x35 = sc[35] * bf2f(col[4760]);
    s0 = 0.f; s1 = 0.f; s2 = 0.f; s3 = 0.f;
    a = *(const LAS f32x4*)(Am + 2380);
    s0 = fmaf(a.x, x0, s0);
    s1 = fmaf(a.y, x1, s1);
    s2 = fmaf(a.z, x2, s2);
    s3 = fmaf(a.w, x3, s3);
    a = *(const LAS f32x4*)(Am + 2384);
    s0 = fmaf(a.x, x4, s0);
    s1 = fmaf(a.y, x5, s1);
    s2 = fmaf(a.z, x6, s2);
    s3 = fmaf(a.w, x7, s3);
    a = *(const LAS f32x4*)(Am + 2388);
    s0 = fmaf(a.x, x8, s0);
    s1 = fmaf(a.y, x9, s1);
    s2 = fmaf(a.z, x10, s2);
    s3 = fmaf(a.w, x11, s3);
    a = *(const LAS f32x4*)(Am + 2392);
    s0 = fmaf(a.x, x12, s0);
    s1 = fmaf(a.y, x13, s1);
    s2 = fmaf(a.z, x14, s2);
    s3 = fmaf(a.w, x15, s3);
    a = *(const LAS f32x4*)(Am + 2396);
    s0 = fmaf(a.x, x16, s0);
    s1 = fmaf(a.y, x17, s1);
    s2 = fmaf(a.z, x18, s2);
    s3 = fmaf(a.w, x19, s3);
    a = *(const LAS f32x4*)(Am + 2400);
    s0 = fmaf(a.x, x20, s0);
    s1 = fmaf(a.y, x21, s1);
    s2 = fmaf(a.z, x22, s2);
    s3 = fmaf(a.w, x23, s3);
    a = *(const LAS f32x4*)(Am + 2404);
    s0 = fmaf(a.x, x24, s0);
    s1 = fmaf(a.y, x25, s1);
    s2 = fmaf(a.z, x26, s2);
    s3 = fmaf(a.w, x27, s3);
    a = *(const LAS f32x4*)(Am + 2408);
    s0 = fmaf(a.x, x28, s0);
    s1 = fmaf(a.y, x29, s1);
    s2 = fmaf(a.z, x30, s2);
    s3 = fmaf(a.w, x31, s3);
    a = *(const LAS f32x4*)(Am + 2412);
    s0 = fmaf(a.x, x32, s0);
    s1 = fmaf(a.y, x33, s1);
    const float al35 = a.z;
    x35 = (x35 - ((s0 + s1) + (s2 + s3))) - al35 * x34;
    outp[35 * rstride] = f2bf(x35);
    float x36 = sc[36] * bf2f(col[4896]);
    s0 = 0.f; s1 = 0.f; s2 = 0.f; s3 = 0.f;
    a = *(const LAS f32x4*)(Am + 2448);
    s0 = fmaf(a.x, x0, s0);
    s1 = fmaf(a.y, x1, s1);
    s2 = fmaf(a.z, x2, s2);
    s3 = fmaf(a.w, x3, s3);
    a = *(const LAS f32x4*)(Am + 2452);
    s0 = fmaf(a.x, x4, s0);
    s1 = fmaf(a.y, x5, s1);
    s2 = fmaf(a.z, x6, s2);
    s3 = fmaf(a.w, x7, s3);
    a = *(const LAS f32x4*)(Am + 2456);
    s0 = fmaf(a.x, x8, s0);
    s1 = fmaf(a.y, x9, s1);
    s2 = fmaf(a.z, x10, s2);
    s3 = fmaf(a.w, x11, s3);
    a = *(const LAS f32x4*)(Am + 2460);
    s0 = fmaf(a.x, x12, s0);
    s1 = fmaf(a.y, x13, s1);
    s2 = fmaf(a.z, x14, s2);
    s3 = fmaf(a.w, x15, s3);
    a = *(const LAS f32x4*)(Am + 2464);
    s0 = fmaf(a.x, x16, s0);
    s1 = fmaf(a.y, x17, s1);
    s2 = fmaf(a.z, x18, s2);
    s3 = fmaf(a.w, x19, s3);
    a = *(const LAS f32x4*)(Am + 2468);
    s0 = fmaf(a.x, x20, s0);
    s1 = fmaf(a.y, x21, s1);
    s2 = fmaf(a.z, x22, s2);
    s3 = fmaf(a.w, x23, s3);
    a = *(const LAS f32x4*)(Am + 2472);
    s0 = fmaf(a.x, x24, s0);
    s1 = fmaf(a.y, x25, s1);
    s2 = fmaf(a.z, x26, s2);
    s3 = fmaf(a.w, x27, s3);
    a = *(const LAS f32x4*)(Am + 2476);
    s0 = fmaf(a.x, x28, s0);
    s1 = fmaf(a.y, x29, s1);
    s2 = fmaf(a.z, x30, s2);
    s3 = fmaf(a.w, x31, s3);
    a = *(const LAS f32x4*)(Am + 2480);
    s0 = fmaf(a.x, x32, s0);
    s1 = fmaf(a.y, x33, s1);
    s2 = fmaf(a.z, x34, s2);
    const float al36 = a.w;
    x36 = (x36 - ((s0 + s1) + (s2 + s3))) - al36 * x35;
    outp[36 * rstride] = f2bf(x36);
    float x37 = sc[37] * bf2f(col[5032]);
    s0 = 0.f; s1 = 0.f; s2 = 0.f; s3 = 0.f;
    a = *(const LAS f32x4*)(Am + 2516);
    s0 = fmaf(a.x, x0, s0);
    s1 = fmaf(a.y, x1, s1);
    s2 = fmaf(a.z, x2, s2);
    s3 = fmaf(a.w, x3, s3);
    a = *(const LAS f32x4*)(Am + 2520);
    s0 = fmaf(a.x, x4, s0);
    s1 = fmaf(a.y, x5, s1);
    s2 = fmaf(a.z, x6, s2);
    s3 = fmaf(a.w, x7, s3);
    a = *(const LAS f32x4*)(Am + 2524);
    s0 = fmaf(a.x, x8, s0);
    s1 = fmaf(a.y, x9, s1);
    s2 = fmaf(a.z, x10, s2);
    s3 = fmaf(a.w, x11, s3);
    a = *(const LAS f32x4*)(Am + 2528);
    s0 = fmaf(a.x, x12, s0);
    s1 = fmaf(a.y, x13, s1);
    s2 = fmaf(a.z, x14, s2);
    s3 = fmaf(a.w, x15, s3);
    a = *(const LAS f32x4*)(Am + 2532);
    s0 = fmaf(a.x, x16, s0);
    s1 = fmaf(a.y, x17, s1);
    s2 = fmaf(a.z, x18, s2);
    s3 = fmaf(a.w, x19, s3);
    a = *(const LAS f32x4*)(Am + 2536);
    s0 = fmaf(a.x, x20, s0);
    s1 = fmaf(a.y, x21, s1);
    s2 = fmaf(a.z, x22, s2);
    s3 = fmaf(a.w, x23, s3);
    a = *(const LAS f32x4*)(Am + 2540);
    s0 = fmaf(a.x, x24, s0);
    s1 = fmaf(a.y, x25, s1);
    s2 = fmaf(a.z, x26, s2);
    s3 = fmaf(a.w, x27, s3);
    a = *(const LAS f32x4*)(Am + 2544);
    s0 = fmaf(a.x, x28, s0);
    s1 = fmaf(a.y, x29, s1);
    s2 = fmaf(a.z, x30, s2);
    s3 = fmaf(a.w, x31, s3);
    a = *(const LAS f32x4*)(Am + 2548);
    s0 = fmaf(a.x, x32, s0);
    s1 = fmaf(a.y, x33, s1);
    s2 = fmaf(a.z, x34, s2);
    s3 = fmaf(a.w, x35, s3);
    a = *(const LAS f32x4*)(Am + 2552);
    const float al37 = a.x;
    x37 = (x37 - ((s0 + s1) + (s2 + s3))) - al37 * x36;
    outp[37 * rstride] = f2bf(x37);
    float x38 = sc[38] * bf2f(col[5168]);
    s0 = 0.f; s1 = 0.f; s2 = 0.f; s3 = 0.f;
    a = *(const LAS f32x4*)(Am + 2584);
    s0 = fmaf(a.x, x0, s0);
    s1 = fmaf(a.y, x1, s1);
    s2 = fmaf(a.z, x2, s2);
    s3 = fmaf(a.w, x3, s3);
    a = *(const LAS f32x4*)(Am + 2588);
    s0 = fmaf(a.x, x4, s0);
    s1 = fmaf(a.y, x5, s1);
    s2 = fmaf(a.z, x6, s2);
    s3 = fmaf(a.w, x7, s3);
    a = *(const LAS f32x4*)(Am + 2592);
    s0 = fmaf(a.x, x8, s0);
    s1 = fmaf(a.y, x9, s1);
    s2 = fmaf(a.z, x10, s2);
    s3 = fmaf(a.w, x11, s3);
    a = *(const LAS f32x4*)(Am + 2596);
    s0 = fmaf(a.x, x12, s0);
    s1 = fmaf(a.y, x13, s1);
    s2 = fmaf(a.z, x14, s2);
    s3 = fmaf(a.w, x15, s3);
    a = *(const LAS f32x4*)(Am + 2600);
    s0 = fmaf(a.x, x16, s0);
    s1 = fmaf(a.y, x17, s1);
    s2 = fmaf(a.z, x18, s2);
    s3 = fmaf(a.w, x19, s3);
    a = *(const LAS f32x4*)(Am + 2604);
    s0 = fmaf(a.x, x20, s0);
    s1 = fmaf(a.y, x21, s1);
    s2 = fmaf(a.z, x22, s2);
    s3 = fmaf(a.w, x23, s3);
    a = *(const LAS f32x4*)(Am + 2608);
    s0 = fmaf(a.x, x24, s0);
    s1 = fmaf(a.y, x25, s1);
    s2 = fmaf(a.z, x26, s2);
    s3 = fmaf(a.w, x27, s3);
    a = *(const LAS f32x4*)(Am + 2612);
    s0 = fmaf(a.x, x28, s0);
    s1 = fmaf(a.y, x29, s1);
    s2 = fmaf(a.z, x30, s2);
    s3 = fmaf(a.w, x31, s3);
    a = *(const LAS f32x4*)(Am + 2616);
    s0 = fmaf(a.x, x32, s0);
    s1 = fmaf(a.y, x33, s1);
    s2 = fmaf(a.z, x34, s2);
    s3 = fmaf(a.w, x35, s3);
    a = *(const LAS f32x4*)(Am + 2620);
    s0 = fmaf(a.x, x36, s0);
    const float al38 = a.y;
    x38 = (x38 - ((s0 + s1) + (s2 + s3))) - al38 * x37;
    outp[38 * rstride] = f2bf(x38);
    float x39 = sc[39] * bf2f(col[5304]);
    s0 = 0.f; s1 = 0.f; s2 = 0.f; s3 = 0.f;
    a = *(const LAS f32x4*)(Am + 2652);
    s0 = fmaf(a.x, x0, s0);
    s1 = fmaf(a.y, x1, s1);
    s2 = fmaf(a.z, x2, s2);
    s3 = fmaf(a.w, x3, s3);
    a = *(const LAS f32x4*)(Am + 2656);
    s0 = fmaf(a.x, x4, s0);
    s1 = fmaf(a.y, x5, s1);
    s2 = fmaf(a.z, x6, s2);
    s3 = fmaf(a.w, x7, s3);
    a = *(const LAS f32x4*)(Am + 2660);
    s0 = fmaf(a.x, x8, s0);
    s1 = fmaf(a.y, x9, s1);
    s2 = fmaf(a.z, x10, s2);
    s3 = fmaf(a.w, x11, s3);
    a = *(const LAS f32x4*)(Am + 2664);
    s0 = fmaf(a.x, x12, s0);
    s1 = fmaf(a.y, x13, s1);
    s2 = fmaf(a.z, x14, s2);
    s3 = fmaf(a.w, x15, s3);
    a = *(const LAS f32x4*)(Am + 2668);
    s0 = fmaf(a.x, x16, s0);
    s1 = fmaf(a.y, x17, s1);
    s2 = fmaf(a.z, x18, s2);
    s3 = fmaf(a.w, x19, s3);
    a = *(const LAS f32x4*)(Am + 2672);
    s0 = fmaf(a.x, x20, s0);
    s1 = fmaf(a.y, x21, s1);
    s2 = fmaf(a.z, x22, s2);
    s3 = fmaf(a.w, x23, s3);
    a = *(const LAS f32x4*)(Am + 2676);
    s0 = fmaf(a.x, x24, s0);
    s1 = fmaf(a.y, x25, s1);
    s2 = fmaf(a.z, x26, s2);
    s3 = fmaf(a.w, x27, s3);
    a = *(const LAS f32x4*)(Am + 2680);
    s0 = fmaf(a.x, x28, s0);
    s1 = fmaf(a.y, x29, s1);
    s2 = fmaf(a.z, x30, s2);
    s3 = fmaf(a.w, x31, s3);
    a = *(const LAS f32x4*)(Am + 2684);
    s0 = fmaf(a.x, x32, s0);
    s1 = fmaf(a.y, x33, s1);
    s2 = fmaf(a.z, x34, s2);
    s3 = fmaf(a.w, x35, s3);
    a = *(const LAS f32x4*)(Am + 2688);
    s0 = fmaf(a.x, x36, s0);
    s1 = fmaf(a.y, x37, s1);
    const float al39 = a.z;
    x39 = (x39 - ((s0 + s1) + (s2 + s3))) - al39 * x38;
    outp[39 * rstride] = f2bf(x39);
    float x40 = sc[40] * bf2f(col[5440]);
    s0 = 0.f; s1 = 0.f; s2 = 0.f; s3 = 0.f;
    a = *(const LAS f32x4*)(Am + 2720);
    s0 = fmaf(a.x, x0, s0);
    s1 = fmaf(a.y, x1, s1);
    s2 = fmaf(a.z, x2, s2);
    s3 = fmaf(a.w, x3, s3);
    a = *(const LAS f32x4*)(Am + 2724);
    s0 = fmaf(a.x, x4, s0);
    s1 = fmaf(a.y, x5, s1);
    s2 = fmaf(a.z, x6, s2);
    s3 = fmaf(a.w, x7, s3);
    a = *(const LAS f32x4*)(Am + 2728);
    s0 = fmaf(a.x, x8, s0);
    s1 = fmaf(a.y, x9, s1);
    s2 = fmaf(a.z, x10, s2);
    s3 = fmaf(a.w, x11, s3);
    a = *(const LAS f32x4*)(Am + 2732);
    s0 = fmaf(a.x, x12, s0);
    s1 = fmaf(a.y, x13, s1);
    s2 = fmaf(a.z, x14, s2);
    s3 = fmaf(a.w, x15, s3);
    a = *(const LAS f32x4*)(Am + 2736);
    s0 = fmaf(a.x, x16, s0);
    s1 = fmaf(a.y, x17, s1);
    s2 = fmaf(a.z, x18, s2);
    s3 = fmaf(a.w, x19, s3);
    a = *(const LAS f32x4*)(Am + 2740);
    s0 = fmaf(a.x, x20, s0);
    s1 = fmaf(a.y, x21, s1);
    s2 = fmaf(a.z, x22, s2);
    s3 = fmaf(a.w, x23, s3);
    a = *(const LAS f32x4*)(Am + 2744);
    s0 = fmaf(a.x, x24, s0);
    s1 = fmaf(a.y, x25, s1);
    s2 = fmaf(a.z, x26, s2);
    s3 = fmaf(a.w, x27, s3);
    a = *(const LAS f32x4*)(Am + 2748);
    s0 = fmaf(a.x, x28, s0);
    s1 = fmaf(a.y, x29, s1);
    s2 = fmaf(a.z, x30, s2);
    s3 = fmaf(a.w, x31, s3);
    a = *(const LAS f32x4*)(Am + 2752);
    s0 = fmaf(a.x, x32, s0);
    s1 = fmaf(a.y, x33, s1);
    s2 = fmaf(a.z, x34, s2);
    s3 = fmaf(a.w, x35, s3);
    a = *(const LAS f32x4*)(Am + 2756);
    s0 = fmaf(a.x, x36, s0);
    s1 = fmaf(a.y, x37, s1);
    s2 = fmaf(a.z, x38, s2);
    const float al40 = a.w;
    x40 = (x40 - ((s0 + s1) + (s2 + s3))) - al40 * x39;
    outp[40 * rstride] = f2bf(x40);
    float x41 = sc[41] * bf2f(col[5576]);
    s0 = 0.f; s1 = 0.f; s2 = 0.f; s3 = 0.f;
    a = *(const LAS f32x4*)(Am + 2788);
    s0 = fmaf(a.x, x0, s0);
    s1 = fmaf(a.y, x1, s1);
    s2 = fmaf(a.z, x2, s2);
    s3 = fmaf(a.w, x3, s3);
    a = *(const LAS f32x4*)(Am + 2792);
    s0 = fmaf(a.x, x4, s0);
    s1 = fmaf(a.y, x5, s1);
    s2 = fmaf(a.z, x6, s2);
    s3 = fmaf(a.w, x7, s3);
    a = *(const LAS f32x4*)(Am + 2796);
    s0 = fmaf(a.x, x8, s0);
    s1 = fmaf(a.y, x9, s1);
    s2 = fmaf(a.z, x10, s2);
    s3 = fmaf(a.w, x11, s3);
    a = *(const LAS f32x4*)(Am + 2800);
    s0 = fmaf(a.x, x12, s0);
    s1 = fmaf(a.y, x13, s1);
    s2 = fmaf(a.z, x14, s2);
    s3 = fmaf(a.w, x15, s3);
    a = *(const LAS f32x4*)(Am + 2804);
    s0 = fmaf(a.x, x16, s0);
    s1 = fmaf(a.y, x17, s1);
    s2 = fmaf(a.z, x18, s2);
    s3 = fmaf(a.w, x19, s3);
    a = *(const LAS f32x4*)(Am + 2808);
    s0 = fmaf(a.x, x20, s0);
    s1 = fmaf(a.y, x21, s1);
    s2 = fmaf(a.z, x22, s2);
    s3 = fmaf(a.w, x23, s3);
    a = *(const LAS f32x4*)(Am + 2812);
    s0 = fmaf(a.x, x24, s0);
    s1 = fmaf(a.y, x25, s1);
    s2 = fmaf(a.z, x26, s2);
    s3 = fmaf(a.w, x27, s3);
    a = *(const LAS f32x4*)(Am + 2816);
    s0 = fmaf(a.x, x28, s0);
    s1 = fmaf(a.y, x29, s1);
    s2 = fmaf(a.z, x30, s2);
    s3 = fmaf(a.w, x31, s3);
    a = *(const LAS f32x4*)(Am + 2820);
    s0 = fmaf(a.x, x32, s0);
    s1 = fmaf(a.y, x33, s1);
    s2 = fmaf(a.z, x34, s2);
    s3 = fmaf(a.w, x35, s3);
    a = *(const LAS f32x4*)(Am + 2824);
    s0 = fmaf(a.x, x36, s0);
    s1 = fmaf(a.y, x37, s1);
    s2 = fmaf(a.z, x38, s2);
    s3 = fmaf(a.w, x39, s3);
    a = *(const LAS f32x4*)(Am + 2828);
    const float al41 = a.x;
    x41 = (x41 - ((s0 + s1) + (s2 + s3))) - al41 * x40;
    outp[41 * rstride] = f2bf(x41);
    float x42 = sc[42] * bf2f(col[5712]);
    s0 = 0.f; s1 = 0.f; s2 = 0.f; s3 = 0.f;
    a = *(const LAS f32x4*)(Am + 2856);
    s0 = fmaf(a.x, x0, s0);
    s1 = fmaf(a.y, x1, s1);
    s2 = fmaf(a.z, x2, s2);
    s3 = fmaf(a.w, x3, s3);
    a = *(const LAS f32x4*)(Am + 2860);
    s0 = fmaf(a.x, x4, s0);
    s1 = fmaf(a.y, x5, s1);
    s2 = fmaf(a.z, x6, s2);
    s3 = fmaf(a.w, x7, s3);
    a = *(const LAS f32x4*)(Am + 2864);
    s0 = fmaf(a.x, x8, s0);
    s1 = fmaf(a.y, x9, s1);
    s2 = fmaf(a.z, x10, s2);
    s3 = fmaf(a.w, x11, s3);
    a = *(const LAS f32x4*)(Am + 2868);
    s0 = fmaf(a.x, x12, s0);
    s1 = fmaf(a.y, x13, s1);
    s2 = fmaf(a.z, x14, s2);
    s3 = fmaf(a.w, x15, s3);
    a = *(const LAS f32x4*)(Am + 2872);
    s0 = fmaf(a.x, x16, s0);
    s1 = fmaf(a.y, x17, s1);
    s2 = fmaf(a.z, x18, s2);
    s3 = fmaf(a.w, x19, s3);
    a = *(const LAS f32x4*)(Am + 2876);
    s0 = fmaf(a.x, x20, s0);
    s1 = fmaf(a.y, x21, s1);
    s2 = fmaf(a.z, x22, s2);
    s3 = fmaf(a.w, x23, s3);
    a = *(const LAS f32x4*)(Am + 2880);
    s0 = fmaf(a.x, x24, s0);
    s1 = fmaf(a.y, x25, s1);
    s2 = fmaf(a.z, x26, s2);
    s3 = fmaf(a.w, x27, s3);
    a = *(const LAS f32x4*)(Am + 2884);
    s0 = fmaf(a.x, x28, s0);
    s1 = fmaf(a.y, x29, s1);
    s2 = fmaf(a.z, x30, s2);
    s3 = fmaf(a.w, x31, s3);
    a = *(const LAS f32x4*)(Am + 2888);
    s0 = fmaf(a.x, x32, s0);
    s1 = fmaf(a.y, x33, s1);
    s2 = fmaf(a.z, x34, s2);
    s3 = fmaf(a.w, x35, s3);
    a = *(const LAS f32x4*)(Am + 2892);
    s0 = fmaf(a.x, x36, s0);
    s1 = fmaf(a.y, x37, s1);
    s2 = fmaf(a.z, x38, s2);
    s3 = fmaf(a.w, x39, s3);
    a = *(const LAS f32x4*)(Am + 2896);
    s0 = fmaf(a.x, x40, s0);
    const float al42 = a.y;
    x42 = (x42 - ((s0 + s1) + (s2 + s3))) - al42 * x41;
    outp[42 * rstride] = f2bf(x42);
    float x43 = sc[43] * bf2f(col[5848]);
    s0 = 0.f; s1 = 0.f; s2 = 0.f; s3 = 0.f;
    a = *(const LAS f32x4*)(Am + 2924);
    s0 = fmaf(a.x, x0, s0);
    s1 = fmaf(a.y, x1, s1);
    s2 = fmaf(a.z, x2, s2);
    s3 = fmaf(a.w, x3, s3);
    a = *(const LAS f32x4*)(Am + 2928);
    s0 = fmaf(a.x, x4, s0);
    s1 = fmaf(a.y, x5, s1);
    s2 = fmaf(a.z, x6, s2);
    s3 = fmaf(a.w, x7, s3);
    a = *(const LAS f32x4*)(Am + 2932);
    s0 = fmaf(a.x, x8, s0);
    s1 = fmaf(a.y, x9, s1);
    s2 = fmaf(a.z, x10, s2);
    s3 = fmaf(a.w, x11, s3);
    a = *(const LAS f32x4*)(Am + 2936);
    s0 = fmaf(a.x, x12, s0);
    s1 = fmaf(a.y, x13, s1);
    s2 = fmaf(a.z, x14, s2);
    s3 = fmaf(a.w, x15, s3);
    a = *(const LAS f32x4*)(Am + 2940);
    s0 = fmaf(a.x, x16, s0);
    s1 = fmaf(a.y, x17, s1);
    s2 = fmaf(a.z, x18, s2);
    s3 = fmaf(a.w, x19, s3);
    a = *(const LAS f32x4*)(Am + 2944);
    s0 = fmaf(a.x, x20, s0);
    s1 = fmaf(a.y, x21, s1);
    s2 = fmaf(a.z, x22, s2);
    s3 = fmaf(a.w, x23, s3);
    a = *(const LAS f32x4*)(Am + 2948);
    s0 = fmaf(a.x, x24, s0);
    s1 = fmaf(a.y, x25, s1);
    s2 = fmaf(a.z, x26, s2);
    s3 = fmaf(a.w, x27, s3);
    a = *(const LAS f32x4*)(Am + 2952);
    s0 = fmaf(a.x, x28, s0);
    s1 = fmaf(a.y, x29, s1);
    s2 = fmaf(a.z, x30, s2);
    s3 = fmaf(a.w, x31, s3);
    a = *(const LAS f32x4*)(Am + 2956);
    s0 = fmaf(a.x, x32, s0);
    s1 = fmaf(a.y, x33, s1);
    s2 = fmaf(a.z, x34, s2);
    s3 = fmaf(a.w, x35, s3);
    a = *(const LAS f32x4*)(Am + 2960);
    s0 = fmaf(a.x, x36, s0);
    s1 = fmaf(a.y, x37, s1);
    s2 = fmaf(a.z, x38, s2);
    s3 = fmaf(a.w, x39, s3);
    a = *(const LAS f32x4*)(Am + 2964);
    s0 = fmaf(a.x, x40, s0);
    s1 = fmaf(a.y, x41, s1);
    const float al43 = a.z;
    x43 = (x43 - ((s0 + s1) + (s2 + s3))) - al43 * x42;
    outp[43 * rstride] = f2bf(x43);
    float x44 = sc[44] * bf2f(col[5984]);
    s0 = 0.f; s1 = 0.f; s2 = 0.f; s3 = 0.f;
    a = *(const LAS f32x4*)(Am + 2992);
    s0 = fmaf(a.x, x0, s0);
    s1 = fmaf(a.y, x1, s1);
    s2 = fmaf(a.z, x2, s2);
    s3 = fmaf(a.w, x3, s3);
    a = *(const LAS f32x4*)(Am + 2996);
    s0 = fmaf(a.x, x4, s0);
    s1 = fmaf(a.y, x5, s1);
    s2 = fmaf(a.z, x6, s2);
    s3 = fmaf(a.w, x7, s3);
    a = *(const LAS f32x4*)(Am + 3000);
    s0 = fmaf(a.x, x8, s0);
    s1 = fmaf(a.y, x9, s1);
    s2 = fmaf(a.z, x10, s2);
    s3 = fmaf(a.w, x11, s3);
    a = *(const LAS f32x4*)(Am + 3004);
    s0 = fmaf(a.x, x12, s0);
    s1 = fmaf(a.y, x13, s1);
    s2 = fmaf(a.z, x14, s2);
    s3 = fmaf(a.w, x15, s3);
    a = *(const LAS f32x4*)(Am + 3008);
    s0 = fmaf(a.x, x16, s0);
    s1 = fmaf(a.y, x17, s1);
    s2 = fmaf(a.z, x18, s2);
    s3 = fmaf(a.w, x19, s3);
    a = *(const LAS f32x4*)(Am + 3012);
    s0 = fmaf(a.x, x20, s0);
    s1 = fmaf(a.y, x21, s1);
    s2 = fmaf(a.z, x22, s2);
    s3 = fmaf(a.w, x23, s3);
    a = *(const LAS f32x4*)(Am + 3016);
    s0 = fmaf(a.x, x24, s0);
    s1 = fmaf(a.y, x25, s1);
    s2 = fmaf(a.z, x26, s2);
    s3 = fmaf(a.w, x27, s3);
    a = *(const LAS f32x4*)(Am + 3020);
    s0 = fmaf(a.x, x28, s0);
    s1 = fmaf(a.y, x29, s1);
    s2 = fmaf(a.z, x30, s2);
    s3 = fmaf(a.w, x31, s3);
    a = *(const LAS f32x4*)(Am + 3024);
    s0 = fmaf(a.x, x32, s0);
    s1 = fmaf(a.y, x33, s1);
    s2 = fmaf(a.z, x34, s2);
    s3 = fmaf(a.w, x35, s3);
    a = *(const LAS f32x4*)(Am + 3028);
    s0 = fmaf(a.x, x36, s0);
    s1 = fmaf(a.y, x37, s1);
    s2 = fmaf(a.z, x38, s2);
    s3 = fmaf(a.w, x39, s3);
    a = *(const LAS f32x4*)(Am + 3032);
    s0 = fmaf(a.x, x40, s0);
    s1 = fmaf(a.y, x41, s1);
    s2 = fmaf(a.z, x42, s2);
    const float al44 = a.w;
    x44 = (x44 - ((s0 + s1) + (s2 + s3))) - al44 * x43;
    outp[44 * rstride] = f2bf(x44);
    float x45 = sc[45] * bf2f(col[6120]);
    s0 = 0.f; s1 = 0.f; s2 = 0.f; s3 = 0.f;
    a = *(const LAS f32x4*)(Am + 3060);
    s0 = fmaf(a.x, x0, s0);
    s1 = fmaf(a.y, x1, s1);
    s2 = fmaf(a.z, x2, s2);
    s3 = fmaf(a.w, x3, s3);
    a = *(const LAS f32x4*)(Am + 3064);
    s0 = fmaf(a.x, x4, s0);
    s1 = fmaf(a.y, x5, s1);
    s2 = fmaf(a.z, x6, s2);
    s3 = fmaf(a.w, x7, s3);
    a = *(const LAS f32x4*)(Am + 3068);
    s0 = fmaf(a.x, x8, s0);
    s1 = fmaf(a.y, x9, s1);
    s2 = fmaf(a.z, x10, s2);
    s3 = fmaf(a.w, x11, s3);
    a = *(const LAS f32x4*)(Am + 3072);
    s0 = fmaf(a.x, x12, s0);
    s1 = fmaf(a.y, x13, s1);
    s2 = fmaf(a.z, x14, s2);
    s3 = fmaf(a.w, x15, s3);
    a = *(const LAS f32x4*)(Am + 3076);
    s0 = fmaf(a.x, x16, s0);
    s1 = fmaf(a.y, x17, s1);
    s2 = fmaf(a.z, x18, s2);
    s3 = fmaf(a.w, x19, s3);
    a = *(const LAS f32x4*)(Am + 3080);
    s0 = fmaf(a.x, x20, s0);
    s1 = fmaf(a.y, x21, s1);
    s2 = fmaf(a.z, x22, s2);
    s3 = fmaf(a.w, x23, s3);
    a = *(const LAS f32x4*)(Am + 3084);
    s0 = fmaf(a.x, x24, s0);
    s1 = fmaf(a.y, x25, s1);
    s2 = fmaf(a.z, x26, s2);
    s3 = fmaf(a.w, x27, s3);
    a = *(const LAS f32x4*)(Am + 3088);
    s0 = fmaf(a.x, x28, s0);
    s1 = fmaf(a.y, x29, s1);
    s2 = fmaf(a.z, x30, s2);
    s3 = fmaf(a.w, x31, s3);
    a = *(const LAS f32x4*)(Am + 3092);
    s0 = fmaf(a.x, x32, s0);
    s1 = fmaf(a.y, x33, s1);
    s2 = fmaf(a.z, x34, s2);
    s3 = fmaf(a.w, x35, s3);
    a = *(const LAS f32x4*)(Am + 3096);
    s0 = fmaf(a.x, x36, s0);
    s1 = fmaf(a.y, x37, s1);
    s2 = fmaf(a.z, x38, s2);
    s3 = fmaf(a.w, x39, s3);
    a = *(const LAS f32x4*)(Am + 3100);
    s0 = fmaf(a.x, x40, s0);
    s1 = fmaf(a.y, x41, s1);
    s2 = fmaf(a.z, x42, s2);
    s3 = fmaf(a.w, x43, s3);
    a = *(const LAS f32x4*)(Am + 3104);
    const float al45 = a.x;
    x45 = (x45 - ((s0 + s1) + (s2 + s3))) - al45 * x44;
    outp[45 * rstride] = f2bf(x45);
    float x46 = sc[46] * bf2f(col[6256]);
    s0 = 0.f; s1 = 0.f; s2 = 0.f; s3 = 0.f;
    a = *(const LAS f32x4*)(Am + 3128);
    s0 = fmaf(a.x, x0, s0);
    s1 = fmaf(a.y, x1, s1);
    s2 = fmaf(a.z, x2, s2);
    s3 = fmaf(a.w, x3, s3);
    a = *(const LAS f32x4*)(Am + 3132);
    s0 = fmaf(a.x, x4, s0);
    s1 = fmaf(a.y, x5, s1);
    s2 = fmaf(a.z, x6, s2);
    s3 = fmaf(a.w, x7, s3);
    a = *(const LAS f32x4*)(Am + 3136);
    s0 = fmaf(a.x, x8, s0);
    s1 = fmaf(a.y, x9, s1);
    s2 = fmaf(a.z, x10, s2);
    s3 = fmaf(a.w, x11, s3);
    a = *(const LAS f32x4*)(Am + 3140);
    s0 = fmaf(a.x, x12, s0);
    s1 = fmaf(a.y, x13, s1);
    s2 = fmaf(a.z, x14, s2);
    s3 = fmaf(a.w, x15, s3);
    a = *(const LAS f32x4*)(Am + 3144);
    s0 = fmaf(a.x, x16, s0);
    s1 = fmaf(a.y, x17, s1);
    s2 = fmaf(a.z, x18, s2);
    s3 = fmaf(a.w, x19, s3);
    a = *(const LAS f32x4*)(Am + 3148);
    s0 = fmaf(a.x, x20, s0);
    s1 = fmaf(a.y, x21, s1);
    s2 = fmaf(a.z, x22, s2);
    s3 = fmaf(a.w, x23, s3);
    a = *(const LAS f32x4*)(Am + 3152);
    s0 = fmaf(a.x, x24, s0);
    s1 = fmaf(a.y, x25, s1);
    s2 = fmaf(a.z, x26, s2);
    s3 = fmaf(a.w, x27, s3);
    a = *(const LAS f32x4*)(Am + 3156);
    s0 = fmaf(a.x, x28, s0);
    s1 = fmaf(a.y, x29, s1);
    s2 = fmaf(a.z, x30, s2);
    s3 = fmaf(a.w, x31, s3);
    a = *(const LAS f32x4*)(Am + 3160);
    s0 = fmaf(a.x, x32, s0);
    s1 = fmaf(a.y, x33, s1);
    s2 = fmaf(a.z, x34, s2);
    s3 = fmaf(a.w, x35, s3);
    a = *(const LAS f32x4*)(Am + 3164);
    s0 = fmaf(a.x, x36, s0);
    s1 = fmaf(a.y, x37, s1);
    s2 = fmaf(a.z, x38, s2);
    s3 = fmaf(a.w, x39, s3);
    a = *(const LAS f32x4*)(Am + 3168);
    s0 = fmaf(a.x, x40, s0);
    s1 = fmaf(a.y, x41, s1);
    s2 = fmaf(a.z, x42, s2);
    s3 = fmaf(a.w, x43, s3);
    a = *(const LAS f32x4*)(Am + 3172);
    s0 = fmaf(a.x, x44, s0);
    const float al46 = a.y;
    x46 = (x46 - ((s0 + s1) + (s2 + s3))) - al46 * x45;
    outp[46 * rstride] = f2bf(x46);
    float x47 = sc[47] * bf2f(col[6392]);
    s0 = 0.f; s1 = 0.f; s2 = 0.f; s3 = 0.f;
    a = *(const LAS f32x4*)(Am + 3196);
    s0 = fmaf(a.x, x0, s0);
    s1 = fmaf(a.y, x1, s1);
    s2 = fmaf(a.z, x2, s2);
    s3 = fmaf(a.w, x3, s3);
    a = *(const LAS f32x4*)(Am + 3200);
    s0 = fmaf(a.x, x4, s0);
    s1 = fmaf(a.y, x5, s1);
    s2 = fmaf(a.z, x6, s2);
    s3 = fmaf(a.w, x7, s3);
    a = *(const LAS f32x4*)(Am + 3204);
    s0 = fmaf(a.x, x8, s0);
    s1 = fmaf(a.y, x9, s1);
    s2 = fmaf(a.z, x10, s2);
    s3 = fmaf(a.w, x11, s3);
    a = *(const LAS f32x4*)(Am + 3208);
    s0 = fmaf(a.x, x12, s0);
    s1 = fmaf(a.y, x13, s1);
    s2 = fmaf(a.z, x14, s2);
    s3 = fmaf(a.w, x15, s3);
    a = *(const LAS f32x4*)(Am + 3212);
    s0 = fmaf(a.x, x16, s0);
    s1 = fmaf(a.y, x17, s1);
    s2 = fmaf(a.z, x18, s2);
    s3 = fmaf(a.w, x19, s3);
    a = *(const LAS f32x4*)(Am + 3216);
    s0 = fmaf(a.x, x20, s0);
    s1 = fmaf(a.y, x21, s1);
    s2 = fmaf(a.z, x22, s2);
    s3 = fmaf(a.w, x23, s3);
    a = *(const LAS f32x4*)(Am + 3220);
    s0 = fmaf(a.x, x24, s0);
    s1 = fmaf(a.y, x25, s1);
    s2 = fmaf(a.z, x26, s2);
    s3 = fmaf(a.w, x27, s3);
    a = *(const LAS f32x4*)(Am + 3224);
    s0 = fmaf(a.x, x28, s0);
    s1 = fmaf(a.y, x29, s1);
    s2 = fmaf(a.z, x30, s2);
    s3 = fmaf(a.w, x31, s3);
    a = *(const LAS f32x4*)(Am + 3228);
    s0 = fmaf(a.x, x32, s0);
    s1 = fmaf(a.y, x33, s1);
    s2 = fmaf(a.z, x34, s2);
    s3 = fmaf(a.w, x35, s3);
    a = *(const LAS f32x4*)(Am + 3232);
    s0 = fmaf(a.x, x36, s0);
    s1 = fmaf(a.y, x37, s1);
    s2 = fmaf(a.z, x38, s2);
    s3 = fmaf(a.w, x39, s3);
    a = *(const LAS f32x4*)(Am + 3236);
    s0 = fmaf(a.x, x40, s0);
    s1 = fmaf(a.y, x41, s1);
    s2 = fmaf(a.z, x42, s2);
    s3 = fmaf(a.w, x43, s3);
    a = *(const LAS f32x4*)(Am + 3240);
    s0 = fmaf(a.x, x44, s0);
    s1 = fmaf(a.y, x45, s1);
    const float al47 = a.z;
    x47 = (x47 - ((s0 + s1) + (s2 + s3))) - al47 * x46;
    outp[47 * rstride] = f2bf(x47);
    float x48 = sc[48] * bf2f(col[6528]);
    s0 = 0.f; s1 = 0.f; s2 = 0.f; s3 = 0.f;
    a = *(const LAS f32x4*)(Am + 3264);
    s0 = fmaf(a.x, x0, s0);
    s1 = fmaf(a.y, x1, s1);
    s2 = fmaf(a.z, x2, s2);
    s3 = fmaf(a.w, x3, s3);
    a = *(const LAS f32x4*)(Am + 3268);
    s0 = fmaf(a.x, x4, s0);
    s1 = fmaf(a.y, x5, s1);
    s2 = fmaf(a.z, x6, s2);
    s3 = fmaf(a.w, x7, s3);
    a = *(const LAS f32x4*)(Am + 3272);
    s0 = fmaf(a.x, x8, s0);
    s1 = fmaf(a.y, x9, s1);
    s2 = fmaf(a.z, x10, s2);
    s3 = fmaf(a.w, x11, s3);
    a = *(const LAS f32x4*)(Am + 3276);
    s0 = fmaf(a.x, x12, s0);
    s1 = fmaf(a.y, x13, s1);
    s2 = fmaf(a.z, x14, s2);
    s3 = fmaf(a.w, x15, s3);
    a = *(const LAS f32x4*)(Am + 3280);
    s0 = fmaf(a.x, x16, s0);
    s1 = fmaf(a.y, x17, s1);
    s2 = fmaf(a.z, x18, s2);
    s3 = fmaf(a.w, x19, s3);
    a = *(const LAS f32x4*)(Am + 3284);
    s0 = fmaf(a.x, x20, s0);
    s1 = fmaf(a.y, x21, s1);
    s2 = fmaf(a.z, x22, s2);
    s3 = fmaf(a.w, x23, s3);
    a = *(const LAS f32x4*)(Am + 3288);
    s0 = fmaf(a.x, x24, s0);
    s1 = fmaf(a.y, x25, s1);
    s2 = fmaf(a.z, x26, s2);
    s3 = fmaf(a.w, x27, s3);
    a = *(const LAS f32x4*)(Am + 3292);
    s0 = fmaf(a.x, x28, s0);
    s1 = fmaf(a.y, x29, s1);
    s2 = fmaf(a.z, x30, s2);
    s3 = fmaf(a.w, x31, s3);
    a = *(const LAS f32x4*)(Am + 3296);
    s0 = fmaf(a.x, x32, s0);
    s1 = fmaf(a.y, x33, s1);
    s2 = fmaf(a.z, x34, s2);
    s3 = fmaf(a.w, x35, s3);
    a = *(const LAS f32x4*)(Am + 3300);
    s0 = fmaf(a.x, x36, s0);
    s1 = fmaf(a.y, x37, s1);
    s2 = fmaf(a.z, x38, s2);
    s3 = fmaf(a.w, x39, s3);
    a = *(const LAS f32x4*)(Am + 3304);
    s0 = fmaf(a.x, x40, s0);
    s1 = fmaf(a.y, x41, s1);
    s2 = fmaf(a.z, x42, s2);
    s3 = fmaf(a.w, x43, s3);
    a = *(const LAS f32x4*)(Am + 3308);
    s0 = fmaf(a.x, x44, s0);
    s1 = fmaf(a.y, x45, s1);
    s2 = fmaf(a.z, x46, s2);
    const float al48 = a.w;
    x48 = (x48 - ((s0 + s1) + (s2 + s3))) - al48 * x47;
    outp[48 * rstride] = f2bf(x48);
    float x49 = sc[49] * bf2f(col[6664]);
    s0 = 0.f; s1 = 0.f; s2 = 0.f; s3 = 0.f;
    a = *(const LAS f32x4*)(Am + 3332);
    s0 = fmaf(a.x, x0, s0);
    s1 = fmaf(a.y, x1, s1);
    s2 = fmaf(a.z, x2, s2);
    s3 = fmaf(a.w, x3, s3);
    a = *(const LAS f32x4*)(Am + 3336);
    s0 = fmaf(a.x, x4, s0);
    s1 = fmaf(a.y, x5, s1);
    s2 = fmaf(a.z, x6, s2);
    s3 = fmaf(a.w, x7, s3);
    a = *(const LAS f32x4*)(Am + 3340);
    s0 = fmaf(a.x, x8, s0);
    s1 = fmaf(a.y, x9, s1);
    s2 = fmaf(a.z, x10, s2);
    s3 = fmaf(a.w, x11, s3);
    a = *(const LAS f32x4*)(Am + 3344);
    s0 = fmaf(a.x, x12, s0);
    s1 = fmaf(a.y, x13, s1);
    s2 = fmaf(a.z, x14, s2);
    s3 = fmaf(a.w, x15, s3);
    a = *(const LAS f32x4*)(Am + 3348);
    s0 = fmaf(a.x, x16, s0);
    s1 = fmaf(a.y, x17, s1);
    s2 = fmaf(a.z, x18, s2);
    s3 = fmaf(a.w, x19, s3);
    a = *(const LAS f32x4*)(Am + 3352);
    s0 = fmaf(a.x, x20, s0);
    s1 = fmaf(a.y, x21, s1);
    s2 = fmaf(a.z, x22, s2);
    s3 = fmaf(a.w, x23, s3);
    a = *(const LAS f32x4*)(Am + 3356);
    s0 = fmaf(a.x, x24, s0);
    s1 = fmaf(a.y, x25, s1);
    s2 = fmaf(a.z, x26, s2);
    s3 = fmaf(a.w, x27, s3);
    a = *(const LAS f32x4*)(Am + 3360);
    s0 = fmaf(a.x, x28, s0);
    s1 = fmaf(a.y, x29, s1);
    s2 = fmaf(a.z, x30, s2);
    s3 = fmaf(a.w, x31, s3);
    a = *(const LAS f32x4*)(Am + 3364);
    s0 = fmaf(a.x, x32, s0);
    s1 = fmaf(a.y, x33, s1);
    s2 = fmaf(a.z, x34, s2);
    s3 = fmaf(a.w, x35, s3);
    a = *(const LAS f32x4*)(Am + 3368);
    s0 = fmaf(a.x, x36, s0);
    s1 = fmaf(a.y, x37, s1);
    s2 = fmaf(a.z, x38, s2);
    s3 = fmaf(a.w, x39, s3);
    a = *(const LAS f32x4*)(Am + 3372);
    s0 = fmaf(a.x, x40, s0);
    s1 = fmaf(a.y, x41, s1);
    s2 = fmaf(a.z, x42, s2);
    s3 = fmaf(a.w, x43, s3);
    a = *(const LAS f32x4*)(Am + 3376);
    s0 = fmaf(a.x, x44, s0);
    s1 = fmaf(a.y, x45, s1);
    s2 = fmaf(a.z, x46, s2);
    s3 = fmaf(a.w, x47, s3);
    a = *(const LAS f32x4*)(Am + 3380);
    const float al49 = a.x;
    x49 = (x49 - ((s0 + s1) + (s2 + s3))) - al49 * x48;
    outp[49 * rstride] = f2bf(x49);
    float x50 = sc[50] * bf2f(col[6800]);
    s0 = 0.f; s1 = 0.f; s2 = 0.f; s3 = 0.f;
    a = *(const LAS f32x4*)(Am + 3400);
    s0 = fmaf(a.x, x0, s0);
    s1 = fmaf(a.y, x1, s1);
    s2 = fmaf(a.z, x2, s2);
    s3 = fmaf(a.w, x3, s3);
    a = *(const LAS f32x4*)(Am + 3404);
    s0 = fmaf(a.x, x4, s0);
    s1 = fmaf(a.y, x5, s1);
    s2 = fmaf(a.z, x6, s2);
    s3 = fmaf(a.w, x7, s3);
    a = *(const LAS f32x4*)(Am + 3408);
    s0 = fmaf(a.x, x8, s0);
    s1 = fmaf(a.y, x9, s1);
    s2 = fmaf(a.z, x10, s2);
    s3 = fmaf(a.w, x11, s3);
    a = *(const LAS f32x4*)(Am + 3412);
    s0 = fmaf(a.x, x12, s0);
    s1 = fmaf(a.y, x13, s1);
    s2 = fmaf(a.z, x14, s2);
    s3 = fmaf(a.w, x15, s3);
    a = *(const LAS f32x4*)(Am + 3416);
    s0 = fmaf(a.x, x16, s0);
    s1 = fmaf(a.y, x17, s1);
    s2 = fmaf(a.z, x18, s2);
    s3 = fmaf(a.w, x19, s3);
    a = *(const LAS f32x4*)(Am + 3420);
    s0 = fmaf(a.x, x20, s0);
    s1 = fmaf(a.y, x21, s1);
    s2 = fmaf(a.z, x22, s2);
    s3 = fmaf(a.w, x23, s3);
    a = *(const LAS f32x4*)(Am + 3424);
    s0 = fmaf(a.x, x24, s0);
    s1 = fmaf(a.y, x25, s1);
    s2 = fmaf(a.z, x26, s2);
    s3 = fmaf(a.w, x27, s3);
    a = *(const LAS f32x4*)(Am + 3428);
    s0 = fmaf(a.x, x28, s0);
    s1 = fmaf(a.y, x29, s1);
    s2 = fmaf(a.z, x30, s2);
    s3 = fmaf(a.w, x31, s3);
    a = *(const LAS f32x4*)(Am + 3432);
    s0 = fmaf(a.x, x32, s0);
    s1 = fmaf(a.y, x33, s1);
    s2 = fmaf(a.z, x34, s2);
    s3 = fmaf(a.w, x35, s3);
    a = *(const LAS f32x4*)(Am + 3436);
    s0 = fmaf(a.x, x36, s0);
    s1 = fmaf(a.y, x37, s1);
    s2 = fmaf(a.z, x38, s2);
    s3 = fmaf(a.w, x39, s3);
    a = *(const LAS f32x4*)(Am + 3440);
    s0 = fmaf(a.x, x40, s0);
    s1 = fmaf(a.y, x41, s1);
    s2 = fmaf(a.z, x42, s2);
    s3 = fmaf(a.w, x43, s3);
    a = *(const LAS f32x4*)(Am + 3444);
    s0 = fmaf(a.x, x44, s0);
    s1 = fmaf(a.y, x45, s1);
    s2 = fmaf(a.z, x46, s2);
    s3 = fmaf(a.w, x47, s3);
    a = *(const LAS f32x4*)(Am + 3448);
    s0 = fmaf(a.x, x48, s0);
    const float al50 = a.y;
    x50 = (x50 - ((s0 + s1) + (s2 + s3))) - al50 * x49;
    outp[50 * rstride] = f2bf(x50);
    float x51 = sc[51] * bf2f(col[6936]);
    s0 = 0.f; s1 = 0.f; s2 = 0.f; s3 = 0.f;
    a = *(const LAS f32x4*)(Am + 3468);
    s0 = fmaf(a.x, x0, s0);
    s1 = fmaf(a.y, x1, s1);
    s2 = fmaf(a.z, x2, s2);
    s3 = fmaf(a.w, x3, s3);
    a = *(const LAS f32x4*)(Am + 3472);
    s0 = fmaf(a.x, x4, s0);
    s1 = fmaf(a.y, x5, s1);
    s2 = fmaf(a.z, x6, s2);
    s3 = fmaf(a.w, x7, s3);
    a = *(const LAS f32x4*)(Am + 3476);
    s0 = fmaf(a.x, x8, s0);
    s1 = fmaf(a.y, x9, s1);
    s2 = fmaf(a.z, x10, s2);
    s3 = fmaf(a.w, x11, s3);
    a = *(const LAS f32x4*)(Am + 3480);
    s0 = fmaf(a.x, x12, s0);
    s1 = fmaf(a.y, x13, s1);
    s2 = fmaf(a.z, x14, s2);
    s3 = fmaf(a.w, x15, s3);
    a = *(const LAS f32x4*)(Am + 3484);
    s0 = fmaf(a.x, x16, s0);
    s1 = fmaf(a.y, x17, s1);
    s2 = fmaf(a.z, x18, s2);
    s3 = fmaf(a.w, x19, s3);
    a = *(const LAS f32x4*)(Am + 3488);
    s0 = fmaf(a.x, x20, s0);
    s1 = fmaf(a.y, x21, s1);
    s2 = fmaf(a.z, x22, s2);
    s3 = fmaf(a.w, x23, s3);
    a = *(const LAS f32x4*)(Am + 3492);
    s0 = fmaf(a.x, x24, s0);
    s1 = fmaf(a.y, x25, s1);
    s2 = fmaf(a.z, x26, s2);
    s3 = fmaf(a.w, x27, s3);
    a = *(const LAS f32x4*)(Am + 3496);
    s0 = fmaf(a.x, x28, s0);
    s1 = fmaf(a.y, x29, s1);
    s2 = fmaf(a.z, x30, s2);
    s3 = fmaf(a.w, x31, s3);
    a = *(const LAS f32x4*)(Am + 3500);
    s0 = fmaf(a.x, x32, s0);
    s1 = fmaf(a.y, x33, s1);
    s2 = fmaf(a.z, x34, s2);
    s3 = fmaf(a.w, x35, s3);
    a = *(const LAS f32x4*)(Am + 3504);
    s0 = fmaf(a.x, x36, s0);
    s1 = fmaf(a.y, x37, s1);
    s2 = fmaf(a.z, x38, s2);
    s3 = fmaf(a.w, x39, s3);
    a = *(const LAS f32x4*)(Am + 3508);
    s0 = fmaf(a.x, x40, s0);
    s1 = fmaf(a.y, x41, s1);
    s2 = fmaf(a.z, x42, s2);
    s3 = fmaf(a.w, x43, s3);
    a = *(const LAS f32x4*)(Am + 3512);
    s0 = fmaf(a.x, x44, s0);
    s1 = fmaf(a.y, x45, s1);
    s2 = fmaf(a.z, x46, s2);
    s3 = fmaf(a.w, x47, s3);
    a = *(const LAS f32x4*)(Am + 3516);
    s0 = fmaf(a.x, x48, s0);
    s1 = fmaf(a.y, x49, s1);
    const float al51 = a.z;
    x51 = (x51 - ((s0 + s1) + (s2 + s3))) - al51 * x50;
    outp[51 * rstride] = f2bf(x51);
    float x52 = sc[52] * bf2f(col[7072]);
    s0 = 0.f; s1 = 0.f; s2 = 0.f; s3 = 0.f;
    a = *(const LAS f32x4*)(Am + 3536);
    s0 = fmaf(a.x, x0, s0);
    s1 = fmaf(a.y, x1, s1);
    s2 = fmaf(a.z, x2, s2);
    s3 = fmaf(a.w, x3, s3);
    a = *(const LAS f32x4*)(Am + 3540);
    s0 = fmaf(a.x, x4, s0);
    s1 = fmaf(a.y, x5, s1);
    s2 = fmaf(a.z, x6, s2);
    s3 = fmaf(a.w, x7, s3);
    a = *(const LAS f32x4*)(Am + 3544);
    s0 = fmaf(a.x, x8, s0);
    s1 = fmaf(a.y, x9, s1);
    s2 = fmaf(a.z, x10, s2);
    s3 = fmaf(a.w, x11, s3);
    a = *(const LAS f32x4*)(Am + 3548);
    s0 = fmaf(a.x, x12, s0);
    s1 = fmaf(a.y, x13, s1);
    s2 = fmaf(a.z, x14, s2);
    s3 = fmaf(a.w, x15, s3);
    a = *(const LAS f32x4*)(Am + 3552);
    s0 = fmaf(a.x, x16, s0);
    s1 = fmaf(a.y, x17, s1);
    s2 = fmaf(a.z, x18, s2);
    s3 = fmaf(a.w, x19, s3);
    a = *(const LAS f32x4*)(Am + 3556);
    s0 = fmaf(a.x, x20, s0);
    s1 = fmaf(a.y, x21, s1);
    s2 = fmaf(a.z, x22, s2);
    s3 = fmaf(a.w, x23, s3);
    a = *(const LAS f32x4*)(Am + 3560);
    s0 = fmaf(a.x, x24, s0);
    s1 = fmaf(a.y, x25, s1);
    s2 = fmaf(a.z, x26, s2);
    s3 = fmaf(a.w, x27, s3);
    a = *(const LAS f32x4*)(Am + 3564);
    s0 = fmaf(a.x, x28, s0);
    s1 = fmaf(a.y, x29, s1);
    s2 = fmaf(a.z, x30, s2);
    s3 = fmaf(a.w, x31, s3);
    a = *(const LAS f32x4*)(Am + 3568);
    s0 = fmaf(a.x, x32, s0);
    s1 = fmaf(a.y, x33, s1);
    s2 = fmaf(a.z, x34, s2);
    s3 = fmaf(a.w, x35, s3);
    a = *(const LAS f32x4*)(Am + 3572);
    s0 = fmaf(a.x, x36, s0);
    s1 = fmaf(a.y, x37, s1);
    s2 = fmaf(a.z, x38, s2);
    s3 = fmaf(a.w, x39, s3);
    a = *(const LAS f32x4*)(Am + 3576);
    s0 = fmaf(a.x, x40, s0);
    s1 = fmaf(a.y, x41, s1);
    s2 = fmaf(a.z, x42, s2);
    s3 = fmaf(a.w, x43, s3);
    a = *(const LAS f32x4*)(Am + 3580);
    s0 = fmaf(a.x, x44, s0);
    s1 = fmaf(a.y, x45, s1);
    s2 = fmaf(a.z, x46, s2);
    s3 = fmaf(a.w, x47, s3);
    a = *(const LAS f32x4*)(Am + 3584);
    s0 = fmaf(a.x, x48, s0);
    s1 = fmaf(a.y, x49, s1);
    s2 = fmaf(a.z, x50, s2);
    const float al52 = a.w;
    x52 = (x52 - ((s0 + s1) + (s2 + s3))) - al52 * x51;
    outp[52 * rstride] = f2bf(x52);
    float x53 = sc[53] * bf2f(col[7208]);
    s0 = 0.f; s1 = 0.f; s2 = 0.f; s3 = 0.f;
    a = *(const LAS f32x4*)(Am + 3604);
    s0 = fmaf(a.x, x0, s0);
    s1 = fmaf(a.y, x1, s1);
    s2 = fmaf(a.z, x2, s2);
    s3 = fmaf(a.w, x3, s3);
    a = *(const LAS f32x4*)(Am + 3608);
    s0 = fmaf(a.x, x4, s0);
    s1 = fmaf(a.y, x5, s1);
    s2 = fmaf(a.z, x6, s2);
    s3 = fmaf(a.w, x7, s3);
    a = *(const LAS f32x4*)(Am + 3612);
    s0 = fmaf(a.x, x8, s0);
    s1 = fmaf(a.y, x9, s1);
    s2 = fmaf(a.z, x10, s2);
    s3 = fmaf(a.w, x11, s3);
    a = *(const LAS f32x4*)(Am + 3616);
    s0 = fmaf(a.x, x12, s0);
    s1 = fmaf(a.y, x13, s1);
    s2 = fmaf(a.z, x14, s2);
    s3 = fmaf(a.w, x15, s3);
    a = *(const LAS f32x4*)(Am + 3620);
    s0 = fmaf(a.x, x16, s0);
    s1 = fmaf(a.y, x17, s1);
    s2 = fmaf(a.z, x18, s2);
    s3 = fmaf(a.w, x19, s3);
    a = *(const LAS f32x4*)(Am + 3624);
    s0 = fmaf(a.x, x20, s0);
    s1 = fmaf(a.y, x21, s1);
    s2 = fmaf(a.z, x22, s2);
    s3 = fmaf(a.w, x23, s3);
    a = *(const LAS f32x4*)(Am + 3628);
    s0 = fmaf(a.x, x24, s0);
    s1 = fmaf(a.y, x25, s1);
    s2 = fmaf(a.z, x26, s2);
    s3 = fmaf(a.w, x27, s3);
    a = *(const LAS f32x4*)(Am + 3632);
    s0 = fmaf(a.x, x28, s0);
    s1 = fmaf(a.y, x29, s1);
    s2 = fmaf(a.z, x30, s2);
    s3 = fmaf(a.w, x31, s3);
    a = *(const LAS f32x4*)(Am + 3636);
    s0 = fmaf(a.x, x32, s0);
    s1 = fmaf(a.y, x33, s1);
    s2 = fmaf(a.z, x34, s2);
    s3 = fmaf(a.w, x35, s3);
    a = *(const LAS f32x4*)(Am + 3640);
    s0 = fmaf(a.x, x36, s0);
    s1 = fmaf(a.y, x37, s1);
    s2 = fmaf(a.z, x38, s2);
    s3 = fmaf(a.w, x39, s3);
    a = *(const LAS f32x4*)(Am + 3644);
    s0 = fmaf(a.x, x40, s0);
    s1 = fmaf(a.y, x41, s1);
    s2 = fmaf(a.z, x42, s2);
    s3 = fmaf(a.w, x43, s3);
    a = *(const LAS f32x4*)(Am + 3648);
    s0 = fmaf(a.x, x44, s0);
    s1 = fmaf(a.y, x45, s1);
    s2 = fmaf(a.z, x46, s2);
    s3 = fmaf(a.w, x47, s3);
    a = *(const LAS f32x4*)(Am + 3652);
    s0 = fmaf(a.x, x48, s0);
    s1 = fmaf(a.y, x49, s1);
    s2 = fmaf(a.z, x50, s2);
    s3 = fmaf(a.w, x51, s3);
    a = *(const LAS f32x4*)(Am + 3656);
    const float al53 = a.x;
    x53 = (x53 - ((s0 + s1) + (s2 + s3))) - al53 * x52;
    outp[53 * rstride] = f2bf(x53);
    float x54 = sc[54] * bf2f(col[7344]);
    s0 = 0.f; s1 = 0.f; s2 = 0.f; s3 = 0.f;
    a = *(const LAS f32x4*)(Am + 3672);
    s0 = fmaf(a.x, x0, s0);
    s1 = fmaf(a.y, x1, s1);
    s2 = fmaf(a.z, x2, s2);
    s3 = fmaf(a.w, x3, s3);
    a = *(const LAS f32x4*)(Am + 3676);
    s0 = fmaf(a.x, x4, s0);
    s1 = fmaf(a.y, x5, s1);
    s2 = fmaf(a.z, x6, s2);
    s3 = fmaf(a.w, x7, s3);
    a = *(const LAS f32x4*)(Am + 3680);
    s0 = fmaf(a.x, x8, s0);
    s1 = fmaf(a.y, x9, s1);
    s2 = fmaf(a.z, x10, s2);
    s3 = fmaf(a.w, x11, s3);
    a = *(const LAS f32x4*)(Am + 3684);
    s0 = fmaf(a.x, x12, s0);
    s1 = fmaf(a.y, x13, s1);
    s2 = fmaf(a.z, x14, s2);
    s3 = fmaf(a.w, x15, s3);
    a = *(const LAS f32x4*)(Am + 3688);
    s0 = fmaf(a.x, x16, s0);
    s1 = fmaf(a.y, x17, s1);
    s2 = fmaf(a.z, x18, s2);
    s3 = fmaf(a.w, x19, s3);
    a = *(const LAS f32x4*)(Am + 3692);
    s0 = fmaf(a.x, x20, s0);
    s1 = fmaf(a.y, x21, s1);
    s2 = fmaf(a.z, x22, s2);
    s3 = fmaf(a.w, x23, s3);
    a = *(const LAS f32x4*)(Am + 3696);
    s0 = fmaf(a.x, x24, s0);
    s1 = fmaf(a.y, x25, s1);
    s2 = fmaf(a.z, x26, s2);
    s3 = fmaf(a.w, x27, s3);
    a = *(const LAS f32x4*)(Am + 3700);
    s0 = fmaf(a.x, x28, s0);
    s1 = fmaf(a.y, x29, s1);
    s2 = fmaf(a.z, x30, s2);
    s3 = fmaf(a.w, x31, s3);
    a = *(const LAS f32x4*)(Am + 3704);
    s0 = fmaf(a.x, x32, s0);
    s1 = fmaf(a.y, x33, s1);
    s2 = fmaf(a.z, x34, s2);
    s3 = fmaf(a.w, x35, s3);
    a = *(const LAS f32x4*)(Am + 3708);
    s0 = fmaf(a.x, x36, s0);
    s1 = fmaf(a.y, x37, s1);
    s2 = fmaf(a.z, x38, s2);
    s3 = fmaf(a.w, x39, s3);
    a = *(const LAS f32x4*)(Am + 3712);
    s0 = fmaf(a.x, x40, s0);
    s1 = fmaf(a.y, x41, s1);
    s2 = fmaf(a.z, x42, s2);
    s3 = fmaf(a.w, x43, s3);
    a = *(const LAS f32x4*)(Am + 3716);
    s0 = fmaf(a.x, x44, s0);
    s1 = fmaf(a.y, x45, s1);
    s2 = fmaf(a.z, x46, s2);
    s3 = fmaf(a.w, x47, s3);
    a = *(const LAS f32x4*)(Am + 3720);
    s0 = fmaf(a.x, x48, s0);
    s1 = fmaf(a.y, x49, s1);
    s2 = fmaf(a.z, x50, s2);
    s3 = fmaf(a.w, x51, s3);
    a = *(const LAS f32x4*)(Am + 3724);
    s0 = fmaf(a.x, x52, s0);
    const float al54 = a.y;
    x54 = (x54 - ((s0 + s1) + (s2 + s3))) - al54 * x53;
    outp[54 * rstride] = f2bf(x54);
    float x55 = sc[55] * bf2f(col[7480]);
    s0 = 0.f; s1 = 0.f; s2 = 0.f; s3 = 0.f;
    a = *(const LAS f32x4*)(Am + 3740);
    s0 = fmaf(a.x, x0, s0);
    s1 = fmaf(a.y, x1, s1);
    s2 = fmaf(a.z, x2, s2);
    s3 = fmaf(a.w, x3, s3);
    a = *(const LAS f32x4*)(Am + 3744);
    s0 = fmaf(a.x, x4, s0);
    s1 = fmaf(a.y, x5, s1);
    s2 = fmaf(a.z, x6, s2);
    s3 = fmaf(a.w, x7, s3);
    a = *(const LAS f32x4*)(Am + 3748);
    s0 = fmaf(a.x, x8, s0);
    s1 = fmaf(a.y, x9, s1);
    s2 = fmaf(a.z, x10, s2);
    s3 = fmaf(a.w, x11, s3);
    a = *(const LAS f32x4*)(Am + 3752);
    s0 = fmaf(a.x, x12, s0);
    s1 = fmaf(a.y, x13, s1);
    s2 = fmaf(a.z, x14, s2);
    s3 = fmaf(a.w, x15, s3);
    a = *(const LAS f32x4*)(Am + 3756);
    s0 = fmaf(a.x, x16, s0);
    s1 = fmaf(a.y, x17, s1);
    s2 = fmaf(a.z, x18, s2);
    s3 = fmaf(a.w, x19, s3);
    a = *(const LAS f32x4*)(Am + 3760);
    s0 = fmaf(a.x, x20, s0);
    s1 = fmaf(a.y, x21, s1);
    s2 = fmaf(a.z, x22, s2);
    s3 = fmaf(a.w, x23, s3);
    a = *(const LAS f32x4*)(Am + 3764);
    s0 = fmaf(a.x, x24, s0);
    s1 = fmaf(a.y, x25, s1);
    s2 = fmaf(a.z, x26, s2);
    s3 = fmaf(a.w, x27, s3);
    a = *(const LAS f32x4*)(Am + 3768);
    s0 = fmaf(a.x, x28, s0);
    s1 = fmaf(a.y, x29, s1);
    s2 = fmaf(a.z, x30, s2);
    s3 = fmaf(a.w, x31, s3);
    a = *(const LAS f32x4*)(Am + 3772);
    s0 = fmaf(a.x, x32, s0);
    s1 = fmaf(a.y, x33, s1);
    s2 = fmaf(a.z, x34, s2);
    s3 = fmaf(a.w, x35, s3);
    a = *(const LAS f32x4*)(Am + 3776);
    s0 = fmaf(a.x, x36, s0);
    s1 = fmaf(a.y, x37, s1);
    s2 = fmaf(a.z, x38, s2);
    s3 = fmaf(a.w, x39, s3);
    a = *(const LAS f32x4*)(Am + 3780);
    s0 = fmaf(a.x, x40, s0);
    s1 = fmaf(a.y, x41, s1);
    s2 = fmaf(a.z, x42, s2);
    s3 = fmaf(a.w, x43, s3);
    a = *(const LAS f32x4*)(Am + 3784);
    s0 = fmaf(a.x, x44, s0);
    s1 = fmaf(a.y, x45, s1);
    s2 = fmaf(a.z, x46, s2);
    s3 = fmaf(a.w, x47, s3);
    a = *(const LAS f32x4*)(Am + 3788);
    s0 = fmaf(a.x, x48, s0);
    s1 = fmaf(a.y, x49, s1);
    s2 = fmaf(a.z, x50, s2);
    s3 = fmaf(a.w, x51, s3);
    a = *(const LAS f32x4*)(Am + 3792);
    s0 = fmaf(a.x, x52, s0);
    s1 = fmaf(a.y, x53, s1);
    const float al55 = a.z;
    x55 = (x55 - ((s0 + s1) + (s2 + s3))) - al55 * x54;
    outp[55 * rstride] = f2bf(x55);
    float x56 = sc[56] * bf2f(col[7616]);
    s0 = 0.f; s1 = 0.f; s2 = 0.f; s3 = 0.f;
    a = *(const LAS f32x4*)(Am + 3808);
    s0 = fmaf(a.x, x0, s0);
    s1 = fmaf(a.y, x1, s1);
    s2 = fmaf(a.z, x2, s2);
    s3 = fmaf(a.w, x3, s3);
    a = *(const LAS f32x4*)(Am + 3812);
    s0 = fmaf(a.x, x4, s0);
    s1 = fmaf(a.y, x5, s1);
    s2 = fmaf(a.z, x6, s2);
    s3 = fmaf(a.w, x7, s3);
    a = *(const LAS f32x4*)(Am + 3816);
    s0 = fmaf(a.x, x8, s0);
    s1 = fmaf(a.y, x9, s1);
    s2 = fmaf(a.z, x10, s2);
    s3 = fmaf(a.w, x11, s3);
    a = *(const LAS f32x4*)(Am + 3820);
    s0 = fmaf(a.x, x12, s0);
    s1 = fmaf(a.y, x13, s1);
    s2 = fmaf(a.z, x14, s2);
    s3 = fmaf(a.w, x15, s3);
    a = *(const LAS f32x4*)(Am + 3824);
    s0 = fmaf(a.x, x16, s0);
    s1 = fmaf(a.y, x17, s1);
    s2 = fmaf(a.z, x18, s2);
    s3 = fmaf(a.w, x19, s3);
    a = *(const LAS f32x4*)(Am + 3828);
    s0 = fmaf(a.x, x20, s0);
    s1 = fmaf(a.y, x21, s1);
    s2 = fmaf(a.z, x22, s2);
    s3 = fmaf(a.w, x23, s3);
    a = *(const LAS f32x4*)(Am + 3832);
    s0 = fmaf(a.x, x24, s0);
    s1 = fmaf(a.y, x25, s1);
    s2 = fmaf(a.z, x26, s2);
    s3 = fmaf(a.w, x27, s3);
    a = *(const LAS f32x4*)(Am + 3836);
    s0 = fmaf(a.x, x28, s0);
    s1 = fmaf(a.y, x29, s1);
    s2 = fmaf(a.z, x30, s2);
    s3 = fmaf(a.w, x31, s3);
    a = *(const LAS f32x4*)(Am + 3840);
    s0 = fmaf(a.x, x32, s0);
    s1 = fmaf(a.y, x33, s1);
    s2 = fmaf(a.z, x34, s2);
    s3 = fmaf(a.w, x35, s3);
    a = *(const LAS f32x4*)(Am + 3844);
    s0 = fmaf(a.x, x36, s0);
    s1 = fmaf(a.y, x37, s1);
    s2 = fmaf(a.z, x38, s2);
    s3 = fmaf(a.w, x39, s3);
    a = *(const LAS f32x4*)(Am + 3848);
    s0 = fmaf(a.x, x40, s0);
    s1 = fmaf(a.y, x41, s1);
    s2 = fmaf(a.z, x42, s2);
    s3 = fmaf(a.w, x43, s3);
    a = *(const LAS f32x4*)(Am + 3852);
    s0 = fmaf(a.x, x44, s0);
    s1 = fmaf(a.y, x45, s1);
    s2 = fmaf(a.z, x46, s2);
    s3 = fmaf(a.w, x47, s3);
    a = *(const LAS f32x4*)(Am + 3856);
    s0 = fmaf(a.x, x48, s0);
    s1 = fmaf(a.y, x49, s1);
    s2 = fmaf(a.z, x50, s2);
    s3 = fmaf(a.w, x51, s3);
    a = *(const LAS f32x4*)(Am + 3860);
    s0 = fmaf(a.x, x52, s0);
    s1 = fmaf(a.y, x53, s1);
    s2 = fmaf(a.z, x54, s2);
    const float al56 = a.w;
    x56 = (x56 - ((s0 + s1) + (s2 + s3))) - al56 * x55;
    outp[56 * rstride] = f2bf(x56);
    float x57 = sc[57] * bf2f(col[7752]);
    s0 = 0.f; s1 = 0.f; s2 = 0.f; s3 = 0.f;
    a = *(const LAS f32x4*)(Am + 3876);
    s0 = fmaf(a.x, x0, s0);
    s1 = fmaf(a.y, x1, s1);
    s2 = fmaf(a.z, x2, s2);
    s3 = fmaf(a.w, x3, s3);
    a = *(const LAS f32x4*)(Am + 3880);
    s0 = fmaf(a.x, x4, s0);
    s1 = fmaf(a.y, x5, s1);
    s2 = fmaf(a.z, x6, s2);
    s3 = fmaf(a.w, x7, s3);
    a = *(const LAS f32x4*)(Am + 3884);
    s0 = fmaf(a.x, x8, s0);
    s1 = fmaf(a.y, x9, s1);
    s2 = fmaf(a.z, x10, s2);
    s3 = fmaf(a.w, x11, s3);
    a = *(const LAS f32x4*)(Am + 3888);
    s0 = fmaf(a.x, x12, s0);
    s1 = fmaf(a.y, x13, s1);
    s2 = fmaf(a.z, x14, s2);
    s3 = fmaf(a.w, x15, s3);
    a = *(const LAS f32x4*)(Am + 3892);
    s0 = fmaf(a.x, x16, s0);
    s1 = fmaf(a.y, x17, s1);
    s2 = fmaf(a.z, x18, s2);
    s3 = fmaf(a.w, x19, s3);
    a = *(const LAS f32x4*)(Am + 3896);
    s0 = fmaf(a.x, x20, s0);
    s1 = fmaf(a.y, x21, s1);
    s2 = fmaf(a.z, x22, s2);
    s3 = fmaf(a.w, x23, s3);
    a = *(const LAS f32x4*)(Am + 3900);
    s0 = fmaf(a.x, x24, s0);
    s1 = fmaf(a.y, x25, s1);
    s2 = fmaf(a.z, x26, s2);
    s3 = fmaf(a.w, x27, s3);
    a = *(const LAS f32x4*)(Am + 3904);
    s0 = fmaf(a.x, x28, s0);
    s1 = fmaf(a.y, x29, s1);
    s2 = fmaf(a.z, x30, s2);
    s3 = fmaf(a.w, x31, s3);
    a = *(const LAS f32x4*)(Am + 3908);
    s0 = fmaf(a.x, x32, s0);
    s1 = fmaf(a.y, x33, s1);
    s2 = fmaf(a.z, x34, s2);
    s3 = fmaf(a.w, x35, s3);
    a = *(const LAS f32x4*)(Am + 3912);
    s0 = fmaf(a.x, x36, s0);
    s1 = fmaf(a.y, x37, s1);
    s2 = fmaf(a.z, x38, s2);
    s3 = fmaf(a.w, x39, s3);
    a = *(const LAS f32x4*)(Am + 3916);
    s0 = fmaf(a.x, x40, s0);
    s1 = fmaf(a.y, x41, s1);
    s2 = fmaf(a.z, x42, s2);
    s3 = fmaf(a.w, x43, s3);
    a = *(const LAS f32x4*)(Am + 3920);
    s0 = fmaf(a.x, x44, s0);
    s1 = fmaf(a.y, x45, s1);
    s2 = fmaf(a.z, x46, s2);
    s3 = fmaf(a.w, x47, s3);
    a = *(const LAS f32x4*)(Am + 3924);
    s0 = fmaf(a.x, x48, s0);
    s1 = fmaf(a.y, x49, s1);
    s2 = fmaf(a.z, x50, s2);
    s3 = fmaf(a.w, x51, s3);
    a = *(const LAS f32x4*)(Am + 3928);
    s0 = fmaf(a.x, x52, s0);
    s1 = fmaf(a.y, x53, s1);
    s2 = fmaf(a.z, x54, s2);
    s3 = fmaf(a.w, x55, s3);
    a = *(const LAS f32x4*)(Am + 3932);
    const float al57 = a.x;
    x57 = (x57 - ((s0 + s1) + (s2 + s3))) - al57 * x56;
    outp[57 * rstride] = f2bf(x57);
    float x58 = sc[58] * bf2f(col[7888]);
    s0 = 0.f; s1 = 0.f; s2 = 0.f; s3 = 0.f;
    a = *(const LAS f32x4*)(Am + 3944);
    s0 = fmaf(a.x, x0, s0);
    s1 = fmaf(a.y, x1, s1);
    s2 = fmaf(a.z, x2, s2);
    s3 = fmaf(a.w, x3, s3);
    a = *(const LAS f32x4*)(Am + 3948);
    s0 = fmaf(a.x, x4, s0);
    s1 = fmaf(a.y, x5, s1);
    s2 = fmaf(a.z, x6, s2);
    s3 = fmaf(a.w, x7, s3);
    a = *(const LAS f32x4*)(Am + 3952);
    s0 = fmaf(a.x, x8, s0);
    s1 = fmaf(a.y, x9, s1);
    s2 = fmaf(a.z, x10, s2);
    s3 = fmaf(a.w, x11, s3);
    a = *(const LAS f32x4*)(Am + 3956);
    s0 = fmaf(a.x, x12, s0);
    s1 = fmaf(a.y, x13, s1);
    s2 = fmaf(a.z, x14, s2);
    s3 = fmaf(a.w, x15, s3);
    a = *(const LAS f32x4*)(Am + 3960);
    s0 = fmaf(a.x, x16, s0);
    s1 = fmaf(a.y, x17, s1);
    s2 = fmaf(a.z, x18, s2);
    s3 = fmaf(a.w, x19, s3);
    a = *(const LAS f32x4*)(Am + 3964);
    s0 = fmaf(a.x, x20, s0);
    s1 = fmaf(a.y, x21, s1);
    s2 = fmaf(a.z, x22, s2);
    s3 = fmaf(a.w, x23, s3);
    a = *(const LAS f32x4*)(Am + 3968);
    s0 = fmaf(a.x, x24, s0);
    s1 = fmaf(a.y, x25, s1);
    s2 = fmaf(a.z, x26, s2);
    s3 = fmaf(a.w, x27, s3);
    a = *(const LAS f32x4*)(Am + 3972);
    s0 = fmaf(a.x, x28, s0);
    s1 = fmaf(a.y, x29, s1);
    s2 = fmaf(a.z, x30, s2);
    s3 = fmaf(a.w, x31, s3);
    a = *(const LAS f32x4*)(Am + 3976);
    s0 = fmaf(a.x, x32, s0);
    s1 = fmaf(a.y, x33, s1);
    s2 = fmaf(a.z, x34, s2);
    s3 = fmaf(a.w, x35, s3);
    a = *(const LAS f32x4*)(Am + 3980);
    s0 = fmaf(a.x, x36, s0);
    s1 = fmaf(a.y, x37, s1);
    s2 = fmaf(a.z, x38, s2);
    s3 = fmaf(a.w, x39, s3);
    a = *(const LAS f32x4*)(Am + 3984);
    s0 = fmaf(a.x, x40, s0);
    s1 = fmaf(a.y, x41, s1);
    s2 = fmaf(a.z, x42, s2);
    s3 = fmaf(a.w, x43, s3);
    a = *(const LAS f32x4*)(Am + 3988);
    s0 = fmaf(a.x, x44, s0);
    s1 = fmaf(a.y, x45, s1);
    s2 = fmaf(a.z, x46, s2);
    s3 = fmaf(a.w, x47, s3);
    a = *(const LAS f32x4*)(Am + 3992);
    s0 = fmaf(a.x, x48, s0);
    s1 = fmaf(a.y, x49, s1);
    s2 = fmaf(a.z, x50, s2);
    s3 = fmaf(a.w, x51, s3);
    a = *(const LAS f32x4*)(Am + 3996);
    s0 = fmaf(a.x, x52, s0);
    s1 = fmaf(a.y, x53, s1);
    s2 = fmaf(a.z, x54, s2);
    s3 = fmaf(a.w, x55, s3);
    a = *(const LAS f32x4*)(Am + 4000);
    s0 = fmaf(a.x, x56, s0);
    const float al58 = a.y;
    x58 = (x58 - ((s0 + s1) + (s2 + s3))) - al58 * x57;
    outp[58 * rstride] = f2bf(x58);
    float x59 = sc[59] * bf2f(col[8024]);
    s0 = 0.f; s1 = 0.f; s2 = 0.f; s3 = 0.f;
    a = *(const LAS f32x4*)(Am + 4012);
    s0 = fmaf(a.x, x0, s0);
    s1 = fmaf(a.y, x1, s1);
    s2 = fmaf(a.z, x2, s2);
    s3 = fmaf(a.w, x3, s3);
    a = *(const LAS f32x4*)(Am + 4016);
    s0 = fmaf(a.x, x4, s0);
    s1 = fmaf(a.y, x5, s1);
    s2 = fmaf(a.z, x6, s2);
    s3 = fmaf(a.w, x7, s3);
    a = *(const LAS f32x4*)(Am + 4020);
    s0 = fmaf(a.x, x8, s0);
    s1 = fmaf(a.y, x9, s1);
    s2 = fmaf(a.z, x10, s2);
    s3 = fmaf(a.w, x11, s3);
    a = *(const LAS f32x4*)(Am + 4024);
    s0 = fmaf(a.x, x12, s0);
    s1 = fmaf(a.y, x13, s1);
    s2 = fmaf(a.z, x14, s2);
    s3 = fmaf(a.w, x15, s3);
    a = *(const LAS f32x4*)(Am + 4028);
    s0 = fmaf(a.x, x16, s0);
    s1 = fmaf(a.y, x17, s1);
    s2 = fmaf(a.z, x18, s2);
    s3 = fmaf(a.w, x19, s3);
    a = *(const LAS f32x4*)(Am + 4032);
    s0 = fmaf(a.x, x20, s0);
    s1 = fmaf(a.y, x21, s1);
    s2 = fmaf(a.z, x22, s2);
    s3 = fmaf(a.w, x23, s3);
    a = *(const LAS f32x4*)(Am + 4036);
    s0 = fmaf(a.x, x24, s0);
    s1 = fmaf(a.y, x25, s1);
    s2 = fmaf(a.z, x26, s2);
    s3 = fmaf(a.w, x27, s3);
    a = *(const LAS f32x4*)(Am + 4040);
    s0 = fmaf(a.x, x28, s0);
    s1 = fmaf(a.y, x29, s1);
    s2 = fmaf(a.z, x30, s2);
    s3 = fmaf(a.w, x31, s3);
    a = *(const LAS f32x4*)(Am + 4044);
    s0 = fmaf(a.x, x32, s0);
    s1 = fmaf(a.y, x33, s1);
    s2 = fmaf(a.z, x34, s2);
    s3 = fmaf(a.w, x35, s3);
    a = *(const LAS f32x4*)(Am + 4048);
    s0 = fmaf(a.x, x36, s0);
    s1 = fmaf(a.y, x37, s1);
    s2 = fmaf(a.z, x38, s2);
    s3 = fmaf(a.w, x39, s3);
    a = *(const LAS f32x4*)(Am + 4052);
    s0 = fmaf(a.x, x40, s0);
    s1 = fmaf(a.y, x41, s1);
    s2 = fmaf(a.z, x42, s2);
    s3 = fmaf(a.w, x43, s3);
    a = *(const LAS f32x4*)(Am + 4056);
    s0 = fmaf(a.x, x44, s0);
    s1 = fmaf(a.y, x45, s1);
    s2 = fmaf(a.z, x46, s2);
    s3 = fmaf(a.w, x47, s3);
    a = *(const LAS f32x4*)(Am + 4060);
    s0 = fmaf(a.x, x48, s0);
    s1 = fmaf(a.y, x49, s1);
    s2 = fmaf(a.z, x50, s2);
    s3 = fmaf(a.w, x51, s3);
    a = *(const LAS f32x4*)(Am + 4064);
    s0 = fmaf(a.x, x52, s0);
    s1 = fmaf(a.y, x53, s1);
    s2 = fmaf(a.z, x54, s2);
    s3 = fmaf(a.w, x55, s3);
    a = *(const LAS f32x4*)(Am + 4068);
    s0 = fmaf(a.x, x56, s0);
    s1 = fmaf(a.y, x57, s1);
    const float al59 = a.z;
    x59 = (x59 - ((s0 + s1) + (s2 + s3))) - al59 * x58;
    outp[59 * rstride] = f2bf(x59);
    float x60 = sc[60] * bf2f(col[8160]);
    s0 = 0.f; s1 = 0.f; s2 = 0.f; s3 = 0.f;
    a = *(const LAS f32x4*)(Am + 4080);
    s0 = fmaf(a.x, x0, s0);
    s1 = fmaf(a.y, x1, s1);
    s2 = fmaf(a.z, x2, s2);
    s3 = fmaf(a.w, x3, s3);
    a = *(const LAS f32x4*)(Am + 4084);
    s0 = fmaf(a.x, x4, s0);
    s1 = fmaf(a.y, x5, s1);
    s2 = fmaf(a.z, x6, s2);
    s3 = fmaf(a.w, x7, s3);
    a = *(const LAS f32x4*)(Am + 4088);
    s0 = fmaf(a.x, x8, s0);
    s1 = fmaf(a.y, x9, s1);
    s2 = fmaf(a.z, x10, s2);
    s3 = fmaf(a.w, x11, s3);
    a = *(const LAS f32x4*)(Am + 4092);
    s0 = fmaf(a.x, x12, s0);
    s1 = fmaf(a.y, x13, s1);
    s2 = fmaf(a.z, x14, s2);
    s3 = fmaf(a.w, x15, s3);
    a = *(const LAS f32x4*)(Am + 4096);
    s0 = fmaf(a.x, x16, s0);
    s1 = fmaf(a.y, x17, s1);
    s2 = fmaf(a.z, x18, s2);
    s3 = fmaf(a.w, x19, s3);
    a = *(const LAS f32x4*)(Am + 4100);
    s0 = fmaf(a.x, x20, s0);
    s1 = fmaf(a.y, x21, s1);
    s2 = fmaf(a.z, x22, s2);
    s3 = fmaf(a.w, x23, s3);
    a = *(const LAS f32x4*)(Am + 4104);
    s0 = fmaf(a.x, x24, s0);
    s1 = fmaf(a.y, x25, s1);
    s2 = fmaf(a.z, x26, s2);
    s3 = fmaf(a.w, x27, s3);
    a = *(const LAS f32x4*)(Am + 4108);
    s0 = fmaf(a.x, x28, s0);
    s1 = fmaf(a.y, x29, s1);
    s2 = fmaf(a.z, x30, s2);
    s3 = fmaf(a.w, x31, s3);
    a = *(const LAS f32x4*)(Am + 4112);
    s0 = fmaf(a.x, x32, s0);
    s1 = fmaf(a.y, x33, s1);
    s2 = fmaf(a.z, x34, s2);
    s3 = fmaf(a.w, x35, s3);
    a = *(const LAS f32x4*)(Am + 4116);
    s0 = fmaf(a.x, x36, s0);
    s1 = fmaf(a.y, x37, s1);
    s2 = fmaf(a.z, x38, s2);
    s3 = fmaf(a.w, x39, s3);
    a = *(const LAS f32x4*)(Am + 4120);
    s0 = fmaf(a.x, x40, s0);
    s1 = fmaf(a.y, x41, s1);
    s2 = fmaf(a.z, x42, s2);
    s3 = fmaf(a.w, x43, s3);
    a = *(const LAS f32x4*)(Am + 4124);
    s0 = fmaf(a.x, x44, s0);
    s1 = fmaf(a.y, x45, s1);
    s2 = fmaf(a.z, x46, s2);
    s3 = fmaf(a.w, x47, s3);
    a = *(const LAS f32x4*)(Am + 4128);
    s0 = fmaf(a.x, x48, s0);
    s1 = fmaf(a.y, x49, s1);
    s2 = fmaf(a.z, x50, s2);
    s3 = fmaf(a.w, x51, s3);
    a = *(const LAS f32x4*)(Am + 4132);
    s0 = fmaf(a.x, x52, s0);
    s1 = fmaf(a.y, x53, s1);
    s2 = fmaf(a.z, x54, s2);
    s3 = fmaf(a.w, x55, s3);
    a = *(const LAS f32x4*)(Am + 4136);
    s0 = fmaf(a.x, x56, s0);
    s1 = fmaf(a.y, x57, s1);
    s2 = fmaf(a.z, x58, s2);
    const float al60 = a.w;
    x60 = (x60 - ((s0 + s1) + (s2 + s3))) - al60 * x59;
    outp[60 * rstride] = f2bf(x60);
    float x61 = sc[61] * bf2f(col[8296]);
    s0 = 0.f; s1 = 0.f; s2 = 0.f; s3 = 0.f;
    a = *(const LAS f32x4*)(Am + 4148);
    s0 = fmaf(a.x, x0, s0);
    s1 = fmaf(a.y, x1, s1);
    s2 = fmaf(a.z, x2, s2);
    s3 = fmaf(a.w, x3, s3);
    a = *(const LAS f32x4*)(Am + 4152);
    s0 = fmaf(a.x, x4, s0);
    s1 = fmaf(a.y, x5, s1);
    s2 = fmaf(a.z, x6, s2);
    s3 = fmaf(a.w, x7, s3);
    a = *(const LAS f32x4*)(Am + 4156);
    s0 = fmaf(a.x, x8, s0);
    s1 = fmaf(a.y, x9, s1);
    s2 = fmaf(a.z, x10, s2);
    s3 = fmaf(a.w, x11, s3);
    a = *(const LAS f32x4*)(Am + 4160);
    s0 = fmaf(a.x, x12, s0);
    s1 = fmaf(a.y, x13, s1);
    s2 = fmaf(a.z, x14, s2);
    s3 = fmaf(a.w, x15, s3);
    a = *(const LAS f32x4*)(Am + 4164);
    s0 = fmaf(a.x, x16, s0);
    s1 = fmaf(a.y, x17, s1);
    s2 = fmaf(a.z, x18, s2);
    s3 = fmaf(a.w, x19, s3);
    a = *(const LAS f32x4*)(Am + 4168);
    s0 = fmaf(a.x, x20, s0);
    s1 = fmaf(a.y, x21, s1);
    s2 = fmaf(a.z, x22, s2);
    s3 = fmaf(a.w, x23, s3);
    a = *(const LAS f32x4*)(Am + 4172);
    s0 = fmaf(a.x, x24, s0);
    s1 = fmaf(a.y, x25, s1);
    s2 = fmaf(a.z, x26, s2);
    s3 = fmaf(a.w, x27, s3);
    a = *(const LAS f32x4*)(Am + 4176);
    s0 = fmaf(a.x, x28, s0);
    s1 = fmaf(a.y, x29, s1);
    s2 = fmaf(a.z, x30, s2);
    s3 = fmaf(a.w, x31, s3);
    a = *(const LAS f32x4*)(Am + 4180);
    s0 = fmaf(a.x, x32, s0);
    s1 = fmaf(a.y, x33, s1);
    s2 = fmaf(a.z, x34, s2);
    s3 = fmaf(a.w, x35, s3);
    a = *(const LAS f32x4*)(Am + 4184);
    s0 = fmaf(a.x, x36, s0);
    s1 = fmaf(a.y, x37, s1);
    s2 = fmaf(a.z, x38, s2);
    s3 = fmaf(a.w, x39, s3);
    a = *(const LAS f32x4*)(Am + 4188);
    s0 = fmaf(a.x, x40, s0);
    s1 = fmaf(a.y, x41, s1);
    s2 = fmaf(a.z, x42, s2);
    s3 = fmaf(a.w, x43, s3);
    a = *(const LAS f32x4*)(Am + 4192);
    s0 = fmaf(a.x, x44, s0);
    s1 = fmaf(a.y, x45, s1);
    s2 = fmaf(a.z, x46, s2);
    s3 = fmaf(a.w, x47, s3);
    a = *(const LAS f32x4*)(Am + 4196);
    s0 = fmaf(a.x, x48, s0);
    s1 = fmaf(a.y, x49, s1);
    s2 = fmaf(a.z, x50, s2);
    s3 = fmaf(a.w, x51, s3);
    a = *(const LAS f32x4*)(Am + 4200);
    s0 = fmaf(a.x, x52, s0);
    s1 = fmaf(a.y, x53, s1);
    s2 = fmaf(a.z, x54, s2);
    s3 = fmaf(a.w, x55, s3);
    a = *(const LAS f32x4*)(Am + 4204);
    s0 = fmaf(a.x, x56, s0);
    s1 = fmaf(a.y, x57, s1);
    s2 = fmaf(a.z, x58, s2);
    s3 = fmaf(a.w, x59, s3);
    a = *(const LAS f32x4*)(Am + 4208);
    const float al61 = a.x;
    x61 = (x61 - ((s0 + s1) + (s2 + s3))) - al61 * x60;
    outp[61 * rstride] = f2bf(x61);
    float x62 = sc[62] * bf2f(col[8432]);
    s0 = 0.f; s1 = 0.f; s2 = 0.f; s3 = 0.f;
    a = *(const LAS f32x4*)(Am + 4216);
    s0 = fmaf(a.x, x0, s0);
    s1 = fmaf(a.y, x1, s1);
    s2 = fmaf(a.z, x2, s2);
    s3 = fmaf(a.w, x3, s3);
    a = *(const LAS f32x4*)(Am + 4220);
    s0 = fmaf(a.x, x4, s0);
    s1 = fmaf(a.y, x5, s1);
    s2 = fmaf(a.z, x6, s2);
    s3 = fmaf(a.w, x7, s3);
    a = *(const LAS f32x4*)(Am + 4224);
    s0 = fmaf(a.x, x8, s0);
    s1 = fmaf(a.y, x9, s1);
    s2 = fmaf(a.z, x10, s2);
    s3 = fmaf(a.w, x11, s3);
    a = *(const LAS f32x4*)(Am + 4228);
    s0 = fmaf(a.x, x12, s0);
    s1 = fmaf(a.y, x13, s1);
    s2 = fmaf(a.z, x14, s2);
    s3 = fmaf(a.w, x15, s3);
    a = *(const LAS f32x4*)(Am + 4232);
    s0 = fmaf(a.x, x16, s0);
    s1 = fmaf(a.y, x17, s1);
    s2 = fmaf(a.z, x18, s2);
    s3 = fmaf(a.w, x19, s3);
    a = *(const LAS f32x4*)(Am + 4236);
    s0 = fmaf(a.x, x20, s0);
    s1 = fmaf(a.y, x21, s1);
    s2 = fmaf(a.z, x22, s2);
    s3 = fmaf(a.w, x23, s3);
    a = *(const LAS f32x4*)(Am + 4240);
    s0 = fmaf(a.x, x24, s0);
    s1 = fmaf(a.y, x25, s1);
    s2 = fmaf(a.z, x26, s2);
    s3 = fmaf(a.w, x27, s3);
    a = *(const LAS f32x4*)(Am + 4244);
    s0 = fmaf(a.x, x28, s0);
    s1 = fmaf(a.y, x29, s1);
    s2 = fmaf(a.z, x30, s2);
    s3 = fmaf(a.w, x31, s3);
    a = *(const LAS f32x4*)(Am + 4248);
    s0 = fmaf(a.x, x32, s0);
    s1 = fmaf(a.y, x33, s1);
    s2 = fmaf(a.z, x34, s2);
    s3 = fmaf(a.w, x35, s3);
    a = *(const LAS f32x4*)(Am + 4252);
    s0 = fmaf(a.x, x36, s0);
    s1 = fmaf(a.y, x37, s1);
    s2 = fmaf(a.z, x38, s2);
    s3 = fmaf(a.w, x39, s3);
    a = *(const LAS f32x4*)(Am + 4256);
    s0 = fmaf(a.x, x40, s0);
    s1 = fmaf(a.y, x41, s1);
    s2 = fmaf(a.z, x42, s2);
    s3 = fmaf(a.w, x43, s3);
    a = *(const LAS f32x4*)(Am + 4260);
    s0 = fmaf(a.x, x44, s0);
    s1 = fmaf(a.y, x45, s1);
    s2 = fmaf(a.z, x46, s2);
    s3 = fmaf(a.w, x47, s3);
    a = *(const LAS f32x4*)(Am + 4264);
    s0 = fmaf(a.x, x48, s0);
    s1 = fmaf(a.y, x49, s1);
    s2 = fmaf(a.z, x50, s2);
    s3 = fmaf(a.w, x51, s3);
    a = *(const LAS f32x4*)(Am + 4268);
    s0 = fmaf(a.x, x52, s0);
    s1 = fmaf(a.y, x53, s1);
    s2 = fmaf(a.z, x54, s2);
    s3 = fmaf(a.w, x55, s3);
    a = *(const LAS f32x4*)(Am + 4272);
    s0 = fmaf(a.x, x56, s0);
    s1 = fmaf(a.y, x57, s1);
    s2 = fmaf(a.z, x58, s2);
    s3 = fmaf(a.w, x59, s3);
    a = *(const LAS f32x4*)(Am + 4276);
    s0 = fmaf(a.x, x60, s0);
    const float al62 = a.y;
    x62 = (x62 - ((s0 + s1) + (s2 + s3))) - al62 * x61;
    outp[62 * rstride] = f2bf(x62);
    float x63 = sc[63] * bf2f(col[8568]);
    s0 = 0.f; s1 = 0.f; s2 = 0.f; s3 = 0.f;
    a = *(const LAS f32x4*)(Am + 4284);
    s0 = fmaf(a.x, x0, s0);
    s1 = fmaf(a.y, x1, s1);
    s2 = fmaf(a.z, x2, s2);
    s3 = fmaf(a.w, x3, s3);
    a = *(const LAS f32x4*)(Am + 4288);
    s0 = fmaf(a.x, x4, s0);
    s1 = fmaf(a.y, x5, s1);
    s2 = fmaf(a.z, x6, s2);
    s3 = fmaf(a.w, x7, s3);
    a = *(const LAS f32x4*)(Am + 4292);
    s0 = fmaf(a.x, x8, s0);
    s1 = fmaf(a.y, x9, s1);
    s2 = fmaf(a.z, x10, s2);
    s3 = fmaf(a.w, x11, s3);
    a = *(const LAS f32x4*)(Am + 4296);
    s0 = fmaf(a.x, x12, s0);
    s1 = fmaf(a.y, x13, s1);
    s2 = fmaf(a.z, x14, s2);
    s3 = fmaf(a.w, x15, s3);
    a = *(const LAS f32x4*)(Am + 4300);
    s0 = fmaf(a.x, x16, s0);
    s1 = fmaf(a.y, x17, s1);
    s2 = fmaf(a.z, x18, s2);
    s3 = fmaf(a.w, x19, s3);
    a = *(const LAS f32x4*)(Am + 4304);
    s0 = fmaf(a.x, x20, s0);
    s1 = fmaf(a.y, x21, s1);
    s2 = fmaf(a.z, x22, s2);
    s3 = fmaf(a.w, x23, s3);
    a = *(const LAS f32x4*)(Am + 4308);
    s0 = fmaf(a.x, x24, s0);
    s1 = fmaf(a.y, x25, s1);
    s2 = fmaf(a.z, x26, s2);
    s3 = fmaf(a.w, x27, s3);
    a = *(const LAS f32x4*)(Am + 4312);
    s0 = fmaf(a.x, x28, s0);
    s1 = fmaf(a.y, x29, s1);
    s2 = fmaf(a.z, x30, s2);
    s3 = fmaf(a.w, x31, s3);
    a = *(const LAS f32x4*)(Am + 4316);
    s0 = fmaf(a.x, x32, s0);
    s1 = fmaf(a.y, x33, s1);
    s2 = fmaf(a.z, x34, s2);
    s3 = fmaf(a.w, x35, s3);
    a = *(const LAS f32x4*)(Am + 4320);
    s0 = fmaf(a.x, x36, s0);
    s1 = fmaf(a.y, x37, s1);
    s2 = fmaf(a.z, x38, s2);
    s3 = fmaf(a.w, x39, s3);
    a = *(const LAS f32x4*)(Am + 4324);
    s0 = fmaf(a.x, x40, s0);
    s1 = fmaf(a.y, x41, s1);
    s2 = fmaf(a.z, x42, s2);
    s3 = fmaf(a.w, x43, s3);
    a = *(const LAS f32x4*)(Am + 4328);
    s0 = fmaf(a.x, x44, s0);
    s1 = fmaf(a.y, x45, s1);
    s2 = fmaf(a.z, x46, s2);
    s3 = fmaf(a.w, x47, s3);
    a = *(const LAS f32x4*)(Am + 4332);
    s0 = fmaf(a.x, x48, s0);
    s1 = fmaf(a.y, x49, s1);
    s2 = fmaf(a.z, x50, s2);
    s3 = fmaf(a.w, x51, s3);
    a = *(const LAS f32x4*)(Am + 4336);
    s0 = fmaf(a.x, x52, s0);
    s1 = fmaf(a.y, x53, s1);
    s2 = fmaf(a.z, x54, s2);
    s3 = fmaf(a.w, x55, s3);
    a = *(const LAS f32x4*)(Am + 4340);
    s0 = fmaf(a.x, x56, s0);
    s1 = fmaf(a.y, x57, s1);
    s2 = fmaf(a.z, x58, s2);
    s3 = fmaf(a.w, x59, s3);
    a = *(const LAS f32x4*)(Am + 4344);
    s0 = fmaf(a.x, x60, s0);
    s1 = fmaf(a.y, x61, s1);
    const float al63 = a.z;
    x63 = (x63 - ((s0 + s1) + (s2 + s3))) - al63 * x62;
    outp[63 * rstride] = f2bf(x63);
}
typedef short bf16x8_t __attribute__((ext_vector_type(8)));
template <int K> __device__ __forceinline__ f32x4 mma_tile(const LAS unsigned short* A, int lda, const LAS unsigned short* Bt, int ldb, f32x4 acc) {
    const int lane = threadIdx.x & 63, r = lane & 15, q = lane >> 4;
#pragma unroll
    for (int ks = 0; ks < K / 32; ++ks) {
        const bf16x8_t a = *(const LAS bf16x8_t*)(A + r * lda + ks * 32 + q * 8);
        const bf16x8_t b = *(const LAS bf16x8_t*)(Bt + r * ldb + ks * 32 + q * 8);
        acc = __builtin_amdgcn_mfma_f32_16x16x32_bf16(a, b, acc, 0, 0, 0);
    }
    return acc;
}

typedef unsigned short u16x4_t __attribute__((ext_vector_type(4)));
__device__ __forceinline__ void tr_frag2(unsigned base_addr, int pitch, int c, bf16x8_t& f0, bf16x8_t& f1) {
    const int lane = threadIdx.x & 63, g = lane >> 4, qq = (lane & 15) >> 2, pp = lane & 3;
    const unsigned a00 = base_addr + (unsigned)((8 * g + qq) * pitch + 32 * c + 8 * pp);
    const unsigned a01 = a00 + 4u * (unsigned)pitch, a10 = a00 + 32u * (unsigned)pitch, a11 = a10 + 4u * (unsigned)pitch;
    u16x4_t r00, r01, r10, r11;
    asm volatile("ds_read_b64_tr_b16 %0, %4\n\tds_read_b64_tr_b16 %1, %5\n\tds_read_b64_tr_b16 %2, %6\n\tds_read_b64_tr_b16 %3, %7\n\ts_waitcnt lgkmcnt(0)"
                 : "=&v"(r00), "=&v"(r01), "=&v"(r10), "=&v"(r11) : "v"(a00), "v"(a01), "v"(a10), "v"(a11) : "memory");
    f0 = (bf16x8_t){(short)r00.x, (short)r00.y, (short)r00.z, (short)r00.w, (short)r01.x, (short)r01.y, (short)r01.z, (short)r01.w};
    f1 = (bf16x8_t){(short)r10.x, (short)r10.y, (short)r10.z, (short)r10.w, (short)r11.x, (short)r11.y, (short)r11.z, (short)r11.w};
}
constexpr size_t WS_G = 235 * MiB;

__device__ __forceinline__ void delta_prep(LDSp lds, const Params& p) {
    const bf16_t* QKVN = (const bf16_t*)(p.ws + WS_QKV); const float* BETA = (const float*)(p.ws + WS_BETA); const float* LA = (const float*)(p.ws + WS_LA);
    bf16_t* Z = (bf16_t*)(p.ws + WS_Z); float* GB = (float*)(p.ws + WS_G);
    LAS unsigned short* Qb = (LAS unsigned short*)lds;
    LAS unsigned short* Kb = (LAS unsigned short*)(lds + 17408);
    LAS unsigned short* Vb = (LAS unsigned short*)(lds + 34816);
    LAS float* Am = (LAS float*)(lds + 52224);
    LAS float* gl = (LAS float*)(lds + 69632);
    LAS float* be = gl + 64;
    LAS float* beg = gl + 128;
    LAS float* la = gl + 192;
    const int tid = threadIdx.x, lane = tid & 63, wid = tid >> 6, r = lane & 15, q = lane >> 4;
    u32x4 pre[6]; float pla = 0.f, pbe = 0.f;
#define DP_LOAD(u_) do { const int dir_ = (u_) >> 10, b_ = ((u_) >> 8) & 3, h_ = ((u_) >> 6) & 3, n_ = (u_) & 63; \
        const long tk0_ = (long)b_ * S_ + (dir_ ? (S_ - 1 - n_ * 64) : n_ * 64); const long ts_ = dir_ ? -1 : 1; \
        _Pragma("unroll") for (int i = 0; i < 6; ++i) { const int pi = tid + NTHR * i, which = pi >> 10, l = (pi >> 4) & 63, c8 = pi & 15; \
            pre[i] = *(const u32x4*)(QKVN + (tk0_ + l * ts_) * 1536 + which * 512 + h_ * 128 + c8 * 8); } \
        if (tid < 64) { const long tk = tk0_ + tid * ts_; pla = LA[tk * 8 + dir_ * 4 + h_]; pbe = BETA[tk * 8 + dir_ * 4 + h_]; } } while (0)
    for (int unit = blockIdx.x; unit < 2048; unit += gridDim.x) {
        const int dir = unit >> 10, b = (unit >> 8) & 3, h = (unit >> 6) & 3, n = unit & 63;
        const long tok0 = (long)b * S_ + (dir ? (S_ - 1 - n * 64) : n * 64); const long tstep = dir ? -1 : 1;
        if (unit == (int)blockIdx.x) { DP_LOAD(unit); }
#pragma unroll
        for (int i = 0; i < 6; ++i) { const int pi = tid + NTHR * i, which = pi >> 10, l = (pi >> 4) & 63, c8 = pi & 15; *(LAS u32x4*)(lds + which * 17408 + l * 272 + c8 * 16) = pre[i]; }
        if (tid < 64) { la[tid] = pla; be[tid] = pbe; }
        __syncthreads();
        if (tid < 64) { float g = 0.f; for (int j = 0; j <= tid; ++j) g += la[j]; gl[tid] = g; beg[tid] = be[tid] * __expf(g); GB[((size_t)dir * T_ + (tok0 + tid * tstep)) * 4 + h] = g; }
        __syncthreads();
#pragma unroll
        for (int tt = 0; tt < 2; ++tt) { const int idx = wid * 2 + tt, mt = idx >> 2, nt = idx & 3;
            f32x4 kk = {0.f, 0.f, 0.f, 0.f}, qk = {0.f, 0.f, 0.f, 0.f};
            if (mt >= nt) { kk = mma_tile<128>(Kb + mt * 16 * 136, 136, Kb + nt * 16 * 136, 136, kk); qk = mma_tile<128>(Qb + mt * 16 * 136, 136, Kb + nt * 16 * 136, 136, qk); }
            const int j = nt * 16 + r; const float gj = gl[j];
#pragma unroll
            for (int i4 = 0; i4 < 4; ++i4) { const int i = mt * 16 + q * 4 + i4; const float dec = (i >= j) ? __expf(gl[i] - gj) : 0.f;
                Am[i * 68 + j] = (i > j) ? be[i] * kk[i4] * dec : 0.f;
                Z[(tok0 + i * tstep) * 3072 + 2048 + dir * 256 + h * 64 + j] = f2bf(qk[i4] * dec); }
        }
        __syncthreads();
        if (unit + (int)gridDim.x < 2048) { DP_LOAD(unit + (int)gridDim.x); }
        if (tid < 256) { const int c = tid;
            tri_solve64(Am, c < 128 ? Vb + c : Kb + (c - 128), c < 128 ? be : beg, Z + tok0 * 3072 + (c < 128 ? 0 : 1024) + dir * 512 + h * 128 + (c & 127), tstep * 3072); }
        __syncthreads();
    }
}

__device__ __forceinline__ void delta_scan2(LDSp lds, const Params& p) {
    const bf16_t* QKVN = (const bf16_t*)(p.ws + WS_QKV); const bf16_t* Z = (const bf16_t*)(p.ws + WS_Z); const float* GB = (const float*)(p.ws + WS_G);
    LAS unsigned short* Wb  = (LAS unsigned short*)lds;
    LAS unsigned short* Qg  = (LAS unsigned short*)(lds + 17408);
    LAS unsigned short* Kg  = (LAS unsigned short*)(lds + 34816);
    LAS unsigned short* At  = (LAS unsigned short*)(lds + 53248);
    LAS unsigned short* Ub  = (LAS unsigned short*)(lds + 62464);
    LAS unsigned short* St  = (LAS unsigned short*)(lds + 66560);
    LAS unsigned short* Vt  = (LAS unsigned short*)(lds + 75264);
    const int tid = threadIdx.x, lane = tid & 63, wid = tid >> 6, r = lane & 15, q = lane >> 4;
    for (int unit = blockIdx.x; unit < 128; unit += gridDim.x) {
        const int dir = unit >> 6, b = (unit >> 4) & 3, h = (unit >> 2) & 3, sl = unit & 3;
        bf16_t* O = (bf16_t*)(p.ws + (dir ? WS_OB : WS_OF));
        const long tstep = dir ? -1 : 1;
        f32x4 S0 = {0.f, 0.f, 0.f, 0.f}, S1 = {0.f, 0.f, 0.f, 0.f};
        u32x4 rwA[2], rqA[2], rkA[2], raA, ruA = {0u, 0u, 0u, 0u}; float g0A = 0.f, g1A = 0.f, gLA = 0.f;
        u32x4 rwB[2], rqB[2], rkB[2], raB, ruB = {0u, 0u, 0u, 0u}; float g0B = 0.f, g1B = 0.f, gLB = 0.f;
#define D2_TOK0(n) ((long)b * S_ + (dir ? (S_ - 1 - (n) * 64) : (n) * 64))
#define D2_LOAD(n, X) do { const long t0_ = D2_TOK0(n); \
        _Pragma("unroll") for (int i = 0; i < 2; ++i) { const int pi = tid + NTHR * i, l = pi >> 4, c8 = pi & 15; const long tk = t0_ + l * tstep; \
            rw##X[i] = *(const u32x4*)(Z + tk * 3072 + 1024 + dir * 512 + h * 128 + c8 * 8); \
            rq##X[i] = *(const u32x4*)(QKVN + tk * 1536 + h * 128 + c8 * 8); rk##X[i] = *(const u32x4*)(QKVN + tk * 1536 + 512 + h * 128 + c8 * 8); } \
        { const int l = tid >> 3, c8 = tid & 7; ra##X = *(const u32x4*)(Z + (t0_ + l * tstep) * 3072 + 2048 + dir * 256 + h * 64 + c8 * 8); } \
        if (tid < 256) { const int l = tid >> 2, c8 = tid & 3; ru##X = *(const u32x4*)(Z + (t0_ + l * tstep) * 3072 + dir * 512 + h * 128 + sl * 32 + c8 * 8); } \
        g0##X = GB[((size_t)dir * T_ + (t0_ + (tid >> 4) * tstep)) * 4 + h]; g1##X = GB[((size_t)dir * T_ + (t0_ + ((tid >> 4) + 32) * tstep)) * 4 + h]; \
        gL##X = GB[((size_t)dir * T_ + (t0_ + 63 * tstep)) * 4 + h]; } while (0)
#define D2_ITER(n, X) do { \
            const float egL = __expf(gL##X); \
            _Pragma("unroll") for (int i = 0; i < 2; ++i) { const int pi = tid + NTHR * i, l = pi >> 4, c8 = pi & 15; const float gl_ = i == 0 ? g0##X : g1##X; \
                *(LAS u32x4*)(Wb + l * 136 + c8 * 8) = rw##X[i]; \
                float f[8]; unpack8(rq##X[i], f); const float eg = __expf(gl_); \
                u32x4 o; o.x = pk2(f[0] * eg, f[1] * eg); o.y = pk2(f[2] * eg, f[3] * eg); o.z = pk2(f[4] * eg, f[5] * eg); o.w = pk2(f[6] * eg, f[7] * eg); \
                *(LAS u32x4*)(Qg + l * 136 + c8 * 8) = o; \
                unpack8(rk##X[i], f); const float ek = __expf(gL##X - gl_); \
                o.x = pk2(f[0] * ek, f[1] * ek); o.y = pk2(f[2] * ek, f[3] * ek); o.z = pk2(f[4] * ek, f[5] * ek); o.w = pk2(f[6] * ek, f[7] * ek); \
                *(LAS u32x4*)(Kg + l * 144 + c8 * 8) = o; } \
            { const int l = tid >> 3, c8 = tid & 7; *(LAS u32x4*)(At + l * 72 + c8 * 8) = ra##X; } \
            if (tid < 256) { const int l = tid >> 2, c8 = tid & 3; *(LAS u32x4*)(Ub + l * 32 + c8 * 8) = ru##X; } \
            { u32x2 w0; w0.x = pk2(S0.x, S0.y); w0.y = pk2(S0.z, S0.w); *(LAS u32x2*)(St + r * 136 + wid * 16 + q * 4) = w0; \
              u32x2 w1; w1.x = pk2(S1.x, S1.y); w1.y = pk2(S1.z, S1.w); *(LAS u32x2*)(St + (16 + r) * 136 + wid * 16 + q * 4) = w1; } \
            __syncthreads(); \
            if ((n) + 2 < 64) D2_LOAD((n) + 2, X); \
            const int mt = wid >> 1, nt = wid & 1; \
            f32x4 p1 = {0.f, 0.f, 0.f, 0.f}, p2 = {0.f, 0.f, 0.f, 0.f}; \
            p1 = mma_tile<128>(Wb + mt * 16 * 136, 136, St + nt * 16 * 136, 136, p1); \
            p2 = mma_tile<128>(Qg + mt * 16 * 136, 136, St + nt * 16 * 136, 136, p2); \
            { const int l0 = mt * 16 + q * 4, v = nt * 16 + r; float vn[4]; \
              _Pragma("unroll") for (int i = 0; i < 4; ++i) vn[i] = bf2f(Ub[(l0 + i) * 32 + v]) - p1[i]; \
              u32x2 w; w.x = pk2(vn[0], vn[1]); w.y = pk2(vn[2], vn[3]); *(LAS u32x2*)(Vt + v * 72 + l0) = w; } \
            __syncthreads(); \
            p2 = mma_tile<64>(At + mt * 16 * 72, 72, Vt + nt * 16 * 72, 72, p2); \
            { const long t0_ = D2_TOK0(n); \
              _Pragma("unroll") for (int i = 0; i < 4; ++i) O[(t0_ + (mt * 16 + q * 4 + i) * tstep) * 512 + h * 128 + sl * 32 + nt * 16 + r] = f2bf(p2[i]); } \
            S0 = S0 * egL; S1 = S1 * egL; \
            { bf16x8_t ka0, ka1; tr_frag2((unsigned)(unsigned long long)Kg, 288, wid, ka0, ka1); \
              const bf16x8_t vb00 = *(const LAS bf16x8_t*)(Vt + r * 72 + q * 8), vb01 = *(const LAS bf16x8_t*)(Vt + r * 72 + 32 + q * 8); \
              const bf16x8_t vb10 = *(const LAS bf16x8_t*)(Vt + (16 + r) * 72 + q * 8), vb11 = *(const LAS bf16x8_t*)(Vt + (16 + r) * 72 + 32 + q * 8); \
              S0 = __builtin_amdgcn_mfma_f32_16x16x32_bf16(ka0, vb00, S0, 0, 0, 0); S0 = __builtin_amdgcn_mfma_f32_16x16x32_bf16(ka1, vb01, S0, 0, 0, 0); \
              S1 = __builtin_amdgcn_mfma_f32_16x16x32_bf16(ka0, vb10, S1, 0, 0, 0); S1 = __builtin_amdgcn_mfma_f32_16x16x32_bf16(ka1, vb11, S1, 0, 0, 0); } \
            __syncthreads(); } while (0)
        D2_LOAD(0, A); D2_LOAD(1, B);
#pragma unroll 1
        for (int n = 0; n < 64; n += 2) { D2_ITER(n, A); D2_ITER(n + 1, B); }
#undef D2_ITER
#undef D2_LOAD
#undef D2_TOK0
    }
}
constexpr size_t WS_CT = WS_OF, WS_NV = 235 * MiB, WS_MS = 235 * MiB + 524288, WS_CT2 = 169 * MiB, WS_NV2 = 236 * MiB;
__device__ __forceinline__ void mlstm_a(LDSp lds, const Params& p) {
    const bf16_t* Z = (const bf16_t*)(p.ws + WS_Z); const float* LI = (const float*)(p.ws + WS_BETA); const float* LF = (const float*)(p.ws + WS_LA);
    bf16_t* CT = (bf16_t*)(p.ws + WS_CT); float* NV = (float*)(p.ws + WS_NV); float* MS = (float*)(p.ws + WS_MS);
    LAS unsigned short* KsT = (LAS unsigned short*)lds;
    LAS unsigned short* Vt = (LAS unsigned short*)(lds + 9216);
    LAS float* lf = (LAS float*)(lds + 27648); LAS float* li = lf + 64; LAS float* sw = lf + 128;
    const int tid = threadIdx.x, lane = tid & 63, wid = tid >> 6, r = lane & 15, q = lane >> 4;
    for (int unit = blockIdx.x; unit < 2048; unit += gridDim.x) {
        const int dir = unit >> 10, b = (unit >> 8) & 3, h = (unit >> 6) & 3, n = unit & 63, pc = dir ? 63 - n : n;
        const size_t tok0 = (size_t)b * S_ + pc * 64;
        if (tid < 64) { lf[tid] = LF[(tok0 + tid) * 8 + dir * 4 + h]; li[tid] = LI[(tok0 + tid) * 8 + dir * 4 + h]; }
        __syncthreads();
        if (tid < 64) { float bc = 0.f, tot = 0.f;
            for (int j = 0; j < 64; ++j) { const float x = lf[j]; tot += x; if (dir ? (j >= tid) : (j <= tid)) bc += x; }
            const float we = tot - bc + li[tid]; float mx = we;
#pragma unroll
            for (int o = 32; o; o >>= 1) mx = fmaxf(mx, __shfl_xor(mx, o));
            sw[tid] = __expf(we - mx);
            if (tid == 0) { MS[unit * 32] = tot; MS[unit * 32 + 1] = mx; } }
        __syncthreads();
        { const int pp = tid >> 3, c8 = tid & 7; const u32x4 kv = *(const u32x4*)(Z + (tok0 + pp) * 2560 + 1280 + h * 64 + c8 * 8); float f[8]; unpack8(kv, f); const float s = sw[pp];
#pragma unroll
          for (int j = 0; j < 8; ++j) KsT[(c8 * 8 + j) * 72 + pp] = f2bf(f[j] * s); }
#pragma unroll
        for (int i = 0; i < 2; ++i) { const int pi = tid + NTHR * i, pp = pi >> 4, c8 = pi & 15; const u32x4 v = *(const u32x4*)(Z + (tok0 + pp) * 2560 + 1536 + h * 128 + c8 * 8);
            Vt[(c8 * 8 + 0) * 72 + pp] = (unsigned short)(v.x & 0xffffu); Vt[(c8 * 8 + 1) * 72 + pp] = (unsigned short)(v.x >> 16);
            Vt[(c8 * 8 + 2) * 72 + pp] = (unsigned short)(v.y & 0xffffu); Vt[(c8 * 8 + 3) * 72 + pp] = (unsigned short)(v.y >> 16);
            Vt[(c8 * 8 + 4) * 72 + pp] = (unsigned short)(v.z & 0xffffu); Vt[(c8 * 8 + 5) * 72 + pp] = (unsigned short)(v.z >> 16);
            Vt[(c8 * 8 + 6) * 72 + pp] = (unsigned short)(v.w & 0xffffu); Vt[(c8 * 8 + 7) * 72 + pp] = (unsigned short)(v.w >> 16); }
        __syncthreads();
#pragma unroll
        for (int dt = 0; dt < 4; ++dt) { f32x4 acc = {0.f, 0.f, 0.f, 0.f};
            acc = mma_tile<64>(KsT + dt * 16 * 72, 72, Vt + wid * 16 * 72, 72, acc);
            u32x2 w; w.x = pk2(acc.x, acc.y); w.y = pk2(acc.z, acc.w);
            *(u32x2*)(CT + (size_t)unit * 8192 + (wid * 16 + r) * 64 + dt * 16 + q * 4) = w; }
        if (tid < 64) { float a = 0.f; for (int j = 0; j < 64; ++j) a += bf2f(KsT[tid * 72 + j]); NV[(size_t)unit * 64 + tid] = a; }
        __syncthreads();
    }
}
__device__ __forceinline__ void mlstm_b(const Params& p) {
    const bf16_t* CT = (const bf16_t*)(p.ws + WS_CT); const float* NV = (const float*)(p.ws + WS_NV); float* MS = (float*)(p.ws + WS_MS); bf16_t* CT2 = (bf16_t*)(p.ws + WS_CT2); float* NV2 = (float*)(p.ws + WS_NV2);
    const int tid = threadIdx.x;
    for (int wgi = blockIdx.x; wgi < 128; wgi += gridDim.x) {
        const int scan = wgi >> 2, part = wgi & 3; const size_t e = (size_t)(part * NTHR + tid) * 4;
        const bool nvw = (part == 0 && tid < 64);
        float m = 0.f, c0 = 0.f, c1 = 0.f, c2 = 0.f, c3 = 0.f, nn = 0.f;
#pragma unroll 1
        for (int hf = 0; hf < 4; ++hf) {
        u32x2 dc[16]; float dn[16], blv[16], mlv[16];
#pragma unroll
        for (int n = 0; n < 16; ++n) { blv[n] = MS[(scan * 64 + hf * 16 + n) * 32]; mlv[n] = MS[(scan * 64 + hf * 16 + n) * 32 + 1]; dc[n] = (EXPC == 2) ? (u32x2){0u, 0u} : *(const u32x2*)(CT + (size_t)(scan * 64 + hf * 16 + n) * 8192 + e); dn[n] = nvw ? NV[(size_t)(scan * 64 + hf * 16 + n) * 64 + tid] : 0.f; }
#pragma unroll
        for (int n = 0; n < 16; ++n) { const int unit = scan * 64 + hf * 16 + n;
            const float bl = blv[n], ml = mlv[n];
            u32x2 w; w.x = pk2(c0, c1); w.y = pk2(c2, c3); *(u32x2*)(CT2 + (size_t)unit * 8192 + e) = w;
            if (nvw) NV2[(size_t)unit * 64 + tid] = nn;
            if (part == 0 && tid == 0) MS[65536 + unit] = m;
            const float mn = fmaxf(bl + m, ml), a = __expf(bl + m - mn), bb = __expf(ml - mn);
            c0 = a * c0 + bb * bflo(dc[n].x); c1 = a * c1 + bb * bfhi(dc[n].x); c2 = a * c2 + bb * bflo(dc[n].y); c3 = a * c3 + bb * bfhi(dc[n].y);
            nn = a * nn + bb * dn[n]; m = mn; }
        }
    }
}
__device__ __forceinline__ void mlstm_c(LDSp lds, const Params& p) {
    const bf16_t* Z = (const bf16_t*)(p.ws + WS_Z); const float* LI = (const float*)(p.ws + WS_BETA); const float* LF = (const float*)(p.ws + WS_LA);
    const bf16_t* CT = (const bf16_t*)(p.ws + WS_CT2); const float* NV = (const float*)(p.ws + WS_NV2); const float* MS = (const float*)(p.ws + WS_MS);
    bf16_t* Y = (bf16_t*)(p.ws + WS_HN); const float* gn = p.in[19];
    LAS unsigned short* Qb = (LAS unsigned short*)lds;
    LAS unsigned short* Kb = (LAS unsigned short*)(lds + 9216);
    LAS unsigned short* Vt = (LAS unsigned short*)(lds + 18432);
    LAS unsigned short* Cb = (LAS unsigned short*)(lds + 36864);
    LAS unsigned short* Pb = (LAS unsigned short*)(lds + 55296);
    LAS float* lf = (LAS float*)(lds + 64512); LAS float* li = lf + 64; LAS float* bcs = lf + 128; LAS float* mtv = lf + 192; LAS float* iw = lf + 256;
    LAS float* dn = lf + 320; LAS float* nv = lf + 384; LAS float* emt = lf + 448; LAS float* dnp = lf + 512  ; LAS float* ssp = lf + 768  ;
    const int tid = threadIdx.x, lane = tid & 63, wid = tid >> 6, r = lane & 15, q = lane >> 4;
    for (int unit = blockIdx.x; unit < 1024; unit += gridDim.x) {
        const int b = unit >> 8, h = (unit >> 6) & 3, pc = unit & 63; const size_t tok0 = (size_t)b * S_ + pc * 64;
        { const int pp = tid >> 3, c8 = tid & 7;
          *(LAS u32x4*)(Qb + pp * 72 + c8 * 8) = *(const u32x4*)(Z + (tok0 + pp) * 2560 + 1024 + h * 64 + c8 * 8);
          *(LAS u32x4*)(Kb + pp * 72 + c8 * 8) = *(const u32x4*)(Z + (tok0 + pp) * 2560 + 1280 + h * 64 + c8 * 8); }
#pragma unroll
        for (int i = 0; i < 2; ++i) { const int pi = tid + NTHR * i, pp = pi >> 4, c8 = pi & 15; const u32x4 v = *(const u32x4*)(Z + (tok0 + pp) * 2560 + 1536 + h * 128 + c8 * 8);
            Vt[(c8 * 8 + 0) * 72 + pp] = (unsigned short)(v.x & 0xffffu); Vt[(c8 * 8 + 1) * 72 + pp] = (unsigned short)(v.x >> 16);
            Vt[(c8 * 8 + 2) * 72 + pp] = (unsigned short)(v.y & 0xffffu); Vt[(c8 * 8 + 3) * 72 + pp] = (unsigned short)(v.y >> 16);
            Vt[(c8 * 8 + 4) * 72 + pp] = (unsigned short)(v.z & 0xffffu); Vt[(c8 * 8 + 5) * 72 + pp] = (unsigned short)(v.z >> 16);
            Vt[(c8 * 8 + 6) * 72 + pp] = (unsigned short)(v.w & 0xffffu); Vt[(c8 * 8 + 7) * 72 + pp] = (unsigned short)(v.w >> 16); }
        f32x4 hacc[4];
#pragma unroll
        for (int mt = 0; mt < 4; ++mt) hacc[mt] = (f32x4){0.f, 0.f, 0.f, 0.f};
#pragma unroll 1
        for (int dir = 0; dir < 2; ++dir) {
            const int n = dir ? 63 - pc : pc; const size_t u2 = (size_t)(((dir * 4 + b) * 4 + h) * 64 + n);
#pragma unroll
            for (int i = 0; i < 2; ++i) { const int pi = tid + NTHR * i, v = pi >> 3, c8 = pi & 7; *(LAS u32x4*)(Cb + v * 72 + c8 * 8) = (EXPC == 1) ? (u32x4){0u, 0u, 0u, 0u} : *(const u32x4*)(CT + u2 * 8192 + v * 64 + c8 * 8); }
            if (tid < 64) { lf[tid] = LF[(tok0 + tid) * 8 + dir * 4 + h]; li[tid] = LI[(tok0 + tid) * 8 + dir * 4 + h]; nv[tid] = (EXPC == 1) ? 0.f : NV[u2 * 64 + tid]; }
            const float mst = (EXPC == 1) ? 0.f : MS[65536 + u2];
            __syncthreads();
            if (tid < 64) { float bc = 0.f;
                for (int j = 0; j < 64; ++j) { const float x = lf[j]; if (dir ? (j >= tid) : (j <= tid)) bc += x; }
                bcs[tid] = bc; }
            __syncthreads();
            if (tid < 64) { const float bt = bcs[tid]; float dmax = -3.0e38f;
                for (int j = 0; j < 64; ++j) { const float d = bt - bcs[j] + li[j]; if (dir ? (j >= tid) : (j <= tid)) dmax = fmaxf(dmax, d); }
                const float m = fmaxf(bt + mst, dmax), w = __expf(bt + mst - m);
                float qn = 0.f;
                for (int d = 0; d < 64; ++d) qn = fmaf(bf2f(Qb[tid * 72 + d]), nv[d], qn);
                mtv[tid] = m; iw[tid] = w * 0.125f; emt[tid] = __expf(-m); dn[tid] = w * 0.125f * qn; }
            __syncthreads();
#pragma unroll
            for (int tt = 0; tt < 2; ++tt) { const int idx = wid * 2 + tt, mt = idx >> 2, nt = idx & 3;
                f32x4 sc = {0.f, 0.f, 0.f, 0.f};
                sc = mma_tile<64>(Qb + mt * 16 * 72, 72, Kb + nt * 16 * 72, 72, sc);
                const int s = nt * 16 + r; const float bs = bcs[s] - li[s];
#pragma unroll
                for (int i = 0; i < 4; ++i) { const int t = mt * 16 + q * 4 + i; const bool ok = dir ? (s >= t) : (s <= t);
                    const float pv = ok ? __expf(bcs[t] - bs - mtv[t]) * sc[i] * 0.125f : 0.f;
                    const unsigned short pb = f2bf(pv); Pb[t * 72 + s] = pb;
                    const float rs = row16_sum(bf2f(pb));
                    if (r == 0) dnp[nt * 64 + t] = rs; }
            }
            __syncthreads();
#pragma unroll
            for (int mt = 0; mt < 4; ++mt) { f32x4 a1 = {0.f, 0.f, 0.f, 0.f}, a2 = {0.f, 0.f, 0.f, 0.f};
                a1 = mma_tile<64>(Qb + mt * 16 * 72, 72, Cb + wid * 16 * 72, 72, a1);
                a2 = mma_tile<64>(Pb + mt * 16 * 72, 72, Vt + wid * 16 * 72, 72, a2);
#pragma unroll
                for (int i = 0; i < 4; ++i) { const int t = mt * 16 + q * 4 + i;
                    const float den = dn[t] + ((dnp[t] + dnp[64 + t]) + (dnp[128 + t] + dnp[192 + t]));
                    hacc[mt][i] += (iw[t] * a1[i] + a2[i]) / fmaxf(fabsf(den), emt[t]); }
            }
            __syncthreads();
        }
#pragma unroll
        for (int mt = 0; mt < 4; ++mt)
#pragma unroll
            for (int i = 0; i < 4; ++i) { const float s = row16_sum(hacc[mt][i] * hacc[mt][i]); if (r == 0) ssp[wid * 64 + mt * 16 + q * 4 + i] = s; }
        __syncthreads();
        { const int v = wid * 16 + r; const float g = gn[v];
#pragma unroll
          for (int mt = 0; mt < 4; ++mt)
#pragma unroll
              for (int i = 0; i < 4; ++i) { const int t = mt * 16 + q * 4 + i;
                  float ss = 0.f;
#pragma unroll
                  for (int w = 0; w < 8; ++w) ss += ssp[w * 64 + t];
                  const float rstd = rsqrtf(ss * (1.0f / 128.0f) + 1e-6f);
                  const float og = sigm_f(bf2f(Z[(tok0 + t) * 2560 + 2048 + h * 128 + v]));
                  Y[(tok0 + t) * 1024 + 512 + h * 128 + v] = f2bf(hacc[mt][i] * rstd * g * og); } }
        __syncthreads();
    }
}
__device__ __forceinline__ void headnorm_phase(const Params& p, const float* __restrict__ g, int zld, int zcol, int act) {
    const bf16_t* OF = (const bf16_t*)(p.ws + WS_OF); const bf16_t* OB = (const bf16_t*)(p.ws + WS_OB); const bf16_t* Z = (const bf16_t*)(p.ws + WS_Z); bf16_t* Y = (bf16_t*)(p.ws + WS_HN);
    const int tid = threadIdx.x, lane = tid & 63, wid = tid >> 6, c = lane * 8;
    const f32x4 g0 = *(const f32x4*)(g + (c & 127)), g1 = *(const f32x4*)(g + (c & 127) + 4);
    for (int tok = blockIdx.x * 8 + wid; tok < T_; tok += gridDim.x * 8) {
        const u32x4 a = *(const u32x4*)(OF + (size_t)tok * 512 + c), bq = *(const u32x4*)(OB + (size_t)tok * 512 + c), gz = *(const u32x4*)(Z + (size_t)tok * zld + zcol + c);
        float fa[8], fb[8], fg[8], o[8]; unpack8(a, fa); unpack8(bq, fb); unpack8(gz, fg);
        float ss = 0.f;
#pragma unroll
        for (int i = 0; i < 8; ++i) { o[i] = fa[i] + fb[i]; ss = fmaf(o[i], o[i], ss); }
        ss = row16_sum(ss);
        const float rstd = rsqrtf(ss * (1.0f / 128.0f) + 1e-6f);
        const float gg[8] = {g0.x, g0.y, g0.z, g0.w, g1.x, g1.y, g1.z, g1.w};
        float y[8];
#pragma unroll
        for (int i = 0; i < 8; ++i) y[i] = o[i] * rstd * gg[i] * (act == 0 ? fg[i] * sigm_f(fg[i]) : sigm_f(fg[i]));
        u32x4 w; w.x = pk2(y[0], y[1]); w.y = pk2(y[2], y[3]); w.z = pk2(y[4], y[5]); w.w = pk2(y[6], y[7]);
        *(u32x4*)(Y + (size_t)tok * 1024 + 512 + c) = w;
    }
}

__device__ __forceinline__ void odd_prep(const Params& p) {
    const bf16_t* Z = (const bf16_t*)(p.ws + WS_Z); bf16_t* VV = (bf16_t*)(p.ws + WS_QKV);
    const float* gates = (const float*)(p.ws + WS_GATES); float* LI = (float*)(p.ws + WS_BETA); float* LF = (float*)(p.ws + WS_LA);
    const float* ln_g = p.in[13]; const float* ln_b = p.in[14]; const float* ib = p.in[17]; const float* fb = p.in[18];
    const int tid = threadIdx.x, lane = tid & 63, wid = tid >> 6, c = lane * 8;
    const f32x4 g0 = *(const f32x4*)(ln_g + c), g1 = *(const f32x4*)(ln_g + c + 4), b0 = *(const f32x4*)(ln_b + c), b1 = *(const f32x4*)(ln_b + c + 4);
    const float gg[8] = {g0.x, g0.y, g0.z, g0.w, g1.x, g1.y, g1.z, g1.w}, bb[8] = {b0.x, b0.y, b0.z, b0.w, b1.x, b1.y, b1.z, b1.w};
    for (int tok = blockIdx.x * 8 + wid; tok < T_; tok += gridDim.x * 8) {
        const u32x4 v = *(const u32x4*)(Z + (size_t)tok * 2560 + 512 + c);
        float x[8]; unpack8(v, x); float sm = 0.f;
#pragma unroll
        for (int i = 0; i < 8; ++i) { x[i] = gelu_t(x[i]); sm += x[i]; }
        const float mean = wave_sum(sm) * (1.0f / 512.0f); float sq = 0.f;
#pragma unroll
        for (int i = 0; i < 8; ++i) { x[i] -= mean; sq = fmaf(x[i], x[i], sq); }
        const float rstd = rsqrtf(wave_sum(sq) * (1.0f / 512.0f) + 1e-5f);
        float y[8];
#pragma unroll
        for (int i = 0; i < 8; ++i) y[i] = x[i] * rstd * gg[i] + bb[i];
        u32x4 w; w.x = pk2(y[0], y[1]); w.y = pk2(y[2], y[3]); w.z = pk2(y[4], y[5]); w.w = pk2(y[6], y[7]);
        *(u32x4*)(VV + (size_t)tok * 512 + c) = w;
        if (lane < 8) { LI[(size_t)tok * 8 + lane] = gates[(size_t)tok * 16 + lane] + ib[lane];
                        LF[(size_t)tok * 8 + lane] = -softplus_(-(gates[(size_t)tok * 16 + 8 + lane] + fb[lane])); }
    }
}

__device__ __forceinline__ void sg_phase(LDSp lds, const Params& p, int sgId, int sgG) {
    typedef short bf16x8 __attribute__((ext_vector_type(8)));
    const bf16_t* Z = (const bf16_t*)(p.ws + WS_Z); const bf16_t* VV = (const bf16_t*)(p.ws + WS_QKV); bf16_t* Y = (bf16_t*)(p.ws + WS_HN);
    const float* sgw = p.in[15]; const float* sgb = p.in[16];
    LAS unsigned short* Wb = (LAS unsigned short*)lds;
    LAS unsigned short* Vt = (LAS unsigned short*)(lds + 34816);
    const int tid = threadIdx.x, lane = tid & 63, wid = tid >> 6;
    for (int unit = sgId; unit < 512; unit += sgG) {
        const int g = unit & 3, n = (unit >> 2) & 31, b = unit >> 7; const size_t tok0 = (size_t)b * S_ + n * 128;
#pragma unroll
        for (int i = 0; i < 8; ++i) { const int i4 = tid + NTHR * i, t = i4 >> 5, s4 = (i4 & 31) << 2; const f32x4 w = *(const f32x4*)(sgw + (size_t)g * 16384 + t * 128 + s4);
            u32x2 o; o.x = pk2(w.x, w.y); o.y = pk2(w.z, w.w); *(LAS u32x2*)(Wb + t * 136 + s4) = o; }
#pragma unroll
        for (int i = 0; i < 4; ++i) { const int pi = tid + NTHR * i, s = pi >> 4, c8 = (pi & 15) << 3; const u32x4 v = *(const u32x4*)(VV + (tok0 + s) * 512 + g * 128 + c8);
            Vt[(c8 + 0) * 136 + s] = (unsigned short)(v.x & 0xffffu); Vt[(c8 + 1) * 136 + s] = (unsigned short)(v.x >> 16);
            Vt[(c8 + 2) * 136 + s] = (unsigned short)(v.y & 0xffffu); Vt[(c8 + 3) * 136 + s] = (unsigned short)(v.y >> 16);
            Vt[(c8 + 4) * 136 + s] = (unsigned short)(v.z & 0xffffu); Vt[(c8 + 5) * 136 + s] = (unsigned short)(v.z >> 16);
            Vt[(c8 + 6) * 136 + s] = (unsigned short)(v.w & 0xffffu); Vt[(c8 + 7) * 136 + s] = (unsigned short)(v.w >> 16); }
        __syncthreads();
        bf16x8 af[4];
#pragma unroll
        for (int ks = 0; ks < 4; ++ks) af[ks] = *(const LAS bf16x8*)(Wb + (16 * wid + (lane & 15)) * 136 + ks * 32 + (lane >> 4) * 8);
#pragma unroll
        for (int nn = 0; nn < 8; ++nn) {
            f32x4 acc = {0.f, 0.f, 0.f, 0.f};
#pragma unroll
            for (int ks = 0; ks < 4; ++ks) { const bf16x8 bfrag = *(const LAS bf16x8*)(Vt + (16 * nn + (lane & 15)) * 136 + ks * 32 + (lane >> 4) * 8);
                acc = __builtin_amdgcn_mfma_f32_16x16x32_bf16(af[ks], bfrag, acc, 0, 0, 0); }
            const int cc = g * 128 + 16 * nn + (lane & 15);
#pragma unroll
            for (int i = 0; i < 4; ++i) { const int t = 16 * wid + (lane >> 4) * 4 + i; const size_t tok = tok0 + t;
                const float u = gelu_t(bf2f(Z[tok * 2560 + cc]));
                Y[tok * 1024 + cc] = f2bf(u * (acc[i] + sgb[g * 128 + t])); }
        }
        __syncthreads();
    }
}

__device__ __forceinline__ void mlstm_scan(LDSp lds, const Params& p) {
    const bf16_t* Z = (const bf16_t*)(p.ws + WS_Z); const float* LI = (const float*)(p.ws + WS_BETA); const float* LF = (const float*)(p.ws + WS_LA);
    const int tid = threadIdx.x, jl = tid >> 4, sub = tid & 15;
    constexpr int BUF = 20992;
    LAS float* ost = (LAS float*)(lds + 2 * BUF);
    for (int unit = blockIdx.x; unit < 128; unit += gridDim.x) {
        const int dir = unit >> 6, b = (unit >> 4) & 3, h = (unit >> 2) & 3, sl = unit & 3;
        bf16_t* O = (bf16_t*)(p.ws + (dir ? WS_OB : WS_OF));
        float C[4], N[4];
#pragma unroll
        for (int i = 0; i < 4; ++i) { C[i] = 0.f; N[i] = 0.f; }
        u32x4 rq, rk, rv = {0u, 0u, 0u, 0u}; float ri = 0.f, rf = 0.f;
#define ML_TOK(n, s) ((size_t)b * S_ + (dir ? (S_ - 1 - ((n) * 64 + (s))) : ((n) * 64 + (s))))
#define ML_LOAD(n) do { { const int s = tid >> 3, c8 = tid & 7; const size_t tk = ML_TOK(n, s); \
            rq = *(const u32x4*)(Z + tk * 2560 + 1024 + h * 64 + c8 * 8); rk = *(const u32x4*)(Z + tk * 2560 + 1280 + h * 64 + c8 * 8); } \
        if (tid < 256) { const int s = tid >> 2, c8 = tid & 3; rv = *(const u32x4*)(Z + ML_TOK(n, s) * 2560 + 1536 + h * 128 + sl * 32 + c8 * 8); } \
        if (tid < 64) { const size_t tk = ML_TOK(n, tid); ri = expf(LI[tk * 8 + dir * 4 + h]); rf = expf(LF[tk * 8 + dir * 4 + h]); } } while (0)
#define ML_STORE(bufp) do { *(LAS u32x4*)((bufp) + tid * 16) = rq; *(LAS u32x4*)((bufp) + 8192 + tid * 16) = rk; \
        if (tid < 256) *(LAS u32x4*)((bufp) + 16384 + tid * 16) = rv; \
        if (tid < 64) { *(LAS float*)((bufp) + 20480 + tid * 8) = ri; *(LAS float*)((bufp) + 20480 + tid * 8 + 4) = rf; } } while (0)
        ML_LOAD(0); ML_STORE(lds); __syncthreads();
#pragma unroll 1
        for (int n = 0; n < 64; ++n) {
            LDSp cb = lds + (n & 1) * BUF; LDSp nb = lds + ((n + 1) & 1) * BUF; LAS float* os = ost + (n & 1) * 2048;
            if (n < 63) ML_LOAD(n + 1);
#pragma unroll 4
            for (int s = 0; s < 64; ++s) {
                const u32x2 qq = *(const LAS u32x2*)(cb + s * 128 + sub * 8), kk = *(const LAS u32x2*)(cb + 8192 + s * 128 + sub * 8);
                const float vj = bf2f(*(const LAS unsigned short*)(cb + 16384 + s * 64 + jl * 2));
                const float ig = *(const LAS float*)(cb + 20480 + s * 8), fg = *(const LAS float*)(cb + 20480 + s * 8 + 4);
                const float qf[4] = {bflo(qq.x), bfhi(qq.x), bflo(qq.y), bfhi(qq.y)}, kf[4] = {bflo(kk.x), bfhi(kk.x), bflo(kk.y), bfhi(kk.y)};
                const float iv = ig * vj; float num = 0.f, den = 0.f;
#pragma unroll
                for (int i = 0; i < 4; ++i) { C[i] = fmaf(iv, kf[i], fg * C[i]); N[i] = fmaf(ig, kf[i], fg * N[i]); num = fmaf(qf[i], C[i], num); den = fmaf(qf[i], N[i], den); }
                num = row16_sum(num); den = row16_sum(den);
                if (sub == 0) os[s * 32 + jl] = 0.125f * num / fmaxf(fabsf(0.125f * den), 1.0f);
            }
            if (n < 63) ML_STORE(nb);
            __syncthreads();
            { const int s = tid >> 3, j4 = (tid & 7) << 2; const f32x4 o4 = *(const LAS f32x4*)(os + s * 32 + j4);
              u32x2 w; w.x = pk2(o4.x, o4.y); w.y = pk2(o4.z, o4.w);
              *(u32x2*)(O + ML_TOK(n, s) * 512 + h * 128 + sl * 32 + j4) = w; }
        }
        __syncthreads();
#undef ML_LOAD
#undef ML_STORE
#undef ML_TOK
    }
}

#define XB_TMO      128
#define XB_XCNT(j)  (256  + 64 * (j))
#define XB_XSUB(j)  (1280 + 64 * (j))
#define XB_XGEN(j)  (2304 + 64 * (j))
#define XB_TOP      3328
#define XB_TOPGEN   3392
#define XCD_BAR_WORDS 3456
#define XB_SPIN_CAP (1u << 18)

__device__ __forceinline__ unsigned xb_ld(unsigned* p)              { return __hip_atomic_load(p, __ATOMIC_RELAXED, __HIP_MEMORY_SCOPE_AGENT); }
__device__ __forceinline__ unsigned xb_add(unsigned* p, unsigned v) { return __hip_atomic_fetch_add(p, v, __ATOMIC_RELAXED, __HIP_MEMORY_SCOPE_AGENT); }
__device__ __forceinline__ unsigned xb_xcc_id() { return (unsigned)__builtin_amdgcn_s_getreg((3 << 11) | 20) & 0xFu; }
#define XB_SPIN(cond, bar) do { unsigned _sp = 0; while (cond) { __builtin_amdgcn_s_sleep(1); \
    if ((++_sp & 255u) == 0u) { if (xb_ld(&(bar)[XB_TMO])) break; if (_sp > XB_SPIN_CAP) { atomicAdd(&(bar)[XB_TMO], 1u); break; } } } } while (0)

struct XcdBarrier {
    unsigned* bar; unsigned x;
    volatile LAS unsigned* st;
};

__device__ __forceinline__ XcdBarrier xcd_barrier_post(unsigned* bar, volatile LAS unsigned* st) {
    XcdBarrier b; b.bar = bar; b.x = xb_xcc_id(); b.st = st;
    if (threadIdx.x == 0) (void)xb_add(&bar[XB_XCNT(b.x)], 1u);
    return b;
}
__device__ __forceinline__ void xcd_barrier_complete(unsigned* bar, unsigned x, unsigned& nloc, unsigned& nx) {
    const unsigned G = gridDim.x * gridDim.y * gridDim.z;
    unsigned sum, cnt, mine, sp = 0u;
    for (;;) {
        sum = 0u; cnt = 0u; mine = 0u;
#pragma unroll
        for (unsigned j = 0; j < 16; ++j) { const unsigned c = xb_ld(&bar[XB_XCNT(j)]); sum += c; cnt += (c > 0u) ? 1u : 0u; mine = (j == x) ? c : mine; }
        if (sum == G) break;
        __builtin_amdgcn_s_sleep(1);
        if ((++sp & 255u) == 0u) { if (xb_ld(&bar[XB_TMO])) break; if (sp > XB_SPIN_CAP) { atomicAdd(&bar[XB_TMO], 1u); break; } }
    }
    nloc = mine > 0u ? mine : 1u; nx = cnt > 0u ? cnt : 1u;
}

__device__ __forceinline__ void xcd_barrier(const XcdBarrier& b) {
    asm volatile("s_waitcnt vmcnt(0)" ::: "memory");
    __syncthreads();
    if (threadIdx.x == 0) {
        unsigned* bar = b.bar;
        __builtin_amdgcn_s_waitcnt(0);
        unsigned nloc = b.st[0], nx = b.st[1];
        if (nloc == 0u) { xcd_barrier_complete(bar, b.x, nloc, nx); b.st[0] = nloc; b.st[1] = nx; }
        const unsigned old = xb_add(&bar[XB_XSUB(b.x)], 1u);
        const unsigned gen = old / nloc;
        if (old + 1u == (gen + 1u) * nloc) {
            __builtin_amdgcn_fence(__ATOMIC_RELEASE, "agent");
            asm volatile("s_waitcnt vmcnt(0)" ::: "memory");
            const unsigned og = xb_add(&bar[XB_TOP], 1u);
            const unsigned tg = og / nx;
            if (og + 1u == (tg + 1u) * nx) xb_add(&bar[XB_TOPGEN], 1u);
            else XB_SPIN(xb_ld(&bar[XB_TOPGEN]) == tg, bar);
            __builtin_amdgcn_fence(__ATOMIC_ACQUIRE, "agent");
            xb_add(&bar[XB_XGEN(b.x)], 1u);
            asm volatile("s_waitcnt vmcnt(0)" ::: "memory");
        } else {
            XB_SPIN(xb_ld(&bar[XB_XGEN(b.x)]) == gen, bar);
            __builtin_amdgcn_fence(__ATOMIC_ACQUIRE, "agent");
            asm volatile("s_waitcnt vmcnt(0)" ::: "memory");
        }
    }
    __syncthreads();
}
constexpr size_t WS_BAR = 238 * MiB;
#ifndef N_PHASES
#define N_PHASES 21
#endif
template <int L, int SUB> __device__ __forceinline__ void run_phase(LDSp lds, const Params& p) {
    unsigned char* ws = p.ws;
    bf16_t* HN = (bf16_t*)(ws + WS_HN); bf16_t* Zb = (bf16_t*)(ws + WS_Z); float* h = p.out; float* gates = (float*)(ws + WS_GATES);
    const bf16_t* W_IN = (const bf16_t*)(ws + WS_WB + WB_IN); const bf16_t* W_OUT = (const bf16_t*)(ws + WS_WB + WB_OUT);
    const bf16_t* W_UP = (const bf16_t*)(ws + WS_WB + WB_UP); const bf16_t* W_DN = (const bf16_t*)(ws + WS_WB + WB_DN);
    const int G = gridDim.x;
    if constexpr (L == 2) { rms_phase(lds, h, p.in[25], nullptr, nullptr, h, nullptr, 0, 0, nullptr); }
    else if constexpr (SUB == 0) {
        convert_layer(lds, p, L);
        if constexpr (L == 0) rms_phase(lds, p.in[0], p.in[1], HN, h, nullptr, p.in[2], 3088, 3072, gates);
        else                  rms_phase(lds, h, p.in[1] + 1024, HN, nullptr, nullptr, p.in[12], 2576, 2560, gates);
    } else if constexpr (SUB == 1) { constexpr int N = L == 0 ? 3072 : 2560;
        pg8::Gemm g{HN, W_IN, T_, N, 1024}; pg8::StaticOrder S; S.init(T_, N, G, (int)blockIdx.x);
        pg8::EpiBf16<0> E{Zb, N, nullptr, 0, 0};
        pg8::gemm_phase<pg8::EpiBf16<0>, pg8::StaticOrder>(lds, g, S, E, nullptr);
    } else if constexpr (SUB == 2) { if constexpr (L == 0) even_prep(lds, p); else odd_prep(p); }
    else if constexpr (SUB == 9) { delta_prep(lds, p); }
    else if constexpr (SUB == 10) { mlstm_b(p); }
    else if constexpr (SUB == 11) { mlstm_c(lds, p); }
    else if constexpr (SUB == 12) { mlstm_scan(lds, p); }
    else if constexpr (SUB == 3) {
        if constexpr (L == 0) delta_scan2(lds, p);
        else { mlstm_a(lds, p); sg_phase(lds, p, (int)blockIdx.x, G); }
    } else if constexpr (SUB == 4) { if constexpr (L == 0) headnorm_phase(p, p.in[10], 3072, 2560, 0); else headnorm_phase(p, p.in[19], 2560, 2048, 1); }
    else if constexpr (SUB == 5) { pg8::Gemm g{HN, W_OUT, T_, 1024, 1024}; pg8::StaticOrder S; S.init(T_, 1024, G, (int)blockIdx.x);
        pg8::EpiAddF32 E{h, 1024};
        pg8::gemm_phase<pg8::EpiAddF32, pg8::StaticOrder>(lds, g, S, E, nullptr);
    } else if constexpr (SUB == 6) { rms_phase(lds, h, p.in[21] + L * 1024, HN, nullptr, nullptr, nullptr, 0, 0, nullptr); }
    else if constexpr (SUB == 7) { pg8::Gemm g{HN, W_UP, T_, 2 * DFF, 1024}; pg8::StaticOrder S; S.init(T_, 2 * DFF, G, (int)blockIdx.x);
        pg8::EpiSwiGLU E{Zb, DFF};
        pg8::gemm_phase<pg8::EpiSwiGLU, pg8::StaticOrder>(lds, g, S, E, nullptr);
    } else if constexpr (SUB == 8) { pg8::Gemm g{Zb, W_DN, T_, 1024, DFF}; pg8::StaticOrder S; S.init(T_, 1024, G, (int)blockIdx.x);
        pg8::EpiAddF32 E{h, 1024};
        pg8::gemm_phase<pg8::EpiAddF32, pg8::StaticOrder>(lds, g, S, E, nullptr);
    }
}
__global__ void __launch_bounds__(NTHR, 2) mega(Params p, int ph_lo, int ph_hi) {
    extern __shared__ __attribute__((aligned(16))) unsigned char lds_raw[];
    LDSp lds = (LDSp)lds_raw;
    cg::grid_group grid = cg::this_grid();
    volatile LAS unsigned* xst = (volatile LAS unsigned*)(lds + LDS_BYTES - 16);
    if (threadIdx.x == 0) { xst[0] = 0u; xst[1] = 0u; }
    __syncthreads();
    XcdBarrier xbar; xbar.bar = (unsigned*)(p.ws + WS_BAR); xbar.x = 0; xbar.st = xst;
    if (ph_hi - ph_lo > 1) xbar = xcd_barrier_post((unsigned*)(p.ws + WS_BAR), xst);
#ifndef REP_MASK
#define REP_MASK 0
#endif
#define PH(k, L, SUB) if (ph_lo <= (k) && (k) < ph_hi) { run_phase<L, SUB>(lds, p); if ((REP_MASK >> (k)) & 1) { __syncthreads(); run_phase<L, SUB>(lds, p); } if ((k) + 1 < ph_hi) { if ((k) == 0) grid.sync(); else xcd_barrier(xbar); } }
    PH(0, 0, 0) PH(1, 0, 1) PH(2, 0, 2) PH(3, 0, 9) PH(4, 0, 3) PH(5, 0, 4) PH(6, 0, 5) PH(7, 0, 6) PH(8, 0, 7) PH(9, 0, 8)
    PH(10, 1, 0) PH(11, 1, 1) PH(12, 1, 2) PH(13, 1, 3) PH(14, 1, 10) PH(15, 1, 11)
#ifdef EXP_OLD
    { run_phase<1, 12>(lds, p); grid.sync(); run_phase<1, 4>(lds, p); grid.sync(); }
#endif
    PH(16, 1, 5) PH(17, 1, 6) PH(18, 1, 7) PH(19, 1, 8)
    PH(20, 2, 0)
#ifdef EXTRA_SYNCS
    for (int i_ = 0; i_ < EXTRA_SYNCS; ++i_) grid.sync();
#endif
#undef PH
}

extern "C" void kernel_launch(void* const* d_in, const int* in_sizes, int n_in, void* d_out, int out_size, void* d_ws, size_t ws_size, hipStream_t stream) {
    static int grid = 0;
    if (grid == 0) {
        int dev = 0, cus = 0, per_cu = 0;
        (void)hipGetDevice(&dev);
        (void)hipDeviceGetAttribute(&cus, hipDeviceAttributeMultiprocessorCount, dev);
        (void)hipFuncSetAttribute((const void*)mega, hipFuncAttributeMaxDynamicSharedMemorySize, LDS_BYTES);
        if (hipOccupancyMaxActiveBlocksPerMultiprocessor(&per_cu, (const void*)mega, NTHR, LDS_BYTES) != hipSuccess || per_cu < 1) per_cu = 1;
        (void)hipGetLastError();
        if (cus <= 0) cus = 256;
        grid = cus * per_cu;
    }
    if (ws_size < 239 * MiB) { fprintf(stderr, "workspace too small: %zu\n", ws_size); return; }
    Params p{};
    for (int i = 0; i < 26; ++i) p.in[i] = (const float*)d_in[i];
    p.out = (float*)d_out; p.ws = (unsigned char*)d_ws;
#if defined(MULTI_LAUNCH)
    for (int ph = 0; ph < N_PHASES; ++ph) hipLaunchKernelGGL(mega, dim3(grid), dim3(NTHR), LDS_BYTES, stream, p, ph, ph + 1);
#else
    (void)hipMemsetAsync((char*)d_ws + WS_BAR, 0, XCD_BAR_WORDS * 4, stream);
    int lo = 0, hi = N_PHASES;
    void* args[] = {(void*)&p, (void*)&lo, (void*)&hi};
    hipError_t e = hipLaunchCooperativeKernel((const void*)mega, dim3(grid), dim3(NTHR), args, LDS_BYTES, stream);
    if (e != hipSuccess) fprintf(stderr, "cooperative launch failed: %s (grid %d)\n", hipGetErrorString(e), grid);
#endif
}
```

```cpp
#include <hip/hip_runtime.h>
#include <hip/hip_cooperative_groups.h>
#include <cstdio>
namespace cg = cooperative_groups;
namespace pg8 {
#define PG8_LAS __attribute__((address_space(3)))
typedef unsigned short bf16_t;
typedef short bf16x8 __attribute__((ext_vector_type(8)));
typedef float f32x4 __attribute__((ext_vector_type(4)));
typedef unsigned u32x4 __attribute__((ext_vector_type(4)));
constexpr int BM = 256, BK = 64, HALF = 128, HTB = HALF * BK * 2  , STAGE_BYTES = 8 * HTB, NXCD = 8, WGM = 8;

__host__ __device__ __forceinline__ int lds_byte(int r, int c) { const int st = (r >> 4) * 2 + (c >> 5), rr = r & 15, cc = c & 31, ob = rr * 64 + cc * 2; return st * 1024 + (ob ^ (((ob >> 9) & 1) << 5)); }
__host__ __device__ __forceinline__ void stage_rc(int b, int& R, int& C) { const int st = b / 1024, sb = b % 1024, swz = sb ^ (((sb >> 9) & 1) << 5); R = (st >> 1) * 16 + swz / 64; C = (st & 1) * 32 + (swz % 64) / 2; }
__host__ __device__ __forceinline__ int perm32(int rho) { const int n = rho >> 4, i = rho & 15; return 8 * (i >> 2) + 4 * n + (i & 3); }

struct Unit { int pm, pn; };
struct Gemm { const bf16_t* A; const bf16_t* Bt; int M, N, K; };

struct StaticOrder {
    int nM, nN, nwg, G, c;
    __host__ __device__ void init(int M, int N, int G_, int c_) { nM = M / BM; nN = N / BM; nwg = nM * nN; G = G_; c = c_; }
    __host__ __device__ bool next(int i, Unit& u) const {
        const long L = (long)i * G + c; if (L >= nwg) return false;
        int wgid = (int)L; { const int q = nwg / NXCD, r = nwg % NXCD, xcd = wgid % NXCD, off = wgid / NXCD; wgid = (xcd < r ? xcd * (q + 1) : r * (q + 1) + (xcd - r) * q) + off; }
        const int nig = WGM * nN, gid = wgid / nig, fm = gid * WGM, gsz = (nM - fm) < WGM ? (nM - fm) : WGM;
        u.pm = fm + ((wgid % nig) % gsz); u.pn = (wgid % nig) / gsz; return true;
    }
    __device__ __forceinline__ void a_ready(const Unit&) const {}
    __device__ __forceinline__ void done(const Unit&) const {}
};
__device__ __forceinline__ unsigned cvt_pk_bf16(float lo, float hi) { unsigned r; asm volatile("v_cvt_pk_bf16_f32 %0, %1, %2" : "=v"(r) : "v"(lo), "v"(hi)); return r; }
typedef float f32x2 __attribute__((ext_vector_type(2)));
__device__ __forceinline__ f32x2 gelu_pk(f32x2 v) {
    const f32x2 av = __builtin_elementwise_abs(v), d = av * 0.2316418882f + 1.0f;
    f32x2 t; t.x = __builtin_amdgcn_rcpf(d.x); t.y = __builtin_amdgcn_rcpf(d.y);
    f32x2 q = t * 0.5307027145f + (-0.7265760135f); q = q * t + 0.7107068705f; q = q * t + (-0.142248368f); q = q * t + 0.127414796f; q = q * t;
    const f32x2 s = (v * v) * (-0.72134752044f);
    f32x2 e; e.x = __builtin_amdgcn_exp2f(s.x); e.y = __builtin_amdgcn_exp2f(s.y);
    const f32x2 m = v * (q * e), r = v - m;
    f32x2 o; o.x = v.x < 0.f ? m.x : r.x; o.y = v.y < 0.f ? m.y : r.y; return o;
}
template <int ACT  > struct EpiBf16 {
    static constexpr bool PERM = true, AFTER_DRAIN = false;
    bf16_t* O; int ldc; const float* bias; int split_cols; size_t split_stride;
    __device__ __forceinline__ void operator()(const f32x4 (&acc)[2][2][4][2], const Unit& u, int wr, int wc, int fr, int fq) const {
        const int row0 = u.pm * BM + wr * 64 + fr; int colt = u.pn * BM; bf16_t* base = O;
        if (split_cols) { const int t = colt / split_cols; base += (size_t)t * split_stride; colt -= t * split_cols; }
        const int col0 = colt + wc * 32 + 8 * fq, bcol0 = u.pn * BM + wc * 32 + 8 * fq;
        f32x4 bv[2][2];
#pragma unroll
        for (int bj = 0; bj < 2; ++bj)
#pragma unroll
            for (int n = 0; n < 2; ++n) bv[bj][n] = bias ? *(const f32x4*)(bias + bcol0 + bj * HALF + 4 * n) : (f32x4){0.f, 0.f, 0.f, 0.f};
#pragma unroll
        for (int ai = 0; ai < 2; ++ai)
#pragma unroll
            for (int m = 0; m < 4; ++m) { bf16_t* rowp = base + (size_t)(row0 + ai * HALF + m * 16) * ldc + col0;
#pragma unroll
                for (int bj = 0; bj < 2; ++bj) { f32x4 v0 = acc[ai][bj][m][0] + bv[bj][0], v1 = acc[ai][bj][m][1] + bv[bj][1];
                    if (ACT == 1) { f32x2 a = gelu_pk((f32x2){v0[0], v0[1]}), b = gelu_pk((f32x2){v0[2], v0[3]}), c = gelu_pk((f32x2){v1[0], v1[1]}), d = gelu_pk((f32x2){v1[2], v1[3]});
                        v0 = (f32x4){a.x, a.y, b.x, b.y}; v1 = (f32x4){c.x, c.y, d.x, d.y}; }
                    if (ACT == 2) {
#pragma unroll
                        for (int j = 0; j < 4; ++j) { v0[j] = 0.5f * v0[j] * (1.0f + erff(v0[j] * 0.70710678f)); v1[j] = 0.5f * v1[j] * (1.0f + erff(v1[j] * 0.70710678f)); } }
                    u32x4 w; w.x = cvt_pk_bf16(v0[0], v0[1]); w.y = cvt_pk_bf16(v0[2], v0[3]); w.z = cvt_pk_bf16(v1[0], v1[1]); w.w = cvt_pk_bf16(v1[2], v1[3]);
                    *(u32x4*)(rowp + bj * HALF) = w; } }
    }
};
struct EpiAddF32 {
    static constexpr bool PERM = false, AFTER_DRAIN = false;
    float* C; int ldc; const float* R;
    __device__ __forceinline__ void operator()(const f32x4 (&acc)[2][2][4][2], const Unit& u, int wr, int wc, int fr, int fq) const {
        const int row0 = u.pm * BM + wr * 64 + fr, col0 = u.pn * BM + wc * 32 + 4 * fq;
#pragma unroll
        for (int ai = 0; ai < 2; ++ai)
#pragma unroll
            for (int m = 0; m < 4; ++m) { const size_t ro = (size_t)(row0 + ai * HALF + m * 16) * ldc + col0; float* rowp = C + ro; const float* srcp = R + ro;
#pragma unroll
                for (int bj = 0; bj < 2; ++bj)
#pragma unroll
                    for (int n = 0; n < 2; ++n) { const f32x4 o = *(const f32x4*)(srcp + bj * HALF + n * 16); *(f32x4*)(rowp + bj * HALF + n * 16) = o + acc[ai][bj][m][n]; } }
    }
};
struct EpiSwiGLU {
    static constexpr bool PERM = true, AFTER_DRAIN = false;
    bf16_t* H; int ldh;
    __device__ __forceinline__ void operator()(const f32x4 (&acc)[2][2][4][2], const Unit& u, int wr, int wc, int fr, int fq) const {
        const int row0 = u.pm * BM + wr * 64 + fr, hcol = u.pn * HALF + wc * 32 + 8 * fq;
#pragma unroll
        for (int ai = 0; ai < 2; ++ai)
#pragma unroll
            for (int m = 0; m < 4; ++m) { bf16_t* rowp = H + (size_t)(row0 + ai * HALF + m * 16) * ldh + hcol;
                float h[8];
#pragma unroll
                for (int n = 0; n < 2; ++n) { const f32x4 a = acc[ai][0][m][n], b = acc[ai][1][m][n];
#pragma unroll
                    for (int j = 0; j < 4; ++j) h[4 * n + j] = a[j] * __builtin_amdgcn_rcpf(1.0f + __expf(-a[j])) * b[j]; }
                u32x4 w; w.x = cvt_pk_bf16(h[0], h[1]); w.y = cvt_pk_bf16(h[2], h[3]); w.z = cvt_pk_bf16(h[4], h[5]); w.w = cvt_pk_bf16(h[6], h[7]);
                *(u32x4*)rowp = w; }
    }
};
template <class Epi, class Sched, bool STAMP = false>
__device__ __forceinline__ void gemm_phase(PG8_LAS unsigned char* lds, const Gemm g, const Sched& S, const Epi& E, unsigned long long* stamps) {
    const int tid = threadIdx.x, wid = __builtin_amdgcn_readfirstlane(tid >> 6), lane = tid & 63, wr = wid >> 2, wc = wid & 3, fr = lane & 15, fq = lane >> 4;
    const int K = g.K, nt = K / BK;
    int ts_lo = 0, ts_hi = 0, nts = 0; const unsigned long long rt_entry = STAMP ? (unsigned long long)wall_clock64() : 0ull;
#define PG8_STAMP() do { if (STAMP && wid == 0 && nts < 64) { const unsigned long long _c = (unsigned long long)clock64(); \
        ts_lo = (lane == nts) ? (int)(unsigned)_c : ts_lo; ts_hi = (lane == nts) ? (int)(unsigned)(_c >> 32) : ts_hi; ++nts; } } while (0)
    PG8_STAMP();
    unsigned voffA[2], voffB[2];
#pragma unroll
    for (int i = 0; i < 2; ++i) { int R, C; stage_rc(tid * 16 + i * 8192, R, C); const int Rb = Epi::PERM ? ((R & ~31) + perm32(R & 31)) : R;
        voffA[i] = (unsigned)(R * K + C) * 2u; voffB[i] = (unsigned)(Rb * K + C) * 2u; }
    const size_t kstep = (size_t)(BK * 2);
    const size_t hstep = (size_t)HALF * K * 2;
    const size_t tstep = 2 * hstep;
    const unsigned ldsw = (unsigned)wid * 1024u;
    const int aoff = lds_byte(wr * 64 + fr, fq * 8), boff = lds_byte(wc * 32 + fr, fq * 8);
#define PG8_SA(b, h) (((b) * 2 + (h)) * HTB)
#define PG8_SB(b, h) ((4 + (b) * 2 + (h)) * HTB)
#define PG8_STAGE(bufoff, gbase, voff) do { _Pragma("unroll") for (int _i = 0; _i < 2; ++_i) \
        __builtin_amdgcn_global_load_lds((const unsigned*)((const char*)(gbase) + (voff)[_i]), (PG8_LAS unsigned*)(lds + (bufoff) + ldsw + _i * 8192), 16, 0, 0); } while (0)
#define PG8_LDA(dst, b, h) do { _Pragma("unroll") for (int m = 0; m < 4; ++m) _Pragma("unroll") for (int k = 0; k < 2; ++k) dst[m][k] = *(const PG8_LAS bf16x8*)(lds + PG8_SA(b, h) + aoff + m * 2048 + k * 1024); } while (0)
#define PG8_LDB(dst, b, h) do { _Pragma("unroll") for (int n = 0; n < 2; ++n) _Pragma("unroll") for (int k = 0; k < 2; ++k) dst[n][k] = *(const PG8_LAS bf16x8*)(lds + PG8_SB(b, h) + boff + n * 2048 + k * 1024); } while (0)
#define PG8_MMA(ai, bj, At, Bt) do { __builtin_amdgcn_s_setprio(1); _Pragma("unroll") for (int m = 0; m < 4; ++m) _Pragma("unroll") for (int n = 0; n < 2; ++n) _Pragma("unroll") for (int k = 0; k < 2; ++k) \
        acc[ai][bj][m][n] = __builtin_amdgcn_mfma_f32_16x16x32_bf16(Bt[n][k], At[m][k], acc[ai][bj][m][n], 0, 0, 0); __builtin_amdgcn_s_setprio(0); } while (0)
#define PG8_WAIT_V(n) asm volatile("s_waitcnt vmcnt(" #n ")" ::: "memory")
#define PG8_WAIT_L(n) asm volatile("s_waitcnt lgkmcnt(" #n ")" ::: "memory")
#define PG8_BAR __builtin_amdgcn_s_barrier()
#define PG8_SCHED __builtin_amdgcn_sched_barrier(0)
    Unit cur, nxt; int ui = 0;
    if (!S.next(0, cur)) return;
    f32x4 acc[2][2][4][2];
#pragma unroll
    for (int a = 0; a < 2; ++a)
#pragma unroll
        for (int b = 0; b < 2; ++b)
#pragma unroll
            for (int m = 0; m < 4; ++m)
#pragma unroll
                for (int n = 0; n < 2; ++n) acc[a][b][m][n] = (f32x4){0.f, 0.f, 0.f, 0.f};
    bf16x8 At[4][2], B0[2][2], B1[2][2];
    const char* cA = (const char*)g.A + (size_t)cur.pm * tstep; const char* cB = (const char*)g.Bt + (size_t)cur.pn * tstep;
    S.a_ready(cur);
    PG8_STAGE(PG8_SB(0, 0), cB, voffB); PG8_STAGE(PG8_SA(0, 0), cA, voffA); PG8_STAGE(PG8_SB(0, 1), cB + hstep, voffB); PG8_STAGE(PG8_SA(0, 1), cA + hstep, voffA);
    if (wr == 1) PG8_BAR;
    PG8_WAIT_V(4); PG8_BAR;
    PG8_STAGE(PG8_SB(1, 0), cB + kstep, voffB); PG8_STAGE(PG8_SA(1, 0), cA + kstep, voffA); PG8_STAGE(PG8_SB(1, 1), cB + hstep + kstep, voffB);
    PG8_WAIT_V(6); PG8_BAR;
    PG8_STAMP();
    for (;;) {
        const bool has_next = S.next(ui + 1, nxt);
        const char* nA = has_next ? (const char*)g.A + (size_t)nxt.pm * tstep : cA; const char* nB = has_next ? (const char*)g.Bt + (size_t)nxt.pn * tstep : cB;
        for (int t = 0; t < nt; t += 2) {
            const bool last = (t == nt - 2);
            const char* a1 = cA + (size_t)(t + 1) * kstep;
            const char* a2 = last ? nA : cA + (size_t)(t + 2) * kstep; const char* b2 = last ? nB : cB + (size_t)(t + 2) * kstep;
            const char* a3 = a2 + kstep; const char* b3 = b2 + kstep;
            if (last && has_next) S.a_ready(nxt);
            PG8_LDB(B0, 0, 0); PG8_SCHED; PG8_LDA(At, 0, 0); PG8_STAGE(PG8_SA(1, 1), a1 + hstep, voffA);
            PG8_WAIT_L(8); PG8_BAR; PG8_WAIT_L(0); PG8_MMA(0, 0, At, B0); PG8_BAR; PG8_SCHED;
            PG8_LDB(B1, 0, 1); PG8_STAGE(PG8_SB(0, 0), b2, voffB);
            PG8_BAR; PG8_WAIT_L(0); PG8_MMA(0, 1, At, B1); PG8_BAR;
            PG8_LDA(At, 0, 1); PG8_STAGE(PG8_SA(0, 0), a2, voffA);
            PG8_BAR; PG8_WAIT_L(0); PG8_MMA(1, 0, At, B0); PG8_BAR; PG8_SCHED;
            PG8_STAGE(PG8_SB(0, 1), b2 + hstep, voffB);
            PG8_WAIT_V(6); PG8_BAR; PG8_MMA(1, 1, At, B1); PG8_BAR;
            PG8_LDB(B0, 1, 0); PG8_SCHED; PG8_LDA(At, 1, 0); PG8_STAGE(PG8_SA(0, 1), a2 + hstep, voffA);
            PG8_WAIT_L(8); PG8_BAR; PG8_WAIT_L(0); PG8_MMA(0, 0, At, B0); PG8_BAR; PG8_SCHED;
            PG8_LDB(B1, 1, 1); PG8_STAGE(PG8_SB(1, 0), b3, voffB);
            PG8_BAR; PG8_WAIT_L(0); PG8_MMA(0, 1, At, B1); PG8_BAR;
            PG8_LDA(At, 1, 1); PG8_STAGE(PG8_SA(1, 0), a3, voffA);
            PG8_BAR; PG8_WAIT_L(0); PG8_MMA(1, 0, At, B0); PG8_BAR; PG8_SCHED;
            PG8_STAGE(PG8_SB(1, 1), b3 + hstep, voffB);
            PG8_WAIT_V(6); PG8_BAR; PG8_MMA(1, 1, At, B1); PG8_BAR;
        }
        PG8_STAMP();
        if constexpr (!Epi::AFTER_DRAIN) { E(acc, cur, wr, wc, fr, fq); S.done(cur); }
        PG8_STAMP();
        if (!has_next) break;
#pragma unroll
        for (int a = 0; a < 2; ++a)
#pragma unroll
            for (int b = 0; b < 2; ++b)
#pragma unroll
                for (int m = 0; m < 4; ++m)
#pragma unroll
                    for (int n = 0; n < 2; ++n) acc[a][b][m][n] = (f32x4){0.f, 0.f, 0.f, 0.f};
        cur = nxt; cA = nA; cB = nB; ++ui;
    }
    PG8_WAIT_V(0);
    if (wr == 0) PG8_BAR;
    PG8_BAR;
    if constexpr (Epi::AFTER_DRAIN) { E.fused(acc, cur, wr, wc, fr, fq, lds, wid, lane); S.done(cur); }
    PG8_STAMP();
    if (STAMP && wid == 0) { stamps[lane] = lane < nts ? (((unsigned long long)(unsigned)ts_hi << 32) | (unsigned)ts_lo) : 0ull;
        if (lane == 62) stamps[62] = rt_entry; if (lane == 63) stamps[63] = (unsigned long long)wall_clock64(); }
#undef PG8_STAMP
#undef PG8_SA
#undef PG8_SB
#undef PG8_STAGE
#undef PG8_LDA
#undef PG8_LDB
#undef PG8_MMA
#undef PG8_WAIT_V
#undef PG8_WAIT_L
#undef PG8_BAR
#undef PG8_SCHED
}
}
#define LAS __attribute__((address_space(3)))
typedef LAS unsigned char* LDSp;
typedef pg8::bf16_t bf16_t;
typedef unsigned u32x4 __attribute__((ext_vector_type(4)));
typedef unsigned u32x2 __attribute__((ext_vector_type(2)));
typedef float f32x4 __attribute__((ext_vector_type(4)));
typedef float f32x2 __attribute__((ext_vector_type(2)));

#ifndef EXPC
#define EXPC 0
#endif
#ifndef EVP_SKIP
#define EVP_SKIP 0
#endif
constexpr int T_ = 16384, D_ = 1024, S_ = 4096, NTHR = 512;
constexpr int LDS_BYTES = 147456;
constexpr size_t MiB = 1048576;
constexpr size_t WS_WB = 0, WS_HN = 25 * MiB, WS_Z = 57 * MiB, WS_QKV = 153 * MiB, WS_OF = 201 * MiB, WS_OB = 217 * MiB,
                 WS_GATES = 233 * MiB, WS_BETA = 234 * MiB, WS_LA = 234 * MiB + 524288;
constexpr size_t WB_IN = 0, WB_OUT = 6291456, WB_UP = 8388608, WB_DN = 19922944;
constexpr int DFF = 2816;

struct Params { const float* in[26]; float* out; unsigned char* ws; };

__device__ __forceinline__ float bf2f(unsigned short b) { return __uint_as_float(((unsigned)b) << 16); }
__device__ __forceinline__ float bflo(unsigned u) { return __uint_as_float(u << 16); }
__device__ __forceinline__ float bfhi(unsigned u) { return __uint_as_float(u & 0xffff0000u); }
__device__ __forceinline__ unsigned short f2bf(float f) { unsigned u = __float_as_uint(f); u += 0x7FFFu + ((u >> 16) & 1u); return (unsigned short)(u >> 16); }
typedef __bf16 bf16x2_v __attribute__((ext_vector_type(2)));
__device__ __forceinline__ unsigned pk2(float lo, float hi) { const f32x2 v = {lo, hi}; const bf16x2_v b = __builtin_convertvector(v, bf16x2_v); return __builtin_bit_cast(unsigned, b); }
__device__ __forceinline__ float sigm(float x) { return __builtin_amdgcn_rcpf(1.0f + __expf(-x)); }
__device__ __forceinline__ float sigm_f(float x) { return __builtin_amdgcn_rcpf(1.0f + __expf(-x)); }
__device__ __forceinline__ float silu_(float x) { return x * sigm(x); }
__device__ __forceinline__ float gelu_t(float x) { const float u = 0.7978845608028654f * (x + 0.044715f * x * x * x); const float t = 1.0f - 2.0f / (1.0f + __expf(2.0f * u)); return 0.5f * x * (1.0f + t); }
__device__ __forceinline__ float softplus_(float x) { return x > 20.0f ? x : log1pf(expf(x)); }
__device__ __forceinline__ float wave_sum(float v) {
#pragma unroll
    for (int o = 32; o; o >>= 1) v += __shfl_xor(v, o);
    return v; }
template <int CTRL> __device__ __forceinline__ float dppf(float v) { return __int_as_float(__builtin_amdgcn_update_dpp(0, __float_as_int(v), CTRL, 0xf, 0xf, true)); }
__device__ __forceinline__ float row16_sum(float v) { v += dppf<0xB1>(v); v += dppf<0x4E>(v); v += dppf<0x141>(v); v += dppf<0x140>(v); return v; }
__device__ __forceinline__ void unpack8(const u32x4 w, float (&f)[8]) { f[0] = bflo(w.x); f[1] = bfhi(w.x); f[2] = bflo(w.y); f[3] = bfhi(w.y); f[4] = bflo(w.z); f[5] = bfhi(w.z); f[6] = bflo(w.w); f[7] = bfhi(w.w); }


__device__ __forceinline__ float wave_scan_sum(float x, bool fwd) {
    const int lane = threadIdx.x & 63;
#pragma unroll
    for (int o = 1; o < 64; o <<= 1) { const float y = fwd ? __shfl_up(x, o) : __shfl_down(x, o); if (fwd ? (lane >= o) : (lane + o < 64)) x += y; }
    return x; }
__device__ __forceinline__ float wave_scan_max(float x, bool fwd) {
    const int lane = threadIdx.x & 63;
#pragma unroll
    for (int o = 1; o < 64; o <<= 1) { const float y = fwd ? __shfl_up(x, o) : __shfl_down(x, o); if (fwd ? (lane >= o) : (lane + o < 64)) x = fmaxf(x, y); }
    return x; }
__device__ __forceinline__ void conv_job(LDSp lds, const float* __restrict__ src, int ldn, int K, int col0, int ncols, bf16_t* __restrict__ dst, int mode, int off) {
    LAS float* tl = (LAS float*)lds;
    const int tid = threadIdx.x, nnt = ncols >> 6, ntl = (K >> 6) * nnt;
    const int r = tid >> 4, c4 = (tid & 15) << 2;
    f32x4 pv[2];
    if ((int)blockIdx.x < ntl) { const int kt = (int)blockIdx.x / nnt, nt = (int)blockIdx.x - kt * nnt;
#pragma unroll
        for (int i = 0; i < 2; ++i) pv[i] = *(const f32x4*)(src + (size_t)(kt * 64 + r + 32 * i) * ldn + col0 + nt * 64 + c4); }
    for (int tile = blockIdx.x; tile < ntl; tile += gridDim.x) {
        const int kt = tile / nnt, nt = tile - kt * nnt;
#pragma unroll
        for (int i = 0; i < 2; ++i) { const int k = r + 32 * i; const f32x4 v = pv[i];
            tl[k * 65 + c4 + 0] = v.x; tl[k * 65 + c4 + 1] = v.y; tl[k * 65 + c4 + 2] = v.z; tl[k * 65 + c4 + 3] = v.w; }
        { const int tn = tile + (int)gridDim.x; if (tn < ntl) { const int kt2 = tn / nnt, nt2 = tn - kt2 * nnt;
#pragma unroll
            for (int i = 0; i < 2; ++i) pv[i] = *(const f32x4*)(src + (size_t)(kt2 * 64 + r + 32 * i) * ldn + col0 + nt2 * 64 + c4); } }
        __syncthreads();
        const int n = tid >> 3, k8 = (tid & 7) << 3; float f[8];
#pragma unroll
        for (int j = 0; j < 8; ++j) f[j] = tl[(k8 + j) * 65 + n];
        u32x4 w; w.x = pk2(f[0], f[1]); w.y = pk2(f[2], f[3]); w.z = pk2(f[4], f[5]); w.w = pk2(f[6], f[7]);
        const int ncol = nt * 64 + n;
        const int row = mode == 0 ? off + ncol : ((ncol >> 7) << 8) + (ncol & 127) + off;
        *(u32x4*)(dst + (size_t)row * K + kt * 64 + k8) = w;
        __syncthreads();
    }
}
__device__ __forceinline__ void convert_layer(LDSp lds, const Params& p, int L) {
    bf16_t* wb = (bf16_t*)(p.ws + WS_WB);
    if (L == 0) { conv_job(lds, p.in[2], 3088, 1024, 0, 3072, (bf16_t*)((char*)wb + WB_IN), 0, 0);
                  conv_job(lds, p.in[11], 1024, 1024, 0, 1024, (bf16_t*)((char*)wb + WB_OUT), 0, 0); }
    else        { conv_job(lds, p.in[12], 2576, 1024, 0, 2560, (bf16_t*)((char*)wb + WB_IN), 0, 0);
                  conv_job(lds, p.in[20], 1024, 1024, 0, 1024, (bf16_t*)((char*)wb + WB_OUT), 0, 0); }
    conv_job(lds, p.in[22] + (size_t)L * 1024 * DFF, DFF, 1024, 0, DFF, (bf16_t*)((char*)wb + WB_UP), 1, 0);
    conv_job(lds, p.in[23] + (size_t)L * 1024 * DFF, DFF, 1024, 0, DFF, (bf16_t*)((char*)wb + WB_UP), 1, 128);
    conv_job(lds, p.in[24] + (size_t)L * DFF * 1024, 1024, DFF, 0, 1024, (bf16_t*)((char*)wb + WB_DN), 0, 0);
}

__device__ __forceinline__ void rms_phase(LDSp lds, const float* src, const float* __restrict__ g, bf16_t* hn, float* copy_out, float* final_out,
                                          const float* __restrict__ gw, int gw_ld, int gw_col0, float* gates) {
    LAS float* wg = (LAS float*)lds;
    const int tid = threadIdx.x, lane = tid & 63, wid = tid >> 6;
    if (gw) { for (int idx = tid; idx < 16384; idx += NTHR) { const int k = idx >> 4, j = idx & 15; wg[j * 1024 + k] = gw[(size_t)k * gw_ld + gw_col0 + j]; } __syncthreads(); }
    f32x4 gv[4];
#pragma unroll
    for (int i = 0; i < 4; ++i) gv[i] = *(const f32x4*)(g + 4 * lane + 256 * i);
    f32x4 xn[4];
    { const int row0 = blockIdx.x * 8 + wid;
#pragma unroll
      for (int i = 0; i < 4; ++i) xn[i] = *(const f32x4*)(src + (size_t)row0 * D_ + 4 * lane + 256 * i); }
    for (int row = blockIdx.x * 8 + wid; row < T_; row += gridDim.x * 8) {
        f32x4 x[4]; float ss = 0.f;
#pragma unroll
        for (int i = 0; i < 4; ++i) { x[i] = xn[i]; ss += x[i].x * x[i].x + x[i].y * x[i].y + x[i].z * x[i].z + x[i].w * x[i].w; }
        { const int rn = row + (int)gridDim.x * 8; if (rn < T_) {
#pragma unroll
            for (int i = 0; i < 4; ++i) xn[i] = *(const f32x4*)(src + (size_t)rn * D_ + 4 * lane + 256 * i); } }
        if (copy_out) {
#pragma unroll
            for (int i = 0; i < 4; ++i) *(f32x4*)(copy_out + (size_t)row * D_ + 4 * lane + 256 * i) = x[i]; }
        ss = wave_sum(ss);
        const float rstd = rsqrtf(ss * (1.0f / 1024.0f) + 1e-6f);
        f32x4 y[4];
#pragma unroll
        for (int i = 0; i < 4; ++i) y[i] = x[i] * rstd * gv[i];
        if (final_out) {
#pragma unroll
            for (int i = 0; i < 4; ++i) *(f32x4*)(final_out + (size_t)row * D_ + 4 * lane + 256 * i) = y[i];
        } else {
#pragma unroll
            for (int i = 0; i < 4; ++i) { u32x2 w; w.x = pk2(y[i].x, y[i].y); w.y = pk2(y[i].z, y[i].w); *(u32x2*)(hn + (size_t)row * D_ + 4 * lane + 256 * i) = w; }
        }
        if (gw) {
            float s[16];
#pragma unroll
            for (int j = 0; j < 16; ++j) { float a = 0.f;
#pragma unroll
                for (int i = 0; i < 4; ++i) { const f32x4 w = *(const LAS f32x4*)(wg + j * 1024 + 4 * lane + 256 * i); a += y[i].x * w.x + y[i].y * w.y + y[i].z * w.z + y[i].w * w.w; }
                s[j] = wave_sum(a); }
            if (lane == 0) {
#pragma unroll
                for (int q = 0; q < 4; ++q) *(f32x4*)(gates + (size_t)row * 16 + 4 * q) = (f32x4){s[4 * q], s[4 * q + 1], s[4 * q + 2], s[4 * q + 3]}; }
        }
    }
    __syncthreads();
}

__device__ __forceinline__ void even_prep(LDSp lds, const Params& p) {
    const bf16_t* Z = (const bf16_t*)(p.ws + WS_Z); bf16_t* Y = (bf16_t*)(p.ws + WS_HN); bf16_t* QKVN = (bf16_t*)(p.ws + WS_QKV);
    const float* gates = (const float*)(p.ws + WS_GATES); float* BETA = (float*)(p.ws + WS_BETA); float* LA = (float*)(p.ws + WS_LA);
    const float* conv_w = p.in[3]; const float* conv_b = p.in[4]; const float* ln_g = p.in[5]; const float* ln_b = p.in[6];
    const float* dn_w = p.in[7]; const float* a_log = p.in[8]; const float* dt_bias = p.in[9];
    LAS float* glu = (LAS float*)lds;
    const int tid = threadIdx.x, lane = tid & 63, wid = tid >> 6, c = tid;
    for (int tile = blockIdx.x; tile < T_ / 32; tile += gridDim.x) {
        const int t0 = tile * 32, b = t0 >> 12, s0 = t0 & 4095;
#if !(EVP_SKIP & 1)
        for (int it = tid; it < 62 * 64; it += NTHR) { const int r = it >> 6, c8 = (it & 63) << 3, sp = s0 - 15 + r;
            f32x4 o0 = {0.f, 0.f, 0.f, 0.f}, o1 = {0.f, 0.f, 0.f, 0.f};
            if (sp >= 0 && sp < S_) { const size_t tok = (size_t)b * S_ + sp; const u32x4 av = *(const u32x4*)(Z + tok * 3072 + c8); const u32x4 gv = *(const u32x4*)(Z + tok * 3072 + 512 + c8);
                float a[8], g[8]; unpack8(av, a); unpack8(gv, g);
                o0 = (f32x4){a[0] * sigm(g[0]), a[1] * sigm(g[1]), a[2] * sigm(g[2]), a[3] * sigm(g[3])}; o1 = (f32x4){a[4] * sigm(g[4]), a[5] * sigm(g[5]), a[6] * sigm(g[6]), a[7] * sigm(g[7])}; }
            *(LAS f32x4*)(glu + r * 512 + c8) = o0; *(LAS f32x4*)(glu + r * 512 + c8 + 4) = o1; }
        __syncthreads();
        {
            float cw[31];
#pragma unroll
            for (int w = 0; w < 31; ++w) cw[w] = conv_w[w * 512 + c];
            const float cb = conv_b[c];
            f32x4 res[8];
#pragma unroll
            for (int t4 = 0; t4 < 8; ++t4) {
                float x[34];
#pragma unroll
                for (int i = 0; i < 34; ++i) x[i] = glu[(t4 * 4 + i) * 512 + c];
                float a0 = cb, a1 = cb, a2 = cb, a3 = cb;
#pragma unroll
                for (int w = 0; w < 31; ++w) { a0 = fmaf(x[w], cw[w], a0); a1 = fmaf(x[w + 1], cw[w], a1); a2 = fmaf(x[w + 2], cw[w], a2); a3 = fmaf(x[w + 3], cw[w], a3); }
                res[t4] = (f32x4){a0, a1, a2, a3};
            }
            __syncthreads();
#pragma unroll
            for (int t4 = 0; t4 < 8; ++t4) { glu[(t4 * 4 + 0) * 512 + c] = res[t4].x; glu[(t4 * 4 + 1) * 512 + c] = res[t4].y; glu[(t4 * 4 + 2) * 512 + c] = res[t4].z; glu[(t4 * 4 + 3) * 512 + c] = res[t4].w; }
        }
        __syncthreads();
        {
            const f32x4 g0 = *(const f32x4*)(ln_g + 4 * lane), g1 = *(const f32x4*)(ln_g + 256 + 4 * lane), b0 = *(const f32x4*)(ln_b + 4 * lane), b1 = *(const f32x4*)(ln_b + 256 + 4 * lane);
#pragma unroll
            for (int tt = 0; tt < 4; ++tt) { const int t = wid * 4 + tt;
                const f32x4 x0 = *(const LAS f32x4*)(glu + t * 512 + 4 * lane), x1 = *(const LAS f32x4*)(glu + t * 512 + 256 + 4 * lane);
                const float mean = wave_sum((x0.x + x0.y) + (x0.z + x0.w) + (x1.x + x1.y) + (x1.z + x1.w)) * (1.0f / 512.0f);
                const f32x4 d0 = x0 - mean, d1 = x1 - mean;
                const float var = wave_sum(d0.x * d0.x + d0.y * d0.y + d0.z * d0.z + d0.w * d0.w + d1.x * d1.x + d1.y * d1.y + d1.z * d1.z + d1.w * d1.w) * (1.0f / 512.0f);
                const float rstd = rsqrtf(var + 1e-5f);
                const f32x4 y0 = d0 * rstd * g0 + b0, y1 = d1 * rstd * g1 + b1;
                u32x2 w0, w1; w0.x = pk2(silu_(y0.x), silu_(y0.y)); w0.y = pk2(silu_(y0.z), silu_(y0.w)); w1.x = pk2(silu_(y1.x), silu_(y1.y)); w1.y = pk2(silu_(y1.z), silu_(y1.w));
                *(u32x2*)(Y + (size_t)(t0 + t) * 1024 + 4 * lane) = w0; *(u32x2*)(Y + (size_t)(t0 + t) * 1024 + 256 + 4 * lane) = w1; }
        }
        __syncthreads();
#endif
#if !(EVP_SKIP & 2)
#pragma unroll 1
        for (int gi = 0; gi < 3; ++gi) {
            const int col = 1024 + gi * 512 + c;
            float w5[5];
#pragma unroll
            for (int w = 0; w < 5; ++w) w5[w] = dn_w[w * 1536 + gi * 512 + c];
            const bf16_t* zc = Z + (size_t)b * S_ * 3072 + col;
#define ZLD(sp) (((sp) >= 0 && (sp) < S_) ? bf2f(zc[(size_t)(sp) * 3072]) : 0.f)
            float x0 = ZLD(s0 - 2), x1 = ZLD(s0 - 1), x2 = ZLD(s0), x3 = ZLD(s0 + 1);
#pragma unroll 16
            for (int t = 0; t < 32; ++t) { const float x4 = ZLD(s0 + t + 2);
                float v = x0 * w5[0]; v = fmaf(x1, w5[1], v); v = fmaf(x2, w5[2], v); v = fmaf(x3, w5[3], v); v = fmaf(x4, w5[4], v);
                v = silu_(v);
                if (gi == 2) QKVN[(size_t)(t0 + t) * 1536 + 1024 + c] = f2bf(v); else glu[t * 512 + c] = v;
                x0 = x1; x1 = x2; x2 = x3; x3 = x4; }
#undef ZLD
            if (gi < 2) {
                __syncthreads();
                const float qs = gi == 0 ? 0.08838834764831845f : 1.0f;
#pragma unroll
                for (int pp = 0; pp < 4; ++pp) { const int pr = wid * 16 + pp * 4 + (lane >> 4), t = pr >> 2, hd = pr & 3, c8 = (lane & 15) * 8;
                    const f32x4 x0 = *(const LAS f32x4*)(glu + t * 512 + hd * 128 + c8), x1 = *(const LAS f32x4*)(glu + t * 512 + hd * 128 + c8 + 4);
                    const float ss = row16_sum(x0.x * x0.x + x0.y * x0.y + x0.z * x0.z + x0.w * x0.w + x1.x * x1.x + x1.y * x1.y + x1.z * x1.z + x1.w * x1.w);
                    const float sc = rsqrtf(ss + 1e-6f) * qs;
                    u32x4 w; w.x = pk2(x0.x * sc, x0.y * sc); w.y = pk2(x0.z * sc, x0.w * sc); w.z = pk2(x1.x * sc, x1.y * sc); w.w = pk2(x1.z * sc, x1.w * sc);
                    *(u32x4*)(QKVN + (size_t)(t0 + t) * 1536 + gi * 512 + hd * 128 + c8) = w; }
                __syncthreads();
            }
        }
#endif
#if !(EVP_SKIP & 4)
        if (tid < 256) { const int t = tid >> 3, j = tid & 7; const size_t tok = (size_t)(t0 + t);
            const float bp = gates[tok * 16 + j], ap = gates[tok * 16 + 8 + j];
            BETA[tok * 8 + j] = sigm(bp); LA[tok * 8 + j] = -expf(a_log[j]) * softplus_(ap + dt_bias[j]); }
#endif
        __syncthreads();
    }
}

__device__ __forceinline__ void tri_inv64(const LAS float* Am, int c, float su, float sw, LAS unsigned short* Tu, LAS unsigned short* Tw) {
    f32x4 a; float s0, s1, s2, s3; const float cf = (float)c;
    float x0 = fmaxf(0.0f, 1.0f - fabsf(cf - 0.0f));
    Tu[0 + c] = f2bf(x0 * su); Tw[0 + c] = f2bf(x0 * sw); asm volatile("" ::: "memory");
    float x1 = fmaxf(0.0f, 1.0f - fabsf(cf - 1.0f));
    s0 = 0.f; s1 = 0.f; s2 = 0.f; s3 = 0.f;
    a = *(const LAS f32x4*)(Am + 68);
    const float al1 = a.x;
    x1 = (x1 - ((s0 + s1) + (s2 + s3))) - al1 * x0;
    Tu[136 + c] = f2bf(x1 * su); Tw[136 + c] = f2bf(x1 * sw); asm volatile("" ::: "memory");
    float x2 = fmaxf(0.0f, 1.0f - fabsf(cf - 2.0f));
    s0 = 0.f; s1 = 0.f; s2 = 0.f; s3 = 0.f;
    a = *(const LAS f32x4*)(Am + 136);
    s0 = fmaf(a.x, x0, s0);
    const float al2 = a.y;
    x2 = (x2 - ((s0 + s1) + (s2 + s3))) - al2 * x1;
    Tu[272 + c] = f2bf(x2 * su); Tw[272 + c] = f2bf(x2 * sw); asm volatile("" ::: "memory");
    float x3 = fmaxf(0.0f, 1.0f - fabsf(cf - 3.0f));
    s0 = 0.f; s1 = 0.f; s2 = 0.f; s3 = 0.f;
    a = *(const LAS f32x4*)(Am + 204);
    s0 = fmaf(a.x, x0, s0);
    s1 = fmaf(a.y, x1, s1);
    const float al3 = a.z;
    x3 = (x3 - ((s0 + s1) + (s2 + s3))) - al3 * x2;
    Tu[408 + c] = f2bf(x3 * su); Tw[408 + c] = f2bf(x3 * sw); asm volatile("" ::: "memory");
    float x4 = fmaxf(0.0f, 1.0f - fabsf(cf - 4.0f));
    s0 = 0.f; s1 = 0.f; s2 = 0.f; s3 = 0.f;
    a = *(const LAS f32x4*)(Am + 272);
    s0 = fmaf(a.x, x0, s0);
    s1 = fmaf(a.y, x1, s1);
    s2 = fmaf(a.z, x2, s2);
    const float al4 = a.w;
    x4 = (x4 - ((s0 + s1) + (s2 + s3))) - al4 * x3;
    Tu[544 + c] = f2bf(x4 * su); Tw[544 + c] = f2bf(x4 * sw); asm volatile("" ::: "memory");
    float x5 = fmaxf(0.0f, 1.0f - fabsf(cf - 5.0f));
    s0 = 0.f; s1 = 0.f; s2 = 0.f; s3 = 0.f;
    a = *(const LAS f32x4*)(Am + 340);
    s0 = fmaf(a.x, x0, s0);
    s1 = fmaf(a.y, x1, s1);
    s2 = fmaf(a.z, x2, s2);
    s3 = fmaf(a.w, x3, s3);
    a = *(const LAS f32x4*)(Am + 344);
    const float al5 = a.x;
    x5 = (x5 - ((s0 + s1) + (s2 + s3))) - al5 * x4;
    Tu[680 + c] = f2bf(x5 * su); Tw[680 + c] = f2bf(x5 * sw); asm volatile("" ::: "memory");
    float x6 = fmaxf(0.0f, 1.0f - fabsf(cf - 6.0f));
    s0 = 0.f; s1 = 0.f; s2 = 0.f; s3 = 0.f;
    a = *(const LAS f32x4*)(Am + 408);
    s0 = fmaf(a.x, x0, s0);
    s1 = fmaf(a.y, x1, s1);
    s2 = fmaf(a.z, x2, s2);
    s3 = fmaf(a.w, x3, s3);
    a = *(const LAS f32x4*)(Am + 412);
    s0 = fmaf(a.x, x4, s0);
    const float al6 = a.y;
    x6 = (x6 - ((s0 + s1) + (s2 + s3))) - al6 * x5;
    Tu[816 + c] = f2bf(x6 * su); Tw[816 + c] = f2bf(x6 * sw); asm volatile("" ::: "memory");
    float x7 = fmaxf(0.0f, 1.0f - fabsf(cf - 7.0f));
    s0 = 0.f; s1 = 0.f; s2 = 0.f; s3 = 0.f;
    a = *(const LAS f32x4*)(Am + 476);
    s0 = fmaf(a.x, x0, s0);
    s1 = fmaf(a.y, x1, s1);
    s2 = fmaf(a.z, x2, s2);
    s3 = fmaf(a.w, x3, s3);
    a = *(const LAS f32x4*)(Am + 480);
    s0 = fmaf(a.x, x4, s0);
    s1 = fmaf(a.y, x5, s1);
    const float al7 = a.z;
    x7 = (x7 - ((s0 + s1) + (s2 + s3))) - al7 * x6;
    Tu[952 + c] = f2bf(x7 * su); Tw[952 + c] = f2bf(x7 * sw); asm volatile("" ::: "memory");
    float x8 = fmaxf(0.0f, 1.0f - fabsf(cf - 8.0f));
    s0 = 0.f; s1 = 0.f; s2 = 0.f; s3 = 0.f;
    a = *(const LAS f32x4*)(Am + 544);
    s0 = fmaf(a.x, x0, s0);
    s1 = fmaf(a.y, x1, s1);
    s2 = fmaf(a.z, x2, s2);
    s3 = fmaf(a.w, x3, s3);
    a = *(const LAS f32x4*)(Am + 548);
    s0 = fmaf(a.x, x4, s0);
    s1 = fmaf(a.y, x5, s1);
    s2 = fmaf(a.z, x6, s2);
    const float al8 = a.w;
    x8 = (x8 - ((s0 + s1) + (s2 + s3))) - al8 * x7;
    Tu[1088 + c] = f2bf(x8 * su); Tw[1088 + c] = f2bf(x8 * sw); asm volatile("" ::: "memory");
    float x9 = fmaxf(0.0f, 1.0f - fabsf(cf - 9.0f));
    s0 = 0.f; s1 = 0.f; s2 = 0.f; s3 = 0.f;
    a = *(const LAS f32x4*)(Am + 612);
    s0 = fmaf(a.x, x0, s0);
    s1 = fmaf(a.y, x1, s1);
    s2 = fmaf(a.z, x2, s2);
    s3 = fmaf(a.w, x3, s3);
    a = *(const LAS f32x4*)(Am + 616);
    s0 = fmaf(a.x, x4, s0);
    s1 = fmaf(a.y, x5, s1);
    s2 = fmaf(a.z, x6, s2);
    s3 = fmaf(a.w, x7, s3);
    a = *(const LAS f32x4*)(Am + 620);
    const float al9 = a.x;
    x9 = (x9 - ((s0 + s1) + (s2 + s3))) - al9 * x8;
    Tu[1224 + c] = f2bf(x9 * su); Tw[1224 + c] = f2bf(x9 * sw); asm volatile("" ::: "memory");
    float x10 = fmaxf(0.0f, 1.0f - fabsf(cf - 10.0f));
    s0 = 0.f; s1 = 0.f; s2 = 0.f; s3 = 0.f;
    a = *(const LAS f32x4*)(Am + 680);
    s0 = fmaf(a.x, x0, s0);
    s1 = fmaf(a.y, x1, s1);
    s2 = fmaf(a.z, x2, s2);
    s3 = fmaf(a.w, x3, s3);
    a = *(const LAS f32x4*)(Am + 684);
    s0 = fmaf(a.x, x4, s0);
    s1 = fmaf(a.y, x5, s1);
    s2 = fmaf(a.z, x6, s2);
    s3 = fmaf(a.w, x7, s3);
    a = *(const LAS f32x4*)(Am + 688);
    s0 = fmaf(a.x, x8, s0);
    const float al10 = a.y;
    x10 = (x10 - ((s0 + s1) + (s2 + s3))) - al10 * x9;
    Tu[1360 + c] = f2bf(x10 * su); Tw[1360 + c] = f2bf(x10 * sw); asm volatile("" ::: "memory");
    float x11 = fmaxf(0.0f, 1.0f - fabsf(cf - 11.0f));
    s0 = 0.f; s1 = 0.f; s2 = 0.f; s3 = 0.f;
    a = *(const LAS f32x4*)(Am + 748);
    s0 = fmaf(a.x, x0, s0);
    s1 = fmaf(a.y, x1, s1);
    s2 = fmaf(a.z, x2, s2);
    s3 = fmaf(a.w, x3, s3);
    a = *(const LAS f32x4*)(Am + 752);
    s0 = fmaf(a.x, x4, s0);
    s1 = fmaf(a.y, x5, s1);
    s2 = fmaf(a.z, x6, s2);
    s3 = fmaf(a.w, x7, s3);
    a = *(const LAS f32x4*)(Am + 756);
    s0 = fmaf(a.x, x8, s0);
    s1 = fmaf(a.y, x9, s1);
    const float al11 = a.z;
    x11 = (x11 - ((s0 + s1) + (s2 + s3))) - al11 * x10;
    Tu[1496 + c] = f2bf(x11 * su); Tw[1496 + c] = f2bf(x11 * sw); asm volatile("" ::: "memory");
    float x12 = fmaxf(0.0f, 1.0f - fabsf(cf - 12.0f));
    s0 = 0.f; s1 = 0.f; s2 = 0.f; s3 = 0.f;
    a = *(const LAS f32x4*)(Am + 816);
    s0 = fmaf(a.x, x0, s0);
    s1 = fmaf(a.y, x1, s1);
    s2 = fmaf(a.z, x2, s2);
    s3 = fmaf(a.w, x3, s3);
    a = *(const LAS f32x4*)(Am + 820);
    s0 = fmaf(a.x, x4, s0);
    s1 = fmaf(a.y, x5, s1);
    s2 = fmaf(a.z, x6, s2);
    s3 = fmaf(a.w, x7, s3);
    a = *(const LAS f32x4*)(Am + 824);
    s0 = fmaf(a.x, x8, s0);
    s1 = fmaf(a.y, x9, s1);
    s2 = fmaf(a.z, x10, s2);
    const float al12 = a.w;
    x12 = (x12 - ((s0 + s1) + (s2 + s3))) - al12 * x11;
    Tu[1632 + c] = f2bf(x12 * su); Tw[1632 + c] = f2bf(x12 * sw); asm volatile("" ::: "memory");
    float x13 = fmaxf(0.0f, 1.0f - fabsf(cf - 13.0f));
    s0 = 0.f; s1 = 0.f; s2 = 0.f; s3 = 0.f;
    a = *(const LAS f32x4*)(Am + 884);
    s0 = fmaf(a.x, x0, s0);
    s1 = fmaf(a.y, x1, s1);
    s2 = fmaf(a.z, x2, s2);
    s3 = fmaf(a.w, x3, s3);
    a = *(const LAS f32x4*)(Am + 888);
    s0 = fmaf(a.x, x4, s0);
    s1 = fmaf(a.y, x5, s1);
    s2 = fmaf(a.z, x6, s2);
    s3 = fmaf(a.w, x7, s3);
    a = *(const LAS f32x4*)(Am + 892);
    s0 = fmaf(a.x, x8, s0);
    s1 = fmaf(a.y, x9, s1);
    s2 = fmaf(a.z, x10, s2);
    s3 = fmaf(a.w, x11, s3);
    a = *(const LAS f32x4*)(Am + 896);
    const float al13 = a.x;
    x13 = (x13 - ((s0 + s1) + (s2 + s3))) - al13 * x12;
    Tu[1768 + c] = f2bf(x13 * su); Tw[1768 + c] = f2bf(x13 * sw); asm volatile("" ::: "memory");
    float x14 = fmaxf(0.0f, 1.0f - fabsf(cf - 14.0f));
    s0 = 0.f; s1 = 0.f; s2 = 0.f; s3 = 0.f;
    a = *(const LAS f32x4*)(Am + 952);
    s0 = fmaf(a.x, x0, s0);
    s1 = fmaf(a.y, x1, s1);
    s2 = fmaf(a.z, x2, s2);
    s3 = fmaf(a.w, x3, s3);
    a = *(const LAS f32x4*)(Am + 956);
    s0 = fmaf(a.x, x4, s0);
    s1 = fmaf(a.y, x5, s1);
    s2 = fmaf(a.z, x6, s2);
    s3 = fmaf(a.w, x7, s3);
    a = *(const LAS f32x4*)(Am + 960);
    s0 = fmaf(a.x, x8, s0);
    s1 = fmaf(a.y, x9, s1);
    s2 = fmaf(a.z, x10, s2);
    s3 = fmaf(a.w, x11, s3);
    a = *(const LAS f32x4*)(Am + 964);
    s0 = fmaf(a.x, x12, s0);
    const float al14 = a.y;
    x14 = (x14 - ((s0 + s1) + (s2 + s3))) - al14 * x13;
    Tu[1904 + c] = f2bf(x14 * su); Tw[1904 + c] = f2bf(x14 * sw); asm volatile("" ::: "memory");
    float x15 = fmaxf(0.0f, 1.0f - fabsf(cf - 15.0f));
    s0 = 0.f; s1 = 0.f; s2 = 0.f; s3 = 0.f;
    a = *(const LAS f32x4*)(Am + 1020);
    s0 = fmaf(a.x, x0, s0);
    s1 = fmaf(a.y, x1, s1);
    s2 = fmaf(a.z, x2, s2);
    s3 = fmaf(a.w, x3, s3);
    a = *(const LAS f32x4*)(Am + 1024);
    s0 = fmaf(a.x, x4, s0);
    s1 = fmaf(a.y, x5, s1);
    s2 = fmaf(a.z, x6, s2);
    s3 = fmaf(a.w, x7, s3);
    a = *(const LAS f32x4*)(Am + 1028);
    s0 = fmaf(a.x, x8, s0);
    s1 = fmaf(a.y, x9, s1);
    s2 = fmaf(a.z, x10, s2);
    s3 = fmaf(a.w, x11, s3);
    a = *(const LAS f32x4*)(Am + 1032);
    s0 = fmaf(a.x, x12, s0);
    s1 = fmaf(a.y, x13, s1);
    const float al15 = a.z;
    x15 = (x15 - ((s0 + s1) + (s2 + s3))) - al15 * x14;
    Tu[2040 + c] = f2bf(x15 * su); Tw[2040 + c] = f2bf(x15 * sw); asm volatile("" ::: "memory");
    float x16 = fmaxf(0.0f, 1.0f - fabsf(cf - 16.0f));
    s0 = 0.f; s1 = 0.f; s2 = 0.f; s3 = 0.f;
    a = *(const LAS f32x4*)(Am + 1088);
    s0 = fmaf(a.x, x0, s0);
    s1 = fmaf(a.y, x1, s1);
    s2 = fmaf(a.z, x2, s2);
    s3 = fmaf(a.w, x3, s3);
    a = *(const LAS f32x4*)(Am + 1092);
    s0 = fmaf(a.x, x4, s0);
    s1 = fmaf(a.y, x5, s1);
    s2 = fmaf(a.z, x6, s2);
    s3 = fmaf(a.w, x7, s3);
    a = *(const LAS f32x4*)(Am + 1096);
    s0 = fmaf(a.x, x8, s0);
    s1 = fmaf(a.y, x9, s1);
    s2 = fmaf(a.z, x10, s2);
    s3 = fmaf(a.w, x11, s3);
    a = *(const LAS f32x4*)(Am + 1100);
    s0 = fmaf(a.x, x12, s0);
    s1 = fmaf(a.y, x13, s1);
    s2 = fmaf(a.z, x14, s2);
    const float al16 = a.w;
    x16 = (x16 - ((s0 + s1) + (s2 + s3))) - al16 * x15;
    Tu[2176 + c] = f2bf(x16 * su); Tw[2176 + c] = f2bf(x16 * sw); asm volatile("" ::: "memory");
    float x17 = fmaxf(0.0f, 1.0f - fabsf(cf - 17.0f));
    s0 = 0.f; s1 = 0.f; s2 = 0.f; s3 = 0.f;
    a = *(const LAS f32x4*)(Am + 1156);
    s0 = fmaf(a.x, x0, s0);
    s1 = fmaf(a.y, x1, s1);
    s2 = fmaf(a.z, x2, s2);
    s3 = fmaf(a.w, x3, s3);
    a = *(const LAS f32x4*)(Am + 1160);
    s0 = fmaf(a.x, x4, s0);
    s1 = fmaf(a.y, x5, s1);
    s2 = fmaf(a.z, x6, s2);
    s3 = fmaf(a.w, x7, s3);
    a = *(const LAS f32x4*)(Am + 1164);
    s0 = fmaf(a.x, x8, s0);
    s1 = fmaf(a.y, x9, s1);
    s2 = fmaf(a.z, x10, s2);
    s3 = fmaf(a.w, x11, s3);
    a = *(const LAS f32x4*)(Am + 1168);
    s0 = fmaf(a.x, x12, s0);
    s1 = fmaf(a.y, x13, s1);
    s2 = fmaf(a.z, x14, s2);
    s3 = fmaf(a.w, x15, s3);
    a = *(const LAS f32x4*)(Am + 1172);
    const float al17 = a.x;
    x17 = (x17 - ((s0 + s1) + (s2 + s3))) - al17 * x16;
    Tu[2312 + c] = f2bf(x17 * su); Tw[2312 + c] = f2bf(x17 * sw); asm volatile("" ::: "memory");
    float x18 = fmaxf(0.0f, 1.0f - fabsf(cf - 18.0f));
    s0 = 0.f; s1 = 0.f; s2 = 0.f; s3 = 0.f;
    a = *(const LAS f32x4*)(Am + 1224);
    s0 = fmaf(a.x, x0, s0);
    s1 = fmaf(a.y, x1, s1);
    s2 = fmaf(a.z, x2, s2);
    s3 = fmaf(a.w, x3, s3);
    a = *(const LAS f32x4*)(Am + 1228);
    s0 = fmaf(a.x, x4, s0);
    s1 = fmaf(a.y, x5, s1);
    s2 = fmaf(a.z, x6, s2);
    s3 = fmaf(a.w, x7, s3);
    a = *(const LAS f32x4*)(Am + 1232);
    s0 = fmaf(a.x, x8, s0);
    s1 = fmaf(a.y, x9, s1);
    s2 = fmaf(a.z, x10, s2);
    s3 = fmaf(a.w, x11, s3);
    a = *(const LAS f32x4*)(Am + 1236);
    s0 = fmaf(a.x, x12, s0);
    s1 = fmaf(a.y, x13, s1);
    s2 = fmaf(a.z, x14, s2);
    s3 = fmaf(a.w, x15, s3);
    a = *(const LAS f32x4*)(Am + 1240);
    s0 = fmaf(a.x, x16, s0);
    const float al18 = a.y;
    x18 = (x18 - ((s0 + s1) + (s2 + s3))) - al18 * x17;
    Tu[2448 + c] = f2bf(x18 * su); Tw[2448 + c] = f2bf(x18 * sw); asm volatile("" ::: "memory");
    float x19 = fmaxf(0.0f, 1.0f - fabsf(cf - 19.0f));
    s0 = 0.f; s1 = 0.f; s2 = 0.f; s3 = 0.f;
    a = *(const LAS f32x4*)(Am + 1292);
    s0 = fmaf(a.x, x0, s0);
    s1 = fmaf(a.y, x1, s1);
    s2 = fmaf(a.z, x2, s2);
    s3 = fmaf(a.w, x3, s3);
    a = *(const LAS f32x4*)(Am + 1296);
    s0 = fmaf(a.x, x4, s0);
    s1 = fmaf(a.y, x5, s1);
    s2 = fmaf(a.z, x6, s2);
    s3 = fmaf(a.w, x7, s3);
    a = *(const LAS f32x4*)(Am + 1300);
    s0 = fmaf(a.x, x8, s0);
    s1 = fmaf(a.y, x9, s1);
    s2 = fmaf(a.z, x10, s2);
    s3 = fmaf(a.w, x11, s3);
    a = *(const LAS f32x4*)(Am + 1304);
    s0 = fmaf(a.x, x12, s0);
    s1 = fmaf(a.y, x13, s1);
    s2 = fmaf(a.z, x14, s2);
    s3 = fmaf(a.w, x15, s3);
    a = *(const LAS f32x4*)(Am + 1308);
    s0 = fmaf(a.x, x16, s0);
    s1 = fmaf(a.y, x17, s1);
    const float al19 = a.z;
    x19 = (x19 - ((s0 + s1) + (s2 + s3))) - al19 * x18;
    Tu[2584 + c] = f2bf(x19 * su); Tw[2584 + c] = f2bf(x19 * sw); asm volatile("" ::: "memory");
    float x20 = fmaxf(0.0f, 1.0f - fabsf(cf - 20.0f));
    s0 = 0.f; s1 = 0.f; s2 = 0.f; s3 = 0.f;
    a = *(const LAS f32x4*)(Am + 1360);
    s0 = fmaf(a.x, x0, s0);
    s1 = fmaf(a.y, x1, s1);
    s2 = fmaf(a.z, x2, s2);
    s3 = fmaf(a.w, x3, s3);
    a = *(const LAS f32x4*)(Am + 1364);
    s0 = fmaf(a.x, x4, s0);
    s1 = fmaf(a.y, x5, s1);
    s2 = fmaf(a.z, x6, s2);
    s3 = fmaf(a.w, x7, s3);
    a = *(const LAS f32x4*)(Am + 1368);
    s0 = fmaf(a.x, x8, s0);
    s1 = fmaf(a.y, x9, s1);
    s2 = fmaf(a.z, x10, s2);
    s3 = fmaf(a.w, x11, s3);
    a = *(const LAS f32x4*)(Am + 1372);
    s0 = fmaf(a.x, x12, s0);
    s1 = fmaf(a.y, x13, s1);
    s2 = fmaf(a.z, x14, s2);
    s3 = fmaf(a.w, x15, s3);
    a = *(const LAS f32x4*)(Am + 1376);
    s0 = fmaf(a.x, x16, s0);
    s1 = fmaf(a.y, x17, s1);
    s2 = fmaf(a.z, x18, s2);
    const float al20 = a.w;
    x20 = (x20 - ((s0 + s1) + (s2 + s3))) - al20 * x19;
    Tu[2720 + c] = f2bf(x20 * su); Tw[2720 + c] = f2bf(x20 * sw); asm volatile("" ::: "memory");
    float x21 = fmaxf(0.0f, 1.0f - fabsf(cf - 21.0f));
    s0 = 0.f; s1 = 0.f; s2 = 0.f; s3 = 0.f;
    a = *(const LAS f32x4*)(Am + 1428);
    s0 = fmaf(a.x, x0, s0);
    s1 = fmaf(a.y, x1, s1);
    s2 = fmaf(a.z, x2, s2);
    s3 = fmaf(a.w, x3, s3);
    a = *(const LAS f32x4*)(Am + 1432);
    s0 = fmaf(a.x, x4, s0);
    s1 = fmaf(a.y, x5, s1);
    s2 = fmaf(a.z, x6, s2);
    s3 = fmaf(a.w, x7, s3);
    a = *(const LAS f32x4*)(Am + 1436);
    s0 = fmaf(a.x, x8, s0);
    s1 = fmaf(a.y, x9, s1);
    s2 = fmaf(a.z, x10, s2);
    s3 = fmaf(a.w, x11, s3);
    a = *(const LAS f32x4*)(Am + 1440);
    s0 = fmaf(a.x, x12, s0);
    s1 = fmaf(a.y, x13, s1);
    s2 = fmaf(a.z, x14, s2);
    s3 = fmaf(a.w, x15, s3);
    a = *(const LAS f32x4*)(Am + 1444);
    s0 = fmaf(a.x, x16, s0);
    s1 = fmaf(a.y, x17, s1);
    s2 = fmaf(a.z, x18, s2);
    s3 = fmaf(a.w, x19, s3);
    a = *(const LAS f32x4*)(Am + 1448);
    const float al21 = a.x;
    x21 = (x21 - ((s0 + s1) + (s2 + s3))) - al21 * x20;
    Tu[2856 + c] = f2bf(x21 * su); Tw[2856 + c] = f2bf(x21 * sw); asm volatile("" ::: "memory");
    float x22 = fmaxf(0.0f, 1.0f - fabsf(cf - 22.0f));
    s0 = 0.f; s1 = 0.f; s2 = 0.f; s3 = 0.f;
    a = *(const LAS f32x4*)(Am + 1496);
    s0 = fmaf(a.x, x0, s0);
    s1 = fmaf(a.y, x1, s1);
    s2 = fmaf(a.z, x2, s2);
    s3 = fmaf(a.w, x3, s3);
    a = *(const LAS f32x4*)(Am + 1500);
    s0 = fmaf(a.x, x4, s0);
    s1 = fmaf(a.y, x5, s1);
    s2 = fmaf(a.z, x6, s2);
    s3 = fmaf(a.w, x7, s3);
    a = *(const LAS f32x4*)(Am + 1504);
    s0 = fmaf(a.x, x8, s0);
    s1 = fmaf(a.y, x9, s1);
    s2 = fmaf(a.z, x10, s2);
    s3 = fmaf(a.w, x11, s3);
    a = *(const LAS f32x4*)(Am + 1508);
    s0 = fmaf(a.x, x12, s0);
    s1 = fmaf(a.y, x13, s1);
    s2 = fmaf(a.z, x14, s2);
    s3 = fmaf(a.w, x15, s3);
    a = *(const LAS f32x4*)(Am + 1512);
    s0 = fmaf(a.x, x16, s0);
    s1 = fmaf(a.y, x17, s1);
    s2 = fmaf(a.z, x18, s2);
    s3 = fmaf(a.w, x19, s3);
    a = *(const LAS f32x4*)(Am + 1516);
    s0 = fmaf(a.x, x20, s0);
    const float al22 = a.y;
    x22 = (x22 - ((s0 + s1) + (s2 + s3))) - al22 * x21;
    Tu[2992 + c] = f2bf(x22 * su); Tw[2992 + c] = f2bf(x22 * sw); asm volatile("" ::: "memory");
    float x23 = fmaxf(0.0f, 1.0f - fabsf(cf - 23.0f));
    s0 = 0.f; s1 = 0.f; s2 = 0.f; s3 = 0.f;
    a = *(const LAS f32x4*)(Am + 1564);
    s0 = fmaf(a.x, x0, s0);
    s1 = fmaf(a.y, x1, s1);
    s2 = fmaf(a.z, x2, s2);
    s3 = fmaf(a.w, x3, s3);
    a = *(const LAS f32x4*)(Am + 1568);
    s0 = fmaf(a.x, x4, s0);
    s1 = fmaf(a.y, x5, s1);
    s2 = fmaf(a.z, x6, s2);
    s3 = fmaf(a.w, x7, s3);
    a = *(const LAS f32x4*)(Am + 1572);
    s0 = fmaf(a.x, x8, s0);
    s1 = fmaf(a.y, x9, s1);
    s2 = fmaf(a.z, x10, s2);
    s3 = fmaf(a.w, x11, s3);
    a = *(const LAS f32x4*)(Am + 1576);
    s0 = fmaf(a.x, x12, s0);
    s1 = fmaf(a.y, x13, s1);
    s2 = fmaf(a.z, x14, s2);
    s3 = fmaf(a.w, x15, s3);
    a = *(const LAS f32x4*)(Am + 1580);
    s0 = fmaf(a.x, x16, s0);
    s1 = fmaf(a.y, x17, s1);
    s2 = fmaf(a.z, x18, s2);
    s3 = fmaf(a.w, x19, s3);
    a = *(const LAS f32x4*)(Am + 1584);
    s0 = fmaf(a.x, x20, s0);
    s1 = fmaf(a.y, x21, s1);
    const float al23 = a.z;
    x23 = (x23 - ((s0 + s1) + (s2 + s3))) - al23 * x22;
    Tu[3128 + c] = f2bf(x23 * su); Tw[3128 + c] = f2bf(x23 * sw); asm volatile("" ::: "memory");
    float x24 = fmaxf(0.0f, 1.0f - fabsf(cf - 24.0f));
    s0 = 0.f; s1 = 0.f; s2 = 0.f; s3 = 0.f;
    a = *(const LAS f32x4*)(Am + 1632);
    s0 = fmaf(a.x, x0, s0);
    s1 = fmaf(a.y, x1, s1);
    s2 = fmaf(a.z, x2, s2);
    s3 = fmaf(a.w, x3, s3);
    a = *(const LAS f32x4*)(Am + 1636);
    s0 = fmaf(a.x, x4, s0);
    s1 = fmaf(a.y, x5, s1);
    s2 = fmaf(a.z, x6, s2);
    s3 = fmaf(a.w, x7, s3);
    a = *(const LAS f32x4*)(Am + 1640);
    s0 = fmaf(a.x, x8, s0);
    s1 = fmaf(a.y, x9, s1);
    s2 = fmaf(a.z, x10, s2);
    s3 = fmaf(a.w, x11, s3);
    a = *(const LAS f32x4*)(Am + 1644);
    s0 = fmaf(a.x, x12, s0);
    s1 = fmaf(a.y, x13, s1);
    s2 = fmaf(a.z, x14, s2);
    s3 = fmaf(a.w, x15, s3);
    a = *(const LAS f32x4*)(Am + 1648);
    s0 = fmaf(a.x, x16, s0);
    s1 = fmaf(a.y, x17, s1);
    s2 = fmaf(a.z, x18, s2);
    s3 = fmaf(a.w, x19, s3);
    a = *(const LAS f32x4*)(Am + 1652);
    s0 = fmaf(a.x, x20, s0);
    s1 = fmaf(a.y, x21, s1);
    s2 = fmaf(a.z, x22, s2);
    const float al24 = a.w;
    x24 = (x24 - ((s0 + s1) + (s2 + s3))) - al24 * x23;
    Tu[3264 + c] = f2bf(x24 * su); Tw[3264 + c] = f2bf(x24 * sw); asm volatile("" ::: "memory");
    float x25 = fmaxf(0.0f, 1.0f - fabsf(cf - 25.0f));
    s0 = 0.f; s1 = 0.f; s2 = 0.f; s3 = 0.f;
    a = *(const LAS f32x4*)(Am + 1700);
    s0 = fmaf(a.x, x0, s0);
    s1 = fmaf(a.y, x1, s1);
    s2 = fmaf(a.z, x2, s2);
    s3 = fmaf(a.w, x3, s3);
    a = *(const LAS f32x4*)(Am + 1704);
    s0 = fmaf(a.x, x4, s0);
    s1 = fmaf(a.y, x5, s1);
    s2 = fmaf(a.z, x6, s2);
    s3 = fmaf(a.w, x7, s3);
    a = *(const LAS f32x4*)(Am + 1708);
    s0 = fmaf(a.x, x8, s0);
    s1 = fmaf(a.y, x9, s1);
    s2 = fmaf(a.z, x10, s2);
    s3 = fmaf(a.w, x11, s3);
    a = *(const LAS f32x4*)(Am + 1712);
    s0 = fmaf(a.x, x12, s0);
    s1 = fmaf(a.y, x13, s1);
    s2 = fmaf(a.z, x14, s2);
    s3 = fmaf(a.w, x15, s3);
    a = *(const LAS f32x4*)(Am + 1716);
    s0 = fmaf(a.x, x16, s0);
    s1 = fmaf(a.y, x17, s1);
    s2 = fmaf(a.z, x18, s2);
    s3 = fmaf(a.w, x19, s3);
    a = *(const LAS f32x4*)(Am + 1720);
    s0 = fmaf(a.x, x20, s0);
    s1 = fmaf(a.y, x21, s1);
    s2 = fmaf(a.z, x22, s2);
    s3 = fmaf(a.w, x23, s3);
    a = *(const LAS f32x4*)(Am + 1724);
    const float al25 = a.x;
    x25 = (x25 - ((s0 + s1) + (s2 + s3))) - al25 * x24;
    Tu[3400 + c] = f2bf(x25 * su); Tw[3400 + c] = f2bf(x25 * sw); asm volatile("" ::: "memory");
    float x26 = fmaxf(0.0f, 1.0f - fabsf(cf - 26.0f));
    s0 = 0.f; s1 = 0.f; s2 = 0.f; s3 = 0.f;
    a = *(const LAS f32x4*)(Am + 1768);
    s0 = fmaf(a.x, x0, s0);
    s1 = fmaf(a.y, x1, s1);
    s2 = fmaf(a.z, x2, s2);
    s3 = fmaf(a.w, x3, s3);
    a = *(const LAS f32x4*)(Am + 1772);
    s0 = fmaf(a.x, x4, s0);
    s1 = fmaf(a.y, x5, s1);
    s2 = fmaf(a.z, x6, s2);
    s3 = fmaf(a.w, x7, s3);
    a = *(const LAS f32x4*)(Am + 1776);
    s0 = fmaf(a.x, x8, s0);
    s1 = fmaf(a.y, x9, s1);
    s2 = fmaf(a.z, x10, s2);
    s3 = fmaf(a.w, x11, s3);
    a = *(const LAS f32x4*)(Am + 1780);
    s0 = fmaf(a.x, x12, s0);
    s1 = fmaf(a.y, x13, s1);
    s2 = fmaf(a.z, x14, s2);
    s3 = fmaf(a.w, x15, s3);
    a = *(const LAS f32x4*)(Am + 1784);
    s0 = fmaf(a.x, x16, s0);
    s1 = fmaf(a.y, x17, s1);
    s2 = fmaf(a.z, x18, s2);
    s3 = fmaf(a.w, x19, s3);
    a = *(const LAS f32x4*)(Am + 1788);
    s0 = fmaf(a.x, x20, s0);
    s1 = fmaf(a.y, x21, s1);
    s2 = fmaf(a.z, x22, s2);
    s3 = fmaf(a.w, x23, s3);
    a = *(const LAS f32x4*)(Am + 1792);
    s0 = fmaf(a.x, x24, s0);
    const float al26 = a.y;
    x26 = (x26 - ((s0 + s1) + (s2 + s3))) - al26 * x25;
    Tu[3536 + c] = f2bf(x26 * su); Tw[3536 + c] = f2bf(x26 * sw); asm volatile("" ::: "memory");
    float x27 = fmaxf(0.0f, 1.0f - fabsf(cf - 27.0f));
    s0 = 0.f; s1 = 0.f; s2 = 0.f; s3 = 0.f;
    a = *(const LAS f32x4*)(Am + 1836);
    s0 = fmaf(a.x, x0, s0);
    s1 = fmaf(a.y, x1, s1);
    s2 = fmaf(a.z, x2, s2);
    s3 = fmaf(a.w, x3, s3);
    a = *(const LAS f32x4*)(Am + 1840);
    s0 = fmaf(a.x, x4, s0);
    s1 = fmaf(a.y, x5, s1);
    s2 = fmaf(a.z, x6, s2);
    s3 = fmaf(a.w, x7, s3);
    a = *(const LAS f32x4*)(Am + 1844);
    s0 = fmaf(a.x, x8, s0);
    s1 = fmaf(a.y, x9, s1);
    s2 = fmaf(a.z, x10, s2);
    s3 = fmaf(a.w, x11, s3);
    a = *(const LAS f32x4*)(Am + 1848);
    s0 = fmaf(a.x, x12, s0);
    s1 = fmaf(a.y, x13, s1);
    s2 = fmaf(a.z, x14, s2);
    s3 = fmaf(a.w, x15, s3);
    a = *(const LAS f32x4*)(Am + 1852);
    s0 = fmaf(a.x, x16, s0);
    s1 = fmaf(a.y, x17, s1);
    s2 = fmaf(a.z, x18, s2);
    s3 = fmaf(a.w, x19, s3);
    a = *(const LAS f32x4*)(Am + 1856);
    s0 = fmaf(a.x, x20, s0);
    s1 = fmaf(a.y, x21, s1);
    s2 = fmaf(a.z, x22, s2);
    s3 = fmaf(a.w, x23, s3);
    a = *(const LAS f32x4*)(Am + 1860);
    s0 = fmaf(a.x, x24, s0);
    s1 = fmaf(a.y, x25, s1);
    const float al27 = a.z;
    x27 = (x27 - ((s0 + s1) + (s2 + s3))) - al27 * x26;
    Tu[3672 + c] = f2bf(x27 * su); Tw[3672 + c] = f2bf(x27 * sw); asm volatile("" ::: "memory");
    float x28 = fmaxf(0.0f, 1.0f - fabsf(cf - 28.0f));
    s0 = 0.f; s1 = 0.f; s2 = 0.f; s3 = 0.f;
    a = *(const LAS f32x4*)(Am + 1904);
    s0 = fmaf(a.x, x0, s0);
    s1 = fmaf(a.y, x1, s1);
    s2 = fmaf(a.z, x2, s2);
    s3 = fmaf(a.w, x3, s3);
    a = *(const LAS f32x4*)(Am + 1908);
    s0 = fmaf(a.x, x4, s0);
    s1 = fmaf(a.y, x5, s1);
    s2 = fmaf(a.z, x6, s2);
    s3 = fmaf(a.w, x7, s3);
    a = *(const LAS f32x4*)(Am + 1912);
    s0 = fmaf(a.x, x8, s0);
    s1 = fmaf(a.y, x9, s1);
    s2 = fmaf(a.z, x10, s2);
    s3 = fmaf(a.w, x11, s3);
    a = *(const LAS f32x4*)(Am + 1916);
    s0 = fmaf(a.x, x12, s0);
    s1 = fmaf(a.y, x13, s1);
    s2 = fmaf(a.z, x14, s2);
    s3 = fmaf(a.w, x15, s3);
    a = *(const LAS f32x4*)(Am + 1920);
    s0 = fmaf(a.x, x16, s0);
    s1 = fmaf(a.y, x17, s1);
    s2 = fmaf(a.z, x18, s2);
    s3 = fmaf(a.w, x19, s3);
    a = *(const LAS f32x4*)(Am + 1924);
    s0 = fmaf(a.x, x20, s0);
    s1 = fmaf(a.y, x21, s1);
    s2 = fmaf(a.z, x22, s2);
    s3 = fmaf(a.w, x23, s3);
    a = *(const LAS f32x4*)(Am + 1928);
    s0 = fmaf(a.x, x24, s0);
    s1 = fmaf(a.y, x25, s1);
    s2 = fmaf(a.z, x26, s2);
    const float al28 = a.w;
    x28 = (x28 - ((s0 + s1) + (s2 + s3))) - al28 * x27;
    Tu[3808 + c] = f2bf(x28 * su); Tw[3808 + c] = f2bf(x28 * sw); asm volatile("" ::: "memory");
    float x29 = fmaxf(0.0f, 1.0f - fabsf(cf - 29.0f));
    s0 = 0.f; s1 = 0.f; s2 = 0.f; s3 = 0.f;
    a = *(const LAS f32x4*)(Am + 1972);
    s0 = fmaf(a.x, x0, s0);
    s1 = fmaf(a.y, x1, s1);
    s2 = fmaf(a.z, x2, s2);
    s3 = fmaf(a.w, x3, s3);
    a = *(const LAS f32x4*)(Am + 1976);
    s0 = fmaf(a.x, x4, s0);
    s1 = fmaf(a.y, x5, s1);
    s2 = fmaf(a.z, x6, s2);
    s3 = fmaf(a.w, x7, s3);
    a = *(const LAS f32x4*)(Am + 1980);
    s0 = fmaf(a.x, x8, s0);
    s1 = fmaf(a.y, x9, s1);
    s2 = fmaf(a.z, x10, s2);
    s3 = fmaf(a.w, x11, s3);
    a = *(const LAS f32x4*)(Am + 1984);
    s0 = fmaf(a.x, x12, s0);
    s1 = fmaf(a.y, x13, s1);
    s2 = fmaf(a.z, x14, s2);
    s3 = fmaf(a.w, x15, s3);
    a = *(const LAS f32x4*)(Am + 1988);
    s0 = fmaf(a.x, x16, s0);
    s1 = fmaf(a.y, x17, s1);
    s2 = fmaf(a.z, x18, s2);
    s3 = fmaf(a.w, x19, s3);
    a = *(const LAS f32x4*)(Am + 1992);
    s0 = fmaf(a.x, x20, s0);
    s1 = fmaf(a.y, x21, s1);
    s2 = fmaf(a.z, x22, s2);
    s3 = fmaf(a.w, x23, s3);
    a = *(const LAS f32x4*)(Am + 1996);
    s0 = fmaf(a.x, x24, s0);
    s1 = fmaf(a.y, x25, s1);
    s2 = fmaf(a.z, x26, s2);
    s3 = fmaf(a.w, x27, s3);
    a = *(const LAS f32x4*)(Am + 2000);
    const float al29 = a.x;
    x29 = (x29 - ((s0 + s1) + (s2 + s3))) - al29 * x28;
    Tu[3944 + c] = f2bf(x29 * su); Tw[3944 + c] = f2bf(x29 * sw); asm volatile("" ::: "memory");
    float x30 = fmaxf(0.0f, 1.0f - fabsf(cf - 30.0f));
    s0 = 0.f; s1 = 0.f; s2 = 0.f; s3 = 0.f;
    a = *(const LAS f32x4*)(Am + 2040);
    s0 = fmaf(a.x, x0, s0);
    s1 = fmaf(a.y, x1, s1);
    s2 = fmaf(a.z, x2, s2);
    s3 = fmaf(a.w, x3, s3);
    a = *(const LAS f32x4*)(Am + 2044);
    s0 = fmaf(a.x, x4, s0);
    s1 = fmaf(a.y, x5, s1);
    s2 = fmaf(a.z, x6, s2);
    s3 = fmaf(a.w, x7, s3);
    a = *(const LAS f32x4*)(Am + 2048);
    s0 = fmaf(a.x, x8, s0);
    s1 = fmaf(a.y, x9, s1);
    s2 = fmaf(a.z, x10, s2);
    s3 = fmaf(a.w, x11, s3);
    a = *(const LAS f32x4*)(Am + 2052);
    s0 = fmaf(a.x, x12, s0);
    s1 = fmaf(a.y, x13, s1);
    s2 = fmaf(a.z, x14, s2);
    s3 = fmaf(a.w, x15, s3);
    a = *(const LAS f32x4*)(Am + 2056);
    s0 = fmaf(a.x, x16, s0);
    s1 = fmaf(a.y, x17, s1);
    s2 = fmaf(a.z, x18, s2);
    s3 = fmaf(a.w, x19, s3);
    a = *(const LAS f32x4*)(Am + 2060);
    s0 = fmaf(a.x, x20, s0);
    s1 = fmaf(a.y, x21, s1);
    s2 = fmaf(a.z, x22, s2);
    s3 = fmaf(a.w, x23, s3);
    a = *(const LAS f32x4*)(Am + 2064);
    s0 = fmaf(a.x, x24, s0);
    s1 = fmaf(a.y, x25, s1);
    s2 = fmaf(a.z, x26, s2);
    s3 = fmaf(a.w, x27, s3);
    a = *(const LAS f32x4*)(Am + 2068);
    s0 = fmaf(a.x, x28, s0);
    const float al30 = a.y;
    x30 = (x30 - ((s0 + s1) + (s2 + s3))) - al30 * x29;
    Tu[4080 + c] = f2bf(x30 * su); Tw[4080 + c] = f2bf(x30 * sw); asm volatile("" ::: "memory");
    float x31 = fmaxf(0.0f, 1.0f - fabsf(cf - 31.0f));
    s0 = 0.f; s1 = 0.f; s2 = 0.f; s3 = 0.f;
    a = *(const LAS f32x4*)(Am + 2108);
    s0 = fmaf(a.x, x0, s0);
    s1 = fmaf(a.y, x1, s1);
    s2 = fmaf(a.z, x2, s2);
    s3 = fmaf(a.w, x3, s3);
    a = *(const LAS f32x4*)(Am + 2112);
    s0 = fmaf(a.x, x4, s0);
    s1 = fmaf(a.y, x5, s1);
    s2 = fmaf(a.z, x6, s2);
    s3 = fmaf(a.w, x7, s3);
    a = *(const LAS f32x4*)(Am + 2116);
    s0 = fmaf(a.x, x8, s0);
    s1 = fmaf(a.y, x9, s1);
    s2 = fmaf(a.z, x10, s2);
    s3 = fmaf(a.w, x11, s3);
    a = *(const LAS f32x4*)(Am + 2120);
    s0 = fmaf(a.x, x12, s0);
    s1 = fmaf(a.y, x13, s1);
    s2 = fmaf(a.z, x14, s2);
    s3 = fmaf(a.w, x15, s3);
    a = *(const LAS f32x4*)(Am + 2124);
    s0 = fmaf(a.x, x16, s0);
    s1 = fmaf(a.y, x17, s1);
    s2 = fmaf(a.z, x18, s2);
    s3 = fmaf(a.w, x19, s3);
    a = *(const LAS f32x4*)(Am + 2128);
    s0 = fmaf(a.x, x20, s0);
    s1 = fmaf(a.y, x21, s1);
    s2 = fmaf(a.z, x22, s2);
    s3 = fmaf(a.w, x23, s3);
    a = *(const LAS f32x4*)(Am + 2132);
    s0 = fmaf(a.x, x24, s0);
    s1 = fmaf(a.y, x25, s1);
    s2 = fmaf(a.z, x26, s2);
    s3 = fmaf(a.w, x27, s3);
    a = *(const LAS f32x4*)(Am + 2136);
    s0 = fmaf(a.x, x28, s0);
    s1 = fmaf(a.y, x29, s1);
    const float al31 = a.z;
    x31 = (x31 - ((s0 + s1) + (s2 + s3))) - al31 * x30;
    Tu[4216 + c] = f2bf(x31 * su); Tw[4216 + c] = f2bf(x31 * sw); asm volatile("" ::: "memory");
    float x32 = fmaxf(0.0f, 1.0f - fabsf(cf - 32.0f));
    s0 = 0.f; s1 = 0.f; s2 = 0.f; s3 = 0.f;
    a = *(const LAS f32x4*)(Am + 2176);
    s0 = fmaf(a.x, x0, s0);
    s1 = fmaf(a.y, x1, s1);
    s2 = fmaf(a.z, x2, s2);
    s3 = fmaf(a.w, x3, s3);
    a = *(const LAS f32x4*)(Am + 2180);
    s0 = fmaf(a.x, x4, s0);
    s1 = fmaf(a.y, x5, s1);
    s2 = fmaf(a.z, x6, s2);
    s3 = fmaf(a.w, x7, s3);
    a = *(const LAS f32x4*)(Am + 2184);
    s0 = fmaf(a.x, x8, s0);
    s1 = fmaf(a.y, x9, s1);
    s2 = fmaf(a.z, x10, s2);
    s3 = fmaf(a.w, x11, s3);
    a = *(const LAS f32x4*)(Am + 2188);
    s0 = fmaf(a.x, x12, s0);
    s1 = fmaf(a.y, x13, s1);
    s2 = fmaf(a.z, x14, s2);
    s3 = fmaf(a.w, x15, s3);
    a = *(const LAS f32x4*)(Am + 2192);
    s0 = fmaf(a.x, x16, s0);
    s1 = fmaf(a.y, x17, s1);
    s2 = fmaf(a.z, x18, s2);
    s3 = fmaf(a.w, x19, s3);
    a = *(const LAS f32x4*)(Am + 2196);
    s0 = fmaf(a.x, x20, s0);
    s1 = fmaf(a.y, x21, s1);
    s2 = fmaf(a.z, x22, s2);
    s3 = fmaf(a.w, x23, s3);
    a = *(const LAS f32x4*)(Am + 2200);
    s0 = fmaf(a.x, x24, s0);
    s1 = fmaf(a.y, x25, s1);
    s2 = fmaf(a.z, x26, s2);
    s3 = fmaf(a.w, x27, s3);
    a = *(const LAS f32x4*)(Am + 2204);
    s0 = fmaf(a.x, x28, s0);
    s1 = fmaf(a.y, x29, s1);
    s2 = fmaf(a.z, x30, s2);
    const float al32 = a.w;
    x32 = (x32 - ((s0 + s1) + (s2 + s3))) - al32 * x31;
    Tu[4352 + c] = f2bf(x32 * su); Tw[4352 + c] = f2bf(x32 * sw); asm volatile("" ::: "memory");
    float x33 = fmaxf(0.0f, 1.0f - fabsf(cf - 33.0f));
    s0 = 0.f; s1 = 0.f; s2 = 0.f; s3 = 0.f;
    a = *(const LAS f32x4*)(Am + 2244);
    s0 = fmaf(a.x, x0, s0);
    s1 = fmaf(a.y, x1, s1);
    s2 = fmaf(a.z, x2, s2);
    s3 = fmaf(a.w, x3, s3);
    a = *(const LAS f32x4*)(Am + 2248);
    s0 = fmaf(a.x, x4, s0);
    s1 = fmaf(a.y, x5, s1);
    s2 = fmaf(a.z, x6, s2);
    s3 = fmaf(a.w, x7, s3);
    a = *(const LAS f32x4*)(Am + 2252);
    s0 = fmaf(a.x, x8, s0);
    s1 = fmaf(a.y, x9, s1);
    s2 = fmaf(a.z, x10, s2);
    s3 = fmaf(a.w, x11, s3);
    a = *(const LAS f32x4*)(Am + 2256);
    s0 = fmaf(a.x, x12, s0);
    s1 = fmaf(a.y, x13, s1);
    s2 = fmaf(a.z, x14, s2);
    s3 = fmaf(a.w, x15, s3);
    a = *(const LAS f32x4*)(Am + 2260);
    s0 = fmaf(a.x, x16, s0);
    s1 = fmaf(a.y, x17, s1);
    s2 = fmaf(a.z, x18, s2);
    s3 = fmaf(a.w, x19, s3);
    a = *(const LAS f32x4*)(Am + 2264);
    s0 = fmaf(a.x, x20, s0);
    s1 = fmaf(a.y, x21, s1);
    s2 = fmaf(a.z, x22, s2);
    s3 = fmaf(a.w, x23, s3);
    a = *(const LAS f32x4*)(Am + 2268);
    s0 = fmaf(a.x, x24, s0);
    s1 = fmaf(a.y, x25, s1);
    s2 = fmaf(a.z, x26, s2);
    s3 = fmaf(a.w, x27, s3);
    a = *(const LAS f32x4*)(Am + 2272);
    s0 = fmaf(a.x, x28, s0);
    s1 = fmaf(a.y, x29, s1);
    s2 = fmaf(a.z, x30, s2);
    s3 = fmaf(a.w, x31, s3);
    a = *(const LAS f32x4*)(Am + 2276);
    const float al33 = a.x;
    x33 = (x33 - ((s0 + s1) + (s2 + s3))) - al33 * x32;
    Tu[4488 + c] = f2bf(x33 * su); Tw[4488 + c] = f2bf(x33 * sw); asm volatile("" ::: "memory");
    float x34 = fmaxf(0.0f, 1.0f - fabsf(cf - 34.0f));
    s0 = 0.f; s1 = 0.f; s2 = 0.f; s3 = 0.f;
    a = *(const LAS f32x4*)(Am + 2312);
    s0 = fmaf(a.x, x0, s0);
    s1 = fmaf(a.y, x1, s1);
    s2 = fmaf(a.z, x2, s2);
    s3 = fmaf(a.w, x3, s3);
    a = *(const LAS f32x4*)(Am + 2316);
    s0 = fmaf(a.x, x4, s0);
    s1 = fmaf(a.y, x5, s1);
    s2 = fmaf(a.z, x6, s2);
    s3 = fmaf(a.w, x7, s3);
    a = *(const LAS f32x4*)(Am + 2320);
    s0 = fmaf(a.x, x8, s0);
    s1 = fmaf(a.y, x9, s1);
    s2 = fmaf(a.z, x10, s2);
    s3 = fmaf(a.w, x11, s3);
    a = *(const LAS f32x4*)(Am + 2324);
    s0 = fmaf(a.x, x12, s0);
    s1 = fmaf(a.y, x13, s1);
    s2 = fmaf(a.z, x14, s2);
    s3 = fmaf(a.w, x15, s3);
    a = *(const LAS f32x4*)(Am + 2328);
    s0 = fmaf(a.x, x16, s0);
    s1 = fmaf(a.y, x17, s1);
    s2 = fmaf(a.z, x18, s2);
    s3 = fmaf(a.w, x19, s3);
    a = *(const LAS f32x4*)(Am + 2332);
    s0 = fmaf(a.x, x20, s0);
    s1 = fmaf(a.y, x21, s1);
    s2 = fmaf(a.z, x22, s2);
    s3 = fmaf(a.w, x23, s3);
    a = *(const LAS f32x4*)(Am + 2336);
    s0 = fmaf(a.x, x24, s0);
    s1 = fmaf(a.y, x25, s1);
    s2 = fmaf(a.z, x26, s2);
    s3 = fmaf(a.w, x27, s3);
    a = *(const LAS f32x4*)(Am + 2340);
    s0 = fmaf(a.x, x28, s0);
    s1 = fmaf(a.y, x29, s1);
    s2 = fmaf(a.z, x30, s2);
    s3 = fmaf(a.w, x31, s3);
    a = *(const LAS f32x4*)(Am + 2344);
    s0 = fmaf(a.x, x32, s0);
    const float al34 = a.y;
    x34 = (x34 - ((s0 + s1) + (s2 + s3))) - al34 * x33;
    Tu[4624 + c] = f2bf(x34 * su); Tw[4624 + c] = f2bf(x34 * sw); asm volatile("" ::: "memory");
    float x35 = fmaxf(0.0f, 1.0f - fabsf(cf - 35.0f));
    s0 = 0.f; s1 = 0.f; s2 = 0.f; s3 = 0.f;
    a = *(const LAS f32x4*)(Am + 2380);
    s0 = fmaf(a.x, x0, s0);
    s1 = fmaf(a.y, x1, s1);
    s2 = fmaf(a.z, x2, s2);
    s3 = fmaf(a.w, x3, s3);
    a = *(const LAS f32x4*)(Am + 2384);
    s0 = fmaf(a.x, x4, s0);
    s1 = fmaf(a.y, x5, s1);
    s2 = fmaf(a.z, x6, s2);
    s3 = fmaf(a.w, x7, s3);
    a = *(const LAS f32x4*)(Am + 2388);
    s0 = fmaf(a.x, x8, s0);
    s1 = fmaf(a.y, x9, s1);
    s2 = fmaf(a.z, x10, s2);
    s3 = fmaf(a.w, x11, s3);
    a = *(const LAS f32x4*)(Am + 2392);
    s0 = fmaf(a.x, x12, s0);
    s1 = fmaf(a.y, x13, s1);
    s2 = fmaf(a.z, x14, s2);
    s3 = fmaf(a.w, x15, s3);
    a = *(const LAS f32x4*)(Am + 2396);
    s0 = fmaf(a.x, x16, s0);
    s1 = fmaf(a.y, x17, s1);
    s2 = fmaf(a.z, x18, s2);
    s3 = fmaf(a.w, x19, s3);
    a = *(const LAS f32x4*)(Am + 2400);
    s0 = fmaf(a.x, x20, s0);
    s1 = fmaf(a.y, x21, s1);
    s2 = fmaf(a.z, x22, s2);
    s3 = fmaf(a.w, x23, s3);
    a = *(const LAS f32x4*)(Am + 2404);
    s0 = fmaf(a.x, x24, s0);
    s1 = fmaf(a.y, x25, s1);
    s2 = fmaf(a.z, x26, s2);
    s3 = fmaf(a.w, x27, s3);
    a = *(const LAS f32x4*)(Am + 2408);
    s0 = fmaf(a.x, x28, s0);
    s1 = fmaf(a.y, x29, s1);
    s2 = fmaf(a.z, x30, s2);
    s3 = fmaf(a.w, x31, s3);
    a = *(const LAS f32x4*)(Am + 2412);
    s0 = fmaf(a.x, x32, s0);
    s1 = fmaf(a.y, x33, s1);
    const float al35 = a.z;
    x35 = (x35 - ((s0 + s1) + (s2 + s3))) - al35 * x34;
    Tu[4760 + c] = f2bf(x35 * su); Tw[4760 + c] = f2bf(x35 * sw); asm volatile("" ::: "memory");
    float x36 = fmaxf(0.0f, 1.0f - fabsf(cf - 36.0f));
    s0 = 0.f; s1 = 0.f; s2 = 0.f; s3 = 0.f;
    a = *(const LAS f32x4*)(Am + 2448);
    s0 = fmaf(a.x, x0, s0);
    s1 = fmaf(a.y, x1, s1);
    s2 = fmaf(a.z, x2, s2);
    s3 = fmaf(a.w, x3, s3);
    a = *(const LAS f32x4*)(Am + 2452);
    s0 = fmaf(a.x, x4, s0);
    s1 = fmaf(a.y, x5, s1);
    s2 = fmaf(a.z, x6, s2);
    s3 = fmaf(a.w, x7, s3);
    a = *(const LAS f32x4*)(Am + 2456);
    s0 = fmaf(a.x, x8, s0);
    s1 = fmaf(a.y, x9, s1);
    s2 = fmaf(a.z, x10, s2);
    s3 = fmaf(a.w, x11, s3);
    a = *(const LAS f32x4*)(Am + 2460);
    s0 = fmaf(a.x, x12, s0);
    s1 = fmaf(a.y, x13, s1);
    s2 = fmaf(a.z, x14, s2);
    s3 = fmaf(a.w, x15, s3);
    a = *(const LAS f32x4*)(Am + 2464);
    s0 = fmaf(a.x, x16, s0);
    s1 = fmaf(a.y, x17, s1);
    s2 = fmaf(a.z, x18, s2);
    s3 = fmaf(a.w, x19, s3);
    a = *(const LAS f32x4*)(Am + 2468);
    s0 = fmaf(a.x, x20, s0);
    s1 = fmaf(a.y, x21, s1);
    s2 = fmaf(a.z, x22, s2);
    s3 = fmaf(a.w, x23, s3);
    a = *(const LAS f32x4*)(Am + 2472);
    s0 = fmaf(a.x, x24, s0);
    s1 = fmaf(a.y, x25, s1);
    s2 = fmaf(a.z, x26, s2);
    s3 = fmaf(a.w, x27, s3);
    a = *(const LAS f32x4*)(Am + 2476);
    s0 = fmaf(a.x, x28, s0);
    s1 = fmaf(a.y, x29, s1);
    s2 = fmaf(a.z, x30, s2);
    s3 = fmaf(a.w, x31, s3);
    a = *(const LAS f32x4*)(Am + 2480);
    s0 = fmaf(a.x, x32, s0);
    s1 = fmaf(a.y, x33, s1);
    s2 = fmaf(a.z, x34, s2);
    const float al36 = a.w;
    x36 = (x36 - ((s0 + s1) + (s2 + s3))) - al36 * x35;
    Tu[4896 + c] = f2bf(x36 * su); Tw[4896 + c] = f2bf(x36 * sw); asm volatile("" ::: "memory");
    float x37 = fmaxf(0.0f, 1.0f - fabsf(cf - 37.0f));
    s0 = 0.f; s1 = 0.f; s2 = 0.f; s3 = 0.f;
    a = *(const LAS f32x4*)(Am + 2516);
    s0 = fmaf(a.x, x0, s0);
    s1 = fmaf(a.y, x1, s1);
    s2 = fmaf(a.z, x2, s2);
    s3 = fmaf(a.w, x3, s3);
    a = *(const LAS f32x4*)(Am + 2520);
    s0 = fmaf(a.x, x4, s0);
    s1 = fmaf(a.y, x5, s1);
    s2 = fmaf(a.z, x6, s2);
    s3 = fmaf(a.w, x7, s3);
    a = *(const LAS f32x4*)(Am + 2524);
    s0 = fmaf(a.x, x8, s0);
    s1 = fmaf(a.y, x9, s1);
    s2 = fmaf(a.z, x10, s2);
    s3 = fmaf(a.w, x11, s3);
    a = *(const LAS f32x4*)(Am + 2528);
    s0 = fmaf(a.x, x12, s0);
    s1 = fmaf(a.y, x13, s1);
    s2 = fmaf(a.z, x14, s2);
    s3 = fmaf(a.w, x15, s3);
    a = *(const LAS f32x4*)(Am + 2532);
    s0 = fmaf(a.x, x16, s0);
    s1 = fmaf(a.y, x17, s1);
    s2 = fmaf(a.z, x18, s2);
    s3 = fmaf(a.w, x19, s3);
    a = *(const LAS f32x4*)(Am + 2536);
    s0 = fmaf(a.x, x20, s0);
    s1 = fmaf(a.y, x21, s1);
    s2 = fmaf(a.z, x22, s2);
    s3 = fmaf(a.w, x23, s3);
    a = *(const LAS f32x4*)(Am + 2540);
    s0 = fmaf(a.x, x24, s0);
    s1 = fmaf(a.y, x25, s1);
    s2 = fmaf(a.z, x26, s2);
    s3 = fmaf(a.w, x27, s3);
    a = *(const LAS f32x4*)(Am + 2544);
    s0 = fmaf(a.x, x28, s0);
    s1 = fmaf(a.y, x29, s1);
    s2 = fmaf(a.z, x30, s2);
    s3 = fmaf(a.w, x31, s3);
    a = *(const LAS f32x4*)(Am + 2548);
    s0 = fmaf(a.x, x32, s0);
    s1 = fmaf(a.y, x33, s1);
    s2 = fmaf(a.z, x34, s2);
    s3 = fmaf(a.w, x35, s3);
    a = *(const LAS f32x4*)(Am + 2552);
    const float al37 = a.x;
    x37 = (x37 - ((s0 + s1) + (s2 + s3))) - al37 * x36;
    Tu[5032 + c] = f2bf(x37 * su); Tw[5032 + c] = f2bf(x37 * sw); asm volatile("" ::: "memory");
    float x38 = fmaxf(0.0f, 1.0f - fabsf(cf - 38.0f));
    s0 = 0.f; s1 = 0.f; s2 = 0.f; s3 = 0.f;
    a = *(const LAS f32x4*)(Am + 2584);
    s0 = fmaf(a.x, x0, s0);
    s1 = fmaf(a.y, x1, s1);
    s2 = fmaf(a.z, x2, s2);
    s3 = fmaf(a.w, x3, s3);
    a = *(const LAS f32x4*)(Am + 2588);
    s0 = fmaf(a.x, x4, s0);
    s1 = fmaf(a.y, x5, s1);
    s2 = fmaf(a.z, x6, s2);
    s3 = fmaf(a.w, x7, s3);
    a = *(const LAS f32x4*)(Am + 2592);
    s0 = fmaf(a.x, x8, s0);
    s1 = fmaf(a.y, x9, s1);
    s2 = fmaf(a.z, x10, s2);
    s3 = fmaf(a.w, x11, s3);
    a = *(const LAS f32x4*)(Am + 2596);
    s0 = fmaf(a.x, x12, s0);
    s1 = fmaf(a.y, x13, s1);
    s2 = fmaf(a.z, x14, s2);
    s3 = fmaf(a.w, x15, s3);
    a = *(const LAS f32x4*)(Am + 2600);
    s0 = fmaf(a.x, x16, s0);
    s1 = fmaf(a.y, x17, s1);
    s2 = fmaf(a.z, x18, s2);
    s3 = fmaf(a.w, x19, s3);
    a = *(const LAS f32x4*)(Am + 2604);
    s0 = fmaf(a.x, x20, s0);
    s1 = fmaf(a.y, x21, s1);
    s2 = fmaf(a.z, x22, s2);
    s3 = fmaf(a.w, x23, s3);
    a = *(const LAS f32x4*)(Am + 2608);
    s0 = fmaf(a.x, x24, s0);
    s1 = fmaf(a.y, x25, s1);
    s2 = fmaf(a.z, x26, s2);
    s3 = fmaf(a.w, x27, s3);
    a = *(const LAS f32x4*)(Am + 2612);
    s0 = fmaf(a.x, x28, s0);
    s1 = fmaf(a.y, x29, s1);
    s2 = fmaf(a.z, x30, s2);
    s3 = fmaf(a.w, x31, s3);
    a = *(const LAS f32x4*)(Am + 2616);
    s0 = fmaf(a.x, x32, s0);
    s1 = fmaf(a.y, x33, s1);
    s2 = fmaf(a.z, x34, s2);
    s3 = fmaf(a.w, x35, s3);
    a = *(const LAS f32x4*)(Am + 2620);
    s0 = fmaf(a.x, x36, s0);
    const float al38 = a.y;
    x38 = (x38 - ((s0 + s1) + (s2 + s3))) - al38 * x37;
    Tu[5168 + c] = f2bf(x38 * su); Tw[5168 + c] = f2bf(x38 * sw); asm volatile("" ::: "memory");
    float x39 = fmaxf(0.0f, 1.0f - fabsf(cf - 39.0f));
    s0 = 0.f; s1 = 0.f; s2 = 0.f; s3 = 0.f;
    a = *(const LAS f32x4*)(Am + 2652);
    s0 = fmaf(a.x, x0, s0);
    s1 = fmaf(a.y, x1, s1);
    s2 = fmaf(a.z, x2, s2);
    s3 = fmaf(a.w, x3, s3);
    a = *(const LAS f32x4*)(Am + 2656);
    s0 = fmaf(a.x, x4, s0);
    s1 = fmaf(a.y, x5, s1);
    s2 = fmaf(a.z, x6, s2);
    s3 = fmaf(a.w, x7, s3);
    a = *(const LAS f32x4*)(Am + 2660);
    s0 = fmaf(a.x, x8, s0);
    s1 = fmaf(a.y, x9, s1);
    s2 = fmaf(a.z, x10, s2);
    s3 = fmaf(a.w, x11, s3);
    a = *(const LAS f32x4*)(Am + 2664);
    s0 = fmaf(a.x, x12, s0);
    s1 = fmaf(a.y, x13, s1);
    s2 = fmaf(a.z, x14, s2);
    s3 = fmaf(a.w, x15, s3);
    a = *(const LAS f32x4*)(Am + 2668);
    s0 = fmaf(a.x, x16, s0);
    s1 = fmaf(a.y, x17, s1);
    s2 = fmaf(a.z, x18, s2);
    s3 = fmaf(a.w, x19, s3);
    a = *(const LAS f32x4*)(Am + 2672);
    s0 = fmaf(a.x, x20, s0);
    s1 = fmaf(a.y, x21, s1);
    s2 = fmaf(a.z, x22, s2);
    s3 = fmaf(a.w, x23, s3);
    a = *(const LAS f32x4*)(Am + 2676);
    s0 = fmaf(a.x, x24, s0);
    s1 = fmaf(a.y, x25, s1);
    s2 = fmaf(a.z, x26, s2);
    s3 = fmaf(a.w, x27, s3);
    a = *(const LAS f32x4*)(Am + 2680);
    s0 = fmaf(a.x, x28, s0);
    s1 = fmaf(a.y, x29, s1);
    s2 = fmaf(a.z, x30, s2);
    s3 = fmaf(a.w, x31, s3);
    a = *(const LAS f32x4*)(Am + 2684);
    s0 = fmaf(a.x, x32, s0);
    s1 = fmaf(a.y, x33, s1);
    s2 = fmaf(a.z, x34, s2);
    s3 = fmaf(a.w, x35, s3);
    a = *(const LAS f32x4*)(Am + 2688);
    s0 = fmaf(a.x, x36, s0);
    s1 = fmaf(a.y, x37, s1);
    const float al39 = a.z;
    x39 = (x39 - ((s0 + s1) + (s2 + s3))) - al39 * x38;
    Tu[5304 + c] = f2bf(x39 * su); Tw[5304 + c] = f2bf(x39 * sw); asm volatile("" ::: "memory");
    float x40 = fmaxf(0.0f, 1.0f - fabsf(cf - 40.0f));
    s0 = 0.f; s1 = 0.f; s2 = 0.f; s3 = 0.f;
    a = *(const LAS f32x4*)(Am + 2720);
    s0 = fmaf(a.x, x0, s0);
    s1 = fmaf(a.y, x1, s1);
    s2 = fmaf(a.z, x2, s2);
    s3 = fmaf(a.w, x3, s3);
    a = *(const LAS f32x4*)(Am + 2724);
    s0 = fmaf(a.x, x4, s0);
    s1 = fmaf(a.y, x5, s1);
    s2 = fmaf(a.z, x6, s2);
    s3 = fmaf(a.w, x7, s3);
    a = *(const LAS f32x4*)(Am + 2728);
    s0 = fmaf(a.x, x8, s0);
    s1 = fmaf(a.y, x9, s1);
    s2 = fmaf(a.z, x10, s2);
    s3 = fmaf(a.w, x11, s3);
    a = *(const LAS f32x4*)(Am + 2732);
    s0 = fmaf(a.x, x12, s0);
    s1 = fmaf(a.y, x13, s1);
    s2 = fmaf(a.z, x14, s2);
    s3 = fmaf(a.w, x15, s3);
    a = *(const LAS f32x4*)(Am + 2736);
    s0 = fmaf(a.x, x16, s0);
    s1 = fmaf(a.y, x17, s1);
    s2 = fmaf(a.z, x18, s2);
    s3 = fmaf(a.w, x19, s3);
    a = *(const LAS f32x4*)(Am + 2740);
    s0 = fmaf(a.x, x20, s0);
    s1 = fmaf(a.y, x21, s1);
    s2 = fmaf(a.z, x22, s2);
    s3 = fmaf(a.w, x23, s3);
    a = *(const LAS f32x4*)(Am + 2744);
    s0 = fmaf(a.x, x24, s0);
    s1 = fmaf(a.y, x25, s1);
    s2 = fmaf(a.z, x26, s2);
    s3 = fmaf(a.w, x27, s3);
    a = *(const LAS f32x4*)(Am + 2748);
    s0 = fmaf(a.x, x28, s0);
    s1 = fmaf(a.y, x29, s1);
    s2 = fmaf(a.z, x30, s2);
    s3 = fmaf(a.w, x31, s3);
    a = *(const LAS f32x4*)(Am + 2752);
    s0 = fmaf(a.x, x32, s0);
    s1 = fmaf(a.y, x33, s1);
    s2 = fmaf(a.z, x34, s2);
    s3 = fmaf(a.w, x35, s3);
    a = *(const LAS f32x4*)(Am + 2756);
    s0 = fmaf(a.x, x36, s0);
    s1 = fmaf(a.y, x37, s1);
    s2 = fmaf(a.z, x38, s2);
    const float al40 = a.w;
    x40 = (x40 - ((s0 + s1) + (s2 + s3))) - al40 * x39;
    Tu[5440 + c] = f2bf(x40 * su); Tw[5440 + c] = f2bf(x40 * sw); asm volatile("" ::: "memory");
    float x41 = fmaxf(0.0f, 1.0f - fabsf(cf - 41.0f));
    s0 = 0.f; s1 = 0.f; s2 = 0.f; s3 = 0.f;
    a = *(const LAS f32x4*)(Am + 2788);
    s0 = fmaf(a.x, x0, s0);
    s1 = fmaf(a.y, x1, s1);
    s2 = fmaf(a.z, x2, s2);
    s3 = fmaf(a.w, x3, s3);
    a = *(const LAS f32x4*)(Am + 2792);
    s0 = fmaf(a.x, x4, s0);
    s1 = fmaf(a.y, x5, s1);
    s2 = fmaf(a.z, x6, s2);
    s3 = fmaf(a.w, x7, s3);
    a = *(const LAS f32x4*)(Am + 2796);
    s0 = fmaf(a.x, x8, s0);
    s1 = fmaf(a.y, x9, s1);
    s2 = fmaf(a.z, x10, s2);
    s3 = fmaf(a.w, x11, s3);
    a = *(const LAS f32x4*)(Am + 2800);
    s0 = fmaf(a.x, x12, s0);
    s1 = fmaf(a.y, x13, s1);
    s2 = fmaf(a.z, x14, s2);
    s3 = fmaf(a.w, x15, s3);
    a = *(const LAS f32x4*)(Am + 2804);
    s0 = fmaf(a.x, x16, s0);
    s1 = fmaf(a.y, x17, s1);
    s2 = fmaf(a.z, x18, s2);
    s3 = fmaf(a.w, x19, s3);
    a = *(const LAS f32x4*)(Am + 2808);
    s0 = fmaf(a.x, x20, s0);
    s1 = fmaf(a.y, x21, s1);
    s2 = fmaf(a.z, x22, s2);
    s3 = fmaf(a.w, x23, s3);
    a = *(const LAS f32x4*)(Am + 2812);
    s0 = fmaf(a.x, x24, s0);
    s1 = fmaf(a.y, x25, s1);
    s2 = fmaf(a.z, x26, s2);
    s3 = fmaf(a.w, x27, s3);
    a = *(const LAS f32x4*)(Am + 2816);
    s0 = fmaf(a.x, x28, s0);
    s1 = fmaf(a.y, x29, s1);
    s2 = fmaf(a.z, x30, s2);
    s3 = fmaf(a.w, x31, s3);
    a = *(const LAS f32x4*)(Am + 2820);
    s0 = fmaf(a.x, x32, s0);
    s1 = fmaf(a.y, x33, s1);
    s2 = fmaf(a.z, x34, s2);
    s3 = fmaf(a.w, x35, s3);
    a = *(const LAS f32x4*)(Am + 2824);
    s0 = fmaf(a.x, x36, s0);
    s1 = fmaf(a.y, x37, s1);
    s2 = fmaf(a.z, x38, s2);
    s3 = fmaf(a.w, x39, s3);
    a = *(const LAS f32x4*)(Am + 2828);
    const float al41 = a.x;
    x41 = (x41 - ((s0 + s1) + (s2 + s3))) - al41 * x40;
    Tu[5576 + c] = f2bf(x41 * su); Tw[5576 + c] = f2bf(x41 * sw); asm volatile("" ::: "memory");
    float x42 = fmaxf(0.0f, 1.0f - fabsf(cf - 42.0f));
    s0 = 0.f; s1 = 0.f; s2 = 0.f; s3 = 0.f;
    a = *(const LAS f32x4*)(Am + 2856);
    s0 = fmaf(a.x, x0, s0);
    s1 = fmaf(a.y, x1, s1);
    s2 = fmaf(a.z, x2, s2);
    s3 = fmaf(a.w, x3, s3);
    a = *(const LAS f32x4*)(Am + 2860);
    s0 = fmaf(a.x, x4, s0);
    s1 = fmaf(a.y, x5, s1);
    s2 = fmaf(a.z, x6, s2);
    s3 = fmaf(a.w, x7, s3);
    a = *(const LAS f32x4*)(Am + 2864);
    s0 = fmaf(a.x, x8, s0);
    s1 = fmaf(a.y, x9, s1);
    s2 = fmaf(a.z, x10, s2);
    s3 = fmaf(a.w, x11, s3);
    a = *(const LAS f32x4*)(Am + 2868);
    s0 = fmaf(a.x, x12, s0);
    s1 = fmaf(a.y, x13, s1);
    s2 = fmaf(a.z, x14, s2);
    s3 = fmaf(a.w, x15, s3);
    a = *(const LAS f32x4*)(Am + 2872);
    s0 = fmaf(a.x, x16, s0);
    s1 = fmaf(a.y, x17, s1);
    s2 = fmaf(a.z, x18, s2);
    s3 = fmaf(a.w, x19, s3);
    a = *(const LAS f32x4*)(Am + 2876);
    s0 = fmaf(a.x, x20, s0);
    s1 = fmaf(a.y, x21, s1);
    s2 = fmaf(a.z, x22, s2);
    s3 = fmaf(a.w, x23, s3);
    a = *(const LAS f32x4*)(Am + 2880);
    s0 = fmaf(a.x, x24, s0);
    s1 = fmaf(a.y, x25, s1);
    s2 = fmaf(a.z, x26, s2);
    s3 = fmaf(a.w, x27, s3);
    a = *(const LAS f32x4*)(Am + 2884);
    s0 = fmaf(a.x, x28, s0);
    s1 = fmaf(a.y, x29, s1);
    s2 = fmaf(a.z, x30, s2);
    s3 = fmaf(a.w, x31, s3);
    a = *(const LAS f32x4*)(Am + 2888);
    s0 = fmaf(a.x, x32, s0);
    s1 = fmaf(a.y, x33, s1);
    s2 = fmaf(a.z, x34, s2);
    s3 = fmaf(a.w, x35, s3);
    a = *(const LAS f32x4*)(Am + 2892);
    s0 = fmaf(a.x, x36, s0);
    s1 = fmaf(a.y, x37, s1);
    s2 = fmaf(a.z, x38, s2);
    s3 = fmaf(a.w, x39, s3);
    a = *(const LAS f32x4*)(Am + 2896);
    s0 = fmaf(a.x, x40, s0);
    const float al42 = a.y;
    x42 = (x42 - ((s0 + s1) + (s2 + s3))) - al42 * x41;
    Tu[5712 + c] = f2bf(x42 * su); Tw[5712 + c] = f2bf(x42 * sw); asm volatile("" ::: "memory");
    float x43 = fmaxf(0.0f, 1.0f - fabsf(cf - 43.0f));
    s0 = 0.f; s1 = 0.f; s2 = 0.f; s3 = 0.f;
    a = *(const LAS f32x4*)(Am + 2924);
    s0 = fmaf(a.x, x0, s0);
    s1 = fmaf(a.y, x1, s1);
    s2 = fmaf(a.z, x2, s2);
    s3 = fmaf(a.w, x3, s3);
    a = *(const LAS f32x4*)(Am + 2928);
    s0 = fmaf(a.x, x4, s0);
    s1 = fmaf(a.y, x5, s1);
    s2 = fmaf(a.z, x6, s2);
    s3 = fmaf(a.w, x7, s3);
    a = *(const LAS f32x4*)(Am + 2932);
    s0 = fmaf(a.x, x8, s0);
    s1 = fmaf(a.y, x9, s1);
    s2 = fmaf(a.z, x10, s2);
    s3 = fmaf(a.w, x11, s3);
    a = *(const LAS f32x4*)(Am + 2936);
    s0 = fmaf(a.x, x12, s0);
    s1 = fmaf(a.y, x13, s1);
    s2 = fmaf(a.z, x14, s2);
    s3 = fmaf(a.w, x15, s3);
    a = *(const LAS f32x4*)(Am + 2940);
    s0 = fmaf(a.x, x16, s0);
    s1 = fmaf(a.y, x17, s1);
    s2 = fmaf(a.z, x18, s2);
    s3 = fmaf(a.w, x19, s3);
    a = *(const LAS f32x4*)(Am + 2944);
    s0 = fmaf(a.x, x20, s0);
    s1 = fmaf(a.y, x21, s1);
    s2 = fmaf(a.z, x22, s2);
    s3 = fmaf(a.w, x23, s3);
    a = *(const LAS f32x4*)(Am + 2948);
    s0 = fmaf(a.x, x24, s0);
    s1 = fmaf(a.y, x25, s1);
    s2 = fmaf(a.z, x26, s2);
    s3 = fmaf(a.w, x27, s3);
    a = *(const LAS f32x4*)(Am + 2952);
    s0 = fmaf(a.x, x28, s0);
    s1 = fmaf(a.y, x29, s1);
    s2 = fmaf(a.z, x30, s2);
    s3 = fmaf(a.w, x31, s3);
    a = *(const LAS f32x4*)(Am + 2956);
    s0 = fmaf(a.x, x32, s0);
    s1 = fmaf(a.y, x33, s1);
    s2 = fmaf(a.z, x34, s2);
    s3 = fmaf(a.w, x35, s3);
    a = *(const LAS f32x4*)(Am + 2960);
    s0 = fmaf(a.x, x36, s0);
    s1 = fmaf(a.y, x37, s1);
    s2 = fmaf(a.z, x38, s2);
    s3 = fmaf(a.w, x39, s3);
    a = *(const LAS f32x4*)(Am + 2964);
    s0 = fmaf(a.x, x40, s0);
    s1 = fmaf(a.y, x41, s1);
    const float al43 = a.z;
    x43 = (x43 - ((s0 + s1) + (s2 + s3))) - al43 * x42;
    Tu[5848 + c] = f2bf(x43 * su); Tw[5848 + c] = f2bf(x43 * sw); asm volatile("" ::: "memory");
    float x44 = fmaxf(0.0f, 1.0f - fabsf(cf - 44.0f));
    s0 = 0.f; s1 = 0.f; s2 = 0.f; s3 = 0.f;
    a = *(const LAS f32x4*)(Am + 2992);
    s0 = fmaf(a.x, x0, s0);
    s1 = fmaf(a.y, x1, s1);
    s2 = fmaf(a.z, x2, s2);
    s3 = fmaf(a.w, x3, s3);
    a = *(const LAS f32x4*)(Am + 2996);
    s0 = fmaf(a.x, x4, s0);
    s1 = fmaf(a.y, x5, s1);
    s2 = fmaf(a.z, x6, s2);
    s3 = fmaf(a.w, x7, s3);
    a = *(const LAS f32x4*)(Am + 3000);
    s0 = fmaf(a.x, x8, s0);
    s1 = fmaf(a.y, x9, s1);
    s2 = fmaf(a.z, x10, s2);
    s3 = fmaf(a.w, x11, s3);
    a = *(const LAS f32x4*)(Am + 3004);
    s0 = fmaf(a.x, x12, s0);
    s1 = fmaf(a.y, x13, s1);
    s2 = fmaf(a.z, x14, s2);
    s3 = fmaf(a.w, x15, s3);
    a = *(const LAS f32x4*)(Am + 3008);
    s0 = fmaf(a.x, x16, s0);
    s1 = fmaf(a.y, x17, s1);
    s2 = fmaf(a.z, x18, s2);
    s3 = fmaf(a.w, x19, s3);
    a = *(const LAS f32x4*)(Am + 3012);
    s0 = fmaf(a.x, x20, s0);
    s1 = fmaf(a.y, x21, s1);
    s2 = fmaf(a.z, x22, s2);
    s3 = fmaf(a.w, x23, s3);
    a = *(const LAS f32x4*)(Am + 3016);
    s0 = fmaf(a.x, x24, s0);
    s1 = fmaf(a.y, x25, s1);
    s2 = fmaf(a.z, x26, s2);
    s3 = fmaf(a.w, x27, s3);
    a = *(const LAS f32x4*)(Am + 3020);
    s0 = fmaf(a.x, x28, s0);
    s1 = fmaf(a.y, x29, s1);
    s2 = fmaf(a.z, x30, s2);
    s3 = fmaf(a.w, x31, s3);
    a = *(const LAS f32x4*)(Am + 3024);
    s0 = fmaf(a.x, x32, s0);
    s1 = fmaf(a.y, x33, s1);
    s2 = fmaf(a.z, x34, s2);
    s3 = fmaf(a.w, x35, s3);
    a = *(const LAS f32x4*)(Am + 3028);
    s0 = fmaf(a.x, x36, s0);
    s1 = fmaf(a.y, x37, s1);
    s2 = fmaf(a.z, x38, s2);
    s3 = fmaf(a.w, x39, s3);
    a = *(const LAS f32x4*)(Am + 3032);
    s0 = fmaf(a.x, x40, s0);
    s1 = fmaf(a.y, x41, s1);
    s2 = fmaf(a.z, x42, s2);
    const float al44 = a.w;
    x44 = (x44 - ((s0 + s1) + (s2 + s3))) - al44 * x43;
    Tu[5984 + c] = f2bf(x44 * su); Tw[5984 + c] = f2bf(x44 * sw); asm volatile("" ::: "memory");
    float x45 = fmaxf(0.0f, 1.0f - fabsf(cf - 45.0f));
    s0 = 0.f; s1 = 0.f; s2 = 0.f; s3 = 0.f;
    a = *(const LAS f32x4*)(Am + 3060);
    s0 = fmaf(a.x, x0, s0);
    s1 = fmaf(a.y, x1, s1);
    s2 = fmaf(a.z, x2, s2);
    s3 = fmaf(a.w, x3, s3);
    a = *(const LAS f32x4*)(Am + 3064);
    s0 = fmaf(a.x, x4, s0);
    s1 = fmaf(a.y, x5, s1);
    s2 = fmaf(a.z, x6, s2);
    s3 = fmaf(a.w, x7, s3);
    a = *(const LAS f32x4*)(Am + 3068);
    s0 = fmaf(a.x, x8, s0);
    s1 = fmaf(a.y, x9, s1);
    s2 = fmaf(a.z, x10, s2);
    s3 = fmaf(a.w, x11, s3);
    a = *(const LAS f32x4*)(Am + 3072);
    s0 = fmaf(a.x, x12, s0);
    s1 = fmaf(a.y, x13, s1);
    s2 = fmaf(a.z, x14, s2);
    s3 = fmaf(a.w, x15, s3);
    a = *(const LAS f32x4*)(Am + 3076);
    s0 = fmaf(a.x, x16, s0);
    s1 = fmaf(a.y, x17, s1);
    s2 = fmaf(a.z, x18, s2);
    s3 = fmaf(a.w, x19, s3);
    a = *(const LAS f32x4*)(Am + 3080);
    s0 = fmaf(a.x, x20, s0);
    s1 = fmaf(a.y, x21, s1);
    s2 = fmaf(a.z, x22, s2);
    s3 = fmaf(a.w, x23, s3);
    a = *(const LAS f32x4*)(Am + 3084);
    s0 = fmaf(a.x, x24, s0);
    s1 = fmaf(a.y, x25, s1);
    s2 = fmaf(a.z, x26, s2);
    s3 = fmaf(a.w, x27, s3);
    a = *(const LAS f32x4*)(Am + 3088);
    s0 = fmaf(a.x, x28, s0);
    s1 = fmaf(a.y, x29, s1);
    s2 = fmaf(a.z, x30, s2);
    s3 = fmaf(a.w, x31, s3);
    a = *(const LAS f32x4*)(Am + 3092);
    s0 = fmaf(a.x, x32, s0);
    s1 = fmaf(a.y, x33, s1);
    s2 = fmaf(a.z, x34, s2);
    s3 = fmaf(a.w, x35, s3);
    a = *(const LAS f32x4*)(Am + 3096);
    s0 = fmaf(a.x, x36, s0);
    s1 = fmaf(a.y, x37, s1);
    s2 = fmaf(a.z, x38, s2);
    s3 = fmaf(a.w, x39, s3);
    a = *(const LAS f32x4*)(Am + 3100);
    s0 = fmaf(a.x, x40, s0);
    s1 = fmaf(a.y, x41, s1);
    s2 = fmaf(a.z, x42, s2);
    s3 = fmaf(a.w, x43, s3);
    a = *(const LAS f32x4*)(Am + 3104);
    const float al45 = a.x;
    x45 = (x45 - ((s0 + s1) + (s2 + s3))) - al45 * x44;
    Tu[6120 + c] = f2bf(x45 * su); Tw[6120 + c] = f2bf(x45 * sw); asm volatile("" ::: "memory");
    float x46 = fmaxf(0.0f, 1.0f - fabsf(cf - 46.0f));
    s0 = 0.f; s1 = 0.f; s2 = 0.f; s3 = 0.f;
    a = *(const LAS f32x4*)(Am + 3128);
    s0 = fmaf(a.x, x0, s0);
    s1 = fmaf(a.y, x1, s1);
    s2 = fmaf(a.z, x2, s2);
    s3 = fmaf(a.w, x3, s3);
    a = *(const LAS f32x4*)(Am + 3132);
    s0 = fmaf(a.x, x4, s0);
    s1 = fmaf(a.y, x5, s1);
    s2 = fmaf(a.z, x6, s2);
    s3 = fmaf(a.w, x7, s3);
    a = *(const LAS f32x4*)(Am + 3136);
    s0 = fmaf(a.x, x8, s0);
    s1 = fmaf(a.y, x9, s1);
    s2 = fmaf(a.z, x10, s2);
    s3 = fmaf(a.w, x11, s3);
    a = *(const LAS f32x4*)(Am + 3140);
    s0 = fmaf(a.x, x12, s0);
    s1 = fmaf(a.y, x13, s1);
    s2 = fmaf(a.z, x14, s2);
    s3 = fmaf(a.w, x15, s3);
    a = *(const LAS f32x4*)(Am + 3144);
    s0 = fmaf(a.x, x16, s0);
    s1 = fmaf(a.y, x17, s1);
    s2 = fmaf(a.z, x18, s2);
    s3 = fmaf(a.w, x19, s3);
    a = *(const LAS f32x4*)(Am + 3148);
    s0 = fmaf(a.x, x20, s0);
    s1 = fmaf(a.y, x21, s1);
    s2 = fmaf(a.z, x22, s2);
    s3 = fmaf(a.w, x23, s3);
    a = *(const LAS f32x4*)(Am + 3152);
    s0 = fmaf(a.x, x24, s0);
    s1 = fmaf(a.y, x25, s1);
    s2 = fmaf(a.z, x26, s2);
    s3 = fmaf(a.w, x27, s3);
    a = *(const LAS f32x4*)(Am + 3156);
    s0 = fmaf(a.x, x28, s0);
    s1 = fmaf(a.y, x29, s1);
    s2 = fmaf(a.z, x30, s2);
    s3 = fmaf(a.w, x31, s3);
    a = *(const LAS f32x4*)(Am + 3160);
    s0 = fmaf(a.x, x32, s0);
    s1 = fmaf(a.y, x33, s1);
    s2 = fmaf(a.z, x34, s2);
    s3 = fmaf(a.w, x35, s3);
    a = *(const LAS f32x4*)(Am + 3164);
    s0 = fmaf(a.x, x36, s0);
    s1 = fmaf(a.y, x37, s1);
    s2 = fmaf(a.z, x38, s2);
    s3 = fmaf(a.w, x39, s3);
    a = *(const LAS f32x4*)(Am + 3168);
    s0 = fmaf(a.x, x40, s0);
    s1 = fmaf(a.y, x41, s1);
    s2 = fmaf(a.z, x42, s2);
    s3 = fmaf(a.w, x43, s3);
    a = *(const LAS f32x4*)(Am + 3172);
    s0 = fmaf(a.x, x44, s0);
    const float al46 = a.y;
    x46 = (x46 - ((s0 + s1) + (s2 + s3))) - al46 * x45;
    Tu[6256 + c] = f2bf(x46 * su); Tw[6256 + c] = f2bf(x46 * sw); asm volatile("" ::: "memory");
    float x47 = fmaxf(0.0f, 1.0f - fabsf(cf - 47.0f));
    s0 = 0.f; s1 = 0.f; s2 = 0.f; s3 = 0.f;
    a = *(const LAS f32x4*)(Am + 3196);
    s0 = fmaf(a.x, x0, s0);
    s1 = fmaf(a.y, x1, s1);
    s2 = fmaf(a.z, x2, s2);
    s3 = fmaf(a.w, x3, s3);
    a = *(const LAS f32x4*)(Am + 3200);
    s0 = fmaf(a.x, x4, s0);
    s1 = fmaf(a.y, x5, s1);
    s2 = fmaf(a.z, x6, s2);
    s3 = fmaf(a.w, x7, s3);
    a = *(const LAS f32x4*)(Am + 3204);
    s0 = fmaf(a.x, x8, s0);
    s1 = fmaf(a.y, x9, s1);
    s2 = fmaf(a.z, x10, s2);
    s3 = fmaf(a.w, x11, s3);
    a = *(const LAS f32x4*)(Am + 3208);
    s0 = fmaf(a.x, x12, s0);
    s1 = fmaf(a.y, x13, s1);
    s2 = fmaf(a.z, x14, s2);
    s3 = fmaf(a.w, x15, s3);
    a = *(const LAS f32x4*)(Am + 3212);
    s0 = fmaf(a.x, x16, s0);
    s1 = fmaf(a.y, x17, s1);
    s2 = fmaf(a.z, x18, s2);
    s3 = fmaf(a.w, x19, s3);
    a = *(const LAS f32x4*)(Am + 3216);
    s0 = fmaf(a.x, x20, s0);
    s1 = fmaf(a.y, x21, s1);
    s2 = fmaf(a.z, x22, s2);
    s3 = fmaf(a.w, x23, s3);
    a = *(const LAS f32x4*)(Am + 3220);
    s0 = fmaf(a.x, x24, s0);
    s1 = fmaf(a.y, x25, s1);
    s2 = fmaf(a.z, x26, s2);
    s3 = fmaf(a.w, x27, s3);
    a = *(const LAS f32x4*)(Am + 3224);
    s0 = fmaf(a.x, x28, s0);
    s1 = fmaf(a.y, x29, s1);
    s2 = fmaf(a.z, x30, s2);
    s3 = fmaf(a.w, x31, s3);
    a = *(const LAS f32x4*)(Am + 3228);
    s0 = fmaf(a.x, x32, s0);
    s1 = fmaf(a.y, x33, s1);
    s2 = fmaf(a.z, x34, s2);
    s3 = fmaf(a.w, x35, s3);
    a = *(const LAS f32x4*)(Am + 3232);
    s0 = fmaf(a.x, x36, s0);
    s1 = fmaf(a.y, x37, s1);
    s2 = fmaf(a.z, x38, s2);
    s3 = fmaf(a.w, x39, s3);
    a = *(const LAS f32x4*)(Am + 3236);
    s0 = fmaf(a.x, x40, s0);
    s1 = fmaf(a.y, x41, s1);
    s2 = fmaf(a.z, x42, s2);
    s3 = fmaf(a.w, x43, s3);
    a = *(const LAS f32x4*)(Am + 3240);
    s0 = fmaf(a.x, x44, s0);
    s1 = fmaf(a.y, x45, s1);
    const float al47 = a.z;
    x47 = (x47 - ((s0 + s1) + (s2 + s3))) - al47 * x46;
    Tu[6392 + c] = f2bf(x47 * su); Tw[6392 + c] = f2bf(x47 * sw); asm volatile("" ::: "memory");
    float x48 = fmaxf(0.0f, 1.0f - fabsf(cf - 48.0f));
    s0 = 0.f; s1 = 0.f; s2 = 0.f; s3 = 0.f;
    a = *(const LAS f32x4*)(Am + 3264);
    s0 = fmaf(a.x, x0, s0);
    s1 = fmaf(a.y, x1, s1);
    s2 = fmaf(a.z, x2, s2);
    s3 = fmaf(a.w, x3, s3);
    a = *(const LAS f32x4*)(Am + 3268);
    s0 = fmaf(a.x, x4, s0);
    s1 = fmaf(a.y, x5, s1);
    s2 = fmaf(a.z, x6, s2);
    s3 = fmaf(a.w, x7, s3);
    a = *(const LAS f32x4*)(Am + 3272);
    s0 = fmaf(a.x, x8, s0);
    s1 = fmaf(a.y, x9, s1);
    s2 = fmaf(a.z, x10, s2);
    s3 = fmaf(a.w, x11, s3);
    a = *(const LAS f32x4*)(Am + 3276);
    s0 = fmaf(a.x, x12, s0);
    s1 = fmaf(a.y, x13, s1);
    s2 = fmaf(a.z, x14, s2);
    s3 = fmaf(a.w, x15, s3);
    a = *(const LAS f32x4*)(Am + 3280);
    s0 = fmaf(a.x, x16, s0);
    s1 = fmaf(a.y, x17, s1);
    s2 = fmaf(a.z, x18, s2);
    s3 = fmaf(a.w, x19, s3);
    a = *(const LAS f32x4*)(Am + 3284);
    s0 = fmaf(a.x, x20, s0);
    s1 = fmaf(a.y, x21, s1);
    s2 = fmaf(a.z, x22, s2);
    s3 = fmaf(a.w, x23, s3);
    a = *(const LAS f32x4*)(Am + 3288);
    s0 = fmaf(a.x, x24, s0);
    s1 = fmaf(a.y, x25, s1);
    s2 = fmaf(a.z, x26, s2);
    s3 = fmaf(a.w, x27, s3);
    a = *(const LAS f32x4*)(Am + 3292);
    s0 = fmaf(a.x, x28, s0);
    s1 = fmaf(a.y, x29, s1);
    s2 = fmaf(a.z, x30, s2);
    s3 = fmaf(a.w, x31, s3);
    a = *(const LAS f32x4*)(Am + 3296);
    s0 = fmaf(a.x, x32, s0);
    s1 = fmaf(a.y, x33, s1);
    s2 = fmaf(a.z, x34, s2);
    s3 = fmaf(a.w, x35, s3);
    a = *(const LAS f32x4*)(Am + 3300);
    s0 = fmaf(a.x, x36, s0);
    s1 = fmaf(a.y, x37, s1);
    s2 = fmaf(a.z, x38, s2);
    s3 = fmaf(a.w, x39, s3);
    a = *(const LAS f32x4*)(Am + 3304);
    s0 = fmaf(a.x, x40, s0);
    s1 = fmaf(a.y, x41, s1);
    s2 = fmaf(a.z, x42, s2);
    s3 = fmaf(a.w, x43, s3);
    a = *(const LAS f32x4*)(Am + 3308);
    s0 = fmaf(a.x, x44, s0);
    s1 = fmaf(a.y, x45, s1);
    s2 = fmaf(a.z, x46, s2);
    const float al48 = a.w;
    x48 = (x48 - ((s0 + s1) + (s2 + s3))) - al48 * x47;
    Tu[6528 + c] = f2bf(x48 * su); Tw[6528 + c] = f2bf(x48 * sw); asm volatile("" ::: "memory");
    float x49 = fmaxf(0.0f, 1.0f - fabsf(cf - 49.0f));
    s0 = 0.f; s1 = 0.f; s2 = 0.f; s3 = 0.f;
    a = *(const LAS f32x4*)(Am + 3332);
    s0 = fmaf(a.x, x0, s0);
    s1 = fmaf(a.y, x1, s1);
    s2 = fmaf(a.z, x2, s2);
    s3 = fmaf(a.w, x3, s3);
    a = *(const LAS f32x4*)(Am + 3336);
    s0 = fmaf(a.x, x4, s0);
    s1 = fmaf(a.y, x5, s1);
    s2 = fmaf(a.z, x6, s2);
    s3 = fmaf(a.w, x7, s3);
    a = *(const LAS f32x4*)(Am + 3340);
    s0 = fmaf(a.x, x8, s0);
    s1 = fmaf(a.y, x9, s1);
    s2 = fmaf(a.z, x10, s2);
    s3 = fmaf(a.w, x11, s3);
    a = *(const LAS f32x4*)(Am + 3344);
    s0 = fmaf(a.x, x12, s0);
    s1 = fmaf(a.y, x13, s1);
    s2 = fmaf(a.z, x14, s2);
    s3 = fmaf(a.w, x15, s3);
    a = *(const LAS f32x4*)(Am + 3348);
    s0 = fmaf(a.x, x16, s0);
    s1 = fmaf(a.y, x17, s1);
    s2 = fmaf(a.z, x18, s2);
    s3 = fmaf(a.w, x19, s3);
    a = *(const LAS f32x4*)(Am + 3352);
    s0 = fmaf(a.x, x20, s0);
    s1 = fmaf(a.y, x21, s1);
    s2 = fmaf(a.z, x22, s2);
    s3 = fmaf(a.w, x23, s3);
    a = *(const LAS f32x4*)(Am + 3356);
    s0 = fmaf(a.x, x24, s0);
    s1 = fmaf(a.y, x25, s1);
    s2 = fmaf(a.z, x26, s2);
    s3 = fmaf(a.w, x27, s3);
    a = *(const LAS f32x4*)(Am + 3360);
    s0 = fmaf(a.x, x28, s0);
    s1 = fmaf(a.y, x29, s1);
    s2 = fmaf(a.z, x30, s2);
    s3 = fmaf(a.w, x31, s3);
    a = *(const LAS f32x4*)(Am + 3364);
    s0 = fmaf(a.x, x32, s0);
    s1 = fmaf(a.y, x33, s1);
    s2 = fmaf(a.z, x34, s2);
    s3 = fmaf(a.w, x35, s3);
    a = *(const LAS f32x4*)(Am + 3368);
    s0 = fmaf(a.x, x36, s0);
    s1 = fmaf(a.y, x37, s1);
    s2 = fmaf(a.z, x38, s2);
    s3 = fmaf(a.w, x39, s3);
    a = *(const LAS f32x4*)(Am + 3372);
    s0 = fmaf(a.x, x40, s0);
    s1 = fmaf(a.y, x41, s1);
    s2 = fmaf(a.z, x42, s2);
    s3 = fmaf(a.w, x43, s3);
    a = *(const LAS f32x4*)(Am + 3376);
    s0 = fmaf(a.x, x44, s0);
    s1 = fmaf(a.y, x45, s1);
    s2 = fmaf(a.z, x46, s2);
    s3 = fmaf(a.w, x47, s3);
    a = *(const LAS f32x4*)(Am + 3380);
    const float al49 = a.x;
    x49 = (x49 - ((s0 + s1) + (s2 + s3))) - al49 * x48;
    Tu[6664 + c] = f2bf(x49 * su); Tw[6664 + c] = f2bf(x49 * sw); asm volatile("" ::: "memory");
    float x50 = fmaxf(0.0f, 1.0f - fabsf(cf - 50.0f));
    s0 = 0.f; s1 = 0.f; s2 = 0.f; s3 = 0.f;
    a = *(const LAS f32x4*)(Am + 3400);
    s0 = fmaf(a.x, x0, s0);
    s1 = fmaf(a.y, x1, s1);
    s2 = fmaf(a.z, x2, s2);
    s3 = fmaf(a.w, x3, s3);
    a = *(const LAS f32x4*)(Am + 3404);
    s0 = fmaf(a.x, x4, s0);
    s1 = fmaf(a.y, x5, s1);
    s2 = fmaf(a.z, x6, s2);
    s3 = fmaf(a.w, x7, s3);
    a = *(const LAS f32x4*)(Am + 3408);
    s0 = fmaf(a.x, x8, s0);
    s1 = fmaf(a.y, x9, s1);
    s2 = fmaf(a.z, x10, s2);
    s3 = fmaf(a.w, x11, s3);
    a = *(const LAS f32x4*)(Am + 3412);
    s0 = fmaf(a.x, x12, s0);
    s1 = fmaf(a.y, x13, s1);
    s2 = fmaf(a.z, x14, s2);
    s3 = fmaf(a.w, x15, s3);
    a = *(const LAS f32x4*)(Am + 3416);
    s0 = fmaf(a.x, x16, s0);
    s1 = fmaf(a.y, x17, s1);
    s2 = fmaf(a.z, x18, s2);
    s3 = fmaf(a.w, x19, s3);
    a = *(const LAS f32x4*)(Am + 3420);
    s0 = fmaf(a.x, x20, s0);
    s1 = fmaf(a.y, x21, s1);
    s2 = fmaf(a.z, x22, s2);
    s3 = fmaf(a.w, x23, s3);
    a = *(const LAS f32x4*)(Am + 3424);
    s0 = fmaf(a.x, x24, s0);
    s1 = fmaf(a.y, x25, s1);
    s2 = fmaf(a.z, x26, s2);
    s3 = fmaf(a.w, x27, s3);
    a = *(const LAS f32x4*)(Am + 3428);
    s0 = fmaf(a.x, x28, s0);
    s1 = fmaf(a.y, x29, s1);
    s2 = fmaf(a.z, x30, s2);
    s3 = fmaf(a.w, x31, s3);
    a = *(const LAS f32x4*)(Am + 3432);
    s0 = fmaf(a.x, x32, s0);
    s1 = fmaf(a.y, x33, s1);
    s2 = fmaf(a.z, x34, s2);
    s3 = fmaf(a.w, x35, s3);
    a = *(const LAS f32x4*)(Am + 3436);
    s0 = fmaf(a.x, x36, s0);
    s1 = fmaf(a.y, x37, s1);
    s2 = fmaf(a.z, x38, s2);
    s3 = fmaf(a.w, x39, s3);
    a = *(const LAS f32x4*)(Am + 3440);
    s0 = fmaf(a.x, x40, s0);
    s1 = fmaf(a.y, x41, s1);
    s2 = fmaf(a.z, x42, s2);
    s3 = fmaf(a.w, x43, s3);
    a = *(const LAS f32x4*)(Am + 3444);
    s0 = fmaf(a.x, x44, s0);
    s1 = fmaf(a.y, x45, s1);
    s2 = fmaf(a.z, x46, s2);
    s3 = fmaf(a.w, x47, s3);
    a = *(const LAS f32x4*)(Am + 3448);
    s0 = fmaf(a.x, x48, s0);
    const float al50 = a.y;
    x50 = (x50 - ((s0 + s1) + (s2 + s3))) - al50 * x49;
    Tu[6800 + c] = f2bf(x50 * su); Tw[6800 + c] = f2bf(x50 * sw); asm volatile("" ::: "memory");
    float x51 = fmaxf(0.0f, 1.0f - fabsf(cf - 51.0f));
    s0 = 0.f; s1 = 0.f; s2 = 0.f; s3 = 0.f;
    a = *(const LAS f32x4*)(Am + 3468);
    s0 = fmaf(a.x, x0, s0);
    s1 = fmaf(a.y, x1, s1);
    s2 = fmaf(a.z, x2, s2);
    s3 = fmaf(a.w, x3, s3);
    a = *(const LAS f32x4*)(Am + 3472);
    s0 = fmaf(a.x, x4, s0);
    s1 = fmaf(a.y, x5, s1);
    s2 = fmaf(a.z, x6, s2);
    s3 = fmaf(a.w, x7, s3);
    a = *(const LAS f32x4*)(Am + 3476);
    s0 = fmaf(a.x, x8, s0);
    s1 = fmaf(a.y, x9, s1);
    s2 = fmaf(a.z, x10, s2);
    s3 = fmaf(a.w, x11, s3);
    a = *(const LAS f32x4*)(Am + 3480);
    s0 = fmaf(a.x, x12, s0);
    s1 = fmaf(a.y, x13, s1);
    s2 = fmaf(a.z, x14, s2);
    s3 = fmaf(a.w, x15, s3);
    a = *(const LAS f32x4*)(Am + 3484);
    s0 = fmaf(a.x, x16, s0);
    s1 = fmaf(a.y, x17, s1);
    s2 = fmaf(a.z, x18, s2);
    s3 = fmaf(a.w, x19, s3);
    a = *(const LAS f32x4*)(Am + 3488);
    s0 = fmaf(a.x, x20, s0);
    s1 = fmaf(a.y, x21, s1);
    s2 = fmaf(a.z, x22, s2);
    s3 = fmaf(a.w, x23, s3);
    a = *(const LAS f32x4*)(Am + 3492);
    s0 = fmaf(a.x, x24, s0);
    s1 = fmaf(a.y, x25, s1);
    s2 = fmaf(a.z, x26, s2);
    s3 = fmaf(a.w, x27, s3);
    a = *(const LAS f32x4*)(Am + 3496);
    s0 = fmaf(a.x, x28, s0);
    s1 = fmaf(a.y, x29, s1);
    s2 = fmaf(a.z, x30, s2);
    s3 = fmaf(a.w, x31, s3);
    a = *(const LAS f32x4*)(Am + 3500);
    s0 = fmaf(a.x, x32, s0);
    s1 = fmaf(a.y, x33, s1);
    s2 = fmaf(a.z, x34, s2);
    s3 = fmaf(a.w, x35, s3);
    a = *(const LAS f32x4*)(Am + 3504);
    s0 = fmaf(a.x, x36, s0);
    s1 = fmaf(a.y, x37, s1);
    s2 = fmaf(a.z, x38, s2);
    s3 = fmaf(a.w, x39, s3);
    a = *(const LAS f32x4*)(Am + 3508);
    s0 = fmaf(a.x, x40, s0);
    s1 = fmaf(a.y, x41, s1);
    s2 = fmaf(a.z, x42, s2);
    s3 = fmaf(a.w, x43, s3);
    a = *(const LAS f32x4*)(Am + 3512);
    s0 = fmaf(a.x, x44, s0);
    s1 = fmaf(a.y, x45, s1);
    s2 = fmaf(a.z, x46, s2);
    s3 = fmaf(a.w, x47, s3);
    a = *(const LAS f32x4*)(Am + 3516);
    s0 = fmaf(a.x, x48, s0);
    s1 = fmaf(a.y, x49, s1);
    const float al51 = a.z;
    x51 = (x51 - ((s0 + s1) + (s2 + s3))) - al51 * x50;
    Tu[6936 + c] = f2bf(x51 * su); Tw[6936 + c] = f2bf(x51 * sw); asm volatile("" ::: "memory");
    float x52 = fmaxf(0.0f, 1.0f - fabsf(cf - 52.0f));
    s0 = 0.f; s1 = 0.f; s2 = 0.f; s3 = 0.f;
    a = *(const LAS f32x4*)(Am + 3536);
    s0 = fmaf(a.x, x0, s0);
    s1 = fmaf(a.y, x1, s1);
    s2 = fmaf(a.z, x2, s2);
    s3 = fmaf(a.w, x3, s3);
    a = *(const LAS f32x4*)(Am + 3540);
    s0 = fmaf(a.x, x4, s0);
    s1 = fmaf(a.y, x5, s1);
    s2 = fmaf(a.z, x6, s2);
    s3 = fmaf(a.w, x7, s3);
    a = *(const LAS f32x4*)(Am + 3544);
    s0 = fmaf(a.x, x8, s0);
    s1 = fmaf(a.y, x9, s1);
    s2 = fmaf(a.z, x10, s2);
    s3 = fmaf(a.w, x11, s3);
    a = *(const LAS f32x4*)(Am + 3548);
    s0 = fmaf(a.x, x12, s0);
    s1 = fmaf(a.y, x13, s1);
    s2 = fmaf(a.z, x14, s2);
    s3 = fmaf(a.w, x15, s3);
    a = *(const LAS f32x4*)(Am + 3552);
    s0 = fmaf(a.x, x16, s0);
    s1 = fmaf(a.y, x17, s1);
    s2 = fmaf(a.z, x18, s2);
    s3 = fmaf(a.w, x19, s3);
    a = *(const LAS f32x4*)(Am + 3556);
    s0 = fmaf(a.x, x20, s0);
    s1 = fmaf(a.y, x21, s1);
    s2 = fmaf(a.z, x22, s2);
    s3 = fmaf(a.w, x23, s3);
    a = *(const LAS f32x4*)(Am + 3560);
    s0 = fmaf(a.x, x24, s0);
    s1 = fmaf(a.y, x25, s1);
    s2 = fmaf(a.z, x26, s2);
    s3 = fmaf(a.w, x27, s3);
    a = *(const LAS f32x4*)(Am + 3564);
    s0 = fmaf(a.x, x28, s0);
    s1 = fmaf(a.y, x29, s1);
    s2 = fmaf(a.z, x30, s2);
    s3 = fmaf(a.w, x31, s3);
    a = *(const LAS f32x4*)(Am + 3568);
    s0 = fmaf(a.x, x32, s0);
    s1 = fmaf(a.y, x33, s1);
    s2 = fmaf(a.z, x34, s2);
    s3 = fmaf(a.w, x35, s3);
    a = *(const LAS f32x4*)(Am + 3572);
    s0 = fmaf(a.x, x36, s0);
    s1 = fmaf(a.y, x37, s1);
    s2 = fmaf(a.z, x38, s2);
    s3 = fmaf(a.w, x39, s3);
    a = *(const LAS f32x4*)(Am + 3576);
    s0 = fmaf(a.x, x40, s0);
    s1 = fmaf(a.y, x41, s1);
    s2 = fmaf(a.z, x42, s2);
    s3 = fmaf(a.w, x43, s3);
    a = *(const LAS f32x4*)(Am + 3580);
    s0 = fmaf(a.x, x44, s0);
    s1 = fmaf(a.y, x45, s1);
    s2 = fmaf(a.z, x46, s2);
    s3 = fmaf(a.w, x47, s3);
    a = *(const LAS f32x4*)(Am + 3584);
    s0 = fmaf(a.x, x48, s0);
    s1 = fmaf(a.y, x49, s1);
    s2 = fmaf(a.z, x50, s2);
    const float al52 = a.w;
    x52 = (x52 - ((s0 + s1) + (s2 + s3))) - al52 * x51;
    Tu[7072 + c] = f2bf(x52 * su); Tw[7072 + c] = f2bf(x52 * sw); asm volatile("" ::: "memory");
    float x53 = fmaxf(0.0f, 1.0f - fabsf(cf - 53.0f));
    s0 = 0.f; s1 = 0.f; s2 = 0.f; s3 = 0.f;
    a = *(const LAS f32x4*)(Am + 3604);
    s0 = fmaf(a.x, x0, s0);
    s1 = fmaf(a.y, x1, s1);
    s2 = fmaf(a.z, x2, s2);
    s3 = fmaf(a.w, x3, s3);
    a = *(const LAS f32x4*)(Am + 3608);
    s0 = fmaf(a.x, x4, s0);
    s1 = fmaf(a.y, x5, s1);
    s2 = fmaf(a.z, x6, s2);
    s3 = fmaf(a.w, x7, s3);
    a = *(const LAS f32x4*)(Am + 3612);
    s0 = fmaf(a.x, x8, s0);
    s1 = fmaf(a.y, x9, s1);
    s2 = fmaf(a.z, x10, s2);
    s3 = fmaf(a.w, x11, s3);
    a = *(const LAS f32x4*)(Am + 3616);
    s0 = fmaf(a.x, x12, s0);
    s1 = fmaf(a.y, x13, s1);
    s2 = fmaf(a.z, x14, s2);
    s3 = fmaf(a.w, x15, s3);
    a = *(const LAS f32x4*)(Am + 3620);
    s0 = fmaf(a.x, x16, s0);
    s1 = fmaf(a.y, x17, s1);
    s2 = fmaf(a.z, x18, s2);
    s3 = fmaf(a.w, x19, s3);
    a = *(const LAS f32x4*)(Am + 3624);
    s0 = fmaf(a.x, x20, s0);
    s1 = fmaf(a.y, x21, s1);
    s2 = fmaf(a.z, x22, s2);
    s3 = fmaf(a.w, x23, s3);
    a = *(const LAS f32x4*)(Am + 3628);
    s0 = fmaf(a.x, x24, s0);
    s1 = fmaf(a.y, x25, s1);
    s2 = fmaf(a.z, x26, s2);
    s3 = fmaf(a.w, x27, s3);
    a = *(const LAS f32x4*)(Am + 3632);
    s0 = fmaf(a.x, x28, s0);
    s1 = fmaf(a.y, x29, s1);
    s2 = fmaf(a.z, x30, s2);
    s3 = fmaf(a.w, x31, s3);
    a = *(const LAS f32x4*)(Am + 3636);
    s0 = fmaf(a.x, x32, s0);
    s1 = fmaf(a.y, x33, s1);
    s2 = fmaf(a.z, x34, s2);
    s3 = fmaf(a.w, x35, s3);
    a = *(const LAS f32x4*)(Am + 3640);
    s0 = fmaf(a.x, x36, s0);
    s1 = fmaf(a.y, x37, s1);
    s2 = fmaf(a.z, x38, s2);
    s3 = fmaf(a.w, x39, s3);
    a = *(const LAS f32x4*)(Am + 3644);
    s0 = fmaf(a.x, x40, s0);
    s1 = fmaf(a.y, x41, s1);
    s2 = fmaf(a.z, x42, s2);
    s3 = fmaf(a.w, x43, s3);
    a = *(const LAS f32x4*)(Am + 3648);
    s0 = fmaf(a.x, x44, s0);
    s1 = fmaf(a.y, x45, s1);
    s2 = fmaf(a.z, x46, s2);
    s3 = fmaf(a.w, x47, s3);
    a = *(const LAS f32x4*)(Am + 3652);
    s0 = fmaf(a.x, x48, s0);
    s1 = fmaf(a.y, x49, s1);
    s2 = fmaf(a.z, x50, s2);
    s3 = fmaf(a.w, x51, s3);
    a = *(const LAS f32x4*)(Am + 3656);
    const float al53 = a.x;
    x53 = (x53 - ((s0 + s1) + (s2 + s3))) - al53 * x52;
    Tu[7208 + c] = f2bf(x53 * su); Tw[7208 + c] = f2bf(x53 * sw); asm volatile("" ::: "memory");
    float x54 = fmaxf(0.0f, 1.0f - fabsf(cf - 54.0f));
    s0 = 0.f; s1 = 0.f; s2 = 0.f; s3 = 0.f;
    a = *(const LAS f32x4*)(Am + 3672);
    s0 = fmaf(a.x, x0, s0);
    s1 = fmaf(a.y, x1, s1);
    s2 = fmaf(a.z, x2, s2);
    s3 = fmaf(a.w, x3, s3);
    a = *(const LAS f32x4*)(Am + 3676);
    s0 = fmaf(a.x, x4, s0);
    s1 = fmaf(a.y, x5, s1);
    s2 = fmaf(a.z, x6, s2);
    s3 = fmaf(a.w, x7, s3);
    a = *(const LAS f32x4*)(Am + 3680);
    s0 = fmaf(a.x, x8, s0);
    s1 = fmaf(a.y, x9, s1);
    s2 = fmaf(a.z, x10, s2);
    s3 = fmaf(a.w, x11, s3);
    a = *(const LAS f32x4*)(Am + 3684);
    s0 = fmaf(a.x, x12, s0);
    s1 = fmaf(a.y, x13, s1);
    s2 = fmaf(a.z, x14, s2);
    s3 = fmaf(a.w, x15, s3);
    a = *(const LAS f32x4*)(Am + 3688);
    s0 = fmaf(a.x, x16, s0);
    s1 = fmaf(a.y, x17, s1);
    s2 = fmaf(a.z, x18, s2);
    s3 = fmaf(a.w, x19, s3);
    a = *(const LAS f32x4*)(Am + 3692);
    s0 = fmaf(a.x, x20, s0);
    s1 = fmaf(a.y, x21, s1);
    s2 = fmaf(a.z, x22, s2);
    s3 = fmaf(a.w, x23, s3);
    a = *(const LAS f32x4*)(Am + 3696);
    s0 = fmaf(a.x, x24, s0);
    s1 = fmaf(a.y, x25, s1);
    s2 = fmaf(a.z, x26, s2);
    s3 = fmaf(a.w, x27, s3);
    a = *(const LAS f32x4*)(Am + 3700);
    s0 = fmaf(a.x, x28, s0);
    s1 = fmaf(a.y, x29, s1);
    s2 = fmaf(a.z, x30, s2);
    s3 = fmaf(a.w, x31, s3);
    a = *(const LAS f32x4*)(Am + 3704);
    s0 = fmaf(a.x, x32, s0);
    s1 = fmaf(a.y, x33, s1);
    s2 = fmaf(a.z, x34, s2);
    s3 = fmaf(a.w, x35, s3);
    a = *(const LAS f32x4*)(Am + 3708);
    s0 = fmaf(a.x, x36, s0);
    s1 = fmaf(a.y, x37, s1);
    s2 = fmaf(a.z, x38, s2);
    s3 = fmaf(a.w, x39, s3);
    a = *(const LAS f32x4*)(Am + 3712);
    s0 = fmaf(a.x, x40, s0);
    s1 = fmaf(a.y, x41, s1);
    s2 = fmaf(a.z, x42, s2);
    s3 = fmaf(a.w, x43, s3);
    a = *(const LAS f32x4*)(Am + 3716);
    s0 = fmaf(a.x, x44, s0);
    s1 = fmaf(a.y, x45, s1);
    s2 = fmaf(a.z, x46, s2);
    s3 = fmaf(a.w, x47, s3);
    a = *(const LAS f32x4*)(Am + 3720);
    s0 = fmaf(a.x, x48, s0);
    s1 = fmaf(a.y, x49, s1);
    s2 = fmaf(a.z, x50, s2);
    s3 = fmaf(a.w, x51, s3);
    a = *(const LAS f32x4*)(Am + 3724);
    s0 = fmaf(a.x, x52, s0);
    const float al54 = a.y;
    x54 = (x54 - ((s0 + s1) + (s2 + s3))) - al54 * x53;
    Tu[7344 + c] = f2bf(x54 * su); Tw[7344 + c] = f2bf(x54 * sw); asm volatile("" ::: "memory");
    float x55 = fmaxf(0.0f, 1.0f - fabsf(cf - 55.0f));
    s0 = 0.f; s1 = 0.f; s2 = 0.f; s3 = 0.f;
    a = *(const LAS f32x4*)(Am + 3740);
    s0 = fmaf(a.x, x0, s0);
    s1 = fmaf(a.y, x1, s1);
    s2 = fmaf(a.z, x2, s2);
    s3 = fmaf(a.w, x3, s3);
    a = *(const LAS f32x4*)(Am + 3744);
    s0 = fmaf(a.x, x4, s0);
    s1 = fmaf(a.y, x5, s1);
    s2 = fmaf(a.z, x6, s2);
    s3 = fmaf(a.w, x7, s3);
    a = *(const LAS f32x4*)(Am + 3748);
    s0 = fmaf(a.x, x8, s0);
    s1 = fmaf(a.y, x9, s1);
    s2 = fmaf(a.z, x10, s2);
    s3 = fmaf(a.w, x11, s3);
    a = *(const LAS f32x4*)(Am + 3752);
    s0 = fmaf(a.x, x12, s0);
    s1 = fmaf(a.y, x13, s1);
    s2 = fmaf(a.z, x14, s2);
    s3 = fmaf(a.w, x15, s3);
    a = *(const LAS f32x4*)(Am + 3756);
    s0 = fmaf(a.x, x16, s0);
    s1 = fmaf(a.y, x17, s1);
    s2 = fmaf(a.z, x18, s2);
    s3 = fmaf(a.w, x19, s3);
    a = *(const LAS f32x4*)(Am + 3760);
    s0 = fmaf(a.x, x20, s0);
    s1 = fmaf(a.y, x21, s1);
    s2 = fmaf(a.z, x22, s2);
    s3 = fmaf(a.w, x23, s3);
    a = *(const LAS f32x4*)(Am + 3764);
    s0 = fmaf(a.x, x24, s0);
    s1 = fmaf(a.y, x25, s1);
    s2 = fmaf(a.z, x26, s2);
    s3 = fmaf(a.w, x27, s3);
    a = *(const LAS f32x4*)(Am + 3768);
    s0 = fmaf(a.x, x28, s0);
    s1 = fmaf(a.y, x29, s1);
    s2 = fmaf(a.z, x30, s2);
    s3 = fmaf(a.w, x31, s3);
    a = *(const LAS f32x4*)(Am + 3772);
    s0 = fmaf(a.x, x32, s0);
    s1 = fmaf(a.y, x33, s1);
    s2 = fmaf(a.z, x34, s2);
    s3 = fmaf(a.w, x35, s3);
    a = *(const LAS f32x4*)(Am + 3776);
    s0 = fmaf(a.x, x36, s0);
    s1 = fmaf(a.y, x37, s1);
    s2 = fmaf(a.z, x38, s2);
    s3 = fmaf(a.w, x39, s3);
    a = *(const LAS f32x4*)(Am + 3780);
    s0 = fmaf(a.x, x40, s0);
    s1 = fmaf(a.y, x41, s1);
    s2 = fmaf(a.z, x42, s2);
    s3 = fmaf(a.w, x43, s3);
    a = *(const LAS f32x4*)(Am + 3784);
    s0 = fmaf(a.x, x44, s0);
    s1 = fmaf(a.y, x45, s1);
    s2 = fmaf(a.z, x46, s2);
    s3 = fmaf(a.w, x47, s3);
    a = *(const LAS f32x4*)(Am + 3788);
    s0 = fmaf(a.x, x48, s0);
    s1 = fmaf(a.y, x49, s1);
    s2 = fmaf(a.z, x50, s2);
    s3 = fmaf(a.w, x51, s3);
    a = *(const LAS f32x4*)(Am + 3792);
    s0 = fmaf(a.x, x52, s0);
    s1 = fmaf(a.y, x53, s1);
    const float al55 = a.z;
    x55 = (x55 - ((s0 + s1) + (s2 + s3))) - al55 * x54;
    Tu[7480 + c] = f2bf(x55 * su); Tw[7480 + c] = f2bf(x55 * sw); asm volatile("" ::: "memory");
    float x56 = fmaxf(0.0f, 1.0f - fabsf(cf - 56.0f));
    s0 = 0.f; s1 = 0.f; s2 = 0.f; s3 = 0.f;
    a = *(const LAS f32x4*)(Am + 3808);
    s0 = fmaf(a.x, x0, s0);
    s1 = fmaf(a.y, x1, s1);
    s2 = fmaf(a.z, x2, s2);
    s3 = fmaf(a.w, x3, s3);
    a = *(const LAS f32x4*)(Am + 3812);
    s0 = fmaf(a.x, x4, s0);
    s1 = fmaf(a.y, x5, s1);
    s2 = fmaf(a.z, x6, s2);
    s3 = fmaf(a.w, x7, s3);
    a = *(const LAS f32x4*)(Am + 3816);
    s0 = fmaf(a.x, x8, s0);
    s1 = fmaf(a.y, x9, s1);
    s2 = fmaf(a.z, x10, s2);
    s3 = fmaf(a.w, x11, s3);
    a = *(const LAS f32x4*)(Am + 3820);
    s0 = fmaf(a.x, x12, s0);
    s1 = fmaf(a.y, x13, s1);
    s2 = fmaf(a.z, x14, s2);
    s3 = fmaf(a.w, x15, s3);
    a = *(const LAS f32x4*)(Am + 3824);
    s0 = fmaf(a.x, x16, s0);
    s1 = fmaf(a.y, x17, s1);
    s2 = fmaf(a.z, x18, s2);
    s3 = fmaf(a.w, x19, s3);
    a = *(const LAS f32x4*)(Am + 3828);
    s0 = fmaf(a.x, x20, s0);
    s1 = fmaf(a.y, x21, s1);
    s2 = fmaf(a.z, x22, s2);
    s3 = fmaf(a.w, x23, s3);
    a = *(const LAS f32x4*)(Am + 3832);
    s0 = fmaf(a.x, x24, s0);
    s1 = fmaf(a.y, x25, s1);
    s2 = fmaf(a.z, x26, s2);
    s3 = fmaf(a.w, x27, s3);
    a = *(const LAS f32x4*)(Am + 3836);
    s0 = fmaf(a.x, x28, s0);
    s1 = fmaf(a.y, x29, s1);
    s2 = fmaf(a.z, x30, s2);
    s3 = fmaf(a.w, x31, s3);
    a = *(const LAS f32x4*)(Am + 3840);
    s0 = fmaf(a.x, x32, s0);
    s1 = fmaf(a.y, x33, s1);
    s2 = fmaf(a.z, x34, s2);
    s3 = fmaf(a.w, x35, s3);
    a = *(const LAS f32x4*)(Am + 3844);
    s0 = fmaf(a.x, x36, s0);
    s1 = fmaf(a.y, x37, s1);
    s2 = fmaf(a.z, x38, s2);
    s3 = fmaf(a.w, x39, s3);
    a = *(const LAS f32x4*)(Am + 3848);
    s0 = fmaf(a.x, x40, s0);
    s1 = fmaf(a.y, x41, s1);
    s2 = fmaf(a.z, x42, s2);
    s3 = fmaf(a.w, x43, s3);
    a = *(const LAS f32x4*)(Am + 3852);
    s0 = fmaf(a.x, x44, s0);
    s1 = fmaf(a.y, x45, s1);
    s2 = fmaf(a.z, x46, s2);
    s3 = fmaf(a.w, x47, s3);
    a = *(const LAS f32x4*)(Am + 3856);
    s0 = fmaf(a.x, x48, s0);
    s1 = fmaf(a.y, x49, s1);
    s2 = fmaf(a.z, x50, s2);
    s3 = fmaf(a.w, x51, s3);
    a = *(const LAS f32x4*)(Am + 3860);
    s0 = fmaf(a.x, x52, s0);
    s1 = fmaf(a.y, x53, s1);
    s2 = fmaf(a.z, x54, s2);
    const float al56 = a.w;
    x56 = (x56 - ((s0 + s1) + (s2 + s3))) - al56 * x55;
    Tu[7616 + c] = f2bf(x56 * su); Tw[7616 + c] = f2bf(x56 * sw); asm volatile("" ::: "memory");
    float x57 = fmaxf(0.0f, 1.0f - fabsf(cf - 57.0f));
    s0 = 0.f; s1 = 0.f; s2 = 0.f; s3 = 0.f;
    a = *(const LAS f32x4*)(Am + 3876);
    s0 = fmaf(a.x, x0, s0);
    s1 = fmaf(a.y, x1, s1);
    s2 = fmaf(a.z, x2, s2);
    s3 = fmaf(a.w, x3, s3);
    a = *(const LAS f32x4*)(Am + 3880);
    s0 = fmaf(a.x, x4, s0);
    s1 = fmaf(a.y, x5, s1);
    s2 = fmaf(a.z, x6, s2);
    s3 = fmaf(a.w, x7, s3);
    a = *(const LAS f32x4*)(Am + 3884);
    s0 = fmaf(a.x, x8, s0);
    s1 = fmaf(a.y, x9, s1);
    s2 = fmaf(a.z, x10, s2);
    s3 = fmaf(a.w, x11, s3);
    a = *(const LAS f32x4*)(Am + 3888);
    s0 = fmaf(a.x, x12, s0);
    s1 = fmaf(a.y, x13, s1);
    s2 = fmaf(a.z, x14, s2);
    s3 = fmaf(a.w, x15, s3);
    a = *(const LAS f32x4*)(Am + 3892);
    s0 = fmaf(a.x, x16, s0);
    s1 = fmaf(a.y, x17, s1);
    s2 = fmaf(a.z, x18, s2);
    s3 = fmaf(a.w, x19, s3);
    a = *(const LAS f32x4*)(Am + 3896);
    s0 = fmaf(a.x, x20, s0);
    s1 = fmaf(a.y, x21, s1);
    s2 = fmaf(a.z, x22, s2);
    s3 = fmaf(a.w, x23, s3);
    a = *(const LAS f32x4*)(Am + 3900);
    s0 = fmaf(a.x, x24, s0);
    s1 = fmaf(a.y, x25, s1);
    s2 = fmaf(a.z, x26, s2);
    s3 = fmaf(a.w, x27, s3);
    a = *(const LAS f32x4*)(Am + 3904);
    s0 = fmaf(a.x, x28, s0);
    s1 = fmaf(a.y, x29, s1);
    s2 = fmaf(a.z, x30, s2);
    s3 = fmaf(a.w, x31, s3);
    a = *(const LAS f32x4*)(Am + 3908);
    s0 = fmaf(a.x, x32, s0);
    s1 = fmaf(a.y, x33, s1);
    s2 = fmaf(a.z, x34, s2);
    s3 = fmaf(a.w, x35, s3);
    a = *(const LAS f32x4*)(Am + 3912);
    s0 = fmaf(a.x, x36, s0);
    s1 = fmaf(a.y, x37, s1);
    s2 = fmaf(a.z, x38, s2);
    s3 = fmaf(a.w, x39, s3);
    a = *(const LAS f32x4*)(Am + 3916);
    s0 = fmaf(a.x, x40, s0);
    s1 = fmaf(a.y, x41, s1);
    s2 = fmaf(a.z, x42, s2);
    s3 = fmaf(a.w, x43, s3);
    a = *(const LAS f32x4*)(Am + 3920);
    s0 = fmaf(a.x, x44, s0);
    s1 = fmaf(a.y, x45, s1);
    s2 = fmaf(a.z, x46, s2);
    s3 = fmaf(a.w, x47, s3);
    a = *(const LAS f32x4*)(Am + 3924);
    s0 = fmaf(a.x, x48, s0);
    s1 = fmaf(a.y, x49, s1);
    s2 = fmaf(a.z, x50, s2);
    s3 = fmaf(a.w, x51, s3);
    a = *(const LAS f32x4*)(Am + 3928);
    s0 = fmaf(a.x, x52, s0);
    s1 = fmaf(a.y, x53, s1);
    s2 = fmaf(a.z, x54, s2);
    s3 = fmaf(a.w, x55, s3);
    a = *(const LAS f32x4*)(Am + 3932);
    const float al57 = a.x;
    x57 = (x57 - ((s0 + s1) + (s2 + s3))) - al57 * x56;
    Tu[7752 + c] = f2bf(x57 * su); Tw[7752 + c] = f2bf(x57 * sw); asm volatile("" ::: "memory");
    float x58 = fmaxf(0.0f, 1.0f - fabsf(cf - 58.0f));
    s0 = 0.f; s1 = 0.f; s2 = 0.f; s3 = 0.f;
    a = *(const LAS f32x4*)(Am + 3944);
    s0 = fmaf(a.x, x0, s0);
    s1 = fmaf(a.y, x1, s1);
    s2 = fmaf(a.z, x2, s2);
    s3 = fmaf(a.w, x3, s3);
    a = *(const LAS f32x4*)(Am + 3948);
    s0 = fmaf(a.x, x4, s0);
    s1 = fmaf(a.y, x5, s1);
    s2 = fmaf(a.z, x6, s2);
    s3 = fmaf(a.w, x7, s3);
    a = *(const LAS f32x4*)(Am + 3952);
    s0 = fmaf(a.x, x8, s0);
    s1 = fmaf(a.y, x9, s1);
    s2 = fmaf(a.z, x10, s2);
    s3 = fmaf(a.w, x11, s3);
    a = *(const LAS f32x4*)(Am + 3956);
    s0 = fmaf(a.x, x12, s0);
    s1 = fmaf(a.y, x13, s1);
    s2 = fmaf(a.z, x14, s2);
    s3 = fmaf(a.w, x15, s3);
    a = *(const LAS f32x4*)(Am + 3960);
    s0 = fmaf(a.x, x16, s0);
    s1 = fmaf(a.y, x17, s1);
    s2 = fmaf(a.z, x18, s2);
    s3 = fmaf(a.w, x19, s3);
    a = *(const LAS f32x4*)(Am + 3964);
    s0 = fmaf(a.x, x20, s0);
    s1 = fmaf(a.y, x21, s1);
    s2 = fmaf(a.z, x22, s2);
    s3 = fmaf(a.w, x23, s3);
    a = *(const LAS f32x4*)(Am + 3968);
    s0 = fmaf(a.x, x24, s0);
    s1 = fmaf(a.y, x25, s1);
    s2 = fmaf(a.z, x26, s2);
    s3 = fmaf(a.w, x27, s3);
    a = *(const LAS f32x4*)(Am + 3972);
    s0 = fmaf(a.x, x28, s0);
    s1 = fmaf(a.y, x29, s1);
    s2 = fmaf(a.z, x30, s2);
    s3 = fmaf(a.w, x31, s3);
    a = *(const LAS f32x4*)(Am + 3976);
    s0 = fmaf(a.x, x32, s0);
    s1 = fmaf(a.y, x33, s1);
    s2 = fmaf(a.z, x34, s2);
    s3 = fmaf(a.w, x35, s3);
    a = *(const LAS f32x4*)(Am + 3980);
    s0 = fmaf(a.x, x36, s0);
    s1 = fmaf(a.y, x37, s1);
    s2 = fmaf(a.z, x38, s2);
    s3 = fmaf(a.w, x39, s3);
    a = *(const LAS f32x4*)(Am + 3984);
    s0 = fmaf(a.x, x40, s0);
    s1 = fmaf(a.y, x41, s1);
    s2 = fmaf(a.z, x42, s2);
    s3 = fmaf(a.w, x43, s3);
    a = *(const LAS f32x4*)(Am + 3988);
    s0 = fmaf(a.x, x44, s0);
    s1 = fmaf(a.y, x45, s1);
    s2 = fmaf(a.z, x46, s2);
    s3 = fmaf(a.w, x47, s3);
    a = *(const LAS f32x4*)(Am + 3992);
    s0 = fmaf(a.x, x48, s0);
    s1 = fmaf(a.y, x49, s1);
    s2 = fmaf(a.z, x50, s2);
    s3 = fmaf(a.w, x51, s3);
    a = *(const LAS f32x4*)(Am + 3996);
    s0 = fmaf(a.x, x52, s0);
    s1 = fmaf(a.y, x53, s1);
    s2 = fmaf(a.z, x54, s2);
    s3 = fmaf(a.w, x55, s3);
    a = *(const LAS f32x4*)(Am + 4000);
    s0 = fmaf(a.x, x56, s0);
    const float al58 = a.y;
    x58 = (x58 - ((s0 + s1) + (s2 + s3))) - al58 * x57;
    Tu[7888 + c] = f2bf(x58 * su); Tw[7888 + c] = f2bf(x58 * sw); asm volatile("" ::: "memory");
    float x59 = fmaxf(0.0f, 1.0f - fabsf(cf - 59.0f));
    s0 = 0.f; s1 = 0.f; s2 = 0.f; s3 = 0.f;
    a = *(const LAS f32x4*)(Am + 4012);
    s0 = fmaf(a.x, x0, s0);
    s1 = fmaf(a.y, x1, s1);
    s2 = fmaf(a.z, x2, s2);
    s3 = fmaf(a.w, x3, s3);
    a = *(const LAS f32x4*)(Am + 4016);
    s0 = fmaf(a.x, x4, s0);
    s1 = fmaf(a.y, x5, s1);
    s2 = fmaf(a.z, x6, s2);
    s3 = fmaf(a.w, x7, s3);
    a = *(const LAS f32x4*)(Am + 4020);
    s0 = fmaf(a.x, x8, s0);
    s1 = fmaf(a.y, x9, s1);
    s2 = fmaf(a.z, x10, s2);
    s3 = fmaf(a.w, x11, s3);
    a = *(const LAS f32x4*)(Am + 4024);
    s0 = fmaf(a.x, x12, s0);
    s1 = fmaf(a.y, x13, s1);
    s2 = fmaf(a.z, x14, s2);
    s3 = fmaf(a.w, x15, s3);
    a = *(const LAS f32x4*)(Am + 4028);
    s0 = fmaf(a.x, x16, s0);
    s1 = fmaf(a.y, x17, s1);
    s2 = fmaf(a.z, x18, s2);
    s3 = fmaf(a.w, x19, s3);
    a = *(const LAS f32x4*)(Am + 4032);
    s0 = fmaf(a.x, x20, s0);
    s1 = fmaf(a.y, x21, s1);
    s2 = fmaf(a.z, x22, s2);
    s3 = fmaf(a.w, x23, s3);
    a = *(const LAS f32x4*)(Am + 4036);
    s0 = fmaf(a.x, x24, s0);
    s1 = fmaf(a.y, x25, s1);
    s2 = fmaf(a.z, x26, s2);
    s3 = fmaf(a.w, x27, s3);
    a = *(const LAS f32x4*)(Am + 4040);
    s0 = fmaf(a.x, x28, s0);
    s1 = fmaf(a.y, x29, s1);
    s2 = fmaf(a.z, x30, s2);
    s3 = fmaf(a.w, x31, s3);
    a = *(const LAS f32x4*)(Am + 4044);
    s0 = fmaf(a.x, x32, s0);
    s1 = fmaf(a.y, x33, s1);
    s2 = fmaf(a.z, x34, s2);
    s3 = fmaf(a.w, x35, s3);
    a = *(const LAS f32x4*)(Am + 4048);
    s0 = fmaf(a.x, x36, s0);
    s1 = fmaf(a.y, x37, s1);
    s2 = fmaf(a.z, x38, s2);
    s3 = fmaf(a.w, x39, s3);
    a = *(const LAS f32x4*)(Am + 4052);
    s0 = fmaf(a.x, x40, s0);
    s1 = fmaf(a.y, x41, s1);
    s2 = fmaf(a.z, x42, s2);
    s3 = fmaf(a.w, x43, s3);
    a = *(const LAS f32x4*)(Am + 4056);
    s0 = fmaf(a.x, x44, s0);
    s1 = fmaf(a.y, x45, s1);
    s2 = fmaf(a.z, x46, s2);
    s3 = fmaf(a.w, x47, s3);
    a = *(const LAS f32x4*)(Am + 4060);
    s0 = fmaf(a.x, x48, s0);
    s1 = fmaf(a.y, x49, s1);
    s2 = fmaf(a.z, x50, s2);
    s3 = fmaf(a.w, x51, s3);
    a = *(const LAS f32x4*)(Am + 4064);
    s0 = fmaf(a.x, x52, s0);
    s1 = fmaf(a.y, x53, s1);
    s2 = fmaf(a.z, x54, s2);
    s3 = fmaf(a.w, x55, s3);
    a = *(const LAS f32x4*)(Am + 4068);
    s0 = fmaf(a.x, x56, s0);
    s1 = fmaf(a.y, x57, s1);
    const float al59 = a.z;
    x59 = (x59 - ((s0 + s1) + (s2 + s3))) - al59 * x58;
    Tu[8024 + c] = f2bf(x59 * su); Tw[8024 + c] = f2bf(x59 * sw); asm volatile("" ::: "memory");
    float x60 = fmaxf(0.0f, 1.0f - fabsf(cf - 60.0f));
    s0 = 0.f; s1 = 0.f; s2 = 0.f; s3 = 0.f;
    a = *(const LAS f32x4*)(Am + 4080);
    s0 = fmaf(a.x, x0, s0);
    s1 = fmaf(a.y, x1, s1);
    s2 = fmaf(a.z, x2, s2);
    s3 = fmaf(a.w, x3, s3);
    a = *(const LAS f32x4*)(Am + 4084);
    s0 = fmaf(a.x, x4, s0);
    s1 = fmaf(a.y, x5, s1);
    s2 = fmaf(a.z, x6, s2);
    s3 = fmaf(a.w, x7, s3);
    a = *(const LAS f32x4*)(Am + 4088);
    s0 = fmaf(a.x, x8, s0);
    s1 = fmaf(a.y, x9, s1);
    s2 = fmaf(a.z, x10, s2);
    s3 = fmaf(a.w, x11, s3);
    a = *(const LAS f32x4*)(Am + 4092);
    s0 = fmaf(a.x, x12, s0);
    s1 = fmaf(a.y, x13, s1);
    s2 = fmaf(a.z, x14, s2);
    s3 = fmaf(a.w, x15, s3);
    a = *(const LAS f32x4*)(Am + 4096);
    s0 = fmaf(a.x, x16, s0);
    s1 = fmaf(a.y, x17, s1);
    s2 = fmaf(a.z, x18, s2);
    s3 = fmaf(a.w, x19, s3);
    a = *(const LAS f32x4*)(Am + 4100);
    s0 = fmaf(a.x, x20, s0);
    s1 = fmaf(a.y, x21, s1);
    s2 = fmaf(a.z, x22, s2);
    s3 = fmaf(a.w, x23, s3);
    a = *(const LAS f32x4*)(Am + 4104);
    s0 = fmaf(a.x, x24, s0);
    s1 = fmaf(a.y, x25, s1);
    s2 = fmaf(a.z, x26, s2);
    s3 = fmaf(a.w, x27, s3);
    a = *(const LAS f32x4*)(Am + 4108);
    s0 = fmaf(a.x, x28, s0);
    s1 = fmaf(a.y, x29, s1);
    s2 = fmaf(a.z, x30, s2);
    s3 = fmaf(a.w, x31, s3);
    a = *(const LAS f32x4*)(Am + 4112);
    s0 = fmaf(a.x, x32, s0);
    s1 = fmaf(a.y, x33, s1);
    s2 = fmaf(a.z, x34, s2);
    s3 = fmaf(a.w, x35, s3);
    a = *(const LAS f32x4*)(Am + 4116);
    s0 = fmaf(a.x, x36, s0);
    s1 = fmaf(a.y, x37, s1);
    s2 = fmaf(a.z, x38, s2);
    s3 = fmaf(a.w, x39, s3);
    a = *(const LAS f32x4*)(Am + 4120);
    s0 = fmaf(a.x, x40, s0);
    s1 = fmaf(a.y, x41, s1);
    s2 = fmaf(a.z, x42, s2);
    s3 = fmaf(a.w, x43, s3);
    a = *(const LAS f32x4*)(Am + 4124);
    s0 = fmaf(a.x, x44, s0);
    s1 = fmaf(a.y, x45, s1);
    s2 = fmaf(a.z, x46, s2);
    s3 = fmaf(a.w, x47, s3);
    a = *(const LAS f32x4*)(Am + 4128);
    s0 = fmaf(a.x, x48, s0);
    s1 = fmaf(a.y, x49, s1);
    s2 = fmaf(a.z, x50, s2);
    s3 = fmaf(a.w, x51, s3);
    a = *(const LAS f32x4*)(Am + 4132);
    s0 = fmaf(a.x, x52, s0);
    s1 = fmaf(a.y, x53, s1);
    s2 = fmaf(a.z, x54, s2);
    s3 = fmaf(a.w, x55, s3);
    a = *(const LAS f32x4*)(Am + 4136);
    s0 = fmaf(a.x, x56, s0);
    s1 = fmaf(a.y, x57, s1);
    s2 = fmaf(a.z, x58, s2);
    const float al60 = a.w;
    x60 = (x60 - ((s0 + s1) + (s2 + s3))) - al60 * x59;
    Tu[8160 + c] = f2bf(x60 * su); Tw[8160 + c] = f2bf(x60 * sw); asm volatile("" ::: "memory");
    float x61 = fmaxf(0.0f, 1.0f - fabsf(cf - 61.0f));
    s0 = 0.f; s1 = 0.f; s2 = 0.f; s3 = 0.f;
    a = *(const LAS f32x4*)(Am + 4148);
    s0 = fmaf(a.x, x0, s0);
    s1 = fmaf(a.y, x1, s1);
    s2 = fmaf(a.z, x2, s2);
    s3 = fmaf(a.w, x3, s3);
    a = *(const LAS f32x4*)(Am + 4152);
    s0 = fmaf(a.x, x4, s0);
    s1 = fmaf(a.y, x5, s1);
    s2 = fmaf(a.z, x6, s2);
    s3 = fmaf(a.w, x7, s3);
    a = *(const LAS f32x4*)(Am + 4156);
    s0 = fmaf(a.x, x8, s0);
    s1 = fmaf(a.y, x9, s1);
    s2 = fmaf(a.z, x10, s2);
    s3 = fmaf(a.w, x11, s3);
    a = *(const LAS f32x4*)(Am + 4160);
    s0 = fmaf(a.x, x12, s0);
    s1 = fmaf(a.y, x13, s1);
    s2 = fmaf(a.z, x14, s2);
    s3 = fmaf(a.w, x15, s3);
    a = *(const LAS f32x4*)(Am + 4164);
    s0 = fmaf(a.x, x16, s0);
    s1 = fmaf(a.y, x17, s1);
    s2 = fmaf(a.z, x18, s2);
    s3 = fmaf(a.w, x19, s3);
    a = *(const LAS f32x4*)(Am + 4168);
    s0 = fmaf(a.x, x20, s0);
    s1 = fmaf(a.y, x21, s1);
    s2 = fmaf(a.z, x22, s2);
    s3 = fmaf(a.w, x23, s3);
    a = *(const LAS f32x4*)(Am + 4172);
    s0 = fmaf(a.x, x24, s0);
    s1 = fmaf(a.y, x25, s1);
    s2 = fmaf(a.z, x26, s2);
    s3 = fmaf(a.w, x27, s3);
    a = *(const LAS f32x4*)(Am + 4176);
    s0 = fmaf(a.x, x28, s0);
    s1 = fmaf(a.y, x29, s1);
    s2 = fmaf(a.z, x30, s2);
    s3 = fmaf(a.w, x31, s3);
    a = *(const LAS f32x4*)(Am + 4180);
    s0 = fmaf(a.x, x32, s0);
    s1 = fmaf(a.y, x33, s1);
    s2 = fmaf(a.z, x34, s2);
    s3 = fmaf(a.w, x35, s3);
    a = *(const LAS f32x4*)(Am + 4184);
    s0 = fmaf(a.x, x36, s0);
    s1 = fmaf(a.y, x37, s1);
    s2 = fmaf(a.z, x38, s2);
    s3 = fmaf(a.w, x39, s3);
    a = *(const LAS f32x4*)(Am + 4188);
    s0 = fmaf(a.x, x40, s0);
    s1 = fmaf(a.y, x41, s1);
    s2 = fmaf(a.z, x42, s2);
    s3 = fmaf(a.w, x43, s3);
    a = *(const LAS f32x4*)(Am + 4192);
    s0 = fmaf(a.x, x44, s0);
    s1 = fmaf(a.y, x45, s1);
    s2 = fmaf(a.z, x46, s2);
    s3 = fmaf(a.w, x47, s3);
    a = *(const LAS f32x4*)(Am + 4196);
    s0 = fmaf(a.x, x48, s0);
    s1 = fmaf(a.y, x49, s1);
    s2 = fmaf(a.z, x50, s2);
    s3 = fmaf(a.w, x51, s3);
    a = *(const LAS f32x4*)(Am + 4200);
    s0 = fmaf(a.x, x52, s0);
    s1 = fmaf(a.y, x53, s1);
    s2 = fmaf(a.z, x54, s2);
    s3 = fmaf(a.w, x55, s3);
    a = *(const LAS f32x4*)(Am + 4204);
    s0 = fmaf(a.x, x56, s0);
    s1 = fmaf(a.y, x57, s1);
    s2 = fmaf(a.z, x58, s2);
    s3 = fmaf(a.w, x59, s3);
    a = *(const LAS f32x4*)(Am + 4208);
    const float al61 = a.x;
    x61 = (x61 - ((s0 + s1) + (s2 + s3))) - al61 * x60;
    Tu[8296 + c] = f2bf(x61 * su); Tw[8296 + c] = f2bf(x61 * sw); asm volatile("" ::: "memory");
    float x62 = fmaxf(0.0f, 1.0f - fabsf(cf - 62.0f));
    s0 = 0.f; s1 = 0.f; s2 = 0.f; s3 = 0.f;
    a = *(const LAS f32x4*)(Am + 4216);
    s0 = fmaf(a.x, x0, s0);
    s1 = fmaf(a.y, x1, s1);
    s2 = fmaf(a.z, x2, s2);
    s3 = fmaf(a.w, x3, s3);
    a = *(const LAS f32x4*)(Am + 4220);
    s0 = fmaf(a.x, x4, s0);
    s1 = fmaf(a.y, x5, s1);
    s2 = fmaf(a.z, x6, s2);
    s3 = fmaf(a.w, x7, s3);
    a = *(const LAS f32x4*)(Am + 4224);
    s0 = fmaf(a.x, x8, s0);
    s1 = fmaf(a.y, x9, s1);
    s2 = fmaf(a.z, x10, s2);
    s3 = fmaf(a.w, x11, s3);
    a = *(const LAS f32x4*)(Am + 4228);
    s0 = fmaf(a.x, x12, s0);
    s1 = fmaf(a.y, x13, s1);
    s2 = fmaf(a.z, x14, s2);
    s3 = fmaf(a.w, x15, s3);
    a = *(const LAS f32x4*)(Am + 4232);
    s0 = fmaf(a.x, x16, s0);
    s1 = fmaf(a.y, x17, s1);
    s2 = fmaf(a.z, x18, s2);
    s3 = fmaf(a.w, x19, s3);
    a = *(const LAS f32x4*)(Am + 4236);
    s0 = fmaf(a.x, x20, s0);
    s1 = fmaf(a.y, x21, s1);
    s2 = fmaf(a.z, x22, s2);
    s3 = fmaf(a.w, x23, s3);
    a = *(const LAS f32x4*)(Am + 4240);
    s0 = fmaf(a.x, x24, s0);
    s1 = fmaf(a.y, x25, s1);
    s2 = fmaf(a.z, x26, s2);
    s3 = fmaf(a.w, x27, s3);
    a = *(const LAS f32x4*)(Am + 4244);
    s0 = fmaf(a.x, x28, s0);
    s1 = fmaf(a.y, x29, s1);
    s2 = fmaf(a.z, x30, s2);
    s3 = fmaf(a.w, x31, s3);
    a = *(const LAS f32x4*)(Am + 4248);
    s0 = fmaf(a.x, x32, s0);
    s1 = fmaf(a.y, x33, s1);
    s2 = fmaf(a.z, x34, s2);
    s3 = fmaf(a.w, x35, s3);
    a = *(const LAS f32x4*)(Am + 4252);
    s0 = fmaf(a.x, x36, s0);
    s1 = fmaf(a.y, x37, s1);
    s2 = fmaf(a.z, x38, s2);
    s3 = fmaf(a.w, x39, s3);
    a = *(const LAS f32x4*)(Am + 4256);
    s0 = fmaf(a.x, x40, s0);
    s1 = fmaf(a.y, x41, s1);
    s2 = fmaf(a.z, x42, s2);
    s3 = fmaf(a.w, x43, s3);
    a = *(const LAS f32x4*)(Am + 4260);
    s0 = fmaf(a.x, x44, s0);
    s1 = fmaf(a.y, x45, s1);
    s2 = fmaf(a.z, x46, s2);
    s3 = fmaf(a.w, x47, s3);
    a = *(const LAS f32x4*)(Am + 4264);
    s0 = fmaf(a.x, x48, s0);
    s1 = fmaf(a.y, x49, s1);
    s2 = fmaf(a.z, x50, s2);
    s3 = fmaf(a.w, x51, s3);
    a = *(const LAS f32x4*)(Am + 4268);
    s0 = fmaf(a.x, x52, s0);
    s1 = fmaf(a.y, x53, s1);
    s2 = fmaf(a.z, x54, s2);
    s3 = fmaf(a.w, x55, s3);
    a = *(const LAS f32x4*)(Am + 4272);
    s0 = fmaf(a.x, x56, s0);
    s1 = fmaf(a.y, x57, s1);
    s2 = fmaf(a.z, x58, s2);
    s3 = fmaf(a.w, x59, s3);
    a = *(const LAS f32x4*)(Am + 4276);
    s0 = fmaf(a.x, x60, s0);
    const float al62 = a.y;
    x62 = (x62 - ((s0 + s1) + (s2 + s3))) - al62 * x61;
    Tu[8432 + c] = f2bf(x62 * su); Tw[8432 + c] = f2bf(x62 * sw); asm volatile("" ::: "memory");
    float x63 = fmaxf(0.0f, 1.0f - fabsf(cf - 63.0f));
    s0 = 0.f; s1 = 0.f; s2 = 0.f; s3 = 0.f;
    a = *(const LAS f32x4*)(Am + 4284);
    s0 = fmaf(a.x, x0, s0);
    s1 = fmaf(a.y, x1, s1);
    s2 = fmaf(a.z, x2, s2);
    s3 = fmaf(a.w, x3, s3);
    a = *(const LAS f32x4*)(Am + 4288);
    s0 = fmaf(a.x, x4, s0);
    s1 = fmaf(a.y, x5, s1);
    s2 = fmaf(a.z, x6, s2);
    s3 = fmaf(a.w, x7, s3);
    a = *(const LAS f32x4*)(Am + 4292);
    s0 = fmaf(a.x, x8, s0);
    s1 = fmaf(a.y, x9, s1);
    s2 = fmaf(a.z, x10, s2);
    s3 = fmaf(a.w, x11, s3);
    a = *(const LAS f32x4*)(Am + 4296);
    s0 = fmaf(a.x, x12, s0);
    s1 = fmaf(a.y, x13, s1);
    s2 = fmaf(a.z, x14, s2);
    s3 = fmaf(a.w, x15, s3);
    a = *(const LAS f32x4*)(Am + 4300);
    s0 = fmaf(a.x, x16, s0);
    s1 = fmaf(a.y, x17, s1);
    s2 = fmaf(a.z, x18, s2);
    s3 = fmaf(a.w, x19, s3);
    a = *(const LAS f32x4*)(Am + 4304);
    s0 = fmaf(a.x, x20, s0);
    s1 = fmaf(a.y, x21, s1);
    s2 = fmaf(a.z, x22, s2);
    s3 = fmaf(a.w, x23, s3);
    a = *(const LAS f32x4*)(Am + 4308);
    s0 = fmaf(a.x, x24, s0);
    s1 = fmaf(a.y, x25, s1);
    s2 = fmaf(a.z, x26, s2);
    s3 = fmaf(a.w, x27, s3);
    a = *(const LAS f32x4*)(Am + 4312);
    s0 = fmaf(a.x, x28, s0);
    s1 = fmaf(a.y, x29, s1);
    s2 = fmaf(a.z, x30, s2);
    s3 = fmaf(a.w, x31, s3);
    a = *(const LAS f32x4*)(Am + 4316);
    s0 = fmaf(a.x, x32, s0);
    s1 = fmaf(a.y, x33, s1);
    s2 = fmaf(a.z, x34, s2);
    s3 = fmaf(a.w, x35, s3);
    a = *(const LAS f32x4*)(Am + 4320);
    s0 = fmaf(a.x, x36, s0);
    s1 = fmaf(a.y, x37, s1);
    s2 = fmaf(a.z, x38, s2);
    s3 = fmaf(a.w, x39, s3);
    a = *(const LAS f32x4*)(Am + 4324);
    s0 = fmaf(a.x, x40, s0);
    s1 = fmaf(a.y, x41, s1);
    s2 = fmaf(a.z, x42, s2);
    s3 = fmaf(a.w, x43, s3);
    a = *(const LAS f32x4*)(Am + 4328);
    s0 = fmaf(a.x, x44, s0);
    s1 = fmaf(a.y, x45, s1);
    s2 = fmaf(a.z, x46, s2);
    s3 = fmaf(a.w, x47, s3);
    a = *(const LAS f32x4*)(Am + 4332);
    s0 = fmaf(a.x, x48, s0);
    s1 = fmaf(a.y, x49, s1);
    s2 = fmaf(a.z, x50, s2);
    s3 = fmaf(a.w, x51, s3);
    a = *(const LAS f32x4*)(Am + 4336);
    s0 = fmaf(a.x, x52, s0);
    s1 = fmaf(a.y, x53, s1);
    s2 = fmaf(a.z, x54, s2);
    s3 = fmaf(a.w, x55, s3);
    a = *(const LAS f32x4*)(Am + 4340);
    s0 = fmaf(a.x, x56, s0);
    s1 = fmaf(a.y, x57, s1);
    s2 = fmaf(a.z, x58, s2);
    s3 = fmaf(a.w, x59, s3);
    a = *(const LAS f32x4*)(Am + 4344);
    s0 = fmaf(a.x, x60, s0);
    s1 = fmaf(a.y, x61, s1);
    const float al63 = a.z;
    x63 = (x63 - ((s0 + s1) + (s2 + s3))) - al63 * x62;
    Tu[8568 + c] = f2bf(x63 * su); Tw[8568 + c] = f2bf(x63 * sw); asm volatile("" ::: "memory");
}
typedef short bf16x8_t __attribute__((ext_vector_type(8)));
template <int K> __device__ __forceinline__ f32x4 mma_tile(const LAS unsigned short* A, int lda, const LAS unsigned short* Bt, int ldb, f32x4 acc) {
    const int lane = threadIdx.x & 63, r = lane & 15, q = lane >> 4;
#pragma unroll
    for (int ks = 0; ks < K / 32; ++ks) {
        const bf16x8_t a = *(const LAS bf16x8_t*)(A + r * lda + ks * 32 + q * 8);
        const bf16x8_t b = *(const LAS bf16x8_t*)(Bt + r * ldb + ks * 32 + q * 8);
        acc = __builtin_amdgcn_mfma_f32_16x16x32_bf16(a, b, acc, 0, 0, 0);
    }
    return acc;
}

typedef unsigned short u16x4_t __attribute__((ext_vector_type(4)));
__device__ __forceinline__ void tr_frag2(unsigned base_addr, int pitch, int c, bf16x8_t& f0, bf16x8_t& f1) {
    const int lane = threadIdx.x & 63, g = lane >> 4, qq = (lane & 15) >> 2, pp = lane & 3;
    const unsigned a00 = base_addr + (unsigned)((8 * g + qq) * pitch + 32 * c + 8 * pp);
    const unsigned a01 = a00 + 4u * (unsigned)pitch, a10 = a00 + 32u * (unsigned)pitch, a11 = a10 + 4u * (unsigned)pitch;
    u16x4_t r00, r01, r10, r11;
    asm volatile("ds_read_b64_tr_b16 %0, %4\n\tds_read_b64_tr_b16 %1, %5\n\tds_read_b64_tr_b16 %2, %6\n\tds_read_b64_tr_b16 %3, %7\n\ts_waitcnt lgkmcnt(0)"
                 : "=&v"(r00), "=&v"(r01), "=&v"(r10), "=&v"(r11) : "v"(a00), "v"(a01), "v"(a10), "v"(a11) : "memory");
    f0 = (bf16x8_t){(short)r00.x, (short)r00.y, (short)r00.z, (short)r00.w, (short)r01.x, (short)r01.y, (short)r01.z, (short)r01.w};
    f1 = (bf16x8_t){(short)r10.x, (short)r10.y, (short)r10.z, (short)r10.w, (short)r11.x, (short)r11.y, (short)r11.z, (short)r11.w};
}
constexpr size_t WS_G = 235 * MiB;

__device__ __forceinline__ void delta_prep(LDSp lds, const Params& p) {
    const bf16_t* QKVN = (const bf16_t*)(p.ws + WS_QKV); const float* BETA = (const float*)(p.ws + WS_BETA); const float* LA = (const float*)(p.ws + WS_LA);
    bf16_t* Z = (bf16_t*)(p.ws + WS_Z); float* GB = (float*)(p.ws + WS_G);
    LAS unsigned short* Qb = (LAS unsigned short*)lds;
    LAS unsigned short* Kb = (LAS unsigned short*)(lds + 17408);
    LAS unsigned short* Ast = (LAS unsigned short*)(lds + 107776);
    const int tid = threadIdx.x, lane = tid & 63, wid = tid >> 6, r = lane & 15, q = lane >> 4;
    const int G = gridDim.x;
    u32x4 pq[4]; float pla = 0.f, pbe = 0.f;
#define DPL(u_, vmode) do { const int dir_ = (u_) >> 10, b_ = ((u_) >> 8) & 3, h_ = ((u_) >> 6) & 3, n_ = (u_) & 63; \
        const long tk0_ = (long)b_ * S_ + (dir_ ? (S_ - 1 - n_ * 64) : n_ * 64); const long ts_ = dir_ ? -1 : 1; \
        _Pragma("unroll") for (int i = 0; i < 4; ++i) { const int pi = tid + NTHR * i, which = pi >> 10, l = (pi >> 4) & 63, c8 = pi & 15; \
            pq[i] = *(const u32x4*)(QKVN + (tk0_ + l * ts_) * 1536 + ((vmode) ? (which ? 512 : 1024) : which * 512) + h_ * 128 + c8 * 8); } \
        if (!(vmode) && tid < 64) { const long tk = tk0_ + tid * ts_; pla = LA[tk * 8 + dir_ * 4 + h_]; pbe = BETA[tk * 8 + dir_ * 4 + h_]; } } while (0)
#define DPS() do { _Pragma("unroll") for (int i = 0; i < 4; ++i) { const int pi = tid + NTHR * i, which = pi >> 10, l = (pi >> 4) & 63, c8 = pi & 15; *(LAS u32x4*)(lds + which * 17408 + l * 272 + c8 * 16) = pq[i]; } } while (0)
    if ((int)blockIdx.x < 2048) DPL((int)blockIdx.x, 0);
    for (int ub = blockIdx.x; ub < 2048; ub += 4 * G) {
#pragma unroll 1
        for (int j = 0; j < 4; ++j) { const int unit = ub + j * G; if (unit >= 2048) break;
            const int dir = unit >> 10, b = (unit >> 8) & 3, h = (unit >> 6) & 3, n = unit & 63;
            const long tok0 = (long)b * S_ + (dir ? (S_ - 1 - n * 64) : n * 64); const long tstep = dir ? -1 : 1;
            LAS float* Am = (LAS float*)(lds + 34816 + j * 17408); LAS float* gl = (LAS float*)(lds + 104448 + j * 768); LAS float* be = gl + 64; LAS float* beg = gl + 128; LAS float* la = (LAS float*)(lds + 107520);
            DPS();
            if (tid < 64) { la[tid] = pla; be[tid] = pbe; }
            __syncthreads();
            { const int un = ub + (j + 1) * G; if (j < 3 && un < 2048) DPL(un, 0); else DPL(ub, 1); }
            if (tid < 64) { const float g = wave_scan_sum(la[tid], true); gl[tid] = g; beg[tid] = be[tid] * __expf(g); GB[((size_t)dir * T_ + (tok0 + tid * tstep)) * 4 + h] = g; }
            __syncthreads();
#pragma unroll
            for (int tt = 0; tt < 2; ++tt) { const int idx = wid * 2 + tt, mt = idx >> 2, nt = idx & 3;
                f32x4 kk = {0.f, 0.f, 0.f, 0.f}, qk = {0.f, 0.f, 0.f, 0.f};
                if (mt >= nt) { kk = mma_tile<128>(Kb + mt * 16 * 136, 136, Kb + nt * 16 * 136, 136, kk); qk = mma_tile<128>(Qb + mt * 16 * 136, 136, Kb + nt * 16 * 136, 136, qk); }
                const int jj = nt * 16 + r; const float gj = gl[jj];
#pragma unroll
                for (int i4 = 0; i4 < 4; ++i4) { const int i = mt * 16 + q * 4 + i4; const float dec = (i >= jj) ? __expf(gl[i] - gj) : 0.f;
                    Am[i * 68 + jj] = (i > jj) ? be[i] * kk[i4] * dec : 0.f;
                    Ast[i * 72 + jj] = f2bf(qk[i4] * dec); }
            }
            __syncthreads();
            { const int l = tid >> 3, c8 = tid & 7;
              *(u32x4*)(Z + (tok0 + l * tstep) * 3072 + 2048 + dir * 256 + h * 64 + c8 * 8) = *(const LAS u32x4*)(Ast + l * 72 + c8 * 8); }
        }
        if (wid < 4 && ub + wid * G < 2048) { int cc = lane; asm volatile("" : "+v"(cc));
            LAS float* Am = (LAS float*)(lds + 34816 + wid * 17408); LAS float* gl = (LAS float*)(lds + 104448 + wid * 768);
            tri_inv64(Am, cc, gl[64 + lane], gl[128 + lane], (LAS unsigned short*)Am, (LAS unsigned short*)Am + 64); }
        __syncthreads();
#pragma unroll 1
        for (int j = 0; j < 4; ++j) { const int unit = ub + j * G; if (unit >= 2048) break;
            const int dir = unit >> 10, b = (unit >> 8) & 3, h = (unit >> 6) & 3, n = unit & 63;
            const long tok0 = (long)b * S_ + (dir ? (S_ - 1 - n * 64) : n * 64); const long tstep = dir ? -1 : 1;
            const LAS unsigned short* Tu = (const LAS unsigned short*)(lds + 34816 + j * 17408);
            DPS();
            __syncthreads();
            { const int un = ub + (j + 1) * G; if (j < 3 && un < 2048) DPL(un, 1); else if (ub + 4 * G < 2048) DPL(ub + 4 * G, 0); }
            {   bf16x8_t vb0, vb1, kb0, kb1; tr_frag2((unsigned)(unsigned long long)Qb, 272, wid, vb0, vb1); tr_frag2((unsigned)(unsigned long long)Kb, 272, wid, kb0, kb1);
                __syncthreads();
#pragma unroll
                for (int mt = 0; mt < 4; ++mt) {
                    const bf16x8_t tu0 = *(const LAS bf16x8_t*)(Tu + (mt * 16 + r) * 136 + q * 8), tu1 = *(const LAS bf16x8_t*)(Tu + (mt * 16 + r) * 136 + 32 + q * 8);
                    const bf16x8_t tw0 = *(const LAS bf16x8_t*)(Tu + (mt * 16 + r) * 136 + 64 + q * 8), tw1 = *(const LAS bf16x8_t*)(Tu + (mt * 16 + r) * 136 + 96 + q * 8);
                    f32x4 au = {0.f, 0.f, 0.f, 0.f}, aw = {0.f, 0.f, 0.f, 0.f};
                    au = __builtin_amdgcn_mfma_f32_16x16x32_bf16(tu0, vb0, au, 0, 0, 0); au = __builtin_amdgcn_mfma_f32_16x16x32_bf16(tu1, vb1, au, 0, 0, 0);
                    aw = __builtin_amdgcn_mfma_f32_16x16x32_bf16(tw0, kb0, aw, 0, 0, 0); aw = __builtin_amdgcn_mfma_f32_16x16x32_bf16(tw1, kb1, aw, 0, 0, 0);
#pragma unroll
                    for (int i4 = 0; i4 < 4; ++i4) { const int l = mt * 16 + q * 4 + i4; Qb[l * 136 + wid * 16 + r] = f2bf(au[i4]); Kb[l * 136 + wid * 16 + r] = f2bf(aw[i4]); }
                }
            }
            __syncthreads();
#pragma unroll
            for (int i = 0; i < 4; ++i) { const int pi = tid + NTHR * i, which = pi >> 10, l = (pi >> 4) & 63, c8 = pi & 15;
                *(u32x4*)(Z + (tok0 + l * tstep) * 3072 + which * 1024 + dir * 512 + h * 128 + c8 * 8) = *(const LAS u32x4*)(lds + which * 17408 + l * 272 + c8 * 16); }
            __syncthreads();
        }
    }
}
#undef DPL
#undef DPS

__device__ __forceinline__ void delta_scan2(LDSp lds, const Params& p) {
    const bf16_t* QKVN = (const bf16_t*)(p.ws + WS_QKV); const bf16_t* Z = (const bf16_t*)(p.ws + WS_Z); const float* GB = (const float*)(p.ws + WS_G);
    LAS unsigned short* Wb  = (LAS unsigned short*)lds;
    LAS unsigned short* Qg  = (LAS unsigned short*)(lds + 17408);
    LAS unsigned short* Kg  = (LAS unsigned short*)(lds + 34816);
    LAS unsigned short* At  = (LAS unsigned short*)(lds + 53248);
    LAS unsigned short* Ub  = (LAS unsigned short*)(lds + 62464);
    LAS unsigned short* St  = (LAS unsigned short*)(lds + 66560);
    LAS unsigned short* Vt  = (LAS unsigned short*)(lds + 75264);
    const int tid = threadIdx.x, lane = tid & 63, wid = tid >> 6, r = lane & 15, q = lane >> 4;
    for (int unit = blockIdx.x; unit < 128; unit += gridDim.x) {
        const int dir = unit >> 6, b = (unit >> 4) & 3, h = (unit >> 2) & 3, sl = unit & 3;
        bf16_t* O = (bf16_t*)(p.ws + (dir ? WS_OB : WS_OF));
        const long tstep = dir ? -1 : 1;
        f32x4 S0 = {0.f, 0.f, 0.f, 0.f}, S1 = {0.f, 0.f, 0.f, 0.f};
        u32x4 rwA[2], rqA[2], rkA[2], raA, ruA = {0u, 0u, 0u, 0u}; float g0A = 0.f, g1A = 0.f, gLA = 0.f;
        u32x4 rwB[2], rqB[2], rkB[2], raB, ruB = {0u, 0u, 0u, 0u}; float g0B = 0.f, g1B = 0.f, gLB = 0.f;
#define D2_TOK0(n) ((long)b * S_ + (dir ? (S_ - 1 - (n) * 64) : (n) * 64))
#define D2_LOAD(n, X) do { const long t0_ = D2_TOK0(n); \
        _Pragma("unroll") for (int i = 0; i < 2; ++i) { const int pi = tid + NTHR * i, l = pi >> 4, c8 = pi & 15; const long tk = t0_ + l * tstep; \
            rw##X[i] = *(const u32x4*)(Z + tk * 3072 + 1024 + dir * 512 + h * 128 + c8 * 8); \
            rq##X[i] = *(const u32x4*)(QKVN + tk * 1536 + h * 128 + c8 * 8); rk##X[i] = *(const u32x4*)(QKVN + tk * 1536 + 512 + h * 128 + c8 * 8); } \
        { const int l = tid >> 3, c8 = tid & 7; ra##X = *(const u32x4*)(Z + (t0_ + l * tstep) * 3072 + 2048 + dir * 256 + h * 64 + c8 * 8); } \
        if (tid < 256) { const int l = tid >> 2, c8 = tid & 3; ru##X = *(const u32x4*)(Z + (t0_ + l * tstep) * 3072 + dir * 512 + h * 128 + sl * 32 + c8 * 8); } \
        g0##X = GB[((size_t)dir * T_ + (t0_ + (tid >> 4) * tstep)) * 4 + h]; g1##X = GB[((size_t)dir * T_ + (t0_ + ((tid >> 4) + 32) * tstep)) * 4 + h]; \
        gL##X = GB[((size_t)dir * T_ + (t0_ + 63 * tstep)) * 4 + h]; } while (0)
#define D2_ITER(n, X) do { \
            const float egL = __expf(gL##X); \
            _Pragma("unroll") for (int i = 0; i < 2; ++i) { const int pi = tid + NTHR * i, l = pi >> 4, c8 = pi & 15; const float gl_ = i == 0 ? g0##X : g1##X; \
                *(LAS u32x4*)(Wb + l * 136 + c8 * 8) = rw##X[i]; \
                float f[8]; unpack8(rq##X[i], f); const float eg = __expf(gl_); \
                u32x4 o; o.x = pk2(f[0] * eg, f[1] * eg); o.y = pk2(f[2] * eg, f[3] * eg); o.z = pk2(f[4] * eg, f[5] * eg); o.w = pk2(f[6] * eg, f[7] * eg); \
                *(LAS u32x4*)(Qg + l * 136 + c8 * 8) = o; \
                unpack8(rk##X[i], f); const float ek = __expf(gL##X - gl_); \
                o.x = pk2(f[0] * ek, f[1] * ek); o.y = pk2(f[2] * ek, f[3] * ek); o.z = pk2(f[4] * ek, f[5] * ek); o.w = pk2(f[6] * ek, f[7] * ek); \
                *(LAS u32x4*)(Kg + l * 144 + c8 * 8) = o; } \
            { const int l = tid >> 3, c8 = tid & 7; *(LAS u32x4*)(At + l * 72 + c8 * 8) = ra##X; } \
            if (tid < 256) { const int l = tid >> 2, c8 = tid & 3; *(LAS u32x4*)(Ub + l * 32 + c8 * 8) = ru##X; } \
            { u32x2 w0; w0.x = pk2(S0.x, S0.y); w0.y = pk2(S0.z, S0.w); *(LAS u32x2*)(St + r * 136 + wid * 16 + q * 4) = w0; \
              u32x2 w1; w1.x = pk2(S1.x, S1.y); w1.y = pk2(S1.z, S1.w); *(LAS u32x2*)(St + (16 + r) * 136 + wid * 16 + q * 4) = w1; } \
            __syncthreads(); \
            if ((n) + 2 < 64) D2_LOAD((n) + 2, X); \
            const int mt = wid >> 1, nt = wid & 1; \
            f32x4 p1 = {0.f, 0.f, 0.f, 0.f}, p2 = {0.f, 0.f, 0.f, 0.f}; \
            p1 = mma_tile<128>(Wb + mt * 16 * 136, 136, St + nt * 16 * 136, 136, p1); \
            p2 = mma_tile<128>(Qg + mt * 16 * 136, 136, St + nt * 16 * 136, 136, p2); \
            { const int l0 = mt * 16 + q * 4, v = nt * 16 + r; float vn[4]; \
              _Pragma("unroll") for (int i = 0; i < 4; ++i) vn[i] = bf2f(Ub[(l0 + i) * 32 + v]) - p1[i]; \
              u32x2 w; w.x = pk2(vn[0], vn[1]); w.y = pk2(vn[2], vn[3]); *(LAS u32x2*)(Vt + v * 72 + l0) = w; } \
            __syncthreads(); \
            p2 = mma_tile<64>(At + mt * 16 * 72, 72, Vt + nt * 16 * 72, 72, p2); \
            { const long t0_ = D2_TOK0(n); \
              _Pragma("unroll") for (int i = 0; i < 4; ++i) O[(t0_ + (mt * 16 + q * 4 + i) * tstep) * 512 + h * 128 + sl * 32 + nt * 16 + r] = f2bf(p2[i]); } \
            S0 = S0 * egL; S1 = S1 * egL; \
            { bf16x8_t ka0, ka1; tr_frag2((unsigned)(unsigned long long)Kg, 288, wid, ka0, ka1); \
              const bf16x8_t vb00 = *(const LAS bf16x8_t*)(Vt + r * 72 + q * 8), vb01 = *(const LAS bf16x8_t*)(Vt + r * 72 + 32 + q * 8); \
              const bf16x8_t vb10 = *(const LAS bf16x8_t*)(Vt + (16 + r) * 72 + q * 8), vb11 = *(const LAS bf16x8_t*)(Vt + (16 + r) * 72 + 32 + q * 8); \
              S0 = __builtin_amdgcn_mfma_f32_16x16x32_bf16(ka0, vb00, S0, 0, 0, 0); S0 = __builtin_amdgcn_mfma_f32_16x16x32_bf16(ka1, vb01, S0, 0, 0, 0); \
              S1 = __builtin_amdgcn_mfma_f32_16x16x32_bf16(ka0, vb10, S1, 0, 0, 0); S1 = __builtin_amdgcn_mfma_f32_16x16x32_bf16(ka1, vb11, S1, 0, 0, 0); } \
            __syncthreads(); } while (0)
        D2_LOAD(0, A); D2_LOAD(1, B);
#pragma unroll 1
        for (int n = 0; n < 64; n += 2) { D2_ITER(n, A); D2_ITER(n + 1, B); }
#undef D2_ITER
#undef D2_LOAD
#undef D2_TOK0
    }
}
constexpr size_t WS_CT = WS_OF, WS_NV = 235 * MiB, WS_MS = 235 * MiB + 524288, WS_CT2 = 169 * MiB, WS_NV2 = 236 * MiB;
__device__ __forceinline__ void mlstm_a(LDSp lds, const Params& p) {
    const bf16_t* Z = (const bf16_t*)(p.ws + WS_Z); const float* LI = (const float*)(p.ws + WS_BETA); const float* LF = (const float*)(p.ws + WS_LA);
    bf16_t* CT = (bf16_t*)(p.ws + WS_CT); float* NV = (float*)(p.ws + WS_NV); float* MS = (float*)(p.ws + WS_MS);
    LAS unsigned short* Ks = (LAS unsigned short*)lds;
    LAS unsigned short* Vr = (LAS unsigned short*)(lds + 9216);
    LAS float* lf = (LAS float*)(lds + 27648); LAS float* li = lf + 64; LAS float* sw = lf + 128; LAS float* red = lf + 192  ;
    const int tid = threadIdx.x, lane = tid & 63, wid = tid >> 6, r = lane & 15, q = lane >> 4;
    for (int unit = blockIdx.x; unit < 2048; unit += gridDim.x) {
        const int dir = unit >> 10, b = (unit >> 8) & 3, h = (unit >> 6) & 3, n = unit & 63, pc = dir ? 63 - n : n;
        const size_t tok0 = (size_t)b * S_ + pc * 64;
        if (tid < 64) { lf[tid] = LF[(tok0 + tid) * 8 + dir * 4 + h]; li[tid] = LI[(tok0 + tid) * 8 + dir * 4 + h]; }
        __syncthreads();
        if (tid < 64) { const float bc = wave_scan_sum(lf[tid], dir == 0);
            const float tot = __shfl(bc, dir ? 0 : 63);
            const float we = tot - bc + li[tid]; float mx = we;
#pragma unroll
            for (int o = 32; o; o >>= 1) mx = fmaxf(mx, __shfl_xor(mx, o));
            sw[tid] = __expf(we - mx);
            if (tid == 0) { MS[unit * 32] = tot; MS[unit * 32 + 1] = mx; } }
        __syncthreads();
        { const int pp = tid >> 3, c8 = tid & 7; const u32x4 kv = *(const u32x4*)(Z + (tok0 + pp) * 2560 + 1280 + h * 64 + c8 * 8); float f[8]; unpack8(kv, f); const float s = sw[pp];
          u32x4 o; o.x = pk2(f[0] * s, f[1] * s); o.y = pk2(f[2] * s, f[3] * s); o.z = pk2(f[4] * s, f[5] * s); o.w = pk2(f[6] * s, f[7] * s);
          *(LAS u32x4*)(Ks + pp * 72 + c8 * 8) = o; }
#pragma unroll
        for (int i = 0; i < 2; ++i) { const int pi = tid + NTHR * i, pp = pi >> 4, c8 = pi & 15;
            *(LAS u32x4*)(Vr + pp * 144 + c8 * 8) = *(const u32x4*)(Z + (tok0 + pp) * 2560 + 1536 + h * 128 + c8 * 8); }
        __syncthreads();
        { bf16x8_t vb0, vb1; tr_frag2((unsigned)(unsigned long long)Vr, 288, wid, vb0, vb1);
#pragma unroll
          for (int dt = 0; dt < 4; ++dt) { bf16x8_t ka0, ka1; tr_frag2((unsigned)(unsigned long long)Ks, 144, dt, ka0, ka1);
            f32x4 acc = {0.f, 0.f, 0.f, 0.f};
            acc = __builtin_amdgcn_mfma_f32_16x16x32_bf16(ka0, vb0, acc, 0, 0, 0); acc = __builtin_amdgcn_mfma_f32_16x16x32_bf16(ka1, vb1, acc, 0, 0, 0);
            u32x2 w; w.x = pk2(acc.x, acc.y); w.y = pk2(acc.z, acc.w);
            *(u32x2*)(CT + (size_t)unit * 8192 + (wid * 16 + r) * 64 + dt * 16 + q * 4) = w; } }
        { const int d = tid & 63; float a = 0.f;
#pragma unroll
          for (int j = 0; j < 8; ++j) a += bf2f(Ks[(wid * 8 + j) * 72 + d]);
          red[wid * 64 + d] = a; }
        __syncthreads();
        if (tid < 64) { float a = 0.f;
#pragma unroll
            for (int w = 0; w < 8; ++w) a += red[w * 64 + tid];
            NV[(size_t)unit * 64 + tid] = a; }
        __syncthreads();
    }
}
__device__ __forceinline__ void mlstm_b(const Params& p) {
    const bf16_t* CT = (const bf16_t*)(p.ws + WS_CT); const float* NV = (const float*)(p.ws + WS_NV); float* MS = (float*)(p.ws + WS_MS); bf16_t* CT2 = (bf16_t*)(p.ws + WS_CT2); float* NV2 = (float*)(p.ws + WS_NV2);
    const int tid = threadIdx.x;
    for (int wgi = blockIdx.x; wgi < 128; wgi += gridDim.x) {
        const int scan = wgi >> 2, part = wgi & 3; const size_t e = (size_t)(part * NTHR + tid) * 4;
        const bool nvw = (part == 0 && tid < 64);
        float m = 0.f, c0 = 0.f, c1 = 0.f, c2 = 0.f, c3 = 0.f, nn = 0.f;
#pragma unroll 1
        for (int hf = 0; hf < 4; ++hf) {
        u32x2 dc[16]; float dn[16], blv[16], mlv[16];
#pragma unroll
        for (int n = 0; n < 16; ++n) { blv[n] = MS[(scan * 64 + hf * 16 + n) * 32]; mlv[n] = MS[(scan * 64 + hf * 16 + n) * 32 + 1]; dc[n] = (EXPC == 2) ? (u32x2){0u, 0u} : *(const u32x2*)(CT + (size_t)(scan * 64 + hf * 16 + n) * 8192 + e); dn[n] = nvw ? NV[(size_t)(scan * 64 + hf * 16 + n) * 64 + tid] : 0.f; }
#pragma unroll
        for (int n = 0; n < 16; ++n) { const int unit = scan * 64 + hf * 16 + n;
            const float bl = blv[n], ml = mlv[n];
            u32x2 w; w.x = pk2(c0, c1); w.y = pk2(c2, c3); *(u32x2*)(CT2 + (size_t)unit * 8192 + e) = w;
            if (nvw) NV2[(size_t)unit * 64 + tid] = nn;
            if (part == 0 && tid == 0) MS[65536 + unit] = m;
            const float mn = fmaxf(bl + m, ml), a = __expf(bl + m - mn), bb = __expf(ml - mn);
            c0 = a * c0 + bb * bflo(dc[n].x); c1 = a * c1 + bb * bfhi(dc[n].x); c2 = a * c2 + bb * bflo(dc[n].y); c3 = a * c3 + bb * bfhi(dc[n].y);
            nn = a * nn + bb * dn[n]; m = mn; }
        }
    }
}
__device__ __forceinline__ void mlstm_c(LDSp lds, const Params& p) {
    const bf16_t* Z = (const bf16_t*)(p.ws + WS_Z); const float* LI = (const float*)(p.ws + WS_BETA); const float* LF = (const float*)(p.ws + WS_LA);
    const bf16_t* CT = (const bf16_t*)(p.ws + WS_CT2); const float* NV = (const float*)(p.ws + WS_NV2); const float* MS = (const float*)(p.ws + WS_MS);
    bf16_t* Y = (bf16_t*)(p.ws + WS_HN); const float* gn = p.in[19];
    LAS unsigned short* Qb = (LAS unsigned short*)lds;
    LAS unsigned short* Kb = (LAS unsigned short*)(lds + 9216);
    LAS unsigned short* Vr = (LAS unsigned short*)(lds + 18432);
    LAS float* ssp = (LAS float*)(lds + 100352);
#define MC_CB(d) ((LAS unsigned short*)(lds + 36864 + (d) * 18432))
#define MC_PB(d) ((LAS unsigned short*)(lds + 73728 + (d) * 9216))
#define MC_SC(d) ((LAS float*)(lds + 92160 + (d) * 4096))
    const int tid = threadIdx.x, wid = tid >> 6;
    for (int unit = blockIdx.x; unit < 1024; unit += gridDim.x) {
        int lane = tid & 63; asm volatile("" : "+v"(lane));
        const int r = lane & 15, q = lane >> 4;
        const int b = unit >> 8, h = (unit >> 6) & 3, pc = unit & 63; const size_t tok0 = (size_t)b * S_ + pc * 64;
        const size_t ua = (size_t)(((0 * 4 + b) * 4 + h) * 64 + pc), ub = (size_t)(((1 * 4 + b) * 4 + h) * 64 + (63 - pc));
        { const int pp = tid >> 3, c8 = tid & 7;
          *(LAS u32x4*)(Qb + pp * 72 + c8 * 8) = *(const u32x4*)(Z + (tok0 + pp) * 2560 + 1024 + h * 64 + c8 * 8);
          *(LAS u32x4*)(Kb + pp * 72 + c8 * 8) = *(const u32x4*)(Z + (tok0 + pp) * 2560 + 1280 + h * 64 + c8 * 8); }
#pragma unroll
        for (int i = 0; i < 2; ++i) { const int pi = tid + NTHR * i, pp = pi >> 4, c8 = pi & 15; *(LAS u32x4*)(Vr + pp * 144 + c8 * 8) = *(const u32x4*)(Z + (tok0 + pp) * 2560 + 1536 + h * 128 + c8 * 8); }
#pragma unroll
        for (int i = 0; i < 2; ++i) { const int pi = tid + NTHR * i, v = pi >> 3, c8 = pi & 7;
            *(LAS u32x4*)(MC_CB(0) + v * 72 + c8 * 8) = *(const u32x4*)(CT + ua * 8192 + v * 64 + c8 * 8); *(LAS u32x4*)(MC_CB(1) + v * 72 + c8 * 8) = *(const u32x4*)(CT + ub * 8192 + v * 64 + c8 * 8); }
        float mst = 0.f;
        if (tid < 128) { const int d = tid >> 6; const size_t ud = d ? ub : ua; LAS float* sc = MC_SC(d);
            sc[lane] = LF[(tok0 + lane) * 8 + d * 4 + h]; sc[64 + lane] = LI[(tok0 + lane) * 8 + d * 4 + h]; sc[384 + lane] = NV[ud * 64 + lane]; mst = MS[65536 + ud]; }
        __syncthreads();
        bf16x8_t vb0, vb1; tr_frag2((unsigned)(unsigned long long)Vr, 288, wid, vb0, vb1);
        {
            const int t = tid >> 3, part = tid & 7; const u32x4 qv = *(const LAS u32x4*)(Qb + t * 72 + part * 8); float f[8]; unpack8(qv, f);
#pragma unroll
            for (int d = 0; d < 2; ++d) { LAS float* sc = MC_SC(d);
                const f32x4 n0 = *(const LAS f32x4*)(sc + 384 + part * 8), n1 = *(const LAS f32x4*)(sc + 384 + part * 8 + 4);
                float a = f[0] * n0.x; a = fmaf(f[1], n0.y, a); a = fmaf(f[2], n0.z, a); a = fmaf(f[3], n0.w, a); a = fmaf(f[4], n1.x, a); a = fmaf(f[5], n1.y, a); a = fmaf(f[6], n1.z, a); a = fmaf(f[7], n1.w, a);
                a += dppf<0xB1>(a); a += dppf<0x4E>(a); a += dppf<0x141>(a);
                if (part == 0) sc[320 + t] = a; } }
        if (tid < 128) {
            const int d = tid >> 6; LAS float* sc = MC_SC(d);
            const float bt = wave_scan_sum(sc[lane], d == 0);
            const float dmax = bt + wave_scan_max(sc[64 + lane] - bt, d == 0);
            const float m = fmaxf(bt + mst, dmax), w = __expf(bt + mst - m);
            sc[128 + lane] = bt; sc[192 + lane] = m; sc[256 + lane] = w * 0.125f; sc[448 + lane] = __expf(-m); }
        __syncthreads();
#pragma unroll 1
        for (int tt = 0; tt < 2; ++tt) { const int idx = wid * 2 + tt, mt = idx >> 2, nt = idx & 3;
            f32x4 scv = {0.f, 0.f, 0.f, 0.f};
            scv = mma_tile<64>(Qb + mt * 16 * 72, 72, Kb + nt * 16 * 72, 72, scv);
            const int s_ = nt * 16 + r;
#pragma unroll 1
            for (int d = 0; d < 2; ++d) { LAS float* sc = MC_SC(d); LAS unsigned short* Pb = MC_PB(d); const float bs = sc[128 + s_] - sc[64 + s_];
#pragma unroll
                for (int i = 0; i < 4; ++i) { const int t = mt * 16 + q * 4 + i; const bool ok = d ? (s_ >= t) : (s_ <= t);
                    const float pv = ok ? __expf(sc[128 + t] - bs - sc[192 + t]) * scv[i] * 0.125f : 0.f;
                    const unsigned short pb = f2bf(pv); Pb[t * 72 + s_] = pb;
                    const float rs = row16_sum(bf2f(pb));
                    if (r == 0) sc[512 + nt * 64 + t] = rs; } }
        }
        __syncthreads();
        f32x4 hacc[4];
#pragma unroll
        for (int mt = 0; mt < 4; ++mt) { hacc[mt] = (f32x4){0.f, 0.f, 0.f, 0.f};
            const bf16x8_t qa0 = *(const LAS bf16x8_t*)(Qb + (mt * 16 + r) * 72 + q * 8), qa1 = *(const LAS bf16x8_t*)(Qb + (mt * 16 + r) * 72 + 32 + q * 8);
#pragma unroll 1
            for (int d = 0; d < 2; ++d) { const LAS float* sc = MC_SC(d); const LAS unsigned short* Pb = MC_PB(d); const LAS unsigned short* Cb = MC_CB(d);
                f32x4 a1 = {0.f, 0.f, 0.f, 0.f}, a2 = {0.f, 0.f, 0.f, 0.f};
                const bf16x8_t cb0 = *(const LAS bf16x8_t*)(Cb + (wid * 16 + r) * 72 + q * 8), cb1 = *(const LAS bf16x8_t*)(Cb + (wid * 16 + r) * 72 + 32 + q * 8);
                a1 = __builtin_amdgcn_mfma_f32_16x16x32_bf16(qa0, cb0, a1, 0, 0, 0); a1 = __builtin_amdgcn_mfma_f32_16x16x32_bf16(qa1, cb1, a1, 0, 0, 0);
                const bf16x8_t pa0 = *(const LAS bf16x8_t*)(Pb + (mt * 16 + r) * 72 + q * 8), pa1 = *(const LAS bf16x8_t*)(Pb + (mt * 16 + r) * 72 + 32 + q * 8);
                a2 = __builtin_amdgcn_mfma_f32_16x16x32_bf16(pa0, vb0, a2, 0, 0, 0); a2 = __builtin_amdgcn_mfma_f32_16x16x32_bf16(pa1, vb1, a2, 0, 0, 0);
#pragma unroll
                for (int i = 0; i < 4; ++i) { const int t = mt * 16 + q * 4 + i;
                    const float den = sc[256 + t] * sc[320 + t] + ((sc[512 + t] + sc[576 + t]) + (sc[640 + t] + sc[704 + t]));
                    hacc[mt][i] += (sc[256 + t] * a1[i] + a2[i]) * __builtin_amdgcn_rcpf(fmaxf(fabsf(den), sc[448 + t])); }
            }
        }
#pragma unroll
        for (int mt = 0; mt < 4; ++mt)
#pragma unroll
            for (int i = 0; i < 4; ++i) { const float s = row16_sum(hacc[mt][i] * hacc[mt][i]); if (r == 0) ssp[wid * 64 + mt * 16 + q * 4 + i] = s; }
        __syncthreads();
        { const int v = wid * 16 + r; const float g = gn[v]; LAS unsigned short* Yt = MC_CB(0);
#pragma unroll
          for (int mt = 0; mt < 4; ++mt)
#pragma unroll
              for (int i = 0; i < 4; ++i) { const int t = mt * 16 + q * 4 + i;
                  float ss = 0.f;
#pragma unroll
                  for (int w = 0; w < 8; ++w) ss += ssp[w * 64 + t];
                  const float rstd = rsqrtf(ss * (1.0f / 128.0f) + 1e-6f);
                  Yt[t * 136 + v] = f2bf(hacc[mt][i] * rstd * g); } }
        __syncthreads();
#pragma unroll
        for (int i = 0; i < 2; ++i) { const int pi = tid + NTHR * i, t = pi >> 4, c8 = (pi & 15) * 8;
            const u32x4 yv = *(const LAS u32x4*)(MC_CB(0) + t * 136 + c8); const u32x4 ov = *(const u32x4*)(Z + (tok0 + t) * 2560 + 2048 + h * 128 + c8);
            float y[8], o[8]; unpack8(yv, y); unpack8(ov, o);
            u32x4 w; w.x = pk2(y[0] * sigm_f(o[0]), y[1] * sigm_f(o[1])); w.y = pk2(y[2] * sigm_f(o[2]), y[3] * sigm_f(o[3])); w.z = pk2(y[4] * sigm_f(o[4]), y[5] * sigm_f(o[5])); w.w = pk2(y[6] * sigm_f(o[6]), y[7] * sigm_f(o[7]));
            *(u32x4*)(Y + (tok0 + t) * 1024 + 512 + h * 128 + c8) = w; }
        __syncthreads();
    }
#undef MC_CB
#undef MC_PB
#undef MC_SC
}
__device__ __forceinline__ void headnorm_phase(const Params& p, const float* __restrict__ g, int zld, int zcol, int act) {
    const bf16_t* OF = (const bf16_t*)(p.ws + WS_OF); const bf16_t* OB = (const bf16_t*)(p.ws + WS_OB); const bf16_t* Z = (const bf16_t*)(p.ws + WS_Z); bf16_t* Y = (bf16_t*)(p.ws + WS_HN);
    const int tid = threadIdx.x, lane = tid & 63, wid = tid >> 6, c = lane * 8;
    const f32x4 g0 = *(const f32x4*)(g + (c & 127)), g1 = *(const f32x4*)(g + (c & 127) + 4);
    for (int tok = blockIdx.x * 8 + wid; tok < T_; tok += gridDim.x * 8) {
        const u32x4 a = *(const u32x4*)(OF + (size_t)tok * 512 + c), bq = *(const u32x4*)(OB + (size_t)tok * 512 + c), gz = *(const u32x4*)(Z + (size_t)tok * zld + zcol + c);
        float fa[8], fb[8], fg[8], o[8]; unpack8(a, fa); unpack8(bq, fb); unpack8(gz, fg);
        float ss = 0.f;
#pragma unroll
        for (int i = 0; i < 8; ++i) { o[i] = fa[i] + fb[i]; ss = fmaf(o[i], o[i], ss); }
        ss = row16_sum(ss);
        const float rstd = rsqrtf(ss * (1.0f / 128.0f) + 1e-6f);
        const float gg[8] = {g0.x, g0.y, g0.z, g0.w, g1.x, g1.y, g1.z, g1.w};
        float y[8];
#pragma unroll
        for (int i = 0; i < 8; ++i) y[i] = o[i] * rstd * gg[i] * (act == 0 ? fg[i] * sigm_f(fg[i]) : sigm_f(fg[i]));
        u32x4 w; w.x = pk2(y[0], y[1]); w.y = pk2(y[2], y[3]); w.z = pk2(y[4], y[5]); w.w = pk2(y[6], y[7]);
        *(u32x4*)(Y + (size_t)tok * 1024 + 512 + c) = w;
    }
}

__device__ __forceinline__ void odd_prep(const Params& p) {
    const bf16_t* Z = (const bf16_t*)(p.ws + WS_Z); bf16_t* VV = (bf16_t*)(p.ws + WS_QKV);
    const float* gates = (const float*)(p.ws + WS_GATES); float* LI = (float*)(p.ws + WS_BETA); float* LF = (float*)(p.ws + WS_LA);
    const float* ln_g = p.in[13]; const float* ln_b = p.in[14]; const float* ib = p.in[17]; const float* fb = p.in[18];
    const int tid = threadIdx.x, lane = tid & 63, wid = tid >> 6, c = lane * 8;
    const f32x4 g0 = *(const f32x4*)(ln_g + c), g1 = *(const f32x4*)(ln_g + c + 4), b0 = *(const f32x4*)(ln_b + c), b1 = *(const f32x4*)(ln_b + c + 4);
    const float gg[8] = {g0.x, g0.y, g0.z, g0.w, g1.x, g1.y, g1.z, g1.w}, bb[8] = {b0.x, b0.y, b0.z, b0.w, b1.x, b1.y, b1.z, b1.w};
    for (int tok = blockIdx.x * 8 + wid; tok < T_; tok += gridDim.x * 8) {
        const u32x4 v = *(const u32x4*)(Z + (size_t)tok * 2560 + 512 + c);
        float x[8]; unpack8(v, x); float sm = 0.f;
#pragma unroll
        for (int i = 0; i < 8; ++i) { x[i] = gelu_t(x[i]); sm += x[i]; }
        const float mean = wave_sum(sm) * (1.0f / 512.0f); float sq = 0.f;
#pragma unroll
        for (int i = 0; i < 8; ++i) { x[i] -= mean; sq = fmaf(x[i], x[i], sq); }
        const float rstd = rsqrtf(wave_sum(sq) * (1.0f / 512.0f) + 1e-5f);
        float y[8];
#pragma unroll
        for (int i = 0; i < 8; ++i) y[i] = x[i] * rstd * gg[i] + bb[i];
        u32x4 w; w.x = pk2(y[0], y[1]); w.y = pk2(y[2], y[3]); w.z = pk2(y[4], y[5]); w.w = pk2(y[6], y[7]);
        *(u32x4*)(VV + (size_t)tok * 512 + c) = w;
        if (lane < 8) { LI[(size_t)tok * 8 + lane] = gates[(size_t)tok * 16 + lane] + ib[lane];
                        LF[(size_t)tok * 8 + lane] = -softplus_(-(gates[(size_t)tok * 16 + 8 + lane] + fb[lane])); }
    }
}

__device__ __forceinline__ void sg_phase(LDSp lds, const Params& p, int sgId, int sgG) {
    typedef short bf16x8 __attribute__((ext_vector_type(8)));
    const bf16_t* Z = (const bf16_t*)(p.ws + WS_Z); const bf16_t* VV = (const bf16_t*)(p.ws + WS_QKV); bf16_t* Y = (bf16_t*)(p.ws + WS_HN);
    const float* sgw = p.in[15]; const float* sgb = p.in[16];
    LAS unsigned short* Wb = (LAS unsigned short*)lds;
    LAS unsigned short* Vt = (LAS unsigned short*)(lds + 34816);
    const int tid = threadIdx.x, lane = tid & 63, wid = tid >> 6;
    for (int unit = sgId; unit < 512; unit += sgG) {
        const int g = unit & 3, n = (unit >> 2) & 31, b = unit >> 7; const size_t tok0 = (size_t)b * S_ + n * 128;
#pragma unroll
        for (int i = 0; i < 8; ++i) { const int i4 = tid + NTHR * i, t = i4 >> 5, s4 = (i4 & 31) << 2; const f32x4 w = *(const f32x4*)(sgw + (size_t)g * 16384 + t * 128 + s4);
            u32x2 o; o.x = pk2(w.x, w.y); o.y = pk2(w.z, w.w); *(LAS u32x2*)(Wb + t * 136 + s4) = o; }
#pragma unroll
        for (int i = 0; i < 4; ++i) { const int pi = tid + NTHR * i, s = pi >> 4, c8 = (pi & 15) << 3; const u32x4 v = *(const u32x4*)(VV + (tok0 + s) * 512 + g * 128 + c8);
            Vt[(c8 + 0) * 136 + s] = (unsigned short)(v.x & 0xffffu); Vt[(c8 + 1) * 136 + s] = (unsigned short)(v.x >> 16);
            Vt[(c8 + 2) * 136 + s] = (unsigned short)(v.y & 0xffffu); Vt[(c8 + 3) * 136 + s] = (unsigned short)(v.y >> 16);
            Vt[(c8 + 4) * 136 + s] = (unsigned short)(v.z & 0xffffu); Vt[(c8 + 5) * 136 + s] = (unsigned short)(v.z >> 16);
            Vt[(c8 + 6) * 136 + s] = (unsigned short)(v.w & 0xffffu); Vt[(c8 + 7) * 136 + s] = (unsigned short)(v.w >> 16); }
        __syncthreads();
        bf16x8 af[4];
#pragma unroll
        for (int ks = 0; ks < 4; ++ks) af[ks] = *(const LAS bf16x8*)(Wb + (16 * wid + (lane & 15)) * 136 + ks * 32 + (lane >> 4) * 8);
        f32x4 accs[8];
#pragma unroll
        for (int nn = 0; nn < 8; ++nn) {
            f32x4 acc = {0.f, 0.f, 0.f, 0.f};
#pragma unroll
            for (int ks = 0; ks < 4; ++ks) { const bf16x8 bfrag = *(const LAS bf16x8*)(Vt + (16 * nn + (lane & 15)) * 136 + ks * 32 + (lane >> 4) * 8);
                acc = __builtin_amdgcn_mfma_f32_16x16x32_bf16(af[ks], bfrag, acc, 0, 0, 0); }
            accs[nn] = acc; }
        __syncthreads();
#pragma unroll
        for (int nn = 0; nn < 8; ++nn)
#pragma unroll
            for (int i = 0; i < 4; ++i) { const int t = 16 * wid + (lane >> 4) * 4 + i; Wb[t * 136 + 16 * nn + (lane & 15)] = f2bf(accs[nn][i] + sgb[g * 128 + t]); }
        __syncthreads();
#pragma unroll
        for (int i = 0; i < 4; ++i) { const int pi = tid + NTHR * i, t = pi >> 4, c8 = (pi & 15) << 3; const size_t tok = tok0 + t;
            const u32x4 mv = *(const LAS u32x4*)(Wb + t * 136 + c8); const u32x4 uv = *(const u32x4*)(Z + tok * 2560 + g * 128 + c8);
            float m[8], u[8]; unpack8(mv, m); unpack8(uv, u);
            u32x4 w; w.x = pk2(gelu_t(u[0]) * m[0], gelu_t(u[1]) * m[1]); w.y = pk2(gelu_t(u[2]) * m[2], gelu_t(u[3]) * m[3]); w.z = pk2(gelu_t(u[4]) * m[4], gelu_t(u[5]) * m[5]); w.w = pk2(gelu_t(u[6]) * m[6], gelu_t(u[7]) * m[7]);
            *(u32x4*)(Y + tok * 1024 + g * 128 + c8) = w; }
        __syncthreads();
    }
}

#define XB_TMO      128
#define XB_XCNT(j)  (256  + 64 * (j))
#define XB_XSUB(j)  (1280 + 64 * (j))
#define XB_XGEN(j)  (2304 + 64 * (j))
#define XB_TOP      3328
#define XB_TOPGEN   3392
#define XCD_BAR_WORDS 3456
#define XB_SPIN_CAP (1u << 18)

__device__ __forceinline__ unsigned xb_ld(unsigned* p)              { return __hip_atomic_load(p, __ATOMIC_RELAXED, __HIP_MEMORY_SCOPE_AGENT); }
__device__ __forceinline__ unsigned xb_add(unsigned* p, unsigned v) { return __hip_atomic_fetch_add(p, v, __ATOMIC_RELAXED, __HIP_MEMORY_SCOPE_AGENT); }
__device__ __forceinline__ unsigned xb_xcc_id() { return (unsigned)__builtin_amdgcn_s_getreg((3 << 11) | 20) & 0xFu; }
#define XB_SPIN(cond, bar) do { unsigned _sp = 0; while (cond) { __builtin_amdgcn_s_sleep(1); \
    if ((++_sp & 255u) == 0u) { if (xb_ld(&(bar)[XB_TMO])) break; if (_sp > XB_SPIN_CAP) { atomicAdd(&(bar)[XB_TMO], 1u); break; } } } } while (0)

struct XcdBarrier {
    unsigned* bar; unsigned x;
    volatile LAS unsigned* st;
};

__device__ __forceinline__ XcdBarrier xcd_barrier_post(unsigned* bar, volatile LAS unsigned* st) {
    XcdBarrier b; b.bar = bar; b.x = xb_xcc_id(); b.st = st;
    if (threadIdx.x == 0) (void)xb_add(&bar[XB_XCNT(b.x)], 1u);
    return b;
}
__device__ __forceinline__ void xcd_barrier_complete(unsigned* bar, unsigned x, unsigned& nloc, unsigned& nx) {
    const unsigned G = gridDim.x * gridDim.y * gridDim.z;
    unsigned sum, cnt, mine, sp = 0u;
    for (;;) {
        sum = 0u; cnt = 0u; mine = 0u;
#pragma unroll
        for (unsigned j = 0; j < 16; ++j) { const unsigned c = xb_ld(&bar[XB_XCNT(j)]); sum += c; cnt += (c > 0u) ? 1u : 0u; mine = (j == x) ? c : mine; }
        if (sum == G) break;
        __builtin_amdgcn_s_sleep(1);
        if ((++sp & 255u) == 0u) { if (xb_ld(&bar[XB_TMO])) break; if (sp > XB_SPIN_CAP) { atomicAdd(&bar[XB_TMO], 1u); break; } }
    }
    nloc = mine > 0u ? mine : 1u; nx = cnt > 0u ? cnt : 1u;
}

__device__ __forceinline__ void xcd_barrier(const XcdBarrier& b) {
    asm volatile("s_waitcnt vmcnt(0)" ::: "memory");
    __syncthreads();
    if (threadIdx.x == 0) {
        unsigned* bar = b.bar;
        __builtin_amdgcn_s_waitcnt(0);
        unsigned nloc = b.st[0], nx = b.st[1];
        if (nloc == 0u) { xcd_barrier_complete(bar, b.x, nloc, nx); b.st[0] = nloc; b.st[1] = nx; }
        const unsigned old = xb_add(&bar[XB_XSUB(b.x)], 1u);
        const unsigned gen = old / nloc;
        if (old + 1u == (gen + 1u) * nloc) {
            __builtin_amdgcn_fence(__ATOMIC_RELEASE, "agent");
            asm volatile("s_waitcnt vmcnt(0)" ::: "memory");
            const unsigned og = xb_add(&bar[XB_TOP], 1u);
            const unsigned tg = og / nx;
            if (og + 1u == (tg + 1u) * nx) xb_add(&bar[XB_TOPGEN], 1u);
            else XB_SPIN(xb_ld(&bar[XB_TOPGEN]) == tg, bar);
            __builtin_amdgcn_fence(__ATOMIC_ACQUIRE, "agent");
            xb_add(&bar[XB_XGEN(b.x)], 1u);
            asm volatile("s_waitcnt vmcnt(0)" ::: "memory");
        } else {
            XB_SPIN(xb_ld(&bar[XB_XGEN(b.x)]) == gen, bar);
            __builtin_amdgcn_fence(__ATOMIC_ACQUIRE, "agent");
            asm volatile("s_waitcnt vmcnt(0)" ::: "memory");
        }
    }
    __syncthreads();
}
constexpr size_t WS_BAR = 238 * MiB;
#ifndef N_PHASES
#define N_PHASES 21
#endif
template <int L, int SUB> __device__ __forceinline__ void run_phase(LDSp lds, const Params& p) {
    unsigned char* ws = p.ws;
    bf16_t* HN = (bf16_t*)(ws + WS_HN); bf16_t* Zb = (bf16_t*)(ws + WS_Z); float* h = p.out; float* gates = (float*)(ws + WS_GATES);
    const bf16_t* W_IN = (const bf16_t*)(ws + WS_WB + WB_IN); const bf16_t* W_OUT = (const bf16_t*)(ws + WS_WB + WB_OUT);
    const bf16_t* W_UP = (const bf16_t*)(ws + WS_WB + WB_UP); const bf16_t* W_DN = (const bf16_t*)(ws + WS_WB + WB_DN);
    const int G = gridDim.x;
    if constexpr (L == 2) { rms_phase(lds, h, p.in[25], nullptr, nullptr, h, nullptr, 0, 0, nullptr); }
    else if constexpr (SUB == 0) {
        convert_layer(lds, p, L);
        if constexpr (L == 0) rms_phase(lds, p.in[0], p.in[1], HN, nullptr, nullptr, p.in[2], 3088, 3072, gates);
        else                  rms_phase(lds, h, p.in[1] + 1024, HN, nullptr, nullptr, p.in[12], 2576, 2560, gates);
    } else if constexpr (SUB == 1) { constexpr int N = L == 0 ? 3072 : 2560;
        pg8::Gemm g{HN, W_IN, T_, N, 1024}; pg8::StaticOrder S; S.init(T_, N, G, (int)blockIdx.x);
        pg8::EpiBf16<0> E{Zb, N, nullptr, 0, 0};
        pg8::gemm_phase<pg8::EpiBf16<0>, pg8::StaticOrder>(lds, g, S, E, nullptr);
    } else if constexpr (SUB == 2) { if constexpr (L == 0) even_prep(lds, p); else odd_prep(p); }
    else if constexpr (SUB == 9) { delta_prep(lds, p); }
    else if constexpr (SUB == 10) { mlstm_b(p); }
    else if constexpr (SUB == 11) { mlstm_c(lds, p); }
    else if constexpr (SUB == 3) {
        if constexpr (L == 0) delta_scan2(lds, p);
        else { mlstm_a(lds, p); sg_phase(lds, p, (int)blockIdx.x, G); }
    } else if constexpr (SUB == 4) { if constexpr (L == 0) headnorm_phase(p, p.in[10], 3072, 2560, 0); else headnorm_phase(p, p.in[19], 2560, 2048, 1); }
    else if constexpr (SUB == 5) { pg8::Gemm g{HN, W_OUT, T_, 1024, 1024}; pg8::StaticOrder S; S.init(T_, 1024, G, (int)blockIdx.x);
        pg8::EpiAddF32 E{h, 1024, L == 0 ? p.in[0] : (const float*)h};
        pg8::gemm_phase<pg8::EpiAddF32, pg8::StaticOrder>(lds, g, S, E, nullptr);
    } else if constexpr (SUB == 6) { rms_phase(lds, h, p.in[21] + L * 1024, HN, nullptr, nullptr, nullptr, 0, 0, nullptr); }
    else if constexpr (SUB == 7) { pg8::Gemm g{HN, W_UP, T_, 2 * DFF, 1024}; pg8::StaticOrder S; S.init(T_, 2 * DFF, G, (int)blockIdx.x);
        pg8::EpiSwiGLU E{Zb, DFF};
        pg8::gemm_phase<pg8::EpiSwiGLU, pg8::StaticOrder>(lds, g, S, E, nullptr);
    } else if constexpr (SUB == 8) { pg8::Gemm g{Zb, W_DN, T_, 1024, DFF}; pg8::StaticOrder S; S.init(T_, 1024, G, (int)blockIdx.x);
        pg8::EpiAddF32 E{h, 1024, (const float*)h};
        pg8::gemm_phase<pg8::EpiAddF32, pg8::StaticOrder>(lds, g, S, E, nullptr);
    }
}
__global__ void __launch_bounds__(NTHR, 2) mega(Params p, int ph_lo, int ph_hi) {
    extern __shared__ __attribute__((aligned(16))) unsigned char lds_raw[];
    LDSp lds = (LDSp)lds_raw;
    cg::grid_group grid = cg::this_grid();
    volatile LAS unsigned* xst = (volatile LAS unsigned*)(lds + LDS_BYTES - 16);
    if (threadIdx.x == 0) { xst[0] = 0u; xst[1] = 0u; }
    __syncthreads();
    XcdBarrier xbar; xbar.bar = (unsigned*)(p.ws + WS_BAR); xbar.x = 0; xbar.st = xst;
    if (ph_hi - ph_lo > 1) xbar = xcd_barrier_post((unsigned*)(p.ws + WS_BAR), xst);
#ifndef REP_MASK
#define REP_MASK 0
#endif
#define PH(k, L, SUB) if (ph_lo <= (k) && (k) < ph_hi) { run_phase<L, SUB>(lds, p); if ((REP_MASK >> (k)) & 1) { __syncthreads(); run_phase<L, SUB>(lds, p); } if ((k) + 1 < ph_hi) { if (ph_lo < 0) grid.sync(); else xcd_barrier(xbar); } }
    PH(0, 0, 0) PH(1, 0, 1) PH(2, 0, 2) PH(3, 0, 9) PH(4, 0, 3) PH(5, 0, 4) PH(6, 0, 5) PH(7, 0, 6) PH(8, 0, 7) PH(9, 0, 8)
    PH(10, 1, 0) PH(11, 1, 1) PH(12, 1, 2) PH(13, 1, 3) PH(14, 1, 10) PH(15, 1, 11)
    PH(16, 1, 5) PH(17, 1, 6) PH(18, 1, 7) PH(19, 1, 8)
    PH(20, 2, 0)
#ifdef EXTRA_SYNCS
    for (int i_ = 0; i_ < EXTRA_SYNCS; ++i_) grid.sync();
#endif
#undef PH
}

extern "C" void kernel_launch(void* const* d_in, const int* in_sizes, int n_in, void* d_out, int out_size, void* d_ws, size_t ws_size, hipStream_t stream) {
    static int grid = 0;
    if (grid == 0) {
        int dev = 0, cus = 0, per_cu = 0;
        (void)hipGetDevice(&dev);
        (void)hipDeviceGetAttribute(&cus, hipDeviceAttributeMultiprocessorCount, dev);
        (void)hipFuncSetAttribute((const void*)mega, hipFuncAttributeMaxDynamicSharedMemorySize, LDS_BYTES);
        if (hipOccupancyMaxActiveBlocksPerMultiprocessor(&per_cu, (const void*)mega, NTHR, LDS_BYTES) != hipSuccess || per_cu < 1) per_cu = 1;
        (void)hipGetLastError();
        if (cus <= 0) cus = 256;
        grid = cus * per_cu;
    }
    if (ws_size < 239 * MiB) { fprintf(stderr, "workspace too small: %zu\n", ws_size); return; }
    Params p{};
    for (int i = 0; i < 26; ++i) p.in[i] = (const float*)d_in[i];
    p.out = (float*)d_out; p.ws = (unsigned char*)d_ws;
#if defined(MULTI_LAUNCH)
    for (int ph = 0; ph < N_PHASES; ++ph) hipLaunchKernelGGL(mega, dim3(grid), dim3(NTHR), LDS_BYTES, stream, p, ph, ph + 1);
#else
    (void)hipMemsetAsync((char*)d_ws + WS_BAR, 0, XCD_BAR_WORDS * 4, stream);
    int lo = 0, hi = N_PHASES;
    void* args[] = {(void*)&p, (void*)&lo, (void*)&hi};
    hipError_t e = hipLaunchCooperativeKernel((const void*)mega, dim3(grid), dim3(NTHR), args, LDS_BYTES, stream);
    if (e != hipSuccess) fprintf(stderr, "cooperative launch failed: %s (grid %d)\n", hipGetErrorString(e), grid);
#endif
}
```

```cpp
#include <hip/hip_runtime.h>
#include <hip/hip_cooperative_groups.h>
#include <cstdio>
namespace cg = cooperative_groups;
namespace pg8 {
#define PG8_LAS __attribute__((address_space(3)))
typedef unsigned short bf16_t;
typedef short bf16x8 __attribute__((ext_vector_type(8)));
typedef float f32x4 __attribute__((ext_vector_type(4)));
typedef unsigned u32x4 __attribute__((ext_vector_type(4)));
constexpr int BM = 256, BK = 64, HALF = 128, HTB = HALF * BK * 2  , STAGE_BYTES = 8 * HTB, NXCD = 8, WGM = 8;

__host__ __device__ __forceinline__ int lds_byte(int r, int c) { const int st = (r >> 4) * 2 + (c >> 5), rr = r & 15, cc = c & 31, ob = rr * 64 + cc * 2; return st * 1024 + (ob ^ (((ob >> 9) & 1) << 5)); }
__host__ __device__ __forceinline__ void stage_rc(int b, int& R, int& C) { const int st = b / 1024, sb = b % 1024, swz = sb ^ (((sb >> 9) & 1) << 5); R = (st >> 1) * 16 + swz / 64; C = (st & 1) * 32 + (swz % 64) / 2; }
__host__ __device__ __forceinline__ int perm32(int rho) { const int n = rho >> 4, i = rho & 15; return 8 * (i >> 2) + 4 * n + (i & 3); }

struct Unit { int pm, pn; };
struct Gemm { const bf16_t* A; const bf16_t* Bt; int M, N, K; };

struct StaticOrder {
    int nM, nN, nwg, G, c;
    __host__ __device__ void init(int M, int N, int G_, int c_) { nM = M / BM; nN = N / BM; nwg = nM * nN; G = G_; c = c_; }
    __host__ __device__ bool next(int i, Unit& u) const {
        const long L = (long)i * G + c; if (L >= nwg) return false;
        int wgid = (int)L; { const int q = nwg / NXCD, r = nwg % NXCD, xcd = wgid % NXCD, off = wgid / NXCD; wgid = (xcd < r ? xcd * (q + 1) : r * (q + 1) + (xcd - r) * q) + off; }
        const int nig = WGM * nN, gid = wgid / nig, fm = gid * WGM, gsz = (nM - fm) < WGM ? (nM - fm) : WGM;
        u.pm = fm + ((wgid % nig) % gsz); u.pn = (wgid % nig) / gsz; return true;
    }
    __device__ __forceinline__ void a_ready(const Unit&) const {}
    __device__ __forceinline__ void done(const Unit&) const {}
};
__device__ __forceinline__ unsigned cvt_pk_bf16(float lo, float hi) { unsigned r; asm volatile("v_cvt_pk_bf16_f32 %0, %1, %2" : "=v"(r) : "v"(lo), "v"(hi)); return r; }
typedef float f32x2 __attribute__((ext_vector_type(2)));
__device__ __forceinline__ f32x2 gelu_pk(f32x2 v) {
    const f32x2 av = __builtin_elementwise_abs(v), d = av * 0.2316418882f + 1.0f;
    f32x2 t; t.x = __builtin_amdgcn_rcpf(d.x); t.y = __builtin_amdgcn_rcpf(d.y);
    f32x2 q = t * 0.5307027145f + (-0.7265760135f); q = q * t + 0.7107068705f; q = q * t + (-0.142248368f); q = q * t + 0.127414796f; q = q * t;
    const f32x2 s = (v * v) * (-0.72134752044f);
    f32x2 e; e.x = __builtin_amdgcn_exp2f(s.x); e.y = __builtin_amdgcn_exp2f(s.y);
    const f32x2 m = v * (q * e), r = v - m;
    f32x2 o; o.x = v.x < 0.f ? m.x : r.x; o.y = v.y < 0.f ? m.y : r.y; return o;
}
template <int ACT  > struct EpiBf16 {
    static constexpr bool PERM = true, AFTER_DRAIN = false;
    bf16_t* O; int ldc; const float* bias; int split_cols; size_t split_stride;
    __device__ __forceinline__ void operator()(const f32x4 (&acc)[2][2][4][2], const Unit& u, int wr, int wc, int fr, int fq) const {
        const int row0 = u.pm * BM + wr * 64 + fr; int colt = u.pn * BM; bf16_t* base = O;
        if (split_cols) { const int t = colt / split_cols; base += (size_t)t * split_stride; colt -= t * split_cols; }
        const int col0 = colt + wc * 32 + 8 * fq, bcol0 = u.pn * BM + wc * 32 + 8 * fq;
        f32x4 bv[2][2];
#pragma unroll
        for (int bj = 0; bj < 2; ++bj)
#pragma unroll
            for (int n = 0; n < 2; ++n) bv[bj][n] = bias ? *(const f32x4*)(bias + bcol0 + bj * HALF + 4 * n) : (f32x4){0.f, 0.f, 0.f, 0.f};
#pragma unroll
        for (int ai = 0; ai < 2; ++ai)
#pragma unroll
            for (int m = 0; m < 4; ++m) { bf16_t* rowp = base + (size_t)(row0 + ai * HALF + m * 16) * ldc + col0;
#pragma unroll
                for (int bj = 0; bj < 2; ++bj) { f32x4 v0 = acc[ai][bj][m][0] + bv[bj][0], v1 = acc[ai][bj][m][1] + bv[bj][1];
                    if (ACT == 1) { f32x2 a = gelu_pk((f32x2){v0[0], v0[1]}), b = gelu_pk((f32x2){v0[2], v0[3]}), c = gelu_pk((f32x2){v1[0], v1[1]}), d = gelu_pk((f32x2){v1[2], v1[3]});
                        v0 = (f32x4){a.x, a.y, b.x, b.y}; v1 = (f32x4){c.x, c.y, d.x, d.y}; }
                    if (ACT == 2) {
#pragma unroll
                        for (int j = 0; j < 4; ++j) { v0[j] = 0.5f * v0[j] * (1.0f + erff(v0[j] * 0.70710678f)); v1[j] = 0.5f * v1[j] * (1.0f + erff(v1[j] * 0.70710678f)); } }
                    u32x4 w; w.x = cvt_pk_bf16(v0[0], v0[1]); w.y = cvt_pk_bf16(v0[2], v0[3]); w.z = cvt_pk_bf16(v1[0], v1[1]); w.w = cvt_pk_bf16(v1[2], v1[3]);
                    *(u32x4*)(rowp + bj * HALF) = w; } }
    }
};
struct EpiAddF32 {
    static constexpr bool PERM = false, AFTER_DRAIN = false;
    float* C; int ldc; const float* R;
    __device__ __forceinline__ void operator()(const f32x4 (&acc)[2][2][4][2], const Unit& u, int wr, int wc, int fr, int fq) const {
        const int row0 = u.pm * BM + wr * 64 + fr, col0 = u.pn * BM + wc * 32 + 4 * fq;
#pragma unroll
        for (int ai = 0; ai < 2; ++ai)
#pragma unroll
            for (int m = 0; m < 4; ++m) { const size_t ro = (size_t)(row0 + ai * HALF + m * 16) * ldc + col0; float* rowp = C + ro; const float* srcp = R + ro;
#pragma unroll
                for (int bj = 0; bj < 2; ++bj)
#pragma unroll
                    for (int n = 0; n < 2; ++n) { const f32x4 o = *(const f32x4*)(srcp + bj * HALF + n * 16); *(f32x4*)(rowp + bj * HALF + n * 16) = o + acc[ai][bj][m][n]; } }
    }
};
struct EpiSwiGLU {
    static constexpr bool PERM = true, AFTER_DRAIN = false;
    bf16_t* H; int ldh;
    __device__ __forceinline__ void operator()(const f32x4 (&acc)[2][2][4][2], const Unit& u, int wr, int wc, int fr, int fq) const {
        const int row0 = u.pm * BM + wr * 64 + fr, hcol = u.pn * HALF + wc * 32 + 8 * fq;
#pragma unroll
        for (int ai = 0; ai < 2; ++ai)
#pragma unroll
            for (int m = 0; m < 4; ++m) { bf16_t* rowp = H + (size_t)(row0 + ai * HALF + m * 16) * ldh + hcol;
                float h[8];
#pragma unroll
                for (int n = 0; n < 2; ++n) { const f32x4 a = acc[ai][0][m][n], b = acc[ai][1][m][n];
#pragma unroll
                    for (int j = 0; j < 4; ++j) h[4 * n + j] = a[j] * __builtin_amdgcn_rcpf(1.0f + __expf(-a[j])) * b[j]; }
                u32x4 w; w.x = cvt_pk_bf16(h[0], h[1]); w.y = cvt_pk_bf16(h[2], h[3]); w.z = cvt_pk_bf16(h[4], h[5]); w.w = cvt_pk_bf16(h[6], h[7]);
                *(u32x4*)rowp = w; }
    }
};
template <class Epi, class Sched, bool STAMP = false>
__device__ __forceinline__ void gemm_phase(PG8_LAS unsigned char* lds, const Gemm g, const Sched& S, const Epi& E, unsigned long long* stamps) {
    const int tid = threadIdx.x, wid = __builtin_amdgcn_readfirstlane(tid >> 6), lane = tid & 63, wr = wid >> 2, wc = wid & 3, fr = lane & 15, fq = lane >> 4;
    const int K = g.K, nt = K / BK;
    int ts_lo = 0, ts_hi = 0, nts = 0; const unsigned long long rt_entry = STAMP ? (unsigned long long)wall_clock64() : 0ull;
#define PG8_STAMP() do { if (STAMP && wid == 0 && nts < 64) { const unsigned long long _c = (unsigned long long)clock64(); \
        ts_lo = (lane == nts) ? (int)(unsigned)_c : ts_lo; ts_hi = (lane == nts) ? (int)(unsigned)(_c >> 32) : ts_hi; ++nts; } } while (0)
    PG8_STAMP();
    unsigned voffA[2], voffB[2];
#pragma unroll
    for (int i = 0; i < 2; ++i) { int R, C; stage_rc(tid * 16 + i * 8192, R, C); const int Rb = Epi::PERM ? ((R & ~31) + perm32(R & 31)) : R;
        voffA[i] = (unsigned)(R * K + C) * 2u; voffB[i] = (unsigned)(Rb * K + C) * 2u; }
    const size_t kstep = (size_t)(BK * 2);
    const size_t hstep = (size_t)HALF * K * 2;
    const size_t tstep = 2 * hstep;
    const unsigned ldsw = (unsigned)wid * 1024u;
    const int aoff = lds_byte(wr * 64 + fr, fq * 8), boff = lds_byte(wc * 32 + fr, fq * 8);
#define PG8_SA(b, h) (((b) * 2 + (h)) * HTB)
#define PG8_SB(b, h) ((4 + (b) * 2 + (h)) * HTB)
#define PG8_STAGE(bufoff, gbase, voff) do { _Pragma("unroll") for (int _i = 0; _i < 2; ++_i) \
        __builtin_amdgcn_global_load_lds((const unsigned*)((const char*)(gbase) + (voff)[_i]), (PG8_LAS unsigned*)(lds + (bufoff) + ldsw + _i * 8192), 16, 0, 0); } while (0)
#define PG8_LDA(dst, b, h) do { _Pragma("unroll") for (int m = 0; m < 4; ++m) _Pragma("unroll") for (int k = 0; k < 2; ++k) dst[m][k] = *(const PG8_LAS bf16x8*)(lds + PG8_SA(b, h) + aoff + m * 2048 + k * 1024); } while (0)
#define PG8_LDB(dst, b, h) do { _Pragma("unroll") for (int n = 0; n < 2; ++n) _Pragma("unroll") for (int k = 0; k < 2; ++k) dst[n][k] = *(const PG8_LAS bf16x8*)(lds + PG8_SB(b, h) + boff + n * 2048 + k * 1024); } while (0)
#define PG8_MMA(ai, bj, At, Bt) do { __builtin_amdgcn_s_setprio(1); _Pragma("unroll") for (int m = 0; m < 4; ++m) _Pragma("unroll") for (int n = 0; n < 2; ++n) _Pragma("unroll") for (int k = 0; k < 2; ++k) \
        acc[ai][bj][m][n] = __builtin_amdgcn_mfma_f32_16x16x32_bf16(Bt[n][k], At[m][k], acc[ai][bj][m][n], 0, 0, 0); __builtin_amdgcn_s_setprio(0); } while (0)
#define PG8_WAIT_V(n) asm volatile("s_waitcnt vmcnt(" #n ")" ::: "memory")
#define PG8_WAIT_L(n) asm volatile("s_waitcnt lgkmcnt(" #n ")" ::: "memory")
#define PG8_BAR __builtin_amdgcn_s_barrier()
#define PG8_SCHED __builtin_amdgcn_sched_barrier(0)
    Unit cur, nxt; int ui = 0;
    if (!S.next(0, cur)) return;
    f32x4 acc[2][2][4][2];
#pragma unroll
    for (int a = 0; a < 2; ++a)
#pragma unroll
        for (int b = 0; b < 2; ++b)
#pragma unroll
            for (int m = 0; m < 4; ++m)
#pragma unroll
                for (int n = 0; n < 2; ++n) acc[a][b][m][n] = (f32x4){0.f, 0.f, 0.f, 0.f};
    bf16x8 At[4][2], B0[2][2], B1[2][2];
    const char* cA = (const char*)g.A + (size_t)cur.pm * tstep; const char* cB = (const char*)g.Bt + (size_t)cur.pn * tstep;
    S.a_ready(cur);
    PG8_STAGE(PG8_SB(0, 0), cB, voffB); PG8_STAGE(PG8_SA(0, 0), cA, voffA); PG8_STAGE(PG8_SB(0, 1), cB + hstep, voffB); PG8_STAGE(PG8_SA(0, 1), cA + hstep, voffA);
    if (wr == 1) PG8_BAR;
    PG8_WAIT_V(4); PG8_BAR;
    PG8_STAGE(PG8_SB(1, 0), cB + kstep, voffB); PG8_STAGE(PG8_SA(1, 0), cA + kstep, voffA); PG8_STAGE(PG8_SB(1, 1), cB + hstep + kstep, voffB);
    PG8_WAIT_V(6); PG8_BAR;
    PG8_STAMP();
    for (;;) {
        const bool has_next = S.next(ui + 1, nxt);
        const char* nA = has_next ? (const char*)g.A + (size_t)nxt.pm * tstep : cA; const char* nB = has_next ? (const char*)g.Bt + (size_t)nxt.pn * tstep : cB;
        for (int t = 0; t < nt; t += 2) {
            const bool last = (t == nt - 2);
            const char* a1 = cA + (size_t)(t + 1) * kstep;
            const char* a2 = last ? nA : cA + (size_t)(t + 2) * kstep; const char* b2 = last ? nB : cB + (size_t)(t + 2) * kstep;
            const char* a3 = a2 + kstep; const char* b3 = b2 + kstep;
            if (last && has_next) S.a_ready(nxt);
            PG8_LDB(B0, 0, 0); PG8_SCHED; PG8_LDA(At, 0, 0); PG8_STAGE(PG8_SA(1, 1), a1 + hstep, voffA);
            PG8_WAIT_L(8); PG8_BAR; PG8_WAIT_L(0); PG8_MMA(0, 0, At, B0); PG8_BAR; PG8_SCHED;
            PG8_LDB(B1, 0, 1); PG8_STAGE(PG8_SB(0, 0), b2, voffB);
            PG8_BAR; PG8_WAIT_L(0); PG8_MMA(0, 1, At, B1); PG8_BAR;
            PG8_LDA(At, 0, 1); PG8_STAGE(PG8_SA(0, 0), a2, voffA);
            PG8_BAR; PG8_WAIT_L(0); PG8_MMA(1, 0, At, B0); PG8_BAR; PG8_SCHED;
            PG8_STAGE(PG8_SB(0, 1), b2 + hstep, voffB);
            PG8_WAIT_V(6); PG8_BAR; PG8_MMA(1, 1, At, B1); PG8_BAR;
            PG8_LDB(B0, 1, 0); PG8_SCHED; PG8_LDA(At, 1, 0); PG8_STAGE(PG8_SA(0, 1), a2 + hstep, voffA);
            PG8_WAIT_L(8); PG8_BAR; PG8_WAIT_L(0); PG8_MMA(0, 0, At, B0); PG8_BAR; PG8_SCHED;
            PG8_LDB(B1, 1, 1); PG8_STAGE(PG8_SB(1, 0), b3, voffB);
            PG8_BAR; PG8_WAIT_L(0); PG8_MMA(0, 1, At, B1); PG8_BAR;
            PG8_LDA(At, 1, 1); PG8_STAGE(PG8_SA(1, 0), a3, voffA);
            PG8_BAR; PG8_WAIT_L(0); PG8_MMA(1, 0, At, B0); PG8_BAR; PG8_SCHED;
            PG8_STAGE(PG8_SB(1, 1), b3 + hstep, voffB);
            PG8_WAIT_V(6); PG8_BAR; PG8_MMA(1, 1, At, B1); PG8_BAR;
        }
        PG8_STAMP();
        if constexpr (!Epi::AFTER_DRAIN) { E(acc, cur, wr, wc, fr, fq); S.done(cur); }
        PG8_STAMP();
        if (!has_next) break;
#pragma unroll
        for (int a = 0; a < 2; ++a)
#pragma unroll
            for (int b = 0; b < 2; ++b)
#pragma unroll
                for (int m = 0; m < 4; ++m)
#pragma unroll
                    for (int n = 0; n < 2; ++n) acc[a][b][m][n] = (f32x4){0.f, 0.f, 0.f, 0.f};
        cur = nxt; cA = nA; cB = nB; ++ui;
    }
    PG8_WAIT_V(0);
    if (wr == 0) PG8_BAR;
    PG8_BAR;
    if constexpr (Epi::AFTER_DRAIN) { E.fused(acc, cur, wr, wc, fr, fq, lds, wid, lane); S.done(cur); }
    PG8_STAMP();
    if (STAMP && wid == 0) { stamps[lane] = lane < nts ? (((unsigned long long)(unsigned)ts_hi << 32) | (unsigned)ts_lo) : 0ull;
        if (lane == 62) stamps[62] = rt_entry; if (lane == 63) stamps[63] = (unsigned long long)wall_clock64(); }
#undef PG8_STAMP
#undef PG8_SA
#undef PG8_SB
#undef PG8_STAGE
#undef PG8_LDA
#undef PG8_LDB
#undef PG8_MMA
#undef PG8_WAIT_V
#undef PG8_WAIT_L
#undef PG8_BAR
#undef PG8_SCHED
}
}
#define LAS __attribute__((address_space(3)))
typedef LAS unsigned char* LDSp;
typedef pg8::bf16_t bf16_t;
typedef unsigned u32x4 __attribute__((ext_vector_type(4)));
typedef unsigned u32x2 __attribute__((ext_vector_type(2)));
typedef float f32x4 __attribute__((ext_vector_type(4)));
typedef float f32x2 __attribute__((ext_vector_type(2)));

#ifndef EXPC
#define EXPC 0
#endif
#ifndef EVP_SKIP
#define EVP_SKIP 0
#endif
constexpr int T_ = 16384, D_ = 1024, S_ = 4096, NTHR = 512;
constexpr int LDS_BYTES = 147456;
constexpr size_t MiB = 1048576;
constexpr size_t WS_WB = 0, WS_HN = 25 * MiB, WS_Z = 57 * MiB, WS_QKV = 153 * MiB, WS_OF = 201 * MiB, WS_OB = 217 * MiB,
                 WS_GATES = 233 * MiB, WS_BETA = 234 * MiB, WS_LA = 234 * MiB + 524288;
constexpr size_t WB_IN = 0, WB_OUT = 6291456, WB_UP = 8388608, WB_DN = 19922944;
constexpr int DFF = 2816;

struct Params { const float* in[26]; float* out; unsigned char* ws; };

__device__ __forceinline__ float bf2f(unsigned short b) { return __uint_as_float(((unsigned)b) << 16); }
__device__ __forceinline__ float bflo(unsigned u) { return __uint_as_float(u << 16); }
__device__ __forceinline__ float bfhi(unsigned u) { return __uint_as_float(u & 0xffff0000u); }
__device__ __forceinline__ unsigned short f2bf(float f) { unsigned u = __float_as_uint(f); u += 0x7FFFu + ((u >> 16) & 1u); return (unsigned short)(u >> 16); }
typedef __bf16 bf16x2_v __attribute__((ext_vector_type(2)));
__device__ __forceinline__ unsigned pk2(float lo, float hi) { const f32x2 v = {lo, hi}; const bf16x2_v b = __builtin_convertvector(v, bf16x2_v); return __builtin_bit_cast(unsigned, b); }
__device__ __forceinline__ float sigm(float x) { return __builtin_amdgcn_rcpf(1.0f + __expf(-x)); }
__device__ __forceinline__ float sigm_f(float x) { return __builtin_amdgcn_rcpf(1.0f + __expf(-x)); }
__device__ __forceinline__ float silu_(float x) { return x * sigm(x); }
__device__ __forceinline__ float gelu_t(float x) { const float u = 0.7978845608028654f * (x + 0.044715f * x * x * x); const float t = 1.0f - 2.0f / (1.0f + __expf(2.0f * u)); return 0.5f * x * (1.0f + t); }
__device__ __forceinline__ float softplus_(float x) { return x > 20.0f ? x : log1pf(expf(x)); }
__device__ __forceinline__ float wave_sum(float v) {
#pragma unroll
    for (int o = 32; o; o >>= 1) v += __shfl_xor(v, o);
    return v; }
template <int CTRL> __device__ __forceinline__ float dppf(float v) { return __int_as_float(__builtin_amdgcn_update_dpp(0, __float_as_int(v), CTRL, 0xf, 0xf, true)); }
__device__ __forceinline__ float row16_sum(float v) { v += dppf<0xB1>(v); v += dppf<0x4E>(v); v += dppf<0x141>(v); v += dppf<0x140>(v); return v; }
__device__ __forceinline__ void unpack8(const u32x4 w, float (&f)[8]) { f[0] = bflo(w.x); f[1] = bfhi(w.x); f[2] = bflo(w.y); f[3] = bfhi(w.y); f[4] = bflo(w.z); f[5] = bfhi(w.z); f[6] = bflo(w.w); f[7] = bfhi(w.w); }


__device__ __forceinline__ float wave_scan_sum(float x, bool fwd) {
    const int lane = threadIdx.x & 63;
#pragma unroll
    for (int o = 1; o < 64; o <<= 1) { const float y = fwd ? __shfl_up(x, o) : __shfl_down(x, o); if (fwd ? (lane >= o) : (lane + o < 64)) x += y; }
    return x; }
__device__ __forceinline__ float wave_scan_max(float x, bool fwd) {
    const int lane = threadIdx.x & 63;
#pragma unroll
    for (int o = 1; o < 64; o <<= 1) { const float y = fwd ? __shfl_up(x, o) : __shfl_down(x, o); if (fwd ? (lane >= o) : (lane + o < 64)) x = fmaxf(x, y); }
    return x; }
__device__ __forceinline__ void conv_job(LDSp lds, const float* __restrict__ src, int ldn, int K, int col0, int ncols, bf16_t* __restrict__ dst, int mode, int off) {
    LAS float* tl = (LAS float*)lds;
    const int tid = threadIdx.x, nnt = ncols >> 6, ntl = (K >> 6) * nnt;
    const int r = tid >> 4, c4 = (tid & 15) << 2;
    f32x4 pv[2];
    if ((int)blockIdx.x < ntl) { const int kt = (int)blockIdx.x / nnt, nt = (int)blockIdx.x - kt * nnt;
#pragma unroll
        for (int i = 0; i < 2; ++i) pv[i] = *(const f32x4*)(src + (size_t)(kt * 64 + r + 32 * i) * ldn + col0 + nt * 64 + c4); }
    for (int tile = blockIdx.x; tile < ntl; tile += gridDim.x) {
        const int kt = tile / nnt, nt = tile - kt * nnt;
#pragma unroll
        for (int i = 0; i < 2; ++i) { const int k = r + 32 * i; const f32x4 v = pv[i];
            tl[k * 65 + c4 + 0] = v.x; tl[k * 65 + c4 + 1] = v.y; tl[k * 65 + c4 + 2] = v.z; tl[k * 65 + c4 + 3] = v.w; }
        { const int tn = tile + (int)gridDim.x; if (tn < ntl) { const int kt2 = tn / nnt, nt2 = tn - kt2 * nnt;
#pragma unroll
            for (int i = 0; i < 2; ++i) pv[i] = *(const f32x4*)(src + (size_t)(kt2 * 64 + r + 32 * i) * ldn + col0 + nt2 * 64 + c4); } }
        __syncthreads();
        const int n = tid >> 3, k8 = (tid & 7) << 3; float f[8];
#pragma unroll
        for (int j = 0; j < 8; ++j) f[j] = tl[(k8 + j) * 65 + n];
        u32x4 w; w.x = pk2(f[0], f[1]); w.y = pk2(f[2], f[3]); w.z = pk2(f[4], f[5]); w.w = pk2(f[6], f[7]);
        const int ncol = nt * 64 + n;
        const int row = mode == 0 ? off + ncol : ((ncol >> 7) << 8) + (ncol & 127) + off;
        *(u32x4*)(dst + (size_t)row * K + kt * 64 + k8) = w;
        __syncthreads();
    }
}
__device__ __forceinline__ void convert_layer(LDSp lds, const Params& p, int L) {
    bf16_t* wb = (bf16_t*)(p.ws + WS_WB);
    if (L == 0) { conv_job(lds, p.in[2], 3088, 1024, 0, 3072, (bf16_t*)((char*)wb + WB_IN), 0, 0);
                  conv_job(lds, p.in[11], 1024, 1024, 0, 1024, (bf16_t*)((char*)wb + WB_OUT), 0, 0); }
    else        { conv_job(lds, p.in[12], 2576, 1024, 0, 2560, (bf16_t*)((char*)wb + WB_IN), 0, 0);
                  conv_job(lds, p.in[20], 1024, 1024, 0, 1024, (bf16_t*)((char*)wb + WB_OUT), 0, 0); }
    conv_job(lds, p.in[22] + (size_t)L * 1024 * DFF, DFF, 1024, 0, DFF, (bf16_t*)((char*)wb + WB_UP), 1, 0);
    conv_job(lds, p.in[23] + (size_t)L * 1024 * DFF, DFF, 1024, 0, DFF, (bf16_t*)((char*)wb + WB_UP), 1, 128);
    conv_job(lds, p.in[24] + (size_t)L * DFF * 1024, 1024, DFF, 0, 1024, (bf16_t*)((char*)wb + WB_DN), 0, 0);
}

__device__ __forceinline__ void rms_phase(LDSp lds, const float* src, const float* __restrict__ g, bf16_t* hn, float* copy_out, float* final_out,
                                          const float* __restrict__ gw, int gw_ld, int gw_col0, float* gates) {
    LAS float* wg = (LAS float*)lds;
    const int tid = threadIdx.x, lane = tid & 63, wid = tid >> 6;
    if (gw) { for (int idx = tid; idx < 16384; idx += NTHR) { const int k = idx >> 4, j = idx & 15; wg[j * 1024 + k] = gw[(size_t)k * gw_ld + gw_col0 + j]; } __syncthreads(); }
    f32x4 gv[4];
#pragma unroll
    for (int i = 0; i < 4; ++i) gv[i] = *(const f32x4*)(g + 4 * lane + 256 * i);
    f32x4 xn[4];
    { const int row0 = blockIdx.x * 8 + wid;
#pragma unroll
      for (int i = 0; i < 4; ++i) xn[i] = *(const f32x4*)(src + (size_t)row0 * D_ + 4 * lane + 256 * i); }
    for (int row = blockIdx.x * 8 + wid; row < T_; row += gridDim.x * 8) {
        f32x4 x[4]; float ss = 0.f;
#pragma unroll
        for (int i = 0; i < 4; ++i) { x[i] = xn[i]; ss += x[i].x * x[i].x + x[i].y * x[i].y + x[i].z * x[i].z + x[i].w * x[i].w; }
        { const int rn = row + (int)gridDim.x * 8; if (rn < T_) {
#pragma unroll
            for (int i = 0; i < 4; ++i) xn[i] = *(const f32x4*)(src + (size_t)rn * D_ + 4 * lane + 256 * i); } }
        if (copy_out) {
#pragma unroll
            for (int i = 0; i < 4; ++i) *(f32x4*)(copy_out + (size_t)row * D_ + 4 * lane + 256 * i) = x[i]; }
        ss = wave_sum(ss);
        const float rstd = rsqrtf(ss * (1.0f / 1024.0f) + 1e-6f);
        f32x4 y[4];
#pragma unroll
        for (int i = 0; i < 4; ++i) y[i] = x[i] * rstd * gv[i];
        if (final_out) {
#pragma unroll
            for (int i = 0; i < 4; ++i) *(f32x4*)(final_out + (size_t)row * D_ + 4 * lane + 256 * i) = y[i];
        } else {
#pragma unroll
            for (int i = 0; i < 4; ++i) { u32x2 w; w.x = pk2(y[i].x, y[i].y); w.y = pk2(y[i].z, y[i].w); *(u32x2*)(hn + (size_t)row * D_ + 4 * lane + 256 * i) = w; }
        }
        if (gw) {
            float s[16];
#pragma unroll
            for (int j = 0; j < 16; ++j) { float a = 0.f;
#pragma unroll
                for (int i = 0; i < 4; ++i) { const f32x4 w = *(const LAS f32x4*)(wg + j * 1024 + 4 * lane + 256 * i); a += y[i].x * w.x + y[i].y * w.y + y[i].z * w.z + y[i].w * w.w; }
                s[j] = wave_sum(a); }
            if (lane == 0) {
#pragma unroll
                for (int q = 0; q < 4; ++q) *(f32x4*)(gates + (size_t)row * 16 + 4 * q) = (f32x4){s[4 * q], s[4 * q + 1], s[4 * q + 2], s[4 * q + 3]}; }
        }
    }
    __syncthreads();
}

__device__ __forceinline__ void even_prep(LDSp lds, const Params& p) {
    const bf16_t* Z = (const bf16_t*)(p.ws + WS_Z); bf16_t* Y = (bf16_t*)(p.ws + WS_HN); bf16_t* QKVN = (bf16_t*)(p.ws + WS_QKV);
    const float* gates = (const float*)(p.ws + WS_GATES); float* BETA = (float*)(p.ws + WS_BETA); float* LA = (float*)(p.ws + WS_LA);
    const float* conv_w = p.in[3]; const float* conv_b = p.in[4]; const float* ln_g = p.in[5]; const float* ln_b = p.in[6];
    const float* dn_w = p.in[7]; const float* a_log = p.in[8]; const float* dt_bias = p.in[9];
    LAS float* glu = (LAS float*)lds;
    const int tid = threadIdx.x, lane = tid & 63, wid = tid >> 6, c = tid;
    for (int tile = blockIdx.x; tile < T_ / 32; tile += gridDim.x) {
        const int t0 = tile * 32, b = t0 >> 12, s0 = t0 & 4095;
#if !(EVP_SKIP & 1)
        for (int it = tid; it < 62 * 64; it += NTHR) { const int r = it >> 6, c8 = (it & 63) << 3, sp = s0 - 15 + r;
            f32x4 o0 = {0.f, 0.f, 0.f, 0.f}, o1 = {0.f, 0.f, 0.f, 0.f};
            if (sp >= 0 && sp < S_) { const size_t tok = (size_t)b * S_ + sp; const u32x4 av = *(const u32x4*)(Z + tok * 3072 + c8); const u32x4 gv = *(const u32x4*)(Z + tok * 3072 + 512 + c8);
                float a[8], g[8]; unpack8(av, a); unpack8(gv, g);
                o0 = (f32x4){a[0] * sigm(g[0]), a[1] * sigm(g[1]), a[2] * sigm(g[2]), a[3] * sigm(g[3])}; o1 = (f32x4){a[4] * sigm(g[4]), a[5] * sigm(g[5]), a[6] * sigm(g[6]), a[7] * sigm(g[7])}; }
            *(LAS f32x4*)(glu + r * 512 + c8) = o0; *(LAS f32x4*)(glu + r * 512 + c8 + 4) = o1; }
        __syncthreads();
        {
            float cw[31];
#pragma unroll
            for (int w = 0; w < 31; ++w) cw[w] = conv_w[w * 512 + c];
            const float cb = conv_b[c];
            f32x4 res[8];
#pragma unroll
            for (int t4 = 0; t4 < 8; ++t4) {
                float x[34];
#pragma unroll
                for (int i = 0; i < 34; ++i) x[i] = glu[(t4 * 4 + i) * 512 + c];
                float a0 = cb, a1 = cb, a2 = cb, a3 = cb;
#pragma unroll
                for (int w = 0; w < 31; ++w) { a0 = fmaf(x[w], cw[w], a0); a1 = fmaf(x[w + 1], cw[w], a1); a2 = fmaf(x[w + 2], cw[w], a2); a3 = fmaf(x[w + 3], cw[w], a3); }
                res[t4] = (f32x4){a0, a1, a2, a3};
            }
            __syncthreads();
#pragma unroll
            for (int t4 = 0; t4 < 8; ++t4) { glu[(t4 * 4 + 0) * 512 + c] = res[t4].x; glu[(t4 * 4 + 1) * 512 + c] = res[t4].y; glu[(t4 * 4 + 2) * 512 + c] = res[t4].z; glu[(t4 * 4 + 3) * 512 + c] = res[t4].w; }
        }
        __syncthreads();
        {
            const f32x4 g0 = *(const f32x4*)(ln_g + 4 * lane), g1 = *(const f32x4*)(ln_g + 256 + 4 * lane), b0 = *(const f32x4*)(ln_b + 4 * lane), b1 = *(const f32x4*)(ln_b + 256 + 4 * lane);
#pragma unroll
            for (int tt = 0; tt < 4; ++tt) { const int t = wid * 4 + tt;
                const f32x4 x0 = *(const LAS f32x4*)(glu + t * 512 + 4 * lane), x1 = *(const LAS f32x4*)(glu + t * 512 + 256 + 4 * lane);
                const float mean = wave_sum((x0.x + x0.y) + (x0.z + x0.w) + (x1.x + x1.y) + (x1.z + x1.w)) * (1.0f / 512.0f);
                const f32x4 d0 = x0 - mean, d1 = x1 - mean;
                const float var = wave_sum(d0.x * d0.x + d0.y * d0.y + d0.z * d0.z + d0.w * d0.w + d1.x * d1.x + d1.y * d1.y + d1.z * d1.z + d1.w * d1.w) * (1.0f / 512.0f);
                const float rstd = rsqrtf(var + 1e-5f);
                const f32x4 y0 = d0 * rstd * g0 + b0, y1 = d1 * rstd * g1 + b1;
                u32x2 w0, w1; w0.x = pk2(silu_(y0.x), silu_(y0.y)); w0.y = pk2(silu_(y0.z), silu_(y0.w)); w1.x = pk2(silu_(y1.x), silu_(y1.y)); w1.y = pk2(silu_(y1.z), silu_(y1.w));
                *(u32x2*)(Y + (size_t)(t0 + t) * 1024 + 4 * lane) = w0; *(u32x2*)(Y + (size_t)(t0 + t) * 1024 + 256 + 4 * lane) = w1; }
        }
        __syncthreads();
#endif
#if !(EVP_SKIP & 2)
        LAS unsigned short* xin = (LAS unsigned short*)(glu + 32 * 512);
#pragma unroll 1
        for (int gi = 0; gi < 3; ++gi) {
            float w5[5];
#pragma unroll
            for (int w = 0; w < 5; ++w) w5[w] = dn_w[w * 1536 + gi * 512 + c];
            for (int it = tid; it < 36 * 64; it += NTHR) { const int rr = it >> 6, c8 = (it & 63) << 3, sp = s0 - 2 + rr;
                u32x4 v = {0u, 0u, 0u, 0u};
                if (sp >= 0 && sp < S_) v = *(const u32x4*)(Z + ((size_t)b * S_ + sp) * 3072 + 1024 + gi * 512 + c8);
                *(LAS u32x4*)(xin + rr * 512 + c8) = v; }
            __syncthreads();
            float x0 = bf2f(xin[c]), x1 = bf2f(xin[512 + c]), x2 = bf2f(xin[1024 + c]), x3 = bf2f(xin[1536 + c]);
#pragma unroll 8
            for (int t = 0; t < 32; ++t) { const float x4 = bf2f(xin[(t + 4) * 512 + c]);
                float v = x0 * w5[0]; v = fmaf(x1, w5[1], v); v = fmaf(x2, w5[2], v); v = fmaf(x3, w5[3], v); v = fmaf(x4, w5[4], v);
                glu[t * 512 + c] = silu_(v);
                x0 = x1; x1 = x2; x2 = x3; x3 = x4; }
            __syncthreads();
            const float qs = gi == 0 ? 0.08838834764831845f : 1.0f;
#pragma unroll
            for (int pp = 0; pp < 4; ++pp) { const int pr = wid * 16 + pp * 4 + (lane >> 4), t = pr >> 2, hd = pr & 3, c8 = (lane & 15) * 8;
                const f32x4 y0 = *(const LAS f32x4*)(glu + t * 512 + hd * 128 + c8), y1 = *(const LAS f32x4*)(glu + t * 512 + hd * 128 + c8 + 4);
                const float ss = row16_sum(y0.x * y0.x + y0.y * y0.y + y0.z * y0.z + y0.w * y0.w + y1.x * y1.x + y1.y * y1.y + y1.z * y1.z + y1.w * y1.w);
                const float sc = gi == 2 ? 1.0f : rsqrtf(ss + 1e-6f) * qs;
                u32x4 w; w.x = pk2(y0.x * sc, y0.y * sc); w.y = pk2(y0.z * sc, y0.w * sc); w.z = pk2(y1.x * sc, y1.y * sc); w.w = pk2(y1.z * sc, y1.w * sc);
                *(u32x4*)(QKVN + (size_t)(t0 + t) * 1536 + gi * 512 + hd * 128 + c8) = w; }
            __syncthreads();
        }
#endif
#if !(EVP_SKIP & 4)
        if (tid < 256) { const int t = tid >> 3, j = tid & 7; const size_t tok = (size_t)(t0 + t);
            const float bp = gates[tok * 16 + j], ap = gates[tok * 16 + 8 + j];
            BETA[tok * 8 + j] = sigm(bp); LA[tok * 8 + j] = -expf(a_log[j]) * softplus_(ap + dt_bias[j]); }
#endif
        __syncthreads();
    }
}

__device__ __forceinline__ void tri_inv64(const LAS float* Am, int c, float su, float sw, LAS unsigned short* Tu, LAS unsigned short* Tw) {
    f32x4 a; float s0, s1, s2, s3; const float cf = (float)c;
    float x0 = fmaxf(0.0f, 1.0f - fabsf(cf - 0.0f));
    Tu[0 + c] = f2bf(x0 * su); Tw[0 + c] = f2bf(x0 * sw); asm volatile("" ::: "memory");
    float x1 = fmaxf(0.0f, 1.0f - fabsf(cf - 1.0f));
    s0 = 0.f; s1 = 0.f; s2 = 0.f; s3 = 0.f;
    a = *(const LAS f32x4*)(Am + 68);
    const float al1 = a.x;
    x1 = (x1 - ((s0 + s1) + (s2 + s3))) - al1 * x0;
    Tu[136 + c] = f2bf(x1 * su); Tw[136 + c] = f2bf(x1 * sw); asm volatile("" ::: "memory");
    float x2 = fmaxf(0.0f, 1.0f - fabsf(cf - 2.0f));
    s0 = 0.f; s1 = 0.f; s2 = 0.f; s3 = 0.f;
    a = *(const LAS f32x4*)(Am + 136);
    s0 = fmaf(a.x, x0, s0);
    const float al2 = a.y;
    x2 = (x2 - ((s0 + s1) + (s2 + s3))) - al2 * x1;
    Tu[272 + c] = f2bf(x2 * su); Tw[272 + c] = f2bf(x2 * sw); asm volatile("" ::: "memory");
    float x3 = fmaxf(0.0f, 1.0f - fabsf(cf - 3.0f));
    s0 = 0.f; s1 = 0.f; s2 = 0.f; s3 = 0.f;
    a = *(const LAS f32x4*)(Am + 204);
    s0 = fmaf(a.x, x0, s0);
    s1 = fmaf(a.y, x1, s1);
    const float al3 = a.z;
    x3 = (x3 - ((s0 + s1) + (s2 + s3))) - al3 * x2;
    Tu[408 + c] = f2bf(x3 * su); Tw[408 + c] = f2bf(x3 * sw); asm volatile("" ::: "memory");
    float x4 = fmaxf(0.0f, 1.0f - fabsf(cf - 4.0f));
    s0 = 0.f; s1 = 0.f; s2 = 0.f; s3 = 0.f;
    a = *(const LAS f32x4*)(Am + 272);
    s0 = fmaf(a.x, x0, s0);
    s1 = fmaf(a.y, x1, s1);
    s2 = fmaf(a.z, x2, s2);
    const float al4 = a.w;
    x4 = (x4 - ((s0 + s1) + (s2 + s3))) - al4 * x3;
    Tu[544 + c] = f2bf(x4 * su); Tw[544 + c] = f2bf(x4 * sw); asm volatile("" ::: "memory");
    float x5 = fmaxf(0.0f, 1.0f - fabsf(cf - 5.0f));
    s0 = 0.f; s1 = 0.f; s2 = 0.f; s3 = 0.f;
    a = *(const LAS f32x4*)(Am + 340);
    s0 = fmaf(a.x, x0, s0);
    s1 = fmaf(a.y, x1, s1);
    s2 = fmaf(a.z, x2, s2);
    s3 = fmaf(a.w, x3, s3);
    a = *(const LAS f32x4*)(Am + 344);
    const float al5 = a.x;
    x5 = (x5 - ((s0 + s1) + (s2 + s3))) - al5 * x4;
    Tu[680 + c] = f2bf(x5 * su); Tw[680 + c] = f2bf(x5 * sw); asm volatile("" ::: "memory");
    float x6 = fmaxf(0.0f, 1.0f - fabsf(cf - 6.0f));
    s0 = 0.f; s1 = 0.f; s2 = 0.f; s3 = 0.f;
    a = *(const LAS f32x4*)(Am + 408);
    s0 = fmaf(a.x, x0, s0);
    s1 = fmaf(a.y, x1, s1);
    s2 = fmaf(a.z, x2, s2);
    s3 = fmaf(a.w, x3, s3);
    a = *(const LAS f32x4*)(Am + 412);
    s0 = fmaf(a.x, x4, s0);
    const float al6 = a.y;
    x6 = (x6 - ((s0 + s1) + (s2 + s3))) - al6 * x5;
    Tu[816 + c] = f2bf(x6 * su); Tw[816 + c] = f2bf(x6 * sw); asm volatile("" ::: "memory");
    float x7 = fmaxf(0.0f, 1.0f - fabsf(cf - 7.0f));
    s0 = 0.f; s1 = 0.f; s2 = 0.f; s3 = 0.f;
    a = *(const LAS f32x4*)(Am + 476);
    s0 = fmaf(a.x, x0, s0);
    s1 = fmaf(a.y, x1, s1);
    s2 = fmaf(a.z, x2, s2);
    s3 = fmaf(a.w, x3, s3);
    a = *(const LAS f32x4*)(Am + 480);
    s0 = fmaf(a.x, x4, s0);
    s1 = fmaf(a.y, x5, s1);
    const float al7 = a.z;
    x7 = (x7 - ((s0 + s1) + (s2 + s3))) - al7 * x6;
    Tu[952 + c] = f2bf(x7 * su); Tw[952 + c] = f2bf(x7 * sw); asm volatile("" ::: "memory");
    float x8 = fmaxf(0.0f, 1.0f - fabsf(cf - 8.0f));
    s0 = 0.f; s1 = 0.f; s2 = 0.f; s3 = 0.f;
    a = *(const LAS f32x4*)(Am + 544);
    s0 = fmaf(a.x, x0, s0);
    s1 = fmaf(a.y, x1, s1);
    s2 = fmaf(a.z, x2, s2);
    s3 = fmaf(a.w, x3, s3);
    a = *(const LAS f32x4*)(Am + 548);
    s0 = fmaf(a.x, x4, s0);
    s1 = fmaf(a.y, x5, s1);
    s2 = fmaf(a.z, x6, s2);
    const float al8 = a.w;
    x8 = (x8 - ((s0 + s1) + (s2 + s3))) - al8 * x7;
    Tu[1088 + c] = f2bf(x8 * su); Tw[1088 + c] = f2bf(x8 * sw); asm volatile("" ::: "memory");
    float x9 = fmaxf(0.0f, 1.0f - fabsf(cf - 9.0f));
    s0 = 0.f; s1 = 0.f; s2 = 0.f; s3 = 0.f;
    a = *(const LAS f32x4*)(Am + 612);
    s0 = fmaf(a.x, x0, s0);
    s1 = fmaf(a.y, x1, s1);
    s2 = fmaf(a.z, x2, s2);
    s3 = fmaf(a.w, x3, s3);
    a = *(const LAS f32x4*)(Am + 616);
    s0 = fmaf(a.x, x4, s0);
    s1 = fmaf(a.y, x5, s1);
    s2 = fmaf(a.z, x6, s2);
    s3 = fmaf(a.w, x7, s3);
    a = *(const LAS f32x4*)(Am + 620);
    const float al9 = a.x;
    x9 = (x9 - ((s0 + s1) + (s2 + s3))) - al9 * x8;
    Tu[1224 + c] = f2bf(x9 * su); Tw[1224 + c] = f2bf(x9 * sw); asm volatile("" ::: "memory");
    float x10 = fmaxf(0.0f, 1.0f - fabsf(cf - 10.0f));
    s0 = 0.f; s1 = 0.f; s2 = 0.f; s3 = 0.f;
    a = *(const LAS f32x4*)(Am + 680);
    s0 = fmaf(a.x, x0, s0);
    s1 = fmaf(a.y, x1, s1);
    s2 = fmaf(a.z, x2, s2);
    s3 = fmaf(a.w, x3, s3);
    a = *(const LAS f32x4*)(Am + 684);
    s0 = fmaf(a.x, x4, s0);
    s1 = fmaf(a.y, x5, s1);
    s2 = fmaf(a.z, x6, s2);
    s3 = fmaf(a.w, x7, s3);
    a = *(const LAS f32x4*)(Am + 688);
    s0 = fmaf(a.x, x8, s0);
    const float al10 = a.y;
    x10 = (x10 - ((s0 + s1) + (s2 + s3))) - al10 * x9;
    Tu[1360 + c] = f2bf(x10 * su); Tw[1360 + c] = f2bf(x10 * sw); asm volatile("" ::: "memory");
    float x11 = fmaxf(0.0f, 1.0f - fabsf(cf - 11.0f));
    s0 = 0.f; s1 = 0.f; s2 = 0.f; s3 = 0.f;
    a = *(const LAS f32x4*)(Am + 748);
    s0 = fmaf(a.x, x0, s0);
    s1 = fmaf(a.y, x1, s1);
    s2 = fmaf(a.z, x2, s2);
    s3 = fmaf(a.w, x3, s3);
    a = *(const LAS f32x4*)(Am + 752);
    s0 = fmaf(a.x, x4, s0);
    s1 = fmaf(a.y, x5, s1);
    s2 = fmaf(a.z, x6, s2);
    s3 = fmaf(a.w, x7, s3);
    a = *(const LAS f32x4*)(Am + 756);
    s0 = fmaf(a.x, x8, s0);
    s1 = fmaf(a.y, x9, s1);
    const float al11 = a.z;
    x11 = (x11 - ((s0 + s1) + (s2 + s3))) - al11 * x10;
    Tu[1496 + c] = f2bf(x11 * su); Tw[1496 + c] = f2bf(x11 * sw); asm volatile("" ::: "memory");
    float x12 = fmaxf(0.0f, 1.0f - fabsf(cf - 12.0f));
    s0 = 0.f; s1 = 0.f; s2 = 0.f; s3 = 0.f;
    a = *(const LAS f32x4*)(Am + 816);
    s0 = fmaf(a.x, x0, s0);
    s1 = fmaf(a.y, x1, s1);
    s2 = fmaf(a.z, x2, s2);
    s3 = fmaf(a.w, x3, s3);
    a = *(const LAS f32x4*)(Am + 820);
    s0 = fmaf(a.x, x4, s0);
    s1 = fmaf(a.y, x5, s1);
    s2 = fmaf(a.z, x6, s2);
    s3 = fmaf(a.w, x7, s3);
    a = *(const LAS f32x4*)(Am + 824);
    s0 = fmaf(a.x, x8, s0);
    s1 = fmaf(a.y, x9, s1);
    s2 = fmaf(a.z, x10, s2);
    const float al12 = a.w;
    x12 = (x12 - ((s0 + s1) + (s2 + s3))) - al12 * x11;
    Tu[1632 + c] = f2bf(x12 * su); Tw[1632 + c] = f2bf(x12 * sw); asm volatile("" ::: "memory");
    float x13 = fmaxf(0.0f, 1.0f - fabsf(cf - 13.0f));
    s0 = 0.f; s1 = 0.f; s2 = 0.f; s3 = 0.f;
    a = *(const LAS f32x4*)(Am + 884);
    s0 = fmaf(a.x, x0, s0);
    s1 = fmaf(a.y, x1, s1);
    s2 = fmaf(a.z, x2, s2);
    s3 = fmaf(a.w, x3, s3);
    a = *(const LAS f32x4*)(Am + 888);
    s0 = fmaf(a.x, x4, s0);
    s1 = fmaf(a.y, x5, s1);
    s2 = fmaf(a.z, x6, s2);
    s3 = fmaf(a.w, x7, s3);
    a = *(const LAS f32x4*)(Am + 892);
    s0 = fmaf(a.x, x8, s0);
    s1 = fmaf(a.y, x9, s1);
    s2 = fmaf(a.z, x10, s2);
    s3 = fmaf(a.w, x11, s3);
    a = *(const LAS f32x4*)(Am + 896);
    const float al13 = a.x;
    x13 = (x13 - ((s0 + s1) + (s2 + s3))) - al13 * x12;
    Tu[1768 + c] = f2bf(x13 * su); Tw[1768 + c] = f2bf(x13 * sw); asm volatile("" ::: "memory");
    float x14 = fmaxf(0.0f, 1.0f - fabsf(cf - 14.0f));
    s0 = 0.f; s1 = 0.f; s2 = 0.f; s3 = 0.f;
    a = *(const LAS f32x4*)(Am + 952);
    s0 = fmaf(a.x, x0, s0);
    s1 = fmaf(a.y, x1, s1);
    s2 = fmaf(a.z, x2, s2);
    s3 = fmaf(a.w, x3, s3);
    a = *(const LAS f32x4*)(Am + 956);
    s0 = fmaf(a.x, x4, s0);
    s1 = fmaf(a.y, x5, s1);
    s2 = fmaf(a.z, x6, s2);
    s3 = fmaf(a.w, x7, s3);
    a = *(const LAS f32x4*)(Am + 960);
    s0 = fmaf(a.x, x8, s0);
    s1 = fmaf(a.y, x9, s1);
    s2 = fmaf(a.z, x10, s2);
    s3 = fmaf(a.w, x11, s3);
    a = *(const LAS f32x4*)(Am + 964);
    s0 = fmaf(a.x, x12, s0);
    const float al14 = a.y;
    x14 = (x14 - ((s0 + s1) + (s2 + s3))) - al14 * x13;
    Tu[1904 + c] = f2bf(x14 * su); Tw[1904 + c] = f2bf(x14 * sw); asm volatile("" ::: "memory");
    float x15 = fmaxf(0.0f, 1.0f - fabsf(cf - 15.0f));
    s0 = 0.f; s1 = 0.f; s2 = 0.f; s3 = 0.f;
    a = *(const LAS f32x4*)(Am + 1020);
    s0 = fmaf(a.x, x0, s0);
    s1 = fmaf(a.y, x1, s1);
    s2 = fmaf(a.z, x2, s2);
    s3 = fmaf(a.w, x3, s3);
    a = *(const LAS f32x4*)(Am + 1024);
    s0 = fmaf(a.x, x4, s0);
    s1 = fmaf(a.y, x5, s1);
    s2 = fmaf(a.z, x6, s2);
    s3 = fmaf(a.w, x7, s3);
    a = *(const LAS f32x4*)(Am + 1028);
    s0 = fmaf(a.x, x8, s0);
    s1 = fmaf(a.y, x9, s1);
    s2 = fmaf(a.z, x10, s2);
    s3 = fmaf(a.w, x11, s3);
    a = *(const LAS f32x4*)(Am + 1032);
    s0 = fmaf(a.x, x12, s0);
    s1 = fmaf(a.y, x13, s1);
    const float al15 = a.z;
    x15 = (x15 - ((s0 + s1) + (s2 + s3))) - al15 * x14;
    Tu[2040 + c] = f2bf(x15 * su); Tw[2040 + c] = f2bf(x15 * sw); asm volatile("" ::: "memory");
    float x16 = fmaxf(0.0f, 1.0f - fabsf(cf - 16.0f));
    s0 = 0.f; s1 = 0.f; s2 = 0.f; s3 = 0.f;
    a = *(const LAS f32x4*)(Am + 1088);
    s0 = fmaf(a.x, x0, s0);
    s1 = fmaf(a.y, x1, s1);
    s2 = fmaf(a.z, x2, s2);
    s3 = fmaf(a.w, x3, s3);
    a = *(const LAS f32x4*)(Am + 1092);
    s0 = fmaf(a.x, x4, s0);
    s1 = fmaf(a.y, x5, s1);
    s2 = fmaf(a.z, x6, s2);
    s3 = fmaf(a.w, x7, s3);
    a = *(const LAS f32x4*)(Am + 1096);
    s0 = fmaf(a.x, x8, s0);
    s1 = fmaf(a.y, x9, s1);
    s2 = fmaf(a.z, x10, s2);
    s3 = fmaf(a.w, x11, s3);
    a = *(const LAS f32x4*)(Am + 1100);
    s0 = fmaf(a.x, x12, s0);
    s1 = fmaf(a.y, x13, s1);
    s2 = fmaf(a.z, x14, s2);
    const float al16 = a.w;
    x16 = (x16 - ((s0 + s1) + (s2 + s3))) - al16 * x15;
    Tu[2176 + c] = f2bf(x16 * su); Tw[2176 + c] = f2bf(x16 * sw); asm volatile("" ::: "memory");
    float x17 = fmaxf(0.0f, 1.0f - fabsf(cf - 17.0f));
    s0 = 0.f; s1 = 0.f; s2 = 0.f; s3 = 0.f;
    a = *(const LAS f32x4*)(Am + 1156);
    s0 = fmaf(a.x, x0, s0);
    s1 = fmaf(a.y, x1, s1);
    s2 = fmaf(a.z, x2, s2);
    s3 = fmaf(a.w, x3, s3);
    a = *(const LAS f32x4*)(Am + 1160);
    s0 = fmaf(a.x, x4, s0);
    s1 = fmaf(a.y, x5, s1);
    s2 = fmaf(a.z, x6, s2);
    s3 = fmaf(a.w, x7, s3);
    a = *(const LAS f32x4*)(Am + 1164);
    s0 = fmaf(a.x, x8, s0);
    s1 = fmaf(a.y, x9, s1);
    s2 = fmaf(a.z, x10, s2);
    s3 = fmaf(a.w, x11, s3);
    a = *(const LAS f32x4*)(Am + 1168);
    s0 = fmaf(a.x, x12, s0);
    s1 = fmaf(a.y, x13, s1);
    s2 = fmaf(a.z, x14, s2);
    s3 = fmaf(a.w, x15, s3);
    a = *(const LAS f32x4*)(Am + 1172);
    const float al17 = a.x;
    x17 = (x17 - ((s0 + s1) + (s2 + s3))) - al17 * x16;
    Tu[2312 + c] = f2bf(x17 * su); Tw[2312 + c] = f2bf(x17 * sw); asm volatile("" ::: "memory");
    float x18 = fmaxf(0.0f, 1.0f - fabsf(cf - 18.0f));
    s0 = 0.f; s1 = 0.f; s2 = 0.f; s3 = 0.f;
    a = *(const LAS f32x4*)(Am + 1224);
    s0 = fmaf(a.x, x0, s0);
    s1 = fmaf(a.y, x1, s1);
    s2 = fmaf(a.z, x2, s2);
    s3 = fmaf(a.w, x3, s3);
    a = *(const LAS f32x4*)(Am + 1228);
    s0 = fmaf(a.x, x4, s0);
    s1 = fmaf(a.y, x5, s1);
    s2 = fmaf(a.z, x6, s2);
    s3 = fmaf(a.w, x7, s3);
    a = *(const LAS f32x4*)(Am + 1232);
    s0 = fmaf(a.x, x8, s0);
    s1 = fmaf(a.y, x9, s1);
    s2 = fmaf(a.z, x10, s2);
    s3 = fmaf(a.w, x11, s3);
    a = *(const LAS f32x4*)(Am + 1236);
    s0 = fmaf(a.x, x12, s0);
    s1 = fmaf(a.y, x13, s1);
    s2 = fmaf(a.z, x14, s2);
    s3 = fmaf(a.w, x15, s3);
    a = *(const LAS f32x4*)(Am + 1240);
    s0 = fmaf(a.x, x16, s0);
    const float al18 = a.y;
    x18 = (x18 - ((s0 + s1) + (s2 + s3))) - al18 * x17;
    Tu[2448 + c] = f2bf(x18 * su); Tw[2448 + c] = f2bf(x18 * sw); asm volatile("" ::: "memory");
    float x19 = fmaxf(0.0f, 1.0f - fabsf(cf - 19.0f));
    s0 = 0.f; s1 = 0.f; s2 = 0.f; s3 = 0.f;
    a = *(const LAS f32x4*)(Am + 1292);
    s0 = fmaf(a.x, x0, s0);
    s1 = fmaf(a.y, x1, s1);
    s2 = fmaf(a.z, x2, s2);
    s3 = fmaf(a.w, x3, s3);
    a = *(const LAS f32x4*)(Am + 1296);
    s0 = fmaf(a.x, x4, s0);
    s1 = fmaf(a.y, x5, s1);
    s2 = fmaf(a.z, x6, s2);
    s3 = fmaf(a.w, x7, s3);
    a = *(const LAS f32x4*)(Am + 1300);
    s0 = fmaf(a.x, x8, s0);
    s1 = fmaf(a.y, x9, s1);
    s2 = fmaf(a.z, x10, s2);
    s3 = fmaf(a.w, x11, s3);
    a = *(const LAS f32x4*)(Am + 1304);
    s0 = fmaf(a.x, x12, s0);
    s1 = fmaf(a.y, x13, s1);
    s2 = fmaf(a.z, x14, s2);
    s3 = fmaf(a.w, x15, s3);
    a = *(const LAS f32x4*)(Am + 1308);
    s0 = fmaf(a.x, x16, s0);
    s1 = fmaf(a.y, x17, s1);
    const float al19 = a.z;
    x19 = (x19 - ((s0 + s1) + (s2 + s3))) - al19 * x18;
    Tu[2584 + c] = f2bf(x19 * su); Tw[2584 + c] = f2bf(x19 * sw); asm volatile("" ::: "memory");
    float x20 = fmaxf(0.0f, 1.0f - fabsf(cf - 20.0f));
    s0 = 0.f; s1 = 0.f; s2 = 0.f; s3 = 0.f;
    a = *(const LAS f32x4*)(Am + 1360);
    s0 = fmaf(a.x, x0, s0);
    s1 = fmaf(a.y, x1, s1);
    s2 = fmaf(a.z, x2, s2);
    s3 = fmaf(a.w, x3, s3);
    a = *(const LAS f32x4*)(Am + 1364);
    s0 = fmaf(a.x, x4, s0);
    s1 = fmaf(a.y, x5, s1);
    s2 = fmaf(a.z, x6, s2);
    s3 = fmaf(a.w, x7, s3);
    a = *(const LAS f32x4*)(Am + 1368);
    s0 = fmaf(a.x, x8, s0);
    s1 = fmaf(a.y, x9, s1);
    s2 = fmaf(a.z, x10, s2);
    s3 = fmaf(a.w, x11, s3);
    a = *(const LAS f32x4*)(Am + 1372);
    s0 = fmaf(a.x, x12, s0);
    s1 = fmaf(a.y, x13, s1);
    s2 = fmaf(a.z, x14, s2);
    s3 = fmaf(a.w, x15, s3);
    a = *(const LAS f32x4*)(Am + 1376);
    s0 = fmaf(a.x, x16, s0);
    s1 = fmaf(a.y, x17, s1);
    s2 = fmaf(a.z, x18, s2);
    const float al20 = a.w;
    x20 = (x20 - ((s0 + s1) + (s2 + s3))) - al20 * x19;
    Tu[2720 + c] = f2bf(x20 * su); Tw[2720 + c] = f2bf(x20 * sw); asm volatile("" ::: "memory");
    float x21 = fmaxf(0.0f, 1.0f - fabsf(cf - 21.0f));
    s0 = 0.f; s1 = 0.f; s2 = 0.f; s3 = 0.f;
    a = *(const LAS f32x4*)(Am + 1428);
    s0 = fmaf(a.x, x0, s0);
    s1 = fmaf(a.y, x1, s1);
    s2 = fmaf(a.z, x2, s2);
    s3 = fmaf(a.w, x3, s3);
    a = *(const LAS f32x4*)(Am + 1432);
    s0 = fmaf(a.x, x4, s0);
    s1 = fmaf(a.y, x5, s1);
    s2 = fmaf(a.z, x6, s2);
    s3 = fmaf(a.w, x7, s3);
    a = *(const LAS f32x4*)(Am + 1436);
    s0 = fmaf(a.x, x8, s0);
    s1 = fmaf(a.y, x9, s1);
    s2 = fmaf(a.z, x10, s2);
    s3 = fmaf(a.w, x11, s3);
    a = *(const LAS f32x4*)(Am + 1440);
    s0 = fmaf(a.x, x12, s0);
    s1 = fmaf(a.y, x13, s1);
    s2 = fmaf(a.z, x14, s2);
    s3 = fmaf(a.w, x15, s3);
    a = *(const LAS f32x4*)(Am + 1444);
    s0 = fmaf(a.x, x16, s0);
    s1 = fmaf(a.y, x17, s1);
    s2 = fmaf(a.z, x18, s2);
    s3 = fmaf(a.w, x19, s3);
    a = *(const LAS f32x4*)(Am + 1448);
    const float al21 = a.x;
    x21 = (x21 - ((s0 + s1) + (s2 + s3))) - al21 * x20;
    Tu[2856 + c] = f2bf(x21 * su); Tw[2856 + c] = f2bf(x21 * sw); asm volatile("" ::: "memory");
    float x22 = fmaxf(0.0f, 1.0f - fabsf(cf - 22.0f));
    s0 = 0.f; s1 = 0.f; s2 = 0.f; s3 = 0.f;
    a = *(const LAS f32x4*)(Am + 1496);
    s0 = fmaf(a.x, x0, s0);
    s1 = fmaf(a.y, x1, s1);
    s2 = fmaf(a.z, x2, s2);
    s3 = fmaf(a.w, x3, s3);
    a = *(const LAS f32x4*)(Am + 1500);
    s0 = fmaf(a.x, x4, s0);
    s1 = fmaf(a.y, x5, s1);
    s2 = fmaf(a.z, x6, s2);
    s3 = fmaf(a.w, x7, s3);
    a = *(const LAS f32x4*)(Am + 1504);
    s0 = fmaf(a.x, x8, s0);
    s1 = fmaf(a.y, x9, s1);
    s2 = fmaf(a.z, x10, s2);
    s3 = fmaf(a.w, x11, s3);
    a = *(const LAS f32x4*)(Am + 1508);
    s0 = fmaf(a.x, x12, s0);
    s1 = fmaf(a.y, x13, s1);
    s2 = fmaf(a.z, x14, s2);
    s3 = fmaf(a.w, x15, s3);
    a = *(const LAS f32x4*)(Am + 1512);
    s0 = fmaf(a.x, x16, s0);
    s1 = fmaf(a.y, x17, s1);
    s2 = fmaf(a.z, x18, s2);
    s3 = fmaf(a.w, x19, s3);
    a = *(const LAS f32x4*)(Am + 1516);
    s0 = fmaf(a.x, x20, s0);
    const float al22 = a.y;
    x22 = (x22 - ((s0 + s1) + (s2 + s3))) - al22 * x21;
    Tu[2992 + c] = f2bf(x22 * su); Tw[2992 + c] = f2bf(x22 * sw); asm volatile("" ::: "memory");
    float x23 = fmaxf(0.0f, 1.0f - fabsf(cf - 23.0f));
    s0 = 0.f; s1 = 0.f; s2 = 0.f; s3 = 0.f;
    a = *(const LAS f32x4*)(Am + 1564);
    s0 = fmaf(a.x, x0, s0);
    s1 = fmaf(a.y, x1, s1);
    s2 = fmaf(a.z, x2, s2);
    s3 = fmaf(a.w, x3, s3);
    a = *(const LAS f32x4*)(Am + 1568);
    s0 = fmaf(a.x, x4, s0);
    s1 = fmaf(a.y, x5, s1);
    s2 = fmaf(a.z, x6, s2);
    s3 = fmaf(a.w, x7, s3);
    a = *(const LAS f32x4*)(Am + 1572);
    s0 = fmaf(a.x, x8, s0);
    s1 = fmaf(a.y, x9, s1);
    s2 = fmaf(a.z, x10, s2);
    s3 = fmaf(a.w, x11, s3);
    a = *(const LAS f32x4*)(Am + 1576);
    s0 = fmaf(a.x, x12, s0);
    s1 = fmaf(a.y, x13, s1);
    s2 = fmaf(a.z, x14, s2);
    s3 = fmaf(a.w, x15, s3);
    a = *(const LAS f32x4*)(Am + 1580);
    s0 = fmaf(a.x, x16, s0);
    s1 = fmaf(a.y, x17, s1);
    s2 = fmaf(a.z, x18, s2);
    s3 = fmaf(a.w, x19, s3);
    a = *(const LAS f32x4*)(Am + 1584);
    s0 = fmaf(a.x, x20, s0);
    s1 = fmaf(a.y, x21, s1);
    const float al23 = a.z;
    x23 = (x23 - ((s0 + s1) + (s2 + s3))) - al23 * x22;
    Tu[3128 + c] = f2bf(x23 * su); Tw[3128 + c] = f2bf(x23 * sw); asm volatile("" ::: "memory");
    float x24 = fmaxf(0.0f, 1.0f - fabsf(cf - 24.0f));
    s0 = 0.f; s1 = 0.f; s2 = 0.f; s3 = 0.f;
    a = *(const LAS f32x4*)(Am + 1632);
    s0 = fmaf(a.x, x0, s0);
    s1 = fmaf(a.y, x1, s1);
    s2 = fmaf(a.z, x2, s2);
    s3 = fmaf(a.w, x3, s3);
    a = *(const LAS f32x4*)(Am + 1636);
    s0 = fmaf(a.x, x4, s0);
    s1 = fmaf(a.y, x5, s1);
    s2 = fmaf(a.z, x6, s2);
    s3 = fmaf(a.w, x7, s3);
    a = *(const LAS f32x4*)(Am + 1640);
    s0 = fmaf(a.x, x8, s0);
    s1 = fmaf(a.y, x9, s1);
    s2 = fmaf(a.z, x10, s2);
    s3 = fmaf(a.w, x11, s3);
    a = *(const LAS f32x4*)(Am + 1644);
    s0 = fmaf(a.x, x12, s0);
    s1 = fmaf(a.y, x13, s1);
    s2 = fmaf(a.z, x14, s2);
    s3 = fmaf(a.w, x15, s3);
    a = *(const LAS f32x4*)(Am + 1648);
    s0 = fmaf(a.x, x16, s0);
    s1 = fmaf(a.y, x17, s1);
    s2 = fmaf(a.z, x18, s2);
    s3 = fmaf(a.w, x19, s3);
    a = *(const LAS f32x4*)(Am + 1652);
    s0 = fmaf(a.x, x20, s0);
    s1 = fmaf(a.y, x21, s1);
    s2 = fmaf(a.z, x22, s2);
    const float al24 = a.w;
    x24 = (x24 - ((s0 + s1) + (s2 + s3))) - al24 * x23;
    Tu[3264 + c] = f2bf(x24 * su); Tw[3264 + c] = f2bf(x24 * sw); asm volatile("" ::: "memory");
    float x25 = fmaxf(0.0f, 1.0f - fabsf(cf - 25.0f));
    s0 = 0.f; s1 = 0.f; s2 = 0.f; s3 = 0.f;
    a = *(const LAS f32x4*)(Am + 1700);
    s0 = fmaf(a.x, x0, s0);
    s1 = fmaf(a.y, x1, s1);
    s2 = fmaf(a.z, x2, s2);
    s3 = fmaf(a.w, x3, s3);
    a = *(const LAS f32x4*)(Am + 1704);
    s0 = fmaf(a.x, x4, s0);
    s1 = fmaf(a.y, x5, s1);
    s2 = fmaf(a.z, x6, s2);
    s3 = fmaf(a.w, x7, s3);
    a = *(const LAS f32x4*)(Am + 1708);
    s0 = fmaf(a.x, x8, s0);
    s1 = fmaf(a.y, x9, s1);
    s2 = fmaf(a.z, x10, s2);
    s3 = fmaf(a.w, x11, s3);
    a = *(const LAS f32x4*)(Am + 1712);
    s0 = fmaf(a.x, x12, s0);
    s1 = fmaf(a.y, x13, s1);
    s2 = fmaf(a.z, x14, s2);
    s3 = fmaf(a.w, x15, s3);
    a = *(const LAS f32x4*)(Am + 1716);
    s0 = fmaf(a.x, x16, s0);
    s1 = fmaf(a.y, x17, s1);
    s2 = fmaf(a.z, x18, s2);
    s3 = fmaf(a.w, x19, s3);
    a = *(const LAS f32x4*)(Am + 1720);
    s0 = fmaf(a.x, x20, s0);
    s1 = fmaf(a.y, x21, s1);
    s2 = fmaf(a.z, x22, s2);
    s3 = fmaf(a.w, x23, s3);
    a = *(const LAS f32x4*)(Am + 1724);
    const float al25 = a.x;
    x25 = (x25 - ((s0 + s1) + (s2 + s3))) - al25 * x24;
    Tu[3400 + c] = f2bf(x25 * su); Tw[3400 + c] = f2bf(x25 * sw); asm volatile("" ::: "memory");
    float x26 = fmaxf(0.0f, 1.0f - fabsf(cf - 26.0f));
    s0 = 0.f; s1 = 0.f; s2 = 0.f; s3 = 0.f;
    a = *(const LAS f32x4*)(Am + 1768);
    s0 = fmaf(a.x, x0, s0);
    s1 = fmaf(a.y, x1, s1);
    s2 = fmaf(a.z, x2, s2);
    s3 = fmaf(a.w, x3, s3);
    a = *(const LAS f32x4*)(Am + 1772);
    s0 = fmaf(a.x, x4, s0);
    s1 = fmaf(a.y, x5, s1);
    s2 = fmaf(a.z, x6, s2);
    s3 = fmaf(a.w, x7, s3);
    a = *(const LAS f32x4*)(Am + 1776);
    s0 = fmaf(a.x, x8, s0);
    s1 = fmaf(a.y, x9, s1);
    s2 = fmaf(a.z, x10, s2);
    s3 = fmaf(a.w, x11, s3);
    a = *(const LAS f32x4*)(Am + 1780);
    s0 = fmaf(a.x, x12, s0);
    s1 = fmaf(a.y, x13, s1);
    s2 = fmaf(a.z, x14, s2);
    s3 = fmaf(a.w, x15, s3);
    a = *(const LAS f32x4*)(Am + 1784);
    s0 = fmaf(a.x, x16, s0);
    s1 = fmaf(a.y, x17, s1);
    s2 = fmaf(a.z, x18, s2);
    s3 = fmaf(a.w, x19, s3);
    a = *(const LAS f32x4*)(Am + 1788);
    s0 = fmaf(a.x, x20, s0);
    s1 = fmaf(a.y, x21, s1);
    s2 = fmaf(a.z, x22, s2);
    s3 = fmaf(a.w, x23, s3);
    a = *(const LAS f32x4*)(Am + 1792);
    s0 = fmaf(a.x, x24, s0);
    const float al26 = a.y;
    x26 = (x26 - ((s0 + s1) + (s2 + s3))) - al26 * x25;
    Tu[3536 + c] = f2bf(x26 * su); Tw[3536 + c] = f2bf(x26 * sw); asm volatile("" ::: "memory");
    float x27 = fmaxf(0.0f, 1.0f - fabsf(cf - 27.0f));
    s0 = 0.f; s1 = 0.f; s2 = 0.f; s3 = 0.f;
    a = *(const LAS f32x4*)(Am + 1836);
    s0 = fmaf(a.x, x0, s0);
    s1 = fmaf(a.y, x1, s1);
    s2 = fmaf(a.z, x2, s2);
    s3 = fmaf(a.w, x3, s3);
    a = *(const LAS f32x4*)(Am + 1840);
    s0 = fmaf(a.x, x4, s0);
    s1 = fmaf(a.y, x5, s1);
    s2 = fmaf(a.z, x6, s2);
    s3 = fmaf(a.w, x7, s3);
    a = *(const LAS f32x4*)(Am + 1844);
    s0 = fmaf(a.x, x8, s0);
    s1 = fmaf(a.y, x9, s1);
    s2 = fmaf(a.z, x10, s2);
    s3 = fmaf(a.w, x11, s3);
    a = *(const LAS f32x4*)(Am + 1848);
    s0 = fmaf(a.x, x12, s0);
    s1 = fmaf(a.y, x13, s1);
    s2 = fmaf(a.z, x14, s2);
    s3 = fmaf(a.w, x15, s3);
    a = *(const LAS f32x4*)(Am + 1852);
    s0 = fmaf(a.x, x16, s0);
    s1 = fmaf(a.y, x17, s1);
    s2 = fmaf(a.z, x18, s2);
    s3 = fmaf(a.w, x19, s3);
    a = *(const LAS f32x4*)(Am + 1856);
    s0 = fmaf(a.x, x20, s0);
    s1 = fmaf(a.y, x21, s1);
    s2 = fmaf(a.z, x22, s2);
    s3 = fmaf(a.w, x23, s3);
    a = *(const LAS f32x4*)(Am + 1860);
    s0 = fmaf(a.x, x24, s0);
    s1 = fmaf(a.y, x25, s1);
    const float al27 = a.z;
    x27 = (x27 - ((s0 + s1) + (s2 + s3))) - al27 * x26;
    Tu[3672 + c] = f2bf(x27 * su); Tw[3672 + c] = f2bf(x27 * sw); asm volatile("" ::: "memory");
    float x28 = fmaxf(0.0f, 1.0f - fabsf(cf - 28.0f));
    s0 = 0.f; s1 = 0.f; s2 = 0.f; s3 = 0.f;
    a = *(const LAS f32x4*)(Am + 1904);
    s0 = fmaf(a.x, x0, s0);
    s1 = fmaf(a.y, x1, s1);
    s2 = fmaf(a.z, x2, s2);
    s3 = fmaf(a.w, x3, s3);
    a = *(const LAS f32x4*)(Am + 1908);
    s0 = fmaf(a.x, x4, s0);
    s1 = fmaf(a.y, x5, s1);
    s2 = fmaf(a.z, x6, s2);
    s3 = fmaf(a.w, x7, s3);
    a = *(const LAS f32x4*)(Am + 1912);
    s0 = fmaf(a.x, x8, s0);
    s1 = fmaf(a.y, x9, s1);
    s2 = fmaf(a.z, x10, s2);
    s3 = fmaf(a.w, x11, s3);
    a = *(const LAS f32x4*)(Am + 1916);
    s0 = fmaf(a.x, x12, s0);
    s1 = fmaf(a.y, x13, s1);
    s2 = fmaf(a.z, x14, s2);
    s3 = fmaf(a.w, x15, s3);
    a = *(const LAS f32x4*)(Am + 1920);
    s0 = fmaf(a.x, x16, s0);
    s1 = fmaf(a.y, x17, s1);
    s2 = fmaf(a.z, x18, s2);
    s3 = fmaf(a.w, x19, s3);
    a = *(const LAS f32x4*)(Am + 1924);
    s0 = fmaf(a.x, x20, s0);
    s1 = fmaf(a.y, x21, s1);
    s2 = fmaf(a.z, x22, s2);
    s3 = fmaf(a.w, x23, s3);
    a = *(const LAS f32x4*)(Am + 1928);
    s0 = fmaf(a.x, x24, s0);
    s1 = fmaf(a.y, x25, s1);
    s2 = fmaf(a.z, x26, s2);
    const float al28 = a.w;
    x28 = (x28 - ((s0 + s1) + (s2 + s3))) - al28 * x27;
    Tu[3808 + c] = f2bf(x28 * su); Tw[3808 + c] = f2bf(x28 * sw); asm volatile("" ::: "memory");
    float x29 = fmaxf(0.0f, 1.0f - fabsf(cf - 29.0f));
    s0 = 0.f; s1 = 0.f; s2 = 0.f; s3 = 0.f;
    a = *(const LAS f32x4*)(Am + 1972);
    s0 = fmaf(a.x, x0, s0);
    s1 = fmaf(a.y, x1, s1);
    s2 = fmaf(a.z, x2, s2);
    s3 = fmaf(a.w, x3, s3);
    a = *(const LAS f32x4*)(Am + 1976);
    s0 = fmaf(a.x, x4, s0);
    s1 = fmaf(a.y, x5, s1);
    s2 = fmaf(a.z, x6, s2);
    s3 = fmaf(a.w, x7, s3);
    a = *(const LAS f32x4*)(Am + 1980);
    s0 = fmaf(a.x, x8, s0);
    s1 = fmaf(a.y, x9, s1);
    s2 = fmaf(a.z, x10, s2);
    s3 = fmaf(a.w, x11, s3);
    a = *(const LAS f32x4*)(Am + 1984);
    s0 = fmaf(a.x, x12, s0);
    s1 = fmaf(a.y, x13, s1);
    s2 = fmaf(a.z, x14, s2);
    s3 = fmaf(a.w, x15, s3);
    a = *(const LAS f32x4*)(Am + 1988);
    s0 = fmaf(a.x, x16, s0);
    s1 = fmaf(a.y, x17, s1);
    s2 = fmaf(a.z, x18, s2);
    s3 = fmaf(a.w, x19, s3);
    a = *(const LAS f32x4*)(Am + 1992);
    s0 = fmaf(a.x, x20, s0);
    s1 = fmaf(a.y, x21, s1);
    s2 = fmaf(a.z, x22, s2);
    s3 = fmaf(a.w, x23, s3);
    a = *(const LAS f32x4*)(Am + 1996);
    s0 = fmaf(a.x, x24, s0);
    s1 = fmaf(a.y, x25, s1);
    s2 = fmaf(a.z, x26, s2);
    s3 = fmaf(a.w, x27, s3);
    a = *(const LAS f32x4*)(Am + 2000);
    const float al29 = a.x;
    x29 = (x29 - ((s0 + s1) + (s2 + s3))) - al29 * x28;
    Tu[3944 + c] = f2bf(x29 * su); Tw[3944 + c] = f2bf(x29 * sw); asm volatile("" ::: "memory");
    float x30 = fmaxf(0.0f, 1.0f - fabsf(cf - 30.0f));
    s0 = 0.f; s1 = 0.f; s2 = 0.f; s3 = 0.f;
    a = *(const LAS f32x4*)(Am + 2040);
    s0 = fmaf(a.x, x0, s0);
    s1 = fmaf(a.y, x1, s1);
    s2 = fmaf(a.z, x2, s2);
    s3 = fmaf(a.w, x3, s3);
    a = *(const LAS f32x4*)(Am + 2044);
    s0 = fmaf(a.x, x4, s0);
    s1 = fmaf(a.y, x5, s1);
    s2 = fmaf(a.z, x6, s2);
    s3 = fmaf(a.w, x7, s3);
    a = *(const LAS f32x4*)(Am + 2048);
    s0 = fmaf(a.x, x8, s0);
    s1 = fmaf(a.y, x9, s1);
    s2 = fmaf(a.z, x10, s2);
    s3 = fmaf(a.w, x11, s3);
    a = *(const LAS f32x4*)(Am + 2052);
    s0 = fmaf(a.x, x12, s0);
    s1 = fmaf(a.y, x13, s1);
    s2 = fmaf(a.z, x14, s2);
    s3 = fmaf(a.w, x15, s3);
    a = *(const LAS f32x4*)(Am + 2056);
    s0 = fmaf(a.x, x16, s0);
    s1 = fmaf(a.y, x17, s1);
    s2 = fmaf(a.z, x18, s2);
    s3 = fmaf(a.w, x19, s3);
    a = *(const LAS f32x4*)(Am + 2060);
    s0 = fmaf(a.x, x20, s0);
    s1 = fmaf(a.y, x21, s1);
    s2 = fmaf(a.z, x22, s2);
    s3 = fmaf(a.w, x23, s3);
    a = *(const LAS f32x4*)(Am + 2064);
    s0 = fmaf(a.x, x24, s0);
    s1 = fmaf(a.y, x25, s1);
    s2 = fmaf(a.z, x26, s2);
    s3 = fmaf(a.w, x27, s3);
    a = *(const LAS f32x4*)(Am + 2068);
    s0 = fmaf(a.x, x28, s0);
    const float al30 = a.y;
    x30 = (x30 - ((s0 + s1) + (s2 + s3))) - al30 * x29;
    Tu[4080 + c] = f2bf(x30 * su); Tw[4080 + c] = f2bf(x30 * sw); asm volatile("" ::: "memory");
    float x31 = fmaxf(0.0f, 1.0f - fabsf(cf - 31.0f));
    s0 = 0.f; s1 = 0.f; s2 = 0.f; s3 = 0.f;
    a = *(const LAS f32x4*)(Am + 2108);
    s0 = fmaf(a.x, x0, s0);
    s1 = fmaf(a.y, x1, s1);
    s2 = fmaf(a.z, x2, s2);
    s3 = fmaf(a.w, x3, s3);
    a = *(const LAS f32x4*)(Am + 2112);
    s0 = fmaf(a.x, x4, s0);
    s1 = fmaf(a.y, x5, s1);
    s2 = fmaf(a.z, x6, s2);
    s3 = fmaf(a.w, x7, s3);
    a = *(const LAS f32x4*)(Am + 2116);
    s0 = fmaf(a.x, x8, s0);
    s1 = fmaf(a.y, x9, s1);
    s2 = fmaf(a.z, x10, s2);
    s3 = fmaf(a.w, x11, s3);
    a = *(const LAS f32x4*)(Am + 2120);
    s0 = fmaf(a.x, x12, s0);
    s1 = fmaf(a.y, x13, s1);
    s2 = fmaf(a.z, x14, s2);
    s3 = fmaf(a.w, x15, s3);
    a = *(const LAS f32x4*)(Am + 2124);
    s0 = fmaf(a.x, x16, s0);
    s1 = fmaf(a.y, x17, s1);
    s2 = fmaf(a.z, x18, s2);
    s3 = fmaf(a.w, x19, s3);
    a = *(const LAS f32x4*)(Am + 2128);
    s0 = fmaf(a.x, x20, s0);
    s1 = fmaf(a.y, x21, s1);
    s2 = fmaf(a.z, x22, s2);
    s3 = fmaf(a.w, x23, s3);
    a = *(const LAS f32x4*)(Am + 2132);
    s0 = fmaf(a.x, x24, s0);
    s1 = fmaf(a.y, x25, s1);
    s2 = fmaf(a.z, x26, s2);
    s3 = fmaf(a.w, x27, s3);
    a = *(const LAS f32x4*)(Am + 2136);
    s0 = fmaf(a.x, x28, s0);
    s1 = fmaf(a.y, x29, s1);
    const float al31 = a.z;
    x31 = (x31 - ((s0 + s1) + (s2 + s3))) - al31 * x30;
    Tu[4216 + c] = f2bf(x31 * su); Tw[4216 + c] = f2bf(x31 * sw); asm volatile("" ::: "memory");
    float x32 = fmaxf(0.0f, 1.0f - fabsf(cf - 32.0f));
    s0 = 0.f; s1 = 0.f; s2 = 0.f; s3 = 0.f;
    a = *(const LAS f32x4*)(Am + 2176);
    s0 = fmaf(a.x, x0, s0);
    s1 = fmaf(a.y, x1, s1);
    s2 = fmaf(a.z, x2, s2);
    s3 = fmaf(a.w, x3, s3);
    a = *(const LAS f32x4*)(Am + 2180);
    s0 = fmaf(a.x, x4, s0);
    s1 = fmaf(a.y, x5, s1);
    s2 = fmaf(a.z, x6, s2);
    s3 = fmaf(a.w, x7, s3);
    a = *(const LAS f32x4*)(Am + 2184);
    s0 = fmaf(a.x, x8, s0);
    s1 = fmaf(a.y, x9, s1);
    s2 = fmaf(a.z, x10, s2);
    s3 = fmaf(a.w, x11, s3);
    a = *(const LAS f32x4*)(Am + 2188);
    s0 = fmaf(a.x, x12, s0);
    s1 = fmaf(a.y, x13, s1);
    s2 = fmaf(a.z, x14, s2);
    s3 = fmaf(a.w, x15, s3);
    a = *(const LAS f32x4*)(Am + 2192);
    s0 = fmaf(a.x, x16, s0);
    s1 = fmaf(a.y, x17, s1);
    s2 = fmaf(a.z, x18, s2);
    s3 = fmaf(a.w, x19, s3);
    a = *(const LAS f32x4*)(Am + 2196);
    s0 = fmaf(a.x, x20, s0);
    s1 = fmaf(a.y, x21, s1);
    s2 = fmaf(a.z, x22, s2);
    s3 = fmaf(a.w, x23, s3);
    a = *(const LAS f32x4*)(Am + 2200);
    s0 = fmaf(a.x, x24, s0);
    s1 = fmaf(a.y, x25, s1);
    s2 = fmaf(a.z, x26, s2);
    s3 = fmaf(a.w, x27, s3);
    a = *(const LAS f32x4*)(Am + 2204);
    s0 = fmaf(a.x, x28, s0);
    s1 = fmaf(a.y, x29, s1);
    s2 = fmaf(a.z, x30, s2);
    const float al32 = a.w;
    x32 = (x32 - ((s0 + s1) + (s2 + s3))) - al32 * x31;
    Tu[4352 + c] = f2bf(x32 * su); Tw[4352 + c] = f2bf(x32 * sw); asm volatile("" ::: "memory");
    float x33 = fmaxf(0.0f, 1.0f - fabsf(cf - 33.0f));
    s0 = 0.f; s1 = 0.f; s2 = 0.f; s3 = 0.f;
    a = *(const LAS f32x4*)(Am + 2244);
    s0 = fmaf(a.x, x0, s0);
    s1 = fmaf(a.y, x1, s1);
    s2 = fmaf(a.z, x2, s2);
    s3 = fmaf(a.w, x3, s3);
    a = *(const LAS f32x4*)(Am + 2248);
    s0 = fmaf(a.x, x4, s0);
    s1 = fmaf(a.y, x5, s1);
    s2 = fmaf(a.z, x6, s2);
    s3 = fmaf(a.w, x7, s3);
    a = *(const LAS f32x4*)(Am + 2252);
    s0 = fmaf(a.x, x8, s0);
    s1 = fmaf(a.y, x9, s1);
    s2 = fmaf(a.z, x10, s2);
    s3 = fmaf(a.w, x11, s3);
    a = *(const LAS f32x4*)(Am + 2256);
    s0 = fmaf(a.x, x12, s0);
    s1 = fmaf(a.y, x13, s1);
    s2 = fmaf(a.z, x14, s2);
    s3 = fmaf(a.w, x15, s3);
    a = *(const LAS f32x4*)(Am + 2260);
    s0 = fmaf(a.x, x16, s0);
    s1 = fmaf(a.y, x17, s1);
    s2 = fmaf(a.z, x18, s2);
    s3 = fmaf(a.w, x19, s3);
    a = *(const LAS f32x4*)(Am + 2264);
    s0 = fmaf(a.x, x20, s0);
    s1 = fmaf(a.y, x21, s1);
    s2 = fmaf(a.z, x22, s2);
    s3 = fmaf(a.w, x23, s3);
    a = *(const LAS f32x4*)(Am + 2268);
    s0 = fmaf(a.x, x24, s0);
    s1 = fmaf(a.y, x25, s1);
    s2 = fmaf(a.z, x26, s2);
    s3 = fmaf(a.w, x27, s3);
    a = *(const LAS f32x4*)(Am + 2272);
    s0 = fmaf(a.x, x28, s0);
    s1 = fmaf(a.y, x29, s1);
    s2 = fmaf(a.z, x30, s2);
    s3 = fmaf(a.w, x31, s3);
    a = *(const LAS f32x4*)(Am + 2276);
    const float al33 = a.x;
    x33 = (x33 - ((s0 + s1) + (s2 + s3))) - al33 * x32;
    Tu[4488 + c] = f2bf(x33 * su); Tw[4488 + c] = f2bf(x33 * sw); asm volatile("" ::: "memory");
    float x34 = fmaxf(0.0f, 1.0f - fabsf(cf - 34.0f));
    s0 = 0.f; s1 = 0.f; s2 = 0.f; s3 = 0.f;
    a = *(const LAS f32x4*)(Am + 2312);
    s0 = fmaf(a.x, x0, s0);
    s1 = fmaf(a.y, x1, s1);
    s2 = fmaf(a.z, x2, s2);
    s3 = fmaf(a.w, x3, s3);
    a = *(const LAS f32x4*)(Am + 2316);
    s0 = fmaf(a.x, x4, s0);
    s1 = fmaf(a.y, x5, s1);
    s2 = fmaf(a.z, x6, s2);
    s3 = fmaf(a.w, x7, s3);
    a = *(const LAS f32x4*)(Am + 2320);
    s0 = fmaf(a.x, x8, s0);
    s1 = fmaf(a.y, x9, s1);
    s2 = fmaf(a.z, x10, s2);
    s3 = fmaf(a.w, x11, s3);
    a = *(const LAS f32x4*)(Am + 2324);
    s0 = fmaf(a.x, x12, s0);
    s1 = fmaf(a.y, x13, s1);
    s2 = fmaf(a.z, x14, s2);
    s3 = fmaf(a.w, x15, s3);
    a = *(const LAS f32x4*)(Am + 2328);
    s0 = fmaf(a.x, x16, s0);
    s1 = fmaf(a.y, x17, s1);
    s2 = fmaf(a.z, x18, s2);
    s3 = fmaf(a.w, x19, s3);
    a = *(const LAS f32x4*)(Am + 2332);
    s0 = fmaf(a.x, x20, s0);
    s1 = fmaf(a.y, x21, s1);
    s2 = fmaf(a.z, x22, s2);
    s3 = fmaf(a.w, x23, s3);
    a = *(const LAS f32x4*)(Am + 2336);
    s0 = fmaf(a.x, x24, s0);
    s1 = fmaf(a.y, x25, s1);
    s2 = fmaf(a.z, x26, s2);
    s3 = fmaf(a.w, x27, s3);
    a = *(const LAS f32x4*)(Am + 2340);
    s0 = fmaf(a.x, x28, s0);
    s1 = fmaf(a.y, x29, s1);
    s2 = fmaf(a.z, x30, s2);
    s3 = fmaf(a.w, x31, s3);
    a = *(const LAS f32x4*)(Am + 2344);
    s0 = fmaf(a.x, x32, s0);
    const float al34 = a.y;
    x34 = (x34 - ((s0 + s1) + (s2 + s3))) - al34 * x33;
    Tu[4624 + c] = f2bf(x34 * su); Tw[4624 + c] = f2bf(x34 * sw); asm volatile("" ::: "memory");
    float x35 = fmaxf(0.0f, 1.0f - fabsf(cf - 35.0f));
    s0 = 0.f; s1 = 0.f; s2 = 0.f; s3 = 0.f;
    a = *(const LAS f32x4*)(Am + 2380);
    s0 = fmaf(a.x, x0, s0);
    s1 = fmaf(a.y, x1, s1);
    s2 = fmaf(a.z, x2, s2);
    s3 = fmaf(a.w, x3, s3);
    a = *(const LAS f32x4*)(Am + 2384);
    s0 = fmaf(a.x, x4, s0);
    s1 = fmaf(a.y, x5, s1);
    s2 = fmaf(a.z, x6, s2);
    s3 = fmaf(a.w, x7, s3);
    a = *(const LAS f32x4*)(Am + 2388);
    s0 = fmaf(a.x, x8, s0);
    s1 = fmaf(a.y, x9, s1);
    s2 = fmaf(a.z, x10, s2);
    s3 = fmaf(a.w, x11, s3);
    a = *(const LAS f32x4*)(Am + 2392);
    s0 = fmaf(a.x, x12, s0);
    s1 = fmaf(a.y, x13, s1);
    s2 = fmaf(a.z, x14, s2);
    s3 = fmaf(a.w, x15, s3);
    a = *(const LAS f32x4*)(Am + 2396);
    s0 = fmaf(a.x, x16, s0);
    s1 = fmaf(a.y, x17, s1);
    s2 = fmaf(a.z, x18, s2);
    s3 = fmaf(a.w, x19, s3);
    a = *(const LAS f32x4*)(Am + 2400);
    s0 = fmaf(a.x, x20, s0);
    s1 = fmaf(a.y, x21, s1);
    s2 = fmaf(a.z, x22, s2);
    s3 = fmaf(a.w, x23, s3);
    a = *(const LAS f32x4*)(Am + 2404);
    s0 = fmaf(a.x, x24, s0);
    s1 = fmaf(a.y, x25, s1);
    s2 = fmaf(a.z, x26, s2);
    s3 = fmaf(a.w, x27, s3);
    a = *(const LAS f32x4*)(Am + 2408);
    s0 = fmaf(a.x, x28, s0);
    s1 = fmaf(a.y, x29, s1);
    s2 = fmaf(a.z, x30, s2);
    s3 = fmaf(a.w, x31, s3);
    a = *(const LAS f32x4*)(Am + 2412);
    s0 = fmaf(a.x, x32, s0);
    s1 = fmaf(a.y, x33, s1);
    const float al35 = a.z;
    x35 = (x35 - ((s0 + s1) + (s2 + s3))) - al35 * x34;
    Tu[4760 + c] = f2bf(x35 * su); Tw[4760 + c] = f2bf(x35 * sw); asm volatile("" ::: "memory");
    float x36 = fmaxf(0.0f, 1.0f - fabsf(cf - 36.0f));
    s0 = 0.f; s1 = 0.f; s2 = 0.f; s3 = 0.f;
    a = *(const LAS f32x4*)(Am + 2448);
    s0 = fmaf(a.x, x0, s0);
    s1 = fmaf(a.y, x1, s1);
    s2 = fmaf(a.z, x2, s2);
    s3 = fmaf(a.w, x3, s3);
    a = *(const LAS f32x4*)(Am + 2452);
    s0 = fmaf(a.x, x4, s0);
    s1 = fmaf(a.y, x5, s1);
    s2 = fmaf(a.z, x6, s2);
    s3 = fmaf(a.w, x7, s3);
    a = *(const LAS f32x4*)(Am + 2456);
    s0 = fmaf(a.x, x8, s0);
    s1 = fmaf(a.y, x9, s1);
    s2 = fmaf(a.z, x10, s2);
    s3 = fmaf(a.w, x11, s3);
    a = *(const LAS f32x4*)(Am + 2460);
    s0 = fmaf(a.x, x12, s0);
    s1 = fmaf(a.y, x13, s1);
    s2 = fmaf(a.z, x14, s2);
    s3 = fmaf(a.w, x15, s3);
    a = *(const LAS f32x4*)(Am + 2464);
    s0 = fmaf(a.x, x16, s0);
    s1 = fmaf(a.y, x17, s1);
    s2 = fmaf(a.z, x18, s2);
    s3 = fmaf(a.w, x19, s3);
    a = *(const LAS f32x4*)(Am + 2468);
    s0 = fmaf(a.x, x20, s0);
    s1 = fmaf(a.y, x21, s1);
    s2 = fmaf(a.z, x22, s2);
    s3 = fmaf(a.w, x23, s3);
    a = *(const LAS f32x4*)(Am + 2472);
    s0 = fmaf(a.x, x24, s0);
    s1 = fmaf(a.y, x25, s1);
    s2 = fmaf(a.z, x26, s2);
    s3 = fmaf(a.w, x27, s3);
    a = *(const LAS f32x4*)(Am + 2476);
    s0 = fmaf(a.x, x28, s0);
    s1 = fmaf(a.y, x29, s1);
    s2 = fmaf(a.z, x30, s2);
    s3 = fmaf(a.w, x31, s3);
    a = *(const LAS f32x4*)(Am + 2480);
    s0 = fmaf(a.x, x32, s0);
    s1 = fmaf(a.y, x33, s1);
    s2 = fmaf(a.z, x34, s2);
    const float al36 = a.w;
    x36 = (x36 - ((s0 + s1) + (s2 + s3))) - al36 * x35;
    Tu[4896 + c] = f2bf(x36 * su); Tw[4896 + c] = f2bf(x36 * sw); asm volatile("" ::: "memory");
    float x37 = fmaxf(0.0f, 1.0f - fabsf(cf - 37.0f));
    s0 = 0.f; s1 = 0.f; s2 = 0.f; s3 = 0.f;
    a = *(const LAS f32x4*)(Am + 2516);
    s0 = fmaf(a.x, x0, s0);
    s1 = fmaf(a.y, x1, s1);
    s2 = fmaf(a.z, x2, s2);
    s3 = fmaf(a.w, x3, s3);
    a = *(const LAS f32x4*)(Am + 2520);
    s0 = fmaf(a.x, x4, s0);
    s1 = fmaf(a.y, x5, s1);
    s2 = fmaf(a.z, x6, s2);
    s3 = fmaf(a.w, x7, s3);
    a = *(const LAS f32x4*)(Am + 2524);
    s0 = fmaf(a.x, x8, s0);
    s1 = fmaf(a.y, x9, s1);
    s2 = fmaf(a.z, x10, s2);
    s3 = fmaf(a.w, x11, s3);
    a = *(const LAS f32x4*)(Am + 2528);
    s0 = fmaf(a.x, x12, s0);
    s1 = fmaf(a.y, x13, s1);
    s2 = fmaf(a.z, x14, s2);
    s3 = fmaf(a.w, x15, s3);
    a = *(const LAS f32x4*)(Am + 2532);
    s0 = fmaf(a.x, x16, s0);
    s1 = fmaf(a.y, x17, s1);
    s2 = fmaf(a.z, x18, s2);
    s3 = fmaf(a.w, x19, s3);
    a = *(const LAS f32x4*)(Am + 2536);
    s0 = fmaf(a.x, x20, s0);
    s1 = fmaf(a.y, x21, s1);
    s2 = fmaf(a.z, x22, s2);
    s3 = fmaf(a.w, x23, s3);
    a = *(const LAS f32x4*)(Am + 2540);
    s0 = fmaf(a.x, x24, s0);
    s1 = fmaf(a.y, x25, s1);
    s2 = fmaf(a.z, x26, s2);
    s3 = fmaf(a.w, x27, s3);
    a = *(const LAS f32x4*)(Am + 2544);
    s0 = fmaf(a.x, x28, s0);
    s1 = fmaf(a.y, x29, s1);
    s2 = fmaf(a.z, x30, s2);
    s3 = fmaf(a.w, x31, s3);
    a = *(const LAS f32x4*)(Am + 2548);
    s0 = fmaf(a.x, x32, s0);
    s1 = fmaf(a.y, x33, s1);
    s2 = fmaf(a.z, x34, s2);
    s3 = fmaf(a.w, x35, s3);
    a = *(const LAS f32x4*)(Am + 2552);
    const float al37 = a.x;
    x37 = (x37 - ((s0 + s1) + (s2 + s3))) - al37 * x36;
    Tu[5032 + c] = f2bf(x37 * su); Tw[5032 + c] = f2bf(x37 * sw); asm volatile("" ::: "memory");
    float x38 = fmaxf(0.0f, 1.0f - fabsf(cf - 38.0f));
    s0 = 0.f; s1 = 0.f; s2 = 0.f; s3 = 0.f;
    a = *(const LAS f32x4*)(Am + 2584);
    s0 = fmaf(a.x, x0, s0);
    s1 = fmaf(a.y, x1, s1);
    s2 = fmaf(a.z, x2, s2);
    s3 = fmaf(a.w, x3, s3);
    a = *(const LAS f32x4*)(Am + 2588);
    s0 = fmaf(a.x, x4, s0);
    s1 = fmaf(a.y, x5, s1);
    s2 = fmaf(a.z, x6, s2);
    s3 = fmaf(a.w, x7, s3);
    a = *(const LAS f32x4*)(Am + 2592);
    s0 = fmaf(a.x, x8, s0);
    s1 = fmaf(a.y, x9, s1);
    s2 = fmaf(a.z, x10, s2);
    s3 = fmaf(a.w, x11, s3);
    a = *(const LAS f32x4*)(Am + 2596);
    s0 = fmaf(a.x, x12, s0);
    s1 = fmaf(a.y, x13, s1);
    s2 = fmaf(a.z, x14, s2);
    s3 = fmaf(a.w, x15, s3);
    a = *(const LAS f32x4*)(Am + 2600);
    s0 = fmaf(a.x, x16, s0);
    s1 = fmaf(a.y, x17, s1);
    s2 = fmaf(a.z, x18, s2);
    s3 = fmaf(a.w, x19, s3);
    a = *(const LAS f32x4*)(Am + 2604);
    s0 = fmaf(a.x, x20, s0);
    s1 = fmaf(a.y, x21, s1);
    s2 = fmaf(a.z, x22, s2);
    s3 = fmaf(a.w, x23, s3);
    a = *(const LAS f32x4*)(Am + 2608);
    s0 = fmaf(a.x, x24, s0);
    s1 = fmaf(a.y, x25, s1);
    s2 = fmaf(a.z, x26, s2);
    s3 = fmaf(a.w, x27, s3);
    a = *(const LAS f32x4*)(Am + 2612);
    s0 = fmaf(a.x, x28, s0);
    s1 = fmaf(a.y, x29, s1);
    s2 = fmaf(a.z, x30, s2);
    s3 = fmaf(a.w, x31, s3);
    a = *(const LAS f32x4*)(Am + 2616);
    s0 = fmaf(a.x, x32, s0);
    s1 = fmaf(a.y, x33, s1);
    s2 = fmaf(a.z, x34, s2);
    s3 = fmaf(a.w, x35, s3);
    a = *(const LAS f32x4*)(Am + 2620);
    s0 = fmaf(a.x, x36, s0);
    const float al38 = a.y;
    x38 = (x38 - ((s0 + s1) + (s2 + s3))) - al38 * x37;
    Tu[5168 + c] = f2bf(x38 * su); Tw[5168 + c] = f2bf(x38 * sw); asm volatile("" ::: "memory");
    float x39 = fmaxf(0.0f, 1.0f - fabsf(cf - 39.0f));
    s0 = 0.f; s1 = 0.f; s2 = 0.f; s3 = 0.f;
    a = *(const LAS f32x4*)(Am + 2652);
    s0 = fmaf(a.x, x0, s0);
    s1 = fmaf(a.y, x1, s1);
    s2 = fmaf(a.z, x2, s2);
    s3 = fmaf(a.w, x3, s3);
    a = *(const LAS f32x4*)(Am + 2656);
    s0 = fmaf(a.x, x4, s0);
    s1 = fmaf(a.y, x5, s1);
    s2 = fmaf(a.z, x6, s2);
    s3 = fmaf(a.w, x7, s3);
    a = *(const LAS f32x4*)(Am + 2660);
    s0 = fmaf(a.x, x8, s0);
    s1 = fmaf(a.y, x9, s1);
    s2 = fmaf(a.z, x10, s2);
    s3 = fmaf(a.w, x11, s3);
    a = *(const LAS f32x4*)(Am + 2664);
    s0 = fmaf(a.x, x12, s0);
    s1 = fmaf(a.y, x13, s1);
    s2 = fmaf(a.z, x14, s2);
    s3 = fmaf(a.w, x15, s3);
    a = *(const LAS f32x4*)(Am + 2668);
    s0 = fmaf(a.x, x16, s0);
    s1 = fmaf(a.y, x17, s1);
    s2 = fmaf(a.z, x18, s2);
    s3 = fmaf(a.w, x19, s3);
    a = *(const LAS f32x4*)(Am + 2672);
    s0 = fmaf(a.x, x20, s0);
    s1 = fmaf(a.y, x21, s1);
    s2 = fmaf(a.z, x22, s2);
    s3 = fmaf(a.w, x23, s3);
    a = *(const LAS f32x4*)(Am + 2676);
    s0 = fmaf(a.x, x24, s0);
    s1 = fmaf(a.y, x25, s1);
    s2 = fmaf(a.z, x26, s2);
    s3 = fmaf(a.w, x27, s3);
    a = *(const LAS f32x4*)(Am + 2680);
    s0 = fmaf(a.x, x28, s0);
    s1 = fmaf(a.y, x29, s1);
    s2 = fmaf(a.z, x30, s2);
    s3 = fmaf(a.w, x31, s3);
    a = *(const LAS f32x4*)(Am + 2684);
    s0 = fmaf(a.x, x32, s0);
    s1 = fmaf(a.y, x33, s1);
    s2 = fmaf(a.z, x34, s2);
    s3 = fmaf(a.w, x35, s3);
    a = *(const LAS f32x4*)(Am + 2688);
    s0 = fmaf(a.x, x36, s0);
    s1 = fmaf(a.y, x37, s1);
    const float al39 = a.z;
    x39 = (x39 - ((s0 + s1) + (s2 + s3))) - al39 * x38;
    Tu[5304 + c] = f2bf(x39 * su); Tw[5304 + c] = f2bf(x39 * sw); asm volatile("" ::: "memory");
    float x40 = fmaxf(0.0f, 1.0f - fabsf(cf - 40.0f));
    s0 = 0.f; s1 = 0.f; s2 = 0.f; s3 = 0.f;
    a = *(const LAS f32x4*)(Am + 2720);
    s0 = fmaf(a.x, x0, s0);
    s1 = fmaf(a.y, x1, s1);
    s2 = fmaf(a.z, x2, s2);
    s3 = fmaf(a.w, x3, s3);
    a = *(const LAS f32x4*)(Am + 2724);
    s0 = fmaf(a.x, x4, s0);
    s1 = fmaf(a.y, x5, s1);
    s2 = fmaf(a.z, x6, s2);
    s3 = fmaf(a.w, x7, s3);
    a = *(const LAS f32x4*)(Am + 2728);
    s0 = fmaf(a.x, x8, s0);
    s1 = fmaf(a.y, x9, s1);
    s2 = fmaf(a.z, x10, s2);
    s3 = fmaf(a.w, x11, s3);
    a = *(const LAS f32x4*)(Am + 2732);
    s0 = fmaf(a.x, x12, s0);
    s1 = fmaf(a.y, x13, s1);
    s2 = fmaf(a.z, x14, s2);
    s3 = fmaf(a.w, x15, s3);
    a = *(const LAS f32x4*)(Am + 2736);
    s0 = fmaf(a.x, x16, s0);
    s1 = fmaf(a.y, x17, s1);
    s2 = fmaf(a.z, x18, s2);
    s3 = fmaf(a.w, x19, s3);
    a = *(const LAS f32x4*)(Am + 2740);
    s0 = fmaf(a.x, x20, s0);
    s1 = fmaf(a.y, x21, s1);
    s2 = fmaf(a.z, x22, s2);
    s3 = fmaf(a.w, x23, s3);
    a = *(const LAS f32x4*)(Am + 2744);
    s0 = fmaf(a.x, x24, s0);
    s1 = fmaf(a.y, x25, s1);
    s2 = fmaf(a.z, x26, s2);
    s3 = fmaf(a.w, x27, s3);
    a = *(const LAS f32x4*)(Am + 2748);
    s0 = fmaf(a.x, x28, s0);
    s1 = fmaf(a.y, x29, s1);
    s2 = fmaf(a.z, x30, s2);
    s3 = fmaf(a.w, x31, s3);
    a = *(const LAS f32x4*)(Am + 2752);
    s0 = fmaf(a.x, x32, s0);
    s1 = fmaf(a.y, x33, s1);
    s2 = fmaf(a.z, x34, s2);
    s3 = fmaf(a.w, x35, s3);
    a = *(const LAS f32x4*)(Am + 2756);
    s0 = fmaf(a.x, x36, s0);
    s1 = fmaf(a.y, x37, s1);
    s2 = fmaf(a.z, x38, s2);
    const float al40 = a.w;
    x40 = (x40 - ((s0 + s1) + (s2 + s3))) - al40 * x39;
    Tu[5440 + c] = f2bf(x40 * su); Tw[5440 + c] = f2bf(x40 * sw); asm volatile("" ::: "memory");
    float x41 = fmaxf(0.0f, 1.0f - fabsf(cf - 41.0f));
    s0 = 0.f; s1 = 0.f; s2 = 0.f; s3 = 0.f;
    a = *(const LAS f32x4*)(Am + 2788);
    s0 = fmaf(a.x, x0, s0);
    s1 = fmaf(a.y, x1, s1);
    s2 = fmaf(a.z, x2, s2);
    s3 = fmaf(a.w, x3, s3);
    a = *(const LAS f32x4*)(Am + 2792);
    s0 = fmaf(a.x, x4, s0);
    s1 = fmaf(a.y, x5, s1);
    s2 = fmaf(a.z, x6, s2);
    s3 = fmaf(a.w, x7, s3);
    a = *(const LAS f32x4*)(Am + 2796);
    s0 = fmaf(a.x, x8, s0);
    s1 = fmaf(a.y, x9, s1);
    s2 = fmaf(a.z, x10, s2);
    s3 = fmaf(a.w, x11, s3);
    a = *(const LAS f32x4*)(Am + 2800);
    s0 = fmaf(a.x, x12, s0);
    s1 = fmaf(a.y, x13, s1);
    s2 = fmaf(a.z, x14, s2);
    s3 = fmaf(a.w, x15, s3);
    a = *(const LAS f32x4*)(Am + 2804);
    s0 = fmaf(a.x, x16, s0);
    s1 = fmaf(a.y, x17, s1);
    s2 = fmaf(a.z, x18, s2);
    s3 = fmaf(a.w, x19, s3);
    a = *(const LAS f32x4*)(Am + 2808);
    s0 = fmaf(a.x, x20, s0);
    s1 = fmaf(a.y, x21, s1);
    s2 = fmaf(a.z, x22, s2);
    s3 = fmaf(a.w, x23, s3);
    a = *(const LAS f32x4*)(Am + 2812);
    s0 = fmaf(a.x, x24, s0);
    s1 = fmaf(a.y, x25, s1);
    s2 = fmaf(a.z, x26, s2);
    s3 = fmaf(a.w, x27, s3);
    a = *(const LAS f32x4*)(Am + 2816);
    s0 = fmaf(a.x, x28, s0);
    s1 = fmaf(a.y, x29, s1);
    s2 = fmaf(a.z, x30, s2);
    s3 = fmaf(a.w, x31, s3);
    a = *(const LAS f32x4*)(Am + 2820);
    s0 = fmaf(a.x, x32, s0);
    s1 = fmaf(a.y, x33, s1);
    s2 = fmaf(a.z, x34, s2);
    s3 = fmaf(a.w, x35, s3);
    a = *(const LAS f32x4*)(Am + 2824);
    s0 = fmaf(a.x, x36, s0);
    s1 = fmaf(a.y, x37, s1);
    s2 = fmaf(a.z, x38, s2);
    s3 = fmaf(a.w, x39, s3);
    a = *(const LAS f32x4*)(Am + 2828);
    const float al41 = a.x;
    x41 = (x41 - ((s0 + s1) + (s2 + s3))) - al41 * x40;
    Tu[5576 + c] = f2bf(x41 * su); Tw[5576 + c] = f2bf(x41 * sw); asm volatile("" ::: "memory");
    float x42 = fmaxf(0.0f, 1.0f - fabsf(cf - 42.0f));
    s0 = 0.f; s1 = 0.f; s2 = 0.f; s3 = 0.f;
    a = *(const LAS f32x4*)(Am + 2856);
    s0 = fmaf(a.x, x0, s0);
    s1 = fmaf(a.y, x1, s1);
    s2 = fmaf(a.z, x2, s2);
    s3 = fmaf(a.w, x3, s3);
    a = *(const LAS f32x4*)(Am + 2860);
    s0 = fmaf(a.x, x4, s0);
    s1 = fmaf(a.y, x5, s1);
    s2 = fmaf(a.z, x6, s2);
    s3 = fmaf(a.w, x7, s3);
    a = *(const LAS f32x4*)(Am + 2864);
    s0 = fmaf(a.x, x8, s0);
    s1 = fmaf(a.y, x9, s1);
    s2 = fmaf(a.z, x10, s2);
    s3 = fmaf(a.w, x11, s3);
    a = *(const LAS f32x4*)(Am + 2868);
    s0 = fmaf(a.x, x12, s0);
    s1 = fmaf(a.y, x13, s1);
    s2 = fmaf(a.z, x14, s2);
    s3 = fmaf(a.w, x15, s3);
    a = *(const LAS f32x4*)(Am + 2872);
    s0 = fmaf(a.x, x16, s0);
    s1 = fmaf(a.y, x17, s1);
    s2 = fmaf(a.z, x18, s2);
    s3 = fmaf(a.w, x19, s3);
    a = *(const LAS f32x4*)(Am + 2876);
    s0 = fmaf(a.x, x20, s0);
    s1 = fmaf(a.y, x21, s1);
    s2 = fmaf(a.z, x22, s2);
    s3 = fmaf(a.w, x23, s3);
    a = *(const LAS f32x4*)(Am + 2880);
    s0 = fmaf(a.x, x24, s0);
    s1 = fmaf(a.y, x25, s1);
    s2 = fmaf(a.z, x26, s2);
    s3 = fmaf(a.w, x27, s3);
    a = *(const LAS f32x4*)(Am + 2884);
    s0 = fmaf(a.x, x28, s0);
    s1 = fmaf(a.y, x29, s1);
    s2 = fmaf(a.z, x30, s2);
    s3 = fmaf(a.w, x31, s3);
    a = *(const LAS f32x4*)(Am + 2888);
    s0 = fmaf(a.x, x32, s0);
    s1 = fmaf(a.y, x33, s1);
    s2 = fmaf(a.z, x34, s2);
    s3 = fmaf(a.w, x35, s3);
    a = *(const LAS f32x4*)(Am + 2892);
    s0 = fmaf(a.x, x36, s0);
    s1 = fmaf(a.y, x37, s1);
    s2 = fmaf(a.z, x38, s2);
    s3 = fmaf(a.w, x39, s3);
    a = *(const LAS f32x4*)(Am + 2896);
    s0 = fmaf(a.x, x40, s0);
    const float al42 = a.y;
    x42 = (x42 - ((s0 + s1) + (s2 + s3))) - al42 * x41;
    Tu[5712 + c] = f2bf(x42 * su); Tw[5712 + c] = f2bf(x42 * sw); asm volatile("" ::: "memory");
    float x43 = fmaxf(0.0f, 1.0f - fabsf(cf - 43.0f));
    s0 = 0.f; s1 = 0.f; s2 = 0.f; s3 = 0.f;
    a = *(const LAS f32x4*)(Am + 2924);
    s0 = fmaf(a.x, x0, s0);
    s1 = fmaf(a.y, x1, s1);
    s2 = fmaf(a.z, x2, s2);
    s3 = fmaf(a.w, x3, s3);
    a = *(const LAS f32x4*)(Am + 2928);
    s0 = fmaf(a.x, x4, s0);
    s1 = fmaf(a.y, x5, s1);
    s2 = fmaf(a.z, x6, s2);
    s3 = fmaf(a.w, x7, s3);
    a = *(const LAS f32x4*)(Am + 2932);
    s0 = fmaf(a.x, x8, s0);
    s1 = fmaf(a.y, x9, s1);
    s2 = fmaf(a.z, x10, s2);
    s3 = fmaf(a.w, x11, s3);
    a = *(const LAS f32x4*)(Am + 2936);
    s0 = fmaf(a.x, x12, s0);
    s1 = fmaf(a.y, x13, s1);
    s2 = fmaf(a.z, x14, s2);
    s3 = fmaf(a.w, x15, s3);
    a = *(const LAS f32x4*)(Am + 2940);
    s0 = fmaf(a.x, x16, s0);
    s1 = fmaf(a.y, x17, s1);
    s2 = fmaf(a.z, x18, s2);
    s3 = fmaf(a.w, x19, s3);
    a = *(const LAS f32x4*)(Am + 2944);
    s0 = fmaf(a.x, x20, s0);
    s1 = fmaf(a.y, x21, s1);
    s2 = fmaf(a.z, x22, s2);
    s3 = fmaf(a.w, x23, s3);
    a = *(const LAS f32x4*)(Am + 2948);
    s0 = fmaf(a.x, x24, s0);
    s1 = fmaf(a.y, x25, s1);
    s2 = fmaf(a.z, x26, s2);
    s3 = fmaf(a.w, x27, s3);
    a = *(const LAS f32x4*)(Am + 2952);
    s0 = fmaf(a.x, x28, s0);
    s1 = fmaf(a.y, x29, s1);
    s2 = fmaf(a.z, x30, s2);
    s3 = fmaf(a.w, x31, s3);
    a = *(const LAS f32x4*)(Am + 2956);
    s0 = fmaf(a.x, x32, s0);
    s1 = fmaf(a.y, x33, s1);
    s2 = fmaf(a.z, x34, s2);
    s3 = fmaf(a.w, x35, s3);
    a = *(const LAS f32x4*)(Am + 2960);
    s0 = fmaf(a.x, x36, s0);
    s1 = fmaf(a.y, x37, s1);
    s2 = fmaf(a.z, x38, s2);
    s3 = fmaf(a.w, x39, s3);
    a = *(const LAS f32x4*)(Am + 2964);
    s0 = fmaf(a.x, x40, s0);
    s1 = fmaf(a.y, x41, s1);
    const float al43 = a.z;
    x43 = (x43 - ((s0 + s1) + (s2 + s3))) - al43 * x42;
    Tu[5848 + c] = f2bf(x43 * su); Tw[5848 + c] = f2bf(x43 * sw); asm volatile("" ::: "memory");
    float x44 = fmaxf(0.0f, 1.0f - fabsf(cf - 44.0f));
    s0 = 0.f; s1 = 0.f; s2 = 0.f; s3 = 0.f;
    a = *(const LAS f32x4*)(Am + 2992);
    s0 = fmaf(a.x, x0, s0);
    s1 = fmaf(a.y, x1, s1);
    s2 = fmaf(a.z, x2, s2);
    s3 = fmaf(a.w, x3, s3);
    a = *(const LAS f32x4*)(Am + 2996);
    s0 = fmaf(a.x, x4, s0);
    s1 = fmaf(a.y, x5, s1);
    s2 = fmaf(a.z, x6, s2);
    s3 = fmaf(a.w, x7, s3);
    a = *(const LAS f32x4*)(Am + 3000);
    s0 = fmaf(a.x, x8, s0);
    s1 = fmaf(a.y, x9, s1);
    s2 = fmaf(a.z, x10, s2);
    s3 = fmaf(a.w, x11, s3);
    a = *(const LAS f32x4*)(Am + 3004);
    s0 = fmaf(a.x, x12, s0);
    s1 = fmaf(a.y, x13, s1);
    s2 = fmaf(a.z, x14, s2);
    s3 = fmaf(a.w, x15, s3);
    a = *(const LAS f32x4*)(Am + 3008);
    s0 = fmaf(a.x, x16, s0);
    s1 = fmaf(a.y, x17, s1);
    s2 = fmaf(a.z, x18, s2);
    s3 = fmaf(a.w, x19, s3);
    a = *(const LAS f32x4*)(Am + 3012);
    s0 = fmaf(a.x, x20, s0);
    s1 = fmaf(a.y, x21, s1);
    s2 = fmaf(a.z, x22, s2);
    s3 = fmaf(a.w, x23, s3);
    a = *(const LAS f32x4*)(Am + 3016);
    s0 = fmaf(a.x, x24, s0);
    s1 = fmaf(a.y, x25, s1);
    s2 = fmaf(a.z, x26, s2);
    s3 = fmaf(a.w, x27, s3);
    a = *(const LAS f32x4*)(Am + 3020);
    s0 = fmaf(a.x, x28, s0);
    s1 = fmaf(a.y, x29, s1);
    s2 = fmaf(a.z, x30, s2);
    s3 = fmaf(a.w, x31, s3);
    a = *(const LAS f32x4*)(Am + 3024);
    s0 = fmaf(a.x, x32, s0);
    s1 = fmaf(a.y, x33, s1);
    s2 = fmaf(a.z, x34, s2);
    s3 = fmaf(a.w, x35, s3);
    a = *(const LAS f32x4*)(Am + 3028);
    s0 = fmaf(a.x, x36, s0);
    s1 = fmaf(a.y, x37, s1);
    s2 = fmaf(a.z, x38, s2);
    s3 = fmaf(a.w, x39, s3);
    a = *(const LAS f32x4*)(Am + 3032);
    s0 = fmaf(a.x, x40, s0);
    s1 = fmaf(a.y, x41, s1);
    s2 = fmaf(a.z, x42, s2);
    const float al44 = a.w;
    x44 = (x44 - ((s0 + s1) + (s2 + s3))) - al44 * x43;
    Tu[5984 + c] = f2bf(x44 * su); Tw[5984 + c] = f2bf(x44 * sw); asm volatile("" ::: "memory");
    float x45 = fmaxf(0.0f, 1.0f - fabsf(cf - 45.0f));
    s0 = 0.f; s1 = 0.f; s2 = 0.f; s3 = 0.f;
    a = *(const LAS f32x4*)(Am + 3060);
    s0 = fmaf(a.x, x0, s0);
    s1 = fmaf(a.y, x1, s1);
    s2 = fmaf(a.z, x2, s2);
    s3 = fmaf(a.w, x3, s3);
    a = *(const LAS f32x4*)(Am + 3064);
    s0 = fmaf(a.x, x4, s0);
    s1 = fmaf(a.y, x5, s1);
    s2 = fmaf(a.z, x6, s2);
    s3 = fmaf(a.w, x7, s3);
    a = *(const LAS f32x4*)(Am + 3068);
    s0 = fmaf(a.x, x8, s0);
    s1 = fmaf(a.y, x9, s1);
    s2 = fmaf(a.z, x10, s2);
    s3 = fmaf(a.w, x11, s3);
    a = *(const LAS f32x4*)(Am + 3072);
    s0 = fmaf(a.x, x12, s0);
    s1 = fmaf(a.y, x13, s1);
    s2 = fmaf(a.z, x14, s2);
    s3 = fmaf(a.w, x15, s3);
    a = *(const LAS f32x4*)(Am + 3076);
    s0 = fmaf(a.x, x16, s0);
    s1 = fmaf(a.y, x17, s1);
    s2 = fmaf(a.z, x18, s2);
    s3 = fmaf(a.w, x19, s3);
    a = *(const LAS f32x4*)(Am + 3080);
    s0 = fmaf(a.x, x20, s0);
    s1 = fmaf(a.y, x21, s1);
    s2 = fmaf(a.z, x22, s2);
    s3 = fmaf(a.w, x23, s3);
    a = *(const LAS f32x4*)(Am + 3084);
    s0 = fmaf(a.x, x24, s0);
    s1 = fmaf(a.y, x25, s1);
    s2 = fmaf(a.z, x26, s2);
    s3 = fmaf(a.w, x27, s3);
    a = *(const LAS f32x4*)(Am + 3088);
    s0 = fmaf(a.x, x28, s0);
    s1 = fmaf(a.y, x29, s1);
    s2 = fmaf(a.z, x30, s2);
    s3 = fmaf(a.w, x31, s3);
    a = *(const LAS f32x4*)(Am + 3092);
    s0 = fmaf(a.x, x32, s0);
    s1 = fmaf(a.y, x33, s1);
    s2 = fmaf(a.z, x34, s2);
    s3 = fmaf(a.w, x35, s3);
    a = *(const LAS f32x4*)(Am + 3096);
    s0 = fmaf(a.x, x36, s0);
    s1 = fmaf(a.y, x37, s1);
    s2 = fmaf(a.z, x38, s2);
    s3 = fmaf(a.w, x39, s3);
    a = *(const LAS f32x4*)(Am + 3100);
    s0 = fmaf(a.x, x40, s0);
    s1 = fmaf(a.y, x41, s1);
    s2 = fmaf(a.z, x42, s2);
    s3 = fmaf(a.w, x43, s3);
    a = *(const LAS f32x4*)(Am + 3104);
    const float al45 = a.x;
    x45 = (x45 - ((s0 + s1) + (s2 + s3))) - al45 * x44;
    Tu[6120 + c] = f2bf(x45 * su); Tw[6120 + c] = f2bf(x45 * sw); asm volatile("" ::: "memory");
    float x46 = fmaxf(0.0f, 1.0f - fabsf(cf - 46.0f));
    s0 = 0.f; s1 = 0.f; s2 = 0.f; s3 = 0.f;
    a = *(const LAS f32x4*)(Am + 3128);
    s0 = fmaf(a.x, x0, s0);
    s1 = fmaf(a.y, x1, s1);
    s2 = fmaf(a.z, x2, s2);
    s3 = fmaf(a.w, x3, s3);
    a = *(const LAS f32x4*)(Am + 3132);
    s0 = fmaf(a.x, x4, s0);
    s1 = fmaf(a.y, x5, s1);
    s2 = fmaf(a.z, x6, s2);
    s3 = fmaf(a.w, x7, s3);
    a = *(const LAS f32x4*)(Am + 3136);
    s0 = fmaf(a.x, x8, s0);
    s1 = fmaf(a.y, x9, s1);
    s2 = fmaf(a.z, x10, s2);
    s3 = fmaf(a.w, x11, s3);
    a = *(const LAS f32x4*)(Am + 3140);
    s0 = fmaf(a.x, x12, s0);
    s1 = fmaf(a.y, x13, s1);
    s2 = fmaf(a.z, x14, s2);
    s3 = fmaf(a.w, x15, s3);
    a = *(const LAS f32x4*)(Am + 3144);
    s0 = fmaf(a.x, x16, s0);
    s1 = fmaf(a.y, x17, s1);
    s2 = fmaf(a.z, x18, s2);
    s3 = fmaf(a.w, x19, s3);
    a = *(const LAS f32x4*)(Am + 3148);
    s0 = fmaf(a.x, x20, s0);
    s1 = fmaf(a.y, x21, s1);
    s2 = fmaf(a.z, x22, s2);
    s3 = fmaf(a.w, x23, s3);
    a = *(const LAS f32x4*)(Am + 3152);
    s0 = fmaf(a.x, x24, s0);
    s1 = fmaf(a.y, x25, s1);
    s2 = fmaf(a.z, x26, s2);
    s3 = fmaf(a.w, x27, s3);
    a = *(const LAS f32x4*)(Am + 3156);
    s0 = fmaf(a.x, x28, s0);
    s1 = fmaf(a.y, x29, s1);
    s2 = fmaf(a.z, x30, s2);
    s3 = fmaf(a.w, x31, s3);
    a = *(const LAS f32x4*)(Am + 3160);
    s0 = fmaf(a.x, x32, s0);
    s1 = fmaf(a.y, x33, s1);
    s2 = fmaf(a.z, x34, s2);
    s3 = fmaf(a.w, x35, s3);
    a = *(const LAS f32x4*)(Am + 3164);
    s0 = fmaf(a.x, x36, s0);
    s1 = fmaf(a.y, x37, s1);
    s2 = fmaf(a.z, x38, s2);
    s3 = fmaf(a.w, x39, s3);
    a = *(const LAS f32x4*)(Am + 3168);
    s0 = fmaf(a.x, x40, s0);
    s1 = fmaf(a.y, x41, s1);
    s2 = fmaf(a.z, x42, s2);
    s3 = fmaf(a.w, x43, s3);
    a = *(const LAS f32x4*)(Am + 3172);
    s0 = fmaf(a.x, x44, s0);
    const float al46 = a.y;
    x46 = (x46 - ((s0 + s1) + (s2 + s3))) - al46 * x45;
    Tu[6256 + c] = f2bf(x46 * su); Tw[6256 + c] = f2bf(x46 * sw); asm volatile("" ::: "memory");
    float x47 = fmaxf(0.0f, 1.0f - fabsf(cf - 47.0f));
    s0 = 0.f; s1 = 0.f; s2 = 0.f; s3 = 0.f;
    a = *(const LAS f32x4*)(Am + 3196);
    s0 = fmaf(a.x, x0, s0);
    s1 = fmaf(a.y, x1, s1);
    s2 = fmaf(a.z, x2, s2);
    s3 = fmaf(a.w, x3, s3);
    a = *(const LAS f32x4*)(Am + 3200);
    s0 = fmaf(a.x, x4, s0);
    s1 = fmaf(a.y, x5, s1);
    s2 = fmaf(a.z, x6, s2);
    s3 = fmaf(a.w, x7, s3);
    a = *(const LAS f32x4*)(Am + 3204);
    s0 = fmaf(a.x, x8, s0);
    s1 = fmaf(a.y, x9, s1);
    s2 = fmaf(a.z, x10, s2);
    s3 = fmaf(a.w, x11, s3);
    a = *(const LAS f32x4*)(Am + 3208);
    s0 = fmaf(a.x, x12, s0);
    s1 = fmaf(a.y, x13, s1);
    s2 = fmaf(a.z, x14, s2);
    s3 = fmaf(a.w, x15, s3);
    a = *(const LAS f32x4*)(Am + 3212);
    s0 = fmaf(a.x, x16, s0);
    s1 = fmaf(a.y, x17, s1);
    s2 = fmaf(a.z, x18, s2);
    s3 = fmaf(a.w, x19, s3);
    a = *(const LAS f32x4*)(Am + 3216);
    s0 = fmaf(a.x, x20, s0);
    s1 = fmaf(a.y, x21, s1);
    s2 = fmaf(a.z, x22, s2);
    s3 = fmaf(a.w, x23, s3);
    a = *(const LAS f32x4*)(Am + 3220);
    s0 = fmaf(a.x, x24, s0);
    s1 = fmaf(a.y, x25, s1);
    s2 = fmaf(a.z, x26, s2);
    s3 = fmaf(a.w, x27, s3);
    a = *(const LAS f32x4*)(Am + 3224);
    s0 = fmaf(a.x, x28, s0);
    s1 = fmaf(a.y, x29, s1);
    s2 = fmaf(a.z, x30, s2);
    s3 = fmaf(a.w, x31, s3);
    a = *(const LAS f32x4*)(Am + 3228);
    s0 = fmaf(a.x, x32, s0);
    s1 = fmaf(a.y, x33, s1);
    s2 = fmaf(a.z, x34, s2);
    s3 = fmaf(a.w, x35, s3);
    a = *(const LAS f32x4*)(Am + 3232);
    s0 = fmaf(a.x, x36, s0);
    s1 = fmaf(a.y, x37, s1);
    s2 = fmaf(a.z, x38, s2);
    s3 = fmaf(a.w, x39, s3);
    a = *(const LAS f32x4*)(Am + 3236);
    s0 = fmaf(a.x, x40, s0);
    s1 = fmaf(a.y, x41, s1);
    s2 = fmaf(a.z, x42, s2);
    s3 = fmaf(a.w, x43, s3);
    a = *(const LAS f32x4*)(Am + 3240);
    s0 = fmaf(a.x, x44, s0);
    s1 = fmaf(a.y, x45, s1);
    const float al47 = a.z;
    x47 = (x47 - ((s0 + s1) + (s2 + s3))) - al47 * x46;
    Tu[6392 + c] = f2bf(x47 * su); Tw[6392 + c] = f2bf(x47 * sw); asm volatile("" ::: "memory");
    float x48 = fmaxf(0.0f, 1.0f - fabsf(cf - 48.0f));
    s0 = 0.f; s1 = 0.f; s2 = 0.f; s3 = 0.f;
    a = *(const LAS f32x4*)(Am + 3264);
    s0 = fmaf(a.x, x0, s0);
    s1 = fmaf(a.y, x1, s1);
    s2 = fmaf(a.z, x2, s2);
    s3 = fmaf(a.w, x3, s3);
    a = *(const LAS f32x4*)(Am + 3268);
    s0 = fmaf(a.x, x4, s0);
    s1 = fmaf(a.y, x5, s1);
    s2 = fmaf(a.z, x6, s2);
    s3 = fmaf(a.w, x7, s3);
    a = *(const LAS f32x4*)(Am + 3272);
    s0 = fmaf(a.x, x8, s0);
    s1 = fmaf(a.y, x9, s1);
    s2 = fmaf(a.z, x10, s2);
    s3 = fmaf(a.w, x11, s3);
    a = *(const LAS f32x4*)(Am + 3276);
    s0 = fmaf(a.x, x12, s0);
    s1 = fmaf(a.y, x13, s1);
    s2 = fmaf(a.z, x14, s2);
    s3 = fmaf(a.w, x15, s3);
    a = *(const LAS f32x4*)(Am + 3280);
    s0 = fmaf(a.x, x16, s0);
    s1 = fmaf(a.y, x17, s1);
    s2 = fmaf(a.z, x18, s2);
    s3 = fmaf(a.w, x19, s3);
    a = *(const LAS f32x4*)(Am + 3284);
    s0 = fmaf(a.x, x20, s0);
    s1 = fmaf(a.y, x21, s1);
    s2 = fmaf(a.z, x22, s2);
    s3 = fmaf(a.w, x23, s3);
    a = *(const LAS f32x4*)(Am + 3288);
    s0 = fmaf(a.x, x24, s0);
    s1 = fmaf(a.y, x25, s1);
    s2 = fmaf(a.z, x26, s2);
    s3 = fmaf(a.w, x27, s3);
    a = *(const LAS f32x4*)(Am + 3292);
    s0 = fmaf(a.x, x28, s0);
    s1 = fmaf(a.y, x29, s1);
    s2 = fmaf(a.z, x30, s2);
    s3 = fmaf(a.w, x31, s3);
    a = *(const LAS f32x4*)(Am + 3296);
    s0 = fmaf(a.x, x32, s0);
    s1 = fmaf(a.y, x33, s1);
    s2 = fmaf(a.z, x34, s2);
    s3 = fmaf(a.w, x35, s3);
    a = *(const LAS f32x4*)(Am + 3300);
    s0 = fmaf(a.x, x36, s0);
    s1 = fmaf(a.y, x37, s1);
    s2 = fmaf(a.z, x38, s2);
    s3 = fmaf(a.w, x39, s3);
    a = *(const LAS f32x4*)(Am + 3304);
    s0 = fmaf(a.x, x40, s0);
    s1 = fmaf(a.y, x41, s1);
    s2 = fmaf(a.z, x42, s2);
    s3 = fmaf(a.w, x43, s3);
    a = *(const LAS f32x4*)(Am + 3308);
    s0 = fmaf(a.x, x44, s0);
    s1 = fmaf(a.y, x45, s1);
    s2 = fmaf(a.z, x46, s2);
    const float al48 = a.w;
    x48 = (x48 - ((s0 + s1) + (s2 + s3))) - al48 * x47;
    Tu[6528 + c] = f2bf(x48 * su); Tw[6528 + c] = f2bf(x48 * sw); asm volatile("" ::: "memory");
    float x49 = fmaxf(0.0f, 1.0f - fabsf(cf - 49.0f));
    s0 = 0.f; s1 = 0.f; s2 = 0.f; s3 = 0.f;
    a = *(const LAS f32x4*)(Am + 3332);
    s0 = fmaf(a.x, x0, s0);
    s1 = fmaf(a.y, x1, s1);
    s2 = fmaf(a.z, x2, s2);
    s3 = fmaf(a.w, x3, s3);
    a = *(const LAS f32x4*)(Am + 3336);
    s0 = fmaf(a.x, x4, s0);
    s1 = fmaf(a.y, x5, s1);
    s2 = fmaf(a.z, x6, s2);
    s3 = fmaf(a.w, x7, s3);
    a = *(const LAS f32x4*)(Am + 3340);
    s0 = fmaf(a.x, x8, s0);
    s1 = fmaf(a.y, x9, s1);
    s2 = fmaf(a.z, x10, s2);
    s3 = fmaf(a.w, x11, s3);
    a = *(const LAS f32x4*)(Am + 3344);
    s0 = fmaf(a.x, x12, s0);
    s1 = fmaf(a.y, x13, s1);
    s2 = fmaf(a.z, x14, s2);
    s3 = fmaf(a.w, x15, s3);
    a = *(const LAS f32x4*)(Am + 3348);
    s0 = fmaf(a.x, x16, s0);
    s1 = fmaf(a.y, x17, s1);
    s2 = fmaf(a.z, x18, s2);
    s3 = fmaf(a.w, x19, s3);
    a = *(const LAS f32x4*)(Am + 3352);
    s0 = fmaf(a.x, x20, s0);
    s1 = fmaf(a.y, x21, s1);
    s2 = fmaf(a.z, x22, s2);
    s3 = fmaf(a.w, x23, s3);
    a = *(const LAS f32x4*)(Am + 3356);
    s0 = fmaf(a.x, x24, s0);
    s1 = fmaf(a.y, x25, s1);
    s2 = fmaf(a.z, x26, s2);
    s3 = fmaf(a.w, x27, s3);
    a = *(const LAS f32x4*)(Am + 3360);
    s0 = fmaf(a.x, x28, s0);
    s1 = fmaf(a.y, x29, s1);
    s2 = fmaf(a.z, x30, s2);
    s3 = fmaf(a.w, x31, s3);
    a = *(const LAS f32x4*)(Am + 3364);
    s0 = fmaf(a.x, x32, s0);
    s1 = fmaf(a.y, x33, s1);
    s2 = fmaf(a.z, x34, s2);
    s3 = fmaf(a.w, x35, s3);
    a = *(const LAS f32x4*)(Am + 3368);
    s0 = fmaf(a.x, x36, s0);
    s1 = fmaf(a.y, x37, s1);
    s2 = fmaf(a.z, x38, s2);
    s3 = fmaf(a.w, x39, s3);
    a = *(const LAS f32x4*)(Am + 3372);
    s0 = fmaf(a.x, x40, s0);
    s1 = fmaf(a.y, x41, s1);
    s2 = fmaf(a.z, x42, s2);
    s3 = fmaf(a.w, x43, s3);
    a = *(const LAS f32x4*)(Am + 3376);
    s0 = fmaf(a.x, x44, s0);
    s1 = fmaf(a.y, x45, s1);
    s2 = fmaf(a.z, x46, s2);
    s3 = fmaf(a.w, x47, s3);
    a = *(const LAS f32x4*)(Am + 3380);
    const float al49 = a.x;
    x49 = (x49 - ((s0 + s1) + (s2 + s3))) - al49 * x48;
    Tu[6664 + c] = f2bf(x49 * su); Tw[6664 + c] = f2bf(x49 * sw); asm volatile("" ::: "memory");
    float x50 = fmaxf(0.0f, 1.0f - fabsf(cf - 50.0f));
    s0 = 0.f; s1 = 0.f; s2 = 0.f; s3 = 0.f;
    a = *(const LAS f32x4*)(Am + 3400);
    s0 = fmaf(a.x, x0, s0);
    s1 = fmaf(a.y, x1, s1);
    s2 = fmaf(a.z, x2, s2);
    s3 = fmaf(a.w, x3, s3);
    a = *(const LAS f32x4*)(Am + 3404);
    s0 = fmaf(a.x, x4, s0);
    s1 = fmaf(a.y, x5, s1);
    s2 = fmaf(a.z, x6, s2);
    s3 = fmaf(a.w, x7, s3);
    a = *(const LAS f32x4*)(Am + 3408);
    s0 = fmaf(a.x, x8, s0);
    s1 = fmaf(a.y, x9, s1);
    s2 = fmaf(a.z, x10, s2);
    s3 = fmaf(a.w, x11, s3);
    a = *(const LAS f32x4*)(Am + 3412);
    s0 = fmaf(a.x, x12, s0);
    s1 = fmaf(a.y, x13, s1);
    s2 = fmaf(a.z, x14, s2);
    s3 = fmaf(a.w, x15, s3);
    a = *(const LAS f32x4*)(Am + 3416);
    s0 = fmaf(a.x, x16, s0);
    s1 = fmaf(a.y, x17, s1);
    s2 = fmaf(a.z, x18, s2);
    s3 = fmaf(a.w, x19, s3);
    a = *(const LAS f32x4*)(Am + 3420);
    s0 = fmaf(a.x, x20, s0);
    s1 = fmaf(a.y, x21, s1);
    s2 = fmaf(a.z, x22, s2);
    s3 = fmaf(a.w, x23, s3);
    a = *(const LAS f32x4*)(Am + 3424);
    s0 = fmaf(a.x, x24, s0);
    s1 = fmaf(a.y, x25, s1);
    s2 = fmaf(a.z, x26, s2);
    s3 = fmaf(a.w, x27, s3);
    a = *(const LAS f32x4*)(Am + 3428);
    s0 = fmaf(a.x, x28, s0);
    s1 = fmaf(a.y, x29, s1);
    s2 = fmaf(a.z, x30, s2);
    s3 = fmaf(a.w, x31, s3);
    a = *(const LAS f32x4*)(Am + 3432);
    s0 = fmaf(a.x, x32, s0);
    s1 = fmaf(a.y, x33, s1);
    s2 = fmaf(a.z, x34, s2);
    s3 = fmaf(a.w, x35, s3);
    a = *(const LAS f32x4*)(Am + 3436);
    s0 = fmaf(a.x, x36, s0);
    s1 = fmaf(a.y, x37, s1);
    s2 = fmaf(a.z, x38, s2);
    s3 = fmaf(a.w, x39, s3);
    a = *(const LAS f32x4*)(Am + 3440);
    s0 = fmaf(a.x, x40, s0);
    s1 = fmaf(a.y, x41, s1);
    s2 = fmaf(a.z, x42, s2);
    s3 = fmaf(a.w, x43, s3);
    a = *(const LAS f32x4*)(Am + 3444);
    s0 = fmaf(a.x, x44, s0);
    s1 = fmaf(a.y, x45, s1);
    s2 = fmaf(a.z, x46, s2);
    s3 = fmaf(a.w, x47, s3);
    a = *(const LAS f32x4*)(Am + 3448);
    s0 = fmaf(a.x, x48, s0);
    const float al50 = a.y;
    x50 = (x50 - ((s0 + s1) + (s2 + s3))) - al50 * x49;
    Tu[6800 + c] = f2bf(x50 * su); Tw[6800 + c] = f2bf(x50 * sw); asm volatile("" ::: "memory");
    float x51 = fmaxf(0.0f, 1.0f - fabsf(cf - 51.0f));
    s0 = 0.f; s1 = 0.f; s2 = 0.f; s3 = 0.f;
    a = *(const LAS f32x4*)(Am + 3468);
    s0 = fmaf(a.x, x0, s0);
    s1 = fmaf(a.y, x1, s1);
    s2 = fmaf(a.z, x2, s2);
    s3 = fmaf(a.w, x3, s3);
    a = *(const LAS f32x4*)(Am + 3472);
    s0 = fmaf(a.x, x4, s0);
    s1 = fmaf(a.y, x5, s1);
    s2 = fmaf(a.z, x6, s2);
    s3 = fmaf(a.w, x7, s3);
    a = *(const LAS f32x4*)(Am + 3476);
    s0 = fmaf(a.x, x8, s0);
    s1 = fmaf(a.y, x9, s1);
    s2 = fmaf(a.z, x10, s2);
    s3 = fmaf(a.w, x11, s3);
    a = *(const LAS f32x4*)(Am + 3480);
    s0 = fmaf(a.x, x12, s0);
    s1 = fmaf(a.y, x13, s1);
    s2 = fmaf(a.z, x14, s2);
    s3 = fmaf(a.w, x15, s3);
    a = *(const LAS f32x4*)(Am + 3484);
    s0 = fmaf(a.x, x16, s0);
    s1 = fmaf(a.y, x17, s1);
    s2 = fmaf(a.z, x18, s2);
    s3 = fmaf(a.w, x19, s3);
    a = *(const LAS f32x4*)(Am + 3488);
    s0 = fmaf(a.x, x20, s0);
    s1 = fmaf(a.y, x21, s1);
    s2 = fmaf(a.z, x22, s2);
    s3 = fmaf(a.w, x23, s3);
    a = *(const LAS f32x4*)(Am + 3492);
    s0 = fmaf(a.x, x24, s0);
    s1 = fmaf(a.y, x25, s1);
    s2 = fmaf(a.z, x26, s2);
    s3 = fmaf(a.w, x27, s3);
    a = *(const LAS f32x4*)(Am + 3496);
    s0 = fmaf(a.x, x28, s0);
    s1 = fmaf(a.y, x29, s1);
    s2 = fmaf(a.z, x30, s2);
    s3 = fmaf(a.w, x31, s3);
    a = *(const LAS f32x4*)(Am + 3500);
    s0 = fmaf(a.x, x32, s0);
    s1 = fmaf(a.y, x33, s1);
    s2 = fmaf(a.z, x34, s2);
    s3 = fmaf(a.w, x35, s3);
    a = *(const LAS f32x4*)(Am + 3504);
    s0 = fmaf(a.x, x36, s0);
    s1 = fmaf(a.y, x37, s1);
    s2 = fmaf(a.z, x38, s2);
    s3 = fmaf(a.w, x39, s3);
    a = *(const LAS f32x4*)(Am + 3508);
    s0 = fmaf(a.x, x40, s0);
    s1 = fmaf(a.y, x41, s1);
    s2 = fmaf(a.z, x42, s2);
    s3 = fmaf(a.w, x43, s3);
    a = *(const LAS f32x4*)(Am + 3512);
    s0 = fmaf(a.x, x44, s0);
    s1 = fmaf(a.y, x45, s1);
    s2 = fmaf(a.z, x46, s2);
    s3 = fmaf(a.w, x47, s3);
    a = *(const LAS f32x4*)(Am + 3516);
    s0 = fmaf(a.x, x48, s0);
    s1 = fmaf(a.y, x49, s1);
    const float al51 = a.z;
    x51 = (x51 - ((s0 + s1) + (s2 + s3))) - al51 * x50;
    Tu[6936 + c] = f2bf(x51 * su); Tw[6936 + c] = f2bf(x51 * sw); asm volatile("" ::: "memory");
    float x52 = fmaxf(0.0f, 1.0f - fabsf(cf - 52.0f));
    s0 = 0.f; s1 = 0.f; s2 = 0.f; s3 = 0.f;
    a = *(const LAS f32x4*)(Am + 3536);
    s0 = fmaf(a.x, x0, s0);
    s1 = fmaf(a.y, x1, s1);
    s2 = fmaf(a.z, x2, s2);
    s3 = fmaf(a.w, x3, s3);
    a = *(const LAS f32x4*)(Am + 3540);
    s0 = fmaf(a.x, x4, s0);
    s1 = fmaf(a.y, x5, s1);
    s2 = fmaf(a.z, x6, s2);
    s3 = fmaf(a.w, x7, s3);
    a = *(const LAS f32x4*)(Am + 3544);
    s0 = fmaf(a.x, x8, s0);
    s1 = fmaf(a.y, x9, s1);
    s2 = fmaf(a.z, x10, s2);
    s3 = fmaf(a.w, x11, s3);
    a = *(const LAS f32x4*)(Am + 3548);
    s0 = fmaf(a.x, x12, s0);
    s1 = fmaf(a.y, x13, s1);
    s2 = fmaf(a.z, x14, s2);
    s3 = fmaf(a.w, x15, s3);
    a = *(const LAS f32x4*)(Am + 3552);
    s0 = fmaf(a.x, x16, s0);
    s1 = fmaf(a.y, x17, s1);
    s2 = fmaf(a.z, x18, s2);
    s3 = fmaf(a.w, x19, s3);
    a = *(const LAS f32x4*)(Am + 3556);
    s0 = fmaf(a.x, x20, s0);
    s1 = fmaf(a.y, x21, s1);
    s2 = fmaf(a.z, x22, s2);
    s3 = fmaf(a.w, x23, s3);
    a = *(const LAS f32x4*)(Am + 3560);
    s0 = fmaf(a.x, x24, s0);
    s1 = fmaf(a.y, x25, s1);
    s2 = fmaf(a.z, x26, s2);
    s3 = fmaf(a.w, x27, s3);
    a = *(const LAS f32x4*)(Am + 3564);
    s0 = fmaf(a.x, x28, s0);
    s1 = fmaf(a.y, x29, s1);
    s2 = fmaf(a.z, x30, s2);
    s3 = fmaf(a.w, x31, s3);
    a = *(const LAS f32x4*)(Am + 3568);
    s0 = fmaf(a.x, x32, s0);
    s1 = fmaf(a.y, x33, s1);
    s2 = fmaf(a.z, x34, s2);
    s3 = fmaf(a.w, x35, s3);
    a = *(const LAS f32x4*)(Am + 3572);
    s0 = fmaf(a.x, x36, s0);
    s1 = fmaf(a.y, x37, s1);
    s2 = fmaf(a.z, x38, s2);
    s3 = fmaf(a.w, x39, s3);
    a = *(const LAS f32x4*)(Am + 3576);
    s0 = fmaf(a.x, x40, s0);
    s1 = fmaf(a.y, x41, s1);
    s2 = fmaf(a.z, x42, s2);
    s3 = fmaf(a.w, x43, s3);
    a = *(const LAS f32x4*)(Am + 3580);
    s0 = fmaf(a.x, x44, s0);
    s1 = fmaf(a.y, x45, s1);
    s2 = fmaf(a.z, x46, s2);
    s3 = fmaf(a.w, x47, s3);
    a = *(const LAS f32x4*)(Am + 3584);
    s0 = fmaf(a.x, x48, s0);
    s1 = fmaf(a.y, x49, s1);
    s2 = fmaf(a.z, x50, s2);
    const float al52 = a.w;
    x52 = (x52 - ((s0 + s1) + (s2 + s3))) - al52 * x51;
    Tu[7072 + c] = f2bf(x52 * su); Tw[7072 + c] = f2bf(x52 * sw); asm volatile("" ::: "memory");
    float x53 = fmaxf(0.0f, 1.0f - fabsf(cf - 53.0f));
    s0 = 0.f; s1 = 0.f; s2 = 0.f; s3 = 0.f;
    a = *(const LAS f32x4*)(Am + 3604);
    s0 = fmaf(a.x, x0, s0);
    s1 = fmaf(a.y, x1, s1);
    s2 = fmaf(a.z, x2, s2);
    s3 = fmaf(a.w, x3, s3);
    a = *(const LAS f32x4*)(Am + 3608);
    s0 = fmaf(a.x, x4, s0);
    s1 = fmaf(a.y, x5, s1);
    s2 = fmaf(a.z, x6, s2);
    s3 = fmaf(a.w, x7, s3);
    a = *(const LAS f32x4*)(Am + 3612);
    s0 = fmaf(a.x, x8, s0);
    s1 = fmaf(a.y, x9, s1);
    s2 = fmaf(a.z, x10, s2);
    s3 = fmaf(a.w, x11, s3);
    a = *(const LAS f32x4*)(Am + 3616);
    s0 = fmaf(a.x, x12, s0);
    s1 = fmaf(a.y, x13, s1);
    s2 = fmaf(a.z, x14, s2);
    s3 = fmaf(a.w, x15, s3);
    a = *(const LAS f32x4*)(Am + 3620);
    s0 = fmaf(a.x, x16, s0);
    s1 = fmaf(a.y, x17, s1);
    s2 = fmaf(a.z, x18, s2);
    s3 = fmaf(a.w, x19, s3);
    a = *(const LAS f32x4*)(Am + 3624);
    s0 = fmaf(a.x, x20, s0);
    s1 = fmaf(a.y, x21, s1);
    s2 = fmaf(a.z, x22, s2);
    s3 = fmaf(a.w, x23, s3);
    a = *(const LAS f32x4*)(Am + 3628);
    s0 = fmaf(a.x, x24, s0);
    s1 = fmaf(a.y, x25, s1);
    s2 = fmaf(a.z, x26, s2);
    s3 = fmaf(a.w, x27, s3);
    a = *(const LAS f32x4*)(Am + 3632);
    s0 = fmaf(a.x, x28, s0);
    s1 = fmaf(a.y, x29, s1);
    s2 = fmaf(a.z, x30, s2);
    s3 = fmaf(a.w, x31, s3);
    a = *(const LAS f32x4*)(Am + 3636);
    s0 = fmaf(a.x, x32, s0);
    s1 = fmaf(a.y, x33, s1);
    s2 = fmaf(a.z, x34, s2);
    s3 = fmaf(a.w, x35, s3);
    a = *(const LAS f32x4*)(Am + 3640);
    s0 = fmaf(a.x, x36, s0);
    s1 = fmaf(a.y, x37, s1);
    s2 = fmaf(a.z, x38, s2);
    s3 = fmaf(a.w, x39, s3);
    a = *(const LAS f32x4*)(Am + 3644);
    s0 = fmaf(a.x, x40, s0);
    s1 = fmaf(a.y, x41, s1);
    s2 = fmaf(a.z, x42, s2);
    s3 = fmaf(a.w, x43, s3);
    a = *(const LAS f32x4*)(Am + 3648);
    s0 = fmaf(a.x, x44, s0);
    s1 = fmaf(a.y, x45, s1);
    s2 = fmaf(a.z, x46, s2);
    s3 = fmaf(a.w, x47, s3);
    a = *(const LAS f32x4*)(Am + 3652);
    s0 = fmaf(a.x, x48, s0);
    s1 = fmaf(a.y, x49, s1);
    s2 = fmaf(a.z, x50, s2);
    s3 = fmaf(a.w, x51, s3);
    a = *(const LAS f32x4*)(Am + 3656);
    const float al53 = a.x;
    x53 = (x53 - ((s0 + s1) + (s2 + s3))) - al53 * x52;
    Tu[7208 + c] = f2bf(x53 * su); Tw[7208 + c] = f2bf(x53 * sw); asm volatile("" ::: "memory");
    float x54 = fmaxf(0.0f, 1.0f - fabsf(cf - 54.0f));
    s0 = 0.f; s1 = 0.f; s2 = 0.f; s3 = 0.f;
    a = *(const LAS f32x4*)(Am + 3672);
    s0 = fmaf(a.x, x0, s0);
    s1 = fmaf(a.y, x1, s1);
    s2 = fmaf(a.z, x2, s2);
    s3 = fmaf(a.w, x3, s3);
    a = *(const LAS f32x4*)(Am + 3676);
    s0 = fmaf(a.x, x4, s0);
    s1 = fmaf(a.y, x5, s1);
    s2 = fmaf(a.z, x6, s2);
    s3 = fmaf(a.w, x7, s3);
    a = *(const LAS f32x4*)(Am + 3680);
    s0 = fmaf(a.x, x8, s0);
    s1 = fmaf(a.y, x9, s1);
    s2 = fmaf(a.z, x10, s2);
    s3 = fmaf(a.w, x11, s3);
    a = *(const LAS f32x4*)(Am + 3684);
    s0 = fmaf(a.x, x12, s0);
    s1 = fmaf(a.y, x13, s1);
    s2 = fmaf(a.z, x14, s2);
    s3 = fmaf(a.w, x15, s3);
    a = *(const LAS f32x4*)(Am + 3688);
    s0 = fmaf(a.x, x16, s0);
    s1 = fmaf(a.y, x17, s1);
    s2 = fmaf(a.z, x18, s2);
    s3 = fmaf(a.w, x19, s3);
    a = *(const LAS f32x4*)(Am + 3692);
    s0 = fmaf(a.x, x20, s0);
    s1 = fmaf(a.y, x21, s1);
    s2 = fmaf(a.z, x22, s2);
    s3 = fmaf(a.w, x23, s3);
    a = *(const LAS f32x4*)(Am + 3696);
    s0 = fmaf(a.x, x24, s0);
    s1 = fmaf(a.y, x25, s1);
    s2 = fmaf(a.z, x26, s2);
    s3 = fmaf(a.w, x27, s3);
    a = *(const LAS f32x4*)(Am + 3700);
    s0 = fmaf(a.x, x28, s0);
    s1 = fmaf(a.y, x29, s1);
    s2 = fmaf(a.z, x30, s2);
    s3 = fmaf(a.w, x31, s3);
    a = *(const LAS f32x4*)(Am + 3704);
    s0 = fmaf(a.x, x32, s0);
    s1 = fmaf(a.y, x33, s1);
    s2 = fmaf(a.z, x34, s2);
    s3 = fmaf(a.w, x35, s3);
    a = *(const LAS f32x4*)(Am + 3708);
    s0 = fmaf(a.x, x36, s0);
    s1 = fmaf(a.y, x37, s1);
    s2 = fmaf(a.z, x38, s2);
    s3 = fmaf(a.w, x39, s3);
    a = *(const LAS f32x4*)(Am + 3712);
    s0 = fmaf(a.x, x40, s0);
    s1 = fmaf(a.y, x41, s1);
    s2 = fmaf(a.z, x42, s2);
    s3 = fmaf(a.w, x43, s3);
    a = *(const LAS f32x4*)(Am + 3716);
    s0 = fmaf(a.x, x44, s0);
    s1 = fmaf(a.y, x45, s1);
    s2 = fmaf(a.z, x46, s2);
    s3 = fmaf(a.w, x47, s3);
    a = *(const LAS f32x4*)(Am + 3720);
    s0 = fmaf(a.x, x48, s0);
    s1 = fmaf(a.y, x49, s1);
    s2 = fmaf(a.z, x50, s2);
    s3 = fmaf(a.w, x51, s3);
    a = *(const LAS f32x4*)(Am + 3724);
    s0 = fmaf(a.x, x52, s0);
    const float al54 = a.y;
    x54 = (x54 - ((s0 + s1) + (s2 + s3))) - al54 * x53;
    Tu[7344 + c] = f2bf(x54 * su); Tw[7344 + c] = f2bf(x54 * sw); asm volatile("" ::: "memory");
    float x55 = fmaxf(0.0f, 1.0f - fabsf(cf - 55.0f));
    s0 = 0.f; s1 = 0.f; s2 = 0.f; s3 = 0.f;
    a = *(const LAS f32x4*)(Am + 3740);
    s0 = fmaf(a.x, x0, s0);
    s1 = fmaf(a.y, x1, s1);
    s2 = fmaf(a.z, x2, s2);
    s3 = fmaf(a.w, x3, s3);
    a = *(const LAS f32x4*)(Am + 3744);
    s0 = fmaf(a.x, x4, s0);
    s1 = fmaf(a.y, x5, s1);
    s2 = fmaf(a.z, x6, s2);
    s3 = fmaf(a.w, x7, s3);
    a = *(const LAS f32x4*)(Am + 3748);
    s0 = fmaf(a.x, x8, s0);
    s1 = fmaf(a.y, x9, s1);
    s2 = fmaf(a.z, x10, s2);
    s3 = fmaf(a.w, x11, s3);
    a = *(const LAS f32x4*)(Am + 3752);
    s0 = fmaf(a.x, x12, s0);
    s1 = fmaf(a.y, x13, s1);
    s2 = fmaf(a.z, x14, s2);
    s3 = fmaf(a.w, x15, s3);
    a = *(const LAS f32x4*)(Am + 3756);
    s0 = fmaf(a.x, x16, s0);
    s1 = fmaf(a.y, x17, s1);
    s2 = fmaf(a.z, x18, s2);
    s3 = fmaf(a.w, x19, s3);
    a = *(const LAS f32x4*)(Am + 3760);
    s0 = fmaf(a.x, x20, s0);
    s1 = fmaf(a.y, x21, s1);
    s2 = fmaf(a.z, x22, s2);
    s3 = fmaf(a.w, x23, s3);
    a = *(const LAS f32x4*)(Am + 3764);
    s0 = fmaf(a.x, x24, s0);
    s1 = fmaf(a.y, x25, s1);
    s2 = fmaf(a.z, x26, s2);
    s3 = fmaf(a.w, x27, s3);
    a = *(const LAS f32x4*)(Am + 3768);
    s0 = fmaf(a.x, x28, s0);
    s1 = fmaf(a.y, x29, s1);
    s2 = fmaf(a.z, x30, s2);
    s3 = fmaf(a.w, x31, s3);
    a = *(const LAS f32x4*)(Am + 3772);
    s0 = fmaf(a.x, x32, s0);
    s1 = fmaf(a.y, x33, s1);
    s2 = fmaf(a.z, x34, s2);
    s3 = fmaf(a.w, x35, s3);
    a = *(const LAS f32x4*)(Am + 3776);
    s0 = fmaf(a.x, x36, s0);
    s1 = fmaf(a.y, x37, s1);
    s2 = fmaf(a.z, x38, s2);
    s3 = fmaf(a.w, x39, s3);
    a = *(const LAS f32x4*)(Am + 3780);
    s0 = fmaf(a.x, x40, s0);
    s1 = fmaf(a.y, x41, s1);
    s2 = fmaf(a.z, x42, s2);
    s3 = fmaf(a.w, x43, s3);
    a = *(const LAS f32x4*)(Am + 3784);
    s0 = fmaf(a.x, x44, s0);
    s1 = fmaf(a.y, x45, s1);
    s2 = fmaf(a.z, x46, s2);
    s3 = fmaf(a.w, x47, s3);
    a = *(const LAS f32x4*)(Am + 3788);
    s0 = fmaf(a.x, x48, s0);
    s1 = fmaf(a.y, x49, s1);
    s2 = fmaf(a.z, x50, s2);
    s3 = fmaf(a.w, x51, s3);
    a = *(const LAS f32x4*)(Am + 3792);
    s0 = fmaf(a.x, x52, s0);
    s1 = fmaf(a.y, x53, s1);
    const float al55 = a.z;
    x55 = (x55 - ((s0 + s1) + (s2 + s3))) - al55 * x54;
    Tu[7480 + c] = f2bf(x55 * su); Tw[7480 + c] = f2bf(x55 * sw); asm volatile("" ::: "memory");
    float x56 = fmaxf(0.0f, 1.0f - fabsf(cf - 56.0f));
    s0 = 0.f; s1 = 0.f; s2 = 0.f; s3 = 0.f;
    a = *(const LAS f32x4*)(Am + 3808);
    s0 = fmaf(a.x, x0, s0);
    s1 = fmaf(a.y, x1, s1);
    s2 = fmaf(a.z, x2, s2);
    s3 = fmaf(a.w, x3, s3);
    a = *(const LAS f32x4*)(Am + 3812);
    s0 = fmaf(a.x, x4, s0);
    s1 = fmaf(a.y, x5, s1);
    s2 = fmaf(a.z, x6, s2);
    s3 = fmaf(a.w, x7, s3);
    a = *(const LAS f32x4*)(Am + 3816);
    s0 = fmaf(a.x, x8, s0);
    s1 = fmaf(a.y, x9, s1);
    s2 = fmaf(a.z, x10, s2);
    s3 = fmaf(a.w, x11, s3);
    a = *(const LAS f32x4*)(Am + 3820);
    s0 = fmaf(a.x, x12, s0);
    s1 = fmaf(a.y, x13, s1);
    s2 = fmaf(a.z, x14, s2);
    s3 = fmaf(a.w, x15, s3);
    a = *(const LAS f32x4*)(Am + 3824);
    s0 = fmaf(a.x, x16, s0);
    s1 = fmaf(a.y, x17, s1);
    s2 = fmaf(a.z, x18, s2);
    s3 = fmaf(a.w, x19, s3);
    a = *(const LAS f32x4*)(Am + 3828);
    s0 = fmaf(a.x, x20, s0);
    s1 = fmaf(a.y, x21, s1);
    s2 = fmaf(a.z, x22, s2);
    s3 = fmaf(a.w, x23, s3);
    a = *(const LAS f32x4*)(Am + 3832);
    s0 = fmaf(a.x, x24, s0);
    s1 = fmaf(a.y, x25, s1);
    s2 = fmaf(a.z, x26, s2);
    s3 = fmaf(a.w, x27, s3);
    a = *(const LAS f32x4*)(Am + 3836);
    s0 = fmaf(a.x, x28, s0);
    s1 = fmaf(a.y, x29, s1);
    s2 = fmaf(a.z, x30, s2);
    s3 = fmaf(a.w, x31, s3);
    a = *(const LAS f32x4*)(Am + 3840);
    s0 = fmaf(a.x, x32, s0);
    s1 = fmaf(a.y, x33, s1);
    s2 = fmaf(a.z, x34, s2);
    s3 = fmaf(a.w, x35, s3);
    a = *(const LAS f32x4*)(Am + 3844);
    s0 = fmaf(a.x, x36, s0);
    s1 = fmaf(a.y, x37, s1);
    s2 = fmaf(a.z, x38, s2);
    s3 = fmaf(a.w, x39, s3);
    a = *(const LAS f32x4*)(Am + 3848);
    s0 = fmaf(a.x, x40, s0);
    s1 = fmaf(a.y, x41, s1);
    s2 = fmaf(a.z, x42, s2);
    s3 = fmaf(a.w, x43, s3);
    a = *(const LAS f32x4*)(Am + 3852);
    s0 = fmaf(a.x, x44, s0);
    s1 = fmaf(a.y, x45, s1);
    s2 = fmaf(a.z, x46, s2);
    s3 = fmaf(a.w, x47, s3);
    a = *(const LAS f32x4*)(Am + 3856);
    s0 = fmaf(a.x, x48, s0);
    s1 = fmaf(a.y, x49, s1);
    s2 = fmaf(a.z, x50, s2);
    s3 = fmaf(a.w, x51, s3);
    a = *(const LAS f32x4*)(Am + 3860);
    s0 = fmaf(a.x, x52, s0);
    s1 = fmaf(a.y, x53, s1);
    s2 = fmaf(a.z, x54, s2);
    const float al56 = a.w;
    x56 = (x56 - ((s0 + s1) + (s2 + s3))) - al56 * x55;
    Tu[7616 + c] = f2bf(x56 * su); Tw[7616 + c] = f2bf(x56 * sw); asm volatile("" ::: "memory");
    float x57 = fmaxf(0.0f, 1.0f - fabsf(cf - 57.0f));
    s0 = 0.f; s1 = 0.f; s2 = 0.f; s3 = 0.f;
    a = *(const LAS f32x4*)(Am + 3876);
    s0 = fmaf(a.x, x0, s0);
    s1 = fmaf(a.y, x1, s1);
    s2 = fmaf(a.z, x2, s2);
    s3 = fmaf(a.w, x3, s3);
    a = *(const LAS f32x4*)(Am + 3880);
    s0 = fmaf(a.x, x4, s0);
    s1 = fmaf(a.y, x5, s1);
    s2 = fmaf(a.z, x6, s2);
    s3 = fmaf(a.w, x7, s3);
    a = *(const LAS f32x4*)(Am + 3884);
    s0 = fmaf(a.x, x8, s0);
    s1 = fmaf(a.y, x9, s1);
    s2 = fmaf(a.z, x10, s2);
    s3 = fmaf(a.w, x11, s3);
    a = *(const LAS f32x4*)(Am + 3888);
    s0 = fmaf(a.x, x12, s0);
    s1 = fmaf(a.y, x13, s1);
    s2 = fmaf(a.z, x14, s2);
    s3 = fmaf(a.w, x15, s3);
    a = *(const LAS f32x4*)(Am + 3892);
    s0 = fmaf(a.x, x16, s0);
    s1 = fmaf(a.y, x17, s1);
    s2 = fmaf(a.z, x18, s2);
    s3 = fmaf(a.w, x19, s3);
    a = *(const LAS f32x4*)(Am + 3896);
    s0 = fmaf(a.x, x20, s0);
    s1 = fmaf(a.y, x21, s1);
    s2 = fmaf(a.z, x22, s2);
    s3 = fmaf(a.w, x23, s3);
    a = *(const LAS f32x4*)(Am + 3900);
    s0 = fmaf(a.x, x24, s0);
    s1 = fmaf(a.y, x25, s1);
    s2 = fmaf(a.z, x26, s2);
    s3 = fmaf(a.w, x27, s3);
    a = *(const LAS f32x4*)(Am + 3904);
    s0 = fmaf(a.x, x28, s0);
    s1 = fmaf(a.y, x29, s1);
    s2 = fmaf(a.z, x30, s2);
    s3 = fmaf(a.w, x31, s3);
    a = *(const LAS f32x4*)(Am + 3908);
    s0 = fmaf(a.x, x32, s0);
    s1 = fmaf(a.y, x33, s1);
    s2 = fmaf(a.z, x34, s2);
    s3 = fmaf(a.w, x35, s3);
    a = *(const LAS f32x4*)(Am + 3912);
    s0 = fmaf(a.x, x36, s0);
    s1 = fmaf(a.y, x37, s1);
    s2 = fmaf(a.z, x38, s2);
    s3 = fmaf(a.w, x39, s3);
    a = *(const LAS f32x4*)(Am + 3916);
    s0 = fmaf(a.x, x40, s0);
    s1 = fmaf(a.y, x41, s1);
    s2 = fmaf(a.z, x42, s2);
    s3 = fmaf(a.w, x43, s3);
    a = *(const LAS f32x4*)(Am + 3920);
    s0 = fmaf(a.x, x44, s0);
    s1 = fmaf(a.y, x45, s1);
    s2 = fmaf(a.z, x46, s2);
    s3 = fmaf(a.w, x47, s3);
    a = *(const LAS f32x4*)(Am + 3924);
    s0 = fmaf(a.x, x48, s0);
    s1 = fmaf(a.y, x49, s1);
    s2 = fmaf(a.z, x50, s2);
    s3 = fmaf(a.w, x51, s3);
    a = *(const LAS f32x4*)(Am + 3928);
    s0 = fmaf(a.x, x52, s0);
    s1 = fmaf(a.y, x53, s1);
    s2 = fmaf(a.z, x54, s2);
    s3 = fmaf(a.w, x55, s3);
    a = *(const LAS f32x4*)(Am + 3932);
    const float al57 = a.x;
    x57 = (x57 - ((s0 + s1) + (s2 + s3))) - al57 * x56;
    Tu[7752 + c] = f2bf(x57 * su); Tw[7752 + c] = f2bf(x57 * sw); asm volatile("" ::: "memory");
    float x58 = fmaxf(0.0f, 1.0f - fabsf(cf - 58.0f));
    s0 = 0.f; s1 = 0.f; s2 = 0.f; s3 = 0.f;
    a = *(const LAS f32x4*)(Am + 3944);
    s0 = fmaf(a.x, x0, s0);
    s1 = fmaf(a.y, x1, s1);
    s2 = fmaf(a.z, x2, s2);
    s3 = fmaf(a.w, x3, s3);
    a = *(const LAS f32x4*)(Am + 3948);
    s0 = fmaf(a.x, x4, s0);
    s1 = fmaf(a.y, x5, s1);
    s2 = fmaf(a.z, x6, s2);
    s3 = fmaf(a.w, x7, s3);
    a = *(const LAS f32x4*)(Am + 3952);
    s0 = fmaf(a.x, x8, s0);
    s1 = fmaf(a.y, x9, s1);
    s2 = fmaf(a.z, x10, s2);
    s3 = fmaf(a.w, x11, s3);
    a = *(const LAS f32x4*)(Am + 3956);
    s0 = fmaf(a.x, x12, s0);
    s1 = fmaf(a.y, x13, s1);
    s2 = fmaf(a.z, x14, s2);
    s3 = fmaf(a.w, x15, s3);
    a = *(const LAS f32x4*)(Am + 3960);
    s0 = fmaf(a.x, x16, s0);
    s1 = fmaf(a.y, x17, s1);
    s2 = fmaf(a.z, x18, s2);
    s3 = fmaf(a.w, x19, s3);
    a = *(const LAS f32x4*)(Am + 3964);
    s0 = fmaf(a.x, x20, s0);
    s1 = fmaf(a.y, x21, s1);
    s2 = fmaf(a.z, x22, s2);
    s3 = fmaf(a.w, x23, s3);
    a = *(const LAS f32x4*)(Am + 3968);
    s0 = fmaf(a.x, x24, s0);
    s1 = fmaf(a.y, x25, s1);
    s2 = fmaf(a.z, x26, s2);
    s3 = fmaf(a.w, x27, s3);
    a = *(const LAS f32x4*)(Am + 3972);
    s0 = fmaf(a.x, x28, s0);
    s1 = fmaf(a.y, x29, s1);
    s2 = fmaf(a.z, x30, s2);
    s3 = fmaf(a.w, x31, s3);
    a = *(const LAS f32x4*)(Am + 3976);
    s0 = fmaf(a.x, x32, s0);
    s1 = fmaf(a.y, x33, s1);
    s2 = fmaf(a.z, x34, s2);
    s3 = fmaf(a.w, x35, s3);
    a = *(const LAS f32x4*)(Am + 3980);
    s0 = fmaf(a.x, x36, s0);
    s1 = fmaf(a.y, x37, s1);
    s2 = fmaf(a.z, x38, s2);
    s3 = fmaf(a.w, x39, s3);
    a = *(const LAS f32x4*)(Am + 3984);
    s0 = fmaf(a.x, x40, s0);
    s1 = fmaf(a.y, x41, s1);
    s2 = fmaf(a.z, x42, s2);
    s3 = fmaf(a.w, x43, s3);
    a = *(const LAS f32x4*)(Am + 3988);
    s0 = fmaf(a.x, x44, s0);
    s1 = fmaf(a.y, x45, s1);
    s2 = fmaf(a.z, x46, s2);
    s3 = fmaf(a.w, x47, s3);
    a = *(const LAS f32x4*)(Am + 3992);
    s0 = fmaf(a.x, x48, s0);
    s1 = fmaf(a.y, x49, s1);
    s2 = fmaf(a.z, x50, s2);
    s3 = fmaf(a.w, x51, s3);
    a = *(const LAS f32x4*)(Am + 3996);
    s0 = fmaf(a.x, x52, s0);
    s1 = fmaf(a.y, x53, s1);
    s2 = fmaf(a.z, x54, s2);
    s3 = fmaf(a.w, x55, s3);
    a = *(const LAS f32x4*)(Am + 4000);
    s0 = fmaf(a.x, x56, s0);
    const float al58 = a.y;
    x58 = (x58 - ((s0 + s1) + (s2 + s3))) - al58 * x57;
    Tu[7888 + c] = f2bf(x58 * su); Tw[7888 + c] = f2bf(x58 * sw); asm volatile("" ::: "memory");
    float x59 = fmaxf(0.0f, 1.0f - fabsf(cf - 59.0f));
    s0 = 0.f; s1 = 0.f; s2 = 0.f; s3 = 0.f;
    a = *(const LAS f32x4*)(Am + 4012);
    s0 = fmaf(a.x, x0, s0);
    s1 = fmaf(a.y, x1, s1);
    s2 = fmaf(a.z, x2, s2);
    s3 = fmaf(a.w, x3, s3);
    a = *(const LAS f32x4*)(Am + 4016);
    s0 = fmaf(a.x, x4, s0);
    s1 = fmaf(a.y, x5, s1);
    s2 = fmaf(a.z, x6, s2);
    s3 = fmaf(a.w, x7, s3);
    a = *(const LAS f32x4*)(Am + 4020);
    s0 = fmaf(a.x, x8, s0);
    s1 = fmaf(a.y, x9, s1);
    s2 = fmaf(a.z, x10, s2);
    s3 = fmaf(a.w, x11, s3);
    a = *(const LAS f32x4*)(Am + 4024);
    s0 = fmaf(a.x, x12, s0);
    s1 = fmaf(a.y, x13, s1);
    s2 = fmaf(a.z, x14, s2);
    s3 = fmaf(a.w, x15, s3);
    a = *(const LAS f32x4*)(Am + 4028);
    s0 = fmaf(a.x, x16, s0);
    s1 = fmaf(a.y, x17, s1);
    s2 = fmaf(a.z, x18, s2);
    s3 = fmaf(a.w, x19, s3);
    a = *(const LAS f32x4*)(Am + 4032);
    s0 = fmaf(a.x, x20, s0);
    s1 = fmaf(a.y, x21, s1);
    s2 = fmaf(a.z, x22, s2);
    s3 = fmaf(a.w, x23, s3);
    a = *(const LAS f32x4*)(Am + 4036);
    s0 = fmaf(a.x, x24, s0);
    s1 = fmaf(a.y, x25, s1);
    s2 = fmaf(a.z, x26, s2);
    s3 = fmaf(a.w, x27, s3);
    a = *(const LAS f32x4*)(Am + 4040);
    s0 = fmaf(a.x, x28, s0);
    s1 = fmaf(a.y, x29, s1);
    s2 = fmaf(a.z, x30, s2);
    s3 = fmaf(a.w, x31, s3);
    a = *(const LAS f32x4*)(Am + 4044);
    s0 = fmaf(a.x, x32, s0);
    s1 = fmaf(a.y, x33, s1);
    s2 = fmaf(a.z, x34, s2);
    s3 = fmaf(a.w, x35, s3);
    a = *(const LAS f32x4*)(Am + 4048);
    s0 = fmaf(a.x, x36, s0);
    s1 = fmaf(a.y, x37, s1);
    s2 = fmaf(a.z, x38, s2);
    s3 = fmaf(a.w, x39, s3);
    a = *(const LAS f32x4*)(Am + 4052);
    s0 = fmaf(a.x, x40, s0);
    s1 = fmaf(a.y, x41, s1);
    s2 = fmaf(a.z, x42, s2);
    s3 = fmaf(a.w, x43, s3);
    a = *(const LAS f32x4*)(Am + 4056);
    s0 = fmaf(a.x, x44, s0);
    s1 = fmaf(a.y, x45, s1);
    s2 = fmaf(a.z, x46, s2);
    s3 = fmaf(a.w, x47, s3);
    a = *(const LAS f32x4*)(Am + 4060);
    s0 = fmaf(a.x, x48, s0);
    s1 = fmaf(a.y, x49, s1);
    s2 = fmaf(a.z, x50, s2);
    s3 = fmaf(a.w, x51, s3);
    a = *(const LAS f32x4*)(Am + 4064);
    s0 = fmaf(a.x, x52, s0);
    s1 = fmaf(a.y, x53, s1);
    s2 = fmaf(a.z, x54, s2);
    s3 = fmaf(a.w, x55, s3);
    a = *(const LAS f32x4*)(Am + 4068);
    s0 = fmaf(a.x, x56, s0);
    s1 = fmaf(a.y, x57, s1);
    const float al59 = a.z;
    x59 = (x59 - ((s0 + s1) + (s2 + s3))) - al59 * x58;
    Tu[8024 + c] = f2bf(x59 * su); Tw[8024 + c] = f2bf(x59 * sw); asm volatile("" ::: "memory");
    float x60 = fmaxf(0.0f, 1.0f - fabsf(cf - 60.0f));
    s0 = 0.f; s1 = 0.f; s2 = 0.f; s3 = 0.f;
    a = *(const LAS f32x4*)(Am + 4080);
    s0 = fmaf(a.x, x0, s0);
    s1 = fmaf(a.y, x1, s1);
    s2 = fmaf(a.z, x2, s2);
    s3 = fmaf(a.w, x3, s3);
    a = *(const LAS f32x4*)(Am + 4084);
    s0 = fmaf(a.x, x4, s0);
    s1 = fmaf(a.y, x5, s1);
    s2 = fmaf(a.z, x6, s2);
    s3 = fmaf(a.w, x7, s3);
    a = *(const LAS f32x4*)(Am + 4088);
    s0 = fmaf(a.x, x8, s0);
    s1 = fmaf(a.y, x9, s1);
    s2 = fmaf(a.z, x10, s2);
    s3 = fmaf(a.w, x11, s3);
    a = *(const LAS f32x4*)(Am + 4092);
    s0 = fmaf(a.x, x12, s0);
    s1 = fmaf(a.y, x13, s1);
    s2 = fmaf(a.z, x14, s2);
    s3 = fmaf(a.w, x15, s3);
    a = *(const LAS f32x4*)(Am + 4096);
    s0 = fmaf(a.x, x16, s0);
    s1 = fmaf(a.y, x17, s1);
    s2 = fmaf(a.z, x18, s2);
    s3 = fmaf(a.w, x19, s3);
    a = *(const LAS f32x4*)(Am + 4100);
    s0 = fmaf(a.x, x20, s0);
    s1 = fmaf(a.y, x21, s1);
    s2 = fmaf(a.z, x22, s2);
    s3 = fmaf(a.w, x23, s3);
    a = *(const LAS f32x4*)(Am + 4104);
    s0 = fmaf(a.x, x24, s0);
    s1 = fmaf(a.y, x25, s1);
    s2 = fmaf(a.z, x26, s2);
    s3 = fmaf(a.w, x27, s3);
    a = *(const LAS f32x4*)(Am + 4108);
    s0 = fmaf(a.x, x28, s0);
    s1 = fmaf(a.y, x29, s1);
    s2 = fmaf(a.z, x30, s2);
    s3 = fmaf(a.w, x31, s3);
    a = *(const LAS f32x4*)(Am + 4112);
    s0 = fmaf(a.x, x32, s0);
    s1 = fmaf(a.y, x33, s1);
    s2 = fmaf(a.z, x34, s2);
    s3 = fmaf(a.w, x35, s3);
    a = *(const LAS f32x4*)(Am + 4116);
    s0 = fmaf(a.x, x36, s0);
    s1 = fmaf(a.y, x37, s1);
    s2 = fmaf(a.z, x38, s2);
    s3 = fmaf(a.w, x39, s3);
    a = *(const LAS f32x4*)(Am + 4120);
    s0 = fmaf(a.x, x40, s0);
    s1 = fmaf(a.y, x41, s1);
    s2 = fmaf(a.z, x42, s2);
    s3 = fmaf(a.w, x43, s3);
    a = *(const LAS f32x4*)(Am + 4124);
    s0 = fmaf(a.x, x44, s0);
    s1 = fmaf(a.y, x45, s1);
    s2 = fmaf(a.z, x46, s2);
    s3 = fmaf(a.w, x47, s3);
    a = *(const LAS f32x4*)(Am + 4128);
    s0 = fmaf(a.x, x48, s0);
    s1 = fmaf(a.y, x49, s1);
    s2 = fmaf(a.z, x50, s2);
    s3 = fmaf(a.w, x51, s3);
    a = *(const LAS f32x4*)(Am + 4132);
    s0 = fmaf(a.x, x52, s0);
    s1 = fmaf(a.y, x53, s1);
    s2 = fmaf(a.z, x54, s2);
    s3 = fmaf(a.w, x55, s3);
    a = *(const LAS f32x4*)(Am + 4136);
    s0 = fmaf(a.x, x56, s0);
    s1 = fmaf(a.y, x57, s1);
    s2 = fmaf(a.z, x58, s2);
    const float al60 = a.w;
    x60 = (x60 - ((s0 + s1) + (s2 + s3))) - al60 * x59;
    Tu[8160 + c] = f2bf(x60 * su); Tw[8160 + c] = f2bf(x60 * sw); asm volatile("" ::: "memory");
    float x61 = fmaxf(0.0f, 1.0f - fabsf(cf - 61.0f));
    s0 = 0.f; s1 = 0.f; s2 = 0.f; s3 = 0.f;
    a = *(const LAS f32x4*)(Am + 4148);
    s0 = fmaf(a.x, x0, s0);
    s1 = fmaf(a.y, x1, s1);
    s2 = fmaf(a.z, x2, s2);
    s3 = fmaf(a.w, x3, s3);
    a = *(const LAS f32x4*)(Am + 4152);
    s0 = fmaf(a.x, x4, s0);
    s1 = fmaf(a.y, x5, s1);
    s2 = fmaf(a.z, x6, s2);
    s3 = fmaf(a.w, x7, s3);
    a = *(const LAS f32x4*)(Am + 4156);
    s0 = fmaf(a.x, x8, s0);
    s1 = fmaf(a.y, x9, s1);
    s2 = fmaf(a.z, x10, s2);
    s3 = fmaf(a.w, x11, s3);
    a = *(const LAS f32x4*)(Am + 4160);
    s0 = fmaf(a.x, x12, s0);
    s1 = fmaf(a.y, x13, s1);
    s2 = fmaf(a.z, x14, s2);
    s3 = fmaf(a.w, x15, s3);
    a = *(const LAS f32x4*)(Am + 4164);
    s0 = fmaf(a.x, x16, s0);
    s1 = fmaf(a.y, x17, s1);
    s2 = fmaf(a.z, x18, s2);
    s3 = fmaf(a.w, x19, s3);
    a = *(const LAS f32x4*)(Am + 4168);
    s0 = fmaf(a.x, x20, s0);
    s1 = fmaf(a.y, x21, s1);
    s2 = fmaf(a.z, x22, s2);
    s3 = fmaf(a.w, x23, s3);
    a = *(const LAS f32x4*)(Am + 4172);
    s0 = fmaf(a.x, x24, s0);
    s1 = fmaf(a.y, x25, s1);
    s2 = fmaf(a.z, x26, s2);
    s3 = fmaf(a.w, x27, s3);
    a = *(const LAS f32x4*)(Am + 4176);
    s0 = fmaf(a.x, x28, s0);
    s1 = fmaf(a.y, x29, s1);
    s2 = fmaf(a.z, x30, s2);
    s3 = fmaf(a.w, x31, s3);
    a = *(const LAS f32x4*)(Am + 4180);
    s0 = fmaf(a.x, x32, s0);
    s1 = fmaf(a.y, x33, s1);
    s2 = fmaf(a.z, x34, s2);
    s3 = fmaf(a.w, x35, s3);
    a = *(const LAS f32x4*)(Am + 4184);
    s0 = fmaf(a.x, x36, s0);
    s1 = fmaf(a.y, x37, s1);
    s2 = fmaf(a.z, x38, s2);
    s3 = fmaf(a.w, x39, s3);
    a = *(const LAS f32x4*)(Am + 4188);
    s0 = fmaf(a.x, x40, s0);
    s1 = fmaf(a.y, x41, s1);
    s2 = fmaf(a.z, x42, s2);
    s3 = fmaf(a.w, x43, s3);
    a = *(const LAS f32x4*)(Am + 4192);
    s0 = fmaf(a.x, x44, s0);
    s1 = fmaf(a.y, x45, s1);
    s2 = fmaf(a.z, x46, s2);
    s3 = fmaf(a.w, x47, s3);
    a = *(const LAS f32x4*)(Am + 4196);
    s0 = fmaf(a.x, x48, s0);
    s1 = fmaf(a.y, x49, s1);
    s2 = fmaf(a.z, x50, s2);
    s3 = fmaf(a.w, x51, s3);
    a = *(const LAS f32x4*)(Am + 4200);
    s0 = fmaf(a.x, x52, s0);
    s1 = fmaf(a.y, x53, s1);
    s2 = fmaf(a.z, x54, s2);
    s3 = fmaf(a.w, x55, s3);
    a = *(const LAS f32x4*)(Am + 4204);
    s0 = fmaf(a.x, x56, s0);
    s1 = fmaf(a.y, x57, s1);
    s2 = fmaf(a.z, x58, s2);
    s3 = fmaf(a.w, x59, s3);
    a = *(const LAS f32x4*)(Am + 4208);
    const float al61 = a.x;
    x61 = (x61 - ((s0 + s1) + (s2 + s3))) - al61 * x60;
    Tu[8296 + c] = f2bf(x61 * su); Tw[8296 + c] = f2bf(x61 * sw); asm volatile("" ::: "memory");
    float x62 = fmaxf(0.0f, 1.0f - fabsf(cf - 62.0f));
    s0 = 0.f; s1 = 0.f; s2 = 0.f; s3 = 0.f;
    a = *(const LAS f32x4*)(Am + 4216);
    s0 = fmaf(a.x, x0, s0);
    s1 = fmaf(a.y, x1, s1);
    s2 = fmaf(a.z, x2, s2);
    s3 = fmaf(a.w, x3, s3);
    a = *(const LAS f32x4*)(Am + 4220);
    s0 = fmaf(a.x, x4, s0);
    s1 = fmaf(a.y, x5, s1);
    s2 = fmaf(a.z, x6, s2);
    s3 = fmaf(a.w, x7, s3);
    a = *(const LAS f32x4*)(Am + 4224);
    s0 = fmaf(a.x, x8, s0);
    s1 = fmaf(a.y, x9, s1);
    s2 = fmaf(a.z, x10, s2);
    s3 = fmaf(a.w, x11, s3);
    a = *(const LAS f32x4*)(Am + 4228);
    s0 = fmaf(a.x, x12, s0);
    s1 = fmaf(a.y, x13, s1);
    s2 = fmaf(a.z, x14, s2);
    s3 = fmaf(a.w, x15, s3);
    a = *(const LAS f32x4*)(Am + 4232);
    s0 = fmaf(a.x, x16, s0);
    s1 = fmaf(a.y, x17, s1);
    s2 = fmaf(a.z, x18, s2);
    s3 = fmaf(a.w, x19, s3);
    a = *(const LAS f32x4*)(Am + 4236);
    s0 = fmaf(a.x, x20, s0);
    s1 = fmaf(a.y, x21, s1);
    s2 = fmaf(a.z, x22, s2);
    s3 = fmaf(a.w, x23, s3);
    a = *(const LAS f32x4*)(Am + 4240);
    s0 = fmaf(a.x, x24, s0);
    s1 = fmaf(a.y, x25, s1);
    s2 = fmaf(a.z, x26, s2);
    s3 = fmaf(a.w, x27, s3);
    a = *(const LAS f32x4*)(Am + 4244);
    s0 = fmaf(a.x, x28, s0);
    s1 = fmaf(a.y, x29, s1);
    s2 = fmaf(a.z, x30, s2);
    s3 = fmaf(a.w, x31, s3);
    a = *(const LAS f32x4*)(Am + 4248);
    s0 = fmaf(a.x, x32, s0);
    s1 = fmaf(a.y, x33, s1);
    s2 = fmaf(a.z, x34, s2);
    s3 = fmaf(a.w, x35, s3);
    a = *(const LAS f32x4*)(Am + 4252);
    s0 = fmaf(a.x, x36, s0);
    s1 = fmaf(a.y, x37, s1);
    s2 = fmaf(a.z, x38, s2);
    s3 = fmaf(a.w, x39, s3);
    a = *(const LAS f32x4*)(Am + 4256);
    s0 = fmaf(a.x, x40, s0);
    s1 = fmaf(a.y, x41, s1);
    s2 = fmaf(a.z, x42, s2);
    s3 = fmaf(a.w, x43, s3);
    a = *(const LAS f32x4*)(Am + 4260);
    s0 = fmaf(a.x, x44, s0);
    s1 = fmaf(a.y, x45, s1);
    s2 = fmaf(a.z, x46, s2);
    s3 = fmaf(a.w, x47, s3);
    a = *(const LAS f32x4*)(Am + 4264);
    s0 = fmaf(a.x, x48, s0);
    s1 = fmaf(a.y, x49, s1);
    s2 = fmaf(a.z, x50, s2);
    s3 = fmaf(a.w, x51, s3);
    a = *(const LAS f32x4*)(Am + 4268);
    s0 = fmaf(a.x, x52, s0);
    s1 = fmaf(a.y, x53, s1);
    s2 = fmaf(a.z, x54, s2);
    s3 = fmaf(a.w, x55, s3);
    a = *(const LAS f32x4*)(Am + 4272);
    s0 = fmaf(a.x, x56, s0);
    s1 = fmaf(a.y, x57, s1);
    s2 = fmaf(a.z, x58, s2);
    s3 = fmaf(a.w, x59, s3);
    a = *(const LAS f32x4*)(Am + 4276);
    s0 = fmaf(a.x, x60, s0);
    const float al62 = a.y;
    x62 = (x62 - ((s0 + s1) + (s2 + s3))) - al62 * x61;
    Tu[8432 + c] = f2bf(x62 * su); Tw[8432 + c] = f2bf(x62 * sw); asm volatile("" ::: "memory");
    float x63 = fmaxf(0.0f, 1.0f - fabsf(cf - 63.0f));
    s0 = 0.f; s1 = 0.f; s2 = 0.f; s3 = 0.f;
    a = *(const LAS f32x4*)(Am + 4284);
    s0 = fmaf(a.x, x0, s0);
    s1 = fmaf(a.y, x1, s1);
    s2 = fmaf(a.z, x2, s2);
    s3 = fmaf(a.w, x3, s3);
    a = *(const LAS f32x4*)(Am + 4288);
    s0 = fmaf(a.x, x4, s0);
    s1 = fmaf(a.y, x5, s1);
    s2 = fmaf(a.z, x6, s2);
    s3 = fmaf(a.w, x7, s3);
    a = *(const LAS f32x4*)(Am + 4292);
    s0 = fmaf(a.x, x8, s0);
    s1 = fmaf(a.y, x9, s1);
    s2 = fmaf(a.z, x10, s2);
    s3 = fmaf(a.w, x11, s3);
    a = *(const LAS f32x4*)(Am + 4296);
    s0 = fmaf(a.x, x12, s0);
    s1 = fmaf(a.y, x13, s1);
    s2 = fmaf(a.z, x14, s2);
    s3 = fmaf(a.w, x15, s3);
    a = *(const LAS f32x4*)(Am + 4300);
    s0 = fmaf(a.x, x16, s0);
    s1 = fmaf(a.y, x17, s1);
    s2 = fmaf(a.z, x18, s2);
    s3 = fmaf(a.w, x19, s3);
    a = *(const LAS f32x4*)(Am + 4304);
    s0 = fmaf(a.x, x20, s0);
    s1 = fmaf(a.y, x21, s1);
    s2 = fmaf(a.z, x22, s2);
    s3 = fmaf(a.w, x23, s3);
    a = *(const LAS f32x4*)(Am + 4308);
    s0 = fmaf(a.x, x24, s0);
    s1 = fmaf(a.y, x25, s1);
    s2 = fmaf(a.z, x26, s2);
    s3 = fmaf(a.w, x27, s3);
    a = *(const LAS f32x4*)(Am + 4312);
    s0 = fmaf(a.x, x28, s0);
    s1 = fmaf(a.y, x29, s1);
    s2 = fmaf(a.z, x30, s2);
    s3 = fmaf(a.w, x31, s3);
    a = *(const LAS f32x4*)(Am + 4316);
    s0 = fmaf(a.x, x32, s0);
    s1 = fmaf(a.y, x33, s1);
    s2 = fmaf(a.z, x34, s2);
    s3 = fmaf(a.w, x35, s3);
    a = *(const LAS f32x4*)(Am + 4320);
    s0 = fmaf(a.x, x36, s0);
    s1 = fmaf(a.y, x37, s1);
    s2 = fmaf(a.z, x38, s2);
    s3 = fmaf(a.w, x39, s3);
    a = *(const LAS f32x4*)(Am + 4324);
    s0 = fmaf(a.x, x40, s0);
    s1 = fmaf(a.y, x41, s1);
    s2 = fmaf(a.z, x42, s2);
    s3 = fmaf(a.w, x43, s3);
    a = *(const LAS f32x4*)(Am + 4328);
    s0 = fmaf(a.x, x44, s0);
    s1 = fmaf(a.y, x45, s1);
    s2 = fmaf(a.z, x46, s2);
    s3 = fmaf(a.w, x47, s3);
    a = *(const LAS f32x4*)(Am + 4332);
    s0 = fmaf(a.x, x48, s0);
    s1 = fmaf(a.y, x49, s1);
    s2 = fmaf(a.z, x50, s2);
    s3 = fmaf(a.w, x51, s3);
    a = *(const LAS f32x4*)(Am + 4336);
    s0 = fmaf(a.x, x52, s0);
    s1 = fmaf(a.y, x53, s1);
    s2 = fmaf(a.z, x54, s2);
    s3 = fmaf(a.w, x55, s3);
    a = *(const LAS f32x4*)(Am + 4340);
    s0 = fmaf(a.x, x56, s0);
    s1 = fmaf(a.y, x57, s1);
    s2 = fmaf(a.z, x58, s2);
    s3 = fmaf(a.w, x59, s3);
    a = *(const LAS f32x4*)(Am + 4344);
    s0 = fmaf(a.x, x60, s0);
    s1 = fmaf(a.y, x61, s1);
    const float al63 = a.z;
    x63 = (x63 - ((s0 + s1) + (s2 + s3))) - al63 * x62;
    Tu[8568 + c] = f2bf(x63 * su); Tw[8568 + c] = f2bf(x63 * sw); asm volatile("" ::: "memory");
}
typedef short bf16x8_t __attribute__((ext_vector_type(8)));
template <int K> __device__ __forceinline__ f32x4 mma_tile(const LAS unsigned short* A, int lda, const LAS unsigned short* Bt, int ldb, f32x4 acc) {
    const int lane = threadIdx.x & 63, r = lane & 15, q = lane >> 4;
#pragma unroll
    for (int ks = 0; ks < K / 32; ++ks) {
        const bf16x8_t a = *(const LAS bf16x8_t*)(A + r * lda + ks * 32 + q * 8);
        const bf16x8_t b = *(const LAS bf16x8_t*)(Bt + r * ldb + ks * 32 + q * 8);
        acc = __builtin_amdgcn_mfma_f32_16x16x32_bf16(a, b, acc, 0, 0, 0);
    }
    return acc;
}

typedef unsigned short u16x4_t __attribute__((ext_vector_type(4)));
__device__ __forceinline__ void tr_frag2(unsigned base_addr, int pitch, int c, bf16x8_t& f0, bf16x8_t& f1) {
    const int lane = threadIdx.x & 63, g = lane >> 4, qq = (lane & 15) >> 2, pp = lane & 3;
    const unsigned a00 = base_addr + (unsigned)((8 * g + qq) * pitch + 32 * c + 8 * pp);
    const unsigned a01 = a00 + 4u * (unsigned)pitch, a10 = a00 + 32u * (unsigned)pitch, a11 = a10 + 4u * (unsigned)pitch;
    u16x4_t r00, r01, r10, r11;
    asm volatile("ds_read_b64_tr_b16 %0, %4\n\tds_read_b64_tr_b16 %1, %5\n\tds_read_b64_tr_b16 %2, %6\n\tds_read_b64_tr_b16 %3, %7\n\ts_waitcnt lgkmcnt(0)"
                 : "=&v"(r00), "=&v"(r01), "=&v"(r10), "=&v"(r11) : "v"(a00), "v"(a01), "v"(a10), "v"(a11) : "memory");
    f0 = (bf16x8_t){(short)r00.x, (short)r00.y, (short)r00.z, (short)r00.w, (short)r01.x, (short)r01.y, (short)r01.z, (short)r01.w};
    f1 = (bf16x8_t){(short)r10.x, (short)r10.y, (short)r10.z, (short)r10.w, (short)r11.x, (short)r11.y, (short)r11.z, (short)r11.w};
}
constexpr size_t WS_G = 235 * MiB;

__device__ __forceinline__ void delta_prep(LDSp lds, const Params& p) {
    const bf16_t* QKVN = (const bf16_t*)(p.ws + WS_QKV); const float* BETA = (const float*)(p.ws + WS_BETA); const float* LA = (const float*)(p.ws + WS_LA);
    bf16_t* Z = (bf16_t*)(p.ws + WS_Z); float* GB = (float*)(p.ws + WS_G);
    LAS unsigned short* Qb = (LAS unsigned short*)lds;
    LAS unsigned short* Kb = (LAS unsigned short*)(lds + 17408);
    LAS unsigned short* Ast = (LAS unsigned short*)(lds + 107776);
    const int tid = threadIdx.x, lane = tid & 63, wid = tid >> 6, r = lane & 15, q = lane >> 4;
    const int G = gridDim.x;
    u32x4 pq[4]; float pla = 0.f, pbe = 0.f;
#define DPL(u_, vmode) do { const int dir_ = (u_) >> 10, b_ = ((u_) >> 8) & 3, h_ = ((u_) >> 6) & 3, n_ = (u_) & 63; \
        const long tk0_ = (long)b_ * S_ + (dir_ ? (S_ - 1 - n_ * 64) : n_ * 64); const long ts_ = dir_ ? -1 : 1; \
        _Pragma("unroll") for (int i = 0; i < 4; ++i) { const int pi = tid + NTHR * i, which = pi >> 10, l = (pi >> 4) & 63, c8 = pi & 15; \
            pq[i] = *(const u32x4*)(QKVN + (tk0_ + l * ts_) * 1536 + ((vmode) ? (which ? 512 : 1024) : which * 512) + h_ * 128 + c8 * 8); } \
        if (!(vmode) && tid < 64) { const long tk = tk0_ + tid * ts_; pla = LA[tk * 8 + dir_ * 4 + h_]; pbe = BETA[tk * 8 + dir_ * 4 + h_]; } } while (0)
#define DPS() do { _Pragma("unroll") for (int i = 0; i < 4; ++i) { const int pi = tid + NTHR * i, which = pi >> 10, l = (pi >> 4) & 63, c8 = pi & 15; *(LAS u32x4*)(lds + which * 17408 + l * 272 + c8 * 16) = pq[i]; } } while (0)
    if ((int)blockIdx.x < 2048) DPL((int)blockIdx.x, 0);
    for (int ub = blockIdx.x; ub < 2048; ub += 4 * G) {
#pragma unroll 1
        for (int j = 0; j < 4; ++j) { const int unit = ub + j * G; if (unit >= 2048) break;
            const int dir = unit >> 10, b = (unit >> 8) & 3, h = (unit >> 6) & 3, n = unit & 63;
            const long tok0 = (long)b * S_ + (dir ? (S_ - 1 - n * 64) : n * 64); const long tstep = dir ? -1 : 1;
            LAS float* Am = (LAS float*)(lds + 34816 + j * 17408); LAS float* gl = (LAS float*)(lds + 104448 + j * 768); LAS float* be = gl + 64; LAS float* beg = gl + 128; LAS float* la = (LAS float*)(lds + 107520);
            DPS();
            if (tid < 64) { la[tid] = pla; be[tid] = pbe; }
            __syncthreads();
            { const int un = ub + (j + 1) * G; if (j < 3 && un < 2048) DPL(un, 0); else DPL(ub, 1); }
            if (tid < 64) { const float g = wave_scan_sum(la[tid], true); gl[tid] = g; beg[tid] = be[tid] * __expf(g); GB[((size_t)dir * T_ + (tok0 + tid * tstep)) * 4 + h] = g; }
            __syncthreads();
#pragma unroll
            for (int tt = 0; tt < 2; ++tt) { const int idx = wid * 2 + tt, mt = idx >> 2, nt = idx & 3;
                f32x4 kk = {0.f, 0.f, 0.f, 0.f}, qk = {0.f, 0.f, 0.f, 0.f};
                if (mt >= nt) { kk = mma_tile<128>(Kb + mt * 16 * 136, 136, Kb + nt * 16 * 136, 136, kk); qk = mma_tile<128>(Qb + mt * 16 * 136, 136, Kb + nt * 16 * 136, 136, qk); }
                const int jj = nt * 16 + r; const float gj = gl[jj];
#pragma unroll
                for (int i4 = 0; i4 < 4; ++i4) { const int i = mt * 16 + q * 4 + i4; const float dec = (i >= jj) ? __expf(gl[i] - gj) : 0.f;
                    Am[i * 68 + jj] = (i > jj) ? be[i] * kk[i4] * dec : 0.f;
                    Ast[i * 72 + jj] = f2bf(qk[i4] * dec); }
            }
            __syncthreads();
            { const int l = tid >> 3, c8 = tid & 7;
              *(u32x4*)(Z + (tok0 + l * tstep) * 3072 + 2048 + dir * 256 + h * 64 + c8 * 8) = *(const LAS u32x4*)(Ast + l * 72 + c8 * 8); }
        }
        if (wid < 4 && ub + wid * G < 2048) { int cc = lane; asm volatile("" : "+v"(cc));
            LAS float* Am = (LAS float*)(lds + 34816 + wid * 17408); LAS float* gl = (LAS float*)(lds + 104448 + wid * 768);
            tri_inv64(Am, cc, gl[64 + lane], gl[128 + lane], (LAS unsigned short*)Am, (LAS unsigned short*)Am + 64); }
        __syncthreads();
#pragma unroll 1
        for (int j = 0; j < 4; ++j) { const int unit = ub + j * G; if (unit >= 2048) break;
            const int dir = unit >> 10, b = (unit >> 8) & 3, h = (unit >> 6) & 3, n = unit & 63;
            const long tok0 = (long)b * S_ + (dir ? (S_ - 1 - n * 64) : n * 64); const long tstep = dir ? -1 : 1;
            const LAS unsigned short* Tu = (const LAS unsigned short*)(lds + 34816 + j * 17408);
            DPS();
            __syncthreads();
            { const int un = ub + (j + 1) * G; if (j < 3 && un < 2048) DPL(un, 1); else if (ub + 4 * G < 2048) DPL(ub + 4 * G, 0); }
            {   bf16x8_t vb0, vb1, kb0, kb1; tr_frag2((unsigned)(unsigned long long)Qb, 272, wid, vb0, vb1); tr_frag2((unsigned)(unsigned long long)Kb, 272, wid, kb0, kb1);
                __syncthreads();
#pragma unroll
                for (int mt = 0; mt < 4; ++mt) {
                    const bf16x8_t tu0 = *(const LAS bf16x8_t*)(Tu + (mt * 16 + r) * 136 + q * 8), tu1 = *(const LAS bf16x8_t*)(Tu + (mt * 16 + r) * 136 + 32 + q * 8);
                    const bf16x8_t tw0 = *(const LAS bf16x8_t*)(Tu + (mt * 16 + r) * 136 + 64 + q * 8), tw1 = *(const LAS bf16x8_t*)(Tu + (mt * 16 + r) * 136 + 96 + q * 8);
                    f32x4 au = {0.f, 0.f, 0.f, 0.f}, aw = {0.f, 0.f, 0.f, 0.f};
                    au = __builtin_amdgcn_mfma_f32_16x16x32_bf16(tu0, vb0, au, 0, 0, 0); au = __builtin_amdgcn_mfma_f32_16x16x32_bf16(tu1, vb1, au, 0, 0, 0);
                    aw = __builtin_amdgcn_mfma_f32_16x16x32_bf16(tw0, kb0, aw, 0, 0, 0); aw = __builtin_amdgcn_mfma_f32_16x16x32_bf16(tw1, kb1, aw, 0, 0, 0);
#pragma unroll
                    for (int i4 = 0; i4 < 4; ++i4) { const int l = mt * 16 + q * 4 + i4; Qb[l * 136 + wid * 16 + r] = f2bf(au[i4]); Kb[l * 136 + wid * 16 + r] = f2bf(aw[i4]); }
                }
            }
            __syncthreads();
#pragma unroll
            for (int i = 0; i < 4; ++i) { const int pi = tid + NTHR * i, which = pi >> 10, l = (pi >> 4) & 63, c8 = pi & 15;
                *(u32x4*)(Z + (tok0 + l * tstep) * 3072 + which * 1024 + dir * 512 + h * 128 + c8 * 8) = *(const LAS u32x4*)(lds + which * 17408 + l * 272 + c8 * 16); }
            __syncthreads();
        }
    }
}
#undef DPL
#undef DPS

__device__ __forceinline__ void delta_scan2(LDSp lds, const Params& p) {
    const bf16_t* QKVN = (const bf16_t*)(p.ws + WS_QKV); const bf16_t* Z = (const bf16_t*)(p.ws + WS_Z); const float* GB = (const float*)(p.ws + WS_G);
    LAS unsigned short* Wb  = (LAS unsigned short*)lds;
    LAS unsigned short* Qg  = (LAS unsigned short*)(lds + 17408);
    LAS unsigned short* Kg  = (LAS unsigned short*)(lds + 34816);
    LAS unsigned short* At  = (LAS unsigned short*)(lds + 53248);
    LAS unsigned short* Ub  = (LAS unsigned short*)(lds + 62464);
    LAS unsigned short* St  = (LAS unsigned short*)(lds + 66560);
    LAS unsigned short* Vt  = (LAS unsigned short*)(lds + 75264);
    const int tid = threadIdx.x, lane = tid & 63, wid = tid >> 6, r = lane & 15, q = lane >> 4;
    for (int unit = blockIdx.x; unit < 128; unit += gridDim.x) {
        const int dir = unit >> 6, b = (unit >> 4) & 3, h = (unit >> 2) & 3, sl = unit & 3;
        bf16_t* O = (bf16_t*)(p.ws + (dir ? WS_OB : WS_OF));
        const long tstep = dir ? -1 : 1;
        f32x4 S0 = {0.f, 0.f, 0.f, 0.f}, S1 = {0.f, 0.f, 0.f, 0.f};
        u32x4 rwA[2], rqA[2], rkA[2], raA, ruA = {0u, 0u, 0u, 0u}; float g0A = 0.f, g1A = 0.f, gLA = 0.f;
        u32x4 rwB[2], rqB[2], rkB[2], raB, ruB = {0u, 0u, 0u, 0u}; float g0B = 0.f, g1B = 0.f, gLB = 0.f;
#define D2_TOK0(n) ((long)b * S_ + (dir ? (S_ - 1 - (n) * 64) : (n) * 64))
#define D2_LOAD(n, X) do { const long t0_ = D2_TOK0(n); \
        _Pragma("unroll") for (int i = 0; i < 2; ++i) { const int pi = tid + NTHR * i, l = pi >> 4, c8 = pi & 15; const long tk = t0_ + l * tstep; \
            rw##X[i] = *(const u32x4*)(Z + tk * 3072 + 1024 + dir * 512 + h * 128 + c8 * 8); \
            rq##X[i] = *(const u32x4*)(QKVN + tk * 1536 + h * 128 + c8 * 8); rk##X[i] = *(const u32x4*)(QKVN + tk * 1536 + 512 + h * 128 + c8 * 8); } \
        { const int l = tid >> 3, c8 = tid & 7; ra##X = *(const u32x4*)(Z + (t0_ + l * tstep) * 3072 + 2048 + dir * 256 + h * 64 + c8 * 8); } \
        if (tid < 256) { const int l = tid >> 2, c8 = tid & 3; ru##X = *(const u32x4*)(Z + (t0_ + l * tstep) * 3072 + dir * 512 + h * 128 + sl * 32 + c8 * 8); } \
        g0##X = GB[((size_t)dir * T_ + (t0_ + (tid >> 4) * tstep)) * 4 + h]; g1##X = GB[((size_t)dir * T_ + (t0_ + ((tid >> 4) + 32) * tstep)) * 4 + h]; \
        gL##X = GB[((size_t)dir * T_ + (t0_ + 63 * tstep)) * 4 + h]; } while (0)
#define D2_ITER(n, X) do { \
            const float egL = __expf(gL##X); \
            _Pragma("unroll") for (int i = 0; i < 2; ++i) { const int pi = tid + NTHR * i, l = pi >> 4, c8 = pi & 15; const float gl_ = i == 0 ? g0##X : g1##X; \
                *(LAS u32x4*)(Wb + l * 136 + c8 * 8) = rw##X[i]; \
                float f[8]; unpack8(rq##X[i], f); const float eg = __expf(gl_); \
                u32x4 o; o.x = pk2(f[0] * eg, f[1] * eg); o.y = pk2(f[2] * eg, f[3] * eg); o.z = pk2(f[4] * eg, f[5] * eg); o.w = pk2(f[6] * eg, f[7] * eg); \
                *(LAS u32x4*)(Qg + l * 136 + c8 * 8) = o; \
                unpack8(rk##X[i], f); const float ek = __expf(gL##X - gl_); \
                o.x = pk2(f[0] * ek, f[1] * ek); o.y = pk2(f[2] * ek, f[3] * ek); o.z = pk2(f[4] * ek, f[5] * ek); o.w = pk2(f[6] * ek, f[7] * ek); \
                *(LAS u32x4*)(Kg + l * 144 + c8 * 8) = o; } \
            { const int l = tid >> 3, c8 = tid & 7; *(LAS u32x4*)(At + l * 72 + c8 * 8) = ra##X; } \
            if (tid < 256) { const int l = tid >> 2, c8 = tid & 3; *(LAS u32x4*)(Ub + l * 32 + c8 * 8) = ru##X; } \
            { u32x2 w0; w0.x = pk2(S0.x, S0.y); w0.y = pk2(S0.z, S0.w); *(LAS u32x2*)(St + r * 136 + wid * 16 + q * 4) = w0; \
              u32x2 w1; w1.x = pk2(S1.x, S1.y); w1.y = pk2(S1.z, S1.w); *(LAS u32x2*)(St + (16 + r) * 136 + wid * 16 + q * 4) = w1; } \
            __syncthreads(); \
            if ((n) + 2 < 64) D2_LOAD((n) + 2, X); \
            const int mt = wid >> 1, nt = wid & 1; \
            f32x4 p1 = {0.f, 0.f, 0.f, 0.f}, p2 = {0.f, 0.f, 0.f, 0.f}; \
            p1 = mma_tile<128>(Wb + mt * 16 * 136, 136, St + nt * 16 * 136, 136, p1); \
            p2 = mma_tile<128>(Qg + mt * 16 * 136, 136, St + nt * 16 * 136, 136, p2); \
            { const int l0 = mt * 16 + q * 4, v = nt * 16 + r; float vn[4]; \
              _Pragma("unroll") for (int i = 0; i < 4; ++i) vn[i] = bf2f(Ub[(l0 + i) * 32 + v]) - p1[i]; \
              u32x2 w; w.x = pk2(vn[0], vn[1]); w.y = pk2(vn[2], vn[3]); *(LAS u32x2*)(Vt + v * 72 + l0) = w; } \
            __syncthreads(); \
            p2 = mma_tile<64>(At + mt * 16 * 72, 72, Vt + nt * 16 * 72, 72, p2); \
            { const long t0_ = D2_TOK0(n); \
              _Pragma("unroll") for (int i = 0; i < 4; ++i) O[(t0_ + (mt * 16 + q * 4 + i) * tstep) * 512 + h * 128 + sl * 32 + nt * 16 + r] = f2bf(p2[i]); } \
            S0 = S0 * egL; S1 = S1 * egL; \
            { bf16x8_t ka0, ka1; tr_frag2((unsigned)(unsigned long long)Kg, 288, wid, ka0, ka1); \
              const bf16x8_t vb00 = *(const LAS bf16x8_t*)(Vt + r * 72 + q * 8), vb01 = *(const LAS bf16x8_t*)(Vt + r * 72 + 32 + q * 8); \
              const bf16x8_t vb10 = *(const LAS bf16x8_t*)(Vt + (16 + r) * 72 + q * 8), vb11 = *(const LAS bf16x8_t*)(Vt + (16 + r) * 72 + 32 + q * 8); \
              S0 = __builtin_amdgcn_mfma_f32_16x16x32_bf16(ka0, vb00, S0, 0, 0, 0); S0 = __builtin_amdgcn_mfma_f32_16x16x32_bf16(ka1, vb01, S0, 0, 0, 0); \
              S1 = __builtin_amdgcn_mfma_f32_16x16x32_bf16(ka0, vb10, S1, 0, 0, 0); S1 = __builtin_amdgcn_mfma_f32_16x16x32_bf16(ka1, vb11, S1, 0, 0, 0); } \
            __syncthreads(); } while (0)
        D2_LOAD(0, A); D2_LOAD(1, B);
#pragma unroll 1
        for (int n = 0; n < 64; n += 2) { D2_ITER(n, A); D2_ITER(n + 1, B); }
#undef D2_ITER
#undef D2_LOAD
#undef D2_TOK0
    }
}
constexpr size_t WS_CT = WS_OF, WS_NV = 235 * MiB, WS_MS = 235 * MiB + 524288, WS_CT2 = 169 * MiB, WS_NV2 = 236 * MiB;
__device__ __forceinline__ void mlstm_a(LDSp lds, const Params& p) {
    const bf16_t* Z = (const bf16_t*)(p.ws + WS_Z); const float* LI = (const float*)(p.ws + WS_BETA); const float* LF = (const float*)(p.ws + WS_LA);
    bf16_t* CT = (bf16_t*)(p.ws + WS_CT); float* NV = (float*)(p.ws + WS_NV); float* MS = (float*)(p.ws + WS_MS);
    LAS unsigned short* Ks = (LAS unsigned short*)lds;
    LAS unsigned short* Vr = (LAS unsigned short*)(lds + 9216);
    LAS float* lf = (LAS float*)(lds + 27648); LAS float* li = lf + 64; LAS float* sw = lf + 128; LAS float* red = lf + 192  ;
    const int tid = threadIdx.x, lane = tid & 63, wid = tid >> 6, r = lane & 15, q = lane >> 4;
    for (int unit = blockIdx.x; unit < 2048; unit += gridDim.x) {
        const int dir = unit >> 10, b = (unit >> 8) & 3, h = (unit >> 6) & 3, n = unit & 63, pc = dir ? 63 - n : n;
        const size_t tok0 = (size_t)b * S_ + pc * 64;
        if (tid < 64) { lf[tid] = LF[(tok0 + tid) * 8 + dir * 4 + h]; li[tid] = LI[(tok0 + tid) * 8 + dir * 4 + h]; }
        __syncthreads();
        if (tid < 64) { const float bc = wave_scan_sum(lf[tid], dir == 0);
            const float tot = __shfl(bc, dir ? 0 : 63);
            const float we = tot - bc + li[tid]; float mx = we;
#pragma unroll
            for (int o = 32; o; o >>= 1) mx = fmaxf(mx, __shfl_xor(mx, o));
            sw[tid] = __expf(we - mx);
            if (tid == 0) { MS[unit * 32] = tot; MS[unit * 32 + 1] = mx; } }
        __syncthreads();
        { const int pp = tid >> 3, c8 = tid & 7; const u32x4 kv = *(const u32x4*)(Z + (tok0 + pp) * 2560 + 1280 + h * 64 + c8 * 8); float f[8]; unpack8(kv, f); const float s = sw[pp];
          u32x4 o; o.x = pk2(f[0] * s, f[1] * s); o.y = pk2(f[2] * s, f[3] * s); o.z = pk2(f[4] * s, f[5] * s); o.w = pk2(f[6] * s, f[7] * s);
          *(LAS u32x4*)(Ks + pp * 72 + c8 * 8) = o; }
#pragma unroll
        for (int i = 0; i < 2; ++i) { const int pi = tid + NTHR * i, pp = pi >> 4, c8 = pi & 15;
            *(LAS u32x4*)(Vr + pp * 144 + c8 * 8) = *(const u32x4*)(Z + (tok0 + pp) * 2560 + 1536 + h * 128 + c8 * 8); }
        __syncthreads();
        { bf16x8_t vb0, vb1; tr_frag2((unsigned)(unsigned long long)Vr, 288, wid, vb0, vb1);
#pragma unroll
          for (int dt = 0; dt < 4; ++dt) { bf16x8_t ka0, ka1; tr_frag2((unsigned)(unsigned long long)Ks, 144, dt, ka0, ka1);
            f32x4 acc = {0.f, 0.f, 0.f, 0.f};
            acc = __builtin_amdgcn_mfma_f32_16x16x32_bf16(ka0, vb0, acc, 0, 0, 0); acc = __builtin_amdgcn_mfma_f32_16x16x32_bf16(ka1, vb1, acc, 0, 0, 0);
            u32x2 w; w.x = pk2(acc.x, acc.y); w.y = pk2(acc.z, acc.w);
            *(u32x2*)(CT + (size_t)unit * 8192 + (wid * 16 + r) * 64 + dt * 16 + q * 4) = w; } }
        { const int d = tid & 63; float a = 0.f;
#pragma unroll
          for (int j = 0; j < 8; ++j) a += bf2f(Ks[(wid * 8 + j) * 72 + d]);
          red[wid * 64 + d] = a; }
        __syncthreads();
        if (tid < 64) { float a = 0.f;
#pragma unroll
            for (int w = 0; w < 8; ++w) a += red[w * 64 + tid];
            NV[(size_t)unit * 64 + tid] = a; }
        __syncthreads();
    }
}
__device__ __forceinline__ void mlstm_b(const Params& p) {
    const bf16_t* CT = (const bf16_t*)(p.ws + WS_CT); const float* NV = (const float*)(p.ws + WS_NV); float* MS = (float*)(p.ws + WS_MS); bf16_t* CT2 = (bf16_t*)(p.ws + WS_CT2); float* NV2 = (float*)(p.ws + WS_NV2);
    const int tid = threadIdx.x;
    for (int wgi = blockIdx.x; wgi < 128; wgi += gridDim.x) {
        const int scan = wgi >> 2, part = wgi & 3; const size_t e = (size_t)(part * NTHR + tid) * 4;
        const bool nvw = (part == 0 && tid < 64);
        float m = 0.f, c0 = 0.f, c1 = 0.f, c2 = 0.f, c3 = 0.f, nn = 0.f;
#pragma unroll 1
        for (int hf = 0; hf < 4; ++hf) {
        u32x2 dc[16]; float dn[16], blv[16], mlv[16];
#pragma unroll
        for (int n = 0; n < 16; ++n) { blv[n] = MS[(scan * 64 + hf * 16 + n) * 32]; mlv[n] = MS[(scan * 64 + hf * 16 + n) * 32 + 1]; dc[n] = (EXPC == 2) ? (u32x2){0u, 0u} : *(const u32x2*)(CT + (size_t)(scan * 64 + hf * 16 + n) * 8192 + e); dn[n] = nvw ? NV[(size_t)(scan * 64 + hf * 16 + n) * 64 + tid] : 0.f; }
#pragma unroll
        for (int n = 0; n < 16; ++n) { const int unit = scan * 64 + hf * 16 + n;
            const float bl = blv[n], ml = mlv[n];
            u32x2 w; w.x = pk2(c0, c1); w.y = pk2(c2, c3); *(u32x2*)(CT2 + (size_t)unit * 8192 + e) = w;
            if (nvw) NV2[(size_t)unit * 64 + tid] = nn;
            if (part == 0 && tid == 0) MS[65536 + unit] = m;
            const float mn = fmaxf(bl + m, ml), a = __expf(bl + m - mn), bb = __expf(ml - mn);
            c0 = a * c0 + bb * bflo(dc[n].x); c1 = a * c1 + bb * bfhi(dc[n].x); c2 = a * c2 + bb * bflo(dc[n].y); c3 = a * c3 + bb * bfhi(dc[n].y);
            nn = a * nn + bb * dn[n]; m = mn; }
        }
    }
}
__device__ __forceinline__ void mlstm_c(LDSp lds, const Params& p) {
    const bf16_t* Z = (const bf16_t*)(p.ws + WS_Z); const float* LI = (const float*)(p.ws + WS_BETA); const float* LF = (const float*)(p.ws + WS_LA);
    const bf16_t* CT = (const bf16_t*)(p.ws + WS_CT2); const float* NV = (const float*)(p.ws + WS_NV2); const float* MS = (const float*)(p.ws + WS_MS);
    bf16_t* Y = (bf16_t*)(p.ws + WS_HN); const float* gn = p.in[19];
    LAS unsigned short* Qb = (LAS unsigned short*)lds;
    LAS unsigned short* Kb = (LAS unsigned short*)(lds + 9216);
    LAS unsigned short* Vr = (LAS unsigned short*)(lds + 18432);
    LAS float* ssp = (LAS float*)(lds + 100352);
#define MC_CB(d) ((LAS unsigned short*)(lds + 36864 + (d) * 18432))
#define MC_PB(d) ((LAS unsigned short*)(lds + 73728 + (d) * 9216))
#define MC_SC(d) ((LAS float*)(lds + 92160 + (d) * 4096))
    const int tid = threadIdx.x, wid = tid >> 6;
    for (int unit = blockIdx.x; unit < 1024; unit += gridDim.x) {
        int lane = tid & 63; asm volatile("" : "+v"(lane));
        const int r = lane & 15, q = lane >> 4;
        const int b = unit >> 8, h = (unit >> 6) & 3, pc = unit & 63; const size_t tok0 = (size_t)b * S_ + pc * 64;
        const size_t ua = (size_t)(((0 * 4 + b) * 4 + h) * 64 + pc), ub = (size_t)(((1 * 4 + b) * 4 + h) * 64 + (63 - pc));
        { const int pp = tid >> 3, c8 = tid & 7;
          *(LAS u32x4*)(Qb + pp * 72 + c8 * 8) = *(const u32x4*)(Z + (tok0 + pp) * 2560 + 1024 + h * 64 + c8 * 8);
          *(LAS u32x4*)(Kb + pp * 72 + c8 * 8) = *(const u32x4*)(Z + (tok0 + pp) * 2560 + 1280 + h * 64 + c8 * 8); }
#pragma unroll
        for (int i = 0; i < 2; ++i) { const int pi = tid + NTHR * i, pp = pi >> 4, c8 = pi & 15; *(LAS u32x4*)(Vr + pp * 144 + c8 * 8) = *(const u32x4*)(Z + (tok0 + pp) * 2560 + 1536 + h * 128 + c8 * 8); }
#pragma unroll
        for (int i = 0; i < 2; ++i) { const int pi = tid + NTHR * i, v = pi >> 3, c8 = pi & 7;
            *(LAS u32x4*)(MC_CB(0) + v * 72 + c8 * 8) = *(const u32x4*)(CT + ua * 8192 + v * 64 + c8 * 8); *(LAS u32x4*)(MC_CB(1) + v * 72 + c8 * 8) = *(const u32x4*)(CT + ub * 8192 + v * 64 + c8 * 8); }
        float mst = 0.f;
        if (tid < 128) { const int d = tid >> 6; const size_t ud = d ? ub : ua; LAS float* sc = MC_SC(d);
            sc[lane] = LF[(tok0 + lane) * 8 + d * 4 + h]; sc[64 + lane] = LI[(tok0 + lane) * 8 + d * 4 + h]; sc[384 + lane] = NV[ud * 64 + lane]; mst = MS[65536 + ud]; }
        __syncthreads();
        bf16x8_t vb0, vb1; tr_frag2((unsigned)(unsigned long long)Vr, 288, wid, vb0, vb1);
        {
            const int t = tid >> 3, part = tid & 7; const u32x4 qv = *(const LAS u32x4*)(Qb + t * 72 + part * 8); float f[8]; unpack8(qv, f);
#pragma unroll
            for (int d = 0; d < 2; ++d) { LAS float* sc = MC_SC(d);
                const f32x4 n0 = *(const LAS f32x4*)(sc + 384 + part * 8), n1 = *(const LAS f32x4*)(sc + 384 + part * 8 + 4);
                float a = f[0] * n0.x; a = fmaf(f[1], n0.y, a); a = fmaf(f[2], n0.z, a); a = fmaf(f[3], n0.w, a); a = fmaf(f[4], n1.x, a); a = fmaf(f[5], n1.y, a); a = fmaf(f[6], n1.z, a); a = fmaf(f[7], n1.w, a);
                a += dppf<0xB1>(a); a += dppf<0x4E>(a); a += dppf<0x141>(a);
                if (part == 0) sc[320 + t] = a; } }
        if (tid < 128) {
            const int d = tid >> 6; LAS float* sc = MC_SC(d);
            const float bt = wave_scan_sum(sc[lane], d == 0);
            const float dmax = bt + wave_scan_max(sc[64 + lane] - bt, d == 0);
            const float m = fmaxf(bt + mst, dmax), w = __expf(bt + mst - m);
            sc[128 + lane] = bt; sc[192 + lane] = m; sc[256 + lane] = w * 0.125f; sc[448 + lane] = __expf(-m); }
        __syncthreads();
#pragma unroll 1
        for (int tt = 0; tt < 2; ++tt) { const int idx = wid * 2 + tt, mt = idx >> 2, nt = idx & 3;
            f32x4 scv = {0.f, 0.f, 0.f, 0.f};
            scv = mma_tile<64>(Qb + mt * 16 * 72, 72, Kb + nt * 16 * 72, 72, scv);
            const int s_ = nt * 16 + r;
#pragma unroll 1
            for (int d = 0; d < 2; ++d) { LAS float* sc = MC_SC(d); LAS unsigned short* Pb = MC_PB(d); const float bs = sc[128 + s_] - sc[64 + s_];
#pragma unroll
                for (int i = 0; i < 4; ++i) { const int t = mt * 16 + q * 4 + i; const bool ok = d ? (s_ >= t) : (s_ <= t);
                    const float pv = ok ? __expf(sc[128 + t] - bs - sc[192 + t]) * scv[i] * 0.125f : 0.f;
                    const unsigned short pb = f2bf(pv); Pb[t * 72 + s_] = pb;
                    const float rs = row16_sum(bf2f(pb));
                    if (r == 0) sc[512 + nt * 64 + t] = rs; } }
        }
        __syncthreads();
        f32x4 hacc[4];
#pragma unroll
        for (int mt = 0; mt < 4; ++mt) { hacc[mt] = (f32x4){0.f, 0.f, 0.f, 0.f};
            const bf16x8_t qa0 = *(const LAS bf16x8_t*)(Qb + (mt * 16 + r) * 72 + q * 8), qa1 = *(const LAS bf16x8_t*)(Qb + (mt * 16 + r) * 72 + 32 + q * 8);
#pragma unroll 1
            for (int d = 0; d < 2; ++d) { const LAS float* sc = MC_SC(d); const LAS unsigned short* Pb = MC_PB(d); const LAS unsigned short* Cb = MC_CB(d);
                f32x4 a1 = {0.f, 0.f, 0.f, 0.f}, a2 = {0.f, 0.f, 0.f, 0.f};
                const bf16x8_t cb0 = *(const LAS bf16x8_t*)(Cb + (wid * 16 + r) * 72 + q * 8), cb1 = *(const LAS bf16x8_t*)(Cb + (wid * 16 + r) * 72 + 32 + q * 8);
                a1 = __builtin_amdgcn_mfma_f32_16x16x32_bf16(qa0, cb0, a1, 0, 0, 0); a1 = __builtin_amdgcn_mfma_f32_16x16x32_bf16(qa1, cb1, a1, 0, 0, 0);
                const bf16x8_t pa0 = *(const LAS bf16x8_t*)(Pb + (mt * 16 + r) * 72 + q * 8), pa1 = *(const LAS bf16x8_t*)(Pb + (mt * 16 + r) * 72 + 32 + q * 8);
                a2 = __builtin_amdgcn_mfma_f32_16x16x32_bf16(pa0, vb0, a2, 0, 0, 0); a2 = __builtin_amdgcn_mfma_f32_16x16x32_bf16(pa1, vb1, a2, 0, 0, 0);
#pragma unroll
                for (int i = 0; i < 4; ++i) { const int t = mt * 16 + q * 4 + i;
                    const float den = sc[256 + t] * sc[320 + t] + ((sc[512 + t] + sc[576 + t]) + (sc[640 + t] + sc[704 + t]));
                    hacc[mt][i] += (sc[256 + t] * a1[i] + a2[i]) * __builtin_amdgcn_rcpf(fmaxf(fabsf(den), sc[448 + t])); }
            }
        }
#pragma unroll
        for (int mt = 0; mt < 4; ++mt)
#pragma unroll
            for (int i = 0; i < 4; ++i) { const float s = row16_sum(hacc[mt][i] * hacc[mt][i]); if (r == 0) ssp[wid * 64 + mt * 16 + q * 4 + i] = s; }
        __syncthreads();
        { const int v = wid * 16 + r; const float g = gn[v]; LAS unsigned short* Yt = MC_CB(0);
#pragma unroll
          for (int mt = 0; mt < 4; ++mt)
#pragma unroll
              for (int i = 0; i < 4; ++i) { const int t = mt * 16 + q * 4 + i;
                  float ss = 0.f;
#pragma unroll
                  for (int w = 0; w < 8; ++w) ss += ssp[w * 64 + t];
                  const float rstd = rsqrtf(ss * (1.0f / 128.0f) + 1e-6f);
                  Yt[t * 136 + v] = f2bf(hacc[mt][i] * rstd * g); } }
        __syncthreads();
#pragma unroll
        for (int i = 0; i < 2; ++i) { const int pi = tid + NTHR * i, t = pi >> 4, c8 = (pi & 15) * 8;
            const u32x4 yv = *(const LAS u32x4*)(MC_CB(0) + t * 136 + c8); const u32x4 ov = *(const u32x4*)(Z + (tok0 + t) * 2560 + 2048 + h * 128 + c8);
            float y[8], o[8]; unpack8(yv, y); unpack8(ov, o);
            u32x4 w; w.x = pk2(y[0] * sigm_f(o[0]), y[1] * sigm_f(o[1])); w.y = pk2(y[2] * sigm_f(o[2]), y[3] * sigm_f(o[3])); w.z = pk2(y[4] * sigm_f(o[4]), y[5] * sigm_f(o[5])); w.w = pk2(y[6] * sigm_f(o[6]), y[7] * sigm_f(o[7]));
            *(u32x4*)(Y + (tok0 + t) * 1024 + 512 + h * 128 + c8) = w; }
        __syncthreads();
    }
#undef MC_CB
#undef MC_PB
#undef MC_SC
}
__device__ __forceinline__ void headnorm_phase(const Params& p, const float* __restrict__ g, int zld, int zcol, int act) {
    const bf16_t* OF = (const bf16_t*)(p.ws + WS_OF); const bf16_t* OB = (const bf16_t*)(p.ws + WS_OB); const bf16_t* Z = (const bf16_t*)(p.ws + WS_Z); bf16_t* Y = (bf16_t*)(p.ws + WS_HN);
    const int tid = threadIdx.x, lane = tid & 63, wid = tid >> 6, c = lane * 8;
    const f32x4 g0 = *(const f32x4*)(g + (c & 127)), g1 = *(const f32x4*)(g + (c & 127) + 4);
    for (int tok = blockIdx.x * 8 + wid; tok < T_; tok += gridDim.x * 8) {
        const u32x4 a = *(const u32x4*)(OF + (size_t)tok * 512 + c), bq = *(const u32x4*)(OB + (size_t)tok * 512 + c), gz = *(const u32x4*)(Z + (size_t)tok * zld + zcol + c);
        float fa[8], fb[8], fg[8], o[8]; unpack8(a, fa); unpack8(bq, fb); unpack8(gz, fg);
        float ss = 0.f;
#pragma unroll
        for (int i = 0; i < 8; ++i) { o[i] = fa[i] + fb[i]; ss = fmaf(o[i], o[i], ss); }
        ss = row16_sum(ss);
        const float rstd = rsqrtf(ss * (1.0f / 128.0f) + 1e-6f);
        const float gg[8] = {g0.x, g0.y, g0.z, g0.w, g1.x, g1.y, g1.z, g1.w};
        float y[8];
#pragma unroll
        for (int i = 0; i < 8; ++i) y[i] = o[i] * rstd * gg[i] * (act == 0 ? fg[i] * sigm_f(fg[i]) : sigm_f(fg[i]));
        u32x4 w; w.x = pk2(y[0], y[1]); w.y = pk2(y[2], y[3]); w.z = pk2(y[4], y[5]); w.w = pk2(y[6], y[7]);
        *(u32x4*)(Y + (size_t)tok * 1024 + 512 + c) = w;
    }
}

__device__ __forceinline__ void odd_prep(const Params& p) {
    const bf16_t* Z = (const bf16_t*)(p.ws + WS_Z); bf16_t* VV = (bf16_t*)(p.ws + WS_QKV);
    const float* gates = (const float*)(p.ws + WS_GATES); float* LI = (float*)(p.ws + WS_BETA); float* LF = (float*)(p.ws + WS_LA);
    const float* ln_g = p.in[13]; const float* ln_b = p.in[14]; const float* ib = p.in[17]; const float* fb = p.in[18];
    const int tid = threadIdx.x, lane = tid & 63, wid = tid >> 6, c = lane * 8;
    const f32x4 g0 = *(const f32x4*)(ln_g + c), g1 = *(const f32x4*)(ln_g + c + 4), b0 = *(const f32x4*)(ln_b + c), b1 = *(const f32x4*)(ln_b + c + 4);
    const float gg[8] = {g0.x, g0.y, g0.z, g0.w, g1.x, g1.y, g1.z, g1.w}, bb[8] = {b0.x, b0.y, b0.z, b0.w, b1.x, b1.y, b1.z, b1.w};
    for (int tok = blockIdx.x * 8 + wid; tok < T_; tok += gridDim.x * 8) {
        const u32x4 v = *(const u32x4*)(Z + (size_t)tok * 2560 + 512 + c);
        float x[8]; unpack8(v, x); float sm = 0.f;
#pragma unroll
        for (int i = 0; i < 8; ++i) { x[i] = gelu_t(x[i]); sm += x[i]; }
        const float mean = wave_sum(sm) * (1.0f / 512.0f); float sq = 0.f;
#pragma unroll
        for (int i = 0; i < 8; ++i) { x[i] -= mean; sq = fmaf(x[i], x[i], sq); }
        const float rstd = rsqrtf(wave_sum(sq) * (1.0f / 512.0f) + 1e-5f);
        float y[8];
#pragma unroll
        for (int i = 0; i < 8; ++i) y[i] = x[i] * rstd * gg[i] + bb[i];
        u32x4 w; w.x = pk2(y[0], y[1]); w.y = pk2(y[2], y[3]); w.z = pk2(y[4], y[5]); w.w = pk2(y[6], y[7]);
        *(u32x4*)(VV + (size_t)tok * 512 + c) = w;
        if (lane < 8) { LI[(size_t)tok * 8 + lane] = gates[(size_t)tok * 16 + lane] + ib[lane];
                        LF[(size_t)tok * 8 + lane] = -softplus_(-(gates[(size_t)tok * 16 + 8 + lane] + fb[lane])); }
    }
}

__device__ __forceinline__ void sg_phase(LDSp lds, const Params& p, int sgId, int sgG) {
    typedef short bf16x8 __attribute__((ext_vector_type(8)));
    const bf16_t* Z = (const bf16_t*)(p.ws + WS_Z); const bf16_t* VV = (const bf16_t*)(p.ws + WS_QKV); bf16_t* Y = (bf16_t*)(p.ws + WS_HN);
    const float* sgw = p.in[15]; const float* sgb = p.in[16];
    LAS unsigned short* Wb = (LAS unsigned short*)lds;
    LAS unsigned short* Vt = (LAS unsigned short*)(lds + 34816);
    const int tid = threadIdx.x, lane = tid & 63, wid = tid >> 6;
    for (int unit = sgId; unit < 512; unit += sgG) {
        const int g = unit & 3, n = (unit >> 2) & 31, b = unit >> 7; const size_t tok0 = (size_t)b * S_ + n * 128;
#pragma unroll
        for (int i = 0; i < 8; ++i) { const int i4 = tid + NTHR * i, t = i4 >> 5, s4 = (i4 & 31) << 2; const f32x4 w = *(const f32x4*)(sgw + (size_t)g * 16384 + t * 128 + s4);
            u32x2 o; o.x = pk2(w.x, w.y); o.y = pk2(w.z, w.w); *(LAS u32x2*)(Wb + t * 136 + s4) = o; }
#pragma unroll
        for (int i = 0; i < 4; ++i) { const int pi = tid + NTHR * i, s = pi >> 4, c8 = (pi & 15) << 3; const u32x4 v = *(const u32x4*)(VV + (tok0 + s) * 512 + g * 128 + c8);
            Vt[(c8 + 0) * 136 + s] = (unsigned short)(v.x & 0xffffu); Vt[(c8 + 1) * 136 + s] = (unsigned short)(v.x >> 16);
            Vt[(c8 + 2) * 136 + s] = (unsigned short)(v.y & 0xffffu); Vt[(c8 + 3) * 136 + s] = (unsigned short)(v.y >> 16);
            Vt[(c8 + 4) * 136 + s] = (unsigned short)(v.z & 0xffffu); Vt[(c8 + 5) * 136 + s] = (unsigned short)(v.z >> 16);
            Vt[(c8 + 6) * 136 + s] = (unsigned short)(v.w & 0xffffu); Vt[(c8 + 7) * 136 + s] = (unsigned short)(v.w >> 16); }
        __syncthreads();
        bf16x8 af[4];
#pragma unroll
        for (int ks = 0; ks < 4; ++ks) af[ks] = *(const LAS bf16x8*)(Wb + (16 * wid + (lane & 15)) * 136 + ks * 32 + (lane >> 4) * 8);
        f32x4 accs[8];
#pragma unroll
        for (int nn = 0; nn < 8; ++nn) {
            f32x4 acc = {0.f, 0.f, 0.f, 0.f};
#pragma unroll
            for (int ks = 0; ks < 4; ++ks) { const bf16x8 bfrag = *(const LAS bf16x8*)(Vt + (16 * nn + (lane & 15)) * 136 + ks * 32 + (lane >> 4) * 8);
                acc = __builtin_amdgcn_mfma_f32_16x16x32_bf16(af[ks], bfrag, acc, 0, 0, 0); }
            accs[nn] = acc; }
        __syncthreads();
#pragma unroll
        for (int nn = 0; nn < 8; ++nn)
#pragma unroll
            for (int i = 0; i < 4; ++i) { const int t = 16 * wid + (lane >> 4) * 4 + i; Wb[t * 136 + 16 * nn + (lane & 15)] = f2bf(accs[nn][i] + sgb[g * 128 + t]); }
        __syncthreads();
#pragma unroll
        for (int i = 0; i < 4; ++i) { const int pi = tid + NTHR * i, t = pi >> 4, c8 = (pi & 15) << 3; const size_t tok = tok0 + t;
            const u32x4 mv = *(const LAS u32x4*)(Wb + t * 136 + c8); const u32x4 uv = *(const u32x4*)(Z + tok * 2560 + g * 128 + c8);
            float m[8], u[8]; unpack8(mv, m); unpack8(uv, u);
            u32x4 w; w.x = pk2(gelu_t(u[0]) * m[0], gelu_t(u[1]) * m[1]); w.y = pk2(gelu_t(u[2]) * m[2], gelu_t(u[3]) * m[3]); w.z = pk2(gelu_t(u[4]) * m[4], gelu_t(u[5]) * m[5]); w.w = pk2(gelu_t(u[6]) * m[6], gelu_t(u[7]) * m[7]);
            *(u32x4*)(Y + tok * 1024 + g * 128 + c8) = w; }
        __syncthreads();
    }
}

#define XB_TMO      128
#define XB_XCNT(j)  (256  + 64 * (j))
#define XB_XSUB(j)  (1280 + 64 * (j))
#define XB_XGEN(j)  (2304 + 64 * (j))
#define XB_TOP      3328
#define XB_TOPGEN   3392
#define XCD_BAR_WORDS 3456
#define XB_SPIN_CAP (1u << 18)

__device__ __forceinline__ unsigned xb_ld(unsigned* p)              { return __hip_atomic_load(p, __ATOMIC_RELAXED, __HIP_MEMORY_SCOPE_AGENT); }
__device__ __forceinline__ unsigned xb_add(unsigned* p, unsigned v) { return __hip_atomic_fetch_add(p, v, __ATOMIC_RELAXED, __HIP_MEMORY_SCOPE_AGENT); }
__device__ __forceinline__ unsigned xb_xcc_id() { return (unsigned)__builtin_amdgcn_s_getreg((3 << 11) | 20) & 0xFu; }
#define XB_SPIN(cond, bar) do { unsigned _sp = 0; while (cond) { __builtin_amdgcn_s_sleep(1); \
    if ((++_sp & 255u) == 0u) { if (xb_ld(&(bar)[XB_TMO])) break; if (_sp > XB_SPIN_CAP) { atomicAdd(&(bar)[XB_TMO], 1u); break; } } } } while (0)

struct XcdBarrier {
    unsigned* bar; unsigned x;
    volatile LAS unsigned* st;
};

__device__ __forceinline__ XcdBarrier xcd_barrier_post(unsigned* bar, volatile LAS unsigned* st) {
    XcdBarrier b; b.bar = bar; b.x = xb_xcc_id(); b.st = st;
    if (threadIdx.x == 0) (void)xb_add(&bar[XB_XCNT(b.x)], 1u);
    return b;
}
__device__ __forceinline__ void xcd_barrier_complete(unsigned* bar, unsigned x, unsigned& nloc, unsigned& nx) {
    const unsigned G = gridDim.x * gridDim.y * gridDim.z;
    unsigned sum, cnt, mine, sp = 0u;
    for (;;) {
        sum = 0u; cnt = 0u; mine = 0u;
#pragma unroll
        for (unsigned j = 0; j < 16; ++j) { const unsigned c = xb_ld(&bar[XB_XCNT(j)]); sum += c; cnt += (c > 0u) ? 1u : 0u; mine = (j == x) ? c : mine; }
        if (sum == G) break;
        __builtin_amdgcn_s_sleep(1);
        if ((++sp & 255u) == 0u) { if (xb_ld(&bar[XB_TMO])) break; if (sp > XB_SPIN_CAP) { atomicAdd(&bar[XB_TMO], 1u); break; } }
    }
    nloc = mine > 0u ? mine : 1u; nx = cnt > 0u ? cnt : 1u;
}

__device__ __forceinline__ void xcd_barrier(const XcdBarrier& b) {
    asm volatile("s_waitcnt vmcnt(0)" ::: "memory");
    __syncthreads();
    if (threadIdx.x == 0) {
        unsigned* bar = b.bar;
        __builtin_amdgcn_s_waitcnt(0);
        unsigned nloc = b.st[0], nx = b.st[1];
        if (nloc == 0u) { xcd_barrier_complete(bar, b.x, nloc, nx); b.st[0] = nloc; b.st[1] = nx; }
        const unsigned old = xb_add(&bar[XB_XSUB(b.x)], 1u);
        const unsigned gen = old / nloc;
        if (old + 1u == (gen + 1u) * nloc) {
            __builtin_amdgcn_fence(__ATOMIC_RELEASE, "agent");
            asm volatile("s_waitcnt vmcnt(0)" ::: "memory");
            const unsigned og = xb_add(&bar[XB_TOP], 1u);
            const unsigned tg = og / nx;
            if (og + 1u == (tg + 1u) * nx) xb_add(&bar[XB_TOPGEN], 1u);
            else XB_SPIN(xb_ld(&bar[XB_TOPGEN]) == tg, bar);
            __builtin_amdgcn_fence(__ATOMIC_ACQUIRE, "agent");
            xb_add(&bar[XB_XGEN(b.x)], 1u);
            asm volatile("s_waitcnt vmcnt(0)" ::: "memory");
        } else {
            XB_SPIN(xb_ld(&bar[XB_XGEN(b.x)]) == gen, bar);
            __builtin_amdgcn_fence(__ATOMIC_ACQUIRE, "agent");
            asm volatile("s_waitcnt vmcnt(0)" ::: "memory");
        }
    }
    __syncthreads();
}
constexpr size_t WS_BAR = 238 * MiB;
#ifndef N_PHASES
#define N_PHASES 21
#endif
template <int L, int SUB> __device__ __forceinline__ void run_phase(LDSp lds, const Params& p) {
    unsigned char* ws = p.ws;
    bf16_t* HN = (bf16_t*)(ws + WS_HN); bf16_t* Zb = (bf16_t*)(ws + WS_Z); float* h = p.out; float* gates = (float*)(ws + WS_GATES);
    const bf16_t* W_IN = (const bf16_t*)(ws + WS_WB + WB_IN); const bf16_t* W_OUT = (const bf16_t*)(ws + WS_WB + WB_OUT);
    const bf16_t* W_UP = (const bf16_t*)(ws + WS_WB + WB_UP); const bf16_t* W_DN = (const bf16_t*)(ws + WS_WB + WB_DN);
    const int G = gridDim.x;
    if constexpr (L == 2) { rms_phase(lds, h, p.in[25], nullptr, nullptr, h, nullptr, 0, 0, nullptr); }
    else if constexpr (SUB == 0) {
        convert_layer(lds, p, L);
        if constexpr (L == 0) rms_phase(lds, p.in[0], p.in[1], HN, nullptr, nullptr, p.in[2], 3088, 3072, gates);
        else                  rms_phase(lds, h, p.in[1] + 1024, HN, nullptr, nullptr, p.in[12], 2576, 2560, gates);
    } else if constexpr (SUB == 1) { constexpr int N = L == 0 ? 3072 : 2560;
        pg8::Gemm g{HN, W_IN, T_, N, 1024}; pg8::StaticOrder S; S.init(T_, N, G, (int)blockIdx.x);
        pg8::EpiBf16<0> E{Zb, N, nullptr, 0, 0};
        pg8::gemm_phase<pg8::EpiBf16<0>, pg8::StaticOrder>(lds, g, S, E, nullptr);
    } else if constexpr (SUB == 2) { if constexpr (L == 0) even_prep(lds, p); else odd_prep(p); }
    else if constexpr (SUB == 9) { delta_prep(lds, p); }
    else if constexpr (SUB == 10) { mlstm_b(p); }
    else if constexpr (SUB == 11) { mlstm_c(lds, p); }
    else if constexpr (SUB == 3) {
        if constexpr (L == 0) delta_scan2(lds, p);
        else { mlstm_a(lds, p); sg_phase(lds, p, (int)blockIdx.x, G); }
    } else if constexpr (SUB == 4) { if constexpr (L == 0) headnorm_phase(p, p.in[10], 3072, 2560, 0); else headnorm_phase(p, p.in[19], 2560, 2048, 1); }
    else if constexpr (SUB == 5) { pg8::Gemm g{HN, W_OUT, T_, 1024, 1024}; pg8::StaticOrder S; S.init(T_, 1024, G, (int)blockIdx.x);
        pg8::EpiAddF32 E{h, 1024, L == 0 ? p.in[0] : (const float*)h};
        pg8::gemm_phase<pg8::EpiAddF32, pg8::StaticOrder>(lds, g, S, E, nullptr);
    } else if constexpr (SUB == 6) { rms_phase(lds, h, p.in[21] + L * 1024, HN, nullptr, nullptr, nullptr, 0, 0, nullptr); }
    else if constexpr (SUB == 7) { pg8::Gemm g{HN, W_UP, T_, 2 * DFF, 1024}; pg8::StaticOrder S; S.init(T_, 2 * DFF, G, (int)blockIdx.x);
        pg8::EpiSwiGLU E{Zb, DFF};
        pg8::gemm_phase<pg8::EpiSwiGLU, pg8::StaticOrder>(lds, g, S, E, nullptr);
    } else if constexpr (SUB == 8) { pg8::Gemm g{Zb, W_DN, T_, 1024, DFF}; pg8::StaticOrder S; S.init(T_, 1024, G, (int)blockIdx.x);
        pg8::EpiAddF32 E{h, 1024, (const float*)h};
        pg8::gemm_phase<pg8::EpiAddF32, pg8::StaticOrder>(lds, g, S, E, nullptr);
    }
}
__global__ void __launch_bounds__(NTHR, 2) mega(Params p, int ph_lo, int ph_hi) {
    extern __shared__ __attribute__((aligned(16))) unsigned char lds_raw[];
    LDSp lds = (LDSp)lds_raw;
    cg::grid_group grid = cg::this_grid();
    volatile LAS unsigned* xst = (volatile LAS unsigned*)(lds + LDS_BYTES - 16);
    if (threadIdx.x == 0) { xst[0] = 0u; xst[1] = 0u; }
    __syncthreads();
    XcdBarrier xbar; xbar.bar = (unsigned*)(p.ws + WS_BAR); xbar.x = 0; xbar.st = xst;
    if (ph_hi - ph_lo > 1) xbar = xcd_barrier_post((unsigned*)(p.ws + WS_BAR), xst);
#ifndef REP_MASK
#define REP_MASK 0
#endif
#define PH(k, L, SUB) if (ph_lo <= (k) && (k) < ph_hi) { run_phase<L, SUB>(lds, p); if ((REP_MASK >> (k)) & 1) { __syncthreads(); run_phase<L, SUB>(lds, p); } if ((k) + 1 < ph_hi) { if (ph_lo < 0) grid.sync(); else xcd_barrier(xbar); } }
    PH(0, 0, 0) PH(1, 0, 1) PH(2, 0, 2) PH(3, 0, 9) PH(4, 0, 3) PH(5, 0, 4) PH(6, 0, 5) PH(7, 0, 6) PH(8, 0, 7) PH(9, 0, 8)
    PH(10, 1, 0) PH(11, 1, 1) PH(12, 1, 2) PH(13, 1, 3) PH(14, 1, 10) PH(15, 1, 11)
    PH(16, 1, 5) PH(17, 1, 6) PH(18, 1, 7) PH(19, 1, 8)
    PH(20, 2, 0)
#ifdef EXTRA_SYNCS
    for (int i_ = 0; i_ < EXTRA_SYNCS; ++i_) grid.sync();
#endif
#undef PH
}

extern "C" void kernel_launch(void* const* d_in, const int* in_sizes, int n_in, void* d_out, int out_size, void* d_ws, size_t ws_size, hipStream_t stream) {
    static int grid = 0;
    if (grid == 0) {
        int dev = 0, cus = 0, per_cu = 0;
        (void)hipGetDevice(&dev);
        (void)hipDeviceGetAttribute(&cus, hipDeviceAttributeMultiprocessorCount, dev);
        (void)hipFuncSetAttribute((const void*)mega, hipFuncAttributeMaxDynamicSharedMemorySize, LDS_BYTES);
        if (hipOccupancyMaxActiveBlocksPerMultiprocessor(&per_cu, (const void*)mega, NTHR, LDS_BYTES) != hipSuccess || per_cu < 1) per_cu = 1;
        (void)hipGetLastError();
        if (cus <= 0) cus = 256;
        grid = cus * per_cu;
    }
    if (ws_size < 239 * MiB) { fprintf(stderr, "workspace too small: %zu\n", ws_size); return; }
    Params p{};
    for (int i = 0; i < 26; ++i) p.in[i] = (const float*)d_in[i];
    p.out = (float*)d_out; p.ws = (unsigned char*)d_ws;
#if defined(MULTI_LAUNCH)
    for (int ph = 0; ph < N_PHASES; ++ph) hipLaunchKernelGGL(mega, dim3(grid), dim3(NTHR), LDS_BYTES, stream, p, ph, ph + 1);
#else
    (void)hipMemsetAsync((char*)d_ws + WS_BAR, 0, XCD_BAR_WORDS * 4, stream);
    int lo = 0, hi = N_PHASES;
    void* args[] = {(void*)&p, (void*)&lo, (void*)&hi};
    hipError_t e = hipLaunchCooperativeKernel((const void*)mega, dim3(grid), dim3(NTHR), args, LDS_BYTES, stream);
    if (e != hipSuccess) fprintf(stderr, "cooperative launch failed: %s (grid %d)\n", hipGetErrorString(e), grid);
#endif
}
```

```cpp
#include <hip/hip_runtime.h>
#include <hip/hip_cooperative_groups.h>
#include <cstdio>
namespace cg = cooperative_groups;
namespace pg8 {
#define PG8_LAS __attribute__((address_space(3)))
typedef unsigned short bf16_t;
typedef short bf16x8 __attribute__((ext_vector_type(8)));
typedef float f32x4 __attribute__((ext_vector_type(4)));
typedef unsigned u32x4 __attribute__((ext_vector_type(4)));
constexpr int BM = 256, BK = 64, HALF = 128, HTB = HALF * BK * 2  , STAGE_BYTES = 8 * HTB, NXCD = 8, WGM = 8;

__host__ __device__ __forceinline__ int lds_byte(int r, int c) { const int st = (r >> 4) * 2 + (c >> 5), rr = r & 15, cc = c & 31, ob = rr * 64 + cc * 2; return st * 1024 + (ob ^ (((ob >> 9) & 1) << 5)); }
__host__ __device__ __forceinline__ void stage_rc(int b, int& R, int& C) { const int st = b / 1024, sb = b % 1024, swz = sb ^ (((sb >> 9) & 1) << 5); R = (st >> 1) * 16 + swz / 64; C = (st & 1) * 32 + (swz % 64) / 2; }
__host__ __device__ __forceinline__ int perm32(int rho) { const int n = rho >> 4, i = rho & 15; return 8 * (i >> 2) + 4 * n + (i & 3); }

struct Unit { int pm, pn; };
struct Gemm { const bf16_t* A; const bf16_t* Bt; int M, N, K; };

struct StaticOrder {
    int nM, nN, nwg, G, c;
    __host__ __device__ void init(int M, int N, int G_, int c_) { nM = M / BM; nN = N / BM; nwg = nM * nN; G = G_; c = c_; }
    __host__ __device__ bool next(int i, Unit& u) const {
        const long L = (long)i * G + c; if (L >= nwg) return false;
        int wgid = (int)L; { const int q = nwg / NXCD, r = nwg % NXCD, xcd = wgid % NXCD, off = wgid / NXCD; wgid = (xcd < r ? xcd * (q + 1) : r * (q + 1) + (xcd - r) * q) + off; }
        const int nig = WGM * nN, gid = wgid / nig, fm = gid * WGM, gsz = (nM - fm) < WGM ? (nM - fm) : WGM;
        u.pm = fm + ((wgid % nig) % gsz); u.pn = (wgid % nig) / gsz; return true;
    }
    __device__ __forceinline__ void a_ready(const Unit&) const {}
    __device__ __forceinline__ void done(const Unit&) const {}
};
__device__ __forceinline__ unsigned cvt_pk_bf16(float lo, float hi) { unsigned r; asm volatile("v_cvt_pk_bf16_f32 %0, %1, %2" : "=v"(r) : "v"(lo), "v"(hi)); return r; }
typedef float f32x2 __attribute__((ext_vector_type(2)));
__device__ __forceinline__ f32x2 gelu_pk(f32x2 v) {
    const f32x2 av = __builtin_elementwise_abs(v), d = av * 0.2316418882f + 1.0f;
    f32x2 t; t.x = __builtin_amdgcn_rcpf(d.x); t.y = __builtin_amdgcn_rcpf(d.y);
    f32x2 q = t * 0.5307027145f + (-0.7265760135f); q = q * t + 0.7107068705f; q = q * t + (-0.142248368f); q = q * t + 0.127414796f; q = q * t;
    const f32x2 s = (v * v) * (-0.72134752044f);
    f32x2 e; e.x = __builtin_amdgcn_exp2f(s.x); e.y = __builtin_amdgcn_exp2f(s.y);
    const f32x2 m = v * (q * e), r = v - m;
    f32x2 o; o.x = v.x < 0.f ? m.x : r.x; o.y = v.y < 0.f ? m.y : r.y; return o;
}
template <int ACT  > struct EpiBf16 {
    static constexpr bool PERM = true, AFTER_DRAIN = false;
    bf16_t* O; int ldc; const float* bias; int split_cols; size_t split_stride;
    __device__ __forceinline__ void operator()(const f32x4 (&acc)[2][2][4][2], const Unit& u, int wr, int wc, int fr, int fq) const {
        const int row0 = u.pm * BM + wr * 64 + fr; int colt = u.pn * BM; bf16_t* base = O;
        if (split_cols) { const int t = colt / split_cols; base += (size_t)t * split_stride; colt -= t * split_cols; }
        const int col0 = colt + wc * 32 + 8 * fq, bcol0 = u.pn * BM + wc * 32 + 8 * fq;
        f32x4 bv[2][2];
#pragma unroll
        for (int bj = 0; bj < 2; ++bj)
#pragma unroll
            for (int n = 0; n < 2; ++n) bv[bj][n] = bias ? *(const f32x4*)(bias + bcol0 + bj * HALF + 4 * n) : (f32x4){0.f, 0.f, 0.f, 0.f};
#pragma unroll
        for (int ai = 0; ai < 2; ++ai)
#pragma unroll
            for (int m = 0; m < 4; ++m) { bf16_t* rowp = base + (size_t)(row0 + ai * HALF + m * 16) * ldc + col0;
#pragma unroll
                for (int bj = 0; bj < 2; ++bj) { f32x4 v0 = acc[ai][bj][m][0] + bv[bj][0], v1 = acc[ai][bj][m][1] + bv[bj][1];
                    if (ACT == 1) { f32x2 a = gelu_pk((f32x2){v0[0], v0[1]}), b = gelu_pk((f32x2){v0[2], v0[3]}), c = gelu_pk((f32x2){v1[0], v1[1]}), d = gelu_pk((f32x2){v1[2], v1[3]});
                        v0 = (f32x4){a.x, a.y, b.x, b.y}; v1 = (f32x4){c.x, c.y, d.x, d.y}; }
                    if (ACT == 2) {
#pragma unroll
                        for (int j = 0; j < 4; ++j) { v0[j] = 0.5f * v0[j] * (1.0f + erff(v0[j] * 0.70710678f)); v1[j] = 0.5f * v1[j] * (1.0f + erff(v1[j] * 0.70710678f)); } }
                    u32x4 w; w.x = cvt_pk_bf16(v0[0], v0[1]); w.y = cvt_pk_bf16(v0[2], v0[3]); w.z = cvt_pk_bf16(v1[0], v1[1]); w.w = cvt_pk_bf16(v1[2], v1[3]);
                    *(u32x4*)(rowp + bj * HALF) = w; } }
    }
};
struct EpiAddF32 {
    static constexpr bool PERM = false, AFTER_DRAIN = false;
    float* C; int ldc; const float* R;
    __device__ __forceinline__ void operator()(const f32x4 (&acc)[2][2][4][2], const Unit& u, int wr, int wc, int fr, int fq) const {
        const int row0 = u.pm * BM + wr * 64 + fr, col0 = u.pn * BM + wc * 32 + 4 * fq;
#pragma unroll
        for (int ai = 0; ai < 2; ++ai)
#pragma unroll
            for (int m = 0; m < 4; ++m) { const size_t ro = (size_t)(row0 + ai * HALF + m * 16) * ldc + col0; float* rowp = C + ro; const float* srcp = R + ro;
#pragma unroll
                for (int bj = 0; bj < 2; ++bj)
#pragma unroll
                    for (int n = 0; n < 2; ++n) { const f32x4 o = *(const f32x4*)(srcp + bj * HALF + n * 16); *(f32x4*)(rowp + bj * HALF + n * 16) = o + acc[ai][bj][m][n]; } }
    }
};
struct EpiSwiGLU {
    static constexpr bool PERM = true, AFTER_DRAIN = false;
    bf16_t* H; int ldh;
    __device__ __forceinline__ void operator()(const f32x4 (&acc)[2][2][4][2], const Unit& u, int wr, int wc, int fr, int fq) const {
        const int row0 = u.pm * BM + wr * 64 + fr, hcol = u.pn * HALF + wc * 32 + 8 * fq;
#pragma unroll
        for (int ai = 0; ai < 2; ++ai)
#pragma unroll
            for (int m = 0; m < 4; ++m) { bf16_t* rowp = H + (size_t)(row0 + ai * HALF + m * 16) * ldh + hcol;
                float h[8];
#pragma unroll
                for (int n = 0; n < 2; ++n) { const f32x4 a = acc[ai][0][m][n], b = acc[ai][1][m][n];
#pragma unroll
                    for (int j = 0; j < 4; ++j) h[4 * n + j] = a[j] * __builtin_amdgcn_rcpf(1.0f + __expf(-a[j])) * b[j]; }
                u32x4 w; w.x = cvt_pk_bf16(h[0], h[1]); w.y = cvt_pk_bf16(h[2], h[3]); w.z = cvt_pk_bf16(h[4], h[5]); w.w = cvt_pk_bf16(h[6], h[7]);
                *(u32x4*)rowp = w; }
    }
};
template <class Epi, class Sched, bool STAMP = false>
__device__ __forceinline__ void gemm_phase(PG8_LAS unsigned char* lds, const Gemm g, const Sched& S, const Epi& E, unsigned long long* stamps) {
    const int tid = threadIdx.x, wid = __builtin_amdgcn_readfirstlane(tid >> 6), lane = tid & 63, wr = wid >> 2, wc = wid & 3, fr = lane & 15, fq = lane >> 4;
    const int K = g.K, nt = K / BK;
    int ts_lo = 0, ts_hi = 0, nts = 0; const unsigned long long rt_entry = STAMP ? (unsigned long long)wall_clock64() : 0ull;
#define PG8_STAMP() do { if (STAMP && wid == 0 && nts < 64) { const unsigned long long _c = (unsigned long long)clock64(); \
        ts_lo = (lane == nts) ? (int)(unsigned)_c : ts_lo; ts_hi = (lane == nts) ? (int)(unsigned)(_c >> 32) : ts_hi; ++nts; } } while (0)
    PG8_STAMP();
    unsigned voffA[2], voffB[2];
#pragma unroll
    for (int i = 0; i < 2; ++i) { int R, C; stage_rc(tid * 16 + i * 8192, R, C); const int Rb = Epi::PERM ? ((R & ~31) + perm32(R & 31)) : R;
        voffA[i] = (unsigned)(R * K + C) * 2u; voffB[i] = (unsigned)(Rb * K + C) * 2u; }
    const size_t kstep = (size_t)(BK * 2);
    const size_t hstep = (size_t)HALF * K * 2;
    const size_t tstep = 2 * hstep;
    const unsigned ldsw = (unsigned)wid * 1024u;
    const int aoff = lds_byte(wr * 64 + fr, fq * 8), boff = lds_byte(wc * 32 + fr, fq * 8);
#define PG8_SA(b, h) (((b) * 2 + (h)) * HTB)
#define PG8_SB(b, h) ((4 + (b) * 2 + (h)) * HTB)
#define PG8_STAGE(bufoff, gbase, voff) do { _Pragma("unroll") for (int _i = 0; _i < 2; ++_i) \
        __builtin_amdgcn_global_load_lds((const unsigned*)((const char*)(gbase) + (voff)[_i]), (PG8_LAS unsigned*)(lds + (bufoff) + ldsw + _i * 8192), 16, 0, 0); } while (0)
#define PG8_LDA(dst, b, h) do { _Pragma("unroll") for (int m = 0; m < 4; ++m) _Pragma("unroll") for (int k = 0; k < 2; ++k) dst[m][k] = *(const PG8_LAS bf16x8*)(lds + PG8_SA(b, h) + aoff + m * 2048 + k * 1024); } while (0)
#define PG8_LDB(dst, b, h) do { _Pragma("unroll") for (int n = 0; n < 2; ++n) _Pragma("unroll") for (int k = 0; k < 2; ++k) dst[n][k] = *(const PG8_LAS bf16x8*)(lds + PG8_SB(b, h) + boff + n * 2048 + k * 1024); } while (0)
#define PG8_MMA(ai, bj, At, Bt) do { __builtin_amdgcn_s_setprio(1); _Pragma("unroll") for (int m = 0; m < 4; ++m) _Pragma("unroll") for (int n = 0; n < 2; ++n) _Pragma("unroll") for (int k = 0; k < 2; ++k) \
        acc[ai][bj][m][n] = __builtin_amdgcn_mfma_f32_16x16x32_bf16(Bt[n][k], At[m][k], acc[ai][bj][m][n], 0, 0, 0); __builtin_amdgcn_s_setprio(0); } while (0)
#define PG8_WAIT_V(n) asm volatile("s_waitcnt vmcnt(" #n ")" ::: "memory")
#define PG8_WAIT_L(n) asm volatile("s_waitcnt lgkmcnt(" #n ")" ::: "memory")
#define PG8_BAR __builtin_amdgcn_s_barrier()
#define PG8_SCHED __builtin_amdgcn_sched_barrier(0)
    Unit cur, nxt; int ui = 0;
    if (!S.next(0, cur)) return;
    f32x4 acc[2][2][4][2];
#pragma unroll
    for (int a = 0; a < 2; ++a)
#pragma unroll
        for (int b = 0; b < 2; ++b)
#pragma unroll
            for (int m = 0; m < 4; ++m)
#pragma unroll
                for (int n = 0; n < 2; ++n) acc[a][b][m][n] = (f32x4){0.f, 0.f, 0.f, 0.f};
    bf16x8 At[4][2], B0[2][2], B1[2][2];
    const char* cA = (const char*)g.A + (size_t)cur.pm * tstep; const char* cB = (const char*)g.Bt + (size_t)cur.pn * tstep;
    S.a_ready(cur);
    PG8_STAGE(PG8_SB(0, 0), cB, voffB); PG8_STAGE(PG8_SA(0, 0), cA, voffA); PG8_STAGE(PG8_SB(0, 1), cB + hstep, voffB); PG8_STAGE(PG8_SA(0, 1), cA + hstep, voffA);
    if (wr == 1) PG8_BAR;
    PG8_WAIT_V(4); PG8_BAR;
    PG8_STAGE(PG8_SB(1, 0), cB + kstep, voffB); PG8_STAGE(PG8_SA(1, 0), cA + kstep, voffA); PG8_STAGE(PG8_SB(1, 1), cB + hstep + kstep, voffB);
    PG8_WAIT_V(6); PG8_BAR;
    PG8_STAMP();
    for (;;) {
        const bool has_next = S.next(ui + 1, nxt);
        const char* nA = has_next ? (const char*)g.A + (size_t)nxt.pm * tstep : cA; const char* nB = has_next ? (const char*)g.Bt + (size_t)nxt.pn * tstep : cB;
        for (int t = 0; t < nt; t += 2) {
            const bool last = (t == nt - 2);
            const char* a1 = cA + (size_t)(t + 1) * kstep;
            const char* a2 = last ? nA : cA + (size_t)(t + 2) * kstep; const char* b2 = last ? nB : cB + (size_t)(t + 2) * kstep;
            const char* a3 = a2 + kstep; const char* b3 = b2 + kstep;
            if (last && has_next) S.a_ready(nxt);
            PG8_LDB(B0, 0, 0); PG8_SCHED; PG8_LDA(At, 0, 0); PG8_STAGE(PG8_SA(1, 1), a1 + hstep, voffA);
            PG8_WAIT_L(8); PG8_BAR; PG8_WAIT_L(0); PG8_MMA(0, 0, At, B0); PG8_BAR; PG8_SCHED;
            PG8_LDB(B1, 0, 1); PG8_STAGE(PG8_SB(0, 0), b2, voffB);
            PG8_BAR; PG8_WAIT_L(0); PG8_MMA(0, 1, At, B1); PG8_BAR;
            PG8_LDA(At, 0, 1); PG8_STAGE(PG8_SA(0, 0), a2, voffA);
            PG8_BAR; PG8_WAIT_L(0); PG8_MMA(1, 0, At, B0); PG8_BAR; PG8_SCHED;
            PG8_STAGE(PG8_SB(0, 1), b2 + hstep, voffB);
            PG8_WAIT_V(6); PG8_BAR; PG8_MMA(1, 1, At, B1); PG8_BAR;
            PG8_LDB(B0, 1, 0); PG8_SCHED; PG8_LDA(At, 1, 0); PG8_STAGE(PG8_SA(0, 1), a2 + hstep, voffA);
            PG8_WAIT_L(8); PG8_BAR; PG8_WAIT_L(0); PG8_MMA(0, 0, At, B0); PG8_BAR; PG8_SCHED;
            PG8_LDB(B1, 1, 1); PG8_STAGE(PG8_SB(1, 0), b3, voffB);
            PG8_BAR; PG8_WAIT_L(0); PG8_MMA(0, 1, At, B1); PG8_BAR;
            PG8_LDA(At, 1, 1); PG8_STAGE(PG8_SA(1, 0), a3, voffA);
            PG8_BAR; PG8_WAIT_L(0); PG8_MMA(1, 0, At, B0); PG8_BAR; PG8_SCHED;
            PG8_STAGE(PG8_SB(1, 1), b3 + hstep, voffB);
            PG8_WAIT_V(6); PG8_BAR; PG8_MMA(1, 1, At, B1); PG8_BAR;
        }
        PG8_STAMP();
        if constexpr (!Epi::AFTER_DRAIN) { E(acc, cur, wr, wc, fr, fq); S.done(cur); }
        PG8_STAMP();
        if (!has_next) break;
#pragma unroll
        for (int a = 0; a < 2; ++a)
#pragma unroll
            for (int b = 0; b < 2; ++b)
#pragma unroll
                for (int m = 0; m < 4; ++m)
#pragma unroll
                    for (int n = 0; n < 2; ++n) acc[a][b][m][n] = (f32x4){0.f, 0.f, 0.f, 0.f};
        cur = nxt; cA = nA; cB = nB; ++ui;
    }
    PG8_WAIT_V(0);
    if (wr == 0) PG8_BAR;
    PG8_BAR;
    if constexpr (Epi::AFTER_DRAIN) { E.fused(acc, cur, wr, wc, fr, fq, lds, wid, lane); S.done(cur); }
    PG8_STAMP();
    if (STAMP && wid == 0) { stamps[lane] = lane < nts ? (((unsigned long long)(unsigned)ts_hi << 32) | (unsigned)ts_lo) : 0ull;
        if (lane == 62) stamps[62] = rt_entry; if (lane == 63) stamps[63] = (unsigned long long)wall_clock64(); }
#undef PG8_STAMP
#undef PG8_SA
#undef PG8_SB
#undef PG8_STAGE
#undef PG8_LDA
#undef PG8_LDB
#undef PG8_MMA
#undef PG8_WAIT_V
#undef PG8_WAIT_L
#undef PG8_BAR
#undef PG8_SCHED
}
template <class Epi, class Sched, bool ALIGN_EPI = false, bool SP2 = false>
__device__ __forceinline__ void gemm_phase_sp2(PG8_LAS unsigned char* lds, const Gemm g, const Sched& S, const Epi& E) {
    const int tid = threadIdx.x, wid = __builtin_amdgcn_readfirstlane(tid >> 6), lane = tid & 63, wr = wid >> 2, wc = wid & 3, fr = lane & 15, fq = lane >> 4;
    const int K = g.K, nt = K / BK;
    unsigned voffA[2], voffB[2];
#pragma unroll
    for (int i = 0; i < 2; ++i) { int R, C; stage_rc(tid * 16 + i * 8192, R, C); const int Rb = Epi::PERM ? ((R & ~31) + perm32(R & 31)) : R;
        voffA[i] = (unsigned)(R * K + C) * 2u; voffB[i] = (unsigned)(Rb * K + C) * 2u; }
    const size_t kstep = (size_t)(BK * 2);
    const size_t hstep = (size_t)HALF * K * 2;
    const size_t tstep = 2 * hstep;
    const unsigned ldsw = (unsigned)wid * 1024u;
    const int aoff = lds_byte(wr * 64 + fr, fq * 8), boff = lds_byte(wc * 32 + fr, fq * 8);
#define PG8_SA(b, h) (((b) * 2 + (h)) * HTB)
#define PG8_SB(b, h) ((4 + (b) * 2 + (h)) * HTB)
#define PG8_STAGE(bufoff, gbase, voff) do { _Pragma("unroll") for (int _i = 0; _i < 2; ++_i) \
        __builtin_amdgcn_global_load_lds((const unsigned*)((const char*)(gbase) + (voff)[_i]), (PG8_LAS unsigned*)(lds + (bufoff) + ldsw + _i * 8192), 16, 0, 0); } while (0)
#define PG8_LDA(dst, b, h) do { _Pragma("unroll") for (int m = 0; m < 4; ++m) _Pragma("unroll") for (int k = 0; k < 2; ++k) dst[m][k] = *(const PG8_LAS bf16x8*)(lds + PG8_SA(b, h) + aoff + m * 2048 + k * 1024); } while (0)
#define PG8_LDB(dst, b, h) do { _Pragma("unroll") for (int n = 0; n < 2; ++n) _Pragma("unroll") for (int k = 0; k < 2; ++k) dst[n][k] = *(const PG8_LAS bf16x8*)(lds + PG8_SB(b, h) + boff + n * 2048 + k * 1024); } while (0)
#define PG8_MMA(ai, bj, At, Bt) do { __builtin_amdgcn_s_setprio(1); _Pragma("unroll") for (int m = 0; m < 4; ++m) _Pragma("unroll") for (int n = 0; n < 2; ++n) _Pragma("unroll") for (int k = 0; k < 2; ++k) \
        acc[ai][bj][m][n] = __builtin_amdgcn_mfma_f32_16x16x32_bf16(Bt[n][k], At[m][k], acc[ai][bj][m][n], 0, 0, 0); __builtin_amdgcn_s_setprio(0); } while (0)
#define PG8_WAIT_V(n) asm volatile("s_waitcnt vmcnt(" #n ")" ::: "memory")
#define PG8_WAIT_L(n) asm volatile("s_waitcnt lgkmcnt(" #n ")" ::: "memory")
#define PG8_BAR __builtin_amdgcn_s_barrier()
#define PG8_SCHED __builtin_amdgcn_sched_barrier(0)
    Unit cur, nxt; int ui = 0;
    if (!S.next(0, cur)) return;
    f32x4 acc[2][2][4][2];
#pragma unroll
    for (int a = 0; a < 2; ++a)
#pragma unroll
        for (int b = 0; b < 2; ++b)
#pragma unroll
            for (int m = 0; m < 4; ++m)
#pragma unroll
                for (int n = 0; n < 2; ++n) acc[a][b][m][n] = (f32x4){0.f, 0.f, 0.f, 0.f};
    bf16x8 At[4][2], B0[2][2], B1[2][2];
    const char* cA = (const char*)g.A + (size_t)cur.pm * tstep; const char* cB = (const char*)g.Bt + (size_t)cur.pn * tstep;
    S.a_ready(cur);
    if constexpr (SP2) {
        PG8_STAGE(PG8_SB(0, 0), cB, voffB); PG8_STAGE(PG8_SB(0, 1), cB + hstep, voffB); PG8_STAGE(PG8_SA(0, 0), cA, voffA); PG8_STAGE(PG8_SA(0, 1), cA + hstep, voffA);
        if (wr == 1) PG8_BAR;
        PG8_WAIT_V(2); PG8_BAR;
        PG8_STAGE(PG8_SB(1, 0), cB + kstep, voffB); PG8_STAGE(PG8_SA(1, 0), cA + kstep, voffA); PG8_STAGE(PG8_SB(1, 1), cB + hstep + kstep, voffB);
        PG8_WAIT_V(6); PG8_BAR;
    } else {
        PG8_STAGE(PG8_SB(0, 0), cB, voffB); PG8_STAGE(PG8_SA(0, 0), cA, voffA); PG8_STAGE(PG8_SB(0, 1), cB + hstep, voffB); PG8_STAGE(PG8_SA(0, 1), cA + hstep, voffA);
        if (wr == 1) PG8_BAR;
        PG8_WAIT_V(4); PG8_BAR;
        PG8_STAGE(PG8_SB(1, 0), cB + kstep, voffB); PG8_STAGE(PG8_SA(1, 0), cA + kstep, voffA); PG8_STAGE(PG8_SB(1, 1), cB + hstep + kstep, voffB);
        PG8_WAIT_V(6); PG8_BAR;
    }
    for (;;) {
        const bool has_next = S.next(ui + 1, nxt);
        const char* nA = has_next ? (const char*)g.A + (size_t)nxt.pm * tstep : cA; const char* nB = has_next ? (const char*)g.Bt + (size_t)nxt.pn * tstep : cB;
        for (int t = 0; t < nt; t += 2) {
            const bool last = (t == nt - 2);
            const char* a1 = cA + (size_t)(t + 1) * kstep;
            const char* a2 = last ? nA : cA + (size_t)(t + 2) * kstep; const char* b2 = last ? nB : cB + (size_t)(t + 2) * kstep;
            const char* a3 = a2 + kstep; const char* b3 = b2 + kstep;
            if (last && has_next) S.a_ready(nxt);
            if constexpr (SP2) {
            PG8_LDB(B0, 0, 0); PG8_LDB(B1, 0, 1); PG8_SCHED; PG8_LDA(At, 0, 0); PG8_STAGE(PG8_SA(1, 1), a1 + hstep, voffA);
            PG8_WAIT_V(8); PG8_WAIT_L(0); PG8_BAR; PG8_MMA(0, 0, At, B0); PG8_MMA(0, 1, At, B1); PG8_BAR; PG8_SCHED;
            PG8_LDA(At, 0, 1); PG8_STAGE(PG8_SB(0, 0), b2, voffB); PG8_STAGE(PG8_SB(0, 1), b2 + hstep, voffB); PG8_STAGE(PG8_SA(0, 0), a2, voffA);
            PG8_WAIT_V(8); PG8_WAIT_L(0); PG8_BAR; PG8_MMA(1, 0, At, B0); PG8_MMA(1, 1, At, B1); PG8_BAR; PG8_SCHED;
            PG8_LDB(B0, 1, 0); PG8_LDB(B1, 1, 1); PG8_SCHED; PG8_LDA(At, 1, 0); PG8_STAGE(PG8_SA(0, 1), a2 + hstep, voffA);
            PG8_WAIT_V(8); PG8_WAIT_L(0); PG8_BAR; PG8_MMA(0, 0, At, B0); PG8_MMA(0, 1, At, B1); PG8_BAR; PG8_SCHED;
            PG8_LDA(At, 1, 1); PG8_STAGE(PG8_SB(1, 0), b3, voffB); PG8_STAGE(PG8_SB(1, 1), b3 + hstep, voffB); PG8_STAGE(PG8_SA(1, 0), a3, voffA);
            PG8_WAIT_V(8); PG8_WAIT_L(0); PG8_BAR; PG8_MMA(1, 0, At, B0); PG8_MMA(1, 1, At, B1); PG8_BAR; PG8_SCHED;
            } else {
            PG8_LDB(B0, 0, 0); PG8_SCHED; PG8_LDA(At, 0, 0); PG8_STAGE(PG8_SA(1, 1), a1 + hstep, voffA);
            PG8_WAIT_L(8); PG8_BAR; PG8_WAIT_L(0); PG8_MMA(0, 0, At, B0); PG8_BAR; PG8_SCHED;
            PG8_LDB(B1, 0, 1); PG8_STAGE(PG8_SB(0, 0), b2, voffB);
            PG8_BAR; PG8_WAIT_L(0); PG8_MMA(0, 1, At, B1); PG8_BAR;
            PG8_LDA(At, 0, 1); PG8_STAGE(PG8_SA(0, 0), a2, voffA);
            PG8_BAR; PG8_WAIT_L(0); PG8_MMA(1, 0, At, B0); PG8_BAR; PG8_SCHED;
            PG8_STAGE(PG8_SB(0, 1), b2 + hstep, voffB);
            PG8_WAIT_V(6); PG8_BAR; PG8_MMA(1, 1, At, B1); PG8_BAR;
            PG8_LDB(B0, 1, 0); PG8_SCHED; PG8_LDA(At, 1, 0); PG8_STAGE(PG8_SA(0, 1), a2 + hstep, voffA);
            PG8_WAIT_L(8); PG8_BAR; PG8_WAIT_L(0); PG8_MMA(0, 0, At, B0); PG8_BAR; PG8_SCHED;
            PG8_LDB(B1, 1, 1); PG8_STAGE(PG8_SB(1, 0), b3, voffB);
            PG8_BAR; PG8_WAIT_L(0); PG8_MMA(0, 1, At, B1); PG8_BAR;
            PG8_LDA(At, 1, 1); PG8_STAGE(PG8_SA(1, 0), a3, voffA);
            PG8_BAR; PG8_WAIT_L(0); PG8_MMA(1, 0, At, B0); PG8_BAR; PG8_SCHED;
            PG8_STAGE(PG8_SB(1, 1), b3 + hstep, voffB);
            PG8_WAIT_V(6); PG8_BAR; PG8_MMA(1, 1, At, B1); PG8_BAR;
            }
        }
        if constexpr (ALIGN_EPI) { if (wr == 0) PG8_BAR; }
        if constexpr (!Epi::AFTER_DRAIN) { E(acc, cur, wr, wc, fr, fq); S.done(cur); }
        if (!has_next) break;
#pragma unroll
        for (int a = 0; a < 2; ++a)
#pragma unroll
            for (int b = 0; b < 2; ++b)
#pragma unroll
                for (int m = 0; m < 4; ++m)
#pragma unroll
                    for (int n = 0; n < 2; ++n) acc[a][b][m][n] = (f32x4){0.f, 0.f, 0.f, 0.f};
        cur = nxt; cA = nA; cB = nB; ++ui;
        if constexpr (ALIGN_EPI) { if (wr == 1) PG8_BAR; }
    }
    PG8_WAIT_V(0);
    if constexpr (!ALIGN_EPI) { if (wr == 0) PG8_BAR; }
    PG8_BAR;
    if constexpr (Epi::AFTER_DRAIN) { E.fused(acc, cur, wr, wc, fr, fq, lds, wid, lane); S.done(cur); }
#undef PG8_SA
#undef PG8_SB
#undef PG8_STAGE
#undef PG8_LDA
#undef PG8_LDB
#undef PG8_MMA
#undef PG8_WAIT_V
#undef PG8_WAIT_L
#undef PG8_BAR
#undef PG8_SCHED
}
}
#define LAS __attribute__((address_space(3)))
typedef LAS unsigned char* LDSp;
typedef pg8::bf16_t bf16_t;
typedef unsigned u32x4 __attribute__((ext_vector_type(4)));
typedef unsigned u32x2 __attribute__((ext_vector_type(2)));
typedef float f32x4 __attribute__((ext_vector_type(4)));
typedef float f32x2 __attribute__((ext_vector_type(2)));

#ifndef EXPC
#define EXPC 0
#endif
#ifndef EVP_SKIP
#define EVP_SKIP 0
#endif
constexpr int T_ = 16384, D_ = 1024, S_ = 4096, NTHR = 512;
constexpr int LDS_BYTES = 147456;
constexpr size_t MiB = 1048576;
constexpr size_t WS_WB = 0, WS_HN = 25 * MiB, WS_Z = 57 * MiB, WS_QKV = 153 * MiB, WS_OF = 201 * MiB, WS_OB = 217 * MiB,
                 WS_GATES = 233 * MiB, WS_BETA = 234 * MiB, WS_LA = 234 * MiB + 524288;
constexpr size_t WB_IN = 0, WB_OUT = 6291456, WB_UP = 8388608, WB_DN = 19922944;
constexpr int DFF = 2816;

struct Params { const float* in[26]; float* out; unsigned char* ws; };

__device__ __forceinline__ float bf2f(unsigned short b) { return __uint_as_float(((unsigned)b) << 16); }
__device__ __forceinline__ float bflo(unsigned u) { return __uint_as_float(u << 16); }
__device__ __forceinline__ float bfhi(unsigned u) { return __uint_as_float(u & 0xffff0000u); }
__device__ __forceinline__ unsigned short f2bf(float f) { unsigned u = __float_as_uint(f); u += 0x7FFFu + ((u >> 16) & 1u); return (unsigned short)(u >> 16); }
typedef __bf16 bf16x2_v __attribute__((ext_vector_type(2)));
__device__ __forceinline__ unsigned pk2(float lo, float hi) { const f32x2 v = {lo, hi}; const bf16x2_v b = __builtin_convertvector(v, bf16x2_v); return __builtin_bit_cast(unsigned, b); }
__device__ __forceinline__ float sigm(float x) { return __builtin_amdgcn_rcpf(1.0f + __expf(-x)); }
__device__ __forceinline__ float sigm_f(float x) { return __builtin_amdgcn_rcpf(1.0f + __expf(-x)); }
__device__ __forceinline__ float silu_(float x) { return x * sigm(x); }
__device__ __forceinline__ float gelu_t(float x) { const float u = 0.7978845608028654f * (x + 0.044715f * x * x * x); const float t = 1.0f - 2.0f / (1.0f + __expf(2.0f * u)); return 0.5f * x * (1.0f + t); }
__device__ __forceinline__ float softplus_(float x) { return x > 20.0f ? x : log1pf(expf(x)); }
__device__ __forceinline__ float wave_sum(float v) {
#pragma unroll
    for (int o = 32; o; o >>= 1) v += __shfl_xor(v, o);
    return v; }
template <int CTRL> __device__ __forceinline__ float dppf(float v) { return __int_as_float(__builtin_amdgcn_update_dpp(0, __float_as_int(v), CTRL, 0xf, 0xf, true)); }
__device__ __forceinline__ float row16_sum(float v) { v += dppf<0xB1>(v); v += dppf<0x4E>(v); v += dppf<0x141>(v); v += dppf<0x140>(v); return v; }
__device__ __forceinline__ void unpack8(const u32x4 w, float (&f)[8]) { f[0] = bflo(w.x); f[1] = bfhi(w.x); f[2] = bflo(w.y); f[3] = bfhi(w.y); f[4] = bflo(w.z); f[5] = bfhi(w.z); f[6] = bflo(w.w); f[7] = bfhi(w.w); }


__device__ __forceinline__ float wave_scan_sum(float x, bool fwd) {
    const int lane = threadIdx.x & 63;
#pragma unroll
    for (int o = 1; o < 64; o <<= 1) { const float y = fwd ? __shfl_up(x, o) : __shfl_down(x, o); if (fwd ? (lane >= o) : (lane + o < 64)) x += y; }
    return x; }
__device__ __forceinline__ float wave_scan_max(float x, bool fwd) {
    const int lane = threadIdx.x & 63;
#pragma unroll
    for (int o = 1; o < 64; o <<= 1) { const float y = fwd ? __shfl_up(x, o) : __shfl_down(x, o); if (fwd ? (lane >= o) : (lane + o < 64)) x = fmaxf(x, y); }
    return x; }
__device__ __forceinline__ void conv_job(LDSp lds, const float* __restrict__ src, int ldn, int K, int col0, int ncols, bf16_t* __restrict__ dst, int mode, int off) {
    LAS float* tl = (LAS float*)lds;
    const int tid = threadIdx.x, nnt = ncols >> 6, ntl = (K >> 6) * nnt;
    const int r = tid >> 4, c4 = (tid & 15) << 2;
    f32x4 pv[2];
    if ((int)blockIdx.x < ntl) { const int kt = (int)blockIdx.x / nnt, nt = (int)blockIdx.x - kt * nnt;
#pragma unroll
        for (int i = 0; i < 2; ++i) pv[i] = *(const f32x4*)(src + (size_t)(kt * 64 + r + 32 * i) * ldn + col0 + nt * 64 + c4); }
    for (int tile = blockIdx.x; tile < ntl; tile += gridDim.x) {
        const int kt = tile / nnt, nt = tile - kt * nnt;
#pragma unroll
        for (int i = 0; i < 2; ++i) { const int k = r + 32 * i; const f32x4 v = pv[i];
            tl[k * 65 + c4 + 0] = v.x; tl[k * 65 + c4 + 1] = v.y; tl[k * 65 + c4 + 2] = v.z; tl[k * 65 + c4 + 3] = v.w; }
        { const int tn = tile + (int)gridDim.x; if (tn < ntl) { const int kt2 = tn / nnt, nt2 = tn - kt2 * nnt;
#pragma unroll
            for (int i = 0; i < 2; ++i) pv[i] = *(const f32x4*)(src + (size_t)(kt2 * 64 + r + 32 * i) * ldn + col0 + nt2 * 64 + c4); } }
        __syncthreads();
        const int n = tid >> 3, k8 = (tid & 7) << 3; float f[8];
#pragma unroll
        for (int j = 0; j < 8; ++j) f[j] = tl[(k8 + j) * 65 + n];
        u32x4 w; w.x = pk2(f[0], f[1]); w.y = pk2(f[2], f[3]); w.z = pk2(f[4], f[5]); w.w = pk2(f[6], f[7]);
        const int ncol = nt * 64 + n;
        const int row = mode == 0 ? off + ncol : ((ncol >> 7) << 8) + (ncol & 127) + off;
        *(u32x4*)(dst + (size_t)row * K + kt * 64 + k8) = w;
        __syncthreads();
    }
}
__device__ __forceinline__ void convert_layer(LDSp lds, const Params& p, int L) {
    bf16_t* wb = (bf16_t*)(p.ws + WS_WB);
    if (L == 0) { conv_job(lds, p.in[2], 3088, 1024, 0, 3072, (bf16_t*)((char*)wb + WB_IN), 0, 0);
                  conv_job(lds, p.in[11], 1024, 1024, 0, 1024, (bf16_t*)((char*)wb + WB_OUT), 0, 0); }
    else        { conv_job(lds, p.in[12], 2576, 1024, 0, 2560, (bf16_t*)((char*)wb + WB_IN), 0, 0);
                  conv_job(lds, p.in[20], 1024, 1024, 0, 1024, (bf16_t*)((char*)wb + WB_OUT), 0, 0); }
    conv_job(lds, p.in[22] + (size_t)L * 1024 * DFF, DFF, 1024, 0, DFF, (bf16_t*)((char*)wb + WB_UP), 1, 0);
    conv_job(lds, p.in[23] + (size_t)L * 1024 * DFF, DFF, 1024, 0, DFF, (bf16_t*)((char*)wb + WB_UP), 1, 128);
    conv_job(lds, p.in[24] + (size_t)L * DFF * 1024, 1024, DFF, 0, 1024, (bf16_t*)((char*)wb + WB_DN), 0, 0);
}

__device__ __forceinline__ void rms_phase(LDSp lds, const float* src, const float* __restrict__ g, bf16_t* hn, float* copy_out, float* final_out,
                                          const float* __restrict__ gw, int gw_ld, int gw_col0, float* gates) {
    LAS float* wg = (LAS float*)lds;
    const int tid = threadIdx.x, lane = tid & 63, wid = tid >> 6;
    if (gw) { for (int idx = tid; idx < 16384; idx += NTHR) { const int k = idx >> 4, j = idx & 15; wg[j * 1024 + k] = gw[(size_t)k * gw_ld + gw_col0 + j]; } __syncthreads(); }
    f32x4 gv[4];
#pragma unroll
    for (int i = 0; i < 4; ++i) gv[i] = *(const f32x4*)(g + 4 * lane + 256 * i);
    f32x4 xn[4];
    { const int row0 = blockIdx.x * 8 + wid;
#pragma unroll
      for (int i = 0; i < 4; ++i) xn[i] = *(const f32x4*)(src + (size_t)row0 * D_ + 4 * lane + 256 * i); }
    for (int row = blockIdx.x * 8 + wid; row < T_; row += gridDim.x * 8) {
        f32x4 x[4]; float ss = 0.f;
#pragma unroll
        for (int i = 0; i < 4; ++i) { x[i] = xn[i]; ss += x[i].x * x[i].x + x[i].y * x[i].y + x[i].z * x[i].z + x[i].w * x[i].w; }
        { const int rn = row + (int)gridDim.x * 8; if (rn < T_) {
#pragma unroll
            for (int i = 0; i < 4; ++i) xn[i] = *(const f32x4*)(src + (size_t)rn * D_ + 4 * lane + 256 * i); } }
        if (copy_out) {
#pragma unroll
            for (int i = 0; i < 4; ++i) *(f32x4*)(copy_out + (size_t)row * D_ + 4 * lane + 256 * i) = x[i]; }
        ss = wave_sum(ss);
        const float rstd = rsqrtf(ss * (1.0f / 1024.0f) + 1e-6f);
        f32x4 y[4];
#pragma unroll
        for (int i = 0; i < 4; ++i) y[i] = x[i] * rstd * gv[i];
        if (final_out) {
#pragma unroll
            for (int i = 0; i < 4; ++i) *(f32x4*)(final_out + (size_t)row * D_ + 4 * lane + 256 * i) = y[i];
        } else {
#pragma unroll
            for (int i = 0; i < 4; ++i) { u32x2 w; w.x = pk2(y[i].x, y[i].y); w.y = pk2(y[i].z, y[i].w); *(u32x2*)(hn + (size_t)row * D_ + 4 * lane + 256 * i) = w; }
        }
        if (gw) {
            float s[16];
#pragma unroll
            for (int j = 0; j < 16; ++j) { float a = 0.f;
#pragma unroll
                for (int i = 0; i < 4; ++i) { const f32x4 w = *(const LAS f32x4*)(wg + j * 1024 + 4 * lane + 256 * i); a += y[i].x * w.x + y[i].y * w.y + y[i].z * w.z + y[i].w * w.w; }
                s[j] = wave_sum(a); }
            if (lane == 0) {
#pragma unroll
                for (int q = 0; q < 4; ++q) *(f32x4*)(gates + (size_t)row * 16 + 4 * q) = (f32x4){s[4 * q], s[4 * q + 1], s[4 * q + 2], s[4 * q + 3]}; }
        }
    }
    __syncthreads();
}

__device__ __forceinline__ void even_prep(LDSp lds, const Params& p) {
    const bf16_t* Z = (const bf16_t*)(p.ws + WS_Z); bf16_t* Y = (bf16_t*)(p.ws + WS_HN); bf16_t* QKVN = (bf16_t*)(p.ws + WS_QKV);
    const float* gates = (const float*)(p.ws + WS_GATES); float* BETA = (float*)(p.ws + WS_BETA); float* LA = (float*)(p.ws + WS_LA);
    const float* conv_w = p.in[3]; const float* conv_b = p.in[4]; const float* ln_g = p.in[5]; const float* ln_b = p.in[6];
    const float* dn_w = p.in[7]; const float* a_log = p.in[8]; const float* dt_bias = p.in[9];
    LAS float* glu = (LAS float*)lds;
    const int tid = threadIdx.x, lane = tid & 63, wid = tid >> 6, c = tid;
    for (int tile = blockIdx.x; tile < T_ / 32; tile += gridDim.x) {
        const int t0 = tile * 32, b = t0 >> 12, s0 = t0 & 4095;
#if !(EVP_SKIP & 1)
        for (int it = tid; it < 62 * 64; it += NTHR) { const int r = it >> 6, c8 = (it & 63) << 3, sp = s0 - 15 + r;
            f32x4 o0 = {0.f, 0.f, 0.f, 0.f}, o1 = {0.f, 0.f, 0.f, 0.f};
            if (sp >= 0 && sp < S_) { const size_t tok = (size_t)b * S_ + sp; const u32x4 av = *(const u32x4*)(Z + tok * 3072 + c8); const u32x4 gv = *(const u32x4*)(Z + tok * 3072 + 512 + c8);
                float a[8], g[8]; unpack8(av, a); unpack8(gv, g);
                o0 = (f32x4){a[0] * sigm(g[0]), a[1] * sigm(g[1]), a[2] * sigm(g[2]), a[3] * sigm(g[3])}; o1 = (f32x4){a[4] * sigm(g[4]), a[5] * sigm(g[5]), a[6] * sigm(g[6]), a[7] * sigm(g[7])}; }
            *(LAS f32x4*)(glu + r * 512 + c8) = o0; *(LAS f32x4*)(glu + r * 512 + c8 + 4) = o1; }
        __syncthreads();
        {
            float cw[31];
#pragma unroll
            for (int w = 0; w < 31; ++w) cw[w] = conv_w[w * 512 + c];
            const float cb = conv_b[c];
            f32x4 res[8];
#pragma unroll
            for (int t4 = 0; t4 < 8; ++t4) {
                float x[34];
#pragma unroll
                for (int i = 0; i < 34; ++i) x[i] = glu[(t4 * 4 + i) * 512 + c];
                float a0 = cb, a1 = cb, a2 = cb, a3 = cb;
#pragma unroll
                for (int w = 0; w < 31; ++w) { a0 = fmaf(x[w], cw[w], a0); a1 = fmaf(x[w + 1], cw[w], a1); a2 = fmaf(x[w + 2], cw[w], a2); a3 = fmaf(x[w + 3], cw[w], a3); }
                res[t4] = (f32x4){a0, a1, a2, a3};
            }
            __syncthreads();
#pragma unroll
            for (int t4 = 0; t4 < 8; ++t4) { glu[(t4 * 4 + 0) * 512 + c] = res[t4].x; glu[(t4 * 4 + 1) * 512 + c] = res[t4].y; glu[(t4 * 4 + 2) * 512 + c] = res[t4].z; glu[(t4 * 4 + 3) * 512 + c] = res[t4].w; }
        }
        __syncthreads();
        {
            const f32x4 g0 = *(const f32x4*)(ln_g + 4 * lane), g1 = *(const f32x4*)(ln_g + 256 + 4 * lane), b0 = *(const f32x4*)(ln_b + 4 * lane), b1 = *(const f32x4*)(ln_b + 256 + 4 * lane);
#pragma unroll
            for (int tt = 0; tt < 4; ++tt) { const int t = wid * 4 + tt;
                const f32x4 x0 = *(const LAS f32x4*)(glu + t * 512 + 4 * lane), x1 = *(const LAS f32x4*)(glu + t * 512 + 256 + 4 * lane);
                const float mean = wave_sum((x0.x + x0.y) + (x0.z + x0.w) + (x1.x + x1.y) + (x1.z + x1.w)) * (1.0f / 512.0f);
                const f32x4 d0 = x0 - mean, d1 = x1 - mean;
                const float var = wave_sum(d0.x * d0.x + d0.y * d0.y + d0.z * d0.z + d0.w * d0.w + d1.x * d1.x + d1.y * d1.y + d1.z * d1.z + d1.w * d1.w) * (1.0f / 512.0f);
                const float rstd = rsqrtf(var + 1e-5f);
                const f32x4 y0 = d0 * rstd * g0 + b0, y1 = d1 * rstd * g1 + b1;
                u32x2 w0, w1; w0.x = pk2(silu_(y0.x), silu_(y0.y)); w0.y = pk2(silu_(y0.z), silu_(y0.w)); w1.x = pk2(silu_(y1.x), silu_(y1.y)); w1.y = pk2(silu_(y1.z), silu_(y1.w));
                *(u32x2*)(Y + (size_t)(t0 + t) * 1024 + 4 * lane) = w0; *(u32x2*)(Y + (size_t)(t0 + t) * 1024 + 256 + 4 * lane) = w1; }
        }
        __syncthreads();
#endif
#if !(EVP_SKIP & 2)
        LAS unsigned short* xin = (LAS unsigned short*)(glu + 32 * 512);
#pragma unroll 1
        for (int gi = 0; gi < 3; ++gi) {
            float w5[5];
#pragma unroll
            for (int w = 0; w < 5; ++w) w5[w] = dn_w[w * 1536 + gi * 512 + c];
            for (int it = tid; it < 36 * 64; it += NTHR) { const int rr = it >> 6, c8 = (it & 63) << 3, sp = s0 - 2 + rr;
                u32x4 v = {0u, 0u, 0u, 0u};
                if (sp >= 0 && sp < S_) v = *(const u32x4*)(Z + ((size_t)b * S_ + sp) * 3072 + 1024 + gi * 512 + c8);
                *(LAS u32x4*)(xin + rr * 512 + c8) = v; }
            __syncthreads();
            float x0 = bf2f(xin[c]), x1 = bf2f(xin[512 + c]), x2 = bf2f(xin[1024 + c]), x3 = bf2f(xin[1536 + c]);
#pragma unroll 8
            for (int t = 0; t < 32; ++t) { const float x4 = bf2f(xin[(t + 4) * 512 + c]);
                float v = x0 * w5[0]; v = fmaf(x1, w5[1], v); v = fmaf(x2, w5[2], v); v = fmaf(x3, w5[3], v); v = fmaf(x4, w5[4], v);
                glu[t * 512 + c] = silu_(v);
                x0 = x1; x1 = x2; x2 = x3; x3 = x4; }
            __syncthreads();
            const float qs = gi == 0 ? 0.08838834764831845f : 1.0f;
#pragma unroll
            for (int pp = 0; pp < 4; ++pp) { const int pr = wid * 16 + pp * 4 + (lane >> 4), t = pr >> 2, hd = pr & 3, c8 = (lane & 15) * 8;
                const f32x4 y0 = *(const LAS f32x4*)(glu + t * 512 + hd * 128 + c8), y1 = *(const LAS f32x4*)(glu + t * 512 + hd * 128 + c8 + 4);
                const float ss = row16_sum(y0.x * y0.x + y0.y * y0.y + y0.z * y0.z + y0.w * y0.w + y1.x * y1.x + y1.y * y1.y + y1.z * y1.z + y1.w * y1.w);
                const float sc = gi == 2 ? 1.0f : rsqrtf(ss + 1e-6f) * qs;
                u32x4 w; w.x = pk2(y0.x * sc, y0.y * sc); w.y = pk2(y0.z * sc, y0.w * sc); w.z = pk2(y1.x * sc, y1.y * sc); w.w = pk2(y1.z * sc, y1.w * sc);
                *(u32x4*)(QKVN + (size_t)(t0 + t) * 1536 + gi * 512 + hd * 128 + c8) = w; }
            __syncthreads();
        }
#endif
#if !(EVP_SKIP & 4)
        if (tid < 256) { const int t = tid >> 3, j = tid & 7; const size_t tok = (size_t)(t0 + t);
            const float bp = gates[tok * 16 + j], ap = gates[tok * 16 + 8 + j];
            BETA[tok * 8 + j] = sigm(bp); LA[tok * 8 + j] = -expf(a_log[j]) * softplus_(ap + dt_bias[j]); }
#endif
        __syncthreads();
    }
}

__device__ __forceinline__ void tri_inv64(const LAS float* Am, int c, float su, float sw, LAS unsigned short* Tu, LAS unsigned short* Tw) {
    f32x4 a; float s0, s1, s2, s3; const float cf = (float)c;
    float x0 = fmaxf(0.0f, 1.0f - fabsf(cf - 0.0f));
    Tu[0 + c] = f2bf(x0 * su); Tw[0 + c] = f2bf(x0 * sw); asm volatile("" ::: "memory");
    float x1 = fmaxf(0.0f, 1.0f - fabsf(cf - 1.0f));
    s0 = 0.f; s1 = 0.f; s2 = 0.f; s3 = 0.f;
    a = *(const LAS f32x4*)(Am + 68);
    const float al1 = a.x;
    x1 = (x1 - ((s0 + s1) + (s2 + s3))) - al1 * x0;
    Tu[136 + c] = f2bf(x1 * su); Tw[136 + c] = f2bf(x1 * sw); asm volatile("" ::: "memory");
    float x2 = fmaxf(0.0f, 1.0f - fabsf(cf - 2.0f));
    s0 = 0.f; s1 = 0.f; s2 = 0.f; s3 = 0.f;
    a = *(const LAS f32x4*)(Am + 136);
    s0 = fmaf(a.x, x0, s0);
    const float al2 = a.y;
    x2 = (x2 - ((s0 + s1) + (s2 + s3))) - al2 * x1;
    Tu[272 + c] = f2bf(x2 * su); Tw[272 + c] = f2bf(x2 * sw); asm volatile("" ::: "memory");
    float x3 = fmaxf(0.0f, 1.0f - fabsf(cf - 3.0f));
    s0 = 0.f; s1 = 0.f; s2 = 0.f; s3 = 0.f;
    a = *(const LAS f32x4*)(Am + 204);
    s0 = fmaf(a.x, x0, s0);
    s1 = fmaf(a.y, x1, s1);
    const float al3 = a.z;
    x3 = (x3 - ((s0 + s1) + (s2 + s3))) - al3 * x2;
    Tu[408 + c] = f2bf(x3 * su); Tw[408 + c] = f2bf(x3 * sw); asm volatile("" ::: "memory");
    float x4 = fmaxf(0.0f, 1.0f - fabsf(cf - 4.0f));
    s0 = 0.f; s1 = 0.f; s2 = 0.f; s3 = 0.f;
    a = *(const LAS f32x4*)(Am + 272);
    s0 = fmaf(a.x, x0, s0);
    s1 = fmaf(a.y, x1, s1);
    s2 = fmaf(a.z, x2, s2);
    const float al4 = a.w;
    x4 = (x4 - ((s0 + s1) + (s2 + s3))) - al4 * x3;
    Tu[544 + c] = f2bf(x4 * su); Tw[544 + c] = f2bf(x4 * sw); asm volatile("" ::: "memory");
    float x5 = fmaxf(0.0f, 1.0f - fabsf(cf - 5.0f));
    s0 = 0.f; s1 = 0.f; s2 = 0.f; s3 = 0.f;
    a = *(const LAS f32x4*)(Am + 340);
    s0 = fmaf(a.x, x0, s0);
    s1 = fmaf(a.y, x1, s1);
    s2 = fmaf(a.z, x2, s2);
    s3 = fmaf(a.w, x3, s3);
    a = *(const LAS f32x4*)(Am + 344);
    const float al5 = a.x;
    x5 = (x5 - ((s0 + s1) + (s2 + s3))) - al5 * x4;
    Tu[680 + c] = f2bf(x5 * su); Tw[680 + c] = f2bf(x5 * sw); asm volatile("" ::: "memory");
    float x6 = fmaxf(0.0f, 1.0f - fabsf(cf - 6.0f));
    s0 = 0.f; s1 = 0.f; s2 = 0.f; s3 = 0.f;
    a = *(const LAS f32x4*)(Am + 408);
    s0 = fmaf(a.x, x0, s0);
    s1 = fmaf(a.y, x1, s1);
    s2 = fmaf(a.z, x2, s2);
    s3 = fmaf(a.w, x3, s3);
    a = *(const LAS f32x4*)(Am + 412);
    s0 = fmaf(a.x, x4, s0);
    const float al6 = a.y;
    x6 = (x6 - ((s0 + s1) + (s2 + s3))) - al6 * x5;
    Tu[816 + c] = f2bf(x6 * su); Tw[816 + c] = f2bf(x6 * sw); asm volatile("" ::: "memory");
    float x7 = fmaxf(0.0f, 1.0f - fabsf(cf - 7.0f));
    s0 = 0.f; s1 = 0.f; s2 = 0.f; s3 = 0.f;
    a = *(const LAS f32x4*)(Am + 476);
    s0 = fmaf(a.x, x0, s0);
    s1 = fmaf(a.y, x1, s1);
    s2 = fmaf(a.z, x2, s2);
    s3 = fmaf(a.w, x3, s3);
    a = *(const LAS f32x4*)(Am + 480);
    s0 = fmaf(a.x, x4, s0);
    s1 = fmaf(a.y, x5, s1);
    const float al7 = a.z;
    x7 = (x7 - ((s0 + s1) + (s2 + s3))) - al7 * x6;
    Tu[952 + c] = f2bf(x7 * su); Tw[952 + c] = f2bf(x7 * sw); asm volatile("" ::: "memory");
    float x8 = fmaxf(0.0f, 1.0f - fabsf(cf - 8.0f));
    s0 = 0.f; s1 = 0.f; s2 = 0.f; s3 = 0.f;
    a = *(const LAS f32x4*)(Am + 544);
    s0 = fmaf(a.x, x0, s0);
    s1 = fmaf(a.y, x1, s1);
    s2 = fmaf(a.z, x2, s2);
    s3 = fmaf(a.w, x3, s3);
    a = *(const LAS f32x4*)(Am + 548);
    s0 = fmaf(a.x, x4, s0);
    s1 = fmaf(a.y, x5, s1);
    s2 = fmaf(a.z, x6, s2);
    const float al8 = a.w;
    x8 = (x8 - ((s0 + s1) + (s2 + s3))) - al8 * x7;
    Tu[1088 + c] = f2bf(x8 * su); Tw[1088 + c] = f2bf(x8 * sw); asm volatile("" ::: "memory");
    float x9 = fmaxf(0.0f, 1.0f - fabsf(cf - 9.0f));
    s0 = 0.f; s1 = 0.f; s2 = 0.f; s3 = 0.f;
    a = *(const LAS f32x4*)(Am + 612);
    s0 = fmaf(a.x, x0, s0);
    s1 = fmaf(a.y, x1, s1);
    s2 = fmaf(a.z, x2, s2);
    s3 = fmaf(a.w, x3, s3);
    a = *(const LAS f32x4*)(Am + 616);
    s0 = fmaf(a.x, x4, s0);
    s1 = fmaf(a.y, x5, s1);
    s2 = fmaf(a.z, x6, s2);
    s3 = fmaf(a.w, x7, s3);
    a = *(const LAS f32x4*)(Am + 620);
    const float al9 = a.x;
    x9 = (x9 - ((s0 + s1) + (s2 + s3))) - al9 * x8;
    Tu[1224 + c] = f2bf(x9 * su); Tw[1224 + c] = f2bf(x9 * sw); asm volatile("" ::: "memory");
    float x10 = fmaxf(0.0f, 1.0f - fabsf(cf - 10.0f));
    s0 = 0.f; s1 = 0.f; s2 = 0.f; s3 = 0.f;
    a = *(const LAS f32x4*)(Am + 680);
    s0 = fmaf(a.x, x0, s0);
    s1 = fmaf(a.y, x1, s1);
    s2 = fmaf(a.z, x2, s2);
    s3 = fmaf(a.w, x3, s3);
    a = *(const LAS f32x4*)(Am + 684);
    s0 = fmaf(a.x, x4, s0);
    s1 = fmaf(a.y, x5, s1);
    s2 = fmaf(a.z, x6, s2);
    s3 = fmaf(a.w, x7, s3);
    a = *(const LAS f32x4*)(Am + 688);
    s0 = fmaf(a.x, x8, s0);
    const float al10 = a.y;
    x10 = (x10 - ((s0 + s1) + (s2 + s3))) - al10 * x9;
    Tu[1360 + c] = f2bf(x10 * su); Tw[1360 + c] = f2bf(x10 * sw); asm volatile("" ::: "memory");
    float x11 = fmaxf(0.0f, 1.0f - fabsf(cf - 11.0f));
    s0 = 0.f; s1 = 0.f; s2 = 0.f; s3 = 0.f;
    a = *(const LAS f32x4*)(Am + 748);
    s0 = fmaf(a.x, x0, s0);
    s1 = fmaf(a.y, x1, s1);
    s2 = fmaf(a.z, x2, s2);
    s3 = fmaf(a.w, x3, s3);
    a = *(const LAS f32x4*)(Am + 752);
    s0 = fmaf(a.x, x4, s0);
    s1 = fmaf(a.y, x5, s1);
    s2 = fmaf(a.z, x6, s2);
    s3 = fmaf(a.w, x7, s3);
    a = *(const LAS f32x4*)(Am + 756);
    s0 = fmaf(a.x, x8, s0);
    s1 = fmaf(a.y, x9, s1);
    const float al11 = a.z;
    x11 = (x11 - ((s0 + s1) + (s2 + s3))) - al11 * x10;
    Tu[1496 + c] = f2bf(x11 * su); Tw[1496 + c] = f2bf(x11 * sw); asm volatile("" ::: "memory");
    float x12 = fmaxf(0.0f, 1.0f - fabsf(cf - 12.0f));
    s0 = 0.f; s1 = 0.f; s2 = 0.f; s3 = 0.f;
    a = *(const LAS f32x4*)(Am + 816);
    s0 = fmaf(a.x, x0, s0);
    s1 = fmaf(a.y, x1, s1);
    s2 = fmaf(a.z, x2, s2);
    s3 = fmaf(a.w, x3, s3);
    a = *(const LAS f32x4*)(Am + 820);
    s0 = fmaf(a.x, x4, s0);
    s1 = fmaf(a.y, x5, s1);
    s2 = fmaf(a.z, x6, s2);
    s3 = fmaf(a.w, x7, s3);
    a = *(const LAS f32x4*)(Am + 824);
    s0 = fmaf(a.x, x8, s0);
    s1 = fmaf(a.y, x9, s1);
    s2 = fmaf(a.z, x10, s2);
    const float al12 = a.w;
    x12 = (x12 - ((s0 + s1) + (s2 + s3))) - al12 * x11;
    Tu[1632 + c] = f2bf(x12 * su); Tw[1632 + c] = f2bf(x12 * sw); asm volatile("" ::: "memory");
    float x13 = fmaxf(0.0f, 1.0f - fabsf(cf - 13.0f));
    s0 = 0.f; s1 = 0.f; s2 = 0.f; s3 = 0.f;
    a = *(const LAS f32x4*)(Am + 884);
    s0 = fmaf(a.x, x0, s0);
    s1 = fmaf(a.y, x1, s1);
    s2 = fmaf(a.z, x2, s2);
    s3 = fmaf(a.w, x3, s3);
    a = *(const LAS f32x4*)(Am + 888);
    s0 = fmaf(a.x, x4, s0);
    s1 = fmaf(a.y, x5, s1);
    s2 = fmaf(a.z, x6, s2);
    s3 = fmaf(a.w, x7, s3);
    a = *(const LAS f32x4*)(Am + 892);
    s0 = fmaf(a.x, x8, s0);
    s1 = fmaf(a.y, x9, s1);
    s2 = fmaf(a.z, x10, s2);
    s3 = fmaf(a.w, x11, s3);
    a = *(const LAS f32x4*)(Am + 896);
    const float al13 = a.x;
    x13 = (x13 - ((s0 + s1) + (s2 + s3))) - al13 * x12;
    Tu[1768 + c] = f2bf(x13 * su); Tw[1768 + c] = f2bf(x13 * sw); asm volatile("" ::: "memory");
    float x14 = fmaxf(0.0f, 1.0f - fabsf(cf - 14.0f));
    s0 = 0.f; s1 = 0.f; s2 = 0.f; s3 = 0.f;
    a = *(const LAS f32x4*)(Am + 952);
    s0 = fmaf(a.x, x0, s0);
    s1 = fmaf(a.y, x1, s1);
    s2 = fmaf(a.z, x2, s2);
    s3 = fmaf(a.w, x3, s3);
    a = *(const LAS f32x4*)(Am + 956);
    s0 = fmaf(a.x, x4, s0);
    s1 = fmaf(a.y, x5, s1);
    s2 = fmaf(a.z, x6, s2);
    s3 = fmaf(a.w, x7, s3);
    a = *(const LAS f32x4*)(Am + 960);
    s0 = fmaf(a.x, x8, s0);
    s1 = fmaf(a.y, x9, s1);
    s2 = fmaf(a.z, x10, s2);
    s3 = fmaf(a.w, x11, s3);
    a = *(const LAS f32x4*)(Am + 964);
    s0 = fmaf(a.x, x12, s0);
    const float al14 = a.y;
    x14 = (x14 - ((s0 + s1) + (s2 + s3))) - al14 * x13;
    Tu[1904 + c] = f2bf(x14 * su); Tw[1904 + c] = f2bf(x14 * sw); asm volatile("" ::: "memory");
    float x15 = fmaxf(0.0f, 1.0f - fabsf(cf - 15.0f));
    s0 = 0.f; s1 = 0.f; s2 = 0.f; s3 = 0.f;
    a = *(const LAS f32x4*)(Am + 1020);
    s0 = fmaf(a.x, x0, s0);
    s1 = fmaf(a.y, x1, s1);
    s2 = fmaf(a.z, x2, s2);
    s3 = fmaf(a.w, x3, s3);
    a = *(const LAS f32x4*)(Am + 1024);
    s0 = fmaf(a.x, x4, s0);
    s1 = fmaf(a.y, x5, s1);
    s2 = fmaf(a.z, x6, s2);
    s3 = fmaf(a.w, x7, s3);
    a = *(const LAS f32x4*)(Am + 1028);
    s0 = fmaf(a.x, x8, s0);
    s1 = fmaf(a.y, x9, s1);
    s2 = fmaf(a.z, x10, s2);
    s3 = fmaf(a.w, x11, s3);
    a = *(const LAS f32x4*)(Am + 1032);
    s0 = fmaf(a.x, x12, s0);
    s1 = fmaf(a.y, x13, s1);
    const float al15 = a.z;
    x15 = (x15 - ((s0 + s1) + (s2 + s3))) - al15 * x14;
    Tu[2040 + c] = f2bf(x15 * su); Tw[2040 + c] = f2bf(x15 * sw); asm volatile("" ::: "memory");
    float x16 = fmaxf(0.0f, 1.0f - fabsf(cf - 16.0f));
    s0 = 0.f; s1 = 0.f; s2 = 0.f; s3 = 0.f;
    a = *(const LAS f32x4*)(Am + 1088);
    s0 = fmaf(a.x, x0, s0);
    s1 = fmaf(a.y, x1, s1);
    s2 = fmaf(a.z, x2, s2);
    s3 = fmaf(a.w, x3, s3);
    a = *(const LAS f32x4*)(Am + 1092);
    s0 = fmaf(a.x, x4, s0);
    s1 = fmaf(a.y, x5, s1);
    s2 = fmaf(a.z, x6, s2);
    s3 = fmaf(a.w, x7, s3);
    a = *(const LAS f32x4*)(Am + 1096);
    s0 = fmaf(a.x, x8, s0);
    s1 = fmaf(a.y, x9, s1);
    s2 = fmaf(a.z, x10, s2);
    s3 = fmaf(a.w, x11, s3);
    a = *(const LAS f32x4*)(Am + 1100);
    s0 = fmaf(a.x, x12, s0);
    s1 = fmaf(a.y, x13, s1);
    s2 = fmaf(a.z, x14, s2);
    const float al16 = a.w;
    x16 = (x16 - ((s0 + s1) + (s2 + s3))) - al16 * x15;
    Tu[2176 + c] = f2bf(x16 * su); Tw[2176 + c] = f2bf(x16 * sw); asm volatile("" ::: "memory");
    float x17 = fmaxf(0.0f, 1.0f - fabsf(cf - 17.0f));
    s0 = 0.f; s1 = 0.f; s2 = 0.f; s3 = 0.f;
    a = *(const LAS f32x4*)(Am + 1156);
    s0 = fmaf(a.x, x0, s0);
    s1 = fmaf(a.y, x1, s1);
    s2 = fmaf(a.z, x2, s2);
    s3 = fmaf(a.w, x3, s3);
    a = *(const LAS f32x4*)(Am + 1160);
    s0 = fmaf(a.x, x4, s0);
    s1 = fmaf(a.y, x5, s1);
    s2 = fmaf(a.z, x6, s2);
    s3 = fmaf(a.w, x7, s3);
    a = *(const LAS f32x4*)(Am + 1164);
    s0 = fmaf(a.x, x8, s0);
    s1 = fmaf(a.y, x9, s1);
    s2 = fmaf(a.z, x10, s2);
    s3 = fmaf(a.w, x11, s3);
    a = *(const LAS f32x4*)(Am + 1168);
    s0 = fmaf(a.x, x12, s0);
    s1 = fmaf(a.y, x13, s1);
    s2 = fmaf(a.z, x14, s2);
    s3 = fmaf(a.w, x15, s3);
    a = *(const LAS f32x4*)(Am + 1172);
    const float al17 = a.x;
    x17 = (x17 - ((s0 + s1) + (s2 + s3))) - al17 * x16;
    Tu[2312 + c] = f2bf(x17 * su); Tw[2312 + c] = f2bf(x17 * sw); asm volatile("" ::: "memory");
    float x18 = fmaxf(0.0f, 1.0f - fabsf(cf - 18.0f));
    s0 = 0.f; s1 = 0.f; s2 = 0.f; s3 = 0.f;
    a = *(const LAS f32x4*)(Am + 1224);
    s0 = fmaf(a.x, x0, s0);
    s1 = fmaf(a.y, x1, s1);
    s2 = fmaf(a.z, x2, s2);
    s3 = fmaf(a.w, x3, s3);
    a = *(const LAS f32x4*)(Am + 1228);
    s0 = fmaf(a.x, x4, s0);
    s1 = fmaf(a.y, x5, s1);
    s2 = fmaf(a.z, x6, s2);
    s3 = fmaf(a.w, x7, s3);
    a = *(const LAS f32x4*)(Am + 1232);
    s0 = fmaf(a.x, x8, s0);
    s1 = fmaf(a.y, x9, s1);
    s2 = fmaf(a.z, x10, s2);
    s3 = fmaf(a.w, x11, s3);
    a = *(const LAS f32x4*)(Am + 1236);
    s0 = fmaf(a.x, x12, s0);
    s1 = fmaf(a.y, x13, s1);
    s2 = fmaf(a.z, x14, s2);
    s3 = fmaf(a.w, x15, s3);
    a = *(const LAS f32x4*)(Am + 1240);
    s0 = fmaf(a.x, x16, s0);
    const float al18 = a.y;
    x18 = (x18 - ((s0 + s1) + (s2 + s3))) - al18 * x17;
    Tu[2448 + c] = f2bf(x18 * su); Tw[2448 + c] = f2bf(x18 * sw); asm volatile("" ::: "memory");
    float x19 = fmaxf(0.0f, 1.0f - fabsf(cf - 19.0f));
    s0 = 0.f; s1 = 0.f; s2 = 0.f; s3 = 0.f;
    a = *(const LAS f32x4*)(Am + 1292);
    s0 = fmaf(a.x, x0, s0);
    s1 = fmaf(a.y, x1, s1);
    s2 = fmaf(a.z, x2, s2);
    s3 = fmaf(a.w, x3, s3);
    a = *(const LAS f32x4*)(Am + 1296);
    s0 = fmaf(a.x, x4, s0);
    s1 = fmaf(a.y, x5, s1);
    s2 = fmaf(a.z, x6, s2);
    s3 = fmaf(a.w, x7, s3);
    a = *(const LAS f32x4*)(Am + 1300);
    s0 = fmaf(a.x, x8, s0);
    s1 = fmaf(a.y, x9, s1);
    s2 = fmaf(a.z, x10, s2);
    s3 = fmaf(a.w, x11, s3);
    a = *(const LAS f32x4*)(Am + 1304);
    s0 = fmaf(a.x, x12, s0);
    s1 = fmaf(a.y, x13, s1);
    s2 = fmaf(a.z, x14, s2);
    s3 = fmaf(a.w, x15, s3);
    a = *(const LAS f32x4*)(Am + 1308);
    s0 = fmaf(a.x, x16, s0);
    s1 = fmaf(a.y, x17, s1);
    const float al19 = a.z;
    x19 = (x19 - ((s0 + s1) + (s2 + s3))) - al19 * x18;
    Tu[2584 + c] = f2bf(x19 * su); Tw[2584 + c] = f2bf(x19 * sw); asm volatile("" ::: "memory");
    float x20 = fmaxf(0.0f, 1.0f - fabsf(cf - 20.0f));
    s0 = 0.f; s1 = 0.f; s2 = 0.f; s3 = 0.f;
    a = *(const LAS f32x4*)(Am + 1360);
    s0 = fmaf(a.x, x0, s0);
    s1 = fmaf(a.y, x1, s1);
    s2 = fmaf(a.z, x2, s2);
    s3 = fmaf(a.w, x3, s3);
    a = *(const LAS f32x4*)(Am + 1364);
    s0 = fmaf(a.x, x4, s0);
    s1 = fmaf(a.y, x5, s1);
    s2 = fmaf(a.z, x6, s2);
    s3 = fmaf(a.w, x7, s3);
    a = *(const LAS f32x4*)(Am + 1368);
    s0 = fmaf(a.x, x8, s0);
    s1 = fmaf(a.y, x9, s1);
    s2 = fmaf(a.z, x10, s2);
    s3 = fmaf(a.w, x11, s3);
    a = *(const LAS f32x4*)(Am + 1372);
    s0 = fmaf(a.x, x12, s0);
    s1 = fmaf(a.y, x13, s1);
    s2 = fmaf(a.z, x14, s2);
    s3 = fmaf(a.w, x15, s3);
    a = *(const LAS f32x4*)(Am + 1376);
    s0 = fmaf(a.x, x16, s0);
    s1 = fmaf(a.y, x17, s1);
    s2 = fmaf(a.z, x18, s2);
    const float al20 = a.w;
    x20 = (x20 - ((s0 + s1) + (s2 + s3))) - al20 * x19;
    Tu[2720 + c] = f2bf(x20 * su); Tw[2720 + c] = f2bf(x20 * sw); asm volatile("" ::: "memory");
    float x21 = fmaxf(0.0f, 1.0f - fabsf(cf - 21.0f));
    s0 = 0.f; s1 = 0.f; s2 = 0.f; s3 = 0.f;
    a = *(const LAS f32x4*)(Am + 1428);
    s0 = fmaf(a.x, x0, s0);
    s1 = fmaf(a.y, x1, s1);
    s2 = fmaf(a.z, x2, s2);
    s3 = fmaf(a.w, x3, s3);
    a = *(const LAS f32x4*)(Am + 1432);
    s0 = fmaf(a.x, x4, s0);
    s1 = fmaf(a.y, x5, s1);
    s2 = fmaf(a.z, x6, s2);
    s3 = fmaf(a.w, x7, s3);
    a = *(const LAS f32x4*)(Am + 1436);
    s0 = fmaf(a.x, x8, s0);
    s1 = fmaf(a.y, x9, s1);
    s2 = fmaf(a.z, x10, s2);
    s3 = fmaf(a.w, x11, s3);
    a = *(const LAS f32x4*)(Am + 1440);
    s0 = fmaf(a.x, x12, s0);
    s1 = fmaf(a.y, x13, s1);
    s2 = fmaf(a.z, x14, s2);
    s3 = fmaf(a.w, x15, s3);
    a = *(const LAS f32x4*)(Am + 1444);
    s0 = fmaf(a.x, x16, s0);
    s1 = fmaf(a.y, x17, s1);
    s2 = fmaf(a.z, x18, s2);
    s3 = fmaf(a.w, x19, s3);
    a = *(const LAS f32x4*)(Am + 1448);
    const float al21 = a.x;
    x21 = (x21 - ((s0 + s1) + (s2 + s3))) - al21 * x20;
    Tu[2856 + c] = f2bf(x21 * su); Tw[2856 + c] = f2bf(x21 * sw); asm volatile("" ::: "memory");
    float x22 = fmaxf(0.0f, 1.0f - fabsf(cf - 22.0f));
    s0 = 0.f; s1 = 0.f; s2 = 0.f; s3 = 0.f;
    a = *(const LAS f32x4*)(Am + 1496);
    s0 = fmaf(a.x, x0, s0);
    s1 = fmaf(a.y, x1, s1);
    s2 = fmaf(a.z, x2, s2);
    s3 = fmaf(a.w, x3, s3);
    a = *(const LAS f32x4*)(Am + 1500);
    s0 = fmaf(a.x, x4, s0);
    s1 = fmaf(a.y, x5, s1);
    s2 = fmaf(a.z, x6, s2);
    s3 = fmaf(a.w, x7, s3);
    a = *(const LAS f32x4*)(Am + 1504);
    s0 = fmaf(a.x, x8, s0);
    s1 = fmaf(a.y, x9, s1);
    s2 = fmaf(a.z, x10, s2);
    s3 = fmaf(a.w, x11, s3);
    a = *(const LAS f32x4*)(Am + 1508);
    s0 = fmaf(a.x, x12, s0);
    s1 = fmaf(a.y, x13, s1);
    s2 = fmaf(a.z, x14, s2);
    s3 = fmaf(a.w, x15, s3);
    a = *(const LAS f32x4*)(Am + 1512);
    s0 = fmaf(a.x, x16, s0);
    s1 = fmaf(a.y, x17, s1);
    s2 = fmaf(a.z, x18, s2);
    s3 = fmaf(a.w, x19, s3);
    a = *(const LAS f32x4*)(Am + 1516);
    s0 = fmaf(a.x, x20, s0);
    const float al22 = a.y;
    x22 = (x22 - ((s0 + s1) + (s2 + s3))) - al22 * x21;
    Tu[2992 + c] = f2bf(x22 * su); Tw[2992 + c] = f2bf(x22 * sw); asm volatile("" ::: "memory");
    float x23 = fmaxf(0.0f, 1.0f - fabsf(cf - 23.0f));
    s0 = 0.f; s1 = 0.f; s2 = 0.f; s3 = 0.f;
    a = *(const LAS f32x4*)(Am + 1564);
    s0 = fmaf(a.x, x0, s0);
    s1 = fmaf(a.y, x1, s1);
    s2 = fmaf(a.z, x2, s2);
    s3 = fmaf(a.w, x3, s3);
    a = *(const LAS f32x4*)(Am + 1568);
    s0 = fmaf(a.x, x4, s0);
    s1 = fmaf(a.y, x5, s1);
    s2 = fmaf(a.z, x6, s2);
    s3 = fmaf(a.w, x7, s3);
    a = *(const LAS f32x4*)(Am + 1572);
    s0 = fmaf(a.x, x8, s0);
    s1 = fmaf(a.y, x9, s1);
    s2 = fmaf(a.z, x10, s2);
    s3 = fmaf(a.w, x11, s3);
    a = *(const LAS f32x4*)(Am + 1576);
    s0 = fmaf(a.x, x12, s0);
    s1 = fmaf(a.y, x13, s1);
    s2 = fmaf(a.z, x14, s2);
    s3 = fmaf(a.w, x15, s3);
    a = *(const LAS f32x4*)(Am + 1580);
    s0 = fmaf(a.x, x16, s0);
    s1 = fmaf(a.y, x17, s1);
    s2 = fmaf(a.z, x18, s2);
    s3 = fmaf(a.w, x19, s3);
    a = *(const LAS f32x4*)(Am + 1584);
    s0 = fmaf(a.x, x20, s0);
    s1 = fmaf(a.y, x21, s1);
    const float al23 = a.z;
    x23 = (x23 - ((s0 + s1) + (s2 + s3))) - al23 * x22;
    Tu[3128 + c] = f2bf(x23 * su); Tw[3128 + c] = f2bf(x23 * sw); asm volatile("" ::: "memory");
    float x24 = fmaxf(0.0f, 1.0f - fabsf(cf - 24.0f));
    s0 = 0.f; s1 = 0.f; s2 = 0.f; s3 = 0.f;
    a = *(const LAS f32x4*)(Am + 1632);
    s0 = fmaf(a.x, x0, s0);
    s1 = fmaf(a.y, x1, s1);
    s2 = fmaf(a.z, x2, s2);
    s3 = fmaf(a.w, x3, s3);
    a = *(const LAS f32x4*)(Am + 1636);
    s0 = fmaf(a.x, x4, s0);
    s1 = fmaf(a.y, x5, s1);
    s2 = fmaf(a.z, x6, s2);
    s3 = fmaf(a.w, x7, s3);
    a = *(const LAS f32x4*)(Am + 1640);
    s0 = fmaf(a.x, x8, s0);
    s1 = fmaf(a.y, x9, s1);
    s2 = fmaf(a.z, x10, s2);
    s3 = fmaf(a.w, x11, s3);
    a = *(const LAS f32x4*)(Am + 1644);
    s0 = fmaf(a.x, x12, s0);
    s1 = fmaf(a.y, x13, s1);
    s2 = fmaf(a.z, x14, s2);
    s3 = fmaf(a.w, x15, s3);
    a = *(const LAS f32x4*)(Am + 1648);
    s0 = fmaf(a.x, x16, s0);
    s1 = fmaf(a.y, x17, s1);
    s2 = fmaf(a.z, x18, s2);
    s3 = fmaf(a.w, x19, s3);
    a = *(const LAS f32x4*)(Am + 1652);
    s0 = fmaf(a.x, x20, s0);
    s1 = fmaf(a.y, x21, s1);
    s2 = fmaf(a.z, x22, s2);
    const float al24 = a.w;
    x24 = (x24 - ((s0 + s1) + (s2 + s3))) - al24 * x23;
    Tu[3264 + c] = f2bf(x24 * su); Tw[3264 + c] = f2bf(x24 * sw); asm volatile("" ::: "memory");
    float x25 = fmaxf(0.0f, 1.0f - fabsf(cf - 25.0f));
    s0 = 0.f; s1 = 0.f; s2 = 0.f; s3 = 0.f;
    a = *(const LAS f32x4*)(Am + 1700);
    s0 = fmaf(a.x, x0, s0);
    s1 = fmaf(a.y, x1, s1);
    s2 = fmaf(a.z, x2, s2);
    s3 = fmaf(a.w, x3, s3);
    a = *(const LAS f32x4*)(Am + 1704);
    s0 = fmaf(a.x, x4, s0);
    s1 = fmaf(a.y, x5, s1);
    s2 = fmaf(a.z, x6, s2);
    s3 = fmaf(a.w, x7, s3);
    a = *(const LAS f32x4*)(Am + 1708);
    s0 = fmaf(a.x, x8, s0);
    s1 = fmaf(a.y, x9, s1);
    s2 = fmaf(a.z, x10, s2);
    s3 = fmaf(a.w, x11, s3);
    a = *(const LAS f32x4*)(Am + 1712);
    s0 = fmaf(a.x, x12, s0);
    s1 = fmaf(a.y, x13, s1);
    s2 = fmaf(a.z, x14, s2);
    s3 = fmaf(a.w, x15, s3);
    a = *(const LAS f32x4*)(Am + 1716);
    s0 = fmaf(a.x, x16, s0);
    s1 = fmaf(a.y, x17, s1);
    s2 = fmaf(a.z, x18, s2);
    s3 = fmaf(a.w, x19, s3);
    a = *(const LAS f32x4*)(Am + 1720);
    s0 = fmaf(a.x, x20, s0);
    s1 = fmaf(a.y, x21, s1);
    s2 = fmaf(a.z, x22, s2);
    s3 = fmaf(a.w, x23, s3);
    a = *(const LAS f32x4*)(Am + 1724);
    const float al25 = a.x;
    x25 = (x25 - ((s0 + s1) + (s2 + s3))) - al25 * x24;
    Tu[3400 + c] = f2bf(x25 * su); Tw[3400 + c] = f2bf(x25 * sw); asm volatile("" ::: "memory");
    float x26 = fmaxf(0.0f, 1.0f - fabsf(cf - 26.0f));
    s0 = 0.f; s1 = 0.f; s2 = 0.f; s3 = 0.f;
    a = *(const LAS f32x4*)(Am + 1768);
    s0 = fmaf(a.x, x0, s0);
    s1 = fmaf(a.y, x1, s1);
    s2 = fmaf(a.z, x2, s2);
    s3 = fmaf(a.w, x3, s3);
    a = *(const LAS f32x4*)(Am + 1772);
    s0 = fmaf(a.x, x4, s0);
    s1 = fmaf(a.y, x5, s1);
    s2 = fmaf(a.z, x6, s2);
    s3 = fmaf(a.w, x7, s3);
    a = *(const LAS f32x4*)(Am + 1776);
    s0 = fmaf(a.x, x8, s0);
    s1 = fmaf(a.y, x9, s1);
    s2 = fmaf(a.z, x10, s2);
    s3 = fmaf(a.w, x11, s3);
    a = *(const LAS f32x4*)(Am + 1780);
    s0 = fmaf(a.x, x12, s0);
    s1 = fmaf(a.y, x13, s1);
    s2 = fmaf(a.z, x14, s2);
    s3 = fmaf(a.w, x15, s3);
    a = *(const LAS f32x4*)(Am + 1784);
    s0 = fmaf(a.x, x16, s0);
    s1 = fmaf(a.y, x17, s1);
    s2 = fmaf(a.z, x18, s2);
    s3 = fmaf(a.w, x19, s3);
    a = *(const LAS f32x4*)(Am + 1788);
    s0 = fmaf(a.x, x20, s0);
    s1 = fmaf(a.y, x21, s1);
    s2 = fmaf(a.z, x22, s2);
    s3 = fmaf(a.w, x23, s3);
    a = *(const LAS f32x4*)(Am + 1792);
    s0 = fmaf(a.x, x24, s0);
    const float al26 = a.y;
    x26 = (x26 - ((s0 + s1) + (s2 + s3))) - al26 * x25;
    Tu[3536 + c] = f2bf(x26 * su); Tw[3536 + c] = f2bf(x26 * sw); asm volatile("" ::: "memory");
    float x27 = fmaxf(0.0f, 1.0f - fabsf(cf - 27.0f));
    s0 = 0.f; s1 = 0.f; s2 = 0.f; s3 = 0.f;
    a = *(const LAS f32x4*)(Am + 1836);
    s0 = fmaf(a.x, x0, s0);
    s1 = fmaf(a.y, x1, s1);
    s2 = fmaf(a.z, x2, s2);
    s3 = fmaf(a.w, x3, s3);
    a = *(const LAS f32x4*)(Am + 1840);
    s0 = fmaf(a.x, x4, s0);
    s1 = fmaf(a.y, x5, s1);
    s2 = fmaf(a.z, x6, s2);
    s3 = fmaf(a.w, x7, s3);
    a = *(const LAS f32x4*)(Am + 1844);
    s0 = fmaf(a.x, x8, s0);
    s1 = fmaf(a.y, x9, s1);
    s2 = fmaf(a.z, x10, s2);
    s3 = fmaf(a.w, x11, s3);
    a = *(const LAS f32x4*)(Am + 1848);
    s0 = fmaf(a.x, x12, s0);
    s1 = fmaf(a.y, x13, s1);
    s2 = fmaf(a.z, x14, s2);
    s3 = fmaf(a.w, x15, s3);
    a = *(const LAS f32x4*)(Am + 1852);
    s0 = fmaf(a.x, x16, s0);
    s1 = fmaf(a.y, x17, s1);
    s2 = fmaf(a.z, x18, s2);
    s3 = fmaf(a.w, x19, s3);
    a = *(const LAS f32x4*)(Am + 1856);
    s0 = fmaf(a.x, x20, s0);
    s1 = fmaf(a.y, x21, s1);
    s2 = fmaf(a.z, x22, s2);
    s3 = fmaf(a.w, x23, s3);
    a = *(const LAS f32x4*)(Am + 1860);
    s0 = fmaf(a.x, x24, s0);
    s1 = fmaf(a.y, x25, s1);
    const float al27 = a.z;
    x27 = (x27 - ((s0 + s1) + (s2 + s3))) - al27 * x26;
    Tu[3672 + c] = f2bf(x27 * su); Tw[3672 + c] = f2bf(x27 * sw); asm volatile("" ::: "memory");
    float x28 = fmaxf(0.0f, 1.0f - fabsf(cf - 28.0f));
    s0 = 0.f; s1 = 0.f; s2 = 0.f; s3 = 0.f;
    a = *(const LAS f32x4*)(Am + 1904);
    s0 = fmaf(a.x, x0, s0);
    s1 = fmaf(a.y, x1, s1);
    s2 = fmaf(a.z, x2, s2);
    s3 = fmaf(a.w, x3, s3);
    a = *(const LAS f32x4*)(Am + 1908);
    s0 = fmaf(a.x, x4, s0);
    s1 = fmaf(a.y, x5, s1);
    s2 = fmaf(a.z, x6, s2);
    s3 = fmaf(a.w, x7, s3);
    a = *(const LAS f32x4*)(Am + 1912);
    s0 = fmaf(a.x, x8, s0);
    s1 = fmaf(a.y, x9, s1);
    s2 = fmaf(a.z, x10, s2);
    s3 = fmaf(a.w, x11, s3);
    a = *(const LAS f32x4*)(Am + 1916);
    s0 = fmaf(a.x, x12, s0);
    s1 = fmaf(a.y, x13, s1);
    s2 = fmaf(a.z, x14, s2);
    s3 = fmaf(a.w, x15, s3);
    a = *(const LAS f32x4*)(Am + 1920);
    s0 = fmaf(a.x, x16, s0);
    s1 = fmaf(a.y, x17, s1);
    s2 = fmaf(a.z, x18, s2);
    s3 = fmaf(a.w, x19, s3);
    a = *(const LAS f32x4*)(Am + 1924);
    s0 = fmaf(a.x, x20, s0);
    s1 = fmaf(a.y, x21, s1);
    s2 = fmaf(a.z, x22, s2);
    s3 = fmaf(a.w, x23, s3);
    a = *(const LAS f32x4*)(Am + 1928);
    s0 = fmaf(a.x, x24, s0);
    s1 = fmaf(a.y, x25, s1);
    s2 = fmaf(a.z, x26, s2);
    const float al28 = a.w;
    x28 = (x28 - ((s0 + s1) + (s2 + s3))) - al28 * x27;
    Tu[3808 + c] = f2bf(x28 * su); Tw[3808 + c] = f2bf(x28 * sw); asm volatile("" ::: "memory");
    float x29 = fmaxf(0.0f, 1.0f - fabsf(cf - 29.0f));
    s0 = 0.f; s1 = 0.f; s2 = 0.f; s3 = 0.f;
    a = *(const LAS f32x4*)(Am + 1972);
    s0 = fmaf(a.x, x0, s0);
    s1 = fmaf(a.y, x1, s1);
    s2 = fmaf(a.z, x2, s2);
    s3 = fmaf(a.w, x3, s3);
    a = *(const LAS f32x4*)(Am + 1976);
    s0 = fmaf(a.x, x4, s0);
    s1 = fmaf(a.y, x5, s1);
    s2 = fmaf(a.z, x6, s2);
    s3 = fmaf(a.w, x7, s3);
    a = *(const LAS f32x4*)(Am + 1980);
    s0 = fmaf(a.x, x8, s0);
    s1 = fmaf(a.y, x9, s1);
    s2 = fmaf(a.z, x10, s2);
    s3 = fmaf(a.w, x11, s3);
    a = *(const LAS f32x4*)(Am + 1984);
    s0 = fmaf(a.x, x12, s0);
    s1 = fmaf(a.y, x13, s1);
    s2 = fmaf(a.z, x14, s2);
    s3 = fmaf(a.w, x15, s3);
    a = *(const LAS f32x4*)(Am + 1988);
    s0 = fmaf(a.x, x16, s0);
    s1 = fmaf(a.y, x17, s1);
    s2 = fmaf(a.z, x18, s2);
    s3 = fmaf(a.w, x19, s3);
    a = *(const LAS f32x4*)(Am + 1992);
    s0 = fmaf(a.x, x20, s0);
    s1 = fmaf(a.y, x21, s1);
    s2 = fmaf(a.z, x22, s2);
    s3 = fmaf(a.w, x23, s3);
    a = *(const LAS f32x4*)(Am + 1996);
    s0 = fmaf(a.x, x24, s0);
    s1 = fmaf(a.y, x25, s1);
    s2 = fmaf(a.z, x26, s2);
    s3 = fmaf(a.w, x27, s3);
    a = *(const LAS f32x4*)(Am + 2000);
    const float al29 = a.x;
    x29 = (x29 - ((s0 + s1) + (s2 + s3))) - al29 * x28;
    Tu[3944 + c] = f2bf(x29 * su); Tw[3944 + c] = f2bf(x29 * sw); asm volatile("" ::: "memory");
    float x30 = fmaxf(0.0f, 1.0f - fabsf(cf - 30.0f));
    s0 = 0.f; s1 = 0.f; s2 = 0.f; s3 = 0.f;
    a = *(const LAS f32x4*)(Am + 2040);
    s0 = fmaf(a.x, x0, s0);
    s1 = fmaf(a.y, x1, s1);
    s2 = fmaf(a.z, x2, s2);
    s3 = fmaf(a.w, x3, s3);
    a = *(const LAS f32x4*)(Am + 2044);
    s0 = fmaf(a.x, x4, s0);
    s1 = fmaf(a.y, x5, s1);
    s2 = fmaf(a.z, x6, s2);
    s3 = fmaf(a.w, x7, s3);
    a = *(const LAS f32x4*)(Am + 2048);
    s0 = fmaf(a.x, x8, s0);
    s1 = fmaf(a.y, x9, s1);
    s2 = fmaf(a.z, x10, s2);
    s3 = fmaf(a.w, x11, s3);
    a = *(const LAS f32x4*)(Am + 2052);
    s0 = fmaf(a.x, x12, s0);
    s1 = fmaf(a.y, x13, s1);
    s2 = fmaf(a.z, x14, s2);
    s3 = fmaf(a.w, x15, s3);
    a = *(const LAS f32x4*)(Am + 2056);
    s0 = fmaf(a.x, x16, s0);
    s1 = fmaf(a.y, x17, s1);
    s2 = fmaf(a.z, x18, s2);
    s3 = fmaf(a.w, x19, s3);
    a = *(const LAS f32x4*)(Am + 2060);
    s0 = fmaf(a.x, x20, s0);
    s1 = fmaf(a.y, x21, s1);
    s2 = fmaf(a.z, x22, s2);
    s3 = fmaf(a.w, x23, s3);
    a = *(const LAS f32x4*)(Am + 2064);
    s0 = fmaf(a.x, x24, s0);
    s1 = fmaf(a.y, x25, s1);
    s2 = fmaf(a.z, x26, s2);
    s3 = fmaf(a.w, x27, s3);
    a = *(const LAS f32x4*)(Am + 2068);
    s0 = fmaf(a.x, x28, s0);
    const float al30 = a.y;
    x30 = (x30 - ((s0 + s1) + (s2 + s3))) - al30 * x29;
    Tu[4080 + c] = f2bf(x30 * su); Tw[4080 + c] = f2bf(x30 * sw); asm volatile("" ::: "memory");
    float x31 = fmaxf(0.0f, 1.0f - fabsf(cf - 31.0f));
    s0 = 0.f; s1 = 0.f; s2 = 0.f; s3 = 0.f;
    a = *(const LAS f32x4*)(Am + 2108);
    s0 = fmaf(a.x, x0, s0);
    s1 = fmaf(a.y, x1, s1);
    s2 = fmaf(a.z, x2, s2);
    s3 = fmaf(a.w, x3, s3);
    a = *(const LAS f32x4*)(Am + 2112);
    s0 = fmaf(a.x, x4, s0);
    s1 = fmaf(a.y, x5, s1);
    s2 = fmaf(a.z, x6, s2);
    s3 = fmaf(a.w, x7, s3);
    a = *(const LAS f32x4*)(Am + 2116);
    s0 = fmaf(a.x, x8, s0);
    s1 = fmaf(a.y, x9, s1);
    s2 = fmaf(a.z, x10, s2);
    s3 = fmaf(a.w, x11, s3);
    a = *(const LAS f32x4*)(Am + 2120);
    s0 = fmaf(a.x, x12, s0);
    s1 = fmaf(a.y, x13, s1);
    s2 = fmaf(a.z, x14, s2);
    s3 = fmaf(a.w, x15, s3);
    a = *(const LAS f32x4*)(Am + 2124);
    s0 = fmaf(a.x, x16, s0);
    s1 = fmaf(a.y, x17, s1);
    s2 = fmaf(a.z, x18, s2);
    s3 = fmaf(a.w, x19, s3);
    a = *(const LAS f32x4*)(Am + 2128);
    s0 = fmaf(a.x, x20, s0);
    s1 = fmaf(a.y, x21, s1);
    s2 = fmaf(a.z, x22, s2);
    s3 = fmaf(a.w, x23, s3);
    a = *(const LAS f32x4*)(Am + 2132);
    s0 = fmaf(a.x, x24, s0);
    s1 = fmaf(a.y, x25, s1);
    s2 = fmaf(a.z, x26, s2);
    s3 = fmaf(a.w, x27, s3);
    a = *(const LAS f32x4*)(Am + 2136);
    s0 = fmaf(a.x, x28, s0);
    s1 = fmaf(a.y, x29, s1);
    const float al31 = a.z;
    x31 = (x31 - ((s0 + s1) + (s2 + s3))) - al31 * x30;
    Tu[4216 + c] = f2bf(x31 * su); Tw[4216 + c] = f2bf(x31 * sw); asm volatile("" ::: "memory");
    float x32 = fmaxf(0.0f, 1.0f - fabsf(cf - 32.0f));
    s0 = 0.f; s1 = 0.f; s2 = 0.f; s3 = 0.f;
    a = *(const LAS f32x4*)(Am + 2176);
    s0 = fmaf(a.x, x0, s0);
    s1 = fmaf(a.y, x1, s1);
    s2 = fmaf(a.z, x2, s2);
    s3 = fmaf(a.w, x3, s3);
    a = *(const LAS f32x4*)(Am + 2180);
    s0 = fmaf(a.x, x4, s0);
    s1 = fmaf(a.y, x5, s1);
    s2 = fmaf(a.z, x6, s2);
    s3 = fmaf(a.w, x7, s3);
    a = *(const LAS f32x4*)(Am + 2184);
    s0 = fmaf(a.x, x8, s0);
    s1 = fmaf(a.y, x9, s1);
    s2 = fmaf(a.z, x10, s2);
    s3 = fmaf(a.w, x11, s3);
    a = *(const LAS f32x4*)(Am + 2188);
    s0 = fmaf(a.x, x12, s0);
    s1 = fmaf(a.y, x13, s1);
    s2 = fmaf(a.z, x14, s2);
    s3 = fmaf(a.w, x15, s3);
    a = *(const LAS f32x4*)(Am + 2192);
    s0 = fmaf(a.x, x16, s0);
    s1 = fmaf(a.y, x17, s1);
    s2 = fmaf(a.z, x18, s2);
    s3 = fmaf(a.w, x19, s3);
    a = *(const LAS f32x4*)(Am + 2196);
    s0 = fmaf(a.x, x20, s0);
    s1 = fmaf(a.y, x21, s1);
    s2 = fmaf(a.z, x22, s2);
    s3 = fmaf(a.w, x23, s3);
    a = *(const LAS f32x4*)(Am + 2200);
    s0 = fmaf(a.x, x24, s0);
    s1 = fmaf(a.y, x25, s1);
    s2 = fmaf(a.z, x26, s2);
    s3 = fmaf(a.w, x27, s3);
    a = *(const LAS f32x4*)(Am + 2204);
    s0 = fmaf(a.x, x28, s0);
    s1 = fmaf(a.y, x29, s1);
    s2 = fmaf(a.z, x30, s2);
    const float al32 = a.w;
    x32 = (x32 - ((s0 + s1) + (s2 + s3))) - al32 * x31;
    Tu[4352 + c] = f2bf(x32 * su); Tw[4352 + c] = f2bf(x32 * sw); asm volatile("" ::: "memory");
    float x33 = fmaxf(0.0f, 1.0f - fabsf(cf - 33.0f));
    s0 = 0.f; s1 = 0.f; s2 = 0.f; s3 = 0.f;
    a = *(const LAS f32x4*)(Am + 2244);
    s0 = fmaf(a.x, x0, s0);
    s1 = fmaf(a.y, x1, s1);
    s2 = fmaf(a.z, x2, s2);
    s3 = fmaf(a.w, x3, s3);
    a = *(const LAS f32x4*)(Am + 2248);
    s0 = fmaf(a.x, x4, s0);
    s1 = fmaf(a.y, x5, s1);
    s2 = fmaf(a.z, x6, s2);
    s3 = fmaf(a.w, x7, s3);
    a = *(const LAS f32x4*)(Am + 2252);
    s0 = fmaf(a.x, x8, s0);
    s1 = fmaf(a.y, x9, s1);
    s2 = fmaf(a.z, x10, s2);
    s3 = fmaf(a.w, x11, s3);
    a = *(const LAS f32x4*)(Am + 2256);
    s0 = fmaf(a.x, x12, s0);
    s1 = fmaf(a.y, x13, s1);
    s2 = fmaf(a.z, x14, s2);
    s3 = fmaf(a.w, x15, s3);
    a = *(const LAS f32x4*)(Am + 2260);
    s0 = fmaf(a.x, x16, s0);
    s1 = fmaf(a.y, x17, s1);
    s2 = fmaf(a.z, x18, s2);
    s3 = fmaf(a.w, x19, s3);
    a = *(const LAS f32x4*)(Am + 2264);
    s0 = fmaf(a.x, x20, s0);
    s1 = fmaf(a.y, x21, s1);
    s2 = fmaf(a.z, x22, s2);
    s3 = fmaf(a.w, x23, s3);
    a = *(const LAS f32x4*)(Am + 2268);
    s0 = fmaf(a.x, x24, s0);
    s1 = fmaf(a.y, x25, s1);
    s2 = fmaf(a.z, x26, s2);
    s3 = fmaf(a.w, x27, s3);
    a = *(const LAS f32x4*)(Am + 2272);
    s0 = fmaf(a.x, x28, s0);
    s1 = fmaf(a.y, x29, s1);
    s2 = fmaf(a.z, x30, s2);
    s3 = fmaf(a.w, x31, s3);
    a = *(const LAS f32x4*)(Am + 2276);
    const float al33 = a.x;
    x33 = (x33 - ((s0 + s1) + (s2 + s3))) - al33 * x32;
    Tu[4488 + c] = f2bf(x33 * su); Tw[4488 + c] = f2bf(x33 * sw); asm volatile("" ::: "memory");
    float x34 = fmaxf(0.0f, 1.0f - fabsf(cf - 34.0f));
    s0 = 0.f; s1 = 0.f; s2 = 0.f; s3 = 0.f;
    a = *(const LAS f32x4*)(Am + 2312);
    s0 = fmaf(a.x, x0, s0);
    s1 = fmaf(a.y, x1, s1);
    s2 = fmaf(a.z, x2, s2);
    s3 = fmaf(a.w, x3, s3);
    a = *(const LAS f32x4*)(Am + 2316);
    s0 = fmaf(a.x, x4, s0);
    s1 = fmaf(a.y, x5, s1);
    s2 = fmaf(a.z, x6, s2);
    s3 = fmaf(a.w, x7, s3);
    a = *(const LAS f32x4*)(Am + 2320);
    s0 = fmaf(a.x, x8, s0);
    s1 = fmaf(a.y, x9, s1);
    s2 = fmaf(a.z, x10, s2);
    s3 = fmaf(a.w, x11, s3);
    a = *(const LAS f32x4*)(Am + 2324);
    s0 = fmaf(a.x, x12, s0);
    s1 = fmaf(a.y, x13, s1);
    s2 = fmaf(a.z, x14, s2);
    s3 = fmaf(a.w, x15, s3);
    a = *(const LAS f32x4*)(Am + 2328);
    s0 = fmaf(a.x, x16, s0);
    s1 = fmaf(a.y, x17, s1);
    s2 = fmaf(a.z, x18, s2);
    s3 = fmaf(a.w, x19, s3);
    a = *(const LAS f32x4*)(Am + 2332);
    s0 = fmaf(a.x, x20, s0);
    s1 = fmaf(a.y, x21, s1);
    s2 = fmaf(a.z, x22, s2);
    s3 = fmaf(a.w, x23, s3);
    a = *(const LAS f32x4*)(Am + 2336);
    s0 = fmaf(a.x, x24, s0);
    s1 = fmaf(a.y, x25, s1);
    s2 = fmaf(a.z, x26, s2);
    s3 = fmaf(a.w, x27, s3);
    a = *(const LAS f32x4*)(Am + 2340);
    s0 = fmaf(a.x, x28, s0);
    s1 = fmaf(a.y, x29, s1);
    s2 = fmaf(a.z, x30, s2);
    s3 = fmaf(a.w, x31, s3);
    a = *(const LAS f32x4*)(Am + 2344);
    s0 = fmaf(a.x, x32, s0);
    const float al34 = a.y;
    x34 = (x34 - ((s0 + s1) + (s2 + s3))) - al34 * x33;
    Tu[4624 + c] = f2bf(x34 * su); Tw[4624 + c] = f2bf(x34 * sw); asm volatile("" ::: "memory");
    float x35 = fmaxf(0.0f, 1.0f - fabsf(cf - 35.0f));
    s0 = 0.f; s1 = 0.f; s2 = 0.f; s3 = 0.f;
    a = *(const LAS f32x4*)(Am + 2380);
    s0 = fmaf(a.x, x0, s0);
    s1 = fmaf(a.y, x1, s1);
    s2 = fmaf(a.z, x2, s2);
    s3 = fmaf(a.w, x3, s3);
    a = *(const LAS f32x4*)(Am + 2384);
    s0 = fmaf(a.x, x4, s0);
    s1 = fmaf(a.y, x5, s1);
    s2 = fmaf(a.z, x6, s2);
    s3 = fmaf(a.w, x7, s3);
    a = *(const LAS f32x4*)(Am + 2388);
    s0 = fmaf(a.x, x8, s0);
    s1 = fmaf(a.y, x9, s1);
    s2 = fmaf(a.z, x10, s2);
    s3 = fmaf(a.w, x11, s3);
    a = *(const LAS f32x4*)(Am + 2392);
    s0 = fmaf(a.x, x12, s0);
    s1 = fmaf(a.y, x13, s1);
    s2 = fmaf(a.z, x14, s2);
    s3 = fmaf(a.w, x15, s3);
    a = *(const LAS f32x4*)(Am + 2396);
    s0 = fmaf(a.x, x16, s0);
    s1 = fmaf(a.y, x17, s1);
    s2 = fmaf(a.z, x18, s2);
    s3 = fmaf(a.w, x19, s3);
    a = *(const LAS f32x4*)(Am + 2400);
    s0 = fmaf(a.x, x20, s0);
    s1 = fmaf(a.y, x21, s1);
    s2 = fmaf(a.z, x22, s2);
    s3 = fmaf(a.w, x23, s3);
    a = *(const LAS f32x4*)(Am + 2404);
    s0 = fmaf(a.x, x24, s0);
    s1 = fmaf(a.y, x25, s1);
    s2 = fmaf(a.z, x26, s2);
    s3 = fmaf(a.w, x27, s3);
    a = *(const LAS f32x4*)(Am + 2408);
    s0 = fmaf(a.x, x28, s0);
    s1 = fmaf(a.y, x29, s1);
    s2 = fmaf(a.z, x30, s2);
    s3 = fmaf(a.w, x31, s3);
    a = *(const LAS f32x4*)(Am + 2412);
    s0 = fmaf(a.x, x32, s0);
    s1 = fmaf(a.y, x33, s1);
    const float al35 = a.z;
    x35 = (x35 - ((s0 + s1) + (s2 + s3))) - al35 * x34;
    Tu[4760 + c] = f2bf(x35 * su); Tw[4760 + c] = f2bf(x35 * sw); asm volatile("" ::: "memory");
    float x36 = fmaxf(0.0f, 1.0f - fabsf(cf - 36.0f));
    s0 = 0.f; s1 = 0.f; s2 = 0.f; s3 = 0.f;
    a = *(const LAS f32x4*)(Am + 2448);
    s0 = fmaf(a.x, x0, s0);
    s1 = fmaf(a.y, x1, s1);
    s2 = fmaf(a.z, x2, s2);
    s3 = fmaf(a.w, x3, s3);
    a = *(const LAS f32x4*)(Am + 2452);
    s0 = fmaf(a.x, x4, s0);
    s1 = fmaf(a.y, x5, s1);
    s2 = fmaf(a.z, x6, s2);
    s3 = fmaf(a.w, x7, s3);
    a = *(const LAS f32x4*)(Am + 2456);
    s0 = fmaf(a.x, x8, s0);
    s1 = fmaf(a.y, x9, s1);
    s2 = fmaf(a.z, x10, s2);
    s3 = fmaf(a.w, x11, s3);
    a = *(const LAS f32x4*)(Am + 2460);
    s0 = fmaf(a.x, x12, s0);
    s1 = fmaf(a.y, x13, s1);
    s2 = fmaf(a.z, x14, s2);
    s3 = fmaf(a.w, x15, s3);
    a = *(const LAS f32x4*)(Am + 2464);
    s0 = fmaf(a.x, x16, s0);
    s1 = fmaf(a.y, x17, s1);
    s2 = fmaf(a.z, x18, s2);
    s3 = fmaf(a.w, x19, s3);
    a = *(const LAS f32x4*)(Am + 2468);
    s0 = fmaf(a.x, x20, s0);
    s1 = fmaf(a.y, x21, s1);
    s2 = fmaf(a.z, x22, s2);
    s3 = fmaf(a.w, x23, s3);
    a = *(const LAS f32x4*)(Am + 2472);
    s0 = fmaf(a.x, x24, s0);
    s1 = fmaf(a.y, x25, s1);
    s2 = fmaf(a.z, x26, s2);
    s3 = fmaf(a.w, x27, s3);
    a = *(const LAS f32x4*)(Am + 2476);
    s0 = fmaf(a.x, x28, s0);
    s1 = fmaf(a.y, x29, s1);
    s2 = fmaf(a.z, x30, s2);
    s3 = fmaf(a.w, x31, s3);
    a = *(const LAS f32x4*)(Am + 2480);
    s0 = fmaf(a.x, x32, s0);
    s1 = fmaf(a.y, x33, s1);
    s2 = fmaf(a.z, x34, s2);
    const float al36 = a.w;
    x36 = (x36 - ((s0 + s1) + (s2 + s3))) - al36 * x35;
    Tu[4896 + c] = f2bf(x36 * su); Tw[4896 + c] = f2bf(x36 * sw); asm volatile("" ::: "memory");
    float x37 = fmaxf(0.0f, 1.0f - fabsf(cf - 37.0f));
    s0 = 0.f; s1 = 0.f; s2 = 0.f; s3 = 0.f;
    a = *(const LAS f32x4*)(Am + 2516);
    s0 = fmaf(a.x, x0, s0);
    s1 = fmaf(a.y, x1, s1);
    s2 = fmaf(a.z, x2, s2);
    s3 = fmaf(a.w, x3, s3);
    a = *(const LAS f32x4*)(Am + 2520);
    s0 = fmaf(a.x, x4, s0);
    s1 = fmaf(a.y, x5, s1);
    s2 = fmaf(a.z, x6, s2);
    s3 = fmaf(a.w, x7, s3);
    a = *(const LAS f32x4*)(Am + 2524);
    s0 = fmaf(a.x, x8, s0);
    s1 = fmaf(a.y, x9, s1);
    s2 = fmaf(a.z, x10, s2);
    s3 = fmaf(a.w, x11, s3);
    a = *(const LAS f32x4*)(Am + 2528);
    s0 = fmaf(a.x, x12, s0);
    s1 = fmaf(a.y, x13, s1);
    s2 = fmaf(a.z, x14, s2);
    s3 = fmaf(a.w, x15, s3);
    a = *(const LAS f32x4*)(Am + 2532);
    s0 = fmaf(a.x, x16, s0);
    s1 = fmaf(a.y, x17, s1);
    s2 = fmaf(a.z, x18, s2);
    s3 = fmaf(a.w, x19, s3);
    a = *(const LAS f32x4*)(Am + 2536);
    s0 = fmaf(a.x, x20, s0);
    s1 = fmaf(a.y, x21, s1);
    s2 = fmaf(a.z, x22, s2);
    s3 = fmaf(a.w, x23, s3);
    a = *(const LAS f32x4*)(Am + 2540);
    s0 = fmaf(a.x, x24, s0);
    s1 = fmaf(a.y, x25, s1);
    s2 = fmaf(a.z, x26, s2);
    s3 = fmaf(a.w, x27, s3);
    a = *(const LAS f32x4*)(Am + 2544);
    s0 = fmaf(a.x, x28, s0);
    s1 = fmaf(a.y, x29, s1);
    s2 = fmaf(a.z, x30, s2);
    s3 = fmaf(a.w, x31, s3);
    a = *(const LAS f32x4*)(Am + 2548);
    s0 = fmaf(a.x, x32, s0);
    s1 = fmaf(a.y, x33, s1);
    s2 = fmaf(a.z, x34, s2);
    s3 = fmaf(a.w, x35, s3);
    a = *(const LAS f32x4*)(Am + 2552);
    const float al37 = a.x;
    x37 = (x37 - ((s0 + s1) + (s2 + s3))) - al37 * x36;
    Tu[5032 + c] = f2bf(x37 * su); Tw[5032 + c] = f2bf(x37 * sw); asm volatile("" ::: "memory");
    float x38 = fmaxf(0.0f, 1.0f - fabsf(cf - 38.0f));
    s0 = 0.f; s1 = 0.f; s2 = 0.f; s3 = 0.f;
    a = *(const LAS f32x4*)(Am + 2584);
    s0 = fmaf(a.x, x0, s0);
    s1 = fmaf(a.y, x1, s1);
    s2 = fmaf(a.z, x2, s2);
    s3 = fmaf(a.w, x3, s3);
    a = *(const LAS f32x4*)(Am + 2588);
    s0 = fmaf(a.x, x4, s0);
    s1 = fmaf(a.y, x5, s1);
    s2 = fmaf(a.z, x6, s2);
    s3 = fmaf(a.w, x7, s3);
    a = *(const LAS f32x4*)(Am + 2592);
    s0 = fmaf(a.x, x8, s0);
    s1 = fmaf(a.y, x9, s1);
    s2 = fmaf(a.z, x10, s2);
    s3 = fmaf(a.w, x11, s3);
    a = *(const LAS f32x4*)(Am + 2596);
    s0 = fmaf(a.x, x12, s0);
    s1 = fmaf(a.y, x13, s1);
    s2 = fmaf(a.z, x14, s2);
    s3 = fmaf(a.w, x15, s3);
    a = *(const LAS f32x4*)(Am + 2600);
    s0 = fmaf(a.x, x16, s0);
    s1 = fmaf(a.y, x17, s1);
    s2 = fmaf(a.z, x18, s2);
    s3 = fmaf(a.w, x19, s3);
    a = *(const LAS f32x4*)(Am + 2604);
    s0 = fmaf(a.x, x20, s0);
    s1 = fmaf(a.y, x21, s1);
    s2 = fmaf(a.z, x22, s2);
    s3 = fmaf(a.w, x23, s3);
    a = *(const LAS f32x4*)(Am + 2608);
    s0 = fmaf(a.x, x24, s0);
    s1 = fmaf(a.y, x25, s1);
    s2 = fmaf(a.z, x26, s2);
    s3 = fmaf(a.w, x27, s3);
    a = *(const LAS f32x4*)(Am + 2612);
    s0 = fmaf(a.x, x28, s0);
    s1 = fmaf(a.y, x29, s1);
    s2 = fmaf(a.z, x30, s2);
    s3 = fmaf(a.w, x31, s3);
    a = *(const LAS f32x4*)(Am + 2616);
    s0 = fmaf(a.x, x32, s0);
    s1 = fmaf(a.y, x33, s1);
    s2 = fmaf(a.z, x34, s2);
    s3 = fmaf(a.w, x35, s3);
    a = *(const LAS f32x4*)(Am + 2620);
    s0 = fmaf(a.x, x36, s0);
    const float al38 = a.y;
    x38 = (x38 - ((s0 + s1) + (s2 + s3))) - al38 * x37;
    Tu[5168 + c] = f2bf(x38 * su); Tw[5168 + c] = f2bf(x38 * sw); asm volatile("" ::: "memory");
    float x39 = fmaxf(0.0f, 1.0f - fabsf(cf - 39.0f));
    s0 = 0.f; s1 = 0.f; s2 = 0.f; s3 = 0.f;
    a = *(const LAS f32x4*)(Am + 2652);
    s0 = fmaf(a.x, x0, s0);
    s1 = fmaf(a.y, x1, s1);
    s2 = fmaf(a.z, x2, s2);
    s3 = fmaf(a.w, x3, s3);
    a = *(const LAS f32x4*)(Am + 2656);
    s0 = fmaf(a.x, x4, s0);
    s1 = fmaf(a.y, x5, s1);
    s2 = fmaf(a.z, x6, s2);
    s3 = fmaf(a.w, x7, s3);
    a = *(const LAS f32x4*)(Am + 2660);
    s0 = fmaf(a.x, x8, s0);
    s1 = fmaf(a.y, x9, s1);
    s2 = fmaf(a.z, x10, s2);
    s3 = fmaf(a.w, x11, s3);
    a = *(const LAS f32x4*)(Am + 2664);
    s0 = fmaf(a.x, x12, s0);
    s1 = fmaf(a.y, x13, s1);
    s2 = fmaf(a.z, x14, s2);
    s3 = fmaf(a.w, x15, s3);
    a = *(const LAS f32x4*)(Am + 2668);
    s0 = fmaf(a.x, x16, s0);
    s1 = fmaf(a.y, x17, s1);
    s2 = fmaf(a.z, x18, s2);
    s3 = fmaf(a.w, x19, s3);
    a = *(const LAS f32x4*)(Am + 2672);
    s0 = fmaf(a.x, x20, s0);
    s1 = fmaf(a.y, x21, s1);
    s2 = fmaf(a.z, x22, s2);
    s3 = fmaf(a.w, x23, s3);
    a = *(const LAS f32x4*)(Am + 2676);
    s0 = fmaf(a.x, x24, s0);
    s1 = fmaf(a.y, x25, s1);
    s2 = fmaf(a.z, x26, s2);
    s3 = fmaf(a.w, x27, s3);
    a = *(const LAS f32x4*)(Am + 2680);
    s0 = fmaf(a.x, x28, s0);
    s1 = fmaf(a.y, x29, s1);
    s2 = fmaf(a.z, x30, s2);
    s3 = fmaf(a.w, x31, s3);
    a = *(const LAS f32x4*)(Am + 2684);
    s0 = fmaf(a.x, x32, s0);
    s1 = fmaf(a.y, x33, s1);
    s2 = fmaf(a.z, x34, s2);
    s3 = fmaf(a.w, x35, s3);
    a = *(const LAS f32x4*)(Am + 2688);
    s0 = fmaf(a.x, x36, s0);
    s1 = fmaf(a.y, x37, s1);
    const float al39 = a.z;
    x39 = (x39 - ((s0 + s1) + (s2 + s3))) - al39 * x38;
    Tu[5304 + c] = f2bf(x39 * su); Tw[5304 + c] = f2bf(x39 * sw); asm volatile("" ::: "memory");
    float x40 = fmaxf(0.0f, 1.0f - fabsf(cf - 40.0f));
    s0 = 0.f; s1 = 0.f; s2 = 0.f; s3 = 0.f;
    a = *(const LAS f32x4*)(Am + 2720);
    s0 = fmaf(a.x, x0, s0);
    s1 = fmaf(a.y, x1, s1);
    s2 = fmaf(a.z, x2, s2);
    s3 = fmaf(a.w, x3, s3);
    a = *(const LAS f32x4*)(Am + 2724);
    s0 = fmaf(a.x, x4, s0);
    s1 = fmaf(a.y, x5, s1);
    s2 = fmaf(a.z, x6, s2);
    s3 = fmaf(a.w, x7, s3);
    a = *(const LAS f32x4*)(Am + 2728);
    s0 = fmaf(a.x, x8, s0);
    s1 = fmaf(a.y, x9, s1);
    s2 = fmaf(a.z, x10, s2);
    s3 = fmaf(a.w, x11, s3);
    a = *(const LAS f32x4*)(Am + 2732);
    s0 = fmaf(a.x, x12, s0);
    s1 = fmaf(a.y, x13, s1);
    s2 = fmaf(a.z, x14, s2);
    s3 = fmaf(a.w, x15, s3);
    a = *(const LAS f32x4*)(Am + 2736);
    s0 = fmaf(a.x, x16, s0);
    s1 = fmaf(a.y, x17, s1);
    s2 = fmaf(a.z, x18, s2);
    s3 = fmaf(a.w, x19, s3);
    a = *(const LAS f32x4*)(Am + 2740);
    s0 = fmaf(a.x, x20, s0);
    s1 = fmaf(a.y, x21, s1);
    s2 = fmaf(a.z, x22, s2);
    s3 = fmaf(a.w, x23, s3);
    a = *(const LAS f32x4*)(Am + 2744);
    s0 = fmaf(a.x, x24, s0);
    s1 = fmaf(a.y, x25, s1);
    s2 = fmaf(a.z, x26, s2);
    s3 = fmaf(a.w, x27, s3);
    a = *(const LAS f32x4*)(Am + 2748);
    s0 = fmaf(a.x, x28, s0);
    s1 = fmaf(a.y, x29, s1);
    s2 = fmaf(a.z, x30, s2);
    s3 = fmaf(a.w, x31, s3);
    a = *(const LAS f32x4*)(Am + 2752);
    s0 = fmaf(a.x, x32, s0);
    s1 = fmaf(a.y, x33, s1);
    s2 = fmaf(a.z, x34, s2);
    s3 = fmaf(a.w, x35, s3);
    a = *(const LAS f32x4*)(Am + 2756);
    s0 = fmaf(a.x, x36, s0);
    s1 = fmaf(a.y, x37, s1);
    s2 = fmaf(a.z, x38, s2);
    const float al40 = a.w;
    x40 = (x40 - ((s0 + s1) + (s2 + s3))) - al40 * x39;
    Tu[5440 + c] = f2bf(x40 * su); Tw[5440 + c] = f2bf(x40 * sw); asm volatile("" ::: "memory");
    float x41 = fmaxf(0.0f, 1.0f - fabsf(cf - 41.0f));
    s0 = 0.f; s1 = 0.f; s2 = 0.f; s3 = 0.f;
    a = *(const LAS f32x4*)(Am + 2788);
    s0 = fmaf(a.x, x0, s0);
    s1 = fmaf(a.y, x1, s1);
    s2 = fmaf(a.z, x2, s2);
    s3 = fmaf(a.w, x3, s3);
    a = *(const LAS f32x4*)(Am + 2792);
    s0 = fmaf(a.x, x4, s0);
    s1 = fmaf(a.y, x5, s1);
    s2 = fmaf(a.z, x6, s2);
    s3 = fmaf(a.w, x7, s3);
    a = *(const LAS f32x4*)(Am + 2796);
    s0 = fmaf(a.x, x8, s0);
    s1 = fmaf(a.y, x9, s1);
    s2 = fmaf(a.z, x10, s2);
    s3 = fmaf(a.w, x11, s3);
    a = *(const LAS f32x4*)(Am + 2800);
    s0 = fmaf(a.x, x12, s0);
    s1 = fmaf(a.y, x13, s1);
    s2 = fmaf(a.z, x14, s2);
    s3 = fmaf(a.w, x15, s3);
    a = *(const LAS f32x4*)(Am + 2804);
    s0 = fmaf(a.x, x16, s0);
    s1 = fmaf(a.y, x17, s1);
    s2 = fmaf(a.z, x18, s2);
    s3 = fmaf(a.w, x19, s3);
    a = *(const LAS f32x4*)(Am + 2808);
    s0 = fmaf(a.x, x20, s0);
    s1 = fmaf(a.y, x21, s1);
    s2 = fmaf(a.z, x22, s2);
    s3 = fmaf(a.w, x23, s3);
    a = *(const LAS f32x4*)(Am + 2812);
    s0 = fmaf(a.x, x24, s0);
    s1 = fmaf(a.y, x25, s1);
    s2 = fmaf(a.z, x26, s2);
    s3 = fmaf(a.w, x27, s3);
    a = *(const LAS f32x4*)(Am + 2816);
    s0 = fmaf(a.x, x28, s0);
    s1 = fmaf(a.y, x29, s1);
    s2 = fmaf(a.z, x30, s2);
    s3 = fmaf(a.w, x31, s3);
    a = *(const LAS f32x4*)(Am + 2820);
    s0 = fmaf(a.x, x32, s0);
    s1 = fmaf(a.y, x33, s1);
    s2 = fmaf(a.z, x34, s2);
    s3 = fmaf(a.w, x35, s3);
    a = *(const LAS f32x4*)(Am + 2824);
    s0 = fmaf(a.x, x36, s0);
    s1 = fmaf(a.y, x37, s1);
    s2 = fmaf(a.z, x38, s2);
    s3 = fmaf(a.w, x39, s3);
    a = *(const LAS f32x4*)(Am + 2828);
    const float al41 = a.x;
    x41 = (x41 - ((s0 + s1) + (s2 + s3))) - al41 * x40;
    Tu[5576 + c] = f2bf(x41 * su); Tw[5576 + c] = f2bf(x41 * sw); asm volatile("" ::: "memory");
    float x42 = fmaxf(0.0f, 1.0f - fabsf(cf - 42.0f));
    s0 = 0.f; s1 = 0.f; s2 = 0.f; s3 = 0.f;
    a = *(const LAS f32x4*)(Am + 2856);
    s0 = fmaf(a.x, x0, s0);
    s1 = fmaf(a.y, x1, s1);
    s2 = fmaf(a.z, x2, s2);
    s3 = fmaf(a.w, x3, s3);
    a = *(const LAS f32x4*)(Am + 2860);
    s0 = fmaf(a.x, x4, s0);
    s1 = fmaf(a.y, x5, s1);
    s2 = fmaf(a.z, x6, s2);
    s3 = fmaf(a.w, x7, s3);
    a = *(const LAS f32x4*)(Am + 2864);
    s0 = fmaf(a.x, x8, s0);
    s1 = fmaf(a.y, x9, s1);
    s2 = fmaf(a.z, x10, s2);
    s3 = fmaf(a.w, x11, s3);
    a = *(const LAS f32x4*)(Am + 2868);
    s0 = fmaf(a.x, x12, s0);
    s1 = fmaf(a.y, x13, s1);
    s2 = fmaf(a.z, x14, s2);
    s3 = fmaf(a.w, x15, s3);
    a = *(const LAS f32x4*)(Am + 2872);
    s0 = fmaf(a.x, x16, s0);
    s1 = fmaf(a.y, x17, s1);
    s2 = fmaf(a.z, x18, s2);
    s3 = fmaf(a.w, x19, s3);
    a = *(const LAS f32x4*)(Am + 2876);
    s0 = fmaf(a.x, x20, s0);
    s1 = fmaf(a.y, x21, s1);
    s2 = fmaf(a.z, x22, s2);
    s3 = fmaf(a.w, x23, s3);
    a = *(const LAS f32x4*)(Am + 2880);
    s0 = fmaf(a.x, x24, s0);
    s1 = fmaf(a.y, x25, s1);
    s2 = fmaf(a.z, x26, s2);
    s3 = fmaf(a.w, x27, s3);
    a = *(const LAS f32x4*)(Am + 2884);
    s0 = fmaf(a.x, x28, s0);
    s1 = fmaf(a.y, x29, s1);
    s2 = fmaf(a.z, x30, s2);
    s3 = fmaf(a.w, x31, s3);
    a = *(const LAS f32x4*)(Am + 2888);
    s0 = fmaf(a.x, x32, s0);
    s1 = fmaf(a.y, x33, s1);
    s2 = fmaf(a.z, x34, s2);
    s3 = fmaf(a.w, x35, s3);
    a = *(const LAS f32x4*)(Am + 2892);
    s0 = fmaf(a.x, x36, s0);
    s1 = fmaf(a.y, x37, s1);
    s2 = fmaf(a.z, x38, s2);
    s3 = fmaf(a.w, x39, s3);
    a = *(const LAS f32x4*)(Am + 2896);
    s0 = fmaf(a.x, x40, s0);
    const float al42 = a.y;
    x42 = (x42 - ((s0 + s1) + (s2 + s3))) - al42 * x41;
    Tu[5712 + c] = f2bf(x42 * su); Tw[5712 + c] = f2bf(x42 * sw); asm volatile("" ::: "memory");
    float x43 = fmaxf(0.0f, 1.0f - fabsf(cf - 43.0f));
    s0 = 0.f; s1 = 0.f; s2 = 0.f; s3 = 0.f;
    a = *(const LAS f32x4*)(Am + 2924);
    s0 = fmaf(a.x, x0, s0);
    s1 = fmaf(a.y, x1, s1);
    s2 = fmaf(a.z, x2, s2);
    s3 = fmaf(a.w, x3, s3);
    a = *(const LAS f32x4*)(Am + 2928);
    s0 = fmaf(a.x, x4, s0);
    s1 = fmaf(a.y, x5, s1);
    s2 = fmaf(a.z, x6, s2);
    s3 = fmaf(a.w, x7, s3);
    a = *(const LAS f32x4*)(Am + 2932);
    s0 = fmaf(a.x, x8, s0);
    s1 = fmaf(a.y, x9, s1);
    s2 = fmaf(a.z, x10, s2);
    s3 = fmaf(a.w, x11, s3);
    a = *(const LAS f32x4*)(Am + 2936);
    s0 = fmaf(a.x, x12, s0);
    s1 = fmaf(a.y, x13, s1);
    s2 = fmaf(a.z, x14, s2);
    s3 = fmaf(a.w, x15, s3);
    a = *(const LAS f32x4*)(Am + 2940);
    s0 = fmaf(a.x, x16, s0);
    s1 = fmaf(a.y, x17, s1);
    s2 = fmaf(a.z, x18, s2);
    s3 = fmaf(a.w, x19, s3);
    a = *(const LAS f32x4*)(Am + 2944);
    s0 = fmaf(a.x, x20, s0);
    s1 = fmaf(a.y, x21, s1);
    s2 = fmaf(a.z, x22, s2);
    s3 = fmaf(a.w, x23, s3);
    a = *(const LAS f32x4*)(Am + 2948);
    s0 = fmaf(a.x, x24, s0);
    s1 = fmaf(a.y, x25, s1);
    s2 = fmaf(a.z, x26, s2);
    s3 = fmaf(a.w, x27, s3);
    a = *(const LAS f32x4*)(Am + 2952);
    s0 = fmaf(a.x, x28, s0);
    s1 = fmaf(a.y, x29, s1);
    s2 = fmaf(a.z, x30, s2);
    s3 = fmaf(a.w, x31, s3);
    a = *(const LAS f32x4*)(Am + 2956);
    s0 = fmaf(a.x, x32, s0);
    s1 = fmaf(a.y, x33, s1);
    s2 = fmaf(a.z, x34, s2);
    s3 = fmaf(a.w, x35, s3);
    a = *(const LAS f32x4*)(Am + 2960);
    s0 = fmaf(a.x, x36, s0);
    s1 = fmaf(a.y, x37, s1);
    s2 = fmaf(a.z, x38, s2);
    s3 = fmaf(a.w, x39, s3);
    a = *(const LAS f32x4*)(Am + 2964);
    s0 = fmaf(a.x, x40, s0);
    s1 = fmaf(a.y, x41, s1);
    const float al43 = a.z;
    x43 = (x43 - ((s0 + s1) + (s2 + s3))) - al43 * x42;
    Tu[5848 + c] = f2bf(x43 * su); Tw[5848 + c] = f2bf(x43 * sw); asm volatile("" ::: "memory");
    float x44 = fmaxf(0.0f, 1.0f - fabsf(cf - 44.0f));
    s0 = 0.f; s1 = 0.f; s2 = 0.f; s3 = 0.f;
    a = *(const LAS f32x4*)(Am + 2992);
    s0 = fmaf(a.x, x0, s0);
    s1 = fmaf(a.y, x1, s1);
    s2 = fmaf(a.z, x2, s2);
    s3 = fmaf(a.w, x3, s3);
    a = *(const LAS f32x4*)(Am + 2996);
    s0 = fmaf(a.x, x4, s0);
    s1 = fmaf(a.y, x5, s1);
    s2 = fmaf(a.z, x6, s2);
    s3 = fmaf(a.w, x7, s3);
    a = *(const LAS f32x4*)(Am + 3000);
    s0 = fmaf(a.x, x8, s0);
    s1 = fmaf(a.y, x9, s1);
    s2 = fmaf(a.z, x10, s2);
    s3 = fmaf(a.w, x11, s3);
    a = *(const LAS f32x4*)(Am + 3004);
    s0 = fmaf(a.x, x12, s0);
    s1 = fmaf(a.y, x13, s1);
    s2 = fmaf(a.z, x14, s2);
    s3 = fmaf(a.w, x15, s3);
    a = *(const LAS f32x4*)(Am + 3008);
    s0 = fmaf(a.x, x16, s0);
    s1 = fmaf(a.y, x17, s1);
    s2 = fmaf(a.z, x18, s2);
    s3 = fmaf(a.w, x19, s3);
    a = *(const LAS f32x4*)(Am + 3012);
    s0 = fmaf(a.x, x20, s0);
    s1 = fmaf(a.y, x21, s1);
    s2 = fmaf(a.z, x22, s2);
    s3 = fmaf(a.w, x23, s3);
    a = *(const LAS f32x4*)(Am + 3016);
    s0 = fmaf(a.x, x24, s0);
    s1 = fmaf(a.y, x25, s1);
    s2 = fmaf(a.z, x26, s2);
    s3 = fmaf(a.w, x27, s3);
    a = *(const LAS f32x4*)(Am + 3020);
    s0 = fmaf(a.x, x28, s0);
    s1 = fmaf(a.y, x29, s1);
    s2 = fmaf(a.z, x30, s2);
    s3 = fmaf(a.w, x31, s3);
    a = *(const LAS f32x4*)(Am + 3024);
    s0 = fmaf(a.x, x32, s0);
    s1 = fmaf(a.y, x33, s1);
    s2 = fmaf(a.z, x34, s2);
    s3 = fmaf(a.w, x35, s3);
    a = *(const LAS f32x4*)(Am + 3028);
    s0 = fmaf(a.x, x36, s0);
    s1 = fmaf(a.y, x37, s1);
    s2 = fmaf(a.z, x38, s2);
    s3 = fmaf(a.w, x39, s3);
    a = *(const LAS f32x4*)(Am + 3032);
    s0 = fmaf(a.x, x40, s0);
    s1 = fmaf(a.y, x41, s1);
    s2 = fmaf(a.z, x42, s2);
    const float al44 = a.w;
    x44 = (x44 - ((s0 + s1) + (s2 + s3))) - al44 * x43;
    Tu[5984 + c] = f2bf(x44 * su); Tw[5984 + c] = f2bf(x44 * sw); asm volatile("" ::: "memory");
    float x45 = fmaxf(0.0f, 1.0f - fabsf(cf - 45.0f));
    s0 = 0.f; s1 = 0.f; s2 = 0.f; s3 = 0.f;
    a = *(const LAS f32x4*)(Am + 3060);
    s0 = fmaf(a.x, x0, s0);
    s1 = fmaf(a.y, x1, s1);
    s2 = fmaf(a.z, x2, s2);
    s3 = fmaf(a.w, x3, s3);
    a = *(const LAS f32x4*)(Am + 3064);
    s0 = fmaf(a.x, x4, s0);
    s1 = fmaf(a.y, x5, s1);
    s2 = fmaf(a.z, x6, s2);
    s3 = fmaf(a.w, x7, s3);
    a = *(const LAS f32x4*)(Am + 3068);
    s0 = fmaf(a.x, x8, s0);
    s1 = fmaf(a.y, x9, s1);
    s2 = fmaf(a.z, x10, s2);
    s3 = fmaf(a.w, x11, s3);
    a = *(const LAS f32x4*)(Am + 3072);
    s0 = fmaf(a.x, x12, s0);
    s1 = fmaf(a.y, x13, s1);
    s2 = fmaf(a.z, x14, s2);
    s3 = fmaf(a.w, x15, s3);
    a = *(const LAS f32x4*)(Am + 3076);
    s0 = fmaf(a.x, x16, s0);
    s1 = fmaf(a.y, x17, s1);
    s2 = fmaf(a.z, x18, s2);
    s3 = fmaf(a.w, x19, s3);
    a = *(const LAS f32x4*)(Am + 3080);
    s0 = fmaf(a.x, x20, s0);
    s1 = fmaf(a.y, x21, s1);
    s2 = fmaf(a.z, x22, s2);
    s3 = fmaf(a.w, x23, s3);
    a = *(const LAS f32x4*)(Am + 3084);
    s0 = fmaf(a.x, x24, s0);
    s1 = fmaf(a.y, x25, s1);
    s2 = fmaf(a.z, x26, s2);
    s3 = fmaf(a.w, x27, s3);
    a = *(const LAS f32x4*)(Am + 3088);
    s0 = fmaf(a.x, x28, s0);
    s1 = fmaf(a.y, x29, s1);
    s2 = fmaf(a.z, x30, s2);
    s3 = fmaf(a.w, x31, s3);
    a = *(const LAS f32x4*)(Am + 3092);
    s0 = fmaf(a.x, x32, s0);
    s1 = fmaf(a.y, x33, s1);
    s2 = fmaf(a.z, x34, s2);
    s3 = fmaf(a.w, x35, s3);
    a = *(const LAS f32x4*)(Am + 3096);
    s0 = fmaf(a.x, x36, s0);
    s1 = fmaf(a.y, x37, s1);
    s2 = fmaf(a.z, x38, s2);
    s3 = fmaf(a.w, x39, s3);
    a = *(const LAS f32x4*)(Am + 3100);
    s0 = fmaf(a.x, x40, s0);
    s1 = fmaf(a.y, x41, s1);
    s2 = fmaf(a.z, x42, s2);
    s3 = fmaf(a.w, x43, s3);
    a = *(const LAS f32x4*)(Am + 3104);
    const float al45 = a.x;
    x45 = (x45 - ((s0 + s1) + (s2 + s3))) - al45 * x44;
    Tu[6120 + c] = f2bf(x45 * su); Tw[6120 + c] = f2bf(x45 * sw); asm volatile("" ::: "memory");
    float x46 = fmaxf(0.0f, 1.0f - fabsf(cf - 46.0f));
    s0 = 0.f; s1 = 0.f; s2 = 0.f; s3 = 0.f;
    a = *(const LAS f32x4*)(Am + 3128);
    s0 = fmaf(a.x, x0, s0);
    s1 = fmaf(a.y, x1, s1);
    s2 = fmaf(a.z, x2, s2);
    s3 = fmaf(a.w, x3, s3);
    a = *(const LAS f32x4*)(Am + 3132);
    s0 = fmaf(a.x, x4, s0);
    s1 = fmaf(a.y, x5, s1);
    s2 = fmaf(a.z, x6, s2);
    s3 = fmaf(a.w, x7, s3);
    a = *(const LAS f32x4*)(Am + 3136);
    s0 = fmaf(a.x, x8, s0);
    s1 = fmaf(a.y, x9, s1);
    s2 = fmaf(a.z, x10, s2);
    s3 = fmaf(a.w, x11, s3);
    a = *(const LAS f32x4*)(Am + 3140);
    s0 = fmaf(a.x, x12, s0);
    s1 = fmaf(a.y, x13, s1);
    s2 = fmaf(a.z, x14, s2);
    s3 = fmaf(a.w, x15, s3);
    a = *(const LAS f32x4*)(Am + 3144);
    s0 = fmaf(a.x, x16, s0);
    s1 = fmaf(a.y, x17, s1);
    s2 = fmaf(a.z, x18, s2);
    s3 = fmaf(a.w, x19, s3);
    a = *(const LAS f32x4*)(Am + 3148);
    s0 = fmaf(a.x, x20, s0);
    s1 = fmaf(a.y, x21, s1);
    s2 = fmaf(a.z, x22, s2);
    s3 = fmaf(a.w, x23, s3);
    a = *(const LAS f32x4*)(Am + 3152);
    s0 = fmaf(a.x, x24, s0);
    s1 = fmaf(a.y, x25, s1);
    s2 = fmaf(a.z, x26, s2);
    s3 = fmaf(a.w, x27, s3);
    a = *(const LAS f32x4*)(Am + 3156);
    s0 = fmaf(a.x, x28, s0);
    s1 = fmaf(a.y, x29, s1);
    s2 = fmaf(a.z, x30, s2);
    s3 = fmaf(a.w, x31, s3);
    a = *(const LAS f32x4*)(Am + 3160);
    s0 = fmaf(a.x, x32, s0);
    s1 = fmaf(a.y, x33, s1);
    s2 = fmaf(a.z, x34, s2);
    s3 = fmaf(a.w, x35, s3);
    a = *(const LAS f32x4*)(Am + 3164);
    s0 = fmaf(a.x, x36, s0);
    s1 = fmaf(a.y, x37, s1);
    s2 = fmaf(a.z, x38, s2);
    s3 = fmaf(a.w, x39, s3);
    a = *(const LAS f32x4*)(Am + 3168);
    s0 = fmaf(a.x, x40, s0);
    s1 = fmaf(a.y, x41, s1);
    s2 = fmaf(a.z, x42, s2);
    s3 = fmaf(a.w, x43, s3);
    a = *(const LAS f32x4*)(Am + 3172);
    s0 = fmaf(a.x, x44, s0);
    const float al46 = a.y;
    x46 = (x46 - ((s0 + s1) + (s2 + s3))) - al46 * x45;
    Tu[6256 + c] = f2bf(x46 * su); Tw[6256 + c] = f2bf(x46 * sw); asm volatile("" ::: "memory");
    float x47 = fmaxf(0.0f, 1.0f - fabsf(cf - 47.0f));
    s0 = 0.f; s1 = 0.f; s2 = 0.f; s3 = 0.f;
    a = *(const LAS f32x4*)(Am + 3196);
    s0 = fmaf(a.x, x0, s0);
    s1 = fmaf(a.y, x1, s1);
    s2 = fmaf(a.z, x2, s2);
    s3 = fmaf(a.w, x3, s3);
    a = *(const LAS f32x4*)(Am + 3200);
    s0 = fmaf(a.x, x4, s0);
    s1 = fmaf(a.y, x5, s1);
    s2 = fmaf(a.z, x6, s2);
    s3 = fmaf(a.w, x7, s3);
    a = *(const LAS f32x4*)(Am + 3204);
    s0 = fmaf(a.x, x8, s0);
    s1 = fmaf(a.y, x9, s1);
    s2 = fmaf(a.z, x10, s2);
    s3 = fmaf(a.w, x11, s3);
    a = *(const LAS f32x4*)(Am + 3208);
    s0 = fmaf(a.x, x12, s0);
    s1 = fmaf(a.y, x13, s1);
    s2 = fmaf(a.z, x14, s2);
    s3 = fmaf(a.w, x15, s3);
    a = *(const LAS f32x4*)(Am + 3212);
    s0 = fmaf(a.x, x16, s0);
    s1 = fmaf(a.y, x17, s1);
    s2 = fmaf(a.z, x18, s2);
    s3 = fmaf(a.w, x19, s3);
    a = *(const LAS f32x4*)(Am + 3216);
    s0 = fmaf(a.x, x20, s0);
    s1 = fmaf(a.y, x21, s1);
    s2 = fmaf(a.z, x22, s2);
    s3 = fmaf(a.w, x23, s3);
    a = *(const LAS f32x4*)(Am + 3220);
    s0 = fmaf(a.x, x24, s0);
    s1 = fmaf(a.y, x25, s1);
    s2 = fmaf(a.z, x26, s2);
    s3 = fmaf(a.w, x27, s3);
    a = *(const LAS f32x4*)(Am + 3224);
    s0 = fmaf(a.x, x28, s0);
    s1 = fmaf(a.y, x29, s1);
    s2 = fmaf(a.z, x30, s2);
    s3 = fmaf(a.w, x31, s3);
    a = *(const LAS f32x4*)(Am + 3228);
    s0 = fmaf(a.x, x32, s0);
    s1 = fmaf(a.y, x33, s1);
    s2 = fmaf(a.z, x34, s2);
    s3 = fmaf(a.w, x35, s3);
    a = *(const LAS f32x4*)(Am + 3232);
    s0 = fmaf(a.x, x36, s0);
    s1 = fmaf(a.y, x37, s1);
    s2 = fmaf(a.z, x38, s2);
    s3 = fmaf(a.w, x39, s3);
    a = *(const LAS f32x4*)(Am + 3236);
    s0 = fmaf(a.x, x40, s0);
    s1 = fmaf(a.y, x41, s1);
    s2 = fmaf(a.z, x42, s2);
    s3 = fmaf(a.w, x43, s3);
    a = *(const LAS f32x4*)(Am + 3240);
    s0 = fmaf(a.x, x44, s0);
    s1 = fmaf(a.y, x45, s1);
    const float al47 = a.z;
    x47 = (x47 - ((s0 + s1) + (s2 + s3))) - al47 * x46;
    Tu[6392 + c] = f2bf(x47 * su); Tw[6392 + c] = f2bf(x47 * sw); asm volatile("" ::: "memory");
    float x48 = fmaxf(0.0f, 1.0f - fabsf(cf - 48.0f));
    s0 = 0.f; s1 = 0.f; s2 = 0.f; s3 = 0.f;
    a = *(const LAS f32x4*)(Am + 3264);
    s0 = fmaf(a.x, x0, s0);
    s1 = fmaf(a.y, x1, s1);
    s2 = fmaf(a.z, x2, s2);
    s3 = fmaf(a.w, x3, s3);
    a = *(const LAS f32x4*)(Am + 3268);
    s0 = fmaf(a.x, x4, s0);
    s1 = fmaf(a.y, x5, s1);
    s2 = fmaf(a.z, x6, s2);
    s3 = fmaf(a.w, x7, s3);
    a = *(const LAS f32x4*)(Am + 3272);
    s0 = fmaf(a.x, x8, s0);
    s1 = fmaf(a.y, x9, s1);
    s2 = fmaf(a.z, x10, s2);
    s3 = fmaf(a.w, x11, s3);
    a = *(const LAS f32x4*)(Am + 3276);
    s0 = fmaf(a.x, x12, s0);
    s1 = fmaf(a.y, x13, s1);
    s2 = fmaf(a.z, x14, s2);
    s3 = fmaf(a.w, x15, s3);
    a = *(const LAS f32x4*)(Am + 3280);
    s0 = fmaf(a.x, x16, s0);
    s1 = fmaf(a.y, x17, s1);
    s2 = fmaf(a.z, x18, s2);
    s3 = fmaf(a.w, x19, s3);
    a = *(const LAS f32x4*)(Am + 3284);
    s0 = fmaf(a.x, x20, s0);
    s1 = fmaf(a.y, x21, s1);
    s2 = fmaf(a.z, x22, s2);
    s3 = fmaf(a.w, x23, s3);
    a = *(const LAS f32x4*)(Am + 3288);
    s0 = fmaf(a.x, x24, s0);
    s1 = fmaf(a.y, x25, s1);
    s2 = fmaf(a.z, x26, s2);
    s3 = fmaf(a.w, x27, s3);
    a = *(const LAS f32x4*)(Am + 3292);
    s0 = fmaf(a.x, x28, s0);
    s1 = fmaf(a.y, x29, s1);
    s2 = fmaf(a.z, x30, s2);
    s3 = fmaf(a.w, x31, s3);
    a = *(const LAS f32x4*)(Am + 3296);
    s0 = fmaf(a.x, x32, s0);
    s1 = fmaf(a.y, x33, s1);
    s2 = fmaf(a.z, x34, s2);
    s3 = fmaf(a.w, x35, s3);
    a = *(const LAS f32x4*)(Am + 3300);
    s0 = fmaf(a.x, x36, s0);
    s1 = fmaf(a.y, x37, s1);
    s2 = fmaf(a.z, x38, s2);
    s3 = fmaf(a.w, x39, s3);
    a = *(const LAS f32x4*)(Am + 3304);
    s0 = fmaf(a.x, x40, s0);
    s1 = fmaf(a.y, x41, s1);
    s2 = fmaf(a.z, x42, s2);
    s3 = fmaf(a.w, x43, s3);
    a = *(const LAS f32x4*)(Am + 3308);
    s0 = fmaf(a.x, x44, s0);
    s1 = fmaf(a.y, x45, s1);
    s2 = fmaf(a.z, x46, s2);
    const float al48 = a.w;
    x48 = (x48 - ((s0 + s1) + (s2 + s3))) - al48 * x47;
    Tu[6528 + c] = f2bf(x48 * su); Tw[6528 + c] = f2bf(x48 * sw); asm volatile("" ::: "memory");
    float x49 = fmaxf(0.0f, 1.0f - fabsf(cf - 49.0f));
    s0 = 0.f; s1 = 0.f; s2 = 0.f; s3 = 0.f;
    a = *(const LAS f32x4*)(Am + 3332);
    s0 = fmaf(a.x, x0, s0);
    s1 = fmaf(a.y, x1, s1);
    s2 = fmaf(a.z, x2, s2);
    s3 = fmaf(a.w, x3, s3);
    a = *(const LAS f32x4*)(Am + 3336);
    s0 = fmaf(a.x, x4, s0);
    s1 = fmaf(a.y, x5, s1);
    s2 = fmaf(a.z, x6, s2);
    s3 = fmaf(a.w, x7, s3);
    a = *(const LAS f32x4*)(Am + 3340);
    s0 = fmaf(a.x, x8, s0);
    s1 = fmaf(a.y, x9, s1);
    s2 = fmaf(a.z, x10, s2);
    s3 = fmaf(a.w, x11, s3);
    a = *(const LAS f32x4*)(Am + 3344);
    s0 = fmaf(a.x, x12, s0);
    s1 = fmaf(a.y, x13, s1);
    s2 = fmaf(a.z, x14, s2);
    s3 = fmaf(a.w, x15, s3);
    a = *(const LAS f32x4*)(Am + 3348);
    s0 = fmaf(a.x, x16, s0);
    s1 = fmaf(a.y, x17, s1);
    s2 = fmaf(a.z, x18, s2);
    s3 = fmaf(a.w, x19, s3);
    a = *(const LAS f32x4*)(Am + 3352);
    s0 = fmaf(a.x, x20, s0);
    s1 = fmaf(a.y, x21, s1);
    s2 = fmaf(a.z, x22, s2);
    s3 = fmaf(a.w, x23, s3);
    a = *(const LAS f32x4*)(Am + 3356);
    s0 = fmaf(a.x, x24, s0);
    s1 = fmaf(a.y, x25, s1);
    s2 = fmaf(a.z, x26, s2);
    s3 = fmaf(a.w, x27, s3);
    a = *(const LAS f32x4*)(Am + 3360);
    s0 = fmaf(a.x, x28, s0);
    s1 = fmaf(a.y, x29, s1);
    s2 = fmaf(a.z, x30, s2);
    s3 = fmaf(a.w, x31, s3);
    a = *(const LAS f32x4*)(Am + 3364);
    s0 = fmaf(a.x, x32, s0);
    s1 = fmaf(a.y, x33, s1);
    s2 = fmaf(a.z, x34, s2);
    s3 = fmaf(a.w, x35, s3);
    a = *(const LAS f32x4*)(Am + 3368);
    s0 = fmaf(a.x, x36, s0);
    s1 = fmaf(a.y, x37, s1);
    s2 = fmaf(a.z, x38, s2);
    s3 = fmaf(a.w, x39, s3);
    a = *(const LAS f32x4*)(Am + 3372);
    s0 = fmaf(a.x, x40, s0);
    s1 = fmaf(a.y, x41, s1);
    s2 = fmaf(a.z, x42, s2);
    s3 = fmaf(a.w, x43, s3);
    a = *(const LAS f32x4*)(Am + 3376);
    s0 = fmaf(a.x, x44, s0);
    s1 = fmaf(a.y, x45, s1);
    s2 = fmaf(a.z, x46, s2);
    s3 = fmaf(a.w, x47, s3);
    a = *(const LAS f32x4*)(Am + 3380);
    const float al49 = a.x;
    x49 = (x49 - ((s0 + s1) + (s2 + s3))) - al49 * x48;
    Tu[6664 + c] = f2bf(x49 * su); Tw[6664 + c] = f2bf(x49 * sw); asm volatile("" ::: "memory");
    float x50 = fmaxf(0.0f, 1.0f - fabsf(cf - 50.0f));
    s0 = 0.f; s1 = 0.f; s2 = 0.f; s3 = 0.f;
    a = *(const LAS f32x4*)(Am + 3400);
    s0 = fmaf(a.x, x0, s0);
    s1 = fmaf(a.y, x1, s1);
    s2 = fmaf(a.z, x2, s2);
    s3 = fmaf(a.w, x3, s3);
    a = *(const LAS f32x4*)(Am + 3404);
    s0 = fmaf(a.x, x4, s0);
    s1 = fmaf(a.y, x5, s1);
    s2 = fmaf(a.z, x6, s2);
    s3 = fmaf(a.w, x7, s3);
    a = *(const LAS f32x4*)(Am + 3408);
    s0 = fmaf(a.x, x8, s0);
    s1 = fmaf(a.y, x9, s1);
    s2 = fmaf(a.z, x10, s2);
    s3 = fmaf(a.w, x11, s3);
    a = *(const LAS f32x4*)(Am + 3412);
    s0 = fmaf(a.x, x12, s0);
    s1 = fmaf(a.y, x13, s1);
    s2 = fmaf(a.z, x14, s2);
    s3 = fmaf(a.w, x15, s3);
    a = *(const LAS f32x4*)(Am + 3416);
    s0 = fmaf(a.x, x16, s0);
    s1 = fmaf(a.y, x17, s1);
    s2 = fmaf(a.z, x18, s2);
    s3 = fmaf(a.w, x19, s3);
    a = *(const LAS f32x4*)(Am + 3420);
    s0 = fmaf(a.x, x20, s0);
    s1 = fmaf(a.y, x21, s1);
    s2 = fmaf(a.z, x22, s2);
    s3 = fmaf(a.w, x23, s3);
    a = *(const LAS f32x4*)(Am + 3424);
    s0 = fmaf(a.x, x24, s0);
    s1 = fmaf(a.y, x25, s1);
    s2 = fmaf(a.z, x26, s2);
    s3 = fmaf(a.w, x27, s3);
    a = *(const LAS f32x4*)(Am + 3428);
    s0 = fmaf(a.x, x28, s0);
    s1 = fmaf(a.y, x29, s1);
    s2 = fmaf(a.z, x30, s2);
    s3 = fmaf(a.w, x31, s3);
    a = *(const LAS f32x4*)(Am + 3432);
    s0 = fmaf(a.x, x32, s0);
    s1 = fmaf(a.y, x33, s1);
    s2 = fmaf(a.z, x34, s2);
    s3 = fmaf(a.w, x35, s3);
    a = *(const LAS f32x4*)(Am + 3436);
    s0 = fmaf(a.x, x36, s0);
    s1 = fmaf(a.y, x37, s1);
    s2 = fmaf(a.z, x38, s2);
    s3 = fmaf(a.w, x39, s3);
    a = *(const LAS f32x4*)(Am + 3440);
    s0 = fmaf(a.x, x40, s0);
    s1 = fmaf(a.y, x41, s1);
    s2 = fmaf(a.z, x42, s2);
    s3 = fmaf(a.w, x43, s3);
    a = *(const LAS f32x4*)(Am + 3444);
    s0 = fmaf(a.x, x44, s0);
    s1 = fmaf(a.y, x45, s1);
    s2 = fmaf(a.z, x46, s2);
    s3 = fmaf(a.w, x47, s3);
    a = *(const LAS f32x4*)(Am + 3448);
    s0 = fmaf(a.x, x48, s0);
    const float al50 = a.y;
    x50 = (x50 - ((s0 + s1) + (s2 + s3))) - al50 * x49;
    Tu[6800 + c] = f2bf(x50 * su); Tw[6800 + c] = f2bf(x50 * sw); asm volatile("" ::: "memory");
    float x51 = fmaxf(0.0f, 1.0f - fabsf(cf - 51.0f));
    s0 = 0.f; s1 = 0.f; s2 = 0.f; s3 = 0.f;
    a = *(const LAS f32x4*)(Am + 3468);
    s0 = fmaf(a.x, x0, s0);
    s1 = fmaf(a.y, x1, s1);
    s2 = fmaf(a.z, x2, s2);
    s3 = fmaf(a.w, x3, s3);
    a = *(const LAS f32x4*)(Am + 3472);
    s0 = fmaf(a.x, x4, s0);
    s1 = fmaf(a.y, x5, s1);
    s2 = fmaf(a.z, x6, s2);
    s3 = fmaf(a.w, x7, s3);
    a = *(const LAS f32x4*)(Am + 3476);
    s0 = fmaf(a.x, x8, s0);
    s1 = fmaf(a.y, x9, s1);
    s2 = fmaf(a.z, x10, s2);
    s3 = fmaf(a.w, x11, s3);
    a = *(const LAS f32x4*)(Am + 3480);
    s0 = fmaf(a.x, x12, s0);
    s1 = fmaf(a.y, x13, s1);
    s2 = fmaf(a.z, x14, s2);
    s3 = fmaf(a.w, x15, s3);
    a = *(const LAS f32x4*)(Am + 3484);
    s0 = fmaf(a.x, x16, s0);
    s1 = fmaf(a.y, x17, s1);
    s2 = fmaf(a.z, x18, s2);
    s3 = fmaf(a.w, x19, s3);
    a = *(const LAS f32x4*)(Am + 3488);
    s0 = fmaf(a.x, x20, s0);
    s1 = fmaf(a.y, x21, s1);
    s2 = fmaf(a.z, x22, s2);
    s3 = fmaf(a.w, x23, s3);
    a = *(const LAS f32x4*)(Am + 3492);
    s0 = fmaf(a.x, x24, s0);
    s1 = fmaf(a.y, x25, s1);
    s2 = fmaf(a.z, x26, s2);
    s3 = fmaf(a.w, x27, s3);
    a = *(const LAS f32x4*)(Am + 3496);
    s0 = fmaf(a.x, x28, s0);
    s1 = fmaf(a.y, x29, s1);
    s2 = fmaf(a.z, x30, s2);
    s3 = fmaf(a.w, x31, s3);
    a = *(const LAS f32x4*)(Am + 3500);
    s0 = fmaf(a.x, x32, s0);
    s1 = fmaf(a.y, x33, s1);
    s2 = fmaf(a.z, x34, s2);
    s3 = fmaf(a.w, x35, s3);
    a = *(const LAS f32x4*)(Am + 3504);
    s0 = fmaf(a.x, x36, s0);
    s1 = fmaf(a.y, x37, s1);
    s2 = fmaf(a.z, x38, s2);
    s3 = fmaf(a.w, x39, s3);
    a = *(const LAS f32x4*)(Am + 3508);
    s0 = fmaf(a.x, x40, s0);
    s1 = fmaf(a.y, x41, s1);
    s2 = fmaf(a.z, x42, s2);
    s3 = fmaf(a.w, x43, s3);
    a = *(const LAS f32x4*)(Am + 3512);
    s0 = fmaf(a.x, x44, s0);
    s1 = fmaf(a.y, x45, s1);
    s2 = fmaf(a.z, x46, s2);
    s3 = fmaf(a.w, x47, s3);
    a = *(const LAS f32x4*)(Am + 3516);
    s0 = fmaf(a.x, x48, s0);
    s1 = fmaf(a.y, x49, s1);
    const float al51 = a.z;
    x51 = (x51 - ((s0 + s1) + (s2 + s3))) - al51 * x50;
    Tu[6936 + c] = f2bf(x51 * su); Tw[6936 + c] = f2bf(x51 * sw); asm volatile("" ::: "memory");
    float x52 = fmaxf(0.0f, 1.0f - fabsf(cf - 52.0f));
    s0 = 0.f; s1 = 0.f; s2 = 0.f; s3 = 0.f;
    a = *(const LAS f32x4*)(Am + 3536);
    s0 = fmaf(a.x, x0, s0);
    s1 = fmaf(a.y, x1, s1);
    s2 = fmaf(a.z, x2, s2);
    s3 = fmaf(a.w, x3, s3);
    a = *(const LAS f32x4*)(Am + 3540);
    s0 = fmaf(a.x, x4, s0);
    s1 = fmaf(a.y, x5, s1);
    s2 = fmaf(a.z, x6, s2);
    s3 = fmaf(a.w, x7, s3);
    a = *(const LAS f32x4*)(Am + 3544);
    s0 = fmaf(a.x, x8, s0);
    s1 = fmaf(a.y, x9, s1);
    s2 = fmaf(a.z, x10, s2);
    s3 = fmaf(a.w, x11, s3);
    a = *(const LAS f32x4*)(Am + 3548);
    s0 = fmaf(a.x, x12, s0);
    s1 = fmaf(a.y, x13, s1);
    s2 = fmaf(a.z, x14, s2);
    s3 = fmaf(a.w, x15, s3);
    a = *(const LAS f32x4*)(Am + 3552);
    s0 = fmaf(a.x, x16, s0);
    s1 = fmaf(a.y, x17, s1);
    s2 = fmaf(a.z, x18, s2);
    s3 = fmaf(a.w, x19, s3);
    a = *(const LAS f32x4*)(Am + 3556);
    s0 = fmaf(a.x, x20, s0);
    s1 = fmaf(a.y, x21, s1);
    s2 = fmaf(a.z, x22, s2);
    s3 = fmaf(a.w, x23, s3);
    a = *(const LAS f32x4*)(Am + 3560);
    s0 = fmaf(a.x, x24, s0);
    s1 = fmaf(a.y, x25, s1);
    s2 = fmaf(a.z, x26, s2);
    s3 = fmaf(a.w, x27, s3);
    a = *(const LAS f32x4*)(Am + 3564);
    s0 = fmaf(a.x, x28, s0);
    s1 = fmaf(a.y, x29, s1);
    s2 = fmaf(a.z, x30, s2);
    s3 = fmaf(a.w, x31, s3);
    a = *(const LAS f32x4*)(Am + 3568);
    s0 = fmaf(a.x, x32, s0);
    s1 = fmaf(a.y, x33, s1);
    s2 = fmaf(a.z, x34, s2);
    s3 = fmaf(a.w, x35, s3);
    a = *(const LAS f32x4*)(Am + 3572);
    s0 = fmaf(a.x, x36, s0);
    s1 = fmaf(a.y, x37, s1);
    s2 = fmaf(a.z, x38, s2);
    s3 = fmaf(a.w, x39, s3);
    a = *(const LAS f32x4*)(Am + 3576);
    s0 = fmaf(a.x, x40, s0);
    s1 = fmaf(a.y, x41, s1);
    s2 = fmaf(a.z, x42, s2);
    s3 = fmaf(a.w, x43, s3);
    a = *(const LAS f32x4*)(Am + 3580);
    s0 = fmaf(a.x, x44, s0);
    s1 = fmaf(a.y, x45, s1);
    s2 = fmaf(a.z, x46, s2);
    s3 = fmaf(a.w, x47, s3);
    a = *(const LAS f32x4*)(Am + 3584);
    s0 = fmaf(a.x, x48, s0);
    s1 = fmaf(a.y, x49, s1);
    s2 = fmaf(a.z, x50, s2);
    const float al52 = a.w;
    x52 = (x52 - ((s0 + s1) + (s2 + s3))) - al52 * x51;
    Tu[7072 + c] = f2bf(x52 * su); Tw[7072 + c] = f2bf(x52 * sw); asm volatile("" ::: "memory");
    float x53 = fmaxf(0.0f, 1.0f - fabsf(cf - 53.0f));
    s0 = 0.f; s1 = 0.f; s2 = 0.f; s3 = 0.f;
    a = *(const LAS f32x4*)(Am + 3604);
    s0 = fmaf(a.x, x0, s0);
    s1 = fmaf(a.y, x1, s1);
    s2 = fmaf(a.z, x2, s2);
    s3 = fmaf(a.w, x3, s3);
    a = *(const LAS f32x4*)(Am + 3608);
    s0 = fmaf(a.x, x4, s0);
    s1 = fmaf(a.y, x5, s1);
    s2 = fmaf(a.z, x6, s2);
    s3 = fmaf(a.w, x7, s3);
    a = *(const LAS f32x4*)(Am + 3612);
    s0 = fmaf(a.x, x8, s0);
    s1 = fmaf(a.y, x9, s1);
    s2 = fmaf(a.z, x10, s2);
    s3 = fmaf(a.w, x11, s3);
    a = *(const LAS f32x4*)(Am + 3616);
    s0 = fmaf(a.x, x12, s0);
    s1 = fmaf(a.y, x13, s1);
    s2 = fmaf(a.z, x14, s2);
    s3 = fmaf(a.w, x15, s3);
    a = *(const LAS f32x4*)(Am + 3620);
    s0 = fmaf(a.x, x16, s0);
    s1 = fmaf(a.y, x17, s1);
    s2 = fmaf(a.z, x18, s2);
    s3 = fmaf(a.w, x19, s3);
    a = *(const LAS f32x4*)(Am + 3624);
    s0 = fmaf(a.x, x20, s0);
    s1 = fmaf(a.y, x21, s1);
    s2 = fmaf(a.z, x22, s2);
    s3 = fmaf(a.w, x23, s3);
    a = *(const LAS f32x4*)(Am + 3628);
    s0 = fmaf(a.x, x24, s0);
    s1 = fmaf(a.y, x25, s1);
    s2 = fmaf(a.z, x26, s2);
    s3 = fmaf(a.w, x27, s3);
    a = *(const LAS f32x4*)(Am + 3632);
    s0 = fmaf(a.x, x28, s0);
    s1 = fmaf(a.y, x29, s1);
    s2 = fmaf(a.z, x30, s2);
    s3 = fmaf(a.w, x31, s3);
    a = *(const LAS f32x4*)(Am + 3636);
    s0 = fmaf(a.x, x32, s0);
    s1 = fmaf(a.y, x33, s1);
    s2 = fmaf(a.z, x34, s2);
    s3 = fmaf(a.w, x35, s3);
    a = *(const LAS f32x4*)(Am + 3640);
    s0 = fmaf(a.x, x36, s0);
    s1 = fmaf(a.y, x37, s1);
    s2 = fmaf(a.z, x38, s2);
    s3 = fmaf(a.w, x39, s3);
    a = *(const LAS f32x4*)(Am + 3644);
    s0 = fmaf(a.x, x40, s0);
    s1 = fmaf(a.y, x41, s1);
    s2 = fmaf(a.z, x42, s2);
    s3 = fmaf(a.w, x43, s3);
    a = *(const LAS f32x4*)(Am + 3648);
    s0 = fmaf(a.x, x44, s0);
    s1 = fmaf(a.y, x45, s1);
    s2 = fmaf(a.z, x46, s2);
    s3 = fmaf(a.w, x47, s3);
    a = *(const LAS f32x4*)(Am + 3652);
    s0 = fmaf(a.x, x48, s0);
    s1 = fmaf(a.y, x49, s1);
    s2 = fmaf(a.z, x50, s2);
    s3 = fmaf(a.w, x51, s3);
    a = *(const LAS f32x4*)(Am + 3656);
    const float al53 = a.x;
    x53 = (x53 - ((s0 + s1) + (s2 + s3))) - al53 * x52;
    Tu[7208 + c] = f2bf(x53 * su); Tw[7208 + c] = f2bf(x53 * sw); asm volatile("" ::: "memory");
    float x54 = fmaxf(0.0f, 1.0f - fabsf(cf - 54.0f));
    s0 = 0.f; s1 = 0.f; s2 = 0.f; s3 = 0.f;
    a = *(const LAS f32x4*)(Am + 3672);
    s0 = fmaf(a.x, x0, s0);
    s1 = fmaf(a.y, x1, s1);
    s2 = fmaf(a.z, x2, s2);
    s3 = fmaf(a.w, x3, s3);
    a = *(const LAS f32x4*)(Am + 3676);
    s0 = fmaf(a.x, x4, s0);
    s1 = fmaf(a.y, x5, s1);
    s2 = fmaf(a.z, x6, s2);
    s3 = fmaf(a.w, x7, s3);
    a = *(const LAS f32x4*)(Am + 3680);
    s0 = fmaf(a.x, x8, s0);
    s1 = fmaf(a.y, x9, s1);
    s2 = fmaf(a.z, x10, s2);
    s3 = fmaf(a.w, x11, s3);
    a = *(const LAS f32x4*)(Am + 3684);
    s0 = fmaf(a.x, x12, s0);
    s1 = fmaf(a.y, x13, s1);
    s2 = fmaf(a.z, x14, s2);
    s3 = fmaf(a.w, x15, s3);
    a = *(const LAS f32x4*)(Am + 3688);
    s0 = fmaf(a.x, x16, s0);
    s1 = fmaf(a.y, x17, s1);
    s2 = fmaf(a.z, x18, s2);
    s3 = fmaf(a.w, x19, s3);
    a = *(const LAS f32x4*)(Am + 3692);
    s0 = fmaf(a.x, x20, s0);
    s1 = fmaf(a.y, x21, s1);
    s2 = fmaf(a.z, x22, s2);
    s3 = fmaf(a.w, x23, s3);
    a = *(const LAS f32x4*)(Am + 3696);
    s0 = fmaf(a.x, x24, s0);
    s1 = fmaf(a.y, x25, s1);
    s2 = fmaf(a.z, x26, s2);
    s3 = fmaf(a.w, x27, s3);
    a = *(const LAS f32x4*)(Am + 3700);
    s0 = fmaf(a.x, x28, s0);
    s1 = fmaf(a.y, x29, s1);
    s2 = fmaf(a.z, x30, s2);
    s3 = fmaf(a.w, x31, s3);
    a = *(const LAS f32x4*)(Am + 3704);
    s0 = fmaf(a.x, x32, s0);
    s1 = fmaf(a.y, x33, s1);
    s2 = fmaf(a.z, x34, s2);
    s3 = fmaf(a.w, x35, s3);
    a = *(const LAS f32x4*)(Am + 3708);
    s0 = fmaf(a.x, x36, s0);
    s1 = fmaf(a.y, x37, s1);
    s2 = fmaf(a.z, x38, s2);
    s3 = fmaf(a.w, x39, s3);
    a = *(const LAS f32x4*)(Am + 3712);
    s0 = fmaf(a.x, x40, s0);
    s1 = fmaf(a.y, x41, s1);
    s2 = fmaf(a.z, x42, s2);
    s3 = fmaf(a.w, x43, s3);
    a = *(const LAS f32x4*)(Am + 3716);
    s0 = fmaf(a.x, x44, s0);
    s1 = fmaf(a.y, x45, s1);
    s2 = fmaf(a.z, x46, s2);
    s3 = fmaf(a.w, x47, s3);
    a = *(const LAS f32x4*)(Am + 3720);
    s0 = fmaf(a.x, x48, s0);
    s1 = fmaf(a.y, x49, s1);
    s2 = fmaf(a.z, x50, s2);
    s3 = fmaf(a.w, x51, s3);
    a = *(const LAS f32x4*)(Am + 3724);
    s0 = fmaf(a.x, x52, s0);
    const float al54 = a.y;
    x54 = (x54 - ((s0 + s1) + (s2 + s3))) - al54 * x53;
    Tu[7344 + c] = f2bf(x54 * su); Tw[7344 + c] = f2bf(x54 * sw); asm volatile("" ::: "memory");
    float x55 = fmaxf(0.0f, 1.0f - fabsf(cf - 55.0f));
    s0 = 0.f; s1 = 0.f; s2 = 0.f; s3 = 0.f;
    a = *(const LAS f32x4*)(Am + 3740);
    s0 = fmaf(a.x, x0, s0);
    s1 = fmaf(a.y, x1, s1);
    s2 = fmaf(a.z, x2, s2);
    s3 = fmaf(a.w, x3, s3);
    a = *(const LAS f32x4*)(Am + 3744);
    s0 = fmaf(a.x, x4, s0);
    s1 = fmaf(a.y, x5, s1);
    s2 = fmaf(a.z, x6, s2);
    s3 = fmaf(a.w, x7, s3);
    a = *(const LAS f32x4*)(Am + 3748);
    s0 = fmaf(a.x, x8, s0);
    s1 = fmaf(a.y, x9, s1);
    s2 = fmaf(a.z, x10, s2);
    s3 = fmaf(a.w, x11, s3);
    a = *(const LAS f32x4*)(Am + 3752);
    s0 = fmaf(a.x, x12, s0);
    s1 = fmaf(a.y, x13, s1);
    s2 = fmaf(a.z, x14, s2);
    s3 = fmaf(a.w, x15, s3);
    a = *(const LAS f32x4*)(Am + 3756);
    s0 = fmaf(a.x, x16, s0);
    s1 = fmaf(a.y, x17, s1);
    s2 = fmaf(a.z, x18, s2);
    s3 = fmaf(a.w, x19, s3);
    a = *(const LAS f32x4*)(Am + 3760);
    s0 = fmaf(a.x, x20, s0);
    s1 = fmaf(a.y, x21, s1);
    s2 = fmaf(a.z, x22, s2);
    s3 = fmaf(a.w, x23, s3);
    a = *(const LAS f32x4*)(Am + 3764);
    s0 = fmaf(a.x, x24, s0);
    s1 = fmaf(a.y, x25, s1);
    s2 = fmaf(a.z, x26, s2);
    s3 = fmaf(a.w, x27, s3);
    a = *(const LAS f32x4*)(Am + 3768);
    s0 = fmaf(a.x, x28, s0);
    s1 = fmaf(a.y, x29, s1);
    s2 = fmaf(a.z, x30, s2);
    s3 = fmaf(a.w, x31, s3);
    a = *(const LAS f32x4*)(Am + 3772);
    s0 = fmaf(a.x, x32, s0);
    s1 = fmaf(a.y, x33, s1);
    s2 = fmaf(a.z, x34, s2);
    s3 = fmaf(a.w, x35, s3);
    a = *(const LAS f32x4*)(Am + 3776);
    s0 = fmaf(a.x, x36, s0);
    s1 = fmaf(a.y, x37, s1);
    s2 = fmaf(a.z, x38, s2);
    s3 = fmaf(a.w, x39, s3);
    a = *(const LAS f32x4*)(Am + 3780);
    s0 = fmaf(a.x, x40, s0);
    s1 = fmaf(a.y, x41, s1);
    s2 = fmaf(a.z, x42, s2);
    s3 = fmaf(a.w, x43, s3);
    a = *(const LAS f32x4*)(Am + 3784);
    s0 = fmaf(a.x, x44, s0);
    s1 = fmaf(a.y, x45, s1);
    s2 = fmaf(a.z, x46, s2);
    s3 = fmaf(a.w, x47, s3);
    a = *(const LAS f32x4*)(Am + 3788);
    s0 = fmaf(a.x, x48, s0);
    s1 = fmaf(a.y, x49, s1);
    s2 = fmaf(a.z, x50, s2);
    s3 = fmaf(a.w, x51, s3);
    a = *(const LAS f32x4*)(Am + 3792);
    s0 = fmaf(a.x, x52, s0);
    s1 = fmaf(a.y, x53, s1);
    const float al55 = a.z;
    x55 = (x55 - ((s0 + s1) + (s2 + s3))) - al55 * x54;
    Tu[7480 + c] = f2bf(x55 * su); Tw[7480 + c] = f2bf(x55 * sw); asm volatile("" ::: "memory");
    float x56 = fmaxf(0.0f, 1.0f - fabsf(cf - 56.0f));
    s0 = 0.f; s1 = 0.f; s2 = 0.f; s3 = 0.f;
    a = *(const LAS f32x4*)(Am + 3808);
    s0 = fmaf(a.x, x0, s0);
    s1 = fmaf(a.y, x1, s1);
    s2 = fmaf(a.z, x2, s2);
    s3 = fmaf(a.w, x3, s3);
    a = *(const LAS f32x4*)(Am + 3812);
    s0 = fmaf(a.x, x4, s0);
    s1 = fmaf(a.y, x5, s1);
    s2 = fmaf(a.z, x6, s2);
    s3 = fmaf(a.w, x7, s3);
    a = *(const LAS f32x4*)(Am + 3816);
    s0 = fmaf(a.x, x8, s0);
    s1 = fmaf(a.y, x9, s1);
    s2 = fmaf(a.z, x10, s2);
    s3 = fmaf(a.w, x11, s3);
    a = *(const LAS f32x4*)(Am + 3820);
    s0 = fmaf(a.x, x12, s0);
    s1 = fmaf(a.y, x13, s1);
    s2 = fmaf(a.z, x14, s2);
    s3 = fmaf(a.w, x15, s3);
    a = *(const LAS f32x4*)(Am + 3824);
    s0 = fmaf(a.x, x16, s0);
    s1 = fmaf(a.y, x17, s1);
    s2 = fmaf(a.z, x18, s2);
    s3 = fmaf(a.w, x19, s3);
    a = *(const LAS f32x4*)(Am + 3828);
    s0 = fmaf(a.x, x20, s0);
    s1 = fmaf(a.y, x21, s1);
    s2 = fmaf(a.z, x22, s2);
    s3 = fmaf(a.w, x23, s3);
    a = *(const LAS f32x4*)(Am + 3832);
    s0 = fmaf(a.x, x24, s0);
    s1 = fmaf(a.y, x25, s1);
    s2 = fmaf(a.z, x26, s2);
    s3 = fmaf(a.w, x27, s3);
    a = *(const LAS f32x4*)(Am + 3836);
    s0 = fmaf(a.x, x28, s0);
    s1 = fmaf(a.y, x29, s1);
    s2 = fmaf(a.z, x30, s2);
    s3 = fmaf(a.w, x31, s3);
    a = *(const LAS f32x4*)(Am + 3840);
    s0 = fmaf(a.x, x32, s0);
    s1 = fmaf(a.y, x33, s1);
    s2 = fmaf(a.z, x34, s2);
    s3 = fmaf(a.w, x35, s3);
    a = *(const LAS f32x4*)(Am + 3844);
    s0 = fmaf(a.x, x36, s0);
    s1 = fmaf(a.y, x37, s1);
    s2 = fmaf(a.z, x38, s2);
    s3 = fmaf(a.w, x39, s3);
    a = *(const LAS f32x4*)(Am + 3848);
    s0 = fmaf(a.x, x40, s0);
    s1 = fmaf(a.y, x41, s1);
    s2 = fmaf(a.z, x42, s2);
    s3 = fmaf(a.w, x43, s3);
    a = *(const LAS f32x4*)(Am + 3852);
    s0 = fmaf(a.x, x44, s0);
    s1 = fmaf(a.y, x45, s1);
    s2 = fmaf(a.z, x46, s2);
    s3 = fmaf(a.w, x47, s3);
    a = *(const LAS f32x4*)(Am + 3856);
    s0 = fmaf(a.x, x48, s0);
    s1 = fmaf(a.y, x49, s1);
    s2 = fmaf(a.z, x50, s2);
    s3 = fmaf(a.w, x51, s3);
    a = *(const LAS f32x4*)(Am + 3860);
    s0 = fmaf(a.x, x52, s0);
    s1 = fmaf(a.y, x53, s1);
    s2 = fmaf(a.z, x54, s2);
    const float al56 = a.w;
    x56 = (x56 - ((s0 + s1) + (s2 + s3))) - al56 * x55;
    Tu[7616 + c] = f2bf(x56 * su); Tw[7616 + c] = f2bf(x56 * sw); asm volatile("" ::: "memory");
    float x57 = fmaxf(0.0f, 1.0f - fabsf(cf - 57.0f));
    s0 = 0.f; s1 = 0.f; s2 = 0.f; s3 = 0.f;
    a = *(const LAS f32x4*)(Am + 3876);
    s0 = fmaf(a.x, x0, s0);
    s1 = fmaf(a.y, x1, s1);
    s2 = fmaf(a.z, x2, s2);
    s3 = fmaf(a.w, x3, s3);
    a = *(const LAS f32x4*)(Am + 3880);
    s0 = fmaf(a.x, x4, s0);
    s1 = fmaf(a.y, x5, s1);
    s2 = fmaf(a.z, x6, s2);
    s3 = fmaf(a.w, x7, s3);
    a = *(const LAS f32x4*)(Am + 3884);
    s0 = fmaf(a.x, x8, s0);
    s1 = fmaf(a.y, x9, s1);
    s2 = fmaf(a.z, x10, s2);
    s3 = fmaf(a.w, x11, s3);
    a = *(const LAS f32x4*)(Am + 3888);
    s0 = fmaf(a.x, x12, s0);
    s1 = fmaf(a.y, x13, s1);
    s2 = fmaf(a.z, x14, s2);
    s3 = fmaf(a.w, x15, s3);
    a = *(const LAS f32x4*)(Am + 3892);
    s0 = fmaf(a.x, x16, s0);
    s1 = fmaf(a.y, x17, s1);
    s2 = fmaf(a.z, x18, s2);
    s3 = fmaf(a.w, x19, s3);
    a = *(const LAS f32x4*)(Am + 3896);
    s0 = fmaf(a.x, x20, s0);
    s1 = fmaf(a.y, x21, s1);
    s2 = fmaf(a.z, x22, s2);
    s3 = fmaf(a.w, x23, s3);
    a = *(const LAS f32x4*)(Am + 3900);
    s0 = fmaf(a.x, x24, s0);
    s1 = fmaf(a.y, x25, s1);
    s2 = fmaf(a.z, x26, s2);
    s3 = fmaf(a.w, x27, s3);
    a = *(const LAS f32x4*)(Am + 3904);
    s0 = fmaf(a.x, x28, s0);
    s1 = fmaf(a.y, x29, s1);
    s2 = fmaf(a.z, x30, s2);
    s3 = fmaf(a.w, x31, s3);
    a = *(const LAS f32x4*)(Am + 3908);
    s0 = fmaf(a.x, x32, s0);
    s1 = fmaf(a.y, x33, s1);
    s2 = fmaf(a.z, x34, s2);
    s3 = fmaf(a.w, x35, s3);
    a = *(const LAS f32x4*)(Am + 3912);
    s0 = fmaf(a.x, x36, s0);
    s1 = fmaf(a.y, x37, s1);
    s2 = fmaf(a.z, x38, s2);
    s3 = fmaf(a.w, x39, s3);
    a = *(const LAS f32x4*)(Am + 3916);
    s0 = fmaf(a.x, x40, s0);
    s1 = fmaf(a.y, x41, s1);
    s2 = fmaf(a.z, x42, s2);
    s3 = fmaf(a.w, x43, s3);
    a = *(const LAS f32x4*)(Am + 3920);
    s0 = fmaf(a.x, x44, s0);
    s1 = fmaf(a.y, x45, s1);
    s2 = fmaf(a.z, x46, s2);
    s3 = fmaf(a.w, x47, s3);
    a = *(const LAS f32x4*)(Am + 3924);
    s0 = fmaf(a.x, x48, s0);
    s1 = fmaf(a.y, x49, s1);
    s2 = fmaf(a.z, x50, s2);
    s3 = fmaf(a.w, x51, s3);
    a = *(const LAS f32x4*)(Am + 3928);
    s0 = fmaf(a.x, x52, s0);
    s1 = fmaf(a.y, x53, s1);
    s2 = fmaf(a.z, x54, s2);
    s3 = fmaf(a.w, x55, s3);
    a = *(const LAS f32x4*)(Am + 3932);
    const float al57 = a.x;
    x57 = (x57 - ((s0 + s1) + (s2 + s3))) - al57 * x56;
    Tu[7752 + c] = f2bf(x57 * su); Tw[7752 + c] = f2bf(x57 * sw); asm volatile("" ::: "memory");
    float x58 = fmaxf(0.0f, 1.0f - fabsf(cf - 58.0f));
    s0 = 0.f; s1 = 0.f; s2 = 0.f; s3 = 0.f;
    a = *(const LAS f32x4*)(Am + 3944);
    s0 = fmaf(a.x, x0, s0);
    s1 = fmaf(a.y, x1, s1);
    s2 = fmaf(a.z, x2, s2);
    s3 = fmaf(a.w, x3, s3);
    a = *(const LAS f32x4*)(Am + 3948);
    s0 = fmaf(a.x, x4, s0);
    s1 = fmaf(a.y, x5, s1);
    s2 = fmaf(a.z, x6, s2);
    s3 = fmaf(a.w, x7, s3);
    a = *(const LAS f32x4*)(Am + 3952);
    s0 = fmaf(a.x, x8, s0);
    s1 = fmaf(a.y, x9, s1);
    s2 = fmaf(a.z, x10, s2);
    s3 = fmaf(a.w, x11, s3);
    a = *(const LAS f32x4*)(Am + 3956);
    s0 = fmaf(a.x, x12, s0);
    s1 = fmaf(a.y, x13, s1);
    s2 = fmaf(a.z, x14, s2);
    s3 = fmaf(a.w, x15, s3);
    a = *(const LAS f32x4*)(Am + 3960);
    s0 = fmaf(a.x, x16, s0);
    s1 = fmaf(a.y, x17, s1);
    s2 = fmaf(a.z, x18, s2);
    s3 = fmaf(a.w, x19, s3);
    a = *(const LAS f32x4*)(Am + 3964);
    s0 = fmaf(a.x, x20, s0);
    s1 = fmaf(a.y, x21, s1);
    s2 = fmaf(a.z, x22, s2);
    s3 = fmaf(a.w, x23, s3);
    a = *(const LAS f32x4*)(Am + 3968);
    s0 = fmaf(a.x, x24, s0);
    s1 = fmaf(a.y, x25, s1);
    s2 = fmaf(a.z, x26, s2);
    s3 = fmaf(a.w, x27, s3);
    a = *(const LAS f32x4*)(Am + 3972);
    s0 = fmaf(a.x, x28, s0);
    s1 = fmaf(a.y, x29, s1);
    s2 = fmaf(a.z, x30, s2);
    s3 = fmaf(a.w, x31, s3);
    a = *(const LAS f32x4*)(Am + 3976);
    s0 = fmaf(a.x, x32, s0);
    s1 = fmaf(a.y, x33, s1);
    s2 = fmaf(a.z, x34, s2);
    s3 = fmaf(a.w, x35, s3);
    a = *(const LAS f32x4*)(Am + 3980);
    s0 = fmaf(a.x, x36, s0);
    s1 = fmaf(a.y, x37, s1);
    s2 = fmaf(a.z, x38, s2);
    s3 = fmaf(a.w, x39, s3);
    a = *(const LAS f32x4*)(Am + 3984);
    s0 = fmaf(a.x, x40, s0);
    s1 = fmaf(a.y, x41, s1);
    s2 = fmaf(a.z, x42, s2);
    s3 = fmaf(a.w, x43, s3);
    a = *(const LAS f32x4*)(Am + 3988);
    s0 = fmaf(a.x, x44, s0);
    s1 = fmaf(a.y, x45, s1);
    s2 = fmaf(a.z, x46, s2);
    s3 = fmaf(a.w, x47, s3);
    a = *(const LAS f32x4*)(Am + 3992);
    s0 = fmaf(a.x, x48, s0);
    s1 = fmaf(a.y, x49, s1);
    s2 = fmaf(a.z, x50, s2);
    s3 = fmaf(a.w, x51, s3);
    a = *(const LAS f32x4*)(Am + 3996);
    s0 = fmaf(a.x, x52, s0);
    s1 = fmaf(a.y, x53, s1);
    s2 = fmaf(a.z, x54, s2);
    s3 = fmaf(a.w, x55, s3);
    a = *(const LAS f32x4*)(Am + 4000);
    s0 = fmaf(a.x, x56, s0);
    const float al58 = a.y;
    x58 = (x58 - ((s0 + s1) + (s2 + s3))) - al58 * x57;
    Tu[7888 + c] = f2bf(x58 * su); Tw[7888 + c] = f2bf(x58 * sw); asm volatile("" ::: "memory");
    float x59 = fmaxf(0.0f, 1.0f - fabsf(cf - 59.0f));
    s0 = 0.f; s1 = 0.f; s2 = 0.f; s3 = 0.f;
    a = *(const LAS f32x4*)(Am + 4012);
    s0 = fmaf(a.x, x0, s0);
    s1 = fmaf(a.y, x1, s1);
    s2 = fmaf(a.z, x2, s2);
    s3 = fmaf(a.w, x3, s3);
    a = *(const LAS f32x4*)(Am + 4016);
    s0 = fmaf(a.x, x4, s0);
    s1 = fmaf(a.y, x5, s1);
    s2 = fmaf(a.z, x6, s2);
    s3 = fmaf(a.w, x7, s3);
    a = *(const LAS f32x4*)(Am + 4020);
    s0 = fmaf(a.x, x8, s0);
    s1 = fmaf(a.y, x9, s1);
    s2 = fmaf(a.z, x10, s2);
    s3 = fmaf(a.w, x11, s3);
    a = *(const LAS f32x4*)(Am + 4024);
    s0 = fmaf(a.x, x12, s0);
    s1 = fmaf(a.y, x13, s1);
    s2 = fmaf(a.z, x14, s2);
    s3 = fmaf(a.w, x15, s3);
    a = *(const LAS f32x4*)(Am + 4028);
    s0 = fmaf(a.x, x16, s0);
    s1 = fmaf(a.y, x17, s1);
    s2 = fmaf(a.z, x18, s2);
    s3 = fmaf(a.w, x19, s3);
    a = *(const LAS f32x4*)(Am + 4032);
    s0 = fmaf(a.x, x20, s0);
    s1 = fmaf(a.y, x21, s1);
    s2 = fmaf(a.z, x22, s2);
    s3 = fmaf(a.w, x23, s3);
    a = *(const LAS f32x4*)(Am + 4036);
    s0 = fmaf(a.x, x24, s0);
    s1 = fmaf(a.y, x25, s1);
    s2 = fmaf(a.z, x26, s2);
    s3 = fmaf(a.w, x27, s3);
    a = *(const LAS f32x4*)(Am + 4040);
    s0 = fmaf(a.x, x28, s0);
    s1 = fmaf(a.y, x29, s1);
    s2 = fmaf(a.z, x30, s2);
    s3 = fmaf(a.w, x31, s3);
    a = *(const LAS f32x4*)(Am + 4044);
    s0 = fmaf(a.x, x32, s0);
    s1 = fmaf(a.y, x33, s1);
    s2 = fmaf(a.z, x34, s2);
    s3 = fmaf(a.w, x35, s3);
    a = *(const LAS f32x4*)(Am + 4048);
    s0 = fmaf(a.x, x36, s0);
    s1 = fmaf(a.y, x37, s1);
    s2 = fmaf(a.z, x38, s2);
    s3 = fmaf(a.w, x39, s3);
    a = *(const LAS f32x4*)(Am + 4052);
    s0 = fmaf(a.x, x40, s0);
    s1 = fmaf(a.y, x41, s1);
    s2 = fmaf(a.z, x42, s2);
    s3 = fmaf(a.w, x43, s3);
    a = *(const LAS f32x4*)(Am + 4056);
    s0 = fmaf(a.x, x44, s0);
    s1 = fmaf(a.y, x45, s1);
    s2 = fmaf(a.z, x46, s2);
    s3 = fmaf(a.w, x47, s3);
    a = *(const LAS f32x4*)(Am + 4060);
    s0 = fmaf(a.x, x48, s0);
    s1 = fmaf(a.y, x49, s1);
    s2 = fmaf(a.z, x50, s2);
    s3 = fmaf(a.w, x51, s3);
    a = *(const LAS f32x4*)(Am + 4064);
    s0 = fmaf(a.x, x52, s0);
    s1 = fmaf(a.y, x53, s1);
    s2 = fmaf(a.z, x54, s2);
    s3 = fmaf(a.w, x55, s3);
    a = *(const LAS f32x4*)(Am + 4068);
    s0 = fmaf(a.x, x56, s0);
    s1 = fmaf(a.y, x57, s1);
    const float al59 = a.z;
    x59 = (x59 - ((s0 + s1) + (s2 + s3))) - al59 * x58;
    Tu[8024 + c] = f2bf(x59 * su); Tw[8024 + c] = f2bf(x59 * sw); asm volatile("" ::: "memory");
    float x60 = fmaxf(0.0f, 1.0f - fabsf(cf - 60.0f));
    s0 = 0.f; s1 = 0.f; s2 = 0.f; s3 = 0.f;
    a = *(const LAS f32x4*)(Am + 4080);
    s0 = fmaf(a.x, x0, s0);
    s1 = fmaf(a.y, x1, s1);
    s2 = fmaf(a.z, x2, s2);
    s3 = fmaf(a.w, x3, s3);
    a = *(const LAS f32x4*)(Am + 4084);
    s0 = fmaf(a.x, x4, s0);
    s1 = fmaf(a.y, x5, s1);
    s2 = fmaf(a.z, x6, s2);
    s3 = fmaf(a.w, x7, s3);
    a = *(const LAS f32x4*)(Am + 4088);
    s0 = fmaf(a.x, x8, s0);
    s1 = fmaf(a.y, x9, s1);
    s2 = fmaf(a.z, x10, s2);
    s3 = fmaf(a.w, x11, s3);
    a = *(const LAS f32x4*)(Am + 4092);
    s0 = fmaf(a.x, x12, s0);
    s1 = fmaf(a.y, x13, s1);
    s2 = fmaf(a.z, x14, s2);
    s3 = fmaf(a.w, x15, s3);
    a = *(const LAS f32x4*)(Am + 4096);
    s0 = fmaf(a.x, x16, s0);
    s1 = fmaf(a.y, x17, s1);
    s2 = fmaf(a.z, x18, s2);
    s3 = fmaf(a.w, x19, s3);
    a = *(const LAS f32x4*)(Am + 4100);
    s0 = fmaf(a.x, x20, s0);
    s1 = fmaf(a.y, x21, s1);
    s2 = fmaf(a.z, x22, s2);
    s3 = fmaf(a.w, x23, s3);
    a = *(const LAS f32x4*)(Am + 4104);
    s0 = fmaf(a.x, x24, s0);
    s1 = fmaf(a.y, x25, s1);
    s2 = fmaf(a.z, x26, s2);
    s3 = fmaf(a.w, x27, s3);
    a = *(const LAS f32x4*)(Am + 4108);
    s0 = fmaf(a.x, x28, s0);
    s1 = fmaf(a.y, x29, s1);
    s2 = fmaf(a.z, x30, s2);
    s3 = fmaf(a.w, x31, s3);
    a = *(const LAS f32x4*)(Am + 4112);
    s0 = fmaf(a.x, x32, s0);
    s1 = fmaf(a.y, x33, s1);
    s2 = fmaf(a.z, x34, s2);
    s3 = fmaf(a.w, x35, s3);
    a = *(const LAS f32x4*)(Am + 4116);
    s0 = fmaf(a.x, x36, s0);
    s1 = fmaf(a.y, x37, s1);
    s2 = fmaf(a.z, x38, s2);
    s3 = fmaf(a.w, x39, s3);
    a = *(const LAS f32x4*)(Am + 4120);
    s0 = fmaf(a.x, x40, s0);
    s1 = fmaf(a.y, x41, s1);
    s2 = fmaf(a.z, x42, s2);
    s3 = fmaf(a.w, x43, s3);
    a = *(const LAS f32x4*)(Am + 4124);
    s0 = fmaf(a.x, x44, s0);
    s1 = fmaf(a.y, x45, s1);
    s2 = fmaf(a.z, x46, s2);
    s3 = fmaf(a.w, x47, s3);
    a = *(const LAS f32x4*)(Am + 4128);
    s0 = fmaf(a.x, x48, s0);
    s1 = fmaf(a.y, x49, s1);
    s2 = fmaf(a.z, x50, s2);
    s3 = fmaf(a.w, x51, s3);
    a = *(const LAS f32x4*)(Am + 4132);
    s0 = fmaf(a.x, x52, s0);
    s1 = fmaf(a.y, x53, s1);
    s2 = fmaf(a.z, x54, s2);
    s3 = fmaf(a.w, x55, s3);
    a = *(const LAS f32x4*)(Am + 4136);
    s0 = fmaf(a.x, x56, s0);
    s1 = fmaf(a.y, x57, s1);
    s2 = fmaf(a.z, x58, s2);
    const float al60 = a.w;
    x60 = (x60 - ((s0 + s1) + (s2 + s3))) - al60 * x59;
    Tu[8160 + c] = f2bf(x60 * su); Tw[8160 + c] = f2bf(x60 * sw); asm volatile("" ::: "memory");
    float x61 = fmaxf(0.0f, 1.0f - fabsf(cf - 61.0f));
    s0 = 0.f; s1 = 0.f; s2 = 0.f; s3 = 0.f;
    a = *(const LAS f32x4*)(Am + 4148);
    s0 = fmaf(a.x, x0, s0);
    s1 = fmaf(a.y, x1, s1);
    s2 = fmaf(a.z, x2, s2);
    s3 = fmaf(a.w, x3, s3);
    a = *(const LAS f32x4*)(Am + 4152);
    s0 = fmaf(a.x, x4, s0);
    s1 = fmaf(a.y, x5, s1);
    s2 = fmaf(a.z, x6, s2);
    s3 = fmaf(a.w, x7, s3);
    a = *(const LAS f32x4*)(Am + 4156);
    s0 = fmaf(a.x, x8, s0);
    s1 = fmaf(a.y, x9, s1);
    s2 = fmaf(a.z, x10, s2);
    s3 = fmaf(a.w, x11, s3);
    a = *(const LAS f32x4*)(Am + 4160);
    s0 = fmaf(a.x, x12, s0);
    s1 = fmaf(a.y, x13, s1);
    s2 = fmaf(a.z, x14, s2);
    s3 = fmaf(a.w, x15, s3);
    a = *(const LAS f32x4*)(Am + 4164);
    s0 = fmaf(a.x, x16, s0);
    s1 = fmaf(a.y, x17, s1);
    s2 = fmaf(a.z, x18, s2);
    s3 = fmaf(a.w, x19, s3);
    a = *(const LAS f32x4*)(Am + 4168);
    s0 = fmaf(a.x, x20, s0);
    s1 = fmaf(a.y, x21, s1);
    s2 = fmaf(a.z, x22, s2);
    s3 = fmaf(a.w, x23, s3);
    a = *(const LAS f32x4*)(Am + 4172);
    s0 = fmaf(a.x, x24, s0);
    s1 = fmaf(a.y, x25, s1);
    s2 = fmaf(a.z, x26, s2);
    s3 = fmaf(a.w, x27, s3);
    a = *(const LAS f32x4*)(Am + 4176);
    s0 = fmaf(a.x, x28, s0);
    s1 = fmaf(a.y, x29, s1);
    s2 = fmaf(a.z, x30, s2);
    s3 = fmaf(a.w, x31, s3);
    a = *(const LAS f32x4*)(Am + 4180);
    s0 = fmaf(a.x, x32, s0);
    s1 = fmaf(a.y, x33, s1);
    s2 = fmaf(a.z, x34, s2);
    s3 = fmaf(a.w, x35, s3);
    a = *(const LAS f32x4*)(Am + 4184);
    s0 = fmaf(a.x, x36, s0);
    s1 = fmaf(a.y, x37, s1);
    s2 = fmaf(a.z, x38, s2);
    s3 = fmaf(a.w, x39, s3);
    a = *(const LAS f32x4*)(Am + 4188);
    s0 = fmaf(a.x, x40, s0);
    s1 = fmaf(a.y, x41, s1);
    s2 = fmaf(a.z, x42, s2);
    s3 = fmaf(a.w, x43, s3);
    a = *(const LAS f32x4*)(Am + 4192);
    s0 = fmaf(a.x, x44, s0);
    s1 = fmaf(a.y, x45, s1);
    s2 = fmaf(a.z, x46, s2);
    s3 = fmaf(a.w, x47, s3);
    a = *(const LAS f32x4*)(Am + 4196);
    s0 = fmaf(a.x, x48, s0);
    s1 = fmaf(a.y, x49, s1);
    s2 = fmaf(a.z, x50, s2);
    s3 = fmaf(a.w, x51, s3);
    a = *(const LAS f32x4*)(Am + 4200);
    s0 = fmaf(a.x, x52, s0);
    s1 = fmaf(a.y, x53, s1);
    s2 = fmaf(a.z, x54, s2);
    s3 = fmaf(a.w, x55, s3);
    a = *(const LAS f32x4*)(Am + 4204);
    s0 = fmaf(a.x, x56, s0);
    s1 = fmaf(a.y, x57, s1);
    s2 = fmaf(a.z, x58, s2);
    s3 = fmaf(a.w, x59, s3);
    a = *(const LAS f32x4*)(Am + 4208);
    const float al61 = a.x;
    x61 = (x61 - ((s0 + s1) + (s2 + s3))) - al61 * x60;
    Tu[8296 + c] = f2bf(x61 * su); Tw[8296 + c] = f2bf(x61 * sw); asm volatile("" ::: "memory");
    float x62 = fmaxf(0.0f, 1.0f - fabsf(cf - 62.0f));
    s0 = 0.f; s1 = 0.f; s2 = 0.f; s3 = 0.f;
    a = *(const LAS f32x4*)(Am + 4216);
    s0 = fmaf(a.x, x0, s0);
    s1 = fmaf(a.y, x1, s1);
    s2 = fmaf(a.z, x2, s2);
    s3 = fmaf(a.w, x3, s3);
    a = *(const LAS f32x4*)(Am + 4220);
    s0 = fmaf(a.x, x4, s0);
    s1 = fmaf(a.y, x5, s1);
    s2 = fmaf(a.z, x6, s2);
    s3 = fmaf(a.w, x7, s3);
    a = *(const LAS f32x4*)(Am + 4224);
    s0 = fmaf(a.x, x8, s0);
    s1 = fmaf(a.y, x9, s1);
    s2 = fmaf(a.z, x10, s2);
    s3 = fmaf(a.w, x11, s3);
    a = *(const LAS f32x4*)(Am + 4228);
    s0 = fmaf(a.x, x12, s0);
    s1 = fmaf(a.y, x13, s1);
    s2 = fmaf(a.z, x14, s2);
    s3 = fmaf(a.w, x15, s3);
    a = *(const LAS f32x4*)(Am + 4232);
    s0 = fmaf(a.x, x16, s0);
    s1 = fmaf(a.y, x17, s1);
    s2 = fmaf(a.z, x18, s2);
    s3 = fmaf(a.w, x19, s3);
    a = *(const LAS f32x4*)(Am + 4236);
    s0 = fmaf(a.x, x20, s0);
    s1 = fmaf(a.y, x21, s1);
    s2 = fmaf(a.z, x22, s2);
    s3 = fmaf(a.w, x23, s3);
    a = *(const LAS f32x4*)(Am + 4240);
    s0 = fmaf(a.x, x24, s0);
    s1 = fmaf(a.y, x25, s1);
    s2 = fmaf(a.z, x26, s2);
    s3 = fmaf(a.w, x27, s3);
    a = *(const LAS f32x4*)(Am + 4244);
    s0 = fmaf(a.x, x28, s0);
    s1 = fmaf(a.y, x29, s1);
    s2 = fmaf(a.z, x30, s2);
    s3 = fmaf(a.w, x31, s3);
    a = *(const LAS f32x4*)(Am + 4248);
    s0 = fmaf(a.x, x32, s0);
    s1 = fmaf(a.y, x33, s1);
    s2 = fmaf(a.z, x34, s2);
    s3 = fmaf(a.w, x35, s3);
    a = *(const LAS f32x4*)(Am + 4252);
    s0 = fmaf(a.x, x36, s0);
    s1 = fmaf(a.y, x37, s1);
    s2 = fmaf(a.z, x38, s2);
    s3 = fmaf(a.w, x39, s3);
    a = *(const LAS f32x4*)(Am + 4256);
    s0 = fmaf(a.x, x40, s0);
    s1 = fmaf(a.y, x41, s1);
    s2 = fmaf(a.z, x42, s2);
    s3 = fmaf(a.w, x43, s3);
    a = *(const LAS f32x4*)(Am + 4260);
    s0 = fmaf(a.x, x44, s0);
    s1 = fmaf(a.y, x45, s1);
    s2 = fmaf(a.z, x46, s2);
    s3 = fmaf(a.w, x47, s3);
    a = *(const LAS f32x4*)(Am + 4264);
    s0 = fmaf(a.x, x48, s0);
    s1 = fmaf(a.y, x49, s1);
    s2 = fmaf(a.z, x50, s2);
    s3 = fmaf(a.w, x51, s3);
    a = *(const LAS f32x4*)(Am + 4268);
    s0 = fmaf(a.x, x52, s0);
    s1 = fmaf(a.y, x53, s1);
    s2 = fmaf(a.z, x54, s2);
    s3 = fmaf(a.w, x55, s3);
    a = *(const LAS f32x4*)(Am + 4272);
    s0 = fmaf(a.x, x56, s0);
    s1 = fmaf(a.y, x57, s1);
    s2 = fmaf(a.z, x58, s2);
    s3 = fmaf(a.w, x59, s3);
    a = *(const LAS f32x4*)(Am + 4276);
    s0 = fmaf(a.x, x60, s0);
    const float al62 = a.y;
    x62 = (x62 - ((s0 + s1) + (s2 + s3))) - al62 * x61;
    Tu[8432 + c] = f2bf(x62 * su); Tw[8432 + c] = f2bf(x62 * sw); asm volatile("" ::: "memory");
    float x63 = fmaxf(0.0f, 1.0f - fabsf(cf - 63.0f));
    s0 = 0.f; s1 = 0.f; s2 = 0.f; s3 = 0.f;
    a = *(const LAS f32x4*)(Am + 4284);
    s0 = fmaf(a.x, x0, s0);
    s1 = fmaf(a.y, x1, s1);
    s2 = fmaf(a.z, x2, s2);
    s3 = fmaf(a.w, x3, s3);
    a = *(const LAS f32x4*)(Am + 4288);
    s0 = fmaf(a.x, x4, s0);
    s1 = fmaf(a.y, x5, s1);
    s2 = fmaf(a.z, x6, s2);
    s3 = fmaf(a.w, x7, s3);
    a = *(const LAS f32x4*)(Am + 4292);
    s0 = fmaf(a.x, x8, s0);
    s1 = fmaf(a.y, x9, s1);
    s2 = fmaf(a.z, x10, s2);
    s3 = fmaf(a.w, x11, s3);
    a = *(const LAS f32x4*)(Am + 4296);
    s0 = fmaf(a.x, x12, s0);
    s1 = fmaf(a.y, x13, s1);
    s2 = fmaf(a.z, x14, s2);
    s3 = fmaf(a.w, x15, s3);
    a = *(const LAS f32x4*)(Am + 4300);
    s0 = fmaf(a.x, x16, s0);
    s1 = fmaf(a.y, x17, s1);
    s2 = fmaf(a.z, x18, s2);
    s3 = fmaf(a.w, x19, s3);
    a = *(const LAS f32x4*)(Am + 4304);
    s0 = fmaf(a.x, x20, s0);
    s1 = fmaf(a.y, x21, s1);
    s2 = fmaf(a.z, x22, s2);
    s3 = fmaf(a.w, x23, s3);
    a = *(const LAS f32x4*)(Am + 4308);
    s0 = fmaf(a.x, x24, s0);
    s1 = fmaf(a.y, x25, s1);
    s2 = fmaf(a.z, x26, s2);
    s3 = fmaf(a.w, x27, s3);
    a = *(const LAS f32x4*)(Am + 4312);
    s0 = fmaf(a.x, x28, s0);
    s1 = fmaf(a.y, x29, s1);
    s2 = fmaf(a.z, x30, s2);
    s3 = fmaf(a.w, x31, s3);
    a = *(const LAS f32x4*)(Am + 4316);
    s0 = fmaf(a.x, x32, s0);
    s1 = fmaf(a.y, x33, s1);
    s2 = fmaf(a.z, x34, s2);
    s3 = fmaf(a.w, x35, s3);
    a = *(const LAS f32x4*)(Am + 4320);
    s0 = fmaf(a.x, x36, s0);
    s1 = fmaf(a.y, x37, s1);
    s2 = fmaf(a.z, x38, s2);
    s3 = fmaf(a.w, x39, s3);
    a = *(const LAS f32x4*)(Am + 4324);
    s0 = fmaf(a.x, x40, s0);
    s1 = fmaf(a.y, x41, s1);
    s2 = fmaf(a.z, x42, s2);
    s3 = fmaf(a.w, x43, s3);
    a = *(const LAS f32x4*)(Am + 4328);
    s0 = fmaf(a.x, x44, s0);
    s1 = fmaf(a.y, x45, s1);
    s2 = fmaf(a.z, x46, s2);
    s3 = fmaf(a.w, x47, s3);
    a = *(const LAS f32x4*)(Am + 4332);
    s0 = fmaf(a.x, x48, s0);
    s1 = fmaf(a.y, x49, s1);
    s2 = fmaf(a.z, x50, s2);
    s3 = fmaf(a.w, x51, s3);
    a = *(const LAS f32x4*)(Am + 4336);
    s0 = fmaf(a.x, x52, s0);
    s1 = fmaf(a.y, x53, s1);
    s2 = fmaf(a.z, x54, s2);
    s3 = fmaf(a.w, x55, s3);
    a = *(const LAS f32x4*)(Am + 4340);
    s0 = fmaf(a.x, x56, s0);
    s1 = fmaf(a.y, x57, s1);
    s2 = fmaf(a.z, x58, s2);
    s3 = fmaf(a.w, x59, s3);
    a = *(const LAS f32x4*)(Am + 4344);
    s0 = fmaf(a.x, x60, s0);
    s1 = fmaf(a.y, x61, s1);
    const float al63 = a.z;
    x63 = (x63 - ((s0 + s1) + (s2 + s3))) - al63 * x62;
    Tu[8568 + c] = f2bf(x63 * su); Tw[8568 + c] = f2bf(x63 * sw); asm volatile("" ::: "memory");
}
typedef short bf16x8_t __attribute__((ext_vector_type(8)));
template <int K> __device__ __forceinline__ f32x4 mma_tile(const LAS unsigned short* A, int lda, const LAS unsigned short* Bt, int ldb, f32x4 acc) {
    const int lane = threadIdx.x & 63, r = lane & 15, q = lane >> 4;
#pragma unroll
    for (int ks = 0; ks < K / 32; ++ks) {
        const bf16x8_t a = *(const LAS bf16x8_t*)(A + r * lda + ks * 32 + q * 8);
        const bf16x8_t b = *(const LAS bf16x8_t*)(Bt + r * ldb + ks * 32 + q * 8);
        acc = __builtin_amdgcn_mfma_f32_16x16x32_bf16(a, b, acc, 0, 0, 0);
    }
    return acc;
}

typedef unsigned short u16x4_t __attribute__((ext_vector_type(4)));
__device__ __forceinline__ void tr_frag2(unsigned base_addr, int pitch, int c, bf16x8_t& f0, bf16x8_t& f1) {
    const int lane = threadIdx.x & 63, g = lane >> 4, qq = (lane & 15) >> 2, pp = lane & 3;
    const unsigned a00 = base_addr + (unsigned)((8 * g + qq) * pitch + 32 * c + 8 * pp);
    const unsigned a01 = a00 + 4u * (unsigned)pitch, a10 = a00 + 32u * (unsigned)pitch, a11 = a10 + 4u * (unsigned)pitch;
    u16x4_t r00, r01, r10, r11;
    asm volatile("ds_read_b64_tr_b16 %0, %4\n\tds_read_b64_tr_b16 %1, %5\n\tds_read_b64_tr_b16 %2, %6\n\tds_read_b64_tr_b16 %3, %7\n\ts_waitcnt lgkmcnt(0)"
                 : "=&v"(r00), "=&v"(r01), "=&v"(r10), "=&v"(r11) : "v"(a00), "v"(a01), "v"(a10), "v"(a11) : "memory");
    f0 = (bf16x8_t){(short)r00.x, (short)r00.y, (short)r00.z, (short)r00.w, (short)r01.x, (short)r01.y, (short)r01.z, (short)r01.w};
    f1 = (bf16x8_t){(short)r10.x, (short)r10.y, (short)r10.z, (short)r10.w, (short)r11.x, (short)r11.y, (short)r11.z, (short)r11.w};
}
constexpr size_t WS_G = 235 * MiB;

__device__ __forceinline__ void delta_prep(LDSp lds, const Params& p) {
    const bf16_t* QKVN = (const bf16_t*)(p.ws + WS_QKV); const float* BETA = (const float*)(p.ws + WS_BETA); const float* LA = (const float*)(p.ws + WS_LA);
    bf16_t* Z = (bf16_t*)(p.ws + WS_Z); float* GB = (float*)(p.ws + WS_G);
    LAS unsigned short* Qb = (LAS unsigned short*)lds;
    LAS unsigned short* Kb = (LAS unsigned short*)(lds + 17408);
    LAS unsigned short* Ast = (LAS unsigned short*)(lds + 107776);
    const int tid = threadIdx.x, lane = tid & 63, wid = tid >> 6, r = lane & 15, q = lane >> 4;
    const int G = gridDim.x;
    u32x4 pq[4]; float pla = 0.f, pbe = 0.f;
#define DPL(u_, vmode) do { const int dir_ = (u_) >> 10, b_ = ((u_) >> 8) & 3, h_ = ((u_) >> 6) & 3, n_ = (u_) & 63; \
        const long tk0_ = (long)b_ * S_ + (dir_ ? (S_ - 1 - n_ * 64) : n_ * 64); const long ts_ = dir_ ? -1 : 1; \
        _Pragma("unroll") for (int i = 0; i < 4; ++i) { const int pi = tid + NTHR * i, which = pi >> 10, l = (pi >> 4) & 63, c8 = pi & 15; \
            pq[i] = *(const u32x4*)(QKVN + (tk0_ + l * ts_) * 1536 + ((vmode) ? (which ? 512 : 1024) : which * 512) + h_ * 128 + c8 * 8); } \
        if (!(vmode) && tid < 64) { const long tk = tk0_ + tid * ts_; pla = LA[tk * 8 + dir_ * 4 + h_]; pbe = BETA[tk * 8 + dir_ * 4 + h_]; } } while (0)
#define DPS() do { _Pragma("unroll") for (int i = 0; i < 4; ++i) { const int pi = tid + NTHR * i, which = pi >> 10, l = (pi >> 4) & 63, c8 = pi & 15; *(LAS u32x4*)(lds + which * 17408 + l * 272 + c8 * 16) = pq[i]; } } while (0)
    if ((int)blockIdx.x < 2048) DPL((int)blockIdx.x, 0);
    for (int ub = blockIdx.x; ub < 2048; ub += 4 * G) {
#pragma unroll 1
        for (int j = 0; j < 4; ++j) { const int unit = ub + j * G; if (unit >= 2048) break;
            const int dir = unit >> 10, b = (unit >> 8) & 3, h = (unit >> 6) & 3, n = unit & 63;
            const long tok0 = (long)b * S_ + (dir ? (S_ - 1 - n * 64) : n * 64); const long tstep = dir ? -1 : 1;
            LAS float* Am = (LAS float*)(lds + 34816 + j * 17408); LAS float* gl = (LAS float*)(lds + 104448 + j * 768); LAS float* be = gl + 64; LAS float* beg = gl + 128; LAS float* la = (LAS float*)(lds + 107520);
            DPS();
            if (tid < 64) { la[tid] = pla; be[tid] = pbe; }
            __syncthreads();
            { const int un = ub + (j + 1) * G; if (j < 3 && un < 2048) DPL(un, 0); else DPL(ub, 1); }
            if (tid < 64) { const float g = wave_scan_sum(la[tid], true); gl[tid] = g; beg[tid] = be[tid] * __expf(g); GB[((size_t)dir * T_ + (tok0 + tid * tstep)) * 4 + h] = g; }
            __syncthreads();
#pragma unroll
            for (int tt = 0; tt < 2; ++tt) { const int idx = wid * 2 + tt, mt = idx >> 2, nt = idx & 3;
                f32x4 kk = {0.f, 0.f, 0.f, 0.f}, qk = {0.f, 0.f, 0.f, 0.f};
                if (mt >= nt) { kk = mma_tile<128>(Kb + mt * 16 * 136, 136, Kb + nt * 16 * 136, 136, kk); qk = mma_tile<128>(Qb + mt * 16 * 136, 136, Kb + nt * 16 * 136, 136, qk); }
                const int jj = nt * 16 + r; const float gj = gl[jj];
#pragma unroll
                for (int i4 = 0; i4 < 4; ++i4) { const int i = mt * 16 + q * 4 + i4; const float dec = (i >= jj) ? __expf(gl[i] - gj) : 0.f;
                    Am[i * 68 + jj] = (i > jj) ? be[i] * kk[i4] * dec : 0.f;
                    Ast[i * 72 + jj] = f2bf(qk[i4] * dec); }
            }
            __syncthreads();
            { const int l = tid >> 3, c8 = tid & 7;
              *(u32x4*)(Z + (tok0 + l * tstep) * 3072 + 2048 + dir * 256 + h * 64 + c8 * 8) = *(const LAS u32x4*)(Ast + l * 72 + c8 * 8); }
        }
        if (wid < 4 && ub + wid * G < 2048) { int cc = lane; asm volatile("" : "+v"(cc));
            LAS float* Am = (LAS float*)(lds + 34816 + wid * 17408); LAS float* gl = (LAS float*)(lds + 104448 + wid * 768);
            tri_inv64(Am, cc, gl[64 + lane], gl[128 + lane], (LAS unsigned short*)Am, (LAS unsigned short*)Am + 64); }
        __syncthreads();
#pragma unroll 1
        for (int j = 0; j < 4; ++j) { const int unit = ub + j * G; if (unit >= 2048) break;
            const int dir = unit >> 10, b = (unit >> 8) & 3, h = (unit >> 6) & 3, n = unit & 63;
            const long tok0 = (long)b * S_ + (dir ? (S_ - 1 - n * 64) : n * 64); const long tstep = dir ? -1 : 1;
            const LAS unsigned short* Tu = (const LAS unsigned short*)(lds + 34816 + j * 17408);
            DPS();
            __syncthreads();
            { const int un = ub + (j + 1) * G; if (j < 3 && un < 2048) DPL(un, 1); else if (ub + 4 * G < 2048) DPL(ub + 4 * G, 0); }
            {   bf16x8_t vb0, vb1, kb0, kb1; tr_frag2((unsigned)(unsigned long long)Qb, 272, wid, vb0, vb1); tr_frag2((unsigned)(unsigned long long)Kb, 272, wid, kb0, kb1);
                __syncthreads();
#pragma unroll
                for (int mt = 0; mt < 4; ++mt) {
                    const bf16x8_t tu0 = *(const LAS bf16x8_t*)(Tu + (mt * 16 + r) * 136 + q * 8), tu1 = *(const LAS bf16x8_t*)(Tu + (mt * 16 + r) * 136 + 32 + q * 8);
                    const bf16x8_t tw0 = *(const LAS bf16x8_t*)(Tu + (mt * 16 + r) * 136 + 64 + q * 8), tw1 = *(const LAS bf16x8_t*)(Tu + (mt * 16 + r) * 136 + 96 + q * 8);
                    f32x4 au = {0.f, 0.f, 0.f, 0.f}, aw = {0.f, 0.f, 0.f, 0.f};
                    au = __builtin_amdgcn_mfma_f32_16x16x32_bf16(tu0, vb0, au, 0, 0, 0); au = __builtin_amdgcn_mfma_f32_16x16x32_bf16(tu1, vb1, au, 0, 0, 0);
                    aw = __builtin_amdgcn_mfma_f32_16x16x32_bf16(tw0, kb0, aw, 0, 0, 0); aw = __builtin_amdgcn_mfma_f32_16x16x32_bf16(tw1, kb1, aw, 0, 0, 0);
#pragma unroll
                    for (int i4 = 0; i4 < 4; ++i4) { const int l = mt * 16 + q * 4 + i4; Qb[l * 136 + wid * 16 + r] = f2bf(au[i4]); Kb[l * 136 + wid * 16 + r] = f2bf(aw[i4]); }
                }
            }
            __syncthreads();
#pragma unroll
            for (int i = 0; i < 4; ++i) { const int pi = tid + NTHR * i, which = pi >> 10, l = (pi >> 4) & 63, c8 = pi & 15;
                *(u32x4*)(Z + (tok0 + l * tstep) * 3072 + which * 1024 + dir * 512 + h * 128 + c8 * 8) = *(const LAS u32x4*)(lds + which * 17408 + l * 272 + c8 * 16); }
            __syncthreads();
        }
    }
}
#undef DPL
#undef DPS

__device__ __forceinline__ void delta_scan2(LDSp lds, const Params& p) {
    const bf16_t* QKVN = (const bf16_t*)(p.ws + WS_QKV); const bf16_t* Z = (const bf16_t*)(p.ws + WS_Z); const float* GB = (const float*)(p.ws + WS_G);
    LAS unsigned short* Wb  = (LAS unsigned short*)lds;
    LAS unsigned short* Qg  = (LAS unsigned short*)(lds + 17408);
    LAS unsigned short* Kg  = (LAS unsigned short*)(lds + 34816);
    LAS unsigned short* At  = (LAS unsigned short*)(lds + 53248);
    LAS unsigned short* Ub  = (LAS unsigned short*)(lds + 62464);
    LAS unsigned short* St  = (LAS unsigned short*)(lds + 66560);
    LAS unsigned short* Vt  = (LAS unsigned short*)(lds + 75264);
    const int tid = threadIdx.x, lane = tid & 63, wid = tid >> 6, r = lane & 15, q = lane >> 4;
    for (int unit = blockIdx.x; unit < 128; unit += gridDim.x) {
        const int dir = unit >> 6, b = (unit >> 4) & 3, h = (unit >> 2) & 3, sl = unit & 3;
        bf16_t* O = (bf16_t*)(p.ws + (dir ? WS_OB : WS_OF));
        const long tstep = dir ? -1 : 1;
        f32x4 S0 = {0.f, 0.f, 0.f, 0.f}, S1 = {0.f, 0.f, 0.f, 0.f};
        u32x4 rwA[2], rqA[2], rkA[2], raA, ruA = {0u, 0u, 0u, 0u}; float g0A = 0.f, g1A = 0.f, gLA = 0.f;
        u32x4 rwB[2], rqB[2], rkB[2], raB, ruB = {0u, 0u, 0u, 0u}; float g0B = 0.f, g1B = 0.f, gLB = 0.f;
#define D2_TOK0(n) ((long)b * S_ + (dir ? (S_ - 1 - (n) * 64) : (n) * 64))
#define D2_LOAD(n, X) do { const long t0_ = D2_TOK0(n); \
        _Pragma("unroll") for (int i = 0; i < 2; ++i) { const int pi = tid + NTHR * i, l = pi >> 4, c8 = pi & 15; const long tk = t0_ + l * tstep; \
            rw##X[i] = *(const u32x4*)(Z + tk * 3072 + 1024 + dir * 512 + h * 128 + c8 * 8); \
            rq##X[i] = *(const u32x4*)(QKVN + tk * 1536 + h * 128 + c8 * 8); rk##X[i] = *(const u32x4*)(QKVN + tk * 1536 + 512 + h * 128 + c8 * 8); } \
        { const int l = tid >> 3, c8 = tid & 7; ra##X = *(const u32x4*)(Z + (t0_ + l * tstep) * 3072 + 2048 + dir * 256 + h * 64 + c8 * 8); } \
        if (tid < 256) { const int l = tid >> 2, c8 = tid & 3; ru##X = *(const u32x4*)(Z + (t0_ + l * tstep) * 3072 + dir * 512 + h * 128 + sl * 32 + c8 * 8); } \
        g0##X = GB[((size_t)dir * T_ + (t0_ + (tid >> 4) * tstep)) * 4 + h]; g1##X = GB[((size_t)dir * T_ + (t0_ + ((tid >> 4) + 32) * tstep)) * 4 + h]; \
        gL##X = GB[((size_t)dir * T_ + (t0_ + 63 * tstep)) * 4 + h]; } while (0)
#define D2_ITER(n, X) do { \
            const float egL = __expf(gL##X); \
            _Pragma("unroll") for (int i = 0; i < 2; ++i) { const int pi = tid + NTHR * i, l = pi >> 4, c8 = pi & 15; const float gl_ = i == 0 ? g0##X : g1##X; \
                *(LAS u32x4*)(Wb + l * 136 + c8 * 8) = rw##X[i]; \
                float f[8]; unpack8(rq##X[i], f); const float eg = __expf(gl_); \
                u32x4 o; o.x = pk2(f[0] * eg, f[1] * eg); o.y = pk2(f[2] * eg, f[3] * eg); o.z = pk2(f[4] * eg, f[5] * eg); o.w = pk2(f[6] * eg, f[7] * eg); \
                *(LAS u32x4*)(Qg + l * 136 + c8 * 8) = o; \
                unpack8(rk##X[i], f); const float ek = __expf(gL##X - gl_); \
                o.x = pk2(f[0] * ek, f[1] * ek); o.y = pk2(f[2] * ek, f[3] * ek); o.z = pk2(f[4] * ek, f[5] * ek); o.w = pk2(f[6] * ek, f[7] * ek); \
                *(LAS u32x4*)(Kg + l * 144 + c8 * 8) = o; } \
            { const int l = tid >> 3, c8 = tid & 7; *(LAS u32x4*)(At + l * 72 + c8 * 8) = ra##X; } \
            if (tid < 256) { const int l = tid >> 2, c8 = tid & 3; *(LAS u32x4*)(Ub + l * 32 + c8 * 8) = ru##X; } \
            { u32x2 w0; w0.x = pk2(S0.x, S0.y); w0.y = pk2(S0.z, S0.w); *(LAS u32x2*)(St + r * 136 + wid * 16 + q * 4) = w0; \
              u32x2 w1; w1.x = pk2(S1.x, S1.y); w1.y = pk2(S1.z, S1.w); *(LAS u32x2*)(St + (16 + r) * 136 + wid * 16 + q * 4) = w1; } \
            __syncthreads(); \
            if ((n) + 2 < 64) D2_LOAD((n) + 2, X); \
            const int mt = wid >> 1, nt = wid & 1; \
            f32x4 p1 = {0.f, 0.f, 0.f, 0.f}, p2 = {0.f, 0.f, 0.f, 0.f}; \
            p1 = mma_tile<128>(Wb + mt * 16 * 136, 136, St + nt * 16 * 136, 136, p1); \
            p2 = mma_tile<128>(Qg + mt * 16 * 136, 136, St + nt * 16 * 136, 136, p2); \
            { const int l0 = mt * 16 + q * 4, v = nt * 16 + r; float vn[4]; \
              _Pragma("unroll") for (int i = 0; i < 4; ++i) vn[i] = bf2f(Ub[(l0 + i) * 32 + v]) - p1[i]; \
              u32x2 w; w.x = pk2(vn[0], vn[1]); w.y = pk2(vn[2], vn[3]); *(LAS u32x2*)(Vt + v * 72 + l0) = w; } \
            __syncthreads(); \
            p2 = mma_tile<64>(At + mt * 16 * 72, 72, Vt + nt * 16 * 72, 72, p2); \
            { const long t0_ = D2_TOK0(n); \
              _Pragma("unroll") for (int i = 0; i < 4; ++i) O[(t0_ + (mt * 16 + q * 4 + i) * tstep) * 512 + h * 128 + sl * 32 + nt * 16 + r] = f2bf(p2[i]); } \
            S0 = S0 * egL; S1 = S1 * egL; \
            { bf16x8_t ka0, ka1; tr_frag2((unsigned)(unsigned long long)Kg, 288, wid, ka0, ka1); \
              const bf16x8_t vb00 = *(const LAS bf16x8_t*)(Vt + r * 72 + q * 8), vb01 = *(const LAS bf16x8_t*)(Vt + r * 72 + 32 + q * 8); \
              const bf16x8_t vb10 = *(const LAS bf16x8_t*)(Vt + (16 + r) * 72 + q * 8), vb11 = *(const LAS bf16x8_t*)(Vt + (16 + r) * 72 + 32 + q * 8); \
              S0 = __builtin_amdgcn_mfma_f32_16x16x32_bf16(ka0, vb00, S0, 0, 0, 0); S0 = __builtin_amdgcn_mfma_f32_16x16x32_bf16(ka1, vb01, S0, 0, 0, 0); \
              S1 = __builtin_amdgcn_mfma_f32_16x16x32_bf16(ka0, vb10, S1, 0, 0, 0); S1 = __builtin_amdgcn_mfma_f32_16x16x32_bf16(ka1, vb11, S1, 0, 0, 0); } \
            __syncthreads(); } while (0)
        D2_LOAD(0, A); D2_LOAD(1, B);
#pragma unroll 1
        for (int n = 0; n < 64; n += 2) { D2_ITER(n, A); D2_ITER(n + 1, B); }
#undef D2_ITER
#undef D2_LOAD
#undef D2_TOK0
    }
}
constexpr size_t WS_CT = WS_OF, WS_NV = 235 * MiB, WS_MS = 235 * MiB + 524288, WS_CT2 = 169 * MiB, WS_NV2 = 236 * MiB;
__device__ __forceinline__ void mlstm_a(LDSp lds, const Params& p) {
    const bf16_t* Z = (const bf16_t*)(p.ws + WS_Z); const float* LI = (const float*)(p.ws + WS_BETA); const float* LF = (const float*)(p.ws + WS_LA);
    bf16_t* CT = (bf16_t*)(p.ws + WS_CT); float* NV = (float*)(p.ws + WS_NV); float* MS = (float*)(p.ws + WS_MS);
    LAS unsigned short* Ks = (LAS unsigned short*)lds;
    LAS unsigned short* Vr = (LAS unsigned short*)(lds + 9216);
    LAS float* lf = (LAS float*)(lds + 27648); LAS float* li = lf + 64; LAS float* sw = lf + 128; LAS float* red = lf + 192  ;
    const int tid = threadIdx.x, lane = tid & 63, wid = tid >> 6, r = lane & 15, q = lane >> 4;
    for (int unit = blockIdx.x; unit < 2048; unit += gridDim.x) {
        const int dir = unit >> 10, b = (unit >> 8) & 3, h = (unit >> 6) & 3, n = unit & 63, pc = dir ? 63 - n : n;
        const size_t tok0 = (size_t)b * S_ + pc * 64;
        if (tid < 64) { lf[tid] = LF[(tok0 + tid) * 8 + dir * 4 + h]; li[tid] = LI[(tok0 + tid) * 8 + dir * 4 + h]; }
        __syncthreads();
        if (tid < 64) { const float bc = wave_scan_sum(lf[tid], dir == 0);
            const float tot = __shfl(bc, dir ? 0 : 63);
            const float we = tot - bc + li[tid]; float mx = we;
#pragma unroll
            for (int o = 32; o; o >>= 1) mx = fmaxf(mx, __shfl_xor(mx, o));
            sw[tid] = __expf(we - mx);
            if (tid == 0) { MS[unit * 32] = tot; MS[unit * 32 + 1] = mx; } }
        __syncthreads();
        { const int pp = tid >> 3, c8 = tid & 7; const u32x4 kv = *(const u32x4*)(Z + (tok0 + pp) * 2560 + 1280 + h * 64 + c8 * 8); float f[8]; unpack8(kv, f); const float s = sw[pp];
          u32x4 o; o.x = pk2(f[0] * s, f[1] * s); o.y = pk2(f[2] * s, f[3] * s); o.z = pk2(f[4] * s, f[5] * s); o.w = pk2(f[6] * s, f[7] * s);
          *(LAS u32x4*)(Ks + pp * 72 + c8 * 8) = o; }
#pragma unroll
        for (int i = 0; i < 2; ++i) { const int pi = tid + NTHR * i, pp = pi >> 4, c8 = pi & 15;
            *(LAS u32x4*)(Vr + pp * 144 + c8 * 8) = *(const u32x4*)(Z + (tok0 + pp) * 2560 + 1536 + h * 128 + c8 * 8); }
        __syncthreads();
        { bf16x8_t vb0, vb1; tr_frag2((unsigned)(unsigned long long)Vr, 288, wid, vb0, vb1);
#pragma unroll
          for (int dt = 0; dt < 4; ++dt) { bf16x8_t ka0, ka1; tr_frag2((unsigned)(unsigned long long)Ks, 144, dt, ka0, ka1);
            f32x4 acc = {0.f, 0.f, 0.f, 0.f};
            acc = __builtin_amdgcn_mfma_f32_16x16x32_bf16(ka0, vb0, acc, 0, 0, 0); acc = __builtin_amdgcn_mfma_f32_16x16x32_bf16(ka1, vb1, acc, 0, 0, 0);
            u32x2 w; w.x = pk2(acc.x, acc.y); w.y = pk2(acc.z, acc.w);
            *(u32x2*)(CT + (size_t)unit * 8192 + (wid * 16 + r) * 64 + dt * 16 + q * 4) = w; } }
        { const int d = tid & 63; float a = 0.f;
#pragma unroll
          for (int j = 0; j < 8; ++j) a += bf2f(Ks[(wid * 8 + j) * 72 + d]);
          red[wid * 64 + d] = a; }
        __syncthreads();
        if (tid < 64) { float a = 0.f;
#pragma unroll
            for (int w = 0; w < 8; ++w) a += red[w * 64 + tid];
            NV[(size_t)unit * 64 + tid] = a; }
        __syncthreads();
    }
}
__device__ __forceinline__ void mlstm_b(const Params& p) {
    const bf16_t* CT = (const bf16_t*)(p.ws + WS_CT); const float* NV = (const float*)(p.ws + WS_NV); float* MS = (float*)(p.ws + WS_MS); bf16_t* CT2 = (bf16_t*)(p.ws + WS_CT2); float* NV2 = (float*)(p.ws + WS_NV2);
    const int tid = threadIdx.x;
    for (int wgi = blockIdx.x; wgi < 128; wgi += gridDim.x) {
        const int scan = wgi >> 2, part = wgi & 3; const size_t e = (size_t)(part * NTHR + tid) * 4;
        const bool nvw = (part == 0 && tid < 64);
        float m = 0.f, c0 = 0.f, c1 = 0.f, c2 = 0.f, c3 = 0.f, nn = 0.f;
#pragma unroll 1
        for (int hf = 0; hf < 4; ++hf) {
        u32x2 dc[16]; float dn[16], blv[16], mlv[16];
#pragma unroll
        for (int n = 0; n < 16; ++n) { blv[n] = MS[(scan * 64 + hf * 16 + n) * 32]; mlv[n] = MS[(scan * 64 + hf * 16 + n) * 32 + 1]; dc[n] = (EXPC == 2) ? (u32x2){0u, 0u} : *(const u32x2*)(CT + (size_t)(scan * 64 + hf * 16 + n) * 8192 + e); dn[n] = nvw ? NV[(size_t)(scan * 64 + hf * 16 + n) * 64 + tid] : 0.f; }
#pragma unroll
        for (int n = 0; n < 16; ++n) { const int unit = scan * 64 + hf * 16 + n;
            const float bl = blv[n], ml = mlv[n];
            u32x2 w; w.x = pk2(c0, c1); w.y = pk2(c2, c3); *(u32x2*)(CT2 + (size_t)unit * 8192 + e) = w;
            if (nvw) NV2[(size_t)unit * 64 + tid] = nn;
            if (part == 0 && tid == 0) MS[65536 + unit] = m;
            const float mn = fmaxf(bl + m, ml), a = __expf(bl + m - mn), bb = __expf(ml - mn);
            c0 = a * c0 + bb * bflo(dc[n].x); c1 = a * c1 + bb * bfhi(dc[n].x); c2 = a * c2 + bb * bflo(dc[n].y); c3 = a * c3 + bb * bfhi(dc[n].y);
            nn = a * nn + bb * dn[n]; m = mn; }
        }
    }
}
__device__ __forceinline__ void mlstm_c(LDSp lds, const Params& p) {
    const bf16_t* Z = (const bf16_t*)(p.ws + WS_Z); const float* LI = (const float*)(p.ws + WS_BETA); const float* LF = (const float*)(p.ws + WS_LA);
    const bf16_t* CT = (const bf16_t*)(p.ws + WS_CT2); const float* NV = (const float*)(p.ws + WS_NV2); const float* MS = (const float*)(p.ws + WS_MS);
    bf16_t* Y = (bf16_t*)(p.ws + WS_HN); const float* gn = p.in[19];
    LAS unsigned short* Qb = (LAS unsigned short*)lds;
    LAS unsigned short* Kb = (LAS unsigned short*)(lds + 9216);
    LAS unsigned short* Vr = (LAS unsigned short*)(lds + 18432);
    LAS float* ssp = (LAS float*)(lds + 100352);
#define MC_CB(d) ((LAS unsigned short*)(lds + 36864 + (d) * 18432))
#define MC_PB(d) ((LAS unsigned short*)(lds + 73728 + (d) * 9216))
#define MC_SC(d) ((LAS float*)(lds + 92160 + (d) * 4096))
    const int tid = threadIdx.x, wid = tid >> 6;
    for (int unit = blockIdx.x; unit < 1024; unit += gridDim.x) {
        int lane = tid & 63; asm volatile("" : "+v"(lane));
        const int r = lane & 15, q = lane >> 4;
        const int b = unit >> 8, h = (unit >> 6) & 3, pc = unit & 63; const size_t tok0 = (size_t)b * S_ + pc * 64;
        const size_t ua = (size_t)(((0 * 4 + b) * 4 + h) * 64 + pc), ub = (size_t)(((1 * 4 + b) * 4 + h) * 64 + (63 - pc));
        { const int pp = tid >> 3, c8 = tid & 7;
          *(LAS u32x4*)(Qb + pp * 72 + c8 * 8) = *(const u32x4*)(Z + (tok0 + pp) * 2560 + 1024 + h * 64 + c8 * 8);
          *(LAS u32x4*)(Kb + pp * 72 + c8 * 8) = *(const u32x4*)(Z + (tok0 + pp) * 2560 + 1280 + h * 64 + c8 * 8); }
#pragma unroll
        for (int i = 0; i < 2; ++i) { const int pi = tid + NTHR * i, pp = pi >> 4, c8 = pi & 15; *(LAS u32x4*)(Vr + pp * 144 + c8 * 8) = *(const u32x4*)(Z + (tok0 + pp) * 2560 + 1536 + h * 128 + c8 * 8); }
#pragma unroll
        for (int i = 0; i < 2; ++i) { const int pi = tid + NTHR * i, v = pi >> 3, c8 = pi & 7;
            *(LAS u32x4*)(MC_CB(0) + v * 72 + c8 * 8) = *(const u32x4*)(CT + ua * 8192 + v * 64 + c8 * 8); *(LAS u32x4*)(MC_CB(1) + v * 72 + c8 * 8) = *(const u32x4*)(CT + ub * 8192 + v * 64 + c8 * 8); }
        float mst = 0.f;
        if (tid < 128) { const int d = tid >> 6; const size_t ud = d ? ub : ua; LAS float* sc = MC_SC(d);
            sc[lane] = LF[(tok0 + lane) * 8 + d * 4 + h]; sc[64 + lane] = LI[(tok0 + lane) * 8 + d * 4 + h]; sc[384 + lane] = NV[ud * 64 + lane]; mst = MS[65536 + ud]; }
        __syncthreads();
        bf16x8_t vb0, vb1; tr_frag2((unsigned)(unsigned long long)Vr, 288, wid, vb0, vb1);
        {
            const int t = tid >> 3, part = tid & 7; const u32x4 qv = *(const LAS u32x4*)(Qb + t * 72 + part * 8); float f[8]; unpack8(qv, f);
#pragma unroll
            for (int d = 0; d < 2; ++d) { LAS float* sc = MC_SC(d);
                const f32x4 n0 = *(const LAS f32x4*)(sc + 384 + part * 8), n1 = *(const LAS f32x4*)(sc + 384 + part * 8 + 4);
                float a = f[0] * n0.x; a = fmaf(f[1], n0.y, a); a = fmaf(f[2], n0.z, a); a = fmaf(f[3], n0.w, a); a = fmaf(f[4], n1.x, a); a = fmaf(f[5], n1.y, a); a = fmaf(f[6], n1.z, a); a = fmaf(f[7], n1.w, a);
                a += dppf<0xB1>(a); a += dppf<0x4E>(a); a += dppf<0x141>(a);
                if (part == 0) sc[320 + t] = a; } }
        if (tid < 128) {
            const int d = tid >> 6; LAS float* sc = MC_SC(d);
            const float bt = wave_scan_sum(sc[lane], d == 0);
            const float dmax = bt + wave_scan_max(sc[64 + lane] - bt, d == 0);
            const float m = fmaxf(bt + mst, dmax), w = __expf(bt + mst - m);
            sc[128 + lane] = bt; sc[192 + lane] = m; sc[256 + lane] = w * 0.125f; sc[448 + lane] = __expf(-m); }
        __syncthreads();
#pragma unroll 1
        for (int tt = 0; tt < 2; ++tt) { const int idx = wid * 2 + tt, mt = idx >> 2, nt = idx & 3;
            f32x4 scv = {0.f, 0.f, 0.f, 0.f};
            scv = mma_tile<64>(Qb + mt * 16 * 72, 72, Kb + nt * 16 * 72, 72, scv);
            const int s_ = nt * 16 + r;
#pragma unroll 1
            for (int d = 0; d < 2; ++d) { LAS float* sc = MC_SC(d); LAS unsigned short* Pb = MC_PB(d); const float bs = sc[128 + s_] - sc[64 + s_];
#pragma unroll
                for (int i = 0; i < 4; ++i) { const int t = mt * 16 + q * 4 + i; const bool ok = d ? (s_ >= t) : (s_ <= t);
                    const float pv = ok ? __expf(sc[128 + t] - bs - sc[192 + t]) * scv[i] * 0.125f : 0.f;
                    const unsigned short pb = f2bf(pv); Pb[t * 72 + s_] = pb;
                    const float rs = row16_sum(bf2f(pb));
                    if (r == 0) sc[512 + nt * 64 + t] = rs; } }
        }
        __syncthreads();
        f32x4 hacc[4];
#pragma unroll
        for (int mt = 0; mt < 4; ++mt) { hacc[mt] = (f32x4){0.f, 0.f, 0.f, 0.f};
            const bf16x8_t qa0 = *(const LAS bf16x8_t*)(Qb + (mt * 16 + r) * 72 + q * 8), qa1 = *(const LAS bf16x8_t*)(Qb + (mt * 16 + r) * 72 + 32 + q * 8);
#pragma unroll 1
            for (int d = 0; d < 2; ++d) { const LAS float* sc = MC_SC(d); const LAS unsigned short* Pb = MC_PB(d); const LAS unsigned short* Cb = MC_CB(d);
                f32x4 a1 = {0.f, 0.f, 0.f, 0.f}, a2 = {0.f, 0.f, 0.f, 0.f};
                const bf16x8_t cb0 = *(const LAS bf16x8_t*)(Cb + (wid * 16 + r) * 72 + q * 8), cb1 = *(const LAS bf16x8_t*)(Cb + (wid * 16 + r) * 72 + 32 + q * 8);
                a1 = __builtin_amdgcn_mfma_f32_16x16x32_bf16(qa0, cb0, a1, 0, 0, 0); a1 = __builtin_amdgcn_mfma_f32_16x16x32_bf16(qa1, cb1, a1, 0, 0, 0);
                const bf16x8_t pa0 = *(const LAS bf16x8_t*)(Pb + (mt * 16 + r) * 72 + q * 8), pa1 = *(const LAS bf16x8_t*)(Pb + (mt * 16 + r) * 72 + 32 + q * 8);
                a2 = __builtin_amdgcn_mfma_f32_16x16x32_bf16(pa0, vb0, a2, 0, 0, 0); a2 = __builtin_amdgcn_mfma_f32_16x16x32_bf16(pa1, vb1, a2, 0, 0, 0);
#pragma unroll
                for (int i = 0; i < 4; ++i) { const int t = mt * 16 + q * 4 + i;
                    const float den = sc[256 + t] * sc[320 + t] + ((sc[512 + t] + sc[576 + t]) + (sc[640 + t] + sc[704 + t]));
                    hacc[mt][i] += (sc[256 + t] * a1[i] + a2[i]) * __builtin_amdgcn_rcpf(fmaxf(fabsf(den), sc[448 + t])); }
            }
        }
#pragma unroll
        for (int mt = 0; mt < 4; ++mt)
#pragma unroll
            for (int i = 0; i < 4; ++i) { const float s = row16_sum(hacc[mt][i] * hacc[mt][i]); if (r == 0) ssp[wid * 64 + mt * 16 + q * 4 + i] = s; }
        __syncthreads();
        { const int v = wid * 16 + r; const float g = gn[v]; LAS unsigned short* Yt = MC_CB(0);
#pragma unroll
          for (int mt = 0; mt < 4; ++mt)
#pragma unroll
              for (int i = 0; i < 4; ++i) { const int t = mt * 16 + q * 4 + i;
                  float ss = 0.f;
#pragma unroll
                  for (int w = 0; w < 8; ++w) ss += ssp[w * 64 + t];
                  const float rstd = rsqrtf(ss * (1.0f / 128.0f) + 1e-6f);
                  Yt[t * 136 + v] = f2bf(hacc[mt][i] * rstd * g); } }
        __syncthreads();
#pragma unroll
        for (int i = 0; i < 2; ++i) { const int pi = tid + NTHR * i, t = pi >> 4, c8 = (pi & 15) * 8;
            const u32x4 yv = *(const LAS u32x4*)(MC_CB(0) + t * 136 + c8); const u32x4 ov = *(const u32x4*)(Z + (tok0 + t) * 2560 + 2048 + h * 128 + c8);
            float y[8], o[8]; unpack8(yv, y); unpack8(ov, o);
            u32x4 w; w.x = pk2(y[0] * sigm_f(o[0]), y[1] * sigm_f(o[1])); w.y = pk2(y[2] * sigm_f(o[2]), y[3] * sigm_f(o[3])); w.z = pk2(y[4] * sigm_f(o[4]), y[5] * sigm_f(o[5])); w.w = pk2(y[6] * sigm_f(o[6]), y[7] * sigm_f(o[7]));
            *(u32x4*)(Y + (tok0 + t) * 1024 + 512 + h * 128 + c8) = w; }
        __syncthreads();
    }
#undef MC_CB
#undef MC_PB
#undef MC_SC
}
__device__ __forceinline__ void headnorm_phase(const Params& p, const float* __restrict__ g, int zld, int zcol, int act) {
    const bf16_t* OF = (const bf16_t*)(p.ws + WS_OF); const bf16_t* OB = (const bf16_t*)(p.ws + WS_OB); const bf16_t* Z = (const bf16_t*)(p.ws + WS_Z); bf16_t* Y = (bf16_t*)(p.ws + WS_HN);
    const int tid = threadIdx.x, lane = tid & 63, wid = tid >> 6, c = lane * 8;
    const f32x4 g0 = *(const f32x4*)(g + (c & 127)), g1 = *(const f32x4*)(g + (c & 127) + 4);
    for (int tok = blockIdx.x * 8 + wid; tok < T_; tok += gridDim.x * 8) {
        const u32x4 a = *(const u32x4*)(OF + (size_t)tok * 512 + c), bq = *(const u32x4*)(OB + (size_t)tok * 512 + c), gz = *(const u32x4*)(Z + (size_t)tok * zld + zcol + c);
        float fa[8], fb[8], fg[8], o[8]; unpack8(a, fa); unpack8(bq, fb); unpack8(gz, fg);
        float ss = 0.f;
#pragma unroll
        for (int i = 0; i < 8; ++i) { o[i] = fa[i] + fb[i]; ss = fmaf(o[i], o[i], ss); }
        ss = row16_sum(ss);
        const float rstd = rsqrtf(ss * (1.0f / 128.0f) + 1e-6f);
        const float gg[8] = {g0.x, g0.y, g0.z, g0.w, g1.x, g1.y, g1.z, g1.w};
        float y[8];
#pragma unroll
        for (int i = 0; i < 8; ++i) y[i] = o[i] * rstd * gg[i] * (act == 0 ? fg[i] * sigm_f(fg[i]) : sigm_f(fg[i]));
        u32x4 w; w.x = pk2(y[0], y[1]); w.y = pk2(y[2], y[3]); w.z = pk2(y[4], y[5]); w.w = pk2(y[6], y[7]);
        *(u32x4*)(Y + (size_t)tok * 1024 + 512 + c) = w;
    }
}

__device__ __forceinline__ void odd_prep(const Params& p) {
    const bf16_t* Z = (const bf16_t*)(p.ws + WS_Z); bf16_t* VV = (bf16_t*)(p.ws + WS_QKV);
    const float* gates = (const float*)(p.ws + WS_GATES); float* LI = (float*)(p.ws + WS_BETA); float* LF = (float*)(p.ws + WS_LA);
    const float* ln_g = p.in[13]; const float* ln_b = p.in[14]; const float* ib = p.in[17]; const float* fb = p.in[18];
    const int tid = threadIdx.x, lane = tid & 63, wid = tid >> 6, c = lane * 8;
    const f32x4 g0 = *(const f32x4*)(ln_g + c), g1 = *(const f32x4*)(ln_g + c + 4), b0 = *(const f32x4*)(ln_b + c), b1 = *(const f32x4*)(ln_b + c + 4);
    const float gg[8] = {g0.x, g0.y, g0.z, g0.w, g1.x, g1.y, g1.z, g1.w}, bb[8] = {b0.x, b0.y, b0.z, b0.w, b1.x, b1.y, b1.z, b1.w};
    for (int tok = blockIdx.x * 8 + wid; tok < T_; tok += gridDim.x * 8) {
        const u32x4 v = *(const u32x4*)(Z + (size_t)tok * 2560 + 512 + c);
        float x[8]; unpack8(v, x); float sm = 0.f;
#pragma unroll
        for (int i = 0; i < 8; ++i) { x[i] = gelu_t(x[i]); sm += x[i]; }
        const float mean = wave_sum(sm) * (1.0f / 512.0f); float sq = 0.f;
#pragma unroll
        for (int i = 0; i < 8; ++i) { x[i] -= mean; sq = fmaf(x[i], x[i], sq); }
        const float rstd = rsqrtf(wave_sum(sq) * (1.0f / 512.0f) + 1e-5f);
        float y[8];
#pragma unroll
        for (int i = 0; i < 8; ++i) y[i] = x[i] * rstd * gg[i] + bb[i];
        u32x4 w; w.x = pk2(y[0], y[1]); w.y = pk2(y[2], y[3]); w.z = pk2(y[4], y[5]); w.w = pk2(y[6], y[7]);
        *(u32x4*)(VV + (size_t)tok * 512 + c) = w;
        if (lane < 8) { LI[(size_t)tok * 8 + lane] = gates[(size_t)tok * 16 + lane] + ib[lane];
                        LF[(size_t)tok * 8 + lane] = -softplus_(-(gates[(size_t)tok * 16 + 8 + lane] + fb[lane])); }
    }
}

__device__ __forceinline__ void sg_phase(LDSp lds, const Params& p, int sgId, int sgG) {
    typedef short bf16x8 __attribute__((ext_vector_type(8)));
    const bf16_t* Z = (const bf16_t*)(p.ws + WS_Z); const bf16_t* VV = (const bf16_t*)(p.ws + WS_QKV); bf16_t* Y = (bf16_t*)(p.ws + WS_HN);
    const float* sgw = p.in[15]; const float* sgb = p.in[16];
    LAS unsigned short* Wb = (LAS unsigned short*)lds;
    LAS unsigned short* Vt = (LAS unsigned short*)(lds + 34816);
    const int tid = threadIdx.x, lane = tid & 63, wid = tid >> 6;
    for (int unit = sgId; unit < 512; unit += sgG) {
        const int g = unit & 3, n = (unit >> 2) & 31, b = unit >> 7; const size_t tok0 = (size_t)b * S_ + n * 128;
#pragma unroll
        for (int i = 0; i < 8; ++i) { const int i4 = tid + NTHR * i, t = i4 >> 5, s4 = (i4 & 31) << 2; const f32x4 w = *(const f32x4*)(sgw + (size_t)g * 16384 + t * 128 + s4);
            u32x2 o; o.x = pk2(w.x, w.y); o.y = pk2(w.z, w.w); *(LAS u32x2*)(Wb + t * 136 + s4) = o; }
#pragma unroll
        for (int i = 0; i < 4; ++i) { const int pi = tid + NTHR * i, s = pi >> 4, c8 = (pi & 15) << 3; const u32x4 v = *(const u32x4*)(VV + (tok0 + s) * 512 + g * 128 + c8);
            Vt[(c8 + 0) * 136 + s] = (unsigned short)(v.x & 0xffffu); Vt[(c8 + 1) * 136 + s] = (unsigned short)(v.x >> 16);
            Vt[(c8 + 2) * 136 + s] = (unsigned short)(v.y & 0xffffu); Vt[(c8 + 3) * 136 + s] = (unsigned short)(v.y >> 16);
            Vt[(c8 + 4) * 136 + s] = (unsigned short)(v.z & 0xffffu); Vt[(c8 + 5) * 136 + s] = (unsigned short)(v.z >> 16);
            Vt[(c8 + 6) * 136 + s] = (unsigned short)(v.w & 0xffffu); Vt[(c8 + 7) * 136 + s] = (unsigned short)(v.w >> 16); }
        __syncthreads();
        bf16x8 af[4];
#pragma unroll
        for (int ks = 0; ks < 4; ++ks) af[ks] = *(const LAS bf16x8*)(Wb + (16 * wid + (lane & 15)) * 136 + ks * 32 + (lane >> 4) * 8);
        f32x4 accs[8];
#pragma unroll
        for (int nn = 0; nn < 8; ++nn) {
            f32x4 acc = {0.f, 0.f, 0.f, 0.f};
#pragma unroll
            for (int ks = 0; ks < 4; ++ks) { const bf16x8 bfrag = *(const LAS bf16x8*)(Vt + (16 * nn + (lane & 15)) * 136 + ks * 32 + (lane >> 4) * 8);
                acc = __builtin_amdgcn_mfma_f32_16x16x32_bf16(af[ks], bfrag, acc, 0, 0, 0); }
            accs[nn] = acc; }
        __syncthreads();
#pragma unroll
        for (int nn = 0; nn < 8; ++nn)
#pragma unroll
            for (int i = 0; i < 4; ++i) { const int t = 16 * wid + (lane >> 4) * 4 + i; Wb[t * 136 + 16 * nn + (lane & 15)] = f2bf(accs[nn][i] + sgb[g * 128 + t]); }
        __syncthreads();
#pragma unroll
        for (int i = 0; i < 4; ++i) { const int pi = tid + NTHR * i, t = pi >> 4, c8 = (pi & 15) << 3; const size_t tok = tok0 + t;
            const u32x4 mv = *(const LAS u32x4*)(Wb + t * 136 + c8); const u32x4 uv = *(const u32x4*)(Z + tok * 2560 + g * 128 + c8);
            float m[8], u[8]; unpack8(mv, m); unpack8(uv, u);
            u32x4 w; w.x = pk2(gelu_t(u[0]) * m[0], gelu_t(u[1]) * m[1]); w.y = pk2(gelu_t(u[2]) * m[2], gelu_t(u[3]) * m[3]); w.z = pk2(gelu_t(u[4]) * m[4], gelu_t(u[5]) * m[5]); w.w = pk2(gelu_t(u[6]) * m[6], gelu_t(u[7]) * m[7]);
            *(u32x4*)(Y + tok * 1024 + g * 128 + c8) = w; }
        __syncthreads();
    }
}

#define XB_TMO      128
#define XB_XCNT(j)  (256  + 64 * (j))
#define XB_XSUB(j)  (1280 + 64 * (j))
#define XB_XGEN(j)  (2304 + 64 * (j))
#define XB_TOP      3328
#define XB_TOPGEN   3392
#define XCD_BAR_WORDS 3456
#define XB_SPIN_CAP (1u << 18)

__device__ __forceinline__ unsigned xb_ld(unsigned* p)              { return __hip_atomic_load(p, __ATOMIC_RELAXED, __HIP_MEMORY_SCOPE_AGENT); }
__device__ __forceinline__ unsigned xb_add(unsigned* p, unsigned v) { return __hip_atomic_fetch_add(p, v, __ATOMIC_RELAXED, __HIP_MEMORY_SCOPE_AGENT); }
__device__ __forceinline__ unsigned xb_xcc_id() { return (unsigned)__builtin_amdgcn_s_getreg((3 << 11) | 20) & 0xFu; }
#define XB_SPIN(cond, bar) do { unsigned _sp = 0; while (cond) { __builtin_amdgcn_s_sleep(1); \
    if ((++_sp & 255u) == 0u) { if (xb_ld(&(bar)[XB_TMO])) break; if (_sp > XB_SPIN_CAP) { atomicAdd(&(bar)[XB_TMO], 1u); break; } } } } while (0)

struct XcdBarrier {
    unsigned* bar; unsigned x;
    volatile LAS unsigned* st;
};

__device__ __forceinline__ XcdBarrier xcd_barrier_post(unsigned* bar, volatile LAS unsigned* st) {
    XcdBarrier b; b.bar = bar; b.x = xb_xcc_id(); b.st = st;
    if (threadIdx.x == 0) (void)xb_add(&bar[XB_XCNT(b.x)], 1u);
    return b;
}
__device__ __forceinline__ void xcd_barrier_complete(unsigned* bar, unsigned x, unsigned& nloc, unsigned& nx) {
    const unsigned G = gridDim.x * gridDim.y * gridDim.z;
    unsigned sum, cnt, mine, sp = 0u;
    for (;;) {
        sum = 0u; cnt = 0u; mine = 0u;
#pragma unroll
        for (unsigned j = 0; j < 16; ++j) { const unsigned c = xb_ld(&bar[XB_XCNT(j)]); sum += c; cnt += (c > 0u) ? 1u : 0u; mine = (j == x) ? c : mine; }
        if (sum == G) break;
        __builtin_amdgcn_s_sleep(1);
        if ((++sp & 255u) == 0u) { if (xb_ld(&bar[XB_TMO])) break; if (sp > XB_SPIN_CAP) { atomicAdd(&bar[XB_TMO], 1u); break; } }
    }
    nloc = mine > 0u ? mine : 1u; nx = cnt > 0u ? cnt : 1u;
}

__device__ __forceinline__ void xcd_barrier(const XcdBarrier& b) {
    asm volatile("s_waitcnt vmcnt(0)" ::: "memory");
    __syncthreads();
    if (threadIdx.x == 0) {
        unsigned* bar = b.bar;
        __builtin_amdgcn_s_waitcnt(0);
        unsigned nloc = b.st[0], nx = b.st[1];
        if (nloc == 0u) { xcd_barrier_complete(bar, b.x, nloc, nx); b.st[0] = nloc; b.st[1] = nx; }
        const unsigned old = xb_add(&bar[XB_XSUB(b.x)], 1u);
        const unsigned gen = old / nloc;
        if (old + 1u == (gen + 1u) * nloc) {
            __builtin_amdgcn_fence(__ATOMIC_RELEASE, "agent");
            asm volatile("s_waitcnt vmcnt(0)" ::: "memory");
            const unsigned og = xb_add(&bar[XB_TOP], 1u);
            const unsigned tg = og / nx;
            if (og + 1u == (tg + 1u) * nx) xb_add(&bar[XB_TOPGEN], 1u);
            else XB_SPIN(xb_ld(&bar[XB_TOPGEN]) == tg, bar);
            __builtin_amdgcn_fence(__ATOMIC_ACQUIRE, "agent");
            xb_add(&bar[XB_XGEN(b.x)], 1u);
            asm volatile("s_waitcnt vmcnt(0)" ::: "memory");
        } else {
            XB_SPIN(xb_ld(&bar[XB_XGEN(b.x)]) == gen, bar);
            __builtin_amdgcn_fence(__ATOMIC_ACQUIRE, "agent");
            asm volatile("s_waitcnt vmcnt(0)" ::: "memory");
        }
    }
    __syncthreads();
}
constexpr size_t WS_BAR = 238 * MiB;
#ifndef N_PHASES
#define N_PHASES 21
#endif
template <int L, int SUB> __device__ __forceinline__ void run_phase(LDSp lds, const Params& p) {
    unsigned char* ws = p.ws;
    bf16_t* HN = (bf16_t*)(ws + WS_HN); bf16_t* Zb = (bf16_t*)(ws + WS_Z); float* h = p.out; float* gates = (float*)(ws + WS_GATES);
    const bf16_t* W_IN = (const bf16_t*)(ws + WS_WB + WB_IN); const bf16_t* W_OUT = (const bf16_t*)(ws + WS_WB + WB_OUT);
    const bf16_t* W_UP = (const bf16_t*)(ws + WS_WB + WB_UP); const bf16_t* W_DN = (const bf16_t*)(ws + WS_WB + WB_DN);
    const int G = gridDim.x;
    if constexpr (L == 2) { rms_phase(lds, h, p.in[25], nullptr, nullptr, h, nullptr, 0, 0, nullptr); }
    else if constexpr (SUB == 0) {
        convert_layer(lds, p, L);
        if constexpr (L == 0) rms_phase(lds, p.in[0], p.in[1], HN, nullptr, nullptr, p.in[2], 3088, 3072, gates);
        else                  rms_phase(lds, h, p.in[1] + 1024, HN, nullptr, nullptr, p.in[12], 2576, 2560, gates);
    } else if constexpr (SUB == 1) { constexpr int N = L == 0 ? 3072 : 2560;
        pg8::Gemm g{HN, W_IN, T_, N, 1024}; pg8::StaticOrder S; S.init(T_, N, G, (int)blockIdx.x);
        pg8::EpiBf16<0> E{Zb, N, nullptr, 0, 0};
        pg8::gemm_phase_sp2<pg8::EpiBf16<0>, pg8::StaticOrder, true, true>(lds, g, S, E);
    } else if constexpr (SUB == 2) { if constexpr (L == 0) even_prep(lds, p); else odd_prep(p); }
    else if constexpr (SUB == 9) { delta_prep(lds, p); }
    else if constexpr (SUB == 10) { mlstm_b(p); }
    else if constexpr (SUB == 11) { mlstm_c(lds, p); }
    else if constexpr (SUB == 3) {
        if constexpr (L == 0) delta_scan2(lds, p);
        else { mlstm_a(lds, p); sg_phase(lds, p, (int)blockIdx.x, G); }
    } else if constexpr (SUB == 4) { if constexpr (L == 0) headnorm_phase(p, p.in[10], 3072, 2560, 0); else headnorm_phase(p, p.in[19], 2560, 2048, 1); }
    else if constexpr (SUB == 5) { pg8::Gemm g{HN, W_OUT, T_, 1024, 1024}; pg8::StaticOrder S; S.init(T_, 1024, G, (int)blockIdx.x);
        pg8::EpiAddF32 E{h, 1024, L == 0 ? p.in[0] : (const float*)h};
        pg8::gemm_phase_sp2<pg8::EpiAddF32, pg8::StaticOrder, false, true>(lds, g, S, E);
    } else if constexpr (SUB == 6) { rms_phase(lds, h, p.in[21] + L * 1024, HN, nullptr, nullptr, nullptr, 0, 0, nullptr); }
    else if constexpr (SUB == 7) { pg8::Gemm g{HN, W_UP, T_, 2 * DFF, 1024}; pg8::StaticOrder S; S.init(T_, 2 * DFF, G, (int)blockIdx.x);
        pg8::EpiSwiGLU E{Zb, DFF};
        pg8::gemm_phase_sp2<pg8::EpiSwiGLU, pg8::StaticOrder, true, true>(lds, g, S, E);
    } else if constexpr (SUB == 8) { pg8::Gemm g{Zb, W_DN, T_, 1024, DFF}; pg8::StaticOrder S; S.init(T_, 1024, G, (int)blockIdx.x);
        pg8::EpiAddF32 E{h, 1024, (const float*)h};
        pg8::gemm_phase_sp2<pg8::EpiAddF32, pg8::StaticOrder, false, true>(lds, g, S, E);
    }
}
__global__ void __launch_bounds__(NTHR, 2) mega(Params p, int ph_lo, int ph_hi) {
    extern __shared__ __attribute__((aligned(16))) unsigned char lds_raw[];
    LDSp lds = (LDSp)lds_raw;
    cg::grid_group grid = cg::this_grid();
    volatile LAS unsigned* xst = (volatile LAS unsigned*)(lds + LDS_BYTES - 16);
    if (threadIdx.x == 0) { xst[0] = 0u; xst[1] = 0u; }
    __syncthreads();
    XcdBarrier xbar; xbar.bar = (unsigned*)(p.ws + WS_BAR); xbar.x = 0; xbar.st = xst;
    if (ph_hi - ph_lo > 1) xbar = xcd_barrier_post((unsigned*)(p.ws + WS_BAR), xst);
#ifndef REP_MASK
#define REP_MASK 0
#endif
#define PH(k, L, SUB) if (ph_lo <= (k) && (k) < ph_hi) { run_phase<L, SUB>(lds, p); if ((REP_MASK >> (k)) & 1) { __syncthreads(); run_phase<L, SUB>(lds, p); } if ((k) + 1 < ph_hi) { if (ph_lo < 0) grid.sync(); else xcd_barrier(xbar); } }
    PH(0, 0, 0) PH(1, 0, 1) PH(2, 0, 2) PH(3, 0, 9) PH(4, 0, 3) PH(5, 0, 4) PH(6, 0, 5) PH(7, 0, 6) PH(8, 0, 7) PH(9, 0, 8)
    PH(10, 1, 0) PH(11, 1, 1) PH(12, 1, 2) PH(13, 1, 3) PH(14, 1, 10) PH(15, 1, 11)
    PH(16, 1, 5) PH(17, 1, 6) PH(18, 1, 7) PH(19, 1, 8)
    PH(20, 2, 0)
#ifdef EXTRA_SYNCS
    for (int i_ = 0; i_ < EXTRA_SYNCS; ++i_) grid.sync();
#endif
#undef PH
}

extern "C" void kernel_launch(void* const* d_in, const int* in_sizes, int n_in, void* d_out, int out_size, void* d_ws, size_t ws_size, hipStream_t stream) {
    static int grid = 0;
    if (grid == 0) {
        int dev = 0, cus = 0, per_cu = 0;
        (void)hipGetDevice(&dev);
        (void)hipDeviceGetAttribute(&cus, hipDeviceAttributeMultiprocessorCount, dev);
        (void)hipFuncSetAttribute((const void*)mega, hipFuncAttributeMaxDynamicSharedMemorySize, LDS_BYTES);
        if (hipOccupancyMaxActiveBlocksPerMultiprocessor(&per_cu, (const void*)mega, NTHR, LDS_BYTES) != hipSuccess || per_cu < 1) per_cu = 1;
        (void)hipGetLastError();
        if (cus <= 0) cus = 256;
        grid = cus * per_cu;
    }
    if (ws_size < 239 * MiB) { fprintf(stderr, "workspace too small: %zu\n", ws_size); return; }
    Params p{};
    for (int i = 0; i < 26; ++i) p.in[i] = (const float*)d_in[i];
    p.out = (float*)d_out; p.ws = (unsigned char*)d_ws;
#if defined(MULTI_LAUNCH)
    for (int ph = 0; ph < N_PHASES; ++ph) hipLaunchKernelGGL(mega, dim3(grid), dim3(NTHR), LDS_BYTES, stream, p, ph, ph + 1);
#else
    (void)hipMemsetAsync((char*)d_ws + WS_BAR, 0, XCD_BAR_WORDS * 4, stream);
    int lo = 0, hi = N_PHASES;
    void* args[] = {(void*)&p, (void*)&lo, (void*)&hi};
    hipError_t e = hipLaunchCooperativeKernel((const void*)mega, dim3(grid), dim3(NTHR), args, LDS_BYTES, stream);
    if (e != hipSuccess) fprintf(stderr, "cooperative launch failed: %s (grid %d)\n", hipGetErrorString(e), grid);
#endif
}
```

```cpp
#include <hip/hip_runtime.h>
#include <hip/hip_cooperative_groups.h>
#include <cstdio>
namespace cg = cooperative_groups;
namespace pg8 {
#define PG8_LAS __attribute__((address_space(3)))
typedef unsigned short bf16_t;
typedef short bf16x8 __attribute__((ext_vector_type(8)));
typedef float f32x4 __attribute__((ext_vector_type(4)));
typedef unsigned u32x4 __attribute__((ext_vector_type(4)));
constexpr int BM = 256, BK = 64, HALF = 128, HTB = HALF * BK * 2  , STAGE_BYTES = 8 * HTB, NXCD = 8, WGM = 8;

__host__ __device__ __forceinline__ int lds_byte(int r, int c) { const int st = (r >> 4) * 2 + (c >> 5), rr = r & 15, cc = c & 31, ob = rr * 64 + cc * 2; return st * 1024 + (ob ^ (((ob >> 9) & 1) << 5)); }
__host__ __device__ __forceinline__ void stage_rc(int b, int& R, int& C) { const int st = b / 1024, sb = b % 1024, swz = sb ^ (((sb >> 9) & 1) << 5); R = (st >> 1) * 16 + swz / 64; C = (st & 1) * 32 + (swz % 64) / 2; }
__host__ __device__ __forceinline__ int perm32(int rho) { const int n = rho >> 4, i = rho & 15; return 8 * (i >> 2) + 4 * n + (i & 3); }

struct Unit { int pm, pn; };
struct Gemm { const bf16_t* A; const bf16_t* Bt; int M, N, K; };

struct StaticOrder {
    int nM, nN, nwg, G, c;
    __host__ __device__ void init(int M, int N, int G_, int c_) { nM = M / BM; nN = N / BM; nwg = nM * nN; G = G_; c = c_; }
    __host__ __device__ bool next(int i, Unit& u) const {
        const long L = (long)i * G + c; if (L >= nwg) return false;
        int wgid = (int)L; { const int q = nwg / NXCD, r = nwg % NXCD, xcd = wgid % NXCD, off = wgid / NXCD; wgid = (xcd < r ? xcd * (q + 1) : r * (q + 1) + (xcd - r) * q) + off; }
        const int nig = WGM * nN, gid = wgid / nig, fm = gid * WGM, gsz = (nM - fm) < WGM ? (nM - fm) : WGM;
        u.pm = fm + ((wgid % nig) % gsz); u.pn = (wgid % nig) / gsz; return true;
    }
    __device__ __forceinline__ void a_ready(const Unit&) const {}
    __device__ __forceinline__ void done(const Unit&) const {}
};
__device__ __forceinline__ unsigned cvt_pk_bf16(float lo, float hi) { unsigned r; asm volatile("v_cvt_pk_bf16_f32 %0, %1, %2" : "=v"(r) : "v"(lo), "v"(hi)); return r; }
typedef float f32x2 __attribute__((ext_vector_type(2)));
__device__ __forceinline__ f32x2 gelu_pk(f32x2 v) {
    const f32x2 av = __builtin_elementwise_abs(v), d = av * 0.2316418882f + 1.0f;
    f32x2 t; t.x = __builtin_amdgcn_rcpf(d.x); t.y = __builtin_amdgcn_rcpf(d.y);
    f32x2 q = t * 0.5307027145f + (-0.7265760135f); q = q * t + 0.7107068705f; q = q * t + (-0.142248368f); q = q * t + 0.127414796f; q = q * t;
    const f32x2 s = (v * v) * (-0.72134752044f);
    f32x2 e; e.x = __builtin_amdgcn_exp2f(s.x); e.y = __builtin_amdgcn_exp2f(s.y);
    const f32x2 m = v * (q * e), r = v - m;
    f32x2 o; o.x = v.x < 0.f ? m.x : r.x; o.y = v.y < 0.f ? m.y : r.y; return o;
}
template <int ACT  > struct EpiBf16 {
    static constexpr bool PERM = true, AFTER_DRAIN = false;
    bf16_t* O; int ldc; const float* bias; int split_cols; size_t split_stride;
    __device__ __forceinline__ void operator()(const f32x4 (&acc)[2][2][4][2], const Unit& u, int wr, int wc, int fr, int fq) const {
        const int row0 = u.pm * BM + wr * 64 + fr; int colt = u.pn * BM; bf16_t* base = O;
        if (split_cols) { const int t = colt / split_cols; base += (size_t)t * split_stride; colt -= t * split_cols; }
        const int col0 = colt + wc * 32 + 8 * fq, bcol0 = u.pn * BM + wc * 32 + 8 * fq;
        f32x4 bv[2][2];
#pragma unroll
        for (int bj = 0; bj < 2; ++bj)
#pragma unroll
            for (int n = 0; n < 2; ++n) bv[bj][n] = bias ? *(const f32x4*)(bias + bcol0 + bj * HALF + 4 * n) : (f32x4){0.f, 0.f, 0.f, 0.f};
#pragma unroll
        for (int ai = 0; ai < 2; ++ai)
#pragma unroll
            for (int m = 0; m < 4; ++m) { bf16_t* rowp = base + (size_t)(row0 + ai * HALF + m * 16) * ldc + col0;
#pragma unroll
                for (int bj = 0; bj < 2; ++bj) { f32x4 v0 = acc[ai][bj][m][0] + bv[bj][0], v1 = acc[ai][bj][m][1] + bv[bj][1];
                    if (ACT == 1) { f32x2 a = gelu_pk((f32x2){v0[0], v0[1]}), b = gelu_pk((f32x2){v0[2], v0[3]}), c = gelu_pk((f32x2){v1[0], v1[1]}), d = gelu_pk((f32x2){v1[2], v1[3]});
                        v0 = (f32x4){a.x, a.y, b.x, b.y}; v1 = (f32x4){c.x, c.y, d.x, d.y}; }
                    if (ACT == 2) {
#pragma unroll
                        for (int j = 0; j < 4; ++j) { v0[j] = 0.5f * v0[j] * (1.0f + erff(v0[j] * 0.70710678f)); v1[j] = 0.5f * v1[j] * (1.0f + erff(v1[j] * 0.70710678f)); } }
                    u32x4 w; w.x = cvt_pk_bf16(v0[0], v0[1]); w.y = cvt_pk_bf16(v0[2], v0[3]); w.z = cvt_pk_bf16(v1[0], v1[1]); w.w = cvt_pk_bf16(v1[2], v1[3]);
                    *(u32x4*)(rowp + bj * HALF) = w; } }
    }
};
struct EpiAddF32 {
    static constexpr bool PERM = false, AFTER_DRAIN = false;
    float* C; int ldc; const float* R;
    __device__ __forceinline__ void operator()(const f32x4 (&acc)[2][2][4][2], const Unit& u, int wr, int wc, int fr, int fq) const {
        const int row0 = u.pm * BM + wr * 64 + fr, col0 = u.pn * BM + wc * 32 + 4 * fq;
#pragma unroll
        for (int ai = 0; ai < 2; ++ai)
#pragma unroll
            for (int m = 0; m < 4; ++m) { const size_t ro = (size_t)(row0 + ai * HALF + m * 16) * ldc + col0; float* rowp = C + ro; const float* srcp = R + ro;
#pragma unroll
                for (int bj = 0; bj < 2; ++bj)
#pragma unroll
                    for (int n = 0; n < 2; ++n) { const f32x4 o = *(const f32x4*)(srcp + bj * HALF + n * 16); *(f32x4*)(rowp + bj * HALF + n * 16) = o + acc[ai][bj][m][n]; } }
    }
};
struct EpiSwiGLU {
    static constexpr bool PERM = true, AFTER_DRAIN = false;
    bf16_t* H; int ldh;
    __device__ __forceinline__ void operator()(const f32x4 (&acc)[2][2][4][2], const Unit& u, int wr, int wc, int fr, int fq) const {
        const int row0 = u.pm * BM + wr * 64 + fr, hcol = u.pn * HALF + wc * 32 + 8 * fq;
#pragma unroll
        for (int ai = 0; ai < 2; ++ai)
#pragma unroll
            for (int m = 0; m < 4; ++m) { bf16_t* rowp = H + (size_t)(row0 + ai * HALF + m * 16) * ldh + hcol;
                float h[8];
#pragma unroll
                for (int n = 0; n < 2; ++n) { const f32x4 a = acc[ai][0][m][n], b = acc[ai][1][m][n];
#pragma unroll
                    for (int j = 0; j < 4; ++j) h[4 * n + j] = a[j] * __builtin_amdgcn_rcpf(1.0f + __expf(-a[j])) * b[j]; }
                u32x4 w; w.x = cvt_pk_bf16(h[0], h[1]); w.y = cvt_pk_bf16(h[2], h[3]); w.z = cvt_pk_bf16(h[4], h[5]); w.w = cvt_pk_bf16(h[6], h[7]);
                *(u32x4*)rowp = w; }
    }
};
template <class Epi, class Sched, bool STAMP = false>
__device__ __forceinline__ void gemm_phase(PG8_LAS unsigned char* lds, const Gemm g, const Sched& S, const Epi& E, unsigned long long* stamps) {
    const int tid = threadIdx.x, wid = __builtin_amdgcn_readfirstlane(tid >> 6), lane = tid & 63, wr = wid >> 2, wc = wid & 3, fr = lane & 15, fq = lane >> 4;
    const int K = g.K, nt = K / BK;
    int ts_lo = 0, ts_hi = 0, nts = 0; const unsigned long long rt_entry = STAMP ? (unsigned long long)wall_clock64() : 0ull;
#define PG8_STAMP() do { if (STAMP && wid == 0 && nts < 64) { const unsigned long long _c = (unsigned long long)clock64(); \
        ts_lo = (lane == nts) ? (int)(unsigned)_c : ts_lo; ts_hi = (lane == nts) ? (int)(unsigned)(_c >> 32) : ts_hi; ++nts; } } while (0)
    PG8_STAMP();
    unsigned voffA[2], voffB[2];
#pragma unroll
    for (int i = 0; i < 2; ++i) { int R, C; stage_rc(tid * 16 + i * 8192, R, C); const int Rb = Epi::PERM ? ((R & ~31) + perm32(R & 31)) : R;
        voffA[i] = (unsigned)(R * K + C) * 2u; voffB[i] = (unsigned)(Rb * K + C) * 2u; }
    const size_t kstep = (size_t)(BK * 2);
    const size_t hstep = (size_t)HALF * K * 2;
    const size_t tstep = 2 * hstep;
    const unsigned ldsw = (unsigned)wid * 1024u;
    const int aoff = lds_byte(wr * 64 + fr, fq * 8), boff = lds_byte(wc * 32 + fr, fq * 8);
#define PG8_SA(b, h) (((b) * 2 + (h)) * HTB)
#define PG8_SB(b, h) ((4 + (b) * 2 + (h)) * HTB)
#define PG8_STAGE(bufoff, gbase, voff) do { _Pragma("unroll") for (int _i = 0; _i < 2; ++_i) \
        __builtin_amdgcn_global_load_lds((const unsigned*)((const char*)(gbase) + (voff)[_i]), (PG8_LAS unsigned*)(lds + (bufoff) + ldsw + _i * 8192), 16, 0, 0); } while (0)
#define PG8_LDA(dst, b, h) do { _Pragma("unroll") for (int m = 0; m < 4; ++m) _Pragma("unroll") for (int k = 0; k < 2; ++k) dst[m][k] = *(const PG8_LAS bf16x8*)(lds + PG8_SA(b, h) + aoff + m * 2048 + k * 1024); } while (0)
#define PG8_LDB(dst, b, h) do { _Pragma("unroll") for (int n = 0; n < 2; ++n) _Pragma("unroll") for (int k = 0; k < 2; ++k) dst[n][k] = *(const PG8_LAS bf16x8*)(lds + PG8_SB(b, h) + boff + n * 2048 + k * 1024); } while (0)
#define PG8_MMA(ai, bj, At, Bt) do { __builtin_amdgcn_s_setprio(1); _Pragma("unroll") for (int m = 0; m < 4; ++m) _Pragma("unroll") for (int n = 0; n < 2; ++n) _Pragma("unroll") for (int k = 0; k < 2; ++k) \
        acc[ai][bj][m][n] = __builtin_amdgcn_mfma_f32_16x16x32_bf16(Bt[n][k], At[m][k], acc[ai][bj][m][n], 0, 0, 0); __builtin_amdgcn_s_setprio(0); } while (0)
#define PG8_WAIT_V(n) asm volatile("s_waitcnt vmcnt(" #n ")" ::: "memory")
#define PG8_WAIT_L(n) asm volatile("s_waitcnt lgkmcnt(" #n ")" ::: "memory")
#define PG8_BAR __builtin_amdgcn_s_barrier()
#define PG8_SCHED __builtin_amdgcn_sched_barrier(0)
    Unit cur, nxt; int ui = 0;
    if (!S.next(0, cur)) return;
    f32x4 acc[2][2][4][2];
#pragma unroll
    for (int a = 0; a < 2; ++a)
#pragma unroll
        for (int b = 0; b < 2; ++b)
#pragma unroll
            for (int m = 0; m < 4; ++m)
#pragma unroll
                for (int n = 0; n < 2; ++n) acc[a][b][m][n] = (f32x4){0.f, 0.f, 0.f, 0.f};
    bf16x8 At[4][2], B0[2][2], B1[2][2];
    const char* cA = (const char*)g.A + (size_t)cur.pm * tstep; const char* cB = (const char*)g.Bt + (size_t)cur.pn * tstep;
    S.a_ready(cur);
    PG8_STAGE(PG8_SB(0, 0), cB, voffB); PG8_STAGE(PG8_SA(0, 0), cA, voffA); PG8_STAGE(PG8_SB(0, 1), cB + hstep, voffB); PG8_STAGE(PG8_SA(0, 1), cA + hstep, voffA);
    if (wr == 1) PG8_BAR;
    PG8_WAIT_V(4); PG8_BAR;
    PG8_STAGE(PG8_SB(1, 0), cB + kstep, voffB); PG8_STAGE(PG8_SA(1, 0), cA + kstep, voffA); PG8_STAGE(PG8_SB(1, 1), cB + hstep + kstep, voffB);
    PG8_WAIT_V(6); PG8_BAR;
    PG8_STAMP();
    for (;;) {
        const bool has_next = S.next(ui + 1, nxt);
        const char* nA = has_next ? (const char*)g.A + (size_t)nxt.pm * tstep : cA; const char* nB = has_next ? (const char*)g.Bt + (size_t)nxt.pn * tstep : cB;
        for (int t = 0; t < nt; t += 2) {
            const bool last = (t == nt - 2);
            const char* a1 = cA + (size_t)(t + 1) * kstep;
            const char* a2 = last ? nA : cA + (size_t)(t + 2) * kstep; const char* b2 = last ? nB : cB + (size_t)(t + 2) * kstep;
            const char* a3 = a2 + kstep; const char* b3 = b2 + kstep;
            if (last && has_next) S.a_ready(nxt);
            PG8_LDB(B0, 0, 0); PG8_SCHED; PG8_LDA(At, 0, 0); PG8_STAGE(PG8_SA(1, 1), a1 + hstep, voffA);
            PG8_WAIT_L(8); PG8_BAR; PG8_WAIT_L(0); PG8_MMA(0, 0, At, B0); PG8_BAR; PG8_SCHED;
            PG8_LDB(B1, 0, 1); PG8_STAGE(PG8_SB(0, 0), b2, voffB);
            PG8_BAR; PG8_WAIT_L(0); PG8_MMA(0, 1, At, B1); PG8_BAR;
            PG8_LDA(At, 0, 1); PG8_STAGE(PG8_SA(0, 0), a2, voffA);
            PG8_BAR; PG8_WAIT_L(0); PG8_MMA(1, 0, At, B0); PG8_BAR; PG8_SCHED;
            PG8_STAGE(PG8_SB(0, 1), b2 + hstep, voffB);
            PG8_WAIT_V(6); PG8_BAR; PG8_MMA(1, 1, At, B1); PG8_BAR;
            PG8_LDB(B0, 1, 0); PG8_SCHED; PG8_LDA(At, 1, 0); PG8_STAGE(PG8_SA(0, 1), a2 + hstep, voffA);
            PG8_WAIT_L(8); PG8_BAR; PG8_WAIT_L(0); PG8_MMA(0, 0, At, B0); PG8_BAR; PG8_SCHED;
            PG8_LDB(B1, 1, 1); PG8_STAGE(PG8_SB(1, 0), b3, voffB);
            PG8_BAR; PG8_WAIT_L(0); PG8_MMA(0, 1, At, B1); PG8_BAR;
            PG8_LDA(At, 1, 1); PG8_STAGE(PG8_SA(1, 0), a3, voffA);
            PG8_BAR; PG8_WAIT_L(0); PG8_MMA(1, 0, At, B0); PG8_BAR; PG8_SCHED;
            PG8_STAGE(PG8_SB(1, 1), b3 + hstep, voffB);
            PG8_WAIT_V(6); PG8_BAR; PG8_MMA(1, 1, At, B1); PG8_BAR;
        }
        PG8_STAMP();
        if constexpr (!Epi::AFTER_DRAIN) { E(acc, cur, wr, wc, fr, fq); S.done(cur); }
        PG8_STAMP();
        if (!has_next) break;
#pragma unroll
        for (int a = 0; a < 2; ++a)
#pragma unroll
            for (int b = 0; b < 2; ++b)
#pragma unroll
                for (int m = 0; m < 4; ++m)
#pragma unroll
                    for (int n = 0; n < 2; ++n) acc[a][b][m][n] = (f32x4){0.f, 0.f, 0.f, 0.f};
        cur = nxt; cA = nA; cB = nB; ++ui;
    }
    PG8_WAIT_V(0);
    if (wr == 0) PG8_BAR;
    PG8_BAR;
    if constexpr (Epi::AFTER_DRAIN) { E.fused(acc, cur, wr, wc, fr, fq, lds, wid, lane); S.done(cur); }
    PG8_STAMP();
    if (STAMP && wid == 0) { stamps[lane] = lane < nts ? (((unsigned long long)(unsigned)ts_hi << 32) | (unsigned)ts_lo) : 0ull;
        if (lane == 62) stamps[62] = rt_entry; if (lane == 63) stamps[63] = (unsigned long long)wall_clock64(); }
#undef PG8_STAMP
#undef PG8_SA
#undef PG8_SB
#undef PG8_STAGE
#undef PG8_LDA
#undef PG8_LDB
#undef PG8_MMA
#undef PG8_WAIT_V
#undef PG8_WAIT_L
#undef PG8_BAR
#undef PG8_SCHED
}
template <class Epi, class Sched, bool ALIGN_EPI = false, bool SP2 = false>
__device__ __forceinline__ void gemm_phase_sp2(PG8_LAS unsigned char* lds, const Gemm g, const Sched& S, const Epi& E) {
    const int tid = threadIdx.x, wid = __builtin_amdgcn_readfirstlane(tid >> 6), lane = tid & 63, wr = wid >> 2, wc = wid & 3, fr = lane & 15, fq = lane >> 4;
    const int K = g.K, nt = K / BK;
    unsigned voffA[2], voffB[2];
#pragma unroll
    for (int i = 0; i < 2; ++i) { int R, C; stage_rc(tid * 16 + i * 8192, R, C); const int Rb = Epi::PERM ? ((R & ~31) + perm32(R & 31)) : R;
        voffA[i] = (unsigned)(R * K + C) * 2u; voffB[i] = (unsigned)(Rb * K + C) * 2u; }
    const size_t kstep = (size_t)(BK * 2);
    const size_t hstep = (size_t)HALF * K * 2;
    const size_t tstep = 2 * hstep;
    const unsigned ldsw = (unsigned)wid * 1024u;
    const int aoff = lds_byte(wr * 64 + fr, fq * 8), boff = lds_byte(wc * 32 + fr, fq * 8);
#define PG8_SA(b, h) (((b) * 2 + (h)) * HTB)
#define PG8_SB(b, h) ((4 + (b) * 2 + (h)) * HTB)
#define PG8_STAGE(bufoff, gbase, voff) do { _Pragma("unroll") for (int _i = 0; _i < 2; ++_i) \
        __builtin_amdgcn_global_load_lds((const unsigned*)((const char*)(gbase) + (voff)[_i]), (PG8_LAS unsigned*)(lds + (bufoff) + ldsw + _i * 8192), 16, 0, 0); } while (0)
#define PG8_LDA(dst, b, h) do { _Pragma("unroll") for (int m = 0; m < 4; ++m) _Pragma("unroll") for (int k = 0; k < 2; ++k) dst[m][k] = *(const PG8_LAS bf16x8*)(lds + PG8_SA(b, h) + aoff + m * 2048 + k * 1024); } while (0)
#define PG8_LDB(dst, b, h) do { _Pragma("unroll") for (int n = 0; n < 2; ++n) _Pragma("unroll") for (int k = 0; k < 2; ++k) dst[n][k] = *(const PG8_LAS bf16x8*)(lds + PG8_SB(b, h) + boff + n * 2048 + k * 1024); } while (0)
#define PG8_MMA(ai, bj, At, Bt) do { __builtin_amdgcn_s_setprio(1); _Pragma("unroll") for (int m = 0; m < 4; ++m) _Pragma("unroll") for (int n = 0; n < 2; ++n) _Pragma("unroll") for (int k = 0; k < 2; ++k) \
        acc[ai][bj][m][n] = __builtin_amdgcn_mfma_f32_16x16x32_bf16(Bt[n][k], At[m][k], acc[ai][bj][m][n], 0, 0, 0); __builtin_amdgcn_s_setprio(0); } while (0)
#define PG8_WAIT_V(n) asm volatile("s_waitcnt vmcnt(" #n ")" ::: "memory")
#define PG8_WAIT_L(n) asm volatile("s_waitcnt lgkmcnt(" #n ")" ::: "memory")
#define PG8_BAR __builtin_amdgcn_s_barrier()
#define PG8_SCHED __builtin_amdgcn_sched_barrier(0)
    Unit cur, nxt; int ui = 0;
    if (!S.next(0, cur)) return;
    f32x4 acc[2][2][4][2];
#pragma unroll
    for (int a = 0; a < 2; ++a)
#pragma unroll
        for (int b = 0; b < 2; ++b)
#pragma unroll
            for (int m = 0; m < 4; ++m)
#pragma unroll
                for (int n = 0; n < 2; ++n) acc[a][b][m][n] = (f32x4){0.f, 0.f, 0.f, 0.f};
    bf16x8 At[4][2], B0[2][2], B1[2][2];
    const char* cA = (const char*)g.A + (size_t)cur.pm * tstep; const char* cB = (const char*)g.Bt + (size_t)cur.pn * tstep;
    S.a_ready(cur);
    if constexpr (SP2) {
        PG8_STAGE(PG8_SB(0, 0), cB, voffB); PG8_STAGE(PG8_SB(0, 1), cB + hstep, voffB); PG8_STAGE(PG8_SA(0, 0), cA, voffA); PG8_STAGE(PG8_SA(0, 1), cA + hstep, voffA);
        if (wr == 1) PG8_BAR;
        PG8_WAIT_V(2); PG8_BAR;
        PG8_STAGE(PG8_SB(1, 0), cB + kstep, voffB); PG8_STAGE(PG8_SA(1, 0), cA + kstep, voffA); PG8_STAGE(PG8_SB(1, 1), cB + hstep + kstep, voffB);
        PG8_WAIT_V(6); PG8_BAR;
    } else {
        PG8_STAGE(PG8_SB(0, 0), cB, voffB); PG8_STAGE(PG8_SA(0, 0), cA, voffA); PG8_STAGE(PG8_SB(0, 1), cB + hstep, voffB); PG8_STAGE(PG8_SA(0, 1), cA + hstep, voffA);
        if (wr == 1) PG8_BAR;
        PG8_WAIT_V(4); PG8_BAR;
        PG8_STAGE(PG8_SB(1, 0), cB + kstep, voffB); PG8_STAGE(PG8_SA(1, 0), cA + kstep, voffA); PG8_STAGE(PG8_SB(1, 1), cB + hstep + kstep, voffB);
        PG8_WAIT_V(6); PG8_BAR;
    }
    for (;;) {
        const bool has_next = S.next(ui + 1, nxt);
        const char* nA = has_next ? (const char*)g.A + (size_t)nxt.pm * tstep : cA; const char* nB = has_next ? (const char*)g.Bt + (size_t)nxt.pn * tstep : cB;
        for (int t = 0; t < nt; t += 2) {
            const bool last = (t == nt - 2);
            const char* a1 = cA + (size_t)(t + 1) * kstep;
            const char* a2 = last ? nA : cA + (size_t)(t + 2) * kstep; const char* b2 = last ? nB : cB + (size_t)(t + 2) * kstep;
            const char* a3 = a2 + kstep; const char* b3 = b2 + kstep;
            if (last && has_next) S.a_ready(nxt);
            if constexpr (SP2) {
            PG8_LDB(B0, 0, 0); PG8_LDB(B1, 0, 1); PG8_SCHED; PG8_LDA(At, 0, 0); PG8_STAGE(PG8_SA(1, 1), a1 + hstep, voffA);
            PG8_WAIT_V(8); PG8_WAIT_L(0); PG8_BAR; PG8_MMA(0, 0, At, B0); PG8_MMA(0, 1, At, B1); PG8_BAR; PG8_SCHED;
            PG8_LDA(At, 0, 1); PG8_STAGE(PG8_SB(0, 0), b2, voffB); PG8_STAGE(PG8_SB(0, 1), b2 + hstep, voffB); PG8_STAGE(PG8_SA(0, 0), a2, voffA);
            PG8_WAIT_V(8); PG8_WAIT_L(0); PG8_BAR; PG8_MMA(1, 0, At, B0); PG8_MMA(1, 1, At, B1); PG8_BAR; PG8_SCHED;
            PG8_LDB(B0, 1, 0); PG8_LDB(B1, 1, 1); PG8_SCHED; PG8_LDA(At, 1, 0); PG8_STAGE(PG8_SA(0, 1), a2 + hstep, voffA);
            PG8_WAIT_V(8); PG8_WAIT_L(0); PG8_BAR; PG8_MMA(0, 0, At, B0); PG8_MMA(0, 1, At, B1); PG8_BAR; PG8_SCHED;
            PG8_LDA(At, 1, 1); PG8_STAGE(PG8_SB(1, 0), b3, voffB); PG8_STAGE(PG8_SB(1, 1), b3 + hstep, voffB); PG8_STAGE(PG8_SA(1, 0), a3, voffA);
            PG8_WAIT_V(8); PG8_WAIT_L(0); PG8_BAR; PG8_MMA(1, 0, At, B0); PG8_MMA(1, 1, At, B1); PG8_BAR; PG8_SCHED;
            } else {
            PG8_LDB(B0, 0, 0); PG8_SCHED; PG8_LDA(At, 0, 0); PG8_STAGE(PG8_SA(1, 1), a1 + hstep, voffA);
            PG8_WAIT_L(8); PG8_BAR; PG8_WAIT_L(0); PG8_MMA(0, 0, At, B0); PG8_BAR; PG8_SCHED;
            PG8_LDB(B1, 0, 1); PG8_STAGE(PG8_SB(0, 0), b2, voffB);
            PG8_BAR; PG8_WAIT_L(0); PG8_MMA(0, 1, At, B1); PG8_BAR;
            PG8_LDA(At, 0, 1); PG8_STAGE(PG8_SA(0, 0), a2, voffA);
            PG8_BAR; PG8_WAIT_L(0); PG8_MMA(1, 0, At, B0); PG8_BAR; PG8_SCHED;
            PG8_STAGE(PG8_SB(0, 1), b2 + hstep, voffB);
            PG8_WAIT_V(6); PG8_BAR; PG8_MMA(1, 1, At, B1); PG8_BAR;
            PG8_LDB(B0, 1, 0); PG8_SCHED; PG8_LDA(At, 1, 0); PG8_STAGE(PG8_SA(0, 1), a2 + hstep, voffA);
            PG8_WAIT_L(8); PG8_BAR; PG8_WAIT_L(0); PG8_MMA(0, 0, At, B0); PG8_BAR; PG8_SCHED;
            PG8_LDB(B1, 1, 1); PG8_STAGE(PG8_SB(1, 0), b3, voffB);
            PG8_BAR; PG8_WAIT_L(0); PG8_MMA(0, 1, At, B1); PG8_BAR;
            PG8_LDA(At, 1, 1); PG8_STAGE(PG8_SA(1, 0), a3, voffA);
            PG8_BAR; PG8_WAIT_L(0); PG8_MMA(1, 0, At, B0); PG8_BAR; PG8_SCHED;
            PG8_STAGE(PG8_SB(1, 1), b3 + hstep, voffB);
            PG8_WAIT_V(6); PG8_BAR; PG8_MMA(1, 1, At, B1); PG8_BAR;
            }
        }
        if constexpr (ALIGN_EPI) { if (wr == 0) PG8_BAR; }
        if constexpr (!Epi::AFTER_DRAIN) { E(acc, cur, wr, wc, fr, fq); S.done(cur); }
        if (!has_next) break;
#pragma unroll
        for (int a = 0; a < 2; ++a)
#pragma unroll
            for (int b = 0; b < 2; ++b)
#pragma unroll
                for (int m = 0; m < 4; ++m)
#pragma unroll
                    for (int n = 0; n < 2; ++n) acc[a][b][m][n] = (f32x4){0.f, 0.f, 0.f, 0.f};
        cur = nxt; cA = nA; cB = nB; ++ui;
        if constexpr (ALIGN_EPI) { if (wr == 1) PG8_BAR; }
    }
    PG8_WAIT_V(0);
    if constexpr (!ALIGN_EPI) { if (wr == 0) PG8_BAR; }
    PG8_BAR;
    if constexpr (Epi::AFTER_DRAIN) { E.fused(acc, cur, wr, wc, fr, fq, lds, wid, lane); S.done(cur); }
#undef PG8_SA
#undef PG8_SB
#undef PG8_STAGE
#undef PG8_LDA
#undef PG8_LDB
#undef PG8_MMA
#undef PG8_WAIT_V
#undef PG8_WAIT_L
#undef PG8_BAR
#undef PG8_SCHED
}
}
#define LAS __attribute__((address_space(3)))
typedef LAS unsigned char* LDSp;
typedef pg8::bf16_t bf16_t;
typedef unsigned u32x4 __attribute__((ext_vector_type(4)));
typedef unsigned u32x2 __attribute__((ext_vector_type(2)));
typedef float f32x4 __attribute__((ext_vector_type(4)));
typedef float f32x2 __attribute__((ext_vector_type(2)));

#ifndef EXPC
#define EXPC 0
#endif
#ifndef EVP_SKIP
#define EVP_SKIP 0
#endif
constexpr int T_ = 16384, D_ = 1024, S_ = 4096, NTHR = 512;
constexpr int LDS_BYTES = 147456;
constexpr size_t MiB = 1048576;
constexpr size_t WS_WB = 0, WS_HN = 25 * MiB, WS_Z = 57 * MiB, WS_QKV = 153 * MiB, WS_OF = 201 * MiB, WS_OB = 217 * MiB,
                 WS_GATES = 233 * MiB, WS_BETA = 234 * MiB, WS_LA = 234 * MiB + 524288;
constexpr size_t WB_IN = 0, WB_OUT = 6291456, WB_UP = 8388608, WB_DN = 19922944;
constexpr int DFF = 2816;

struct Params { const float* in[26]; float* out; unsigned char* ws; };

__device__ __forceinline__ float bf2f(unsigned short b) { return __uint_as_float(((unsigned)b) << 16); }
__device__ __forceinline__ float bflo(unsigned u) { return __uint_as_float(u << 16); }
__device__ __forceinline__ float bfhi(unsigned u) { return __uint_as_float(u & 0xffff0000u); }
__device__ __forceinline__ unsigned short f2bf(float f) { unsigned u = __float_as_uint(f); u += 0x7FFFu + ((u >> 16) & 1u); return (unsigned short)(u >> 16); }
typedef __bf16 bf16x2_v __attribute__((ext_vector_type(2)));
__device__ __forceinline__ unsigned pk2(float lo, float hi) { const f32x2 v = {lo, hi}; const bf16x2_v b = __builtin_convertvector(v, bf16x2_v); return __builtin_bit_cast(unsigned, b); }
__device__ __forceinline__ float sigm(float x) { return __builtin_amdgcn_rcpf(1.0f + __expf(-x)); }
__device__ __forceinline__ float sigm_f(float x) { return __builtin_amdgcn_rcpf(1.0f + __expf(-x)); }
__device__ __forceinline__ float silu_(float x) { return x * sigm(x); }
__device__ __forceinline__ float gelu_t(float x) { const float u = 0.7978845608028654f * (x + 0.044715f * x * x * x); const float t = 1.0f - 2.0f / (1.0f + __expf(2.0f * u)); return 0.5f * x * (1.0f + t); }
__device__ __forceinline__ float softplus_(float x) { return x > 20.0f ? x : log1pf(expf(x)); }
__device__ __forceinline__ float wave_sum(float v) {
#pragma unroll
    for (int o = 32; o; o >>= 1) v += __shfl_xor(v, o);
    return v; }
template <int CTRL> __device__ __forceinline__ float dppf(float v) { return __int_as_float(__builtin_amdgcn_update_dpp(0, __float_as_int(v), CTRL, 0xf, 0xf, true)); }
__device__ __forceinline__ float row16_sum(float v) { v += dppf<0xB1>(v); v += dppf<0x4E>(v); v += dppf<0x141>(v); v += dppf<0x140>(v); return v; }
__device__ __forceinline__ void unpack8(const u32x4 w, float (&f)[8]) { f[0] = bflo(w.x); f[1] = bfhi(w.x); f[2] = bflo(w.y); f[3] = bfhi(w.y); f[4] = bflo(w.z); f[5] = bfhi(w.z); f[6] = bflo(w.w); f[7] = bfhi(w.w); }


__device__ __forceinline__ float wave_scan_sum(float x, bool fwd) {
    const int lane = threadIdx.x & 63;
#pragma unroll
    for (int o = 1; o < 64; o <<= 1) { const float y = fwd ? __shfl_up(x, o) : __shfl_down(x, o); if (fwd ? (lane >= o) : (lane + o < 64)) x += y; }
    return x; }
__device__ __forceinline__ float wave_scan_max(float x, bool fwd) {
    const int lane = threadIdx.x & 63;
#pragma unroll
    for (int o = 1; o < 64; o <<= 1) { const float y = fwd ? __shfl_up(x, o) : __shfl_down(x, o); if (fwd ? (lane >= o) : (lane + o < 64)) x = fmaxf(x, y); }
    return x; }
__device__ __forceinline__ void conv_job(LDSp lds, const float* __restrict__ src, int ldn, int K, int col0, int ncols, bf16_t* __restrict__ dst, int mode, int off) {
    LAS float* tl = (LAS float*)lds;
    const int tid = threadIdx.x, nnt = ncols >> 6, ntl = (K >> 6) * nnt;
    const int r = tid >> 4, c4 = (tid & 15) << 2;
    f32x4 pv[2];
    if ((int)blockIdx.x < ntl) { const int kt = (int)blockIdx.x / nnt, nt = (int)blockIdx.x - kt * nnt;
#pragma unroll
        for (int i = 0; i < 2; ++i) pv[i] = *(const f32x4*)(src + (size_t)(kt * 64 + r + 32 * i) * ldn + col0 + nt * 64 + c4); }
    for (int tile = blockIdx.x; tile < ntl; tile += gridDim.x) {
        const int kt = tile / nnt, nt = tile - kt * nnt;
#pragma unroll
        for (int i = 0; i < 2; ++i) { const int k = r + 32 * i; const f32x4 v = pv[i];
            tl[k * 65 + c4 + 0] = v.x; tl[k * 65 + c4 + 1] = v.y; tl[k * 65 + c4 + 2] = v.z; tl[k * 65 + c4 + 3] = v.w; }
        { const int tn = tile + (int)gridDim.x; if (tn < ntl) { const int kt2 = tn / nnt, nt2 = tn - kt2 * nnt;
#pragma unroll
            for (int i = 0; i < 2; ++i) pv[i] = *(const f32x4*)(src + (size_t)(kt2 * 64 + r + 32 * i) * ldn + col0 + nt2 * 64 + c4); } }
        __syncthreads();
        const int n = tid >> 3, k8 = (tid & 7) << 3; float f[8];
#pragma unroll
        for (int j = 0; j < 8; ++j) f[j] = tl[(k8 + j) * 65 + n];
        u32x4 w; w.x = pk2(f[0], f[1]); w.y = pk2(f[2], f[3]); w.z = pk2(f[4], f[5]); w.w = pk2(f[6], f[7]);
        const int ncol = nt * 64 + n;
        const int row = mode == 0 ? off + ncol : ((ncol >> 7) << 8) + (ncol & 127) + off;
        *(u32x4*)(dst + (size_t)row * K + kt * 64 + k8) = w;
        __syncthreads();
    }
}
__device__ __forceinline__ void convert_layer(LDSp lds, const Params& p, int L) {
    bf16_t* wb = (bf16_t*)(p.ws + WS_WB);
    if (L == 0) { conv_job(lds, p.in[2], 3088, 1024, 0, 3072, (bf16_t*)((char*)wb + WB_IN), 0, 0);
                  conv_job(lds, p.in[11], 1024, 1024, 0, 1024, (bf16_t*)((char*)wb + WB_OUT), 0, 0); }
    else        { conv_job(lds, p.in[12], 2576, 1024, 0, 2560, (bf16_t*)((char*)wb + WB_IN), 0, 0);
                  conv_job(lds, p.in[20], 1024, 1024, 0, 1024, (bf16_t*)((char*)wb + WB_OUT), 0, 0); }
    conv_job(lds, p.in[22] + (size_t)L * 1024 * DFF, DFF, 1024, 0, DFF, (bf16_t*)((char*)wb + WB_UP), 1, 0);
    conv_job(lds, p.in[23] + (size_t)L * 1024 * DFF, DFF, 1024, 0, DFF, (bf16_t*)((char*)wb + WB_UP), 1, 128);
    conv_job(lds, p.in[24] + (size_t)L * DFF * 1024, 1024, DFF, 0, 1024, (bf16_t*)((char*)wb + WB_DN), 0, 0);
}

__device__ __forceinline__ void rms_phase(LDSp lds, const float* src, const float* __restrict__ g, bf16_t* hn, float* copy_out, float* final_out,
                                          const float* __restrict__ gw, int gw_ld, int gw_col0, float* gates) {
    LAS float* wg = (LAS float*)lds;
    const int tid = threadIdx.x, lane = tid & 63, wid = tid >> 6;
    if (gw) { for (int idx = tid; idx < 16384; idx += NTHR) { const int k = idx >> 4, j = idx & 15; wg[j * 1024 + k] = gw[(size_t)k * gw_ld + gw_col0 + j]; } __syncthreads(); }
    f32x4 gv[4];
#pragma unroll
    for (int i = 0; i < 4; ++i) gv[i] = *(const f32x4*)(g + 4 * lane + 256 * i);
    f32x4 xn[4];
    { const int row0 = blockIdx.x * 8 + wid;
#pragma unroll
      for (int i = 0; i < 4; ++i) xn[i] = *(const f32x4*)(src + (size_t)row0 * D_ + 4 * lane + 256 * i); }
    for (int row = blockIdx.x * 8 + wid; row < T_; row += gridDim.x * 8) {
        f32x4 x[4]; float ss = 0.f;
#pragma unroll
        for (int i = 0; i < 4; ++i) { x[i] = xn[i]; ss += x[i].x * x[i].x + x[i].y * x[i].y + x[i].z * x[i].z + x[i].w * x[i].w; }
        { const int rn = row + (int)gridDim.x * 8; if (rn < T_) {
#pragma unroll
            for (int i = 0; i < 4; ++i) xn[i] = *(const f32x4*)(src + (size_t)rn * D_ + 4 * lane + 256 * i); } }
        if (copy_out) {
#pragma unroll
            for (int i = 0; i < 4; ++i) *(f32x4*)(copy_out + (size_t)row * D_ + 4 * lane + 256 * i) = x[i]; }
        ss = wave_sum(ss);
        const float rstd = rsqrtf(ss * (1.0f / 1024.0f) + 1e-6f);
        f32x4 y[4];
#pragma unroll
        for (int i = 0; i < 4; ++i) y[i] = x[i] * rstd * gv[i];
        if (final_out) {
#pragma unroll
            for (int i = 0; i < 4; ++i) *(f32x4*)(final_out + (size_t)row * D_ + 4 * lane + 256 * i) = y[i];
        } else {
#pragma unroll
            for (int i = 0; i < 4; ++i) { u32x2 w; w.x = pk2(y[i].x, y[i].y); w.y = pk2(y[i].z, y[i].w); *(u32x2*)(hn + (size_t)row * D_ + 4 * lane + 256 * i) = w; }
        }
        if (gw) {
            float s[16];
#pragma unroll
            for (int j = 0; j < 16; ++j) { float a = 0.f;
#pragma unroll
                for (int i = 0; i < 4; ++i) { const f32x4 w = *(const LAS f32x4*)(wg + j * 1024 + 4 * lane + 256 * i); a += y[i].x * w.x + y[i].y * w.y + y[i].z * w.z + y[i].w * w.w; }
                s[j] = a; }
            const bool h5 = (lane & 32) != 0, h4 = (lane & 16) != 0, h3 = (lane & 8) != 0, h2 = (lane & 4) != 0;
            float r8[8], r4[4], r2[2], r1;
#pragma unroll
            for (int j = 0; j < 8; ++j) { const float keep = h5 ? s[j + 8] : s[j], send = h5 ? s[j] : s[j + 8]; r8[j] = keep + __shfl_xor(send, 32); }
#pragma unroll
            for (int j = 0; j < 4; ++j) { const float keep = h4 ? r8[j + 4] : r8[j], send = h4 ? r8[j] : r8[j + 4]; r4[j] = keep + __shfl_xor(send, 16); }
#pragma unroll
            for (int j = 0; j < 2; ++j) { const float keep = h3 ? r4[j + 2] : r4[j], send = h3 ? r4[j] : r4[j + 2]; r2[j] = keep + __shfl_xor(send, 8); }
            { const float keep = h2 ? r2[1] : r2[0], send = h2 ? r2[0] : r2[1]; r1 = keep + __shfl_xor(send, 4); }
            r1 += __shfl_xor(r1, 2); r1 += __shfl_xor(r1, 1);
            if ((lane & 3) == 0) gates[(size_t)row * 16 + (h5 ? 8 : 0) + (h4 ? 4 : 0) + (h3 ? 2 : 0) + (h2 ? 1 : 0)] = r1;
        }
    }
    __syncthreads();
}

__device__ __forceinline__ void even_prep(LDSp lds, const Params& p) {
    const bf16_t* Z = (const bf16_t*)(p.ws + WS_Z); bf16_t* Y = (bf16_t*)(p.ws + WS_HN); bf16_t* QKVN = (bf16_t*)(p.ws + WS_QKV);
    const float* gates = (const float*)(p.ws + WS_GATES); float* BETA = (float*)(p.ws + WS_BETA); float* LA = (float*)(p.ws + WS_LA);
    const float* conv_w = p.in[3]; const float* conv_b = p.in[4]; const float* ln_g = p.in[5]; const float* ln_b = p.in[6];
    const float* dn_w = p.in[7]; const float* a_log = p.in[8]; const float* dt_bias = p.in[9];
    LAS float* glu = (LAS float*)lds;
    const int tid = threadIdx.x, lane = tid & 63, wid = tid >> 6, c = tid;
    for (int tile = blockIdx.x; tile < T_ / 32; tile += gridDim.x) {
        const int t0 = tile * 32, b = t0 >> 12, s0 = t0 & 4095;
#if !(EVP_SKIP & 1)
        for (int it = tid; it < 62 * 64; it += NTHR) { const int r = it >> 6, c8 = (it & 63) << 3, sp = s0 - 15 + r;
            f32x4 o0 = {0.f, 0.f, 0.f, 0.f}, o1 = {0.f, 0.f, 0.f, 0.f};
            if (sp >= 0 && sp < S_) { const size_t tok = (size_t)b * S_ + sp; const u32x4 av = *(const u32x4*)(Z + tok * 3072 + c8); const u32x4 gv = *(const u32x4*)(Z + tok * 3072 + 512 + c8);
                float a[8], g[8]; unpack8(av, a); unpack8(gv, g);
                o0 = (f32x4){a[0] * sigm(g[0]), a[1] * sigm(g[1]), a[2] * sigm(g[2]), a[3] * sigm(g[3])}; o1 = (f32x4){a[4] * sigm(g[4]), a[5] * sigm(g[5]), a[6] * sigm(g[6]), a[7] * sigm(g[7])}; }
            *(LAS f32x4*)(glu + r * 512 + c8) = o0; *(LAS f32x4*)(glu + r * 512 + c8 + 4) = o1; }
        __syncthreads();
        {
            float cw[31];
#pragma unroll
            for (int w = 0; w < 31; ++w) cw[w] = conv_w[w * 512 + c];
            const float cb = conv_b[c];
            f32x4 res[8];
#pragma unroll
            for (int t4 = 0; t4 < 8; ++t4) {
                float x[34];
#pragma unroll
                for (int i = 0; i < 34; ++i) x[i] = glu[(t4 * 4 + i) * 512 + c];
                float a0 = cb, a1 = cb, a2 = cb, a3 = cb;
#pragma unroll
                for (int w = 0; w < 31; ++w) { a0 = fmaf(x[w], cw[w], a0); a1 = fmaf(x[w + 1], cw[w], a1); a2 = fmaf(x[w + 2], cw[w], a2); a3 = fmaf(x[w + 3], cw[w], a3); }
                res[t4] = (f32x4){a0, a1, a2, a3};
            }
            __syncthreads();
#pragma unroll
            for (int t4 = 0; t4 < 8; ++t4) { glu[(t4 * 4 + 0) * 512 + c] = res[t4].x; glu[(t4 * 4 + 1) * 512 + c] = res[t4].y; glu[(t4 * 4 + 2) * 512 + c] = res[t4].z; glu[(t4 * 4 + 3) * 512 + c] = res[t4].w; }
        }
        __syncthreads();
        {
            const f32x4 g0 = *(const f32x4*)(ln_g + 4 * lane), g1 = *(const f32x4*)(ln_g + 256 + 4 * lane), b0 = *(const f32x4*)(ln_b + 4 * lane), b1 = *(const f32x4*)(ln_b + 256 + 4 * lane);
#pragma unroll
            for (int tt = 0; tt < 4; ++tt) { const int t = wid * 4 + tt;
                const f32x4 x0 = *(const LAS f32x4*)(glu + t * 512 + 4 * lane), x1 = *(const LAS f32x4*)(glu + t * 512 + 256 + 4 * lane);
                const float mean = wave_sum((x0.x + x0.y) + (x0.z + x0.w) + (x1.x + x1.y) + (x1.z + x1.w)) * (1.0f / 512.0f);
                const f32x4 d0 = x0 - mean, d1 = x1 - mean;
                const float var = wave_sum(d0.x * d0.x + d0.y * d0.y + d0.z * d0.z + d0.w * d0.w + d1.x * d1.x + d1.y * d1.y + d1.z * d1.z + d1.w * d1.w) * (1.0f / 512.0f);
                const float rstd = rsqrtf(var + 1e-5f);
                const f32x4 y0 = d0 * rstd * g0 + b0, y1 = d1 * rstd * g1 + b1;
                u32x2 w0, w1; w0.x = pk2(silu_(y0.x), silu_(y0.y)); w0.y = pk2(silu_(y0.z), silu_(y0.w)); w1.x = pk2(silu_(y1.x), silu_(y1.y)); w1.y = pk2(silu_(y1.z), silu_(y1.w));
                *(u32x2*)(Y + (size_t)(t0 + t) * 1024 + 4 * lane) = w0; *(u32x2*)(Y + (size_t)(t0 + t) * 1024 + 256 + 4 * lane) = w1; }
        }
        __syncthreads();
#endif
#if !(EVP_SKIP & 2)
        LAS unsigned short* xin = (LAS unsigned short*)(glu + 32 * 512);
#pragma unroll 1
        for (int gi = 0; gi < 3; ++gi) {
            float w5[5];
#pragma unroll
            for (int w = 0; w < 5; ++w) w5[w] = dn_w[w * 1536 + gi * 512 + c];
            for (int it = tid; it < 36 * 64; it += NTHR) { const int rr = it >> 6, c8 = (it & 63) << 3, sp = s0 - 2 + rr;
                u32x4 v = {0u, 0u, 0u, 0u};
                if (sp >= 0 && sp < S_) v = *(const u32x4*)(Z + ((size_t)b * S_ + sp) * 3072 + 1024 + gi * 512 + c8);
                *(LAS u32x4*)(xin + rr * 512 + c8) = v; }
            __syncthreads();
            float x0 = bf2f(xin[c]), x1 = bf2f(xin[512 + c]), x2 = bf2f(xin[1024 + c]), x3 = bf2f(xin[1536 + c]);
#pragma unroll 8
            for (int t = 0; t < 32; ++t) { const float x4 = bf2f(xin[(t + 4) * 512 + c]);
                float v = x0 * w5[0]; v = fmaf(x1, w5[1], v); v = fmaf(x2, w5[2], v); v = fmaf(x3, w5[3], v); v = fmaf(x4, w5[4], v);
                glu[t * 512 + c] = silu_(v);
                x0 = x1; x1 = x2; x2 = x3; x3 = x4; }
            __syncthreads();
            const float qs = gi == 0 ? 0.08838834764831845f : 1.0f;
#pragma unroll
            for (int pp = 0; pp < 4; ++pp) { const int pr = wid * 16 + pp * 4 + (lane >> 4), t = pr >> 2, hd = pr & 3, c8 = (lane & 15) * 8;
                const f32x4 y0 = *(const LAS f32x4*)(glu + t * 512 + hd * 128 + c8), y1 = *(const LAS f32x4*)(glu + t * 512 + hd * 128 + c8 + 4);
                const float ss = row16_sum(y0.x * y0.x + y0.y * y0.y + y0.z * y0.z + y0.w * y0.w + y1.x * y1.x + y1.y * y1.y + y1.z * y1.z + y1.w * y1.w);
                const float sc = gi == 2 ? 1.0f : rsqrtf(ss + 1e-6f) * qs;
                u32x4 w; w.x = pk2(y0.x * sc, y0.y * sc); w.y = pk2(y0.z * sc, y0.w * sc); w.z = pk2(y1.x * sc, y1.y * sc); w.w = pk2(y1.z * sc, y1.w * sc);
                *(u32x4*)(QKVN + (size_t)(t0 + t) * 1536 + gi * 512 + hd * 128 + c8) = w; }
            __syncthreads();
        }
#endif
#if !(EVP_SKIP & 4)
        if (tid < 256) { const int t = tid >> 3, j = tid & 7; const size_t tok = (size_t)(t0 + t);
            const float bp = gates[tok * 16 + j], ap = gates[tok * 16 + 8 + j];
            BETA[tok * 8 + j] = sigm(bp); LA[tok * 8 + j] = -expf(a_log[j]) * softplus_(ap + dt_bias[j]); }
#endif
        __syncthreads();
    }
}

__device__ __forceinline__ void tri_inv64(const LAS float* Am, int c, float su, float sw, LAS unsigned short* Tu, LAS unsigned short* Tw) {
    f32x4 a; float s0, s1, s2, s3; const float cf = (float)c;
    float x0 = fmaxf(0.0f, 1.0f - fabsf(cf - 0.0f));
    Tu[0 + c] = f2bf(x0 * su); Tw[0 + c] = f2bf(x0 * sw); asm volatile("" ::: "memory");
    float x1 = fmaxf(0.0f, 1.0f - fabsf(cf - 1.0f));
    s0 = 0.f; s1 = 0.f; s2 = 0.f; s3 = 0.f;
    a = *(const LAS f32x4*)(Am + 68);
    const float al1 = a.x;
    x1 = (x1 - ((s0 + s1) + (s2 + s3))) - al1 * x0;
    Tu[136 + c] = f2bf(x1 * su); Tw[136 + c] = f2bf(x1 * sw); asm volatile("" ::: "memory");
    float x2 = fmaxf(0.0f, 1.0f - fabsf(cf - 2.0f));
    s0 = 0.f; s1 = 0.f; s2 = 0.f; s3 = 0.f;
    a = *(const LAS f32x4*)(Am + 136);
    s0 = fmaf(a.x, x0, s0);
    const float al2 = a.y;
    x2 = (x2 - ((s0 + s1) + (s2 + s3))) - al2 * x1;
    Tu[272 + c] = f2bf(x2 * su); Tw[272 + c] = f2bf(x2 * sw); asm volatile("" ::: "memory");
    float x3 = fmaxf(0.0f, 1.0f - fabsf(cf - 3.0f));
    s0 = 0.f; s1 = 0.f; s2 = 0.f; s3 = 0.f;
    a = *(const LAS f32x4*)(Am + 204);
    s0 = fmaf(a.x, x0, s0);
    s1 = fmaf(a.y, x1, s1);
    const float al3 = a.z;
    x3 = (x3 - ((s0 + s1) + (s2 + s3))) - al3 * x2;
    Tu[408 + c] = f2bf(x3 * su); Tw[408 + c] = f2bf(x3 * sw); asm volatile("" ::: "memory");
    float x4 = fmaxf(0.0f, 1.0f - fabsf(cf - 4.0f));
    s0 = 0.f; s1 = 0.f; s2 = 0.f; s3 = 0.f;
    a = *(const LAS f32x4*)(Am + 272);
    s0 = fmaf(a.x, x0, s0);
    s1 = fmaf(a.y, x1, s1);
    s2 = fmaf(a.z, x2, s2);
    const float al4 = a.w;
    x4 = (x4 - ((s0 + s1) + (s2 + s3))) - al4 * x3;
    Tu[544 + c] = f2bf(x4 * su); Tw[544 + c] = f2bf(x4 * sw); asm volatile("" ::: "memory");
    float x5 = fmaxf(0.0f, 1.0f - fabsf(cf - 5.0f));
    s0 = 0.f; s1 = 0.f; s2 = 0.f; s3 = 0.f;
    a = *(const LAS f32x4*)(Am + 340);
    s0 = fmaf(a.x, x0, s0);
    s1 = fmaf(a.y, x1, s1);
    s2 = fmaf(a.z, x2, s2);
    s3 = fmaf(a.w, x3, s3);
    a = *(const LAS f32x4*)(Am + 344);
    const float al5 = a.x;
    x5 = (x5 - ((s0 + s1) + (s2 + s3))) - al5 * x4;
    Tu[680 + c] = f2bf(x5 * su); Tw[680 + c] = f2bf(x5 * sw); asm volatile("" ::: "memory");
    float x6 = fmaxf(0.0f, 1.0f - fabsf(cf - 6.0f));
    s0 = 0.f; s1 = 0.f; s2 = 0.f; s3 = 0.f;
    a = *(const LAS f32x4*)(Am + 408);
    s0 = fmaf(a.x, x0, s0);
    s1 = fmaf(a.y, x1, s1);
    s2 = fmaf(a.z, x2, s2);
    s3 = fmaf(a.w, x3, s3);
    a = *(const LAS f32x4*)(Am + 412);
    s0 = fmaf(a.x, x4, s0);
    const float al6 = a.y;
    x6 = (x6 - ((s0 + s1) + (s2 + s3))) - al6 * x5;
    Tu[816 + c] = f2bf(x6 * su); Tw[816 + c] = f2bf(x6 * sw); asm volatile("" ::: "memory");
    float x7 = fmaxf(0.0f, 1.0f - fabsf(cf - 7.0f));
    s0 = 0.f; s1 = 0.f; s2 = 0.f; s3 = 0.f;
    a = *(const LAS f32x4*)(Am + 476);
    s0 = fmaf(a.x, x0, s0);
    s1 = fmaf(a.y, x1, s1);
    s2 = fmaf(a.z, x2, s2);
    s3 = fmaf(a.w, x3, s3);
    a = *(const LAS f32x4*)(Am + 480);
    s0 = fmaf(a.x, x4, s0);
    s1 = fmaf(a.y, x5, s1);
    const float al7 = a.z;
    x7 = (x7 - ((s0 + s1) + (s2 + s3))) - al7 * x6;
    Tu[952 + c] = f2bf(x7 * su); Tw[952 + c] = f2bf(x7 * sw); asm volatile("" ::: "memory");
    float x8 = fmaxf(0.0f, 1.0f - fabsf(cf - 8.0f));
    s0 = 0.f; s1 = 0.f; s2 = 0.f; s3 = 0.f;
    a = *(const LAS f32x4*)(Am + 544);
    s0 = fmaf(a.x, x0, s0);
    s1 = fmaf(a.y, x1, s1);
    s2 = fmaf(a.z, x2, s2);
    s3 = fmaf(a.w, x3, s3);
    a = *(const LAS f32x4*)(Am + 548);
    s0 = fmaf(a.x, x4, s0);
    s1 = fmaf(a.y, x5, s1);
    s2 = fmaf(a.z, x6, s2);
    const float al8 = a.w;
    x8 = (x8 - ((s0 + s1) + (s2 + s3))) - al8 * x7;
    Tu[1088 + c] = f2bf(x8 * su); Tw[1088 + c] = f2bf(x8 * sw); asm volatile("" ::: "memory");
    float x9 = fmaxf(0.0f, 1.0f - fabsf(cf - 9.0f));
    s0 = 0.f; s1 = 0.f; s2 = 0.f; s3 = 0.f;
    a = *(const LAS f32x4*)(Am + 612);
    s0 = fmaf(a.x, x0, s0);
    s1 = fmaf(a.y, x1, s1);
    s2 = fmaf(a.z, x2, s2);
    s3 = fmaf(a.w, x3, s3);
    a = *(const LAS f32x4*)(Am + 616);
    s0 = fmaf(a.x, x4, s0);
    s1 = fmaf(a.y, x5, s1);
    s2 = fmaf(a.z, x6, s2);
    s3 = fmaf(a.w, x7, s3);
    a = *(const LAS f32x4*)(Am + 620);
    const float al9 = a.x;
    x9 = (x9 - ((s0 + s1) + (s2 + s3))) - al9 * x8;
    Tu[1224 + c] = f2bf(x9 * su); Tw[1224 + c] = f2bf(x9 * sw); asm volatile("" ::: "memory");
    float x10 = fmaxf(0.0f, 1.0f - fabsf(cf - 10.0f));
    s0 = 0.f; s1 = 0.f; s2 = 0.f; s3 = 0.f;
    a = *(const LAS f32x4*)(Am + 680);
    s0 = fmaf(a.x, x0, s0);
    s1 = fmaf(a.y, x1, s1);
    s2 = fmaf(a.z, x2, s2);
    s3 = fmaf(a.w, x3, s3);
    a = *(const LAS f32x4*)(Am + 684);
    s0 = fmaf(a.x, x4, s0);
    s1 = fmaf(a.y, x5, s1);
    s2 = fmaf(a.z, x6, s2);
    s3 = fmaf(a.w, x7, s3);
    a = *(const LAS f32x4*)(Am + 688);
    s0 = fmaf(a.x, x8, s0);
    const float al10 = a.y;
    x10 = (x10 - ((s0 + s1) + (s2 + s3))) - al10 * x9;
    Tu[1360 + c] = f2bf(x10 * su); Tw[1360 + c] = f2bf(x10 * sw); asm volatile("" ::: "memory");
    float x11 = fmaxf(0.0f, 1.0f - fabsf(cf - 11.0f));
    s0 = 0.f; s1 = 0.f; s2 = 0.f; s3 = 0.f;
    a = *(const LAS f32x4*)(Am + 748);
    s0 = fmaf(a.x, x0, s0);
    s1 = fmaf(a.y, x1, s1);
    s2 = fmaf(a.z, x2, s2);
    s3 = fmaf(a.w, x3, s3);
    a = *(const LAS f32x4*)(Am + 752);
    s0 = fmaf(a.x, x4, s0);
    s1 = fmaf(a.y, x5, s1);
    s2 = fmaf(a.z, x6, s2);
    s3 = fmaf(a.w, x7, s3);
    a = *(const LAS f32x4*)(Am + 756);
    s0 = fmaf(a.x, x8, s0);
    s1 = fmaf(a.y, x9, s1);
    const float al11 = a.z;
    x11 = (x11 - ((s0 + s1) + (s2 + s3))) - al11 * x10;
    Tu[1496 + c] = f2bf(x11 * su); Tw[1496 + c] = f2bf(x11 * sw); asm volatile("" ::: "memory");
    float x12 = fmaxf(0.0f, 1.0f - fabsf(cf - 12.0f));
    s0 = 0.f; s1 = 0.f; s2 = 0.f; s3 = 0.f;
    a = *(const LAS f32x4*)(Am + 816);
    s0 = fmaf(a.x, x0, s0);
    s1 = fmaf(a.y, x1, s1);
    s2 = fmaf(a.z, x2, s2);
    s3 = fmaf(a.w, x3, s3);
    a = *(const LAS f32x4*)(Am + 820);
    s0 = fmaf(a.x, x4, s0);
    s1 = fmaf(a.y, x5, s1);
    s2 = fmaf(a.z, x6, s2);
    s3 = fmaf(a.w, x7, s3);
    a = *(const LAS f32x4*)(Am + 824);
    s0 = fmaf(a.x, x8, s0);
    s1 = fmaf(a.y, x9, s1);
    s2 = fmaf(a.z, x10, s2);
    const float al12 = a.w;
    x12 = (x12 - ((s0 + s1) + (s2 + s3))) - al12 * x11;
    Tu[1632 + c] = f2bf(x12 * su); Tw[1632 + c] = f2bf(x12 * sw); asm volatile("" ::: "memory");
    float x13 = fmaxf(0.0f, 1.0f - fabsf(cf - 13.0f));
    s0 = 0.f; s1 = 0.f; s2 = 0.f; s3 = 0.f;
    a = *(const LAS f32x4*)(Am + 884);
    s0 = fmaf(a.x, x0, s0);
    s1 = fmaf(a.y, x1, s1);
    s2 = fmaf(a.z, x2, s2);
    s3 = fmaf(a.w, x3, s3);
    a = *(const LAS f32x4*)(Am + 888);
    s0 = fmaf(a.x, x4, s0);
    s1 = fmaf(a.y, x5, s1);
    s2 = fmaf(a.z, x6, s2);
    s3 = fmaf(a.w, x7, s3);
    a = *(const LAS f32x4*)(Am + 892);
    s0 = fmaf(a.x, x8, s0);
    s1 = fmaf(a.y, x9, s1);
    s2 = fmaf(a.z, x10, s2);
    s3 = fmaf(a.w, x11, s3);
    a = *(const LAS f32x4*)(Am + 896);
    const float al13 = a.x;
    x13 = (x13 - ((s0 + s1) + (s2 + s3))) - al13 * x12;
    Tu[1768 + c] = f2bf(x13 * su); Tw[1768 + c] = f2bf(x13 * sw); asm volatile("" ::: "memory");
    float x14 = fmaxf(0.0f, 1.0f - fabsf(cf - 14.0f));
    s0 = 0.f; s1 = 0.f; s2 = 0.f; s3 = 0.f;
    a = *(const LAS f32x4*)(Am + 952);
    s0 = fmaf(a.x, x0, s0);
    s1 = fmaf(a.y, x1, s1);
    s2 = fmaf(a.z, x2, s2);
    s3 = fmaf(a.w, x3, s3);
    a = *(const LAS f32x4*)(Am + 956);
    s0 = fmaf(a.x, x4, s0);
    s1 = fmaf(a.y, x5, s1);
    s2 = fmaf(a.z, x6, s2);
    s3 = fmaf(a.w, x7, s3);
    a = *(const LAS f32x4*)(Am + 960);
    s0 = fmaf(a.x, x8, s0);
    s1 = fmaf(a.y, x9, s1);
    s2 = fmaf(a.z, x10, s2);
    s3 = fmaf(a.w, x11, s3);
    a = *(const LAS f32x4*)(Am + 964);
    s0 = fmaf(a.x, x12, s0);
    const float al14 = a.y;
    x14 = (x14 - ((s0 + s1) + (s2 + s3))) - al14 * x13;
    Tu[1904 + c] = f2bf(x14 * su); Tw[1904 + c] = f2bf(x14 * sw); asm volatile("" ::: "memory");
    float x15 = fmaxf(0.0f, 1.0f - fabsf(cf - 15.0f));
    s0 = 0.f; s1 = 0.f; s2 = 0.f; s3 = 0.f;
    a = *(const LAS f32x4*)(Am + 1020);
    s0 = fmaf(a.x, x0, s0);
    s1 = fmaf(a.y, x1, s1);
    s2 = fmaf(a.z, x2, s2);
    s3 = fmaf(a.w, x3, s3);
    a = *(const LAS f32x4*)(Am + 1024);
    s0 = fmaf(a.x, x4, s0);
    s1 = fmaf(a.y, x5, s1);
    s2 = fmaf(a.z, x6, s2);
    s3 = fmaf(a.w, x7, s3);
    a = *(const LAS f32x4*)(Am + 1028);
    s0 = fmaf(a.x, x8, s0);
    s1 = fmaf(a.y, x9, s1);
    s2 = fmaf(a.z, x10, s2);
    s3 = fmaf(a.w, x11, s3);
    a = *(const LAS f32x4*)(Am + 1032);
    s0 = fmaf(a.x, x12, s0);
    s1 = fmaf(a.y, x13, s1);
    const float al15 = a.z;
    x15 = (x15 - ((s0 + s1) + (s2 + s3))) - al15 * x14;
    Tu[2040 + c] = f2bf(x15 * su); Tw[2040 + c] = f2bf(x15 * sw); asm volatile("" ::: "memory");
    float x16 = fmaxf(0.0f, 1.0f - fabsf(cf - 16.0f));
    s0 = 0.f; s1 = 0.f; s2 = 0.f; s3 = 0.f;
    a = *(const LAS f32x4*)(Am + 1088);
    s0 = fmaf(a.x, x0, s0);
    s1 = fmaf(a.y, x1, s1);
    s2 = fmaf(a.z, x2, s2);
    s3 = fmaf(a.w, x3, s3);
    a = *(const LAS f32x4*)(Am + 1092);
    s0 = fmaf(a.x, x4, s0);
    s1 = fmaf(a.y, x5, s1);
    s2 = fmaf(a.z, x6, s2);
    s3 = fmaf(a.w, x7, s3);
    a = *(const LAS f32x4*)(Am + 1096);
    s0 = fmaf(a.x, x8, s0);
    s1 = fmaf(a.y, x9, s1);
    s2 = fmaf(a.z, x10, s2);
    s3 = fmaf(a.w, x11, s3);
    a = *(const LAS f32x4*)(Am + 1100);
    s0 = fmaf(a.x, x12, s0);
    s1 = fmaf(a.y, x13, s1);
    s2 = fmaf(a.z, x14, s2);
    const float al16 = a.w;
    x16 = (x16 - ((s0 + s1) + (s2 + s3))) - al16 * x15;
    Tu[2176 + c] = f2bf(x16 * su); Tw[2176 + c] = f2bf(x16 * sw); asm volatile("" ::: "memory");
    float x17 = fmaxf(0.0f, 1.0f - fabsf(cf - 17.0f));
    s0 = 0.f; s1 = 0.f; s2 = 0.f; s3 = 0.f;
    a = *(const LAS f32x4*)(Am + 1156);
    s0 = fmaf(a.x, x0, s0);
    s1 = fmaf(a.y, x1, s1);
    s2 = fmaf(a.z, x2, s2);
    s3 = fmaf(a.w, x3, s3);
    a = *(const LAS f32x4*)(Am + 1160);
    s0 = fmaf(a.x, x4, s0);
    s1 = fmaf(a.y, x5, s1);
    s2 = fmaf(a.z, x6, s2);
    s3 = fmaf(a.w, x7, s3);
    a = *(const LAS f32x4*)(Am + 1164);
    s0 = fmaf(a.x, x8, s0);
    s1 = fmaf(a.y, x9, s1);
    s2 = fmaf(a.z, x10, s2);
    s3 = fmaf(a.w, x11, s3);
    a = *(const LAS f32x4*)(Am + 1168);
    s0 = fmaf(a.x, x12, s0);
    s1 = fmaf(a.y, x13, s1);
    s2 = fmaf(a.z, x14, s2);
    s3 = fmaf(a.w, x15, s3);
    a = *(const LAS f32x4*)(Am + 1172);
    const float al17 = a.x;
    x17 = (x17 - ((s0 + s1) + (s2 + s3))) - al17 * x16;
    Tu[2312 + c] = f2bf(x17 * su); Tw[2312 + c] = f2bf(x17 * sw); asm volatile("" ::: "memory");
    float x18 = fmaxf(0.0f, 1.0f - fabsf(cf - 18.0f));
    s0 = 0.f; s1 = 0.f; s2 = 0.f; s3 = 0.f;
    a = *(const LAS f32x4*)(Am + 1224);
    s0 = fmaf(a.x, x0, s0);
    s1 = fmaf(a.y, x1, s1);
    s2 = fmaf(a.z, x2, s2);
    s3 = fmaf(a.w, x3, s3);
    a = *(const LAS f32x4*)(Am + 1228);
    s0 = fmaf(a.x, x4, s0);
    s1 = fmaf(a.y, x5, s1);
    s2 = fmaf(a.z, x6, s2);
    s3 = fmaf(a.w, x7, s3);
    a = *(const LAS f32x4*)(Am + 1232);
    s0 = fmaf(a.x, x8, s0);
    s1 = fmaf(a.y, x9, s1);
    s2 = fmaf(a.z, x10, s2);
    s3 = fmaf(a.w, x11, s3);
    a = *(const LAS f32x4*)(Am + 1236);
    s0 = fmaf(a.x, x12, s0);
    s1 = fmaf(a.y, x13, s1);
    s2 = fmaf(a.z, x14, s2);
    s3 = fmaf(a.w, x15, s3);
    a = *(const LAS f32x4*)(Am + 1240);
    s0 = fmaf(a.x, x16, s0);
    const float al18 = a.y;
    x18 = (x18 - ((s0 + s1) + (s2 + s3))) - al18 * x17;
    Tu[2448 + c] = f2bf(x18 * su); Tw[2448 + c] = f2bf(x18 * sw); asm volatile("" ::: "memory");
    float x19 = fmaxf(0.0f, 1.0f - fabsf(cf - 19.0f));
    s0 = 0.f; s1 = 0.f; s2 = 0.f; s3 = 0.f;
    a = *(const LAS f32x4*)(Am + 1292);
    s0 = fmaf(a.x, x0, s0);
    s1 = fmaf(a.y, x1, s1);
    s2 = fmaf(a.z, x2, s2);
    s3 = fmaf(a.w, x3, s3);
    a = *(const LAS f32x4*)(Am + 1296);
    s0 = fmaf(a.x, x4, s0);
    s1 = fmaf(a.y, x5, s1);
    s2 = fmaf(a.z, x6, s2);
    s3 = fmaf(a.w, x7, s3);
    a = *(const LAS f32x4*)(Am + 1300);
    s0 = fmaf(a.x, x8, s0);
    s1 = fmaf(a.y, x9, s1);
    s2 = fmaf(a.z, x10, s2);
    s3 = fmaf(a.w, x11, s3);
    a = *(const LAS f32x4*)(Am + 1304);
    s0 = fmaf(a.x, x12, s0);
    s1 = fmaf(a.y, x13, s1);
    s2 = fmaf(a.z, x14, s2);
    s3 = fmaf(a.w, x15, s3);
    a = *(const LAS f32x4*)(Am + 1308);
    s0 = fmaf(a.x, x16, s0);
    s1 = fmaf(a.y, x17, s1);
    const float al19 = a.z;
    x19 = (x19 - ((s0 + s1) + (s2 + s3))) - al19 * x18;
    Tu[2584 + c] = f2bf(x19 * su); Tw[2584 + c] = f2bf(x19 * sw); asm volatile("" ::: "memory");
    float x20 = fmaxf(0.0f, 1.0f - fabsf(cf - 20.0f));
    s0 = 0.f; s1 = 0.f; s2 = 0.f; s3 = 0.f;
    a = *(const LAS f32x4*)(Am + 1360);
    s0 = fmaf(a.x, x0, s0);
    s1 = fmaf(a.y, x1, s1);
    s2 = fmaf(a.z, x2, s2);
    s3 = fmaf(a.w, x3, s3);
    a = *(const LAS f32x4*)(Am + 1364);
    s0 = fmaf(a.x, x4, s0);
    s1 = fmaf(a.y, x5, s1);
    s2 = fmaf(a.z, x6, s2);
    s3 = fmaf(a.w, x7, s3);
    a = *(const LAS f32x4*)(Am + 1368);
    s0 = fmaf(a.x, x8, s0);
    s1 = fmaf(a.y, x9, s1);
    s2 = fmaf(a.z, x10, s2);
    s3 = fmaf(a.w, x11, s3);
    a = *(const LAS f32x4*)(Am + 1372);
    s0 = fmaf(a.x, x12, s0);
    s1 = fmaf(a.y, x13, s1);
    s2 = fmaf(a.z, x14, s2);
    s3 = fmaf(a.w, x15, s3);
    a = *(const LAS f32x4*)(Am + 1376);
    s0 = fmaf(a.x, x16, s0);
    s1 = fmaf(a.y, x17, s1);
    s2 = fmaf(a.z, x18, s2);
    const float al20 = a.w;
    x20 = (x20 - ((s0 + s1) + (s2 + s3))) - al20 * x19;
    Tu[2720 + c] = f2bf(x20 * su); Tw[2720 + c] = f2bf(x20 * sw); asm volatile("" ::: "memory");
    float x21 = fmaxf(0.0f, 1.0f - fabsf(cf - 21.0f));
    s0 = 0.f; s1 = 0.f; s2 = 0.f; s3 = 0.f;
    a = *(const LAS f32x4*)(Am + 1428);
    s0 = fmaf(a.x, x0, s0);
    s1 = fmaf(a.y, x1, s1);
    s2 = fmaf(a.z, x2, s2);
    s3 = fmaf(a.w, x3, s3);
    a = *(const LAS f32x4*)(Am + 1432);
    s0 = fmaf(a.x, x4, s0);
    s1 = fmaf(a.y, x5, s1);
    s2 = fmaf(a.z, x6, s2);
    s3 = fmaf(a.w, x7, s3);
    a = *(const LAS f32x4*)(Am + 1436);
    s0 = fmaf(a.x, x8, s0);
    s1 = fmaf(a.y, x9, s1);
    s2 = fmaf(a.z, x10, s2);
    s3 = fmaf(a.w, x11, s3);
    a = *(const LAS f32x4*)(Am + 1440);
    s0 = fmaf(a.x, x12, s0);
    s1 = fmaf(a.y, x13, s1);
    s2 = fmaf(a.z, x14, s2);
    s3 = fmaf(a.w, x15, s3);
    a = *(const LAS f32x4*)(Am + 1444);
    s0 = fmaf(a.x, x16, s0);
    s1 = fmaf(a.y, x17, s1);
    s2 = fmaf(a.z, x18, s2);
    s3 = fmaf(a.w, x19, s3);
    a = *(const LAS f32x4*)(Am + 1448);
    const float al21 = a.x;
    x21 = (x21 - ((s0 + s1) + (s2 + s3))) - al21 * x20;
    Tu[2856 + c] = f2bf(x21 * su); Tw[2856 + c] = f2bf(x21 * sw); asm volatile("" ::: "memory");
    float x22 = fmaxf(0.0f, 1.0f - fabsf(cf - 22.0f));
    s0 = 0.f; s1 = 0.f; s2 = 0.f; s3 = 0.f;
    a = *(const LAS f32x4*)(Am + 1496);
    s0 = fmaf(a.x, x0, s0);
    s1 = fmaf(a.y, x1, s1);
    s2 = fmaf(a.z, x2, s2);
    s3 = fmaf(a.w, x3, s3);
    a = *(const LAS f32x4*)(Am + 1500);
    s0 = fmaf(a.x, x4, s0);
    s1 = fmaf(a.y, x5, s1);
    s2 = fmaf(a.z, x6, s2);
    s3 = fmaf(a.w, x7, s3);
    a = *(const LAS f32x4*)(Am + 1504);
    s0 = fmaf(a.x, x8, s0);
    s1 = fmaf(a.y, x9, s1);
    s2 = fmaf(a.z, x10, s2);
    s3 = fmaf(a.w, x11, s3);
    a = *(const LAS f32x4*)(Am + 1508);
    s0 = fmaf(a.x, x12, s0);
    s1 = fmaf(a.y, x13, s1);
    s2 = fmaf(a.z, x14, s2);
    s3 = fmaf(a.w, x15, s3);
    a = *(const LAS f32x4*)(Am + 1512);
    s0 = fmaf(a.x, x16, s0);
    s1 = fmaf(a.y, x17, s1);
    s2 = fmaf(a.z, x18, s2);
    s3 = fmaf(a.w, x19, s3);
    a = *(const LAS f32x4*)(Am + 1516);
    s0 = fmaf(a.x, x20, s0);
    const float al22 = a.y;
    x22 = (x22 - ((s0 + s1) + (s2 + s3))) - al22 * x21;
    Tu[2992 + c] = f2bf(x22 * su); Tw[2992 + c] = f2bf(x22 * sw); asm volatile("" ::: "memory");
    float x23 = fmaxf(0.0f, 1.0f - fabsf(cf - 23.0f));
    s0 = 0.f; s1 = 0.f; s2 = 0.f; s3 = 0.f;
    a = *(const LAS f32x4*)(Am + 1564);
    s0 = fmaf(a.x, x0, s0);
    s1 = fmaf(a.y, x1, s1);
    s2 = fmaf(a.z, x2, s2);
    s3 = fmaf(a.w, x3, s3);
    a = *(const LAS f32x4*)(Am + 1568);
    s0 = fmaf(a.x, x4, s0);
    s1 = fmaf(a.y, x5, s1);
    s2 = fmaf(a.z, x6, s2);
    s3 = fmaf(a.w, x7, s3);
    a = *(const LAS f32x4*)(Am + 1572);
    s0 = fmaf(a.x, x8, s0);
    s1 = fmaf(a.y, x9, s1);
    s2 = fmaf(a.z, x10, s2);
    s3 = fmaf(a.w, x11, s3);
    a = *(const LAS f32x4*)(Am + 1576);
    s0 = fmaf(a.x, x12, s0);
    s1 = fmaf(a.y, x13, s1);
    s2 = fmaf(a.z, x14, s2);
    s3 = fmaf(a.w, x15, s3);
    a = *(const LAS f32x4*)(Am + 1580);
    s0 = fmaf(a.x, x16, s0);
    s1 = fmaf(a.y, x17, s1);
    s2 = fmaf(a.z, x18, s2);
    s3 = fmaf(a.w, x19, s3);
    a = *(const LAS f32x4*)(Am + 1584);
    s0 = fmaf(a.x, x20, s0);
    s1 = fmaf(a.y, x21, s1);
    const float al23 = a.z;
    x23 = (x23 - ((s0 + s1) + (s2 + s3))) - al23 * x22;
    Tu[3128 + c] = f2bf(x23 * su); Tw[3128 + c] = f2bf(x23 * sw); asm volatile("" ::: "memory");
    float x24 = fmaxf(0.0f, 1.0f - fabsf(cf - 24.0f));
    s0 = 0.f; s1 = 0.f; s2 = 0.f; s3 = 0.f;
    a = *(const LAS f32x4*)(Am + 1632);
    s0 = fmaf(a.x, x0, s0);
    s1 = fmaf(a.y, x1, s1);
    s2 = fmaf(a.z, x2, s2);
    s3 = fmaf(a.w, x3, s3);
    a = *(const LAS f32x4*)(Am + 1636);
    s0 = fmaf(a.x, x4, s0);
    s1 = fmaf(a.y, x5, s1);
    s2 = fmaf(a.z, x6, s2);
    s3 = fmaf(a.w, x7, s3);
    a = *(const LAS f32x4*)(Am + 1640);
    s0 = fmaf(a.x, x8, s0);
    s1 = fmaf(a.y, x9, s1);
    s2 = fmaf(a.z, x10, s2);
    s3 = fmaf(a.w, x11, s3);
    a = *(const LAS f32x4*)(Am + 1644);
    s0 = fmaf(a.x, x12, s0);
    s1 = fmaf(a.y, x13, s1);
    s2 = fmaf(a.z, x14, s2);
    s3 = fmaf(a.w, x15, s3);
    a = *(const LAS f32x4*)(Am + 1648);
    s0 = fmaf(a.x, x16, s0);
    s1 = fmaf(a.y, x17, s1);
    s2 = fmaf(a.z, x18, s2);
    s3 = fmaf(a.w, x19, s3);
    a = *(const LAS f32x4*)(Am + 1652);
    s0 = fmaf(a.x, x20, s0);
    s1 = fmaf(a.y, x21, s1);
    s2 = fmaf(a.z, x22, s2);
    const float al24 = a.w;
    x24 = (x24 - ((s0 + s1) + (s2 + s3))) - al24 * x23;
    Tu[3264 + c] = f2bf(x24 * su); Tw[3264 + c] = f2bf(x24 * sw); asm volatile("" ::: "memory");
    float x25 = fmaxf(0.0f, 1.0f - fabsf(cf - 25.0f));
    s0 = 0.f; s1 = 0.f; s2 = 0.f; s3 = 0.f;
    a = *(const LAS f32x4*)(Am + 1700);
    s0 = fmaf(a.x, x0, s0);
    s1 = fmaf(a.y, x1, s1);
    s2 = fmaf(a.z, x2, s2);
    s3 = fmaf(a.w, x3, s3);
    a = *(const LAS f32x4*)(Am + 1704);
    s0 = fmaf(a.x, x4, s0);
    s1 = fmaf(a.y, x5, s1);
    s2 = fmaf(a.z, x6, s2);
    s3 = fmaf(a.w, x7, s3);
    a = *(const LAS f32x4*)(Am + 1708);
    s0 = fmaf(a.x, x8, s0);
    s1 = fmaf(a.y, x9, s1);
    s2 = fmaf(a.z, x10, s2);
    s3 = fmaf(a.w, x11, s3);
    a = *(const LAS f32x4*)(Am + 1712);
    s0 = fmaf(a.x, x12, s0);
    s1 = fmaf(a.y, x13, s1);
    s2 = fmaf(a.z, x14, s2);
    s3 = fmaf(a.w, x15, s3);
    a = *(const LAS f32x4*)(Am + 1716);
    s0 = fmaf(a.x, x16, s0);
    s1 = fmaf(a.y, x17, s1);
    s2 = fmaf(a.z, x18, s2);
    s3 = fmaf(a.w, x19, s3);
    a = *(const LAS f32x4*)(Am + 1720);
    s0 = fmaf(a.x, x20, s0);
    s1 = fmaf(a.y, x21, s1);
    s2 = fmaf(a.z, x22, s2);
    s3 = fmaf(a.w, x23, s3);
    a = *(const LAS f32x4*)(Am + 1724);
    const float al25 = a.x;
    x25 = (x25 - ((s0 + s1) + (s2 + s3))) - al25 * x24;
    Tu[3400 + c] = f2bf(x25 * su); Tw[3400 + c] = f2bf(x25 * sw); asm volatile("" ::: "memory");
    float x26 = fmaxf(0.0f, 1.0f - fabsf(cf - 26.0f));
    s0 = 0.f; s1 = 0.f; s2 = 0.f; s3 = 0.f;
    a = *(const LAS f32x4*)(Am + 1768);
    s0 = fmaf(a.x, x0, s0);
    s1 = fmaf(a.y, x1, s1);
    s2 = fmaf(a.z, x2, s2);
    s3 = fmaf(a.w, x3, s3);
    a = *(const LAS f32x4*)(Am + 1772);
    s0 = fmaf(a.x, x4, s0);
    s1 = fmaf(a.y, x5, s1);
    s2 = fmaf(a.z, x6, s2);
    s3 = fmaf(a.w, x7, s3);
    a = *(const LAS f32x4*)(Am + 1776);
    s0 = fmaf(a.x, x8, s0);
    s1 = fmaf(a.y, x9, s1);
    s2 = fmaf(a.z, x10, s2);
    s3 = fmaf(a.w, x11, s3);
    a = *(const LAS f32x4*)(Am + 1780);
    s0 = fmaf(a.x, x12, s0);
    s1 = fmaf(a.y, x13, s1);
    s2 = fmaf(a.z, x14, s2);
    s3 = fmaf(a.w, x15, s3);
    a = *(const LAS f32x4*)(Am + 1784);
    s0 = fmaf(a.x, x16, s0);
    s1 = fmaf(a.y, x17, s1);
    s2 = fmaf(a.z, x18, s2);
    s3 = fmaf(a.w, x19, s3);
    a = *(const LAS f32x4*)(Am + 1788);
    s0 = fmaf(a.x, x20, s0);
    s1 = fmaf(a.y, x21, s1);
    s2 = fmaf(a.z, x22, s2);
    s3 = fmaf(a.w, x23, s3);
    a = *(const LAS f32x4*)(Am + 1792);
    s0 = fmaf(a.x, x24, s0);
    const float al26 = a.y;
    x26 = (x26 - ((s0 + s1) + (s2 + s3))) - al26 * x25;
    Tu[3536 + c] = f2bf(x26 * su); Tw[3536 + c] = f2bf(x26 * sw); asm volatile("" ::: "memory");
    float x27 = fmaxf(0.0f, 1.0f - fabsf(cf - 27.0f));
    s0 = 0.f; s1 = 0.f; s2 = 0.f; s3 = 0.f;
    a = *(const LAS f32x4*)(Am + 1836);
    s0 = fmaf(a.x, x0, s0);
    s1 = fmaf(a.y, x1, s1);
    s2 = fmaf(a.z, x2, s2);
    s3 = fmaf(a.w, x3, s3);
    a = *(const LAS f32x4*)(Am + 1840);
    s0 = fmaf(a.x, x4, s0);
    s1 = fmaf(a.y, x5, s1);
    s2 = fmaf(a.z, x6, s2);
    s3 = fmaf(a.w, x7, s3);
    a = *(const LAS f32x4*)(Am + 1844);
    s0 = fmaf(a.x, x8, s0);
    s1 = fmaf(a.y, x9, s1);
    s2 = fmaf(a.z, x10, s2);
    s3 = fmaf(a.w, x11, s3);
    a = *(const LAS f32x4*)(Am + 1848);
    s0 = fmaf(a.x, x12, s0);
    s1 = fmaf(a.y, x13, s1);
    s2 = fmaf(a.z, x14, s2);
    s3 = fmaf(a.w, x15, s3);
    a = *(const LAS f32x4*)(Am + 1852);
    s0 = fmaf(a.x, x16, s0);
    s1 = fmaf(a.y, x17, s1);
    s2 = fmaf(a.z, x18, s2);
    s3 = fmaf(a.w, x19, s3);
    a = *(const LAS f32x4*)(Am + 1856);
    s0 = fmaf(a.x, x20, s0);
    s1 = fmaf(a.y, x21, s1);
    s2 = fmaf(a.z, x22, s2);
    s3 = fmaf(a.w, x23, s3);
    a = *(const LAS f32x4*)(Am + 1860);
    s0 = fmaf(a.x, x24, s0);
    s1 = fmaf(a.y, x25, s1);
    const float al27 = a.z;
    x27 = (x27 - ((s0 + s1) + (s2 + s3))) - al27 * x26;
    Tu[3672 + c] = f2bf(x27 * su); Tw[3672 + c] = f2bf(x27 * sw); asm volatile("" ::: "memory");
    float x28 = fmaxf(0.0f, 1.0f - fabsf(cf - 28.0f));
    s0 = 0.f; s1 = 0.f; s2 = 0.f; s3 = 0.f;
    a = *(const LAS f32x4*)(Am + 1904);
    s0 = fmaf(a.x, x0, s0);
    s1 = fmaf(a.y, x1, s1);
    s2 = fmaf(a.z, x2, s2);
    s3 = fmaf(a.w, x3, s3);
    a = *(const LAS f32x4*)(Am + 1908);
    s0 = fmaf(a.x, x4, s0);
    s1 = fmaf(a.y, x5, s1);
    s2 = fmaf(a.z, x6, s2);
    s3 = fmaf(a.w, x7, s3);
    a = *(const LAS f32x4*)(Am + 1912);
    s0 = fmaf(a.x, x8, s0);
    s1 = fmaf(a.y, x9, s1);
    s2 = fmaf(a.z, x10, s2);
    s3 = fmaf(a.w, x11, s3);
    a = *(const LAS f32x4*)(Am + 1916);
    s0 = fmaf(a.x, x12, s0);
    s1 = fmaf(a.y, x13, s1);
    s2 = fmaf(a.z, x14, s2);
    s3 = fmaf(a.w, x15, s3);
    a = *(const LAS f32x4*)(Am + 1920);
    s0 = fmaf(a.x, x16, s0);
    s1 = fmaf(a.y, x17, s1);
    s2 = fmaf(a.z, x18, s2);
    s3 = fmaf(a.w, x19, s3);
    a = *(const LAS f32x4*)(Am + 1924);
    s0 = fmaf(a.x, x20, s0);
    s1 = fmaf(a.y, x21, s1);
    s2 = fmaf(a.z, x22, s2);
    s3 = fmaf(a.w, x23, s3);
    a = *(const LAS f32x4*)(Am + 1928);
    s0 = fmaf(a.x, x24, s0);
    s1 = fmaf(a.y, x25, s1);
    s2 = fmaf(a.z, x26, s2);
    const float al28 = a.w;
    x28 = (x28 - ((s0 + s1) + (s2 + s3))) - al28 * x27;
    Tu[3808 + c] = f2bf(x28 * su); Tw[3808 + c] = f2bf(x28 * sw); asm volatile("" ::: "memory");
    float x29 = fmaxf(0.0f, 1.0f - fabsf(cf - 29.0f));
    s0 = 0.f; s1 = 0.f; s2 = 0.f; s3 = 0.f;
    a = *(const LAS f32x4*)(Am + 1972);
    s0 = fmaf(a.x, x0, s0);
    s1 = fmaf(a.y, x1, s1);
    s2 = fmaf(a.z, x2, s2);
    s3 = fmaf(a.w, x3, s3);
    a = *(const LAS f32x4*)(Am + 1976);
    s0 = fmaf(a.x, x4, s0);
    s1 = fmaf(a.y, x5, s1);
    s2 = fmaf(a.z, x6, s2);
    s3 = fmaf(a.w, x7, s3);
    a = *(const LAS f32x4*)(Am + 1980);
    s0 = fmaf(a.x, x8, s0);
    s1 = fmaf(a.y, x9, s1);
    s2 = fmaf(a.z, x10, s2);
    s3 = fmaf(a.w, x11, s3);
    a = *(const LAS f32x4*)(Am + 1984);
    s0 = fmaf(a.x, x12, s0);
    s1 = fmaf(a.y, x13, s1);
    s2 = fmaf(a.z, x14, s2);
    s3 = fmaf(a.w, x15, s3);
    a = *(const LAS f32x4*)(Am + 1988);
    s0 = fmaf(a.x, x16, s0);
    s1 = fmaf(a.y, x17, s1);
    s2 = fmaf(a.z, x18, s2);
    s3 = fmaf(a.w, x19, s3);
    a = *(const LAS f32x4*)(Am + 1992);
    s0 = fmaf(a.x, x20, s0);
    s1 = fmaf(a.y, x21, s1);
    s2 = fmaf(a.z, x22, s2);
    s3 = fmaf(a.w, x23, s3);
    a = *(const LAS f32x4*)(Am + 1996);
    s0 = fmaf(a.x, x24, s0);
    s1 = fmaf(a.y, x25, s1);
    s2 = fmaf(a.z, x26, s2);
    s3 = fmaf(a.w, x27, s3);
    a = *(const LAS f32x4*)(Am + 2000);
    const float al29 = a.x;
    x29 = (x29 - ((s0 + s1) + (s2 + s3))) - al29 * x28;
    Tu[3944 + c] = f2bf(x29 * su); Tw[3944 + c] = f2bf(x29 * sw); asm volatile("" ::: "memory");
    float x30 = fmaxf(0.0f, 1.0f - fabsf(cf - 30.0f));
    s0 = 0.f; s1 = 0.f; s2 = 0.f; s3 = 0.f;
    a = *(const LAS f32x4*)(Am + 2040);
    s0 = fmaf(a.x, x0, s0);
    s1 = fmaf(a.y, x1, s1);
    s2 = fmaf(a.z, x2, s2);
    s3 = fmaf(a.w, x3, s3);
    a = *(const LAS f32x4*)(Am + 2044);
    s0 = fmaf(a.x, x4, s0);
    s1 = fmaf(a.y, x5, s1);
    s2 = fmaf(a.z, x6, s2);
    s3 = fmaf(a.w, x7, s3);
    a = *(const LAS f32x4*)(Am + 2048);
    s0 = fmaf(a.x, x8, s0);
    s1 = fmaf(a.y, x9, s1);
    s2 = fmaf(a.z, x10, s2);
    s3 = fmaf(a.w, x11, s3);
    a = *(const LAS f32x4*)(Am + 2052);
    s0 = fmaf(a.x, x12, s0);
    s1 = fmaf(a.y, x13, s1);
    s2 = fmaf(a.z, x14, s2);
    s3 = fmaf(a.w, x15, s3);
    a = *(const LAS f32x4*)(Am + 2056);
    s0 = fmaf(a.x, x16, s0);
    s1 = fmaf(a.y, x17, s1);
    s2 = fmaf(a.z, x18, s2);
    s3 = fmaf(a.w, x19, s3);
    a = *(const LAS f32x4*)(Am + 2060);
    s0 = fmaf(a.x, x20, s0);
    s1 = fmaf(a.y, x21, s1);
    s2 = fmaf(a.z, x22, s2);
    s3 = fmaf(a.w, x23, s3);
    a = *(const LAS f32x4*)(Am + 2064);
    s0 = fmaf(a.x, x24, s0);
    s1 = fmaf(a.y, x25, s1);
    s2 = fmaf(a.z, x26, s2);
    s3 = fmaf(a.w, x27, s3);
    a = *(const LAS f32x4*)(Am + 2068);
    s0 = fmaf(a.x, x28, s0);
    const float al30 = a.y;
    x30 = (x30 - ((s0 + s1) + (s2 + s3))) - al30 * x29;
    Tu[4080 + c] = f2bf(x30 * su); Tw[4080 + c] = f2bf(x30 * sw); asm volatile("" ::: "memory");
    float x31 = fmaxf(0.0f, 1.0f - fabsf(cf - 31.0f));
    s0 = 0.f; s1 = 0.f; s2 = 0.f; s3 = 0.f;
    a = *(const LAS f32x4*)(Am + 2108);
    s0 = fmaf(a.x, x0, s0);
    s1 = fmaf(a.y, x1, s1);
    s2 = fmaf(a.z, x2, s2);
    s3 = fmaf(a.w, x3, s3);
    a = *(const LAS f32x4*)(Am + 2112);
    s0 = fmaf(a.x, x4, s0);
    s1 = fmaf(a.y, x5, s1);
    s2 = fmaf(a.z, x6, s2);
    s3 = fmaf(a.w, x7, s3);
    a = *(const LAS f32x4*)(Am + 2116);
    s0 = fmaf(a.x, x8, s0);
    s1 = fmaf(a.y, x9, s1);
    s2 = fmaf(a.z, x10, s2);
    s3 = fmaf(a.w, x11, s3);
    a = *(const LAS f32x4*)(Am + 2120);
    s0 = fmaf(a.x, x12, s0);
    s1 = fmaf(a.y, x13, s1);
    s2 = fmaf(a.z, x14, s2);
    s3 = fmaf(a.w, x15, s3);
    a = *(const LAS f32x4*)(Am + 2124);
    s0 = fmaf(a.x, x16, s0);
    s1 = fmaf(a.y, x17, s1);
    s2 = fmaf(a.z, x18, s2);
    s3 = fmaf(a.w, x19, s3);
    a = *(const LAS f32x4*)(Am + 2128);
    s0 = fmaf(a.x, x20, s0);
    s1 = fmaf(a.y, x21, s1);
    s2 = fmaf(a.z, x22, s2);
    s3 = fmaf(a.w, x23, s3);
    a = *(const LAS f32x4*)(Am + 2132);
    s0 = fmaf(a.x, x24, s0);
    s1 = fmaf(a.y, x25, s1);
    s2 = fmaf(a.z, x26, s2);
    s3 = fmaf(a.w, x27, s3);
    a = *(const LAS f32x4*)(Am + 2136);
    s0 = fmaf(a.x, x28, s0);
    s1 = fmaf(a.y, x29, s1);
    const float al31 = a.z;
    x31 = (x31 - ((s0 + s1) + (s2 + s3))) - al31 * x30;
    Tu[4216 + c] = f2bf(x31 * su); Tw[4216 + c] = f2bf(x31 * sw); asm volatile("" ::: "memory");
    float x32 = fmaxf(0.0f, 1.0f - fabsf(cf - 32.0f));
    s0 = 0.f; s1 = 0.f; s2 = 0.f; s3 = 0.f;
    a = *(const LAS f32x4*)(Am + 2176);
    s0 = fmaf(a.x, x0, s0);
    s1 = fmaf(a.y, x1, s1);
    s2 = fmaf(a.z, x2, s2);
    s3 = fmaf(a.w, x3, s3);
    a = *(const LAS f32x4*)(Am + 2180);
    s0 = fmaf(a.x, x4, s0);
    s1 = fmaf(a.y, x5, s1);
    s2 = fmaf(a.z, x6, s2);
    s3 = fmaf(a.w, x7, s3);
    a = *(const LAS f32x4*)(Am + 2184);
    s0 = fmaf(a.x, x8, s0);
    s1 = fmaf(a.y, x9, s1);
    s2 = fmaf(a.z, x10, s2);
    s3 = fmaf(a.w, x11, s3);
    a = *(const LAS f32x4*)(Am + 2188);
    s0 = fmaf(a.x, x12, s0);
    s1 = fmaf(a.y, x13, s1);
    s2 = fmaf(a.z, x14, s2);
    s3 = fmaf(a.w, x15, s3);
    a = *(const LAS f32x4*)(Am + 2192);
    s0 = fmaf(a.x, x16, s0);
    s1 = fmaf(a.y, x17, s1);
    s2 = fmaf(a.z, x18, s2);
    s3 = fmaf(a.w, x19, s3);
    a = *(const LAS f32x4*)(Am + 2196);
    s0 = fmaf(a.x, x20, s0);
    s1 = fmaf(a.y, x21, s1);
    s2 = fmaf(a.z, x22, s2);
    s3 = fmaf(a.w, x23, s3);
    a = *(const LAS f32x4*)(Am + 2200);
    s0 = fmaf(a.x, x24, s0);
    s1 = fmaf(a.y, x25, s1);
    s2 = fmaf(a.z, x26, s2);
    s3 = fmaf(a.w, x27, s3);
    a = *(const LAS f32x4*)(Am + 2204);
    s0 = fmaf(a.x, x28, s0);
    s1 = fmaf(a.y, x29, s1);
    s2 = fmaf(a.z, x30, s2);
    const float al32 = a.w;
    x32 = (x32 - ((s0 + s1) + (s2 + s3))) - al32 * x31;
    Tu[4352 + c] = f2bf(x32 * su); Tw[4352 + c] = f2bf(x32 * sw); asm volatile("" ::: "memory");
    float x33 = fmaxf(0.0f, 1.0f - fabsf(cf - 33.0f));
    s0 = 0.f; s1 = 0.f; s2 = 0.f; s3 = 0.f;
    a = *(const LAS f32x4*)(Am + 2244);
    s0 = fmaf(a.x, x0, s0);
    s1 = fmaf(a.y, x1, s1);
    s2 = fmaf(a.z, x2, s2);
    s3 = fmaf(a.w, x3, s3);
    a = *(const LAS f32x4*)(Am + 2248);
    s0 = fmaf(a.x, x4, s0);
    s1 = fmaf(a.y, x5, s1);
    s2 = fmaf(a.z, x6, s2);
    s3 = fmaf(a.w, x7, s3);
    a = *(const LAS f32x4*)(Am + 2252);
    s0 = fmaf(a.x, x8, s0);
    s1 = fmaf(a.y, x9, s1);
    s2 = fmaf(a.z, x10, s2);
    s3 = fmaf(a.w, x11, s3);
    a = *(const LAS f32x4*)(Am + 2256);
    s0 = fmaf(a.x, x12, s0);
    s1 = fmaf(a.y, x13, s1);
    s2 = fmaf(a.z, x14, s2);
    s3 = fmaf(a.w, x15, s3);
    a = *(const LAS f32x4*)(Am + 2260);
    s0 = fmaf(a.x, x16, s0);
    s1 = fmaf(a.y, x17, s1);
    s2 = fmaf(a.z, x18, s2);
    s3 = fmaf(a.w, x19, s3);
    a = *(const LAS f32x4*)(Am + 2264);
    s0 = fmaf(a.x, x20, s0);
    s1 = fmaf(a.y, x21, s1);
    s2 = fmaf(a.z, x22, s2);
    s3 = fmaf(a.w, x23, s3);
    a = *(const LAS f32x4*)(Am + 2268);
    s0 = fmaf(a.x, x24, s0);
    s1 = fmaf(a.y, x25, s1);
    s2 = fmaf(a.z, x26, s2);
    s3 = fmaf(a.w, x27, s3);
    a = *(const LAS f32x4*)(Am + 2272);
    s0 = fmaf(a.x, x28, s0);
    s1 = fmaf(a.y, x29, s1);
    s2 = fmaf(a.z, x30, s2);
    s3 = fmaf(a.w, x31, s3);
    a = *(const LAS f32x4*)(Am + 2276);
    const float al33 = a.x;
    x33 = (x33 - ((s0 + s1) + (s2 + s3))) - al33 * x32;
    Tu[4488 + c] = f2bf(x33 * su); Tw[4488 + c] = f2bf(x33 * sw); asm volatile("" ::: "memory");
    float x34 = fmaxf(0.0f, 1.0f - fabsf(cf - 34.0f));
    s0 = 0.f; s1 = 0.f; s2 = 0.f; s3 = 0.f;
    a = *(const LAS f32x4*)(Am + 2312);
    s0 = fmaf(a.x, x0, s0);
    s1 = fmaf(a.y, x1, s1);
    s2 = fmaf(a.z, x2, s2);
    s3 = fmaf(a.w, x3, s3);
    a = *(const LAS f32x4*)(Am + 2316);
    s0 = fmaf(a.x, x4, s0);
    s1 = fmaf(a.y, x5, s1);
    s2 = fmaf(a.z, x6, s2);
    s3 = fmaf(a.w, x7, s3);
    a = *(const LAS f32x4*)(Am + 2320);
    s0 = fmaf(a.x, x8, s0);
    s1 = fmaf(a.y, x9, s1);
    s2 = fmaf(a.z, x10, s2);
    s3 = fmaf(a.w, x11, s3);
    a = *(const LAS f32x4*)(Am + 2324);
    s0 = fmaf(a.x, x12, s0);
    s1 = fmaf(a.y, x13, s1);
    s2 = fmaf(a.z, x14, s2);
    s3 = fmaf(a.w, x15, s3);
    a = *(const LAS f32x4*)(Am + 2328);
    s0 = fmaf(a.x, x16, s0);
    s1 = fmaf(a.y, x17, s1);
    s2 = fmaf(a.z, x18, s2);
    s3 = fmaf(a.w, x19, s3);
    a = *(const LAS f32x4*)(Am + 2332);
    s0 = fmaf(a.x, x20, s0);
    s1 = fmaf(a.y, x21, s1);
    s2 = fmaf(a.z, x22, s2);
    s3 = fmaf(a.w, x23, s3);
    a = *(const LAS f32x4*)(Am + 2336);
    s0 = fmaf(a.x, x24, s0);
    s1 = fmaf(a.y, x25, s1);
    s2 = fmaf(a.z, x26, s2);
    s3 = fmaf(a.w, x27, s3);
    a = *(const LAS f32x4*)(Am + 2340);
    s0 = fmaf(a.x, x28, s0);
    s1 = fmaf(a.y, x29, s1);
    s2 = fmaf(a.z, x30, s2);
    s3 = fmaf(a.w, x31, s3);
    a = *(const LAS f32x4*)(Am + 2344);
    s0 = fmaf(a.x, x32, s0);
    const float al34 = a.y;
    x34 = (x34 - ((s0 + s1) + (s2 + s3))) - al34 * x33;
    Tu[4624 + c] = f2bf(x34 * su); Tw[4624 + c] = f2bf(x34 * sw); asm volatile("" ::: "memory");
    float x35 = fmaxf(0.0f, 1.0f - fabsf(cf - 35.0f));
    s0 = 0.f; s1 = 0.f; s2 = 0.f; s3 = 0.f;
    a = *(const LAS f32x4*)(Am + 2380);
    s0 = fmaf(a.x, x0, s0);
    s1 = fmaf(a.y, x1, s1);
    s2 = fmaf(a.z, x2, s2);
    s3 = fmaf(a.w, x3, s3);
    a = *(const LAS f32x4*)(Am + 2384);
    s0 = fmaf(a.x, x4, s0);
    s1 = fmaf(a.y, x5, s1);
    s2 = fmaf(a.z, x6, s2);
    s3 = fmaf(a.w, x7, s3);
    a = *(const LAS f32x4*)(Am + 2388);
    s0 = fmaf(a.x, x8, s0);
    s1 = fmaf(a.y, x9, s1);
    s2 = fmaf(a.z, x10, s2);
    s3 = fmaf(a.w, x11, s3);
    a = *(const LAS f32x4*)(Am + 2392);
    s0 = fmaf(a.x, x12, s0);
    s1 = fmaf(a.y, x13, s1);
    s2 = fmaf(a.z, x14, s2);
    s3 = fmaf(a.w, x15, s3);
    a = *(const LAS f32x4*)(Am + 2396);
    s0 = fmaf(a.x, x16, s0);
    s1 = fmaf(a.y, x17, s1);
    s2 = fmaf(a.z, x18, s2);
    s3 = fmaf(a.w, x19, s3);
    a = *(const LAS f32x4*)(Am + 2400);
    s0 = fmaf(a.x, x20, s0);
    s1 = fmaf(a.y, x21, s1);
    s2 = fmaf(a.z, x22, s2);
    s3 = fmaf(a.w, x23, s3);
    a = *(const LAS f32x4*)(Am + 2404);
    s0 = fmaf(a.x, x24, s0);
    s1 = fmaf(a.y, x25, s1);
    s2 = fmaf(a.z, x26, s2);
    s3 = fmaf(a.w, x27, s3);
    a = *(const LAS f32x4*)(Am + 2408);
    s0 = fmaf(a.x, x28, s0);
    s1 = fmaf(a.y, x29, s1);
    s2 = fmaf(a.z, x30, s2);
    s3 = fmaf(a.w, x31, s3);
    a = *(const LAS f32x4*)(Am + 2412);
    s0 = fmaf(a.x, x32, s0);
    s1 = fmaf(a.y, x33, s1);
    const float al35 = a.z;
    x35 = (x35 - ((s0 + s1) + (s2 + s3))) - al35 * x34;
    Tu[4760 + c] = f2bf(x35 * su); Tw[4760 + c] = f2bf(x35 * sw); asm volatile("" ::: "memory");
    float x36 = fmaxf(0.0f, 1.0f - fabsf(cf - 36.0f));
    s0 = 0.f; s1 = 0.f; s2 = 0.f; s3 = 0.f;
    a = *(const LAS f32x4*)(Am + 2448);
    s0 = fmaf(a.x, x0, s0);
    s1 = fmaf(a.y, x1, s1);
    s2 = fmaf(a.z, x2, s2);
    s3 = fmaf(a.w, x3, s3);
    a = *(const LAS f32x4*)(Am + 2452);
    s0 = fmaf(a.x, x4, s0);
    s1 = fmaf(a.y, x5, s1);
    s2 = fmaf(a.z, x6, s2);
    s3 = fmaf(a.w, x7, s3);
    a = *(const LAS f32x4*)(Am + 2456);
    s0 = fmaf(a.x, x8, s0);
    s1 = fmaf(a.y, x9, s1);
    s2 = fmaf(a.z, x10, s2);
    s3 = fmaf(a.w, x11, s3);
    a = *(const LAS f32x4*)(Am + 2460);
    s0 = fmaf(a.x, x12, s0);
    s1 = fmaf(a.y, x13, s1);
    s2 = fmaf(a.z, x14, s2);
    s3 = fmaf(a.w, x15, s3);
    a = *(const LAS f32x4*)(Am + 2464);
    s0 = fmaf(a.x, x16, s0);
    s1 = fmaf(a.y, x17, s1);
    s2 = fmaf(a.z, x18, s2);
    s3 = fmaf(a.w, x19, s3);
    a = *(const LAS f32x4*)(Am + 2468);
    s0 = fmaf(a.x, x20, s0);
    s1 = fmaf(a.y, x21, s1);
    s2 = fmaf(a.z, x22, s2);
    s3 = fmaf(a.w, x23, s3);
    a = *(const LAS f32x4*)(Am + 2472);
    s0 = fmaf(a.x, x24, s0);
    s1 = fmaf(a.y, x25, s1);
    s2 = fmaf(a.z, x26, s2);
    s3 = fmaf(a.w, x27, s3);
    a = *(const LAS f32x4*)(Am + 2476);
    s0 = fmaf(a.x, x28, s0);
    s1 = fmaf(a.y, x29, s1);
    s2 = fmaf(a.z, x30, s2);
    s3 = fmaf(a.w, x31, s3);
    a = *(const LAS f32x4*)(Am + 2480);
    s0 = fmaf(a.x, x32, s0);
    s1 = fmaf(a.y, x33, s1);
    s2 = fmaf(a.z, x34, s2);
    const float al36 = a.w;
    x36 = (x36 - ((s0 + s1) + (s2 + s3))) - al36 * x35;
    Tu[4896 + c] = f2bf(x36 * su); Tw[4896 + c] = f2bf(x36 * sw); asm volatile("" ::: "memory");
    float x37 = fmaxf(0.0f, 1.0f - fabsf(cf - 37.0f));
    s0 = 0.f; s1 = 0.f; s2 = 0.f; s3 = 0.f;
    a = *(const LAS f32x4*)(Am + 2516);
    s0 = fmaf(a.x, x0, s0);
    s1 = fmaf(a.y, x1, s1);
    s2 = fmaf(a.z, x2, s2);
    s3 = fmaf(a.w, x3, s3);
    a = *(const LAS f32x4*)(Am + 2520);
    s0 = fmaf(a.x, x4, s0);
    s1 = fmaf(a.y, x5, s1);
    s2 = fmaf(a.z, x6, s2);
    s3 = fmaf(a.w, x7, s3);
    a = *(const LAS f32x4*)(Am + 2524);
    s0 = fmaf(a.x, x8, s0);
    s1 = fmaf(a.y, x9, s1);
    s2 = fmaf(a.z, x10, s2);
    s3 = fmaf(a.w, x11, s3);
    a = *(const LAS f32x4*)(Am + 2528);
    s0 = fmaf(a.x, x12, s0);
    s1 = fmaf(a.y, x13, s1);
    s2 = fmaf(a.z, x14, s2);
    s3 = fmaf(a.w, x15, s3);
    a = *(const LAS f32x4*)(Am + 2532);
    s0 = fmaf(a.x, x16, s0);
    s1 = fmaf(a.y, x17, s1);
    s2 = fmaf(a.z, x18, s2);
    s3 = fmaf(a.w, x19, s3);
    a = *(const LAS f32x4*)(Am + 2536);
    s0 = fmaf(a.x, x20, s0);
    s1 = fmaf(a.y, x21, s1);
    s2 = fmaf(a.z, x22, s2);
    s3 = fmaf(a.w, x23, s3);
    a = *(const LAS f32x4*)(Am + 2540);
    s0 = fmaf(a.x, x24, s0);
    s1 = fmaf(a.y, x25, s1);
    s2 = fmaf(a.z, x26, s2);
    s3 = fmaf(a.w, x27, s3);
    a = *(const LAS f32x4*)(Am + 2544);
    s0 = fmaf(a.x, x28, s0);
    s1 = fmaf(a.y, x29, s1);
    s2 = fmaf(a.z, x30, s2);
    s3 = fmaf(a.w, x31, s3);
    a = *(const LAS f32x4*)(Am + 2548);
    s0 = fmaf(a.x, x32, s0);
    s1 = fmaf(a.y, x33, s1);
    s2 = fmaf(a.z, x34, s2);
    s3 = fmaf(a.w, x35, s3);
    a = *(const LAS f32x4*)(Am + 2552);
    const float al37 = a.x;
    x37 = (x37 - ((s0 + s1) + (s2 + s3))) - al37 * x36;
    Tu[5032 + c] = f2bf(x37 * su); Tw[5032 + c] = f2bf(x37 * sw); asm volatile("" ::: "memory");
    float x38 = fmaxf(0.0f, 1.0f - fabsf(cf - 38.0f));
    s0 = 0.f; s1 = 0.f; s2 = 0.f; s3 = 0.f;
    a = *(const LAS f32x4*)(Am + 2584);
    s0 = fmaf(a.x, x0, s0);
    s1 = fmaf(a.y, x1, s1);
    s2 = fmaf(a.z, x2, s2);
    s3 = fmaf(a.w, x3, s3);
    a = *(const LAS f32x4*)(Am + 2588);
    s0 = fmaf(a.x, x4, s0);
    s1 = fmaf(a.y, x5, s1);
    s2 = fmaf(a.z, x6, s2);
    s3 = fmaf(a.w, x7, s3);
    a = *(const LAS f32x4*)(Am + 2592);
    s0 = fmaf(a.x, x8, s0);
    s1 = fmaf(a.y, x9, s1);
    s2 = fmaf(a.z, x10, s2);
    s3 = fmaf(a.w, x11, s3);
    a = *(const LAS f32x4*)(Am + 2596);
    s0 = fmaf(a.x, x12, s0);
    s1 = fmaf(a.y, x13, s1);
    s2 = fmaf(a.z, x14, s2);
    s3 = fmaf(a.w, x15, s3);
    a = *(const LAS f32x4*)(Am + 2600);
    s0 = fmaf(a.x, x16, s0);
    s1 = fmaf(a.y, x17, s1);
    s2 = fmaf(a.z, x18, s2);
    s3 = fmaf(a.w, x19, s3);
    a = *(const LAS f32x4*)(Am + 2604);
    s0 = fmaf(a.x, x20, s0);
    s1 = fmaf(a.y, x21, s1);
    s2 = fmaf(a.z, x22, s2);
    s3 = fmaf(a.w, x23, s3);
    a = *(const LAS f32x4*)(Am + 2608);
    s0 = fmaf(a.x, x24, s0);
    s1 = fmaf(a.y, x25, s1);
    s2 = fmaf(a.z, x26, s2);
    s3 = fmaf(a.w, x27, s3);
    a = *(const LAS f32x4*)(Am + 2612);
    s0 = fmaf(a.x, x28, s0);
    s1 = fmaf(a.y, x29, s1);
    s2 = fmaf(a.z, x30, s2);
    s3 = fmaf(a.w, x31, s3);
    a = *(const LAS f32x4*)(Am + 2616);
    s0 = fmaf(a.x, x32, s0);
    s1 = fmaf(a.y, x33, s1);
    s2 = fmaf(a.z, x34, s2);
    s3 = fmaf(a.w, x35, s3);
    a = *(const LAS f32x4*)(Am + 2620);
    s0 = fmaf(a.x, x36, s0);
    const float al38 = a.y;
    x38 = (x38 - ((s0 + s1) + (s2 + s3))) - al38 * x37;
    Tu[5168 + c] = f2bf(x38 * su); Tw[5168 + c] = f2bf(x38 * sw); asm volatile("" ::: "memory");
    float x39 = fmaxf(0.0f, 1.0f - fabsf(cf - 39.0f));
    s0 = 0.f; s1 = 0.f; s2 = 0.f; s3 = 0.f;
    a = *(const LAS f32x4*)(Am + 2652);
    s0 = fmaf(a.x, x0, s0);
    s1 = fmaf(a.y, x1, s1);
    s2 = fmaf(a.z, x2, s2);
    s3 = fmaf(a.w, x3, s3);
    a = *(const LAS f32x4*)(Am + 2656);
    s0 = fmaf(a.x, x4, s0);
    s1 = fmaf(a.y, x5, s1);
    s2 = fmaf(a.z, x6, s2);
    s3 = fmaf(a.w, x7, s3);
    a = *(const LAS f32x4*)(Am + 2660);
    s0 = fmaf(a.x, x8, s0);
    s1 = fmaf(a.y, x9, s1);
    s2 = fmaf(a.z, x10, s2);
    s3 = fmaf(a.w, x11, s3);
    a = *(const LAS f32x4*)(Am + 2664);
    s0 = fmaf(a.x, x12, s0);
    s1 = fmaf(a.y, x13, s1);
    s2 = fmaf(a.z, x14, s2);
    s3 = fmaf(a.w, x15, s3);
    a = *(const LAS f32x4*)(Am + 2668);
    s0 = fmaf(a.x, x16, s0);
    s1 = fmaf(a.y, x17, s1);
    s2 = fmaf(a.z, x18, s2);
    s3 = fmaf(a.w, x19, s3);
    a = *(const LAS f32x4*)(Am + 2672);
    s0 = fmaf(a.x, x20, s0);
    s1 = fmaf(a.y, x21, s1);
    s2 = fmaf(a.z, x22, s2);
    s3 = fmaf(a.w, x23, s3);
    a = *(const LAS f32x4*)(Am + 2676);
    s0 = fmaf(a.x, x24, s0);
    s1 = fmaf(a.y, x25, s1);
    s2 = fmaf(a.z, x26, s2);
    s3 = fmaf(a.w, x27, s3);
    a = *(const LAS f32x4*)(Am + 2680);
    s0 = fmaf(a.x, x28, s0);
    s1 = fmaf(a.y, x29, s1);
    s2 = fmaf(a.z, x30, s2);
    s3 = fmaf(a.w, x31, s3);
    a = *(const LAS f32x4*)(Am + 2684);
    s0 = fmaf(a.x, x32, s0);
    s1 = fmaf(a.y, x33, s1);
    s2 = fmaf(a.z, x34, s2);
    s3 = fmaf(a.w, x35, s3);
    a = *(const LAS f32x4*)(Am + 2688);
    s0 = fmaf(a.x, x36, s0);
    s1 = fmaf(a.y, x37, s1);
    const float al39 = a.z;
    x39 = (x39 - ((s0 + s1) + (s2 + s3))) - al39 * x38;
    Tu[5304 + c] = f2bf(x39 * su); Tw[5304 + c] = f2bf(x39 * sw); asm volatile("" ::: "memory");
    float x40 = fmaxf(0.0f, 1.0f - fabsf(cf - 40.0f));
    s0 = 0.f; s1 = 0.f; s2 = 0.f; s3 = 0.f;
    a = *(const LAS f32x4*)(Am + 2720);
    s0 = fmaf(a.x, x0, s0);
    s1 = fmaf(a.y, x1, s1);
    s2 = fmaf(a.z, x2, s2);
    s3 = fmaf(a.w, x3, s3);
    a = *(const LAS f32x4*)(Am + 2724);
    s0 = fmaf(a.x, x4, s0);
    s1 = fmaf(a.y, x5, s1);
    s2 = fmaf(a.z, x6, s2);
    s3 = fmaf(a.w, x7, s3);
    a = *(const LAS f32x4*)(Am + 2728);
    s0 = fmaf(a.x, x8, s0);
    s1 = fmaf(a.y, x9, s1);
    s2 = fmaf(a.z, x10, s2);
    s3 = fmaf(a.w, x11, s3);
    a = *(const LAS f32x4*)(Am + 2732);
    s0 = fmaf(a.x, x12, s0);
    s1 = fmaf(a.y, x13, s1);
    s2 = fmaf(a.z, x14, s2);
    s3 = fmaf(a.w, x15, s3);
    a = *(const LAS f32x4*)(Am + 2736);
    s0 = fmaf(a.x, x16, s0);
    s1 = fmaf(a.y, x17, s1);
    s2 = fmaf(a.z, x18, s2);
    s3 = fmaf(a.w, x19, s3);
    a = *(const LAS f32x4*)(Am + 2740);
    s0 = fmaf(a.x, x20, s0);
    s1 = fmaf(a.y, x21, s1);
    s2 = fmaf(a.z, x22, s2);
    s3 = fmaf(a.w, x23, s3);
    a = *(const LAS f32x4*)(Am + 2744);
    s0 = fmaf(a.x, x24, s0);
    s1 = fmaf(a.y, x25, s1);
    s2 = fmaf(a.z, x26, s2);
    s3 = fmaf(a.w, x27, s3);
    a = *(const LAS f32x4*)(Am + 2748);
    s0 = fmaf(a.x, x28, s0);
    s1 = fmaf(a.y, x29, s1);
    s2 = fmaf(a.z, x30, s2);
    s3 = fmaf(a.w, x31, s3);
    a = *(const LAS f32x4*)(Am + 2752);
    s0 = fmaf(a.x, x32, s0);
    s1 = fmaf(a.y, x33, s1);
    s2 = fmaf(a.z, x34, s2);
    s3 = fmaf(a.w, x35, s3);
    a = *(const LAS f32x4*)(Am + 2756);
    s0 = fmaf(a.x, x36, s0);
    s1 = fmaf(a.y, x37, s1);
    s2 = fmaf(a.z, x38, s2);
    const float al40 = a.w;
    x40 = (x40 - ((s0 + s1) + (s2 + s3))) - al40 * x39;
    Tu[5440 + c] = f2bf(x40 * su); Tw[5440 + c] = f2bf(x40 * sw); asm volatile("" ::: "memory");
    float x41 = fmaxf(0.0f, 1.0f - fabsf(cf - 41.0f));
    s0 = 0.f; s1 = 0.f; s2 = 0.f; s3 = 0.f;
    a = *(const LAS f32x4*)(Am + 2788);
    s0 = fmaf(a.x, x0, s0);
    s1 = fmaf(a.y, x1, s1);
    s2 = fmaf(a.z, x2, s2);
    s3 = fmaf(a.w, x3, s3);
    a = *(const LAS f32x4*)(Am + 2792);
    s0 = fmaf(a.x, x4, s0);
    s1 = fmaf(a.y, x5, s1);
    s2 = fmaf(a.z, x6, s2);
    s3 = fmaf(a.w, x7, s3);
    a = *(const LAS f32x4*)(Am + 2796);
    s0 = fmaf(a.x, x8, s0);
    s1 = fmaf(a.y, x9, s1);
    s2 = fmaf(a.z, x10, s2);
    s3 = fmaf(a.w, x11, s3);
    a = *(const LAS f32x4*)(Am + 2800);
    s0 = fmaf(a.x, x12, s0);
    s1 = fmaf(a.y, x13, s1);
    s2 = fmaf(a.z, x14, s2);
    s3 = fmaf(a.w, x15, s3);
    a = *(const LAS f32x4*)(Am + 2804);
    s0 = fmaf(a.x, x16, s0);
    s1 = fmaf(a.y, x17, s1);
    s2 = fmaf(a.z, x18, s2);
    s3 = fmaf(a.w, x19, s3);
    a = *(const LAS f32x4*)(Am + 2808);
    s0 = fmaf(a.x, x20, s0);
    s1 = fmaf(a.y, x21, s1);
    s2 = fmaf(a.z, x22, s2);
    s3 = fmaf(a.w, x23, s3);
    a = *(const LAS f32x4*)(Am + 2812);
    s0 = fmaf(a.x, x24, s0);
    s1 = fmaf(a.y, x25, s1);
    s2 = fmaf(a.z, x26, s2);
    s3 = fmaf(a.w, x27, s3);
    a = *(const LAS f32x4*)(Am + 2816);
    s0 = fmaf(a.x, x28, s0);
    s1 = fmaf(a.y, x29, s1);
    s2 = fmaf(a.z, x30, s2);
    s3 = fmaf(a.w, x31, s3);
    a = *(const LAS f32x4*)(Am + 2820);
    s0 = fmaf(a.x, x32, s0);
    s1 = fmaf(a.y, x33, s1);
    s2 = fmaf(a.z, x34, s2);
    s3 = fmaf(a.w, x35, s3);
    a = *(const LAS f32x4*)(Am + 2824);
    s0 = fmaf(a.x, x36, s0);
    s1 = fmaf(a.y, x37, s1);
    s2 = fmaf(a.z, x38, s2);
    s3 = fmaf(a.w, x39, s3);
    a = *(const LAS f32x4*)(Am + 2828);
    const float al41 = a.x;
    x41 = (x41 - ((s0 + s1) + (s2 + s3))) - al41 * x40;
    Tu[5576 + c] = f2bf(x41 * su); Tw[5576 + c] = f2bf(x41 * sw); asm volatile("" ::: "memory");
    float x42 = fmaxf(0.0f, 1.0f - fabsf(cf - 42.0f));
    s0 = 0.f; s1 = 0.f; s2 = 0.f; s3 = 0.f;
    a = *(const LAS f32x4*)(Am + 2856);
    s0 = fmaf(a.x, x0, s0);
    s1 = fmaf(a.y, x1, s1);
    s2 = fmaf(a.z, x2, s2);
    s3 = fmaf(a.w, x3, s3);
    a = *(const LAS f32x4*)(Am + 2860);
    s0 = fmaf(a.x, x4, s0);
    s1 = fmaf(a.y, x5, s1);
    s2 = fmaf(a.z, x6, s2);
    s3 = fmaf(a.w, x7, s3);
    a = *(const LAS f32x4*)(Am + 2864);
    s0 = fmaf(a.x, x8, s0);
    s1 = fmaf(a.y, x9, s1);
    s2 = fmaf(a.z, x10, s2);
    s3 = fmaf(a.w, x11, s3);
    a = *(const LAS f32x4*)(Am + 2868);
    s0 = fmaf(a.x, x12, s0);
    s1 = fmaf(a.y, x13, s1);
    s2 = fmaf(a.z, x14, s2);
    s3 = fmaf(a.w, x15, s3);
    a = *(const LAS f32x4*)(Am + 2872);
    s0 = fmaf(a.x, x16, s0);
    s1 = fmaf(a.y, x17, s1);
    s2 = fmaf(a.z, x18, s2);
    s3 = fmaf(a.w, x19, s3);
    a = *(const LAS f32x4*)(Am + 2876);
    s0 = fmaf(a.x, x20, s0);
    s1 = fmaf(a.y, x21, s1);
    s2 = fmaf(a.z, x22, s2);
    s3 = fmaf(a.w, x23, s3);
    a = *(const LAS f32x4*)(Am + 2880);
    s0 = fmaf(a.x, x24, s0);
    s1 = fmaf(a.y, x25, s1);
    s2 = fmaf(a.z, x26, s2);
    s3 = fmaf(a.w, x27, s3);
    a = *(const LAS f32x4*)(Am + 2884);
    s0 = fmaf(a.x, x28, s0);
    s1 = fmaf(a.y, x29, s1);
    s2 = fmaf(a.z, x30, s2);
    s3 = fmaf(a.w, x31, s3);
    a = *(const LAS f32x4*)(Am + 2888);
    s0 = fmaf(a.x, x32, s0);
    s1 = fmaf(a.y, x33, s1);
    s2 = fmaf(a.z, x34, s2);
    s3 = fmaf(a.w, x35, s3);
    a = *(const LAS f32x4*)(Am + 2892);
    s0 = fmaf(a.x, x36, s0);
    s1 = fmaf(a.y, x37, s1);
    s2 = fmaf(a.z, x38, s2);
    s3 = fmaf(a.w, x39, s3);
    a = *(const LAS f32x4*)(Am + 2896);
    s0 = fmaf(a.x, x40, s0);
    const float al42 = a.y;
    x42 = (x42 - ((s0 + s1) + (s2 + s3))) - al42 * x41;
    Tu[5712 + c] = f2bf(x42 * su); Tw[5712 + c] = f2bf(x42 * sw); asm volatile("" ::: "memory");
    float x43 = fmaxf(0.0f, 1.0f - fabsf(cf - 43.0f));
    s0 = 0.f; s1 = 0.f; s2 = 0.f; s3 = 0.f;
    a = *(const LAS f32x4*)(Am + 2924);
    s0 = fmaf(a.x, x0, s0);
    s1 = fmaf(a.y, x1, s1);
    s2 = fmaf(a.z, x2, s2);
    s3 = fmaf(a.w, x3, s3);
    a = *(const LAS f32x4*)(Am + 2928);
    s0 = fmaf(a.x, x4, s0);
    s1 = fmaf(a.y, x5, s1);
    s2 = fmaf(a.z, x6, s2);
    s3 = fmaf(a.w, x7, s3);
    a = *(const LAS f32x4*)(Am + 2932);
    s0 = fmaf(a.x, x8, s0);
    s1 = fmaf(a.y, x9, s1);
    s2 = fmaf(a.z, x10, s2);
    s3 = fmaf(a.w, x11, s3);
    a = *(const LAS f32x4*)(Am + 2936);
    s0 = fmaf(a.x, x12, s0);
    s1 = fmaf(a.y, x13, s1);
    s2 = fmaf(a.z, x14, s2);
    s3 = fmaf(a.w, x15, s3);
    a = *(const LAS f32x4*)(Am + 2940);
    s0 = fmaf(a.x, x16, s0);
    s1 = fmaf(a.y, x17, s1);
    s2 = fmaf(a.z, x18, s2);
    s3 = fmaf(a.w, x19, s3);
    a = *(const LAS f32x4*)(Am + 2944);
    s0 = fmaf(a.x, x20, s0);
    s1 = fmaf(a.y, x21, s1);
    s2 = fmaf(a.z, x22, s2);
    s3 = fmaf(a.w, x23, s3);
    a = *(const LAS f32x4*)(Am + 2948);
    s0 = fmaf(a.x, x24, s0);
    s1 = fmaf(a.y, x25, s1);
    s2 = fmaf(a.z, x26, s2);
    s3 = fmaf(a.w, x27, s3);
    a = *(const LAS f32x4*)(Am + 2952);
    s0 = fmaf(a.x, x28, s0);
    s1 = fmaf(a.y, x29, s1);
    s2 = fmaf(a.z, x30, s2);
    s3 = fmaf(a.w, x31, s3);
    a = *(const LAS f32x4*)(Am + 2956);
    s0 = fmaf(a.x, x32, s0);
    s1 = fmaf(a.y, x33, s1);
    s2 = fmaf(a.z, x34, s2);
    s3 = fmaf(a.w, x35, s3);
    a = *(const LAS f32x4*)(Am + 2960);
    s0 = fmaf(a.x, x36, s0);
    s1 = fmaf(a.y, x37, s1);
    s2 = fmaf(a.z, x38, s2);
    s3 = fmaf(a.w, x39, s3);
    a = *(const LAS f32x4*)(Am + 2964);
    s0 = fmaf(a.x, x40, s0);
    s1 = fmaf(a.y, x41, s1);
    const float al43 = a.z;
    x43 = (x43 - ((s0 + s1) + (s2 + s3))) - al43 * x42;
    Tu[5848 + c] = f2bf(x43 * su); Tw[5848 + c] = f2bf(x43 * sw); asm volatile("" ::: "memory");
    float x44 = fmaxf(0.0f, 1.0f - fabsf(cf - 44.0f));
    s0 = 0.f; s1 = 0.f; s2 = 0.f; s3 = 0.f;
    a = *(const LAS f32x4*)(Am + 2992);
    s0 = fmaf(a.x, x0, s0);
    s1 = fmaf(a.y, x1, s1);
    s2 = fmaf(a.z, x2, s2);
    s3 = fmaf(a.w, x3, s3);
    a = *(const LAS f32x4*)(Am + 2996);
    s0 = fmaf(a.x, x4, s0);
    s1 = fmaf(a.y, x5, s1);
    s2 = fmaf(a.z, x6, s2);
    s3 = fmaf(a.w, x7, s3);
    a = *(const LAS f32x4*)(Am + 3000);
    s0 = fmaf(a.x, x8, s0);
    s1 = fmaf(a.y, x9, s1);
    s2 = fmaf(a.z, x10, s2);
    s3 = fmaf(a.w, x11, s3);
    a = *(const LAS f32x4*)(Am + 3004);
    s0 = fmaf(a.x, x12, s0);
    s1 = fmaf(a.y, x13, s1);
    s2 = fmaf(a.z, x14, s2);
    s3 = fmaf(a.w, x15, s3);
    a = *(const LAS f32x4*)(Am + 3008);
    s0 = fmaf(a.x, x16, s0);
    s1 = fmaf(a.y, x17, s1);
    s2 = fmaf(a.z, x18, s2);
    s3 = fmaf(a.w, x19, s3);
    a = *(const LAS f32x4*)(Am + 3012);
    s0 = fmaf(a.x, x20, s0);
    s1 = fmaf(a.y, x21, s1);
    s2 = fmaf(a.z, x22, s2);
    s3 = fmaf(a.w, x23, s3);
    a = *(const LAS f32x4*)(Am + 3016);
    s0 = fmaf(a.x, x24, s0);
    s1 = fmaf(a.y, x25, s1);
    s2 = fmaf(a.z, x26, s2);
    s3 = fmaf(a.w, x27, s3);
    a = *(const LAS f32x4*)(Am + 3020);
    s0 = fmaf(a.x, x28, s0);
    s1 = fmaf(a.y, x29, s1);
    s2 = fmaf(a.z, x30, s2);
    s3 = fmaf(a.w, x31, s3);
    a = *(const LAS f32x4*)(Am + 3024);
    s0 = fmaf(a.x, x32, s0);
    s1 = fmaf(a.y, x33, s1);
    s2 = fmaf(a.z, x34, s2);
    s3 = fmaf(a.w, x35, s3);
    a = *(const LAS f32x4*)(Am + 3028);
    s0 = fmaf(a.x, x36, s0);
    s1 = fmaf(a.y, x37, s1);
    s2 = fmaf(a.z, x38, s2);
    s3 = fmaf(a.w, x39, s3);
    a = *(const LAS f32x4*)(Am + 3032);
    s0 = fmaf(a.x, x40, s0);
    s1 = fmaf(a.y, x41, s1);
    s2 = fmaf(a.z, x42, s2);
    const float al44 = a.w;
    x44 = (x44 - ((s0 + s1) + (s2 + s3))) - al44 * x43;
    Tu[5984 + c] = f2bf(x44 * su); Tw[5984 + c] = f2bf(x44 * sw); asm volatile("" ::: "memory");
    float x45 = fmaxf(0.0f, 1.0f - fabsf(cf - 45.0f));
    s0 = 0.f; s1 = 0.f; s2 = 0.f; s3 = 0.f;
    a = *(const LAS f32x4*)(Am + 3060);
    s0 = fmaf(a.x, x0, s0);
    s1 = fmaf(a.y, x1, s1);
    s2 = fmaf(a.z, x2, s2);
    s3 = fmaf(a.w, x3, s3);
    a = *(const LAS f32x4*)(Am + 3064);
    s0 = fmaf(a.x, x4, s0);
    s1 = fmaf(a.y, x5, s1);
    s2 = fmaf(a.z, x6, s2);
    s3 = fmaf(a.w, x7, s3);
    a = *(const LAS f32x4*)(Am + 3068);
    s0 = fmaf(a.x, x8, s0);
    s1 = fmaf(a.y, x9, s1);
    s2 = fmaf(a.z, x10, s2);
    s3 = fmaf(a.w, x11, s3);
    a = *(const LAS f32x4*)(Am + 3072);
    s0 = fmaf(a.x, x12, s0);
    s1 = fmaf(a.y, x13, s1);
    s2 = fmaf(a.z, x14, s2);
    s3 = fmaf(a.w, x15, s3);
    a = *(const LAS f32x4*)(Am + 3076);
    s0 = fmaf(a.x, x16, s0);
    s1 = fmaf(a.y, x17, s1);
    s2 = fmaf(a.z, x18, s2);
    s3 = fmaf(a.w, x19, s3);
    a = *(const LAS f32x4*)(Am + 3080);
    s0 = fmaf(a.x, x20, s0);
    s1 = fmaf(a.y, x21, s1);
    s2 = fmaf(a.z, x22, s2);
    s3 = fmaf(a.w, x23, s3);
    a = *(const LAS f32x4*)(Am + 3084);
    s0 = fmaf(a.x, x24, s0);
    s1 = fmaf(a.y, x25, s1);
    s2 = fmaf(a.z, x26, s2);
    s3 = fmaf(a.w, x27, s3);
    a = *(const LAS f32x4*)(Am + 3088);
    s0 = fmaf(a.x, x28, s0);
    s1 = fmaf(a.y, x29, s1);
    s2 = fmaf(a.z, x30, s2);
    s3 = fmaf(a.w, x31, s3);
    a = *(const LAS f32x4*)(Am + 3092);
    s0 = fmaf(a.x, x32, s0);
    s1 = fmaf(a.y, x33, s1);
    s2 = fmaf(a.z, x34, s2);
    s3 = fmaf(a.w, x35, s3);
    a = *(const LAS f32x4*)(Am + 3096);
    s0 = fmaf(a.x, x36, s0);
    s1 = fmaf(a.y, x37, s1);
    s2 = fmaf(a.z, x38, s2);
    s3 = fmaf(a.w, x39, s3);
    a = *(const LAS f32x4*)(Am + 3100);
    s0 = fmaf(a.x, x40, s0);
    s1 = fmaf(a.y, x41, s1);
    s2 = fmaf(a.z, x42, s2);
    s3 = fmaf(a.w, x43, s3);
    a = *(const LAS f32x4*)(Am + 3104);
    const float al45 = a.x;
    x45 = (x45 - ((s0 + s1) + (s2 + s3))) - al45 * x44;
    Tu[6120 + c] = f2bf(x45 * su); Tw[6120 + c] = f2bf(x45 * sw); asm volatile("" ::: "memory");
    float x46 = fmaxf(0.0f, 1.0f - fabsf(cf - 46.0f));
    s0 = 0.f; s1 = 0.f; s2 = 0.f; s3 = 0.f;
    a = *(const LAS f32x4*)(Am + 3128);
    s0 = fmaf(a.x, x0, s0);
    s1 = fmaf(a.y, x1, s1);
    s2 = fmaf(a.z, x2, s2);
    s3 = fmaf(a.w, x3, s3);
    a = *(const LAS f32x4*)(Am + 3132);
    s0 = fmaf(a.x, x4, s0);
    s1 = fmaf(a.y, x5, s1);
    s2 = fmaf(a.z, x6, s2);
    s3 = fmaf(a.w, x7, s3);
    a = *(const LAS f32x4*)(Am + 3136);
    s0 = fmaf(a.x, x8, s0);
    s1 = fmaf(a.y, x9, s1);
    s2 = fmaf(a.z, x10, s2);
    s3 = fmaf(a.w, x11, s3);
    a = *(const LAS f32x4*)(Am + 3140);
    s0 = fmaf(a.x, x12, s0);
    s1 = fmaf(a.y, x13, s1);
    s2 = fmaf(a.z, x14, s2);
    s3 = fmaf(a.w, x15, s3);
    a = *(const LAS f32x4*)(Am + 3144);
    s0 = fmaf(a.x, x16, s0);
    s1 = fmaf(a.y, x17, s1);
    s2 = fmaf(a.z, x18, s2);
    s3 = fmaf(a.w, x19, s3);
    a = *(const LAS f32x4*)(Am + 3148);
    s0 = fmaf(a.x, x20, s0);
    s1 = fmaf(a.y, x21, s1);
    s2 = fmaf(a.z, x22, s2);
    s3 = fmaf(a.w, x23, s3);
    a = *(const LAS f32x4*)(Am + 3152);
    s0 = fmaf(a.x, x24, s0);
    s1 = fmaf(a.y, x25, s1);
    s2 = fmaf(a.z, x26, s2);
    s3 = fmaf(a.w, x27, s3);
    a = *(const LAS f32x4*)(Am + 3156);
    s0 = fmaf(a.x, x28, s0);
    s1 = fmaf(a.y, x29, s1);
    s2 = fmaf(a.z, x30, s2);
    s3 = fmaf(a.w, x31, s3);
    a = *(const LAS f32x4*)(Am + 3160);
    s0 = fmaf(a.x, x32, s0);
    s1 = fmaf(a.y, x33, s1);
    s2 = fmaf(a.z, x34, s2);
    s3 = fmaf(a.w, x35, s3);
    a = *(const LAS f32x4*)(Am + 3164);
    s0 = fmaf(a.x, x36, s0);
    s1 = fmaf(a.y, x37, s1);
    s2 = fmaf(a.z, x38, s2);
    s3 = fmaf(a.w, x39, s3);
    a = *(const LAS f32x4*)(Am + 3168);
    s0 = fmaf(a.x, x40, s0);
    s1 = fmaf(a.y, x41, s1);
    s2 = fmaf(a.z, x42, s2);
    s3 = fmaf(a.w, x43, s3);
    a = *(const LAS f32x4*)(Am + 3172);
    s0 = fmaf(a.x, x44, s0);
    const float al46 = a.y;
    x46 = (x46 - ((s0 + s1) + (s2 + s3))) - al46 * x45;
    Tu[6256 + c] = f2bf(x46 * su); Tw[6256 + c] = f2bf(x46 * sw); asm volatile("" ::: "memory");
    float x47 = fmaxf(0.0f, 1.0f - fabsf(cf - 47.0f));
    s0 = 0.f; s1 = 0.f; s2 = 0.f; s3 = 0.f;
    a = *(const LAS f32x4*)(Am + 3196);
    s0 = fmaf(a.x, x0, s0);
    s1 = fmaf(a.y, x1, s1);
    s2 = fmaf(a.z, x2, s2);
    s3 = fmaf(a.w, x3, s3);
    a = *(const LAS f32x4*)(Am + 3200);
    s0 = fmaf(a.x, x4, s0);
    s1 = fmaf(a.y, x5, s1);
    s2 = fmaf(a.z, x6, s2);
    s3 = fmaf(a.w, x7, s3);
    a = *(const LAS f32x4*)(Am + 3204);
    s0 = fmaf(a.x, x8, s0);
    s1 = fmaf(a.y, x9, s1);
    s2 = fmaf(a.z, x10, s2);
    s3 = fmaf(a.w, x11, s3);
    a = *(const LAS f32x4*)(Am + 3208);
    s0 = fmaf(a.x, x12, s0);
    s1 = fmaf(a.y, x13, s1);
    s2 = fmaf(a.z, x14, s2);
    s3 = fmaf(a.w, x15, s3);
    a = *(const LAS f32x4*)(Am + 3212);
    s0 = fmaf(a.x, x16, s0);
    s1 = fmaf(a.y, x17, s1);
    s2 = fmaf(a.z, x18, s2);
    s3 = fmaf(a.w, x19, s3);
    a = *(const LAS f32x4*)(Am + 3216);
    s0 = fmaf(a.x, x20, s0);
    s1 = fmaf(a.y, x21, s1);
    s2 = fmaf(a.z, x22, s2);
    s3 = fmaf(a.w, x23, s3);
    a = *(const LAS f32x4*)(Am + 3220);
    s0 = fmaf(a.x, x24, s0);
    s1 = fmaf(a.y, x25, s1);
    s2 = fmaf(a.z, x26, s2);
    s3 = fmaf(a.w, x27, s3);
    a = *(const LAS f32x4*)(Am + 3224);
    s0 = fmaf(a.x, x28, s0);
    s1 = fmaf(a.y, x29, s1);
    s2 = fmaf(a.z, x30, s2);
    s3 = fmaf(a.w, x31, s3);
    a = *(const LAS f32x4*)(Am + 3228);
    s0 = fmaf(a.x, x32, s0);
    s1 = fmaf(a.y, x33, s1);
    s2 = fmaf(a.z, x34, s2);
    s3 = fmaf(a.w, x35, s3);
    a = *(const LAS f32x4*)(Am + 3232);
    s0 = fmaf(a.x, x36, s0);
    s1 = fmaf(a.y, x37, s1);
    s2 = fmaf(a.z, x38, s2);
    s3 = fmaf(a.w, x39, s3);
    a = *(const LAS f32x4*)(Am + 3236);
    s0 = fmaf(a.x, x40, s0);
    s1 = fmaf(a.y, x41, s1);
    s2 = fmaf(a.z, x42, s2);
    s3 = fmaf(a.w, x43, s3);
    a = *(const LAS f32x4*)(Am + 3240);
    s0 = fmaf(a.x, x44, s0);
    s1 = fmaf(a.y, x45, s1);
    const float al47 = a.z;
    x47 = (x47 - ((s0 + s1) + (s2 + s3))) - al47 * x46;
    Tu[6392 + c] = f2bf(x47 * su); Tw[6392 + c] = f2bf(x47 * sw); asm volatile("" ::: "memory");
    float x48 = fmaxf(0.0f, 1.0f - fabsf(cf - 48.0f));
    s0 = 0.f; s1 = 0.f; s2 = 0.f; s3 = 0.f;
    a = *(const LAS f32x4*)(Am + 3264);
    s0 = fmaf(a.x, x0, s0);
    s1 = fmaf(a.y, x1, s1);
    s2 = fmaf(a.z, x2, s2);
    s3 = fmaf(a.w, x3, s3);
    a = *(const LAS f32x4*)(Am + 3268);
    s0 = fmaf(a.x, x4, s0);
    s1 = fmaf(a.y, x5, s1);
    s2 = fmaf(a.z, x6, s2);
    s3 = fmaf(a.w, x7, s3);
    a = *(const LAS f32x4*)(Am + 3272);
    s0 = fmaf(a.x, x8, s0);
    s1 = fmaf(a.y, x9, s1);
    s2 = fmaf(a.z, x10, s2);
    s3 = fmaf(a.w, x11, s3);
    a = *(const LAS f32x4*)(Am + 3276);
    s0 = fmaf(a.x, x12, s0);
    s1 = fmaf(a.y, x13, s1);
    s2 = fmaf(a.z, x14, s2);
    s3 = fmaf(a.w, x15, s3);
    a = *(const LAS f32x4*)(Am + 3280);
    s0 = fmaf(a.x, x16, s0);
    s1 = fmaf(a.y, x17, s1);
    s2 = fmaf(a.z, x18, s2);
    s3 = fmaf(a.w, x19, s3);
    a = *(const LAS f32x4*)(Am + 3284);
    s0 = fmaf(a.x, x20, s0);
    s1 = fmaf(a.y, x21, s1);
    s2 = fmaf(a.z, x22, s2);
    s3 = fmaf(a.w, x23, s3);
    a = *(const LAS f32x4*)(Am + 3288);
    s0 = fmaf(a.x, x24, s0);
    s1 = fmaf(a.y, x25, s1);
    s2 = fmaf(a.z, x26, s2);
    s3 = fmaf(a.w, x27, s3);
    a = *(const LAS f32x4*)(Am + 3292);
    s0 = fmaf(a.x, x28, s0);
    s1 = fmaf(a.y, x29, s1);
    s2 = fmaf(a.z, x30, s2);
    s3 = fmaf(a.w, x31, s3);
    a = *(const LAS f32x4*)(Am + 3296);
    s0 = fmaf(a.x, x32, s0);
    s1 = fmaf(a.y, x33, s1);
    s2 = fmaf(a.z, x34, s2);
    s3 = fmaf(a.w, x35, s3);
    a = *(const LAS f32x4*)(Am + 3300);
    s0 = fmaf(a.x, x36, s0);
    s1 = fmaf(a.y, x37, s1);
    s2 = fmaf(a.z, x38, s2);
    s3 = fmaf(a.w, x39, s3);
    a = *(const LAS f32x4*)(Am + 3304);
    s0 = fmaf(a.x, x40, s0);
    s1 = fmaf(a.y, x41, s1);
    s2 = fmaf(a.z, x42, s2);
    s3 = fmaf(a.w, x43, s3);
    a = *(const LAS f32x4*)(Am + 3308);
    s0 = fmaf(a.x, x44, s0);
    s1 = fmaf(a.y, x45, s1);
    s2 = fmaf(a.z, x46, s2);
    const float al48 = a.w;
    x48 = (x48 - ((s0 + s1) + (s2 + s3))) - al48 * x47;
    Tu[6528 + c] = f2bf(x48 * su); Tw[6528 + c] = f2bf(x48 * sw); asm volatile("" ::: "memory");
    float x49 = fmaxf(0.0f, 1.0f - fabsf(cf - 49.0f));
    s0 = 0.f; s1 = 0.f; s2 = 0.f; s3 = 0.f;
    a = *(const LAS f32x4*)(Am + 3332);
    s0 = fmaf(a.x, x0, s0);
    s1 = fmaf(a.y, x1, s1);
    s2 = fmaf(a.z, x2, s2);
    s3 = fmaf(a.w, x3, s3);
    a = *(const LAS f32x4*)(Am + 3336);
    s0 = fmaf(a.x, x4, s0);
    s1 = fmaf(a.y, x5, s1);
    s2 = fmaf(a.z, x6, s2);
    s3 = fmaf(a.w, x7, s3);
    a = *(const LAS f32x4*)(Am + 3340);
    s0 = fmaf(a.x, x8, s0);
    s1 = fmaf(a.y, x9, s1);
    s2 = fmaf(a.z, x10, s2);
    s3 = fmaf(a.w, x11, s3);
    a = *(const LAS f32x4*)(Am + 3344);
    s0 = fmaf(a.x, x12, s0);
    s1 = fmaf(a.y, x13, s1);
    s2 = fmaf(a.z, x14, s2);
    s3 = fmaf(a.w, x15, s3);
    a = *(const LAS f32x4*)(Am + 3348);
    s0 = fmaf(a.x, x16, s0);
    s1 = fmaf(a.y, x17, s1);
    s2 = fmaf(a.z, x18, s2);
    s3 = fmaf(a.w, x19, s3);
    a = *(const LAS f32x4*)(Am + 3352);
    s0 = fmaf(a.x, x20, s0);
    s1 = fmaf(a.y, x21, s1);
    s2 = fmaf(a.z, x22, s2);
    s3 = fmaf(a.w, x23, s3);
    a = *(const LAS f32x4*)(Am + 3356);
    s0 = fmaf(a.x, x24, s0);
    s1 = fmaf(a.y, x25, s1);
    s2 = fmaf(a.z, x26, s2);
    s3 = fmaf(a.w, x27, s3);
    a = *(const LAS f32x4*)(Am + 3360);
    s0 = fmaf(a.x, x28, s0);
    s1 = fmaf(a.y, x29, s1);
    s2 = fmaf(a.z, x30, s2);
    s3 = fmaf(a.w, x31, s3);
    a = *(const LAS f32x4*)(Am + 3364);
    s0 = fmaf(a.x, x32, s0);
    s1 = fmaf(a.y, x33, s1);
    s2 = fmaf(a.z, x34, s2);
    s3 = fmaf(a.w, x35, s3);
    a = *(const LAS f32x4*)(Am + 3368);
    s0 = fmaf(a.x, x36, s0);
    s1 = fmaf(a.y, x37, s1);
    s2 = fmaf(a.z, x38, s2);
    s3 = fmaf(a.w, x39, s3);
    a = *(const LAS f32x4*)(Am + 3372);
    s0 = fmaf(a.x, x40, s0);
    s1 = fmaf(a.y, x41, s1);
    s2 = fmaf(a.z, x42, s2);
    s3 = fmaf(a.w, x43, s3);
    a = *(const LAS f32x4*)(Am + 3376);
    s0 = fmaf(a.x, x44, s0);
    s1 = fmaf(a.y, x45, s1);
    s2 = fmaf(a.z, x46, s2);
    s3 = fmaf(a.w, x47, s3);
    a = *(const LAS f32x4*)(Am + 3380);
    const float al49 = a.x;
    x49 = (x49 - ((s0 + s1) + (s2 + s3))) - al49 * x48;
    Tu[6664 + c] = f2bf(x49 * su); Tw[6664 + c] = f2bf(x49 * sw); asm volatile("" ::: "memory");
    float x50 = fmaxf(0.0f, 1.0f - fabsf(cf - 50.0f));
    s0 = 0.f; s1 = 0.f; s2 = 0.f; s3 = 0.f;
    a = *(const LAS f32x4*)(Am + 3400);
    s0 = fmaf(a.x, x0, s0);
    s1 = fmaf(a.y, x1, s1);
    s2 = fmaf(a.z, x2, s2);
    s3 = fmaf(a.w, x3, s3);
    a = *(const LAS f32x4*)(Am + 3404);
    s0 = fmaf(a.x, x4, s0);
    s1 = fmaf(a.y, x5, s1);
    s2 = fmaf(a.z, x6, s2);
    s3 = fmaf(a.w, x7, s3);
    a = *(const LAS f32x4*)(Am + 3408);
    s0 = fmaf(a.x, x8, s0);
    s1 = fmaf(a.y, x9, s1);
    s2 = fmaf(a.z, x10, s2);
    s3 = fmaf(a.w, x11, s3);
    a = *(const LAS f32x4*)(Am + 3412);
    s0 = fmaf(a.x, x12, s0);
    s1 = fmaf(a.y, x13, s1);
    s2 = fmaf(a.z, x14, s2);
    s3 = fmaf(a.w, x15, s3);
    a = *(const LAS f32x4*)(Am + 3416);
    s0 = fmaf(a.x, x16, s0);
    s1 = fmaf(a.y, x17, s1);
    s2 = fmaf(a.z, x18, s2);
    s3 = fmaf(a.w, x19, s3);
    a = *(const LAS f32x4*)(Am + 3420);
    s0 = fmaf(a.x, x20, s0);
    s1 = fmaf(a.y, x21, s1);
    s2 = fmaf(a.z, x22, s2);
    s3 = fmaf(a.w, x23, s3);
    a = *(const LAS f32x4*)(Am + 3424);
    s0 = fmaf(a.x, x24, s0);
    s1 = fmaf(a.y, x25, s1);
    s2 = fmaf(a.z, x26, s2);
    s3 = fmaf(a.w, x27, s3);
    a = *(const LAS f32x4*)(Am + 3428);
    s0 = fmaf(a.x, x28, s0);
    s1 = fmaf(a.y, x29, s1);
    s2 = fmaf(a.z, x30, s2);
    s3 = fmaf(a.w, x31, s3);
    a = *(const LAS f32x4*)(Am + 3432);
    s0 = fmaf(a.x, x32, s0);
    s1 = fmaf(a.y, x33, s1);
    s2 = fmaf(a.z, x34, s2);
    s3 = fmaf(a.w, x35, s3);
    a = *(const LAS f32x4*)(Am + 3436);
    s0 = fmaf(a.x, x36, s0);
    s1 = fmaf(a.y, x37, s1);
    s2 = fmaf(a.z, x38, s2);
    s3 = fmaf(a.w, x39, s3);
    a = *(const LAS f32x4*)(Am + 3440);
    s0 = fmaf(a.x, x40, s0);
    s1 = fmaf(a.y, x41, s1);
    s2 = fmaf(a.z, x42, s2);
    s3 = fmaf(a.w, x43, s3);
    a = *(const LAS f32x4*)(Am + 3444);
    s0 = fmaf(a.x, x44, s0);
    s1 = fmaf(a.y, x45, s1);
    s2 = fmaf(a.z, x46, s2);
    s3 = fmaf(a.w, x47, s3);
    a = *(const LAS f32x4*)(Am + 3448);
    s0 = fmaf(a.x, x48, s0);
    const float al50 = a.y;
    x50 = (x50 - ((s0 + s1) + (s2 + s3))) - al50 * x49;
    Tu[6800 + c] = f2bf(x50 * su); Tw[6800 + c] = f2bf(x50 * sw); asm volatile("" ::: "memory");
    float x51 = fmaxf(0.0f, 1.0f - fabsf(cf - 51.0f));
    s0 = 0.f; s1 = 0.f; s2 = 0.f; s3 = 0.f;
    a = *(const LAS f32x4*)(Am + 3468);
    s0 = fmaf(a.x, x0, s0);
    s1 = fmaf(a.y, x1, s1);
    s2 = fmaf(a.z, x2, s2);
    s3 = fmaf(a.w, x3, s3);
    a = *(const LAS f32x4*)(Am + 3472);
    s0 = fmaf(a.x, x4, s0);
    s1 = fmaf(a.y, x5, s1);
    s2 = fmaf(a.z, x6, s2);
    s3 = fmaf(a.w, x7, s3);
    a = *(const LAS f32x4*)(Am + 3476);
    s0 = fmaf(a.x, x8, s0);
    s1 = fmaf(a.y, x9, s1);
    s2 = fmaf(a.z, x10, s2);
    s3 = fmaf(a.w, x11, s3);
    a = *(const LAS f32x4*)(Am + 3480);
    s0 = fmaf(a.x, x12, s0);
    s1 = fmaf(a.y, x13, s1);
    s2 = fmaf(a.z, x14, s2);
    s3 = fmaf(a.w, x15, s3);
    a = *(const LAS f32x4*)(Am + 3484);
    s0 = fmaf(a.x, x16, s0);
    s1 = fmaf(a.y, x17, s1);
    s2 = fmaf(a.z, x18, s2);
    s3 = fmaf(a.w, x19, s3);
    a = *(const LAS f32x4*)(Am + 3488);
    s0 = fmaf(a.x, x20, s0);
    s1 = fmaf(a.y, x21, s1);
    s2 = fmaf(a.z, x22, s2);
    s3 = fmaf(a.w, x23, s3);
    a = *(const LAS f32x4*)(Am + 3492);
    s0 = fmaf(a.x, x24, s0);
    s1 = fmaf(a.y, x25, s1);
    s2 = fmaf(a.z, x26, s2);
    s3 = fmaf(a.w, x27, s3);
    a = *(const LAS f32x4*)(Am + 3496);
    s0 = fmaf(a.x, x28, s0);
    s1 = fmaf(a.y, x29, s1);
    s2 = fmaf(a.z, x30, s2);
    s3 = fmaf(a.w, x31, s3);
    a = *(const LAS f32x4*)(Am + 3500);
    s0 = fmaf(a.x, x32, s0);
    s1 = fmaf(a.y, x33, s1);
    s2 = fmaf(a.z, x34, s2);
    s3 = fmaf(a.w, x35, s3);
    a = *(const LAS f32x4*)(Am + 3504);
    s0 = fmaf(a.x, x36, s0);
    s1 = fmaf(a.y, x37, s1);
    s2 = fmaf(a.z, x38, s2);
    s3 = fmaf(a.w, x39, s3);
    a = *(const LAS f32x4*)(Am + 3508);
    s0 = fmaf(a.x, x40, s0);
    s1 = fmaf(a.y, x41, s1);
    s2 = fmaf(a.z, x42, s2);
    s3 = fmaf(a.w, x43, s3);
    a = *(const LAS f32x4*)(Am + 3512);
    s0 = fmaf(a.x, x44, s0);
    s1 = fmaf(a.y, x45, s1);
    s2 = fmaf(a.z, x46, s2);
    s3 = fmaf(a.w, x47, s3);
    a = *(const LAS f32x4*)(Am + 3516);
    s0 = fmaf(a.x, x48, s0);
    s1 = fmaf(a.y, x49, s1);
    const float al51 = a.z;
    x51 = (x51 - ((s0 + s1) + (s2 + s3))) - al51 * x50;
    Tu[6936 + c] = f2bf(x51 * su); Tw[6936 + c] = f2bf(x51 * sw); asm volatile("" ::: "memory");
    float x52 = fmaxf(0.0f, 1.0f - fabsf(cf - 52.0f));
    s0 = 0.f; s1 = 0.f; s2 = 0.f; s3 = 0.f;
    a = *(const LAS f32x4*)(Am + 3536);
    s0 = fmaf(a.x, x0, s0);
    s1 = fmaf(a.y, x1, s1);
    s2 = fmaf(a.z, x2, s2);
    s3 = fmaf(a.w, x3, s3);
    a = *(const LAS f32x4*)(Am + 3540);
    s0 = fmaf(a.x, x4, s0);
    s1 = fmaf(a.y, x5, s1);
    s2 = fmaf(a.z, x6, s2);
    s3 = fmaf(a.w, x7, s3);
    a = *(const LAS f32x4*)(Am + 3544);
    s0 = fmaf(a.x, x8, s0);
    s1 = fmaf(a.y, x9, s1);
    s2 = fmaf(a.z, x10, s2);
    s3 = fmaf(a.w, x11, s3);
    a = *(const LAS f32x4*)(Am + 3548);
    s0 = fmaf(a.x, x12, s0);
    s1 = fmaf(a.y, x13, s1);
    s2 = fmaf(a.z, x14, s2);
    s3 = fmaf(a.w, x15, s3);
    a = *(const LAS f32x4*)(Am + 3552);
    s0 = fmaf(a.x, x16, s0);
    s1 = fmaf(a.y, x17, s1);
    s2 = fmaf(a.z, x18, s2);
    s3 = fmaf(a.w, x19, s3);
    a = *(const LAS f32x4*)(Am + 3556);
    s0 = fmaf(a.x, x20, s0);
    s1 = fmaf(a.y, x21, s1);
    s2 = fmaf(a.z, x22, s2);
    s3 = fmaf(a.w, x23, s3);
    a = *(const LAS f32x4*)(Am + 3560);
    s0 = fmaf(a.x, x24, s0);
    s1 = fmaf(a.y, x25, s1);
    s2 = fmaf(a.z, x26, s2);
    s3 = fmaf(a.w, x27, s3);
    a = *(const LAS f32x4*)(Am + 3564);
    s0 = fmaf(a.x, x28, s0);
    s1 = fmaf(a.y, x29, s1);
    s2 = fmaf(a.z, x30, s2);
    s3 = fmaf(a.w, x31, s3);
    a = *(const LAS f32x4*)(Am + 3568);
    s0 = fmaf(a.x, x32, s0);
    s1 = fmaf(a.y, x33, s1);
    s2 = fmaf(a.z, x34, s2);
    s3 = fmaf(a.w, x35, s3);
    a = *(const LAS f32x4*)(Am + 3572);
    s0 = fmaf(a.x, x36, s0);
    s1 = fmaf(a.y, x37, s1);
    s2 = fmaf(a.z, x38, s2);
    s3 = fmaf(a.w, x39, s3);
    a = *(const LAS f32x4*)(Am + 3576);
    s0 = fmaf(a.x, x40, s0);
    s1 = fmaf(a.y, x41, s1);
    s2 = fmaf(a.z, x42, s2);
    s3 = fmaf(a.w, x43, s3);
    a = *(const LAS f32x4*)(Am + 3580);
    s0 = fmaf(a.x, x44, s0);
    s1 = fmaf(a.y, x45, s1);
    s2 = fmaf(a.z, x46, s2);
    s3 = fmaf(a.w, x47, s3);
    a = *(const LAS f32x4*)(Am + 3584);
    s0 = fmaf(a.x, x48, s0);
    s1 = fmaf(a.y, x49, s1);
    s2 = fmaf(a.z, x50, s2);
    const float al52 = a.w;
    x52 = (x52 - ((s0 + s1) + (s2 + s3))) - al52 * x51;
    Tu[7072 + c] = f2bf(x52 * su); Tw[7072 + c] = f2bf(x52 * sw); asm volatile("" ::: "memory");
    float x53 = fmaxf(0.0f, 1.0f - fabsf(cf - 53.0f));
    s0 = 0.f; s1 = 0.f; s2 = 0.f; s3 = 0.f;
    a = *(const LAS f32x4*)(Am + 3604);
    s0 = fmaf(a.x, x0, s0);
    s1 = fmaf(a.y, x1, s1);
    s2 = fmaf(a.z, x2, s2);
    s3 = fmaf(a.w, x3, s3);
    a = *(const LAS f32x4*)(Am + 3608);
    s0 = fmaf(a.x, x4, s0);
    s1 = fmaf(a.y, x5, s1);
    s2 = fmaf(a.z, x6, s2);
    s3 = fmaf(a.w, x7, s3);
    a = *(const LAS f32x4*)(Am + 3612);
    s0 = fmaf(a.x, x8, s0);
    s1 = fmaf(a.y, x9, s1);
    s2 = fmaf(a.z, x10, s2);
    s3 = fmaf(a.w, x11, s3);
    a = *(const LAS f32x4*)(Am + 3616);
    s0 = fmaf(a.x, x12, s0);
    s1 = fmaf(a.y, x13, s1);
    s2 = fmaf(a.z, x14, s2);
    s3 = fmaf(a.w, x15, s3);
    a = *(const LAS f32x4*)(Am + 3620);
    s0 = fmaf(a.x, x16, s0);
    s1 = fmaf(a.y, x17, s1);
    s2 = fmaf(a.z, x18, s2);
    s3 = fmaf(a.w, x19, s3);
    a = *(const LAS f32x4*)(Am + 3624);
    s0 = fmaf(a.x, x20, s0);
    s1 = fmaf(a.y, x21, s1);
    s2 = fmaf(a.z, x22, s2);
    s3 = fmaf(a.w, x23, s3);
    a = *(const LAS f32x4*)(Am + 3628);
    s0 = fmaf(a.x, x24, s0);
    s1 = fmaf(a.y, x25, s1);
    s2 = fmaf(a.z, x26, s2);
    s3 = fmaf(a.w, x27, s3);
    a = *(const LAS f32x4*)(Am + 3632);
    s0 = fmaf(a.x, x28, s0);
    s1 = fmaf(a.y, x29, s1);
    s2 = fmaf(a.z, x30, s2);
    s3 = fmaf(a.w, x31, s3);
    a = *(const LAS f32x4*)(Am + 3636);
    s0 = fmaf(a.x, x32, s0);
    s1 = fmaf(a.y, x33, s1);
    s2 = fmaf(a.z, x34, s2);
    s3 = fmaf(a.w, x35, s3);
    a = *(const LAS f32x4*)(Am + 3640);
    s0 = fmaf(a.x, x36, s0);
    s1 = fmaf(a.y, x37, s1);
    s2 = fmaf(a.z, x38, s2);
    s3 = fmaf(a.w, x39, s3);
    a = *(const LAS f32x4*)(Am + 3644);
    s0 = fmaf(a.x, x40, s0);
    s1 = fmaf(a.y, x41, s1);
    s2 = fmaf(a.z, x42, s2);
    s3 = fmaf(a.w, x43, s3);
    a = *(const LAS f32x4*)(Am + 3648);
    s0 = fmaf(a.x, x44, s0);
    s1 = fmaf(a.y, x45, s1);
    s2 = fmaf(a.z, x46, s2);
    s3 = fmaf(a.w, x47, s3);
    a = *(const LAS f32x4*)(Am + 3652);
    s0 = fmaf(a.x, x48, s0);
    s1 = fmaf(a.y, x49, s1);
    s2 = fmaf(a.z, x50, s2);
    s3 = fmaf(a.w, x51, s3);
    a = *(const LAS f32x4*)(Am + 3656);
    const float al53 = a.x;
    x53 = (x53 - ((s0 + s1) + (s2 + s3))) - al53 * x52;
    Tu[7208 + c] = f2bf(x53 * su); Tw[7208 + c] = f2bf(x53 * sw); asm volatile("" ::: "memory");
    float x54 = fmaxf(0.0f, 1.0f - fabsf(cf - 54.0f));
    s0 = 0.f; s1 = 0.f; s2 = 0.f; s3 = 0.f;
    a = *(const LAS f32x4*)(Am + 3672);
    s0 = fmaf(a.x, x0, s0);
    s1 = fmaf(a.y, x1, s1);
    s2 = fmaf(a.z, x2, s2);
    s3 = fmaf(a.w, x3, s3);
    a = *(const LAS f32x4*)(Am + 3676);
    s0 = fmaf(a.x, x4, s0);
    s1 = fmaf(a.y, x5, s1);
    s2 = fmaf(a.z, x6, s2);
    s3 = fmaf(a.w, x7, s3);
    a = *(const LAS f32x4*)(Am + 3680);
    s0 = fmaf(a.x, x8, s0);
    s1 = fmaf(a.y, x9, s1);
    s2 = fmaf(a.z, x10, s2);
    s3 = fmaf(a.w, x11, s3);
    a = *(const LAS f32x4*)(Am + 3684);
    s0 = fmaf(a.x, x12, s0);
    s1 = fmaf(a.y, x13, s1);
    s2 = fmaf(a.z, x14, s2);
    s3 = fmaf(a.w, x15, s3);
    a = *(const LAS f32x4*)(Am + 3688);
    s0 = fmaf(a.x, x16, s0);
    s1 = fmaf(a.y, x17, s1);
    s2 = fmaf(a.z, x18, s2);
    s3 = fmaf(a.w, x19, s3);
    a = *(const LAS f32x4*)(Am + 3692);
    s0 = fmaf(a.x, x20, s0);
    s1 = fmaf(a.y, x21, s1);
    s2 = fmaf(a.z, x22, s2);
    s3 = fmaf(a.w, x23, s3);
    a = *(const LAS f32x4*)(Am + 3696);
    s0 = fmaf(a.x, x24, s0);
    s1 = fmaf(a.y, x25, s1);
    s2 = fmaf(a.z, x26, s2);
    s3 = fmaf(a.w, x27, s3);
    a = *(const LAS f32x4*)(Am + 3700);
    s0 = fmaf(a.x, x28, s0);
    s1 = fmaf(a.y, x29, s1);
    s2 = fmaf(a.z, x30, s2);
    s3 = fmaf(a.w, x31, s3);
    a = *(const LAS f32x4*)(Am + 3704);
    s0 = fmaf(a.x, x32, s0);
    s1 = fmaf(a.y, x33, s1);
    s2 = fmaf(a.z, x34, s2);
    s3 = fmaf(a.w, x35, s3);
    a = *(const LAS f32x4*)(Am + 3708);
    s0 = fmaf(a.x, x36, s0);
    s1 = fmaf(a.y, x37, s1);
    s2 = fmaf(a.z, x38, s2);
    s3 = fmaf(a.w, x39, s3);
    a = *(const LAS f32x4*)(Am + 3712);
    s0 = fmaf(a.x, x40, s0);
    s1 = fmaf(a.y, x41, s1);
    s2 = fmaf(a.z, x42, s2);
    s3 = fmaf(a.w, x43, s3);
    a = *(const LAS f32x4*)(Am + 3716);
    s0 = fmaf(a.x, x44, s0);
    s1 = fmaf(a.y, x45, s1);
    s2 = fmaf(a.z, x46, s2);
    s3 = fmaf(a.w, x47, s3);
    a = *(const LAS f32x4*)(Am + 3720);
    s0 = fmaf(a.x, x48, s0);
    s1 = fmaf(a.y, x49, s1);
    s2 = fmaf(a.z, x50, s2);
    s3 = fmaf(a.w, x51, s3);
    a = *(const LAS f32x4*)(Am + 3724);
    s0 = fmaf(a.x, x52, s0);
    const float al54 = a.y;
    x54 = (x54 - ((s0 + s1) + (s2 + s3))) - al54 * x53;
    Tu[7344 + c] = f2bf(x54 * su); Tw[7344 + c] = f2bf(x54 * sw); asm volatile("" ::: "memory");
    float x55 = fmaxf(0.0f, 1.0f - fabsf(cf - 55.0f));
    s0 = 0.f; s1 = 0.f; s2 = 0.f; s3 = 0.f;
    a = *(const LAS f32x4*)(Am + 3740);
    s0 = fmaf(a.x, x0, s0);
    s1 = fmaf(a.y, x1, s1);
    s2 = fmaf(a.z, x2, s2);
    s3 = fmaf(a.w, x3, s3);
    a = *(const LAS f32x4*)(Am + 3744);
    s0 = fmaf(a.x, x4, s0);
    s1 = fmaf(a.y, x5, s1);
    s2 = fmaf(a.z, x6, s2);
    s3 = fmaf(a.w, x7, s3);
    a = *(const LAS f32x4*)(Am + 3748);
    s0 = fmaf(a.x, x8, s0);
    s1 = fmaf(a.y, x9, s1);
    s2 = fmaf(a.z, x10, s2);
    s3 = fmaf(a.w, x11, s3);
    a = *(const LAS f32x4*)(Am + 3752);
    s0 = fmaf(a.x, x12, s0);
    s1 = fmaf(a.y, x13, s1);
    s2 = fmaf(a.z, x14, s2);
    s3 = fmaf(a.w, x15, s3);
    a = *(const LAS f32x4*)(Am + 3756);
    s0 = fmaf(a.x, x16, s0);
    s1 = fmaf(a.y, x17, s1);
    s2 = fmaf(a.z, x18, s2);
    s3 = fmaf(a.w, x19, s3);
    a = *(const LAS f32x4*)(Am + 3760);
    s0 = fmaf(a.x, x20, s0);
    s1 = fmaf(a.y, x21, s1);
    s2 = fmaf(a.z, x22, s2);
    s3 = fmaf(a.w, x23, s3);
    a = *(const LAS f32x4*)(Am + 3764);
    s0 = fmaf(a.x, x24, s0);
    s1 = fmaf(a.y, x25, s1);
    s2 = fmaf(a.z, x26, s2);
    s3 = fmaf(a.w, x27, s3);
    a = *(const LAS f32x4*)(Am + 3768);
    s0 = fmaf(a.x, x28, s0);
    s1 = fmaf(a.y, x29, s1);
    s2 = fmaf(a.z, x30, s2);
    s3 = fmaf(a.w, x31, s3);
    a = *(const LAS f32x4*)(Am + 3772);
    s0 = fmaf(a.x, x32, s0);
    s1 = fmaf(a.y, x33, s1);
    s2 = fmaf(a.z, x34, s2);
    s3 = fmaf(a.w, x35, s3);
    a = *(const LAS f32x4*)(Am + 3776);
    s0 = fmaf(a.x, x36, s0);
    s1 = fmaf(a.y, x37, s1);
    s2 = fmaf(a.z, x38, s2);
    s3 = fmaf(a.w, x39, s3);
    a = *(const LAS f32x4*)(Am + 3780);
    s0 = fmaf(a.x, x40, s0);
    s1 = fmaf(a.y, x41, s1);
    s2 = fmaf(a.z, x42, s2);
    s3 = fmaf(a.w, x43, s3);
    a = *(const LAS f32x4*)(Am + 3784);
    s0 = fmaf(a.x, x44, s0);
    s1 = fmaf(a.y, x45, s1);
    s2 = fmaf(a.z, x46, s2);
    s3 = fmaf(a.w, x47, s3);
    a = *(const LAS f32x4*)(Am + 3788);
    s0 = fmaf(a.x, x48, s0);
    s1 = fmaf(a.y, x49, s1);
    s2 = fmaf(a.z, x50, s2);
    s3 = fmaf(a.w, x51, s3);
    a = *(const LAS f32x4*)(Am + 3792);
    s0 = fmaf(a.x, x52, s0);
    s1 = fmaf(a.y, x53, s1);
    const float al55 = a.z;
    x55 = (x55 - ((s0 + s1) + (s2 + s3))) - al55 * x54;
    Tu[7480 + c] = f2bf(x55 * su); Tw[7480 + c] = f2bf(x55 * sw); asm volatile("" ::: "memory");
    float x56 = fmaxf(0.0f, 1.0f - fabsf(cf - 56.0f));
    s0 = 0.f; s1 = 0.f; s2 = 0.f; s3 = 0.f;
    a = *(const LAS f32x4*)(Am + 3808);
    s0 = fmaf(a.x, x0, s0);
    s1 = fmaf(a.y, x1, s1);
    s2 = fmaf(a.z, x2, s2);
    s3 = fmaf(a.w, x3, s3);
    a = *(const LAS f32x4*)(Am + 3812);
    s0 = fmaf(a.x, x4, s0);
    s1 = fmaf(a.y, x5, s1);
    s2 = fmaf(a.z, x6, s2);
    s3 = fmaf(a.w, x7, s3);
    a = *(const LAS f32x4*)(Am + 3816);
    s0 = fmaf(a.x, x8, s0);
    s1 = fmaf(a.y, x9, s1);
    s2 = fmaf(a.z, x10, s2);
    s3 = fmaf(a.w, x11, s3);
    a = *(const LAS f32x4*)(Am + 3820);
    s0 = fmaf(a.x, x12, s0);
    s1 = fmaf(a.y, x13, s1);
    s2 = fmaf(a.z, x14, s2);
    s3 = fmaf(a.w, x15, s3);
    a = *(const LAS f32x4*)(Am + 3824);
    s0 = fmaf(a.x, x16, s0);
    s1 = fmaf(a.y, x17, s1);
    s2 = fmaf(a.z, x18, s2);
    s3 = fmaf(a.w, x19, s3);
    a = *(const LAS f32x4*)(Am + 3828);
    s0 = fmaf(a.x, x20, s0);
    s1 = fmaf(a.y, x21, s1);
    s2 = fmaf(a.z, x22, s2);
    s3 = fmaf(a.w, x23, s3);
    a = *(const LAS f32x4*)(Am + 3832);
    s0 = fmaf(a.x, x24, s0);
    s1 = fmaf(a.y, x25, s1);
    s2 = fmaf(a.z, x26, s2);
    s3 = fmaf(a.w, x27, s3);
    a = *(const LAS f32x4*)(Am + 3836);
    s0 = fmaf(a.x, x28, s0);
    s1 = fmaf(a.y, x29, s1);
    s2 = fmaf(a.z, x30, s2);
    s3 = fmaf(a.w, x31, s3);
    a = *(const LAS f32x4*)(Am + 3840);
    s0 = fmaf(a.x, x32, s0);
    s1 = fmaf(a.y, x33, s1);
    s2 = fmaf(a.z, x34, s2);
    s3 = fmaf(a.w, x35, s3);
    a = *(const LAS f32x4*)(Am + 3844);
    s0 = fmaf(a.x, x36, s0);
    s1 = fmaf(a.y, x37, s1);
    s2 = fmaf(a.z, x38, s2);
    s3 = fmaf(a.w, x39, s3);
    a = *(const LAS f32x4*)(Am + 3848);
    s0 = fmaf(a.x, x40, s0);
    s1 = fmaf(a.y, x41, s1);
    s2 = fmaf(a.z, x42, s2);
    s3 = fmaf(a.w, x43, s3);
    a = *(const LAS f32x4*)(Am + 3852);
    s0 = fmaf(a.x, x44, s0);
    s1 = fmaf(a.y, x45, s1);
    s2 = fmaf(a.z, x46, s2);
    s3 = fmaf(a.w, x47, s3);
    a = *(const LAS f32x4*)(Am + 3856);
    s0 = fmaf(a.x, x48, s0);
    s1 = fmaf(a.y, x49, s1);
    s2 = fmaf(a.z, x50, s2);
    s3 = fmaf(a.w, x51, s3);
    a = *(const LAS f32x4*)(Am + 3860);
    s0 = fmaf(a.x, x52, s0);
    s1 = fmaf(a.y, x53, s1);
    s2 = fmaf(a.z, x54, s2);
    const float al56 = a.w;
    x56 = (x56 - ((s0 + s1) + (s2 + s3))) - al56 * x55;
    Tu[7616 + c] = f2bf(x56 * su); Tw[7616 + c] = f2bf(x56 * sw); asm volatile("" ::: "memory");
    float x57 = fmaxf(0.0f, 1.0f - fabsf(cf - 57.0f));
    s0 = 0.f; s1 = 0.f; s2 = 0.f; s3 = 0.f;
    a = *(const LAS f32x4*)(Am + 3876);
    s0 = fmaf(a.x, x0, s0);
    s1 = fmaf(a.y, x1, s1);
    s2 = fmaf(a.z, x2, s2);
    s3 = fmaf(a.w, x3, s3);
    a = *(const LAS f32x4*)(Am + 3880);
    s0 = fmaf(a.x, x4, s0);
    s1 = fmaf(a.y, x5, s1);
    s2 = fmaf(a.z, x6, s2);
    s3 = fmaf(a.w, x7, s3);
    a = *(const LAS f32x4*)(Am + 3884);
    s0 = fmaf(a.x, x8, s0);
    s1 = fmaf(a.y, x9, s1);
    s2 = fmaf(a.z, x10, s2);
    s3 = fmaf(a.w, x11, s3);
    a = *(const LAS f32x4*)(Am + 3888);
    s0 = fmaf(a.x, x12, s0);
    s1 = fmaf(a.y, x13, s1);
    s2 = fmaf(a.z, x14, s2);
    s3 = fmaf(a.w, x15, s3);
    a = *(const LAS f32x4*)(Am + 3892);
    s0 = fmaf(a.x, x16, s0);
    s1 = fmaf(a.y, x17, s1);
    s2 = fmaf(a.z, x18, s2);
    s3 = fmaf(a.w, x19, s3);
    a = *(const LAS f32x4*)(Am + 3896);
    s0 = fmaf(a.x, x20, s0);
    s1 = fmaf(a.y, x21, s1);
    s2 = fmaf(a.z, x22, s2);
    s3 = fmaf(a.w, x23, s3);
    a = *(const LAS f32x4*)(Am + 3900);
    s0 = fmaf(a.x, x24, s0);
    s1 = fmaf(a.y, x25, s1);
    s2 = fmaf(a.z, x26, s2);
    s3 = fmaf(a.w, x27, s3);
    a = *(const LAS f32x4*)(Am + 3904);
    s0 = fmaf(a.x, x28, s0);
    s1 = fmaf(a.y, x29, s1);
    s2 = fmaf(a.z, x30, s2);
    s3 = fmaf(a.w, x31, s3);
    a = *(const LAS f32x4*)(Am + 3908);
    s0 = fmaf(a.x, x32, s0);
    s1 = fmaf(a.y, x33, s1);
    s2 = fmaf(a.z, x34, s2);
    s3 = fmaf(a.w, x35, s3);
    a = *(const LAS f32x4*)(Am + 3912);
    s0 = fmaf(a.x, x36, s0);
    s1 = fmaf(a.y, x37, s1);
    s2 = fmaf(a.z, x38, s2);
    s3 = fmaf(a.w, x39, s3);
    a = *(const LAS f32x4*)(Am + 3916);
    s0 = fmaf(a.x, x40, s0);
    s1 = fmaf(a.y, x41, s1);
    s2 = fmaf(a.z, x42, s2);
    s3 = fmaf(a.w, x43, s3);
    a = *(const LAS f32x4*)(Am + 3920);
    s0 = fmaf(a.x, x44, s0);
    s1 = fmaf(a.y, x45, s1);
    s2 = fmaf(a.z, x46, s2);
    s3 = fmaf(a.w, x47, s3);
    a = *(const LAS f32x4*)(Am + 3924);
    s0 = fmaf(a.x, x48, s0);
    s1 = fmaf(a.y, x49, s1);
    s2 = fmaf(a.z, x50, s2);
    s3 = fmaf(a.w, x51, s3);
    a = *(const LAS f32x4*)(Am + 3928);
    s0 = fmaf(a.x, x52, s0);
    s1 = fmaf(a.y, x53, s1);
    s2 = fmaf(a.z, x54, s2);
    s3 = fmaf(a.w, x55, s3);
    a = *(const LAS f32x4*)(Am + 3932);
    const float al57 = a.x;
    x57 = (x57 - ((s0 + s1) + (s2 + s3))) - al57 * x56;
    Tu[7752 + c] = f2bf(x57 * su); Tw[7752 + c] = f2bf(x57 * sw); asm volatile("" ::: "memory");
    float x58 = fmaxf(0.0f, 1.0f - fabsf(cf - 58.0f));
    s0 = 0.f; s1 = 0.f; s2 = 0.f; s3 = 0.f;
    a = *(const LAS f32x4*)(Am + 3944);
    s0 = fmaf(a.x, x0, s0);
    s1 = fmaf(a.y, x1, s1);
    s2 = fmaf(a.z, x2, s2);
    s3 = fmaf(a.w, x3, s3);
    a = *(const LAS f32x4*)(Am + 3948);
    s0 = fmaf(a.x, x4, s0);
    s1 = fmaf(a.y, x5, s1);
    s2 = fmaf(a.z, x6, s2);
    s3 = fmaf(a.w, x7, s3);
    a = *(const LAS f32x4*)(Am + 3952);
    s0 = fmaf(a.x, x8, s0);
    s1 = fmaf(a.y, x9, s1);
    s2 = fmaf(a.z, x10, s2);
    s3 = fmaf(a.w, x11, s3);
    a = *(const LAS f32x4*)(Am + 3956);
    s0 = fmaf(a.x, x12, s0);
    s1 = fmaf(a.y, x13, s1);
    s2 = fmaf(a.z, x14, s2);
    s3 = fmaf(a.w, x15, s3);
    a = *(const LAS f32x4*)(Am + 3960);
    s0 = fmaf(a.x, x16, s0);
    s1 = fmaf(a.y, x17, s1);
    s2 = fmaf(a.z, x18, s2);
    s3 = fmaf(a.w, x19, s3);
    a = *(const LAS f32x4*)(Am + 3964);
    s0 = fmaf(a.x, x20, s0);
    s1 = fmaf(a.y, x21, s1);
    s2 = fmaf(a.z, x22, s2);
    s3 = fmaf(a.w, x23, s3);
    a = *(const LAS f32x4*)(Am + 3968);
    s0 = fmaf(a.x, x24, s0);
    s1 = fmaf(a.y, x25, s1);
    s2 = fmaf(a.z, x26, s2);
    s3 = fmaf(a.w, x27, s3);
    a = *(const LAS f32x4*)(Am + 3972);
    s0 = fmaf(a.x, x28, s0);
    s1 = fmaf(a.y, x29, s1);
    s2 = fmaf(a.z, x30, s2);
    s3 = fmaf(a.w, x31, s3);
    a = *(const LAS f32x4*)(Am + 3976);
    s0 = fmaf(a.x, x32, s0);
    s1 = fmaf(a.y, x33, s1);
    s2 = fmaf(a.z, x34, s2);
    s3 = fmaf(a.w, x35, s3);
    a = *(const LAS f32x4*)(Am + 3980);
    s0 = fmaf(a.x, x36, s0);
    s1 = fmaf(a.y, x37, s1);
    s2 = fmaf(a.z, x38, s2);
    s3 = fmaf(a.w, x39, s3);
    a = *(const LAS f32x4*)(Am + 3984);
    s0 = fmaf(a.x, x40, s0);
    s1 = fmaf(a.y, x41, s1);
    s2 = fmaf(a.z, x42, s2);
    s3 = fmaf(a.w, x43, s3);
    a = *(const LAS f32x4*)(Am + 3988);
    s0 = fmaf(a.x, x44, s0);
    s1 = fmaf(a.y, x45, s1);
    s2 = fmaf(a.z, x46, s2);
    s3 = fmaf(a.w, x47, s3);
    a = *(const LAS f32x4*)(Am + 3992);
    s0 = fmaf(a.x, x48, s0);
    s1 = fmaf(a.y, x49, s1);
    s2 = fmaf(a.z, x50, s2);
    s3 = fmaf(a.w, x51, s3);
    a = *(const LAS f32x4*)(Am + 3996);
    s0 = fmaf(a.x, x52, s0);
    s1 = fmaf(a.y, x53, s1);
    s2 = fmaf(a.z, x54, s2);
    s3 = fmaf(a.w, x55, s3);
    a = *(const LAS f32x4*)(Am + 4000);
    s0 = fmaf(a.x, x56, s0);
    const float al58 = a.y;
    x58 = (x58 - ((s0 + s1) + (s2 + s3))) - al58 * x57;
    Tu[7888 + c] = f2bf(x58 * su); Tw[7888 + c] = f2bf(x58 * sw); asm volatile("" ::: "memory");
    float x59 = fmaxf(0.0f, 1.0f - fabsf(cf - 59.0f));
    s0 = 0.f; s1 = 0.f; s2 = 0.f; s3 = 0.f;
    a = *(const LAS f32x4*)(Am + 4012);
    s0 = fmaf(a.x, x0, s0);
    s1 = fmaf(a.y, x1, s1);
    s2 = fmaf(a.z, x2, s2);
    s3 = fmaf(a.w, x3, s3);
    a = *(const LAS f32x4*)(Am + 4016);
    s0 = fmaf(a.x, x4, s0);
    s1 = fmaf(a.y, x5, s1);
    s2 = fmaf(a.z, x6, s2);
    s3 = fmaf(a.w, x7, s3);
    a = *(const LAS f32x4*)(Am + 4020);
    s0 = fmaf(a.x, x8, s0);
    s1 = fmaf(a.y, x9, s1);
    s2 = fmaf(a.z, x10, s2);
    s3 = fmaf(a.w, x11, s3);
    a = *(const LAS f32x4*)(Am + 4024);
    s0 = fmaf(a.x, x12, s0);
    s1 = fmaf(a.y, x13, s1);
    s2 = fmaf(a.z, x14, s2);
    s3 = fmaf(a.w, x15, s3);
    a = *(const LAS f32x4*)(Am + 4028);
    s0 = fmaf(a.x, x16, s0);
    s1 = fmaf(a.y, x17, s1);
    s2 = fmaf(a.z, x18, s2);
    s3 = fmaf(a.w, x19, s3);
    a = *(const LAS f32x4*)(Am + 4032);
    s0 = fmaf(a.x, x20, s0);
    s1 = fmaf(a.y, x21, s1);
    s2 = fmaf(a.z, x22, s2);
    s3 = fmaf(a.w, x23, s3);
    a = *(const LAS f32x4*)(Am + 4036);
    s0 = fmaf(a.x, x24, s0);
    s1 = fmaf(a.y, x25, s1);
    s2 = fmaf(a.z, x26, s2);
    s3 = fmaf(a.w, x27, s3);
    a = *(const LAS f32x4*)(Am + 4040);
    s0 = fmaf(a.x, x28, s0);
    s1 = fmaf(a.y, x29, s1);
    s2 = fmaf(a.z, x30, s2);
    s3 = fmaf(a.w, x31, s3);
    a = *(const LAS f32x4*)(Am + 4044);
    s0 = fmaf(a.x, x32, s0);
    s1 = fmaf(a.y, x33, s1);
    s2 = fmaf(a.z, x34, s2);
    s3 = fmaf(a.w, x35, s3);
    a = *(const LAS f32x4*)(Am + 4048);
    s0 = fmaf(a.x, x36, s0);
    s1 = fmaf(a.y, x37, s1);
    s2 = fmaf(a.z, x38, s2);
    s3 = fmaf(a.w, x39, s3);
    a = *(const LAS f32x4*)(Am + 4052);
    s0 = fmaf(a.x, x40, s0);
    s1 = fmaf(a.y, x41, s1);
    s2 = fmaf(a.z, x42, s2);
    s3 = fmaf(a.w, x43, s3);
    a = *(const LAS f32x4*)(Am + 4056);
    s0 = fmaf(a.x, x44, s0);
    s1 = fmaf(a.y, x45, s1);
    s2 = fmaf(a.z, x46, s2);
    s3 = fmaf(a.w, x47, s3);
    a = *(const LAS f32x4*)(Am + 4060);
    s0 = fmaf(a.x, x48, s0);
    s1 = fmaf(a.y, x49, s1);
    s2 = fmaf(a.z, x50, s2);
    s3 = fmaf(a.w, x51, s3);
    a = *(const LAS f32x4*)(Am + 4064);
    s0 = fmaf(a.x, x52, s0);
    s1 = fmaf(a.y, x53, s1);
    s2 = fmaf(a.z, x54, s2);
    s3 = fmaf(a.w, x55, s3);
    a = *(const LAS f32x4*)(Am + 4068);
    s0 = fmaf(a.x, x56, s0);
    s1 = fmaf(a.y, x57, s1);
    const float al59 = a.z;
    x59 = (x59 - ((s0 + s1) + (s2 + s3))) - al59 * x58;
    Tu[8024 + c] = f2bf(x59 * su); Tw[8024 + c] = f2bf(x59 * sw); asm volatile("" ::: "memory");
    float x60 = fmaxf(0.0f, 1.0f - fabsf(cf - 60.0f));
    s0 = 0.f; s1 = 0.f; s2 = 0.f; s3 = 0.f;
    a = *(const LAS f32x4*)(Am + 4080);
    s0 = fmaf(a.x, x0, s0);
    s1 = fmaf(a.y, x1, s1);
    s2 = fmaf(a.z, x2, s2);
    s3 = fmaf(a.w, x3, s3);
    a = *(const LAS f32x4*)(Am + 4084);
    s0 = fmaf(a.x, x4, s0);
    s1 = fmaf(a.y, x5, s1);
    s2 = fmaf(a.z, x6, s2);
    s3 = fmaf(a.w, x7, s3);
    a = *(const LAS f32x4*)(Am + 4088);
    s0 = fmaf(a.x, x8, s0);
    s1 = fmaf(a.y, x9, s1);
    s2 = fmaf(a.z, x10, s2);
    s3 = fmaf(a.w, x11, s3);
    a = *(const LAS f32x4*)(Am + 4092);
    s0 = fmaf(a.x, x12, s0);
    s1 = fmaf(a.y, x13, s1);
    s2 = fmaf(a.z, x14, s2);
    s3 = fmaf(a.w, x15, s3);
    a = *(const LAS f32x4*)(Am + 4096);
    s0 = fmaf(a.x, x16, s0);
    s1 = fmaf(a.y, x17, s1);
    s2 = fmaf(a.z, x18, s2);
    s3 = fmaf(a.w, x19, s3);
    a = *(const LAS f32x4*)(Am + 4100);
    s0 = fmaf(a.x, x20, s0);
    s1 = fmaf(a.y, x21, s1);
    s2 = fmaf(a.z, x22, s2);
    s3 = fmaf(a.w, x23, s3);
    a = *(const LAS f32x4*)(Am + 4104);
    s0 = fmaf(a.x, x24, s0);
    s1 = fmaf(a.y, x25, s1);
    s2 = fmaf(a.z, x26, s2);
    s3 = fmaf(a.w, x27, s3);
    a = *(const LAS f32x4*)(Am + 4108);
    s0 = fmaf(a.x, x28, s0);
    s1 = fmaf(a.y, x29, s1);
    s2 = fmaf(a.z, x30, s2);
    s3 = fmaf(a.w, x31, s3);
    a = *(const LAS f32x4*)(Am + 4112);
    s0 = fmaf(a.x, x32, s0);
    s1 = fmaf(a.y, x33, s1);
    s2 = fmaf(a.z, x34, s2);
    s3 = fmaf(a.w, x35, s3);
    a = *(const LAS f32x4*)(Am + 4116);
    s0 = fmaf(a.x, x36, s0);
    s1 = fmaf(a.y, x37, s1);
    s2 = fmaf(a.z, x38, s2);
    s3 = fmaf(a.w, x39, s3);
    a = *(const LAS f32x4*)(Am + 4120);
    s0 = fmaf(a.x, x40, s0);
    s1 = fmaf(a.y, x41, s1);
    s2 = fmaf(a.z, x42, s2);
    s3 = fmaf(a.w, x43, s3);
    a = *(const LAS f32x4*)(Am + 4124);
    s0 = fmaf(a.x, x44, s0);
    s1 = fmaf(a.y, x45, s1);
    s2 = fmaf(a.z, x46, s2);
    s3 = fmaf(a.w, x47, s3);
    a = *(const LAS f32x4*)(Am + 4128);
    s0 = fmaf(a.x, x48, s0);
    s1 = fmaf(a.y, x49, s1);
    s2 = fmaf(a.z, x50, s2);
    s3 = fmaf(a.w, x51, s3);
    a = *(const LAS f32x4*)(Am + 4132);
    s0 = fmaf(a.x, x52, s0);
    s1 = fmaf(a.y, x53, s1);
    s2 = fmaf(a.z, x54, s2);
    s3 = fmaf(a.w, x55, s3);
    a = *(const LAS f32x4*)(Am + 4136);
    s0 = fmaf(a.x, x56, s0);
    s1 = fmaf(a.y, x57, s1);
    s2 = fmaf(a.z, x58, s2);
    const float al60 = a.w;
    x60 = (x60 - ((s0 + s1) + (s2 + s3))) - al60 * x59;
    Tu[8160 + c] = f2bf(x60 * su); Tw[8160 + c] = f2bf(x60 * sw); asm volatile("" ::: "memory");
    float x61 = fmaxf(0.0f, 1.0f - fabsf(cf - 61.0f));
    s0 = 0.f; s1 = 0.f; s2 = 0.f; s3 = 0.f;
    a = *(const LAS f32x4*)(Am + 4148);
    s0 = fmaf(a.x, x0, s0);
    s1 = fmaf(a.y, x1, s1);
    s2 = fmaf(a.z, x2, s2);
    s3 = fmaf(a.w, x3, s3);
    a = *(const LAS f32x4*)(Am + 4152);
    s0 = fmaf(a.x, x4, s0);
    s1 = fmaf(a.y, x5, s1);
    s2 = fmaf(a.z, x6, s2);
    s3 = fmaf(a.w, x7, s3);
    a = *(const LAS f32x4*)(Am + 4156);
    s0 = fmaf(a.x, x8, s0);
    s1 = fmaf(a.y, x9, s1);
    s2 = fmaf(a.z, x10, s2);
    s3 = fmaf(a.w, x11, s3);
    a = *(const LAS f32x4*)(Am + 4160);
    s0 = fmaf(a.x, x12, s0);
    s1 = fmaf(a.y, x13, s1);
    s2 = fmaf(a.z, x14, s2);
    s3 = fmaf(a.w, x15, s3);
    a = *(const LAS f32x4*)(Am + 4164);
    s0 = fmaf(a.x, x16, s0);
    s1 = fmaf(a.y, x17, s1);
    s2 = fmaf(a.z, x18, s2);
    s3 = fmaf(a.w, x19, s3);
    a = *(const LAS f32x4*)(Am + 4168);
    s0 = fmaf(a.x, x20, s0);
    s1 = fmaf(a.y, x21, s1);
    s2 = fmaf(a.z, x22, s2);
    s3 = fmaf(a.w, x23, s3);
    a = *(const LAS f32x4*)(Am + 4172);
    s0 = fmaf(a.x, x24, s0);
    s1 = fmaf(a.y, x25, s1);
    s2 = fmaf(a.z, x26, s2);
    s3 = fmaf(a.w, x27, s3);
    a = *(const LAS f32x4*)(Am + 4176);
    s0 = fmaf(a.x, x28, s0);
    s1 = fmaf(a.y, x29, s1);
    s2 = fmaf(a.z, x30, s2);
    s3 = fmaf(a.w, x31, s3);
    a = *(const LAS f32x4*)(Am + 4180);
    s0 = fmaf(a.x, x32, s0);
    s1 = fmaf(a.y, x33, s1);
    s2 = fmaf(a.z, x34, s2);
    s3 = fmaf(a.w, x35, s3);
    a = *(const LAS f32x4*)(Am + 4184);
    s0 = fmaf(a.x, x36, s0);
    s1 = fmaf(a.y, x37, s1);
    s2 = fmaf(a.z, x38, s2);
    s3 = fmaf(a.w, x39, s3);
    a = *(const LAS f32x4*)(Am + 4188);
    s0 = fmaf(a.x, x40, s0);
    s1 = fmaf(a.y, x41, s1);
    s2 = fmaf(a.z, x42, s2);
    s3 = fmaf(a.w, x43, s3);
    a = *(const LAS f32x4*)(Am + 4192);
    s0 = fmaf(a.x, x44, s0);
    s1 = fmaf(a.y, x45, s1);
    s2 = fmaf(a.z, x46, s2);
    s3 = fmaf(a.w, x47, s3);
    a = *(const LAS f32x4*)(Am + 4196);
    s0 = fmaf(a.x, x48, s0);
    s1 = fmaf(a.y, x49, s1);
    s2 = fmaf(a.z, x50, s2);
    s3 = fmaf(a.w, x51, s3);
    a = *(const LAS f32x4*)(Am + 4200);
    s0 = fmaf(a.x, x52, s0);
    s1 = fmaf(a.y, x53, s1);
    s2 = fmaf(a.z, x54, s2);
    s3 = fmaf(a.w, x55, s3);
    a = *(const LAS f32x4*)(Am + 4204);
    s0 = fmaf(a.x, x56, s0);
    s1 = fmaf(a.y, x57, s1);
    s2 = fmaf(a.z, x58, s2);
    s3 = fmaf(a.w, x59, s3);
    a = *(const LAS f32x4*)(Am + 4208);
    const float al61 = a.x;
    x61 = (x61 - ((s0 + s1) + (s2 + s3))) - al61 * x60;
    Tu[8296 + c] = f2bf(x61 * su); Tw[8296 + c] = f2bf(x61 * sw); asm volatile("" ::: "memory");
    float x62 = fmaxf(0.0f, 1.0f - fabsf(cf - 62.0f));
    s0 = 0.f; s1 = 0.f; s2 = 0.f; s3 = 0.f;
    a = *(const LAS f32x4*)(Am + 4216);
    s0 = fmaf(a.x, x0, s0);
    s1 = fmaf(a.y, x1, s1);
    s2 = fmaf(a.z, x2, s2);
    s3 = fmaf(a.w, x3, s3);
    a = *(const LAS f32x4*)(Am + 4220);
    s0 = fmaf(a.x, x4, s0);
    s1 = fmaf(a.y, x5, s1);
    s2 = fmaf(a.z, x6, s2);
    s3 = fmaf(a.w, x7, s3);
    a = *(const LAS f32x4*)(Am + 4224);
    s0 = fmaf(a.x, x8, s0);
    s1 = fmaf(a.y, x9, s1);
    s2 = fmaf(a.z, x10, s2);
    s3 = fmaf(a.w, x11, s3);
    a = *(const LAS f32x4*)(Am + 4228);
    s0 = fmaf(a.x, x12, s0);
    s1 = fmaf(a.y, x13, s1);
    s2 = fmaf(a.z, x14, s2);
    s3 = fmaf(a.w, x15, s3);
    a = *(const LAS f32x4*)(Am + 4232);
    s0 = fmaf(a.x, x16, s0);
    s1 = fmaf(a.y, x17, s1);
    s2 = fmaf(a.z, x18, s2);
    s3 = fmaf(a.w, x19, s3);
    a = *(const LAS f32x4*)(Am + 4236);
    s0 = fmaf(a.x, x20, s0);
    s1 = fmaf(a.y, x21, s1);
    s2 = fmaf(a.z, x22, s2);
    s3 = fmaf(a.w, x23, s3);
    a = *(const LAS f32x4*)(Am + 4240);
    s0 = fmaf(a.x, x24, s0);
    s1 = fmaf(a.y, x25, s1);
    s2 = fmaf(a.z, x26, s2);
    s3 = fmaf(a.w, x27, s3);
    a = *(const LAS f32x4*)(Am + 4244);
    s0 = fmaf(a.x, x28, s0);
    s1 = fmaf(a.y, x29, s1);
    s2 = fmaf(a.z, x30, s2);
    s3 = fmaf(a.w, x31, s3);
    a = *(const LAS f32x4*)(Am + 4248);
    s0 = fmaf(a.x, x32, s0);
    s1 = fmaf(a.y, x33, s1);
    s2 = fmaf(a.z, x34, s2);
    s3 = fmaf(a.w, x35, s3);
    a = *(const LAS f32x4*)(Am + 4252);
    s0 = fmaf(a.x, x36, s0);
    s1 = fmaf(a.y, x37, s1);
    s2 = fmaf(a.z, x38, s2);
    s3 = fmaf(a.w, x39, s3);
    a = *(const LAS f32x4*)(Am + 4256);
    s0 = fmaf(a.x, x40, s0);
    s1 = fmaf(a.y, x41, s1);
    s2 = fmaf(a.z, x42, s2);
    s3 = fmaf(a.w, x43, s3);
    a = *(const LAS f32x4*)(Am + 4260);
    s0 = fmaf(a.x, x44, s0);
    s1 = fmaf(a.y, x45, s1);
    s2 = fmaf(a.z, x46, s2);
    s3 = fmaf(a.w, x47, s3);
    a = *(const LAS f32x4*)(Am + 4264);
    s0 = fmaf(a.x, x48, s0);
    s1 = fmaf(a.y, x49, s1);
    s2 = fmaf(a.z, x50, s2);
    s3 = fmaf(a.w, x51, s3);
    a = *(const LAS f32x4*)(Am + 4268);
    s0 = fmaf(a.x, x52, s0);
    s1 = fmaf(a.y, x53, s1);
    s2 = fmaf(a.z, x54, s2);
    s3 = fmaf(a.w, x55, s3);
    a = *(const LAS f32x4*)(Am + 4272);
    s0 = fmaf(a.x, x56, s0);
    s1 = fmaf(a.y, x57, s1);
    s2 = fmaf(a.z, x58, s2);
    s3 = fmaf(a.w, x59, s3);
    a = *(const LAS f32x4*)(Am + 4276);
    s0 = fmaf(a.x, x60, s0);
    const float al62 = a.y;
    x62 = (x62 - ((s0 + s1) + (s2 + s3))) - al62 * x61;
    Tu[8432 + c] = f2bf(x62 * su); Tw[8432 + c] = f2bf(x62 * sw); asm volatile("" ::: "memory");
    float x63 = fmaxf(0.0f, 1.0f - fabsf(cf - 63.0f));
    s0 = 0.f; s1 = 0.f; s2 = 0.f; s3 = 0.f;
    a = *(const LAS f32x4*)(Am + 4284);
    s0 = fmaf(a.x, x0, s0);
    s1 = fmaf(a.y, x1, s1);
    s2 = fmaf(a.z, x2, s2);
    s3 = fmaf(a.w, x3, s3);
    a = *(const LAS f32x4*)(Am + 4288);
    s0 = fmaf(a.x, x4, s0);
    s1 = fmaf(a.y, x5, s1);
    s2 = fmaf(a.z, x6, s2);
    s3 = fmaf(a.w, x7, s3);
    a = *(const LAS f32x4*)(Am + 4292);
    s0 = fmaf(a.x, x8, s0);
    s1 = fmaf(a.y, x9, s1);
    s2 = fmaf(a.z, x10, s2);
    s3 = fmaf(a.w, x11, s3);
    a = *(const LAS f32x4*)(Am + 4296);
    s0 = fmaf(a.x, x12, s0);
    s1 = fmaf(a.y, x13, s1);
    s2 = fmaf(a.z, x14, s2);
    s3 = fmaf(a.w, x15, s3);
    a = *(const LAS f32x4*)(Am + 4300);
    s0 = fmaf(a.x, x16, s0);
    s1 = fmaf(a.y, x17, s1);
    s2 = fmaf(a.z, x18, s2);
    s3 = fmaf(a.w, x19, s3);
    a = *(const LAS f32x4*)(Am + 4304);
    s0 = fmaf(a.x, x20, s0);
    s1 = fmaf(a.y, x21, s1);
    s2 = fmaf(a.z, x22, s2);
    s3 = fmaf(a.w, x23, s3);
    a = *(const LAS f32x4*)(Am + 4308);
    s0 = fmaf(a.x, x24, s0);
    s1 = fmaf(a.y, x25, s1);
    s2 = fmaf(a.z, x26, s2);
    s3 = fmaf(a.w, x27, s3);
    a = *(const LAS f32x4*)(Am + 4312);
    s0 = fmaf(a.x, x28, s0);
    s1 = fmaf(a.y, x29, s1);
    s2 = fmaf(a.z, x30, s2);
    s3 = fmaf(a.w, x31, s3);
    a = *(const LAS f32x4*)(Am + 4316);
    s0 = fmaf(a.x, x32, s0);
    s1 = fmaf(a.y, x33, s1);
    s2 = fmaf(a.z, x34, s2);
    s3 = fmaf(a.w, x35, s3);
    a = *(const LAS f32x4*)(Am + 4320);
    s0 = fmaf(a.x, x36, s0);
    s1 = fmaf(a.y, x37, s1);
    s2 = fmaf(a.z, x38, s2);
    s3 = fmaf(a.w, x39, s3);
    a = *(const LAS f32x4*)(Am + 4324);
    s0 = fmaf(a.x, x40, s0);
    s1 = fmaf(a.y, x41, s1);
    s2 = fmaf(a.z, x42, s2);
    s3 = fmaf(a.w, x43, s3);
    a = *(const LAS f32x4*)(Am + 4328);
    s0 = fmaf(a.x, x44, s0);
    s1 = fmaf(a.y, x45, s1);
    s2 = fmaf(a.z, x46, s2);
    s3 = fmaf(a.w, x47, s3);
    a = *(const LAS f32x4*)(Am + 4332);
    s0 = fmaf(a.x, x48, s0);
    s1 = fmaf(a.y, x49, s1);
    s2 = fmaf(a.z, x50, s2);
    s3 = fmaf(a.w, x51, s3);
    a = *(const LAS f32x4*)(Am + 4336);
    s0 = fmaf(a.x, x52, s0);
    s1 = fmaf(a.y, x53, s1);
    s2 = fmaf(a.z, x54, s2);
    s3 = fmaf(a.w, x55, s3);
    a = *(const LAS f32x4*)(Am + 4340);
    s0 = fmaf(a.x, x56, s0);
    s1 = fmaf(a.y, x57, s1);
    s2 = fmaf(a.z, x58, s2);
    s3 = fmaf(a.w, x59, s3);
    a = *(const LAS f32x4*)(Am + 4344);
    s0 = fmaf(a.x, x60, s0);
    s1 = fmaf(a.y, x61, s1);
    const float al63 = a.z;
    x63 = (x63 - ((s0 + s1) + (s2 + s3))) - al63 * x62;
    Tu[8568 + c] = f2bf(x63 * su); Tw[8568 + c] = f2bf(x63 * sw); asm volatile("" ::: "memory");
}
typedef short bf16x8_t __attribute__((ext_vector_type(8)));
template <int K> __device__ __forceinline__ f32x4 mma_tile(const LAS unsigned short* A, int lda, const LAS unsigned short* Bt, int ldb, f32x4 acc) {
    const int lane = threadIdx.x & 63, r = lane & 15, q = lane >> 4;
#pragma unroll
    for (int ks = 0; ks < K / 32; ++ks) {
        const bf16x8_t a = *(const LAS bf16x8_t*)(A + r * lda + ks * 32 + q * 8);
        const bf16x8_t b = *(const LAS bf16x8_t*)(Bt + r * ldb + ks * 32 + q * 8);
        acc = __builtin_amdgcn_mfma_f32_16x16x32_bf16(a, b, acc, 0, 0, 0);
    }
    return acc;
}

typedef unsigned short u16x4_t __attribute__((ext_vector_type(4)));
__device__ __forceinline__ void tr_frag2(unsigned base_addr, int pitch, int c, bf16x8_t& f0, bf16x8_t& f1) {
    const int lane = threadIdx.x & 63, g = lane >> 4, qq = (lane & 15) >> 2, pp = lane & 3;
    const unsigned a00 = base_addr + (unsigned)((8 * g + qq) * pitch + 32 * c + 8 * pp);
    const unsigned a01 = a00 + 4u * (unsigned)pitch, a10 = a00 + 32u * (unsigned)pitch, a11 = a10 + 4u * (unsigned)pitch;
    u16x4_t r00, r01, r10, r11;
    asm volatile("ds_read_b64_tr_b16 %0, %4\n\tds_read_b64_tr_b16 %1, %5\n\tds_read_b64_tr_b16 %2, %6\n\tds_read_b64_tr_b16 %3, %7\n\ts_waitcnt lgkmcnt(0)"
                 : "=&v"(r00), "=&v"(r01), "=&v"(r10), "=&v"(r11) : "v"(a00), "v"(a01), "v"(a10), "v"(a11) : "memory");
    f0 = (bf16x8_t){(short)r00.x, (short)r00.y, (short)r00.z, (short)r00.w, (short)r01.x, (short)r01.y, (short)r01.z, (short)r01.w};
    f1 = (bf16x8_t){(short)r10.x, (short)r10.y, (short)r10.z, (short)r10.w, (short)r11.x, (short)r11.y, (short)r11.z, (short)r11.w};
}
constexpr size_t WS_G = 235 * MiB;

__device__ __forceinline__ void delta_prep(LDSp lds, const Params& p) {
    const bf16_t* QKVN = (const bf16_t*)(p.ws + WS_QKV); const float* BETA = (const float*)(p.ws + WS_BETA); const float* LA = (const float*)(p.ws + WS_LA);
    bf16_t* Z = (bf16_t*)(p.ws + WS_Z); float* GB = (float*)(p.ws + WS_G);
    LAS unsigned short* Qb = (LAS unsigned short*)lds;
    LAS unsigned short* Kb = (LAS unsigned short*)(lds + 17408);
    LAS unsigned short* Ast = (LAS unsigned short*)(lds + 107776);
    const int tid = threadIdx.x, lane = tid & 63, wid = tid >> 6, r = lane & 15, q = lane >> 4;
    const int G = gridDim.x;
    u32x4 pq[4]; float pla = 0.f, pbe = 0.f;
#define DPL(u_, vmode) do { const int dir_ = (u_) >> 10, b_ = ((u_) >> 8) & 3, h_ = ((u_) >> 6) & 3, n_ = (u_) & 63; \
        const long tk0_ = (long)b_ * S_ + (dir_ ? (S_ - 1 - n_ * 64) : n_ * 64); const long ts_ = dir_ ? -1 : 1; \
        _Pragma("unroll") for (int i = 0; i < 4; ++i) { const int pi = tid + NTHR * i, which = pi >> 10, l = (pi >> 4) & 63, c8 = pi & 15; \
            pq[i] = *(const u32x4*)(QKVN + (tk0_ + l * ts_) * 1536 + ((vmode) ? (which ? 512 : 1024) : which * 512) + h_ * 128 + c8 * 8); } \
        if (!(vmode) && tid < 64) { const long tk = tk0_ + tid * ts_; pla = LA[tk * 8 + dir_ * 4 + h_]; pbe = BETA[tk * 8 + dir_ * 4 + h_]; } } while (0)
#define DPS() do { _Pragma("unroll") for (int i = 0; i < 4; ++i) { const int pi = tid + NTHR * i, which = pi >> 10, l = (pi >> 4) & 63, c8 = pi & 15; *(LAS u32x4*)(lds + which * 17408 + l * 272 + c8 * 16) = pq[i]; } } while (0)
    if ((int)blockIdx.x < 2048) DPL((int)blockIdx.x, 0);
    for (int ub = blockIdx.x; ub < 2048; ub += 4 * G) {
#pragma unroll 1
        for (int j = 0; j < 4; ++j) { const int unit = ub + j * G; if (unit >= 2048) break;
            const int dir = unit >> 10, b = (unit >> 8) & 3, h = (unit >> 6) & 3, n = unit & 63;
            const long tok0 = (long)b * S_ + (dir ? (S_ - 1 - n * 64) : n * 64); const long tstep = dir ? -1 : 1;
            LAS float* Am = (LAS float*)(lds + 34816 + j * 17408); LAS float* gl = (LAS float*)(lds + 104448 + j * 768); LAS float* be = gl + 64; LAS float* beg = gl + 128; LAS float* la = (LAS float*)(lds + 107520);
            DPS();
            if (tid < 64) { la[tid] = pla; be[tid] = pbe; }
            __syncthreads();
            { const int un = ub + (j + 1) * G; if (j < 3 && un < 2048) DPL(un, 0); else DPL(ub, 1); }
            if (tid < 64) { const float g = wave_scan_sum(la[tid], true); gl[tid] = g; beg[tid] = be[tid] * __expf(g); GB[((size_t)dir * T_ + (tok0 + tid * tstep)) * 4 + h] = g; }
            __syncthreads();
#pragma unroll
            for (int tt = 0; tt < 2; ++tt) { const int idx = wid * 2 + tt, mt = idx >> 2, nt = idx & 3;
                f32x4 kk = {0.f, 0.f, 0.f, 0.f}, qk = {0.f, 0.f, 0.f, 0.f};
                if (mt >= nt) { kk = mma_tile<128>(Kb + mt * 16 * 136, 136, Kb + nt * 16 * 136, 136, kk); qk = mma_tile<128>(Qb + mt * 16 * 136, 136, Kb + nt * 16 * 136, 136, qk); }
                const int jj = nt * 16 + r; const float gj = gl[jj];
#pragma unroll
                for (int i4 = 0; i4 < 4; ++i4) { const int i = mt * 16 + q * 4 + i4; const float dec = (i >= jj) ? __expf(gl[i] - gj) : 0.f;
                    Am[i * 68 + jj] = (i > jj) ? be[i] * kk[i4] * dec : 0.f;
                    Ast[i * 72 + jj] = f2bf(qk[i4] * dec); }
            }
            __syncthreads();
            { const int l = tid >> 3, c8 = tid & 7;
              *(u32x4*)(Z + (tok0 + l * tstep) * 3072 + 2048 + dir * 256 + h * 64 + c8 * 8) = *(const LAS u32x4*)(Ast + l * 72 + c8 * 8); }
        }
        if (wid < 4 && ub + wid * G < 2048) { int cc = lane; asm volatile("" : "+v"(cc));
            LAS float* Am = (LAS float*)(lds + 34816 + wid * 17408); LAS float* gl = (LAS float*)(lds + 104448 + wid * 768);
            tri_inv64(Am, cc, gl[64 + lane], gl[128 + lane], (LAS unsigned short*)Am, (LAS unsigned short*)Am + 64); }
        __syncthreads();
#pragma unroll 1
        for (int j = 0; j < 4; ++j) { const int unit = ub + j * G; if (unit >= 2048) break;
            const int dir = unit >> 10, b = (unit >> 8) & 3, h = (unit >> 6) & 3, n = unit & 63;
            const long tok0 = (long)b * S_ + (dir ? (S_ - 1 - n * 64) : n * 64); const long tstep = dir ? -1 : 1;
            const LAS unsigned short* Tu = (const LAS unsigned short*)(lds + 34816 + j * 17408);
            DPS();
            __syncthreads();
            { const int un = ub + (j + 1) * G; if (j < 3 && un < 2048) DPL(un, 1); else if (ub + 4 * G < 2048) DPL(ub + 4 * G, 0); }
            {   bf16x8_t vb0, vb1, kb0, kb1; tr_frag2((unsigned)(unsigned long long)Qb, 272, wid, vb0, vb1); tr_frag2((unsigned)(unsigned long long)Kb, 272, wid, kb0, kb1);
                __syncthreads();
#pragma unroll
                for (int mt = 0; mt < 4; ++mt) {
                    const bf16x8_t tu0 = *(const LAS bf16x8_t*)(Tu + (mt * 16 + r) * 136 + q * 8), tu1 = *(const LAS bf16x8_t*)(Tu + (mt * 16 + r) * 136 + 32 + q * 8);
                    const bf16x8_t tw0 = *(const LAS bf16x8_t*)(Tu + (mt * 16 + r) * 136 + 64 + q * 8), tw1 = *(const LAS bf16x8_t*)(Tu + (mt * 16 + r) * 136 + 96 + q * 8);
                    f32x4 au = {0.f, 0.f, 0.f, 0.f}, aw = {0.f, 0.f, 0.f, 0.f};
                    au = __builtin_amdgcn_mfma_f32_16x16x32_bf16(tu0, vb0, au, 0, 0, 0); au = __builtin_amdgcn_mfma_f32_16x16x32_bf16(tu1, vb1, au, 0, 0, 0);
                    aw = __builtin_amdgcn_mfma_f32_16x16x32_bf16(tw0, kb0, aw, 0, 0, 0); aw = __builtin_amdgcn_mfma_f32_16x16x32_bf16(tw1, kb1, aw, 0, 0, 0);
#pragma unroll
                    for (int i4 = 0; i4 < 4; ++i4) { const int l = mt * 16 + q * 4 + i4; Qb[l * 136 + wid * 16 + r] = f2bf(au[i4]); Kb[l * 136 + wid * 16 + r] = f2bf(aw[i4]); }
                }
            }
            __syncthreads();
#pragma unroll
            for (int i = 0; i < 4; ++i) { const int pi = tid + NTHR * i, which = pi >> 10, l = (pi >> 4) & 63, c8 = pi & 15;
                *(u32x4*)(Z + (tok0 + l * tstep) * 3072 + which * 1024 + dir * 512 + h * 128 + c8 * 8) = *(const LAS u32x4*)(lds + which * 17408 + l * 272 + c8 * 16); }
            __syncthreads();
        }
    }
}
#undef DPL
#undef DPS

__device__ __forceinline__ void delta_scan2(LDSp lds, const Params& p) {
    const bf16_t* QKVN = (const bf16_t*)(p.ws + WS_QKV); const bf16_t* Z = (const bf16_t*)(p.ws + WS_Z); const float* GB = (const float*)(p.ws + WS_G);
    LAS unsigned short* Wb  = (LAS unsigned short*)lds;
    LAS unsigned short* Qg  = (LAS unsigned short*)(lds + 17408);
    LAS unsigned short* Kg  = (LAS unsigned short*)(lds + 34816);
    LAS unsigned short* At  = (LAS unsigned short*)(lds + 53248);
    LAS unsigned short* Ub  = (LAS unsigned short*)(lds + 62464);
    LAS unsigned short* St  = (LAS unsigned short*)(lds + 66560);
    LAS unsigned short* Vt  = (LAS unsigned short*)(lds + 75264);
    const int tid = threadIdx.x, lane = tid & 63, wid = tid >> 6, r = lane & 15, q = lane >> 4;
    for (int unit = blockIdx.x; unit < 128; unit += gridDim.x) {
        const int dir = unit >> 6, b = (unit >> 4) & 3, h = (unit >> 2) & 3, sl = unit & 3;
        bf16_t* O = (bf16_t*)(p.ws + (dir ? WS_OB : WS_OF));
        const long tstep = dir ? -1 : 1;
        f32x4 S0 = {0.f, 0.f, 0.f, 0.f}, S1 = {0.f, 0.f, 0.f, 0.f};
        u32x4 rwA[2], rqA[2], rkA[2], raA, ruA = {0u, 0u, 0u, 0u}; float g0A = 0.f, g1A = 0.f, gLA = 0.f;
        u32x4 rwB[2], rqB[2], rkB[2], raB, ruB = {0u, 0u, 0u, 0u}; float g0B = 0.f, g1B = 0.f, gLB = 0.f;
#define D2_TOK0(n) ((long)b * S_ + (dir ? (S_ - 1 - (n) * 64) : (n) * 64))
#define D2_LOAD(n, X) do { const long t0_ = D2_TOK0(n); \
        _Pragma("unroll") for (int i = 0; i < 2; ++i) { const int pi = tid + NTHR * i, l = pi >> 4, c8 = pi & 15; const long tk = t0_ + l * tstep; \
            rw##X[i] = *(const u32x4*)(Z + tk * 3072 + 1024 + dir * 512 + h * 128 + c8 * 8); \
            rq##X[i] = *(const u32x4*)(QKVN + tk * 1536 + h * 128 + c8 * 8); rk##X[i] = *(const u32x4*)(QKVN + tk * 1536 + 512 + h * 128 + c8 * 8); } \
        { const int l = tid >> 3, c8 = tid & 7; ra##X = *(const u32x4*)(Z + (t0_ + l * tstep) * 3072 + 2048 + dir * 256 + h * 64 + c8 * 8); } \
        if (tid < 256) { const int l = tid >> 2, c8 = tid & 3; ru##X = *(const u32x4*)(Z + (t0_ + l * tstep) * 3072 + dir * 512 + h * 128 + sl * 32 + c8 * 8); } \
        g0##X = GB[((size_t)dir * T_ + (t0_ + (tid >> 4) * tstep)) * 4 + h]; g1##X = GB[((size_t)dir * T_ + (t0_ + ((tid >> 4) + 32) * tstep)) * 4 + h]; \
        gL##X = GB[((size_t)dir * T_ + (t0_ + 63 * tstep)) * 4 + h]; } while (0)
#define D2_ITER(n, X) do { \
            const float egL = __expf(gL##X); \
            _Pragma("unroll") for (int i = 0; i < 2; ++i) { const int pi = tid + NTHR * i, l = pi >> 4, c8 = pi & 15; const float gl_ = i == 0 ? g0##X : g1##X; \
                *(LAS u32x4*)(Wb + l * 136 + c8 * 8) = rw##X[i]; \
                float f[8]; unpack8(rq##X[i], f); const float eg = __expf(gl_); \
                u32x4 o; o.x = pk2(f[0] * eg, f[1] * eg); o.y = pk2(f[2] * eg, f[3] * eg); o.z = pk2(f[4] * eg, f[5] * eg); o.w = pk2(f[6] * eg, f[7] * eg); \
                *(LAS u32x4*)(Qg + l * 136 + c8 * 8) = o; \
                unpack8(rk##X[i], f); const float ek = __expf(gL##X - gl_); \
                o.x = pk2(f[0] * ek, f[1] * ek); o.y = pk2(f[2] * ek, f[3] * ek); o.z = pk2(f[4] * ek, f[5] * ek); o.w = pk2(f[6] * ek, f[7] * ek); \
                *(LAS u32x4*)(Kg + l * 144 + c8 * 8) = o; } \
            { const int l = tid >> 3, c8 = tid & 7; *(LAS u32x4*)(At + l * 72 + c8 * 8) = ra##X; } \
            if (tid < 256) { const int l = tid >> 2, c8 = tid & 3; *(LAS u32x4*)(Ub + l * 32 + c8 * 8) = ru##X; } \
            { u32x2 w0; w0.x = pk2(S0.x, S0.y); w0.y = pk2(S0.z, S0.w); *(LAS u32x2*)(St + r * 136 + wid * 16 + q * 4) = w0; \
              u32x2 w1; w1.x = pk2(S1.x, S1.y); w1.y = pk2(S1.z, S1.w); *(LAS u32x2*)(St + (16 + r) * 136 + wid * 16 + q * 4) = w1; } \
            __syncthreads(); \
            if ((n) + 2 < 64) D2_LOAD((n) + 2, X); \
            const int mt = wid >> 1, nt = wid & 1; \
            f32x4 p1 = {0.f, 0.f, 0.f, 0.f}, p2 = {0.f, 0.f, 0.f, 0.f}; \
            p1 = mma_tile<128>(Wb + mt * 16 * 136, 136, St + nt * 16 * 136, 136, p1); \
            p2 = mma_tile<128>(Qg + mt * 16 * 136, 136, St + nt * 16 * 136, 136, p2); \
            { const int l0 = mt * 16 + q * 4, v = nt * 16 + r; float vn[4]; \
              _Pragma("unroll") for (int i = 0; i < 4; ++i) vn[i] = bf2f(Ub[(l0 + i) * 32 + v]) - p1[i]; \
              u32x2 w; w.x = pk2(vn[0], vn[1]); w.y = pk2(vn[2], vn[3]); *(LAS u32x2*)(Vt + v * 72 + l0) = w; } \
            __syncthreads(); \
            p2 = mma_tile<64>(At + mt * 16 * 72, 72, Vt + nt * 16 * 72, 72, p2); \
            { const long t0_ = D2_TOK0(n); \
              _Pragma("unroll") for (int i = 0; i < 4; ++i) O[(t0_ + (mt * 16 + q * 4 + i) * tstep) * 512 + h * 128 + sl * 32 + nt * 16 + r] = f2bf(p2[i]); } \
            S0 = S0 * egL; S1 = S1 * egL; \
            { bf16x8_t ka0, ka1; tr_frag2((unsigned)(unsigned long long)Kg, 288, wid, ka0, ka1); \
              const bf16x8_t vb00 = *(const LAS bf16x8_t*)(Vt + r * 72 + q * 8), vb01 = *(const LAS bf16x8_t*)(Vt + r * 72 + 32 + q * 8); \
              const bf16x8_t vb10 = *(const LAS bf16x8_t*)(Vt + (16 + r) * 72 + q * 8), vb11 = *(const LAS bf16x8_t*)(Vt + (16 + r) * 72 + 32 + q * 8); \
              S0 = __builtin_amdgcn_mfma_f32_16x16x32_bf16(ka0, vb00, S0, 0, 0, 0); S0 = __builtin_amdgcn_mfma_f32_16x16x32_bf16(ka1, vb01, S0, 0, 0, 0); \
              S1 = __builtin_amdgcn_mfma_f32_16x16x32_bf16(ka0, vb10, S1, 0, 0, 0); S1 = __builtin_amdgcn_mfma_f32_16x16x32_bf16(ka1, vb11, S1, 0, 0, 0); } \
            __syncthreads(); } while (0)
        D2_LOAD(0, A); D2_LOAD(1, B);
#pragma unroll 1
        for (int n = 0; n < 64; n += 2) { D2_ITER(n, A); D2_ITER(n + 1, B); }
#undef D2_ITER
#undef D2_LOAD
#undef D2_TOK0
    }
}
constexpr size_t WS_CT = WS_OF, WS_NV = 235 * MiB, WS_MS = 235 * MiB + 524288, WS_CT2 = 169 * MiB, WS_NV2 = 236 * MiB;
__device__ __forceinline__ void mlstm_a(LDSp lds, const Params& p) {
    const bf16_t* Z = (const bf16_t*)(p.ws + WS_Z); const float* LI = (const float*)(p.ws + WS_BETA); const float* LF = (const float*)(p.ws + WS_LA);
    bf16_t* CT = (bf16_t*)(p.ws + WS_CT); float* NV = (float*)(p.ws + WS_NV); float* MS = (float*)(p.ws + WS_MS);
    LAS unsigned short* Ks = (LAS unsigned short*)lds;
    LAS unsigned short* Vr = (LAS unsigned short*)(lds + 9216);
    LAS float* lf = (LAS float*)(lds + 27648); LAS float* li = lf + 64; LAS float* sw = lf + 128; LAS float* red = lf + 192  ;
    const int tid = threadIdx.x, lane = tid & 63, wid = tid >> 6, r = lane & 15, q = lane >> 4;
    for (int unit = blockIdx.x; unit < 2048; unit += gridDim.x) {
        const int dir = unit >> 10, b = (unit >> 8) & 3, h = (unit >> 6) & 3, n = unit & 63, pc = dir ? 63 - n : n;
        const size_t tok0 = (size_t)b * S_ + pc * 64;
        if (tid < 64) { lf[tid] = LF[(tok0 + tid) * 8 + dir * 4 + h]; li[tid] = LI[(tok0 + tid) * 8 + dir * 4 + h]; }
        __syncthreads();
        if (tid < 64) { const float bc = wave_scan_sum(lf[tid], dir == 0);
            const float tot = __shfl(bc, dir ? 0 : 63);
            const float we = tot - bc + li[tid]; float mx = we;
#pragma unroll
            for (int o = 32; o; o >>= 1) mx = fmaxf(mx, __shfl_xor(mx, o));
            sw[tid] = __expf(we - mx);
            if (tid == 0) { MS[unit * 32] = tot; MS[unit * 32 + 1] = mx; } }
        __syncthreads();
        { const int pp = tid >> 3, c8 = tid & 7; const u32x4 kv = *(const u32x4*)(Z + (tok0 + pp) * 2560 + 1280 + h * 64 + c8 * 8); float f[8]; unpack8(kv, f); const float s = sw[pp];
          u32x4 o; o.x = pk2(f[0] * s, f[1] * s); o.y = pk2(f[2] * s, f[3] * s); o.z = pk2(f[4] * s, f[5] * s); o.w = pk2(f[6] * s, f[7] * s);
          *(LAS u32x4*)(Ks + pp * 72 + c8 * 8) = o; }
#pragma unroll
        for (int i = 0; i < 2; ++i) { const int pi = tid + NTHR * i, pp = pi >> 4, c8 = pi & 15;
            *(LAS u32x4*)(Vr + pp * 144 + c8 * 8) = *(const u32x4*)(Z + (tok0 + pp) * 2560 + 1536 + h * 128 + c8 * 8); }
        __syncthreads();
        { bf16x8_t vb0, vb1; tr_frag2((unsigned)(unsigned long long)Vr, 288, wid, vb0, vb1);
#pragma unroll
          for (int dt = 0; dt < 4; ++dt) { bf16x8_t ka0, ka1; tr_frag2((unsigned)(unsigned long long)Ks, 144, dt, ka0, ka1);
            f32x4 acc = {0.f, 0.f, 0.f, 0.f};
            acc = __builtin_amdgcn_mfma_f32_16x16x32_bf16(ka0, vb0, acc, 0, 0, 0); acc = __builtin_amdgcn_mfma_f32_16x16x32_bf16(ka1, vb1, acc, 0, 0, 0);
            u32x2 w; w.x = pk2(acc.x, acc.y); w.y = pk2(acc.z, acc.w);
            *(u32x2*)(CT + (size_t)unit * 8192 + (wid * 16 + r) * 64 + dt * 16 + q * 4) = w; } }
        { const int d = tid & 63; float a = 0.f;
#pragma unroll
          for (int j = 0; j < 8; ++j) a += bf2f(Ks[(wid * 8 + j) * 72 + d]);
          red[wid * 64 + d] = a; }
        __syncthreads();
        if (tid < 64) { float a = 0.f;
#pragma unroll
            for (int w = 0; w < 8; ++w) a += red[w * 64 + tid];
            NV[(size_t)unit * 64 + tid] = a; }
        __syncthreads();
    }
}
__device__ __forceinline__ void mlstm_b(const Params& p) {
    const bf16_t* CT = (const bf16_t*)(p.ws + WS_CT); const float* NV = (const float*)(p.ws + WS_NV); float* MS = (float*)(p.ws + WS_MS); bf16_t* CT2 = (bf16_t*)(p.ws + WS_CT2); float* NV2 = (float*)(p.ws + WS_NV2);
    const int tid = threadIdx.x;
    for (int wgi = blockIdx.x; wgi < 128; wgi += gridDim.x) {
        const int scan = wgi >> 2, part = wgi & 3; const size_t e = (size_t)(part * NTHR + tid) * 4;
        const bool nvw = (part == 0 && tid < 64);
        float m = 0.f, c0 = 0.f, c1 = 0.f, c2 = 0.f, c3 = 0.f, nn = 0.f;
#pragma unroll 1
        for (int hf = 0; hf < 4; ++hf) {
        u32x2 dc[16]; float dn[16], blv[16], mlv[16];
#pragma unroll
        for (int n = 0; n < 16; ++n) { blv[n] = MS[(scan * 64 + hf * 16 + n) * 32]; mlv[n] = MS[(scan * 64 + hf * 16 + n) * 32 + 1]; dc[n] = (EXPC == 2) ? (u32x2){0u, 0u} : *(const u32x2*)(CT + (size_t)(scan * 64 + hf * 16 + n) * 8192 + e); dn[n] = nvw ? NV[(size_t)(scan * 64 + hf * 16 + n) * 64 + tid] : 0.f; }
#pragma unroll
        for (int n = 0; n < 16; ++n) { const int unit = scan * 64 + hf * 16 + n;
            const float bl = blv[n], ml = mlv[n];
            u32x2 w; w.x = pk2(c0, c1); w.y = pk2(c2, c3); *(u32x2*)(CT2 + (size_t)unit * 8192 + e) = w;
            if (nvw) NV2[(size_t)unit * 64 + tid] = nn;
            if (part == 0 && tid == 0) MS[65536 + unit] = m;
            const float mn = fmaxf(bl + m, ml), a = __expf(bl + m - mn), bb = __expf(ml - mn);
            c0 = a * c0 + bb * bflo(dc[n].x); c1 = a * c1 + bb * bfhi(dc[n].x); c2 = a * c2 + bb * bflo(dc[n].y); c3 = a * c3 + bb * bfhi(dc[n].y);
            nn = a * nn + bb * dn[n]; m = mn; }
        }
    }
}
__device__ __forceinline__ void mlstm_c(LDSp lds, const Params& p) {
    const bf16_t* Z = (const bf16_t*)(p.ws + WS_Z); const float* LI = (const float*)(p.ws + WS_BETA); const float* LF = (const float*)(p.ws + WS_LA);
    const bf16_t* CT = (const bf16_t*)(p.ws + WS_CT2); const float* NV = (const float*)(p.ws + WS_NV2); const float* MS = (const float*)(p.ws + WS_MS);
    bf16_t* Y = (bf16_t*)(p.ws + WS_HN); const float* gn = p.in[19];
    LAS unsigned short* Qb = (LAS unsigned short*)lds;
    LAS unsigned short* Kb = (LAS unsigned short*)(lds + 9216);
    LAS unsigned short* Vr = (LAS unsigned short*)(lds + 18432);
    LAS float* ssp = (LAS float*)(lds + 100352);
#define MC_CB(d) ((LAS unsigned short*)(lds + 36864 + (d) * 18432))
#define MC_PB(d) ((LAS unsigned short*)(lds + 73728 + (d) * 9216))
#define MC_SC(d) ((LAS float*)(lds + 92160 + (d) * 4096))
    const int tid = threadIdx.x, wid = tid >> 6;
    for (int unit = blockIdx.x; unit < 1024; unit += gridDim.x) {
        int lane = tid & 63; asm volatile("" : "+v"(lane));
        const int r = lane & 15, q = lane >> 4;
        const int b = unit >> 8, h = (unit >> 6) & 3, pc = unit & 63; const size_t tok0 = (size_t)b * S_ + pc * 64;
        const size_t ua = (size_t)(((0 * 4 + b) * 4 + h) * 64 + pc), ub = (size_t)(((1 * 4 + b) * 4 + h) * 64 + (63 - pc));
        { const int pp = tid >> 3, c8 = tid & 7;
          *(LAS u32x4*)(Qb + pp * 72 + c8 * 8) = *(const u32x4*)(Z + (tok0 + pp) * 2560 + 1024 + h * 64 + c8 * 8);
          *(LAS u32x4*)(Kb + pp * 72 + c8 * 8) = *(const u32x4*)(Z + (tok0 + pp) * 2560 + 1280 + h * 64 + c8 * 8); }
#pragma unroll
        for (int i = 0; i < 2; ++i) { const int pi = tid + NTHR * i, pp = pi >> 4, c8 = pi & 15; *(LAS u32x4*)(Vr + pp * 144 + c8 * 8) = *(const u32x4*)(Z + (tok0 + pp) * 2560 + 1536 + h * 128 + c8 * 8); }
#pragma unroll
        for (int i = 0; i < 2; ++i) { const int pi = tid + NTHR * i, v = pi >> 3, c8 = pi & 7;
            *(LAS u32x4*)(MC_CB(0) + v * 72 + c8 * 8) = *(const u32x4*)(CT + ua * 8192 + v * 64 + c8 * 8); *(LAS u32x4*)(MC_CB(1) + v * 72 + c8 * 8) = *(const u32x4*)(CT + ub * 8192 + v * 64 + c8 * 8); }
        float mst = 0.f;
        if (tid < 128) { const int d = tid >> 6; const size_t ud = d ? ub : ua; LAS float* sc = MC_SC(d);
            sc[lane] = LF[(tok0 + lane) * 8 + d * 4 + h]; sc[64 + lane] = LI[(tok0 + lane) * 8 + d * 4 + h]; sc[384 + lane] = NV[ud * 64 + lane]; mst = MS[65536 + ud]; }
        __syncthreads();
        bf16x8_t vb0, vb1; tr_frag2((unsigned)(unsigned long long)Vr, 288, wid, vb0, vb1);
        {
            const int t = tid >> 3, part = tid & 7; const u32x4 qv = *(const LAS u32x4*)(Qb + t * 72 + part * 8); float f[8]; unpack8(qv, f);
#pragma unroll
            for (int d = 0; d < 2; ++d) { LAS float* sc = MC_SC(d);
                const f32x4 n0 = *(const LAS f32x4*)(sc + 384 + part * 8), n1 = *(const LAS f32x4*)(sc + 384 + part * 8 + 4);
                float a = f[0] * n0.x; a = fmaf(f[1], n0.y, a); a = fmaf(f[2], n0.z, a); a = fmaf(f[3], n0.w, a); a = fmaf(f[4], n1.x, a); a = fmaf(f[5], n1.y, a); a = fmaf(f[6], n1.z, a); a = fmaf(f[7], n1.w, a);
                a += dppf<0xB1>(a); a += dppf<0x4E>(a); a += dppf<0x141>(a);
                if (part == 0) sc[320 + t] = a; } }
        if (tid < 128) {
            const int d = tid >> 6; LAS float* sc = MC_SC(d);
            const float bt = wave_scan_sum(sc[lane], d == 0);
            const float dmax = bt + wave_scan_max(sc[64 + lane] - bt, d == 0);
            const float m = fmaxf(bt + mst, dmax), w = __expf(bt + mst - m);
            sc[128 + lane] = bt; sc[192 + lane] = m; sc[256 + lane] = w * 0.125f; sc[448 + lane] = __expf(-m); }
        __syncthreads();
#pragma unroll 1
        for (int tt = 0; tt < 2; ++tt) { const int idx = wid * 2 + tt, mt = idx >> 2, nt = idx & 3;
            f32x4 scv = {0.f, 0.f, 0.f, 0.f};
            scv = mma_tile<64>(Qb + mt * 16 * 72, 72, Kb + nt * 16 * 72, 72, scv);
            const int s_ = nt * 16 + r;
#pragma unroll 1
            for (int d = 0; d < 2; ++d) { LAS float* sc = MC_SC(d); LAS unsigned short* Pb = MC_PB(d); const float bs = sc[128 + s_] - sc[64 + s_];
#pragma unroll
                for (int i = 0; i < 4; ++i) { const int t = mt * 16 + q * 4 + i; const bool ok = d ? (s_ >= t) : (s_ <= t);
                    const float pv = ok ? __expf(sc[128 + t] - bs - sc[192 + t]) * scv[i] * 0.125f : 0.f;
                    const unsigned short pb = f2bf(pv); Pb[t * 72 + s_] = pb;
                    const float rs = row16_sum(bf2f(pb));
                    if (r == 0) sc[512 + nt * 64 + t] = rs; } }
        }
        __syncthreads();
        f32x4 hacc[4];
#pragma unroll
        for (int mt = 0; mt < 4; ++mt) { hacc[mt] = (f32x4){0.f, 0.f, 0.f, 0.f};
            const bf16x8_t qa0 = *(const LAS bf16x8_t*)(Qb + (mt * 16 + r) * 72 + q * 8), qa1 = *(const LAS bf16x8_t*)(Qb + (mt * 16 + r) * 72 + 32 + q * 8);
#pragma unroll 1
            for (int d = 0; d < 2; ++d) { const LAS float* sc = MC_SC(d); const LAS unsigned short* Pb = MC_PB(d); const LAS unsigned short* Cb = MC_CB(d);
                f32x4 a1 = {0.f, 0.f, 0.f, 0.f}, a2 = {0.f, 0.f, 0.f, 0.f};
                const bf16x8_t cb0 = *(const LAS bf16x8_t*)(Cb + (wid * 16 + r) * 72 + q * 8), cb1 = *(const LAS bf16x8_t*)(Cb + (wid * 16 + r) * 72 + 32 + q * 8);
                a1 = __builtin_amdgcn_mfma_f32_16x16x32_bf16(qa0, cb0, a1, 0, 0, 0); a1 = __builtin_amdgcn_mfma_f32_16x16x32_bf16(qa1, cb1, a1, 0, 0, 0);
                const bf16x8_t pa0 = *(const LAS bf16x8_t*)(Pb + (mt * 16 + r) * 72 + q * 8), pa1 = *(const LAS bf16x8_t*)(Pb + (mt * 16 + r) * 72 + 32 + q * 8);
                a2 = __builtin_amdgcn_mfma_f32_16x16x32_bf16(pa0, vb0, a2, 0, 0, 0); a2 = __builtin_amdgcn_mfma_f32_16x16x32_bf16(pa1, vb1, a2, 0, 0, 0);
#pragma unroll
                for (int i = 0; i < 4; ++i) { const int t = mt * 16 + q * 4 + i;
                    const float den = sc[256 + t] * sc[320 + t] + ((sc[512 + t] + sc[576 + t]) + (sc[640 + t] + sc[704 + t]));
                    hacc[mt][i] += (sc[256 + t] * a1[i] + a2[i]) * __builtin_amdgcn_rcpf(fmaxf(fabsf(den), sc[448 + t])); }
            }
        }
#pragma unroll
        for (int mt = 0; mt < 4; ++mt)
#pragma unroll
            for (int i = 0; i < 4; ++i) { const float s = row16_sum(hacc[mt][i] * hacc[mt][i]); if (r == 0) ssp[wid * 64 + mt * 16 + q * 4 + i] = s; }
        __syncthreads();
        { const int v = wid * 16 + r; const float g = gn[v]; LAS unsigned short* Yt = MC_CB(0);
#pragma unroll
          for (int mt = 0; mt < 4; ++mt)
#pragma unroll
              for (int i = 0; i < 4; ++i) { const int t = mt * 16 + q * 4 + i;
                  float ss = 0.f;
#pragma unroll
                  for (int w = 0; w < 8; ++w) ss += ssp[w * 64 + t];
                  const float rstd = rsqrtf(ss * (1.0f / 128.0f) + 1e-6f);
                  Yt[t * 136 + v] = f2bf(hacc[mt][i] * rstd * g); } }
        __syncthreads();
#pragma unroll
        for (int i = 0; i < 2; ++i) { const int pi = tid + NTHR * i, t = pi >> 4, c8 = (pi & 15) * 8;
            const u32x4 yv = *(const LAS u32x4*)(MC_CB(0) + t * 136 + c8); const u32x4 ov = *(const u32x4*)(Z + (tok0 + t) * 2560 + 2048 + h * 128 + c8);
            float y[8], o[8]; unpack8(yv, y); unpack8(ov, o);
            u32x4 w; w.x = pk2(y[0] * sigm_f(o[0]), y[1] * sigm_f(o[1])); w.y = pk2(y[2] * sigm_f(o[2]), y[3] * sigm_f(o[3])); w.z = pk2(y[4] * sigm_f(o[4]), y[5] * sigm_f(o[5])); w.w = pk2(y[6] * sigm_f(o[6]), y[7] * sigm_f(o[7]));
            *(u32x4*)(Y + (tok0 + t) * 1024 + 512 + h * 128 + c8) = w; }
        __syncthreads();
    }
#undef MC_CB
#undef MC_PB
#undef MC_SC
}
__device__ __forceinline__ void headnorm_phase(const Params& p, const float* __restrict__ g, int zld, int zcol, int act) {
    const bf16_t* OF = (const bf16_t*)(p.ws + WS_OF); const bf16_t* OB = (const bf16_t*)(p.ws + WS_OB); const bf16_t* Z = (const bf16_t*)(p.ws + WS_Z); bf16_t* Y = (bf16_t*)(p.ws + WS_HN);
    const int tid = threadIdx.x, lane = tid & 63, wid = tid >> 6, c = lane * 8;
    const f32x4 g0 = *(const f32x4*)(g + (c & 127)), g1 = *(const f32x4*)(g + (c & 127) + 4);
    for (int tok = blockIdx.x * 8 + wid; tok < T_; tok += gridDim.x * 8) {
        const u32x4 a = *(const u32x4*)(OF + (size_t)tok * 512 + c), bq = *(const u32x4*)(OB + (size_t)tok * 512 + c), gz = *(const u32x4*)(Z + (size_t)tok * zld + zcol + c);
        float fa[8], fb[8], fg[8], o[8]; unpack8(a, fa); unpack8(bq, fb); unpack8(gz, fg);
        float ss = 0.f;
#pragma unroll
        for (int i = 0; i < 8; ++i) { o[i] = fa[i] + fb[i]; ss = fmaf(o[i], o[i], ss); }
        ss = row16_sum(ss);
        const float rstd = rsqrtf(ss * (1.0f / 128.0f) + 1e-6f);
        const float gg[8] = {g0.x, g0.y, g0.z, g0.w, g1.x, g1.y, g1.z, g1.w};
        float y[8];
#pragma unroll
        for (int i = 0; i < 8; ++i) y[i] = o[i] * rstd * gg[i] * (act == 0 ? fg[i] * sigm_f(fg[i]) : sigm_f(fg[i]));
        u32x4 w; w.x = pk2(y[0], y[1]); w.y = pk2(y[2], y[3]); w.z = pk2(y[4], y[5]); w.w = pk2(y[6], y[7]);
        *(u32x4*)(Y + (size_t)tok * 1024 + 512 + c) = w;
    }
}

__device__ __forceinline__ void odd_prep(const Params& p) {
    const bf16_t* Z = (const bf16_t*)(p.ws + WS_Z); bf16_t* VV = (bf16_t*)(p.ws + WS_QKV);
    const float* gates = (const float*)(p.ws + WS_GATES); float* LI = (float*)(p.ws + WS_BETA); float* LF = (float*)(p.ws + WS_LA);
    const float* ln_g = p.in[13]; const float* ln_b = p.in[14]; const float* ib = p.in[17]; const float* fb = p.in[18];
    const int tid = threadIdx.x, lane = tid & 63, wid = tid >> 6, c = lane * 8;
    const f32x4 g0 = *(const f32x4*)(ln_g + c), g1 = *(const f32x4*)(ln_g + c + 4), b0 = *(const f32x4*)(ln_b + c), b1 = *(const f32x4*)(ln_b + c + 4);
    const float gg[8] = {g0.x, g0.y, g0.z, g0.w, g1.x, g1.y, g1.z, g1.w}, bb[8] = {b0.x, b0.y, b0.z, b0.w, b1.x, b1.y, b1.z, b1.w};
    for (int tok = blockIdx.x * 8 + wid; tok < T_; tok += gridDim.x * 8) {
        const u32x4 v = *(const u32x4*)(Z + (size_t)tok * 2560 + 512 + c);
        float x[8]; unpack8(v, x); float sm = 0.f;
#pragma unroll
        for (int i = 0; i < 8; ++i) { x[i] = gelu_t(x[i]); sm += x[i]; }
        const float mean = wave_sum(sm) * (1.0f / 512.0f); float sq = 0.f;
#pragma unroll
        for (int i = 0; i < 8; ++i) { x[i] -= mean; sq = fmaf(x[i], x[i], sq); }
        const float rstd = rsqrtf(wave_sum(sq) * (1.0f / 512.0f) + 1e-5f);
        float y[8];
#pragma unroll
        for (int i = 0; i < 8; ++i) y[i] = x[i] * rstd * gg[i] + bb[i];
        u32x4 w; w.x = pk2(y[0], y[1]); w.y = pk2(y[2], y[3]); w.z = pk2(y[4], y[5]); w.w = pk2(y[6], y[7]);
        *(u32x4*)(VV + (size_t)tok * 512 + c) = w;
        if (lane < 8) { LI[(size_t)tok * 8 + lane] = gates[(size_t)tok * 16 + lane] + ib[lane];
                        LF[(size_t)tok * 8 + lane] = -softplus_(-(gates[(size_t)tok * 16 + 8 + lane] + fb[lane])); }
    }
}

__device__ __forceinline__ void sg_phase(LDSp lds, const Params& p, int sgId, int sgG) {
    typedef short bf16x8 __attribute__((ext_vector_type(8)));
    const bf16_t* Z = (const bf16_t*)(p.ws + WS_Z); const bf16_t* VV = (const bf16_t*)(p.ws + WS_QKV); bf16_t* Y = (bf16_t*)(p.ws + WS_HN);
    const float* sgw = p.in[15]; const float* sgb = p.in[16];
    LAS unsigned short* Wb = (LAS unsigned short*)lds;
    LAS unsigned short* Vt = (LAS unsigned short*)(lds + 34816);
    const int tid = threadIdx.x, lane = tid & 63, wid = tid >> 6;
    for (int unit = sgId; unit < 512; unit += sgG) {
        const int g = unit & 3, n = (unit >> 2) & 31, b = unit >> 7; const size_t tok0 = (size_t)b * S_ + n * 128;
#pragma unroll
        for (int i = 0; i < 8; ++i) { const int i4 = tid + NTHR * i, t = i4 >> 5, s4 = (i4 & 31) << 2; const f32x4 w = *(const f32x4*)(sgw + (size_t)g * 16384 + t * 128 + s4);
            u32x2 o; o.x = pk2(w.x, w.y); o.y = pk2(w.z, w.w); *(LAS u32x2*)(Wb + t * 136 + s4) = o; }
#pragma unroll
        for (int i = 0; i < 4; ++i) { const int pi = tid + NTHR * i, s = pi >> 4, c8 = (pi & 15) << 3; const u32x4 v = *(const u32x4*)(VV + (tok0 + s) * 512 + g * 128 + c8);
            Vt[(c8 + 0) * 136 + s] = (unsigned short)(v.x & 0xffffu); Vt[(c8 + 1) * 136 + s] = (unsigned short)(v.x >> 16);
            Vt[(c8 + 2) * 136 + s] = (unsigned short)(v.y & 0xffffu); Vt[(c8 + 3) * 136 + s] = (unsigned short)(v.y >> 16);
            Vt[(c8 + 4) * 136 + s] = (unsigned short)(v.z & 0xffffu); Vt[(c8 + 5) * 136 + s] = (unsigned short)(v.z >> 16);
            Vt[(c8 + 6) * 136 + s] = (unsigned short)(v.w & 0xffffu); Vt[(c8 + 7) * 136 + s] = (unsigned short)(v.w >> 16); }
        __syncthreads();
        bf16x8 af[4];
#pragma unroll
        for (int ks = 0; ks < 4; ++ks) af[ks] = *(const LAS bf16x8*)(Wb + (16 * wid + (lane & 15)) * 136 + ks * 32 + (lane >> 4) * 8);
        f32x4 accs[8];
#pragma unroll
        for (int nn = 0; nn < 8; ++nn) {
            f32x4 acc = {0.f, 0.f, 0.f, 0.f};
#pragma unroll
            for (int ks = 0; ks < 4; ++ks) { const bf16x8 bfrag = *(const LAS bf16x8*)(Vt + (16 * nn + (lane & 15)) * 136 + ks * 32 + (lane >> 4) * 8);
                acc = __builtin_amdgcn_mfma_f32_16x16x32_bf16(af[ks], bfrag, acc, 0, 0, 0); }
            accs[nn] = acc; }
        __syncthreads();
#pragma unroll
        for (int nn = 0; nn < 8; ++nn)
#pragma unroll
            for (int i = 0; i < 4; ++i) { const int t = 16 * wid + (lane >> 4) * 4 + i; Wb[t * 136 + 16 * nn + (lane & 15)] = f2bf(accs[nn][i] + sgb[g * 128 + t]); }
        __syncthreads();
#pragma unroll
        for (int i = 0; i < 4; ++i) { const int pi = tid + NTHR * i, t = pi >> 4, c8 = (pi & 15) << 3; const size_t tok = tok0 + t;
            const u32x4 mv = *(const LAS u32x4*)(Wb + t * 136 + c8); const u32x4 uv = *(const u32x4*)(Z + tok * 2560 + g * 128 + c8);
            float m[8], u[8]; unpack8(mv, m); unpack8(uv, u);
            u32x4 w; w.x = pk2(gelu_t(u[0]) * m[0], gelu_t(u[1]) * m[1]); w.y = pk2(gelu_t(u[2]) * m[2], gelu_t(u[3]) * m[3]); w.z = pk2(gelu_t(u[4]) * m[4], gelu_t(u[5]) * m[5]); w.w = pk2(gelu_t(u[6]) * m[6], gelu_t(u[7]) * m[7]);
            *(u32x4*)(Y + tok * 1024 + g * 128 + c8) = w; }
        __syncthreads();
    }
}

#define XB_TMO      128
#define XB_XCNT(j)  (256  + 64 * (j))
#define XB_XSUB(j)  (1280 + 64 * (j))
#define XB_XGEN(j)  (2304 + 64 * (j))
#define XB_TOP      3328
#define XB_TOPGEN   3392
#define XCD_BAR_WORDS 3456
#define XB_SPIN_CAP (1u << 18)

__device__ __forceinline__ unsigned xb_ld(unsigned* p)              { return __hip_atomic_load(p, __ATOMIC_RELAXED, __HIP_MEMORY_SCOPE_AGENT); }
__device__ __forceinline__ unsigned xb_add(unsigned* p, unsigned v) { return __hip_atomic_fetch_add(p, v, __ATOMIC_RELAXED, __HIP_MEMORY_SCOPE_AGENT); }
__device__ __forceinline__ unsigned xb_xcc_id() { return (unsigned)__builtin_amdgcn_s_getreg((3 << 11) | 20) & 0xFu; }
#define XB_SPIN(cond, bar) do { unsigned _sp = 0; while (cond) { __builtin_amdgcn_s_sleep(1); \
    if ((++_sp & 255u) == 0u) { if (xb_ld(&(bar)[XB_TMO])) break; if (_sp > XB_SPIN_CAP) { atomicAdd(&(bar)[XB_TMO], 1u); break; } } } } while (0)

struct XcdBarrier {
    unsigned* bar; unsigned x;
    volatile LAS unsigned* st;
};

__device__ __forceinline__ XcdBarrier xcd_barrier_post(unsigned* bar, volatile LAS unsigned* st) {
    XcdBarrier b; b.bar = bar; b.x = xb_xcc_id(); b.st = st;
    if (threadIdx.x == 0) (void)xb_add(&bar[XB_XCNT(b.x)], 1u);
    return b;
}
__device__ __forceinline__ void xcd_barrier_complete(unsigned* bar, unsigned x, unsigned& nloc, unsigned& nx) {
    const unsigned G = gridDim.x * gridDim.y * gridDim.z;
    unsigned sum, cnt, mine, sp = 0u;
    for (;;) {
        sum = 0u; cnt = 0u; mine = 0u;
#pragma unroll
        for (unsigned j = 0; j < 16; ++j) { const unsigned c = xb_ld(&bar[XB_XCNT(j)]); sum += c; cnt += (c > 0u) ? 1u : 0u; mine = (j == x) ? c : mine; }
        if (sum == G) break;
        __builtin_amdgcn_s_sleep(1);
        if ((++sp & 255u) == 0u) { if (xb_ld(&bar[XB_TMO])) break; if (sp > XB_SPIN_CAP) { atomicAdd(&bar[XB_TMO], 1u); break; } }
    }
    nloc = mine > 0u ? mine : 1u; nx = cnt > 0u ? cnt : 1u;
}

__device__ __forceinline__ void xcd_barrier(const XcdBarrier& b) {
    asm volatile("s_waitcnt vmcnt(0)" ::: "memory");
    __syncthreads();
    if (threadIdx.x == 0) {
        unsigned* bar = b.bar;
        __builtin_amdgcn_s_waitcnt(0);
        unsigned nloc = b.st[0], nx = b.st[1];
        if (nloc == 0u) { xcd_barrier_complete(bar, b.x, nloc, nx); b.st[0] = nloc; b.st[1] = nx; }
        const unsigned old = xb_add(&bar[XB_XSUB(b.x)], 1u);
        const unsigned gen = old / nloc;
        if (old + 1u == (gen + 1u) * nloc) {
            __builtin_amdgcn_fence(__ATOMIC_RELEASE, "agent");
            asm volatile("s_waitcnt vmcnt(0)" ::: "memory");
            const unsigned og = xb_add(&bar[XB_TOP], 1u);
            const unsigned tg = og / nx;
            if (og + 1u == (tg + 1u) * nx) xb_add(&bar[XB_TOPGEN], 1u);
            else XB_SPIN(xb_ld(&bar[XB_TOPGEN]) == tg, bar);
            __builtin_amdgcn_fence(__ATOMIC_ACQUIRE, "agent");
            xb_add(&bar[XB_XGEN(b.x)], 1u);
            asm volatile("s_waitcnt vmcnt(0)" ::: "memory");
        } else {
            XB_SPIN(xb_ld(&bar[XB_XGEN(b.x)]) == gen, bar);
            __builtin_amdgcn_fence(__ATOMIC_ACQUIRE, "agent");
            asm volatile("s_waitcnt vmcnt(0)" ::: "memory");
        }
    }
    __syncthreads();
}
constexpr size_t WS_BAR = 238 * MiB;
#ifndef N_PHASES
#define N_PHASES 21
#endif
template <int L, int SUB> __device__ __forceinline__ void run_phase(LDSp lds, const Params& p) {
    unsigned char* ws = p.ws;
    bf16_t* HN = (bf16_t*)(ws + WS_HN); bf16_t* Zb = (bf16_t*)(ws + WS_Z); float* h = p.out; float* gates = (float*)(ws + WS_GATES);
    const bf16_t* W_IN = (const bf16_t*)(ws + WS_WB + WB_IN); const bf16_t* W_OUT = (const bf16_t*)(ws + WS_WB + WB_OUT);
    const bf16_t* W_UP = (const bf16_t*)(ws + WS_WB + WB_UP); const bf16_t* W_DN = (const bf16_t*)(ws + WS_WB + WB_DN);
    const int G = gridDim.x;
    if constexpr (L == 2) { rms_phase(lds, h, p.in[25], nullptr, nullptr, h, nullptr, 0, 0, nullptr); }
    else if constexpr (SUB == 0) {
        convert_layer(lds, p, L);
        if constexpr (L == 0) rms_phase(lds, p.in[0], p.in[1], HN, nullptr, nullptr, p.in[2], 3088, 3072, gates);
        else                  rms_phase(lds, h, p.in[1] + 1024, HN, nullptr, nullptr, p.in[12], 2576, 2560, gates);
    } else if constexpr (SUB == 1) { constexpr int N = L == 0 ? 3072 : 2560;
        pg8::Gemm g{HN, W_IN, T_, N, 1024}; pg8::StaticOrder S; S.init(T_, N, G, (int)blockIdx.x);
        pg8::EpiBf16<0> E{Zb, N, nullptr, 0, 0};
        pg8::gemm_phase_sp2<pg8::EpiBf16<0>, pg8::StaticOrder, true, true>(lds, g, S, E);
    } else if constexpr (SUB == 2) { if constexpr (L == 0) even_prep(lds, p); else odd_prep(p); }
    else if constexpr (SUB == 9) { delta_prep(lds, p); }
    else if constexpr (SUB == 10) { mlstm_b(p); }
    else if constexpr (SUB == 11) { mlstm_c(lds, p); }
    else if constexpr (SUB == 3) {
        if constexpr (L == 0) delta_scan2(lds, p);
        else { mlstm_a(lds, p); sg_phase(lds, p, (int)blockIdx.x, G); }
    } else if constexpr (SUB == 4) { if constexpr (L == 0) headnorm_phase(p, p.in[10], 3072, 2560, 0); else headnorm_phase(p, p.in[19], 2560, 2048, 1); }
    else if constexpr (SUB == 5) { pg8::Gemm g{HN, W_OUT, T_, 1024, 1024}; pg8::StaticOrder S; S.init(T_, 1024, G, (int)blockIdx.x);
        pg8::EpiAddF32 E{h, 1024, L == 0 ? p.in[0] : (const float*)h};
        pg8::gemm_phase_sp2<pg8::EpiAddF32, pg8::StaticOrder, false, true>(lds, g, S, E);
    } else if constexpr (SUB == 6) { rms_phase(lds, h, p.in[21] + L * 1024, HN, nullptr, nullptr, nullptr, 0, 0, nullptr); }
    else if constexpr (SUB == 7) { pg8::Gemm g{HN, W_UP, T_, 2 * DFF, 1024}; pg8::StaticOrder S; S.init(T_, 2 * DFF, G, (int)blockIdx.x);
        pg8::EpiSwiGLU E{Zb, DFF};
        pg8::gemm_phase_sp2<pg8::EpiSwiGLU, pg8::StaticOrder, true, true>(lds, g, S, E);
    } else if constexpr (SUB == 8) { pg8::Gemm g{Zb, W_DN, T_, 1024, DFF}; pg8::StaticOrder S; S.init(T_, 1024, G, (int)blockIdx.x);
        pg8::EpiAddF32 E{h, 1024, (const float*)h};
        pg8::gemm_phase_sp2<pg8::EpiAddF32, pg8::StaticOrder, false, true>(lds, g, S, E);
    }
}
__global__ void __launch_bounds__(NTHR, 2) mega(Params p, int ph_lo, int ph_hi) {
    extern __shared__ __attribute__((aligned(16))) unsigned char lds_raw[];
    LDSp lds = (LDSp)lds_raw;
    cg::grid_group grid = cg::this_grid();
    volatile LAS unsigned* xst = (volatile LAS unsigned*)(lds + LDS_BYTES - 16);
    if (threadIdx.x == 0) { xst[0] = 0u; xst[1] = 0u; }
    __syncthreads();
    XcdBarrier xbar; xbar.bar = (unsigned*)(p.ws + WS_BAR); xbar.x = 0; xbar.st = xst;
    if (ph_hi - ph_lo > 1) xbar = xcd_barrier_post((unsigned*)(p.ws + WS_BAR), xst);
#ifndef REP_MASK
#define REP_MASK 0
#endif
#define PH(k, L, SUB) if (ph_lo <= (k) && (k) < ph_hi) { run_phase<L, SUB>(lds, p); if ((REP_MASK >> (k)) & 1) { __syncthreads(); run_phase<L, SUB>(lds, p); } if ((k) + 1 < ph_hi) { if (ph_lo < 0) grid.sync(); else xcd_barrier(xbar); } }
    PH(0, 0, 0) PH(1, 0, 1) PH(2, 0, 2) PH(3, 0, 9) PH(4, 0, 3) PH(5, 0, 4) PH(6, 0, 5) PH(7, 0, 6) PH(8, 0, 7) PH(9, 0, 8)
    PH(10, 1, 0) PH(11, 1, 1) PH(12, 1, 2) PH(13, 1, 3) PH(14, 1, 10) PH(15, 1, 11)
    PH(16, 1, 5) PH(17, 1, 6) PH(18, 1, 7) PH(19, 1, 8)
    PH(20, 2, 0)
#ifdef EXTRA_SYNCS
    for (int i_ = 0; i_ < EXTRA_SYNCS; ++i_) grid.sync();
#endif
#undef PH
}

extern "C" void kernel_launch(void* const* d_in, const int* in_sizes, int n_in, void* d_out, int out_size, void* d_ws, size_t ws_size, hipStream_t stream) {
    static int grid = 0;
    if (grid == 0) {
        int dev = 0, cus = 0, per_cu = 0;
        (void)hipGetDevice(&dev);
        (void)hipDeviceGetAttribute(&cus, hipDeviceAttributeMultiprocessorCount, dev);
        (void)hipFuncSetAttribute((const void*)mega, hipFuncAttributeMaxDynamicSharedMemorySize, LDS_BYTES);
        if (hipOccupancyMaxActiveBlocksPerMultiprocessor(&per_cu, (const void*)mega, NTHR, LDS_BYTES) != hipSuccess || per_cu < 1) per_cu = 1;
        (void)hipGetLastError();
        if (cus <= 0) cus = 256;
        grid = cus * per_cu;
    }
    if (ws_size < 239 * MiB) { fprintf(stderr, "workspace too small: %zu\n", ws_size); return; }
    Params p{};
    for (int i = 0; i < 26; ++i) p.in[i] = (const float*)d_in[i];
    p.out = (float*)d_out; p.ws = (unsigned char*)d_ws;
#if defined(MULTI_LAUNCH)
    for (int ph = 0; ph < N_PHASES; ++ph) hipLaunchKernelGGL(mega, dim3(grid), dim3(NTHR), LDS_BYTES, stream, p, ph, ph + 1);
#else
    (void)hipMemsetAsync((char*)d_ws + WS_BAR, 0, XCD_BAR_WORDS * 4, stream);
    int lo = 0, hi = N_PHASES;
    void* args[] = {(void*)&p, (void*)&lo, (void*)&hi};
    hipError_t e = hipLaunchCooperativeKernel((const void*)mega, dim3(grid), dim3(NTHR), args, LDS_BYTES, stream);
    if (e != hipSuccess) fprintf(stderr, "cooperative launch failed: %s (grid %d)\n", hipGetErrorString(e), grid);
#endif
}
```

```cpp
#include <hip/hip_runtime.h>
#include <hip/hip_cooperative_groups.h>
#include <cstdio>
namespace cg = cooperative_groups;
namespace pg8 {
#define PG8_LAS __attribute__((address_space(3)))
typedef unsigned short bf16_t;
typedef short bf16x8 __attribute__((ext_vector_type(8)));
typedef float f32x4 __attribute__((ext_vector_type(4)));
typedef unsigned u32x4 __attribute__((ext_vector_type(4)));
constexpr int BM = 256, BK = 64, HALF = 128, HTB = HALF * BK * 2  , STAGE_BYTES = 8 * HTB, NXCD = 8, WGM = 8;

__host__ __device__ __forceinline__ int lds_byte(int r, int c) { const int st = (r >> 4) * 2 + (c >> 5), rr = r & 15, cc = c & 31, ob = rr * 64 + cc * 2; return st * 1024 + (ob ^ (((ob >> 9) & 1) << 5)); }
__host__ __device__ __forceinline__ void stage_rc(int b, int& R, int& C) { const int st = b / 1024, sb = b % 1024, swz = sb ^ (((sb >> 9) & 1) << 5); R = (st >> 1) * 16 + swz / 64; C = (st & 1) * 32 + (swz % 64) / 2; }
__host__ __device__ __forceinline__ int perm32(int rho) { const int n = rho >> 4, i = rho & 15; return 8 * (i >> 2) + 4 * n + (i & 3); }

struct Unit { int pm, pn; };
struct Gemm { const bf16_t* A; const bf16_t* Bt; int M, N, K; };

struct StaticOrder {
    int nM, nN, nwg, G, c;
    __host__ __device__ void init(int M, int N, int G_, int c_) { nM = M / BM; nN = N / BM; nwg = nM * nN; G = G_; c = c_; }
    __host__ __device__ bool next(int i, Unit& u) const {
        const long L = (long)i * G + c; if (L >= nwg) return false;
        int wgid = (int)L; { const int q = nwg / NXCD, r = nwg % NXCD, xcd = wgid % NXCD, off = wgid / NXCD; wgid = (xcd < r ? xcd * (q + 1) : r * (q + 1) + (xcd - r) * q) + off; }
        const int nig = WGM * nN, gid = wgid / nig, fm = gid * WGM, gsz = (nM - fm) < WGM ? (nM - fm) : WGM;
        u.pm = fm + ((wgid % nig) % gsz); u.pn = (wgid % nig) / gsz; return true;
    }
    __device__ __forceinline__ void a_ready(const Unit&) const {}
    __device__ __forceinline__ void done(const Unit&) const {}
};
__device__ __forceinline__ unsigned cvt_pk_bf16(float lo, float hi) { unsigned r; asm volatile("v_cvt_pk_bf16_f32 %0, %1, %2" : "=v"(r) : "v"(lo), "v"(hi)); return r; }
typedef float f32x2 __attribute__((ext_vector_type(2)));
__device__ __forceinline__ f32x2 gelu_pk(f32x2 v) {
    const f32x2 av = __builtin_elementwise_abs(v), d = av * 0.2316418882f + 1.0f;
    f32x2 t; t.x = __builtin_amdgcn_rcpf(d.x); t.y = __builtin_amdgcn_rcpf(d.y);
    f32x2 q = t * 0.5307027145f + (-0.7265760135f); q = q * t + 0.7107068705f; q = q * t + (-0.142248368f); q = q * t + 0.127414796f; q = q * t;
    const f32x2 s = (v * v) * (-0.72134752044f);
    f32x2 e; e.x = __builtin_amdgcn_exp2f(s.x); e.y = __builtin_amdgcn_exp2f(s.y);
    const f32x2 m = v * (q * e), r = v - m;
    f32x2 o; o.x = v.x < 0.f ? m.x : r.x; o.y = v.y < 0.f ? m.y : r.y; return o;
}
template <int ACT  > struct EpiBf16 {
    static constexpr bool PERM = true, AFTER_DRAIN = false;
    bf16_t* O; int ldc; const float* bias; int split_cols; size_t split_stride;
    __device__ __forceinline__ void operator()(const f32x4 (&acc)[2][2][4][2], const Unit& u, int wr, int wc, int fr, int fq) const {
        const int row0 = u.pm * BM + wr * 64 + fr; int colt = u.pn * BM; bf16_t* base = O;
        if (split_cols) { const int t = colt / split_cols; base += (size_t)t * split_stride; colt -= t * split_cols; }
        const int col0 = colt + wc * 32 + 8 * fq, bcol0 = u.pn * BM + wc * 32 + 8 * fq;
        f32x4 bv[2][2];
#pragma unroll
        for (int bj = 0; bj < 2; ++bj)
#pragma unroll
            for (int n = 0; n < 2; ++n) bv[bj][n] = bias ? *(const f32x4*)(bias + bcol0 + bj * HALF + 4 * n) : (f32x4){0.f, 0.f, 0.f, 0.f};
#pragma unroll
        for (int ai = 0; ai < 2; ++ai)
#pragma unroll
            for (int m = 0; m < 4; ++m) { bf16_t* rowp = base + (size_t)(row0 + ai * HALF + m * 16) * ldc + col0;
#pragma unroll
                for (int bj = 0; bj < 2; ++bj) { f32x4 v0 = acc[ai][bj][m][0] + bv[bj][0], v1 = acc[ai][bj][m][1] + bv[bj][1];
                    if (ACT == 1) { f32x2 a = gelu_pk((f32x2){v0[0], v0[1]}), b = gelu_pk((f32x2){v0[2], v0[3]}), c = gelu_pk((f32x2){v1[0], v1[1]}), d = gelu_pk((f32x2){v1[2], v1[3]});
                        v0 = (f32x4){a.x, a.y, b.x, b.y}; v1 = (f32x4){c.x, c.y, d.x, d.y}; }
                    if (ACT == 2) {
#pragma unroll
                        for (int j = 0; j < 4; ++j) { v0[j] = 0.5f * v0[j] * (1.0f + erff(v0[j] * 0.70710678f)); v1[j] = 0.5f * v1[j] * (1.0f + erff(v1[j] * 0.70710678f)); } }
                    u32x4 w; w.x = cvt_pk_bf16(v0[0], v0[1]); w.y = cvt_pk_bf16(v0[2], v0[3]); w.z = cvt_pk_bf16(v1[0], v1[1]); w.w = cvt_pk_bf16(v1[2], v1[3]);
                    *(u32x4*)(rowp + bj * HALF) = w; } }
    }
};
struct EpiAddF32 {
    static constexpr bool PERM = false, AFTER_DRAIN = false;
    float* C; int ldc; const float* R;
    __device__ __forceinline__ void operator()(const f32x4 (&acc)[2][2][4][2], const Unit& u, int wr, int wc, int fr, int fq) const {
        const int row0 = u.pm * BM + wr * 64 + fr, col0 = u.pn * BM + wc * 32 + 4 * fq;
#pragma unroll
        for (int ai = 0; ai < 2; ++ai)
#pragma unroll
            for (int m = 0; m < 4; ++m) { const size_t ro = (size_t)(row0 + ai * HALF + m * 16) * ldc + col0; float* rowp = C + ro; const float* srcp = R + ro;
#pragma unroll
                for (int bj = 0; bj < 2; ++bj)
#pragma unroll
                    for (int n = 0; n < 2; ++n) { const f32x4 o = *(const f32x4*)(srcp + bj * HALF + n * 16); *(f32x4*)(rowp + bj * HALF + n * 16) = o + acc[ai][bj][m][n]; } }
    }
};
struct EpiSwiGLU {
    static constexpr bool PERM = true, AFTER_DRAIN = false;
    bf16_t* H; int ldh;
    __device__ __forceinline__ void operator()(const f32x4 (&acc)[2][2][4][2], const Unit& u, int wr, int wc, int fr, int fq) const {
        const int row0 = u.pm * BM + wr * 64 + fr, hcol = u.pn * HALF + wc * 32 + 8 * fq;
#pragma unroll
        for (int ai = 0; ai < 2; ++ai)
#pragma unroll
            for (int m = 0; m < 4; ++m) { bf16_t* rowp = H + (size_t)(row0 + ai * HALF + m * 16) * ldh + hcol;
                float h[8];
#pragma unroll
                for (int n = 0; n < 2; ++n) { const f32x4 a = acc[ai][0][m][n], b = acc[ai][1][m][n];
#pragma unroll
                    for (int j = 0; j < 4; ++j) h[4 * n + j] = a[j] * __builtin_amdgcn_rcpf(1.0f + __expf(-a[j])) * b[j]; }
                u32x4 w; w.x = cvt_pk_bf16(h[0], h[1]); w.y = cvt_pk_bf16(h[2], h[3]); w.z = cvt_pk_bf16(h[4], h[5]); w.w = cvt_pk_bf16(h[6], h[7]);
                *(u32x4*)rowp = w; }
    }
};
template <class Epi, class Sched, bool STAMP = false>
__device__ __forceinline__ void gemm_phase(PG8_LAS unsigned char* lds, const Gemm g, const Sched& S, const Epi& E, unsigned long long* stamps) {
    const int tid = threadIdx.x, wid = __builtin_amdgcn_readfirstlane(tid >> 6), lane = tid & 63, wr = wid >> 2, wc = wid & 3, fr = lane & 15, fq = lane >> 4;
    const int K = g.K, nt = K / BK;
    int ts_lo = 0, ts_hi = 0, nts = 0; const unsigned long long rt_entry = STAMP ? (unsigned long long)wall_clock64() : 0ull;
#define PG8_STAMP() do { if (STAMP && wid == 0 && nts < 64) { const unsigned long long _c = (unsigned long long)clock64(); \
        ts_lo = (lane == nts) ? (int)(unsigned)_c : ts_lo; ts_hi = (lane == nts) ? (int)(unsigned)(_c >> 32) : ts_hi; ++nts; } } while (0)
    PG8_STAMP();
    unsigned voffA[2], voffB[2];
#pragma unroll
    for (int i = 0; i < 2; ++i) { int R, C; stage_rc(tid * 16 + i * 8192, R, C); const int Rb = Epi::PERM ? ((R & ~31) + perm32(R & 31)) : R;
        voffA[i] = (unsigned)(R * K + C) * 2u; voffB[i] = (unsigned)(Rb * K + C) * 2u; }
    const size_t kstep = (size_t)(BK * 2);
    const size_t hstep = (size_t)HALF * K * 2;
    const size_t tstep = 2 * hstep;
    const unsigned ldsw = (unsigned)wid * 1024u;
    const int aoff = lds_byte(wr * 64 + fr, fq * 8), boff = lds_byte(wc * 32 + fr, fq * 8);
#define PG8_SA(b, h) (((b) * 2 + (h)) * HTB)
#define PG8_SB(b, h) ((4 + (b) * 2 + (h)) * HTB)
#define PG8_STAGE(bufoff, gbase, voff) do { _Pragma("unroll") for (int _i = 0; _i < 2; ++_i) \
        __builtin_amdgcn_global_load_lds((const unsigned*)((const char*)(gbase) + (voff)[_i]), (PG8_LAS unsigned*)(lds + (bufoff) + ldsw + _i * 8192), 16, 0, 0); } while (0)
#define PG8_LDA(dst, b, h) do { _Pragma("unroll") for (int m = 0; m < 4; ++m) _Pragma("unroll") for (int k = 0; k < 2; ++k) dst[m][k] = *(const PG8_LAS bf16x8*)(lds + PG8_SA(b, h) + aoff + m * 2048 + k * 1024); } while (0)
#define PG8_LDB(dst, b, h) do { _Pragma("unroll") for (int n = 0; n < 2; ++n) _Pragma("unroll") for (int k = 0; k < 2; ++k) dst[n][k] = *(const PG8_LAS bf16x8*)(lds + PG8_SB(b, h) + boff + n * 2048 + k * 1024); } while (0)
#define PG8_MMA(ai, bj, At, Bt) do { __builtin_amdgcn_s_setprio(1); _Pragma("unroll") for (int m = 0; m < 4; ++m) _Pragma("unroll") for (int n = 0; n < 2; ++n) _Pragma("unroll") for (int k = 0; k < 2; ++k) \
        acc[ai][bj][m][n] = __builtin_amdgcn_mfma_f32_16x16x32_bf16(Bt[n][k], At[m][k], acc[ai][bj][m][n], 0, 0, 0); __builtin_amdgcn_s_setprio(0); } while (0)
#define PG8_WAIT_V(n) asm volatile("s_waitcnt vmcnt(" #n ")" ::: "memory")
#define PG8_WAIT_L(n) asm volatile("s_waitcnt lgkmcnt(" #n ")" ::: "memory")
#define PG8_BAR __builtin_amdgcn_s_barrier()
#define PG8_SCHED __builtin_amdgcn_sched_barrier(0)
    Unit cur, nxt; int ui = 0;
    if (!S.next(0, cur)) return;
    f32x4 acc[2][2][4][2];
#pragma unroll
    for (int a = 0; a < 2; ++a)
#pragma unroll
        for (int b = 0; b < 2; ++b)
#pragma unroll
            for (int m = 0; m < 4; ++m)
#pragma unroll
                for (int n = 0; n < 2; ++n) acc[a][b][m][n] = (f32x4){0.f, 0.f, 0.f, 0.f};
    bf16x8 At[4][2], B0[2][2], B1[2][2];
    const char* cA = (const char*)g.A + (size_t)cur.pm * tstep; const char* cB = (const char*)g.Bt + (size_t)cur.pn * tstep;
    S.a_ready(cur);
    PG8_STAGE(PG8_SB(0, 0), cB, voffB); PG8_STAGE(PG8_SA(0, 0), cA, voffA); PG8_STAGE(PG8_SB(0, 1), cB + hstep, voffB); PG8_STAGE(PG8_SA(0, 1), cA + hstep, voffA);
    if (wr == 1) PG8_BAR;
    PG8_WAIT_V(4); PG8_BAR;
    PG8_STAGE(PG8_SB(1, 0), cB + kstep, voffB); PG8_STAGE(PG8_SA(1, 0), cA + kstep, voffA); PG8_STAGE(PG8_SB(1, 1), cB + hstep + kstep, voffB);
    PG8_WAIT_V(6); PG8_BAR;
    PG8_STAMP();
    for (;;) {
        const bool has_next = S.next(ui + 1, nxt);
        const char* nA = has_next ? (const char*)g.A + (size_t)nxt.pm * tstep : cA; const char* nB = has_next ? (const char*)g.Bt + (size_t)nxt.pn * tstep : cB;
        for (int t = 0; t < nt; t += 2) {
            const bool last = (t == nt - 2);
            const char* a1 = cA + (size_t)(t + 1) * kstep;
            const char* a2 = last ? nA : cA + (size_t)(t + 2) * kstep; const char* b2 = last ? nB : cB + (size_t)(t + 2) * kstep;
            const char* a3 = a2 + kstep; const char* b3 = b2 + kstep;
            if (last && has_next) S.a_ready(nxt);
            PG8_LDB(B0, 0, 0); PG8_SCHED; PG8_LDA(At, 0, 0); PG8_STAGE(PG8_SA(1, 1), a1 + hstep, voffA);
            PG8_WAIT_L(8); PG8_BAR; PG8_WAIT_L(0); PG8_MMA(0, 0, At, B0); PG8_BAR; PG8_SCHED;
            PG8_LDB(B1, 0, 1); PG8_STAGE(PG8_SB(0, 0), b2, voffB);
            PG8_BAR; PG8_WAIT_L(0); PG8_MMA(0, 1, At, B1); PG8_BAR;
            PG8_LDA(At, 0, 1); PG8_STAGE(PG8_SA(0, 0), a2, voffA);
            PG8_BAR; PG8_WAIT_L(0); PG8_MMA(1, 0, At, B0); PG8_BAR; PG8_SCHED;
            PG8_STAGE(PG8_SB(0, 1), b2 + hstep, voffB);
            PG8_WAIT_V(6); PG8_BAR; PG8_MMA(1, 1, At, B1); PG8_BAR;
            PG8_LDB(B0, 1, 0); PG8_SCHED; PG8_LDA(At, 1, 0); PG8_STAGE(PG8_SA(0, 1), a2 + hstep, voffA);
            PG8_WAIT_L(8); PG8_BAR; PG8_WAIT_L(0); PG8_MMA(0, 0, At, B0); PG8_BAR; PG8_SCHED;
            PG8_LDB(B1, 1, 1); PG8_STAGE(PG8_SB(1, 0), b3, voffB);
            PG8_BAR; PG8_WAIT_L(0); PG8_MMA(0, 1, At, B1); PG8_BAR;
            PG8_LDA(At, 1, 1); PG8_STAGE(PG8_SA(1, 0), a3, voffA);
            PG8_BAR; PG8_WAIT_L(0); PG8_MMA(1, 0, At, B0); PG8_BAR; PG8_SCHED;
            PG8_STAGE(PG8_SB(1, 1), b3 + hstep, voffB);
            PG8_WAIT_V(6); PG8_BAR; PG8_MMA(1, 1, At, B1); PG8_BAR;
        }
        PG8_STAMP();
        if constexpr (!Epi::AFTER_DRAIN) { E(acc, cur, wr, wc, fr, fq); S.done(cur); }
        PG8_STAMP();
        if (!has_next) break;
#pragma unroll
        for (int a = 0; a < 2; ++a)
#pragma unroll
            for (int b = 0; b < 2; ++b)
#pragma unroll
                for (int m = 0; m < 4; ++m)
#pragma unroll
                    for (int n = 0; n < 2; ++n) acc[a][b][m][n] = (f32x4){0.f, 0.f, 0.f, 0.f};
        cur = nxt; cA = nA; cB = nB; ++ui;
    }
    PG8_WAIT_V(0);
    if (wr == 0) PG8_BAR;
    PG8_BAR;
    if constexpr (Epi::AFTER_DRAIN) { E.fused(acc, cur, wr, wc, fr, fq, lds, wid, lane); S.done(cur); }
    PG8_STAMP();
    if (STAMP && wid == 0) { stamps[lane] = lane < nts ? (((unsigned long long)(unsigned)ts_hi << 32) | (unsigned)ts_lo) : 0ull;
        if (lane == 62) stamps[62] = rt_entry; if (lane == 63) stamps[63] = (unsigned long long)wall_clock64(); }
#undef PG8_STAMP
#undef PG8_SA
#undef PG8_SB
#undef PG8_STAGE
#undef PG8_LDA
#undef PG8_LDB
#undef PG8_MMA
#undef PG8_WAIT_V
#undef PG8_WAIT_L
#undef PG8_BAR
#undef PG8_SCHED
}
template <class Epi, class Sched, bool ALIGN_EPI = false, bool SP2 = false>
__device__ __forceinline__ void gemm_phase_sp2(PG8_LAS unsigned char* lds, const Gemm g, const Sched& S, const Epi& E) {
    const int tid = threadIdx.x, wid = __builtin_amdgcn_readfirstlane(tid >> 6), lane = tid & 63, wr = wid >> 2, wc = wid & 3, fr = lane & 15, fq = lane >> 4;
    const int K = g.K, nt = K / BK;
    unsigned voffA[2], voffB[2];
#pragma unroll
    for (int i = 0; i < 2; ++i) { int R, C; stage_rc(tid * 16 + i * 8192, R, C); const int Rb = Epi::PERM ? ((R & ~31) + perm32(R & 31)) : R;
        voffA[i] = (unsigned)(R * K + C) * 2u; voffB[i] = (unsigned)(Rb * K + C) * 2u; }
    const size_t kstep = (size_t)(BK * 2);
    const size_t hstep = (size_t)HALF * K * 2;
    const size_t tstep = 2 * hstep;
    const unsigned ldsw = (unsigned)wid * 1024u;
    const int aoff = lds_byte(wr * 64 + fr, fq * 8), boff = lds_byte(wc * 32 + fr, fq * 8);
#define PG8_SA(b, h) (((b) * 2 + (h)) * HTB)
#define PG8_SB(b, h) ((4 + (b) * 2 + (h)) * HTB)
#define PG8_STAGE(bufoff, gbase, voff) do { _Pragma("unroll") for (int _i = 0; _i < 2; ++_i) \
        __builtin_amdgcn_global_load_lds((const unsigned*)((const char*)(gbase) + (voff)[_i]), (PG8_LAS unsigned*)(lds + (bufoff) + ldsw + _i * 8192), 16, 0, 0); } while (0)
#define PG8_LDA(dst, b, h) do { _Pragma("unroll") for (int m = 0; m < 4; ++m) _Pragma("unroll") for (int k = 0; k < 2; ++k) dst[m][k] = *(const PG8_LAS bf16x8*)(lds + PG8_SA(b, h) + aoff + m * 2048 + k * 1024); } while (0)
#define PG8_LDB(dst, b, h) do { _Pragma("unroll") for (int n = 0; n < 2; ++n) _Pragma("unroll") for (int k = 0; k < 2; ++k) dst[n][k] = *(const PG8_LAS bf16x8*)(lds + PG8_SB(b, h) + boff + n * 2048 + k * 1024); } while (0)
#define PG8_MMA(ai, bj, At, Bt) do { __builtin_amdgcn_s_setprio(1); _Pragma("unroll") for (int m = 0; m < 4; ++m) _Pragma("unroll") for (int n = 0; n < 2; ++n) _Pragma("unroll") for (int k = 0; k < 2; ++k) \
        acc[ai][bj][m][n] = __builtin_amdgcn_mfma_f32_16x16x32_bf16(Bt[n][k], At[m][k], acc[ai][bj][m][n], 0, 0, 0); __builtin_amdgcn_s_setprio(0); } while (0)
#define PG8_WAIT_V(n) asm volatile("s_waitcnt vmcnt(" #n ")" ::: "memory")
#define PG8_WAIT_L(n) asm volatile("s_waitcnt lgkmcnt(" #n ")" ::: "memory")
#define PG8_BAR __builtin_amdgcn_s_barrier()
#define PG8_SCHED __builtin_amdgcn_sched_barrier(0)
    Unit cur, nxt; int ui = 0;
    if (!S.next(0, cur)) return;
    f32x4 acc[2][2][4][2];
#pragma unroll
    for (int a = 0; a < 2; ++a)
#pragma unroll
        for (int b = 0; b < 2; ++b)
#pragma unroll
            for (int m = 0; m < 4; ++m)
#pragma unroll
                for (int n = 0; n < 2; ++n) acc[a][b][m][n] = (f32x4){0.f, 0.f, 0.f, 0.f};
    bf16x8 At[4][2], B0[2][2], B1[2][2];
    const char* cA = (const char*)g.A + (size_t)cur.pm * tstep; const char* cB = (const char*)g.Bt + (size_t)cur.pn * tstep;
    S.a_ready(cur);
    if constexpr (SP2) {
        PG8_STAGE(PG8_SB(0, 0), cB, voffB); PG8_STAGE(PG8_SB(0, 1), cB + hstep, voffB); PG8_STAGE(PG8_SA(0, 0), cA, voffA); PG8_STAGE(PG8_SA(0, 1), cA + hstep, voffA);
        if (wr == 1) PG8_BAR;
        PG8_WAIT_V(2); PG8_BAR;
        PG8_STAGE(PG8_SB(1, 0), cB + kstep, voffB); PG8_STAGE(PG8_SA(1, 0), cA + kstep, voffA); PG8_STAGE(PG8_SB(1, 1), cB + hstep + kstep, voffB);
        PG8_WAIT_V(6); PG8_BAR;
    } else {
        PG8_STAGE(PG8_SB(0, 0), cB, voffB); PG8_STAGE(PG8_SA(0, 0), cA, voffA); PG8_STAGE(PG8_SB(0, 1), cB + hstep, voffB); PG8_STAGE(PG8_SA(0, 1), cA + hstep, voffA);
        if (wr == 1) PG8_BAR;
        PG8_WAIT_V(4); PG8_BAR;
        PG8_STAGE(PG8_SB(1, 0), cB + kstep, voffB); PG8_STAGE(PG8_SA(1, 0), cA + kstep, voffA); PG8_STAGE(PG8_SB(1, 1), cB + hstep + kstep, voffB);
        PG8_WAIT_V(6); PG8_BAR;
    }
    for (;;) {
        const bool has_next = S.next(ui + 1, nxt);
        const char* nA = has_next ? (const char*)g.A + (size_t)nxt.pm * tstep : cA; const char* nB = has_next ? (const char*)g.Bt + (size_t)nxt.pn * tstep : cB;
        for (int t = 0; t < nt; t += 2) {
            const bool last = (t == nt - 2);
            const char* a1 = cA + (size_t)(t + 1) * kstep;
            const char* a2 = last ? nA : cA + (size_t)(t + 2) * kstep; const char* b2 = last ? nB : cB + (size_t)(t + 2) * kstep;
            const char* a3 = a2 + kstep; const char* b3 = b2 + kstep;
            if (last && has_next) S.a_ready(nxt);
            if constexpr (SP2) {
            PG8_LDB(B0, 0, 0); PG8_LDB(B1, 0, 1); PG8_SCHED; PG8_LDA(At, 0, 0); PG8_STAGE(PG8_SA(1, 1), a1 + hstep, voffA);
            PG8_WAIT_V(8); PG8_WAIT_L(0); PG8_BAR; PG8_MMA(0, 0, At, B0); PG8_MMA(0, 1, At, B1); PG8_BAR; PG8_SCHED;
            PG8_LDA(At, 0, 1); PG8_STAGE(PG8_SB(0, 0), b2, voffB); PG8_STAGE(PG8_SB(0, 1), b2 + hstep, voffB); PG8_STAGE(PG8_SA(0, 0), a2, voffA);
            PG8_WAIT_V(8); PG8_WAIT_L(0); PG8_BAR; PG8_MMA(1, 0, At, B0); PG8_MMA(1, 1, At, B1); PG8_BAR; PG8_SCHED;
            PG8_LDB(B0, 1, 0); PG8_LDB(B1, 1, 1); PG8_SCHED; PG8_LDA(At, 1, 0); PG8_STAGE(PG8_SA(0, 1), a2 + hstep, voffA);
            PG8_WAIT_V(8); PG8_WAIT_L(0); PG8_BAR; PG8_MMA(0, 0, At, B0); PG8_MMA(0, 1, At, B1); PG8_BAR; PG8_SCHED;
            PG8_LDA(At, 1, 1); PG8_STAGE(PG8_SB(1, 0), b3, voffB); PG8_STAGE(PG8_SB(1, 1), b3 + hstep, voffB); PG8_STAGE(PG8_SA(1, 0), a3, voffA);
            PG8_WAIT_V(8); PG8_WAIT_L(0); PG8_BAR; PG8_MMA(1, 0, At, B0); PG8_MMA(1, 1, At, B1); PG8_BAR; PG8_SCHED;
            } else {
            PG8_LDB(B0, 0, 0); PG8_SCHED; PG8_LDA(At, 0, 0); PG8_STAGE(PG8_SA(1, 1), a1 + hstep, voffA);
            PG8_WAIT_L(8); PG8_BAR; PG8_WAIT_L(0); PG8_MMA(0, 0, At, B0); PG8_BAR; PG8_SCHED;
            PG8_LDB(B1, 0, 1); PG8_STAGE(PG8_SB(0, 0), b2, voffB);
            PG8_BAR; PG8_WAIT_L(0); PG8_MMA(0, 1, At, B1); PG8_BAR;
            PG8_LDA(At, 0, 1); PG8_STAGE(PG8_SA(0, 0), a2, voffA);
            PG8_BAR; PG8_WAIT_L(0); PG8_MMA(1, 0, At, B0); PG8_BAR; PG8_SCHED;
            PG8_STAGE(PG8_SB(0, 1), b2 + hstep, voffB);
            PG8_WAIT_V(6); PG8_BAR; PG8_MMA(1, 1, At, B1); PG8_BAR;
            PG8_LDB(B0, 1, 0); PG8_SCHED; PG8_LDA(At, 1, 0); PG8_STAGE(PG8_SA(0, 1), a2 + hstep, voffA);
            PG8_WAIT_L(8); PG8_BAR; PG8_WAIT_L(0); PG8_MMA(0, 0, At, B0); PG8_BAR; PG8_SCHED;
            PG8_LDB(B1, 1, 1); PG8_STAGE(PG8_SB(1, 0), b3, voffB);
            PG8_BAR; PG8_WAIT_L(0); PG8_MMA(0, 1, At, B1); PG8_BAR;
            PG8_LDA(At, 1, 1); PG8_STAGE(PG8_SA(1, 0), a3, voffA);
            PG8_BAR; PG8_WAIT_L(0); PG8_MMA(1, 0, At, B0); PG8_BAR; PG8_SCHED;
            PG8_STAGE(PG8_SB(1, 1), b3 + hstep, voffB);
            PG8_WAIT_V(6); PG8_BAR; PG8_MMA(1, 1, At, B1); PG8_BAR;
            }
        }
        if constexpr (ALIGN_EPI) { if (wr == 0) PG8_BAR; }
        if constexpr (!Epi::AFTER_DRAIN) { E(acc, cur, wr, wc, fr, fq); S.done(cur); }
        if (!has_next) break;
#pragma unroll
        for (int a = 0; a < 2; ++a)
#pragma unroll
            for (int b = 0; b < 2; ++b)
#pragma unroll
                for (int m = 0; m < 4; ++m)
#pragma unroll
                    for (int n = 0; n < 2; ++n) acc[a][b][m][n] = (f32x4){0.f, 0.f, 0.f, 0.f};
        cur = nxt; cA = nA; cB = nB; ++ui;
        if constexpr (ALIGN_EPI) { if (wr == 1) PG8_BAR; }
    }
    PG8_WAIT_V(0);
    if constexpr (!ALIGN_EPI) { if (wr == 0) PG8_BAR; }
    PG8_BAR;
    if constexpr (Epi::AFTER_DRAIN) { E.fused(acc, cur, wr, wc, fr, fq, lds, wid, lane); S.done(cur); }
#undef PG8_SA
#undef PG8_SB
#undef PG8_STAGE
#undef PG8_LDA
#undef PG8_LDB
#undef PG8_MMA
#undef PG8_WAIT_V
#undef PG8_WAIT_L
#undef PG8_BAR
#undef PG8_SCHED
}
}
#define LAS __attribute__((address_space(3)))
typedef LAS unsigned char* LDSp;
typedef pg8::bf16_t bf16_t;
typedef unsigned u32x4 __attribute__((ext_vector_type(4)));
typedef unsigned u32x2 __attribute__((ext_vector_type(2)));
typedef float f32x4 __attribute__((ext_vector_type(4)));
typedef float f32x2 __attribute__((ext_vector_type(2)));

#ifndef EXPC
#define EXPC 0
#endif
#ifndef EVP_SKIP
#define EVP_SKIP 0
#endif
constexpr int T_ = 16384, D_ = 1024, S_ = 4096, NTHR = 512;
constexpr int LDS_BYTES = 147456;
constexpr size_t MiB = 1048576;
constexpr size_t WS_WB = 0, WS_HN = 25 * MiB, WS_Z = 57 * MiB, WS_QKV = 153 * MiB, WS_OF = 201 * MiB, WS_OB = 217 * MiB,
                 WS_GATES = 233 * MiB, WS_BETA = 234 * MiB, WS_LA = 234 * MiB + 524288;
constexpr size_t WB_IN = 0, WB_OUT = 6291456, WB_UP = 8388608, WB_DN = 19922944;
constexpr int DFF = 2816;

struct Params { const float* in[26]; float* out; unsigned char* ws; };

__device__ __forceinline__ float bf2f(unsigned short b) { return __uint_as_float(((unsigned)b) << 16); }
__device__ __forceinline__ float bflo(unsigned u) { return __uint_as_float(u << 16); }
__device__ __forceinline__ float bfhi(unsigned u) { return __uint_as_float(u & 0xffff0000u); }
__device__ __forceinline__ unsigned short f2bf(float f) { return __builtin_bit_cast(unsigned short, (__bf16)f); }
typedef __bf16 bf16x2_v __attribute__((ext_vector_type(2)));
__device__ __forceinline__ unsigned pk2(float lo, float hi) { const f32x2 v = {lo, hi}; const bf16x2_v b = __builtin_convertvector(v, bf16x2_v); return __builtin_bit_cast(unsigned, b); }
__device__ __forceinline__ float sigm(float x) { return __builtin_amdgcn_rcpf(1.0f + __expf(-x)); }
__device__ __forceinline__ float sigm_f(float x) { return __builtin_amdgcn_rcpf(1.0f + __expf(-x)); }
__device__ __forceinline__ float silu_(float x) { return x * sigm(x); }
__device__ __forceinline__ float gelu_t(float x) { const float u = 0.7978845608028654f * (x + 0.044715f * x * x * x); const float t = 1.0f - 2.0f / (1.0f + __expf(2.0f * u)); return 0.5f * x * (1.0f + t); }
__device__ __forceinline__ float softplus_(float x) { return x > 20.0f ? x : log1pf(expf(x)); }
__device__ __forceinline__ float wave_sum(float v) {
#pragma unroll
    for (int o = 32; o; o >>= 1) v += __shfl_xor(v, o);
    return v; }
template <int CTRL> __device__ __forceinline__ float dppf(float v) { return __int_as_float(__builtin_amdgcn_update_dpp(0, __float_as_int(v), CTRL, 0xf, 0xf, true)); }
__device__ __forceinline__ float row16_sum(float v) { v += dppf<0xB1>(v); v += dppf<0x4E>(v); v += dppf<0x141>(v); v += dppf<0x140>(v); return v; }
__device__ __forceinline__ void unpack8(const u32x4 w, float (&f)[8]) { f[0] = bflo(w.x); f[1] = bfhi(w.x); f[2] = bflo(w.y); f[3] = bfhi(w.y); f[4] = bflo(w.z); f[5] = bfhi(w.z); f[6] = bflo(w.w); f[7] = bfhi(w.w); }


__device__ __forceinline__ float wave_scan_sum(float x, bool fwd) {
    const int lane = threadIdx.x & 63;
#pragma unroll
    for (int o = 1; o < 64; o <<= 1) { const float y = fwd ? __shfl_up(x, o) : __shfl_down(x, o); if (fwd ? (lane >= o) : (lane + o < 64)) x += y; }
    return x; }
__device__ __forceinline__ float wave_scan_max(float x, bool fwd) {
    const int lane = threadIdx.x & 63;
#pragma unroll
    for (int o = 1; o < 64; o <<= 1) { const float y = fwd ? __shfl_up(x, o) : __shfl_down(x, o); if (fwd ? (lane >= o) : (lane + o < 64)) x = fmaxf(x, y); }
    return x; }
__device__ __forceinline__ void conv_job(LDSp lds, const float* __restrict__ src, int ldn, int K, int col0, int ncols, bf16_t* __restrict__ dst, int mode, int off) {
    LAS float* tl = (LAS float*)lds;
    const int tid = threadIdx.x, nnt = ncols >> 6, ntl = (K >> 6) * nnt;
    const int r = tid >> 4, c4 = (tid & 15) << 2;
    f32x4 pv[2];
    if ((int)blockIdx.x < ntl) { const int kt = (int)blockIdx.x / nnt, nt = (int)blockIdx.x - kt * nnt;
#pragma unroll
        for (int i = 0; i < 2; ++i) pv[i] = *(const f32x4*)(src + (size_t)(kt * 64 + r + 32 * i) * ldn + col0 + nt * 64 + c4); }
    for (int tile = blockIdx.x; tile < ntl; tile += gridDim.x) {
        const int kt = tile / nnt, nt = tile - kt * nnt;
#pragma unroll
        for (int i = 0; i < 2; ++i) { const int k = r + 32 * i; const f32x4 v = pv[i];
            tl[k * 65 + c4 + 0] = v.x; tl[k * 65 + c4 + 1] = v.y; tl[k * 65 + c4 + 2] = v.z; tl[k * 65 + c4 + 3] = v.w; }
        { const int tn = tile + (int)gridDim.x; if (tn < ntl) { const int kt2 = tn / nnt, nt2 = tn - kt2 * nnt;
#pragma unroll
            for (int i = 0; i < 2; ++i) pv[i] = *(const f32x4*)(src + (size_t)(kt2 * 64 + r + 32 * i) * ldn + col0 + nt2 * 64 + c4); } }
        __syncthreads();
        const int n = tid >> 3, k8 = (tid & 7) << 3; float f[8];
#pragma unroll
        for (int j = 0; j < 8; ++j) f[j] = tl[(k8 + j) * 65 + n];
        u32x4 w; w.x = pk2(f[0], f[1]); w.y = pk2(f[2], f[3]); w.z = pk2(f[4], f[5]); w.w = pk2(f[6], f[7]);
        const int ncol = nt * 64 + n;
        const int row = mode == 0 ? off + ncol : ((ncol >> 7) << 8) + (ncol & 127) + off;
        *(u32x4*)(dst + (size_t)row * K + kt * 64 + k8) = w;
        __syncthreads();
    }
}
__device__ __forceinline__ void convert_layer(LDSp lds, const Params& p, int L) {
    bf16_t* wb = (bf16_t*)(p.ws + WS_WB);
    if (L == 0) { conv_job(lds, p.in[2], 3088, 1024, 0, 3072, (bf16_t*)((char*)wb + WB_IN), 0, 0);
                  conv_job(lds, p.in[11], 1024, 1024, 0, 1024, (bf16_t*)((char*)wb + WB_OUT), 0, 0); }
    else        { conv_job(lds, p.in[12], 2576, 1024, 0, 2560, (bf16_t*)((char*)wb + WB_IN), 0, 0);
                  conv_job(lds, p.in[20], 1024, 1024, 0, 1024, (bf16_t*)((char*)wb + WB_OUT), 0, 0); }
    conv_job(lds, p.in[22] + (size_t)L * 1024 * DFF, DFF, 1024, 0, DFF, (bf16_t*)((char*)wb + WB_UP), 1, 0);
    conv_job(lds, p.in[23] + (size_t)L * 1024 * DFF, DFF, 1024, 0, DFF, (bf16_t*)((char*)wb + WB_UP), 1, 128);
    conv_job(lds, p.in[24] + (size_t)L * DFF * 1024, 1024, DFF, 0, 1024, (bf16_t*)((char*)wb + WB_DN), 0, 0);
}

__device__ __forceinline__ void rms_phase(LDSp lds, const float* src, const float* __restrict__ g, bf16_t* hn, float* copy_out, float* final_out,
                                          const float* __restrict__ gw, int gw_ld, int gw_col0, float* gates) {
    LAS float* wg = (LAS float*)lds;
    const int tid = threadIdx.x, lane = tid & 63, wid = tid >> 6;
    if (gw) { for (int idx = tid; idx < 16384; idx += NTHR) { const int k = idx >> 4, j = idx & 15; wg[j * 1024 + k] = gw[(size_t)k * gw_ld + gw_col0 + j]; } __syncthreads(); }
    f32x4 gv[4];
#pragma unroll
    for (int i = 0; i < 4; ++i) gv[i] = *(const f32x4*)(g + 4 * lane + 256 * i);
    f32x4 xn[4];
    { const int row0 = blockIdx.x * 8 + wid;
#pragma unroll
      for (int i = 0; i < 4; ++i) xn[i] = *(const f32x4*)(src + (size_t)row0 * D_ + 4 * lane + 256 * i); }
    for (int row = blockIdx.x * 8 + wid; row < T_; row += gridDim.x * 8) {
        f32x4 x[4]; float ss = 0.f;
#pragma unroll
        for (int i = 0; i < 4; ++i) { x[i] = xn[i]; ss += x[i].x * x[i].x + x[i].y * x[i].y + x[i].z * x[i].z + x[i].w * x[i].w; }
        { const int rn = row + (int)gridDim.x * 8; if (rn < T_) {
#pragma unroll
            for (int i = 0; i < 4; ++i) xn[i] = *(const f32x4*)(src + (size_t)rn * D_ + 4 * lane + 256 * i); } }
        if (copy_out) {
#pragma unroll
            for (int i = 0; i < 4; ++i) *(f32x4*)(copy_out + (size_t)row * D_ + 4 * lane + 256 * i) = x[i]; }
        ss = wave_sum(ss);
        const float rstd = rsqrtf(ss * (1.0f / 1024.0f) + 1e-6f);
        f32x4 y[4];
#pragma unroll
        for (int i = 0; i < 4; ++i) y[i] = x[i] * rstd * gv[i];
        if (final_out) {
#pragma unroll
            for (int i = 0; i < 4; ++i) *(f32x4*)(final_out + (size_t)row * D_ + 4 * lane + 256 * i) = y[i];
        } else {
#pragma unroll
            for (int i = 0; i < 4; ++i) { u32x2 w; w.x = pk2(y[i].x, y[i].y); w.y = pk2(y[i].z, y[i].w); *(u32x2*)(hn + (size_t)row * D_ + 4 * lane + 256 * i) = w; }
        }
        if (gw) {
            float s[16];
#pragma unroll
            for (int j = 0; j < 16; ++j) { float a = 0.f;
#pragma unroll
                for (int i = 0; i < 4; ++i) { const f32x4 w = *(const LAS f32x4*)(wg + j * 1024 + 4 * lane + 256 * i); a += y[i].x * w.x + y[i].y * w.y + y[i].z * w.z + y[i].w * w.w; }
                s[j] = a; }
            const bool h5 = (lane & 32) != 0, h4 = (lane & 16) != 0, h3 = (lane & 8) != 0, h2 = (lane & 4) != 0;
            float r8[8], r4[4], r2[2], r1;
#pragma unroll
            for (int j = 0; j < 8; ++j) { const float keep = h5 ? s[j + 8] : s[j], send = h5 ? s[j] : s[j + 8]; r8[j] = keep + __shfl_xor(send, 32); }
#pragma unroll
            for (int j = 0; j < 4; ++j) { const float keep = h4 ? r8[j + 4] : r8[j], send = h4 ? r8[j] : r8[j + 4]; r4[j] = keep + __shfl_xor(send, 16); }
#pragma unroll
            for (int j = 0; j < 2; ++j) { const float keep = h3 ? r4[j + 2] : r4[j], send = h3 ? r4[j] : r4[j + 2]; r2[j] = keep + __shfl_xor(send, 8); }
            { const float keep = h2 ? r2[1] : r2[0], send = h2 ? r2[0] : r2[1]; r1 = keep + __shfl_xor(send, 4); }
            r1 += __shfl_xor(r1, 2); r1 += __shfl_xor(r1, 1);
            if ((lane & 3) == 0) gates[(size_t)row * 16 + (h5 ? 8 : 0) + (h4 ? 4 : 0) + (h3 ? 2 : 0) + (h2 ? 1 : 0)] = r1;
        }
    }
    __syncthreads();
}

__device__ __forceinline__ void even_prep(LDSp lds, const Params& p) {
    const bf16_t* Z = (const bf16_t*)(p.ws + WS_Z); bf16_t* Y = (bf16_t*)(p.ws + WS_HN); bf16_t* QKVN = (bf16_t*)(p.ws + WS_QKV);
    const float* gates = (const float*)(p.ws + WS_GATES); float* BETA = (float*)(p.ws + WS_BETA); float* LA = (float*)(p.ws + WS_LA);
    const float* conv_w = p.in[3]; const float* conv_b = p.in[4]; const float* ln_g = p.in[5]; const float* ln_b = p.in[6];
    const float* dn_w = p.in[7]; const float* a_log = p.in[8]; const float* dt_bias = p.in[9];
    LAS float* glu = (LAS float*)lds;
    const int tid = threadIdx.x, lane = tid & 63, wid = tid >> 6, c = tid;
    for (int tile = blockIdx.x; tile < T_ / 32; tile += gridDim.x) {
        const int t0 = tile * 32, b = t0 >> 12, s0 = t0 & 4095;
#if !(EVP_SKIP & 1)
        for (int it = tid; it < 62 * 64; it += NTHR) { const int r = it >> 6, c8 = (it & 63) << 3, sp = s0 - 15 + r;
            f32x4 o0 = {0.f, 0.f, 0.f, 0.f}, o1 = {0.f, 0.f, 0.f, 0.f};
            if (sp >= 0 && sp < S_) { const size_t tok = (size_t)b * S_ + sp; const u32x4 av = *(const u32x4*)(Z + tok * 3072 + c8); const u32x4 gv = *(const u32x4*)(Z + tok * 3072 + 512 + c8);
                float a[8], g[8]; unpack8(av, a); unpack8(gv, g);
                o0 = (f32x4){a[0] * sigm(g[0]), a[1] * sigm(g[1]), a[2] * sigm(g[2]), a[3] * sigm(g[3])}; o1 = (f32x4){a[4] * sigm(g[4]), a[5] * sigm(g[5]), a[6] * sigm(g[6]), a[7] * sigm(g[7])}; }
            *(LAS f32x4*)(glu + r * 512 + c8) = o0; *(LAS f32x4*)(glu + r * 512 + c8 + 4) = o1; }
        __syncthreads();
        {
            float cw[31];
#pragma unroll
            for (int w = 0; w < 31; ++w) cw[w] = conv_w[w * 512 + c];
            const float cb = conv_b[c];
            f32x4 res[8];
#pragma unroll
            for (int t4 = 0; t4 < 8; ++t4) {
                float x[34];
#pragma unroll
                for (int i = 0; i < 34; ++i) x[i] = glu[(t4 * 4 + i) * 512 + c];
                float a0 = cb, a1 = cb, a2 = cb, a3 = cb;
#pragma unroll
                for (int w = 0; w < 31; ++w) { a0 = fmaf(x[w], cw[w], a0); a1 = fmaf(x[w + 1], cw[w], a1); a2 = fmaf(x[w + 2], cw[w], a2); a3 = fmaf(x[w + 3], cw[w], a3); }
                res[t4] = (f32x4){a0, a1, a2, a3};
            }
            __syncthreads();
#pragma unroll
            for (int t4 = 0; t4 < 8; ++t4) { glu[(t4 * 4 + 0) * 512 + c] = res[t4].x; glu[(t4 * 4 + 1) * 512 + c] = res[t4].y; glu[(t4 * 4 + 2) * 512 + c] = res[t4].z; glu[(t4 * 4 + 3) * 512 + c] = res[t4].w; }
        }
        __syncthreads();
        {
            const f32x4 g0 = *(const f32x4*)(ln_g + 4 * lane), g1 = *(const f32x4*)(ln_g + 256 + 4 * lane), b0 = *(const f32x4*)(ln_b + 4 * lane), b1 = *(const f32x4*)(ln_b + 256 + 4 * lane);
#pragma unroll
            for (int tt = 0; tt < 4; ++tt) { const int t = wid * 4 + tt;
                const f32x4 x0 = *(const LAS f32x4*)(glu + t * 512 + 4 * lane), x1 = *(const LAS f32x4*)(glu + t * 512 + 256 + 4 * lane);
                const float mean = wave_sum((x0.x + x0.y) + (x0.z + x0.w) + (x1.x + x1.y) + (x1.z + x1.w)) * (1.0f / 512.0f);
                const f32x4 d0 = x0 - mean, d1 = x1 - mean;
                const float var = wave_sum(d0.x * d0.x + d0.y * d0.y + d0.z * d0.z + d0.w * d0.w + d1.x * d1.x + d1.y * d1.y + d1.z * d1.z + d1.w * d1.w) * (1.0f / 512.0f);
                const float rstd = rsqrtf(var + 1e-5f);
                const f32x4 y0 = d0 * rstd * g0 + b0, y1 = d1 * rstd * g1 + b1;
                u32x2 w0, w1; w0.x = pk2(silu_(y0.x), silu_(y0.y)); w0.y = pk2(silu_(y0.z), silu_(y0.w)); w1.x = pk2(silu_(y1.x), silu_(y1.y)); w1.y = pk2(silu_(y1.z), silu_(y1.w));
                *(u32x2*)(Y + (size_t)(t0 + t) * 1024 + 4 * lane) = w0; *(u32x2*)(Y + (size_t)(t0 + t) * 1024 + 256 + 4 * lane) = w1; }
        }
        __syncthreads();
#endif
#if !(EVP_SKIP & 2)
        LAS unsigned short* xin = (LAS unsigned short*)(glu + 32 * 512);
#pragma unroll 1
        for (int gi = 0; gi < 3; ++gi) {
            float w5[5];
#pragma unroll
            for (int w = 0; w < 5; ++w) w5[w] = dn_w[w * 1536 + gi * 512 + c];
            for (int it = tid; it < 36 * 64; it += NTHR) { const int rr = it >> 6, c8 = (it & 63) << 3, sp = s0 - 2 + rr;
                u32x4 v = {0u, 0u, 0u, 0u};
                if (sp >= 0 && sp < S_) v = *(const u32x4*)(Z + ((size_t)b * S_ + sp) * 3072 + 1024 + gi * 512 + c8);
                *(LAS u32x4*)(xin + rr * 512 + c8) = v; }
            __syncthreads();
            float x0 = bf2f(xin[c]), x1 = bf2f(xin[512 + c]), x2 = bf2f(xin[1024 + c]), x3 = bf2f(xin[1536 + c]);
#pragma unroll 8
            for (int t = 0; t < 32; ++t) { const float x4 = bf2f(xin[(t + 4) * 512 + c]);
                float v = x0 * w5[0]; v = fmaf(x1, w5[1], v); v = fmaf(x2, w5[2], v); v = fmaf(x3, w5[3], v); v = fmaf(x4, w5[4], v);
                glu[t * 512 + c] = silu_(v);
                x0 = x1; x1 = x2; x2 = x3; x3 = x4; }
            __syncthreads();
            const float qs = gi == 0 ? 0.08838834764831845f : 1.0f;
#pragma unroll
            for (int pp = 0; pp < 4; ++pp) { const int pr = wid * 16 + pp * 4 + (lane >> 4), t = pr >> 2, hd = pr & 3, c8 = (lane & 15) * 8;
                const f32x4 y0 = *(const LAS f32x4*)(glu + t * 512 + hd * 128 + c8), y1 = *(const LAS f32x4*)(glu + t * 512 + hd * 128 + c8 + 4);
                const float ss = row16_sum(y0.x * y0.x + y0.y * y0.y + y0.z * y0.z + y0.w * y0.w + y1.x * y1.x + y1.y * y1.y + y1.z * y1.z + y1.w * y1.w);
                const float sc = gi == 2 ? 1.0f : rsqrtf(ss + 1e-6f) * qs;
                u32x4 w; w.x = pk2(y0.x * sc, y0.y * sc); w.y = pk2(y0.z * sc, y0.w * sc); w.z = pk2(y1.x * sc, y1.y * sc); w.w = pk2(y1.z * sc, y1.w * sc);
                *(u32x4*)(QKVN + (size_t)(t0 + t) * 1536 + gi * 512 + hd * 128 + c8) = w; }
            __syncthreads();
        }
#endif
#if !(EVP_SKIP & 4)
        if (tid < 256) { const int t = tid >> 3, j = tid & 7; const size_t tok = (size_t)(t0 + t);
            const float bp = gates[tok * 16 + j], ap = gates[tok * 16 + 8 + j];
            BETA[tok * 8 + j] = sigm(bp); LA[tok * 8 + j] = -expf(a_log[j]) * softplus_(ap + dt_bias[j]); }
#endif
        __syncthreads();
    }
}

__device__ __forceinline__ void tri_inv64(const LAS float* Am, int c, float su, float sw, LAS unsigned short* Tu, LAS unsigned short* Tw) {
    f32x4 a; float s0, s1, s2, s3; const float cf = (float)c;
    float x0 = fmaxf(0.0f, 1.0f - fabsf(cf - 0.0f));
    Tu[0 + c] = f2bf(x0 * su); Tw[0 + c] = f2bf(x0 * sw); asm volatile("" ::: "memory");
    float x1 = fmaxf(0.0f, 1.0f - fabsf(cf - 1.0f));
    s0 = 0.f; s1 = 0.f; s2 = 0.f; s3 = 0.f;
    a = *(const LAS f32x4*)(Am + 68);
    const float al1 = a.x;
    x1 = (x1 - ((s0 + s1) + (s2 + s3))) - al1 * x0;
    Tu[136 + c] = f2bf(x1 * su); Tw[136 + c] = f2bf(x1 * sw); asm volatile("" ::: "memory");
    float x2 = fmaxf(0.0f, 1.0f - fabsf(cf - 2.0f));
    s0 = 0.f; s1 = 0.f; s2 = 0.f; s3 = 0.f;
    a = *(const LAS f32x4*)(Am + 136);
    s0 = fmaf(a.x, x0, s0);
    const float al2 = a.y;
    x2 = (x2 - ((s0 + s1) + (s2 + s3))) - al2 * x1;
    Tu[272 + c] = f2bf(x2 * su); Tw[272 + c] = f2bf(x2 * sw); asm volatile("" ::: "memory");
    float x3 = fmaxf(0.0f, 1.0f - fabsf(cf - 3.0f));
    s0 = 0.f; s1 = 0.f; s2 = 0.f; s3 = 0.f;
    a = *(const LAS f32x4*)(Am + 204);
    s0 = fmaf(a.x, x0, s0);
    s1 = fmaf(a.y, x1, s1);
    const float al3 = a.z;
    x3 = (x3 - ((s0 + s1) + (s2 + s3))) - al3 * x2;
    Tu[408 + c] = f2bf(x3 * su); Tw[408 + c] = f2bf(x3 * sw); asm volatile("" ::: "memory");
    float x4 = fmaxf(0.0f, 1.0f - fabsf(cf - 4.0f));
    s0 = 0.f; s1 = 0.f; s2 = 0.f; s3 = 0.f;
    a = *(const LAS f32x4*)(Am + 272);
    s0 = fmaf(a.x, x0, s0);
    s1 = fmaf(a.y, x1, s1);
    s2 = fmaf(a.z, x2, s2);
    const float al4 = a.w;
    x4 = (x4 - ((s0 + s1) + (s2 + s3))) - al4 * x3;
    Tu[544 + c] = f2bf(x4 * su); Tw[544 + c] = f2bf(x4 * sw); asm volatile("" ::: "memory");
    float x5 = fmaxf(0.0f, 1.0f - fabsf(cf - 5.0f));
    s0 = 0.f; s1 = 0.f; s2 = 0.f; s3 = 0.f;
    a = *(const LAS f32x4*)(Am + 340);
    s0 = fmaf(a.x, x0, s0);
    s1 = fmaf(a.y, x1, s1);
    s2 = fmaf(a.z, x2, s2);
    s3 = fmaf(a.w, x3, s3);
    a = *(const LAS f32x4*)(Am + 344);
    const float al5 = a.x;
    x5 = (x5 - ((s0 + s1) + (s2 + s3))) - al5 * x4;
    Tu[680 + c] = f2bf(x5 * su); Tw[680 + c] = f2bf(x5 * sw); asm volatile("" ::: "memory");
    float x6 = fmaxf(0.0f, 1.0f - fabsf(cf - 6.0f));
    s0 = 0.f; s1 = 0.f; s2 = 0.f; s3 = 0.f;
    a = *(const LAS f32x4*)(Am + 408);
    s0 = fmaf(a.x, x0, s0);
    s1 = fmaf(a.y, x1, s1);
    s2 = fmaf(a.z, x2, s2);
    s3 = fmaf(a.w, x3, s3);
    a = *(const LAS f32x4*)(Am + 412);
    s0 = fmaf(a.x, x4, s0);
    const float al6 = a.y;
    x6 = (x6 - ((s0 + s1) + (s2 + s3))) - al6 * x5;
    Tu[816 + c] = f2bf(x6 * su); Tw[816 + c] = f2bf(x6 * sw); asm volatile("" ::: "memory");
    float x7 = fmaxf(0.0f, 1.0f - fabsf(cf - 7.0f));
    s0 = 0.f; s1 = 0.f; s2 = 0.f; s3 = 0.f;
    a = *(const LAS f32x4*)(Am + 476);
    s0 = fmaf(a.x, x0, s0);
    s1 = fmaf(a.y, x1, s1);
    s2 = fmaf(a.z, x2, s2);
    s3 = fmaf(a.w, x3, s3);
    a = *(const LAS f32x4*)(Am + 480);
    s0 = fmaf(a.x, x4, s0);
    s1 = fmaf(a.y, x5, s1);
    const float al7 = a.z;
    x7 = (x7 - ((s0 + s1) + (s2 + s3))) - al7 * x6;
    Tu[952 + c] = f2bf(x7 * su); Tw[952 + c] = f2bf(x7 * sw); asm volatile("" ::: "memory");
    float x8 = fmaxf(0.0f, 1.0f - fabsf(cf - 8.0f));
    s0 = 0.f; s1 = 0.f; s2 = 0.f; s3 = 0.f;
    a = *(const LAS f32x4*)(Am + 544);
    s0 = fmaf(a.x, x0, s0);
    s1 = fmaf(a.y, x1, s1);
    s2 = fmaf(a.z, x2, s2);
    s3 = fmaf(a.w, x3, s3);
    a = *(const LAS f32x4*)(Am + 548);
    s0 = fmaf(a.x, x4, s0);
    s1 = fmaf(a.y, x5, s1);
    s2 = fmaf(a.z, x6, s2);
    const float al8 = a.w;
    x8 = (x8 - ((s0 + s1) + (s2 + s3))) - al8 * x7;
    Tu[1088 + c] = f2bf(x8 * su); Tw[1088 + c] = f2bf(x8 * sw); asm volatile("" ::: "memory");
    float x9 = fmaxf(0.0f, 1.0f - fabsf(cf - 9.0f));
    s0 = 0.f; s1 = 0.f; s2 = 0.f; s3 = 0.f;
    a = *(const LAS f32x4*)(Am + 612);
    s0 = fmaf(a.x, x0, s0);
    s1 = fmaf(a.y, x1, s1);
    s2 = fmaf(a.z, x2, s2);
    s3 = fmaf(a.w, x3, s3);
    a = *(const LAS f32x4*)(Am + 616);
    s0 = fmaf(a.x, x4, s0);
    s1 = fmaf(a.y, x5, s1);
    s2 = fmaf(a.z, x6, s2);
    s3 = fmaf(a.w, x7, s3);
    a = *(const LAS f32x4*)(Am + 620);
    const float al9 = a.x;
    x9 = (x9 - ((s0 + s1) + (s2 + s3))) - al9 * x8;
    Tu[1224 + c] = f2bf(x9 * su); Tw[1224 + c] = f2bf(x9 * sw); asm volatile("" ::: "memory");
    float x10 = fmaxf(0.0f, 1.0f - fabsf(cf - 10.0f));
    s0 = 0.f; s1 = 0.f; s2 = 0.f; s3 = 0.f;
    a = *(const LAS f32x4*)(Am + 680);
    s0 = fmaf(a.x, x0, s0);
    s1 = fmaf(a.y, x1, s1);
    s2 = fmaf(a.z, x2, s2);
    s3 = fmaf(a.w, x3, s3);
    a = *(const LAS f32x4*)(Am + 684);
    s0 = fmaf(a.x, x4, s0);
    s1 = fmaf(a.y, x5, s1);
    s2 = fmaf(a.z, x6, s2);
    s3 = fmaf(a.w, x7, s3);
    a = *(const LAS f32x4*)(Am + 688);
    s0 = fmaf(a.x, x8, s0);
    const float al10 = a.y;
    x10 = (x10 - ((s0 + s1) + (s2 + s3))) - al10 * x9;
    Tu[1360 + c] = f2bf(x10 * su); Tw[1360 + c] = f2bf(x10 * sw); asm volatile("" ::: "memory");
    float x11 = fmaxf(0.0f, 1.0f - fabsf(cf - 11.0f));
    s0 = 0.f; s1 = 0.f; s2 = 0.f; s3 = 0.f;
    a = *(const LAS f32x4*)(Am + 748);
    s0 = fmaf(a.x, x0, s0);
    s1 = fmaf(a.y, x1, s1);
    s2 = fmaf(a.z, x2, s2);
    s3 = fmaf(a.w, x3, s3);
    a = *(const LAS f32x4*)(Am + 752);
    s0 = fmaf(a.x, x4, s0);
    s1 = fmaf(a.y, x5, s1);
    s2 = fmaf(a.z, x6, s2);
    s3 = fmaf(a.w, x7, s3);
    a = *(const LAS f32x4*)(Am + 756);
    s0 = fmaf(a.x, x8, s0);
    s1 = fmaf(a.y, x9, s1);
    const float al11 = a.z;
    x11 = (x11 - ((s0 + s1) + (s2 + s3))) - al11 * x10;
    Tu[1496 + c] = f2bf(x11 * su); Tw[1496 + c] = f2bf(x11 * sw); asm volatile("" ::: "memory");
    float x12 = fmaxf(0.0f, 1.0f - fabsf(cf - 12.0f));
    s0 = 0.f; s1 = 0.f; s2 = 0.f; s3 = 0.f;
    a = *(const LAS f32x4*)(Am + 816);
    s0 = fmaf(a.x, x0, s0);
    s1 = fmaf(a.y, x1, s1);
    s2 = fmaf(a.z, x2, s2);
    s3 = fmaf(a.w, x3, s3);
    a = *(const LAS f32x4*)(Am + 820);
    s0 = fmaf(a.x, x4, s0);
    s1 = fmaf(a.y, x5, s1);
    s2 = fmaf(a.z, x6, s2);
    s3 = fmaf(a.w, x7, s3);
    a = *(const LAS f32x4*)(Am + 824);
    s0 = fmaf(a.x, x8, s0);
    s1 = fmaf(a.y, x9, s1);
    s2 = fmaf(a.z, x10, s2);
    const float al12 = a.w;
    x12 = (x12 - ((s0 + s1) + (s2 + s3))) - al12 * x11;
    Tu[1632 + c] = f2bf(x12 * su); Tw[1632 + c] = f2bf(x12 * sw); asm volatile("" ::: "memory");
    float x13 = fmaxf(0.0f, 1.0f - fabsf(cf - 13.0f));
    s0 = 0.f; s1 = 0.f; s2 = 0.f; s3 = 0.f;
    a = *(const LAS f32x4*)(Am + 884);
    s0 = fmaf(a.x, x0, s0);
    s1 = fmaf(a.y, x1, s1);
    s2 = fmaf(a.z, x2, s2);
    s3 = fmaf(a.w, x3, s3);
    a = *(const LAS f32x4*)(Am + 888);
    s0 = fmaf(a.x, x4, s0);
    s1 = fmaf(a.y, x5, s1);
    s2 = fmaf(a.z, x6, s2);
    s3 = fmaf(a.w, x7, s3);
    a = *(const LAS f32x4*)(Am + 892);
    s0 = fmaf(a.x, x8, s0);
    s1 = fmaf(a.y, x9, s1);
    s2 = fmaf(a.z, x10, s2);
    s3 = fmaf(a.w, x11, s3);
    a = *(const LAS f32x4*)(Am + 896);
    const float al13 = a.x;
    x13 = (x13 - ((s0 + s1) + (s2 + s3))) - al13 * x12;
    Tu[1768 + c] = f2bf(x13 * su); Tw[1768 + c] = f2bf(x13 * sw); asm volatile("" ::: "memory");
    float x14 = fmaxf(0.0f, 1.0f - fabsf(cf - 14.0f));
    s0 = 0.f; s1 = 0.f; s2 = 0.f; s3 = 0.f;
    a = *(const LAS f32x4*)(Am + 952);
    s0 = fmaf(a.x, x0, s0);
    s1 = fmaf(a.y, x1, s1);
    s2 = fmaf(a.z, x2, s2);
    s3 = fmaf(a.w, x3, s3);
    a = *(const LAS f32x4*)(Am + 956);
    s0 = fmaf(a.x, x4, s0);
    s1 = fmaf(a.y, x5, s1);
    s2 = fmaf(a.z, x6, s2);
    s3 = fmaf(a.w, x7, s3);
    a = *(const LAS f32x4*)(Am + 960);
    s0 = fmaf(a.x, x8, s0);
    s1 = fmaf(a.y, x9, s1);
    s2 = fmaf(a.z, x10, s2);
    s3 = fmaf(a.w, x11, s3);
    a = *(const LAS f32x4*)(Am + 964);
    s0 = fmaf(a.x, x12, s0);
    const float al14 = a.y;
    x14 = (x14 - ((s0 + s1) + (s2 + s3))) - al14 * x13;
    Tu[1904 + c] = f2bf(x14 * su); Tw[1904 + c] = f2bf(x14 * sw); asm volatile("" ::: "memory");
    float x15 = fmaxf(0.0f, 1.0f - fabsf(cf - 15.0f));
    s0 = 0.f; s1 = 0.f; s2 = 0.f; s3 = 0.f;
    a = *(const LAS f32x4*)(Am + 1020);
    s0 = fmaf(a.x, x0, s0);
    s1 = fmaf(a.y, x1, s1);
    s2 = fmaf(a.z, x2, s2);
    s3 = fmaf(a.w, x3, s3);
    a = *(const LAS f32x4*)(Am + 1024);
    s0 = fmaf(a.x, x4, s0);
    s1 = fmaf(a.y, x5, s1);
    s2 = fmaf(a.z, x6, s2);
    s3 = fmaf(a.w, x7, s3);
    a = *(const LAS f32x4*)(Am + 1028);
    s0 = fmaf(a.x, x8, s0);
    s1 = fmaf(a.y, x9, s1);
    s2 = fmaf(a.z, x10, s2);
    s3 = fmaf(a.w, x11, s3);
    a = *(const LAS f32x4*)(Am + 1032);
    s0 = fmaf(a.x, x12, s0);
    s1 = fmaf(a.y, x13, s1);
    const float al15 = a.z;
    x15 = (x15 - ((s0 + s1) + (s2 + s3))) - al15 * x14;
    Tu[2040 + c] = f2bf(x15 * su); Tw[2040 + c] = f2bf(x15 * sw); asm volatile("" ::: "memory");
    float x16 = fmaxf(0.0f, 1.0f - fabsf(cf - 16.0f));
    s0 = 0.f; s1 = 0.f; s2 = 0.f; s3 = 0.f;
    a = *(const LAS f32x4*)(Am + 1088);
    s0 = fmaf(a.x, x0, s0);
    s1 = fmaf(a.y, x1, s1);
    s2 = fmaf(a.z, x2, s2);
    s3 = fmaf(a.w, x3, s3);
    a = *(const LAS f32x4*)(Am + 1092);
    s0 = fmaf(a.x, x4, s0);
    s1 = fmaf(a.y, x5, s1);
    s2 = fmaf(a.z, x6, s2);
    s3 = fmaf(a.w, x7, s3);
    a = *(const LAS f32x4*)(Am + 1096);
    s0 = fmaf(a.x, x8, s0);
    s1 = fmaf(a.y, x9, s1);
    s2 = fmaf(a.z, x10, s2);
    s3 = fmaf(a.w, x11, s3);
    a = *(const LAS f32x4*)(Am + 1100);
    s0 = fmaf(a.x, x12, s0);
    s1 = fmaf(a.y, x13, s1);
    s2 = fmaf(a.z, x14, s2);
    const float al16 = a.w;
    x16 = (x16 - ((s0 + s1) + (s2 + s3))) - al16 * x15;
    Tu[2176 + c] = f2bf(x16 * su); Tw[2176 + c] = f2bf(x16 * sw); asm volatile("" ::: "memory");
    float x17 = fmaxf(0.0f, 1.0f - fabsf(cf - 17.0f));
    s0 = 0.f; s1 = 0.f; s2 = 0.f; s3 = 0.f;
    a = *(const LAS f32x4*)(Am + 1156);
    s0 = fmaf(a.x, x0, s0);
    s1 = fmaf(a.y, x1, s1);
    s2 = fmaf(a.z, x2, s2);
    s3 = fmaf(a.w, x3, s3);
    a = *(const LAS f32x4*)(Am + 1160);
    s0 = fmaf(a.x, x4, s0);
    s1 = fmaf(a.y, x5, s1);
    s2 = fmaf(a.z, x6, s2);
    s3 = fmaf(a.w, x7, s3);
    a = *(const LAS f32x4*)(Am + 1164);
    s0 = fmaf(a.x, x8, s0);
    s1 = fmaf(a.y, x9, s1);
    s2 = fmaf(a.z, x10, s2);
    s3 = fmaf(a.w, x11, s3);
    a = *(const LAS f32x4*)(Am + 1168);
    s0 = fmaf(a.x, x12, s0);
    s1 = fmaf(a.y, x13, s1);
    s2 = fmaf(a.z, x14, s2);
    s3 = fmaf(a.w, x15, s3);
    a = *(const LAS f32x4*)(Am + 1172);
    const float al17 = a.x;
    x17 = (x17 - ((s0 + s1) + (s2 + s3))) - al17 * x16;
    Tu[2312 + c] = f2bf(x17 * su); Tw[2312 + c] = f2bf(x17 * sw); asm volatile("" ::: "memory");
    float x18 = fmaxf(0.0f, 1.0f - fabsf(cf - 18.0f));
    s0 = 0.f; s1 = 0.f; s2 = 0.f; s3 = 0.f;
    a = *(const LAS f32x4*)(Am + 1224);
    s0 = fmaf(a.x, x0, s0);
    s1 = fmaf(a.y, x1, s1);
    s2 = fmaf(a.z, x2, s2);
    s3 = fmaf(a.w, x3, s3);
    a = *(const LAS f32x4*)(Am + 1228);
    s0 = fmaf(a.x, x4, s0);
    s1 = fmaf(a.y, x5, s1);
    s2 = fmaf(a.z, x6, s2);
    s3 = fmaf(a.w, x7, s3);
    a = *(const LAS f32x4*)(Am + 1232);
    s0 = fmaf(a.x, x8, s0);
    s1 = fmaf(a.y, x9, s1);
    s2 = fmaf(a.z, x10, s2);
    s3 = fmaf(a.w, x11, s3);
    a = *(const LAS f32x4*)(Am + 1236);
    s0 = fmaf(a.x, x12, s0);
    s1 = fmaf(a.y, x13, s1);
    s2 = fmaf(a.z, x14, s2);
    s3 = fmaf(a.w, x15, s3);
    a = *(const LAS f32x4*)(Am + 1240);
    s0 = fmaf(a.x, x16, s0);
    const float al18 = a.y;
    x18 = (x18 - ((s0 + s1) + (s2 + s3))) - al18 * x17;
    Tu[2448 + c] = f2bf(x18 * su); Tw[2448 + c] = f2bf(x18 * sw); asm volatile("" ::: "memory");
    float x19 = fmaxf(0.0f, 1.0f - fabsf(cf - 19.0f));
    s0 = 0.f; s1 = 0.f; s2 = 0.f; s3 = 0.f;
    a = *(const LAS f32x4*)(Am + 1292);
    s0 = fmaf(a.x, x0, s0);
    s1 = fmaf(a.y, x1, s1);
    s2 = fmaf(a.z, x2, s2);
    s3 = fmaf(a.w, x3, s3);
    a = *(const LAS f32x4*)(Am + 1296);
    s0 = fmaf(a.x, x4, s0);
    s1 = fmaf(a.y, x5, s1);
    s2 = fmaf(a.z, x6, s2);
    s3 = fmaf(a.w, x7, s3);
    a = *(const LAS f32x4*)(Am + 1300);
    s0 = fmaf(a.x, x8, s0);
    s1 = fmaf(a.y, x9, s1);
    s2 = fmaf(a.z, x10, s2);
    s3 = fmaf(a.w, x11, s3);
    a = *(const LAS f32x4*)(Am + 1304);
    s0 = fmaf(a.x, x12, s0);
    s1 = fmaf(a.y, x13, s1);
    s2 = fmaf(a.z, x14, s2);
    s3 = fmaf(a.w, x15, s3);
    a = *(const LAS f32x4*)(Am + 1308);
    s0 = fmaf(a.x, x16, s0);
    s1 = fmaf(a.y, x17, s1);
    const float al19 = a.z;
    x19 = (x19 - ((s0 + s1) + (s2 + s3))) - al19 * x18;
    Tu[2584 + c] = f2bf(x19 * su); Tw[2584 + c] = f2bf(x19 * sw); asm volatile("" ::: "memory");
    float x20 = fmaxf(0.0f, 1.0f - fabsf(cf - 20.0f));
    s0 = 0.f; s1 = 0.f; s2 = 0.f; s3 = 0.f;
    a = *(const LAS f32x4*)(Am + 1360);
    s0 = fmaf(a.x, x0, s0);
    s1 = fmaf(a.y, x1, s1);
    s2 = fmaf(a.z, x2, s2);
    s3 = fmaf(a.w, x3, s3);
    a = *(const LAS f32x4*)(Am + 1364);
    s0 = fmaf(a.x, x4, s0);
    s1 = fmaf(a.y, x5, s1);
    s2 = fmaf(a.z, x6, s2);
    s3 = fmaf(a.w, x7, s3);
    a = *(const LAS f32x4*)(Am + 1368);
    s0 = fmaf(a.x, x8, s0);
    s1 = fmaf(a.y, x9, s1);
    s2 = fmaf(a.z, x10, s2);
    s3 = fmaf(a.w, x11, s3);
    a = *(const LAS f32x4*)(Am + 1372);
    s0 = fmaf(a.x, x12, s0);
    s1 = fmaf(a.y, x13, s1);
    s2 = fmaf(a.z, x14, s2);
    s3 = fmaf(a.w, x15, s3);
    a = *(const LAS f32x4*)(Am + 1376);
    s0 = fmaf(a.x, x16, s0);
    s1 = fmaf(a.y, x17, s1);
    s2 = fmaf(a.z, x18, s2);
    const float al20 = a.w;
    x20 = (x20 - ((s0 + s1) + (s2 + s3))) - al20 * x19;
    Tu[2720 + c] = f2bf(x20 * su); Tw[2720 + c] = f2bf(x20 * sw); asm volatile("" ::: "memory");
    float x21 = fmaxf(0.0f, 1.0f - fabsf(cf - 21.0f));
    s0 = 0.f; s1 = 0.f; s2 = 0.f; s3 = 0.f;
    a = *(const LAS f32x4*)(Am + 1428);
    s0 = fmaf(a.x, x0, s0);
    s1 = fmaf(a.y, x1, s1);
    s2 = fmaf(a.z, x2, s2);
    s3 = fmaf(a.w, x3, s3);
    a = *(const LAS f32x4*)(Am + 1432);
    s0 = fmaf(a.x, x4, s0);
    s1 = fmaf(a.y, x5, s1);
    s2 = fmaf(a.z, x6, s2);
    s3 = fmaf(a.w, x7, s3);
    a = *(const LAS f32x4*)(Am + 1436);
    s0 = fmaf(a.x, x8, s0);
    s1 = fmaf(a.y, x9, s1);
    s2 = fmaf(a.z, x10, s2);
    s3 = fmaf(a.w, x11, s3);
    a = *(const LAS f32x4*)(Am + 1440);
    s0 = fmaf(a.x, x12, s0);
    s1 = fmaf(a.y, x13, s1);
    s2 = fmaf(a.z, x14, s2);
    s3 = fmaf(a.w, x15, s3);
    a = *(const LAS f32x4*)(Am + 1444);
    s0 = fmaf(a.x, x16, s0);
    s1 = fmaf(a.y, x17, s1);
    s2 = fmaf(a.z, x18, s2);
    s3 = fmaf(a.w, x19, s3);
    a = *(const LAS f32x4*)(Am + 1448);
    const float al21 = a.x;
    x21 = (x21 - ((s0 + s1) + (s2 + s3))) - al21 * x20;
    Tu[2856 + c] = f2bf(x21 * su); Tw[2856 + c] = f2bf(x21 * sw); asm volatile("" ::: "memory");
    float x22 = fmaxf(0.0f, 1.0f - fabsf(cf - 22.0f));
    s0 = 0.f; s1 = 0.f; s2 = 0.f; s3 = 0.f;
    a = *(const LAS f32x4*)(Am + 1496);
    s0 = fmaf(a.x, x0, s0);
    s1 = fmaf(a.y, x1, s1);
    s2 = fmaf(a.z, x2, s2);
    s3 = fmaf(a.w, x3, s3);
    a = *(const LAS f32x4*)(Am + 1500);
    s0 = fmaf(a.x, x4, s0);
    s1 = fmaf(a.y, x5, s1);
    s2 = fmaf(a.z, x6, s2);
    s3 = fmaf(a.w, x7, s3);
    a = *(const LAS f32x4*)(Am + 1504);
    s0 = fmaf(a.x, x8, s0);
    s1 = fmaf(a.y, x9, s1);
    s2 = fmaf(a.z, x10, s2);
    s3 = fmaf(a.w, x11, s3);
    a = *(const LAS f32x4*)(Am + 1508);
    s0 = fmaf(a.x, x12, s0);
    s1 = fmaf(a.y, x13, s1);
    s2 = fmaf(a.z, x14, s2);
    s3 = fmaf(a.w, x15, s3);
    a = *(const LAS f32x4*)(Am + 1512);
    s0 = fmaf(a.x, x16, s0);
    s1 = fmaf(a.y, x17, s1);
    s2 = fmaf(a.z, x18, s2);
    s3 = fmaf(a.w, x19, s3);
    a = *(const LAS f32x4*)(Am + 1516);
    s0 = fmaf(a.x, x20, s0);
    const float al22 = a.y;
    x22 = (x22 - ((s0 + s1) + (s2 + s3))) - al22 * x21;
    Tu[2992 + c] = f2bf(x22 * su); Tw[2992 + c] = f2bf(x22 * sw); asm volatile("" ::: "memory");
    float x23 = fmaxf(0.0f, 1.0f - fabsf(cf - 23.0f));
    s0 = 0.f; s1 = 0.f; s2 = 0.f; s3 = 0.f;
    a = *(const LAS f32x4*)(Am + 1564);
    s0 = fmaf(a.x, x0, s0);
    s1 = fmaf(a.y, x1, s1);
    s2 = fmaf(a.z, x2, s2);
    s3 = fmaf(a.w, x3, s3);
    a = *(const LAS f32x4*)(Am + 1568);
    s0 = fmaf(a.x, x4, s0);
    s1 = fmaf(a.y, x5, s1);
    s2 = fmaf(a.z, x6, s2);
    s3 = fmaf(a.w, x7, s3);
    a = *(const LAS f32x4*)(Am + 1572);
    s0 = fmaf(a.x, x8, s0);
    s1 = fmaf(a.y, x9, s1);
    s2 = fmaf(a.z, x10, s2);
    s3 = fmaf(a.w, x11, s3);
    a = *(const LAS f32x4*)(Am + 1576);
    s0 = fmaf(a.x, x12, s0);
    s1 = fmaf(a.y, x13, s1);
    s2 = fmaf(a.z, x14, s2);
    s3 = fmaf(a.w, x15, s3);
    a = *(const LAS f32x4*)(Am + 1580);
    s0 = fmaf(a.x, x16, s0);
    s1 = fmaf(a.y, x17, s1);
    s2 = fmaf(a.z, x18, s2);
    s3 = fmaf(a.w, x19, s3);
    a = *(const LAS f32x4*)(Am + 1584);
    s0 = fmaf(a.x, x20, s0);
    s1 = fmaf(a.y, x21, s1);
    const float al23 = a.z;
    x23 = (x23 - ((s0 + s1) + (s2 + s3))) - al23 * x22;
    Tu[3128 + c] = f2bf(x23 * su); Tw[3128 + c] = f2bf(x23 * sw); asm volatile("" ::: "memory");
    float x24 = fmaxf(0.0f, 1.0f - fabsf(cf - 24.0f));
    s0 = 0.f; s1 = 0.f; s2 = 0.f; s3 = 0.f;
    a = *(const LAS f32x4*)(Am + 1632);
    s0 = fmaf(a.x, x0, s0);
    s1 = fmaf(a.y, x1, s1);
    s2 = fmaf(a.z, x2, s2);
    s3 = fmaf(a.w, x3, s3);
    a = *(const LAS f32x4*)(Am + 1636);
    s0 = fmaf(a.x, x4, s0);
    s1 = fmaf(a.y, x5, s1);
    s2 = fmaf(a.z, x6, s2);
    s3 = fmaf(a.w, x7, s3);
    a = *(const LAS f32x4*)(Am + 1640);
    s0 = fmaf(a.x, x8, s0);
    s1 = fmaf(a.y, x9, s1);
    s2 = fmaf(a.z, x10, s2);
    s3 = fmaf(a.w, x11, s3);
    a = *(const LAS f32x4*)(Am + 1644);
    s0 = fmaf(a.x, x12, s0);
    s1 = fmaf(a.y, x13, s1);
    s2 = fmaf(a.z, x14, s2);
    s3 = fmaf(a.w, x15, s3);
    a = *(const LAS f32x4*)(Am + 1648);
    s0 = fmaf(a.x, x16, s0);
    s1 = fmaf(a.y, x17, s1);
    s2 = fmaf(a.z, x18, s2);
    s3 = fmaf(a.w, x19, s3);
    a = *(const LAS f32x4*)(Am + 1652);
    s0 = fmaf(a.x, x20, s0);
    s1 = fmaf(a.y, x21, s1);
    s2 = fmaf(a.z, x22, s2);
    const float al24 = a.w;
    x24 = (x24 - ((s0 + s1) + (s2 + s3))) - al24 * x23;
    Tu[3264 + c] = f2bf(x24 * su); Tw[3264 + c] = f2bf(x24 * sw); asm volatile("" ::: "memory");
    float x25 = fmaxf(0.0f, 1.0f - fabsf(cf - 25.0f));
    s0 = 0.f; s1 = 0.f; s2 = 0.f; s3 = 0.f;
    a = *(const LAS f32x4*)(Am + 1700);
    s0 = fmaf(a.x, x0, s0);
    s1 = fmaf(a.y, x1, s1);
    s2 = fmaf(a.z, x2, s2);
    s3 = fmaf(a.w, x3, s3);
    a = *(const LAS f32x4*)(Am + 1704);
    s0 = fmaf(a.x, x4, s0);
    s1 = fmaf(a.y, x5, s1);
    s2 = fmaf(a.z, x6, s2);
    s3 = fmaf(a.w, x7, s3);
    a = *(const LAS f32x4*)(Am + 1708);
    s0 = fmaf(a.x, x8, s0);
    s1 = fmaf(a.y, x9, s1);
    s2 = fmaf(a.z, x10, s2);
    s3 = fmaf(a.w, x11, s3);
    a = *(const LAS f32x4*)(Am + 1712);
    s0 = fmaf(a.x, x12, s0);
    s1 = fmaf(a.y, x13, s1);
    s2 = fmaf(a.z, x14, s2);
    s3 = fmaf(a.w, x15, s3);
    a = *(const LAS f32x4*)(Am + 1716);
    s0 = fmaf(a.x, x16, s0);
    s1 = fmaf(a.y, x17, s1);
    s2 = fmaf(a.z, x18, s2);
    s3 = fmaf(a.w, x19, s3);
    a = *(const LAS f32x4*)(Am + 1720);
    s0 = fmaf(a.x, x20, s0);
    s1 = fmaf(a.y, x21, s1);
    s2 = fmaf(a.z, x22, s2);
    s3 = fmaf(a.w, x23, s3);
    a = *(const LAS f32x4*)(Am + 1724);
    const float al25 = a.x;
    x25 = (x25 - ((s0 + s1) + (s2 + s3))) - al25 * x24;
    Tu[3400 + c] = f2bf(x25 * su); Tw[3400 + c] = f2bf(x25 * sw); asm volatile("" ::: "memory");
    float x26 = fmaxf(0.0f, 1.0f - fabsf(cf - 26.0f));
    s0 = 0.f; s1 = 0.f; s2 = 0.f; s3 = 0.f;
    a = *(const LAS f32x4*)(Am + 1768);
    s0 = fmaf(a.x, x0, s0);
    s1 = fmaf(a.y, x1, s1);
    s2 = fmaf(a.z, x2, s2);
    s3 = fmaf(a.w, x3, s3);
    a = *(const LAS f32x4*)(Am + 1772);
    s0 = fmaf(a.x, x4, s0);
    s1 = fmaf(a.y, x5, s1);
    s2 = fmaf(a.z, x6, s2);
    s3 = fmaf(a.w, x7, s3);
    a = *(const LAS f32x4*)(Am + 1776);
    s0 = fmaf(a.x, x8, s0);
    s1 = fmaf(a.y, x9, s1);
    s2 = fmaf(a.z, x10, s2);
    s3 = fmaf(a.w, x11, s3);
    a = *(const LAS f32x4*)(Am + 1780);
    s0 = fmaf(a.x, x12, s0);
    s1 = fmaf(a.y, x13, s1);
    s2 = fmaf(a.z, x14, s2);
    s3 = fmaf(a.w, x15, s3);
    a = *(const LAS f32x4*)(Am + 1784);
    s0 = fmaf(a.x, x16, s0);
    s1 = fmaf(a.y, x17, s1);
    s2 = fmaf(a.z, x18, s2);
    s3 = fmaf(a.w, x19, s3);
    a = *(const LAS f32x4*)(Am + 1788);
    s0 = fmaf(a.x, x20, s0);
    s1 = fmaf(a.y, x21, s1);
    s2 = fmaf(a.z, x22, s2);
    s3 = fmaf(a.w, x23, s3);
    a = *(const LAS f32x4*)(Am + 1792);
    s0 = fmaf(a.x, x24, s0);
    const float al26 = a.y;
    x26 = (x26 - ((s0 + s1) + (s2 + s3))) - al26 * x25;
    Tu[3536 + c] = f2bf(x26 * su); Tw[3536 + c] = f2bf(x26 * sw); asm volatile("" ::: "memory");
    float x27 = fmaxf(0.0f, 1.0f - fabsf(cf - 27.0f));
    s0 = 0.f; s1 = 0.f; s2 = 0.f; s3 = 0.f;
    a = *(const LAS f32x4*)(Am + 1836);
    s0 = fmaf(a.x, x0, s0);
    s1 = fmaf(a.y, x1, s1);
    s2 = fmaf(a.z, x2, s2);
    s3 = fmaf(a.w, x3, s3);
    a = *(const LAS f32x4*)(Am + 1840);
    s0 = fmaf(a.x, x4, s0);
    s1 = fmaf(a.y, x5, s1);
    s2 = fmaf(a.z, x6, s2);
    s3 = fmaf(a.w, x7, s3);
    a = *(const LAS f32x4*)(Am + 1844);
    s0 = fmaf(a.x, x8, s0);
    s1 = fmaf(a.y, x9, s1);
    s2 = fmaf(a.z, x10, s2);
    s3 = fmaf(a.w, x11, s3);
    a = *(const LAS f32x4*)(Am + 1848);
    s0 = fmaf(a.x, x12, s0);
    s1 = fmaf(a.y, x13, s1);
    s2 = fmaf(a.z, x14, s2);
    s3 = fmaf(a.w, x15, s3);
    a = *(const LAS f32x4*)(Am + 1852);
    s0 = fmaf(a.x, x16, s0);
    s1 = fmaf(a.y, x17, s1);
    s2 = fmaf(a.z, x18, s2);
    s3 = fmaf(a.w, x19, s3);
    a = *(const LAS f32x4*)(Am + 1856);
    s0 = fmaf(a.x, x20, s0);
    s1 = fmaf(a.y, x21, s1);
    s2 = fmaf(a.z, x22, s2);
    s3 = fmaf(a.w, x23, s3);
    a = *(const LAS f32x4*)(Am + 1860);
    s0 = fmaf(a.x, x24, s0);
    s1 = fmaf(a.y, x25, s1);
    const float al27 = a.z;
    x27 = (x27 - ((s0 + s1) + (s2 + s3))) - al27 * x26;
    Tu[3672 + c] = f2bf(x27 * su); Tw[3672 + c] = f2bf(x27 * sw); asm volatile("" ::: "memory");
    float x28 = fmaxf(0.0f, 1.0f - fabsf(cf - 28.0f));
    s0 = 0.f; s1 = 0.f; s2 = 0.f; s3 = 0.f;
    a = *(const LAS f32x4*)(Am + 1904);
    s0 = fmaf(a.x, x0, s0);
    s1 = fmaf(a.y, x1, s1);
    s2 = fmaf(a.z, x2, s2);
    s3 = fmaf(a.w, x3, s3);
    a = *(const LAS f32x4*)(Am + 1908);
    s0 = fmaf(a.x, x4, s0);
    s1 = fmaf(a.y, x5, s1);
    s2 = fmaf(a.z, x6, s2);
    s3 = fmaf(a.w, x7, s3);
    a = *(const LAS f32x4*)(Am + 1912);
    s0 = fmaf(a.x, x8, s0);
    s1 = fmaf(a.y, x9, s1);
    s2 = fmaf(a.z, x10, s2);
    s3 = fmaf(a.w, x11, s3);
    a = *(const LAS f32x4*)(Am + 1916);
    s0 = fmaf(a.x, x12, s0);
    s1 = fmaf(a.y, x13, s1);
    s2 = fmaf(a.z, x14, s2);
    s3 = fmaf(a.w, x15, s3);
    a = *(const LAS f32x4*)(Am + 1920);
    s0 = fmaf(a.x, x16, s0);
    s1 = fmaf(a.y, x17, s1);
    s2 = fmaf(a.z, x18, s2);
    s3 = fmaf(a.w, x19, s3);
    a = *(const LAS f32x4*)(Am + 1924);
    s0 = fmaf(a.x, x20, s0);
    s1 = fmaf(a.y, x21, s1);
    s2 = fmaf(a.z, x22, s2);
    s3 = fmaf(a.w, x23, s3);
    a = *(const LAS f32x4*)(Am + 1928);
    s0 = fmaf(a.x, x24, s0);
    s1 = fmaf(a.y, x25, s1);
    s2 = fmaf(a.z, x26, s2);
    const float al28 = a.w;
    x28 = (x28 - ((s0 + s1) + (s2 + s3))) - al28 * x27;
    Tu[3808 + c] = f2bf(x28 * su); Tw[3808 + c] = f2bf(x28 * sw); asm volatile("" ::: "memory");
    float x29 = fmaxf(0.0f, 1.0f - fabsf(cf - 29.0f));
    s0 = 0.f; s1 = 0.f; s2 = 0.f; s3 = 0.f;
    a = *(const LAS f32x4*)(Am + 1972);
    s0 = fmaf(a.x, x0, s0);
    s1 = fmaf(a.y, x1, s1);
    s2 = fmaf(a.z, x2, s2);
    s3 = fmaf(a.w, x3, s3);
    a = *(const LAS f32x4*)(Am + 1976);
    s0 = fmaf(a.x, x4, s0);
    s1 = fmaf(a.y, x5, s1);
    s2 = fmaf(a.z, x6, s2);
    s3 = fmaf(a.w, x7, s3);
    a = *(const LAS f32x4*)(Am + 1980);
    s0 = fmaf(a.x, x8, s0);
    s1 = fmaf(a.y, x9, s1);
    s2 = fmaf(a.z, x10, s2);
    s3 = fmaf(a.w, x11, s3);
    a = *(const LAS f32x4*)(Am + 1984);
    s0 = fmaf(a.x, x12, s0);
    s1 = fmaf(a.y, x13, s1);
    s2 = fmaf(a.z, x14, s2);
    s3 = fmaf(a.w, x15, s3);
    a = *(const LAS f32x4*)(Am + 1988);
    s0 = fmaf(a.x, x16, s0);
    s1 = fmaf(a.y, x17, s1);
    s2 = fmaf(a.z, x18, s2);
    s3 = fmaf(a.w, x19, s3);
    a = *(const LAS f32x4*)(Am + 1992);
    s0 = fmaf(a.x, x20, s0);
    s1 = fmaf(a.y, x21, s1);
    s2 = fmaf(a.z, x22, s2);
    s3 = fmaf(a.w, x23, s3);
    a = *(const LAS f32x4*)(Am + 1996);
    s0 = fmaf(a.x, x24, s0);
    s1 = fmaf(a.y, x25, s1);
    s2 = fmaf(a.z, x26, s2);
    s3 = fmaf(a.w, x27, s3);
    a = *(const LAS f32x4*)(Am + 2000);
    const float al29 = a.x;
    x29 = (x29 - ((s0 + s1) + (s2 + s3))) - al29 * x28;
    Tu[3944 + c] = f2bf(x29 * su); Tw[3944 + c] = f2bf(x29 * sw); asm volatile("" ::: "memory");
    float x30 = fmaxf(0.0f, 1.0f - fabsf(cf - 30.0f));
    s0 = 0.f; s1 = 0.f; s2 = 0.f; s3 = 0.f;
    a = *(const LAS f32x4*)(Am + 2040);
    s0 = fmaf(a.x, x0, s0);
    s1 = fmaf(a.y, x1, s1);
    s2 = fmaf(a.z, x2, s2);
    s3 = fmaf(a.w, x3, s3);
    a = *(const LAS f32x4*)(Am + 2044);
    s0 = fmaf(a.x, x4, s0);
    s1 = fmaf(a.y, x5, s1);
    s2 = fmaf(a.z, x6, s2);
    s3 = fmaf(a.w, x7, s3);
    a = *(const LAS f32x4*)(Am + 2048);
    s0 = fmaf(a.x, x8, s0);
    s1 = fmaf(a.y, x9, s1);
    s2 = fmaf(a.z, x10, s2);
    s3 = fmaf(a.w, x11, s3);
    a = *(const LAS f32x4*)(Am + 2052);
    s0 = fmaf(a.x, x12, s0);
    s1 = fmaf(a.y, x13, s1);
    s2 = fmaf(a.z, x14, s2);
    s3 = fmaf(a.w, x15, s3);
    a = *(const LAS f32x4*)(Am + 2056);
    s0 = fmaf(a.x, x16, s0);
    s1 = fmaf(a.y, x17, s1);
    s2 = fmaf(a.z, x18, s2);
    s3 = fmaf(a.w, x19, s3);
    a = *(const LAS f32x4*)(Am + 2060);
    s0 = fmaf(a.x, x20, s0);
    s1 = fmaf(a.y, x21, s1);
    s2 = fmaf(a.z, x22, s2);
    s3 = fmaf(a.w, x23, s3);
    a = *(const LAS f32x4*)(Am + 2064);
    s0 = fmaf(a.x, x24, s0);
    s1 = fmaf(a.y, x25, s1);
    s2 = fmaf(a.z, x26, s2);
    s3 = fmaf(a.w, x27, s3);
    a = *(const LAS f32x4*)(Am + 2068);
    s0 = fmaf(a.x, x28, s0);
    const float al30 = a.y;
    x30 = (x30 - ((s0 + s1) + (s2 + s3))) - al30 * x29;
    Tu[4080 + c] = f2bf(x30 * su); Tw[4080 + c] = f2bf(x30 * sw); asm volatile("" ::: "memory");
    float x31 = fmaxf(0.0f, 1.0f - fabsf(cf - 31.0f));
    s0 = 0.f; s1 = 0.f; s2 = 0.f; s3 = 0.f;
    a = *(const LAS f32x4*)(Am + 2108);
    s0 = fmaf(a.x, x0, s0);
    s1 = fmaf(a.y, x1, s1);
    s2 = fmaf(a.z, x2, s2);
    s3 = fmaf(a.w, x3, s3);
    a = *(const LAS f32x4*)(Am + 2112);
    s0 = fmaf(a.x, x4, s0);
    s1 = fmaf(a.y, x5, s1);
    s2 = fmaf(a.z, x6, s2);
    s3 = fmaf(a.w, x7, s3);
    a = *(const LAS f32x4*)(Am + 2116);
    s0 = fmaf(a.x, x8, s0);
    s1 = fmaf(a.y, x9, s1);
    s2 = fmaf(a.z, x10, s2);
    s3 = fmaf(a.w, x11, s3);
    a = *(const LAS f32x4*)(Am + 2120);
    s0 = fmaf(a.x, x12, s0);
    s1 = fmaf(a.y, x13, s1);
    s2 = fmaf(a.z, x14, s2);
    s3 = fmaf(a.w, x15, s3);
    a = *(const LAS f32x4*)(Am + 2124);
    s0 = fmaf(a.x, x16, s0);
    s1 = fmaf(a.y, x17, s1);
    s2 = fmaf(a.z, x18, s2);
    s3 = fmaf(a.w, x19, s3);
    a = *(const LAS f32x4*)(Am + 2128);
    s0 = fmaf(a.x, x20, s0);
    s1 = fmaf(a.y, x21, s1);
    s2 = fmaf(a.z, x22, s2);
    s3 = fmaf(a.w, x23, s3);
    a = *(const LAS f32x4*)(Am + 2132);
    s0 = fmaf(a.x, x24, s0);
    s1 = fmaf(a.y, x25, s1);
    s2 = fmaf(a.z, x26, s2);
    s3 = fmaf(a.w, x27, s3);
    a = *(const LAS f32x4*)(Am + 2136);
    s0 = fmaf(a.x, x28, s0);
    s1 = fmaf(a.y, x29, s1);
    const float al31 = a.z;
    x31 = (x31 - ((s0 + s1) + (s2 + s3))) - al31 * x30;
    Tu[4216 + c] = f2bf(x31 * su); Tw[4216 + c] = f2bf(x31 * sw); asm volatile("" ::: "memory");
    float x32 = fmaxf(0.0f, 1.0f - fabsf(cf - 32.0f));
    s0 = 0.f; s1 = 0.f; s2 = 0.f; s3 = 0.f;
    a = *(const LAS f32x4*)(Am + 2176);
    s0 = fmaf(a.x, x0, s0);
    s1 = fmaf(a.y, x1, s1);
    s2 = fmaf(a.z, x2, s2);
    s3 = fmaf(a.w, x3, s3);
    a = *(const LAS f32x4*)(Am + 2180);
    s0 = fmaf(a.x, x4, s0);
    s1 = fmaf(a.y, x5, s1);
    s2 = fmaf(a.z, x6, s2);
    s3 = fmaf(a.w, x7, s3);
    a = *(const LAS f32x4*)(Am + 2184);
    s0 = fmaf(a.x, x8, s0);
    s1 = fmaf(a.y, x9, s1);
    s2 = fmaf(a.z, x10, s2);
    s3 = fmaf(a.w, x11, s3);
    a = *(const LAS f32x4*)(Am + 2188);
    s0 = fmaf(a.x, x12, s0);
    s1 = fmaf(a.y, x13, s1);
    s2 = fmaf(a.z, x14, s2);
    s3 = fmaf(a.w, x15, s3);
    a = *(const LAS f32x4*)(Am + 2192);
    s0 = fmaf(a.x, x16, s0);
    s1 = fmaf(a.y, x17, s1);
    s2 = fmaf(a.z, x18, s2);
    s3 = fmaf(a.w, x19, s3);
    a = *(const LAS f32x4*)(Am + 2196);
    s0 = fmaf(a.x, x20, s0);
    s1 = fmaf(a.y, x21, s1);
    s2 = fmaf(a.z, x22, s2);
    s3 = fmaf(a.w, x23, s3);
    a = *(const LAS f32x4*)(Am + 2200);
    s0 = fmaf(a.x, x24, s0);
    s1 = fmaf(a.y, x25, s1);
    s2 = fmaf(a.z, x26, s2);
    s3 = fmaf(a.w, x27, s3);
    a = *(const LAS f32x4*)(Am + 2204);
    s0 = fmaf(a.x, x28, s0);
    s1 = fmaf(a.y, x29, s1);
    s2 = fmaf(a.z, x30, s2);
    const float al32 = a.w;
    x32 = (x32 - ((s0 + s1) + (s2 + s3))) - al32 * x31;
    Tu[4352 + c] = f2bf(x32 * su); Tw[4352 + c] = f2bf(x32 * sw); asm volatile("" ::: "memory");
    float x33 = fmaxf(0.0f, 1.0f - fabsf(cf - 33.0f));
    s0 = 0.f; s1 = 0.f; s2 = 0.f; s3 = 0.f;
    a = *(const LAS f32x4*)(Am + 2244);
    s0 = fmaf(a.x, x0, s0);
    s1 = fmaf(a.y, x1, s1);
    s2 = fmaf(a.z, x2, s2);
    s3 = fmaf(a.w, x3, s3);
    a = *(const LAS f32x4*)(Am + 2248);
    s0 = fmaf(a.x, x4, s0);
    s1 = fmaf(a.y, x5, s1);
    s2 = fmaf(a.z, x6, s2);
    s3 = fmaf(a.w, x7, s3);
    a = *(const LAS f32x4*)(Am + 2252);
    s0 = fmaf(a.x, x8, s0);
    s1 = fmaf(a.y, x9, s1);
    s2 = fmaf(a.z, x10, s2);
    s3 = fmaf(a.w, x11, s3);
    a = *(const LAS f32x4*)(Am + 2256);
    s0 = fmaf(a.x, x12, s0);
    s1 = fmaf(a.y, x13, s1);
    s2 = fmaf(a.z, x14, s2);
    s3 = fmaf(a.w, x15, s3);
    a = *(const LAS f32x4*)(Am + 2260);
    s0 = fmaf(a.x, x16, s0);
    s1 = fmaf(a.y, x17, s1);
    s2 = fmaf(a.z, x18, s2);
    s3 = fmaf(a.w, x19, s3);
    a = *(const LAS f32x4*)(Am + 2264);
    s0 = fmaf(a.x, x20, s0);
    s1 = fmaf(a.y, x21, s1);
    s2 = fmaf(a.z, x22, s2);
    s3 = fmaf(a.w, x23, s3);
    a = *(const LAS f32x4*)(Am + 2268);
    s0 = fmaf(a.x, x24, s0);
    s1 = fmaf(a.y, x25, s1);
    s2 = fmaf(a.z, x26, s2);
    s3 = fmaf(a.w, x27, s3);
    a = *(const LAS f32x4*)(Am + 2272);
    s0 = fmaf(a.x, x28, s0);
    s1 = fmaf(a.y, x29, s1);
    s2 = fmaf(a.z, x30, s2);
    s3 = fmaf(a.w, x31, s3);
    a = *(const LAS f32x4*)(Am + 2276);
    const float al33 = a.x;
    x33 = (x33 - ((s0 + s1) + (s2 + s3))) - al33 * x32;
    Tu[4488 + c] = f2bf(x33 * su); Tw[4488 + c] = f2bf(x33 * sw); asm volatile("" ::: "memory");
    float x34 = fmaxf(0.0f, 1.0f - fabsf(cf - 34.0f));
    s0 = 0.f; s1 = 0.f; s2 = 0.f; s3 = 0.f;
    a = *(const LAS f32x4*)(Am + 2312);
    s0 = fmaf(a.x, x0, s0);
    s1 = fmaf(a.y, x1, s1);
    s2 = fmaf(a.z, x2, s2);
    s3 = fmaf(a.w, x3, s3);
    a = *(const LAS f32x4*)(Am + 2316);
    s0 = fmaf(a.x, x4, s0);
    s1 = fmaf(a.y, x5, s1);
    s2 = fmaf(a.z, x6, s2);
    s3 = fmaf(a.w, x7, s3);
    a = *(const LAS f32x4*)(Am + 2320);
    s0 = fmaf(a.x, x8, s0);
    s1 = fmaf(a.y, x9, s1);
    s2 = fmaf(a.z, x10, s2);
    s3 = fmaf(a.w, x11, s3);
    a = *(const LAS f32x4*)(Am + 2324);
    s0 = fmaf(a.x, x12, s0);
    s1 = fmaf(a.y, x13, s1);
    s2 = fmaf(a.z, x14, s2);
    s3 = fmaf(a.w, x15, s3);
    a = *(const LAS f32x4*)(Am + 2328);
    s0 = fmaf(a.x, x16, s0);
    s1 = fmaf(a.y, x17, s1);
    s2 = fmaf(a.z, x18, s2);
    s3 = fmaf(a.w, x19, s3);
    a = *(const LAS f32x4*)(Am + 2332);
    s0 = fmaf(a.x, x20, s0);
    s1 = fmaf(a.y, x21, s1);
    s2 = fmaf(a.z, x22, s2);
    s3 = fmaf(a.w, x23, s3);
    a = *(const LAS f32x4*)(Am + 2336);
    s0 = fmaf(a.x, x24, s0);
    s1 = fmaf(a.y, x25, s1);
    s2 = fmaf(a.z, x26, s2);
    s3 = fmaf(a.w, x27, s3);
    a = *(const LAS f32x4*)(Am + 2340);
    s0 = fmaf(a.x, x28, s0);
    s1 = fmaf(a.y, x29, s1);
    s2 = fmaf(a.z, x30, s2);
    s3 = fmaf(a.w, x31, s3);
    a = *(const LAS f32x4*)(Am + 2344);
    s0 = fmaf(a.x, x32, s0);
    const float al34 = a.y;
    x34 = (x34 - ((s0 + s1) + (s2 + s3))) - al34 * x33;
    Tu[4624 + c] = f2bf(x34 * su); Tw[4624 + c] = f2bf(x34 * sw); asm volatile("" ::: "memory");
    float x35 = fmaxf(0.0f, 1.0f - fabsf(cf - 35.0f));
    s0 = 0.f; s1 = 0.f; s2 = 0.f; s3 = 0.f;
    a = *(const LAS f32x4*)(Am + 2380);
    s0 = fmaf(a.x, x0, s0);
    s1 = fmaf(a.y, x1, s1);
    s2 = fmaf(a.z, x2, s2);
    s3 = fmaf(a.w, x3, s3);
    a = *(const LAS f32x4*)(Am + 2384);
    s0 = fmaf(a.x, x4, s0);
    s1 = fmaf(a.y, x5, s1);
    s2 = fmaf(a.z, x6, s2);
    s3 = fmaf(a.w, x7, s3);
    a = *(const LAS f32x4*)(Am + 2388);
    s0 = fmaf(a.x, x8, s0);
    s1 = fmaf(a.y, x9, s1);
    s2 = fmaf(a.z, x10, s2);
    s3 = fmaf(a.w, x11, s3);
    a = *(const LAS f32x4*)(Am + 2392);
    s0 = fmaf(a.x, x12, s0);
    s1 = fmaf(a.y, x13, s1);
    s2 = fmaf(a.z, x14, s2);
    s3 = fmaf(a.w, x15, s3);
    a = *(const LAS f32x4*)(Am + 2396);
    s0 = fmaf(a.x, x16, s0);
    s1 = fmaf(a.y, x17, s1);
    s2 = fmaf(a.z, x18, s2);
    s3 = fmaf(a.w, x19, s3);
    a = *(const LAS f32x4*)(Am + 2400);
    s0 = fmaf(a.x, x20, s0);
    s1 = fmaf(a.y, x21, s1);
    s2 = fmaf(a.z, x22, s2);
    s3 = fmaf(a.w, x23, s3);
    a = *(const LAS f32x4*)(Am + 2404);
    s0 = fmaf(a.x, x24, s0);
    s1 = fmaf(a.y, x25, s1);
    s2 = fmaf(a.z, x26, s2);
    s3 = fmaf(a.w, x27, s3);
    a = *(const LAS f32x4*)(Am + 2408);
    s0 = fmaf(a.x, x28, s0);
    s1 = fmaf(a.y, x29, s1);
    s2 = fmaf(a.z, x30, s2);
    s3 = fmaf(a.w, x31, s3);
    a = *(const LAS f32x4*)(Am + 2412);
    s0 = fmaf(a.x, x32, s0);
    s1 = fmaf(a.y, x33, s1);
    const float al35 = a.z;
    x35 = (x35 - ((s0 + s1) + (s2 + s3))) - al35 * x34;
    Tu[4760 + c] = f2bf(x35 * su); Tw[4760 + c] = f2bf(x35 * sw); asm volatile("" ::: "memory");
    float x36 = fmaxf(0.0f, 1.0f - fabsf(cf - 36.0f));
    s0 = 0.f; s1 = 0.f; s2 = 0.f; s3 = 0.f;
    a = *(const LAS f32x4*)(Am + 2448);
    s0 = fmaf(a.x, x0, s0);
    s1 = fmaf(a.y, x1, s1);
    s2 = fmaf(a.z, x2, s2);
    s3 = fmaf(a.w, x3, s3);
    a = *(const LAS f32x4*)(Am + 2452);
    s0 = fmaf(a.x, x4, s0);
    s1 = fmaf(a.y, x5, s1);
    s2 = fmaf(a.z, x6, s2);
    s3 = fmaf(a.w, x7, s3);
    a = *(const LAS f32x4*)(Am + 2456);
    s0 = fmaf(a.x, x8, s0);
    s1 = fmaf(a.y, x9, s1);
    s2 = fmaf(a.z, x10, s2);
    s3 = fmaf(a.w, x11, s3);
    a = *(const LAS f32x4*)(Am + 2460);
    s0 = fmaf(a.x, x12, s0);
    s1 = fmaf(a.y, x13, s1);
    s2 = fmaf(a.z, x14, s2);
    s3 = fmaf(a.w, x15, s3);
    a = *(const LAS f32x4*)(Am + 2464);
    s0 = fmaf(a.x, x16, s0);
    s1 = fmaf(a.y, x17, s1);
    s2 = fmaf(a.z, x18, s2);
    s3 = fmaf(a.w, x19, s3);
    a = *(const LAS f32x4*)(Am + 2468);
    s0 = fmaf(a.x, x20, s0);
    s1 = fmaf(a.y, x21, s1);
    s2 = fmaf(a.z, x22, s2);
    s3 = fmaf(a.w, x23, s3);
    a = *(const LAS f32x4*)(Am + 2472);
    s0 = fmaf(a.x, x24, s0);
    s1 = fmaf(a.y, x25, s1);
    s2 = fmaf(a.z, x26, s2);
    s3 = fmaf(a.w, x27, s3);
    a = *(const LAS f32x4*)(Am + 2476);
    s0 = fmaf(a.x, x28, s0);
    s1 = fmaf(a.y, x29, s1);
    s2 = fmaf(a.z, x30, s2);
    s3 = fmaf(a.w, x31, s3);
    a = *(const LAS f32x4*)(Am + 2480);
    s0 = fmaf(a.x, x32, s0);
    s1 = fmaf(a.y, x33, s1);
    s2 = fmaf(a.z, x34, s2);
    const float al36 = a.w;
    x36 = (x36 - ((s0 + s1) + (s2 + s3))) - al36 * x35;
    Tu[4896 + c] = f2bf(x36 * su); Tw[4896 + c] = f2bf(x36 * sw); asm volatile("" ::: "memory");
    float x37 = fmaxf(0.0f, 1.0f - fabsf(cf - 37.0f));
    s0 = 0.f; s1 = 0.f; s2 = 0.f; s3 = 0.f;
    a = *(const LAS f32x4*)(Am + 2516);
    s0 = fmaf(a.x, x0, s0);
    s1 = fmaf(a.y, x1, s1);
    s2 = fmaf(a.z, x2, s2);
    s3 = fmaf(a.w, x3, s3);
    a = *(const LAS f32x4*)(Am + 2520);
    s0 = fmaf(a.x, x4, s0);
    s1 = fmaf(a.y, x5, s1);
    s2 = fmaf(a.z, x6, s2);
    s3 = fmaf(a.w, x7, s3);
    a = *(const LAS f32x4*)(Am + 2524);
    s0 = fmaf(a.x, x8, s0);
    s1 = fmaf(a.y, x9, s1);
    s2 = fmaf(a.z, x10, s2);
    s3 = fmaf(a.w, x11, s3);
    a = *(const LAS f32x4*)(Am + 2528);
    s0 = fmaf(a.x, x12, s0);
    s1 = fmaf(a.y, x13, s1);
    s2 = fmaf(a.z, x14, s2);
    s3 = fmaf(a.w, x15, s3);
    a = *(const LAS f32x4*)(Am + 2532);
    s0 = fmaf(a.x, x16, s0);
    s1 = fmaf(a.y, x17, s1);
    s2 = fmaf(a.z, x18, s2);
    s3 = fmaf(a.w, x19, s3);
    a = *(const LAS f32x4*)(Am + 2536);
    s0 = fmaf(a.x, x20, s0);
    s1 = fmaf(a.y, x21, s1);
    s2 = fmaf(a.z, x22, s2);
    s3 = fmaf(a.w, x23, s3);
    a = *(const LAS f32x4*)(Am + 2540);
    s0 = fmaf(a.x, x24, s0);
    s1 = fmaf(a.y, x25, s1);
    s2 = fmaf(a.z, x26, s2);
    s3 = fmaf(a.w, x27, s3);
    a = *(const LAS f32x4*)(Am + 2544);
    s0 = fmaf(a.x, x28, s0);
    s1 = fmaf(a.y, x29, s1);
    s2 = fmaf(a.z, x30, s2);
    s3 = fmaf(a.w, x31, s3);
    a = *(const LAS f32x4*)(Am + 2548);
    s0 = fmaf(a.x, x32, s0);
    s1 = fmaf(a.y, x33, s1);
    s2 = fmaf(a.z, x34, s2);
    s3 = fmaf(a.w, x35, s3);
    a = *(const LAS f32x4*)(Am + 2552);
    const float al37 = a.x;
    x37 = (x37 - ((s0 + s1) + (s2 + s3))) - al37 * x36;
    Tu[5032 + c] = f2bf(x37 * su); Tw[5032 + c] = f2bf(x37 * sw); asm volatile("" ::: "memory");
    float x38 = fmaxf(0.0f, 1.0f - fabsf(cf - 38.0f));
    s0 = 0.f; s1 = 0.f; s2 = 0.f; s3 = 0.f;
    a = *(const LAS f32x4*)(Am + 2584);
    s0 = fmaf(a.x, x0, s0);
    s1 = fmaf(a.y, x1, s1);
    s2 = fmaf(a.z, x2, s2);
    s3 = fmaf(a.w, x3, s3);
    a = *(const LAS f32x4*)(Am + 2588);
    s0 = fmaf(a.x, x4, s0);
    s1 = fmaf(a.y, x5, s1);
    s2 = fmaf(a.z, x6, s2);
    s3 = fmaf(a.w, x7, s3);
    a = *(const LAS f32x4*)(Am + 2592);
    s0 = fmaf(a.x, x8, s0);
    s1 = fmaf(a.y, x9, s1);
    s2 = fmaf(a.z, x10, s2);
    s3 = fmaf(a.w, x11, s3);
    a = *(const LAS f32x4*)(Am + 2596);
    s0 = fmaf(a.x, x12, s0);
    s1 = fmaf(a.y, x13, s1);
    s2 = fmaf(a.z, x14, s2);
    s3 = fmaf(a.w, x15, s3);
    a = *(const LAS f32x4*)(Am + 2600);
    s0 = fmaf(a.x, x16, s0);
    s1 = fmaf(a.y, x17, s1);
    s2 = fmaf(a.z, x18, s2);
    s3 = fmaf(a.w, x19, s3);
    a = *(const LAS f32x4*)(Am + 2604);
    s0 = fmaf(a.x, x20, s0);
    s1 = fmaf(a.y, x21, s1);
    s2 = fmaf(a.z, x22, s2);
    s3 = fmaf(a.w, x23, s3);
    a = *(const LAS f32x4*)(Am + 2608);
    s0 = fmaf(a.x, x24, s0);
    s1 = fmaf(a.y, x25, s1);
    s2 = fmaf(a.z, x26, s2);
    s3 = fmaf(a.w, x27, s3);
    a = *(const LAS f32x4*)(Am + 2612);
    s0 = fmaf(a.x, x28, s0);
    s1 = fmaf(a.y, x29, s1);
    s2 = fmaf(a.z, x30, s2);
    s3 = fmaf(a.w, x31, s3);
    a = *(const LAS f32x4*)(Am + 2616);
    s0 = fmaf(a.x, x32, s0);
    s1 = fmaf(a.y, x33, s1);
    s2 = fmaf(a.z, x34, s2);
    s3 = fmaf(a.w, x35, s3);
    a = *(const LAS f32x4*)(Am + 2620);
    s0 = fmaf(a.x, x36, s0);
    const float al38 = a.y;
    x38 = (x38 - ((s0 + s1) + (s2 + s3))) - al38 * x37;
    Tu[5168 + c] = f2bf(x38 * su); Tw[5168 + c] = f2bf(x38 * sw); asm volatile("" ::: "memory");
    float x39 = fmaxf(0.0f, 1.0f - fabsf(cf - 39.0f));
    s0 = 0.f; s1 = 0.f; s2 = 0.f; s3 = 0.f;
    a = *(const LAS f32x4*)(Am + 2652);
    s0 = fmaf(a.x, x0, s0);
    s1 = fmaf(a.y, x1, s1);
    s2 = fmaf(a.z, x2, s2);
    s3 = fmaf(a.w, x3, s3);
    a = *(const LAS f32x4*)(Am + 2656);
    s0 = fmaf(a.x, x4, s0);
    s1 = fmaf(a.y, x5, s1);
    s2 = fmaf(a.z, x6, s2);
    s3 = fmaf(a.w, x7, s3);
    a = *(const LAS f32x4*)(Am + 2660);
    s0 = fmaf(a.x, x8, s0);
    s1 = fmaf(a.y, x9, s1);
    s2 = fmaf(a.z, x10, s2);
    s3 = fmaf(a.w, x11, s3);
    a = *(const LAS f32x4*)(Am + 2664);
    s0 = fmaf(a.x, x12, s0);
    s1 = fmaf(a.y, x13, s1);
    s2 = fmaf(a.z, x14, s2);
    s3 = fmaf(a.w, x15, s3);
    a = *(const LAS f32x4*)(Am + 2668);
    s0 = fmaf(a.x, x16, s0);
    s1 = fmaf(a.y, x17, s1);
    s2 = fmaf(a.z, x18, s2);
    s3 = fmaf(a.w, x19, s3);
    a = *(const LAS f32x4*)(Am + 2672);
    s0 = fmaf(a.x, x20, s0);
    s1 = fmaf(a.y, x21, s1);
    s2 = fmaf(a.z, x22, s2);
    s3 = fmaf(a.w, x23, s3);
    a = *(const LAS f32x4*)(Am + 2676);
    s0 = fmaf(a.x, x24, s0);
    s1 = fmaf(a.y, x25, s1);
    s2 = fmaf(a.z, x26, s2);
    s3 = fmaf(a.w, x27, s3);
    a = *(const LAS f32x4*)(Am + 2680);
    s0 = fmaf(a.x, x28, s0);
    s1 = fmaf(a.y, x29, s1);
    s2 = fmaf(a.z, x30, s2);
    s3 = fmaf(a.w, x31, s3);
    a = *(const LAS f32x4*)(Am + 2684);
    s0 = fmaf(a.x, x32, s0);
    s1 = fmaf(a.y, x33, s1);
    s2 = fmaf(a.z, x34, s2);
    s3 = fmaf(a.w, x35, s3);
    a = *(const LAS f32x4*)(Am + 2688);
    s0 = fmaf(a.x, x36, s0);
    s1 = fmaf(a.y, x37, s1);
    const float al39 = a.z;
    x39 = (x39 - ((s0 + s1) + (s2 + s3))) - al39 * x38;
    Tu[5304 + c] = f2bf(x39 * su); Tw[5304 + c] = f2bf(x39 * sw); asm volatile("" ::: "memory");
    float x40 = fmaxf(0.0f, 1.0f - fabsf(cf - 40.0f));
    s0 = 0.f; s1 = 0.f; s2 = 0.f; s3 = 0.f;
    a = *(const LAS f32x4*)(Am + 2720);
    s0 = fmaf(a.x, x0, s0);
    s1 = fmaf(a.y, x1, s1);
    s2 = fmaf(a.z, x2, s2);
    s3 = fmaf(a.w, x3, s3);
    a = *(const LAS f32x4*)(Am + 2724);
    s0 = fmaf(a.x, x4, s0);
    s1 = fmaf(a.y, x5, s1);
    s2 = fmaf(a.z, x6, s2);
    s3 = fmaf(a.w, x7, s3);
    a = *(const LAS f32x4*)(Am + 2728);
    s0 = fmaf(a.x, x8, s0);
    s1 = fmaf(a.y, x9, s1);
    s2 = fmaf(a.z, x10, s2);
    s3 = fmaf(a.w, x11, s3);
    a = *(const LAS f32x4*)(Am + 2732);
    s0 = fmaf(a.x, x12, s0);
    s1 = fmaf(a.y, x13, s1);
    s2 = fmaf(a.z, x14, s2);
    s3 = fmaf(a.w, x15, s3);
    a = *(const LAS f32x4*)(Am + 2736);
    s0 = fmaf(a.x, x16, s0);
    s1 = fmaf(a.y, x17, s1);
    s2 = fmaf(a.z, x18, s2);
    s3 = fmaf(a.w, x19, s3);
    a = *(const LAS f32x4*)(Am + 2740);
    s0 = fmaf(a.x, x20, s0);
    s1 = fmaf(a.y, x21, s1);
    s2 = fmaf(a.z, x22, s2);
    s3 = fmaf(a.w, x23, s3);
    a = *(const LAS f32x4*)(Am + 2744);
    s0 = fmaf(a.x, x24, s0);
    s1 = fmaf(a.y, x25, s1);
    s2 = fmaf(a.z, x26, s2);
    s3 = fmaf(a.w, x27, s3);
    a = *(const LAS f32x4*)(Am + 2748);
    s0 = fmaf(a.x, x28, s0);
    s1 = fmaf(a.y, x29, s1);
    s2 = fmaf(a.z, x30, s2);
    s3 = fmaf(a.w, x31, s3);
    a = *(const LAS f32x4*)(Am + 2752);
    s0 = fmaf(a.x, x32, s0);
    s1 = fmaf(a.y, x33, s1);
    s2 = fmaf(a.z, x34, s2);
    s3 = fmaf(a.w, x35, s3);
    a = *(const LAS f32x4*)(Am + 2756);
    s0 = fmaf(a.x, x36, s0);
    s1 = fmaf(a.y, x37, s1);
    s2 = fmaf(a.z, x38, s2);
    const float al40 = a.w;
    x40 = (x40 - ((s0 + s1) + (s2 + s3))) - al40 * x39;
    Tu[5440 + c] = f2bf(x40 * su); Tw[5440 + c] = f2bf(x40 * sw); asm volatile("" ::: "memory");
    float x41 = fmaxf(0.0f, 1.0f - fabsf(cf - 41.0f));
    s0 = 0.f; s1 = 0.f; s2 = 0.f; s3 = 0.f;
    a = *(const LAS f32x4*)(Am + 2788);
    s0 = fmaf(a.x, x0, s0);
    s1 = fmaf(a.y, x1, s1);
    s2 = fmaf(a.z, x2, s2);
    s3 = fmaf(a.w, x3, s3);
    a = *(const LAS f32x4*)(Am + 2792);
    s0 = fmaf(a.x, x4, s0);
    s1 = fmaf(a.y, x5, s1);
    s2 = fmaf(a.z, x6, s2);
    s3 = fmaf(a.w, x7, s3);
    a = *(const LAS f32x4*)(Am + 2796);
    s0 = fmaf(a.x, x8, s0);
    s1 = fmaf(a.y, x9, s1);
    s2 = fmaf(a.z, x10, s2);
    s3 = fmaf(a.w, x11, s3);
    a = *(const LAS f32x4*)(Am + 2800);
    s0 = fmaf(a.x, x12, s0);
    s1 = fmaf(a.y, x13, s1);
    s2 = fmaf(a.z, x14, s2);
    s3 = fmaf(a.w, x15, s3);
    a = *(const LAS f32x4*)(Am + 2804);
    s0 = fmaf(a.x, x16, s0);
    s1 = fmaf(a.y, x17, s1);
    s2 = fmaf(a.z, x18, s2);
    s3 = fmaf(a.w, x19, s3);
    a = *(const LAS f32x4*)(Am + 2808);
    s0 = fmaf(a.x, x20, s0);
    s1 = fmaf(a.y, x21, s1);
    s2 = fmaf(a.z, x22, s2);
    s3 = fmaf(a.w, x23, s3);
    a = *(const LAS f32x4*)(Am + 2812);
    s0 = fmaf(a.x, x24, s0);
    s1 = fmaf(a.y, x25, s1);
    s2 = fmaf(a.z, x26, s2);
    s3 = fmaf(a.w, x27, s3);
    a = *(const LAS f32x4*)(Am + 2816);
    s0 = fmaf(a.x, x28, s0);
    s1 = fmaf(a.y, x29, s1);
    s2 = fmaf(a.z, x30, s2);
    s3 = fmaf(a.w, x31, s3);
    a = *(const LAS f32x4*)(Am + 2820);
    s0 = fmaf(a.x, x32, s0);
    s1 = fmaf(a.y, x33, s1);
    s2 = fmaf(a.z, x34, s2);
    s3 = fmaf(a.w, x35, s3);
    a = *(const LAS f32x4*)(Am + 2824);
    s0 = fmaf(a.x, x36, s0);
    s1 = fmaf(a.y, x37, s1);
    s2 = fmaf(a.z, x38, s2);
    s3 = fmaf(a.w, x39, s3);
    a = *(const LAS f32x4*)(Am + 2828);
    const float al41 = a.x;
    x41 = (x41 - ((s0 + s1) + (s2 + s3))) - al41 * x40;
    Tu[5576 + c] = f2bf(x41 * su); Tw[5576 + c] = f2bf(x41 * sw); asm volatile("" ::: "memory");
    float x42 = fmaxf(0.0f, 1.0f - fabsf(cf - 42.0f));
    s0 = 0.f; s1 = 0.f; s2 = 0.f; s3 = 0.f;
    a = *(const LAS f32x4*)(Am + 2856);
    s0 = fmaf(a.x, x0, s0);
    s1 = fmaf(a.y, x1, s1);
    s2 = fmaf(a.z, x2, s2);
    s3 = fmaf(a.w, x3, s3);
    a = *(const LAS f32x4*)(Am + 2860);
    s0 = fmaf(a.x, x4, s0);
    s1 = fmaf(a.y, x5, s1);
    s2 = fmaf(a.z, x6, s2);
    s3 = fmaf(a.w, x7, s3);
    a = *(const LAS f32x4*)(Am + 2864);
    s0 = fmaf(a.x, x8, s0);
    s1 = fmaf(a.y, x9, s1);
    s2 = fmaf(a.z, x10, s2);
    s3 = fmaf(a.w, x11, s3);
    a = *(const LAS f32x4*)(Am + 2868);
    s0 = fmaf(a.x, x12, s0);
    s1 = fmaf(a.y, x13, s1);
    s2 = fmaf(a.z, x14, s2);
    s3 = fmaf(a.w, x15, s3);
    a = *(const LAS f32x4*)(Am + 2872);
    s0 = fmaf(a.x, x16, s0);
    s1 = fmaf(a.y, x17, s1);
    s2 = fmaf(a.z, x18, s2);
    s3 = fmaf(a.w, x19, s3);
    a = *(const LAS f32x4*)(Am + 2876);
    s0 = fmaf(a.x, x20, s0);
    s1 = fmaf(a.y, x21, s1);
    s2 = fmaf(a.z, x22, s2);
    s3 = fmaf(a.w, x23, s3);
    a = *(const LAS f32x4*)(Am + 2880);
    s0 = fmaf(a.x, x24, s0);
    s1 = fmaf(a.y, x25, s1);
    s2 = fmaf(a.z, x26, s2);
    s3 = fmaf(a.w, x27, s3);
    a = *(const LAS f32x4*)(Am + 2884);
    s0 = fmaf(a.x, x28, s0);
    s1 = fmaf(a.y, x29, s1);
    s2 = fmaf(a.z, x30, s2);
    s3 = fmaf(a.w, x31, s3);
    a = *(const LAS f32x4*)(Am + 2888);
    s0 = fmaf(a.x, x32, s0);
    s1 = fmaf(a.y, x33, s1);
    s2 = fmaf(a.z, x34, s2);
    s3 = fmaf(a.w, x35, s3);
    a = *(const LAS f32x4*)(Am + 2892);
    s0 = fmaf(a.x, x36, s0);
    s1 = fmaf(a.y, x37, s1);
    s2 = fmaf(a.z, x38, s2);
    s3 = fmaf(a.w, x39, s3);
    a = *(const LAS f32x4*)(Am + 2896);
    s0 = fmaf(a.x, x40, s0);
    const float al42 = a.y;
    x42 = (x42 - ((s0 + s1) + (s2 + s3))) - al42 * x41;
    Tu[5712 + c] = f2bf(x42 * su); Tw[5712 + c] = f2bf(x42 * sw); asm volatile("" ::: "memory");
    float x43 = fmaxf(0.0f, 1.0f - fabsf(cf - 43.0f));
    s0 = 0.f; s1 = 0.f; s2 = 0.f; s3 = 0.f;
    a = *(const LAS f32x4*)(Am + 2924);
    s0 = fmaf(a.x, x0, s0);
    s1 = fmaf(a.y, x1, s1);
    s2 = fmaf(a.z, x2, s2);
    s3 = fmaf(a.w, x3, s3);
    a = *(const LAS f32x4*)(Am + 2928);
    s0 = fmaf(a.x, x4, s0);
    s1 = fmaf(a.y, x5, s1);
    s2 = fmaf(a.z, x6, s2);
    s3 = fmaf(a.w, x7, s3);
    a = *(const LAS f32x4*)(Am + 2932);
    s0 = fmaf(a.x, x8, s0);
    s1 = fmaf(a.y, x9, s1);
    s2 = fmaf(a.z, x10, s2);
    s3 = fmaf(a.w, x11, s3);
    a = *(const LAS f32x4*)(Am + 2936);
    s0 = fmaf(a.x, x12, s0);
    s1 = fmaf(a.y, x13, s1);
    s2 = fmaf(a.z, x14, s2);
    s3 = fmaf(a.w, x15, s3);
    a = *(const LAS f32x4*)(Am + 2940);
    s0 = fmaf(a.x, x16, s0);
    s1 = fmaf(a.y, x17, s1);
    s2 = fmaf(a.z, x18, s2);
    s3 = fmaf(a.w, x19, s3);
    a = *(const LAS f32x4*)(Am + 2944);
    s0 = fmaf(a.x, x20, s0);
    s1 = fmaf(a.y, x21, s1);
    s2 = fmaf(a.z, x22, s2);
    s3 = fmaf(a.w, x23, s3);
    a = *(const LAS f32x4*)(Am + 2948);
    s0 = fmaf(a.x, x24, s0);
    s1 = fmaf(a.y, x25, s1);
    s2 = fmaf(a.z, x26, s2);
    s3 = fmaf(a.w, x27, s3);
    a = *(const LAS f32x4*)(Am + 2952);
    s0 = fmaf(a.x, x28, s0);
    s1 = fmaf(a.y, x29, s1);
    s2 = fmaf(a.z, x30, s2);
    s3 = fmaf(a.w, x31, s3);
    a = *(const LAS f32x4*)(Am + 2956);
    s0 = fmaf(a.x, x32, s0);
    s1 = fmaf(a.y, x33, s1);
    s2 = fmaf(a.z, x34, s2);
    s3 = fmaf(a.w, x35, s3);
    a = *(const LAS f32x4*)(Am + 2960);
    s0 = fmaf(a.x, x36, s0);
    s1 = fmaf(a.y, x37, s1);
    s2 = fmaf(a.z, x38, s2);
    s3 = fmaf(a.w, x39, s3);
    a = *(const LAS f32x4*)(Am + 2964);
    s0 = fmaf(a.x, x40, s0);
    s1 = fmaf(a.y, x41, s1);
    const float al43 = a.z;
    x43 = (x43 - ((s0 + s1) + (s2 + s3))) - al43 * x42;
    Tu[5848 + c] = f2bf(x43 * su); Tw[5848 + c] = f2bf(x43 * sw); asm volatile("" ::: "memory");
    float x44 = fmaxf(0.0f, 1.0f - fabsf(cf - 44.0f));
    s0 = 0.f; s1 = 0.f; s2 = 0.f; s3 = 0.f;
    a = *(const LAS f32x4*)(Am + 2992);
    s0 = fmaf(a.x, x0, s0);
    s1 = fmaf(a.y, x1, s1);
    s2 = fmaf(a.z, x2, s2);
    s3 = fmaf(a.w, x3, s3);
    a = *(const LAS f32x4*)(Am + 2996);
    s0 = fmaf(a.x, x4, s0);
    s1 = fmaf(a.y, x5, s1);
    s2 = fmaf(a.z, x6, s2);
    s3 = fmaf(a.w, x7, s3);
    a = *(const LAS f32x4*)(Am + 3000);
    s0 = fmaf(a.x, x8, s0);
    s1 = fmaf(a.y, x9, s1);
    s2 = fmaf(a.z, x10, s2);
    s3 = fmaf(a.w, x11, s3);
    a = *(const LAS f32x4*)(Am + 3004);
    s0 = fmaf(a.x, x12, s0);
    s1 = fmaf(a.y, x13, s1);
    s2 = fmaf(a.z, x14, s2);
    s3 = fmaf(a.w, x15, s3);
    a = *(const LAS f32x4*)(Am + 3008);
    s0 = fmaf(a.x, x16, s0);
    s1 = fmaf(a.y, x17, s1);
    s2 = fmaf(a.z, x18, s2);
    s3 = fmaf(a.w, x19, s3);
    a = *(const LAS f32x4*)(Am + 3012);
    s0 = fmaf(a.x, x20, s0);
    s1 = fmaf(a.y, x21, s1);
    s2 = fmaf(a.z, x22, s2);
    s3 = fmaf(a.w, x23, s3);
    a = *(const LAS f32x4*)(Am + 3016);
    s0 = fmaf(a.x, x24, s0);
    s1 = fmaf(a.y, x25, s1);
    s2 = fmaf(a.z, x26, s2);
    s3 = fmaf(a.w, x27, s3);
    a = *(const LAS f32x4*)(Am + 3020);
    s0 = fmaf(a.x, x28, s0);
    s1 = fmaf(a.y, x29, s1);
    s2 = fmaf(a.z, x30, s2);
    s3 = fmaf(a.w, x31, s3);
    a = *(const LAS f32x4*)(Am + 3024);
    s0 = fmaf(a.x, x32, s0);
    s1 = fmaf(a.y, x33, s1);
    s2 = fmaf(a.z, x34, s2);
    s3 = fmaf(a.w, x35, s3);
    a = *(const LAS f32x4*)(Am + 3028);
    s0 = fmaf(a.x, x36, s0);
    s1 = fmaf(a.y, x37, s1);
    s2 = fmaf(a.z, x38, s2);
    s3 = fmaf(a.w, x39, s3);
    a = *(const LAS f32x4*)(Am + 3032);
    s0 = fmaf(a.x, x40, s0);
    s1 = fmaf(a.y, x41, s1);
    s2 = fmaf(a.z, x42, s2);
    const float al44 = a.w;
    x44 = (x44 - ((s0 + s1) + (s2 + s3))) - al44 * x43;
    Tu[5984 + c] = f2bf(x44 * su); Tw[5984 + c] = f2bf(x44 * sw); asm volatile("" ::: "memory");
    float x45 = fmaxf(0.0f, 1.0f - fabsf(cf - 45.0f));
    s0 = 0.f; s1 = 0.f; s2 = 0.f; s3 = 0.f;
    a = *(const LAS f32x4*)(Am + 3060);
    s0 = fmaf(a.x, x0, s0);
    s1 = fmaf(a.y, x1, s1);
    s2 = fmaf(a.z, x2, s2);
    s3 = fmaf(a.w, x3, s3);
    a = *(const LAS f32x4*)(Am + 3064);
    s0 = fmaf(a.x, x4, s0);
    s1 = fmaf(a.y, x5, s1);
    s2 = fmaf(a.z, x6, s2);
    s3 = fmaf(a.w, x7, s3);
    a = *(const LAS f32x4*)(Am + 3068);
    s0 = fmaf(a.x, x8, s0);
    s1 = fmaf(a.y, x9, s1);
    s2 = fmaf(a.z, x10, s2);
    s3 = fmaf(a.w, x11, s3);
    a = *(const LAS f32x4*)(Am + 3072);
    s0 = fmaf(a.x, x12, s0);
    s1 = fmaf(a.y, x13, s1);
    s2 = fmaf(a.z, x14, s2);
    s3 = fmaf(a.w, x15, s3);
    a = *(const LAS f32x4*)(Am + 3076);
    s0 = fmaf(a.x, x16, s0);
    s1 = fmaf(a.y, x17, s1);
    s2 = fmaf(a.z, x18, s2);
    s3 = fmaf(a.w, x19, s3);
    a = *(const LAS f32x4*)(Am + 3080);
    s0 = fmaf(a.x, x20, s0);
    s1 = fmaf(a.y, x21, s1);
    s2 = fmaf(a.z, x22, s2);
    s3 = fmaf(a.w, x23, s3);
    a = *(const LAS f32x4*)(Am + 3084);
    s0 = fmaf(a.x, x24, s0);
    s1 = fmaf(a.y, x25, s1);
    s2 = fmaf(a.z, x26, s2);
    s3 = fmaf(a.w, x27, s3);
    a = *(const LAS f32x4*)(Am + 3088);
    s0 = fmaf(a.x, x28, s0);
    s1 = fmaf(a.y, x29, s1);
    s2 = fmaf(a.z, x30, s2);
    s3 = fmaf(a.w, x31, s3);
    a = *(const LAS f32x4*)(Am + 3092);
    s0 = fmaf(a.x, x32, s0);
    s1 = fmaf(a.y, x33, s1);
    s2 = fmaf(a.z, x34, s2);
    s3 = fmaf(a.w, x35, s3);
    a = *(const LAS f32x4*)(Am + 3096);
    s0 = fmaf(a.x, x36, s0);
    s1 = fmaf(a.y, x37, s1);
    s2 = fmaf(a.z, x38, s2);
    s3 = fmaf(a.w, x39, s3);
    a = *(const LAS f32x4*)(Am + 3100);
    s0 = fmaf(a.x, x40, s0);
    s1 = fmaf(a.y, x41, s1);
    s2 = fmaf(a.z, x42, s2);
    s3 = fmaf(a.w, x43, s3);
    a = *(const LAS f32x4*)(Am + 3104);
    const float al45 = a.x;
    x45 = (x45 - ((s0 + s1) + (s2 + s3))) - al45 * x44;
    Tu[6120 + c] = f2bf(x45 * su); Tw[6120 + c] = f2bf(x45 * sw); asm volatile("" ::: "memory");
    float x46 = fmaxf(0.0f, 1.0f - fabsf(cf - 46.0f));
    s0 = 0.f; s1 = 0.f; s2 = 0.f; s3 = 0.f;
    a = *(const LAS f32x4*)(Am + 3128);
    s0 = fmaf(a.x, x0, s0);
    s1 = fmaf(a.y, x1, s1);
    s2 = fmaf(a.z, x2, s2);
    s3 = fmaf(a.w, x3, s3);
    a = *(const LAS f32x4*)(Am + 3132);
    s0 = fmaf(a.x, x4, s0);
    s1 = fmaf(a.y, x5, s1);
    s2 = fmaf(a.z, x6, s2);
    s3 = fmaf(a.w, x7, s3);
    a = *(const LAS f32x4*)(Am + 3136);
    s0 = fmaf(a.x, x8, s0);
    s1 = fmaf(a.y, x9, s1);
    s2 = fmaf(a.z, x10, s2);
    s3 = fmaf(a.w, x11, s3);
    a = *(const LAS f32x4*)(Am + 3140);
    s0 = fmaf(a.x, x12, s0);
    s1 = fmaf(a.y, x13, s1);
    s2 = fmaf(a.z, x14, s2);
    s3 = fmaf(a.w, x15, s3);
    a = *(const LAS f32x4*)(Am + 3144);
    s0 = fmaf(a.x, x16, s0);
    s1 = fmaf(a.y, x17, s1);
    s2 = fmaf(a.z, x18, s2);
    s3 = fmaf(a.w, x19, s3);
    a = *(const LAS f32x4*)(Am + 3148);
    s0 = fmaf(a.x, x20, s0);
    s1 = fmaf(a.y, x21, s1);
    s2 = fmaf(a.z, x22, s2);
    s3 = fmaf(a.w, x23, s3);
    a = *(const LAS f32x4*)(Am + 3152);
    s0 = fmaf(a.x, x24, s0);
    s1 = fmaf(a.y, x25, s1);
    s2 = fmaf(a.z, x26, s2);
    s3 = fmaf(a.w, x27, s3);
    a = *(const LAS f32x4*)(Am + 3156);
    s0 = fmaf(a.x, x28, s0);
    s1 = fmaf(a.y, x29, s1);
    s2 = fmaf(a.z, x30, s2);
    s3 = fmaf(a.w, x31, s3);
    a = *(const LAS f32x4*)(Am + 3160);
    s0 = fmaf(a.x, x32, s0);
    s1 = fmaf(a.y, x33, s1);
    s2 = fmaf(a.z, x34, s2);
    s3 = fmaf(a.w, x35, s3);
    a = *(const LAS f32x4*)(Am + 3164);
    s0 = fmaf(a.x, x36, s0);
    s1 = fmaf(a.y, x37, s1);
    s2 = fmaf(a.z, x38, s2);
    s3 = fmaf(a.w, x39, s3);
    a = *(const LAS f32x4*)(Am + 3168);
    s0 = fmaf(a.x, x40, s0);
    s1 = fmaf(a.y, x41, s1);
    s2 = fmaf(a.z, x42, s2);
    s3 = fmaf(a.w, x43, s3);
    a = *(const LAS f32x4*)(Am + 3172);
    s0 = fmaf(a.x, x44, s0);
    const float al46 = a.y;
    x46 = (x46 - ((s0 + s1) + (s2 + s3))) - al46 * x45;
    Tu[6256 + c] = f2bf(x46 * su); Tw[6256 + c] = f2bf(x46 * sw); asm volatile("" ::: "memory");
    float x47 = fmaxf(0.0f, 1.0f - fabsf(cf - 47.0f));
    s0 = 0.f; s1 = 0.f; s2 = 0.f; s3 = 0.f;
    a = *(const LAS f32x4*)(Am + 3196);
    s0 = fmaf(a.x, x0, s0);
    s1 = fmaf(a.y, x1, s1);
    s2 = fmaf(a.z, x2, s2);
    s3 = fmaf(a.w, x3, s3);
    a = *(const LAS f32x4*)(Am + 3200);
    s0 = fmaf(a.x, x4, s0);
    s1 = fmaf(a.y, x5, s1);
    s2 = fmaf(a.z, x6, s2);
    s3 = fmaf(a.w, x7, s3);
    a = *(const LAS f32x4*)(Am + 3204);
    s0 = fmaf(a.x, x8, s0);
    s1 = fmaf(a.y, x9, s1);
    s2 = fmaf(a.z, x10, s2);
    s3 = fmaf(a.w, x11, s3);
    a = *(const LAS f32x4*)(Am + 3208);
    s0 = fmaf(a.x, x12, s0);
    s1 = fmaf(a.y, x13, s1);
    s2 = fmaf(a.z, x14, s2);
    s3 = fmaf(a.w, x15, s3);
    a = *(const LAS f32x4*)(Am + 3212);
    s0 = fmaf(a.x, x16, s0);
    s1 = fmaf(a.y, x17, s1);
    s2 = fmaf(a.z, x18, s2);
    s3 = fmaf(a.w, x19, s3);
    a = *(const LAS f32x4*)(Am + 3216);
    s0 = fmaf(a.x, x20, s0);
    s1 = fmaf(a.y, x21, s1);
    s2 = fmaf(a.z, x22, s2);
    s3 = fmaf(a.w, x23, s3);
    a = *(const LAS f32x4*)(Am + 3220);
    s0 = fmaf(a.x, x24, s0);
    s1 = fmaf(a.y, x25, s1);
    s2 = fmaf(a.z, x26, s2);
    s3 = fmaf(a.w, x27, s3);
    a = *(const LAS f32x4*)(Am + 3224);
    s0 = fmaf(a.x, x28, s0);
    s1 = fmaf(a.y, x29, s1);
    s2 = fmaf(a.z, x30, s2);
    s3 = fmaf(a.w, x31, s3);
    a = *(const LAS f32x4*)(Am + 3228);
    s0 = fmaf(a.x, x32, s0);
    s1 = fmaf(a.y, x33, s1);
    s2 = fmaf(a.z, x34, s2);
    s3 = fmaf(a.w, x35, s3);
    a = *(const LAS f32x4*)(Am + 3232);
    s0 = fmaf(a.x, x36, s0);
    s1 = fmaf(a.y, x37, s1);
    s2 = fmaf(a.z, x38, s2);
    s3 = fmaf(a.w, x39, s3);
    a = *(const LAS f32x4*)(Am + 3236);
    s0 = fmaf(a.x, x40, s0);
    s1 = fmaf(a.y, x41, s1);
    s2 = fmaf(a.z, x42, s2);
    s3 = fmaf(a.w, x43, s3);
    a = *(const LAS f32x4*)(Am + 3240);
    s0 = fmaf(a.x, x44, s0);
    s1 = fmaf(a.y, x45, s1);
    const float al47 = a.z;
    x47 = (x47 - ((s0 + s1) + (s2 + s3))) - al47 * x46;
    Tu[6392 + c] = f2bf(x47 * su); Tw[6392 + c] = f2bf(x47 * sw); asm volatile("" ::: "memory");
    float x48 = fmaxf(0.0f, 1.0f - fabsf(cf - 48.0f));
    s0 = 0.f; s1 = 0.f; s2 = 0.f; s3 = 0.f;
    a = *(const LAS f32x4*)(Am + 3264);
    s0 = fmaf(a.x, x0, s0);
    s1 = fmaf(a.y, x1, s1);
    s2 = fmaf(a.z, x2, s2);
    s3 = fmaf(a.w, x3, s3);
    a = *(const LAS f32x4*)(Am + 3268);
    s0 = fmaf(a.x, x4, s0);
    s1 = fmaf(a.y, x5, s1);
    s2 = fmaf(a.z, x6, s2);
    s3 = fmaf(a.w, x7, s3);
    a = *(const LAS f32x4*)(Am + 3272);
    s0 = fmaf(a.x, x8, s0);
    s1 = fmaf(a.y, x9, s1);
    s2 = fmaf(a.z, x10, s2);
    s3 = fmaf(a.w, x11, s3);
    a = *(const LAS f32x4*)(Am + 3276);
    s0 = fmaf(a.x, x12, s0);
    s1 = fmaf(a.y, x13, s1);
    s2 = fmaf(a.z, x14, s2);
    s3 = fmaf(a.w, x15, s3);
    a = *(const LAS f32x4*)(Am + 3280);
    s0 = fmaf(a.x, x16, s0);
    s1 = fmaf(a.y, x17, s1);
    s2 = fmaf(a.z, x18, s2);
    s3 = fmaf(a.w, x19, s3);
    a = *(const LAS f32x4*)(Am + 3284);
    s0 = fmaf(a.x, x20, s0);
    s1 = fmaf(a.y, x21, s1);
    s2 = fmaf(a.z, x22, s2);
    s3 = fmaf(a.w, x23, s3);
    a = *(const LAS f32x4*)(Am + 3288);
    s0 = fmaf(a.x, x24, s0);
    s1 = fmaf(a.y, x25, s1);
    s2 = fmaf(a.z, x26, s2);
    s3 = fmaf(a.w, x27, s3);
    a = *(const LAS f32x4*)(Am + 3292);
    s0 = fmaf(a.x, x28, s0);
    s1 = fmaf(a.y, x29, s1);
    s2 = fmaf(a.z, x30, s2);
    s3 = fmaf(a.w, x31, s3);
    a = *(const LAS f32x4*)(Am + 3296);
    s0 = fmaf(a.x, x32, s0);
    s1 = fmaf(a.y, x33, s1);
    s2 = fmaf(a.z, x34, s2);
    s3 = fmaf(a.w, x35, s3);
    a = *(const LAS f32x4*)(Am + 3300);
    s0 = fmaf(a.x, x36, s0);
    s1 = fmaf(a.y, x37, s1);
    s2 = fmaf(a.z, x38, s2);
    s3 = fmaf(a.w, x39, s3);
    a = *(const LAS f32x4*)(Am + 3304);
    s0 = fmaf(a.x, x40, s0);
    s1 = fmaf(a.y, x41, s1);
    s2 = fmaf(a.z, x42, s2);
    s3 = fmaf(a.w, x43, s3);
    a = *(const LAS f32x4*)(Am + 3308);
    s0 = fmaf(a.x, x44, s0);
    s1 = fmaf(a.y, x45, s1);
    s2 = fmaf(a.z, x46, s2);
    const float al48 = a.w;
    x48 = (x48 - ((s0 + s1) + (s2 + s3))) - al48 * x47;
    Tu[6528 + c] = f2bf(x48 * su); Tw[6528 + c] = f2bf(x48 * sw); asm volatile("" ::: "memory");
    float x49 = fmaxf(0.0f, 1.0f - fabsf(cf - 49.0f));
    s0 = 0.f; s1 = 0.f; s2 = 0.f; s3 = 0.f;
    a = *(const LAS f32x4*)(Am + 3332);
    s0 = fmaf(a.x, x0, s0);
    s1 = fmaf(a.y, x1, s1);
    s2 = fmaf(a.z, x2, s2);
    s3 = fmaf(a.w, x3, s3);
    a = *(const LAS f32x4*)(Am + 3336);
    s0 = fmaf(a.x, x4, s0);
    s1 = fmaf(a.y, x5, s1);
    s2 = fmaf(a.z, x6, s2);
    s3 = fmaf(a.w, x7, s3);
    a = *(const LAS f32x4*)(Am + 3340);
    s0 = fmaf(a.x, x8, s0);
    s1 = fmaf(a.y, x9, s1);
    s2 = fmaf(a.z, x10, s2);
    s3 = fmaf(a.w, x11, s3);
    a = *(const LAS f32x4*)(Am + 3344);
    s0 = fmaf(a.x, x12, s0);
    s1 = fmaf(a.y, x13, s1);
    s2 = fmaf(a.z, x14, s2);
    s3 = fmaf(a.w, x15, s3);
    a = *(const LAS f32x4*)(Am + 3348);
    s0 = fmaf(a.x, x16, s0);
    s1 = fmaf(a.y, x17, s1);
    s2 = fmaf(a.z, x18, s2);
    s3 = fmaf(a.w, x19, s3);
    a = *(const LAS f32x4*)(Am + 3352);
    s0 = fmaf(a.x, x20, s0);
    s1 = fmaf(a.y, x21, s1);
    s2 = fmaf(a.z, x22, s2);
    s3 = fmaf(a.w, x23, s3);
    a = *(const LAS f32x4*)(Am + 3356);
    s0 = fmaf(a.x, x24, s0);
    s1 = fmaf(a.y, x25, s1);
    s2 = fmaf(a.z, x26, s2);
    s3 = fmaf(a.w, x27, s3);
    a = *(const LAS f32x4*)(Am + 3360);
    s0 = fmaf(a.x, x28, s0);
    s1 = fmaf(a.y, x29, s1);
    s2 = fmaf(a.z, x30, s2);
    s3 = fmaf(a.w, x31, s3);
    a = *(const LAS f32x4*)(Am + 3364);
    s0 = fmaf(a.x, x32, s0);
    s1 = fmaf(a.y, x33, s1);
    s2 = fmaf(a.z, x34, s2);
    s3 = fmaf(a.w, x35, s3);
    a = *(const LAS f32x4*)(Am + 3368);
    s0 = fmaf(a.x, x36, s0);
    s1 = fmaf(a.y, x37, s1);
    s2 = fmaf(a.z, x38, s2);
    s3 = fmaf(a.w, x39, s3);
    a = *(const LAS f32x4*)(Am + 3372);
    s0 = fmaf(a.x, x40, s0);
    s1 = fmaf(a.y, x41, s1);
    s2 = fmaf(a.z, x42, s2);
    s3 = fmaf(a.w, x43, s3);
    a = *(const LAS f32x4*)(Am + 3376);
    s0 = fmaf(a.x, x44, s0);
    s1 = fmaf(a.y, x45, s1);
    s2 = fmaf(a.z, x46, s2);
    s3 = fmaf(a.w, x47, s3);
    a = *(const LAS f32x4*)(Am + 3380);
    const float al49 = a.x;
    x49 = (x49 - ((s0 + s1) + (s2 + s3))) - al49 * x48;
    Tu[6664 + c] = f2bf(x49 * su); Tw[6664 + c] = f2bf(x49 * sw); asm volatile("" ::: "memory");
    float x50 = fmaxf(0.0f, 1.0f - fabsf(cf - 50.0f));
    s0 = 0.f; s1 = 0.f; s2 = 0.f; s3 = 0.f;
    a = *(const LAS f32x4*)(Am + 3400);
    s0 = fmaf(a.x, x0, s0);
    s1 = fmaf(a.y, x1, s1);
    s2 = fmaf(a.z, x2, s2);
    s3 = fmaf(a.w, x3, s3);
    a = *(const LAS f32x4*)(Am + 3404);
    s0 = fmaf(a.x, x4, s0);
    s1 = fmaf(a.y, x5, s1);
    s2 = fmaf(a.z, x6, s2);
    s3 = fmaf(a.w, x7, s3);
    a = *(const LAS f32x4*)(Am + 3408);
    s0 = fmaf(a.x, x8, s0);
    s1 = fmaf(a.y, x9, s1);
    s2 = fmaf(a.z, x10, s2);
    s3 = fmaf(a.w, x11, s3);
    a = *(const LAS f32x4*)(Am + 3412);
    s0 = fmaf(a.x, x12, s0);
    s1 = fmaf(a.y, x13, s1);
    s2 = fmaf(a.z, x14, s2);
    s3 = fmaf(a.w, x15, s3);
    a = *(const LAS f32x4*)(Am + 3416);
    s0 = fmaf(a.x, x16, s0);
    s1 = fmaf(a.y, x17, s1);
    s2 = fmaf(a.z, x18, s2);
    s3 = fmaf(a.w, x19, s3);
    a = *(const LAS f32x4*)(Am + 3420);
    s0 = fmaf(a.x, x20, s0);
    s1 = fmaf(a.y, x21, s1);
    s2 = fmaf(a.z, x22, s2);
    s3 = fmaf(a.w, x23, s3);
    a = *(const LAS f32x4*)(Am + 3424);
    s0 = fmaf(a.x, x24, s0);
    s1 = fmaf(a.y, x25, s1);
    s2 = fmaf(a.z, x26, s2);
    s3 = fmaf(a.w, x27, s3);
    a = *(const LAS f32x4*)(Am + 3428);
    s0 = fmaf(a.x, x28, s0);
    s1 = fmaf(a.y, x29, s1);
    s2 = fmaf(a.z, x30, s2);
    s3 = fmaf(a.w, x31, s3);
    a = *(const LAS f32x4*)(Am + 3432);
    s0 = fmaf(a.x, x32, s0);
    s1 = fmaf(a.y, x33, s1);
    s2 = fmaf(a.z, x34, s2);
    s3 = fmaf(a.w, x35, s3);
    a = *(const LAS f32x4*)(Am + 3436);
    s0 = fmaf(a.x, x36, s0);
    s1 = fmaf(a.y, x37, s1);
    s2 = fmaf(a.z, x38, s2);
    s3 = fmaf(a.w, x39, s3);
    a = *(const LAS f32x4*)(Am + 3440);
    s0 = fmaf(a.x, x40, s0);
    s1 = fmaf(a.y, x41, s1);
    s2 = fmaf(a.z, x42, s2);
    s3 = fmaf(a.w, x43, s3);
    a = *(const LAS f32x4*)(Am + 3444);
    s0 = fmaf(a.x, x44, s0);
    s1 = fmaf(a.y, x45, s1);
    s2 = fmaf(a.z, x46, s2);
    s3 = fmaf(a.w, x47, s3);
    a = *(const LAS f32x4*)(Am + 3448);
    s0 = fmaf(a.x, x48, s0);
    const float al50 = a.y;
    x50 = (x50 - ((s0 + s1) + (s2 + s3))) - al50 * x49;
    Tu[6800 + c] = f2bf(x50 * su); Tw[6800 + c] = f2bf(x50 * sw); asm volatile("" ::: "memory");
    float x51 = fmaxf(0.0f, 1.0f - fabsf(cf - 51.0f));
    s0 = 0.f; s1 = 0.f; s2 = 0.f; s3 = 0.f;
    a = *(const LAS f32x4*)(Am + 3468);
    s0 = fmaf(a.x, x0, s0);
    s1 = fmaf(a.y, x1, s1);
    s2 = fmaf(a.z, x2, s2);
    s3 = fmaf(a.w, x3, s3);
    a = *(const LAS f32x4*)(Am + 3472);
    s0 = fmaf(a.x, x4, s0);
    s1 = fmaf(a.y, x5, s1);
    s2 = fmaf(a.z, x6, s2);
    s3 = fmaf(a.w, x7, s3);
    a = *(const LAS f32x4*)(Am + 3476);
    s0 = fmaf(a.x, x8, s0);
    s1 = fmaf(a.y, x9, s1);
    s2 = fmaf(a.z, x10, s2);
    s3 = fmaf(a.w, x11, s3);
    a = *(const LAS f32x4*)(Am + 3480);
    s0 = fmaf(a.x, x12, s0);
    s1 = fmaf(a.y, x13, s1);
    s2 = fmaf(a.z, x14, s2);
    s3 = fmaf(a.w, x15, s3);
    a = *(const LAS f32x4*)(Am + 3484);
    s0 = fmaf(a.x, x16, s0);
    s1 = fmaf(a.y, x17, s1);
    s2 = fmaf(a.z, x18, s2);
    s3 = fmaf(a.w, x19, s3);
    a = *(const LAS f32x4*)(Am + 3488);
    s0 = fmaf(a.x, x20, s0);
    s1 = fmaf(a.y, x21, s1);
    s2 = fmaf(a.z, x22, s2);
    s3 = fmaf(a.w, x23, s3);
    a = *(const LAS f32x4*)(Am + 3492);
    s0 = fmaf(a.x, x24, s0);
    s1 = fmaf(a.y, x25, s1);
    s2 = fmaf(a.z, x26, s2);
    s3 = fmaf(a.w, x27, s3);
    a = *(const LAS f32x4*)(Am + 3496);
    s0 = fmaf(a.x, x28, s0);
    s1 = fmaf(a.y, x29, s1);
    s2 = fmaf(a.z, x30, s2);
    s3 = fmaf(a.w, x31, s3);
    a = *(const LAS f32x4*)(Am + 3500);
    s0 = fmaf(a.x, x32, s0);
    s1 = fmaf(a.y, x33, s1);
    s2 = fmaf(a.z, x34, s2);
    s3 = fmaf(a.w, x35, s3);
    a = *(const LAS f32x4*)(Am + 3504);
    s0 = fmaf(a.x, x36, s0);
    s1 = fmaf(a.y, x37, s1);
    s2 = fmaf(a.z, x38, s2);
    s3 = fmaf(a.w, x39, s3);
    a = *(const LAS f32x4*)(Am + 3508);
    s0 = fmaf(a.x, x40, s0);
    s1 = fmaf(a.y, x41, s1);
    s2 = fmaf(a.z, x42, s2);
    s3 = fmaf(a.w, x43, s3);
    a = *(const LAS f32x4*)(Am + 3512);
    s0 = fmaf(a.x, x44, s0);
    s1 = fmaf(a.y, x45, s1);
    s2 = fmaf(a.z, x46, s2);
    s3 = fmaf(a.w, x47, s3);
    a = *(const LAS f32x4*)(Am + 3516);
    s0 = fmaf(a.x, x48, s0);
    s1 = fmaf(a.y, x49, s1);
    const float al51 = a.z;
    x51 = (x51 - ((s0 + s1) + (s2 + s3))) - al51 * x50;
    Tu[6936 + c] = f2bf(x51 * su); Tw[6936 + c] = f2bf(x51 * sw); asm volatile("" ::: "memory");
    float x52 = fmaxf(0.0f, 1.0f - fabsf(cf - 52.0f));
    s0 = 0.f; s1 = 0.f; s2 = 0.f; s3 = 0.f;
    a = *(const LAS f32x4*)(Am + 3536);
    s0 = fmaf(a.x, x0, s0);
    s1 = fmaf(a.y, x1, s1);
    s2 = fmaf(a.z, x2, s2);
    s3 = fmaf(a.w, x3, s3);
    a = *(const LAS f32x4*)(Am + 3540);
    s0 = fmaf(a.x, x4, s0);
    s1 = fmaf(a.y, x5, s1);
    s2 = fmaf(a.z, x6, s2);
    s3 = fmaf(a.w, x7, s3);
    a = *(const LAS f32x4*)(Am + 3544);
    s0 = fmaf(a.x, x8, s0);
    s1 = fmaf(a.y, x9, s1);
    s2 = fmaf(a.z, x10, s2);
    s3 = fmaf(a.w, x11, s3);
    a = *(const LAS f32x4*)(Am + 3548);
    s0 = fmaf(a.x, x12, s0);
    s1 = fmaf(a.y, x13, s1);
    s2 = fmaf(a.z, x14, s2);
    s3 = fmaf(a.w, x15, s3);
    a = *(const LAS f32x4*)(Am + 3552);
    s0 = fmaf(a.x, x16, s0);
    s1 = fmaf(a.y, x17, s1);
    s2 = fmaf(a.z, x18, s2);
    s3 = fmaf(a.w, x19, s3);
    a = *(const LAS f32x4*)(Am + 3556);
    s0 = fmaf(a.x, x20, s0);
    s1 = fmaf(a.y, x21, s1);
    s2 = fmaf(a.z, x22, s2);
    s3 = fmaf(a.w, x23, s3);
    a = *(const LAS f32x4*)(Am + 3560);
    s0 = fmaf(a.x, x24, s0);
    s1 = fmaf(a.y, x25, s1);
    s2 = fmaf(a.z, x26, s2);
    s3 = fmaf(a.w, x27, s3);
    a = *(const LAS f32x4*)(Am + 3564);
    s0 = fmaf(a.x, x28, s0);
    s1 = fmaf(a.y, x29, s1);
    s2 = fmaf(a.z, x30, s2);
    s3 = fmaf(a.w, x31, s3);
    a = *(const LAS f32x4*)(Am + 3568);
    s0 = fmaf(a.x, x32, s0);
    s1 = fmaf(a.y, x33, s1);
    s2 = fmaf(a.z, x34, s2);
    s3 = fmaf(a.w, x35, s3);
    a = *(const LAS f32x4*)(Am + 3572);
    s0 = fmaf(a.x, x36, s0);
    s1 = fmaf(a.y, x37, s1);
    s2 = fmaf(a.z, x38, s2);
    s3 = fmaf(a.w, x39, s3);
    a = *(const LAS f32x4*)(Am + 3576);
    s0 = fmaf(a.x, x40, s0);
    s1 = fmaf(a.y, x41, s1);
    s2 = fmaf(a.z, x42, s2);
    s3 = fmaf(a.w, x43, s3);
    a = *(const LAS f32x4*)(Am + 3580);
    s0 = fmaf(a.x, x44, s0);
    s1 = fmaf(a.y, x45, s1);
    s2 = fmaf(a.z, x46, s2);
    s3 = fmaf(a.w, x47, s3);
    a = *(const LAS f32x4*)(Am + 3584);
    s0 = fmaf(a.x, x48, s0);
    s1 = fmaf(a.y, x49, s1);
    s2 = fmaf(a.z, x50, s2);
    const float al52 = a.w;
    x52 = (x52 - ((s0 + s1) + (s2 + s3))) - al52 * x51;
    Tu[7072 + c] = f2bf(x52 * su); Tw[7072 + c] = f2bf(x52 * sw); asm volatile("" ::: "memory");
    float x53 = fmaxf(0.0f, 1.0f - fabsf(cf - 53.0f));
    s0 = 0.f; s1 = 0.f; s2 = 0.f; s3 = 0.f;
    a = *(const LAS f32x4*)(Am + 3604);
    s0 = fmaf(a.x, x0, s0);
    s1 = fmaf(a.y, x1, s1);
    s2 = fmaf(a.z, x2, s2);
    s3 = fmaf(a.w, x3, s3);
    a = *(const LAS f32x4*)(Am + 3608);
    s0 = fmaf(a.x, x4, s0);
    s1 = fmaf(a.y, x5, s1);
    s2 = fmaf(a.z, x6, s2);
    s3 = fmaf(a.w, x7, s3);
    a = *(const LAS f32x4*)(Am + 3612);
    s0 = fmaf(a.x, x8, s0);
    s1 = fmaf(a.y, x9, s1);
    s2 = fmaf(a.z, x10, s2);
    s3 = fmaf(a.w, x11, s3);
    a = *(const LAS f32x4*)(Am + 3616);
    s0 = fmaf(a.x, x12, s0);
    s1 = fmaf(a.y, x13, s1);
    s2 = fmaf(a.z, x14, s2);
    s3 = fmaf(a.w, x15, s3);
    a = *(const LAS f32x4*)(Am + 3620);
    s0 = fmaf(a.x, x16, s0);
    s1 = fmaf(a.y, x17, s1);
    s2 = fmaf(a.z, x18, s2);
    s3 = fmaf(a.w, x19, s3);
    a = *(const LAS f32x4*)(Am + 3624);
    s0 = fmaf(a.x, x20, s0);
    s1 = fmaf(a.y, x21, s1);
    s2 = fmaf(a.z, x22, s2);
    s3 = fmaf(a.w, x23, s3);
    a = *(const LAS f32x4*)(Am + 3628);
    s0 = fmaf(a.x, x24, s0);
    s1 = fmaf(a.y, x25, s1);
    s2 = fmaf(a.z, x26, s2);
    s3 = fmaf(a.w, x27, s3);
    a = *(const LAS f32x4*)(Am + 3632);
    s0 = fmaf(a.x, x28, s0);
    s1 = fmaf(a.y, x29, s1);
    s2 = fmaf(a.z, x30, s2);
    s3 = fmaf(a.w, x31, s3);
    a = *(const LAS f32x4*)(Am + 3636);
    s0 = fmaf(a.x, x32, s0);
    s1 = fmaf(a.y, x33, s1);
    s2 = fmaf(a.z, x34, s2);
    s3 = fmaf(a.w, x35, s3);
    a = *(const LAS f32x4*)(Am + 3640);
    s0 = fmaf(a.x, x36, s0);
    s1 = fmaf(a.y, x37, s1);
    s2 = fmaf(a.z, x38, s2);
    s3 = fmaf(a.w, x39, s3);
    a = *(const LAS f32x4*)(Am + 3644);
    s0 = fmaf(a.x, x40, s0);
    s1 = fmaf(a.y, x41, s1);
    s2 = fmaf(a.z, x42, s2);
    s3 = fmaf(a.w, x43, s3);
    a = *(const LAS f32x4*)(Am + 3648);
    s0 = fmaf(a.x, x44, s0);
    s1 = fmaf(a.y, x45, s1);
    s2 = fmaf(a.z, x46, s2);
    s3 = fmaf(a.w, x47, s3);
    a = *(const LAS f32x4*)(Am + 3652);
    s0 = fmaf(a.x, x48, s0);
    s1 = fmaf(a.y, x49, s1);
    s2 = fmaf(a.z, x50, s2);
    s3 = fmaf(a.w, x51, s3);
    a = *(const LAS f32x4*)(Am + 3656);
    const float al53 = a.x;
    x53 = (x53 - ((s0 + s1) + (s2 + s3))) - al53 * x52;
    Tu[7208 + c] = f2bf(x53 * su); Tw[7208 + c] = f2bf(x53 * sw); asm volatile("" ::: "memory");
    float x54 = fmaxf(0.0f, 1.0f - fabsf(cf - 54.0f));
    s0 = 0.f; s1 = 0.f; s2 = 0.f; s3 = 0.f;
    a = *(const LAS f32x4*)(Am + 3672);
    s0 = fmaf(a.x, x0, s0);
    s1 = fmaf(a.y, x1, s1);
    s2 = fmaf(a.z, x2, s2);
    s3 = fmaf(a.w, x3, s3);
    a = *(const LAS f32x4*)(Am + 3676);
    s0 = fmaf(a.x, x4, s0);
    s1 = fmaf(a.y, x5, s1);
    s2 = fmaf(a.z, x6, s2);
    s3 = fmaf(a.w, x7, s3);
    a = *(const LAS f32x4*)(Am + 3680);
    s0 = fmaf(a.x, x8, s0);
    s1 = fmaf(a.y, x9, s1);
    s2 = fmaf(a.z, x10, s2);
    s3 = fmaf(a.w, x11, s3);
    a = *(const LAS f32x4*)(Am + 3684);
    s0 = fmaf(a.x, x12, s0);
    s1 = fmaf(a.y, x13, s1);
    s2 = fmaf(a.z, x14, s2);
    s3 = fmaf(a.w, x15, s3);
    a = *(const LAS f32x4*)(Am + 3688);
    s0 = fmaf(a.x, x16, s0);
    s1 = fmaf(a.y, x17, s1);
    s2 = fmaf(a.z, x18, s2);
    s3 = fmaf(a.w, x19, s3);
    a = *(const LAS f32x4*)(Am + 3692);
    s0 = fmaf(a.x, x20, s0);
    s1 = fmaf(a.y, x21, s1);
    s2 = fmaf(a.z, x22, s2);
    s3 = fmaf(a.w, x23, s3);
    a = *(const LAS f32x4*)(Am + 3696);
    s0 = fmaf(a.x, x24, s0);
    s1 = fmaf(a.y, x25, s1);
    s2 = fmaf(a.z, x26, s2);
    s3 = fmaf(a.w, x27, s3);
    a = *(const LAS f32x4*)(Am + 3700);
    s0 = fmaf(a.x, x28, s0);
    s1 = fmaf(a.y, x29, s1);
    s2 = fmaf(a.z, x30, s2);
    s3 = fmaf(a.w, x31, s3);
    a = *(const LAS f32x4*)(Am + 3704);
    s0 = fmaf(a.x, x32, s0);
    s1 = fmaf(a.y, x33, s1);
    s2 = fmaf(a.z, x34, s2);
    s3 = fmaf(a.w, x35, s3);
    a = *(const LAS f32x4*)(Am + 3708);
    s0 = fmaf(a.x, x36, s0);
    s1 = fmaf(a.y, x37, s1);
    s2 = fmaf(a.z, x38, s2);
    s3 = fmaf(a.w, x39, s3);
    a = *(const LAS f32x4*)(Am + 3712);
    s0 = fmaf(a.x, x40, s0);
    s1 = fmaf(a.y, x41, s1);
    s2 = fmaf(a.z, x42, s2);
    s3 = fmaf(a.w, x43, s3);
    a = *(const LAS f32x4*)(Am + 3716);
    s0 = fmaf(a.x, x44, s0);
    s1 = fmaf(a.y, x45, s1);
    s2 = fmaf(a.z, x46, s2);
    s3 = fmaf(a.w, x47, s3);
    a = *(const LAS f32x4*)(Am + 3720);
    s0 = fmaf(a.x, x48, s0);
    s1 = fmaf(a.y, x49, s1);
    s2 = fmaf(a.z, x50, s2);
    s3 = fmaf(a.w, x51, s3);
    a = *(const LAS f32x4*)(Am + 3724);
    s0 = fmaf(a.x, x52, s0);
    const float al54 = a.y;
    x54 = (x54 - ((s0 + s1) + (s2 + s3))) - al54 * x53;
    Tu[7344 + c] = f2bf(x54 * su); Tw[7344 + c] = f2bf(x54 * sw); asm volatile("" ::: "memory");
    float x55 = fmaxf(0.0f, 1.0f - fabsf(cf - 55.0f));
    s0 = 0.f; s1 = 0.f; s2 = 0.f; s3 = 0.f;
    a = *(const LAS f32x4*)(Am + 3740);
    s0 = fmaf(a.x, x0, s0);
    s1 = fmaf(a.y, x1, s1);
    s2 = fmaf(a.z, x2, s2);
    s3 = fmaf(a.w, x3, s3);
    a = *(const LAS f32x4*)(Am + 3744);
    s0 = fmaf(a.x, x4, s0);
    s1 = fmaf(a.y, x5, s1);
    s2 = fmaf(a.z, x6, s2);
    s3 = fmaf(a.w, x7, s3);
    a = *(const LAS f32x4*)(Am + 3748);
    s0 = fmaf(a.x, x8, s0);
    s1 = fmaf(a.y, x9, s1);
    s2 = fmaf(a.z, x10, s2);
    s3 = fmaf(a.w, x11, s3);
    a = *(const LAS f32x4*)(Am + 3752);
    s0 = fmaf(a.x, x12, s0);
    s1 = fmaf(a.y, x13, s1);
    s2 = fmaf(a.z, x14, s2);
    s3 = fmaf(a.w, x15, s3);
    a = *(const LAS f32x4*)(Am + 3756);
    s0 = fmaf(a.x, x16, s0);
    s1 = fmaf(a.y, x17, s1);
    s2 = fmaf(a.z, x18, s2);
    s3 = fmaf(a.w, x19, s3);
    a = *(const LAS f32x4*)(Am + 3760);
    s0 = fmaf(a.x, x20, s0);
    s1 = fmaf(a.y, x21, s1);
    s2 = fmaf(a.z, x22, s2);
    s3 = fmaf(a.w, x23, s3);
    a = *(const LAS f32x4*)(Am + 3764);
    s0 = fmaf(a.x, x24, s0);
    s1 = fmaf(a.y, x25, s1);
    s2 = fmaf(a.z, x26, s2);
    s3 = fmaf(a.w, x27, s3);
    a = *(const LAS f32x4*)(Am + 3768);
    s0 = fmaf(a.x, x28, s0);
    s1 = fmaf(a.y, x29, s1);
    s2 = fmaf(a.z, x30, s2);
    s3 = fmaf(a.w, x31, s3);
    a = *(const LAS f32x4*)(Am + 3772);
    s0 = fmaf(a.x, x32, s0);
    s1 = fmaf(a.y, x33, s1);
    s2 = fmaf(a.z, x34, s2);
    s3 = fmaf(a.w, x35, s3);
    a = *(const LAS f32x4*)(Am + 3776);
    s0 = fmaf(a.x, x36, s0);
    s1 = fmaf(a.y, x37, s1);
    s2 = fmaf(a.z, x38, s2);
    s3 = fmaf(a.w, x39, s3);
    a = *(const LAS f32x4*)(Am + 3780);
    s0 = fmaf(a.x, x40, s0);
    s1 = fmaf(a.y, x41, s1);
    s2 = fmaf(a.z, x42, s2);
    s3 = fmaf(a.w, x43, s3);
    a = *(const LAS f32x4*)(Am + 3784);
    s0 = fmaf(a.x, x44, s0);
    s1 = fmaf(a.y, x45, s1);
    s2 = fmaf(a.z, x46, s2);
    s3 = fmaf(a.w, x47, s3);
    a = *(const LAS f32x4*)(Am + 3788);
    s0 = fmaf(a.x, x48, s0);
    s1 = fmaf(a.y, x49, s1);
    s2 = fmaf(a.z, x50, s2);
    s3 = fmaf(a.w, x51, s3);
    a = *(const LAS f32x4*)(Am + 3792);
    s0 = fmaf(a.x, x52, s0);
    s1 = fmaf(a.y, x53, s1);
    const float al55 = a.z;
    x55 = (x55 - ((s0 + s1) + (s2 + s3))) - al55 * x54;
    Tu[7480 + c] = f2bf(x55 * su); Tw[7480 + c] = f2bf(x55 * sw); asm volatile("" ::: "memory");
    float x56 = fmaxf(0.0f, 1.0f - fabsf(cf - 56.0f));
    s0 = 0.f; s1 = 0.f; s2 = 0.f; s3 = 0.f;
    a = *(const LAS f32x4*)(Am + 3808);
    s0 = fmaf(a.x, x0, s0);
    s1 = fmaf(a.y, x1, s1);
    s2 = fmaf(a.z, x2, s2);
    s3 = fmaf(a.w, x3, s3);
    a = *(const LAS f32x4*)(Am + 3812);
    s0 = fmaf(a.x, x4, s0);
    s1 = fmaf(a.y, x5, s1);
    s2 = fmaf(a.z, x6, s2);
    s3 = fmaf(a.w, x7, s3);
    a = *(const LAS f32x4*)(Am + 3816);
    s0 = fmaf(a.x, x8, s0);
    s1 = fmaf(a.y, x9, s1);
    s2 = fmaf(a.z, x10, s2);
    s3 = fmaf(a.w, x11, s3);
    a = *(const LAS f32x4*)(Am + 3820);
    s0 = fmaf(a.x, x12, s0);
    s1 = fmaf(a.y, x13, s1);
    s2 = fmaf(a.z, x14, s2);
    s3 = fmaf(a.w, x15, s3);
    a = *(const LAS f32x4*)(Am + 3824);
    s0 = fmaf(a.x, x16, s0);
    s1 = fmaf(a.y, x17, s1);
    s2 = fmaf(a.z, x18, s2);
    s3 = fmaf(a.w, x19, s3);
    a = *(const LAS f32x4*)(Am + 3828);
    s0 = fmaf(a.x, x20, s0);
    s1 = fmaf(a.y, x21, s1);
    s2 = fmaf(a.z, x22, s2);
    s3 = fmaf(a.w, x23, s3);
    a = *(const LAS f32x4*)(Am + 3832);
    s0 = fmaf(a.x, x24, s0);
    s1 = fmaf(a.y, x25, s1);
    s2 = fmaf(a.z, x26, s2);
    s3 = fmaf(a.w, x27, s3);
    a = *(const LAS f32x4*)(Am + 3836);
    s0 = fmaf(a.x, x28, s0);
    s1 = fmaf(a.y, x29, s1);
    s2 = fmaf(a.z, x30, s2);
    s3 = fmaf(a.w, x31, s3);
    a = *(const LAS f32x4*)(Am + 3840);
    s0 = fmaf(a.x, x32, s0);
    s1 = fmaf(a.y, x33, s1);
    s2 = fmaf(a.z, x34, s2);
    s3 = fmaf(a.w, x35, s3);
    a = *(const LAS f32x4*)(Am + 3844);
    s0 = fmaf(a.x, x36, s0);
    s1 = fmaf(a.y, x37, s1);
    s2 = fmaf(a.z, x38, s2);
    s3 = fmaf(a.w, x39, s3);
    a = *(const LAS f32x4*)(Am + 3848);
    s0 = fmaf(a.x, x40, s0);
    s1 = fmaf(a.y, x41, s1);
    s2 = fmaf(a.z, x42, s2);
    s3 = fmaf(a.w, x43, s3);
    a = *(const LAS f32x4*)(Am + 3852);
    s0 = fmaf(a.x, x44, s0);
    s1 = fmaf(a.y, x45, s1);
    s2 = fmaf(a.z, x46, s2);
    s3 = fmaf(a.w, x47, s3);
    a = *(const LAS f32x4*)(Am + 3856);
    s0 = fmaf(a.x, x48, s0);
    s1 = fmaf(a.y, x49, s1);
    s2 = fmaf(a.z, x50, s2);
    s3 = fmaf(a.w, x51, s3);
    a = *(const LAS f32x4*)(Am + 3860);
    s0 = fmaf(a.x, x52, s0);
    s1 = fmaf(a.y, x53, s1);
    s2 = fmaf(a.z, x54, s2);
    const float al56 = a.w;
    x56 = (x56 - ((s0 + s1) + (s2 + s3))) - al56 * x55;
    Tu[7616 + c] = f2bf(x56 * su); Tw[7616 + c] = f2bf(x56 * sw); asm volatile("" ::: "memory");
    float x57 = fmaxf(0.0f, 1.0f - fabsf(cf - 57.0f));
    s0 = 0.f; s1 = 0.f; s2 = 0.f; s3 = 0.f;
    a = *(const LAS f32x4*)(Am + 3876);
    s0 = fmaf(a.x, x0, s0);
    s1 = fmaf(a.y, x1, s1);
    s2 = fmaf(a.z, x2, s2);
    s3 = fmaf(a.w, x3, s3);
    a = *(const LAS f32x4*)(Am + 3880);
    s0 = fmaf(a.x, x4, s0);
    s1 = fmaf(a.y, x5, s1);
    s2 = fmaf(a.z, x6, s2);
    s3 = fmaf(a.w, x7, s3);
    a = *(const LAS f32x4*)(Am + 3884);
    s0 = fmaf(a.x, x8, s0);
    s1 = fmaf(a.y, x9, s1);
    s2 = fmaf(a.z, x10, s2);
    s3 = fmaf(a.w, x11, s3);
    a = *(const LAS f32x4*)(Am + 3888);
    s0 = fmaf(a.x, x12, s0);
    s1 = fmaf(a.y, x13, s1);
    s2 = fmaf(a.z, x14, s2);
    s3 = fmaf(a.w, x15, s3);
    a = *(const LAS f32x4*)(Am + 3892);
    s0 = fmaf(a.x, x16, s0);
    s1 = fmaf(a.y, x17, s1);
    s2 = fmaf(a.z, x18, s2);
    s3 = fmaf(a.w, x19, s3);
    a = *(const LAS f32x4*)(Am + 3896);
    s0 = fmaf(a.x, x20, s0);
    s1 = fmaf(a.y, x21, s1);
    s2 = fmaf(a.z, x22, s2);
    s3 = fmaf(a.w, x23, s3);
    a = *(const LAS f32x4*)(Am + 3900);
    s0 = fmaf(a.x, x24, s0);
    s1 = fmaf(a.y, x25, s1);
    s2 = fmaf(a.z, x26, s2);
    s3 = fmaf(a.w, x27, s3);
    a = *(const LAS f32x4*)(Am + 3904);
    s0 = fmaf(a.x, x28, s0);
    s1 = fmaf(a.y, x29, s1);
    s2 = fmaf(a.z, x30, s2);
    s3 = fmaf(a.w, x31, s3);
    a = *(const LAS f32x4*)(Am + 3908);
    s0 = fmaf(a.x, x32, s0);
    s1 = fmaf(a.y, x33, s1);
    s2 = fmaf(a.z, x34, s2);
    s3 = fmaf(a.w, x35, s3);
    a = *(const LAS f32x4*)(Am + 3912);
    s0 = fmaf(a.x, x36, s0);
    s1 = fmaf(a.y, x37, s1);
    s2 = fmaf(a.z, x38, s2);
    s3 = fmaf(a.w, x39, s3);
    a = *(const LAS f32x4*)(Am + 3916);
    s0 = fmaf(a.x, x40, s0);
    s1 = fmaf(a.y, x41, s1);
    s2 = fmaf(a.z, x42, s2);
    s3 = fmaf(a.w, x43, s3);
    a = *(const LAS f32x4*)(Am + 3920);
    s0 = fmaf(a.x, x44, s0);
    s1 = fmaf(a.y, x45, s1);
    s2 = fmaf(a.z, x46, s2);
    s3 = fmaf(a.w, x47, s3);
    a = *(const LAS f32x4*)(Am + 3924);
    s0 = fmaf(a.x, x48, s0);
    s1 = fmaf(a.y, x49, s1);
    s2 = fmaf(a.z, x50, s2);
    s3 = fmaf(a.w, x51, s3);
    a = *(const LAS f32x4*)(Am + 3928);
    s0 = fmaf(a.x, x52, s0);
    s1 = fmaf(a.y, x53, s1);
    s2 = fmaf(a.z, x54, s2);
    s3 = fmaf(a.w, x55, s3);
    a = *(const LAS f32x4*)(Am + 3932);
    const float al57 = a.x;
    x57 = (x57 - ((s0 + s1) + (s2 + s3))) - al57 * x56;
    Tu[7752 + c] = f2bf(x57 * su); Tw[7752 + c] = f2bf(x57 * sw); asm volatile("" ::: "memory");
    float x58 = fmaxf(0.0f, 1.0f - fabsf(cf - 58.0f));
    s0 = 0.f; s1 = 0.f; s2 = 0.f; s3 = 0.f;
    a = *(const LAS f32x4*)(Am + 3944);
    s0 = fmaf(a.x, x0, s0);
    s1 = fmaf(a.y, x1, s1);
    s2 = fmaf(a.z, x2, s2);
    s3 = fmaf(a.w, x3, s3);
    a = *(const LAS f32x4*)(Am + 3948);
    s0 = fmaf(a.x, x4, s0);
    s1 = fmaf(a.y, x5, s1);
    s2 = fmaf(a.z, x6, s2);
    s3 = fmaf(a.w, x7, s3);
    a = *(const LAS f32x4*)(Am + 3952);
    s0 = fmaf(a.x, x8, s0);
    s1 = fmaf(a.y, x9, s1);
    s2 = fmaf(a.z, x10, s2);
    s3 = fmaf(a.w, x11, s3);
    a = *(const LAS f32x4*)(Am + 3956);
    s0 = fmaf(a.x, x12, s0);
    s1 = fmaf(a.y, x13, s1);
    s2 = fmaf(a.z, x14, s2);
    s3 = fmaf(a.w, x15, s3);
    a = *(const LAS f32x4*)(Am + 3960);
    s0 = fmaf(a.x, x16, s0);
    s1 = fmaf(a.y, x17, s1);
    s2 = fmaf(a.z, x18, s2);
    s3 = fmaf(a.w, x19, s3);
    a = *(const LAS f32x4*)(Am + 3964);
    s0 = fmaf(a.x, x20, s0);
    s1 = fmaf(a.y, x21, s1);
    s2 = fmaf(a.z, x22, s2);
    s3 = fmaf(a.w, x23, s3);
    a = *(const LAS f32x4*)(Am + 3968);
    s0 = fmaf(a.x, x24, s0);
    s1 = fmaf(a.y, x25, s1);
    s2 = fmaf(a.z, x26, s2);
    s3 = fmaf(a.w, x27, s3);
    a = *(const LAS f32x4*)(Am + 3972);
    s0 = fmaf(a.x, x28, s0);
    s1 = fmaf(a.y, x29, s1);
    s2 = fmaf(a.z, x30, s2);
    s3 = fmaf(a.w, x31, s3);
    a = *(const LAS f32x4*)(Am + 3976);
    s0 = fmaf(a.x, x32, s0);
    s1 = fmaf(a.y, x33, s1);
    s2 = fmaf(a.z, x34, s2);
    s3 = fmaf(a.w, x35, s3);
    a = *(const LAS f32x4*)(Am + 3980);
    s0 = fmaf(a.x, x36, s0);
    s1 = fmaf(a.y, x37, s1);
    s2 = fmaf(a.z, x38, s2);
    s3 = fmaf(a.w, x39, s3);
    a = *(const LAS f32x4*)(Am + 3984);
    s0 = fmaf(a.x, x40, s0);
    s1 = fmaf(a.y, x41, s1);
    s2 = fmaf(a.z, x42, s2);
    s3 = fmaf(a.w, x43, s3);
    a = *(const LAS f32x4*)(Am + 3988);
    s0 = fmaf(a.x, x44, s0);
    s1 = fmaf(a.y, x45, s1);
    s2 = fmaf(a.z, x46, s2);
    s3 = fmaf(a.w, x47, s3);
    a = *(const LAS f32x4*)(Am + 3992);
    s0 = fmaf(a.x, x48, s0);
    s1 = fmaf(a.y, x49, s1);
    s2 = fmaf(a.z, x50, s2);
    s3 = fmaf(a.w, x51, s3);
    a = *(const LAS f32x4*)(Am + 3996);
    s0 = fmaf(a.x, x52, s0);
    s1 = fmaf(a.y, x53, s1);
    s2 = fmaf(a.z, x54, s2);
    s3 = fmaf(a.w, x55, s3);
    a = *(const LAS f32x4*)(Am + 4000);
    s0 = fmaf(a.x, x56, s0);
    const float al58 = a.y;
    x58 = (x58 - ((s0 + s1) + (s2 + s3))) - al58 * x57;
    Tu[7888 + c] = f2bf(x58 * su); Tw[7888 + c] = f2bf(x58 * sw); asm volatile("" ::: "memory");
    float x59 = fmaxf(0.0f, 1.0f - fabsf(cf - 59.0f));
    s0 = 0.f; s1 = 0.f; s2 = 0.f; s3 = 0.f;
    a = *(const LAS f32x4*)(Am + 4012);
    s0 = fmaf(a.x, x0, s0);
    s1 = fmaf(a.y, x1, s1);
    s2 = fmaf(a.z, x2, s2);
    s3 = fmaf(a.w, x3, s3);
    a = *(const LAS f32x4*)(Am + 4016);
    s0 = fmaf(a.x, x4, s0);
    s1 = fmaf(a.y, x5, s1);
    s2 = fmaf(a.z, x6, s2);
    s3 = fmaf(a.w, x7, s3);
    a = *(const LAS f32x4*)(Am + 4020);
    s0 = fmaf(a.x, x8, s0);
    s1 = fmaf(a.y, x9, s1);
    s2 = fmaf(a.z, x10, s2);
    s3 = fmaf(a.w, x11, s3);
    a = *(const LAS f32x4*)(Am + 4024);
    s0 = fmaf(a.x, x12, s0);
    s1 = fmaf(a.y, x13, s1);
    s2 = fmaf(a.z, x14, s2);
    s3 = fmaf(a.w, x15, s3);
    a = *(const LAS f32x4*)(Am + 4028);
    s0 = fmaf(a.x, x16, s0);
    s1 = fmaf(a.y, x17, s1);
    s2 = fmaf(a.z, x18, s2);
    s3 = fmaf(a.w, x19, s3);
    a = *(const LAS f32x4*)(Am + 4032);
    s0 = fmaf(a.x, x20, s0);
    s1 = fmaf(a.y, x21, s1);
    s2 = fmaf(a.z, x22, s2);
    s3 = fmaf(a.w, x23, s3);
    a = *(const LAS f32x4*)(Am + 4036);
    s0 = fmaf(a.x, x24, s0);
    s1 = fmaf(a.y, x25, s1);
    s2 = fmaf(a.z, x26, s2);
    s3 = fmaf(a.w, x27, s3);
    a = *(const LAS f32x4*)(Am + 4040);
    s0 = fmaf(a.x, x28, s0);
    s1 = fmaf(a.y, x29, s1);
    s2 = fmaf(a.z, x30, s2);
    s3 = fmaf(a.w, x31, s3);
    a = *(const LAS f32x4*)(Am + 4044);
    s0 = fmaf(a.x, x32, s0);
    s1 = fmaf(a.y, x33, s1);
    s2 = fmaf(a.z, x34, s2);
    s3 = fmaf(a.w, x35, s3);
    a = *(const LAS f32x4*)(Am + 4048);
    s0 = fmaf(a.x, x36, s0);
    s1 = fmaf(a.y, x37, s1);
    s2 = fmaf(a.z, x38, s2);
    s3 = fmaf(a.w, x39, s3);
    a = *(const LAS f32x4*)(Am + 4052);
    s0 = fmaf(a.x, x40, s0);
    s1 = fmaf(a.y, x41, s1);
    s2 = fmaf(a.z, x42, s2);
    s3 = fmaf(a.w, x43, s3);
    a = *(const LAS f32x4*)(Am + 4056);
    s0 = fmaf(a.x, x44, s0);
    s1 = fmaf(a.y, x45, s1);
    s2 = fmaf(a.z, x46, s2);
    s3 = fmaf(a.w, x47, s3);
    a = *(const LAS f32x4*)(Am + 4060);
    s0 = fmaf(a.x, x48, s0);
    s1 = fmaf(a.y, x49, s1);
    s2 = fmaf(a.z, x50, s2);
    s3 = fmaf(a.w, x51, s3);
    a = *(const LAS f32x4*)(Am + 4064);
    s0 = fmaf(a.x, x52, s0);
    s1 = fmaf(a.y, x53, s1);
    s2 = fmaf(a.z, x54, s2);
    s3 = fmaf(a.w, x55, s3);
    a = *(const LAS f32x4*)(Am + 4068);
    s0 = fmaf(a.x, x56, s0);
    s1 = fmaf(a.y, x57, s1);
    const float al59 = a.z;
    x59 = (x59 - ((s0 + s1) + (s2 + s3))) - al59 * x58;
    Tu[8024 + c] = f2bf(x59 * su); Tw[8024 + c] = f2bf(x59 * sw); asm volatile("" ::: "memory");
    float x60 = fmaxf(0.0f, 1.0f - fabsf(cf - 60.0f));
    s0 = 0.f; s1 = 0.f; s2 = 0.f; s3 = 0.f;
    a = *(const LAS f32x4*)(Am + 4080);
    s0 = fmaf(a.x, x0, s0);
    s1 = fmaf(a.y, x1, s1);
    s2 = fmaf(a.z, x2, s2);
    s3 = fmaf(a.w, x3, s3);
    a = *(const LAS f32x4*)(Am + 4084);
    s0 = fmaf(a.x, x4, s0);
    s1 = fmaf(a.y, x5, s1);
    s2 = fmaf(a.z, x6, s2);
    s3 = fmaf(a.w, x7, s3);
    a = *(const LAS f32x4*)(Am + 4088);
    s0 = fmaf(a.x, x8, s0);
    s1 = fmaf(a.y, x9, s1);
    s2 = fmaf(a.z, x10, s2);
    s3 = fmaf(a.w, x11, s3);
    a = *(const LAS f32x4*)(Am + 4092);
    s0 = fmaf(a.x, x12, s0);
    s1 = fmaf(a.y, x13, s1);
    s2 = fmaf(a.z, x14, s2);
    s3 = fmaf(a.w, x15, s3);
    a = *(const LAS f32x4*)(Am + 4096);
    s0 = fmaf(a.x, x16, s0);
    s1 = fmaf(a.y, x17, s1);
    s2 = fmaf(a.z, x18, s2);
    s3 = fmaf(a.w, x19, s3);
    a = *(const LAS f32x4*)(Am + 4100);
    s0 = fmaf(a.x, x20, s0);
    s1 = fmaf(a.y, x21, s1);
    s2 = fmaf(a.z, x22, s2);
    s3 = fmaf(a.w, x23, s3);
    a = *(const LAS f32x4*)(Am + 4104);
    s0 = fmaf(a.x, x24, s0);
    s1 = fmaf(a.y, x25, s1);
    s2 = fmaf(a.z, x26, s2);
    s3 = fmaf(a.w, x27, s3);
    a = *(const LAS f32x4*)(Am + 4108);
    s0 = fmaf(a.x, x28, s0);
    s1 = fmaf(a.y, x29, s1);
    s2 = fmaf(a.z, x30, s2);
    s3 = fmaf(a.w, x31, s3);
    a = *(const LAS f32x4*)(Am + 4112);
    s0 = fmaf(a.x, x32, s0);
    s1 = fmaf(a.y, x33, s1);
    s2 = fmaf(a.z, x34, s2);
    s3 = fmaf(a.w, x35, s3);
    a = *(const LAS f32x4*)(Am + 4116);
    s0 = fmaf(a.x, x36, s0);
    s1 = fmaf(a.y, x37, s1);
    s2 = fmaf(a.z, x38, s2);
    s3 = fmaf(a.w, x39, s3);
    a = *(const LAS f32x4*)(Am + 4120);
    s0 = fmaf(a.x, x40, s0);
    s1 = fmaf(a.y, x41, s1);
    s2 = fmaf(a.z, x42, s2);
    s3 = fmaf(a.w, x43, s3);
    a = *(const LAS f32x4*)(Am + 4124);
    s0 = fmaf(a.x, x44, s0);
    s1 = fmaf(a.y, x45, s1);
    s2 = fmaf(a.z, x46, s2);
    s3 = fmaf(a.w, x47, s3);
    a = *(const LAS f32x4*)(Am + 4128);
    s0 = fmaf(a.x, x48, s0);
    s1 = fmaf(a.y, x49, s1);
    s2 = fmaf(a.z, x50, s2);
    s3 = fmaf(a.w, x51, s3);
    a = *(const LAS f32x4*)(Am + 4132);
    s0 = fmaf(a.x, x52, s0);
    s1 = fmaf(a.y, x53, s1);
    s2 = fmaf(a.z, x54, s2);
    s3 = fmaf(a.w, x55, s3);
    a = *(const LAS f32x4*)(Am + 4136);
    s0 = fmaf(a.x, x56, s0);
    s1 = fmaf(a.y, x57, s1);
    s2 = fmaf(a.z, x58, s2);
    const float al60 = a.w;
    x60 = (x60 - ((s0 + s1) + (s2 + s3))) - al60 * x59;
    Tu[8160 + c] = f2bf(x60 * su); Tw[8160 + c] = f2bf(x60 * sw); asm volatile("" ::: "memory");
    float x61 = fmaxf(0.0f, 1.0f - fabsf(cf - 61.0f));
    s0 = 0.f; s1 = 0.f; s2 = 0.f; s3 = 0.f;
    a = *(const LAS f32x4*)(Am + 4148);
    s0 = fmaf(a.x, x0, s0);
    s1 = fmaf(a.y, x1, s1);
    s2 = fmaf(a.z, x2, s2);
    s3 = fmaf(a.w, x3, s3);
    a = *(const LAS f32x4*)(Am + 4152);
    s0 = fmaf(a.x, x4, s0);
    s1 = fmaf(a.y, x5, s1);
    s2 = fmaf(a.z, x6, s2);
    s3 = fmaf(a.w, x7, s3);
    a = *(const LAS f32x4*)(Am + 4156);
    s0 = fmaf(a.x, x8, s0);
    s1 = fmaf(a.y, x9, s1);
    s2 = fmaf(a.z, x10, s2);
    s3 = fmaf(a.w, x11, s3);
    a = *(const LAS f32x4*)(Am + 4160);
    s0 = fmaf(a.x, x12, s0);
    s1 = fmaf(a.y, x13, s1);
    s2 = fmaf(a.z, x14, s2);
    s3 = fmaf(a.w, x15, s3);
    a = *(const LAS f32x4*)(Am + 4164);
    s0 = fmaf(a.x, x16, s0);
    s1 = fmaf(a.y, x17, s1);
    s2 = fmaf(a.z, x18, s2);
    s3 = fmaf(a.w, x19, s3);
    a = *(const LAS f32x4*)(Am + 4168);
    s0 = fmaf(a.x, x20, s0);
    s1 = fmaf(a.y, x21, s1);
    s2 = fmaf(a.z, x22, s2);
    s3 = fmaf(a.w, x23, s3);
    a = *(const LAS f32x4*)(Am + 4172);
    s0 = fmaf(a.x, x24, s0);
    s1 = fmaf(a.y, x25, s1);
    s2 = fmaf(a.z, x26, s2);
    s3 = fmaf(a.w, x27, s3);
    a = *(const LAS f32x4*)(Am + 4176);
    s0 = fmaf(a.x, x28, s0);
    s1 = fmaf(a.y, x29, s1);
    s2 = fmaf(a.z, x30, s2);
    s3 = fmaf(a.w, x31, s3);
    a = *(const LAS f32x4*)(Am + 4180);
    s0 = fmaf(a.x, x32, s0);
    s1 = fmaf(a.y, x33, s1);
    s2 = fmaf(a.z, x34, s2);
    s3 = fmaf(a.w, x35, s3);
    a = *(const LAS f32x4*)(Am + 4184);
    s0 = fmaf(a.x, x36, s0);
    s1 = fmaf(a.y, x37, s1);
    s2 = fmaf(a.z, x38, s2);
    s3 = fmaf(a.w, x39, s3);
    a = *(const LAS f32x4*)(Am + 4188);
    s0 = fmaf(a.x, x40, s0);
    s1 = fmaf(a.y, x41, s1);
    s2 = fmaf(a.z, x42, s2);
    s3 = fmaf(a.w, x43, s3);
    a = *(const LAS f32x4*)(Am + 4192);
    s0 = fmaf(a.x, x44, s0);
    s1 = fmaf(a.y, x45, s1);
    s2 = fmaf(a.z, x46, s2);
    s3 = fmaf(a.w, x47, s3);
    a = *(const LAS f32x4*)(Am + 4196);
    s0 = fmaf(a.x, x48, s0);
    s1 = fmaf(a.y, x49, s1);
    s2 = fmaf(a.z, x50, s2);
    s3 = fmaf(a.w, x51, s3);
    a = *(const LAS f32x4*)(Am + 4200);
    s0 = fmaf(a.x, x52, s0);
    s1 = fmaf(a.y, x53, s1);
    s2 = fmaf(a.z, x54, s2);
    s3 = fmaf(a.w, x55, s3);
    a = *(const LAS f32x4*)(Am + 4204);
    s0 = fmaf(a.x, x56, s0);
    s1 = fmaf(a.y, x57, s1);
    s2 = fmaf(a.z, x58, s2);
    s3 = fmaf(a.w, x59, s3);
    a = *(const LAS f32x4*)(Am + 4208);
    const float al61 = a.x;
    x61 = (x61 - ((s0 + s1) + (s2 + s3))) - al61 * x60;
    Tu[8296 + c] = f2bf(x61 * su); Tw[8296 + c] = f2bf(x61 * sw); asm volatile("" ::: "memory");
    float x62 = fmaxf(0.0f, 1.0f - fabsf(cf - 62.0f));
    s0 = 0.f; s1 = 0.f; s2 = 0.f; s3 = 0.f;
    a = *(const LAS f32x4*)(Am + 4216);
    s0 = fmaf(a.x, x0, s0);
    s1 = fmaf(a.y, x1, s1);
    s2 = fmaf(a.z, x2, s2);
    s3 = fmaf(a.w, x3, s3);
    a = *(const LAS f32x4*)(Am + 4220);
    s0 = fmaf(a.x, x4, s0);
    s1 = fmaf(a.y, x5, s1);
    s2 = fmaf(a.z, x6, s2);
    s3 = fmaf(a.w, x7, s3);
    a = *(const LAS f32x4*)(Am + 4224);
    s0 = fmaf(a.x, x8, s0);
    s1 = fmaf(a.y, x9, s1);
    s2 = fmaf(a.z, x10, s2);
    s3 = fmaf(a.w, x11, s3);
    a = *(const LAS f32x4*)(Am + 4228);
    s0 = fmaf(a.x, x12, s0);
    s1 = fmaf(a.y, x13, s1);
    s2 = fmaf(a.z, x14, s2);
    s3 = fmaf(a.w, x15, s3);
    a = *(const LAS f32x4*)(Am + 4232);
    s0 = fmaf(a.x, x16, s0);
    s1 = fmaf(a.y, x17, s1);
    s2 = fmaf(a.z, x18, s2);
    s3 = fmaf(a.w, x19, s3);
    a = *(const LAS f32x4*)(Am + 4236);
    s0 = fmaf(a.x, x20, s0);
    s1 = fmaf(a.y, x21, s1);
    s2 = fmaf(a.z, x22, s2);
    s3 = fmaf(a.w, x23, s3);
    a = *(const LAS f32x4*)(Am + 4240);
    s0 = fmaf(a.x, x24, s0);
    s1 = fmaf(a.y, x25, s1);
    s2 = fmaf(a.z, x26, s2);
    s3 = fmaf(a.w, x27, s3);
    a = *(const LAS f32x4*)(Am + 4244);
    s0 = fmaf(a.x, x28, s0);
    s1 = fmaf(a.y, x29, s1);
    s2 = fmaf(a.z, x30, s2);
    s3 = fmaf(a.w, x31, s3);
    a = *(const LAS f32x4*)(Am + 4248);
    s0 = fmaf(a.x, x32, s0);
    s1 = fmaf(a.y, x33, s1);
    s2 = fmaf(a.z, x34, s2);
    s3 = fmaf(a.w, x35, s3);
    a = *(const LAS f32x4*)(Am + 4252);
    s0 = fmaf(a.x, x36, s0);
    s1 = fmaf(a.y, x37, s1);
    s2 = fmaf(a.z, x38, s2);
    s3 = fmaf(a.w, x39, s3);
    a = *(const LAS f32x4*)(Am + 4256);
    s0 = fmaf(a.x, x40, s0);
    s1 = fmaf(a.y, x41, s1);
    s2 = fmaf(a.z, x42, s2);
    s3 = fmaf(a.w, x43, s3);
    a = *(const LAS f32x4*)(Am + 4260);
    s0 = fmaf(a.x, x44, s0);
    s1 = fmaf(a.y, x45, s1);
    s2 = fmaf(a.z, x46, s2);
    s3 = fmaf(a.w, x47, s3);
    a = *(const LAS f32x4*)(Am + 4264);
    s0 = fmaf(a.x, x48, s0);
    s1 = fmaf(a.y, x49, s1);
    s2 = fmaf(a.z, x50, s2);
    s3 = fmaf(a.w, x51, s3);
    a = *(const LAS f32x4*)(Am + 4268);
    s0 = fmaf(a.x, x52, s0);
    s1 = fmaf(a.y, x53, s1);
    s2 = fmaf(a.z, x54, s2);
    s3 = fmaf(a.w, x55, s3);
    a = *(const LAS f32x4*)(Am + 4272);
    s0 = fmaf(a.x, x56, s0);
    s1 = fmaf(a.y, x57, s1);
    s2 = fmaf(a.z, x58, s2);
    s3 = fmaf(a.w, x59, s3);
    a = *(const LAS f32x4*)(Am + 4276);
    s0 = fmaf(a.x, x60, s0);
    const float al62 = a.y;
    x62 = (x62 - ((s0 + s1) + (s2 + s3))) - al62 * x61;
    Tu[8432 + c] = f2bf(x62 * su); Tw[8432 + c] = f2bf(x62 * sw); asm volatile("" ::: "memory");
    float x63 = fmaxf(0.0f, 1.0f - fabsf(cf - 63.0f));
    s0 = 0.f; s1 = 0.f; s2 = 0.f; s3 = 0.f;
    a = *(const LAS f32x4*)(Am + 4284);
    s0 = fmaf(a.x, x0, s0);
    s1 = fmaf(a.y, x1, s1);
    s2 = fmaf(a.z, x2, s2);
    s3 = fmaf(a.w, x3, s3);
    a = *(const LAS f32x4*)(Am + 4288);
    s0 = fmaf(a.x, x4, s0);
    s1 = fmaf(a.y, x5, s1);
    s2 = fmaf(a.z, x6, s2);
    s3 = fmaf(a.w, x7, s3);
    a = *(const LAS f32x4*)(Am + 4292);
    s0 = fmaf(a.x, x8, s0);
    s1 = fmaf(a.y, x9, s1);
    s2 = fmaf(a.z, x10, s2);
    s3 = fmaf(a.w, x11, s3);
    a = *(const LAS f32x4*)(Am + 4296);
    s0 = fmaf(a.x, x12, s0);
    s1 = fmaf(a.y, x13, s1);
    s2 = fmaf(a.z, x14, s2);
    s3 = fmaf(a.w, x15, s3);
    a = *(const LAS f32x4*)(Am + 4300);
    s0 = fmaf(a.x, x16, s0);
    s1 = fmaf(a.y, x17, s1);
    s2 = fmaf(a.z, x18, s2);
    s3 = fmaf(a.w, x19, s3);
    a = *(const LAS f32x4*)(Am + 4304);
    s0 = fmaf(a.x, x20, s0);
    s1 = fmaf(a.y, x21, s1);
    s2 = fmaf(a.z, x22, s2);
    s3 = fmaf(a.w, x23, s3);
    a = *(const LAS f32x4*)(Am + 4308);
    s0 = fmaf(a.x, x24, s0);
    s1 = fmaf(a.y, x25, s1);
    s2 = fmaf(a.z, x26, s2);
    s3 = fmaf(a.w, x27, s3);
    a = *(const LAS f32x4*)(Am + 4312);
    s0 = fmaf(a.x, x28, s0);
    s1 = fmaf(a.y, x29, s1);
    s2 = fmaf(a.z, x30, s2);
    s3 = fmaf(a.w, x31, s3);
    a = *(const LAS f32x4*)(Am + 4316);
    s0 = fmaf(a.x, x32, s0);
    s1 = fmaf(a.y, x33, s1);
    s2 = fmaf(a.z, x34, s2);
    s3 = fmaf(a.w, x35, s3);
    a = *(const LAS f32x4*)(Am + 4320);
    s0 = fmaf(a.x, x36, s0);
    s1 = fmaf(a.y, x37, s1);
    s2 = fmaf(a.z, x38, s2);
    s3 = fmaf(a.w, x39, s3);
    a = *(const LAS f32x4*)(Am + 4324);
    s0 = fmaf(a.x, x40, s0);
    s1 = fmaf(a.y, x41, s1);
    s2 = fmaf(a.z, x42, s2);
    s3 = fmaf(a.w, x43, s3);
    a = *(const LAS f32x4*)(Am + 4328);
    s0 = fmaf(a.x, x44, s0);
    s1 = fmaf(a.y, x45, s1);
    s2 = fmaf(a.z, x46, s2);
    s3 = fmaf(a.w, x47, s3);
    a = *(const LAS f32x4*)(Am + 4332);
    s0 = fmaf(a.x, x48, s0);
    s1 = fmaf(a.y, x49, s1);
    s2 = fmaf(a.z, x50, s2);
    s3 = fmaf(a.w, x51, s3);
    a = *(const LAS f32x4*)(Am + 4336);
    s0 = fmaf(a.x, x52, s0);
    s1 = fmaf(a.y, x53, s1);
    s2 = fmaf(a.z, x54, s2);
    s3 = fmaf(a.w, x55, s3);
    a = *(const LAS f32x4*)(Am + 4340);
    s0 = fmaf(a.x, x56, s0);
    s1 = fmaf(a.y, x57, s1);
    s2 = fmaf(a.z, x58, s2);
    s3 = fmaf(a.w, x59, s3);
    a = *(const LAS f32x4*)(Am + 4344);
    s0 = fmaf(a.x, x60, s0);
    s1 = fmaf(a.y, x61, s1);
    const float al63 = a.z;
    x63 = (x63 - ((s0 + s1) + (s2 + s3))) - al63 * x62;
    Tu[8568 + c] = f2bf(x63 * su); Tw[8568 + c] = f2bf(x63 * sw); asm volatile("" ::: "memory");
}
typedef short bf16x8_t __attribute__((ext_vector_type(8)));
template <int K> __device__ __forceinline__ f32x4 mma_tile(const LAS unsigned short* A, int lda, const LAS unsigned short* Bt, int ldb, f32x4 acc) {
    const int lane = threadIdx.x & 63, r = lane & 15, q = lane >> 4;
#pragma unroll
    for (int ks = 0; ks < K / 32; ++ks) {
        const bf16x8_t a = *(const LAS bf16x8_t*)(A + r * lda + ks * 32 + q * 8);
        const bf16x8_t b = *(const LAS bf16x8_t*)(Bt + r * ldb + ks * 32 + q * 8);
        acc = __builtin_amdgcn_mfma_f32_16x16x32_bf16(a, b, acc, 0, 0, 0);
    }
    return acc;
}

typedef unsigned short u16x4_t __attribute__((ext_vector_type(4)));
__device__ __forceinline__ void tr_frag2(unsigned base_addr, int pitch, int c, bf16x8_t& f0, bf16x8_t& f1) {
    const int lane = threadIdx.x & 63, g = lane >> 4, qq = (lane & 15) >> 2, pp = lane & 3;
    const unsigned a00 = base_addr + (unsigned)((8 * g + qq) * pitch + 32 * c + 8 * pp);
    const unsigned a01 = a00 + 4u * (unsigned)pitch, a10 = a00 + 32u * (unsigned)pitch, a11 = a10 + 4u * (unsigned)pitch;
    u16x4_t r00, r01, r10, r11;
    asm volatile("ds_read_b64_tr_b16 %0, %4\n\tds_read_b64_tr_b16 %1, %5\n\tds_read_b64_tr_b16 %2, %6\n\tds_read_b64_tr_b16 %3, %7\n\ts_waitcnt lgkmcnt(0)"
                 : "=&v"(r00), "=&v"(r01), "=&v"(r10), "=&v"(r11) : "v"(a00), "v"(a01), "v"(a10), "v"(a11) : "memory");
    f0 = (bf16x8_t){(short)r00.x, (short)r00.y, (short)r00.z, (short)r00.w, (short)r01.x, (short)r01.y, (short)r01.z, (short)r01.w};
    f1 = (bf16x8_t){(short)r10.x, (short)r10.y, (short)r10.z, (short)r10.w, (short)r11.x, (short)r11.y, (short)r11.z, (short)r11.w};
}
constexpr size_t WS_G = 235 * MiB;

__device__ __forceinline__ void delta_prep(LDSp lds, const Params& p) {
    const bf16_t* QKVN = (const bf16_t*)(p.ws + WS_QKV); const float* BETA = (const float*)(p.ws + WS_BETA); const float* LA = (const float*)(p.ws + WS_LA);
    bf16_t* Z = (bf16_t*)(p.ws + WS_Z); float* GB = (float*)(p.ws + WS_G);
    LAS unsigned short* Qb = (LAS unsigned short*)lds;
    LAS unsigned short* Kb = (LAS unsigned short*)(lds + 17408);
    LAS unsigned short* Ast = (LAS unsigned short*)(lds + 107776);
    const int tid = threadIdx.x, lane = tid & 63, wid = tid >> 6, r = lane & 15, q = lane >> 4;
    const int G = gridDim.x;
    u32x4 pq[4]; float pla = 0.f, pbe = 0.f;
#define DPL(u_, vmode) do { const int dir_ = (u_) >> 10, b_ = ((u_) >> 8) & 3, h_ = ((u_) >> 6) & 3, n_ = (u_) & 63; \
        const long tk0_ = (long)b_ * S_ + (dir_ ? (S_ - 1 - n_ * 64) : n_ * 64); const long ts_ = dir_ ? -1 : 1; \
        _Pragma("unroll") for (int i = 0; i < 4; ++i) { const int pi = tid + NTHR * i, which = pi >> 10, l = (pi >> 4) & 63, c8 = pi & 15; \
            pq[i] = *(const u32x4*)(QKVN + (tk0_ + l * ts_) * 1536 + ((vmode) ? (which ? 512 : 1024) : which * 512) + h_ * 128 + c8 * 8); } \
        if (!(vmode) && tid < 64) { const long tk = tk0_ + tid * ts_; pla = LA[tk * 8 + dir_ * 4 + h_]; pbe = BETA[tk * 8 + dir_ * 4 + h_]; } } while (0)
#define DPS() do { _Pragma("unroll") for (int i = 0; i < 4; ++i) { const int pi = tid + NTHR * i, which = pi >> 10, l = (pi >> 4) & 63, c8 = pi & 15; *(LAS u32x4*)(lds + which * 17408 + l * 272 + c8 * 16) = pq[i]; } } while (0)
    if ((int)blockIdx.x < 2048) DPL((int)blockIdx.x, 0);
    for (int ub = blockIdx.x; ub < 2048; ub += 4 * G) {
#pragma unroll 1
        for (int j = 0; j < 4; ++j) { const int unit = ub + j * G; if (unit >= 2048) break;
            const int dir = unit >> 10, b = (unit >> 8) & 3, h = (unit >> 6) & 3, n = unit & 63;
            const long tok0 = (long)b * S_ + (dir ? (S_ - 1 - n * 64) : n * 64); const long tstep = dir ? -1 : 1;
            LAS float* Am = (LAS float*)(lds + 34816 + j * 17408); LAS float* gl = (LAS float*)(lds + 104448 + j * 768); LAS float* be = gl + 64; LAS float* beg = gl + 128; LAS float* la = (LAS float*)(lds + 107520);
            DPS();
            if (tid < 64) { la[tid] = pla; be[tid] = pbe; }
            __syncthreads();
            { const int un = ub + (j + 1) * G; if (j < 3 && un < 2048) DPL(un, 0); else DPL(ub, 1); }
            if (tid < 64) { const float g = wave_scan_sum(la[tid], true); gl[tid] = g; beg[tid] = be[tid] * __expf(g); GB[((size_t)dir * T_ + (tok0 + tid * tstep)) * 4 + h] = g; }
            __syncthreads();
#pragma unroll
            for (int tt = 0; tt < 2; ++tt) { const int idx = wid * 2 + tt, mt = idx >> 2, nt = idx & 3;
                f32x4 kk = {0.f, 0.f, 0.f, 0.f}, qk = {0.f, 0.f, 0.f, 0.f};
                if (mt >= nt) { kk = mma_tile<128>(Kb + mt * 16 * 136, 136, Kb + nt * 16 * 136, 136, kk); qk = mma_tile<128>(Qb + mt * 16 * 136, 136, Kb + nt * 16 * 136, 136, qk); }
                const int jj = nt * 16 + r; const float gj = gl[jj];
#pragma unroll
                for (int i4 = 0; i4 < 4; ++i4) { const int i = mt * 16 + q * 4 + i4; const float dec = (i >= jj) ? __expf(gl[i] - gj) : 0.f;
                    Am[i * 68 + jj] = (i > jj) ? be[i] * kk[i4] * dec : 0.f;
                    Ast[i * 72 + jj] = f2bf(qk[i4] * dec); }
            }
            __syncthreads();
            { const int l = tid >> 3, c8 = tid & 7;
              *(u32x4*)(Z + (tok0 + l * tstep) * 3072 + 2048 + dir * 256 + h * 64 + c8 * 8) = *(const LAS u32x4*)(Ast + l * 72 + c8 * 8); }
        }
        if (wid < 4 && ub + wid * G < 2048) { int cc = lane; asm volatile("" : "+v"(cc));
            LAS float* Am = (LAS float*)(lds + 34816 + wid * 17408); LAS float* gl = (LAS float*)(lds + 104448 + wid * 768);
            tri_inv64(Am, cc, gl[64 + lane], gl[128 + lane], (LAS unsigned short*)Am, (LAS unsigned short*)Am + 64); }
        __syncthreads();
#pragma unroll 1
        for (int j = 0; j < 4; ++j) { const int unit = ub + j * G; if (unit >= 2048) break;
            const int dir = unit >> 10, b = (unit >> 8) & 3, h = (unit >> 6) & 3, n = unit & 63;
            const long tok0 = (long)b * S_ + (dir ? (S_ - 1 - n * 64) : n * 64); const long tstep = dir ? -1 : 1;
            const LAS unsigned short* Tu = (const LAS unsigned short*)(lds + 34816 + j * 17408);
            DPS();
            __syncthreads();
            { const int un = ub + (j + 1) * G; if (j < 3 && un < 2048) DPL(un, 1); else if (ub + 4 * G < 2048) DPL(ub + 4 * G, 0); }
            {   bf16x8_t vb0, vb1, kb0, kb1; tr_frag2((unsigned)(unsigned long long)Qb, 272, wid, vb0, vb1); tr_frag2((unsigned)(unsigned long long)Kb, 272, wid, kb0, kb1);
                __syncthreads();
#pragma unroll
                for (int mt = 0; mt < 4; ++mt) {
                    const bf16x8_t tu0 = *(const LAS bf16x8_t*)(Tu + (mt * 16 + r) * 136 + q * 8), tu1 = *(const LAS bf16x8_t*)(Tu + (mt * 16 + r) * 136 + 32 + q * 8);
                    const bf16x8_t tw0 = *(const LAS bf16x8_t*)(Tu + (mt * 16 + r) * 136 + 64 + q * 8), tw1 = *(const LAS bf16x8_t*)(Tu + (mt * 16 + r) * 136 + 96 + q * 8);
                    f32x4 au = {0.f, 0.f, 0.f, 0.f}, aw = {0.f, 0.f, 0.f, 0.f};
                    au = __builtin_amdgcn_mfma_f32_16x16x32_bf16(tu0, vb0, au, 0, 0, 0); au = __builtin_amdgcn_mfma_f32_16x16x32_bf16(tu1, vb1, au, 0, 0, 0);
                    aw = __builtin_amdgcn_mfma_f32_16x16x32_bf16(tw0, kb0, aw, 0, 0, 0); aw = __builtin_amdgcn_mfma_f32_16x16x32_bf16(tw1, kb1, aw, 0, 0, 0);
#pragma unroll
                    for (int i4 = 0; i4 < 4; ++i4) { const int l = mt * 16 + q * 4 + i4; Qb[l * 136 + wid * 16 + r] = f2bf(au[i4]); Kb[l * 136 + wid * 16 + r] = f2bf(aw[i4]); }
                }
            }
            __syncthreads();
#pragma unroll
            for (int i = 0; i < 4; ++i) { const int pi = tid + NTHR * i, which = pi >> 10, l = (pi >> 4) & 63, c8 = pi & 15;
                *(u32x4*)(Z + (tok0 + l * tstep) * 3072 + which * 1024 + dir * 512 + h * 128 + c8 * 8) = *(const LAS u32x4*)(lds + which * 17408 + l * 272 + c8 * 16); }
            __syncthreads();
        }
    }
}
#undef DPL
#undef DPS

__device__ __forceinline__ void delta_scan2(LDSp lds, const Params& p) {
    const bf16_t* QKVN = (const bf16_t*)(p.ws + WS_QKV); const bf16_t* Z = (const bf16_t*)(p.ws + WS_Z); const float* GB = (const float*)(p.ws + WS_G);
    LAS unsigned short* Wb  = (LAS unsigned short*)lds;
    LAS unsigned short* Qg  = (LAS unsigned short*)(lds + 17408);
    LAS unsigned short* Kg  = (LAS unsigned short*)(lds + 34816);
    LAS unsigned short* At  = (LAS unsigned short*)(lds + 53248);
    LAS unsigned short* Ub  = (LAS unsigned short*)(lds + 62464);
    LAS unsigned short* St  = (LAS unsigned short*)(lds + 66560);
    LAS unsigned short* Vt  = (LAS unsigned short*)(lds + 75264);
    const int tid = threadIdx.x, lane = tid & 63, wid = tid >> 6, r = lane & 15, q = lane >> 4;
    for (int unit = blockIdx.x; unit < 128; unit += gridDim.x) {
        const int dir = unit >> 6, b = (unit >> 4) & 3, h = (unit >> 2) & 3, sl = unit & 3;
        bf16_t* O = (bf16_t*)(p.ws + (dir ? WS_OB : WS_OF));
        const long tstep = dir ? -1 : 1;
        f32x4 S0 = {0.f, 0.f, 0.f, 0.f}, S1 = {0.f, 0.f, 0.f, 0.f};
        u32x4 rwA[2], rqA[2], rkA[2], raA, ruA = {0u, 0u, 0u, 0u}; float g0A = 0.f, g1A = 0.f, gLA = 0.f;
        u32x4 rwB[2], rqB[2], rkB[2], raB, ruB = {0u, 0u, 0u, 0u}; float g0B = 0.f, g1B = 0.f, gLB = 0.f;
#define D2_TOK0(n) ((long)b * S_ + (dir ? (S_ - 1 - (n) * 64) : (n) * 64))
#define D2_LOAD(n, X) do { const long t0_ = D2_TOK0(n); \
        _Pragma("unroll") for (int i = 0; i < 2; ++i) { const int pi = tid + NTHR * i, l = pi >> 4, c8 = pi & 15; const long tk = t0_ + l * tstep; \
            rw##X[i] = *(const u32x4*)(Z + tk * 3072 + 1024 + dir * 512 + h * 128 + c8 * 8); \
            rq##X[i] = *(const u32x4*)(QKVN + tk * 1536 + h * 128 + c8 * 8); rk##X[i] = *(const u32x4*)(QKVN + tk * 1536 + 512 + h * 128 + c8 * 8); } \
        { const int l = tid >> 3, c8 = tid & 7; ra##X = *(const u32x4*)(Z + (t0_ + l * tstep) * 3072 + 2048 + dir * 256 + h * 64 + c8 * 8); } \
        if (tid < 256) { const int l = tid >> 2, c8 = tid & 3; ru##X = *(const u32x4*)(Z + (t0_ + l * tstep) * 3072 + dir * 512 + h * 128 + sl * 32 + c8 * 8); } \
        g0##X = GB[((size_t)dir * T_ + (t0_ + (tid >> 4) * tstep)) * 4 + h]; g1##X = GB[((size_t)dir * T_ + (t0_ + ((tid >> 4) + 32) * tstep)) * 4 + h]; \
        gL##X = GB[((size_t)dir * T_ + (t0_ + 63 * tstep)) * 4 + h]; } while (0)
#define D2_ITER(n, X) do { \
            const float egL = __expf(gL##X); \
            _Pragma("unroll") for (int i = 0; i < 2; ++i) { const int pi = tid + NTHR * i, l = pi >> 4, c8 = pi & 15; const float gl_ = i == 0 ? g0##X : g1##X; \
                *(LAS u32x4*)(Wb + l * 136 + c8 * 8) = rw##X[i]; \
                float f[8]; unpack8(rq##X[i], f); const float eg = __expf(gl_); \
                u32x4 o; o.x = pk2(f[0] * eg, f[1] * eg); o.y = pk2(f[2] * eg, f[3] * eg); o.z = pk2(f[4] * eg, f[5] * eg); o.w = pk2(f[6] * eg, f[7] * eg); \
                *(LAS u32x4*)(Qg + l * 136 + c8 * 8) = o; \
                unpack8(rk##X[i], f); const float ek = __expf(gL##X - gl_); \
                o.x = pk2(f[0] * ek, f[1] * ek); o.y = pk2(f[2] * ek, f[3] * ek); o.z = pk2(f[4] * ek, f[5] * ek); o.w = pk2(f[6] * ek, f[7] * ek); \
                *(LAS u32x4*)(Kg + l * 144 + c8 * 8) = o; } \
            { const int l = tid >> 3, c8 = tid & 7; *(LAS u32x4*)(At + l * 72 + c8 * 8) = ra##X; } \
            if (tid < 256) { const int l = tid >> 2, c8 = tid & 3; *(LAS u32x4*)(Ub + l * 32 + c8 * 8) = ru##X; } \
            { u32x2 w0; w0.x = pk2(S0.x, S0.y); w0.y = pk2(S0.z, S0.w); *(LAS u32x2*)(St + r * 136 + wid * 16 + q * 4) = w0; \
              u32x2 w1; w1.x = pk2(S1.x, S1.y); w1.y = pk2(S1.z, S1.w); *(LAS u32x2*)(St + (16 + r) * 136 + wid * 16 + q * 4) = w1; } \
            __syncthreads(); \
            if ((n) + 2 < 64) D2_LOAD((n) + 2, X); \
            const int mt = wid >> 1, nt = wid & 1; \
            f32x4 p1 = {0.f, 0.f, 0.f, 0.f}, p2 = {0.f, 0.f, 0.f, 0.f}; \
            p1 = mma_tile<128>(Wb + mt * 16 * 136, 136, St + nt * 16 * 136, 136, p1); \
            p2 = mma_tile<128>(Qg + mt * 16 * 136, 136, St + nt * 16 * 136, 136, p2); \
            { const int l0 = mt * 16 + q * 4, v = nt * 16 + r; float vn[4]; \
              _Pragma("unroll") for (int i = 0; i < 4; ++i) vn[i] = bf2f(Ub[(l0 + i) * 32 + v]) - p1[i]; \
              u32x2 w; w.x = pk2(vn[0], vn[1]); w.y = pk2(vn[2], vn[3]); *(LAS u32x2*)(Vt + v * 72 + l0) = w; } \
            __syncthreads(); \
            p2 = mma_tile<64>(At + mt * 16 * 72, 72, Vt + nt * 16 * 72, 72, p2); \
            { const long t0_ = D2_TOK0(n); \
              _Pragma("unroll") for (int i = 0; i < 4; ++i) O[(t0_ + (mt * 16 + q * 4 + i) * tstep) * 512 + h * 128 + sl * 32 + nt * 16 + r] = f2bf(p2[i]); } \
            S0 = S0 * egL; S1 = S1 * egL; \
            { bf16x8_t ka0, ka1; tr_frag2((unsigned)(unsigned long long)Kg, 288, wid, ka0, ka1); \
              const bf16x8_t vb00 = *(const LAS bf16x8_t*)(Vt + r * 72 + q * 8), vb01 = *(const LAS bf16x8_t*)(Vt + r * 72 + 32 + q * 8); \
              const bf16x8_t vb10 = *(const LAS bf16x8_t*)(Vt + (16 + r) * 72 + q * 8), vb11 = *(const LAS bf16x8_t*)(Vt + (16 + r) * 72 + 32 + q * 8); \
              S0 = __builtin_amdgcn_mfma_f32_16x16x32_bf16(ka0, vb00, S0, 0, 0, 0); S0 = __builtin_amdgcn_mfma_f32_16x16x32_bf16(ka1, vb01, S0, 0, 0, 0); \
              S1 = __builtin_amdgcn_mfma_f32_16x16x32_bf16(ka0, vb10, S1, 0, 0, 0); S1 = __builtin_amdgcn_mfma_f32_16x16x32_bf16(ka1, vb11, S1, 0, 0, 0); } \
            __syncthreads(); } while (0)
        D2_LOAD(0, A); D2_LOAD(1, B);
#pragma unroll 1
        for (int n = 0; n < 64; n += 2) { D2_ITER(n, A); D2_ITER(n + 1, B); }
#undef D2_ITER
#undef D2_LOAD
#undef D2_TOK0
    }
}
constexpr size_t WS_CT = WS_OF, WS_NV = 235 * MiB, WS_MS = 235 * MiB + 524288, WS_CT2 = 169 * MiB, WS_NV2 = 236 * MiB;
__device__ __forceinline__ void mlstm_a(LDSp lds, const Params& p) {
    const bf16_t* Z = (const bf16_t*)(p.ws + WS_Z); const float* LI = (const float*)(p.ws + WS_BETA); const float* LF = (const float*)(p.ws + WS_LA);
    bf16_t* CT = (bf16_t*)(p.ws + WS_CT); float* NV = (float*)(p.ws + WS_NV); float* MS = (float*)(p.ws + WS_MS);
    LAS unsigned short* Ks = (LAS unsigned short*)lds;
    LAS unsigned short* Vr = (LAS unsigned short*)(lds + 9216);
    LAS float* lf = (LAS float*)(lds + 27648); LAS float* li = lf + 64; LAS float* sw = lf + 128; LAS float* red = lf + 192  ;
    const int tid = threadIdx.x, lane = tid & 63, wid = tid >> 6, r = lane & 15, q = lane >> 4;
    for (int unit = blockIdx.x; unit < 2048; unit += gridDim.x) {
        const int dir = unit >> 10, b = (unit >> 8) & 3, h = (unit >> 6) & 3, n = unit & 63, pc = dir ? 63 - n : n;
        const size_t tok0 = (size_t)b * S_ + pc * 64;
        if (tid < 64) { lf[tid] = LF[(tok0 + tid) * 8 + dir * 4 + h]; li[tid] = LI[(tok0 + tid) * 8 + dir * 4 + h]; }
        __syncthreads();
        if (tid < 64) { const float bc = wave_scan_sum(lf[tid], dir == 0);
            const float tot = __shfl(bc, dir ? 0 : 63);
            const float we = tot - bc + li[tid]; float mx = we;
#pragma unroll
            for (int o = 32; o; o >>= 1) mx = fmaxf(mx, __shfl_xor(mx, o));
            sw[tid] = __expf(we - mx);
            if (tid == 0) { MS[unit * 32] = tot; MS[unit * 32 + 1] = mx; } }
        __syncthreads();
        { const int pp = tid >> 3, c8 = tid & 7; const u32x4 kv = *(const u32x4*)(Z + (tok0 + pp) * 2560 + 1280 + h * 64 + c8 * 8); float f[8]; unpack8(kv, f); const float s = sw[pp];
          u32x4 o; o.x = pk2(f[0] * s, f[1] * s); o.y = pk2(f[2] * s, f[3] * s); o.z = pk2(f[4] * s, f[5] * s); o.w = pk2(f[6] * s, f[7] * s);
          *(LAS u32x4*)(Ks + pp * 72 + c8 * 8) = o; }
#pragma unroll
        for (int i = 0; i < 2; ++i) { const int pi = tid + NTHR * i, pp = pi >> 4, c8 = pi & 15;
            *(LAS u32x4*)(Vr + pp * 144 + c8 * 8) = *(const u32x4*)(Z + (tok0 + pp) * 2560 + 1536 + h * 128 + c8 * 8); }
        __syncthreads();
        { bf16x8_t vb0, vb1; tr_frag2((unsigned)(unsigned long long)Vr, 288, wid, vb0, vb1);
#pragma unroll
          for (int dt = 0; dt < 4; ++dt) { bf16x8_t ka0, ka1; tr_frag2((unsigned)(unsigned long long)Ks, 144, dt, ka0, ka1);
            f32x4 acc = {0.f, 0.f, 0.f, 0.f};
            acc = __builtin_amdgcn_mfma_f32_16x16x32_bf16(ka0, vb0, acc, 0, 0, 0); acc = __builtin_amdgcn_mfma_f32_16x16x32_bf16(ka1, vb1, acc, 0, 0, 0);
            u32x2 w; w.x = pk2(acc.x, acc.y); w.y = pk2(acc.z, acc.w);
            *(u32x2*)(CT + (size_t)unit * 8192 + (wid * 16 + r) * 64 + dt * 16 + q * 4) = w; } }
        { const int d = tid & 63; float a = 0.f;
#pragma unroll
          for (int j = 0; j < 8; ++j) a += bf2f(Ks[(wid * 8 + j) * 72 + d]);
          red[wid * 64 + d] = a; }
        __syncthreads();
        if (tid < 64) { float a = 0.f;
#pragma unroll
            for (int w = 0; w < 8; ++w) a += red[w * 64 + tid];
            NV[(size_t)unit * 64 + tid] = a; }
        __syncthreads();
    }
}
__device__ __forceinline__ void mlstm_b(const Params& p) {
    const bf16_t* CT = (const bf16_t*)(p.ws + WS_CT); const float* NV = (const float*)(p.ws + WS_NV); float* MS = (float*)(p.ws + WS_MS); bf16_t* CT2 = (bf16_t*)(p.ws + WS_CT2); float* NV2 = (float*)(p.ws + WS_NV2);
    const int tid = threadIdx.x;
    for (int wgi = blockIdx.x; wgi < 128; wgi += gridDim.x) {
        const int scan = wgi >> 2, part = wgi & 3; const size_t e = (size_t)(part * NTHR + tid) * 4;
        const bool nvw = (part == 0 && tid < 64);
        float m = 0.f, c0 = 0.f, c1 = 0.f, c2 = 0.f, c3 = 0.f, nn = 0.f;
#pragma unroll 1
        for (int hf = 0; hf < 4; ++hf) {
        u32x2 dc[16]; float dn[16], blv[16], mlv[16];
#pragma unroll
        for (int n = 0; n < 16; ++n) { blv[n] = MS[(scan * 64 + hf * 16 + n) * 32]; mlv[n] = MS[(scan * 64 + hf * 16 + n) * 32 + 1]; dc[n] = (EXPC == 2) ? (u32x2){0u, 0u} : *(const u32x2*)(CT + (size_t)(scan * 64 + hf * 16 + n) * 8192 + e); dn[n] = nvw ? NV[(size_t)(scan * 64 + hf * 16 + n) * 64 + tid] : 0.f; }
#pragma unroll
        for (int n = 0; n < 16; ++n) { const int unit = scan * 64 + hf * 16 + n;
            const float bl = blv[n], ml = mlv[n];
            u32x2 w; w.x = pk2(c0, c1); w.y = pk2(c2, c3); *(u32x2*)(CT2 + (size_t)unit * 8192 + e) = w;
            if (nvw) NV2[(size_t)unit * 64 + tid] = nn;
            if (part == 0 && tid == 0) MS[65536 + unit] = m;
            const float mn = fmaxf(bl + m, ml), a = __expf(bl + m - mn), bb = __expf(ml - mn);
            c0 = a * c0 + bb * bflo(dc[n].x); c1 = a * c1 + bb * bfhi(dc[n].x); c2 = a * c2 + bb * bflo(dc[n].y); c3 = a * c3 + bb * bfhi(dc[n].y);
            nn = a * nn + bb * dn[n]; m = mn; }
        }
    }
}
__device__ __forceinline__ void mlstm_c(LDSp lds, const Params& p) {
    const bf16_t* Z = (const bf16_t*)(p.ws + WS_Z); const float* LI = (const float*)(p.ws + WS_BETA); const float* LF = (const float*)(p.ws + WS_LA);
    const bf16_t* CT = (const bf16_t*)(p.ws + WS_CT2); const float* NV = (const float*)(p.ws + WS_NV2); const float* MS = (const float*)(p.ws + WS_MS);
    bf16_t* Y = (bf16_t*)(p.ws + WS_HN); const float* gn = p.in[19];
    LAS unsigned short* Qb = (LAS unsigned short*)lds;
    LAS unsigned short* Kb = (LAS unsigned short*)(lds + 9216);
    LAS unsigned short* Vr = (LAS unsigned short*)(lds + 18432);
    LAS float* ssp = (LAS float*)(lds + 100352);
#define MC_CB(d) ((LAS unsigned short*)(lds + 36864 + (d) * 18432))
#define MC_PB(d) ((LAS unsigned short*)(lds + 73728 + (d) * 9216))
#define MC_SC(d) ((LAS float*)(lds + 92160 + (d) * 4096))
    const int tid = threadIdx.x, wid = tid >> 6;
    for (int unit = blockIdx.x; unit < 1024; unit += gridDim.x) {
        int lane = tid & 63; asm volatile("" : "+v"(lane));
        const int r = lane & 15, q = lane >> 4;
        const int b = unit >> 8, h = (unit >> 6) & 3, pc = unit & 63; const size_t tok0 = (size_t)b * S_ + pc * 64;
        const size_t ua = (size_t)(((0 * 4 + b) * 4 + h) * 64 + pc), ub = (size_t)(((1 * 4 + b) * 4 + h) * 64 + (63 - pc));
        { const int pp = tid >> 3, c8 = tid & 7;
          *(LAS u32x4*)(Qb + pp * 72 + c8 * 8) = *(const u32x4*)(Z + (tok0 + pp) * 2560 + 1024 + h * 64 + c8 * 8);
          *(LAS u32x4*)(Kb + pp * 72 + c8 * 8) = *(const u32x4*)(Z + (tok0 + pp) * 2560 + 1280 + h * 64 + c8 * 8); }
#pragma unroll
        for (int i = 0; i < 2; ++i) { const int pi = tid + NTHR * i, pp = pi >> 4, c8 = pi & 15; *(LAS u32x4*)(Vr + pp * 144 + c8 * 8) = *(const u32x4*)(Z + (tok0 + pp) * 2560 + 1536 + h * 128 + c8 * 8); }
#pragma unroll
        for (int i = 0; i < 2; ++i) { const int pi = tid + NTHR * i, v = pi >> 3, c8 = pi & 7;
            *(LAS u32x4*)(MC_CB(0) + v * 72 + c8 * 8) = *(const u32x4*)(CT + ua * 8192 + v * 64 + c8 * 8); *(LAS u32x4*)(MC_CB(1) + v * 72 + c8 * 8) = *(const u32x4*)(CT + ub * 8192 + v * 64 + c8 * 8); }
        float mst = 0.f;
        if (tid < 128) { const int d = tid >> 6; const size_t ud = d ? ub : ua; LAS float* sc = MC_SC(d);
            sc[lane] = LF[(tok0 + lane) * 8 + d * 4 + h]; sc[64 + lane] = LI[(tok0 + lane) * 8 + d * 4 + h]; sc[384 + lane] = NV[ud * 64 + lane]; mst = MS[65536 + ud]; }
        __syncthreads();
        bf16x8_t vb0, vb1; tr_frag2((unsigned)(unsigned long long)Vr, 288, wid, vb0, vb1);
        {
            const int t = tid >> 3, part = tid & 7; const u32x4 qv = *(const LAS u32x4*)(Qb + t * 72 + part * 8); float f[8]; unpack8(qv, f);
#pragma unroll
            for (int d = 0; d < 2; ++d) { LAS float* sc = MC_SC(d);
                const f32x4 n0 = *(const LAS f32x4*)(sc + 384 + part * 8), n1 = *(const LAS f32x4*)(sc + 384 + part * 8 + 4);
                float a = f[0] * n0.x; a = fmaf(f[1], n0.y, a); a = fmaf(f[2], n0.z, a); a = fmaf(f[3], n0.w, a); a = fmaf(f[4], n1.x, a); a = fmaf(f[5], n1.y, a); a = fmaf(f[6], n1.z, a); a = fmaf(f[7], n1.w, a);
                a += dppf<0xB1>(a); a += dppf<0x4E>(a); a += dppf<0x141>(a);
                if (part == 0) sc[320 + t] = a; } }
        if (tid < 128) {
            const int d = tid >> 6; LAS float* sc = MC_SC(d);
            const float bt = wave_scan_sum(sc[lane], d == 0);
            const float dmax = bt + wave_scan_max(sc[64 + lane] - bt, d == 0);
            const float m = fmaxf(bt + mst, dmax), w = __expf(bt + mst - m);
            sc[128 + lane] = bt; sc[192 + lane] = m; sc[256 + lane] = w * 0.125f; sc[448 + lane] = __expf(-m); }
        __syncthreads();
#pragma unroll 1
        for (int tt = 0; tt < 2; ++tt) { const int idx = wid * 2 + tt, mt = idx >> 2, nt = idx & 3;
            f32x4 scv = {0.f, 0.f, 0.f, 0.f};
            scv = mma_tile<64>(Qb + mt * 16 * 72, 72, Kb + nt * 16 * 72, 72, scv);
            const int s_ = nt * 16 + r;
#pragma unroll 1
            for (int d = 0; d < 2; ++d) { LAS float* sc = MC_SC(d); LAS unsigned short* Pb = MC_PB(d); const float bs = sc[128 + s_] - sc[64 + s_];
#pragma unroll
                for (int i = 0; i < 4; ++i) { const int t = mt * 16 + q * 4 + i; const bool ok = d ? (s_ >= t) : (s_ <= t);
                    const float pv = ok ? __expf(sc[128 + t] - bs - sc[192 + t]) * scv[i] * 0.125f : 0.f;
                    const unsigned short pb = f2bf(pv); Pb[t * 72 + s_] = pb;
                    const float rs = row16_sum(bf2f(pb));
                    if (r == 0) sc[512 + nt * 64 + t] = rs; } }
        }
        __syncthreads();
        f32x4 hacc[4];
#pragma unroll
        for (int mt = 0; mt < 4; ++mt) { hacc[mt] = (f32x4){0.f, 0.f, 0.f, 0.f};
            const bf16x8_t qa0 = *(const LAS bf16x8_t*)(Qb + (mt * 16 + r) * 72 + q * 8), qa1 = *(const LAS bf16x8_t*)(Qb + (mt * 16 + r) * 72 + 32 + q * 8);
#pragma unroll 1
            for (int d = 0; d < 2; ++d) { const LAS float* sc = MC_SC(d); const LAS unsigned short* Pb = MC_PB(d); const LAS unsigned short* Cb = MC_CB(d);
                f32x4 a1 = {0.f, 0.f, 0.f, 0.f}, a2 = {0.f, 0.f, 0.f, 0.f};
                const bf16x8_t cb0 = *(const LAS bf16x8_t*)(Cb + (wid * 16 + r) * 72 + q * 8), cb1 = *(const LAS bf16x8_t*)(Cb + (wid * 16 + r) * 72 + 32 + q * 8);
                a1 = __builtin_amdgcn_mfma_f32_16x16x32_bf16(qa0, cb0, a1, 0, 0, 0); a1 = __builtin_amdgcn_mfma_f32_16x16x32_bf16(qa1, cb1, a1, 0, 0, 0);
                const bf16x8_t pa0 = *(const LAS bf16x8_t*)(Pb + (mt * 16 + r) * 72 + q * 8), pa1 = *(const LAS bf16x8_t*)(Pb + (mt * 16 + r) * 72 + 32 + q * 8);
                a2 = __builtin_amdgcn_mfma_f32_16x16x32_bf16(pa0, vb0, a2, 0, 0, 0); a2 = __builtin_amdgcn_mfma_f32_16x16x32_bf16(pa1, vb1, a2, 0, 0, 0);
#pragma unroll
                for (int i = 0; i < 4; ++i) { const int t = mt * 16 + q * 4 + i;
                    const float den = sc[256 + t] * sc[320 + t] + ((sc[512 + t] + sc[576 + t]) + (sc[640 + t] + sc[704 + t]));
                    hacc[mt][i] += (sc[256 + t] * a1[i] + a2[i]) * __builtin_amdgcn_rcpf(fmaxf(fabsf(den), sc[448 + t])); }
            }
        }
#pragma unroll
        for (int mt = 0; mt < 4; ++mt)
#pragma unroll
            for (int i = 0; i < 4; ++i) { const float s = row16_sum(hacc[mt][i] * hacc[mt][i]); if (r == 0) ssp[wid * 64 + mt * 16 + q * 4 + i] = s; }
        __syncthreads();
        { const int v = wid * 16 + r; const float g = gn[v]; LAS unsigned short* Yt = MC_CB(0);
#pragma unroll
          for (int mt = 0; mt < 4; ++mt)
#pragma unroll
              for (int i = 0; i < 4; ++i) { const int t = mt * 16 + q * 4 + i;
                  float ss = 0.f;
#pragma unroll
                  for (int w = 0; w < 8; ++w) ss += ssp[w * 64 + t];
                  const float rstd = rsqrtf(ss * (1.0f / 128.0f) + 1e-6f);
                  Yt[t * 136 + v] = f2bf(hacc[mt][i] * rstd * g); } }
        __syncthreads();
#pragma unroll
        for (int i = 0; i < 2; ++i) { const int pi = tid + NTHR * i, t = pi >> 4, c8 = (pi & 15) * 8;
            const u32x4 yv = *(const LAS u32x4*)(MC_CB(0) + t * 136 + c8); const u32x4 ov = *(const u32x4*)(Z + (tok0 + t) * 2560 + 2048 + h * 128 + c8);
            float y[8], o[8]; unpack8(yv, y); unpack8(ov, o);
            u32x4 w; w.x = pk2(y[0] * sigm_f(o[0]), y[1] * sigm_f(o[1])); w.y = pk2(y[2] * sigm_f(o[2]), y[3] * sigm_f(o[3])); w.z = pk2(y[4] * sigm_f(o[4]), y[5] * sigm_f(o[5])); w.w = pk2(y[6] * sigm_f(o[6]), y[7] * sigm_f(o[7]));
            *(u32x4*)(Y + (tok0 + t) * 1024 + 512 + h * 128 + c8) = w; }
        __syncthreads();
    }
#undef MC_CB
#undef MC_PB
#undef MC_SC
}
__device__ __forceinline__ void headnorm_phase(const Params& p, const float* __restrict__ g, int zld, int zcol, int act) {
    const bf16_t* OF = (const bf16_t*)(p.ws + WS_OF); const bf16_t* OB = (const bf16_t*)(p.ws + WS_OB); const bf16_t* Z = (const bf16_t*)(p.ws + WS_Z); bf16_t* Y = (bf16_t*)(p.ws + WS_HN);
    const int tid = threadIdx.x, lane = tid & 63, wid = tid >> 6, c = lane * 8;
    const f32x4 g0 = *(const f32x4*)(g + (c & 127)), g1 = *(const f32x4*)(g + (c & 127) + 4);
    for (int tok = blockIdx.x * 8 + wid; tok < T_; tok += gridDim.x * 8) {
        const u32x4 a = *(const u32x4*)(OF + (size_t)tok * 512 + c), bq = *(const u32x4*)(OB + (size_t)tok * 512 + c), gz = *(const u32x4*)(Z + (size_t)tok * zld + zcol + c);
        float fa[8], fb[8], fg[8], o[8]; unpack8(a, fa); unpack8(bq, fb); unpack8(gz, fg);
        float ss = 0.f;
#pragma unroll
        for (int i = 0; i < 8; ++i) { o[i] = fa[i] + fb[i]; ss = fmaf(o[i], o[i], ss); }
        ss = row16_sum(ss);
        const float rstd = rsqrtf(ss * (1.0f / 128.0f) + 1e-6f);
        const float gg[8] = {g0.x, g0.y, g0.z, g0.w, g1.x, g1.y, g1.z, g1.w};
        float y[8];
#pragma unroll
        for (int i = 0; i < 8; ++i) y[i] = o[i] * rstd * gg[i] * (act == 0 ? fg[i] * sigm_f(fg[i]) : sigm_f(fg[i]));
        u32x4 w; w.x = pk2(y[0], y[1]); w.y = pk2(y[2], y[3]); w.z = pk2(y[4], y[5]); w.w = pk2(y[6], y[7]);
        *(u32x4*)(Y + (size_t)tok * 1024 + 512 + c) = w;
    }
}

__device__ __forceinline__ void odd_prep(const Params& p) {
    const bf16_t* Z = (const bf16_t*)(p.ws + WS_Z); bf16_t* VV = (bf16_t*)(p.ws + WS_QKV);
    const float* gates = (const float*)(p.ws + WS_GATES); float* LI = (float*)(p.ws + WS_BETA); float* LF = (float*)(p.ws + WS_LA);
    const float* ln_g = p.in[13]; const float* ln_b = p.in[14]; const float* ib = p.in[17]; const float* fb = p.in[18];
    const int tid = threadIdx.x, lane = tid & 63, wid = tid >> 6, c = lane * 8;
    const f32x4 g0 = *(const f32x4*)(ln_g + c), g1 = *(const f32x4*)(ln_g + c + 4), b0 = *(const f32x4*)(ln_b + c), b1 = *(const f32x4*)(ln_b + c + 4);
    const float gg[8] = {g0.x, g0.y, g0.z, g0.w, g1.x, g1.y, g1.z, g1.w}, bb[8] = {b0.x, b0.y, b0.z, b0.w, b1.x, b1.y, b1.z, b1.w};
    for (int tok = blockIdx.x * 8 + wid; tok < T_; tok += gridDim.x * 8) {
        const u32x4 v = *(const u32x4*)(Z + (size_t)tok * 2560 + 512 + c);
        float x[8]; unpack8(v, x); float sm = 0.f;
#pragma unroll
        for (int i = 0; i < 8; ++i) { x[i] = gelu_t(x[i]); sm += x[i]; }
        const float mean = wave_sum(sm) * (1.0f / 512.0f); float sq = 0.f;
#pragma unroll
        for (int i = 0; i < 8; ++i) { x[i] -= mean; sq = fmaf(x[i], x[i], sq); }
        const float rstd = rsqrtf(wave_sum(sq) * (1.0f / 512.0f) + 1e-5f);
        float y[8];
#pragma unroll
        for (int i = 0; i < 8; ++i) y[i] = x[i] * rstd * gg[i] + bb[i];
        u32x4 w; w.x = pk2(y[0], y[1]); w.y = pk2(y[2], y[3]); w.z = pk2(y[4], y[5]); w.w = pk2(y[6], y[7]);
        *(u32x4*)(VV + (size_t)tok * 512 + c) = w;
        if (lane < 8) { LI[(size_t)tok * 8 + lane] = gates[(size_t)tok * 16 + lane] + ib[lane];
                        LF[(size_t)tok * 8 + lane] = -softplus_(-(gates[(size_t)tok * 16 + 8 + lane] + fb[lane])); }
    }
}

__device__ __forceinline__ void sg_phase(LDSp lds, const Params& p, int sgId, int sgG) {
    typedef short bf16x8 __attribute__((ext_vector_type(8)));
    const bf16_t* Z = (const bf16_t*)(p.ws + WS_Z); const bf16_t* VV = (const bf16_t*)(p.ws + WS_QKV); bf16_t* Y = (bf16_t*)(p.ws + WS_HN);
    const float* sgw = p.in[15]; const float* sgb = p.in[16];
    LAS unsigned short* Wb = (LAS unsigned short*)lds;
    LAS unsigned short* Vt = (LAS unsigned short*)(lds + 34816);
    const int tid = threadIdx.x, lane = tid & 63, wid = tid >> 6;
    for (int unit = sgId; unit < 512; unit += sgG) {
        const int g = unit & 3, n = (unit >> 2) & 31, b = unit >> 7; const size_t tok0 = (size_t)b * S_ + n * 128;
#pragma unroll
        for (int i = 0; i < 8; ++i) { const int i4 = tid + NTHR * i, t = i4 >> 5, s4 = (i4 & 31) << 2; const f32x4 w = *(const f32x4*)(sgw + (size_t)g * 16384 + t * 128 + s4);
            u32x2 o; o.x = pk2(w.x, w.y); o.y = pk2(w.z, w.w); *(LAS u32x2*)(Wb + t * 136 + s4) = o; }
#pragma unroll
        for (int i = 0; i < 4; ++i) { const int pi = tid + NTHR * i, s = pi >> 4, c8 = (pi & 15) << 3; const u32x4 v = *(const u32x4*)(VV + (tok0 + s) * 512 + g * 128 + c8);
            Vt[(c8 + 0) * 136 + s] = (unsigned short)(v.x & 0xffffu); Vt[(c8 + 1) * 136 + s] = (unsigned short)(v.x >> 16);
            Vt[(c8 + 2) * 136 + s] = (unsigned short)(v.y & 0xffffu); Vt[(c8 + 3) * 136 + s] = (unsigned short)(v.y >> 16);
            Vt[(c8 + 4) * 136 + s] = (unsigned short)(v.z & 0xffffu); Vt[(c8 + 5) * 136 + s] = (unsigned short)(v.z >> 16);
            Vt[(c8 + 6) * 136 + s] = (unsigned short)(v.w & 0xffffu); Vt[(c8 + 7) * 136 + s] = (unsigned short)(v.w >> 16); }
        __syncthreads();
        bf16x8 af[4];
#pragma unroll
        for (int ks = 0; ks < 4; ++ks) af[ks] = *(const LAS bf16x8*)(Wb + (16 * wid + (lane & 15)) * 136 + ks * 32 + (lane >> 4) * 8);
        f32x4 accs[8];
#pragma unroll
        for (int nn = 0; nn < 8; ++nn) {
            f32x4 acc = {0.f, 0.f, 0.f, 0.f};
#pragma unroll
            for (int ks = 0; ks < 4; ++ks) { const bf16x8 bfrag = *(const LAS bf16x8*)(Vt + (16 * nn + (lane & 15)) * 136 + ks * 32 + (lane >> 4) * 8);
                acc = __builtin_amdgcn_mfma_f32_16x16x32_bf16(af[ks], bfrag, acc, 0, 0, 0); }
            accs[nn] = acc; }
        __syncthreads();
#pragma unroll
        for (int nn = 0; nn < 8; ++nn)
#pragma unroll
            for (int i = 0; i < 4; ++i) { const int t = 16 * wid + (lane >> 4) * 4 + i; Wb[t * 136 + 16 * nn + (lane & 15)] = f2bf(accs[nn][i] + sgb[g * 128 + t]); }
        __syncthreads();
#pragma unroll
        for (int i = 0; i < 4; ++i) { const int pi = tid + NTHR * i, t = pi >> 4, c8 = (pi & 15) << 3; const size_t tok = tok0 + t;
            const u32x4 mv = *(const LAS u32x4*)(Wb + t * 136 + c8); const u32x4 uv = *(const u32x4*)(Z + tok * 2560 + g * 128 + c8);
            float m[8], u[8]; unpack8(mv, m); unpack8(uv, u);
            u32x4 w; w.x = pk2(gelu_t(u[0]) * m[0], gelu_t(u[1]) * m[1]); w.y = pk2(gelu_t(u[2]) * m[2], gelu_t(u[3]) * m[3]); w.z = pk2(gelu_t(u[4]) * m[4], gelu_t(u[5]) * m[5]); w.w = pk2(gelu_t(u[6]) * m[6], gelu_t(u[7]) * m[7]);
            *(u32x4*)(Y + tok * 1024 + g * 128 + c8) = w; }
        __syncthreads();
    }
}

#define XB_TMO      128
#define XB_XCNT(j)  (256  + 64 * (j))
#define XB_XSUB(j)  (1280 + 64 * (j))
#define XB_XGEN(j)  (2304 + 64 * (j))
#define XB_TOP      3328
#define XB_TOPGEN   3392
#define XCD_BAR_WORDS 3456
#define XB_SPIN_CAP (1u << 18)

__device__ __forceinline__ unsigned xb_ld(unsigned* p)              { return __hip_atomic_load(p, __ATOMIC_RELAXED, __HIP_MEMORY_SCOPE_AGENT); }
__device__ __forceinline__ unsigned xb_add(unsigned* p, unsigned v) { return __hip_atomic_fetch_add(p, v, __ATOMIC_RELAXED, __HIP_MEMORY_SCOPE_AGENT); }
__device__ __forceinline__ unsigned xb_xcc_id() { return (unsigned)__builtin_amdgcn_s_getreg((3 << 11) | 20) & 0xFu; }
#define XB_SPIN(cond, bar) do { unsigned _sp = 0; while (cond) { __builtin_amdgcn_s_sleep(1); \
    if ((++_sp & 255u) == 0u) { if (xb_ld(&(bar)[XB_TMO])) break; if (_sp > XB_SPIN_CAP) { atomicAdd(&(bar)[XB_TMO], 1u); break; } } } } while (0)

struct XcdBarrier {
    unsigned* bar; unsigned x;
    volatile LAS unsigned* st;
};

__device__ __forceinline__ XcdBarrier xcd_barrier_post(unsigned* bar, volatile LAS unsigned* st) {
    XcdBarrier b; b.bar = bar; b.x = xb_xcc_id(); b.st = st;
    if (threadIdx.x == 0) (void)xb_add(&bar[XB_XCNT(b.x)], 1u);
    return b;
}
__device__ __forceinline__ void xcd_barrier_complete(unsigned* bar, unsigned x, unsigned& nloc, unsigned& nx) {
    const unsigned G = gridDim.x * gridDim.y * gridDim.z;
    unsigned sum, cnt, mine, sp = 0u;
    for (;;) {
        sum = 0u; cnt = 0u; mine = 0u;
#pragma unroll
        for (unsigned j = 0; j < 16; ++j) { const unsigned c = xb_ld(&bar[XB_XCNT(j)]); sum += c; cnt += (c > 0u) ? 1u : 0u; mine = (j == x) ? c : mine; }
        if (sum == G) break;
        __builtin_amdgcn_s_sleep(1);
        if ((++sp & 255u) == 0u) { if (xb_ld(&bar[XB_TMO])) break; if (sp > XB_SPIN_CAP) { atomicAdd(&bar[XB_TMO], 1u); break; } }
    }
    nloc = mine > 0u ? mine : 1u; nx = cnt > 0u ? cnt : 1u;
}

__device__ __forceinline__ void xcd_barrier(const XcdBarrier& b) {
    asm volatile("s_waitcnt vmcnt(0)" ::: "memory");
    __syncthreads();
    if (threadIdx.x == 0) {
        unsigned* bar = b.bar;
        __builtin_amdgcn_s_waitcnt(0);
        unsigned nloc = b.st[0], nx = b.st[1];
        if (nloc == 0u) { xcd_barrier_complete(bar, b.x, nloc, nx); b.st[0] = nloc; b.st[1] = nx; }
        const unsigned old = xb_add(&bar[XB_XSUB(b.x)], 1u);
        const unsigned gen = old / nloc;
        if (old + 1u == (gen + 1u) * nloc) {
            __builtin_amdgcn_fence(__ATOMIC_RELEASE, "agent");
            asm volatile("s_waitcnt vmcnt(0)" ::: "memory");
            const unsigned og = xb_add(&bar[XB_TOP], 1u);
            const unsigned tg = og / nx;
            if (og + 1u == (tg + 1u) * nx) xb_add(&bar[XB_TOPGEN], 1u);
            else XB_SPIN(xb_ld(&bar[XB_TOPGEN]) == tg, bar);
            __builtin_amdgcn_fence(__ATOMIC_ACQUIRE, "agent");
            xb_add(&bar[XB_XGEN(b.x)], 1u);
            asm volatile("s_waitcnt vmcnt(0)" ::: "memory");
        } else {
            XB_SPIN(xb_ld(&bar[XB_XGEN(b.x)]) == gen, bar);
            __builtin_amdgcn_fence(__ATOMIC_ACQUIRE, "agent");
            asm volatile("s_waitcnt vmcnt(0)" ::: "memory");
        }
    }
    __syncthreads();
}
constexpr size_t WS_BAR = 238 * MiB;
#ifndef N_PHASES
#define N_PHASES 21
#endif
template <int L, int SUB> __device__ __forceinline__ void run_phase(LDSp lds, const Params& p) {
    unsigned char* ws = p.ws;
    bf16_t* HN = (bf16_t*)(ws + WS_HN); bf16_t* Zb = (bf16_t*)(ws + WS_Z); float* h = p.out; float* gates = (float*)(ws + WS_GATES);
    const bf16_t* W_IN = (const bf16_t*)(ws + WS_WB + WB_IN); const bf16_t* W_OUT = (const bf16_t*)(ws + WS_WB + WB_OUT);
    const bf16_t* W_UP = (const bf16_t*)(ws + WS_WB + WB_UP); const bf16_t* W_DN = (const bf16_t*)(ws + WS_WB + WB_DN);
    const int G = gridDim.x;
    if constexpr (L == 2) { rms_phase(lds, h, p.in[25], nullptr, nullptr, h, nullptr, 0, 0, nullptr); }
    else if constexpr (SUB == 0) {
        convert_layer(lds, p, L);
        if constexpr (L == 0) rms_phase(lds, p.in[0], p.in[1], HN, nullptr, nullptr, p.in[2], 3088, 3072, gates);
        else                  rms_phase(lds, h, p.in[1] + 1024, HN, nullptr, nullptr, p.in[12], 2576, 2560, gates);
    } else if constexpr (SUB == 1) { constexpr int N = L == 0 ? 3072 : 2560;
        pg8::Gemm g{HN, W_IN, T_, N, 1024}; pg8::StaticOrder S; S.init(T_, N, G, (int)blockIdx.x);
        pg8::EpiBf16<0> E{Zb, N, nullptr, 0, 0};
        pg8::gemm_phase_sp2<pg8::EpiBf16<0>, pg8::StaticOrder, true, true>(lds, g, S, E);
    } else if constexpr (SUB == 2) { if constexpr (L == 0) even_prep(lds, p); else odd_prep(p); }
    else if constexpr (SUB == 9) { delta_prep(lds, p); }
    else if constexpr (SUB == 10) { mlstm_b(p); }
    else if constexpr (SUB == 11) { mlstm_c(lds, p); }
    else if constexpr (SUB == 3) {
        if constexpr (L == 0) delta_scan2(lds, p);
        else { mlstm_a(lds, p); sg_phase(lds, p, (int)blockIdx.x, G); }
    } else if constexpr (SUB == 4) { if constexpr (L == 0) headnorm_phase(p, p.in[10], 3072, 2560, 0); else headnorm_phase(p, p.in[19], 2560, 2048, 1); }
    else if constexpr (SUB == 5) { pg8::Gemm g{HN, W_OUT, T_, 1024, 1024}; pg8::StaticOrder S; S.init(T_, 1024, G, (int)blockIdx.x);
        pg8::EpiAddF32 E{h, 1024, L == 0 ? p.in[0] : (const float*)h};
        pg8::gemm_phase_sp2<pg8::EpiAddF32, pg8::StaticOrder, false, true>(lds, g, S, E);
    } else if constexpr (SUB == 6) { rms_phase(lds, h, p.in[21] + L * 1024, HN, nullptr, nullptr, nullptr, 0, 0, nullptr); }
    else if constexpr (SUB == 7) { pg8::Gemm g{HN, W_UP, T_, 2 * DFF, 1024}; pg8::StaticOrder S; S.init(T_, 2 * DFF, G, (int)blockIdx.x);
        pg8::EpiSwiGLU E{Zb, DFF};
        pg8::gemm_phase_sp2<pg8::EpiSwiGLU, pg8::StaticOrder, true, true>(lds, g, S, E);
    } else if constexpr (SUB == 8) { pg8::Gemm g{Zb, W_DN, T_, 1024, DFF}; pg8::StaticOrder S; S.init(T_, 1024, G, (int)blockIdx.x);
        pg8::EpiAddF32 E{h, 1024, (const float*)h};
        pg8::gemm_phase_sp2<pg8::EpiAddF32, pg8::StaticOrder, false, true>(lds, g, S, E);
    }
}
__global__ void __launch_bounds__(NTHR, 2) mega(Params p, int ph_lo, int ph_hi) {
    extern __shared__ __attribute__((aligned(16))) unsigned char lds_raw[];
    LDSp lds = (LDSp)lds_raw;
    cg::grid_group grid = cg::this_grid();
    volatile LAS unsigned* xst = (volatile LAS unsigned*)(lds + LDS_BYTES - 16);
    if (threadIdx.x == 0) { xst[0] = 0u; xst[1] = 0u; }
    __syncthreads();
    XcdBarrier xbar; xbar.bar = (unsigned*)(p.ws + WS_BAR); xbar.x = 0; xbar.st = xst;
    if (ph_hi - ph_lo > 1) xbar = xcd_barrier_post((unsigned*)(p.ws + WS_BAR), xst);
#ifndef REP_MASK
#define REP_MASK 0
#endif
#define PH(k, L, SUB) if (ph_lo <= (k) && (k) < ph_hi) { run_phase<L, SUB>(lds, p); if ((REP_MASK >> (k)) & 1) { __syncthreads(); run_phase<L, SUB>(lds, p); } if ((k) + 1 < ph_hi) { if (ph_lo < 0) grid.sync(); else xcd_barrier(xbar); } }
    PH(0, 0, 0) PH(1, 0, 1) PH(2, 0, 2) PH(3, 0, 9) PH(4, 0, 3) PH(5, 0, 4) PH(6, 0, 5) PH(7, 0, 6) PH(8, 0, 7) PH(9, 0, 8)
    PH(10, 1, 0) PH(11, 1, 1) PH(12, 1, 2) PH(13, 1, 3) PH(14, 1, 10) PH(15, 1, 11)
    PH(16, 1, 5) PH(17, 1, 6) PH(18, 1, 7) PH(19, 1, 8)
    PH(20, 2, 0)
#ifdef EXTRA_SYNCS
    for (int i_ = 0; i_ < EXTRA_SYNCS; ++i_) grid.sync();
#endif
#undef PH
}

extern "C" void kernel_launch(void* const* d_in, const int* in_sizes, int n_in, void* d_out, int out_size, void* d_ws, size_t ws_size, hipStream_t stream) {
    static int grid = 0;
    if (grid == 0) {
        int dev = 0, cus = 0, per_cu = 0;
        (void)hipGetDevice(&dev);
        (void)hipDeviceGetAttribute(&cus, hipDeviceAttributeMultiprocessorCount, dev);
        (void)hipFuncSetAttribute((const void*)mega, hipFuncAttributeMaxDynamicSharedMemorySize, LDS_BYTES);
        if (hipOccupancyMaxActiveBlocksPerMultiprocessor(&per_cu, (const void*)mega, NTHR, LDS_BYTES) != hipSuccess || per_cu < 1) per_cu = 1;
        (void)hipGetLastError();
        if (cus <= 0) cus = 256;
        grid = cus * per_cu;
    }
    if (ws_size < 239 * MiB) { fprintf(stderr, "workspace too small: %zu\n", ws_size); return; }
    Params p{};
    for (int i = 0; i < 26; ++i) p.in[i] = (const float*)d_in[i];
    p.out = (float*)d_out; p.ws = (unsigned char*)d_ws;
#if defined(MULTI_LAUNCH)
    for (int ph = 0; ph < N_PHASES; ++ph) hipLaunchKernelGGL(mega, dim3(grid), dim3(NTHR), LDS_BYTES, stream, p, ph, ph + 1);
#else
    (void)hipMemsetAsync((char*)d_ws + WS_BAR, 0, XCD_BAR_WORDS * 4, stream);
    int lo = 0, hi = N_PHASES;
    void* args[] = {(void*)&p, (void*)&lo, (void*)&hi};
    hipError_t e = hipLaunchCooperativeKernel((const void*)mega, dim3(grid), dim3(NTHR), args, LDS_BYTES, stream);
    if (e != hipSuccess) fprintf(stderr, "cooperative launch failed: %s (grid %d)\n", hipGetErrorString(e), grid);
#endif
}
```

```cpp
#include <hip/hip_runtime.h>
#include <hip/hip_cooperative_groups.h>
#include <cstdio>
namespace cg = cooperative_groups;
namespace pg8 {
#define PG8_LAS __attribute__((address_space(3)))
typedef unsigned short bf16_t;
typedef short bf16x8 __attribute__((ext_vector_type(8)));
typedef float f32x4 __attribute__((ext_vector_type(4)));
typedef unsigned u32x4 __attribute__((ext_vector_type(4)));
constexpr int BM = 256, BK = 64, HALF = 128, HTB = HALF * BK * 2  , STAGE_BYTES = 8 * HTB, NXCD = 8, WGM = 8;

__host__ __device__ __forceinline__ int lds_byte(int r, int c) { const int st = (r >> 4) * 2 + (c >> 5), rr = r & 15, cc = c & 31, ob = rr * 64 + cc * 2; return st * 1024 + (ob ^ (((ob >> 9) & 1) << 5)); }
__host__ __device__ __forceinline__ void stage_rc(int b, int& R, int& C) { const int st = b / 1024, sb = b % 1024, swz = sb ^ (((sb >> 9) & 1) << 5); R = (st >> 1) * 16 + swz / 64; C = (st & 1) * 32 + (swz % 64) / 2; }
__host__ __device__ __forceinline__ int perm32(int rho) { const int n = rho >> 4, i = rho & 15; return 8 * (i >> 2) + 4 * n + (i & 3); }

struct Unit { int pm, pn; };
struct Gemm { const bf16_t* A; const bf16_t* Bt; int M, N, K; };

struct StaticOrder {
    int nM, nN, nwg, G, c;
    __host__ __device__ void init(int M, int N, int G_, int c_) { nM = M / BM; nN = N / BM; nwg = nM * nN; G = G_; c = c_; }
    __host__ __device__ bool next(int i, Unit& u) const {
        const long L = (long)i * G + c; if (L >= nwg) return false;
        int wgid = (int)L; { const int q = nwg / NXCD, r = nwg % NXCD, xcd = wgid % NXCD, off = wgid / NXCD; wgid = (xcd < r ? xcd * (q + 1) : r * (q + 1) + (xcd - r) * q) + off; }
        const int nig = WGM * nN, gid = wgid / nig, fm = gid * WGM, gsz = (nM - fm) < WGM ? (nM - fm) : WGM;
        u.pm = fm + ((wgid % nig) % gsz); u.pn = (wgid % nig) / gsz; return true;
    }
    __device__ __forceinline__ void a_ready(const Unit&) const {}
    __device__ __forceinline__ void done(const Unit&) const {}
};
__device__ __forceinline__ unsigned cvt_pk_bf16(float lo, float hi) { unsigned r; asm volatile("v_cvt_pk_bf16_f32 %0, %1, %2" : "=v"(r) : "v"(lo), "v"(hi)); return r; }
typedef float f32x2 __attribute__((ext_vector_type(2)));
__device__ __forceinline__ f32x2 gelu_pk(f32x2 v) {
    const f32x2 av = __builtin_elementwise_abs(v), d = av * 0.2316418882f + 1.0f;
    f32x2 t; t.x = __builtin_amdgcn_rcpf(d.x); t.y = __builtin_amdgcn_rcpf(d.y);
    f32x2 q = t * 0.5307027145f + (-0.7265760135f); q = q * t + 0.7107068705f; q = q * t + (-0.142248368f); q = q * t + 0.127414796f; q = q * t;
    const f32x2 s = (v * v) * (-0.72134752044f);
    f32x2 e; e.x = __builtin_amdgcn_exp2f(s.x); e.y = __builtin_amdgcn_exp2f(s.y);
    const f32x2 m = v * (q * e), r = v - m;
    f32x2 o; o.x = v.x < 0.f ? m.x : r.x; o.y = v.y < 0.f ? m.y : r.y; return o;
}
template <int ACT  > struct EpiBf16 {
    static constexpr bool PERM = true, AFTER_DRAIN = false;
    bf16_t* O; int ldc; const float* bias; int split_cols; size_t split_stride;
    __device__ __forceinline__ void operator()(const f32x4 (&acc)[2][2][4][2], const Unit& u, int wr, int wc, int fr, int fq) const {
        const int row0 = u.pm * BM + wr * 64 + fr; int colt = u.pn * BM; bf16_t* base = O;
        if (split_cols) { const int t = colt / split_cols; base += (size_t)t * split_stride; colt -= t * split_cols; }
        const int col0 = colt + wc * 32 + 8 * fq, bcol0 = u.pn * BM + wc * 32 + 8 * fq;
        f32x4 bv[2][2];
#pragma unroll
        for (int bj = 0; bj < 2; ++bj)
#pragma unroll
            for (int n = 0; n < 2; ++n) bv[bj][n] = bias ? *(const f32x4*)(bias + bcol0 + bj * HALF + 4 * n) : (f32x4){0.f, 0.f, 0.f, 0.f};
#pragma unroll
        for (int ai = 0; ai < 2; ++ai)
#pragma unroll
            for (int m = 0; m < 4; ++m) { bf16_t* rowp = base + (size_t)(row0 + ai * HALF + m * 16) * ldc + col0;
#pragma unroll
                for (int bj = 0; bj < 2; ++bj) { f32x4 v0 = acc[ai][bj][m][0] + bv[bj][0], v1 = acc[ai][bj][m][1] + bv[bj][1];
                    if (ACT == 1) { f32x2 a = gelu_pk((f32x2){v0[0], v0[1]}), b = gelu_pk((f32x2){v0[2], v0[3]}), c = gelu_pk((f32x2){v1[0], v1[1]}), d = gelu_pk((f32x2){v1[2], v1[3]});
                        v0 = (f32x4){a.x, a.y, b.x, b.y}; v1 = (f32x4){c.x, c.y, d.x, d.y}; }
                    if (ACT == 2) {
#pragma unroll
                        for (int j = 0; j < 4; ++j) { v0[j] = 0.5f * v0[j] * (1.0f + erff(v0[j] * 0.70710678f)); v1[j] = 0.5f * v1[j] * (1.0f + erff(v1[j] * 0.70710678f)); } }
                    u32x4 w; w.x = cvt_pk_bf16(v0[0], v0[1]); w.y = cvt_pk_bf16(v0[2], v0[3]); w.z = cvt_pk_bf16(v1[0], v1[1]); w.w = cvt_pk_bf16(v1[2], v1[3]);
                    *(u32x4*)(rowp + bj * HALF) = w; } }
    }
};
struct EpiAddF32 {
    static constexpr bool PERM = false, AFTER_DRAIN = false;
    float* C; int ldc; const float* R;
    __device__ __forceinline__ void operator()(const f32x4 (&acc)[2][2][4][2], const Unit& u, int wr, int wc, int fr, int fq) const {
        const int row0 = u.pm * BM + wr * 64 + fr, col0 = u.pn * BM + wc * 32 + 4 * fq;
#pragma unroll
        for (int ai = 0; ai < 2; ++ai)
#pragma unroll
            for (int m = 0; m < 4; ++m) { const size_t ro = (size_t)(row0 + ai * HALF + m * 16) * ldc + col0; float* rowp = C + ro; const float* srcp = R + ro;
#pragma unroll
                for (int bj = 0; bj < 2; ++bj)
#pragma unroll
                    for (int n = 0; n < 2; ++n) { const f32x4 o = *(const f32x4*)(srcp + bj * HALF + n * 16); *(f32x4*)(rowp + bj * HALF + n * 16) = o + acc[ai][bj][m][n]; } }
    }
};
struct EpiSwiGLU {
    static constexpr bool PERM = true, AFTER_DRAIN = false;
    bf16_t* H; int ldh;
    __device__ __forceinline__ void operator()(const f32x4 (&acc)[2][2][4][2], const Unit& u, int wr, int wc, int fr, int fq) const {
        const int row0 = u.pm * BM + wr * 64 + fr, hcol = u.pn * HALF + wc * 32 + 8 * fq;
#pragma unroll
        for (int ai = 0; ai < 2; ++ai)
#pragma unroll
            for (int m = 0; m < 4; ++m) { bf16_t* rowp = H + (size_t)(row0 + ai * HALF + m * 16) * ldh + hcol;
                float h[8];
#pragma unroll
                for (int n = 0; n < 2; ++n) { const f32x4 a = acc[ai][0][m][n], b = acc[ai][1][m][n];
#pragma unroll
                    for (int j = 0; j < 4; ++j) h[4 * n + j] = a[j] * __builtin_amdgcn_rcpf(1.0f + __expf(-a[j])) * b[j]; }
                u32x4 w; w.x = cvt_pk_bf16(h[0], h[1]); w.y = cvt_pk_bf16(h[2], h[3]); w.z = cvt_pk_bf16(h[4], h[5]); w.w = cvt_pk_bf16(h[6], h[7]);
                *(u32x4*)rowp = w; }
    }
};

struct EpiInEven {
    static constexpr bool PERM = true, AFTER_DRAIN = false;
    bf16_t* O; int ldc;
    __device__ __forceinline__ void operator()(const f32x4 (&acc)[2][2][4][2], const Unit& u, int wr, int wc, int fr, int fq) const {
        const int row0 = u.pm * BM + wr * 64 + fr;
        if (u.pn < 4) {
            const int hcol = u.pn * HALF + wc * 32 + 8 * fq;
#pragma unroll
            for (int ai = 0; ai < 2; ++ai)
#pragma unroll
                for (int m = 0; m < 4; ++m) { bf16_t* rowp = O + (size_t)(row0 + ai * HALF + m * 16) * ldc + hcol; float h[8];
#pragma unroll
                    for (int n = 0; n < 2; ++n) { const f32x4 a = acc[ai][0][m][n], g = acc[ai][1][m][n];
#pragma unroll
                        for (int j = 0; j < 4; ++j) h[4 * n + j] = a[j] * __builtin_amdgcn_rcpf(1.0f + __expf(-g[j])); }
                    u32x4 w; w.x = cvt_pk_bf16(h[0], h[1]); w.y = cvt_pk_bf16(h[2], h[3]); w.z = cvt_pk_bf16(h[4], h[5]); w.w = cvt_pk_bf16(h[6], h[7]);
                    *(u32x4*)rowp = w; }
        } else {
            const int col0 = u.pn * BM + wc * 32 + 8 * fq;
#pragma unroll
            for (int ai = 0; ai < 2; ++ai)
#pragma unroll
                for (int m = 0; m < 4; ++m) { bf16_t* rowp = O + (size_t)(row0 + ai * HALF + m * 16) * ldc + col0;
#pragma unroll
                    for (int bj = 0; bj < 2; ++bj) { const f32x4 v0 = acc[ai][bj][m][0], v1 = acc[ai][bj][m][1];
                        u32x4 w; w.x = cvt_pk_bf16(v0[0], v0[1]); w.y = cvt_pk_bf16(v0[2], v0[3]); w.z = cvt_pk_bf16(v1[0], v1[1]); w.w = cvt_pk_bf16(v1[2], v1[3]);
                        *(u32x4*)(rowp + bj * HALF) = w; } }
        }
    }
};
template <class Epi, class Sched, bool STAMP = false>
__device__ __forceinline__ void gemm_phase(PG8_LAS unsigned char* lds, const Gemm g, const Sched& S, const Epi& E, unsigned long long* stamps) {
    const int tid = threadIdx.x, wid = __builtin_amdgcn_readfirstlane(tid >> 6), lane = tid & 63, wr = wid >> 2, wc = wid & 3, fr = lane & 15, fq = lane >> 4;
    const int K = g.K, nt = K / BK;
    int ts_lo = 0, ts_hi = 0, nts = 0; const unsigned long long rt_entry = STAMP ? (unsigned long long)wall_clock64() : 0ull;
#define PG8_STAMP() do { if (STAMP && wid == 0 && nts < 64) { const unsigned long long _c = (unsigned long long)clock64(); \
        ts_lo = (lane == nts) ? (int)(unsigned)_c : ts_lo; ts_hi = (lane == nts) ? (int)(unsigned)(_c >> 32) : ts_hi; ++nts; } } while (0)
    PG8_STAMP();
    unsigned voffA[2], voffB[2];
#pragma unroll
    for (int i = 0; i < 2; ++i) { int R, C; stage_rc(tid * 16 + i * 8192, R, C); const int Rb = Epi::PERM ? ((R & ~31) + perm32(R & 31)) : R;
        voffA[i] = (unsigned)(R * K + C) * 2u; voffB[i] = (unsigned)(Rb * K + C) * 2u; }
    const size_t kstep = (size_t)(BK * 2);
    const size_t hstep = (size_t)HALF * K * 2;
    const size_t tstep = 2 * hstep;
    const unsigned ldsw = (unsigned)wid * 1024u;
    const int aoff = lds_byte(wr * 64 + fr, fq * 8), boff = lds_byte(wc * 32 + fr, fq * 8);
#define PG8_SA(b, h) (((b) * 2 + (h)) * HTB)
#define PG8_SB(b, h) ((4 + (b) * 2 + (h)) * HTB)
#define PG8_STAGE(bufoff, gbase, voff) do { _Pragma("unroll") for (int _i = 0; _i < 2; ++_i) \
        __builtin_amdgcn_global_load_lds((const unsigned*)((const char*)(gbase) + (voff)[_i]), (PG8_LAS unsigned*)(lds + (bufoff) + ldsw + _i * 8192), 16, 0, 0); } while (0)
#define PG8_LDA(dst, b, h) do { _Pragma("unroll") for (int m = 0; m < 4; ++m) _Pragma("unroll") for (int k = 0; k < 2; ++k) dst[m][k] = *(const PG8_LAS bf16x8*)(lds + PG8_SA(b, h) + aoff + m * 2048 + k * 1024); } while (0)
#define PG8_LDB(dst, b, h) do { _Pragma("unroll") for (int n = 0; n < 2; ++n) _Pragma("unroll") for (int k = 0; k < 2; ++k) dst[n][k] = *(const PG8_LAS bf16x8*)(lds + PG8_SB(b, h) + boff + n * 2048 + k * 1024); } while (0)
#define PG8_MMA(ai, bj, At, Bt) do { __builtin_amdgcn_s_setprio(1); _Pragma("unroll") for (int m = 0; m < 4; ++m) _Pragma("unroll") for (int n = 0; n < 2; ++n) _Pragma("unroll") for (int k = 0; k < 2; ++k) \
        acc[ai][bj][m][n] = __builtin_amdgcn_mfma_f32_16x16x32_bf16(Bt[n][k], At[m][k], acc[ai][bj][m][n], 0, 0, 0); __builtin_amdgcn_s_setprio(0); } while (0)
#define PG8_WAIT_V(n) asm volatile("s_waitcnt vmcnt(" #n ")" ::: "memory")
#define PG8_WAIT_L(n) asm volatile("s_waitcnt lgkmcnt(" #n ")" ::: "memory")
#define PG8_BAR __builtin_amdgcn_s_barrier()
#define PG8_SCHED __builtin_amdgcn_sched_barrier(0)
    Unit cur, nxt; int ui = 0;
    if (!S.next(0, cur)) return;
    f32x4 acc[2][2][4][2];
#pragma unroll
    for (int a = 0; a < 2; ++a)
#pragma unroll
        for (int b = 0; b < 2; ++b)
#pragma unroll
            for (int m = 0; m < 4; ++m)
#pragma unroll
                for (int n = 0; n < 2; ++n) acc[a][b][m][n] = (f32x4){0.f, 0.f, 0.f, 0.f};
    bf16x8 At[4][2], B0[2][2], B1[2][2];
    const char* cA = (const char*)g.A + (size_t)cur.pm * tstep; const char* cB = (const char*)g.Bt + (size_t)cur.pn * tstep;
    S.a_ready(cur);
    PG8_STAGE(PG8_SB(0, 0), cB, voffB); PG8_STAGE(PG8_SA(0, 0), cA, voffA); PG8_STAGE(PG8_SB(0, 1), cB + hstep, voffB); PG8_STAGE(PG8_SA(0, 1), cA + hstep, voffA);
    if (wr == 1) PG8_BAR;
    PG8_WAIT_V(4); PG8_BAR;
    PG8_STAGE(PG8_SB(1, 0), cB + kstep, voffB); PG8_STAGE(PG8_SA(1, 0), cA + kstep, voffA); PG8_STAGE(PG8_SB(1, 1), cB + hstep + kstep, voffB);
    PG8_WAIT_V(6); PG8_BAR;
    PG8_STAMP();
    for (;;) {
        const bool has_next = S.next(ui + 1, nxt);
        const char* nA = has_next ? (const char*)g.A + (size_t)nxt.pm * tstep : cA; const char* nB = has_next ? (const char*)g.Bt + (size_t)nxt.pn * tstep : cB;
        for (int t = 0; t < nt; t += 2) {
            const bool last = (t == nt - 2);
            const char* a1 = cA + (size_t)(t + 1) * kstep;
            const char* a2 = last ? nA : cA + (size_t)(t + 2) * kstep; const char* b2 = last ? nB : cB + (size_t)(t + 2) * kstep;
            const char* a3 = a2 + kstep; const char* b3 = b2 + kstep;
            if (last && has_next) S.a_ready(nxt);
            PG8_LDB(B0, 0, 0); PG8_SCHED; PG8_LDA(At, 0, 0); PG8_STAGE(PG8_SA(1, 1), a1 + hstep, voffA);
            PG8_WAIT_L(8); PG8_BAR; PG8_WAIT_L(0); PG8_MMA(0, 0, At, B0); PG8_BAR; PG8_SCHED;
            PG8_LDB(B1, 0, 1); PG8_STAGE(PG8_SB(0, 0), b2, voffB);
            PG8_BAR; PG8_WAIT_L(0); PG8_MMA(0, 1, At, B1); PG8_BAR;
            PG8_LDA(At, 0, 1); PG8_STAGE(PG8_SA(0, 0), a2, voffA);
            PG8_BAR; PG8_WAIT_L(0); PG8_MMA(1, 0, At, B0); PG8_BAR; PG8_SCHED;
            PG8_STAGE(PG8_SB(0, 1), b2 + hstep, voffB);
            PG8_WAIT_V(6); PG8_BAR; PG8_MMA(1, 1, At, B1); PG8_BAR;
            PG8_LDB(B0, 1, 0); PG8_SCHED; PG8_LDA(At, 1, 0); PG8_STAGE(PG8_SA(0, 1), a2 + hstep, voffA);
            PG8_WAIT_L(8); PG8_BAR; PG8_WAIT_L(0); PG8_MMA(0, 0, At, B0); PG8_BAR; PG8_SCHED;
            PG8_LDB(B1, 1, 1); PG8_STAGE(PG8_SB(1, 0), b3, voffB);
            PG8_BAR; PG8_WAIT_L(0); PG8_MMA(0, 1, At, B1); PG8_BAR;
            PG8_LDA(At, 1, 1); PG8_STAGE(PG8_SA(1, 0), a3, voffA);
            PG8_BAR; PG8_WAIT_L(0); PG8_MMA(1, 0, At, B0); PG8_BAR; PG8_SCHED;
            PG8_STAGE(PG8_SB(1, 1), b3 + hstep, voffB);
            PG8_WAIT_V(6); PG8_BAR; PG8_MMA(1, 1, At, B1); PG8_BAR;
        }
        PG8_STAMP();
        if constexpr (!Epi::AFTER_DRAIN) { E(acc, cur, wr, wc, fr, fq); S.done(cur); }
        PG8_STAMP();
        if (!has_next) break;
#pragma unroll
        for (int a = 0; a < 2; ++a)
#pragma unroll
            for (int b = 0; b < 2; ++b)
#pragma unroll
                for (int m = 0; m < 4; ++m)
#pragma unroll
                    for (int n = 0; n < 2; ++n) acc[a][b][m][n] = (f32x4){0.f, 0.f, 0.f, 0.f};
        cur = nxt; cA = nA; cB = nB; ++ui;
    }
    PG8_WAIT_V(0);
    if (wr == 0) PG8_BAR;
    PG8_BAR;
    if constexpr (Epi::AFTER_DRAIN) { E.fused(acc, cur, wr, wc, fr, fq, lds, wid, lane); S.done(cur); }
    PG8_STAMP();
    if (STAMP && wid == 0) { stamps[lane] = lane < nts ? (((unsigned long long)(unsigned)ts_hi << 32) | (unsigned)ts_lo) : 0ull;
        if (lane == 62) stamps[62] = rt_entry; if (lane == 63) stamps[63] = (unsigned long long)wall_clock64(); }
#undef PG8_STAMP
#undef PG8_SA
#undef PG8_SB
#undef PG8_STAGE
#undef PG8_LDA
#undef PG8_LDB
#undef PG8_MMA
#undef PG8_WAIT_V
#undef PG8_WAIT_L
#undef PG8_BAR
#undef PG8_SCHED
}
template <class Epi, class Sched, bool ALIGN_EPI = false, bool SP2 = false>
__device__ __forceinline__ void gemm_phase_sp2(PG8_LAS unsigned char* lds, const Gemm g, const Sched& S, const Epi& E) {
    const int tid = threadIdx.x, wid = __builtin_amdgcn_readfirstlane(tid >> 6), lane = tid & 63, wr = wid >> 2, wc = wid & 3, fr = lane & 15, fq = lane >> 4;
    const int K = g.K, nt = K / BK;
    unsigned voffA[2], voffB[2];
#pragma unroll
    for (int i = 0; i < 2; ++i) { int R, C; stage_rc(tid * 16 + i * 8192, R, C); const int Rb = Epi::PERM ? ((R & ~31) + perm32(R & 31)) : R;
        voffA[i] = (unsigned)(R * K + C) * 2u; voffB[i] = (unsigned)(Rb * K + C) * 2u; }
    const size_t kstep = (size_t)(BK * 2);
    const size_t hstep = (size_t)HALF * K * 2;
    const size_t tstep = 2 * hstep;
    const unsigned ldsw = (unsigned)wid * 1024u;
    const int aoff = lds_byte(wr * 64 + fr, fq * 8), boff = lds_byte(wc * 32 + fr, fq * 8);
#define PG8_SA(b, h) (((b) * 2 + (h)) * HTB)
#define PG8_SB(b, h) ((4 + (b) * 2 + (h)) * HTB)
#define PG8_STAGE(bufoff, gbase, voff) do { _Pragma("unroll") for (int _i = 0; _i < 2; ++_i) \
        __builtin_amdgcn_global_load_lds((const unsigned*)((const char*)(gbase) + (voff)[_i]), (PG8_LAS unsigned*)(lds + (bufoff) + ldsw + _i * 8192), 16, 0, 0); } while (0)
#define PG8_LDA(dst, b, h) do { _Pragma("unroll") for (int m = 0; m < 4; ++m) _Pragma("unroll") for (int k = 0; k < 2; ++k) dst[m][k] = *(const PG8_LAS bf16x8*)(lds + PG8_SA(b, h) + aoff + m * 2048 + k * 1024); } while (0)
#define PG8_LDB(dst, b, h) do { _Pragma("unroll") for (int n = 0; n < 2; ++n) _Pragma("unroll") for (int k = 0; k < 2; ++k) dst[n][k] = *(const PG8_LAS bf16x8*)(lds + PG8_SB(b, h) + boff + n * 2048 + k * 1024); } while (0)
#define PG8_MMA(ai, bj, At, Bt) do { __builtin_amdgcn_s_setprio(1); _Pragma("unroll") for (int m = 0; m < 4; ++m) _Pragma("unroll") for (int n = 0; n < 2; ++n) _Pragma("unroll") for (int k = 0; k < 2; ++k) \
        acc[ai][bj][m][n] = __builtin_amdgcn_mfma_f32_16x16x32_bf16(Bt[n][k], At[m][k], acc[ai][bj][m][n], 0, 0, 0); __builtin_amdgcn_s_setprio(0); } while (0)
#define PG8_WAIT_V(n) asm volatile("s_waitcnt vmcnt(" #n ")" ::: "memory")
#define PG8_WAIT_L(n) asm volatile("s_waitcnt lgkmcnt(" #n ")" ::: "memory")
#define PG8_BAR __builtin_amdgcn_s_barrier()
#define PG8_SCHED __builtin_amdgcn_sched_barrier(0)
    Unit cur, nxt; int ui = 0;
    if (!S.next(0, cur)) return;
    f32x4 acc[2][2][4][2];
#pragma unroll
    for (int a = 0; a < 2; ++a)
#pragma unroll
        for (int b = 0; b < 2; ++b)
#pragma unroll
            for (int m = 0; m < 4; ++m)
#pragma unroll
                for (int n = 0; n < 2; ++n) acc[a][b][m][n] = (f32x4){0.f, 0.f, 0.f, 0.f};
    bf16x8 At[4][2], B0[2][2], B1[2][2];
    const char* cA = (const char*)g.A + (size_t)cur.pm * tstep; const char* cB = (const char*)g.Bt + (size_t)cur.pn * tstep;
    S.a_ready(cur);
    if constexpr (SP2) {
        PG8_STAGE(PG8_SB(0, 0), cB, voffB); PG8_STAGE(PG8_SB(0, 1), cB + hstep, voffB); PG8_STAGE(PG8_SA(0, 0), cA, voffA); PG8_STAGE(PG8_SA(0, 1), cA + hstep, voffA);
        if (wr == 1) PG8_BAR;
        PG8_WAIT_V(2); PG8_BAR;
        PG8_STAGE(PG8_SB(1, 0), cB + kstep, voffB); PG8_STAGE(PG8_SA(1, 0), cA + kstep, voffA); PG8_STAGE(PG8_SB(1, 1), cB + hstep + kstep, voffB);
        PG8_WAIT_V(6); PG8_BAR;
    } else {
        PG8_STAGE(PG8_SB(0, 0), cB, voffB); PG8_STAGE(PG8_SA(0, 0), cA, voffA); PG8_STAGE(PG8_SB(0, 1), cB + hstep, voffB); PG8_STAGE(PG8_SA(0, 1), cA + hstep, voffA);
        if (wr == 1) PG8_BAR;
        PG8_WAIT_V(4); PG8_BAR;
        PG8_STAGE(PG8_SB(1, 0), cB + kstep, voffB); PG8_STAGE(PG8_SA(1, 0), cA + kstep, voffA); PG8_STAGE(PG8_SB(1, 1), cB + hstep + kstep, voffB);
        PG8_WAIT_V(6); PG8_BAR;
    }
    for (;;) {
        const bool has_next = S.next(ui + 1, nxt);
        const char* nA = has_next ? (const char*)g.A + (size_t)nxt.pm * tstep : cA; const char* nB = has_next ? (const char*)g.Bt + (size_t)nxt.pn * tstep : cB;
        for (int t = 0; t < nt; t += 2) {
            const bool last = (t == nt - 2);
            const char* a1 = cA + (size_t)(t + 1) * kstep;
            const char* a2 = last ? nA : cA + (size_t)(t + 2) * kstep; const char* b2 = last ? nB : cB + (size_t)(t + 2) * kstep;
            const char* a3 = a2 + kstep; const char* b3 = b2 + kstep;
            if (last && has_next) S.a_ready(nxt);
            if constexpr (SP2) {
            PG8_LDB(B0, 0, 0); PG8_LDB(B1, 0, 1); PG8_SCHED; PG8_LDA(At, 0, 0); PG8_STAGE(PG8_SA(1, 1), a1 + hstep, voffA);
            PG8_WAIT_V(8); PG8_WAIT_L(0); PG8_BAR; PG8_MMA(0, 0, At, B0); PG8_MMA(0, 1, At, B1); PG8_BAR; PG8_SCHED;
            PG8_LDA(At, 0, 1); PG8_STAGE(PG8_SB(0, 0), b2, voffB); PG8_STAGE(PG8_SB(0, 1), b2 + hstep, voffB); PG8_STAGE(PG8_SA(0, 0), a2, voffA);
            PG8_WAIT_V(8); PG8_WAIT_L(0); PG8_BAR; PG8_MMA(1, 0, At, B0); PG8_MMA(1, 1, At, B1); PG8_BAR; PG8_SCHED;
            PG8_LDB(B0, 1, 0); PG8_LDB(B1, 1, 1); PG8_SCHED; PG8_LDA(At, 1, 0); PG8_STAGE(PG8_SA(0, 1), a2 + hstep, voffA);
            PG8_WAIT_V(8); PG8_WAIT_L(0); PG8_BAR; PG8_MMA(0, 0, At, B0); PG8_MMA(0, 1, At, B1); PG8_BAR; PG8_SCHED;
            PG8_LDA(At, 1, 1); PG8_STAGE(PG8_SB(1, 0), b3, voffB); PG8_STAGE(PG8_SB(1, 1), b3 + hstep, voffB); PG8_STAGE(PG8_SA(1, 0), a3, voffA);
            PG8_WAIT_V(8); PG8_WAIT_L(0); PG8_BAR; PG8_MMA(1, 0, At, B0); PG8_MMA(1, 1, At, B1); PG8_BAR; PG8_SCHED;
            } else {
            PG8_LDB(B0, 0, 0); PG8_SCHED; PG8_LDA(At, 0, 0); PG8_STAGE(PG8_SA(1, 1), a1 + hstep, voffA);
            PG8_WAIT_L(8); PG8_BAR; PG8_WAIT_L(0); PG8_MMA(0, 0, At, B0); PG8_BAR; PG8_SCHED;
            PG8_LDB(B1, 0, 1); PG8_STAGE(PG8_SB(0, 0), b2, voffB);
            PG8_BAR; PG8_WAIT_L(0); PG8_MMA(0, 1, At, B1); PG8_BAR;
            PG8_LDA(At, 0, 1); PG8_STAGE(PG8_SA(0, 0), a2, voffA);
            PG8_BAR; PG8_WAIT_L(0); PG8_MMA(1, 0, At, B0); PG8_BAR; PG8_SCHED;
            PG8_STAGE(PG8_SB(0, 1), b2 + hstep, voffB);
            PG8_WAIT_V(6); PG8_BAR; PG8_MMA(1, 1, At, B1); PG8_BAR;
            PG8_LDB(B0, 1, 0); PG8_SCHED; PG8_LDA(At, 1, 0); PG8_STAGE(PG8_SA(0, 1), a2 + hstep, voffA);
            PG8_WAIT_L(8); PG8_BAR; PG8_WAIT_L(0); PG8_MMA(0, 0, At, B0); PG8_BAR; PG8_SCHED;
            PG8_LDB(B1, 1, 1); PG8_STAGE(PG8_SB(1, 0), b3, voffB);
            PG8_BAR; PG8_WAIT_L(0); PG8_MMA(0, 1, At, B1); PG8_BAR;
            PG8_LDA(At, 1, 1); PG8_STAGE(PG8_SA(1, 0), a3, voffA);
            PG8_BAR; PG8_WAIT_L(0); PG8_MMA(1, 0, At, B0); PG8_BAR; PG8_SCHED;
            PG8_STAGE(PG8_SB(1, 1), b3 + hstep, voffB);
            PG8_WAIT_V(6); PG8_BAR; PG8_MMA(1, 1, At, B1); PG8_BAR;
            }
        }
        if constexpr (ALIGN_EPI) { if (wr == 0) PG8_BAR; }
        if constexpr (!Epi::AFTER_DRAIN) { E(acc, cur, wr, wc, fr, fq); S.done(cur); }
        if (!has_next) break;
#pragma unroll
        for (int a = 0; a < 2; ++a)
#pragma unroll
            for (int b = 0; b < 2; ++b)
#pragma unroll
                for (int m = 0; m < 4; ++m)
#pragma unroll
                    for (int n = 0; n < 2; ++n) acc[a][b][m][n] = (f32x4){0.f, 0.f, 0.f, 0.f};
        cur = nxt; cA = nA; cB = nB; ++ui;
        if constexpr (ALIGN_EPI) { if (wr == 1) PG8_BAR; }
    }
    PG8_WAIT_V(0);
    if constexpr (!ALIGN_EPI) { if (wr == 0) PG8_BAR; }
    PG8_BAR;
    if constexpr (Epi::AFTER_DRAIN) { E.fused(acc, cur, wr, wc, fr, fq, lds, wid, lane); S.done(cur); }
#undef PG8_SA
#undef PG8_SB
#undef PG8_STAGE
#undef PG8_LDA
#undef PG8_LDB
#undef PG8_MMA
#undef PG8_WAIT_V
#undef PG8_WAIT_L
#undef PG8_BAR
#undef PG8_SCHED
}
}
#define LAS __attribute__((address_space(3)))
typedef LAS unsigned char* LDSp;
typedef pg8::bf16_t bf16_t;
typedef unsigned u32x4 __attribute__((ext_vector_type(4)));
typedef unsigned u32x2 __attribute__((ext_vector_type(2)));
typedef float f32x4 __attribute__((ext_vector_type(4)));
typedef float f32x2 __attribute__((ext_vector_type(2)));

#ifndef EXPC
#define EXPC 0
#endif
#ifndef EVP_SKIP
#define EVP_SKIP 0
#endif
constexpr int T_ = 16384, D_ = 1024, S_ = 4096, NTHR = 512;
constexpr int LDS_BYTES = 147456;
constexpr size_t MiB = 1048576;
constexpr size_t WS_WB = 0, WS_HN = 25 * MiB, WS_Z = 57 * MiB, WS_QKV = 153 * MiB, WS_OF = 201 * MiB, WS_OB = 217 * MiB,
                 WS_GATES = 233 * MiB, WS_BETA = 234 * MiB, WS_LA = 234 * MiB + 524288;
constexpr size_t WB_IN = 0, WB_OUT = 6291456, WB_UP = 8388608, WB_DN = 19922944;
constexpr int DFF = 2816;

struct Params { const float* in[26]; float* out; unsigned char* ws; };

__device__ __forceinline__ float bf2f(unsigned short b) { return __uint_as_float(((unsigned)b) << 16); }
__device__ __forceinline__ float bflo(unsigned u) { return __uint_as_float(u << 16); }
__device__ __forceinline__ float bfhi(unsigned u) { return __uint_as_float(u & 0xffff0000u); }
__device__ __forceinline__ unsigned short f2bf(float f) { return __builtin_bit_cast(unsigned short, (__bf16)f); }
typedef __bf16 bf16x2_v __attribute__((ext_vector_type(2)));
__device__ __forceinline__ unsigned pk2(float lo, float hi) { const f32x2 v = {lo, hi}; const bf16x2_v b = __builtin_convertvector(v, bf16x2_v); return __builtin_bit_cast(unsigned, b); }
__device__ __forceinline__ float sigm(float x) { return __builtin_amdgcn_rcpf(1.0f + __expf(-x)); }
__device__ __forceinline__ float sigm_f(float x) { return __builtin_amdgcn_rcpf(1.0f + __expf(-x)); }
__device__ __forceinline__ float silu_(float x) { return x * sigm(x); }
__device__ __forceinline__ float gelu_t(float x) { const float u = 0.7978845608028654f * (x + 0.044715f * x * x * x); const float t = 1.0f - 2.0f / (1.0f + __expf(2.0f * u)); return 0.5f * x * (1.0f + t); }
__device__ __forceinline__ float softplus_(float x) { return x > 20.0f ? x : log1pf(expf(x)); }
__device__ __forceinline__ float wave_sum(float v) {
#pragma unroll
    for (int o = 32; o; o >>= 1) v += __shfl_xor(v, o);
    return v; }
template <int CTRL> __device__ __forceinline__ float dppf(float v) { return __int_as_float(__builtin_amdgcn_update_dpp(0, __float_as_int(v), CTRL, 0xf, 0xf, true)); }
__device__ __forceinline__ float row16_sum(float v) { v += dppf<0xB1>(v); v += dppf<0x4E>(v); v += dppf<0x141>(v); v += dppf<0x140>(v); return v; }
__device__ __forceinline__ void unpack8(const u32x4 w, float (&f)[8]) { f[0] = bflo(w.x); f[1] = bfhi(w.x); f[2] = bflo(w.y); f[3] = bfhi(w.y); f[4] = bflo(w.z); f[5] = bfhi(w.z); f[6] = bflo(w.w); f[7] = bfhi(w.w); }


__device__ __forceinline__ float wave_scan_sum(float x, bool fwd) {
    const int lane = threadIdx.x & 63;
#pragma unroll
    for (int o = 1; o < 64; o <<= 1) { const float y = fwd ? __shfl_up(x, o) : __shfl_down(x, o); if (fwd ? (lane >= o) : (lane + o < 64)) x += y; }
    return x; }
__device__ __forceinline__ float wave_scan_max(float x, bool fwd) {
    const int lane = threadIdx.x & 63;
#pragma unroll
    for (int o = 1; o < 64; o <<= 1) { const float y = fwd ? __shfl_up(x, o) : __shfl_down(x, o); if (fwd ? (lane >= o) : (lane + o < 64)) x = fmaxf(x, y); }
    return x; }
__device__ __forceinline__ void conv_job(LDSp lds, const float* __restrict__ src, int ldn, int K, int col0, int ncols, bf16_t* __restrict__ dst, int mode, int off) {
    LAS float* tl = (LAS float*)lds;
    const int tid = threadIdx.x, nnt = ncols >> 6, ntl = (K >> 6) * nnt;
    const int r = tid >> 4, c4 = (tid & 15) << 2;
    f32x4 pv[2];
    if ((int)blockIdx.x < ntl) { const int kt = (int)blockIdx.x / nnt, nt = (int)blockIdx.x - kt * nnt;
#pragma unroll
        for (int i = 0; i < 2; ++i) pv[i] = *(const f32x4*)(src + (size_t)(kt * 64 + r + 32 * i) * ldn + col0 + nt * 64 + c4); }
    for (int tile = blockIdx.x; tile < ntl; tile += gridDim.x) {
        const int kt = tile / nnt, nt = tile - kt * nnt;
#pragma unroll
        for (int i = 0; i < 2; ++i) { const int k = r + 32 * i; const f32x4 v = pv[i];
            tl[k * 65 + c4 + 0] = v.x; tl[k * 65 + c4 + 1] = v.y; tl[k * 65 + c4 + 2] = v.z; tl[k * 65 + c4 + 3] = v.w; }
        { const int tn = tile + (int)gridDim.x; if (tn < ntl) { const int kt2 = tn / nnt, nt2 = tn - kt2 * nnt;
#pragma unroll
            for (int i = 0; i < 2; ++i) pv[i] = *(const f32x4*)(src + (size_t)(kt2 * 64 + r + 32 * i) * ldn + col0 + nt2 * 64 + c4); } }
        __syncthreads();
        const int n = tid >> 3, k8 = (tid & 7) << 3; float f[8];
#pragma unroll
        for (int j = 0; j < 8; ++j) f[j] = tl[(k8 + j) * 65 + n];
        u32x4 w; w.x = pk2(f[0], f[1]); w.y = pk2(f[2], f[3]); w.z = pk2(f[4], f[5]); w.w = pk2(f[6], f[7]);
        const int ncol = nt * 64 + n;
        const int row = mode == 0 ? off + ncol : mode == 1 ? ((ncol >> 7) << 8) + (ncol & 127) + off
                      : (ncol < 512 ? ((ncol >> 7) << 8) + (ncol & 127) : ncol < 1024 ? (((ncol - 512) >> 7) << 8) + 128 + ((ncol - 512) & 127) : ncol);
        *(u32x4*)(dst + (size_t)row * K + kt * 64 + k8) = w;
        __syncthreads();
    }
}
__device__ __forceinline__ void convert_layer(LDSp lds, const Params& p, int L) {
    bf16_t* wb = (bf16_t*)(p.ws + WS_WB);
    if (L == 0) { conv_job(lds, p.in[2], 3088, 1024, 0, 3072, (bf16_t*)((char*)wb + WB_IN), 2, 0);
                  conv_job(lds, p.in[11], 1024, 1024, 0, 1024, (bf16_t*)((char*)wb + WB_OUT), 0, 0); }
    else        { conv_job(lds, p.in[12], 2576, 1024, 0, 2560, (bf16_t*)((char*)wb + WB_IN), 0, 0);
                  conv_job(lds, p.in[20], 1024, 1024, 0, 1024, (bf16_t*)((char*)wb + WB_OUT), 0, 0); }
    conv_job(lds, p.in[22] + (size_t)L * 1024 * DFF, DFF, 1024, 0, DFF, (bf16_t*)((char*)wb + WB_UP), 1, 0);
    conv_job(lds, p.in[23] + (size_t)L * 1024 * DFF, DFF, 1024, 0, DFF, (bf16_t*)((char*)wb + WB_UP), 1, 128);
    conv_job(lds, p.in[24] + (size_t)L * DFF * 1024, 1024, DFF, 0, 1024, (bf16_t*)((char*)wb + WB_DN), 0, 0);
}

__device__ __forceinline__ void rms_phase(LDSp lds, const float* src, const float* __restrict__ g, bf16_t* hn, float* copy_out, float* final_out,
                                          const float* __restrict__ gw, int gw_ld, int gw_col0, float* gates) {
    LAS float* wg = (LAS float*)lds;
    const int tid = threadIdx.x, lane = tid & 63, wid = tid >> 6;
    if (gw) { for (int idx = tid; idx < 16384; idx += NTHR) { const int k = idx >> 4, j = idx & 15; wg[j * 1024 + k] = gw[(size_t)k * gw_ld + gw_col0 + j]; } __syncthreads(); }
    f32x4 gv[4];
#pragma unroll
    for (int i = 0; i < 4; ++i) gv[i] = *(const f32x4*)(g + 4 * lane + 256 * i);
    f32x4 xn[4];
    { const int row0 = blockIdx.x * 8 + wid;
#pragma unroll
      for (int i = 0; i < 4; ++i) xn[i] = *(const f32x4*)(src + (size_t)row0 * D_ + 4 * lane + 256 * i); }
    for (int row = blockIdx.x * 8 + wid; row < T_; row += gridDim.x * 8) {
        f32x4 x[4]; float ss = 0.f;
#pragma unroll
        for (int i = 0; i < 4; ++i) { x[i] = xn[i]; ss += x[i].x * x[i].x + x[i].y * x[i].y + x[i].z * x[i].z + x[i].w * x[i].w; }
        { const int rn = row + (int)gridDim.x * 8; if (rn < T_) {
#pragma unroll
            for (int i = 0; i < 4; ++i) xn[i] = *(const f32x4*)(src + (size_t)rn * D_ + 4 * lane + 256 * i); } }
        if (copy_out) {
#pragma unroll
            for (int i = 0; i < 4; ++i) *(f32x4*)(copy_out + (size_t)row * D_ + 4 * lane + 256 * i) = x[i]; }
        ss = wave_sum(ss);
        const float rstd = rsqrtf(ss * (1.0f / 1024.0f) + 1e-6f);
        f32x4 y[4];
#pragma unroll
        for (int i = 0; i < 4; ++i) y[i] = x[i] * rstd * gv[i];
        if (final_out) {
#pragma unroll
            for (int i = 0; i < 4; ++i) *(f32x4*)(final_out + (size_t)row * D_ + 4 * lane + 256 * i) = y[i];
        } else {
#pragma unroll
            for (int i = 0; i < 4; ++i) { u32x2 w; w.x = pk2(y[i].x, y[i].y); w.y = pk2(y[i].z, y[i].w); *(u32x2*)(hn + (size_t)row * D_ + 4 * lane + 256 * i) = w; }
        }
        if (gw) {
            float s[16];
#pragma unroll
            for (int j = 0; j < 16; ++j) { float a = 0.f;
#pragma unroll
                for (int i = 0; i < 4; ++i) { const f32x4 w = *(const LAS f32x4*)(wg + j * 1024 + 4 * lane + 256 * i); a += y[i].x * w.x + y[i].y * w.y + y[i].z * w.z + y[i].w * w.w; }
                s[j] = a; }
            const bool h5 = (lane & 32) != 0, h4 = (lane & 16) != 0, h3 = (lane & 8) != 0, h2 = (lane & 4) != 0;
            float r8[8], r4[4], r2[2], r1;
#pragma unroll
            for (int j = 0; j < 8; ++j) { const float keep = h5 ? s[j + 8] : s[j], send = h5 ? s[j] : s[j + 8]; r8[j] = keep + __shfl_xor(send, 32); }
#pragma unroll
            for (int j = 0; j < 4; ++j) { const float keep = h4 ? r8[j + 4] : r8[j], send = h4 ? r8[j] : r8[j + 4]; r4[j] = keep + __shfl_xor(send, 16); }
#pragma unroll
            for (int j = 0; j < 2; ++j) { const float keep = h3 ? r4[j + 2] : r4[j], send = h3 ? r4[j] : r4[j + 2]; r2[j] = keep + __shfl_xor(send, 8); }
            { const float keep = h2 ? r2[1] : r2[0], send = h2 ? r2[0] : r2[1]; r1 = keep + __shfl_xor(send, 4); }
            r1 += __shfl_xor(r1, 2); r1 += __shfl_xor(r1, 1);
            if ((lane & 3) == 0) gates[(size_t)row * 16 + (h5 ? 8 : 0) + (h4 ? 4 : 0) + (h3 ? 2 : 0) + (h2 ? 1 : 0)] = r1;
        }
    }
    __syncthreads();
}

__device__ __forceinline__ void even_prep(LDSp lds, const Params& p) {
    const bf16_t* Z = (const bf16_t*)(p.ws + WS_Z); bf16_t* Y = (bf16_t*)(p.ws + WS_HN); bf16_t* QKVN = (bf16_t*)(p.ws + WS_QKV);
    const float* gates = (const float*)(p.ws + WS_GATES); float* BETA = (float*)(p.ws + WS_BETA); float* LA = (float*)(p.ws + WS_LA);
    const float* conv_w = p.in[3]; const float* conv_b = p.in[4]; const float* ln_g = p.in[5]; const float* ln_b = p.in[6];
    const float* dn_w = p.in[7]; const float* a_log = p.in[8]; const float* dt_bias = p.in[9];
    LAS float* glu = (LAS float*)lds;
    const int tid = threadIdx.x, lane = tid & 63, wid = tid >> 6, c = tid;
    for (int tile = blockIdx.x; tile < T_ / 32; tile += gridDim.x) {
        const int t0 = tile * 32, b = t0 >> 12, s0 = t0 & 4095;
#if !(EVP_SKIP & 1)
        for (int it = tid; it < 62 * 64; it += NTHR) { const int r = it >> 6, c8 = (it & 63) << 3, sp = s0 - 15 + r;
            f32x4 o0 = {0.f, 0.f, 0.f, 0.f}, o1 = {0.f, 0.f, 0.f, 0.f};
            if (sp >= 0 && sp < S_) { const size_t tok = (size_t)b * S_ + sp; const u32x4 av = *(const u32x4*)(Z + tok * 3072 + c8);
                float a[8]; unpack8(av, a);
                o0 = (f32x4){a[0], a[1], a[2], a[3]}; o1 = (f32x4){a[4], a[5], a[6], a[7]}; }
            *(LAS f32x4*)(glu + r * 512 + c8) = o0; *(LAS f32x4*)(glu + r * 512 + c8 + 4) = o1; }
        __syncthreads();
        {
            float cw[31];
#pragma unroll
            for (int w = 0; w < 31; ++w) cw[w] = conv_w[w * 512 + c];
            const float cb = conv_b[c];
            f32x4 res[8];
#pragma unroll
            for (int t4 = 0; t4 < 8; ++t4) {
                float x[34];
#pragma unroll
                for (int i = 0; i < 34; ++i) x[i] = glu[(t4 * 4 + i) * 512 + c];
                float a0 = cb, a1 = cb, a2 = cb, a3 = cb;
#pragma unroll
                for (int w = 0; w < 31; ++w) { a0 = fmaf(x[w], cw[w], a0); a1 = fmaf(x[w + 1], cw[w], a1); a2 = fmaf(x[w + 2], cw[w], a2); a3 = fmaf(x[w + 3], cw[w], a3); }
                res[t4] = (f32x4){a0, a1, a2, a3};
            }
            __syncthreads();
#pragma unroll
            for (int t4 = 0; t4 < 8; ++t4) { glu[(t4 * 4 + 0) * 512 + c] = res[t4].x; glu[(t4 * 4 + 1) * 512 + c] = res[t4].y; glu[(t4 * 4 + 2) * 512 + c] = res[t4].z; glu[(t4 * 4 + 3) * 512 + c] = res[t4].w; }
        }
        __syncthreads();
        {
            const f32x4 g0 = *(const f32x4*)(ln_g + 4 * lane), g1 = *(const f32x4*)(ln_g + 256 + 4 * lane), b0 = *(const f32x4*)(ln_b + 4 * lane), b1 = *(const f32x4*)(ln_b + 256 + 4 * lane);
#pragma unroll
            for (int tt = 0; tt < 4; ++tt) { const int t = wid * 4 + tt;
                const f32x4 x0 = *(const LAS f32x4*)(glu + t * 512 + 4 * lane), x1 = *(const LAS f32x4*)(glu + t * 512 + 256 + 4 * lane);
                const float mean = wave_sum((x0.x + x0.y) + (x0.z + x0.w) + (x1.x + x1.y) + (x1.z + x1.w)) * (1.0f / 512.0f);
                const f32x4 d0 = x0 - mean, d1 = x1 - mean;
                const float var = wave_sum(d0.x * d0.x + d0.y * d0.y + d0.z * d0.z + d0.w * d0.w + d1.x * d1.x + d1.y * d1.y + d1.z * d1.z + d1.w * d1.w) * (1.0f / 512.0f);
                const float rstd = rsqrtf(var + 1e-5f);
                const f32x4 y0 = d0 * rstd * g0 + b0, y1 = d1 * rstd * g1 + b1;
                u32x2 w0, w1; w0.x = pk2(silu_(y0.x), silu_(y0.y)); w0.y = pk2(silu_(y0.z), silu_(y0.w)); w1.x = pk2(silu_(y1.x), silu_(y1.y)); w1.y = pk2(silu_(y1.z), silu_(y1.w));
                *(u32x2*)(Y + (size_t)(t0 + t) * 1024 + 4 * lane) = w0; *(u32x2*)(Y + (size_t)(t0 + t) * 1024 + 256 + 4 * lane) = w1; }
        }
        __syncthreads();
#endif
#if !(EVP_SKIP & 2)
        LAS unsigned short* xin = (LAS unsigned short*)(glu + 32 * 512);
#pragma unroll 1
        for (int gi = 0; gi < 3; ++gi) {
            float w5[5];
#pragma unroll
            for (int w = 0; w < 5; ++w) w5[w] = dn_w[w * 1536 + gi * 512 + c];
            for (int it = tid; it < 36 * 64; it += NTHR) { const int rr = it >> 6, c8 = (it & 63) << 3, sp = s0 - 2 + rr;
                u32x4 v = {0u, 0u, 0u, 0u};
                if (sp >= 0 && sp < S_) v = *(const u32x4*)(Z + ((size_t)b * S_ + sp) * 3072 + 1024 + gi * 512 + c8);
                *(LAS u32x4*)(xin + rr * 512 + c8) = v; }
            __syncthreads();
            float x0 = bf2f(xin[c]), x1 = bf2f(xin[512 + c]), x2 = bf2f(xin[1024 + c]), x3 = bf2f(xin[1536 + c]);
#pragma unroll 8
            for (int t = 0; t < 32; ++t) { const float x4 = bf2f(xin[(t + 4) * 512 + c]);
                float v = x0 * w5[0]; v = fmaf(x1, w5[1], v); v = fmaf(x2, w5[2], v); v = fmaf(x3, w5[3], v); v = fmaf(x4, w5[4], v);
                glu[t * 512 + c] = silu_(v);
                x0 = x1; x1 = x2; x2 = x3; x3 = x4; }
            __syncthreads();
            const float qs = gi == 0 ? 0.08838834764831845f : 1.0f;
#pragma unroll
            for (int pp = 0; pp < 4; ++pp) { const int pr = wid * 16 + pp * 4 + (lane >> 4), t = pr >> 2, hd = pr & 3, c8 = (lane & 15) * 8;
                const f32x4 y0 = *(const LAS f32x4*)(glu + t * 512 + hd * 128 + c8), y1 = *(const LAS f32x4*)(glu + t * 512 + hd * 128 + c8 + 4);
                const float ss = row16_sum(y0.x * y0.x + y0.y * y0.y + y0.z * y0.z + y0.w * y0.w + y1.x * y1.x + y1.y * y1.y + y1.z * y1.z + y1.w * y1.w);
                const float sc = gi == 2 ? 1.0f : rsqrtf(ss + 1e-6f) * qs;
                u32x4 w; w.x = pk2(y0.x * sc, y0.y * sc); w.y = pk2(y0.z * sc, y0.w * sc); w.z = pk2(y1.x * sc, y1.y * sc); w.w = pk2(y1.z * sc, y1.w * sc);
                *(u32x4*)(QKVN + (size_t)(t0 + t) * 1536 + gi * 512 + hd * 128 + c8) = w; }
            __syncthreads();
        }
#endif
#if !(EVP_SKIP & 4)
        if (tid < 256) { const int t = tid >> 3, j = tid & 7; const size_t tok = (size_t)(t0 + t);
            const float bp = gates[tok * 16 + j], ap = gates[tok * 16 + 8 + j];
            BETA[tok * 8 + j] = sigm(bp); LA[tok * 8 + j] = -expf(a_log[j]) * softplus_(ap + dt_bias[j]); }
#endif
        __syncthreads();
    }
}

__device__ __forceinline__ void tri_inv64(const LAS float* Am, int c, float su, float sw, LAS unsigned short* Tu, LAS unsigned short* Tw) {
    f32x4 a; float s0, s1, s2, s3; const float cf = (float)c;
    float x0 = fmaxf(0.0f, 1.0f - fabsf(cf - 0.0f));
    Tu[0 + c] = f2bf(x0 * su); Tw[0 + c] = f2bf(x0 * sw); asm volatile("" ::: "memory");
    float x1 = fmaxf(0.0f, 1.0f - fabsf(cf - 1.0f));
    s0 = 0.f; s1 = 0.f; s2 = 0.f; s3 = 0.f;
    a = *(const LAS f32x4*)(Am + 68);
    const float al1 = a.x;
    x1 = (x1 - ((s0 + s1) + (s2 + s3))) - al1 * x0;
    Tu[136 + c] = f2bf(x1 * su); Tw[136 + c] = f2bf(x1 * sw); asm volatile("" ::: "memory");
    float x2 = fmaxf(0.0f, 1.0f - fabsf(cf - 2.0f));
    s0 = 0.f; s1 = 0.f; s2 = 0.f; s3 = 0.f;
    a = *(const LAS f32x4*)(Am + 136);
    s0 = fmaf(a.x, x0, s0);
    const float al2 = a.y;
    x2 = (x2 - ((s0 + s1) + (s2 + s3))) - al2 * x1;
    Tu[272 + c] = f2bf(x2 * su); Tw[272 + c] = f2bf(x2 * sw); asm volatile("" ::: "memory");
    float x3 = fmaxf(0.0f, 1.0f - fabsf(cf - 3.0f));
    s0 = 0.f; s1 = 0.f; s2 = 0.f; s3 = 0.f;
    a = *(const LAS f32x4*)(Am + 204);
    s0 = fmaf(a.x, x0, s0);
    s1 = fmaf(a.y, x1, s1);
    const float al3 = a.z;
    x3 = (x3 - ((s0 + s1) + (s2 + s3))) - al3 * x2;
    Tu[408 + c] = f2bf(x3 * su); Tw[408 + c] = f2bf(x3 * sw); asm volatile("" ::: "memory");
    float x4 = fmaxf(0.0f, 1.0f - fabsf(cf - 4.0f));
    s0 = 0.f; s1 = 0.f; s2 = 0.f; s3 = 0.f;
    a = *(const LAS f32x4*)(Am + 272);
    s0 = fmaf(a.x, x0, s0);
    s1 = fmaf(a.y, x1, s1);
    s2 = fmaf(a.z, x2, s2);
    const float al4 = a.w;
    x4 = (x4 - ((s0 + s1) + (s2 + s3))) - al4 * x3;
    Tu[544 + c] = f2bf(x4 * su); Tw[544 + c] = f2bf(x4 * sw); asm volatile("" ::: "memory");
    float x5 = fmaxf(0.0f, 1.0f - fabsf(cf - 5.0f));
    s0 = 0.f; s1 = 0.f; s2 = 0.f; s3 = 0.f;
    a = *(const LAS f32x4*)(Am + 340);
    s0 = fmaf(a.x, x0, s0);
    s1 = fmaf(a.y, x1, s1);
    s2 = fmaf(a.z, x2, s2);
    s3 = fmaf(a.w, x3, s3);
    a = *(const LAS f32x4*)(Am + 344);
    const float al5 = a.x;
    x5 = (x5 - ((s0 + s1) + (s2 + s3))) - al5 * x4;
    Tu[680 + c] = f2bf(x5 * su); Tw[680 + c] = f2bf(x5 * sw); asm volatile("" ::: "memory");
    float x6 = fmaxf(0.0f, 1.0f - fabsf(cf - 6.0f));
    s0 = 0.f; s1 = 0.f; s2 = 0.f; s3 = 0.f;
    a = *(const LAS f32x4*)(Am + 408);
    s0 = fmaf(a.x, x0, s0);
    s1 = fmaf(a.y, x1, s1);
    s2 = fmaf(a.z, x2, s2);
    s3 = fmaf(a.w, x3, s3);
    a = *(const LAS f32x4*)(Am + 412);
    s0 = fmaf(a.x, x4, s0);
    const float al6 = a.y;
    x6 = (x6 - ((s0 + s1) + (s2 + s3))) - al6 * x5;
    Tu[816 + c] = f2bf(x6 * su); Tw[816 + c] = f2bf(x6 * sw); asm volatile("" ::: "memory");
    float x7 = fmaxf(0.0f, 1.0f - fabsf(cf - 7.0f));
    s0 = 0.f; s1 = 0.f; s2 = 0.f; s3 = 0.f;
    a = *(const LAS f32x4*)(Am + 476);
    s0 = fmaf(a.x, x0, s0);
    s1 = fmaf(a.y, x1, s1);
    s2 = fmaf(a.z, x2, s2);
    s3 = fmaf(a.w, x3, s3);
    a = *(const LAS f32x4*)(Am + 480);
    s0 = fmaf(a.x, x4, s0);
    s1 = fmaf(a.y, x5, s1);
    const float al7 = a.z;
    x7 = (x7 - ((s0 + s1) + (s2 + s3))) - al7 * x6;
    Tu[952 + c] = f2bf(x7 * su); Tw[952 + c] = f2bf(x7 * sw); asm volatile("" ::: "memory");
    float x8 = fmaxf(0.0f, 1.0f - fabsf(cf - 8.0f));
    s0 = 0.f; s1 = 0.f; s2 = 0.f; s3 = 0.f;
    a = *(const LAS f32x4*)(Am + 544);
    s0 = fmaf(a.x, x0, s0);
    s1 = fmaf(a.y, x1, s1);
    s2 = fmaf(a.z, x2, s2);
    s3 = fmaf(a.w, x3, s3);
    a = *(const LAS f32x4*)(Am + 548);
    s0 = fmaf(a.x, x4, s0);
    s1 = fmaf(a.y, x5, s1);
    s2 = fmaf(a.z, x6, s2);
    const float al8 = a.w;
    x8 = (x8 - ((s0 + s1) + (s2 + s3))) - al8 * x7;
    Tu[1088 + c] = f2bf(x8 * su); Tw[1088 + c] = f2bf(x8 * sw); asm volatile("" ::: "memory");
    float x9 = fmaxf(0.0f, 1.0f - fabsf(cf - 9.0f));
    s0 = 0.f; s1 = 0.f; s2 = 0.f; s3 = 0.f;
    a = *(const LAS f32x4*)(Am + 612);
    s0 = fmaf(a.x, x0, s0);
    s1 = fmaf(a.y, x1, s1);
    s2 = fmaf(a.z, x2, s2);
    s3 = fmaf(a.w, x3, s3);
    a = *(const LAS f32x4*)(Am + 616);
    s0 = fmaf(a.x, x4, s0);
    s1 = fmaf(a.y, x5, s1);
    s2 = fmaf(a.z, x6, s2);
    s3 = fmaf(a.w, x7, s3);
    a = *(const LAS f32x4*)(Am + 620);
    const float al9 = a.x;
    x9 = (x9 - ((s0 + s1) + (s2 + s3))) - al9 * x8;
    Tu[1224 + c] = f2bf(x9 * su); Tw[1224 + c] = f2bf(x9 * sw); asm volatile("" ::: "memory");
    float x10 = fmaxf(0.0f, 1.0f - fabsf(cf - 10.0f));
    s0 = 0.f; s1 = 0.f; s2 = 0.f; s3 = 0.f;
    a = *(const LAS f32x4*)(Am + 680);
    s0 = fmaf(a.x, x0, s0);
    s1 = fmaf(a.y, x1, s1);
    s2 = fmaf(a.z, x2, s2);
    s3 = fmaf(a.w, x3, s3);
    a = *(const LAS f32x4*)(Am + 684);
    s0 = fmaf(a.x, x4, s0);
    s1 = fmaf(a.y, x5, s1);
    s2 = fmaf(a.z, x6, s2);
    s3 = fmaf(a.w, x7, s3);
    a = *(const LAS f32x4*)(Am + 688);
    s0 = fmaf(a.x, x8, s0);
    const float al10 = a.y;
    x10 = (x10 - ((s0 + s1) + (s2 + s3))) - al10 * x9;
    Tu[1360 + c] = f2bf(x10 * su); Tw[1360 + c] = f2bf(x10 * sw); asm volatile("" ::: "memory");
    float x11 = fmaxf(0.0f, 1.0f - fabsf(cf - 11.0f));
    s0 = 0.f; s1 = 0.f; s2 = 0.f; s3 = 0.f;
    a = *(const LAS f32x4*)(Am + 748);
    s0 = fmaf(a.x, x0, s0);
    s1 = fmaf(a.y, x1, s1);
    s2 = fmaf(a.z, x2, s2);
    s3 = fmaf(a.w, x3, s3);
    a = *(const LAS f32x4*)(Am + 752);
    s0 = fmaf(a.x, x4, s0);
    s1 = fmaf(a.y, x5, s1);
    s2 = fmaf(a.z, x6, s2);
    s3 = fmaf(a.w, x7, s3);
    a = *(const LAS f32x4*)(Am + 756);
    s0 = fmaf(a.x, x8, s0);
    s1 = fmaf(a.y, x9, s1);
    const float al11 = a.z;
    x11 = (x11 - ((s0 + s1) + (s2 + s3))) - al11 * x10;
    Tu[1496 + c] = f2bf(x11 * su); Tw[1496 + c] = f2bf(x11 * sw); asm volatile("" ::: "memory");
    float x12 = fmaxf(0.0f, 1.0f - fabsf(cf - 12.0f));
    s0 = 0.f; s1 = 0.f; s2 = 0.f; s3 = 0.f;
    a = *(const LAS f32x4*)(Am + 816);
    s0 = fmaf(a.x, x0, s0);
    s1 = fmaf(a.y, x1, s1);
    s2 = fmaf(a.z, x2, s2);
    s3 = fmaf(a.w, x3, s3);
    a = *(const LAS f32x4*)(Am + 820);
    s0 = fmaf(a.x, x4, s0);
    s1 = fmaf(a.y, x5, s1);
    s2 = fmaf(a.z, x6, s2);
    s3 = fmaf(a.w, x7, s3);
    a = *(const LAS f32x4*)(Am + 824);
    s0 = fmaf(a.x, x8, s0);
    s1 = fmaf(a.y, x9, s1);
    s2 = fmaf(a.z, x10, s2);
    const float al12 = a.w;
    x12 = (x12 - ((s0 + s1) + (s2 + s3))) - al12 * x11;
    Tu[1632 + c] = f2bf(x12 * su); Tw[1632 + c] = f2bf(x12 * sw); asm volatile("" ::: "memory");
    float x13 = fmaxf(0.0f, 1.0f - fabsf(cf - 13.0f));
    s0 = 0.f; s1 = 0.f; s2 = 0.f; s3 = 0.f;
    a = *(const LAS f32x4*)(Am + 884);
    s0 = fmaf(a.x, x0, s0);
    s1 = fmaf(a.y, x1, s1);
    s2 = fmaf(a.z, x2, s2);
    s3 = fmaf(a.w, x3, s3);
    a = *(const LAS f32x4*)(Am + 888);
    s0 = fmaf(a.x, x4, s0);
    s1 = fmaf(a.y, x5, s1);
    s2 = fmaf(a.z, x6, s2);
    s3 = fmaf(a.w, x7, s3);
    a = *(const LAS f32x4*)(Am + 892);
    s0 = fmaf(a.x, x8, s0);
    s1 = fmaf(a.y, x9, s1);
    s2 = fmaf(a.z, x10, s2);
    s3 = fmaf(a.w, x11, s3);
    a = *(const LAS f32x4*)(Am + 896);
    const float al13 = a.x;
    x13 = (x13 - ((s0 + s1) + (s2 + s3))) - al13 * x12;
    Tu[1768 + c] = f2bf(x13 * su); Tw[1768 + c] = f2bf(x13 * sw); asm volatile("" ::: "memory");
    float x14 = fmaxf(0.0f, 1.0f - fabsf(cf - 14.0f));
    s0 = 0.f; s1 = 0.f; s2 = 0.f; s3 = 0.f;
    a = *(const LAS f32x4*)(Am + 952);
    s0 = fmaf(a.x, x0, s0);
    s1 = fmaf(a.y, x1, s1);
    s2 = fmaf(a.z, x2, s2);
    s3 = fmaf(a.w, x3, s3);
    a = *(const LAS f32x4*)(Am + 956);
    s0 = fmaf(a.x, x4, s0);
    s1 = fmaf(a.y, x5, s1);
    s2 = fmaf(a.z, x6, s2);
    s3 = fmaf(a.w, x7, s3);
    a = *(const LAS f32x4*)(Am + 960);
    s0 = fmaf(a.x, x8, s0);
    s1 = fmaf(a.y, x9, s1);
    s2 = fmaf(a.z, x10, s2);
    s3 = fmaf(a.w, x11, s3);
    a = *(const LAS f32x4*)(Am + 964);
    s0 = fmaf(a.x, x12, s0);
    const float al14 = a.y;
    x14 = (x14 - ((s0 + s1) + (s2 + s3))) - al14 * x13;
    Tu[1904 + c] = f2bf(x14 * su); Tw[1904 + c] = f2bf(x14 * sw); asm volatile("" ::: "memory");
    float x15 = fmaxf(0.0f, 1.0f - fabsf(cf - 15.0f));
    s0 = 0.f; s1 = 0.f; s2 = 0.f; s3 = 0.f;
    a = *(const LAS f32x4*)(Am + 1020);
    s0 = fmaf(a.x, x0, s0);
    s1 = fmaf(a.y, x1, s1);
    s2 = fmaf(a.z, x2, s2);
    s3 = fmaf(a.w, x3, s3);
    a = *(const LAS f32x4*)(Am + 1024);
    s0 = fmaf(a.x, x4, s0);
    s1 = fmaf(a.y, x5, s1);
    s2 = fmaf(a.z, x6, s2);
    s3 = fmaf(a.w, x7, s3);
    a = *(const LAS f32x4*)(Am + 1028);
    s0 = fmaf(a.x, x8, s0);
    s1 = fmaf(a.y, x9, s1);
    s2 = fmaf(a.z, x10, s2);
    s3 = fmaf(a.w, x11, s3);
    a = *(const LAS f32x4*)(Am + 1032);
    s0 = fmaf(a.x, x12, s0);
    s1 = fmaf(a.y, x13, s1);
    const float al15 = a.z;
    x15 = (x15 - ((s0 + s1) + (s2 + s3))) - al15 * x14;
    Tu[2040 + c] = f2bf(x15 * su); Tw[2040 + c] = f2bf(x15 * sw); asm volatile("" ::: "memory");
    float x16 = fmaxf(0.0f, 1.0f - fabsf(cf - 16.0f));
    s0 = 0.f; s1 = 0.f; s2 = 0.f; s3 = 0.f;
    a = *(const LAS f32x4*)(Am + 1088);
    s0 = fmaf(a.x, x0, s0);
    s1 = fmaf(a.y, x1, s1);
    s2 = fmaf(a.z, x2, s2);
    s3 = fmaf(a.w, x3, s3);
    a = *(const LAS f32x4*)(Am + 1092);
    s0 = fmaf(a.x, x4, s0);
    s1 = fmaf(a.y, x5, s1);
    s2 = fmaf(a.z, x6, s2);
    s3 = fmaf(a.w, x7, s3);
    a = *(const LAS f32x4*)(Am + 1096);
    s0 = fmaf(a.x, x8, s0);
    s1 = fmaf(a.y, x9, s1);
    s2 = fmaf(a.z, x10, s2);
    s3 = fmaf(a.w, x11, s3);
    a = *(const LAS f32x4*)(Am + 1100);
    s0 = fmaf(a.x, x12, s0);
    s1 = fmaf(a.y, x13, s1);
    s2 = fmaf(a.z, x14, s2);
    const float al16 = a.w;
    x16 = (x16 - ((s0 + s1) + (s2 + s3))) - al16 * x15;
    Tu[2176 + c] = f2bf(x16 * su); Tw[2176 + c] = f2bf(x16 * sw); asm volatile("" ::: "memory");
    float x17 = fmaxf(0.0f, 1.0f - fabsf(cf - 17.0f));
    s0 = 0.f; s1 = 0.f; s2 = 0.f; s3 = 0.f;
    a = *(const LAS f32x4*)(Am + 1156);
    s0 = fmaf(a.x, x0, s0);
    s1 = fmaf(a.y, x1, s1);
    s2 = fmaf(a.z, x2, s2);
    s3 = fmaf(a.w, x3, s3);
    a = *(const LAS f32x4*)(Am + 1160);
    s0 = fmaf(a.x, x4, s0);
    s1 = fmaf(a.y, x5, s1);
    s2 = fmaf(a.z, x6, s2);
    s3 = fmaf(a.w, x7, s3);
    a = *(const LAS f32x4*)(Am + 1164);
    s0 = fmaf(a.x, x8, s0);
    s1 = fmaf(a.y, x9, s1);
    s2 = fmaf(a.z, x10, s2);
    s3 = fmaf(a.w, x11, s3);
    a = *(const LAS f32x4*)(Am + 1168);
    s0 = fmaf(a.x, x12, s0);
    s1 = fmaf(a.y, x13, s1);
    s2 = fmaf(a.z, x14, s2);
    s3 = fmaf(a.w, x15, s3);
    a = *(const LAS f32x4*)(Am + 1172);
    const float al17 = a.x;
    x17 = (x17 - ((s0 + s1) + (s2 + s3))) - al17 * x16;
    Tu[2312 + c] = f2bf(x17 * su); Tw[2312 + c] = f2bf(x17 * sw); asm volatile("" ::: "memory");
    float x18 = fmaxf(0.0f, 1.0f - fabsf(cf - 18.0f));
    s0 = 0.f; s1 = 0.f; s2 = 0.f; s3 = 0.f;
    a = *(const LAS f32x4*)(Am + 1224);
    s0 = fmaf(a.x, x0, s0);
    s1 = fmaf(a.y, x1, s1);
    s2 = fmaf(a.z, x2, s2);
    s3 = fmaf(a.w, x3, s3);
    a = *(const LAS f32x4*)(Am + 1228);
    s0 = fmaf(a.x, x4, s0);
    s1 = fmaf(a.y, x5, s1);
    s2 = fmaf(a.z, x6, s2);
    s3 = fmaf(a.w, x7, s3);
    a = *(const LAS f32x4*)(Am + 1232);
    s0 = fmaf(a.x, x8, s0);
    s1 = fmaf(a.y, x9, s1);
    s2 = fmaf(a.z, x10, s2);
    s3 = fmaf(a.w, x11, s3);
    a = *(const LAS f32x4*)(Am + 1236);
    s0 = fmaf(a.x, x12, s0);
    s1 = fmaf(a.y, x13, s1);
    s2 = fmaf(a.z, x14, s2);
    s3 = fmaf(a.w, x15, s3);
    a = *(const LAS f32x4*)(Am + 1240);
    s0 = fmaf(a.x, x16, s0);
    const float al18 = a.y;
    x18 = (x18 - ((s0 + s1) + (s2 + s3))) - al18 * x17;
    Tu[2448 + c] = f2bf(x18 * su); Tw[2448 + c] = f2bf(x18 * sw); asm volatile("" ::: "memory");
    float x19 = fmaxf(0.0f, 1.0f - fabsf(cf - 19.0f));
    s0 = 0.f; s1 = 0.f; s2 = 0.f; s3 = 0.f;
    a = *(const LAS f32x4*)(Am + 1292);
    s0 = fmaf(a.x, x0, s0);
    s1 = fmaf(a.y, x1, s1);
    s2 = fmaf(a.z, x2, s2);
    s3 = fmaf(a.w, x3, s3);
    a = *(const LAS f32x4*)(Am + 1296);
    s0 = fmaf(a.x, x4, s0);
    s1 = fmaf(a.y, x5, s1);
    s2 = fmaf(a.z, x6, s2);
    s3 = fmaf(a.w, x7, s3);
    a = *(const LAS f32x4*)(Am + 1300);
    s0 = fmaf(a.x, x8, s0);
    s1 = fmaf(a.y, x9, s1);
    s2 = fmaf(a.z, x10, s2);
    s3 = fmaf(a.w, x11, s3);
    a = *(const LAS f32x4*)(Am + 1304);
    s0 = fmaf(a.x, x12, s0);
    s1 = fmaf(a.y, x13, s1);
    s2 = fmaf(a.z, x14, s2);
    s3 = fmaf(a.w, x15, s3);
    a = *(const LAS f32x4*)(Am + 1308);
    s0 = fmaf(a.x, x16, s0);
    s1 = fmaf(a.y, x17, s1);
    const float al19 = a.z;
    x19 = (x19 - ((s0 + s1) + (s2 + s3))) - al19 * x18;
    Tu[2584 + c] = f2bf(x19 * su); Tw[2584 + c] = f2bf(x19 * sw); asm volatile("" ::: "memory");
    float x20 = fmaxf(0.0f, 1.0f - fabsf(cf - 20.0f));
    s0 = 0.f; s1 = 0.f; s2 = 0.f; s3 = 0.f;
    a = *(const LAS f32x4*)(Am + 1360);
    s0 = fmaf(a.x, x0, s0);
    s1 = fmaf(a.y, x1, s1);
    s2 = fmaf(a.z, x2, s2);
    s3 = fmaf(a.w, x3, s3);
    a = *(const LAS f32x4*)(Am + 1364);
    s0 = fmaf(a.x, x4, s0);
    s1 = fmaf(a.y, x5, s1);
    s2 = fmaf(a.z, x6, s2);
    s3 = fmaf(a.w, x7, s3);
    a = *(const LAS f32x4*)(Am + 1368);
    s0 = fmaf(a.x, x8, s0);
    s1 = fmaf(a.y, x9, s1);
    s2 = fmaf(a.z, x10, s2);
    s3 = fmaf(a.w, x11, s3);
    a = *(const LAS f32x4*)(Am + 1372);
    s0 = fmaf(a.x, x12, s0);
    s1 = fmaf(a.y, x13, s1);
    s2 = fmaf(a.z, x14, s2);
    s3 = fmaf(a.w, x15, s3);
    a = *(const LAS f32x4*)(Am + 1376);
    s0 = fmaf(a.x, x16, s0);
    s1 = fmaf(a.y, x17, s1);
    s2 = fmaf(a.z, x18, s2);
    const float al20 = a.w;
    x20 = (x20 - ((s0 + s1) + (s2 + s3))) - al20 * x19;
    Tu[2720 + c] = f2bf(x20 * su); Tw[2720 + c] = f2bf(x20 * sw); asm volatile("" ::: "memory");
    float x21 = fmaxf(0.0f, 1.0f - fabsf(cf - 21.0f));
    s0 = 0.f; s1 = 0.f; s2 = 0.f; s3 = 0.f;
    a = *(const LAS f32x4*)(Am + 1428);
    s0 = fmaf(a.x, x0, s0);
    s1 = fmaf(a.y, x1, s1);
    s2 = fmaf(a.z, x2, s2);
    s3 = fmaf(a.w, x3, s3);
    a = *(const LAS f32x4*)(Am + 1432);
    s0 = fmaf(a.x, x4, s0);
    s1 = fmaf(a.y, x5, s1);
    s2 = fmaf(a.z, x6, s2);
    s3 = fmaf(a.w, x7, s3);
    a = *(const LAS f32x4*)(Am + 1436);
    s0 = fmaf(a.x, x8, s0);
    s1 = fmaf(a.y, x9, s1);
    s2 = fmaf(a.z, x10, s2);
    s3 = fmaf(a.w, x11, s3);
    a = *(const LAS f32x4*)(Am + 1440);
    s0 = fmaf(a.x, x12, s0);
    s1 = fmaf(a.y, x13, s1);
    s2 = fmaf(a.z, x14, s2);
    s3 = fmaf(a.w, x15, s3);
    a = *(const LAS f32x4*)(Am + 1444);
    s0 = fmaf(a.x, x16, s0);
    s1 = fmaf(a.y, x17, s1);
    s2 = fmaf(a.z, x18, s2);
    s3 = fmaf(a.w, x19, s3);
    a = *(const LAS f32x4*)(Am + 1448);
    const float al21 = a.x;
    x21 = (x21 - ((s0 + s1) + (s2 + s3))) - al21 * x20;
    Tu[2856 + c] = f2bf(x21 * su); Tw[2856 + c] = f2bf(x21 * sw); asm volatile("" ::: "memory");
    float x22 = fmaxf(0.0f, 1.0f - fabsf(cf - 22.0f));
    s0 = 0.f; s1 = 0.f; s2 = 0.f; s3 = 0.f;
    a = *(const LAS f32x4*)(Am + 1496);
    s0 = fmaf(a.x, x0, s0);
    s1 = fmaf(a.y, x1, s1);
    s2 = fmaf(a.z, x2, s2);
    s3 = fmaf(a.w, x3, s3);
    a = *(const LAS f32x4*)(Am + 1500);
    s0 = fmaf(a.x, x4, s0);
    s1 = fmaf(a.y, x5, s1);
    s2 = fmaf(a.z, x6, s2);
    s3 = fmaf(a.w, x7, s3);
    a = *(const LAS f32x4*)(Am + 1504);
    s0 = fmaf(a.x, x8, s0);
    s1 = fmaf(a.y, x9, s1);
    s2 = fmaf(a.z, x10, s2);
    s3 = fmaf(a.w, x11, s3);
    a = *(const LAS f32x4*)(Am + 1508);
    s0 = fmaf(a.x, x12, s0);
    s1 = fmaf(a.y, x13, s1);
    s2 = fmaf(a.z, x14, s2);
    s3 = fmaf(a.w, x15, s3);
    a = *(const LAS f32x4*)(Am + 1512);
    s0 = fmaf(a.x, x16, s0);
    s1 = fmaf(a.y, x17, s1);
    s2 = fmaf(a.z, x18, s2);
    s3 = fmaf(a.w, x19, s3);
    a = *(const LAS f32x4*)(Am + 1516);
    s0 = fmaf(a.x, x20, s0);
    const float al22 = a.y;
    x22 = (x22 - ((s0 + s1) + (s2 + s3))) - al22 * x21;
    Tu[2992 + c] = f2bf(x22 * su); Tw[2992 + c] = f2bf(x22 * sw); asm volatile("" ::: "memory");
    float x23 = fmaxf(0.0f, 1.0f - fabsf(cf - 23.0f));
    s0 = 0.f; s1 = 0.f; s2 = 0.f; s3 = 0.f;
    a = *(const LAS f32x4*)(Am + 1564);
    s0 = fmaf(a.x, x0, s0);
    s1 = fmaf(a.y, x1, s1);
    s2 = fmaf(a.z, x2, s2);
    s3 = fmaf(a.w, x3, s3);
    a = *(const LAS f32x4*)(Am + 1568);
    s0 = fmaf(a.x, x4, s0);
    s1 = fmaf(a.y, x5, s1);
    s2 = fmaf(a.z, x6, s2);
    s3 = fmaf(a.w, x7, s3);
    a = *(const LAS f32x4*)(Am + 1572);
    s0 = fmaf(a.x, x8, s0);
    s1 = fmaf(a.y, x9, s1);
    s2 = fmaf(a.z, x10, s2);
    s3 = fmaf(a.w, x11, s3);
    a = *(const LAS f32x4*)(Am + 1576);
    s0 = fmaf(a.x, x12, s0);
    s1 = fmaf(a.y, x13, s1);
    s2 = fmaf(a.z, x14, s2);
    s3 = fmaf(a.w, x15, s3);
    a = *(const LAS f32x4*)(Am + 1580);
    s0 = fmaf(a.x, x16, s0);
    s1 = fmaf(a.y, x17, s1);
    s2 = fmaf(a.z, x18, s2);
    s3 = fmaf(a.w, x19, s3);
    a = *(const LAS f32x4*)(Am + 1584);
    s0 = fmaf(a.x, x20, s0);
    s1 = fmaf(a.y, x21, s1);
    const float al23 = a.z;
    x23 = (x23 - ((s0 + s1) + (s2 + s3))) - al23 * x22;
    Tu[3128 + c] = f2bf(x23 * su); Tw[3128 + c] = f2bf(x23 * sw); asm volatile("" ::: "memory");
    float x24 = fmaxf(0.0f, 1.0f - fabsf(cf - 24.0f));
    s0 = 0.f; s1 = 0.f; s2 = 0.f; s3 = 0.f;
    a = *(const LAS f32x4*)(Am + 1632);
    s0 = fmaf(a.x, x0, s0);
    s1 = fmaf(a.y, x1, s1);
    s2 = fmaf(a.z, x2, s2);
    s3 = fmaf(a.w, x3, s3);
    a = *(const LAS f32x4*)(Am + 1636);
    s0 = fmaf(a.x, x4, s0);
    s1 = fmaf(a.y, x5, s1);
    s2 = fmaf(a.z, x6, s2);
    s3 = fmaf(a.w, x7, s3);
    a = *(const LAS f32x4*)(Am + 1640);
    s0 = fmaf(a.x, x8, s0);
    s1 = fmaf(a.y, x9, s1);
    s2 = fmaf(a.z, x10, s2);
    s3 = fmaf(a.w, x11, s3);
    a = *(const LAS f32x4*)(Am + 1644);
    s0 = fmaf(a.x, x12, s0);
    s1 = fmaf(a.y, x13, s1);
    s2 = fmaf(a.z, x14, s2);
    s3 = fmaf(a.w, x15, s3);
    a = *(const LAS f32x4*)(Am + 1648);
    s0 = fmaf(a.x, x16, s0);
    s1 = fmaf(a.y, x17, s1);
    s2 = fmaf(a.z, x18, s2);
    s3 = fmaf(a.w, x19, s3);
    a = *(const LAS f32x4*)(Am + 1652);
    s0 = fmaf(a.x, x20, s0);
    s1 = fmaf(a.y, x21, s1);
    s2 = fmaf(a.z, x22, s2);
    const float al24 = a.w;
    x24 = (x24 - ((s0 + s1) + (s2 + s3))) - al24 * x23;
    Tu[3264 + c] = f2bf(x24 * su); Tw[3264 + c] = f2bf(x24 * sw); asm volatile("" ::: "memory");
    float x25 = fmaxf(0.0f, 1.0f - fabsf(cf - 25.0f));
    s0 = 0.f; s1 = 0.f; s2 = 0.f; s3 = 0.f;
    a = *(const LAS f32x4*)(Am + 1700);
    s0 = fmaf(a.x, x0, s0);
    s1 = fmaf(a.y, x1, s1);
    s2 = fmaf(a.z, x2, s2);
    s3 = fmaf(a.w, x3, s3);
    a = *(const LAS f32x4*)(Am + 1704);
    s0 = fmaf(a.x, x4, s0);
    s1 = fmaf(a.y, x5, s1);
    s2 = fmaf(a.z, x6, s2);
    s3 = fmaf(a.w, x7, s3);
    a = *(const LAS f32x4*)(Am + 1708);
    s0 = fmaf(a.x, x8, s0);
    s1 = fmaf(a.y, x9, s1);
    s2 = fmaf(a.z, x10, s2);
    s3 = fmaf(a.w, x11, s3);
    a = *(const LAS f32x4*)(Am + 1712);
    s0 = fmaf(a.x, x12, s0);
    s1 = fmaf(a.y, x13, s1);
    s2 = fmaf(a.z, x14, s2);
    s3 = fmaf(a.w, x15, s3);
    a = *(const LAS f32x4*)(Am + 1716);
    s0 = fmaf(a.x, x16, s0);
    s1 = fmaf(a.y, x17, s1);
    s2 = fmaf(a.z, x18, s2);
    s3 = fmaf(a.w, x19, s3);
    a = *(const LAS f32x4*)(Am + 1720);
    s0 = fmaf(a.x, x20, s0);
    s1 = fmaf(a.y, x21, s1);
    s2 = fmaf(a.z, x22, s2);
    s3 = fmaf(a.w, x23, s3);
    a = *(const LAS f32x4*)(Am + 1724);
    const float al25 = a.x;
    x25 = (x25 - ((s0 + s1) + (s2 + s3))) - al25 * x24;
    Tu[3400 + c] = f2bf(x25 * su); Tw[3400 + c] = f2bf(x25 * sw); asm volatile("" ::: "memory");
    float x26 = fmaxf(0.0f, 1.0f - fabsf(cf - 26.0f));
    s0 = 0.f; s1 = 0.f; s2 = 0.f; s3 = 0.f;
    a = *(const LAS f32x4*)(Am + 1768);
    s0 = fmaf(a.x, x0, s0);
    s1 = fmaf(a.y, x1, s1);
    s2 = fmaf(a.z, x2, s2);
    s3 = fmaf(a.w, x3, s3);
    a = *(const LAS f32x4*)(Am + 1772);
    s0 = fmaf(a.x, x4, s0);
    s1 = fmaf(a.y, x5, s1);
    s2 = fmaf(a.z, x6, s2);
    s3 = fmaf(a.w, x7, s3);
    a = *(const LAS f32x4*)(Am + 1776);
    s0 = fmaf(a.x, x8, s0);
    s1 = fmaf(a.y, x9, s1);
    s2 = fmaf(a.z, x10, s2);
    s3 = fmaf(a.w, x11, s3);
    a = *(const LAS f32x4*)(Am + 1780);
    s0 = fmaf(a.x, x12, s0);
    s1 = fmaf(a.y, x13, s1);
    s2 = fmaf(a.z, x14, s2);
    s3 = fmaf(a.w, x15, s3);
    a = *(const LAS f32x4*)(Am + 1784);
    s0 = fmaf(a.x, x16, s0);
    s1 = fmaf(a.y, x17, s1);
    s2 = fmaf(a.z, x18, s2);
    s3 = fmaf(a.w, x19, s3);
    a = *(const LAS f32x4*)(Am + 1788);
    s0 = fmaf(a.x, x20, s0);
    s1 = fmaf(a.y, x21, s1);
    s2 = fmaf(a.z, x22, s2);
    s3 = fmaf(a.w, x23, s3);
    a = *(const LAS f32x4*)(Am + 1792);
    s0 = fmaf(a.x, x24, s0);
    const float al26 = a.y;
    x26 = (x26 - ((s0 + s1) + (s2 + s3))) - al26 * x25;
    Tu[3536 + c] = f2bf(x26 * su); Tw[3536 + c] = f2bf(x26 * sw); asm volatile("" ::: "memory");
    float x27 = fmaxf(0.0f, 1.0f - fabsf(cf - 27.0f));
    s0 = 0.f; s1 = 0.f; s2 = 0.f; s3 = 0.f;
    a = *(const LAS f32x4*)(Am + 1836);
    s0 = fmaf(a.x, x0, s0);
    s1 = fmaf(a.y, x1, s1);
    s2 = fmaf(a.z, x2, s2);
    s3 = fmaf(a.w, x3, s3);
    a = *(const LAS f32x4*)(Am + 1840);
    s0 = fmaf(a.x, x4, s0);
    s1 = fmaf(a.y, x5, s1);
    s2 = fmaf(a.z, x6, s2);
    s3 = fmaf(a.w, x7, s3);
    a = *(const LAS f32x4*)(Am + 1844);
    s0 = fmaf(a.x, x8, s0);
    s1 = fmaf(a.y, x9, s1);
    s2 = fmaf(a.z, x10, s2);
    s3 = fmaf(a.w, x11, s3);
    a = *(const LAS f32x4*)(Am + 1848);
    s0 = fmaf(a.x, x12, s0);
    s1 = fmaf(a.y, x13, s1);
    s2 = fmaf(a.z, x14, s2);
    s3 = fmaf(a.w, x15, s3);
    a = *(const LAS f32x4*)(Am + 1852);
    s0 = fmaf(a.x, x16, s0);
    s1 = fmaf(a.y, x17, s1);
    s2 = fmaf(a.z, x18, s2);
    s3 = fmaf(a.w, x19, s3);
    a = *(const LAS f32x4*)(Am + 1856);
    s0 = fmaf(a.x, x20, s0);
    s1 = fmaf(a.y, x21, s1);
    s2 = fmaf(a.z, x22, s2);
    s3 = fmaf(a.w, x23, s3);
    a = *(const LAS f32x4*)(Am + 1860);
    s0 = fmaf(a.x, x24, s0);
    s1 = fmaf(a.y, x25, s1);
    const float al27 = a.z;
    x27 = (x27 - ((s0 + s1) + (s2 + s3))) - al27 * x26;
    Tu[3672 + c] = f2bf(x27 * su); Tw[3672 + c] = f2bf(x27 * sw); asm volatile("" ::: "memory");
    float x28 = fmaxf(0.0f, 1.0f - fabsf(cf - 28.0f));
    s0 = 0.f; s1 = 0.f; s2 = 0.f; s3 = 0.f;
    a = *(const LAS f32x4*)(Am + 1904);
    s0 = fmaf(a.x, x0, s0);
    s1 = fmaf(a.y, x1, s1);
    s2 = fmaf(a.z, x2, s2);
    s3 = fmaf(a.w, x3, s3);
    a = *(const LAS f32x4*)(Am + 1908);
    s0 = fmaf(a.x, x4, s0);
    s1 = fmaf(a.y, x5, s1);
    s2 = fmaf(a.z, x6, s2);
    s3 = fmaf(a.w, x7, s3);
    a = *(const LAS f32x4*)(Am + 1912);
    s0 = fmaf(a.x, x8, s0);
    s1 = fmaf(a.y, x9, s1);
    s2 = fmaf(a.z, x10, s2);
    s3 = fmaf(a.w, x11, s3);
    a = *(const LAS f32x4*)(Am + 1916);
    s0 = fmaf(a.x, x12, s0);
    s1 = fmaf(a.y, x13, s1);
    s2 = fmaf(a.z, x14, s2);
    s3 = fmaf(a.w, x15, s3);
    a = *(const LAS f32x4*)(Am + 1920);
    s0 = fmaf(a.x, x16, s0);
    s1 = fmaf(a.y, x17, s1);
    s2 = fmaf(a.z, x18, s2);
    s3 = fmaf(a.w, x19, s3);
    a = *(const LAS f32x4*)(Am + 1924);
    s0 = fmaf(a.x, x20, s0);
    s1 = fmaf(a.y, x21, s1);
    s2 = fmaf(a.z, x22, s2);
    s3 = fmaf(a.w, x23, s3);
    a = *(const LAS f32x4*)(Am + 1928);
    s0 = fmaf(a.x, x24, s0);
    s1 = fmaf(a.y, x25, s1);
    s2 = fmaf(a.z, x26, s2);
    const float al28 = a.w;
    x28 = (x28 - ((s0 + s1) + (s2 + s3))) - al28 * x27;
    Tu[3808 + c] = f2bf(x28 * su); Tw[3808 + c] = f2bf(x28 * sw); asm volatile("" ::: "memory");
    float x29 = fmaxf(0.0f, 1.0f - fabsf(cf - 29.0f));
    s0 = 0.f; s1 = 0.f; s2 = 0.f; s3 = 0.f;
    a = *(const LAS f32x4*)(Am + 1972);
    s0 = fmaf(a.x, x0, s0);
    s1 = fmaf(a.y, x1, s1);
    s2 = fmaf(a.z, x2, s2);
    s3 = fmaf(a.w, x3, s3);
    a = *(const LAS f32x4*)(Am + 1976);
    s0 = fmaf(a.x, x4, s0);
    s1 = fmaf(a.y, x5, s1);
    s2 = fmaf(a.z, x6, s2);
    s3 = fmaf(a.w, x7, s3);
    a = *(const LAS f32x4*)(Am + 1980);
    s0 = fmaf(a.x, x8, s0);
    s1 = fmaf(a.y, x9, s1);
    s2 = fmaf(a.z, x10, s2);
    s3 = fmaf(a.w, x11, s3);
    a = *(const LAS f32x4*)(Am + 1984);
    s0 = fmaf(a.x, x12, s0);
    s1 = fmaf(a.y, x13, s1);
    s2 = fmaf(a.z, x14, s2);
    s3 = fmaf(a.w, x15, s3);
    a = *(const LAS f32x4*)(Am + 1988);
    s0 = fmaf(a.x, x16, s0);
    s1 = fmaf(a.y, x17, s1);
    s2 = fmaf(a.z, x18, s2);
    s3 = fmaf(a.w, x19, s3);
    a = *(const LAS f32x4*)(Am + 1992);
    s0 = fmaf(a.x, x20, s0);
    s1 = fmaf(a.y, x21, s1);
    s2 = fmaf(a.z, x22, s2);
    s3 = fmaf(a.w, x23, s3);
    a = *(const LAS f32x4*)(Am + 1996);
    s0 = fmaf(a.x, x24, s0);
    s1 = fmaf(a.y, x25, s1);
    s2 = fmaf(a.z, x26, s2);
    s3 = fmaf(a.w, x27, s3);
    a = *(const LAS f32x4*)(Am + 2000);
    const float al29 = a.x;
    x29 = (x29 - ((s0 + s1) + (s2 + s3))) - al29 * x28;
    Tu[3944 + c] = f2bf(x29 * su); Tw[3944 + c] = f2bf(x29 * sw); asm volatile("" ::: "memory");
    float x30 = fmaxf(0.0f, 1.0f - fabsf(cf - 30.0f));
    s0 = 0.f; s1 = 0.f; s2 = 0.f; s3 = 0.f;
    a = *(const LAS f32x4*)(Am + 2040);
    s0 = fmaf(a.x, x0, s0);
    s1 = fmaf(a.y, x1, s1);
    s2 = fmaf(a.z, x2, s2);
    s3 = fmaf(a.w, x3, s3);
    a = *(const LAS f32x4*)(Am + 2044);
    s0 = fmaf(a.x, x4, s0);
    s1 = fmaf(a.y, x5, s1);
    s2 = fmaf(a.z, x6, s2);
    s3 = fmaf(a.w, x7, s3);
    a = *(const LAS f32x4*)(Am + 2048);
    s0 = fmaf(a.x, x8, s0);
    s1 = fmaf(a.y, x9, s1);
    s2 = fmaf(a.z, x10, s2);
    s3 = fmaf(a.w, x11, s3);
    a = *(const LAS f32x4*)(Am + 2052);
    s0 = fmaf(a.x, x12, s0);
    s1 = fmaf(a.y, x13, s1);
    s2 = fmaf(a.z, x14, s2);
    s3 = fmaf(a.w, x15, s3);
    a = *(const LAS f32x4*)(Am + 2056);
    s0 = fmaf(a.x, x16, s0);
    s1 = fmaf(a.y, x17, s1);
    s2 = fmaf(a.z, x18, s2);
    s3 = fmaf(a.w, x19, s3);
    a = *(const LAS f32x4*)(Am + 2060);
    s0 = fmaf(a.x, x20, s0);
    s1 = fmaf(a.y, x21, s1);
    s2 = fmaf(a.z, x22, s2);
    s3 = fmaf(a.w, x23, s3);
    a = *(const LAS f32x4*)(Am + 2064);
    s0 = fmaf(a.x, x24, s0);
    s1 = fmaf(a.y, x25, s1);
    s2 = fmaf(a.z, x26, s2);
    s3 = fmaf(a.w, x27, s3);
    a = *(const LAS f32x4*)(Am + 2068);
    s0 = fmaf(a.x, x28, s0);
    const float al30 = a.y;
    x30 = (x30 - ((s0 + s1) + (s2 + s3))) - al30 * x29;
    Tu[4080 + c] = f2bf(x30 * su); Tw[4080 + c] = f2bf(x30 * sw); asm volatile("" ::: "memory");
    float x31 = fmaxf(0.0f, 1.0f - fabsf(cf - 31.0f));
    s0 = 0.f; s1 = 0.f; s2 = 0.f; s3 = 0.f;
    a = *(const LAS f32x4*)(Am + 2108);
    s0 = fmaf(a.x, x0, s0);
    s1 = fmaf(a.y, x1, s1);
    s2 = fmaf(a.z, x2, s2);
    s3 = fmaf(a.w, x3, s3);
    a = *(const LAS f32x4*)(Am + 2112);
    s0 = fmaf(a.x, x4, s0);
    s1 = fmaf(a.y, x5, s1);
    s2 = fmaf(a.z, x6, s2);
    s3 = fmaf(a.w, x7, s3);
    a = *(const LAS f32x4*)(Am + 2116);
    s0 = fmaf(a.x, x8, s0);
    s1 = fmaf(a.y, x9, s1);
    s2 = fmaf(a.z, x10, s2);
    s3 = fmaf(a.w, x11, s3);
    a = *(const LAS f32x4*)(Am + 2120);
    s0 = fmaf(a.x, x12, s0);
    s1 = fmaf(a.y, x13, s1);
    s2 = fmaf(a.z, x14, s2);
    s3 = fmaf(a.w, x15, s3);
    a = *(const LAS f32x4*)(Am + 2124);
    s0 = fmaf(a.x, x16, s0);
    s1 = fmaf(a.y, x17, s1);
    s2 = fmaf(a.z, x18, s2);
    s3 = fmaf(a.w, x19, s3);
    a = *(const LAS f32x4*)(Am + 2128);
    s0 = fmaf(a.x, x20, s0);
    s1 = fmaf(a.y, x21, s1);
    s2 = fmaf(a.z, x22, s2);
    s3 = fmaf(a.w, x23, s3);
    a = *(const LAS f32x4*)(Am + 2132);
    s0 = fmaf(a.x, x24, s0);
    s1 = fmaf(a.y, x25, s1);
    s2 = fmaf(a.z, x26, s2);
    s3 = fmaf(a.w, x27, s3);
    a = *(const LAS f32x4*)(Am + 2136);
    s0 = fmaf(a.x, x28, s0);
    s1 = fmaf(a.y, x29, s1);
    const float al31 = a.z;
    x31 = (x31 - ((s0 + s1) + (s2 + s3))) - al31 * x30;
    Tu[4216 + c] = f2bf(x31 * su); Tw[4216 + c] = f2bf(x31 * sw); asm volatile("" ::: "memory");
    float x32 = fmaxf(0.0f, 1.0f - fabsf(cf - 32.0f));
    s0 = 0.f; s1 = 0.f; s2 = 0.f; s3 = 0.f;
    a = *(const LAS f32x4*)(Am + 2176);
    s0 = fmaf(a.x, x0, s0);
    s1 = fmaf(a.y, x1, s1);
    s2 = fmaf(a.z, x2, s2);
    s3 = fmaf(a.w, x3, s3);
    a = *(const LAS f32x4*)(Am + 2180);
    s0 = fmaf(a.x, x4, s0);
    s1 = fmaf(a.y, x5, s1);
    s2 = fmaf(a.z, x6, s2);
    s3 = fmaf(a.w, x7, s3);
    a = *(const LAS f32x4*)(Am + 2184);
    s0 = fmaf(a.x, x8, s0);
    s1 = fmaf(a.y, x9, s1);
    s2 = fmaf(a.z, x10, s2);
    s3 = fmaf(a.w, x11, s3);
    a = *(const LAS f32x4*)(Am + 2188);
    s0 = fmaf(a.x, x12, s0);
    s1 = fmaf(a.y, x13, s1);
    s2 = fmaf(a.z, x14, s2);
    s3 = fmaf(a.w, x15, s3);
    a = *(const LAS f32x4*)(Am + 2192);
    s0 = fmaf(a.x, x16, s0);
    s1 = fmaf(a.y, x17, s1);
    s2 = fmaf(a.z, x18, s2);
    s3 = fmaf(a.w, x19, s3);
    a = *(const LAS f32x4*)(Am + 2196);
    s0 = fmaf(a.x, x20, s0);
    s1 = fmaf(a.y, x21, s1);
    s2 = fmaf(a.z, x22, s2);
    s3 = fmaf(a.w, x23, s3);
    a = *(const LAS f32x4*)(Am + 2200);
    s0 = fmaf(a.x, x24, s0);
    s1 = fmaf(a.y, x25, s1);
    s2 = fmaf(a.z, x26, s2);
    s3 = fmaf(a.w, x27, s3);
    a = *(const LAS f32x4*)(Am + 2204);
    s0 = fmaf(a.x, x28, s0);
    s1 = fmaf(a.y, x29, s1);
    s2 = fmaf(a.z, x30, s2);
    const float al32 = a.w;
    x32 = (x32 - ((s0 + s1) + (s2 + s3))) - al32 * x31;
    Tu[4352 + c] = f2bf(x32 * su); Tw[4352 + c] = f2bf(x32 * sw); asm volatile("" ::: "memory");
    float x33 = fmaxf(0.0f, 1.0f - fabsf(cf - 33.0f));
    s0 = 0.f; s1 = 0.f; s2 = 0.f; s3 = 0.f;
    a = *(const LAS f32x4*)(Am + 2244);
    s0 = fmaf(a.x, x0, s0);
    s1 = fmaf(a.y, x1, s1);
    s2 = fmaf(a.z, x2, s2);
    s3 = fmaf(a.w, x3, s3);
    a = *(const LAS f32x4*)(Am + 2248);
    s0 = fmaf(a.x, x4, s0);
    s1 = fmaf(a.y, x5, s1);
    s2 = fmaf(a.z, x6, s2);
    s3 = fmaf(a.w, x7, s3);
    a = *(const LAS f32x4*)(Am + 2252);
    s0 = fmaf(a.x, x8, s0);
    s1 = fmaf(a.y, x9, s1);
    s2 = fmaf(a.z, x10, s2);
    s3 = fmaf(a.w, x11, s3);
    a = *(const LAS f32x4*)(Am + 2256);
    s0 = fmaf(a.x, x12, s0);
    s1 = fmaf(a.y, x13, s1);
    s2 = fmaf(a.z, x14, s2);
    s3 = fmaf(a.w, x15, s3);
    a = *(const LAS f32x4*)(Am + 2260);
    s0 = fmaf(a.x, x16, s0);
    s1 = fmaf(a.y, x17, s1);
    s2 = fmaf(a.z, x18, s2);
    s3 = fmaf(a.w, x19, s3);
    a = *(const LAS f32x4*)(Am + 2264);
    s0 = fmaf(a.x, x20, s0);
    s1 = fmaf(a.y, x21, s1);
    s2 = fmaf(a.z, x22, s2);
    s3 = fmaf(a.w, x23, s3);
    a = *(const LAS f32x4*)(Am + 2268);
    s0 = fmaf(a.x, x24, s0);
    s1 = fmaf(a.y, x25, s1);
    s2 = fmaf(a.z, x26, s2);
    s3 = fmaf(a.w, x27, s3);
    a = *(const LAS f32x4*)(Am + 2272);
    s0 = fmaf(a.x, x28, s0);
    s1 = fmaf(a.y, x29, s1);
    s2 = fmaf(a.z, x30, s2);
    s3 = fmaf(a.w, x31, s3);
    a = *(const LAS f32x4*)(Am + 2276);
    const float al33 = a.x;
    x33 = (x33 - ((s0 + s1) + (s2 + s3))) - al33 * x32;
    Tu[4488 + c] = f2bf(x33 * su); Tw[4488 + c] = f2bf(x33 * sw); asm volatile("" ::: "memory");
    float x34 = fmaxf(0.0f, 1.0f - fabsf(cf - 34.0f));
    s0 = 0.f; s1 = 0.f; s2 = 0.f; s3 = 0.f;
    a = *(const LAS f32x4*)(Am + 2312);
    s0 = fmaf(a.x, x0, s0);
    s1 = fmaf(a.y, x1, s1);
    s2 = fmaf(a.z, x2, s2);
    s3 = fmaf(a.w, x3, s3);
    a = *(const LAS f32x4*)(Am + 2316);
    s0 = fmaf(a.x, x4, s0);
    s1 = fmaf(a.y, x5, s1);
    s2 = fmaf(a.z, x6, s2);
    s3 = fmaf(a.w, x7, s3);
    a = *(const LAS f32x4*)(Am + 2320);
    s0 = fmaf(a.x, x8, s0);
    s1 = fmaf(a.y, x9, s1);
    s2 = fmaf(a.z, x10, s2);
    s3 = fmaf(a.w, x11, s3);
    a = *(const LAS f32x4*)(Am + 2324);
    s0 = fmaf(a.x, x12, s0);
    s1 = fmaf(a.y, x13, s1);
    s2 = fmaf(a.z, x14, s2);
    s3 = fmaf(a.w, x15, s3);
    a = *(const LAS f32x4*)(Am + 2328);
    s0 = fmaf(a.x, x16, s0);
    s1 = fmaf(a.y, x17, s1);
    s2 = fmaf(a.z, x18, s2);
    s3 = fmaf(a.w, x19, s3);
    a = *(const LAS f32x4*)(Am + 2332);
    s0 = fmaf(a.x, x20, s0);
    s1 = fmaf(a.y, x21, s1);
    s2 = fmaf(a.z, x22, s2);
    s3 = fmaf(a.w, x23, s3);
    a = *(const LAS f32x4*)(Am + 2336);
    s0 = fmaf(a.x, x24, s0);
    s1 = fmaf(a.y, x25, s1);
    s2 = fmaf(a.z, x26, s2);
    s3 = fmaf(a.w, x27, s3);
    a = *(const LAS f32x4*)(Am + 2340);
    s0 = fmaf(a.x, x28, s0);
    s1 = fmaf(a.y, x29, s1);
    s2 = fmaf(a.z, x30, s2);
    s3 = fmaf(a.w, x31, s3);
    a = *(const LAS f32x4*)(Am + 2344);
    s0 = fmaf(a.x, x32, s0);
    const float al34 = a.y;
    x34 = (x34 - ((s0 + s1) + (s2 + s3))) - al34 * x33;
    Tu[4624 + c] = f2bf(x34 * su); Tw[4624 + c] = f2bf(x34 * sw); asm volatile("" ::: "memory");
    float x35 = fmaxf(0.0f, 1.0f - fabsf(cf - 35.0f));
    s0 = 0.f; s1 = 0.f; s2 = 0.f; s3 = 0.f;
    a = *(const LAS f32x4*)(Am + 2380);
    s0 = fmaf(a.x, x0, s0);
    s1 = fmaf(a.y, x1, s1);
    s2 = fmaf(a.z, x2, s2);
    s3 = fmaf(a.w, x3, s3);
    a = *(const LAS f32x4*)(Am + 2384);
    s0 = fmaf(a.x, x4, s0);
    s1 = fmaf(a.y, x5, s1);
    s2 = fmaf(a.z, x6, s2);
    s3 = fmaf(a.w, x7, s3);
    a = *(const LAS f32x4*)(Am + 2388);
    s0 = fmaf(a.x, x8, s0);
    s1 = fmaf(a.y, x9, s1);
    s2 = fmaf(a.z, x10, s2);
    s3 = fmaf(a.w, x11, s3);
    a = *(const LAS f32x4*)(Am + 2392);
    s0 = fmaf(a.x, x12, s0);
    s1 = fmaf(a.y, x13, s1);
    s2 = fmaf(a.z, x14, s2);
    s3 = fmaf(a.w, x15, s3);
    a = *(const LAS f32x4*)(Am + 2396);
    s0 = fmaf(a.x, x16, s0);
    s1 = fmaf(a.y, x17, s1);
    s2 = fmaf(a.z, x18, s2);
    s3 = fmaf(a.w, x19, s3);
    a = *(const LAS f32x4*)(Am + 2400);
    s0 = fmaf(a.x, x20, s0);
    s1 = fmaf(a.y, x21, s1);
    s2 = fmaf(a.z, x22, s2);
    s3 = fmaf(a.w, x23, s3);
    a = *(const LAS f32x4*)(Am + 2404);
    s0 = fmaf(a.x, x24, s0);
    s1 = fmaf(a.y, x25, s1);
    s2 = fmaf(a.z, x26, s2);
    s3 = fmaf(a.w, x27, s3);
    a = *(const LAS f32x4*)(Am + 2408);
    s0 = fmaf(a.x, x28, s0);
    s1 = fmaf(a.y, x29, s1);
    s2 = fmaf(a.z, x30, s2);
    s3 = fmaf(a.w, x31, s3);
    a = *(const LAS f32x4*)(Am + 2412);
    s0 = fmaf(a.x, x32, s0);
    s1 = fmaf(a.y, x33, s1);
    const float al35 = a.z;
    x35 = (x35 - ((s0 + s1) + (s2 + s3))) - al35 * x34;
    Tu[4760 + c] = f2bf(x35 * su); Tw[4760 + c] = f2bf(x35 * sw); asm volatile("" ::: "memory");
    float x36 = fmaxf(0.0f, 1.0f - fabsf(cf - 36.0f));
    s0 = 0.f; s1 = 0.f; s2 = 0.f; s3 = 0.f;
    a = *(const LAS f32x4*)(Am + 2448);
    s0 = fmaf(a.x, x0, s0);
    s1 = fmaf(a.y, x1, s1);
    s2 = fmaf(a.z, x2, s2);
    s3 = fmaf(a.w, x3, s3);
    a = *(const LAS f32x4*)(Am + 2452);
    s0 = fmaf(a.x, x4, s0);
    s1 = fmaf(a.y, x5, s1);
    s2 = fmaf(a.z, x6, s2);
    s3 = fmaf(a.w, x7, s3);
    a = *(const LAS f32x4*)(Am + 2456);
    s0 = fmaf(a.x, x8, s0);
    s1 = fmaf(a.y, x9, s1);
    s2 = fmaf(a.z, x10, s2);
    s3 = fmaf(a.w, x11, s3);
    a = *(const LAS f32x4*)(Am + 2460);
    s0 = fmaf(a.x, x12, s0);
    s1 = fmaf(a.y, x13, s1);
    s2 = fmaf(a.z, x14, s2);
    s3 = fmaf(a.w, x15, s3);
    a = *(const LAS f32x4*)(Am + 2464);
    s0 = fmaf(a.x, x16, s0);
    s1 = fmaf(a.y, x17, s1);
    s2 = fmaf(a.z, x18, s2);
    s3 = fmaf(a.w, x19, s3);
    a = *(const LAS f32x4*)(Am + 2468);
    s0 = fmaf(a.x, x20, s0);
    s1 = fmaf(a.y, x21, s1);
    s2 = fmaf(a.z, x22, s2);
    s3 = fmaf(a.w, x23, s3);
    a = *(const LAS f32x4*)(Am + 2472);
    s0 = fmaf(a.x, x24, s0);
    s1 = fmaf(a.y, x25, s1);
    s2 = fmaf(a.z, x26, s2);
    s3 = fmaf(a.w, x27, s3);
    a = *(const LAS f32x4*)(Am + 2476);
    s0 = fmaf(a.x, x28, s0);
    s1 = fmaf(a.y, x29, s1);
    s2 = fmaf(a.z, x30, s2);
    s3 = fmaf(a.w, x31, s3);
    a = *(const LAS f32x4*)(Am + 2480);
    s0 = fmaf(a.x, x32, s0);
    s1 = fmaf(a.y, x33, s1);
    s2 = fmaf(a.z, x34, s2);
    const float al36 = a.w;
    x36 = (x36 - ((s0 + s1) + (s2 + s3))) - al36 * x35;
    Tu[4896 + c] = f2bf(x36 * su); Tw[4896 + c] = f2bf(x36 * sw); asm volatile("" ::: "memory");
    float x37 = fmaxf(0.0f, 1.0f - fabsf(cf - 37.0f));
    s0 = 0.f; s1 = 0.f; s2 = 0.f; s3 = 0.f;
    a = *(const LAS f32x4*)(Am + 2516);
    s0 = fmaf(a.x, x0, s0);
    s1 = fmaf(a.y, x1, s1);
    s2 = fmaf(a.z, x2, s2);
    s3 = fmaf(a.w, x3, s3);
    a = *(const LAS f32x4*)(Am + 2520);
    s0 = fmaf(a.x, x4, s0);
    s1 = fmaf(a.y, x5, s1);
    s2 = fmaf(a.z, x6, s2);
    s3 = fmaf(a.w, x7, s3);
    a = *(const LAS f32x4*)(Am + 2524);
    s0 = fmaf(a.x, x8, s0);
    s1 = fmaf(a.y, x9, s1);
    s2 = fmaf(a.z, x10, s2);
    s3 = fmaf(a.w, x11, s3);
    a = *(const LAS f32x4*)(Am + 2528);
    s0 = fmaf(a.x, x12, s0);
    s1 = fmaf(a.y, x13, s1);
    s2 = fmaf(a.z, x14, s2);
    s3 = fmaf(a.w, x15, s3);
    a = *(const LAS f32x4*)(Am + 2532);
    s0 = fmaf(a.x, x16, s0);
    s1 = fmaf(a.y, x17, s1);
    s2 = fmaf(a.z, x18, s2);
    s3 = fmaf(a.w, x19, s3);
    a = *(const LAS f32x4*)(Am + 2536);
    s0 = fmaf(a.x, x20, s0);
    s1 = fmaf(a.y, x21, s1);
    s2 = fmaf(a.z, x22, s2);
    s3 = fmaf(a.w, x23, s3);
    a = *(const LAS f32x4*)(Am + 2540);
    s0 = fmaf(a.x, x24, s0);
    s1 = fmaf(a.y, x25, s1);
    s2 = fmaf(a.z, x26, s2);
    s3 = fmaf(a.w, x27, s3);
    a = *(const LAS f32x4*)(Am + 2544);
    s0 = fmaf(a.x, x28, s0);
    s1 = fmaf(a.y, x29, s1);
    s2 = fmaf(a.z, x30, s2);
    s3 = fmaf(a.w, x31, s3);
    a = *(const LAS f32x4*)(Am + 2548);
    s0 = fmaf(a.x, x32, s0);
    s1 = fmaf(a.y, x33, s1);
    s2 = fmaf(a.z, x34, s2);
    s3 = fmaf(a.w, x35, s3);
    a = *(const LAS f32x4*)(Am + 2552);
    const float al37 = a.x;
    x37 = (x37 - ((s0 + s1) + (s2 + s3))) - al37 * x36;
    Tu[5032 + c] = f2bf(x37 * su); Tw[5032 + c] = f2bf(x37 * sw); asm volatile("" ::: "memory");
    float x38 = fmaxf(0.0f, 1.0f - fabsf(cf - 38.0f));
    s0 = 0.f; s1 = 0.f; s2 = 0.f; s3 = 0.f;
    a = *(const LAS f32x4*)(Am + 2584);
    s0 = fmaf(a.x, x0, s0);
    s1 = fmaf(a.y, x1, s1);
    s2 = fmaf(a.z, x2, s2);
    s3 = fmaf(a.w, x3, s3);
    a = *(const LAS f32x4*)(Am + 2588);
    s0 = fmaf(a.x, x4, s0);
    s1 = fmaf(a.y, x5, s1);
    s2 = fmaf(a.z, x6, s2);
    s3 = fmaf(a.w, x7, s3);
    a = *(const LAS f32x4*)(Am + 2592);
    s0 = fmaf(a.x, x8, s0);
    s1 = fmaf(a.y, x9, s1);
    s2 = fmaf(a.z, x10, s2);
    s3 = fmaf(a.w, x11, s3);
    a = *(const LAS f32x4*)(Am + 2596);
    s0 = fmaf(a.x, x12, s0);
    s1 = fmaf(a.y, x13, s1);
    s2 = fmaf(a.z, x14, s2);
    s3 = fmaf(a.w, x15, s3);
    a = *(const LAS f32x4*)(Am + 2600);
    s0 = fmaf(a.x, x16, s0);
    s1 = fmaf(a.y, x17, s1);
    s2 = fmaf(a.z, x18, s2);
    s3 = fmaf(a.w, x19, s3);
    a = *(const LAS f32x4*)(Am + 2604);
    s0 = fmaf(a.x, x20, s0);
    s1 = fmaf(a.y, x21, s1);
    s2 = fmaf(a.z, x22, s2);
    s3 = fmaf(a.w, x23, s3);
    a = *(const LAS f32x4*)(Am + 2608);
    s0 = fmaf(a.x, x24, s0);
    s1 = fmaf(a.y, x25, s1);
    s2 = fmaf(a.z, x26, s2);
    s3 = fmaf(a.w, x27, s3);
    a = *(const LAS f32x4*)(Am + 2612);
    s0 = fmaf(a.x, x28, s0);
    s1 = fmaf(a.y, x29, s1);
    s2 = fmaf(a.z, x30, s2);
    s3 = fmaf(a.w, x31, s3);
    a = *(const LAS f32x4*)(Am + 2616);
    s0 = fmaf(a.x, x32, s0);
    s1 = fmaf(a.y, x33, s1);
    s2 = fmaf(a.z, x34, s2);
    s3 = fmaf(a.w, x35, s3);
    a = *(const LAS f32x4*)(Am + 2620);
    s0 = fmaf(a.x, x36, s0);
    const float al38 = a.y;
    x38 = (x38 - ((s0 + s1) + (s2 + s3))) - al38 * x37;
    Tu[5168 + c] = f2bf(x38 * su); Tw[5168 + c] = f2bf(x38 * sw); asm volatile("" ::: "memory");
    float x39 = fmaxf(0.0f, 1.0f - fabsf(cf - 39.0f));
    s0 = 0.f; s1 = 0.f; s2 = 0.f; s3 = 0.f;
    a = *(const LAS f32x4*)(Am + 2652);
    s0 = fmaf(a.x, x0, s0);
    s1 = fmaf(a.y, x1, s1);
    s2 = fmaf(a.z, x2, s2);
    s3 = fmaf(a.w, x3, s3);
    a = *(const LAS f32x4*)(Am + 2656);
    s0 = fmaf(a.x, x4, s0);
    s1 = fmaf(a.y, x5, s1);
    s2 = fmaf(a.z, x6, s2);
    s3 = fmaf(a.w, x7, s3);
    a = *(const LAS f32x4*)(Am + 2660);
    s0 = fmaf(a.x, x8, s0);
    s1 = fmaf(a.y, x9, s1);
    s2 = fmaf(a.z, x10, s2);
    s3 = fmaf(a.w, x11, s3);
    a = *(const LAS f32x4*)(Am + 2664);
    s0 = fmaf(a.x, x12, s0);
    s1 = fmaf(a.y, x13, s1);
    s2 = fmaf(a.z, x14, s2);
    s3 = fmaf(a.w, x15, s3);
    a = *(const LAS f32x4*)(Am + 2668);
    s0 = fmaf(a.x, x16, s0);
    s1 = fmaf(a.y, x17, s1);
    s2 = fmaf(a.z, x18, s2);
    s3 = fmaf(a.w, x19, s3);
    a = *(const LAS f32x4*)(Am + 2672);
    s0 = fmaf(a.x, x20, s0);
    s1 = fmaf(a.y, x21, s1);
    s2 = fmaf(a.z, x22, s2);
    s3 = fmaf(a.w, x23, s3);
    a = *(const LAS f32x4*)(Am + 2676);
    s0 = fmaf(a.x, x24, s0);
    s1 = fmaf(a.y, x25, s1);
    s2 = fmaf(a.z, x26, s2);
    s3 = fmaf(a.w, x27, s3);
    a = *(const LAS f32x4*)(Am + 2680);
    s0 = fmaf(a.x, x28, s0);
    s1 = fmaf(a.y, x29, s1);
    s2 = fmaf(a.z, x30, s2);
    s3 = fmaf(a.w, x31, s3);
    a = *(const LAS f32x4*)(Am + 2684);
    s0 = fmaf(a.x, x32, s0);
    s1 = fmaf(a.y, x33, s1);
    s2 = fmaf(a.z, x34, s2);
    s3 = fmaf(a.w, x35, s3);
    a = *(const LAS f32x4*)(Am + 2688);
    s0 = fmaf(a.x, x36, s0);
    s1 = fmaf(a.y, x37, s1);
    const float al39 = a.z;
    x39 = (x39 - ((s0 + s1) + (s2 + s3))) - al39 * x38;
    Tu[5304 + c] = f2bf(x39 * su); Tw[5304 + c] = f2bf(x39 * sw); asm volatile("" ::: "memory");
    float x40 = fmaxf(0.0f, 1.0f - fabsf(cf - 40.0f));
    s0 = 0.f; s1 = 0.f; s2 = 0.f; s3 = 0.f;
    a = *(const LAS f32x4*)(Am + 2720);
    s0 = fmaf(a.x, x0, s0);
    s1 = fmaf(a.y, x1, s1);
    s2 = fmaf(a.z, x2, s2);
    s3 = fmaf(a.w, x3, s3);
    a = *(const LAS f32x4*)(Am + 2724);
    s0 = fmaf(a.x, x4, s0);
    s1 = fmaf(a.y, x5, s1);
    s2 = fmaf(a.z, x6, s2);
    s3 = fmaf(a.w, x7, s3);
    a = *(const LAS f32x4*)(Am + 2728);
    s0 = fmaf(a.x, x8, s0);
    s1 = fmaf(a.y, x9, s1);
    s2 = fmaf(a.z, x10, s2);
    s3 = fmaf(a.w, x11, s3);
    a = *(const LAS f32x4*)(Am + 2732);
    s0 = fmaf(a.x, x12, s0);
    s1 = fmaf(a.y, x13, s1);
    s2 = fmaf(a.z, x14, s2);
    s3 = fmaf(a.w, x15, s3);
    a = *(const LAS f32x4*)(Am + 2736);
    s0 = fmaf(a.x, x16, s0);
    s1 = fmaf(a.y, x17, s1);
    s2 = fmaf(a.z, x18, s2);
    s3 = fmaf(a.w, x19, s3);
    a = *(const LAS f32x4*)(Am + 2740);
    s0 = fmaf(a.x, x20, s0);
    s1 = fmaf(a.y, x21, s1);
    s2 = fmaf(a.z, x22, s2);
    s3 = fmaf(a.w, x23, s3);
    a = *(const LAS f32x4*)(Am + 2744);
    s0 = fmaf(a.x, x24, s0);
    s1 = fmaf(a.y, x25, s1);
    s2 = fmaf(a.z, x26, s2);
    s3 = fmaf(a.w, x27, s3);
    a = *(const LAS f32x4*)(Am + 2748);
    s0 = fmaf(a.x, x28, s0);
    s1 = fmaf(a.y, x29, s1);
    s2 = fmaf(a.z, x30, s2);
    s3 = fmaf(a.w, x31, s3);
    a = *(const LAS f32x4*)(Am + 2752);
    s0 = fmaf(a.x, x32, s0);
    s1 = fmaf(a.y, x33, s1);
    s2 = fmaf(a.z, x34, s2);
    s3 = fmaf(a.w, x35, s3);
    a = *(const LAS f32x4*)(Am + 2756);
    s0 = fmaf(a.x, x36, s0);
    s1 = fmaf(a.y, x37, s1);
    s2 = fmaf(a.z, x38, s2);
    const float al40 = a.w;
    x40 = (x40 - ((s0 + s1) + (s2 + s3))) - al40 * x39;
    Tu[5440 + c] = f2bf(x40 * su); Tw[5440 + c] = f2bf(x40 * sw); asm volatile("" ::: "memory");
    float x41 = fmaxf(0.0f, 1.0f - fabsf(cf - 41.0f));
    s0 = 0.f; s1 = 0.f; s2 = 0.f; s3 = 0.f;
    a = *(const LAS f32x4*)(Am + 2788);
    s0 = fmaf(a.x, x0, s0);
    s1 = fmaf(a.y, x1, s1);
    s2 = fmaf(a.z, x2, s2);
    s3 = fmaf(a.w, x3, s3);
    a = *(const LAS f32x4*)(Am + 2792);
    s0 = fmaf(a.x, x4, s0);
    s1 = fmaf(a.y, x5, s1);
    s2 = fmaf(a.z, x6, s2);
    s3 = fmaf(a.w, x7, s3);
    a = *(const LAS f32x4*)(Am + 2796);
    s0 = fmaf(a.x, x8, s0);
    s1 = fmaf(a.y, x9, s1);
    s2 = fmaf(a.z, x10, s2);
    s3 = fmaf(a.w, x11, s3);
    a = *(const LAS f32x4*)(Am + 2800);
    s0 = fmaf(a.x, x12, s0);
    s1 = fmaf(a.y, x13, s1);
    s2 = fmaf(a.z, x14, s2);
    s3 = fmaf(a.w, x15, s3);
    a = *(const LAS f32x4*)(Am + 2804);
    s0 = fmaf(a.x, x16, s0);
    s1 = fmaf(a.y, x17, s1);
    s2 = fmaf(a.z, x18, s2);
    s3 = fmaf(a.w, x19, s3);
    a = *(const LAS f32x4*)(Am + 2808);
    s0 = fmaf(a.x, x20, s0);
    s1 = fmaf(a.y, x21, s1);
    s2 = fmaf(a.z, x22, s2);
    s3 = fmaf(a.w, x23, s3);
    a = *(const LAS f32x4*)(Am + 2812);
    s0 = fmaf(a.x, x24, s0);
    s1 = fmaf(a.y, x25, s1);
    s2 = fmaf(a.z, x26, s2);
    s3 = fmaf(a.w, x27, s3);
    a = *(const LAS f32x4*)(Am + 2816);
    s0 = fmaf(a.x, x28, s0);
    s1 = fmaf(a.y, x29, s1);
    s2 = fmaf(a.z, x30, s2);
    s3 = fmaf(a.w, x31, s3);
    a = *(const LAS f32x4*)(Am + 2820);
    s0 = fmaf(a.x, x32, s0);
    s1 = fmaf(a.y, x33, s1);
    s2 = fmaf(a.z, x34, s2);
    s3 = fmaf(a.w, x35, s3);
    a = *(const LAS f32x4*)(Am + 2824);
    s0 = fmaf(a.x, x36, s0);
    s1 = fmaf(a.y, x37, s1);
    s2 = fmaf(a.z, x38, s2);
    s3 = fmaf(a.w, x39, s3);
    a = *(const LAS f32x4*)(Am + 2828);
    const float al41 = a.x;
    x41 = (x41 - ((s0 + s1) + (s2 + s3))) - al41 * x40;
    Tu[5576 + c] = f2bf(x41 * su); Tw[5576 + c] = f2bf(x41 * sw); asm volatile("" ::: "memory");
    float x42 = fmaxf(0.0f, 1.0f - fabsf(cf - 42.0f));
    s0 = 0.f; s1 = 0.f; s2 = 0.f; s3 = 0.f;
    a = *(const LAS f32x4*)(Am + 2856);
    s0 = fmaf(a.x, x0, s0);
    s1 = fmaf(a.y, x1, s1);
    s2 = fmaf(a.z, x2, s2);
    s3 = fmaf(a.w, x3, s3);
    a = *(const LAS f32x4*)(Am + 2860);
    s0 = fmaf(a.x, x4, s0);
    s1 = fmaf(a.y, x5, s1);
    s2 = fmaf(a.z, x6, s2);
    s3 = fmaf(a.w, x7, s3);
    a = *(const LAS f32x4*)(Am + 2864);
    s0 = fmaf(a.x, x8, s0);
    s1 = fmaf(a.y, x9, s1);
    s2 = fmaf(a.z, x10, s2);
    s3 = fmaf(a.w, x11, s3);
    a = *(const LAS f32x4*)(Am + 2868);
    s0 = fmaf(a.x, x12, s0);
    s1 = fmaf(a.y, x13, s1);
    s2 = fmaf(a.z, x14, s2);
    s3 = fmaf(a.w, x15, s3);
    a = *(const LAS f32x4*)(Am + 2872);
    s0 = fmaf(a.x, x16, s0);
    s1 = fmaf(a.y, x17, s1);
    s2 = fmaf(a.z, x18, s2);
    s3 = fmaf(a.w, x19, s3);
    a = *(const LAS f32x4*)(Am + 2876);
    s0 = fmaf(a.x, x20, s0);
    s1 = fmaf(a.y, x21, s1);
    s2 = fmaf(a.z, x22, s2);
    s3 = fmaf(a.w, x23, s3);
    a = *(const LAS f32x4*)(Am + 2880);
    s0 = fmaf(a.x, x24, s0);
    s1 = fmaf(a.y, x25, s1);
    s2 = fmaf(a.z, x26, s2);
    s3 = fmaf(a.w, x27, s3);
    a = *(const LAS f32x4*)(Am + 2884);
    s0 = fmaf(a.x, x28, s0);
    s1 = fmaf(a.y, x29, s1);
    s2 = fmaf(a.z, x30, s2);
    s3 = fmaf(a.w, x31, s3);
    a = *(const LAS f32x4*)(Am + 2888);
    s0 = fmaf(a.x, x32, s0);
    s1 = fmaf(a.y, x33, s1);
    s2 = fmaf(a.z, x34, s2);
    s3 = fmaf(a.w, x35, s3);
    a = *(const LAS f32x4*)(Am + 2892);
    s0 = fmaf(a.x, x36, s0);
    s1 = fmaf(a.y, x37, s1);
    s2 = fmaf(a.z, x38, s2);
    s3 = fmaf(a.w, x39, s3);
    a = *(const LAS f32x4*)(Am + 2896);
    s0 = fmaf(a.x, x40, s0);
    const float al42 = a.y;
    x42 = (x42 - ((s0 + s1) + (s2 + s3))) - al42 * x41;
    Tu[5712 + c] = f2bf(x42 * su); Tw[5712 + c] = f2bf(x42 * sw); asm volatile("" ::: "memory");
    float x43 = fmaxf(0.0f, 1.0f - fabsf(cf - 43.0f));
    s0 = 0.f; s1 = 0.f; s2 = 0.f; s3 = 0.f;
    a = *(const LAS f32x4*)(Am + 2924);
    s0 = fmaf(a.x, x0, s0);
    s1 = fmaf(a.y, x1, s1);
    s2 = fmaf(a.z, x2, s2);
    s3 = fmaf(a.w, x3, s3);
    a = *(const LAS f32x4*)(Am + 2928);
    s0 = fmaf(a.x, x4, s0);
    s1 = fmaf(a.y, x5, s1);
    s2 = fmaf(a.z, x6, s2);
    s3 = fmaf(a.w, x7, s3);
    a = *(const LAS f32x4*)(Am + 2932);
    s0 = fmaf(a.x, x8, s0);
    s1 = fmaf(a.y, x9, s1);
    s2 = fmaf(a.z, x10, s2);
    s3 = fmaf(a.w, x11, s3);
    a = *(const LAS f32x4*)(Am + 2936);
    s0 = fmaf(a.x, x12, s0);
    s1 = fmaf(a.y, x13, s1);
    s2 = fmaf(a.z, x14, s2);
    s3 = fmaf(a.w, x15, s3);
    a = *(const LAS f32x4*)(Am + 2940);
    s0 = fmaf(a.x, x16, s0);
    s1 = fmaf(a.y, x17, s1);
    s2 = fmaf(a.z, x18, s2);
    s3 = fmaf(a.w, x19, s3);
    a = *(const LAS f32x4*)(Am + 2944);
    s0 = fmaf(a.x, x20, s0);
    s1 = fmaf(a.y, x21, s1);
    s2 = fmaf(a.z, x22, s2);
    s3 = fmaf(a.w, x23, s3);
    a = *(const LAS f32x4*)(Am + 2948);
    s0 = fmaf(a.x, x24, s0);
    s1 = fmaf(a.y, x25, s1);
    s2 = fmaf(a.z, x26, s2);
    s3 = fmaf(a.w, x27, s3);
    a = *(const LAS f32x4*)(Am + 2952);
    s0 = fmaf(a.x, x28, s0);
    s1 = fmaf(a.y, x29, s1);
    s2 = fmaf(a.z, x30, s2);
    s3 = fmaf(a.w, x31, s3);
    a = *(const LAS f32x4*)(Am + 2956);
    s0 = fmaf(a.x, x32, s0);
    s1 = fmaf(a.y, x33, s1);
    s2 = fmaf(a.z, x34, s2);
    s3 = fmaf(a.w, x35, s3);
    a = *(const LAS f32x4*)(Am + 2960);
    s0 = fmaf(a.x, x36, s0);
    s1 = fmaf(a.y, x37, s1);
    s2 = fmaf(a.z, x38, s2);
    s3 = fmaf(a.w, x39, s3);
    a = *(const LAS f32x4*)(Am + 2964);
    s0 = fmaf(a.x, x40, s0);
    s1 = fmaf(a.y, x41, s1);
    const float al43 = a.z;
    x43 = (x43 - ((s0 + s1) + (s2 + s3))) - al43 * x42;
    Tu[5848 + c] = f2bf(x43 * su); Tw[5848 + c] = f2bf(x43 * sw); asm volatile("" ::: "memory");
    float x44 = fmaxf(0.0f, 1.0f - fabsf(cf - 44.0f));
    s0 = 0.f; s1 = 0.f; s2 = 0.f; s3 = 0.f;
    a = *(const LAS f32x4*)(Am + 2992);
    s0 = fmaf(a.x, x0, s0);
    s1 = fmaf(a.y, x1, s1);
    s2 = fmaf(a.z, x2, s2);
    s3 = fmaf(a.w, x3, s3);
    a = *(const LAS f32x4*)(Am + 2996);
    s0 = fmaf(a.x, x4, s0);
    s1 = fmaf(a.y, x5, s1);
    s2 = fmaf(a.z, x6, s2);
    s3 = fmaf(a.w, x7, s3);
    a = *(const LAS f32x4*)(Am + 3000);
    s0 = fmaf(a.x, x8, s0);
    s1 = fmaf(a.y, x9, s1);
    s2 = fmaf(a.z, x10, s2);
    s3 = fmaf(a.w, x11, s3);
    a = *(const LAS f32x4*)(Am + 3004);
    s0 = fmaf(a.x, x12, s0);
    s1 = fmaf(a.y, x13, s1);
    s2 = fmaf(a.z, x14, s2);
    s3 = fmaf(a.w, x15, s3);
    a = *(const LAS f32x4*)(Am + 3008);
    s0 = fmaf(a.x, x16, s0);
    s1 = fmaf(a.y, x17, s1);
    s2 = fmaf(a.z, x18, s2);
    s3 = fmaf(a.w, x19, s3);
    a = *(const LAS f32x4*)(Am + 3012);
    s0 = fmaf(a.x, x20, s0);
    s1 = fmaf(a.y, x21, s1);
    s2 = fmaf(a.z, x22, s2);
    s3 = fmaf(a.w, x23, s3);
    a = *(const LAS f32x4*)(Am + 3016);
    s0 = fmaf(a.x, x24, s0);
    s1 = fmaf(a.y, x25, s1);
    s2 = fmaf(a.z, x26, s2);
    s3 = fmaf(a.w, x27, s3);
    a = *(const LAS f32x4*)(Am + 3020);
    s0 = fmaf(a.x, x28, s0);
    s1 = fmaf(a.y, x29, s1);
    s2 = fmaf(a.z, x30, s2);
    s3 = fmaf(a.w, x31, s3);
    a = *(const LAS f32x4*)(Am + 3024);
    s0 = fmaf(a.x, x32, s0);
    s1 = fmaf(a.y, x33, s1);
    s2 = fmaf(a.z, x34, s2);
    s3 = fmaf(a.w, x35, s3);
    a = *(const LAS f32x4*)(Am + 3028);
    s0 = fmaf(a.x, x36, s0);
    s1 = fmaf(a.y, x37, s1);
    s2 = fmaf(a.z, x38, s2);
    s3 = fmaf(a.w, x39, s3);
    a = *(const LAS f32x4*)(Am + 3032);
    s0 = fmaf(a.x, x40, s0);
    s1 = fmaf(a.y, x41, s1);
    s2 = fmaf(a.z, x42, s2);
    const float al44 = a.w;
    x44 = (x44 - ((s0 + s1) + (s2 + s3))) - al44 * x43;
    Tu[5984 + c] = f2bf(x44 * su); Tw[5984 + c] = f2bf(x44 * sw); asm volatile("" ::: "memory");
    float x45 = fmaxf(0.0f, 1.0f - fabsf(cf - 45.0f));
    s0 = 0.f; s1 = 0.f; s2 = 0.f; s3 = 0.f;
    a = *(const LAS f32x4*)(Am + 3060);
    s0 = fmaf(a.x, x0, s0);
    s1 = fmaf(a.y, x1, s1);
    s2 = fmaf(a.z, x2, s2);
    s3 = fmaf(a.w, x3, s3);
    a = *(const LAS f32x4*)(Am + 3064);
    s0 = fmaf(a.x, x4, s0);
    s1 = fmaf(a.y, x5, s1);
    s2 = fmaf(a.z, x6, s2);
    s3 = fmaf(a.w, x7, s3);
    a = *(const LAS f32x4*)(Am + 3068);
    s0 = fmaf(a.x, x8, s0);
    s1 = fmaf(a.y, x9, s1);
    s2 = fmaf(a.z, x10, s2);
    s3 = fmaf(a.w, x11, s3);
    a = *(const LAS f32x4*)(Am + 3072);
    s0 = fmaf(a.x, x12, s0);
    s1 = fmaf(a.y, x13, s1);
    s2 = fmaf(a.z, x14, s2);
    s3 = fmaf(a.w, x15, s3);
    a = *(const LAS f32x4*)(Am + 3076);
    s0 = fmaf(a.x, x16, s0);
    s1 = fmaf(a.y, x17, s1);
    s2 = fmaf(a.z, x18, s2);
    s3 = fmaf(a.w, x19, s3);
    a = *(const LAS f32x4*)(Am + 3080);
    s0 = fmaf(a.x, x20, s0);
    s1 = fmaf(a.y, x21, s1);
    s2 = fmaf(a.z, x22, s2);
    s3 = fmaf(a.w, x23, s3);
    a = *(const LAS f32x4*)(Am + 3084);
    s0 = fmaf(a.x, x24, s0);
    s1 = fmaf(a.y, x25, s1);
    s2 = fmaf(a.z, x26, s2);
    s3 = fmaf(a.w, x27, s3);
    a = *(const LAS f32x4*)(Am + 3088);
    s0 = fmaf(a.x, x28, s0);
    s1 = fmaf(a.y, x29, s1);
    s2 = fmaf(a.z, x30, s2);
    s3 = fmaf(a.w, x31, s3);
    a = *(const LAS f32x4*)(Am + 3092);
    s0 = fmaf(a.x, x32, s0);
    s1 = fmaf(a.y, x33, s1);
    s2 = fmaf(a.z, x34, s2);
    s3 = fmaf(a.w, x35, s3);
    a = *(const LAS f32x4*)(Am + 3096);
    s0 = fmaf(a.x, x36, s0);
    s1 = fmaf(a.y, x37, s1);
    s2 = fmaf(a.z, x38, s2);
    s3 = fmaf(a.w, x39, s3);
    a = *(const LAS f32x4*)(Am + 3100);
    s0 = fmaf(a.x, x40, s0);
    s1 = fmaf(a.y, x41, s1);
    s2 = fmaf(a.z, x42, s2);
    s3 = fmaf(a.w, x43, s3);
    a = *(const LAS f32x4*)(Am + 3104);
    const float al45 = a.x;
    x45 = (x45 - ((s0 + s1) + (s2 + s3))) - al45 * x44;
    Tu[6120 + c] = f2bf(x45 * su); Tw[6120 + c] = f2bf(x45 * sw); asm volatile("" ::: "memory");
    float x46 = fmaxf(0.0f, 1.0f - fabsf(cf - 46.0f));
    s0 = 0.f; s1 = 0.f; s2 = 0.f; s3 = 0.f;
    a = *(const LAS f32x4*)(Am + 3128);
    s0 = fmaf(a.x, x0, s0);
    s1 = fmaf(a.y, x1, s1);
    s2 = fmaf(a.z, x2, s2);
    s3 = fmaf(a.w, x3, s3);
    a = *(const LAS f32x4*)(Am + 3132);
    s0 = fmaf(a.x, x4, s0);
    s1 = fmaf(a.y, x5, s1);
    s2 = fmaf(a.z, x6, s2);
    s3 = fmaf(a.w, x7, s3);
    a = *(const LAS f32x4*)(Am + 3136);
    s0 = fmaf(a.x, x8, s0);
    s1 = fmaf(a.y, x9, s1);
    s2 = fmaf(a.z, x10, s2);
    s3 = fmaf(a.w, x11, s3);
    a = *(const LAS f32x4*)(Am + 3140);
    s0 = fmaf(a.x, x12, s0);
    s1 = fmaf(a.y, x13, s1);
    s2 = fmaf(a.z, x14, s2);
    s3 = fmaf(a.w, x15, s3);
    a = *(const LAS f32x4*)(Am + 3144);
    s0 = fmaf(a.x, x16, s0);
    s1 = fmaf(a.y, x17, s1);
    s2 = fmaf(a.z, x18, s2);
    s3 = fmaf(a.w, x19, s3);
    a = *(const LAS f32x4*)(Am + 3148);
    s0 = fmaf(a.x, x20, s0);
    s1 = fmaf(a.y, x21, s1);
    s2 = fmaf(a.z, x22, s2);
    s3 = fmaf(a.w, x23, s3);
    a = *(const LAS f32x4*)(Am + 3152);
    s0 = fmaf(a.x, x24, s0);
    s1 = fmaf(a.y, x25, s1);
    s2 = fmaf(a.z, x26, s2);
    s3 = fmaf(a.w, x27, s3);
    a = *(const LAS f32x4*)(Am + 3156);
    s0 = fmaf(a.x, x28, s0);
    s1 = fmaf(a.y, x29, s1);
    s2 = fmaf(a.z, x30, s2);
    s3 = fmaf(a.w, x31, s3);
    a = *(const LAS f32x4*)(Am + 3160);
    s0 = fmaf(a.x, x32, s0);
    s1 = fmaf(a.y, x33, s1);
    s2 = fmaf(a.z, x34, s2);
    s3 = fmaf(a.w, x35, s3);
    a = *(const LAS f32x4*)(Am + 3164);
    s0 = fmaf(a.x, x36, s0);
    s1 = fmaf(a.y, x37, s1);
    s2 = fmaf(a.z, x38, s2);
    s3 = fmaf(a.w, x39, s3);
    a = *(const LAS f32x4*)(Am + 3168);
    s0 = fmaf(a.x, x40, s0);
    s1 = fmaf(a.y, x41, s1);
    s2 = fmaf(a.z, x42, s2);
    s3 = fmaf(a.w, x43, s3);
    a = *(const LAS f32x4*)(Am + 3172);
    s0 = fmaf(a.x, x44, s0);
    const float al46 = a.y;
    x46 = (x46 - ((s0 + s1) + (s2 + s3))) - al46 * x45;
    Tu[6256 + c] = f2bf(x46 * su); Tw[6256 + c] = f2bf(x46 * sw); asm volatile("" ::: "memory");
    float x47 = fmaxf(0.0f, 1.0f - fabsf(cf - 47.0f));
    s0 = 0.f; s1 = 0.f; s2 = 0.f; s3 = 0.f;
    a = *(const LAS f32x4*)(Am + 3196);
    s0 = fmaf(a.x, x0, s0);
    s1 = fmaf(a.y, x1, s1);
    s2 = fmaf(a.z, x2, s2);
    s3 = fmaf(a.w, x3, s3);
    a = *(const LAS f32x4*)(Am + 3200);
    s0 = fmaf(a.x, x4, s0);
    s1 = fmaf(a.y, x5, s1);
    s2 = fmaf(a.z, x6, s2);
    s3 = fmaf(a.w, x7, s3);
    a = *(const LAS f32x4*)(Am + 3204);
    s0 = fmaf(a.x, x8, s0);
    s1 = fmaf(a.y, x9, s1);
    s2 = fmaf(a.z, x10, s2);
    s3 = fmaf(a.w, x11, s3);
    a = *(const LAS f32x4*)(Am + 3208);
    s0 = fmaf(a.x, x12, s0);
    s1 = fmaf(a.y, x13, s1);
    s2 = fmaf(a.z, x14, s2);
    s3 = fmaf(a.w, x15, s3);
    a = *(const LAS f32x4*)(Am + 3212);
    s0 = fmaf(a.x, x16, s0);
    s1 = fmaf(a.y, x17, s1);
    s2 = fmaf(a.z, x18, s2);
    s3 = fmaf(a.w, x19, s3);
    a = *(const LAS f32x4*)(Am + 3216);
    s0 = fmaf(a.x, x20, s0);
    s1 = fmaf(a.y, x21, s1);
    s2 = fmaf(a.z, x22, s2);
    s3 = fmaf(a.w, x23, s3);
    a = *(const LAS f32x4*)(Am + 3220);
    s0 = fmaf(a.x, x24, s0);
    s1 = fmaf(a.y, x25, s1);
    s2 = fmaf(a.z, x26, s2);
    s3 = fmaf(a.w, x27, s3);
    a = *(const LAS f32x4*)(Am + 3224);
    s0 = fmaf(a.x, x28, s0);
    s1 = fmaf(a.y, x29, s1);
    s2 = fmaf(a.z, x30, s2);
    s3 = fmaf(a.w, x31, s3);
    a = *(const LAS f32x4*)(Am + 3228);
    s0 = fmaf(a.x, x32, s0);
    s1 = fmaf(a.y, x33, s1);
    s2 = fmaf(a.z, x34, s2);
    s3 = fmaf(a.w, x35, s3);
    a = *(const LAS f32x4*)(Am + 3232);
    s0 = fmaf(a.x, x36, s0);
    s1 = fmaf(a.y, x37, s1);
    s2 = fmaf(a.z, x38, s2);
    s3 = fmaf(a.w, x39, s3);
    a = *(const LAS f32x4*)(Am + 3236);
    s0 = fmaf(a.x, x40, s0);
    s1 = fmaf(a.y, x41, s1);
    s2 = fmaf(a.z, x42, s2);
    s3 = fmaf(a.w, x43, s3);
    a = *(const LAS f32x4*)(Am + 3240);
    s0 = fmaf(a.x, x44, s0);
    s1 = fmaf(a.y, x45, s1);
    const float al47 = a.z;
    x47 = (x47 - ((s0 + s1) + (s2 + s3))) - al47 * x46;
    Tu[6392 + c] = f2bf(x47 * su); Tw[6392 + c] = f2bf(x47 * sw); asm volatile("" ::: "memory");
    float x48 = fmaxf(0.0f, 1.0f - fabsf(cf - 48.0f));
    s0 = 0.f; s1 = 0.f; s2 = 0.f; s3 = 0.f;
    a = *(const LAS f32x4*)(Am + 3264);
    s0 = fmaf(a.x, x0, s0);
    s1 = fmaf(a.y, x1, s1);
    s2 = fmaf(a.z, x2, s2);
    s3 = fmaf(a.w, x3, s3);
    a = *(const LAS f32x4*)(Am + 3268);
    s0 = fmaf(a.x, x4, s0);
    s1 = fmaf(a.y, x5, s1);
    s2 = fmaf(a.z, x6, s2);
    s3 = fmaf(a.w, x7, s3);
    a = *(const LAS f32x4*)(Am + 3272);
    s0 = fmaf(a.x, x8, s0);
    s1 = fmaf(a.y, x9, s1);
    s2 = fmaf(a.z, x10, s2);
    s3 = fmaf(a.w, x11, s3);
    a = *(const LAS f32x4*)(Am + 3276);
    s0 = fmaf(a.x, x12, s0);
    s1 = fmaf(a.y, x13, s1);
    s2 = fmaf(a.z, x14, s2);
    s3 = fmaf(a.w, x15, s3);
    a = *(const LAS f32x4*)(Am + 3280);
    s0 = fmaf(a.x, x16, s0);
    s1 = fmaf(a.y, x17, s1);
    s2 = fmaf(a.z, x18, s2);
    s3 = fmaf(a.w, x19, s3);
    a = *(const LAS f32x4*)(Am + 3284);
    s0 = fmaf(a.x, x20, s0);
    s1 = fmaf(a.y, x21, s1);
    s2 = fmaf(a.z, x22, s2);
    s3 = fmaf(a.w, x23, s3);
    a = *(const LAS f32x4*)(Am + 3288);
    s0 = fmaf(a.x, x24, s0);
    s1 = fmaf(a.y, x25, s1);
    s2 = fmaf(a.z, x26, s2);
    s3 = fmaf(a.w, x27, s3);
    a = *(const LAS f32x4*)(Am + 3292);
    s0 = fmaf(a.x, x28, s0);
    s1 = fmaf(a.y, x29, s1);
    s2 = fmaf(a.z, x30, s2);
    s3 = fmaf(a.w, x31, s3);
    a = *(const LAS f32x4*)(Am + 3296);
    s0 = fmaf(a.x, x32, s0);
    s1 = fmaf(a.y, x33, s1);
    s2 = fmaf(a.z, x34, s2);
    s3 = fmaf(a.w, x35, s3);
    a = *(const LAS f32x4*)(Am + 3300);
    s0 = fmaf(a.x, x36, s0);
    s1 = fmaf(a.y, x37, s1);
    s2 = fmaf(a.z, x38, s2);
    s3 = fmaf(a.w, x39, s3);
    a = *(const LAS f32x4*)(Am + 3304);
    s0 = fmaf(a.x, x40, s0);
    s1 = fmaf(a.y, x41, s1);
    s2 = fmaf(a.z, x42, s2);
    s3 = fmaf(a.w, x43, s3);
    a = *(const LAS f32x4*)(Am + 3308);
    s0 = fmaf(a.x, x44, s0);
    s1 = fmaf(a.y, x45, s1);
    s2 = fmaf(a.z, x46, s2);
    const float al48 = a.w;
    x48 = (x48 - ((s0 + s1) + (s2 + s3))) - al48 * x47;
    Tu[6528 + c] = f2bf(x48 * su); Tw[6528 + c] = f2bf(x48 * sw); asm volatile("" ::: "memory");
    float x49 = fmaxf(0.0f, 1.0f - fabsf(cf - 49.0f));
    s0 = 0.f; s1 = 0.f; s2 = 0.f; s3 = 0.f;
    a = *(const LAS f32x4*)(Am + 3332);
    s0 = fmaf(a.x, x0, s0);
    s1 = fmaf(a.y, x1, s1);
    s2 = fmaf(a.z, x2, s2);
    s3 = fmaf(a.w, x3, s3);
    a = *(const LAS f32x4*)(Am + 3336);
    s0 = fmaf(a.x, x4, s0);
    s1 = fmaf(a.y, x5, s1);
    s2 = fmaf(a.z, x6, s2);
    s3 = fmaf(a.w, x7, s3);
    a = *(const LAS f32x4*)(Am + 3340);
    s0 = fmaf(a.x, x8, s0);
    s1 = fmaf(a.y, x9, s1);
    s2 = fmaf(a.z, x10, s2);
    s3 = fmaf(a.w, x11, s3);
    a = *(const LAS f32x4*)(Am + 3344);
    s0 = fmaf(a.x, x12, s0);
    s1 = fmaf(a.y, x13, s1);
    s2 = fmaf(a.z, x14, s2);
    s3 = fmaf(a.w, x15, s3);
    a = *(const LAS f32x4*)(Am + 3348);
    s0 = fmaf(a.x, x16, s0);
    s1 = fmaf(a.y, x17, s1);
    s2 = fmaf(a.z, x18, s2);
    s3 = fmaf(a.w, x19, s3);
    a = *(const LAS f32x4*)(Am + 3352);
    s0 = fmaf(a.x, x20, s0);
    s1 = fmaf(a.y, x21, s1);
    s2 = fmaf(a.z, x22, s2);
    s3 = fmaf(a.w, x23, s3);
    a = *(const LAS f32x4*)(Am + 3356);
    s0 = fmaf(a.x, x24, s0);
    s1 = fmaf(a.y, x25, s1);
    s2 = fmaf(a.z, x26, s2);
    s3 = fmaf(a.w, x27, s3);
    a = *(const LAS f32x4*)(Am + 3360);
    s0 = fmaf(a.x, x28, s0);
    s1 = fmaf(a.y, x29, s1);
    s2 = fmaf(a.z, x30, s2);
    s3 = fmaf(a.w, x31, s3);
    a = *(const LAS f32x4*)(Am + 3364);
    s0 = fmaf(a.x, x32, s0);
    s1 = fmaf(a.y, x33, s1);
    s2 = fmaf(a.z, x34, s2);
    s3 = fmaf(a.w, x35, s3);
    a = *(const LAS f32x4*)(Am + 3368);
    s0 = fmaf(a.x, x36, s0);
    s1 = fmaf(a.y, x37, s1);
    s2 = fmaf(a.z, x38, s2);
    s3 = fmaf(a.w, x39, s3);
    a = *(const LAS f32x4*)(Am + 3372);
    s0 = fmaf(a.x, x40, s0);
    s1 = fmaf(a.y, x41, s1);
    s2 = fmaf(a.z, x42, s2);
    s3 = fmaf(a.w, x43, s3);
    a = *(const LAS f32x4*)(Am + 3376);
    s0 = fmaf(a.x, x44, s0);
    s1 = fmaf(a.y, x45, s1);
    s2 = fmaf(a.z, x46, s2);
    s3 = fmaf(a.w, x47, s3);
    a = *(const LAS f32x4*)(Am + 3380);
    const float al49 = a.x;
    x49 = (x49 - ((s0 + s1) + (s2 + s3))) - al49 * x48;
    Tu[6664 + c] = f2bf(x49 * su); Tw[6664 + c] = f2bf(x49 * sw); asm volatile("" ::: "memory");
    float x50 = fmaxf(0.0f, 1.0f - fabsf(cf - 50.0f));
    s0 = 0.f; s1 = 0.f; s2 = 0.f; s3 = 0.f;
    a = *(const LAS f32x4*)(Am + 3400);
    s0 = fmaf(a.x, x0, s0);
    s1 = fmaf(a.y, x1, s1);
    s2 = fmaf(a.z, x2, s2);
    s3 = fmaf(a.w, x3, s3);
    a = *(const LAS f32x4*)(Am + 3404);
    s0 = fmaf(a.x, x4, s0);
    s1 = fmaf(a.y, x5, s1);
    s2 = fmaf(a.z, x6, s2);
    s3 = fmaf(a.w, x7, s3);
    a = *(const LAS f32x4*)(Am + 3408);
    s0 = fmaf(a.x, x8, s0);
    s1 = fmaf(a.y, x9, s1);
    s2 = fmaf(a.z, x10, s2);
    s3 = fmaf(a.w, x11, s3);
    a = *(const LAS f32x4*)(Am + 3412);
    s0 = fmaf(a.x, x12, s0);
    s1 = fmaf(a.y, x13, s1);
    s2 = fmaf(a.z, x14, s2);
    s3 = fmaf(a.w, x15, s3);
    a = *(const LAS f32x4*)(Am + 3416);
    s0 = fmaf(a.x, x16, s0);
    s1 = fmaf(a.y, x17, s1);
    s2 = fmaf(a.z, x18, s2);
    s3 = fmaf(a.w, x19, s3);
    a = *(const LAS f32x4*)(Am + 3420);
    s0 = fmaf(a.x, x20, s0);
    s1 = fmaf(a.y, x21, s1);
    s2 = fmaf(a.z, x22, s2);
    s3 = fmaf(a.w, x23, s3);
    a = *(const LAS f32x4*)(Am + 3424);
    s0 = fmaf(a.x, x24, s0);
    s1 = fmaf(a.y, x25, s1);
    s2 = fmaf(a.z, x26, s2);
    s3 = fmaf(a.w, x27, s3);
    a = *(const LAS f32x4*)(Am + 3428);
    s0 = fmaf(a.x, x28, s0);
    s1 = fmaf(a.y, x29, s1);
    s2 = fmaf(a.z, x30, s2);
    s3 = fmaf(a.w, x31, s3);
    a = *(const LAS f32x4*)(Am + 3432);
    s0 = fmaf(a.x, x32, s0);
    s1 = fmaf(a.y, x33, s1);
    s2 = fmaf(a.z, x34, s2);
    s3 = fmaf(a.w, x35, s3);
    a = *(const LAS f32x4*)(Am + 3436);
    s0 = fmaf(a.x, x36, s0);
    s1 = fmaf(a.y, x37, s1);
    s2 = fmaf(a.z, x38, s2);
    s3 = fmaf(a.w, x39, s3);
    a = *(const LAS f32x4*)(Am + 3440);
    s0 = fmaf(a.x, x40, s0);
    s1 = fmaf(a.y, x41, s1);
    s2 = fmaf(a.z, x42, s2);
    s3 = fmaf(a.w, x43, s3);
    a = *(const LAS f32x4*)(Am + 3444);
    s0 = fmaf(a.x, x44, s0);
    s1 = fmaf(a.y, x45, s1);
    s2 = fmaf(a.z, x46, s2);
    s3 = fmaf(a.w, x47, s3);
    a = *(const LAS f32x4*)(Am + 3448);
    s0 = fmaf(a.x, x48, s0);
    const float al50 = a.y;
    x50 = (x50 - ((s0 + s1) + (s2 + s3))) - al50 * x49;
    Tu[6800 + c] = f2bf(x50 * su); Tw[6800 + c] = f2bf(x50 * sw); asm volatile("" ::: "memory");
    float x51 = fmaxf(0.0f, 1.0f - fabsf(cf - 51.0f));
    s0 = 0.f; s1 = 0.f; s2 = 0.f; s3 = 0.f;
    a = *(const LAS f32x4*)(Am + 3468);
    s0 = fmaf(a.x, x0, s0);
    s1 = fmaf(a.y, x1, s1);
    s2 = fmaf(a.z, x2, s2);
    s3 = fmaf(a.w, x3, s3);
    a = *(const LAS f32x4*)(Am + 3472);
    s0 = fmaf(a.x, x4, s0);
    s1 = fmaf(a.y, x5, s1);
    s2 = fmaf(a.z, x6, s2);
    s3 = fmaf(a.w, x7, s3);
    a = *(const LAS f32x4*)(Am + 3476);
    s0 = fmaf(a.x, x8, s0);
    s1 = fmaf(a.y, x9, s1);
    s2 = fmaf(a.z, x10, s2);
    s3 = fmaf(a.w, x11, s3);
    a = *(const LAS f32x4*)(Am + 3480);
    s0 = fmaf(a.x, x12, s0);
    s1 = fmaf(a.y, x13, s1);
    s2 = fmaf(a.z, x14, s2);
    s3 = fmaf(a.w, x15, s3);
    a = *(const LAS f32x4*)(Am + 3484);
    s0 = fmaf(a.x, x16, s0);
    s1 = fmaf(a.y, x17, s1);
    s2 = fmaf(a.z, x18, s2);
    s3 = fmaf(a.w, x19, s3);
    a = *(const LAS f32x4*)(Am + 3488);
    s0 = fmaf(a.x, x20, s0);
    s1 = fmaf(a.y, x21, s1);
    s2 = fmaf(a.z, x22, s2);
    s3 = fmaf(a.w, x23, s3);
    a = *(const LAS f32x4*)(Am + 3492);
    s0 = fmaf(a.x, x24, s0);
    s1 = fmaf(a.y, x25, s1);
    s2 = fmaf(a.z, x26, s2);
    s3 = fmaf(a.w, x27, s3);
    a = *(const LAS f32x4*)(Am + 3496);
    s0 = fmaf(a.x, x28, s0);
    s1 = fmaf(a.y, x29, s1);
    s2 = fmaf(a.z, x30, s2);
    s3 = fmaf(a.w, x31, s3);
    a = *(const LAS f32x4*)(Am + 3500);
    s0 = fmaf(a.x, x32, s0);
    s1 = fmaf(a.y, x33, s1);
    s2 = fmaf(a.z, x34, s2);
    s3 = fmaf(a.w, x35, s3);
    a = *(const LAS f32x4*)(Am + 3504);
    s0 = fmaf(a.x, x36, s0);
    s1 = fmaf(a.y, x37, s1);
    s2 = fmaf(a.z, x38, s2);
    s3 = fmaf(a.w, x39, s3);
    a = *(const LAS f32x4*)(Am + 3508);
    s0 = fmaf(a.x, x40, s0);
    s1 = fmaf(a.y, x41, s1);
    s2 = fmaf(a.z, x42, s2);
    s3 = fmaf(a.w, x43, s3);
    a = *(const LAS f32x4*)(Am + 3512);
    s0 = fmaf(a.x, x44, s0);
    s1 = fmaf(a.y, x45, s1);
    s2 = fmaf(a.z, x46, s2);
    s3 = fmaf(a.w, x47, s3);
    a = *(const LAS f32x4*)(Am + 3516);
    s0 = fmaf(a.x, x48, s0);
    s1 = fmaf(a.y, x49, s1);
    const float al51 = a.z;
    x51 = (x51 - ((s0 + s1) + (s2 + s3))) - al51 * x50;
    Tu[6936 + c] = f2bf(x51 * su); Tw[6936 + c] = f2bf(x51 * sw); asm volatile("" ::: "memory");
    float x52 = fmaxf(0.0f, 1.0f - fabsf(cf - 52.0f));
    s0 = 0.f; s1 = 0.f; s2 = 0.f; s3 = 0.f;
    a = *(const LAS f32x4*)(Am + 3536);
    s0 = fmaf(a.x, x0, s0);
    s1 = fmaf(a.y, x1, s1);
    s2 = fmaf(a.z, x2, s2);
    s3 = fmaf(a.w, x3, s3);
    a = *(const LAS f32x4*)(Am + 3540);
    s0 = fmaf(a.x, x4, s0);
    s1 = fmaf(a.y, x5, s1);
    s2 = fmaf(a.z, x6, s2);
    s3 = fmaf(a.w, x7, s3);
    a = *(const LAS f32x4*)(Am + 3544);
    s0 = fmaf(a.x, x8, s0);
    s1 = fmaf(a.y, x9, s1);
    s2 = fmaf(a.z, x10, s2);
    s3 = fmaf(a.w, x11, s3);
    a = *(const LAS f32x4*)(Am + 3548);
    s0 = fmaf(a.x, x12, s0);
    s1 = fmaf(a.y, x13, s1);
    s2 = fmaf(a.z, x14, s2);
    s3 = fmaf(a.w, x15, s3);
    a = *(const LAS f32x4*)(Am + 3552);
    s0 = fmaf(a.x, x16, s0);
    s1 = fmaf(a.y, x17, s1);
    s2 = fmaf(a.z, x18, s2);
    s3 = fmaf(a.w, x19, s3);
    a = *(const LAS f32x4*)(Am + 3556);
    s0 = fmaf(a.x, x20, s0);
    s1 = fmaf(a.y, x21, s1);
    s2 = fmaf(a.z, x22, s2);
    s3 = fmaf(a.w, x23, s3);
    a = *(const LAS f32x4*)(Am + 3560);
    s0 = fmaf(a.x, x24, s0);
    s1 = fmaf(a.y, x25, s1);
    s2 = fmaf(a.z, x26, s2);
    s3 = fmaf(a.w, x27, s3);
    a = *(const LAS f32x4*)(Am + 3564);
    s0 = fmaf(a.x, x28, s0);
    s1 = fmaf(a.y, x29, s1);
    s2 = fmaf(a.z, x30, s2);
    s3 = fmaf(a.w, x31, s3);
    a = *(const LAS f32x4*)(Am + 3568);
    s0 = fmaf(a.x, x32, s0);
    s1 = fmaf(a.y, x33, s1);
    s2 = fmaf(a.z, x34, s2);
    s3 = fmaf(a.w, x35, s3);
    a = *(const LAS f32x4*)(Am + 3572);
    s0 = fmaf(a.x, x36, s0);
    s1 = fmaf(a.y, x37, s1);
    s2 = fmaf(a.z, x38, s2);
    s3 = fmaf(a.w, x39, s3);
    a = *(const LAS f32x4*)(Am + 3576);
    s0 = fmaf(a.x, x40, s0);
    s1 = fmaf(a.y, x41, s1);
    s2 = fmaf(a.z, x42, s2);
    s3 = fmaf(a.w, x43, s3);
    a = *(const LAS f32x4*)(Am + 3580);
    s0 = fmaf(a.x, x44, s0);
    s1 = fmaf(a.y, x45, s1);
    s2 = fmaf(a.z, x46, s2);
    s3 = fmaf(a.w, x47, s3);
    a = *(const LAS f32x4*)(Am + 3584);
    s0 = fmaf(a.x, x48, s0);
    s1 = fmaf(a.y, x49, s1);
    s2 = fmaf(a.z, x50, s2);
    const float al52 = a.w;
    x52 = (x52 - ((s0 + s1) + (s2 + s3))) - al52 * x51;
    Tu[7072 + c] = f2bf(x52 * su); Tw[7072 + c] = f2bf(x52 * sw); asm volatile("" ::: "memory");
    float x53 = fmaxf(0.0f, 1.0f - fabsf(cf - 53.0f));
    s0 = 0.f; s1 = 0.f; s2 = 0.f; s3 = 0.f;
    a = *(const LAS f32x4*)(Am + 3604);
    s0 = fmaf(a.x, x0, s0);
    s1 = fmaf(a.y, x1, s1);
    s2 = fmaf(a.z, x2, s2);
    s3 = fmaf(a.w, x3, s3);
    a = *(const LAS f32x4*)(Am + 3608);
    s0 = fmaf(a.x, x4, s0);
    s1 = fmaf(a.y, x5, s1);
    s2 = fmaf(a.z, x6, s2);
    s3 = fmaf(a.w, x7, s3);
    a = *(const LAS f32x4*)(Am + 3612);
    s0 = fmaf(a.x, x8, s0);
    s1 = fmaf(a.y, x9, s1);
    s2 = fmaf(a.z, x10, s2);
    s3 = fmaf(a.w, x11, s3);
    a = *(const LAS f32x4*)(Am + 3616);
    s0 = fmaf(a.x, x12, s0);
    s1 = fmaf(a.y, x13, s1);
    s2 = fmaf(a.z, x14, s2);
    s3 = fmaf(a.w, x15, s3);
    a = *(const LAS f32x4*)(Am + 3620);
    s0 = fmaf(a.x, x16, s0);
    s1 = fmaf(a.y, x17, s1);
    s2 = fmaf(a.z, x18, s2);
    s3 = fmaf(a.w, x19, s3);
    a = *(const LAS f32x4*)(Am + 3624);
    s0 = fmaf(a.x, x20, s0);
    s1 = fmaf(a.y, x21, s1);
    s2 = fmaf(a.z, x22, s2);
    s3 = fmaf(a.w, x23, s3);
    a = *(const LAS f32x4*)(Am + 3628);
    s0 = fmaf(a.x, x24, s0);
    s1 = fmaf(a.y, x25, s1);
    s2 = fmaf(a.z, x26, s2);
    s3 = fmaf(a.w, x27, s3);
    a = *(const LAS f32x4*)(Am + 3632);
    s0 = fmaf(a.x, x28, s0);
    s1 = fmaf(a.y, x29, s1);
    s2 = fmaf(a.z, x30, s2);
    s3 = fmaf(a.w, x31, s3);
    a = *(const LAS f32x4*)(Am + 3636);
    s0 = fmaf(a.x, x32, s0);
    s1 = fmaf(a.y, x33, s1);
    s2 = fmaf(a.z, x34, s2);
    s3 = fmaf(a.w, x35, s3);
    a = *(const LAS f32x4*)(Am + 3640);
    s0 = fmaf(a.x, x36, s0);
    s1 = fmaf(a.y, x37, s1);
    s2 = fmaf(a.z, x38, s2);
    s3 = fmaf(a.w, x39, s3);
    a = *(const LAS f32x4*)(Am + 3644);
    s0 = fmaf(a.x, x40, s0);
    s1 = fmaf(a.y, x41, s1);
    s2 = fmaf(a.z, x42, s2);
    s3 = fmaf(a.w, x43, s3);
    a = *(const LAS f32x4*)(Am + 3648);
    s0 = fmaf(a.x, x44, s0);
    s1 = fmaf(a.y, x45, s1);
    s2 = fmaf(a.z, x46, s2);
    s3 = fmaf(a.w, x47, s3);
    a = *(const LAS f32x4*)(Am + 3652);
    s0 = fmaf(a.x, x48, s0);
    s1 = fmaf(a.y, x49, s1);
    s2 = fmaf(a.z, x50, s2);
    s3 = fmaf(a.w, x51, s3);
    a = *(const LAS f32x4*)(Am + 3656);
    const float al53 = a.x;
    x53 = (x53 - ((s0 + s1) + (s2 + s3))) - al53 * x52;
    Tu[7208 + c] = f2bf(x53 * su); Tw[7208 + c] = f2bf(x53 * sw); asm volatile("" ::: "memory");
    float x54 = fmaxf(0.0f, 1.0f - fabsf(cf - 54.0f));
    s0 = 0.f; s1 = 0.f; s2 = 0.f; s3 = 0.f;
    a = *(const LAS f32x4*)(Am + 3672);
    s0 = fmaf(a.x, x0, s0);
    s1 = fmaf(a.y, x1, s1);
    s2 = fmaf(a.z, x2, s2);
    s3 = fmaf(a.w, x3, s3);
    a = *(const LAS f32x4*)(Am + 3676);
    s0 = fmaf(a.x, x4, s0);
    s1 = fmaf(a.y, x5, s1);
    s2 = fmaf(a.z, x6, s2);
    s3 = fmaf(a.w, x7, s3);
    a = *(const LAS f32x4*)(Am + 3680);
    s0 = fmaf(a.x, x8, s0);
    s1 = fmaf(a.y, x9, s1);
    s2 = fmaf(a.z, x10, s2);
    s3 = fmaf(a.w, x11, s3);
    a = *(const LAS f32x4*)(Am + 3684);
    s0 = fmaf(a.x, x12, s0);
    s1 = fmaf(a.y, x13, s1);
    s2 = fmaf(a.z, x14, s2);
    s3 = fmaf(a.w, x15, s3);
    a = *(const LAS f32x4*)(Am + 3688);
    s0 = fmaf(a.x, x16, s0);
    s1 = fmaf(a.y, x17, s1);
    s2 = fmaf(a.z, x18, s2);
    s3 = fmaf(a.w, x19, s3);
    a = *(const LAS f32x4*)(Am + 3692);
    s0 = fmaf(a.x, x20, s0);
    s1 = fmaf(a.y, x21, s1);
    s2 = fmaf(a.z, x22, s2);
    s3 = fmaf(a.w, x23, s3);
    a = *(const LAS f32x4*)(Am + 3696);
    s0 = fmaf(a.x, x24, s0);
    s1 = fmaf(a.y, x25, s1);
    s2 = fmaf(a.z, x26, s2);
    s3 = fmaf(a.w, x27, s3);
    a = *(const LAS f32x4*)(Am + 3700);
    s0 = fmaf(a.x, x28, s0);
    s1 = fmaf(a.y, x29, s1);
    s2 = fmaf(a.z, x30, s2);
    s3 = fmaf(a.w, x31, s3);
    a = *(const LAS f32x4*)(Am + 3704);
    s0 = fmaf(a.x, x32, s0);
    s1 = fmaf(a.y, x33, s1);
    s2 = fmaf(a.z, x34, s2);
    s3 = fmaf(a.w, x35, s3);
    a = *(const LAS f32x4*)(Am + 3708);
    s0 = fmaf(a.x, x36, s0);
    s1 = fmaf(a.y, x37, s1);
    s2 = fmaf(a.z, x38, s2);
    s3 = fmaf(a.w, x39, s3);
    a = *(const LAS f32x4*)(Am + 3712);
    s0 = fmaf(a.x, x40, s0);
    s1 = fmaf(a.y, x41, s1);
    s2 = fmaf(a.z, x42, s2);
    s3 = fmaf(a.w, x43, s3);
    a = *(const LAS f32x4*)(Am + 3716);
    s0 = fmaf(a.x, x44, s0);
    s1 = fmaf(a.y, x45, s1);
    s2 = fmaf(a.z, x46, s2);
    s3 = fmaf(a.w, x47, s3);
    a = *(const LAS f32x4*)(Am + 3720);
    s0 = fmaf(a.x, x48, s0);
    s1 = fmaf(a.y, x49, s1);
    s2 = fmaf(a.z, x50, s2);
    s3 = fmaf(a.w, x51, s3);
    a = *(const LAS f32x4*)(Am + 3724);
    s0 = fmaf(a.x, x52, s0);
    const float al54 = a.y;
    x54 = (x54 - ((s0 + s1) + (s2 + s3))) - al54 * x53;
    Tu[7344 + c] = f2bf(x54 * su); Tw[7344 + c] = f2bf(x54 * sw); asm volatile("" ::: "memory");
    float x55 = fmaxf(0.0f, 1.0f - fabsf(cf - 55.0f));
    s0 = 0.f; s1 = 0.f; s2 = 0.f; s3 = 0.f;
    a = *(const LAS f32x4*)(Am + 3740);
    s0 = fmaf(a.x, x0, s0);
    s1 = fmaf(a.y, x1, s1);
    s2 = fmaf(a.z, x2, s2);
    s3 = fmaf(a.w, x3, s3);
    a = *(const LAS f32x4*)(Am + 3744);
    s0 = fmaf(a.x, x4, s0);
    s1 = fmaf(a.y, x5, s1);
    s2 = fmaf(a.z, x6, s2);
    s3 = fmaf(a.w, x7, s3);
    a = *(const LAS f32x4*)(Am + 3748);
    s0 = fmaf(a.x, x8, s0);
    s1 = fmaf(a.y, x9, s1);
    s2 = fmaf(a.z, x10, s2);
    s3 = fmaf(a.w, x11, s3);
    a = *(const LAS f32x4*)(Am + 3752);
    s0 = fmaf(a.x, x12, s0);
    s1 = fmaf(a.y, x13, s1);
    s2 = fmaf(a.z, x14, s2);
    s3 = fmaf(a.w, x15, s3);
    a = *(const LAS f32x4*)(Am + 3756);
    s0 = fmaf(a.x, x16, s0);
    s1 = fmaf(a.y, x17, s1);
    s2 = fmaf(a.z, x18, s2);
    s3 = fmaf(a.w, x19, s3);
    a = *(const LAS f32x4*)(Am + 3760);
    s0 = fmaf(a.x, x20, s0);
    s1 = fmaf(a.y, x21, s1);
    s2 = fmaf(a.z, x22, s2);
    s3 = fmaf(a.w, x23, s3);
    a = *(const LAS f32x4*)(Am + 3764);
    s0 = fmaf(a.x, x24, s0);
    s1 = fmaf(a.y, x25, s1);
    s2 = fmaf(a.z, x26, s2);
    s3 = fmaf(a.w, x27, s3);
    a = *(const LAS f32x4*)(Am + 3768);
    s0 = fmaf(a.x, x28, s0);
    s1 = fmaf(a.y, x29, s1);
    s2 = fmaf(a.z, x30, s2);
    s3 = fmaf(a.w, x31, s3);
    a = *(const LAS f32x4*)(Am + 3772);
    s0 = fmaf(a.x, x32, s0);
    s1 = fmaf(a.y, x33, s1);
    s2 = fmaf(a.z, x34, s2);
    s3 = fmaf(a.w, x35, s3);
    a = *(const LAS f32x4*)(Am + 3776);
    s0 = fmaf(a.x, x36, s0);
    s1 = fmaf(a.y, x37, s1);
    s2 = fmaf(a.z, x38, s2);
    s3 = fmaf(a.w, x39, s3);
    a = *(const LAS f32x4*)(Am + 3780);
    s0 = fmaf(a.x, x40, s0);
    s1 = fmaf(a.y, x41, s1);
    s2 = fmaf(a.z, x42, s2);
    s3 = fmaf(a.w, x43, s3);
    a = *(const LAS f32x4*)(Am + 3784);
    s0 = fmaf(a.x, x44, s0);
    s1 = fmaf(a.y, x45, s1);
    s2 = fmaf(a.z, x46, s2);
    s3 = fmaf(a.w, x47, s3);
    a = *(const LAS f32x4*)(Am + 3788);
    s0 = fmaf(a.x, x48, s0);
    s1 = fmaf(a.y, x49, s1);
    s2 = fmaf(a.z, x50, s2);
    s3 = fmaf(a.w, x51, s3);
    a = *(const LAS f32x4*)(Am + 3792);
    s0 = fmaf(a.x, x52, s0);
    s1 = fmaf(a.y, x53, s1);
    const float al55 = a.z;
    x55 = (x55 - ((s0 + s1) + (s2 + s3))) - al55 * x54;
    Tu[7480 + c] = f2bf(x55 * su); Tw[7480 + c] = f2bf(x55 * sw); asm volatile("" ::: "memory");
    float x56 = fmaxf(0.0f, 1.0f - fabsf(cf - 56.0f));
    s0 = 0.f; s1 = 0.f; s2 = 0.f; s3 = 0.f;
    a = *(const LAS f32x4*)(Am + 3808);
    s0 = fmaf(a.x, x0, s0);
    s1 = fmaf(a.y, x1, s1);
    s2 = fmaf(a.z, x2, s2);
    s3 = fmaf(a.w, x3, s3);
    a = *(const LAS f32x4*)(Am + 3812);
    s0 = fmaf(a.x, x4, s0);
    s1 = fmaf(a.y, x5, s1);
    s2 = fmaf(a.z, x6, s2);
    s3 = fmaf(a.w, x7, s3);
    a = *(const LAS f32x4*)(Am + 3816);
    s0 = fmaf(a.x, x8, s0);
    s1 = fmaf(a.y, x9, s1);
    s2 = fmaf(a.z, x10, s2);
    s3 = fmaf(a.w, x11, s3);
    a = *(const LAS f32x4*)(Am + 3820);
    s0 = fmaf(a.x, x12, s0);
    s1 = fmaf(a.y, x13, s1);
    s2 = fmaf(a.z, x14, s2);
    s3 = fmaf(a.w, x15, s3);
    a = *(const LAS f32x4*)(Am + 3824);
    s0 = fmaf(a.x, x16, s0);
    s1 = fmaf(a.y, x17, s1);
    s2 = fmaf(a.z, x18, s2);
    s3 = fmaf(a.w, x19, s3);
    a = *(const LAS f32x4*)(Am + 3828);
    s0 = fmaf(a.x, x20, s0);
    s1 = fmaf(a.y, x21, s1);
    s2 = fmaf(a.z, x22, s2);
    s3 = fmaf(a.w, x23, s3);
    a = *(const LAS f32x4*)(Am + 3832);
    s0 = fmaf(a.x, x24, s0);
    s1 = fmaf(a.y, x25, s1);
    s2 = fmaf(a.z, x26, s2);
    s3 = fmaf(a.w, x27, s3);
    a = *(const LAS f32x4*)(Am + 3836);
    s0 = fmaf(a.x, x28, s0);
    s1 = fmaf(a.y, x29, s1);
    s2 = fmaf(a.z, x30, s2);
    s3 = fmaf(a.w, x31, s3);
    a = *(const LAS f32x4*)(Am + 3840);
    s0 = fmaf(a.x, x32, s0);
    s1 = fmaf(a.y, x33, s1);
    s2 = fmaf(a.z, x34, s2);
    s3 = fmaf(a.w, x35, s3);
    a = *(const LAS f32x4*)(Am + 3844);
    s0 = fmaf(a.x, x36, s0);
    s1 = fmaf(a.y, x37, s1);
    s2 = fmaf(a.z, x38, s2);
    s3 = fmaf(a.w, x39, s3);
    a = *(const LAS f32x4*)(Am + 3848);
    s0 = fmaf(a.x, x40, s0);
    s1 = fmaf(a.y, x41, s1);
    s2 = fmaf(a.z, x42, s2);
    s3 = fmaf(a.w, x43, s3);
    a = *(const LAS f32x4*)(Am + 3852);
    s0 = fmaf(a.x, x44, s0);
    s1 = fmaf(a.y, x45, s1);
    s2 = fmaf(a.z, x46, s2);
    s3 = fmaf(a.w, x47, s3);
    a = *(const LAS f32x4*)(Am + 3856);
    s0 = fmaf(a.x, x48, s0);
    s1 = fmaf(a.y, x49, s1);
    s2 = fmaf(a.z, x50, s2);
    s3 = fmaf(a.w, x51, s3);
    a = *(const LAS f32x4*)(Am + 3860);
    s0 = fmaf(a.x, x52, s0);
    s1 = fmaf(a.y, x53, s1);
    s2 = fmaf(a.z, x54, s2);
    const float al56 = a.w;
    x56 = (x56 - ((s0 + s1) + (s2 + s3))) - al56 * x55;
    Tu[7616 + c] = f2bf(x56 * su); Tw[7616 + c] = f2bf(x56 * sw); asm volatile("" ::: "memory");
    float x57 = fmaxf(0.0f, 1.0f - fabsf(cf - 57.0f));
    s0 = 0.f; s1 = 0.f; s2 = 0.f; s3 = 0.f;
    a = *(const LAS f32x4*)(Am + 3876);
    s0 = fmaf(a.x, x0, s0);
    s1 = fmaf(a.y, x1, s1);
    s2 = fmaf(a.z, x2, s2);
    s3 = fmaf(a.w, x3, s3);
    a = *(const LAS f32x4*)(Am + 3880);
    s0 = fmaf(a.x, x4, s0);
    s1 = fmaf(a.y, x5, s1);
    s2 = fmaf(a.z, x6, s2);
    s3 = fmaf(a.w, x7, s3);
    a = *(const LAS f32x4*)(Am + 3884);
    s0 = fmaf(a.x, x8, s0);
    s1 = fmaf(a.y, x9, s1);
    s2 = fmaf(a.z, x10, s2);
    s3 = fmaf(a.w, x11, s3);
    a = *(const LAS f32x4*)(Am + 3888);
    s0 = fmaf(a.x, x12, s0);
    s1 = fmaf(a.y, x13, s1);
    s2 = fmaf(a.z, x14, s2);
    s3 = fmaf(a.w, x15, s3);
    a = *(const LAS f32x4*)(Am + 3892);
    s0 = fmaf(a.x, x16, s0);
    s1 = fmaf(a.y, x17, s1);
    s2 = fmaf(a.z, x18, s2);
    s3 = fmaf(a.w, x19, s3);
    a = *(const LAS f32x4*)(Am + 3896);
    s0 = fmaf(a.x, x20, s0);
    s1 = fmaf(a.y, x21, s1);
    s2 = fmaf(a.z, x22, s2);
    s3 = fmaf(a.w, x23, s3);
    a = *(const LAS f32x4*)(Am + 3900);
    s0 = fmaf(a.x, x24, s0);
    s1 = fmaf(a.y, x25, s1);
    s2 = fmaf(a.z, x26, s2);
    s3 = fmaf(a.w, x27, s3);
    a = *(const LAS f32x4*)(Am + 3904);
    s0 = fmaf(a.x, x28, s0);
    s1 = fmaf(a.y, x29, s1);
    s2 = fmaf(a.z, x30, s2);
    s3 = fmaf(a.w, x31, s3);
    a = *(const LAS f32x4*)(Am + 3908);
    s0 = fmaf(a.x, x32, s0);
    s1 = fmaf(a.y, x33, s1);
    s2 = fmaf(a.z, x34, s2);
    s3 = fmaf(a.w, x35, s3);
    a = *(const LAS f32x4*)(Am + 3912);
    s0 = fmaf(a.x, x36, s0);
    s1 = fmaf(a.y, x37, s1);
    s2 = fmaf(a.z, x38, s2);
    s3 = fmaf(a.w, x39, s3);
    a = *(const LAS f32x4*)(Am + 3916);
    s0 = fmaf(a.x, x40, s0);
    s1 = fmaf(a.y, x41, s1);
    s2 = fmaf(a.z, x42, s2);
    s3 = fmaf(a.w, x43, s3);
    a = *(const LAS f32x4*)(Am + 3920);
    s0 = fmaf(a.x, x44, s0);
    s1 = fmaf(a.y, x45, s1);
    s2 = fmaf(a.z, x46, s2);
    s3 = fmaf(a.w, x47, s3);
    a = *(const LAS f32x4*)(Am + 3924);
    s0 = fmaf(a.x, x48, s0);
    s1 = fmaf(a.y, x49, s1);
    s2 = fmaf(a.z, x50, s2);
    s3 = fmaf(a.w, x51, s3);
    a = *(const LAS f32x4*)(Am + 3928);
    s0 = fmaf(a.x, x52, s0);
    s1 = fmaf(a.y, x53, s1);
    s2 = fmaf(a.z, x54, s2);
    s3 = fmaf(a.w, x55, s3);
    a = *(const LAS f32x4*)(Am + 3932);
    const float al57 = a.x;
    x57 = (x57 - ((s0 + s1) + (s2 + s3))) - al57 * x56;
    Tu[7752 + c] = f2bf(x57 * su); Tw[7752 + c] = f2bf(x57 * sw); asm volatile("" ::: "memory");
    float x58 = fmaxf(0.0f, 1.0f - fabsf(cf - 58.0f));
    s0 = 0.f; s1 = 0.f; s2 = 0.f; s3 = 0.f;
    a = *(const LAS f32x4*)(Am + 3944);
    s0 = fmaf(a.x, x0, s0);
    s1 = fmaf(a.y, x1, s1);
    s2 = fmaf(a.z, x2, s2);
    s3 = fmaf(a.w, x3, s3);
    a = *(const LAS f32x4*)(Am + 3948);
    s0 = fmaf(a.x, x4, s0);
    s1 = fmaf(a.y, x5, s1);
    s2 = fmaf(a.z, x6, s2);
    s3 = fmaf(a.w, x7, s3);
    a = *(const LAS f32x4*)(Am + 3952);
    s0 = fmaf(a.x, x8, s0);
    s1 = fmaf(a.y, x9, s1);
    s2 = fmaf(a.z, x10, s2);
    s3 = fmaf(a.w, x11, s3);
    a = *(const LAS f32x4*)(Am + 3956);
    s0 = fmaf(a.x, x12, s0);
    s1 = fmaf(a.y, x13, s1);
    s2 = fmaf(a.z, x14, s2);
    s3 = fmaf(a.w, x15, s3);
    a = *(const LAS f32x4*)(Am + 3960);
    s0 = fmaf(a.x, x16, s0);
    s1 = fmaf(a.y, x17, s1);
    s2 = fmaf(a.z, x18, s2);
    s3 = fmaf(a.w, x19, s3);
    a = *(const LAS f32x4*)(Am + 3964);
    s0 = fmaf(a.x, x20, s0);
    s1 = fmaf(a.y, x21, s1);
    s2 = fmaf(a.z, x22, s2);
    s3 = fmaf(a.w, x23, s3);
    a = *(const LAS f32x4*)(Am + 3968);
    s0 = fmaf(a.x, x24, s0);
    s1 = fmaf(a.y, x25, s1);
    s2 = fmaf(a.z, x26, s2);
    s3 = fmaf(a.w, x27, s3);
    a = *(const LAS f32x4*)(Am + 3972);
    s0 = fmaf(a.x, x28, s0);
    s1 = fmaf(a.y, x29, s1);
    s2 = fmaf(a.z, x30, s2);
    s3 = fmaf(a.w, x31, s3);
    a = *(const LAS f32x4*)(Am + 3976);
    s0 = fmaf(a.x, x32, s0);
    s1 = fmaf(a.y, x33, s1);
    s2 = fmaf(a.z, x34, s2);
    s3 = fmaf(a.w, x35, s3);
    a = *(const LAS f32x4*)(Am + 3980);
    s0 = fmaf(a.x, x36, s0);
    s1 = fmaf(a.y, x37, s1);
    s2 = fmaf(a.z, x38, s2);
    s3 = fmaf(a.w, x39, s3);
    a = *(const LAS f32x4*)(Am + 3984);
    s0 = fmaf(a.x, x40, s0);
    s1 = fmaf(a.y, x41, s1);
    s2 = fmaf(a.z, x42, s2);
    s3 = fmaf(a.w, x43, s3);
    a = *(const LAS f32x4*)(Am + 3988);
    s0 = fmaf(a.x, x44, s0);
    s1 = fmaf(a.y, x45, s1);
    s2 = fmaf(a.z, x46, s2);
    s3 = fmaf(a.w, x47, s3);
    a = *(const LAS f32x4*)(Am + 3992);
    s0 = fmaf(a.x, x48, s0);
    s1 = fmaf(a.y, x49, s1);
    s2 = fmaf(a.z, x50, s2);
    s3 = fmaf(a.w, x51, s3);
    a = *(const LAS f32x4*)(Am + 3996);
    s0 = fmaf(a.x, x52, s0);
    s1 = fmaf(a.y, x53, s1);
    s2 = fmaf(a.z, x54, s2);
    s3 = fmaf(a.w, x55, s3);
    a = *(const LAS f32x4*)(Am + 4000);
    s0 = fmaf(a.x, x56, s0);
    const float al58 = a.y;
    x58 = (x58 - ((s0 + s1) + (s2 + s3))) - al58 * x57;
    Tu[7888 + c] = f2bf(x58 * su); Tw[7888 + c] = f2bf(x58 * sw); asm volatile("" ::: "memory");
    float x59 = fmaxf(0.0f, 1.0f - fabsf(cf - 59.0f));
    s0 = 0.f; s1 = 0.f; s2 = 0.f; s3 = 0.f;
    a = *(const LAS f32x4*)(Am + 4012);
    s0 = fmaf(a.x, x0, s0);
    s1 = fmaf(a.y, x1, s1);
    s2 = fmaf(a.z, x2, s2);
    s3 = fmaf(a.w, x3, s3);
    a = *(const LAS f32x4*)(Am + 4016);
    s0 = fmaf(a.x, x4, s0);
    s1 = fmaf(a.y, x5, s1);
    s2 = fmaf(a.z, x6, s2);
    s3 = fmaf(a.w, x7, s3);
    a = *(const LAS f32x4*)(Am + 4020);
    s0 = fmaf(a.x, x8, s0);
    s1 = fmaf(a.y, x9, s1);
    s2 = fmaf(a.z, x10, s2);
    s3 = fmaf(a.w, x11, s3);
    a = *(const LAS f32x4*)(Am + 4024);
    s0 = fmaf(a.x, x12, s0);
    s1 = fmaf(a.y, x13, s1);
    s2 = fmaf(a.z, x14, s2);
    s3 = fmaf(a.w, x15, s3);
    a = *(const LAS f32x4*)(Am + 4028);
    s0 = fmaf(a.x, x16, s0);
    s1 = fmaf(a.y, x17, s1);
    s2 = fmaf(a.z, x18, s2);
    s3 = fmaf(a.w, x19, s3);
    a = *(const LAS f32x4*)(Am + 4032);
    s0 = fmaf(a.x, x20, s0);
    s1 = fmaf(a.y, x21, s1);
    s2 = fmaf(a.z, x22, s2);
    s3 = fmaf(a.w, x23, s3);
    a = *(const LAS f32x4*)(Am + 4036);
    s0 = fmaf(a.x, x24, s0);
    s1 = fmaf(a.y, x25, s1);
    s2 = fmaf(a.z, x26, s2);
    s3 = fmaf(a.w, x27, s3);
    a = *(const LAS f32x4*)(Am + 4040);
    s0 = fmaf(a.x, x28, s0);
    s1 = fmaf(a.y, x29, s1);
    s2 = fmaf(a.z, x30, s2);
    s3 = fmaf(a.w, x31, s3);
    a = *(const LAS f32x4*)(Am + 4044);
    s0 = fmaf(a.x, x32, s0);
    s1 = fmaf(a.y, x33, s1);
    s2 = fmaf(a.z, x34, s2);
    s3 = fmaf(a.w, x35, s3);
    a = *(const LAS f32x4*)(Am + 4048);
    s0 = fmaf(a.x, x36, s0);
    s1 = fmaf(a.y, x37, s1);
    s2 = fmaf(a.z, x38, s2);
    s3 = fmaf(a.w, x39, s3);
    a = *(const LAS f32x4*)(Am + 4052);
    s0 = fmaf(a.x, x40, s0);
    s1 = fmaf(a.y, x41, s1);
    s2 = fmaf(a.z, x42, s2);
    s3 = fmaf(a.w, x43, s3);
    a = *(const LAS f32x4*)(Am + 4056);
    s0 = fmaf(a.x, x44, s0);
    s1 = fmaf(a.y, x45, s1);
    s2 = fmaf(a.z, x46, s2);
    s3 = fmaf(a.w, x47, s3);
    a = *(const LAS f32x4*)(Am + 4060);
    s0 = fmaf(a.x, x48, s0);
    s1 = fmaf(a.y, x49, s1);
    s2 = fmaf(a.z, x50, s2);
    s3 = fmaf(a.w, x51, s3);
    a = *(const LAS f32x4*)(Am + 4064);
    s0 = fmaf(a.x, x52, s0);
    s1 = fmaf(a.y, x53, s1);
    s2 = fmaf(a.z, x54, s2);
    s3 = fmaf(a.w, x55, s3);
    a = *(const LAS f32x4*)(Am + 4068);
    s0 = fmaf(a.x, x56, s0);
    s1 = fmaf(a.y, x57, s1);
    const float al59 = a.z;
    x59 = (x59 - ((s0 + s1) + (s2 + s3))) - al59 * x58;
    Tu[8024 + c] = f2bf(x59 * su); Tw[8024 + c] = f2bf(x59 * sw); asm volatile("" ::: "memory");
    float x60 = fmaxf(0.0f, 1.0f - fabsf(cf - 60.0f));
    s0 = 0.f; s1 = 0.f; s2 = 0.f; s3 = 0.f;
    a = *(const LAS f32x4*)(Am + 4080);
    s0 = fmaf(a.x, x0, s0);
    s1 = fmaf(a.y, x1, s1);
    s2 = fmaf(a.z, x2, s2);
    s3 = fmaf(a.w, x3, s3);
    a = *(const LAS f32x4*)(Am + 4084);
    s0 = fmaf(a.x, x4, s0);
    s1 = fmaf(a.y, x5, s1);
    s2 = fmaf(a.z, x6, s2);
    s3 = fmaf(a.w, x7, s3);
    a = *(const LAS f32x4*)(Am + 4088);
    s0 = fmaf(a.x, x8, s0);
    s1 = fmaf(a.y, x9, s1);
    s2 = fmaf(a.z, x10, s2);
    s3 = fmaf(a.w, x11, s3);
    a = *(const LAS f32x4*)(Am + 4092);
    s0 = fmaf(a.x, x12, s0);
    s1 = fmaf(a.y, x13, s1);
    s2 = fmaf(a.z, x14, s2);
    s3 = fmaf(a.w, x15, s3);
    a = *(const LAS f32x4*)(Am + 4096);
    s0 = fmaf(a.x, x16, s0);
    s1 = fmaf(a.y, x17, s1);
    s2 = fmaf(a.z, x18, s2);
    s3 = fmaf(a.w, x19, s3);
    a = *(const LAS f32x4*)(Am + 4100);
    s0 = fmaf(a.x, x20, s0);
    s1 = fmaf(a.y, x21, s1);
    s2 = fmaf(a.z, x22, s2);
    s3 = fmaf(a.w, x23, s3);
    a = *(const LAS f32x4*)(Am + 4104);
    s0 = fmaf(a.x, x24, s0);
    s1 = fmaf(a.y, x25, s1);
    s2 = fmaf(a.z, x26, s2);
    s3 = fmaf(a.w, x27, s3);
    a = *(const LAS f32x4*)(Am + 4108);
    s0 = fmaf(a.x, x28, s0);
    s1 = fmaf(a.y, x29, s1);
    s2 = fmaf(a.z, x30, s2);
    s3 = fmaf(a.w, x31, s3);
    a = *(const LAS f32x4*)(Am + 4112);
    s0 = fmaf(a.x, x32, s0);
    s1 = fmaf(a.y, x33, s1);
    s2 = fmaf(a.z, x34, s2);
    s3 = fmaf(a.w, x35, s3);
    a = *(const LAS f32x4*)(Am + 4116);
    s0 = fmaf(a.x, x36, s0);
    s1 = fmaf(a.y, x37, s1);
    s2 = fmaf(a.z, x38, s2);
    s3 = fmaf(a.w, x39, s3);
    a = *(const LAS f32x4*)(Am + 4120);
    s0 = fmaf(a.x, x40, s0);
    s1 = fmaf(a.y, x41, s1);
    s2 = fmaf(a.z, x42, s2);
    s3 = fmaf(a.w, x43, s3);
    a = *(const LAS f32x4*)(Am + 4124);
    s0 = fmaf(a.x, x44, s0);
    s1 = fmaf(a.y, x45, s1);
    s2 = fmaf(a.z, x46, s2);
    s3 = fmaf(a.w, x47, s3);
    a = *(const LAS f32x4*)(Am + 4128);
    s0 = fmaf(a.x, x48, s0);
    s1 = fmaf(a.y, x49, s1);
    s2 = fmaf(a.z, x50, s2);
    s3 = fmaf(a.w, x51, s3);
    a = *(const LAS f32x4*)(Am + 4132);
    s0 = fmaf(a.x, x52, s0);
    s1 = fmaf(a.y, x53, s1);
    s2 = fmaf(a.z, x54, s2);
    s3 = fmaf(a.w, x55, s3);
    a = *(const LAS f32x4*)(Am + 4136);
    s0 = fmaf(a.x, x56, s0);
    s1 = fmaf(a.y, x57, s1);
    s2 = fmaf(a.z, x58, s2);
    const float al60 = a.w;
    x60 = (x60 - ((s0 + s1) + (s2 + s3))) - al60 * x59;
    Tu[8160 + c] = f2bf(x60 * su); Tw[8160 + c] = f2bf(x60 * sw); asm volatile("" ::: "memory");
    float x61 = fmaxf(0.0f, 1.0f - fabsf(cf - 61.0f));
    s0 = 0.f; s1 = 0.f; s2 = 0.f; s3 = 0.f;
    a = *(const LAS f32x4*)(Am + 4148);
    s0 = fmaf(a.x, x0, s0);
    s1 = fmaf(a.y, x1, s1);
    s2 = fmaf(a.z, x2, s2);
    s3 = fmaf(a.w, x3, s3);
    a = *(const LAS f32x4*)(Am + 4152);
    s0 = fmaf(a.x, x4, s0);
    s1 = fmaf(a.y, x5, s1);
    s2 = fmaf(a.z, x6, s2);
    s3 = fmaf(a.w, x7, s3);
    a = *(const LAS f32x4*)(Am + 4156);
    s0 = fmaf(a.x, x8, s0);
    s1 = fmaf(a.y, x9, s1);
    s2 = fmaf(a.z, x10, s2);
    s3 = fmaf(a.w, x11, s3);
    a = *(const LAS f32x4*)(Am + 4160);
    s0 = fmaf(a.x, x12, s0);
    s1 = fmaf(a.y, x13, s1);
    s2 = fmaf(a.z, x14, s2);
    s3 = fmaf(a.w, x15, s3);
    a = *(const LAS f32x4*)(Am + 4164);
    s0 = fmaf(a.x, x16, s0);
    s1 = fmaf(a.y, x17, s1);
    s2 = fmaf(a.z, x18, s2);
    s3 = fmaf(a.w, x19, s3);
    a = *(const LAS f32x4*)(Am + 4168);
    s0 = fmaf(a.x, x20, s0);
    s1 = fmaf(a.y, x21, s1);
    s2 = fmaf(a.z, x22, s2);
    s3 = fmaf(a.w, x23, s3);
    a = *(const LAS f32x4*)(Am + 4172);
    s0 = fmaf(a.x, x24, s0);
    s1 = fmaf(a.y, x25, s1);
    s2 = fmaf(a.z, x26, s2);
    s3 = fmaf(a.w, x27, s3);
    a = *(const LAS f32x4*)(Am + 4176);
    s0 = fmaf(a.x, x28, s0);
    s1 = fmaf(a.y, x29, s1);
    s2 = fmaf(a.z, x30, s2);
    s3 = fmaf(a.w, x31, s3);
    a = *(const LAS f32x4*)(Am + 4180);
    s0 = fmaf(a.x, x32, s0);
    s1 = fmaf(a.y, x33, s1);
    s2 = fmaf(a.z, x34, s2);
    s3 = fmaf(a.w, x35, s3);
    a = *(const LAS f32x4*)(Am + 4184);
    s0 = fmaf(a.x, x36, s0);
    s1 = fmaf(a.y, x37, s1);
    s2 = fmaf(a.z, x38, s2);
    s3 = fmaf(a.w, x39, s3);
    a = *(const LAS f32x4*)(Am + 4188);
    s0 = fmaf(a.x, x40, s0);
    s1 = fmaf(a.y, x41, s1);
    s2 = fmaf(a.z, x42, s2);
    s3 = fmaf(a.w, x43, s3);
    a = *(const LAS f32x4*)(Am + 4192);
    s0 = fmaf(a.x, x44, s0);
    s1 = fmaf(a.y, x45, s1);
    s2 = fmaf(a.z, x46, s2);
    s3 = fmaf(a.w, x47, s3);
    a = *(const LAS f32x4*)(Am + 4196);
    s0 = fmaf(a.x, x48, s0);
    s1 = fmaf(a.y, x49, s1);
    s2 = fmaf(a.z, x50, s2);
    s3 = fmaf(a.w, x51, s3);
    a = *(const LAS f32x4*)(Am + 4200);
    s0 = fmaf(a.x, x52, s0);
    s1 = fmaf(a.y, x53, s1);
    s2 = fmaf(a.z, x54, s2);
    s3 = fmaf(a.w, x55, s3);
    a = *(const LAS f32x4*)(Am + 4204);
    s0 = fmaf(a.x, x56, s0);
    s1 = fmaf(a.y, x57, s1);
    s2 = fmaf(a.z, x58, s2);
    s3 = fmaf(a.w, x59, s3);
    a = *(const LAS f32x4*)(Am + 4208);
    const float al61 = a.x;
    x61 = (x61 - ((s0 + s1) + (s2 + s3))) - al61 * x60;
    Tu[8296 + c] = f2bf(x61 * su); Tw[8296 + c] = f2bf(x61 * sw); asm volatile("" ::: "memory");
    float x62 = fmaxf(0.0f, 1.0f - fabsf(cf - 62.0f));
    s0 = 0.f; s1 = 0.f; s2 = 0.f; s3 = 0.f;
    a = *(const LAS f32x4*)(Am + 4216);
    s0 = fmaf(a.x, x0, s0);
    s1 = fmaf(a.y, x1, s1);
    s2 = fmaf(a.z, x2, s2);
    s3 = fmaf(a.w, x3, s3);
    a = *(const LAS f32x4*)(Am + 4220);
    s0 = fmaf(a.x, x4, s0);
    s1 = fmaf(a.y, x5, s1);
    s2 = fmaf(a.z, x6, s2);
    s3 = fmaf(a.w, x7, s3);
    a = *(const LAS f32x4*)(Am + 4224);
    s0 = fmaf(a.x, x8, s0);
    s1 = fmaf(a.y, x9, s1);
    s2 = fmaf(a.z, x10, s2);
    s3 = fmaf(a.w, x11, s3);
    a = *(const LAS f32x4*)(Am + 4228);
    s0 = fmaf(a.x, x12, s0);
    s1 = fmaf(a.y, x13, s1);
    s2 = fmaf(a.z, x14, s2);
    s3 = fmaf(a.w, x15, s3);
    a = *(const LAS f32x4*)(Am + 4232);
    s0 = fmaf(a.x, x16, s0);
    s1 = fmaf(a.y, x17, s1);
    s2 = fmaf(a.z, x18, s2);
    s3 = fmaf(a.w, x19, s3);
    a = *(const LAS f32x4*)(Am + 4236);
    s0 = fmaf(a.x, x20, s0);
    s1 = fmaf(a.y, x21, s1);
    s2 = fmaf(a.z, x22, s2);
    s3 = fmaf(a.w, x23, s3);
    a = *(const LAS f32x4*)(Am + 4240);
    s0 = fmaf(a.x, x24, s0);
    s1 = fmaf(a.y, x25, s1);
    s2 = fmaf(a.z, x26, s2);
    s3 = fmaf(a.w, x27, s3);
    a = *(const LAS f32x4*)(Am + 4244);
    s0 = fmaf(a.x, x28, s0);
    s1 = fmaf(a.y, x29, s1);
    s2 = fmaf(a.z, x30, s2);
    s3 = fmaf(a.w, x31, s3);
    a = *(const LAS f32x4*)(Am + 4248);
    s0 = fmaf(a.x, x32, s0);
    s1 = fmaf(a.y, x33, s1);
    s2 = fmaf(a.z, x34, s2);
    s3 = fmaf(a.w, x35, s3);
    a = *(const LAS f32x4*)(Am + 4252);
    s0 = fmaf(a.x, x36, s0);
    s1 = fmaf(a.y, x37, s1);
    s2 = fmaf(a.z, x38, s2);
    s3 = fmaf(a.w, x39, s3);
    a = *(const LAS f32x4*)(Am + 4256);
    s0 = fmaf(a.x, x40, s0);
    s1 = fmaf(a.y, x41, s1);
    s2 = fmaf(a.z, x42, s2);
    s3 = fmaf(a.w, x43, s3);
    a = *(const LAS f32x4*)(Am + 4260);
    s0 = fmaf(a.x, x44, s0);
    s1 = fmaf(a.y, x45, s1);
    s2 = fmaf(a.z, x46, s2);
    s3 = fmaf(a.w, x47, s3);
    a = *(const LAS f32x4*)(Am + 4264);
    s0 = fmaf(a.x, x48, s0);
    s1 = fmaf(a.y, x49, s1);
    s2 = fmaf(a.z, x50, s2);
    s3 = fmaf(a.w, x51, s3);
    a = *(const LAS f32x4*)(Am + 4268);
    s0 = fmaf(a.x, x52, s0);
    s1 = fmaf(a.y, x53, s1);
    s2 = fmaf(a.z, x54, s2);
    s3 = fmaf(a.w, x55, s3);
    a = *(const LAS f32x4*)(Am + 4272);
    s0 = fmaf(a.x, x56, s0);
    s1 = fmaf(a.y, x57, s1);
    s2 = fmaf(a.z, x58, s2);
    s3 = fmaf(a.w, x59, s3);
    a = *(const LAS f32x4*)(Am + 4276);
    s0 = fmaf(a.x, x60, s0);
    const float al62 = a.y;
    x62 = (x62 - ((s0 + s1) + (s2 + s3))) - al62 * x61;
    Tu[8432 + c] = f2bf(x62 * su); Tw[8432 + c] = f2bf(x62 * sw); asm volatile("" ::: "memory");
    float x63 = fmaxf(0.0f, 1.0f - fabsf(cf - 63.0f));
    s0 = 0.f; s1 = 0.f; s2 = 0.f; s3 = 0.f;
    a = *(const LAS f32x4*)(Am + 4284);
    s0 = fmaf(a.x, x0, s0);
    s1 = fmaf(a.y, x1, s1);
    s2 = fmaf(a.z, x2, s2);
    s3 = fmaf(a.w, x3, s3);
    a = *(const LAS f32x4*)(Am + 4288);
    s0 = fmaf(a.x, x4, s0);
    s1 = fmaf(a.y, x5, s1);
    s2 = fmaf(a.z, x6, s2);
    s3 = fmaf(a.w, x7, s3);
    a = *(const LAS f32x4*)(Am + 4292);
    s0 = fmaf(a.x, x8, s0);
    s1 = fmaf(a.y, x9, s1);
    s2 = fmaf(a.z, x10, s2);
    s3 = fmaf(a.w, x11, s3);
    a = *(const LAS f32x4*)(Am + 4296);
    s0 = fmaf(a.x, x12, s0);
    s1 = fmaf(a.y, x13, s1);
    s2 = fmaf(a.z, x14, s2);
    s3 = fmaf(a.w, x15, s3);
    a = *(const LAS f32x4*)(Am + 4300);
    s0 = fmaf(a.x, x16, s0);
    s1 = fmaf(a.y, x17, s1);
    s2 = fmaf(a.z, x18, s2);
    s3 = fmaf(a.w, x19, s3);
    a = *(const LAS f32x4*)(Am + 4304);
    s0 = fmaf(a.x, x20, s0);
    s1 = fmaf(a.y, x21, s1);
    s2 = fmaf(a.z, x22, s2);
    s3 = fmaf(a.w, x23, s3);
    a = *(const LAS f32x4*)(Am + 4308);
    s0 = fmaf(a.x, x24, s0);
    s1 = fmaf(a.y, x25, s1);
    s2 = fmaf(a.z, x26, s2);
    s3 = fmaf(a.w, x27, s3);
    a = *(const LAS f32x4*)(Am + 4312);
    s0 = fmaf(a.x, x28, s0);
    s1 = fmaf(a.y, x29, s1);
    s2 = fmaf(a.z, x30, s2);
    s3 = fmaf(a.w, x31, s3);
    a = *(const LAS f32x4*)(Am + 4316);
    s0 = fmaf(a.x, x32, s0);
    s1 = fmaf(a.y, x33, s1);
    s2 = fmaf(a.z, x34, s2);
    s3 = fmaf(a.w, x35, s3);
    a = *(const LAS f32x4*)(Am + 4320);
    s0 = fmaf(a.x, x36, s0);
    s1 = fmaf(a.y, x37, s1);
    s2 = fmaf(a.z, x38, s2);
    s3 = fmaf(a.w, x39, s3);
    a = *(const LAS f32x4*)(Am + 4324);
    s0 = fmaf(a.x, x40, s0);
    s1 = fmaf(a.y, x41, s1);
    s2 = fmaf(a.z, x42, s2);
    s3 = fmaf(a.w, x43, s3);
    a = *(const LAS f32x4*)(Am + 4328);
    s0 = fmaf(a.x, x44, s0);
    s1 = fmaf(a.y, x45, s1);
    s2 = fmaf(a.z, x46, s2);
    s3 = fmaf(a.w, x47, s3);
    a = *(const LAS f32x4*)(Am + 4332);
    s0 = fmaf(a.x, x48, s0);
    s1 = fmaf(a.y, x49, s1);
    s2 = fmaf(a.z, x50, s2);
    s3 = fmaf(a.w, x51, s3);
    a = *(const LAS f32x4*)(Am + 4336);
    s0 = fmaf(a.x, x52, s0);
    s1 = fmaf(a.y, x53, s1);
    s2 = fmaf(a.z, x54, s2);
    s3 = fmaf(a.w, x55, s3);
    a = *(const LAS f32x4*)(Am + 4340);
    s0 = fmaf(a.x, x56, s0);
    s1 = fmaf(a.y, x57, s1);
    s2 = fmaf(a.z, x58, s2);
    s3 = fmaf(a.w, x59, s3);
    a = *(const LAS f32x4*)(Am + 4344);
    s0 = fmaf(a.x, x60, s0);
    s1 = fmaf(a.y, x61, s1);
    const float al63 = a.z;
    x63 = (x63 - ((s0 + s1) + (s2 + s3))) - al63 * x62;
    Tu[8568 + c] = f2bf(x63 * su); Tw[8568 + c] = f2bf(x63 * sw); asm volatile("" ::: "memory");
}
typedef short bf16x8_t __attribute__((ext_vector_type(8)));
template <int K> __device__ __forceinline__ f32x4 mma_tile(const LAS unsigned short* A, int lda, const LAS unsigned short* Bt, int ldb, f32x4 acc) {
    const int lane = threadIdx.x & 63, r = lane & 15, q = lane >> 4;
#pragma unroll
    for (int ks = 0; ks < K / 32; ++ks) {
        const bf16x8_t a = *(const LAS bf16x8_t*)(A + r * lda + ks * 32 + q * 8);
        const bf16x8_t b = *(const LAS bf16x8_t*)(Bt + r * ldb + ks * 32 + q * 8);
        acc = __builtin_amdgcn_mfma_f32_16x16x32_bf16(a, b, acc, 0, 0, 0);
    }
    return acc;
}

typedef unsigned short u16x4_t __attribute__((ext_vector_type(4)));
__device__ __forceinline__ void tr_frag2(unsigned base_addr, int pitch, int c, bf16x8_t& f0, bf16x8_t& f1) {
    const int lane = threadIdx.x & 63, g = lane >> 4, qq = (lane & 15) >> 2, pp = lane & 3;
    const unsigned a00 = base_addr + (unsigned)((8 * g + qq) * pitch + 32 * c + 8 * pp);
    const unsigned a01 = a00 + 4u * (unsigned)pitch, a10 = a00 + 32u * (unsigned)pitch, a11 = a10 + 4u * (unsigned)pitch;
    u16x4_t r00, r01, r10, r11;
    asm volatile("ds_read_b64_tr_b16 %0, %4\n\tds_read_b64_tr_b16 %1, %5\n\tds_read_b64_tr_b16 %2, %6\n\tds_read_b64_tr_b16 %3, %7\n\ts_waitcnt lgkmcnt(0)"
                 : "=&v"(r00), "=&v"(r01), "=&v"(r10), "=&v"(r11) : "v"(a00), "v"(a01), "v"(a10), "v"(a11) : "memory");
    f0 = (bf16x8_t){(short)r00.x, (short)r00.y, (short)r00.z, (short)r00.w, (short)r01.x, (short)r01.y, (short)r01.z, (short)r01.w};
    f1 = (bf16x8_t){(short)r10.x, (short)r10.y, (short)r10.z, (short)r10.w, (short)r11.x, (short)r11.y, (short)r11.z, (short)r11.w};
}
constexpr size_t WS_G = 235 * MiB;

__device__ __forceinline__ void delta_prep(LDSp lds, const Params& p) {
    const bf16_t* QKVN = (const bf16_t*)(p.ws + WS_QKV); const float* BETA = (const float*)(p.ws + WS_BETA); const float* LA = (const float*)(p.ws + WS_LA);
    bf16_t* Z = (bf16_t*)(p.ws + WS_Z); float* GB = (float*)(p.ws + WS_G);
    LAS unsigned short* Qb = (LAS unsigned short*)lds;
    LAS unsigned short* Kb = (LAS unsigned short*)(lds + 17408);
    LAS unsigned short* Ast = (LAS unsigned short*)(lds + 107776);
    const int tid = threadIdx.x, lane = tid & 63, wid = tid >> 6, r = lane & 15, q = lane >> 4;
    const int G = gridDim.x;
    u32x4 pq[4]; float pla = 0.f, pbe = 0.f;
#define DPL(u_, vmode) do { const int dir_ = (u_) >> 10, b_ = ((u_) >> 8) & 3, h_ = ((u_) >> 6) & 3, n_ = (u_) & 63; \
        const long tk0_ = (long)b_ * S_ + (dir_ ? (S_ - 1 - n_ * 64) : n_ * 64); const long ts_ = dir_ ? -1 : 1; \
        _Pragma("unroll") for (int i = 0; i < 4; ++i) { const int pi = tid + NTHR * i, which = pi >> 10, l = (pi >> 4) & 63, c8 = pi & 15; \
            pq[i] = *(const u32x4*)(QKVN + (tk0_ + l * ts_) * 1536 + ((vmode) ? (which ? 512 : 1024) : which * 512) + h_ * 128 + c8 * 8); } \
        if (!(vmode) && tid < 64) { const long tk = tk0_ + tid * ts_; pla = LA[tk * 8 + dir_ * 4 + h_]; pbe = BETA[tk * 8 + dir_ * 4 + h_]; } } while (0)
#define DPS() do { _Pragma("unroll") for (int i = 0; i < 4; ++i) { const int pi = tid + NTHR * i, which = pi >> 10, l = (pi >> 4) & 63, c8 = pi & 15; *(LAS u32x4*)(lds + which * 17408 + l * 272 + c8 * 16) = pq[i]; } } while (0)
    if ((int)blockIdx.x < 2048) DPL((int)blockIdx.x, 0);
    for (int ub = blockIdx.x; ub < 2048; ub += 4 * G) {
#pragma unroll 1
        for (int j = 0; j < 4; ++j) { const int unit = ub + j * G; if (unit >= 2048) break;
            const int dir = unit >> 10, b = (unit >> 8) & 3, h = (unit >> 6) & 3, n = unit & 63;
            const long tok0 = (long)b * S_ + (dir ? (S_ - 1 - n * 64) : n * 64); const long tstep = dir ? -1 : 1;
            LAS float* Am = (LAS float*)(lds + 34816 + j * 17408); LAS float* gl = (LAS float*)(lds + 104448 + j * 768); LAS float* be = gl + 64; LAS float* beg = gl + 128; LAS float* la = (LAS float*)(lds + 107520);
            DPS();
            if (tid < 64) { la[tid] = pla; be[tid] = pbe; }
            __syncthreads();
            { const int un = ub + (j + 1) * G; if (j < 3 && un < 2048) DPL(un, 0); else DPL(ub, 1); }
            if (tid < 64) { const float g = wave_scan_sum(la[tid], true); gl[tid] = g; beg[tid] = be[tid] * __expf(g); GB[((size_t)dir * T_ + (tok0 + tid * tstep)) * 4 + h] = g; }
            __syncthreads();
#pragma unroll
            for (int tt = 0; tt < 2; ++tt) { const int idx = wid * 2 + tt, mt = idx >> 2, nt = idx & 3;
                f32x4 kk = {0.f, 0.f, 0.f, 0.f}, qk = {0.f, 0.f, 0.f, 0.f};
                if (mt >= nt) { kk = mma_tile<128>(Kb + mt * 16 * 136, 136, Kb + nt * 16 * 136, 136, kk); qk = mma_tile<128>(Qb + mt * 16 * 136, 136, Kb + nt * 16 * 136, 136, qk); }
                const int jj = nt * 16 + r; const float gj = gl[jj];
#pragma unroll
                for (int i4 = 0; i4 < 4; ++i4) { const int i = mt * 16 + q * 4 + i4; const float dec = (i >= jj) ? __expf(gl[i] - gj) : 0.f;
                    Am[i * 68 + jj] = (i > jj) ? be[i] * kk[i4] * dec : 0.f;
                    Ast[i * 72 + jj] = f2bf(qk[i4] * dec); }
            }
            __syncthreads();
            { const int l = tid >> 3, c8 = tid & 7;
              *(u32x4*)(Z + (tok0 + l * tstep) * 3072 + 2048 + dir * 256 + h * 64 + c8 * 8) = *(const LAS u32x4*)(Ast + l * 72 + c8 * 8); }
        }
        if (wid < 4 && ub + wid * G < 2048) { int cc = lane; asm volatile("" : "+v"(cc));
            LAS float* Am = (LAS float*)(lds + 34816 + wid * 17408); LAS float* gl = (LAS float*)(lds + 104448 + wid * 768);
            tri_inv64(Am, cc, gl[64 + lane], gl[128 + lane], (LAS unsigned short*)Am, (LAS unsigned short*)Am + 64); }
        __syncthreads();
#pragma unroll 1
        for (int j = 0; j < 4; ++j) { const int unit = ub + j * G; if (unit >= 2048) break;
            const int dir = unit >> 10, b = (unit >> 8) & 3, h = (unit >> 6) & 3, n = unit & 63;
            const long tok0 = (long)b * S_ + (dir ? (S_ - 1 - n * 64) : n * 64); const long tstep = dir ? -1 : 1;
            const LAS unsigned short* Tu = (const LAS unsigned short*)(lds + 34816 + j * 17408);
            DPS();
            __syncthreads();
            { const int un = ub + (j + 1) * G; if (j < 3 && un < 2048) DPL(un, 1); else if (ub + 4 * G < 2048) DPL(ub + 4 * G, 0); }
            {   bf16x8_t vb0, vb1, kb0, kb1; tr_frag2((unsigned)(unsigned long long)Qb, 272, wid, vb0, vb1); tr_frag2((unsigned)(unsigned long long)Kb, 272, wid, kb0, kb1);
                __syncthreads();
#pragma unroll
                for (int mt = 0; mt < 4; ++mt) {
                    const bf16x8_t tu0 = *(const LAS bf16x8_t*)(Tu + (mt * 16 + r) * 136 + q * 8), tu1 = *(const LAS bf16x8_t*)(Tu + (mt * 16 + r) * 136 + 32 + q * 8);
                    const bf16x8_t tw0 = *(const LAS bf16x8_t*)(Tu + (mt * 16 + r) * 136 + 64 + q * 8), tw1 = *(const LAS bf16x8_t*)(Tu + (mt * 16 + r) * 136 + 96 + q * 8);
                    f32x4 au = {0.f, 0.f, 0.f, 0.f}, aw = {0.f, 0.f, 0.f, 0.f};
                    au = __builtin_amdgcn_mfma_f32_16x16x32_bf16(tu0, vb0, au, 0, 0, 0); au = __builtin_amdgcn_mfma_f32_16x16x32_bf16(tu1, vb1, au, 0, 0, 0);
                    aw = __builtin_amdgcn_mfma_f32_16x16x32_bf16(tw0, kb0, aw, 0, 0, 0); aw = __builtin_amdgcn_mfma_f32_16x16x32_bf16(tw1, kb1, aw, 0, 0, 0);
#pragma unroll
                    for (int i4 = 0; i4 < 4; ++i4) { const int l = mt * 16 + q * 4 + i4; Qb[l * 136 + wid * 16 + r] = f2bf(au[i4]); Kb[l * 136 + wid * 16 + r] = f2bf(aw[i4]); }
                }
            }
            __syncthreads();
#pragma unroll
            for (int i = 0; i < 4; ++i) { const int pi = tid + NTHR * i, which = pi >> 10, l = (pi >> 4) & 63, c8 = pi & 15;
                *(u32x4*)(Z + (tok0 + l * tstep) * 3072 + which * 1024 + dir * 512 + h * 128 + c8 * 8) = *(const LAS u32x4*)(lds + which * 17408 + l * 272 + c8 * 16); }
            __syncthreads();
        }
    }
}
#undef DPL
#undef DPS

__device__ __forceinline__ void delta_scan2(LDSp lds, const Params& p) {
    const bf16_t* QKVN = (const bf16_t*)(p.ws + WS_QKV); const bf16_t* Z = (const bf16_t*)(p.ws + WS_Z); const float* GB = (const float*)(p.ws + WS_G);
    LAS unsigned short* Wb  = (LAS unsigned short*)lds;
    LAS unsigned short* Qg  = (LAS unsigned short*)(lds + 17408);
    LAS unsigned short* Kg  = (LAS unsigned short*)(lds + 34816);
    LAS unsigned short* At  = (LAS unsigned short*)(lds + 53248);
    LAS unsigned short* Ub  = (LAS unsigned short*)(lds + 62464);
    LAS unsigned short* St  = (LAS unsigned short*)(lds + 66560);
    LAS unsigned short* Vt  = (LAS unsigned short*)(lds + 75264);
    const int tid = threadIdx.x, lane = tid & 63, wid = tid >> 6, r = lane & 15, q = lane >> 4;
    for (int unit = blockIdx.x; unit < 128; unit += gridDim.x) {
        const int dir = unit >> 6, b = (unit >> 4) & 3, h = (unit >> 2) & 3, sl = unit & 3;
        bf16_t* O = (bf16_t*)(p.ws + (dir ? WS_OB : WS_OF));
        const long tstep = dir ? -1 : 1;
        f32x4 S0 = {0.f, 0.f, 0.f, 0.f}, S1 = {0.f, 0.f, 0.f, 0.f};
        u32x4 rwA[2], rqA[2], rkA[2], raA, ruA = {0u, 0u, 0u, 0u}; float g0A = 0.f, g1A = 0.f, gLA = 0.f;
        u32x4 rwB[2], rqB[2], rkB[2], raB, ruB = {0u, 0u, 0u, 0u}; float g0B = 0.f, g1B = 0.f, gLB = 0.f;
#define D2_TOK0(n) ((long)b * S_ + (dir ? (S_ - 1 - (n) * 64) : (n) * 64))
#define D2_LOAD(n, X) do { const long t0_ = D2_TOK0(n); \
        _Pragma("unroll") for (int i = 0; i < 2; ++i) { const int pi = tid + NTHR * i, l = pi >> 4, c8 = pi & 15; const long tk = t0_ + l * tstep; \
            rw##X[i] = *(const u32x4*)(Z + tk * 3072 + 1024 + dir * 512 + h * 128 + c8 * 8); \
            rq##X[i] = *(const u32x4*)(QKVN + tk * 1536 + h * 128 + c8 * 8); rk##X[i] = *(const u32x4*)(QKVN + tk * 1536 + 512 + h * 128 + c8 * 8); } \
        { const int l = tid >> 3, c8 = tid & 7; ra##X = *(const u32x4*)(Z + (t0_ + l * tstep) * 3072 + 2048 + dir * 256 + h * 64 + c8 * 8); } \
        if (tid < 256) { const int l = tid >> 2, c8 = tid & 3; ru##X = *(const u32x4*)(Z + (t0_ + l * tstep) * 3072 + dir * 512 + h * 128 + sl * 32 + c8 * 8); } \
        g0##X = GB[((size_t)dir * T_ + (t0_ + (tid >> 4) * tstep)) * 4 + h]; g1##X = GB[((size_t)dir * T_ + (t0_ + ((tid >> 4) + 32) * tstep)) * 4 + h]; \
        gL##X = GB[((size_t)dir * T_ + (t0_ + 63 * tstep)) * 4 + h]; } while (0)
#define D2_ITER(n, X) do { \
            const float egL = __expf(gL##X); \
            _Pragma("unroll") for (int i = 0; i < 2; ++i) { const int pi = tid + NTHR * i, l = pi >> 4, c8 = pi & 15; const float gl_ = i == 0 ? g0##X : g1##X; \
                *(LAS u32x4*)(Wb + l * 136 + c8 * 8) = rw##X[i]; \
                float f[8]; unpack8(rq##X[i], f); const float eg = __expf(gl_); \
                u32x4 o; o.x = pk2(f[0] * eg, f[1] * eg); o.y = pk2(f[2] * eg, f[3] * eg); o.z = pk2(f[4] * eg, f[5] * eg); o.w = pk2(f[6] * eg, f[7] * eg); \
                *(LAS u32x4*)(Qg + l * 136 + c8 * 8) = o; \
                unpack8(rk##X[i], f); const float ek = __expf(gL##X - gl_); \
                o.x = pk2(f[0] * ek, f[1] * ek); o.y = pk2(f[2] * ek, f[3] * ek); o.z = pk2(f[4] * ek, f[5] * ek); o.w = pk2(f[6] * ek, f[7] * ek); \
                *(LAS u32x4*)(Kg + l * 144 + c8 * 8) = o; } \
            { const int l = tid >> 3, c8 = tid & 7; *(LAS u32x4*)(At + l * 72 + c8 * 8) = ra##X; } \
            if (tid < 256) { const int l = tid >> 2, c8 = tid & 3; *(LAS u32x4*)(Ub + l * 32 + c8 * 8) = ru##X; } \
            { u32x2 w0; w0.x = pk2(S0.x, S0.y); w0.y = pk2(S0.z, S0.w); *(LAS u32x2*)(St + r * 136 + wid * 16 + q * 4) = w0; \
              u32x2 w1; w1.x = pk2(S1.x, S1.y); w1.y = pk2(S1.z, S1.w); *(LAS u32x2*)(St + (16 + r) * 136 + wid * 16 + q * 4) = w1; } \
            __syncthreads(); \
            if ((n) + 2 < 64) D2_LOAD((n) + 2, X); \
            const int mt = wid >> 1, nt = wid & 1; \
            f32x4 p1 = {0.f, 0.f, 0.f, 0.f}, p2 = {0.f, 0.f, 0.f, 0.f}; \
            p1 = mma_tile<128>(Wb + mt * 16 * 136, 136, St + nt * 16 * 136, 136, p1); \
            p2 = mma_tile<128>(Qg + mt * 16 * 136, 136, St + nt * 16 * 136, 136, p2); \
            { const int l0 = mt * 16 + q * 4, v = nt * 16 + r; float vn[4]; \
              _Pragma("unroll") for (int i = 0; i < 4; ++i) vn[i] = bf2f(Ub[(l0 + i) * 32 + v]) - p1[i]; \
              u32x2 w; w.x = pk2(vn[0], vn[1]); w.y = pk2(vn[2], vn[3]); *(LAS u32x2*)(Vt + v * 72 + l0) = w; } \
            __syncthreads(); \
            p2 = mma_tile<64>(At + mt * 16 * 72, 72, Vt + nt * 16 * 72, 72, p2); \
            { const long t0_ = D2_TOK0(n); \
              _Pragma("unroll") for (int i = 0; i < 4; ++i) O[(t0_ + (mt * 16 + q * 4 + i) * tstep) * 512 + h * 128 + sl * 32 + nt * 16 + r] = f2bf(p2[i]); } \
            S0 = S0 * egL; S1 = S1 * egL; \
            { bf16x8_t ka0, ka1; tr_frag2((unsigned)(unsigned long long)Kg, 288, wid, ka0, ka1); \
              const bf16x8_t vb00 = *(const LAS bf16x8_t*)(Vt + r * 72 + q * 8), vb01 = *(const LAS bf16x8_t*)(Vt + r * 72 + 32 + q * 8); \
              const bf16x8_t vb10 = *(const LAS bf16x8_t*)(Vt + (16 + r) * 72 + q * 8), vb11 = *(const LAS bf16x8_t*)(Vt + (16 + r) * 72 + 32 + q * 8); \
              S0 = __builtin_amdgcn_mfma_f32_16x16x32_bf16(ka0, vb00, S0, 0, 0, 0); S0 = __builtin_amdgcn_mfma_f32_16x16x32_bf16(ka1, vb01, S0, 0, 0, 0); \
              S1 = __builtin_amdgcn_mfma_f32_16x16x32_bf16(ka0, vb10, S1, 0, 0, 0); S1 = __builtin_amdgcn_mfma_f32_16x16x32_bf16(ka1, vb11, S1, 0, 0, 0); } \
            __syncthreads(); } while (0)
        D2_LOAD(0, A); D2_LOAD(1, B);
#pragma unroll 1
        for (int n = 0; n < 64; n += 2) { D2_ITER(n, A); D2_ITER(n + 1, B); }
#undef D2_ITER
#undef D2_LOAD
#undef D2_TOK0
    }
}
constexpr size_t WS_CT = WS_OF, WS_NV = 235 * MiB, WS_MS = 235 * MiB + 524288, WS_CT2 = 169 * MiB, WS_NV2 = 236 * MiB;
__device__ __forceinline__ void mlstm_a(LDSp lds, const Params& p) {
    const bf16_t* Z = (const bf16_t*)(p.ws + WS_Z); const float* LI = (const float*)(p.ws + WS_BETA); const float* LF = (const float*)(p.ws + WS_LA);
    bf16_t* CT = (bf16_t*)(p.ws + WS_CT); float* NV = (float*)(p.ws + WS_NV); float* MS = (float*)(p.ws + WS_MS);
    LAS unsigned short* Ks = (LAS unsigned short*)lds;
    LAS unsigned short* Vr = (LAS unsigned short*)(lds + 9216);
    LAS float* lf = (LAS float*)(lds + 27648); LAS float* li = lf + 64; LAS float* sw = lf + 128; LAS float* red = lf + 192  ;
    const int tid = threadIdx.x, lane = tid & 63, wid = tid >> 6, r = lane & 15, q = lane >> 4;
    for (int unit = blockIdx.x; unit < 2048; unit += gridDim.x) {
        const int dir = unit >> 10, b = (unit >> 8) & 3, h = (unit >> 6) & 3, n = unit & 63, pc = dir ? 63 - n : n;
        const size_t tok0 = (size_t)b * S_ + pc * 64;
        if (tid < 64) { lf[tid] = LF[(tok0 + tid) * 8 + dir * 4 + h]; li[tid] = LI[(tok0 + tid) * 8 + dir * 4 + h]; }
        __syncthreads();
        if (tid < 64) { const float bc = wave_scan_sum(lf[tid], dir == 0);
            const float tot = __shfl(bc, dir ? 0 : 63);
            const float we = tot - bc + li[tid]; float mx = we;
#pragma unroll
            for (int o = 32; o; o >>= 1) mx = fmaxf(mx, __shfl_xor(mx, o));
            sw[tid] = __expf(we - mx);
            if (tid == 0) { MS[unit * 32] = tot; MS[unit * 32 + 1] = mx; } }
        __syncthreads();
        { const int pp = tid >> 3, c8 = tid & 7; const u32x4 kv = *(const u32x4*)(Z + (tok0 + pp) * 2560 + 1280 + h * 64 + c8 * 8); float f[8]; unpack8(kv, f); const float s = sw[pp];
          u32x4 o; o.x = pk2(f[0] * s, f[1] * s); o.y = pk2(f[2] * s, f[3] * s); o.z = pk2(f[4] * s, f[5] * s); o.w = pk2(f[6] * s, f[7] * s);
          *(LAS u32x4*)(Ks + pp * 72 + c8 * 8) = o; }
#pragma unroll
        for (int i = 0; i < 2; ++i) { const int pi = tid + NTHR * i, pp = pi >> 4, c8 = pi & 15;
            *(LAS u32x4*)(Vr + pp * 144 + c8 * 8) = *(const u32x4*)(Z + (tok0 + pp) * 2560 + 1536 + h * 128 + c8 * 8); }
        __syncthreads();
        { bf16x8_t vb0, vb1; tr_frag2((unsigned)(unsigned long long)Vr, 288, wid, vb0, vb1);
#pragma unroll
          for (int dt = 0; dt < 4; ++dt) { bf16x8_t ka0, ka1; tr_frag2((unsigned)(unsigned long long)Ks, 144, dt, ka0, ka1);
            f32x4 acc = {0.f, 0.f, 0.f, 0.f};
            acc = __builtin_amdgcn_mfma_f32_16x16x32_bf16(ka0, vb0, acc, 0, 0, 0); acc = __builtin_amdgcn_mfma_f32_16x16x32_bf16(ka1, vb1, acc, 0, 0, 0);
            u32x2 w; w.x = pk2(acc.x, acc.y); w.y = pk2(acc.z, acc.w);
            *(u32x2*)(CT + (size_t)unit * 8192 + (wid * 16 + r) * 64 + dt * 16 + q * 4) = w; } }
        { const int d = tid & 63; float a = 0.f;
#pragma unroll
          for (int j = 0; j < 8; ++j) a += bf2f(Ks[(wid * 8 + j) * 72 + d]);
          red[wid * 64 + d] = a; }
        __syncthreads();
        if (tid < 64) { float a = 0.f;
#pragma unroll
            for (int w = 0; w < 8; ++w) a += red[w * 64 + tid];
            NV[(size_t)unit * 64 + tid] = a; }
        __syncthreads();
    }
}
__device__ __forceinline__ void mlstm_b(const Params& p) {
    const bf16_t* CT = (const bf16_t*)(p.ws + WS_CT); const float* NV = (const float*)(p.ws + WS_NV); float* MS = (float*)(p.ws + WS_MS); bf16_t* CT2 = (bf16_t*)(p.ws + WS_CT2); float* NV2 = (float*)(p.ws + WS_NV2);
    const int tid = threadIdx.x;
    for (int wgi = blockIdx.x; wgi < 128; wgi += gridDim.x) {
        const int scan = wgi >> 2, part = wgi & 3; const size_t e = (size_t)(part * NTHR + tid) * 4;
        const bool nvw = (part == 0 && tid < 64);
        float m = 0.f, c0 = 0.f, c1 = 0.f, c2 = 0.f, c3 = 0.f, nn = 0.f;
#pragma unroll 1
        for (int hf = 0; hf < 4; ++hf) {
        u32x2 dc[16]; float dn[16], blv[16], mlv[16];
#pragma unroll
        for (int n = 0; n < 16; ++n) { blv[n] = MS[(scan * 64 + hf * 16 + n) * 32]; mlv[n] = MS[(scan * 64 + hf * 16 + n) * 32 + 1]; dc[n] = (EXPC == 2) ? (u32x2){0u, 0u} : *(const u32x2*)(CT + (size_t)(scan * 64 + hf * 16 + n) * 8192 + e); dn[n] = nvw ? NV[(size_t)(scan * 64 + hf * 16 + n) * 64 + tid] : 0.f; }
#pragma unroll
        for (int n = 0; n < 16; ++n) { const int unit = scan * 64 + hf * 16 + n;
            const float bl = blv[n], ml = mlv[n];
            u32x2 w; w.x = pk2(c0, c1); w.y = pk2(c2, c3); *(u32x2*)(CT2 + (size_t)unit * 8192 + e) = w;
            if (nvw) NV2[(size_t)unit * 64 + tid] = nn;
            if (part == 0 && tid == 0) MS[65536 + unit] = m;
            const float mn = fmaxf(bl + m, ml), a = __expf(bl + m - mn), bb = __expf(ml - mn);
            c0 = a * c0 + bb * bflo(dc[n].x); c1 = a * c1 + bb * bfhi(dc[n].x); c2 = a * c2 + bb * bflo(dc[n].y); c3 = a * c3 + bb * bfhi(dc[n].y);
            nn = a * nn + bb * dn[n]; m = mn; }
        }
    }
}
__device__ __forceinline__ void mlstm_c(LDSp lds, const Params& p) {
    const bf16_t* Z = (const bf16_t*)(p.ws + WS_Z); const float* LI = (const float*)(p.ws + WS_BETA); const float* LF = (const float*)(p.ws + WS_LA);
    const bf16_t* CT = (const bf16_t*)(p.ws + WS_CT2); const float* NV = (const float*)(p.ws + WS_NV2); const float* MS = (const float*)(p.ws + WS_MS);
    bf16_t* Y = (bf16_t*)(p.ws + WS_HN); const float* gn = p.in[19];
    LAS unsigned short* Qb = (LAS unsigned short*)lds;
    LAS unsigned short* Kb = (LAS unsigned short*)(lds + 9216);
    LAS unsigned short* Vr = (LAS unsigned short*)(lds + 18432);
    LAS float* ssp = (LAS float*)(lds + 100352);
#define MC_CB(d) ((LAS unsigned short*)(lds + 36864 + (d) * 18432))
#define MC_PB(d) ((LAS unsigned short*)(lds + 73728 + (d) * 9216))
#define MC_SC(d) ((LAS float*)(lds + 92160 + (d) * 4096))
    const int tid = threadIdx.x, wid = tid >> 6;
    for (int unit = blockIdx.x; unit < 1024; unit += gridDim.x) {
        int lane = tid & 63; asm volatile("" : "+v"(lane));
        const int r = lane & 15, q = lane >> 4;
        const int b = unit >> 8, h = (unit >> 6) & 3, pc = unit & 63; const size_t tok0 = (size_t)b * S_ + pc * 64;
        const size_t ua = (size_t)(((0 * 4 + b) * 4 + h) * 64 + pc), ub = (size_t)(((1 * 4 + b) * 4 + h) * 64 + (63 - pc));
        { const int pp = tid >> 3, c8 = tid & 7;
          *(LAS u32x4*)(Qb + pp * 72 + c8 * 8) = *(const u32x4*)(Z + (tok0 + pp) * 2560 + 1024 + h * 64 + c8 * 8);
          *(LAS u32x4*)(Kb + pp * 72 + c8 * 8) = *(const u32x4*)(Z + (tok0 + pp) * 2560 + 1280 + h * 64 + c8 * 8); }
#pragma unroll
        for (int i = 0; i < 2; ++i) { const int pi = tid + NTHR * i, pp = pi >> 4, c8 = pi & 15; *(LAS u32x4*)(Vr + pp * 144 + c8 * 8) = *(const u32x4*)(Z + (tok0 + pp) * 2560 + 1536 + h * 128 + c8 * 8); }
#pragma unroll
        for (int i = 0; i < 2; ++i) { const int pi = tid + NTHR * i, v = pi >> 3, c8 = pi & 7;
            *(LAS u32x4*)(MC_CB(0) + v * 72 + c8 * 8) = *(const u32x4*)(CT + ua * 8192 + v * 64 + c8 * 8); *(LAS u32x4*)(MC_CB(1) + v * 72 + c8 * 8) = *(const u32x4*)(CT + ub * 8192 + v * 64 + c8 * 8); }
        float mst = 0.f;
        if (tid < 128) { const int d = tid >> 6; const size_t ud = d ? ub : ua; LAS float* sc = MC_SC(d);
            sc[lane] = LF[(tok0 + lane) * 8 + d * 4 + h]; sc[64 + lane] = LI[(tok0 + lane) * 8 + d * 4 + h]; sc[384 + lane] = NV[ud * 64 + lane]; mst = MS[65536 + ud]; }
        __syncthreads();
        bf16x8_t vb0, vb1; tr_frag2((unsigned)(unsigned long long)Vr, 288, wid, vb0, vb1);
        {
            const int t = tid >> 3, part = tid & 7; const u32x4 qv = *(const LAS u32x4*)(Qb + t * 72 + part * 8); float f[8]; unpack8(qv, f);
#pragma unroll
            for (int d = 0; d < 2; ++d) { LAS float* sc = MC_SC(d);
                const f32x4 n0 = *(const LAS f32x4*)(sc + 384 + part * 8), n1 = *(const LAS f32x4*)(sc + 384 + part * 8 + 4);
                float a = f[0] * n0.x; a = fmaf(f[1], n0.y, a); a = fmaf(f[2], n0.z, a); a = fmaf(f[3], n0.w, a); a = fmaf(f[4], n1.x, a); a = fmaf(f[5], n1.y, a); a = fmaf(f[6], n1.z, a); a = fmaf(f[7], n1.w, a);
                a += dppf<0xB1>(a); a += dppf<0x4E>(a); a += dppf<0x141>(a);
                if (part == 0) sc[320 + t] = a; } }
        if (tid < 128) {
            const int d = tid >> 6; LAS float* sc = MC_SC(d);
            const float bt = wave_scan_sum(sc[lane], d == 0);
            const float dmax = bt + wave_scan_max(sc[64 + lane] - bt, d == 0);
            const float m = fmaxf(bt + mst, dmax), w = __expf(bt + mst - m);
            sc[128 + lane] = bt; sc[192 + lane] = m; sc[256 + lane] = w * 0.125f; sc[448 + lane] = __expf(-m); }
        __syncthreads();
#pragma unroll 1
        for (int tt = 0; tt < 2; ++tt) { const int idx = wid * 2 + tt, mt = idx >> 2, nt = idx & 3;
            f32x4 scv = {0.f, 0.f, 0.f, 0.f};
            scv = mma_tile<64>(Qb + mt * 16 * 72, 72, Kb + nt * 16 * 72, 72, scv);
            const int s_ = nt * 16 + r;
#pragma unroll 1
            for (int d = 0; d < 2; ++d) { LAS float* sc = MC_SC(d); LAS unsigned short* Pb = MC_PB(d); const float bs = sc[128 + s_] - sc[64 + s_];
#pragma unroll
                for (int i = 0; i < 4; ++i) { const int t = mt * 16 + q * 4 + i; const bool ok = d ? (s_ >= t) : (s_ <= t);
                    const float pv = ok ? __expf(sc[128 + t] - bs - sc[192 + t]) * scv[i] * 0.125f : 0.f;
                    const unsigned short pb = f2bf(pv); Pb[t * 72 + s_] = pb;
                    const float rs = row16_sum(bf2f(pb));
                    if (r == 0) sc[512 + nt * 64 + t] = rs; } }
        }
        __syncthreads();
        f32x4 hacc[4];
#pragma unroll
        for (int mt = 0; mt < 4; ++mt) { hacc[mt] = (f32x4){0.f, 0.f, 0.f, 0.f};
            const bf16x8_t qa0 = *(const LAS bf16x8_t*)(Qb + (mt * 16 + r) * 72 + q * 8), qa1 = *(const LAS bf16x8_t*)(Qb + (mt * 16 + r) * 72 + 32 + q * 8);
#pragma unroll 1
            for (int d = 0; d < 2; ++d) { const LAS float* sc = MC_SC(d); const LAS unsigned short* Pb = MC_PB(d); const LAS unsigned short* Cb = MC_CB(d);
                f32x4 a1 = {0.f, 0.f, 0.f, 0.f}, a2 = {0.f, 0.f, 0.f, 0.f};
                const bf16x8_t cb0 = *(const LAS bf16x8_t*)(Cb + (wid * 16 + r) * 72 + q * 8), cb1 = *(const LAS bf16x8_t*)(Cb + (wid * 16 + r) * 72 + 32 + q * 8);
                a1 = __builtin_amdgcn_mfma_f32_16x16x32_bf16(qa0, cb0, a1, 0, 0, 0); a1 = __builtin_amdgcn_mfma_f32_16x16x32_bf16(qa1, cb1, a1, 0, 0, 0);
                const bf16x8_t pa0 = *(const LAS bf16x8_t*)(Pb + (mt * 16 + r) * 72 + q * 8), pa1 = *(const LAS bf16x8_t*)(Pb + (mt * 16 + r) * 72 + 32 + q * 8);
                a2 = __builtin_amdgcn_mfma_f32_16x16x32_bf16(pa0, vb0, a2, 0, 0, 0); a2 = __builtin_amdgcn_mfma_f32_16x16x32_bf16(pa1, vb1, a2, 0, 0, 0);
#pragma unroll
                for (int i = 0; i < 4; ++i) { const int t = mt * 16 + q * 4 + i;
                    const float den = sc[256 + t] * sc[320 + t] + ((sc[512 + t] + sc[576 + t]) + (sc[640 + t] + sc[704 + t]));
                    hacc[mt][i] += (sc[256 + t] * a1[i] + a2[i]) * __builtin_amdgcn_rcpf(fmaxf(fabsf(den), sc[448 + t])); }
            }
        }
#pragma unroll
        for (int mt = 0; mt < 4; ++mt)
#pragma unroll
            for (int i = 0; i < 4; ++i) { const float s = row16_sum(hacc[mt][i] * hacc[mt][i]); if (r == 0) ssp[wid * 64 + mt * 16 + q * 4 + i] = s; }
        __syncthreads();
        { const int v = wid * 16 + r; const float g = gn[v]; LAS unsigned short* Yt = MC_CB(0);
#pragma unroll
          for (int mt = 0; mt < 4; ++mt)
#pragma unroll
              for (int i = 0; i < 4; ++i) { const int t = mt * 16 + q * 4 + i;
                  float ss = 0.f;
#pragma unroll
                  for (int w = 0; w < 8; ++w) ss += ssp[w * 64 + t];
                  const float rstd = rsqrtf(ss * (1.0f / 128.0f) + 1e-6f);
                  Yt[t * 136 + v] = f2bf(hacc[mt][i] * rstd * g); } }
        __syncthreads();
#pragma unroll
        for (int i = 0; i < 2; ++i) { const int pi = tid + NTHR * i, t = pi >> 4, c8 = (pi & 15) * 8;
            const u32x4 yv = *(const LAS u32x4*)(MC_CB(0) + t * 136 + c8); const u32x4 ov = *(const u32x4*)(Z + (tok0 + t) * 2560 + 2048 + h * 128 + c8);
            float y[8], o[8]; unpack8(yv, y); unpack8(ov, o);
            u32x4 w; w.x = pk2(y[0] * sigm_f(o[0]), y[1] * sigm_f(o[1])); w.y = pk2(y[2] * sigm_f(o[2]), y[3] * sigm_f(o[3])); w.z = pk2(y[4] * sigm_f(o[4]), y[5] * sigm_f(o[5])); w.w = pk2(y[6] * sigm_f(o[6]), y[7] * sigm_f(o[7]));
            *(u32x4*)(Y + (tok0 + t) * 1024 + 512 + h * 128 + c8) = w; }
        __syncthreads();
    }
#undef MC_CB
#undef MC_PB
#undef MC_SC
}
__device__ __forceinline__ void headnorm_phase(const Params& p, const float* __restrict__ g, int zld, int zcol, int act) {
    const bf16_t* OF = (const bf16_t*)(p.ws + WS_OF); const bf16_t* OB = (const bf16_t*)(p.ws + WS_OB); const bf16_t* Z = (const bf16_t*)(p.ws + WS_Z); bf16_t* Y = (bf16_t*)(p.ws + WS_HN);
    const int tid = threadIdx.x, lane = tid & 63, wid = tid >> 6, c = lane * 8;
    const f32x4 g0 = *(const f32x4*)(g + (c & 127)), g1 = *(const f32x4*)(g + (c & 127) + 4);
    for (int tok = blockIdx.x * 8 + wid; tok < T_; tok += gridDim.x * 8) {
        const u32x4 a = *(const u32x4*)(OF + (size_t)tok * 512 + c), bq = *(const u32x4*)(OB + (size_t)tok * 512 + c), gz = *(const u32x4*)(Z + (size_t)tok * zld + zcol + c);
        float fa[8], fb[8], fg[8], o[8]; unpack8(a, fa); unpack8(bq, fb); unpack8(gz, fg);
        float ss = 0.f;
#pragma unroll
        for (int i = 0; i < 8; ++i) { o[i] = fa[i] + fb[i]; ss = fmaf(o[i], o[i], ss); }
        ss = row16_sum(ss);
        const float rstd = rsqrtf(ss * (1.0f / 128.0f) + 1e-6f);
        const float gg[8] = {g0.x, g0.y, g0.z, g0.w, g1.x, g1.y, g1.z, g1.w};
        float y[8];
#pragma unroll
        for (int i = 0; i < 8; ++i) y[i] = o[i] * rstd * gg[i] * (act == 0 ? fg[i] * sigm_f(fg[i]) : sigm_f(fg[i]));
        u32x4 w; w.x = pk2(y[0], y[1]); w.y = pk2(y[2], y[3]); w.z = pk2(y[4], y[5]); w.w = pk2(y[6], y[7]);
        *(u32x4*)(Y + (size_t)tok * 1024 + 512 + c) = w;
    }
}

__device__ __forceinline__ void odd_prep(const Params& p) {
    const bf16_t* Z = (const bf16_t*)(p.ws + WS_Z); bf16_t* VV = (bf16_t*)(p.ws + WS_QKV);
    const float* gates = (const float*)(p.ws + WS_GATES); float* LI = (float*)(p.ws + WS_BETA); float* LF = (float*)(p.ws + WS_LA);
    const float* ln_g = p.in[13]; const float* ln_b = p.in[14]; const float* ib = p.in[17]; const float* fb = p.in[18];
    const int tid = threadIdx.x, lane = tid & 63, wid = tid >> 6, c = lane * 8;
    const f32x4 g0 = *(const f32x4*)(ln_g + c), g1 = *(const f32x4*)(ln_g + c + 4), b0 = *(const f32x4*)(ln_b + c), b1 = *(const f32x4*)(ln_b + c + 4);
    const float gg[8] = {g0.x, g0.y, g0.z, g0.w, g1.x, g1.y, g1.z, g1.w}, bb[8] = {b0.x, b0.y, b0.z, b0.w, b1.x, b1.y, b1.z, b1.w};
    for (int tok = blockIdx.x * 8 + wid; tok < T_; tok += gridDim.x * 8) {
        const u32x4 v = *(const u32x4*)(Z + (size_t)tok * 2560 + 512 + c);
        float x[8]; unpack8(v, x); float sm = 0.f;
#pragma unroll
        for (int i = 0; i < 8; ++i) { x[i] = gelu_t(x[i]); sm += x[i]; }
        const float mean = wave_sum(sm) * (1.0f / 512.0f); float sq = 0.f;
#pragma unroll
        for (int i = 0; i < 8; ++i) { x[i] -= mean; sq = fmaf(x[i], x[i], sq); }
        const float rstd = rsqrtf(wave_sum(sq) * (1.0f / 512.0f) + 1e-5f);
        float y[8];
#pragma unroll
        for (int i = 0; i < 8; ++i) y[i] = x[i] * rstd * gg[i] + bb[i];
        u32x4 w; w.x = pk2(y[0], y[1]); w.y = pk2(y[2], y[3]); w.z = pk2(y[4], y[5]); w.w = pk2(y[6], y[7]);
        *(u32x4*)(VV + (size_t)tok * 512 + c) = w;
        if (lane < 8) { LI[(size_t)tok * 8 + lane] = gates[(size_t)tok * 16 + lane] + ib[lane];
                        LF[(size_t)tok * 8 + lane] = -softplus_(-(gates[(size_t)tok * 16 + 8 + lane] + fb[lane])); }
    }
}

__device__ __forceinline__ void sg_phase(LDSp lds, const Params& p, int sgId, int sgG) {
    typedef short bf16x8 __attribute__((ext_vector_type(8)));
    const bf16_t* Z = (const bf16_t*)(p.ws + WS_Z); const bf16_t* VV = (const bf16_t*)(p.ws + WS_QKV); bf16_t* Y = (bf16_t*)(p.ws + WS_HN);
    const float* sgw = p.in[15]; const float* sgb = p.in[16];
    LAS unsigned short* Wb = (LAS unsigned short*)lds;
    LAS unsigned short* Vt = (LAS unsigned short*)(lds + 34816);
    const int tid = threadIdx.x, lane = tid & 63, wid = tid >> 6;
    for (int unit = sgId; unit < 512; unit += sgG) {
        const int g = unit & 3, n = (unit >> 2) & 31, b = unit >> 7; const size_t tok0 = (size_t)b * S_ + n * 128;
#pragma unroll
        for (int i = 0; i < 8; ++i) { const int i4 = tid + NTHR * i, t = i4 >> 5, s4 = (i4 & 31) << 2; const f32x4 w = *(const f32x4*)(sgw + (size_t)g * 16384 + t * 128 + s4);
            u32x2 o; o.x = pk2(w.x, w.y); o.y = pk2(w.z, w.w); *(LAS u32x2*)(Wb + t * 136 + s4) = o; }
#pragma unroll
        for (int i = 0; i < 4; ++i) { const int pi = tid + NTHR * i, s = pi >> 4, c8 = (pi & 15) << 3; const u32x4 v = *(const u32x4*)(VV + (tok0 + s) * 512 + g * 128 + c8);
            Vt[(c8 + 0) * 136 + s] = (unsigned short)(v.x & 0xffffu); Vt[(c8 + 1) * 136 + s] = (unsigned short)(v.x >> 16);
            Vt[(c8 + 2) * 136 + s] = (unsigned short)(v.y & 0xffffu); Vt[(c8 + 3) * 136 + s] = (unsigned short)(v.y >> 16);
            Vt[(c8 + 4) * 136 + s] = (unsigned short)(v.z & 0xffffu); Vt[(c8 + 5) * 136 + s] = (unsigned short)(v.z >> 16);
            Vt[(c8 + 6) * 136 + s] = (unsigned short)(v.w & 0xffffu); Vt[(c8 + 7) * 136 + s] = (unsigned short)(v.w >> 16); }
        __syncthreads();
        bf16x8 af[4];
#pragma unroll
        for (int ks = 0; ks < 4; ++ks) af[ks] = *(const LAS bf16x8*)(Wb + (16 * wid + (lane & 15)) * 136 + ks * 32 + (lane >> 4) * 8);
        f32x4 accs[8];
#pragma unroll
        for (int nn = 0; nn < 8; ++nn) {
            f32x4 acc = {0.f, 0.f, 0.f, 0.f};
#pragma unroll
            for (int ks = 0; ks < 4; ++ks) { const bf16x8 bfrag = *(const LAS bf16x8*)(Vt + (16 * nn + (lane & 15)) * 136 + ks * 32 + (lane >> 4) * 8);
                acc = __builtin_amdgcn_mfma_f32_16x16x32_bf16(af[ks], bfrag, acc, 0, 0, 0); }
            accs[nn] = acc; }
        __syncthreads();
#pragma unroll
        for (int nn = 0; nn < 8; ++nn)
#pragma unroll
            for (int i = 0; i < 4; ++i) { const int t = 16 * wid + (lane >> 4) * 4 + i; Wb[t * 136 + 16 * nn + (lane & 15)] = f2bf(accs[nn][i] + sgb[g * 128 + t]); }
        __syncthreads();
#pragma unroll
        for (int i = 0; i < 4; ++i) { const int pi = tid + NTHR * i, t = pi >> 4, c8 = (pi & 15) << 3; const size_t tok = tok0 + t;
            const u32x4 mv = *(const LAS u32x4*)(Wb + t * 136 + c8); const u32x4 uv = *(const u32x4*)(Z + tok * 2560 + g * 128 + c8);
            float m[8], u[8]; unpack8(mv, m); unpack8(uv, u);
            u32x4 w; w.x = pk2(gelu_t(u[0]) * m[0], gelu_t(u[1]) * m[1]); w.y = pk2(gelu_t(u[2]) * m[2], gelu_t(u[3]) * m[3]); w.z = pk2(gelu_t(u[4]) * m[4], gelu_t(u[5]) * m[5]); w.w = pk2(gelu_t(u[6]) * m[6], gelu_t(u[7]) * m[7]);
            *(u32x4*)(Y + tok * 1024 + g * 128 + c8) = w; }
        __syncthreads();
    }
}

#define XB_TMO      128
#define XB_XCNT(j)  (256  + 64 * (j))
#define XB_XSUB(j)  (1280 + 64 * (j))
#define XB_XGEN(j)  (2304 + 64 * (j))
#define XB_TOP      3328
#define XB_TOPGEN   3392
#define XCD_BAR_WORDS 3456
#define XB_SPIN_CAP (1u << 18)

__device__ __forceinline__ unsigned xb_ld(unsigned* p)              { return __hip_atomic_load(p, __ATOMIC_RELAXED, __HIP_MEMORY_SCOPE_AGENT); }
__device__ __forceinline__ unsigned xb_add(unsigned* p, unsigned v) { return __hip_atomic_fetch_add(p, v, __ATOMIC_RELAXED, __HIP_MEMORY_SCOPE_AGENT); }
__device__ __forceinline__ unsigned xb_xcc_id() { return (unsigned)__builtin_amdgcn_s_getreg((3 << 11) | 20) & 0xFu; }
#define XB_SPIN(cond, bar) do { unsigned _sp = 0; while (cond) { __builtin_amdgcn_s_sleep(1); \
    if ((++_sp & 255u) == 0u) { if (xb_ld(&(bar)[XB_TMO])) break; if (_sp > XB_SPIN_CAP) { atomicAdd(&(bar)[XB_TMO], 1u); break; } } } } while (0)

struct XcdBarrier {
    unsigned* bar; unsigned x;
    volatile LAS unsigned* st;
};

__device__ __forceinline__ XcdBarrier xcd_barrier_post(unsigned* bar, volatile LAS unsigned* st) {
    XcdBarrier b; b.bar = bar; b.x = xb_xcc_id(); b.st = st;
    if (threadIdx.x == 0) (void)xb_add(&bar[XB_XCNT(b.x)], 1u);
    return b;
}
__device__ __forceinline__ void xcd_barrier_complete(unsigned* bar, unsigned x, unsigned& nloc, unsigned& nx) {
    const unsigned G = gridDim.x * gridDim.y * gridDim.z;
    unsigned sum, cnt, mine, sp = 0u;
    for (;;) {
        sum = 0u; cnt = 0u; mine = 0u;
#pragma unroll
        for (unsigned j = 0; j < 16; ++j) { const unsigned c = xb_ld(&bar[XB_XCNT(j)]); sum += c; cnt += (c > 0u) ? 1u : 0u; mine = (j == x) ? c : mine; }
        if (sum == G) break;
        __builtin_amdgcn_s_sleep(1);
        if ((++sp & 255u) == 0u) { if (xb_ld(&bar[XB_TMO])) break; if (sp > XB_SPIN_CAP) { atomicAdd(&bar[XB_TMO], 1u); break; } }
    }
    nloc = mine > 0u ? mine : 1u; nx = cnt > 0u ? cnt : 1u;
}

__device__ __forceinline__ void xcd_barrier(const XcdBarrier& b) {
    asm volatile("s_waitcnt vmcnt(0)" ::: "memory");
    __syncthreads();
    if (threadIdx.x == 0) {
        unsigned* bar = b.bar;
        __builtin_amdgcn_s_waitcnt(0);
        unsigned nloc = b.st[0], nx = b.st[1];
        if (nloc == 0u) { xcd_barrier_complete(bar, b.x, nloc, nx); b.st[0] = nloc; b.st[1] = nx; }
        const unsigned old = xb_add(&bar[XB_XSUB(b.x)], 1u);
        const unsigned gen = old / nloc;
        if (old + 1u == (gen + 1u) * nloc) {
            __builtin_amdgcn_fence(__ATOMIC_RELEASE, "agent");
            asm volatile("s_waitcnt vmcnt(0)" ::: "memory");
            const unsigned og = xb_add(&bar[XB_TOP], 1u);
            const unsigned tg = og / nx;
            if (og + 1u == (tg + 1u) * nx) xb_add(&bar[XB_TOPGEN], 1u);
            else XB_SPIN(xb_ld(&bar[XB_TOPGEN]) == tg, bar);
            __builtin_amdgcn_fence(__ATOMIC_ACQUIRE, "agent");
            xb_add(&bar[XB_XGEN(b.x)], 1u);
            asm volatile("s_waitcnt vmcnt(0)" ::: "memory");
        } else {
            XB_SPIN(xb_ld(&bar[XB_XGEN(b.x)]) == gen, bar);
            __builtin_amdgcn_fence(__ATOMIC_ACQUIRE, "agent");
            asm volatile("s_waitcnt vmcnt(0)" ::: "memory");
        }
    }
    __syncthreads();
}
constexpr size_t WS_BAR = 238 * MiB;
#ifndef N_PHASES
#define N_PHASES 21
#endif
template <int L, int SUB> __device__ __forceinline__ void run_phase(LDSp lds, const Params& p) {
    unsigned char* ws = p.ws;
    bf16_t* HN = (bf16_t*)(ws + WS_HN); bf16_t* Zb = (bf16_t*)(ws + WS_Z); float* h = p.out; float* gates = (float*)(ws + WS_GATES);
    const bf16_t* W_IN = (const bf16_t*)(ws + WS_WB + WB_IN); const bf16_t* W_OUT = (const bf16_t*)(ws + WS_WB + WB_OUT);
    const bf16_t* W_UP = (const bf16_t*)(ws + WS_WB + WB_UP); const bf16_t* W_DN = (const bf16_t*)(ws + WS_WB + WB_DN);
    const int G = gridDim.x;
    if constexpr (L == 2) { rms_phase(lds, h, p.in[25], nullptr, nullptr, h, nullptr, 0, 0, nullptr); }
    else if constexpr (SUB == 0) {
        convert_layer(lds, p, L);
        if constexpr (L == 0) rms_phase(lds, p.in[0], p.in[1], HN, nullptr, nullptr, p.in[2], 3088, 3072, gates);
        else                  rms_phase(lds, h, p.in[1] + 1024, HN, nullptr, nullptr, p.in[12], 2576, 2560, gates);
    } else if constexpr (SUB == 1) { constexpr int N = L == 0 ? 3072 : 2560;
        pg8::Gemm g{HN, W_IN, T_, N, 1024}; pg8::StaticOrder S; S.init(T_, N, G, (int)blockIdx.x);
        if constexpr (L == 0) { pg8::EpiInEven E{Zb, N}; pg8::gemm_phase_sp2<pg8::EpiInEven, pg8::StaticOrder, true, true>(lds, g, S, E); }
        else { pg8::EpiBf16<0> E{Zb, N, nullptr, 0, 0};
        pg8::gemm_phase_sp2<pg8::EpiBf16<0>, pg8::StaticOrder, true, true>(lds, g, S, E); }
    } else if constexpr (SUB == 2) { if constexpr (L == 0) even_prep(lds, p); else odd_prep(p); }
    else if constexpr (SUB == 9) { delta_prep(lds, p); }
    else if constexpr (SUB == 10) { mlstm_b(p); }
    else if constexpr (SUB == 11) { mlstm_c(lds, p); }
    else if constexpr (SUB == 3) {
        if constexpr (L == 0) delta_scan2(lds, p);
        else { mlstm_a(lds, p); sg_phase(lds, p, (int)blockIdx.x, G); }
    } else if constexpr (SUB == 4) { if constexpr (L == 0) headnorm_phase(p, p.in[10], 3072, 2560, 0); else headnorm_phase(p, p.in[19], 2560, 2048, 1); }
    else if constexpr (SUB == 5) { pg8::Gemm g{HN, W_OUT, T_, 1024, 1024}; pg8::StaticOrder S; S.init(T_, 1024, G, (int)blockIdx.x);
        pg8::EpiAddF32 E{h, 1024, L == 0 ? p.in[0] : (const float*)h};
        pg8::gemm_phase_sp2<pg8::EpiAddF32, pg8::StaticOrder, false, true>(lds, g, S, E);
    } else if constexpr (SUB == 6) { rms_phase(lds, h, p.in[21] + L * 1024, HN, nullptr, nullptr, nullptr, 0, 0, nullptr); }
    else if constexpr (SUB == 7) { pg8::Gemm g{HN, W_UP, T_, 2 * DFF, 1024}; pg8::StaticOrder S; S.init(T_, 2 * DFF, G, (int)blockIdx.x);
        pg8::EpiSwiGLU E{Zb, DFF};
        pg8::gemm_phase_sp2<pg8::EpiSwiGLU, pg8::StaticOrder, true, true>(lds, g, S, E);
    } else if constexpr (SUB == 8) { pg8::Gemm g{Zb, W_DN, T_, 1024, DFF}; pg8::StaticOrder S; S.init(T_, 1024, G, (int)blockIdx.x);
        pg8::EpiAddF32 E{h, 1024, (const float*)h};
        pg8::gemm_phase_sp2<pg8::EpiAddF32, pg8::StaticOrder, false, true>(lds, g, S, E);
    }
}
__global__ void __launch_bounds__(NTHR, 2) mega(Params p, int ph_lo, int ph_hi) {
    extern __shared__ __attribute__((aligned(16))) unsigned char lds_raw[];
    LDSp lds = (LDSp)lds_raw;
    cg::grid_group grid = cg::this_grid();
    volatile LAS unsigned* xst = (volatile LAS unsigned*)(lds + LDS_BYTES - 16);
    if (threadIdx.x == 0) { xst[0] = 0u; xst[1] = 0u; }
    __syncthreads();
    XcdBarrier xbar; xbar.bar = (unsigned*)(p.ws + WS_BAR); xbar.x = 0; xbar.st = xst;
    if (ph_hi - ph_lo > 1) xbar = xcd_barrier_post((unsigned*)(p.ws + WS_BAR), xst);
#ifndef REP_MASK
#define REP_MASK 0
#endif
#define PH(k, L, SUB) if (ph_lo <= (k) && (k) < ph_hi) { run_phase<L, SUB>(lds, p); if ((REP_MASK >> (k)) & 1) { __syncthreads(); run_phase<L, SUB>(lds, p); } if ((k) + 1 < ph_hi) { if (ph_lo < 0) grid.sync(); else xcd_barrier(xbar); } }
    PH(0, 0, 0) PH(1, 0, 1) PH(2, 0, 2) PH(3, 0, 9) PH(4, 0, 3) PH(5, 0, 4) PH(6, 0, 5) PH(7, 0, 6) PH(8, 0, 7) PH(9, 0, 8)
    PH(10, 1, 0) PH(11, 1, 1) PH(12, 1, 2) PH(13, 1, 3) PH(14, 1, 10) PH(15, 1, 11)
    PH(16, 1, 5) PH(17, 1, 6) PH(18, 1, 7) PH(19, 1, 8)
    PH(20, 2, 0)
#ifdef EXTRA_SYNCS
    for (int i_ = 0; i_ < EXTRA_SYNCS; ++i_) grid.sync();
#endif
#undef PH
}

extern "C" void kernel_launch(void* const* d_in, const int* in_sizes, int n_in, void* d_out, int out_size, void* d_ws, size_t ws_size, hipStream_t stream) {
    static int grid = 0;
    if (grid == 0) {
        int dev = 0, cus = 0, per_cu = 0;
        (void)hipGetDevice(&dev);
        (void)hipDeviceGetAttribute(&cus, hipDeviceAttributeMultiprocessorCount, dev);
        (void)hipFuncSetAttribute((const void*)mega, hipFuncAttributeMaxDynamicSharedMemorySize, LDS_BYTES);
        if (hipOccupancyMaxActiveBlocksPerMultiprocessor(&per_cu, (const void*)mega, NTHR, LDS_BYTES) != hipSuccess || per_cu < 1) per_cu = 1;
        (void)hipGetLastError();
        if (cus <= 0) cus = 256;
        grid = cus * per_cu;
    }
    if (ws_size < 239 * MiB) { fprintf(stderr, "workspace too small: %zu\n", ws_size); return; }
    Params p{};
    for (int i = 0; i < 26; ++i) p.in[i] = (const float*)d_in[i];
    p.out = (float*)d_out; p.ws = (unsigned char*)d_ws;
#if defined(MULTI_LAUNCH)
    for (int ph = 0; ph < N_PHASES; ++ph) hipLaunchKernelGGL(mega, dim3(grid), dim3(NTHR), LDS_BYTES, stream, p, ph, ph + 1);
#else
    (void)hipMemsetAsync((char*)d_ws + WS_BAR, 0, XCD_BAR_WORDS * 4, stream);
    int lo = 0, hi = N_PHASES;
    void* args[] = {(void*)&p, (void*)&lo, (void*)&hi};
    hipError_t e = hipLaunchCooperativeKernel((const void*)mega, dim3(grid), dim3(NTHR), args, LDS_BYTES, stream);
    if (e != hipSuccess) fprintf(stderr, "cooperative launch failed: %s (grid %d)\n", hipGetErrorString(e), grid);
#endif
}
```

```cpp
#include <hip/hip_runtime.h>
#include <hip/hip_cooperative_groups.h>
#include <cstdio>
namespace cg = cooperative_groups;
namespace pg8 {
#define PG8_LAS __attribute__((address_space(3)))
typedef unsigned short bf16_t;
typedef short bf16x8 __attribute__((ext_vector_type(8)));
typedef float f32x4 __attribute__((ext_vector_type(4)));
typedef unsigned u32x4 __attribute__((ext_vector_type(4)));
constexpr int BM = 256, BK = 64, HALF = 128, HTB = HALF * BK * 2  , STAGE_BYTES = 8 * HTB, NXCD = 8, WGM = 8;

__host__ __device__ __forceinline__ int lds_byte(int r, int c) { const int st = (r >> 4) * 2 + (c >> 5), rr = r & 15, cc = c & 31, ob = rr * 64 + cc * 2; return st * 1024 + (ob ^ (((ob >> 9) & 1) << 5)); }
__host__ __device__ __forceinline__ void stage_rc(int b, int& R, int& C) { const int st = b / 1024, sb = b % 1024, swz = sb ^ (((sb >> 9) & 1) << 5); R = (st >> 1) * 16 + swz / 64; C = (st & 1) * 32 + (swz % 64) / 2; }
__host__ __device__ __forceinline__ int perm32(int rho) { const int n = rho >> 4, i = rho & 15; return 8 * (i >> 2) + 4 * n + (i & 3); }

struct Unit { int pm, pn; };
struct Gemm { const bf16_t* A; const bf16_t* Bt; int M, N, K; };

struct StaticOrder {
    int nM, nN, nwg, G, c;
    __host__ __device__ void init(int M, int N, int G_, int c_) { nM = M / BM; nN = N / BM; nwg = nM * nN; G = G_; c = c_; }
    __host__ __device__ bool next(int i, Unit& u) const {
        const long L = (long)i * G + c; if (L >= nwg) return false;
        int wgid = (int)L; { const int q = nwg / NXCD, r = nwg % NXCD, xcd = wgid % NXCD, off = wgid / NXCD; wgid = (xcd < r ? xcd * (q + 1) : r * (q + 1) + (xcd - r) * q) + off; }
        const int nig = WGM * nN, gid = wgid / nig, fm = gid * WGM, gsz = (nM - fm) < WGM ? (nM - fm) : WGM;
        u.pm = fm + ((wgid % nig) % gsz); u.pn = (wgid % nig) / gsz; return true;
    }
    __device__ __forceinline__ void a_ready(const Unit&) const {}
    __device__ __forceinline__ void done(const Unit&) const {}
};
__device__ __forceinline__ unsigned cvt_pk_bf16(float lo, float hi) { unsigned r; asm volatile("v_cvt_pk_bf16_f32 %0, %1, %2" : "=v"(r) : "v"(lo), "v"(hi)); return r; }
typedef float f32x2 __attribute__((ext_vector_type(2)));
__device__ __forceinline__ f32x2 gelu_pk(f32x2 v) {
    const f32x2 av = __builtin_elementwise_abs(v), d = av * 0.2316418882f + 1.0f;
    f32x2 t; t.x = __builtin_amdgcn_rcpf(d.x); t.y = __builtin_amdgcn_rcpf(d.y);
    f32x2 q = t * 0.5307027145f + (-0.7265760135f); q = q * t + 0.7107068705f; q = q * t + (-0.142248368f); q = q * t + 0.127414796f; q = q * t;
    const f32x2 s = (v * v) * (-0.72134752044f);
    f32x2 e; e.x = __builtin_amdgcn_exp2f(s.x); e.y = __builtin_amdgcn_exp2f(s.y);
    const f32x2 m = v * (q * e), r = v - m;
    f32x2 o; o.x = v.x < 0.f ? m.x : r.x; o.y = v.y < 0.f ? m.y : r.y; return o;
}
template <int ACT  > struct EpiBf16 {
    static constexpr bool PERM = true, AFTER_DRAIN = false;
    bf16_t* O; int ldc; const float* bias; int split_cols; size_t split_stride;
    __device__ __forceinline__ void operator()(const f32x4 (&acc)[2][2][4][2], const Unit& u, int wr, int wc, int fr, int fq) const {
        const int row0 = u.pm * BM + wr * 64 + fr; int colt = u.pn * BM; bf16_t* base = O;
        if (split_cols) { const int t = colt / split_cols; base += (size_t)t * split_stride; colt -= t * split_cols; }
        const int col0 = colt + wc * 32 + 8 * fq, bcol0 = u.pn * BM + wc * 32 + 8 * fq;
        f32x4 bv[2][2];
#pragma unroll
        for (int bj = 0; bj < 2; ++bj)
#pragma unroll
            for (int n = 0; n < 2; ++n) bv[bj][n] = bias ? *(const f32x4*)(bias + bcol0 + bj * HALF + 4 * n) : (f32x4){0.f, 0.f, 0.f, 0.f};
#pragma unroll
        for (int ai = 0; ai < 2; ++ai)
#pragma unroll
            for (int m = 0; m < 4; ++m) { bf16_t* rowp = base + (size_t)(row0 + ai * HALF + m * 16) * ldc + col0;
#pragma unroll
                for (int bj = 0; bj < 2; ++bj) { f32x4 v0 = acc[ai][bj][m][0] + bv[bj][0], v1 = acc[ai][bj][m][1] + bv[bj][1];
                    if (ACT == 1) { f32x2 a = gelu_pk((f32x2){v0[0], v0[1]}), b = gelu_pk((f32x2){v0[2], v0[3]}), c = gelu_pk((f32x2){v1[0], v1[1]}), d = gelu_pk((f32x2){v1[2], v1[3]});
                        v0 = (f32x4){a.x, a.y, b.x, b.y}; v1 = (f32x4){c.x, c.y, d.x, d.y}; }
                    if (ACT == 2) {
#pragma unroll
                        for (int j = 0; j < 4; ++j) { v0[j] = 0.5f * v0[j] * (1.0f + erff(v0[j] * 0.70710678f)); v1[j] = 0.5f * v1[j] * (1.0f + erff(v1[j] * 0.70710678f)); } }
                    u32x4 w; w.x = cvt_pk_bf16(v0[0], v0[1]); w.y = cvt_pk_bf16(v0[2], v0[3]); w.z = cvt_pk_bf16(v1[0], v1[1]); w.w = cvt_pk_bf16(v1[2], v1[3]);
                    *(u32x4*)(rowp + bj * HALF) = w; } }
    }
};
struct EpiAddF32 {
    static constexpr bool PERM = false, AFTER_DRAIN = false;
    float* C; int ldc; const float* R;
    __device__ __forceinline__ void operator()(const f32x4 (&acc)[2][2][4][2], const Unit& u, int wr, int wc, int fr, int fq) const {
        const int row0 = u.pm * BM + wr * 64 + fr, col0 = u.pn * BM + wc * 32 + 4 * fq;
#pragma unroll
        for (int ai = 0; ai < 2; ++ai)
#pragma unroll
            for (int m = 0; m < 4; ++m) { const size_t ro = (size_t)(row0 + ai * HALF + m * 16) * ldc + col0; float* rowp = C + ro; const float* srcp = R + ro;
#pragma unroll
                for (int bj = 0; bj < 2; ++bj)
#pragma unroll
                    for (int n = 0; n < 2; ++n) { const f32x4 o = *(const f32x4*)(srcp + bj * HALF + n * 16); *(f32x4*)(rowp + bj * HALF + n * 16) = o + acc[ai][bj][m][n]; } }
    }
};
struct EpiSwiGLU {
    static constexpr bool PERM = true, AFTER_DRAIN = false;
    bf16_t* H; int ldh;
    __device__ __forceinline__ void operator()(const f32x4 (&acc)[2][2][4][2], const Unit& u, int wr, int wc, int fr, int fq) const {
        const int row0 = u.pm * BM + wr * 64 + fr, hcol = u.pn * HALF + wc * 32 + 8 * fq;
#pragma unroll
        for (int ai = 0; ai < 2; ++ai)
#pragma unroll
            for (int m = 0; m < 4; ++m) { bf16_t* rowp = H + (size_t)(row0 + ai * HALF + m * 16) * ldh + hcol;
                float h[8];
#pragma unroll
                for (int n = 0; n < 2; ++n) { const f32x4 a = acc[ai][0][m][n], b = acc[ai][1][m][n];
#pragma unroll
                    for (int j = 0; j < 4; ++j) h[4 * n + j] = a[j] * __builtin_amdgcn_rcpf(1.0f + __expf(-a[j])) * b[j]; }
                u32x4 w; w.x = cvt_pk_bf16(h[0], h[1]); w.y = cvt_pk_bf16(h[2], h[3]); w.z = cvt_pk_bf16(h[4], h[5]); w.w = cvt_pk_bf16(h[6], h[7]);
                *(u32x4*)rowp = w; }
    }
};

struct EpiInEven {
    static constexpr bool PERM = true, AFTER_DRAIN = false;
    bf16_t* O; int ldc;
    __device__ __forceinline__ void operator()(const f32x4 (&acc)[2][2][4][2], const Unit& u, int wr, int wc, int fr, int fq) const {
        const int row0 = u.pm * BM + wr * 64 + fr;
        if (u.pn < 4) {
            const int hcol = u.pn * HALF + wc * 32 + 8 * fq;
#pragma unroll
            for (int ai = 0; ai < 2; ++ai)
#pragma unroll
                for (int m = 0; m < 4; ++m) { bf16_t* rowp = O + (size_t)(row0 + ai * HALF + m * 16) * ldc + hcol; float h[8];
#pragma unroll
                    for (int n = 0; n < 2; ++n) { const f32x4 a = acc[ai][0][m][n], g = acc[ai][1][m][n];
#pragma unroll
                        for (int j = 0; j < 4; ++j) h[4 * n + j] = a[j] * __builtin_amdgcn_rcpf(1.0f + __expf(-g[j])); }
                    u32x4 w; w.x = cvt_pk_bf16(h[0], h[1]); w.y = cvt_pk_bf16(h[2], h[3]); w.z = cvt_pk_bf16(h[4], h[5]); w.w = cvt_pk_bf16(h[6], h[7]);
                    *(u32x4*)rowp = w; }
        } else {
            const int col0 = u.pn * BM + wc * 32 + 8 * fq;
#pragma unroll
            for (int ai = 0; ai < 2; ++ai)
#pragma unroll
                for (int m = 0; m < 4; ++m) { bf16_t* rowp = O + (size_t)(row0 + ai * HALF + m * 16) * ldc + col0;
#pragma unroll
                    for (int bj = 0; bj < 2; ++bj) { const f32x4 v0 = acc[ai][bj][m][0], v1 = acc[ai][bj][m][1];
                        u32x4 w; w.x = cvt_pk_bf16(v0[0], v0[1]); w.y = cvt_pk_bf16(v0[2], v0[3]); w.z = cvt_pk_bf16(v1[0], v1[1]); w.w = cvt_pk_bf16(v1[2], v1[3]);
                        *(u32x4*)(rowp + bj * HALF) = w; } }
        }
    }
};
template <class Epi, class Sched, bool STAMP = false>
__device__ __forceinline__ void gemm_phase(PG8_LAS unsigned char* lds, const Gemm g, const Sched& S, const Epi& E, unsigned long long* stamps) {
    const int tid = threadIdx.x, wid = __builtin_amdgcn_readfirstlane(tid >> 6), lane = tid & 63, wr = wid >> 2, wc = wid & 3, fr = lane & 15, fq = lane >> 4;
    const int K = g.K, nt = K / BK;
    int ts_lo = 0, ts_hi = 0, nts = 0; const unsigned long long rt_entry = STAMP ? (unsigned long long)wall_clock64() : 0ull;
#define PG8_STAMP() do { if (STAMP && wid == 0 && nts < 64) { const unsigned long long _c = (unsigned long long)clock64(); \
        ts_lo = (lane == nts) ? (int)(unsigned)_c : ts_lo; ts_hi = (lane == nts) ? (int)(unsigned)(_c >> 32) : ts_hi; ++nts; } } while (0)
    PG8_STAMP();
    unsigned voffA[2], voffB[2];
#pragma unroll
    for (int i = 0; i < 2; ++i) { int R, C; stage_rc(tid * 16 + i * 8192, R, C); const int Rb = Epi::PERM ? ((R & ~31) + perm32(R & 31)) : R;
        voffA[i] = (unsigned)(R * K + C) * 2u; voffB[i] = (unsigned)(Rb * K + C) * 2u; }
    const size_t kstep = (size_t)(BK * 2);
    const size_t hstep = (size_t)HALF * K * 2;
    const size_t tstep = 2 * hstep;
    const unsigned ldsw = (unsigned)wid * 1024u;
    const int aoff = lds_byte(wr * 64 + fr, fq * 8), boff = lds_byte(wc * 32 + fr, fq * 8);
#define PG8_SA(b, h) (((b) * 2 + (h)) * HTB)
#define PG8_SB(b, h) ((4 + (b) * 2 + (h)) * HTB)
#define PG8_STAGE(bufoff, gbase, voff) do { _Pragma("unroll") for (int _i = 0; _i < 2; ++_i) \
        __builtin_amdgcn_global_load_lds((const unsigned*)((const char*)(gbase) + (voff)[_i]), (PG8_LAS unsigned*)(lds + (bufoff) + ldsw + _i * 8192), 16, 0, 0); } while (0)
#define PG8_LDA(dst, b, h) do { _Pragma("unroll") for (int m = 0; m < 4; ++m) _Pragma("unroll") for (int k = 0; k < 2; ++k) dst[m][k] = *(const PG8_LAS bf16x8*)(lds + PG8_SA(b, h) + aoff + m * 2048 + k * 1024); } while (0)
#define PG8_LDB(dst, b, h) do { _Pragma("unroll") for (int n = 0; n < 2; ++n) _Pragma("unroll") for (int k = 0; k < 2; ++k) dst[n][k] = *(const PG8_LAS bf16x8*)(lds + PG8_SB(b, h) + boff + n * 2048 + k * 1024); } while (0)
#define PG8_MMA(ai, bj, At, Bt) do { __builtin_amdgcn_s_setprio(1); _Pragma("unroll") for (int m = 0; m < 4; ++m) _Pragma("unroll") for (int n = 0; n < 2; ++n) _Pragma("unroll") for (int k = 0; k < 2; ++k) \
        acc[ai][bj][m][n] = __builtin_amdgcn_mfma_f32_16x16x32_bf16(Bt[n][k], At[m][k], acc[ai][bj][m][n], 0, 0, 0); __builtin_amdgcn_s_setprio(0); } while (0)
#define PG8_WAIT_V(n) asm volatile("s_waitcnt vmcnt(" #n ")" ::: "memory")
#define PG8_WAIT_L(n) asm volatile("s_waitcnt lgkmcnt(" #n ")" ::: "memory")
#define PG8_BAR __builtin_amdgcn_s_barrier()
#define PG8_SCHED __builtin_amdgcn_sched_barrier(0)
    Unit cur, nxt; int ui = 0;
    if (!S.next(0, cur)) return;
    f32x4 acc[2][2][4][2];
#pragma unroll
    for (int a = 0; a < 2; ++a)
#pragma unroll
        for (int b = 0; b < 2; ++b)
#pragma unroll
            for (int m = 0; m < 4; ++m)
#pragma unroll
                for (int n = 0; n < 2; ++n) acc[a][b][m][n] = (f32x4){0.f, 0.f, 0.f, 0.f};
    bf16x8 At[4][2], B0[2][2], B1[2][2];
    const char* cA = (const char*)g.A + (size_t)cur.pm * tstep; const char* cB = (const char*)g.Bt + (size_t)cur.pn * tstep;
    S.a_ready(cur);
    PG8_STAGE(PG8_SB(0, 0), cB, voffB); PG8_STAGE(PG8_SA(0, 0), cA, voffA); PG8_STAGE(PG8_SB(0, 1), cB + hstep, voffB); PG8_STAGE(PG8_SA(0, 1), cA + hstep, voffA);
    if (wr == 1) PG8_BAR;
    PG8_WAIT_V(4); PG8_BAR;
    PG8_STAGE(PG8_SB(1, 0), cB + kstep, voffB); PG8_STAGE(PG8_SA(1, 0), cA + kstep, voffA); PG8_STAGE(PG8_SB(1, 1), cB + hstep + kstep, voffB);
    PG8_WAIT_V(6); PG8_BAR;
    PG8_STAMP();
    for (;;) {
        const bool has_next = S.next(ui + 1, nxt);
        const char* nA = has_next ? (const char*)g.A + (size_t)nxt.pm * tstep : cA; const char* nB = has_next ? (const char*)g.Bt + (size_t)nxt.pn * tstep : cB;
        for (int t = 0; t < nt; t += 2) {
            const bool last = (t == nt - 2);
            const char* a1 = cA + (size_t)(t + 1) * kstep;
            const char* a2 = last ? nA : cA + (size_t)(t + 2) * kstep; const char* b2 = last ? nB : cB + (size_t)(t + 2) * kstep;
            const char* a3 = a2 + kstep; const char* b3 = b2 + kstep;
            if (last && has_next) S.a_ready(nxt);
            PG8_LDB(B0, 0, 0); PG8_SCHED; PG8_LDA(At, 0, 0); PG8_STAGE(PG8_SA(1, 1), a1 + hstep, voffA);
            PG8_WAIT_L(8); PG8_BAR; PG8_WAIT_L(0); PG8_MMA(0, 0, At, B0); PG8_BAR; PG8_SCHED;
            PG8_LDB(B1, 0, 1); PG8_STAGE(PG8_SB(0, 0), b2, voffB);
            PG8_BAR; PG8_WAIT_L(0); PG8_MMA(0, 1, At, B1); PG8_BAR;
            PG8_LDA(At, 0, 1); PG8_STAGE(PG8_SA(0, 0), a2, voffA);
            PG8_BAR; PG8_WAIT_L(0); PG8_MMA(1, 0, At, B0); PG8_BAR; PG8_SCHED;
            PG8_STAGE(PG8_SB(0, 1), b2 + hstep, voffB);
            PG8_WAIT_V(6); PG8_BAR; PG8_MMA(1, 1, At, B1); PG8_BAR;
            PG8_LDB(B0, 1, 0); PG8_SCHED; PG8_LDA(At, 1, 0); PG8_STAGE(PG8_SA(0, 1), a2 + hstep, voffA);
            PG8_WAIT_L(8); PG8_BAR; PG8_WAIT_L(0); PG8_MMA(0, 0, At, B0); PG8_BAR; PG8_SCHED;
            PG8_LDB(B1, 1, 1); PG8_STAGE(PG8_SB(1, 0), b3, voffB);
            PG8_BAR; PG8_WAIT_L(0); PG8_MMA(0, 1, At, B1); PG8_BAR;
            PG8_LDA(At, 1, 1); PG8_STAGE(PG8_SA(1, 0), a3, voffA);
            PG8_BAR; PG8_WAIT_L(0); PG8_MMA(1, 0, At, B0); PG8_BAR; PG8_SCHED;
            PG8_STAGE(PG8_SB(1, 1), b3 + hstep, voffB);
            PG8_WAIT_V(6); PG8_BAR; PG8_MMA(1, 1, At, B1); PG8_BAR;
        }
        PG8_STAMP();
        if constexpr (!Epi::AFTER_DRAIN) { E(acc, cur, wr, wc, fr, fq); S.done(cur); }
        PG8_STAMP();
        if (!has_next) break;
#pragma unroll
        for (int a = 0; a < 2; ++a)
#pragma unroll
            for (int b = 0; b < 2; ++b)
#pragma unroll
                for (int m = 0; m < 4; ++m)
#pragma unroll
                    for (int n = 0; n < 2; ++n) acc[a][b][m][n] = (f32x4){0.f, 0.f, 0.f, 0.f};
        cur = nxt; cA = nA; cB = nB; ++ui;
    }
    PG8_WAIT_V(0);
    if (wr == 0) PG8_BAR;
    PG8_BAR;
    if constexpr (Epi::AFTER_DRAIN) { E.fused(acc, cur, wr, wc, fr, fq, lds, wid, lane); S.done(cur); }
    PG8_STAMP();
    if (STAMP && wid == 0) { stamps[lane] = lane < nts ? (((unsigned long long)(unsigned)ts_hi << 32) | (unsigned)ts_lo) : 0ull;
        if (lane == 62) stamps[62] = rt_entry; if (lane == 63) stamps[63] = (unsigned long long)wall_clock64(); }
#undef PG8_STAMP
#undef PG8_SA
#undef PG8_SB
#undef PG8_STAGE
#undef PG8_LDA
#undef PG8_LDB
#undef PG8_MMA
#undef PG8_WAIT_V
#undef PG8_WAIT_L
#undef PG8_BAR
#undef PG8_SCHED
}
template <class Epi, class Sched, bool ALIGN_EPI = false, bool SP2 = false>
__device__ __forceinline__ void gemm_phase_sp2(PG8_LAS unsigned char* lds, const Gemm g, const Sched& S, const Epi& E) {
    const int tid = threadIdx.x, wid = __builtin_amdgcn_readfirstlane(tid >> 6), lane = tid & 63, wr = wid >> 2, wc = wid & 3, fr = lane & 15, fq = lane >> 4;
    const int K = g.K, nt = K / BK;
    unsigned voffA[2], voffB[2];
#pragma unroll
    for (int i = 0; i < 2; ++i) { int R, C; stage_rc(tid * 16 + i * 8192, R, C); const int Rb = Epi::PERM ? ((R & ~31) + perm32(R & 31)) : R;
        voffA[i] = (unsigned)(R * K + C) * 2u; voffB[i] = (unsigned)(Rb * K + C) * 2u; }
    const size_t kstep = (size_t)(BK * 2);
    const size_t hstep = (size_t)HALF * K * 2;
    const size_t tstep = 2 * hstep;
    const unsigned ldsw = (unsigned)wid * 1024u;
    const int aoff = lds_byte(wr * 64 + fr, fq * 8), boff = lds_byte(wc * 32 + fr, fq * 8);
#define PG8_SA(b, h) (((b) * 2 + (h)) * HTB)
#define PG8_SB(b, h) ((4 + (b) * 2 + (h)) * HTB)
#define PG8_STAGE(bufoff, gbase, voff) do { _Pragma("unroll") for (int _i = 0; _i < 2; ++_i) \
        __builtin_amdgcn_global_load_lds((const unsigned*)((const char*)(gbase) + (voff)[_i]), (PG8_LAS unsigned*)(lds + (bufoff) + ldsw + _i * 8192), 16, 0, 0); } while (0)
#define PG8_LDA(dst, b, h) do { _Pragma("unroll") for (int m = 0; m < 4; ++m) _Pragma("unroll") for (int k = 0; k < 2; ++k) dst[m][k] = *(const PG8_LAS bf16x8*)(lds + PG8_SA(b, h) + aoff + m * 2048 + k * 1024); } while (0)
#define PG8_LDB(dst, b, h) do { _Pragma("unroll") for (int n = 0; n < 2; ++n) _Pragma("unroll") for (int k = 0; k < 2; ++k) dst[n][k] = *(const PG8_LAS bf16x8*)(lds + PG8_SB(b, h) + boff + n * 2048 + k * 1024); } while (0)
#define PG8_MMA(ai, bj, At, Bt) do { __builtin_amdgcn_s_setprio(1); _Pragma("unroll") for (int m = 0; m < 4; ++m) _Pragma("unroll") for (int n = 0; n < 2; ++n) _Pragma("unroll") for (int k = 0; k < 2; ++k) \
        acc[ai][bj][m][n] = __builtin_amdgcn_mfma_f32_16x16x32_bf16(Bt[n][k], At[m][k], acc[ai][bj][m][n], 0, 0, 0); __builtin_amdgcn_s_setprio(0); } while (0)
#define PG8_WAIT_V(n) asm volatile("s_waitcnt vmcnt(" #n ")" ::: "memory")
#define PG8_WAIT_L(n) asm volatile("s_waitcnt lgkmcnt(" #n ")" ::: "memory")
#define PG8_BAR __builtin_amdgcn_s_barrier()
#define PG8_SCHED __builtin_amdgcn_sched_barrier(0)
    Unit cur, nxt; int ui = 0;
    if (!S.next(0, cur)) return;
    f32x4 acc[2][2][4][2];
#pragma unroll
    for (int a = 0; a < 2; ++a)
#pragma unroll
        for (int b = 0; b < 2; ++b)
#pragma unroll
            for (int m = 0; m < 4; ++m)
#pragma unroll
                for (int n = 0; n < 2; ++n) acc[a][b][m][n] = (f32x4){0.f, 0.f, 0.f, 0.f};
    bf16x8 At[4][2], B0[2][2], B1[2][2];
    const char* cA = (const char*)g.A + (size_t)cur.pm * tstep; const char* cB = (const char*)g.Bt + (size_t)cur.pn * tstep;
    S.a_ready(cur);
    if constexpr (SP2) {
        PG8_STAGE(PG8_SB(0, 0), cB, voffB); PG8_STAGE(PG8_SB(0, 1), cB + hstep, voffB); PG8_STAGE(PG8_SA(0, 0), cA, voffA); PG8_STAGE(PG8_SA(0, 1), cA + hstep, voffA);
        if (wr == 1) PG8_BAR;
        PG8_WAIT_V(2); PG8_BAR;
        PG8_STAGE(PG8_SB(1, 0), cB + kstep, voffB); PG8_STAGE(PG8_SA(1, 0), cA + kstep, voffA); PG8_STAGE(PG8_SB(1, 1), cB + hstep + kstep, voffB);
        PG8_WAIT_V(6); PG8_BAR;
    } else {
        PG8_STAGE(PG8_SB(0, 0), cB, voffB); PG8_STAGE(PG8_SA(0, 0), cA, voffA); PG8_STAGE(PG8_SB(0, 1), cB + hstep, voffB); PG8_STAGE(PG8_SA(0, 1), cA + hstep, voffA);
        if (wr == 1) PG8_BAR;
        PG8_WAIT_V(4); PG8_BAR;
        PG8_STAGE(PG8_SB(1, 0), cB + kstep, voffB); PG8_STAGE(PG8_SA(1, 0), cA + kstep, voffA); PG8_STAGE(PG8_SB(1, 1), cB + hstep + kstep, voffB);
        PG8_WAIT_V(6); PG8_BAR;
    }
    for (;;) {
        const bool has_next = S.next(ui + 1, nxt);
        const char* nA = has_next ? (const char*)g.A + (size_t)nxt.pm * tstep : cA; const char* nB = has_next ? (const char*)g.Bt + (size_t)nxt.pn * tstep : cB;
        for (int t = 0; t < nt; t += 2) {
            const bool last = (t == nt - 2);
            const char* a1 = cA + (size_t)(t + 1) * kstep;
            const char* a2 = last ? nA : cA + (size_t)(t + 2) * kstep; const char* b2 = last ? nB : cB + (size_t)(t + 2) * kstep;
            const char* a3 = a2 + kstep; const char* b3 = b2 + kstep;
            if (last && has_next) S.a_ready(nxt);
            if constexpr (SP2) {
            PG8_LDB(B0, 0, 0); PG8_LDB(B1, 0, 1); PG8_SCHED; PG8_LDA(At, 0, 0); PG8_STAGE(PG8_SA(1, 1), a1 + hstep, voffA);
            PG8_WAIT_V(8); PG8_WAIT_L(0); PG8_BAR; PG8_MMA(0, 0, At, B0); PG8_MMA(0, 1, At, B1); PG8_BAR; PG8_SCHED;
            PG8_LDA(At, 0, 1); PG8_STAGE(PG8_SB(0, 0), b2, voffB); PG8_STAGE(PG8_SB(0, 1), b2 + hstep, voffB); PG8_STAGE(PG8_SA(0, 0), a2, voffA);
            PG8_WAIT_V(8); PG8_WAIT_L(0); PG8_BAR; PG8_MMA(1, 0, At, B0); PG8_MMA(1, 1, At, B1); PG8_BAR; PG8_SCHED;
            PG8_LDB(B0, 1, 0); PG8_LDB(B1, 1, 1); PG8_SCHED; PG8_LDA(At, 1, 0); PG8_STAGE(PG8_SA(0, 1), a2 + hstep, voffA);
            PG8_WAIT_V(8); PG8_WAIT_L(0); PG8_BAR; PG8_MMA(0, 0, At, B0); PG8_MMA(0, 1, At, B1); PG8_BAR; PG8_SCHED;
            PG8_LDA(At, 1, 1); PG8_STAGE(PG8_SB(1, 0), b3, voffB); PG8_STAGE(PG8_SB(1, 1), b3 + hstep, voffB); PG8_STAGE(PG8_SA(1, 0), a3, voffA);
            PG8_WAIT_V(8); PG8_WAIT_L(0); PG8_BAR; PG8_MMA(1, 0, At, B0); PG8_MMA(1, 1, At, B1); PG8_BAR; PG8_SCHED;
            } else {
            PG8_LDB(B0, 0, 0); PG8_SCHED; PG8_LDA(At, 0, 0); PG8_STAGE(PG8_SA(1, 1), a1 + hstep, voffA);
            PG8_WAIT_L(8); PG8_BAR; PG8_WAIT_L(0); PG8_MMA(0, 0, At, B0); PG8_BAR; PG8_SCHED;
            PG8_LDB(B1, 0, 1); PG8_STAGE(PG8_SB(0, 0), b2, voffB);
            PG8_BAR; PG8_WAIT_L(0); PG8_MMA(0, 1, At, B1); PG8_BAR;
            PG8_LDA(At, 0, 1); PG8_STAGE(PG8_SA(0, 0), a2, voffA);
            PG8_BAR; PG8_WAIT_L(0); PG8_MMA(1, 0, At, B0); PG8_BAR; PG8_SCHED;
            PG8_STAGE(PG8_SB(0, 1), b2 + hstep, voffB);
            PG8_WAIT_V(6); PG8_BAR; PG8_MMA(1, 1, At, B1); PG8_BAR;
            PG8_LDB(B0, 1, 0); PG8_SCHED; PG8_LDA(At, 1, 0); PG8_STAGE(PG8_SA(0, 1), a2 + hstep, voffA);
            PG8_WAIT_L(8); PG8_BAR; PG8_WAIT_L(0); PG8_MMA(0, 0, At, B0); PG8_BAR; PG8_SCHED;
            PG8_LDB(B1, 1, 1); PG8_STAGE(PG8_SB(1, 0), b3, voffB);
            PG8_BAR; PG8_WAIT_L(0); PG8_MMA(0, 1, At, B1); PG8_BAR;
            PG8_LDA(At, 1, 1); PG8_STAGE(PG8_SA(1, 0), a3, voffA);
            PG8_BAR; PG8_WAIT_L(0); PG8_MMA(1, 0, At, B0); PG8_BAR; PG8_SCHED;
            PG8_STAGE(PG8_SB(1, 1), b3 + hstep, voffB);
            PG8_WAIT_V(6); PG8_BAR; PG8_MMA(1, 1, At, B1); PG8_BAR;
            }
        }
        if constexpr (ALIGN_EPI) { if (wr == 0) PG8_BAR; }
        if constexpr (!Epi::AFTER_DRAIN) { E(acc, cur, wr, wc, fr, fq); S.done(cur); }
        if (!has_next) break;
#pragma unroll
        for (int a = 0; a < 2; ++a)
#pragma unroll
            for (int b = 0; b < 2; ++b)
#pragma unroll
                for (int m = 0; m < 4; ++m)
#pragma unroll
                    for (int n = 0; n < 2; ++n) acc[a][b][m][n] = (f32x4){0.f, 0.f, 0.f, 0.f};
        cur = nxt; cA = nA; cB = nB; ++ui;
        if constexpr (ALIGN_EPI) { if (wr == 1) PG8_BAR; }
    }
    PG8_WAIT_V(0);
    if constexpr (!ALIGN_EPI) { if (wr == 0) PG8_BAR; }
    PG8_BAR;
    if constexpr (Epi::AFTER_DRAIN) { E.fused(acc, cur, wr, wc, fr, fq, lds, wid, lane); S.done(cur); }
#undef PG8_SA
#undef PG8_SB
#undef PG8_STAGE
#undef PG8_LDA
#undef PG8_LDB
#undef PG8_MMA
#undef PG8_WAIT_V
#undef PG8_WAIT_L
#undef PG8_BAR
#undef PG8_SCHED
}
}
#define LAS __attribute__((address_space(3)))
typedef LAS unsigned char* LDSp;
typedef pg8::bf16_t bf16_t;
typedef unsigned u32x4 __attribute__((ext_vector_type(4)));
typedef unsigned u32x2 __attribute__((ext_vector_type(2)));
typedef float f32x4 __attribute__((ext_vector_type(4)));
typedef float f32x2 __attribute__((ext_vector_type(2)));

#ifndef EXPC
#define EXPC 0
#endif
#ifndef EVP_SKIP
#define EVP_SKIP 0
#endif
constexpr int T_ = 16384, D_ = 1024, S_ = 4096, NTHR = 512;
constexpr int LDS_BYTES = 147456;
constexpr size_t MiB = 1048576;
constexpr size_t WS_WB = 0, WS_HN = 25 * MiB, WS_Z = 57 * MiB, WS_QKV = 153 * MiB, WS_OF = 201 * MiB, WS_OB = 217 * MiB,
                 WS_GATES = 233 * MiB, WS_BETA = 234 * MiB, WS_LA = 234 * MiB + 524288;
constexpr size_t WB_IN = 0, WB_OUT = 6291456, WB_UP = 8388608, WB_DN = 19922944;
constexpr int DFF = 2816;

struct Params { const float* in[26]; float* out; unsigned char* ws; };

__device__ __forceinline__ float bf2f(unsigned short b) { return __uint_as_float(((unsigned)b) << 16); }
__device__ __forceinline__ float bflo(unsigned u) { return __uint_as_float(u << 16); }
__device__ __forceinline__ float bfhi(unsigned u) { return __uint_as_float(u & 0xffff0000u); }
__device__ __forceinline__ unsigned short f2bf(float f) { return __builtin_bit_cast(unsigned short, (__bf16)f); }
typedef __bf16 bf16x2_v __attribute__((ext_vector_type(2)));
__device__ __forceinline__ unsigned pk2(float lo, float hi) { const f32x2 v = {lo, hi}; const bf16x2_v b = __builtin_convertvector(v, bf16x2_v); return __builtin_bit_cast(unsigned, b); }
__device__ __forceinline__ float sigm(float x) { return __builtin_amdgcn_rcpf(1.0f + __expf(-x)); }
__device__ __forceinline__ float sigm_f(float x) { return __builtin_amdgcn_rcpf(1.0f + __expf(-x)); }
__device__ __forceinline__ float silu_(float x) { return x * sigm(x); }
__device__ __forceinline__ float gelu_t(float x) { const float u = 0.7978845608028654f * (x + 0.044715f * x * x * x); const float t = 1.0f - 2.0f * __builtin_amdgcn_rcpf(1.0f + __expf(2.0f * u)); return 0.5f * x * (1.0f + t); }
__device__ __forceinline__ float softplus_(float x) { return x > 20.0f ? x : log1pf(expf(x)); }
__device__ __forceinline__ float wave_sum(float v) {
#pragma unroll
    for (int o = 32; o; o >>= 1) v += __shfl_xor(v, o);
    return v; }
template <int CTRL> __device__ __forceinline__ float dppf(float v) { return __int_as_float(__builtin_amdgcn_update_dpp(0, __float_as_int(v), CTRL, 0xf, 0xf, true)); }
__device__ __forceinline__ float row16_sum(float v) { v += dppf<0xB1>(v); v += dppf<0x4E>(v); v += dppf<0x141>(v); v += dppf<0x140>(v); return v; }
__device__ __forceinline__ void unpack8(const u32x4 w, float (&f)[8]) { f[0] = bflo(w.x); f[1] = bfhi(w.x); f[2] = bflo(w.y); f[3] = bfhi(w.y); f[4] = bflo(w.z); f[5] = bfhi(w.z); f[6] = bflo(w.w); f[7] = bfhi(w.w); }


__device__ __forceinline__ float wave_scan_sum(float x, bool fwd) {
    const int lane = threadIdx.x & 63;
#pragma unroll
    for (int o = 1; o < 64; o <<= 1) { const float y = fwd ? __shfl_up(x, o) : __shfl_down(x, o); if (fwd ? (lane >= o) : (lane + o < 64)) x += y; }
    return x; }
__device__ __forceinline__ float wave_scan_max(float x, bool fwd) {
    const int lane = threadIdx.x & 63;
#pragma unroll
    for (int o = 1; o < 64; o <<= 1) { const float y = fwd ? __shfl_up(x, o) : __shfl_down(x, o); if (fwd ? (lane >= o) : (lane + o < 64)) x = fmaxf(x, y); }
    return x; }
__device__ __forceinline__ void conv_job(LDSp lds, const float* __restrict__ src, int ldn, int K, int col0, int ncols, bf16_t* __restrict__ dst, int mode, int off) {
    LAS float* tl = (LAS float*)lds;
    const int tid = threadIdx.x, nnt = ncols >> 6, ntl = (K >> 6) * nnt;
    const int r = tid >> 4, c4 = (tid & 15) << 2;
    f32x4 pv[2];
    if ((int)blockIdx.x < ntl) { const int kt = (int)blockIdx.x / nnt, nt = (int)blockIdx.x - kt * nnt;
#pragma unroll
        for (int i = 0; i < 2; ++i) pv[i] = *(const f32x4*)(src + (size_t)(kt * 64 + r + 32 * i) * ldn + col0 + nt * 64 + c4); }
    for (int tile = blockIdx.x; tile < ntl; tile += gridDim.x) {
        const int kt = tile / nnt, nt = tile - kt * nnt;
#pragma unroll
        for (int i = 0; i < 2; ++i) { const int k = r + 32 * i; const f32x4 v = pv[i];
            tl[k * 65 + c4 + 0] = v.x; tl[k * 65 + c4 + 1] = v.y; tl[k * 65 + c4 + 2] = v.z; tl[k * 65 + c4 + 3] = v.w; }
        { const int tn = tile + (int)gridDim.x; if (tn < ntl) { const int kt2 = tn / nnt, nt2 = tn - kt2 * nnt;
#pragma unroll
            for (int i = 0; i < 2; ++i) pv[i] = *(const f32x4*)(src + (size_t)(kt2 * 64 + r + 32 * i) * ldn + col0 + nt2 * 64 + c4); } }
        __syncthreads();
        const int n = tid >> 3, k8 = (tid & 7) << 3; float f[8];
#pragma unroll
        for (int j = 0; j < 8; ++j) f[j] = tl[(k8 + j) * 65 + n];
        u32x4 w; w.x = pk2(f[0], f[1]); w.y = pk2(f[2], f[3]); w.z = pk2(f[4], f[5]); w.w = pk2(f[6], f[7]);
        const int ncol = nt * 64 + n;
        const int row = mode == 0 ? off + ncol : mode == 1 ? ((ncol >> 7) << 8) + (ncol & 127) + off
                      : (ncol < 512 ? ((ncol >> 7) << 8) + (ncol & 127) : ncol < 1024 ? (((ncol - 512) >> 7) << 8) + 128 + ((ncol - 512) & 127) : ncol);
        *(u32x4*)(dst + (size_t)row * K + kt * 64 + k8) = w;
        __syncthreads();
    }
}
__device__ __forceinline__ void convert_layer(LDSp lds, const Params& p, int L) {
    bf16_t* wb = (bf16_t*)(p.ws + WS_WB);
    if (L == 0) { conv_job(lds, p.in[2], 3088, 1024, 0, 3072, (bf16_t*)((char*)wb + WB_IN), 2, 0);
                  conv_job(lds, p.in[11], 1024, 1024, 0, 1024, (bf16_t*)((char*)wb + WB_OUT), 0, 0); }
    else        { conv_job(lds, p.in[12], 2576, 1024, 0, 2560, (bf16_t*)((char*)wb + WB_IN), 0, 0);
                  conv_job(lds, p.in[20], 1024, 1024, 0, 1024, (bf16_t*)((char*)wb + WB_OUT), 0, 0); }
    conv_job(lds, p.in[22] + (size_t)L * 1024 * DFF, DFF, 1024, 0, DFF, (bf16_t*)((char*)wb + WB_UP), 1, 0);
    conv_job(lds, p.in[23] + (size_t)L * 1024 * DFF, DFF, 1024, 0, DFF, (bf16_t*)((char*)wb + WB_UP), 1, 128);
    conv_job(lds, p.in[24] + (size_t)L * DFF * 1024, 1024, DFF, 0, 1024, (bf16_t*)((char*)wb + WB_DN), 0, 0);
}

__device__ __forceinline__ void rms_phase(LDSp lds, const float* src, const float* __restrict__ g, bf16_t* hn, float* copy_out, float* final_out,
                                          const float* __restrict__ gw, int gw_ld, int gw_col0, float* gates) {
    LAS float* wg = (LAS float*)lds;
    const int tid = threadIdx.x, lane = tid & 63, wid = tid >> 6;
    if (gw) { for (int idx = tid; idx < 16384; idx += NTHR) { const int k = idx >> 4, j = idx & 15; wg[j * 1024 + k] = gw[(size_t)k * gw_ld + gw_col0 + j]; } __syncthreads(); }
    f32x4 gv[4];
#pragma unroll
    for (int i = 0; i < 4; ++i) gv[i] = *(const f32x4*)(g + 4 * lane + 256 * i);
    f32x4 xn[4];
    { const int row0 = blockIdx.x * 8 + wid;
#pragma unroll
      for (int i = 0; i < 4; ++i) xn[i] = *(const f32x4*)(src + (size_t)row0 * D_ + 4 * lane + 256 * i); }
    for (int row = blockIdx.x * 8 + wid; row < T_; row += gridDim.x * 8) {
        f32x4 x[4]; float ss = 0.f;
#pragma unroll
        for (int i = 0; i < 4; ++i) { x[i] = xn[i]; ss += x[i].x * x[i].x + x[i].y * x[i].y + x[i].z * x[i].z + x[i].w * x[i].w; }
        { const int rn = row + (int)gridDim.x * 8; if (rn < T_) {
#pragma unroll
            for (int i = 0; i < 4; ++i) xn[i] = *(const f32x4*)(src + (size_t)rn * D_ + 4 * lane + 256 * i); } }
        if (copy_out) {
#pragma unroll
            for (int i = 0; i < 4; ++i) *(f32x4*)(copy_out + (size_t)row * D_ + 4 * lane + 256 * i) = x[i]; }
        ss = wave_sum(ss);
        const float rstd = rsqrtf(ss * (1.0f / 1024.0f) + 1e-6f);
        f32x4 y[4];
#pragma unroll
        for (int i = 0; i < 4; ++i) y[i] = x[i] * rstd * gv[i];
        if (final_out) {
#pragma unroll
            for (int i = 0; i < 4; ++i) *(f32x4*)(final_out + (size_t)row * D_ + 4 * lane + 256 * i) = y[i];
        } else {
#pragma unroll
            for (int i = 0; i < 4; ++i) { u32x2 w; w.x = pk2(y[i].x, y[i].y); w.y = pk2(y[i].z, y[i].w); *(u32x2*)(hn + (size_t)row * D_ + 4 * lane + 256 * i) = w; }
        }
        if (gw) {
            float s[16];
#pragma unroll
            for (int j = 0; j < 16; ++j) { float a = 0.f;
#pragma unroll
                for (int i = 0; i < 4; ++i) { const f32x4 w = *(const LAS f32x4*)(wg + j * 1024 + 4 * lane + 256 * i); a += y[i].x * w.x + y[i].y * w.y + y[i].z * w.z + y[i].w * w.w; }
                s[j] = a; }
            const bool h5 = (lane & 32) != 0, h4 = (lane & 16) != 0, h3 = (lane & 8) != 0, h2 = (lane & 4) != 0;
            float r8[8], r4[4], r2[2], r1;
#pragma unroll
            for (int j = 0; j < 8; ++j) { const float keep = h5 ? s[j + 8] : s[j], send = h5 ? s[j] : s[j + 8]; r8[j] = keep + __shfl_xor(send, 32); }
#pragma unroll
            for (int j = 0; j < 4; ++j) { const float keep = h4 ? r8[j + 4] : r8[j], send = h4 ? r8[j] : r8[j + 4]; r4[j] = keep + __shfl_xor(send, 16); }
#pragma unroll
            for (int j = 0; j < 2; ++j) { const float keep = h3 ? r4[j + 2] : r4[j], send = h3 ? r4[j] : r4[j + 2]; r2[j] = keep + __shfl_xor(send, 8); }
            { const float keep = h2 ? r2[1] : r2[0], send = h2 ? r2[0] : r2[1]; r1 = keep + __shfl_xor(send, 4); }
            r1 += __shfl_xor(r1, 2); r1 += __shfl_xor(r1, 1);
            if ((lane & 3) == 0) gates[(size_t)row * 16 + (h5 ? 8 : 0) + (h4 ? 4 : 0) + (h3 ? 2 : 0) + (h2 ? 1 : 0)] = r1;
        }
    }
    __syncthreads();
}

__device__ __forceinline__ void even_prep(LDSp lds, const Params& p) {
    const bf16_t* Z = (const bf16_t*)(p.ws + WS_Z); bf16_t* Y = (bf16_t*)(p.ws + WS_HN); bf16_t* QKVN = (bf16_t*)(p.ws + WS_QKV);
    const float* gates = (const float*)(p.ws + WS_GATES); float* BETA = (float*)(p.ws + WS_BETA); float* LA = (float*)(p.ws + WS_LA);
    const float* conv_w = p.in[3]; const float* conv_b = p.in[4]; const float* ln_g = p.in[5]; const float* ln_b = p.in[6];
    const float* dn_w = p.in[7]; const float* a_log = p.in[8]; const float* dt_bias = p.in[9];
    LAS float* glu = (LAS float*)lds;
    const int tid = threadIdx.x, lane = tid & 63, wid = tid >> 6, c = tid;
    for (int tile = blockIdx.x; tile < T_ / 32; tile += gridDim.x) {
        const int t0 = tile * 32, b = t0 >> 12, s0 = t0 & 4095;
#if !(EVP_SKIP & 1)
        for (int it = tid; it < 62 * 64; it += NTHR) { const int r = it >> 6, c8 = (it & 63) << 3, sp = s0 - 15 + r;
            f32x4 o0 = {0.f, 0.f, 0.f, 0.f}, o1 = {0.f, 0.f, 0.f, 0.f};
            if (sp >= 0 && sp < S_) { const size_t tok = (size_t)b * S_ + sp; const u32x4 av = *(const u32x4*)(Z + tok * 3072 + c8);
                float a[8]; unpack8(av, a);
                o0 = (f32x4){a[0], a[1], a[2], a[3]}; o1 = (f32x4){a[4], a[5], a[6], a[7]}; }
            *(LAS f32x4*)(glu + r * 512 + c8) = o0; *(LAS f32x4*)(glu + r * 512 + c8 + 4) = o1; }
        __syncthreads();
        {
            float cw[31];
#pragma unroll
            for (int w = 0; w < 31; ++w) cw[w] = conv_w[w * 512 + c];
            const float cb = conv_b[c];
            f32x4 res[8];
#pragma unroll
            for (int t4 = 0; t4 < 8; ++t4) {
                float x[34];
#pragma unroll
                for (int i = 0; i < 34; ++i) x[i] = glu[(t4 * 4 + i) * 512 + c];
                float a0 = cb, a1 = cb, a2 = cb, a3 = cb;
#pragma unroll
                for (int w = 0; w < 31; ++w) { a0 = fmaf(x[w], cw[w], a0); a1 = fmaf(x[w + 1], cw[w], a1); a2 = fmaf(x[w + 2], cw[w], a2); a3 = fmaf(x[w + 3], cw[w], a3); }
                res[t4] = (f32x4){a0, a1, a2, a3};
            }
            __syncthreads();
#pragma unroll
            for (int t4 = 0; t4 < 8; ++t4) { glu[(t4 * 4 + 0) * 512 + c] = res[t4].x; glu[(t4 * 4 + 1) * 512 + c] = res[t4].y; glu[(t4 * 4 + 2) * 512 + c] = res[t4].z; glu[(t4 * 4 + 3) * 512 + c] = res[t4].w; }
        }
        __syncthreads();
        {
            const f32x4 g0 = *(const f32x4*)(ln_g + 4 * lane), g1 = *(const f32x4*)(ln_g + 256 + 4 * lane), b0 = *(const f32x4*)(ln_b + 4 * lane), b1 = *(const f32x4*)(ln_b + 256 + 4 * lane);
#pragma unroll
            for (int tt = 0; tt < 4; ++tt) { const int t = wid * 4 + tt;
                const f32x4 x0 = *(const LAS f32x4*)(glu + t * 512 + 4 * lane), x1 = *(const LAS f32x4*)(glu + t * 512 + 256 + 4 * lane);
                const float mean = wave_sum((x0.x + x0.y) + (x0.z + x0.w) + (x1.x + x1.y) + (x1.z + x1.w)) * (1.0f / 512.0f);
                const f32x4 d0 = x0 - mean, d1 = x1 - mean;
                const float var = wave_sum(d0.x * d0.x + d0.y * d0.y + d0.z * d0.z + d0.w * d0.w + d1.x * d1.x + d1.y * d1.y + d1.z * d1.z + d1.w * d1.w) * (1.0f / 512.0f);
                const float rstd = rsqrtf(var + 1e-5f);
                const f32x4 y0 = d0 * rstd * g0 + b0, y1 = d1 * rstd * g1 + b1;
                u32x2 w0, w1; w0.x = pk2(silu_(y0.x), silu_(y0.y)); w0.y = pk2(silu_(y0.z), silu_(y0.w)); w1.x = pk2(silu_(y1.x), silu_(y1.y)); w1.y = pk2(silu_(y1.z), silu_(y1.w));
                *(u32x2*)(Y + (size_t)(t0 + t) * 1024 + 4 * lane) = w0; *(u32x2*)(Y + (size_t)(t0 + t) * 1024 + 256 + 4 * lane) = w1; }
        }
        __syncthreads();
#endif
#if !(EVP_SKIP & 2)
        LAS unsigned short* xin = (LAS unsigned short*)(glu + 32 * 512);
#pragma unroll 1
        for (int gi = 0; gi < 3; ++gi) {
            float w5[5];
#pragma unroll
            for (int w = 0; w < 5; ++w) w5[w] = dn_w[w * 1536 + gi * 512 + c];
            for (int it = tid; it < 36 * 64; it += NTHR) { const int rr = it >> 6, c8 = (it & 63) << 3, sp = s0 - 2 + rr;
                u32x4 v = {0u, 0u, 0u, 0u};
                if (sp >= 0 && sp < S_) v = *(const u32x4*)(Z + ((size_t)b * S_ + sp) * 3072 + 1024 + gi * 512 + c8);
                *(LAS u32x4*)(xin + rr * 512 + c8) = v; }
            __syncthreads();
            float x0 = bf2f(xin[c]), x1 = bf2f(xin[512 + c]), x2 = bf2f(xin[1024 + c]), x3 = bf2f(xin[1536 + c]);
#pragma unroll 8
            for (int t = 0; t < 32; ++t) { const float x4 = bf2f(xin[(t + 4) * 512 + c]);
                float v = x0 * w5[0]; v = fmaf(x1, w5[1], v); v = fmaf(x2, w5[2], v); v = fmaf(x3, w5[3], v); v = fmaf(x4, w5[4], v);
                glu[t * 512 + c] = silu_(v);
                x0 = x1; x1 = x2; x2 = x3; x3 = x4; }
            __syncthreads();
            const float qs = gi == 0 ? 0.08838834764831845f : 1.0f;
#pragma unroll
            for (int pp = 0; pp < 4; ++pp) { const int pr = wid * 16 + pp * 4 + (lane >> 4), t = pr >> 2, hd = pr & 3, c8 = (lane & 15) * 8;
                const f32x4 y0 = *(const LAS f32x4*)(glu + t * 512 + hd * 128 + c8), y1 = *(const LAS f32x4*)(glu + t * 512 + hd * 128 + c8 + 4);
                const float ss = row16_sum(y0.x * y0.x + y0.y * y0.y + y0.z * y0.z + y0.w * y0.w + y1.x * y1.x + y1.y * y1.y + y1.z * y1.z + y1.w * y1.w);
                const float sc = gi == 2 ? 1.0f : rsqrtf(ss + 1e-6f) * qs;
                u32x4 w; w.x = pk2(y0.x * sc, y0.y * sc); w.y = pk2(y0.z * sc, y0.w * sc); w.z = pk2(y1.x * sc, y1.y * sc); w.w = pk2(y1.z * sc, y1.w * sc);
                *(u32x4*)(QKVN + (size_t)(t0 + t) * 1536 + gi * 512 + hd * 128 + c8) = w; }
            __syncthreads();
        }
#endif
#if !(EVP_SKIP & 4)
        if (tid < 256) { const int t = tid >> 3, j = tid & 7; const size_t tok = (size_t)(t0 + t);
            const float bp = gates[tok * 16 + j], ap = gates[tok * 16 + 8 + j];
            BETA[tok * 8 + j] = sigm(bp); LA[tok * 8 + j] = -expf(a_log[j]) * softplus_(ap + dt_bias[j]); }
#endif
        __syncthreads();
    }
}

__device__ __forceinline__ void tri_inv64(const LAS float* Am, int c, float su, float sw, LAS unsigned short* Tu, LAS unsigned short* Tw) {
    f32x4 a; float s0, s1, s2, s3; const float cf = (float)c;
    float x0 = fmaxf(0.0f, 1.0f - fabsf(cf - 0.0f));
    Tu[0 + c] = f2bf(x0 * su); Tw[0 + c] = f2bf(x0 * sw); asm volatile("" ::: "memory");
    float x1 = fmaxf(0.0f, 1.0f - fabsf(cf - 1.0f));
    s0 = 0.f; s1 = 0.f; s2 = 0.f; s3 = 0.f;
    a = *(const LAS f32x4*)(Am + 68);
    const float al1 = a.x;
    x1 = (x1 - ((s0 + s1) + (s2 + s3))) - al1 * x0;
    Tu[136 + c] = f2bf(x1 * su); Tw[136 + c] = f2bf(x1 * sw); asm volatile("" ::: "memory");
    float x2 = fmaxf(0.0f, 1.0f - fabsf(cf - 2.0f));
    s0 = 0.f; s1 = 0.f; s2 = 0.f; s3 = 0.f;
    a = *(const LAS f32x4*)(Am + 136);
    s0 = fmaf(a.x, x0, s0);
    const float al2 = a.y;
    x2 = (x2 - ((s0 + s1) + (s2 + s3))) - al2 * x1;
    Tu[272 + c] = f2bf(x2 * su); Tw[272 + c] = f2bf(x2 * sw); asm volatile("" ::: "memory");
    float x3 = fmaxf(0.0f, 1.0f - fabsf(cf - 3.0f));
    s0 = 0.f; s1 = 0.f; s2 = 0.f; s3 = 0.f;
    a = *(const LAS f32x4*)(Am + 204);
    s0 = fmaf(a.x, x0, s0);
    s1 = fmaf(a.y, x1, s1);
    const float al3 = a.z;
    x3 = (x3 - ((s0 + s1) + (s2 + s3))) - al3 * x2;
    Tu[408 + c] = f2bf(x3 * su); Tw[408 + c] = f2bf(x3 * sw); asm volatile("" ::: "memory");
    float x4 = fmaxf(0.0f, 1.0f - fabsf(cf - 4.0f));
    s0 = 0.f; s1 = 0.f; s2 = 0.f; s3 = 0.f;
    a = *(const LAS f32x4*)(Am + 272);
    s0 = fmaf(a.x, x0, s0);
    s1 = fmaf(a.y, x1, s1);
    s2 = fmaf(a.z, x2, s2);
    const float al4 = a.w;
    x4 = (x4 - ((s0 + s1) + (s2 + s3))) - al4 * x3;
    Tu[544 + c] = f2bf(x4 * su); Tw[544 + c] = f2bf(x4 * sw); asm volatile("" ::: "memory");
    float x5 = fmaxf(0.0f, 1.0f - fabsf(cf - 5.0f));
    s0 = 0.f; s1 = 0.f; s2 = 0.f; s3 = 0.f;
    a = *(const LAS f32x4*)(Am + 340);
    s0 = fmaf(a.x, x0, s0);
    s1 = fmaf(a.y, x1, s1);
    s2 = fmaf(a.z, x2, s2);
    s3 = fmaf(a.w, x3, s3);
    a = *(const LAS f32x4*)(Am + 344);
    const float al5 = a.x;
    x5 = (x5 - ((s0 + s1) + (s2 + s3))) - al5 * x4;
    Tu[680 + c] = f2bf(x5 * su); Tw[680 + c] = f2bf(x5 * sw); asm volatile("" ::: "memory");
    float x6 = fmaxf(0.0f, 1.0f - fabsf(cf - 6.0f));
    s0 = 0.f; s1 = 0.f; s2 = 0.f; s3 = 0.f;
    a = *(const LAS f32x4*)(Am + 408);
    s0 = fmaf(a.x, x0, s0);
    s1 = fmaf(a.y, x1, s1);
    s2 = fmaf(a.z, x2, s2);
    s3 = fmaf(a.w, x3, s3);
    a = *(const LAS f32x4*)(Am + 412);
    s0 = fmaf(a.x, x4, s0);
    const float al6 = a.y;
    x6 = (x6 - ((s0 + s1) + (s2 + s3))) - al6 * x5;
    Tu[816 + c] = f2bf(x6 * su); Tw[816 + c] = f2bf(x6 * sw); asm volatile("" ::: "memory");
    float x7 = fmaxf(0.0f, 1.0f - fabsf(cf - 7.0f));
    s0 = 0.f; s1 = 0.f; s2 = 0.f; s3 = 0.f;
    a = *(const LAS f32x4*)(Am + 476);
    s0 = fmaf(a.x, x0, s0);
    s1 = fmaf(a.y, x1, s1);
    s2 = fmaf(a.z, x2, s2);
    s3 = fmaf(a.w, x3, s3);
    a = *(const LAS f32x4*)(Am + 480);
    s0 = fmaf(a.x, x4, s0);
    s1 = fmaf(a.y, x5, s1);
    const float al7 = a.z;
    x7 = (x7 - ((s0 + s1) + (s2 + s3))) - al7 * x6;
    Tu[952 + c] = f2bf(x7 * su); Tw[952 + c] = f2bf(x7 * sw); asm volatile("" ::: "memory");
    float x8 = fmaxf(0.0f, 1.0f - fabsf(cf - 8.0f));
    s0 = 0.f; s1 = 0.f; s2 = 0.f; s3 = 0.f;
    a = *(const LAS f32x4*)(Am + 544);
    s0 = fmaf(a.x, x0, s0);
    s1 = fmaf(a.y, x1, s1);
    s2 = fmaf(a.z, x2, s2);
    s3 = fmaf(a.w, x3, s3);
    a = *(const LAS f32x4*)(Am + 548);
    s0 = fmaf(a.x, x4, s0);
    s1 = fmaf(a.y, x5, s1);
    s2 = fmaf(a.z, x6, s2);
    const float al8 = a.w;
    x8 = (x8 - ((s0 + s1) + (s2 + s3))) - al8 * x7;
    Tu[1088 + c] = f2bf(x8 * su); Tw[1088 + c] = f2bf(x8 * sw); asm volatile("" ::: "memory");
    float x9 = fmaxf(0.0f, 1.0f - fabsf(cf - 9.0f));
    s0 = 0.f; s1 = 0.f; s2 = 0.f; s3 = 0.f;
    a = *(const LAS f32x4*)(Am + 612);
    s0 = fmaf(a.x, x0, s0);
    s1 = fmaf(a.y, x1, s1);
    s2 = fmaf(a.z, x2, s2);
    s3 = fmaf(a.w, x3, s3);
    a = *(const LAS f32x4*)(Am + 616);
    s0 = fmaf(a.x, x4, s0);
    s1 = fmaf(a.y, x5, s1);
    s2 = fmaf(a.z, x6, s2);
    s3 = fmaf(a.w, x7, s3);
    a = *(const LAS f32x4*)(Am + 620);
    const float al9 = a.x;
    x9 = (x9 - ((s0 + s1) + (s2 + s3))) - al9 * x8;
    Tu[1224 + c] = f2bf(x9 * su); Tw[1224 + c] = f2bf(x9 * sw); asm volatile("" ::: "memory");
    float x10 = fmaxf(0.0f, 1.0f - fabsf(cf - 10.0f));
    s0 = 0.f; s1 = 0.f; s2 = 0.f; s3 = 0.f;
    a = *(const LAS f32x4*)(Am + 680);
    s0 = fmaf(a.x, x0, s0);
    s1 = fmaf(a.y, x1, s1);
    s2 = fmaf(a.z, x2, s2);
    s3 = fmaf(a.w, x3, s3);
    a = *(const LAS f32x4*)(Am + 684);
    s0 = fmaf(a.x, x4, s0);
    s1 = fmaf(a.y, x5, s1);
    s2 = fmaf(a.z, x6, s2);
    s3 = fmaf(a.w, x7, s3);
    a = *(const LAS f32x4*)(Am + 688);
    s0 = fmaf(a.x, x8, s0);
    const float al10 = a.y;
    x10 = (x10 - ((s0 + s1) + (s2 + s3))) - al10 * x9;
    Tu[1360 + c] = f2bf(x10 * su); Tw[1360 + c] = f2bf(x10 * sw); asm volatile("" ::: "memory");
    float x11 = fmaxf(0.0f, 1.0f - fabsf(cf - 11.0f));
    s0 = 0.f; s1 = 0.f; s2 = 0.f; s3 = 0.f;
    a = *(const LAS f32x4*)(Am + 748);
    s0 = fmaf(a.x, x0, s0);
    s1 = fmaf(a.y, x1, s1);
    s2 = fmaf(a.z, x2, s2);
    s3 = fmaf(a.w, x3, s3);
    a = *(const LAS f32x4*)(Am + 752);
    s0 = fmaf(a.x, x4, s0);
    s1 = fmaf(a.y, x5, s1);
    s2 = fmaf(a.z, x6, s2);
    s3 = fmaf(a.w, x7, s3);
    a = *(const LAS f32x4*)(Am + 756);
    s0 = fmaf(a.x, x8, s0);
    s1 = fmaf(a.y, x9, s1);
    const float al11 = a.z;
    x11 = (x11 - ((s0 + s1) + (s2 + s3))) - al11 * x10;
    Tu[1496 + c] = f2bf(x11 * su); Tw[1496 + c] = f2bf(x11 * sw); asm volatile("" ::: "memory");
    float x12 = fmaxf(0.0f, 1.0f - fabsf(cf - 12.0f));
    s0 = 0.f; s1 = 0.f; s2 = 0.f; s3 = 0.f;
    a = *(const LAS f32x4*)(Am + 816);
    s0 = fmaf(a.x, x0, s0);
    s1 = fmaf(a.y, x1, s1);
    s2 = fmaf(a.z, x2, s2);
    s3 = fmaf(a.w, x3, s3);
    a = *(const LAS f32x4*)(Am + 820);
    s0 = fmaf(a.x, x4, s0);
    s1 = fmaf(a.y, x5, s1);
    s2 = fmaf(a.z, x6, s2);
    s3 = fmaf(a.w, x7, s3);
    a = *(const LAS f32x4*)(Am + 824);
    s0 = fmaf(a.x, x8, s0);
    s1 = fmaf(a.y, x9, s1);
    s2 = fmaf(a.z, x10, s2);
    const float al12 = a.w;
    x12 = (x12 - ((s0 + s1) + (s2 + s3))) - al12 * x11;
    Tu[1632 + c] = f2bf(x12 * su); Tw[1632 + c] = f2bf(x12 * sw); asm volatile("" ::: "memory");
    float x13 = fmaxf(0.0f, 1.0f - fabsf(cf - 13.0f));
    s0 = 0.f; s1 = 0.f; s2 = 0.f; s3 = 0.f;
    a = *(const LAS f32x4*)(Am + 884);
    s0 = fmaf(a.x, x0, s0);
    s1 = fmaf(a.y, x1, s1);
    s2 = fmaf(a.z, x2, s2);
    s3 = fmaf(a.w, x3, s3);
    a = *(const LAS f32x4*)(Am + 888);
    s0 = fmaf(a.x, x4, s0);
    s1 = fmaf(a.y, x5, s1);
    s2 = fmaf(a.z, x6, s2);
    s3 = fmaf(a.w, x7, s3);
    a = *(const LAS f32x4*)(Am + 892);
    s0 = fmaf(a.x, x8, s0);
    s1 = fmaf(a.y, x9, s1);
    s2 = fmaf(a.z, x10, s2);
    s3 = fmaf(a.w, x11, s3);
    a = *(const LAS f32x4*)(Am + 896);
    const float al13 = a.x;
    x13 = (x13 - ((s0 + s1) + (s2 + s3))) - al13 * x12;
    Tu[1768 + c] = f2bf(x13 * su); Tw[1768 + c] = f2bf(x13 * sw); asm volatile("" ::: "memory");
    float x14 = fmaxf(0.0f, 1.0f - fabsf(cf - 14.0f));
    s0 = 0.f; s1 = 0.f; s2 = 0.f; s3 = 0.f;
    a = *(const LAS f32x4*)(Am + 952);
    s0 = fmaf(a.x, x0, s0);
    s1 = fmaf(a.y, x1, s1);
    s2 = fmaf(a.z, x2, s2);
    s3 = fmaf(a.w, x3, s3);
    a = *(const LAS f32x4*)(Am + 956);
    s0 = fmaf(a.x, x4, s0);
    s1 = fmaf(a.y, x5, s1);
    s2 = fmaf(a.z, x6, s2);
    s3 = fmaf(a.w, x7, s3);
    a = *(const LAS f32x4*)(Am + 960);
    s0 = fmaf(a.x, x8, s0);
    s1 = fmaf(a.y, x9, s1);
    s2 = fmaf(a.z, x10, s2);
    s3 = fmaf(a.w, x11, s3);
    a = *(const LAS f32x4*)(Am + 964);
    s0 = fmaf(a.x, x12, s0);
    const float al14 = a.y;
    x14 = (x14 - ((s0 + s1) + (s2 + s3))) - al14 * x13;
    Tu[1904 + c] = f2bf(x14 * su); Tw[1904 + c] = f2bf(x14 * sw); asm volatile("" ::: "memory");
    float x15 = fmaxf(0.0f, 1.0f - fabsf(cf - 15.0f));
    s0 = 0.f; s1 = 0.f; s2 = 0.f; s3 = 0.f;
    a = *(const LAS f32x4*)(Am + 1020);
    s0 = fmaf(a.x, x0, s0);
    s1 = fmaf(a.y, x1, s1);
    s2 = fmaf(a.z, x2, s2);
    s3 = fmaf(a.w, x3, s3);
    a = *(const LAS f32x4*)(Am + 1024);
    s0 = fmaf(a.x, x4, s0);
    s1 = fmaf(a.y, x5, s1);
    s2 = fmaf(a.z, x6, s2);
    s3 = fmaf(a.w, x7, s3);
    a = *(const LAS f32x4*)(Am + 1028);
    s0 = fmaf(a.x, x8, s0);
    s1 = fmaf(a.y, x9, s1);
    s2 = fmaf(a.z, x10, s2);
    s3 = fmaf(a.w, x11, s3);
    a = *(const LAS f32x4*)(Am + 1032);
    s0 = fmaf(a.x, x12, s0);
    s1 = fmaf(a.y, x13, s1);
    const float al15 = a.z;
    x15 = (x15 - ((s0 + s1) + (s2 + s3))) - al15 * x14;
    Tu[2040 + c] = f2bf(x15 * su); Tw[2040 + c] = f2bf(x15 * sw); asm volatile("" ::: "memory");
    float x16 = fmaxf(0.0f, 1.0f - fabsf(cf - 16.0f));
    s0 = 0.f; s1 = 0.f; s2 = 0.f; s3 = 0.f;
    a = *(const LAS f32x4*)(Am + 1088);
    s0 = fmaf(a.x, x0, s0);
    s1 = fmaf(a.y, x1, s1);
    s2 = fmaf(a.z, x2, s2);
    s3 = fmaf(a.w, x3, s3);
    a = *(const LAS f32x4*)(Am + 1092);
    s0 = fmaf(a.x, x4, s0);
    s1 = fmaf(a.y, x5, s1);
    s2 = fmaf(a.z, x6, s2);
    s3 = fmaf(a.w, x7, s3);
    a = *(const LAS f32x4*)(Am + 1096);
    s0 = fmaf(a.x, x8, s0);
    s1 = fmaf(a.y, x9, s1);
    s2 = fmaf(a.z, x10, s2);
    s3 = fmaf(a.w, x11, s3);
    a = *(const LAS f32x4*)(Am + 1100);
    s0 = fmaf(a.x, x12, s0);
    s1 = fmaf(a.y, x13, s1);
    s2 = fmaf(a.z, x14, s2);
    const float al16 = a.w;
    x16 = (x16 - ((s0 + s1) + (s2 + s3))) - al16 * x15;
    Tu[2176 + c] = f2bf(x16 * su); Tw[2176 + c] = f2bf(x16 * sw); asm volatile("" ::: "memory");
    float x17 = fmaxf(0.0f, 1.0f - fabsf(cf - 17.0f));
    s0 = 0.f; s1 = 0.f; s2 = 0.f; s3 = 0.f;
    a = *(const LAS f32x4*)(Am + 1156);
    s0 = fmaf(a.x, x0, s0);
    s1 = fmaf(a.y, x1, s1);
    s2 = fmaf(a.z, x2, s2);
    s3 = fmaf(a.w, x3, s3);
    a = *(const LAS f32x4*)(Am + 1160);
    s0 = fmaf(a.x, x4, s0);
    s1 = fmaf(a.y, x5, s1);
    s2 = fmaf(a.z, x6, s2);
    s3 = fmaf(a.w, x7, s3);
    a = *(const LAS f32x4*)(Am + 1164);
    s0 = fmaf(a.x, x8, s0);
    s1 = fmaf(a.y, x9, s1);
    s2 = fmaf(a.z, x10, s2);
    s3 = fmaf(a.w, x11, s3);
    a = *(const LAS f32x4*)(Am + 1168);
    s0 = fmaf(a.x, x12, s0);
    s1 = fmaf(a.y, x13, s1);
    s2 = fmaf(a.z, x14, s2);
    s3 = fmaf(a.w, x15, s3);
    a = *(const LAS f32x4*)(Am + 1172);
    const float al17 = a.x;
    x17 = (x17 - ((s0 + s1) + (s2 + s3))) - al17 * x16;
    Tu[2312 + c] = f2bf(x17 * su); Tw[2312 + c] = f2bf(x17 * sw); asm volatile("" ::: "memory");
    float x18 = fmaxf(0.0f, 1.0f - fabsf(cf - 18.0f));
    s0 = 0.f; s1 = 0.f; s2 = 0.f; s3 = 0.f;
    a = *(const LAS f32x4*)(Am + 1224);
    s0 = fmaf(a.x, x0, s0);
    s1 = fmaf(a.y, x1, s1);
    s2 = fmaf(a.z, x2, s2);
    s3 = fmaf(a.w, x3, s3);
    a = *(const LAS f32x4*)(Am + 1228);
    s0 = fmaf(a.x, x4, s0);
    s1 = fmaf(a.y, x5, s1);
    s2 = fmaf(a.z, x6, s2);
    s3 = fmaf(a.w, x7, s3);
    a = *(const LAS f32x4*)(Am + 1232);
    s0 = fmaf(a.x, x8, s0);
    s1 = fmaf(a.y, x9, s1);
    s2 = fmaf(a.z, x10, s2);
    s3 = fmaf(a.w, x11, s3);
    a = *(const LAS f32x4*)(Am + 1236);
    s0 = fmaf(a.x, x12, s0);
    s1 = fmaf(a.y, x13, s1);
    s2 = fmaf(a.z, x14, s2);
    s3 = fmaf(a.w, x15, s3);
    a = *(const LAS f32x4*)(Am + 1240);
    s0 = fmaf(a.x, x16, s0);
    const float al18 = a.y;
    x18 = (x18 - ((s0 + s1) + (s2 + s3))) - al18 * x17;
    Tu[2448 + c] = f2bf(x18 * su); Tw[2448 + c] = f2bf(x18 * sw); asm volatile("" ::: "memory");
    float x19 = fmaxf(0.0f, 1.0f - fabsf(cf - 19.0f));
    s0 = 0.f; s1 = 0.f; s2 = 0.f; s3 = 0.f;
    a = *(const LAS f32x4*)(Am + 1292);
    s0 = fmaf(a.x, x0, s0);
    s1 = fmaf(a.y, x1, s1);
    s2 = fmaf(a.z, x2, s2);
    s3 = fmaf(a.w, x3, s3);
    a = *(const LAS f32x4*)(Am + 1296);
    s0 = fmaf(a.x, x4, s0);
    s1 = fmaf(a.y, x5, s1);
    s2 = fmaf(a.z, x6, s2);
    s3 = fmaf(a.w, x7, s3);
    a = *(const LAS f32x4*)(Am + 1300);
    s0 = fmaf(a.x, x8, s0);
    s1 = fmaf(a.y, x9, s1);
    s2 = fmaf(a.z, x10, s2);
    s3 = fmaf(a.w, x11, s3);
    a = *(const LAS f32x4*)(Am + 1304);
    s0 = fmaf(a.x, x12, s0);
    s1 = fmaf(a.y, x13, s1);
    s2 = fmaf(a.z, x14, s2);
    s3 = fmaf(a.w, x15, s3);
    a = *(const LAS f32x4*)(Am + 1308);
    s0 = fmaf(a.x, x16, s0);
    s1 = fmaf(a.y, x17, s1);
    const float al19 = a.z;
    x19 = (x19 - ((s0 + s1) + (s2 + s3))) - al19 * x18;
    Tu[2584 + c] = f2bf(x19 * su); Tw[2584 + c] = f2bf(x19 * sw); asm volatile("" ::: "memory");
    float x20 = fmaxf(0.0f, 1.0f - fabsf(cf - 20.0f));
    s0 = 0.f; s1 = 0.f; s2 = 0.f; s3 = 0.f;
    a = *(const LAS f32x4*)(Am + 1360);
    s0 = fmaf(a.x, x0, s0);
    s1 = fmaf(a.y, x1, s1);
    s2 = fmaf(a.z, x2, s2);
    s3 = fmaf(a.w, x3, s3);
    a = *(const LAS f32x4*)(Am + 1364);
    s0 = fmaf(a.x, x4, s0);
    s1 = fmaf(a.y, x5, s1);
    s2 = fmaf(a.z, x6, s2);
    s3 = fmaf(a.w, x7, s3);
    a = *(const LAS f32x4*)(Am + 1368);
    s0 = fmaf(a.x, x8, s0);
    s1 = fmaf(a.y, x9, s1);
    s2 = fmaf(a.z, x10, s2);
    s3 = fmaf(a.w, x11, s3);
    a = *(const LAS f32x4*)(Am + 1372);
    s0 = fmaf(a.x, x12, s0);
    s1 = fmaf(a.y, x13, s1);
    s2 = fmaf(a.z, x14, s2);
    s3 = fmaf(a.w, x15, s3);
    a = *(const LAS f32x4*)(Am + 1376);
    s0 = fmaf(a.x, x16, s0);
    s1 = fmaf(a.y, x17, s1);
    s2 = fmaf(a.z, x18, s2);
    const float al20 = a.w;
    x20 = (x20 - ((s0 + s1) + (s2 + s3))) - al20 * x19;
    Tu[2720 + c] = f2bf(x20 * su); Tw[2720 + c] = f2bf(x20 * sw); asm volatile("" ::: "memory");
    float x21 = fmaxf(0.0f, 1.0f - fabsf(cf - 21.0f));
    s0 = 0.f; s1 = 0.f; s2 = 0.f; s3 = 0.f;
    a = *(const LAS f32x4*)(Am + 1428);
    s0 = fmaf(a.x, x0, s0);
    s1 = fmaf(a.y, x1, s1);
    s2 = fmaf(a.z, x2, s2);
    s3 = fmaf(a.w, x3, s3);
    a = *(const LAS f32x4*)(Am + 1432);
    s0 = fmaf(a.x, x4, s0);
    s1 = fmaf(a.y, x5, s1);
    s2 = fmaf(a.z, x6, s2);
    s3 = fmaf(a.w, x7, s3);
    a = *(const LAS f32x4*)(Am + 1436);
    s0 = fmaf(a.x, x8, s0);
    s1 = fmaf(a.y, x9, s1);
    s2 = fmaf(a.z, x10, s2);
    s3 = fmaf(a.w, x11, s3);
    a = *(const LAS f32x4*)(Am + 1440);
    s0 = fmaf(a.x, x12, s0);
    s1 = fmaf(a.y, x13, s1);
    s2 = fmaf(a.z, x14, s2);
    s3 = fmaf(a.w, x15, s3);
    a = *(const LAS f32x4*)(Am + 1444);
    s0 = fmaf(a.x, x16, s0);
    s1 = fmaf(a.y, x17, s1);
    s2 = fmaf(a.z, x18, s2);
    s3 = fmaf(a.w, x19, s3);
    a = *(const LAS f32x4*)(Am + 1448);
    const float al21 = a.x;
    x21 = (x21 - ((s0 + s1) + (s2 + s3))) - al21 * x20;
    Tu[2856 + c] = f2bf(x21 * su); Tw[2856 + c] = f2bf(x21 * sw); asm volatile("" ::: "memory");
    float x22 = fmaxf(0.0f, 1.0f - fabsf(cf - 22.0f));
    s0 = 0.f; s1 = 0.f; s2 = 0.f; s3 = 0.f;
    a = *(const LAS f32x4*)(Am + 1496);
    s0 = fmaf(a.x, x0, s0);
    s1 = fmaf(a.y, x1, s1);
    s2 = fmaf(a.z, x2, s2);
    s3 = fmaf(a.w, x3, s3);
    a = *(const LAS f32x4*)(Am + 1500);
    s0 = fmaf(a.x, x4, s0);
    s1 = fmaf(a.y, x5, s1);
    s2 = fmaf(a.z, x6, s2);
    s3 = fmaf(a.w, x7, s3);
    a = *(const LAS f32x4*)(Am + 1504);
    s0 = fmaf(a.x, x8, s0);
    s1 = fmaf(a.y, x9, s1);
    s2 = fmaf(a.z, x10, s2);
    s3 = fmaf(a.w, x11, s3);
    a = *(const LAS f32x4*)(Am + 1508);
    s0 = fmaf(a.x, x12, s0);
    s1 = fmaf(a.y, x13, s1);
    s2 = fmaf(a.z, x14, s2);
    s3 = fmaf(a.w, x15, s3);
    a = *(const LAS f32x4*)(Am + 1512);
    s0 = fmaf(a.x, x16, s0);
    s1 = fmaf(a.y, x17, s1);
    s2 = fmaf(a.z, x18, s2);
    s3 = fmaf(a.w, x19, s3);
    a = *(const LAS f32x4*)(Am + 1516);
    s0 = fmaf(a.x, x20, s0);
    const float al22 = a.y;
    x22 = (x22 - ((s0 + s1) + (s2 + s3))) - al22 * x21;
    Tu[2992 + c] = f2bf(x22 * su); Tw[2992 + c] = f2bf(x22 * sw); asm volatile("" ::: "memory");
    float x23 = fmaxf(0.0f, 1.0f - fabsf(cf - 23.0f));
    s0 = 0.f; s1 = 0.f; s2 = 0.f; s3 = 0.f;
    a = *(const LAS f32x4*)(Am + 1564);
    s0 = fmaf(a.x, x0, s0);
    s1 = fmaf(a.y, x1, s1);
    s2 = fmaf(a.z, x2, s2);
    s3 = fmaf(a.w, x3, s3);
    a = *(const LAS f32x4*)(Am + 1568);
    s0 = fmaf(a.x, x4, s0);
    s1 = fmaf(a.y, x5, s1);
    s2 = fmaf(a.z, x6, s2);
    s3 = fmaf(a.w, x7, s3);
    a = *(const LAS f32x4*)(Am + 1572);
    s0 = fmaf(a.x, x8, s0);
    s1 = fmaf(a.y, x9, s1);
    s2 = fmaf(a.z, x10, s2);
    s3 = fmaf(a.w, x11, s3);
    a = *(const LAS f32x4*)(Am + 1576);
    s0 = fmaf(a.x, x12, s0);
    s1 = fmaf(a.y, x13, s1);
    s2 = fmaf(a.z, x14, s2);
    s3 = fmaf(a.w, x15, s3);
    a = *(const LAS f32x4*)(Am + 1580);
    s0 = fmaf(a.x, x16, s0);
    s1 = fmaf(a.y, x17, s1);
    s2 = fmaf(a.z, x18, s2);
    s3 = fmaf(a.w, x19, s3);
    a = *(const LAS f32x4*)(Am + 1584);
    s0 = fmaf(a.x, x20, s0);
    s1 = fmaf(a.y, x21, s1);
    const float al23 = a.z;
    x23 = (x23 - ((s0 + s1) + (s2 + s3))) - al23 * x22;
    Tu[3128 + c] = f2bf(x23 * su); Tw[3128 + c] = f2bf(x23 * sw); asm volatile("" ::: "memory");
    float x24 = fmaxf(0.0f, 1.0f - fabsf(cf - 24.0f));
    s0 = 0.f; s1 = 0.f; s2 = 0.f; s3 = 0.f;
    a = *(const LAS f32x4*)(Am + 1632);
    s0 = fmaf(a.x, x0, s0);
    s1 = fmaf(a.y, x1, s1);
    s2 = fmaf(a.z, x2, s2);
    s3 = fmaf(a.w, x3, s3);
    a = *(const LAS f32x4*)(Am + 1636);
    s0 = fmaf(a.x, x4, s0);
    s1 = fmaf(a.y, x5, s1);
    s2 = fmaf(a.z, x6, s2);
    s3 = fmaf(a.w, x7, s3);
    a = *(const LAS f32x4*)(Am + 1640);
    s0 = fmaf(a.x, x8, s0);
    s1 = fmaf(a.y, x9, s1);
    s2 = fmaf(a.z, x10, s2);
    s3 = fmaf(a.w, x11, s3);
    a = *(const LAS f32x4*)(Am + 1644);
    s0 = fmaf(a.x, x12, s0);
    s1 = fmaf(a.y, x13, s1);
    s2 = fmaf(a.z, x14, s2);
    s3 = fmaf(a.w, x15, s3);
    a = *(const LAS f32x4*)(Am + 1648);
    s0 = fmaf(a.x, x16, s0);
    s1 = fmaf(a.y, x17, s1);
    s2 = fmaf(a.z, x18, s2);
    s3 = fmaf(a.w, x19, s3);
    a = *(const LAS f32x4*)(Am + 1652);
    s0 = fmaf(a.x, x20, s0);
    s1 = fmaf(a.y, x21, s1);
    s2 = fmaf(a.z, x22, s2);
    const float al24 = a.w;
    x24 = (x24 - ((s0 + s1) + (s2 + s3))) - al24 * x23;
    Tu[3264 + c] = f2bf(x24 * su); Tw[3264 + c] = f2bf(x24 * sw); asm volatile("" ::: "memory");
    float x25 = fmaxf(0.0f, 1.0f - fabsf(cf - 25.0f));
    s0 = 0.f; s1 = 0.f; s2 = 0.f; s3 = 0.f;
    a = *(const LAS f32x4*)(Am + 1700);
    s0 = fmaf(a.x, x0, s0);
    s1 = fmaf(a.y, x1, s1);
    s2 = fmaf(a.z, x2, s2);
    s3 = fmaf(a.w, x3, s3);
    a = *(const LAS f32x4*)(Am + 1704);
    s0 = fmaf(a.x, x4, s0);
    s1 = fmaf(a.y, x5, s1);
    s2 = fmaf(a.z, x6, s2);
    s3 = fmaf(a.w, x7, s3);
    a = *(const LAS f32x4*)(Am + 1708);
    s0 = fmaf(a.x, x8, s0);
    s1 = fmaf(a.y, x9, s1);
    s2 = fmaf(a.z, x10, s2);
    s3 = fmaf(a.w, x11, s3);
    a = *(const LAS f32x4*)(Am + 1712);
    s0 = fmaf(a.x, x12, s0);
    s1 = fmaf(a.y, x13, s1);
    s2 = fmaf(a.z, x14, s2);
    s3 = fmaf(a.w, x15, s3);
    a = *(const LAS f32x4*)(Am + 1716);
    s0 = fmaf(a.x, x16, s0);
    s1 = fmaf(a.y, x17, s1);
    s2 = fmaf(a.z, x18, s2);
    s3 = fmaf(a.w, x19, s3);
    a = *(const LAS f32x4*)(Am + 1720);
    s0 = fmaf(a.x, x20, s0);
    s1 = fmaf(a.y, x21, s1);
    s2 = fmaf(a.z, x22, s2);
    s3 = fmaf(a.w, x23, s3);
    a = *(const LAS f32x4*)(Am + 1724);
    const float al25 = a.x;
    x25 = (x25 - ((s0 + s1) + (s2 + s3))) - al25 * x24;
    Tu[3400 + c] = f2bf(x25 * su); Tw[3400 + c] = f2bf(x25 * sw); asm volatile("" ::: "memory");
    float x26 = fmaxf(0.0f, 1.0f - fabsf(cf - 26.0f));
    s0 = 0.f; s1 = 0.f; s2 = 0.f; s3 = 0.f;
    a = *(const LAS f32x4*)(Am + 1768);
    s0 = fmaf(a.x, x0, s0);
    s1 = fmaf(a.y, x1, s1);
    s2 = fmaf(a.z, x2, s2);
    s3 = fmaf(a.w, x3, s3);
    a = *(const LAS f32x4*)(Am + 1772);
    s0 = fmaf(a.x, x4, s0);
    s1 = fmaf(a.y, x5, s1);
    s2 = fmaf(a.z, x6, s2);
    s3 = fmaf(a.w, x7, s3);
    a = *(const LAS f32x4*)(Am + 1776);
    s0 = fmaf(a.x, x8, s0);
    s1 = fmaf(a.y, x9, s1);
    s2 = fmaf(a.z, x10, s2);
    s3 = fmaf(a.w, x11, s3);
    a = *(const LAS f32x4*)(Am + 1780);
    s0 = fmaf(a.x, x12, s0);
    s1 = fmaf(a.y, x13, s1);
    s2 = fmaf(a.z, x14, s2);
    s3 = fmaf(a.w, x15, s3);
    a = *(const LAS f32x4*)(Am + 1784);
    s0 = fmaf(a.x, x16, s0);
    s1 = fmaf(a.y, x17, s1);
    s2 = fmaf(a.z, x18, s2);
    s3 = fmaf(a.w, x19, s3);
    a = *(const LAS f32x4*)(Am + 1788);
    s0 = fmaf(a.x, x20, s0);
    s1 = fmaf(a.y, x21, s1);
    s2 = fmaf(a.z, x22, s2);
    s3 = fmaf(a.w, x23, s3);
    a = *(const LAS f32x4*)(Am + 1792);
    s0 = fmaf(a.x, x24, s0);
    const float al26 = a.y;
    x26 = (x26 - ((s0 + s1) + (s2 + s3))) - al26 * x25;
    Tu[3536 + c] = f2bf(x26 * su); Tw[3536 + c] = f2bf(x26 * sw); asm volatile("" ::: "memory");
    float x27 = fmaxf(0.0f, 1.0f - fabsf(cf - 27.0f));
    s0 = 0.f; s1 = 0.f; s2 = 0.f; s3 = 0.f;
    a = *(const LAS f32x4*)(Am + 1836);
    s0 = fmaf(a.x, x0, s0);
    s1 = fmaf(a.y, x1, s1);
    s2 = fmaf(a.z, x2, s2);
    s3 = fmaf(a.w, x3, s3);
    a = *(const LAS f32x4*)(Am + 1840);
    s0 = fmaf(a.x, x4, s0);
    s1 = fmaf(a.y, x5, s1);
    s2 = fmaf(a.z, x6, s2);
    s3 = fmaf(a.w, x7, s3);
    a = *(const LAS f32x4*)(Am + 1844);
    s0 = fmaf(a.x, x8, s0);
    s1 = fmaf(a.y, x9, s1);
    s2 = fmaf(a.z, x10, s2);
    s3 = fmaf(a.w, x11, s3);
    a = *(const LAS f32x4*)(Am + 1848);
    s0 = fmaf(a.x, x12, s0);
    s1 = fmaf(a.y, x13, s1);
    s2 = fmaf(a.z, x14, s2);
    s3 = fmaf(a.w, x15, s3);
    a = *(const LAS f32x4*)(Am + 1852);
    s0 = fmaf(a.x, x16, s0);
    s1 = fmaf(a.y, x17, s1);
    s2 = fmaf(a.z, x18, s2);
    s3 = fmaf(a.w, x19, s3);
    a = *(const LAS f32x4*)(Am + 1856);
    s0 = fmaf(a.x, x20, s0);
    s1 = fmaf(a.y, x21, s1);
    s2 = fmaf(a.z, x22, s2);
    s3 = fmaf(a.w, x23, s3);
    a = *(const LAS f32x4*)(Am + 1860);
    s0 = fmaf(a.x, x24, s0);
    s1 = fmaf(a.y, x25, s1);
    const float al27 = a.z;
    x27 = (x27 - ((s0 + s1) + (s2 + s3))) - al27 * x26;
    Tu[3672 + c] = f2bf(x27 * su); Tw[3672 + c] = f2bf(x27 * sw); asm volatile("" ::: "memory");
    float x28 = fmaxf(0.0f, 1.0f - fabsf(cf - 28.0f));
    s0 = 0.f; s1 = 0.f; s2 = 0.f; s3 = 0.f;
    a = *(const LAS f32x4*)(Am + 1904);
    s0 = fmaf(a.x, x0, s0);
    s1 = fmaf(a.y, x1, s1);
    s2 = fmaf(a.z, x2, s2);
    s3 = fmaf(a.w, x3, s3);
    a = *(const LAS f32x4*)(Am + 1908);
    s0 = fmaf(a.x, x4, s0);
    s1 = fmaf(a.y, x5, s1);
    s2 = fmaf(a.z, x6, s2);
    s3 = fmaf(a.w, x7, s3);
    a = *(const LAS f32x4*)(Am + 1912);
    s0 = fmaf(a.x, x8, s0);
    s1 = fmaf(a.y, x9, s1);
    s2 = fmaf(a.z, x10, s2);
    s3 = fmaf(a.w, x11, s3);
    a = *(const LAS f32x4*)(Am + 1916);
    s0 = fmaf(a.x, x12, s0);
    s1 = fmaf(a.y, x13, s1);
    s2 = fmaf(a.z, x14, s2);
    s3 = fmaf(a.w, x15, s3);
    a = *(const LAS f32x4*)(Am + 1920);
    s0 = fmaf(a.x, x16, s0);
    s1 = fmaf(a.y, x17, s1);
    s2 = fmaf(a.z, x18, s2);
    s3 = fmaf(a.w, x19, s3);
    a = *(const LAS f32x4*)(Am + 1924);
    s0 = fmaf(a.x, x20, s0);
    s1 = fmaf(a.y, x21, s1);
    s2 = fmaf(a.z, x22, s2);
    s3 = fmaf(a.w, x23, s3);
    a = *(const LAS f32x4*)(Am + 1928);
    s0 = fmaf(a.x, x24, s0);
    s1 = fmaf(a.y, x25, s1);
    s2 = fmaf(a.z, x26, s2);
    const float al28 = a.w;
    x28 = (x28 - ((s0 + s1) + (s2 + s3))) - al28 * x27;
    Tu[3808 + c] = f2bf(x28 * su); Tw[3808 + c] = f2bf(x28 * sw); asm volatile("" ::: "memory");
    float x29 = fmaxf(0.0f, 1.0f - fabsf(cf - 29.0f));
    s0 = 0.f; s1 = 0.f; s2 = 0.f; s3 = 0.f;
    a = *(const LAS f32x4*)(Am + 1972);
    s0 = fmaf(a.x, x0, s0);
    s1 = fmaf(a.y, x1, s1);
    s2 = fmaf(a.z, x2, s2);
    s3 = fmaf(a.w, x3, s3);
    a = *(const LAS f32x4*)(Am + 1976);
    s0 = fmaf(a.x, x4, s0);
    s1 = fmaf(a.y, x5, s1);
    s2 = fmaf(a.z, x6, s2);
    s3 = fmaf(a.w, x7, s3);
    a = *(const LAS f32x4*)(Am + 1980);
    s0 = fmaf(a.x, x8, s0);
    s1 = fmaf(a.y, x9, s1);
    s2 = fmaf(a.z, x10, s2);
    s3 = fmaf(a.w, x11, s3);
    a = *(const LAS f32x4*)(Am + 1984);
    s0 = fmaf(a.x, x12, s0);
    s1 = fmaf(a.y, x13, s1);
    s2 = fmaf(a.z, x14, s2);
    s3 = fmaf(a.w, x15, s3);
    a = *(const LAS f32x4*)(Am + 1988);
    s0 = fmaf(a.x, x16, s0);
    s1 = fmaf(a.y, x17, s1);
    s2 = fmaf(a.z, x18, s2);
    s3 = fmaf(a.w, x19, s3);
    a = *(const LAS f32x4*)(Am + 1992);
    s0 = fmaf(a.x, x20, s0);
    s1 = fmaf(a.y, x21, s1);
    s2 = fmaf(a.z, x22, s2);
    s3 = fmaf(a.w, x23, s3);
    a = *(const LAS f32x4*)(Am + 1996);
    s0 = fmaf(a.x, x24, s0);
    s1 = fmaf(a.y, x25, s1);
    s2 = fmaf(a.z, x26, s2);
    s3 = fmaf(a.w, x27, s3);
    a = *(const LAS f32x4*)(Am + 2000);
    const float al29 = a.x;
    x29 = (x29 - ((s0 + s1) + (s2 + s3))) - al29 * x28;
    Tu[3944 + c] = f2bf(x29 * su); Tw[3944 + c] = f2bf(x29 * sw); asm volatile("" ::: "memory");
    float x30 = fmaxf(0.0f, 1.0f - fabsf(cf - 30.0f));
    s0 = 0.f; s1 = 0.f; s2 = 0.f; s3 = 0.f;
    a = *(const LAS f32x4*)(Am + 2040);
    s0 = fmaf(a.x, x0, s0);
    s1 = fmaf(a.y, x1, s1);
    s2 = fmaf(a.z, x2, s2);
    s3 = fmaf(a.w, x3, s3);
    a = *(const LAS f32x4*)(Am + 2044);
    s0 = fmaf(a.x, x4, s0);
    s1 = fmaf(a.y, x5, s1);
    s2 = fmaf(a.z, x6, s2);
    s3 = fmaf(a.w, x7, s3);
    a = *(const LAS f32x4*)(Am + 2048);
    s0 = fmaf(a.x, x8, s0);
    s1 = fmaf(a.y, x9, s1);
    s2 = fmaf(a.z, x10, s2);
    s3 = fmaf(a.w, x11, s3);
    a = *(const LAS f32x4*)(Am + 2052);
    s0 = fmaf(a.x, x12, s0);
    s1 = fmaf(a.y, x13, s1);
    s2 = fmaf(a.z, x14, s2);
    s3 = fmaf(a.w, x15, s3);
    a = *(const LAS f32x4*)(Am + 2056);
    s0 = fmaf(a.x, x16, s0);
    s1 = fmaf(a.y, x17, s1);
    s2 = fmaf(a.z, x18, s2);
    s3 = fmaf(a.w, x19, s3);
    a = *(const LAS f32x4*)(Am + 2060);
    s0 = fmaf(a.x, x20, s0);
    s1 = fmaf(a.y, x21, s1);
    s2 = fmaf(a.z, x22, s2);
    s3 = fmaf(a.w, x23, s3);
    a = *(const LAS f32x4*)(Am + 2064);
    s0 = fmaf(a.x, x24, s0);
    s1 = fmaf(a.y, x25, s1);
    s2 = fmaf(a.z, x26, s2);
    s3 = fmaf(a.w, x27, s3);
    a = *(const LAS f32x4*)(Am + 2068);
    s0 = fmaf(a.x, x28, s0);
    const float al30 = a.y;
    x30 = (x30 - ((s0 + s1) + (s2 + s3))) - al30 * x29;
    Tu[4080 + c] = f2bf(x30 * su); Tw[4080 + c] = f2bf(x30 * sw); asm volatile("" ::: "memory");
    float x31 = fmaxf(0.0f, 1.0f - fabsf(cf - 31.0f));
    s0 = 0.f; s1 = 0.f; s2 = 0.f; s3 = 0.f;
    a = *(const LAS f32x4*)(Am + 2108);
    s0 = fmaf(a.x, x0, s0);
    s1 = fmaf(a.y, x1, s1);
    s2 = fmaf(a.z, x2, s2);
    s3 = fmaf(a.w, x3, s3);
    a = *(const LAS f32x4*)(Am + 2112);
    s0 = fmaf(a.x, x4, s0);
    s1 = fmaf(a.y, x5, s1);
    s2 = fmaf(a.z, x6, s2);
    s3 = fmaf(a.w, x7, s3);
    a = *(const LAS f32x4*)(Am + 2116);
    s0 = fmaf(a.x, x8, s0);
    s1 = fmaf(a.y, x9, s1);
    s2 = fmaf(a.z, x10, s2);
    s3 = fmaf(a.w, x11, s3);
    a = *(const LAS f32x4*)(Am + 2120);
    s0 = fmaf(a.x, x12, s0);
    s1 = fmaf(a.y, x13, s1);
    s2 = fmaf(a.z, x14, s2);
    s3 = fmaf(a.w, x15, s3);
    a = *(const LAS f32x4*)(Am + 2124);
    s0 = fmaf(a.x, x16, s0);
    s1 = fmaf(a.y, x17, s1);
    s2 = fmaf(a.z, x18, s2);
    s3 = fmaf(a.w, x19, s3);
    a = *(const LAS f32x4*)(Am + 2128);
    s0 = fmaf(a.x, x20, s0);
    s1 = fmaf(a.y, x21, s1);
    s2 = fmaf(a.z, x22, s2);
    s3 = fmaf(a.w, x23, s3);
    a = *(const LAS f32x4*)(Am + 2132);
    s0 = fmaf(a.x, x24, s0);
    s1 = fmaf(a.y, x25, s1);
    s2 = fmaf(a.z, x26, s2);
    s3 = fmaf(a.w, x27, s3);
    a = *(const LAS f32x4*)(Am + 2136);
    s0 = fmaf(a.x, x28, s0);
    s1 = fmaf(a.y, x29, s1);
    const float al31 = a.z;
    x31 = (x31 - ((s0 + s1) + (s2 + s3))) - al31 * x30;
    Tu[4216 + c] = f2bf(x31 * su); Tw[4216 + c] = f2bf(x31 * sw); asm volatile("" ::: "memory");
    float x32 = fmaxf(0.0f, 1.0f - fabsf(cf - 32.0f));
    s0 = 0.f; s1 = 0.f; s2 = 0.f; s3 = 0.f;
    a = *(const LAS f32x4*)(Am + 2176);
    s0 = fmaf(a.x, x0, s0);
    s1 = fmaf(a.y, x1, s1);
    s2 = fmaf(a.z, x2, s2);
    s3 = fmaf(a.w, x3, s3);
    a = *(const LAS f32x4*)(Am + 2180);
    s0 = fmaf(a.x, x4, s0);
    s1 = fmaf(a.y, x5, s1);
    s2 = fmaf(a.z, x6, s2);
    s3 = fmaf(a.w, x7, s3);
    a = *(const LAS f32x4*)(Am + 2184);
    s0 = fmaf(a.x, x8, s0);
    s1 = fmaf(a.y, x9, s1);
    s2 = fmaf(a.z, x10, s2);
    s3 = fmaf(a.w, x11, s3);
    a = *(const LAS f32x4*)(Am + 2188);
    s0 = fmaf(a.x, x12, s0);
    s1 = fmaf(a.y, x13, s1);
    s2 = fmaf(a.z, x14, s2);
    s3 = fmaf(a.w, x15, s3);
    a = *(const LAS f32x4*)(Am + 2192);
    s0 = fmaf(a.x, x16, s0);
    s1 = fmaf(a.y, x17, s1);
    s2 = fmaf(a.z, x18, s2);
    s3 = fmaf(a.w, x19, s3);
    a = *(const LAS f32x4*)(Am + 2196);
    s0 = fmaf(a.x, x20, s0);
    s1 = fmaf(a.y, x21, s1);
    s2 = fmaf(a.z, x22, s2);
    s3 = fmaf(a.w, x23, s3);
    a = *(const LAS f32x4*)(Am + 2200);
    s0 = fmaf(a.x, x24, s0);
    s1 = fmaf(a.y, x25, s1);
    s2 = fmaf(a.z, x26, s2);
    s3 = fmaf(a.w, x27, s3);
    a = *(const LAS f32x4*)(Am + 2204);
    s0 = fmaf(a.x, x28, s0);
    s1 = fmaf(a.y, x29, s1);
    s2 = fmaf(a.z, x30, s2);
    const float al32 = a.w;
    x32 = (x32 - ((s0 + s1) + (s2 + s3))) - al32 * x31;
    Tu[4352 + c] = f2bf(x32 * su); Tw[4352 + c] = f2bf(x32 * sw); asm volatile("" ::: "memory");
    float x33 = fmaxf(0.0f, 1.0f - fabsf(cf - 33.0f));
    s0 = 0.f; s1 = 0.f; s2 = 0.f; s3 = 0.f;
    a = *(const LAS f32x4*)(Am + 2244);
    s0 = fmaf(a.x, x0, s0);
    s1 = fmaf(a.y, x1, s1);
    s2 = fmaf(a.z, x2, s2);
    s3 = fmaf(a.w, x3, s3);
    a = *(const LAS f32x4*)(Am + 2248);
    s0 = fmaf(a.x, x4, s0);
    s1 = fmaf(a.y, x5, s1);
    s2 = fmaf(a.z, x6, s2);
    s3 = fmaf(a.w, x7, s3);
    a = *(const LAS f32x4*)(Am + 2252);
    s0 = fmaf(a.x, x8, s0);
    s1 = fmaf(a.y, x9, s1);
    s2 = fmaf(a.z, x10, s2);
    s3 = fmaf(a.w, x11, s3);
    a = *(const LAS f32x4*)(Am + 2256);
    s0 = fmaf(a.x, x12, s0);
    s1 = fmaf(a.y, x13, s1);
    s2 = fmaf(a.z, x14, s2);
    s3 = fmaf(a.w, x15, s3);
    a = *(const LAS f32x4*)(Am + 2260);
    s0 = fmaf(a.x, x16, s0);
    s1 = fmaf(a.y, x17, s1);
    s2 = fmaf(a.z, x18, s2);
    s3 = fmaf(a.w, x19, s3);
    a = *(const LAS f32x4*)(Am + 2264);
    s0 = fmaf(a.x, x20, s0);
    s1 = fmaf(a.y, x21, s1);
    s2 = fmaf(a.z, x22, s2);
    s3 = fmaf(a.w, x23, s3);
    a = *(const LAS f32x4*)(Am + 2268);
    s0 = fmaf(a.x, x24, s0);
    s1 = fmaf(a.y, x25, s1);
    s2 = fmaf(a.z, x26, s2);
    s3 = fmaf(a.w, x27, s3);
    a = *(const LAS f32x4*)(Am + 2272);
    s0 = fmaf(a.x, x28, s0);
    s1 = fmaf(a.y, x29, s1);
    s2 = fmaf(a.z, x30, s2);
    s3 = fmaf(a.w, x31, s3);
    a = *(const LAS f32x4*)(Am + 2276);
    const float al33 = a.x;
    x33 = (x33 - ((s0 + s1) + (s2 + s3))) - al33 * x32;
    Tu[4488 + c] = f2bf(x33 * su); Tw[4488 + c] = f2bf(x33 * sw); asm volatile("" ::: "memory");
    float x34 = fmaxf(0.0f, 1.0f - fabsf(cf - 34.0f));
    s0 = 0.f; s1 = 0.f; s2 = 0.f; s3 = 0.f;
    a = *(const LAS f32x4*)(Am + 2312);
    s0 = fmaf(a.x, x0, s0);
    s1 = fmaf(a.y, x1, s1);
    s2 = fmaf(a.z, x2, s2);
    s3 = fmaf(a.w, x3, s3);
    a = *(const LAS f32x4*)(Am + 2316);
    s0 = fmaf(a.x, x4, s0);
    s1 = fmaf(a.y, x5, s1);
    s2 = fmaf(a.z, x6, s2);
    s3 = fmaf(a.w, x7, s3);
    a = *(const LAS f32x4*)(Am + 2320);
    s0 = fmaf(a.x, x8, s0);
    s1 = fmaf(a.y, x9, s1);
    s2 = fmaf(a.z, x10, s2);
    s3 = fmaf(a.w, x11, s3);
    a = *(const LAS f32x4*)(Am + 2324);
    s0 = fmaf(a.x, x12, s0);
    s1 = fmaf(a.y, x13, s1);
    s2 = fmaf(a.z, x14, s2);
    s3 = fmaf(a.w, x15, s3);
    a = *(const LAS f32x4*)(Am + 2328);
    s0 = fmaf(a.x, x16, s0);
    s1 = fmaf(a.y, x17, s1);
    s2 = fmaf(a.z, x18, s2);
    s3 = fmaf(a.w, x19, s3);
    a = *(const LAS f32x4*)(Am + 2332);
    s0 = fmaf(a.x, x20, s0);
    s1 = fmaf(a.y, x21, s1);
    s2 = fmaf(a.z, x22, s2);
    s3 = fmaf(a.w, x23, s3);
    a = *(const LAS f32x4*)(Am + 2336);
    s0 = fmaf(a.x, x24, s0);
    s1 = fmaf(a.y, x25, s1);
    s2 = fmaf(a.z, x26, s2);
    s3 = fmaf(a.w, x27, s3);
    a = *(const LAS f32x4*)(Am + 2340);
    s0 = fmaf(a.x, x28, s0);
    s1 = fmaf(a.y, x29, s1);
    s2 = fmaf(a.z, x30, s2);
    s3 = fmaf(a.w, x31, s3);
    a = *(const LAS f32x4*)(Am + 2344);
    s0 = fmaf(a.x, x32, s0);
    const float al34 = a.y;
    x34 = (x34 - ((s0 + s1) + (s2 + s3))) - al34 * x33;
    Tu[4624 + c] = f2bf(x34 * su); Tw[4624 + c] = f2bf(x34 * sw); asm volatile("" ::: "memory");
    float x35 = fmaxf(0.0f, 1.0f - fabsf(cf - 35.0f));
    s0 = 0.f; s1 = 0.f; s2 = 0.f; s3 = 0.f;
    a = *(const LAS f32x4*)(Am + 2380);
    s0 = fmaf(a.x, x0, s0);
    s1 = fmaf(a.y, x1, s1);
    s2 = fmaf(a.z, x2, s2);
    s3 = fmaf(a.w, x3, s3);
    a = *(const LAS f32x4*)(Am + 2384);
    s0 = fmaf(a.x, x4, s0);
    s1 = fmaf(a.y, x5, s1);
    s2 = fmaf(a.z, x6, s2);
    s3 = fmaf(a.w, x7, s3);
    a = *(const LAS f32x4*)(Am + 2388);
    s0 = fmaf(a.x, x8, s0);
    s1 = fmaf(a.y, x9, s1);
    s2 = fmaf(a.z, x10, s2);
    s3 = fmaf(a.w, x11, s3);
    a = *(const LAS f32x4*)(Am + 2392);
    s0 = fmaf(a.x, x12, s0);
    s1 = fmaf(a.y, x13, s1);
    s2 = fmaf(a.z, x14, s2);
    s3 = fmaf(a.w, x15, s3);
    a = *(const LAS f32x4*)(Am + 2396);
    s0 = fmaf(a.x, x16, s0);
    s1 = fmaf(a.y, x17, s1);
    s2 = fmaf(a.z, x18, s2);
    s3 = fmaf(a.w, x19, s3);
    a = *(const LAS f32x4*)(Am + 2400);
    s0 = fmaf(a.x, x20, s0);
    s1 = fmaf(a.y, x21, s1);
    s2 = fmaf(a.z, x22, s2);
    s3 = fmaf(a.w, x23, s3);
    a = *(const LAS f32x4*)(Am + 2404);
    s0 = fmaf(a.x, x24, s0);
    s1 = fmaf(a.y, x25, s1);
    s2 = fmaf(a.z, x26, s2);
    s3 = fmaf(a.w, x27, s3);
    a = *(const LAS f32x4*)(Am + 2408);
    s0 = fmaf(a.x, x28, s0);
    s1 = fmaf(a.y, x29, s1);
    s2 = fmaf(a.z, x30, s2);
    s3 = fmaf(a.w, x31, s3);
    a = *(const LAS f32x4*)(Am + 2412);
    s0 = fmaf(a.x, x32, s0);
    s1 = fmaf(a.y, x33, s1);
    const float al35 = a.z;
    x35 = (x35 - ((s0 + s1) + (s2 + s3))) - al35 * x34;
    Tu[4760 + c] = f2bf(x35 * su); Tw[4760 + c] = f2bf(x35 * sw); asm volatile("" ::: "memory");
    float x36 = fmaxf(0.0f, 1.0f - fabsf(cf - 36.0f));
    s0 = 0.f; s1 = 0.f; s2 = 0.f; s3 = 0.f;
    a = *(const LAS f32x4*)(Am + 2448);
    s0 = fmaf(a.x, x0, s0);
    s1 = fmaf(a.y, x1, s1);
    s2 = fmaf(a.z, x2, s2);
    s3 = fmaf(a.w, x3, s3);
    a = *(const LAS f32x4*)(Am + 2452);
    s0 = fmaf(a.x, x4, s0);
    s1 = fmaf(a.y, x5, s1);
    s2 = fmaf(a.z, x6, s2);
    s3 = fmaf(a.w, x7, s3);
    a = *(const LAS f32x4*)(Am + 2456);
    s0 = fmaf(a.x, x8, s0);
    s1 = fmaf(a.y, x9, s1);
    s2 = fmaf(a.z, x10, s2);
    s3 = fmaf(a.w, x11, s3);
    a = *(const LAS f32x4*)(Am + 2460);
    s0 = fmaf(a.x, x12, s0);
    s1 = fmaf(a.y, x13, s1);
    s2 = fmaf(a.z, x14, s2);
    s3 = fmaf(a.w, x15, s3);
    a = *(const LAS f32x4*)(Am + 2464);
    s0 = fmaf(a.x, x16, s0);
    s1 = fmaf(a.y, x17, s1);
    s2 = fmaf(a.z, x18, s2);
    s3 = fmaf(a.w, x19, s3);
    a = *(const LAS f32x4*)(Am + 2468);
    s0 = fmaf(a.x, x20, s0);
    s1 = fmaf(a.y, x21, s1);
    s2 = fmaf(a.z, x22, s2);
    s3 = fmaf(a.w, x23, s3);
    a = *(const LAS f32x4*)(Am + 2472);
    s0 = fmaf(a.x, x24, s0);
    s1 = fmaf(a.y, x25, s1);
    s2 = fmaf(a.z, x26, s2);
    s3 = fmaf(a.w, x27, s3);
    a = *(const LAS f32x4*)(Am + 2476);
    s0 = fmaf(a.x, x28, s0);
    s1 = fmaf(a.y, x29, s1);
    s2 = fmaf(a.z, x30, s2);
    s3 = fmaf(a.w, x31, s3);
    a = *(const LAS f32x4*)(Am + 2480);
    s0 = fmaf(a.x, x32, s0);
    s1 = fmaf(a.y, x33, s1);
    s2 = fmaf(a.z, x34, s2);
    const float al36 = a.w;
    x36 = (x36 - ((s0 + s1) + (s2 + s3))) - al36 * x35;
    Tu[4896 + c] = f2bf(x36 * su); Tw[4896 + c] = f2bf(x36 * sw); asm volatile("" ::: "memory");
    float x37 = fmaxf(0.0f, 1.0f - fabsf(cf - 37.0f));
    s0 = 0.f; s1 = 0.f; s2 = 0.f; s3 = 0.f;
    a = *(const LAS f32x4*)(Am + 2516);
    s0 = fmaf(a.x, x0, s0);
    s1 = fmaf(a.y, x1, s1);
    s2 = fmaf(a.z, x2, s2);
    s3 = fmaf(a.w, x3, s3);
    a = *(const LAS f32x4*)(Am + 2520);
    s0 = fmaf(a.x, x4, s0);
    s1 = fmaf(a.y, x5, s1);
    s2 = fmaf(a.z, x6, s2);
    s3 = fmaf(a.w, x7, s3);
    a = *(const LAS f32x4*)(Am + 2524);
    s0 = fmaf(a.x, x8, s0);
    s1 = fmaf(a.y, x9, s1);
    s2 = fmaf(a.z, x10, s2);
    s3 = fmaf(a.w, x11, s3);
    a = *(const LAS f32x4*)(Am + 2528);
    s0 = fmaf(a.x, x12, s0);
    s1 = fmaf(a.y, x13, s1);
    s2 = fmaf(a.z, x14, s2);
    s3 = fmaf(a.w, x15, s3);
    a = *(const LAS f32x4*)(Am + 2532);
    s0 = fmaf(a.x, x16, s0);
    s1 = fmaf(a.y, x17, s1);
    s2 = fmaf(a.z, x18, s2);
    s3 = fmaf(a.w, x19, s3);
    a = *(const LAS f32x4*)(Am + 2536);
    s0 = fmaf(a.x, x20, s0);
    s1 = fmaf(a.y, x21, s1);
    s2 = fmaf(a.z, x22, s2);
    s3 = fmaf(a.w, x23, s3);
    a = *(const LAS f32x4*)(Am + 2540);
    s0 = fmaf(a.x, x24, s0);
    s1 = fmaf(a.y, x25, s1);
    s2 = fmaf(a.z, x26, s2);
    s3 = fmaf(a.w, x27, s3);
    a = *(const LAS f32x4*)(Am + 2544);
    s0 = fmaf(a.x, x28, s0);
    s1 = fmaf(a.y, x29, s1);
    s2 = fmaf(a.z, x30, s2);
    s3 = fmaf(a.w, x31, s3);
    a = *(const LAS f32x4*)(Am + 2548);
    s0 = fmaf(a.x, x32, s0);
    s1 = fmaf(a.y, x33, s1);
    s2 = fmaf(a.z, x34, s2);
    s3 = fmaf(a.w, x35, s3);
    a = *(const LAS f32x4*)(Am + 2552);
    const float al37 = a.x;
    x37 = (x37 - ((s0 + s1) + (s2 + s3))) - al37 * x36;
    Tu[5032 + c] = f2bf(x37 * su); Tw[5032 + c] = f2bf(x37 * sw); asm volatile("" ::: "memory");
    float x38 = fmaxf(0.0f, 1.0f - fabsf(cf - 38.0f));
    s0 = 0.f; s1 = 0.f; s2 = 0.f; s3 = 0.f;
    a = *(const LAS f32x4*)(Am + 2584);
    s0 = fmaf(a.x, x0, s0);
    s1 = fmaf(a.y, x1, s1);
    s2 = fmaf(a.z, x2, s2);
    s3 = fmaf(a.w, x3, s3);
    a = *(const LAS f32x4*)(Am + 2588);
    s0 = fmaf(a.x, x4, s0);
    s1 = fmaf(a.y, x5, s1);
    s2 = fmaf(a.z, x6, s2);
    s3 = fmaf(a.w, x7, s3);
    a = *(const LAS f32x4*)(Am + 2592);
    s0 = fmaf(a.x, x8, s0);
    s1 = fmaf(a.y, x9, s1);
    s2 = fmaf(a.z, x10, s2);
    s3 = fmaf(a.w, x11, s3);
    a = *(const LAS f32x4*)(Am + 2596);
    s0 = fmaf(a.x, x12, s0);
    s1 = fmaf(a.y, x13, s1);
    s2 = fmaf(a.z, x14, s2);
    s3 = fmaf(a.w, x15, s3);
    a = *(const LAS f32x4*)(Am + 2600);
    s0 = fmaf(a.x, x16, s0);
    s1 = fmaf(a.y, x17, s1);
    s2 = fmaf(a.z, x18, s2);
    s3 = fmaf(a.w, x19, s3);
    a = *(const LAS f32x4*)(Am + 2604);
    s0 = fmaf(a.x, x20, s0);
    s1 = fmaf(a.y, x21, s1);
    s2 = fmaf(a.z, x22, s2);
    s3 = fmaf(a.w, x23, s3);
    a = *(const LAS f32x4*)(Am + 2608);
    s0 = fmaf(a.x, x24, s0);
    s1 = fmaf(a.y, x25, s1);
    s2 = fmaf(a.z, x26, s2);
    s3 = fmaf(a.w, x27, s3);
    a = *(const LAS f32x4*)(Am + 2612);
    s0 = fmaf(a.x, x28, s0);
    s1 = fmaf(a.y, x29, s1);
    s2 = fmaf(a.z, x30, s2);
    s3 = fmaf(a.w, x31, s3);
    a = *(const LAS f32x4*)(Am + 2616);
    s0 = fmaf(a.x, x32, s0);
    s1 = fmaf(a.y, x33, s1);
    s2 = fmaf(a.z, x34, s2);
    s3 = fmaf(a.w, x35, s3);
    a = *(const LAS f32x4*)(Am + 2620);
    s0 = fmaf(a.x, x36, s0);
    const float al38 = a.y;
    x38 = (x38 - ((s0 + s1) + (s2 + s3))) - al38 * x37;
    Tu[5168 + c] = f2bf(x38 * su); Tw[5168 + c] = f2bf(x38 * sw); asm volatile("" ::: "memory");
    float x39 = fmaxf(0.0f, 1.0f - fabsf(cf - 39.0f));
    s0 = 0.f; s1 = 0.f; s2 = 0.f; s3 = 0.f;
    a = *(const LAS f32x4*)(Am + 2652);
    s0 = fmaf(a.x, x0, s0);
    s1 = fmaf(a.y, x1, s1);
    s2 = fmaf(a.z, x2, s2);
    s3 = fmaf(a.w, x3, s3);
    a = *(const LAS f32x4*)(Am + 2656);
    s0 = fmaf(a.x, x4, s0);
    s1 = fmaf(a.y, x5, s1);
    s2 = fmaf(a.z, x6, s2);
    s3 = fmaf(a.w, x7, s3);
    a = *(const LAS f32x4*)(Am + 2660);
    s0 = fmaf(a.x, x8, s0);
    s1 = fmaf(a.y, x9, s1);
    s2 = fmaf(a.z, x10, s2);
    s3 = fmaf(a.w, x11, s3);
    a = *(const LAS f32x4*)(Am + 2664);
    s0 = fmaf(a.x, x12, s0);
    s1 = fmaf(a.y, x13, s1);
    s2 = fmaf(a.z, x14, s2);
    s3 = fmaf(a.w, x15, s3);
    a = *(const LAS f32x4*)(Am + 2668);
    s0 = fmaf(a.x, x16, s0);
    s1 = fmaf(a.y, x17, s1);
    s2 = fmaf(a.z, x18, s2);
    s3 = fmaf(a.w, x19, s3);
    a = *(const LAS f32x4*)(Am + 2672);
    s0 = fmaf(a.x, x20, s0);
    s1 = fmaf(a.y, x21, s1);
    s2 = fmaf(a.z, x22, s2);
    s3 = fmaf(a.w, x23, s3);
    a = *(const LAS f32x4*)(Am + 2676);
    s0 = fmaf(a.x, x24, s0);
    s1 = fmaf(a.y, x25, s1);
    s2 = fmaf(a.z, x26, s2);
    s3 = fmaf(a.w, x27, s3);
    a = *(const LAS f32x4*)(Am + 2680);
    s0 = fmaf(a.x, x28, s0);
    s1 = fmaf(a.y, x29, s1);
    s2 = fmaf(a.z, x30, s2);
    s3 = fmaf(a.w, x31, s3);
    a = *(const LAS f32x4*)(Am + 2684);
    s0 = fmaf(a.x, x32, s0);
    s1 = fmaf(a.y, x33, s1);
    s2 = fmaf(a.z, x34, s2);
    s3 = fmaf(a.w, x35, s3);
    a = *(const LAS f32x4*)(Am + 2688);
    s0 = fmaf(a.x, x36, s0);
    s1 = fmaf(a.y, x37, s1);
    const float al39 = a.z;
    x39 = (x39 - ((s0 + s1) + (s2 + s3))) - al39 * x38;
    Tu[5304 + c] = f2bf(x39 * su); Tw[5304 + c] = f2bf(x39 * sw); asm volatile("" ::: "memory");
    float x40 = fmaxf(0.0f, 1.0f - fabsf(cf - 40.0f));
    s0 = 0.f; s1 = 0.f; s2 = 0.f; s3 = 0.f;
    a = *(const LAS f32x4*)(Am + 2720);
    s0 = fmaf(a.x, x0, s0);
    s1 = fmaf(a.y, x1, s1);
    s2 = fmaf(a.z, x2, s2);
    s3 = fmaf(a.w, x3, s3);
    a = *(const LAS f32x4*)(Am + 2724);
    s0 = fmaf(a.x, x4, s0);
    s1 = fmaf(a.y, x5, s1);
    s2 = fmaf(a.z, x6, s2);
    s3 = fmaf(a.w, x7, s3);
    a = *(const LAS f32x4*)(Am + 2728);
    s0 = fmaf(a.x, x8, s0);
    s1 = fmaf(a.y, x9, s1);
    s2 = fmaf(a.z, x10, s2);
    s3 = fmaf(a.w, x11, s3);
    a = *(const LAS f32x4*)(Am + 2732);
    s0 = fmaf(a.x, x12, s0);
    s1 = fmaf(a.y, x13, s1);
    s2 = fmaf(a.z, x14, s2);
    s3 = fmaf(a.w, x15, s3);
    a = *(const LAS f32x4*)(Am + 2736);
    s0 = fmaf(a.x, x16, s0);
    s1 = fmaf(a.y, x17, s1);
    s2 = fmaf(a.z, x18, s2);
    s3 = fmaf(a.w, x19, s3);
    a = *(const LAS f32x4*)(Am + 2740);
    s0 = fmaf(a.x, x20, s0);
    s1 = fmaf(a.y, x21, s1);
    s2 = fmaf(a.z, x22, s2);
    s3 = fmaf(a.w, x23, s3);
    a = *(const LAS f32x4*)(Am + 2744);
    s0 = fmaf(a.x, x24, s0);
    s1 = fmaf(a.y, x25, s1);
    s2 = fmaf(a.z, x26, s2);
    s3 = fmaf(a.w, x27, s3);
    a = *(const LAS f32x4*)(Am + 2748);
    s0 = fmaf(a.x, x28, s0);
    s1 = fmaf(a.y, x29, s1);
    s2 = fmaf(a.z, x30, s2);
    s3 = fmaf(a.w, x31, s3);
    a = *(const LAS f32x4*)(Am + 2752);
    s0 = fmaf(a.x, x32, s0);
    s1 = fmaf(a.y, x33, s1);
    s2 = fmaf(a.z, x34, s2);
    s3 = fmaf(a.w, x35, s3);
    a = *(const LAS f32x4*)(Am + 2756);
    s0 = fmaf(a.x, x36, s0);
    s1 = fmaf(a.y, x37, s1);
    s2 = fmaf(a.z, x38, s2);
    const float al40 = a.w;
    x40 = (x40 - ((s0 + s1) + (s2 + s3))) - al40 * x39;
    Tu[5440 + c] = f2bf(x40 * su); Tw[5440 + c] = f2bf(x40 * sw); asm volatile("" ::: "memory");
    float x41 = fmaxf(0.0f, 1.0f - fabsf(cf - 41.0f));
    s0 = 0.f; s1 = 0.f; s2 = 0.f; s3 = 0.f;
    a = *(const LAS f32x4*)(Am + 2788);
    s0 = fmaf(a.x, x0, s0);
    s1 = fmaf(a.y, x1, s1);
    s2 = fmaf(a.z, x2, s2);
    s3 = fmaf(a.w, x3, s3);
    a = *(const LAS f32x4*)(Am + 2792);
    s0 = fmaf(a.x, x4, s0);
    s1 = fmaf(a.y, x5, s1);
    s2 = fmaf(a.z, x6, s2);
    s3 = fmaf(a.w, x7, s3);
    a = *(const LAS f32x4*)(Am + 2796);
    s0 = fmaf(a.x, x8, s0);
    s1 = fmaf(a.y, x9, s1);
    s2 = fmaf(a.z, x10, s2);
    s3 = fmaf(a.w, x11, s3);
    a = *(const LAS f32x4*)(Am + 2800);
    s0 = fmaf(a.x, x12, s0);
    s1 = fmaf(a.y, x13, s1);
    s2 = fmaf(a.z, x14, s2);
    s3 = fmaf(a.w, x15, s3);
    a = *(const LAS f32x4*)(Am + 2804);
    s0 = fmaf(a.x, x16, s0);
    s1 = fmaf(a.y, x17, s1);
    s2 = fmaf(a.z, x18, s2);
    s3 = fmaf(a.w, x19, s3);
    a = *(const LAS f32x4*)(Am + 2808);
    s0 = fmaf(a.x, x20, s0);
    s1 = fmaf(a.y, x21, s1);
    s2 = fmaf(a.z, x22, s2);
    s3 = fmaf(a.w, x23, s3);
    a = *(const LAS f32x4*)(Am + 2812);
    s0 = fmaf(a.x, x24, s0);
    s1 = fmaf(a.y, x25, s1);
    s2 = fmaf(a.z, x26, s2);
    s3 = fmaf(a.w, x27, s3);
    a = *(const LAS f32x4*)(Am + 2816);
    s0 = fmaf(a.x, x28, s0);
    s1 = fmaf(a.y, x29, s1);
    s2 = fmaf(a.z, x30, s2);
    s3 = fmaf(a.w, x31, s3);
    a = *(const LAS f32x4*)(Am + 2820);
    s0 = fmaf(a.x, x32, s0);
    s1 = fmaf(a.y, x33, s1);
    s2 = fmaf(a.z, x34, s2);
    s3 = fmaf(a.w, x35, s3);
    a = *(const LAS f32x4*)(Am + 2824);
    s0 = fmaf(a.x, x36, s0);
    s1 = fmaf(a.y, x37, s1);
    s2 = fmaf(a.z, x38, s2);
    s3 = fmaf(a.w, x39, s3);
    a = *(const LAS f32x4*)(Am + 2828);
    const float al41 = a.x;
    x41 = (x41 - ((s0 + s1) + (s2 + s3))) - al41 * x40;
    Tu[5576 + c] = f2bf(x41 * su); Tw[5576 + c] = f2bf(x41 * sw); asm volatile("" ::: "memory");
    float x42 = fmaxf(0.0f, 1.0f - fabsf(cf - 42.0f));
    s0 = 0.f; s1 = 0.f; s2 = 0.f; s3 = 0.f;
    a = *(const LAS f32x4*)(Am + 2856);
    s0 = fmaf(a.x, x0, s0);
    s1 = fmaf(a.y, x1, s1);
    s2 = fmaf(a.z, x2, s2);
    s3 = fmaf(a.w, x3, s3);
    a = *(const LAS f32x4*)(Am + 2860);
    s0 = fmaf(a.x, x4, s0);
    s1 = fmaf(a.y, x5, s1);
    s2 = fmaf(a.z, x6, s2);
    s3 = fmaf(a.w, x7, s3);
    a = *(const LAS f32x4*)(Am + 2864);
    s0 = fmaf(a.x, x8, s0);
    s1 = fmaf(a.y, x9, s1);
    s2 = fmaf(a.z, x10, s2);
    s3 = fmaf(a.w, x11, s3);
    a = *(const LAS f32x4*)(Am + 2868);
    s0 = fmaf(a.x, x12, s0);
    s1 = fmaf(a.y, x13, s1);
    s2 = fmaf(a.z, x14, s2);
    s3 = fmaf(a.w, x15, s3);
    a = *(const LAS f32x4*)(Am + 2872);
    s0 = fmaf(a.x, x16, s0);
    s1 = fmaf(a.y, x17, s1);
    s2 = fmaf(a.z, x18, s2);
    s3 = fmaf(a.w, x19, s3);
    a = *(const LAS f32x4*)(Am + 2876);
    s0 = fmaf(a.x, x20, s0);
    s1 = fmaf(a.y, x21, s1);
    s2 = fmaf(a.z, x22, s2);
    s3 = fmaf(a.w, x23, s3);
    a = *(const LAS f32x4*)(Am + 2880);
    s0 = fmaf(a.x, x24, s0);
    s1 = fmaf(a.y, x25, s1);
    s2 = fmaf(a.z, x26, s2);
    s3 = fmaf(a.w, x27, s3);
    a = *(const LAS f32x4*)(Am + 2884);
    s0 = fmaf(a.x, x28, s0);
    s1 = fmaf(a.y, x29, s1);
    s2 = fmaf(a.z, x30, s2);
    s3 = fmaf(a.w, x31, s3);
    a = *(const LAS f32x4*)(Am + 2888);
    s0 = fmaf(a.x, x32, s0);
    s1 = fmaf(a.y, x33, s1);
    s2 = fmaf(a.z, x34, s2);
    s3 = fmaf(a.w, x35, s3);
    a = *(const LAS f32x4*)(Am + 2892);
    s0 = fmaf(a.x, x36, s0);
    s1 = fmaf(a.y, x37, s1);
    s2 = fmaf(a.z, x38, s2);
    s3 = fmaf(a.w, x39, s3);
    a = *(const LAS f32x4*)(Am + 2896);
    s0 = fmaf(a.x, x40, s0);
    const float al42 = a.y;
    x42 = (x42 - ((s0 + s1) + (s2 + s3))) - al42 * x41;
    Tu[5712 + c] = f2bf(x42 * su); Tw[5712 + c] = f2bf(x42 * sw); asm volatile("" ::: "memory");
    float x43 = fmaxf(0.0f, 1.0f - fabsf(cf - 43.0f));
    s0 = 0.f; s1 = 0.f; s2 = 0.f; s3 = 0.f;
    a = *(const LAS f32x4*)(Am + 2924);
    s0 = fmaf(a.x, x0, s0);
    s1 = fmaf(a.y, x1, s1);
    s2 = fmaf(a.z, x2, s2);
    s3 = fmaf(a.w, x3, s3);
    a = *(const LAS f32x4*)(Am + 2928);
    s0 = fmaf(a.x, x4, s0);
    s1 = fmaf(a.y, x5, s1);
    s2 = fmaf(a.z, x6, s2);
    s3 = fmaf(a.w, x7, s3);
    a = *(const LAS f32x4*)(Am + 2932);
    s0 = fmaf(a.x, x8, s0);
    s1 = fmaf(a.y, x9, s1);
    s2 = fmaf(a.z, x10, s2);
    s3 = fmaf(a.w, x11, s3);
    a = *(const LAS f32x4*)(Am + 2936);
    s0 = fmaf(a.x, x12, s0);
    s1 = fmaf(a.y, x13, s1);
    s2 = fmaf(a.z, x14, s2);
    s3 = fmaf(a.w, x15, s3);
    a = *(const LAS f32x4*)(Am + 2940);
    s0 = fmaf(a.x, x16, s0);
    s1 = fmaf(a.y, x17, s1);
    s2 = fmaf(a.z, x18, s2);
    s3 = fmaf(a.w, x19, s3);
    a = *(const LAS f32x4*)(Am + 2944);
    s0 = fmaf(a.x, x20, s0);
    s1 = fmaf(a.y, x21, s1);
    s2 = fmaf(a.z, x22, s2);
    s3 = fmaf(a.w, x23, s3);
    a = *(const LAS f32x4*)(Am + 2948);
    s0 = fmaf(a.x, x24, s0);
    s1 = fmaf(a.y, x25, s1);
    s2 = fmaf(a.z, x26, s2);
    s3 = fmaf(a.w, x27, s3);
    a = *(const LAS f32x4*)(Am + 2952);
    s0 = fmaf(a.x, x28, s0);
    s1 = fmaf(a.y, x29, s1);
    s2 = fmaf(a.z, x30, s2);
    s3 = fmaf(a.w, x31, s3);
    a = *(const LAS f32x4*)(Am + 2956);
    s0 = fmaf(a.x, x32, s0);
    s1 = fmaf(a.y, x33, s1);
    s2 = fmaf(a.z, x34, s2);
    s3 = fmaf(a.w, x35, s3);
    a = *(const LAS f32x4*)(Am + 2960);
    s0 = fmaf(a.x, x36, s0);
    s1 = fmaf(a.y, x37, s1);
    s2 = fmaf(a.z, x38, s2);
    s3 = fmaf(a.w, x39, s3);
    a = *(const LAS f32x4*)(Am + 2964);
    s0 = fmaf(a.x, x40, s0);
    s1 = fmaf(a.y, x41, s1);
    const float al43 = a.z;
    x43 = (x43 - ((s0 + s1) + (s2 + s3))) - al43 * x42;
    Tu[5848 + c] = f2bf(x43 * su); Tw[5848 + c] = f2bf(x43 * sw); asm volatile("" ::: "memory");
    float x44 = fmaxf(0.0f, 1.0f - fabsf(cf - 44.0f));
    s0 = 0.f; s1 = 0.f; s2 = 0.f; s3 = 0.f;
    a = *(const LAS f32x4*)(Am + 2992);
    s0 = fmaf(a.x, x0, s0);
    s1 = fmaf(a.y, x1, s1);
    s2 = fmaf(a.z, x2, s2);
    s3 = fmaf(a.w, x3, s3);
    a = *(const LAS f32x4*)(Am + 2996);
    s0 = fmaf(a.x, x4, s0);
    s1 = fmaf(a.y, x5, s1);
    s2 = fmaf(a.z, x6, s2);
    s3 = fmaf(a.w, x7, s3);
    a = *(const LAS f32x4*)(Am + 3000);
    s0 = fmaf(a.x, x8, s0);
    s1 = fmaf(a.y, x9, s1);
    s2 = fmaf(a.z, x10, s2);
    s3 = fmaf(a.w, x11, s3);
    a = *(const LAS f32x4*)(Am + 3004);
    s0 = fmaf(a.x, x12, s0);
    s1 = fmaf(a.y, x13, s1);
    s2 = fmaf(a.z, x14, s2);
    s3 = fmaf(a.w, x15, s3);
    a = *(const LAS f32x4*)(Am + 3008);
    s0 = fmaf(a.x, x16, s0);
    s1 = fmaf(a.y, x17, s1);
    s2 = fmaf(a.z, x18, s2);
    s3 = fmaf(a.w, x19, s3);
    a = *(const LAS f32x4*)(Am + 3012);
    s0 = fmaf(a.x, x20, s0);
    s1 = fmaf(a.y, x21, s1);
    s2 = fmaf(a.z, x22, s2);
    s3 = fmaf(a.w, x23, s3);
    a = *(const LAS f32x4*)(Am + 3016);
    s0 = fmaf(a.x, x24, s0);
    s1 = fmaf(a.y, x25, s1);
    s2 = fmaf(a.z, x26, s2);
    s3 = fmaf(a.w, x27, s3);
    a = *(const LAS f32x4*)(Am + 3020);
    s0 = fmaf(a.x, x28, s0);
    s1 = fmaf(a.y, x29, s1);
    s2 = fmaf(a.z, x30, s2);
    s3 = fmaf(a.w, x31, s3);
    a = *(const LAS f32x4*)(Am + 3024);
    s0 = fmaf(a.x, x32, s0);
    s1 = fmaf(a.y, x33, s1);
    s2 = fmaf(a.z, x34, s2);
    s3 = fmaf(a.w, x35, s3);
    a = *(const LAS f32x4*)(Am + 3028);
    s0 = fmaf(a.x, x36, s0);
    s1 = fmaf(a.y, x37, s1);
    s2 = fmaf(a.z, x38, s2);
    s3 = fmaf(a.w, x39, s3);
    a = *(const LAS f32x4*)(Am + 3032);
    s0 = fmaf(a.x, x40, s0);
    s1 = fmaf(a.y, x41, s1);
    s2 = fmaf(a.z, x42, s2);
    const float al44 = a.w;
    x44 = (x44 - ((s0 + s1) + (s2 + s3))) - al44 * x43;
    Tu[5984 + c] = f2bf(x44 * su); Tw[5984 + c] = f2bf(x44 * sw); asm volatile("" ::: "memory");
    float x45 = fmaxf(0.0f, 1.0f - fabsf(cf - 45.0f));
    s0 = 0.f; s1 = 0.f; s2 = 0.f; s3 = 0.f;
    a = *(const LAS f32x4*)(Am + 3060);
    s0 = fmaf(a.x, x0, s0);
    s1 = fmaf(a.y, x1, s1);
    s2 = fmaf(a.z, x2, s2);
    s3 = fmaf(a.w, x3, s3);
    a = *(const LAS f32x4*)(Am + 3064);
    s0 = fmaf(a.x, x4, s0);
    s1 = fmaf(a.y, x5, s1);
    s2 = fmaf(a.z, x6, s2);
    s3 = fmaf(a.w, x7, s3);
    a = *(const LAS f32x4*)(Am + 3068);
    s0 = fmaf(a.x, x8, s0);
    s1 = fmaf(a.y, x9, s1);
    s2 = fmaf(a.z, x10, s2);
    s3 = fmaf(a.w, x11, s3);
    a = *(const LAS f32x4*)(Am + 3072);
    s0 = fmaf(a.x, x12, s0);
    s1 = fmaf(a.y, x13, s1);
    s2 = fmaf(a.z, x14, s2);
    s3 = fmaf(a.w, x15, s3);
    a = *(const LAS f32x4*)(Am + 3076);
    s0 = fmaf(a.x, x16, s0);
    s1 = fmaf(a.y, x17, s1);
    s2 = fmaf(a.z, x18, s2);
    s3 = fmaf(a.w, x19, s3);
    a = *(const LAS f32x4*)(Am + 3080);
    s0 = fmaf(a.x, x20, s0);
    s1 = fmaf(a.y, x21, s1);
    s2 = fmaf(a.z, x22, s2);
    s3 = fmaf(a.w, x23, s3);
    a = *(const LAS f32x4*)(Am + 3084);
    s0 = fmaf(a.x, x24, s0);
    s1 = fmaf(a.y, x25, s1);
    s2 = fmaf(a.z, x26, s2);
    s3 = fmaf(a.w, x27, s3);
    a = *(const LAS f32x4*)(Am + 3088);
    s0 = fmaf(a.x, x28, s0);
    s1 = fmaf(a.y, x29, s1);
    s2 = fmaf(a.z, x30, s2);
    s3 = fmaf(a.w, x31, s3);
    a = *(const LAS f32x4*)(Am + 3092);
    s0 = fmaf(a.x, x32, s0);
    s1 = fmaf(a.y, x33, s1);
    s2 = fmaf(a.z, x34, s2);
    s3 = fmaf(a.w, x35, s3);
    a = *(const LAS f32x4*)(Am + 3096);
    s0 = fmaf(a.x, x36, s0);
    s1 = fmaf(a.y, x37, s1);
    s2 = fmaf(a.z, x38, s2);
    s3 = fmaf(a.w, x39, s3);
    a = *(const LAS f32x4*)(Am + 3100);
    s0 = fmaf(a.x, x40, s0);
    s1 = fmaf(a.y, x41, s1);
    s2 = fmaf(a.z, x42, s2);
    s3 = fmaf(a.w, x43, s3);
    a = *(const LAS f32x4*)(Am + 3104);
    const float al45 = a.x;
    x45 = (x45 - ((s0 + s1) + (s2 + s3))) - al45 * x44;
    Tu[6120 + c] = f2bf(x45 * su); Tw[6120 + c] = f2bf(x45 * sw); asm volatile("" ::: "memory");
    float x46 = fmaxf(0.0f, 1.0f - fabsf(cf - 46.0f));
    s0 = 0.f; s1 = 0.f; s2 = 0.f; s3 = 0.f;
    a = *(const LAS f32x4*)(Am + 3128);
    s0 = fmaf(a.x, x0, s0);
    s1 = fmaf(a.y, x1, s1);
    s2 = fmaf(a.z, x2, s2);
    s3 = fmaf(a.w, x3, s3);
    a = *(const LAS f32x4*)(Am + 3132);
    s0 = fmaf(a.x, x4, s0);
    s1 = fmaf(a.y, x5, s1);
    s2 = fmaf(a.z, x6, s2);
    s3 = fmaf(a.w, x7, s3);
    a = *(const LAS f32x4*)(Am + 3136);
    s0 = fmaf(a.x, x8, s0);
    s1 = fmaf(a.y, x9, s1);
    s2 = fmaf(a.z, x10, s2);
    s3 = fmaf(a.w, x11, s3);
    a = *(const LAS f32x4*)(Am + 3140);
    s0 = fmaf(a.x, x12, s0);
    s1 = fmaf(a.y, x13, s1);
    s2 = fmaf(a.z, x14, s2);
    s3 = fmaf(a.w, x15, s3);
    a = *(const LAS f32x4*)(Am + 3144);
    s0 = fmaf(a.x, x16, s0);
    s1 = fmaf(a.y, x17, s1);
    s2 = fmaf(a.z, x18, s2);
    s3 = fmaf(a.w, x19, s3);
    a = *(const LAS f32x4*)(Am + 3148);
    s0 = fmaf(a.x, x20, s0);
    s1 = fmaf(a.y, x21, s1);
    s2 = fmaf(a.z, x22, s2);
    s3 = fmaf(a.w, x23, s3);
    a = *(const LAS f32x4*)(Am + 3152);
    s0 = fmaf(a.x, x24, s0);
    s1 = fmaf(a.y, x25, s1);
    s2 = fmaf(a.z, x26, s2);
    s3 = fmaf(a.w, x27, s3);
    a = *(const LAS f32x4*)(Am + 3156);
    s0 = fmaf(a.x, x28, s0);
    s1 = fmaf(a.y, x29, s1);
    s2 = fmaf(a.z, x30, s2);
    s3 = fmaf(a.w, x31, s3);
    a = *(const LAS f32x4*)(Am + 3160);
    s0 = fmaf(a.x, x32, s0);
    s1 = fmaf(a.y, x33, s1);
    s2 = fmaf(a.z, x34, s2);
    s3 = fmaf(a.w, x35, s3);
    a = *(const LAS f32x4*)(Am + 3164);
    s0 = fmaf(a.x, x36, s0);
    s1 = fmaf(a.y, x37, s1);
    s2 = fmaf(a.z, x38, s2);
    s3 = fmaf(a.w, x39, s3);
    a = *(const LAS f32x4*)(Am + 3168);
    s0 = fmaf(a.x, x40, s0);
    s1 = fmaf(a.y, x41, s1);
    s2 = fmaf(a.z, x42, s2);
    s3 = fmaf(a.w, x43, s3);
    a = *(const LAS f32x4*)(Am + 3172);
    s0 = fmaf(a.x, x44, s0);
    const float al46 = a.y;
    x46 = (x46 - ((s0 + s1) + (s2 + s3))) - al46 * x45;
    Tu[6256 + c] = f2bf(x46 * su); Tw[6256 + c] = f2bf(x46 * sw); asm volatile("" ::: "memory");
    float x47 = fmaxf(0.0f, 1.0f - fabsf(cf - 47.0f));
    s0 = 0.f; s1 = 0.f; s2 = 0.f; s3 = 0.f;
    a = *(const LAS f32x4*)(Am + 3196);
    s0 = fmaf(a.x, x0, s0);
    s1 = fmaf(a.y, x1, s1);
    s2 = fmaf(a.z, x2, s2);
    s3 = fmaf(a.w, x3, s3);
    a = *(const LAS f32x4*)(Am + 3200);
    s0 = fmaf(a.x, x4, s0);
    s1 = fmaf(a.y, x5, s1);
    s2 = fmaf(a.z, x6, s2);
    s3 = fmaf(a.w, x7, s3);
    a = *(const LAS f32x4*)(Am + 3204);
    s0 = fmaf(a.x, x8, s0);
    s1 = fmaf(a.y, x9, s1);
    s2 = fmaf(a.z, x10, s2);
    s3 = fmaf(a.w, x11, s3);
    a = *(const LAS f32x4*)(Am + 3208);
    s0 = fmaf(a.x, x12, s0);
    s1 = fmaf(a.y, x13, s1);
    s2 = fmaf(a.z, x14, s2);
    s3 = fmaf(a.w, x15, s3);
    a = *(const LAS f32x4*)(Am + 3212);
    s0 = fmaf(a.x, x16, s0);
    s1 = fmaf(a.y, x17, s1);
    s2 = fmaf(a.z, x18, s2);
    s3 = fmaf(a.w, x19, s3);
    a = *(const LAS f32x4*)(Am + 3216);
    s0 = fmaf(a.x, x20, s0);
    s1 = fmaf(a.y, x21, s1);
    s2 = fmaf(a.z, x22, s2);
    s3 = fmaf(a.w, x23, s3);
    a = *(const LAS f32x4*)(Am + 3220);
    s0 = fmaf(a.x, x24, s0);
    s1 = fmaf(a.y, x25, s1);
    s2 = fmaf(a.z, x26, s2);
    s3 = fmaf(a.w, x27, s3);
    a = *(const LAS f32x4*)(Am + 3224);
    s0 = fmaf(a.x, x28, s0);
    s1 = fmaf(a.y, x29, s1);
    s2 = fmaf(a.z, x30, s2);
    s3 = fmaf(a.w, x31, s3);
    a = *(const LAS f32x4*)(Am + 3228);
    s0 = fmaf(a.x, x32, s0);
    s1 = fmaf(a.y, x33, s1);
    s2 = fmaf(a.z, x34, s2);
    s3 = fmaf(a.w, x35, s3);
    a = *(const LAS f32x4*)(Am + 3232);
    s0 = fmaf(a.x, x36, s0);
    s1 = fmaf(a.y, x37, s1);
    s2 = fmaf(a.z, x38, s2);
    s3 = fmaf(a.w, x39, s3);
    a = *(const LAS f32x4*)(Am + 3236);
    s0 = fmaf(a.x, x40, s0);
    s1 = fmaf(a.y, x41, s1);
    s2 = fmaf(a.z, x42, s2);
    s3 = fmaf(a.w, x43, s3);
    a = *(const LAS f32x4*)(Am + 3240);
    s0 = fmaf(a.x, x44, s0);
    s1 = fmaf(a.y, x45, s1);
    const float al47 = a.z;
    x47 = (x47 - ((s0 + s1) + (s2 + s3))) - al47 * x46;
    Tu[6392 + c] = f2bf(x47 * su); Tw[6392 + c] = f2bf(x47 * sw); asm volatile("" ::: "memory");
    float x48 = fmaxf(0.0f, 1.0f - fabsf(cf - 48.0f));
    s0 = 0.f; s1 = 0.f; s2 = 0.f; s3 = 0.f;
    a = *(const LAS f32x4*)(Am + 3264);
    s0 = fmaf(a.x, x0, s0);
    s1 = fmaf(a.y, x1, s1);
    s2 = fmaf(a.z, x2, s2);
    s3 = fmaf(a.w, x3, s3);
    a = *(const LAS f32x4*)(Am + 3268);
    s0 = fmaf(a.x, x4, s0);
    s1 = fmaf(a.y, x5, s1);
    s2 = fmaf(a.z, x6, s2);
    s3 = fmaf(a.w, x7, s3);
    a = *(const LAS f32x4*)(Am + 3272);
    s0 = fmaf(a.x, x8, s0);
    s1 = fmaf(a.y, x9, s1);
    s2 = fmaf(a.z, x10, s2);
    s3 = fmaf(a.w, x11, s3);
    a = *(const LAS f32x4*)(Am + 3276);
    s0 = fmaf(a.x, x12, s0);
    s1 = fmaf(a.y, x13, s1);
    s2 = fmaf(a.z, x14, s2);
    s3 = fmaf(a.w, x15, s3);
    a = *(const LAS f32x4*)(Am + 3280);
    s0 = fmaf(a.x, x16, s0);
    s1 = fmaf(a.y, x17, s1);
    s2 = fmaf(a.z, x18, s2);
    s3 = fmaf(a.w, x19, s3);
    a = *(const LAS f32x4*)(Am + 3284);
    s0 = fmaf(a.x, x20, s0);
    s1 = fmaf(a.y, x21, s1);
    s2 = fmaf(a.z, x22, s2);
    s3 = fmaf(a.w, x23, s3);
    a = *(const LAS f32x4*)(Am + 3288);
    s0 = fmaf(a.x, x24, s0);
    s1 = fmaf(a.y, x25, s1);
    s2 = fmaf(a.z, x26, s2);
    s3 = fmaf(a.w, x27, s3);
    a = *(const LAS f32x4*)(Am + 3292);
    s0 = fmaf(a.x, x28, s0);
    s1 = fmaf(a.y, x29, s1);
    s2 = fmaf(a.z, x30, s2);
    s3 = fmaf(a.w, x31, s3);
    a = *(const LAS f32x4*)(Am + 3296);
    s0 = fmaf(a.x, x32, s0);
    s1 = fmaf(a.y, x33, s1);
    s2 = fmaf(a.z, x34, s2);
    s3 = fmaf(a.w, x35, s3);
    a = *(const LAS f32x4*)(Am + 3300);
    s0 = fmaf(a.x, x36, s0);
    s1 = fmaf(a.y, x37, s1);
    s2 = fmaf(a.z, x38, s2);
    s3 = fmaf(a.w, x39, s3);
    a = *(const LAS f32x4*)(Am + 3304);
    s0 = fmaf(a.x, x40, s0);
    s1 = fmaf(a.y, x41, s1);
    s2 = fmaf(a.z, x42, s2);
    s3 = fmaf(a.w, x43, s3);
    a = *(const LAS f32x4*)(Am + 3308);
    s0 = fmaf(a.x, x44, s0);
    s1 = fmaf(a.y, x45, s1);
    s2 = fmaf(a.z, x46, s2);
    const float al48 = a.w;
    x48 = (x48 - ((s0 + s1) + (s2 + s3))) - al48 * x47;
    Tu[6528 + c] = f2bf(x48 * su); Tw[6528 + c] = f2bf(x48 * sw); asm volatile("" ::: "memory");
    float x49 = fmaxf(0.0f, 1.0f - fabsf(cf - 49.0f));
    s0 = 0.f; s1 = 0.f; s2 = 0.f; s3 = 0.f;
    a = *(const LAS f32x4*)(Am + 3332);
    s0 = fmaf(a.x, x0, s0);
    s1 = fmaf(a.y, x1, s1);
    s2 = fmaf(a.z, x2, s2);
    s3 = fmaf(a.w, x3, s3);
    a = *(const LAS f32x4*)(Am + 3336);
    s0 = fmaf(a.x, x4, s0);
    s1 = fmaf(a.y, x5, s1);
    s2 = fmaf(a.z, x6, s2);
    s3 = fmaf(a.w, x7, s3);
    a = *(const LAS f32x4*)(Am + 3340);
    s0 = fmaf(a.x, x8, s0);
    s1 = fmaf(a.y, x9, s1);
    s2 = fmaf(a.z, x10, s2);
    s3 = fmaf(a.w, x11, s3);
    a = *(const LAS f32x4*)(Am + 3344);
    s0 = fmaf(a.x, x12, s0);
    s1 = fmaf(a.y, x13, s1);
    s2 = fmaf(a.z, x14, s2);
    s3 = fmaf(a.w, x15, s3);
    a = *(const LAS f32x4*)(Am + 3348);
    s0 = fmaf(a.x, x16, s0);
    s1 = fmaf(a.y, x17, s1);
    s2 = fmaf(a.z, x18, s2);
    s3 = fmaf(a.w, x19, s3);
    a = *(const LAS f32x4*)(Am + 3352);
    s0 = fmaf(a.x, x20, s0);
    s1 = fmaf(a.y, x21, s1);
    s2 = fmaf(a.z, x22, s2);
    s3 = fmaf(a.w, x23, s3);
    a = *(const LAS f32x4*)(Am + 3356);
    s0 = fmaf(a.x, x24, s0);
    s1 = fmaf(a.y, x25, s1);
    s2 = fmaf(a.z, x26, s2);
    s3 = fmaf(a.w, x27, s3);
    a = *(const LAS f32x4*)(Am + 3360);
    s0 = fmaf(a.x, x28, s0);
    s1 = fmaf(a.y, x29, s1);
    s2 = fmaf(a.z, x30, s2);
    s3 = fmaf(a.w, x31, s3);
    a = *(const LAS f32x4*)(Am + 3364);
    s0 = fmaf(a.x, x32, s0);
    s1 = fmaf(a.y, x33, s1);
    s2 = fmaf(a.z, x34, s2);
    s3 = fmaf(a.w, x35, s3);
    a = *(const LAS f32x4*)(Am + 3368);
    s0 = fmaf(a.x, x36, s0);
    s1 = fmaf(a.y, x37, s1);
    s2 = fmaf(a.z, x38, s2);
    s3 = fmaf(a.w, x39, s3);
    a = *(const LAS f32x4*)(Am + 3372);
    s0 = fmaf(a.x, x40, s0);
    s1 = fmaf(a.y, x41, s1);
    s2 = fmaf(a.z, x42, s2);
    s3 = fmaf(a.w, x43, s3);
    a = *(const LAS f32x4*)(Am + 3376);
    s0 = fmaf(a.x, x44, s0);
    s1 = fmaf(a.y, x45, s1);
    s2 = fmaf(a.z, x46, s2);
    s3 = fmaf(a.w, x47, s3);
    a = *(const LAS f32x4*)(Am + 3380);
    const float al49 = a.x;
    x49 = (x49 - ((s0 + s1) + (s2 + s3))) - al49 * x48;
    Tu[6664 + c] = f2bf(x49 * su); Tw[6664 + c] = f2bf(x49 * sw); asm volatile("" ::: "memory");
    float x50 = fmaxf(0.0f, 1.0f - fabsf(cf - 50.0f));
    s0 = 0.f; s1 = 0.f; s2 = 0.f; s3 = 0.f;
    a = *(const LAS f32x4*)(Am + 3400);
    s0 = fmaf(a.x, x0, s0);
    s1 = fmaf(a.y, x1, s1);
    s2 = fmaf(a.z, x2, s2);
    s3 = fmaf(a.w, x3, s3);
    a = *(const LAS f32x4*)(Am + 3404);
    s0 = fmaf(a.x, x4, s0);
    s1 = fmaf(a.y, x5, s1);
    s2 = fmaf(a.z, x6, s2);
    s3 = fmaf(a.w, x7, s3);
    a = *(const LAS f32x4*)(Am + 3408);
    s0 = fmaf(a.x, x8, s0);
    s1 = fmaf(a.y, x9, s1);
    s2 = fmaf(a.z, x10, s2);
    s3 = fmaf(a.w, x11, s3);
    a = *(const LAS f32x4*)(Am + 3412);
    s0 = fmaf(a.x, x12, s0);
    s1 = fmaf(a.y, x13, s1);
    s2 = fmaf(a.z, x14, s2);
    s3 = fmaf(a.w, x15, s3);
    a = *(const LAS f32x4*)(Am + 3416);
    s0 = fmaf(a.x, x16, s0);
    s1 = fmaf(a.y, x17, s1);
    s2 = fmaf(a.z, x18, s2);
    s3 = fmaf(a.w, x19, s3);
    a = *(const LAS f32x4*)(Am + 3420);
    s0 = fmaf(a.x, x20, s0);
    s1 = fmaf(a.y, x21, s1);
    s2 = fmaf(a.z, x22, s2);
    s3 = fmaf(a.w, x23, s3);
    a = *(const LAS f32x4*)(Am + 3424);
    s0 = fmaf(a.x, x24, s0);
    s1 = fmaf(a.y, x25, s1);
    s2 = fmaf(a.z, x26, s2);
    s3 = fmaf(a.w, x27, s3);
    a = *(const LAS f32x4*)(Am + 3428);
    s0 = fmaf(a.x, x28, s0);
    s1 = fmaf(a.y, x29, s1);
    s2 = fmaf(a.z, x30, s2);
    s3 = fmaf(a.w, x31, s3);
    a = *(const LAS f32x4*)(Am + 3432);
    s0 = fmaf(a.x, x32, s0);
    s1 = fmaf(a.y, x33, s1);
    s2 = fmaf(a.z, x34, s2);
    s3 = fmaf(a.w, x35, s3);
    a = *(const LAS f32x4*)(Am + 3436);
    s0 = fmaf(a.x, x36, s0);
    s1 = fmaf(a.y, x37, s1);
    s2 = fmaf(a.z, x38, s2);
    s3 = fmaf(a.w, x39, s3);
    a = *(const LAS f32x4*)(Am + 3440);
    s0 = fmaf(a.x, x40, s0);
    s1 = fmaf(a.y, x41, s1);
    s2 = fmaf(a.z, x42, s2);
    s3 = fmaf(a.w, x43, s3);
    a = *(const LAS f32x4*)(Am + 3444);
    s0 = fmaf(a.x, x44, s0);
    s1 = fmaf(a.y, x45, s1);
    s2 = fmaf(a.z, x46, s2);
    s3 = fmaf(a.w, x47, s3);
    a = *(const LAS f32x4*)(Am + 3448);
    s0 = fmaf(a.x, x48, s0);
    const float al50 = a.y;
    x50 = (x50 - ((s0 + s1) + (s2 + s3))) - al50 * x49;
    Tu[6800 + c] = f2bf(x50 * su); Tw[6800 + c] = f2bf(x50 * sw); asm volatile("" ::: "memory");
    float x51 = fmaxf(0.0f, 1.0f - fabsf(cf - 51.0f));
    s0 = 0.f; s1 = 0.f; s2 = 0.f; s3 = 0.f;
    a = *(const LAS f32x4*)(Am + 3468);
    s0 = fmaf(a.x, x0, s0);
    s1 = fmaf(a.y, x1, s1);
    s2 = fmaf(a.z, x2, s2);
    s3 = fmaf(a.w, x3, s3);
    a = *(const LAS f32x4*)(Am + 3472);
    s0 = fmaf(a.x, x4, s0);
    s1 = fmaf(a.y, x5, s1);
    s2 = fmaf(a.z, x6, s2);
    s3 = fmaf(a.w, x7, s3);
    a = *(const LAS f32x4*)(Am + 3476);
    s0 = fmaf(a.x, x8, s0);
    s1 = fmaf(a.y, x9, s1);
    s2 = fmaf(a.z, x10, s2);
    s3 = fmaf(a.w, x11, s3);
    a = *(const LAS f32x4*)(Am + 3480);
    s0 = fmaf(a.x, x12, s0);
    s1 = fmaf(a.y, x13, s1);
    s2 = fmaf(a.z, x14, s2);
    s3 = fmaf(a.w, x15, s3);
    a = *(const LAS f32x4*)(Am + 3484);
    s0 = fmaf(a.x, x16, s0);
    s1 = fmaf(a.y, x17, s1);
    s2 = fmaf(a.z, x18, s2);
    s3 = fmaf(a.w, x19, s3);
    a = *(const LAS f32x4*)(Am + 3488);
    s0 = fmaf(a.x, x20, s0);
    s1 = fmaf(a.y, x21, s1);
    s2 = fmaf(a.z, x22, s2);
    s3 = fmaf(a.w, x23, s3);
    a = *(const LAS f32x4*)(Am + 3492);
    s0 = fmaf(a.x, x24, s0);
    s1 = fmaf(a.y, x25, s1);
    s2 = fmaf(a.z, x26, s2);
    s3 = fmaf(a.w, x27, s3);
    a = *(const LAS f32x4*)(Am + 3496);
    s0 = fmaf(a.x, x28, s0);
    s1 = fmaf(a.y, x29, s1);
    s2 = fmaf(a.z, x30, s2);
    s3 = fmaf(a.w, x31, s3);
    a = *(const LAS f32x4*)(Am + 3500);
    s0 = fmaf(a.x, x32, s0);
    s1 = fmaf(a.y, x33, s1);
    s2 = fmaf(a.z, x34, s2);
    s3 = fmaf(a.w, x35, s3);
    a = *(const LAS f32x4*)(Am + 3504);
    s0 = fmaf(a.x, x36, s0);
    s1 = fmaf(a.y, x37, s1);
    s2 = fmaf(a.z, x38, s2);
    s3 = fmaf(a.w, x39, s3);
    a = *(const LAS f32x4*)(Am + 3508);
    s0 = fmaf(a.x, x40, s0);
    s1 = fmaf(a.y, x41, s1);
    s2 = fmaf(a.z, x42, s2);
    s3 = fmaf(a.w, x43, s3);
    a = *(const LAS f32x4*)(Am + 3512);
    s0 = fmaf(a.x, x44, s0);
    s1 = fmaf(a.y, x45, s1);
    s2 = fmaf(a.z, x46, s2);
    s3 = fmaf(a.w, x47, s3);
    a = *(const LAS f32x4*)(Am + 3516);
    s0 = fmaf(a.x, x48, s0);
    s1 = fmaf(a.y, x49, s1);
    const float al51 = a.z;
    x51 = (x51 - ((s0 + s1) + (s2 + s3))) - al51 * x50;
    Tu[6936 + c] = f2bf(x51 * su); Tw[6936 + c] = f2bf(x51 * sw); asm volatile("" ::: "memory");
    float x52 = fmaxf(0.0f, 1.0f - fabsf(cf - 52.0f));
    s0 = 0.f; s1 = 0.f; s2 = 0.f; s3 = 0.f;
    a = *(const LAS f32x4*)(Am + 3536);
    s0 = fmaf(a.x, x0, s0);
    s1 = fmaf(a.y, x1, s1);
    s2 = fmaf(a.z, x2, s2);
    s3 = fmaf(a.w, x3, s3);
    a = *(const LAS f32x4*)(Am + 3540);
    s0 = fmaf(a.x, x4, s0);
    s1 = fmaf(a.y, x5, s1);
    s2 = fmaf(a.z, x6, s2);
    s3 = fmaf(a.w, x7, s3);
    a = *(const LAS f32x4*)(Am + 3544);
    s0 = fmaf(a.x, x8, s0);
    s1 = fmaf(a.y, x9, s1);
    s2 = fmaf(a.z, x10, s2);
    s3 = fmaf(a.w, x11, s3);
    a = *(const LAS f32x4*)(Am + 3548);
    s0 = fmaf(a.x, x12, s0);
    s1 = fmaf(a.y, x13, s1);
    s2 = fmaf(a.z, x14, s2);
    s3 = fmaf(a.w, x15, s3);
    a = *(const LAS f32x4*)(Am + 3552);
    s0 = fmaf(a.x, x16, s0);
    s1 = fmaf(a.y, x17, s1);
    s2 = fmaf(a.z, x18, s2);
    s3 = fmaf(a.w, x19, s3);
    a = *(const LAS f32x4*)(Am + 3556);
    s0 = fmaf(a.x, x20, s0);
    s1 = fmaf(a.y, x21, s1);
    s2 = fmaf(a.z, x22, s2);
    s3 = fmaf(a.w, x23, s3);
    a = *(const LAS f32x4*)(Am + 3560);
    s0 = fmaf(a.x, x24, s0);
    s1 = fmaf(a.y, x25, s1);
    s2 = fmaf(a.z, x26, s2);
    s3 = fmaf(a.w, x27, s3);
    a = *(const LAS f32x4*)(Am + 3564);
    s0 = fmaf(a.x, x28, s0);
    s1 = fmaf(a.y, x29, s1);
    s2 = fmaf(a.z, x30, s2);
    s3 = fmaf(a.w, x31, s3);
    a = *(const LAS f32x4*)(Am + 3568);
    s0 = fmaf(a.x, x32, s0);
    s1 = fmaf(a.y, x33, s1);
    s2 = fmaf(a.z, x34, s2);
    s3 = fmaf(a.w, x35, s3);
    a = *(const LAS f32x4*)(Am + 3572);
    s0 = fmaf(a.x, x36, s0);
    s1 = fmaf(a.y, x37, s1);
    s2 = fmaf(a.z, x38, s2);
    s3 = fmaf(a.w, x39, s3);
    a = *(const LAS f32x4*)(Am + 3576);
    s0 = fmaf(a.x, x40, s0);
    s1 = fmaf(a.y, x41, s1);
    s2 = fmaf(a.z, x42, s2);
    s3 = fmaf(a.w, x43, s3);
    a = *(const LAS f32x4*)(Am + 3580);
    s0 = fmaf(a.x, x44, s0);
    s1 = fmaf(a.y, x45, s1);
    s2 = fmaf(a.z, x46, s2);
    s3 = fmaf(a.w, x47, s3);
    a = *(const LAS f32x4*)(Am + 3584);
    s0 = fmaf(a.x, x48, s0);
    s1 = fmaf(a.y, x49, s1);
    s2 = fmaf(a.z, x50, s2);
    const float al52 = a.w;
    x52 = (x52 - ((s0 + s1) + (s2 + s3))) - al52 * x51;
    Tu[7072 + c] = f2bf(x52 * su); Tw[7072 + c] = f2bf(x52 * sw); asm volatile("" ::: "memory");
    float x53 = fmaxf(0.0f, 1.0f - fabsf(cf - 53.0f));
    s0 = 0.f; s1 = 0.f; s2 = 0.f; s3 = 0.f;
    a = *(const LAS f32x4*)(Am + 3604);
    s0 = fmaf(a.x, x0, s0);
    s1 = fmaf(a.y, x1, s1);
    s2 = fmaf(a.z, x2, s2);
    s3 = fmaf(a.w, x3, s3);
    a = *(const LAS f32x4*)(Am + 3608);
    s0 = fmaf(a.x, x4, s0);
    s1 = fmaf(a.y, x5, s1);
    s2 = fmaf(a.z, x6, s2);
    s3 = fmaf(a.w, x7, s3);
    a = *(const LAS f32x4*)(Am + 3612);
    s0 = fmaf(a.x, x8, s0);
    s1 = fmaf(a.y, x9, s1);
    s2 = fmaf(a.z, x10, s2);
    s3 = fmaf(a.w, x11, s3);
    a = *(const LAS f32x4*)(Am + 3616);
    s0 = fmaf(a.x, x12, s0);
    s1 = fmaf(a.y, x13, s1);
    s2 = fmaf(a.z, x14, s2);
    s3 = fmaf(a.w, x15, s3);
    a = *(const LAS f32x4*)(Am + 3620);
    s0 = fmaf(a.x, x16, s0);
    s1 = fmaf(a.y, x17, s1);
    s2 = fmaf(a.z, x18, s2);
    s3 = fmaf(a.w, x19, s3);
    a = *(const LAS f32x4*)(Am + 3624);
    s0 = fmaf(a.x, x20, s0);
    s1 = fmaf(a.y, x21, s1);
    s2 = fmaf(a.z, x22, s2);
    s3 = fmaf(a.w, x23, s3);
    a = *(const LAS f32x4*)(Am + 3628);
    s0 = fmaf(a.x, x24, s0);
    s1 = fmaf(a.y, x25, s1);
    s2 = fmaf(a.z, x26, s2);
    s3 = fmaf(a.w, x27, s3);
    a = *(const LAS f32x4*)(Am + 3632);
    s0 = fmaf(a.x, x28, s0);
    s1 = fmaf(a.y, x29, s1);
    s2 = fmaf(a.z, x30, s2);
    s3 = fmaf(a.w, x31, s3);
    a = *(const LAS f32x4*)(Am + 3636);
    s0 = fmaf(a.x, x32, s0);
    s1 = fmaf(a.y, x33, s1);
    s2 = fmaf(a.z, x34, s2);
    s3 = fmaf(a.w, x35, s3);
    a = *(const LAS f32x4*)(Am + 3640);
    s0 = fmaf(a.x, x36, s0);
    s1 = fmaf(a.y, x37, s1);
    s2 = fmaf(a.z, x38, s2);
    s3 = fmaf(a.w, x39, s3);
    a = *(const LAS f32x4*)(Am + 3644);
    s0 = fmaf(a.x, x40, s0);
    s1 = fmaf(a.y, x41, s1);
    s2 = fmaf(a.z, x42, s2);
    s3 = fmaf(a.w, x43, s3);
    a = *(const LAS f32x4*)(Am + 3648);
    s0 = fmaf(a.x, x44, s0);
    s1 = fmaf(a.y, x45, s1);
    s2 = fmaf(a.z, x46, s2);
    s3 = fmaf(a.w, x47, s3);
    a = *(const LAS f32x4*)(Am + 3652);
    s0 = fmaf(a.x, x48, s0);
    s1 = fmaf(a.y, x49, s1);
    s2 = fmaf(a.z, x50, s2);
    s3 = fmaf(a.w, x51, s3);
    a = *(const LAS f32x4*)(Am + 3656);
    const float al53 = a.x;
    x53 = (x53 - ((s0 + s1) + (s2 + s3))) - al53 * x52;
    Tu[7208 + c] = f2bf(x53 * su); Tw[7208 + c] = f2bf(x53 * sw); asm volatile("" ::: "memory");
    float x54 = fmaxf(0.0f, 1.0f - fabsf(cf - 54.0f));
    s0 = 0.f; s1 = 0.f; s2 = 0.f; s3 = 0.f;
    a = *(const LAS f32x4*)(Am + 3672);
    s0 = fmaf(a.x, x0, s0);
    s1 = fmaf(a.y, x1, s1);
    s2 = fmaf(a.z, x2, s2);
    s3 = fmaf(a.w, x3, s3);
    a = *(const LAS f32x4*)(Am + 3676);
    s0 = fmaf(a.x, x4, s0);
    s1 = fmaf(a.y, x5, s1);
    s2 = fmaf(a.z, x6, s2);
    s3 = fmaf(a.w, x7, s3);
    a = *(const LAS f32x4*)(Am + 3680);
    s0 = fmaf(a.x, x8, s0);
    s1 = fmaf(a.y, x9, s1);
    s2 = fmaf(a.z, x10, s2);
    s3 = fmaf(a.w, x11, s3);
    a = *(const LAS f32x4*)(Am + 3684);
    s0 = fmaf(a.x, x12, s0);
    s1 = fmaf(a.y, x13, s1);
    s2 = fmaf(a.z, x14, s2);
    s3 = fmaf(a.w, x15, s3);
    a = *(const LAS f32x4*)(Am + 3688);
    s0 = fmaf(a.x, x16, s0);
    s1 = fmaf(a.y, x17, s1);
    s2 = fmaf(a.z, x18, s2);
    s3 = fmaf(a.w, x19, s3);
    a = *(const LAS f32x4*)(Am + 3692);
    s0 = fmaf(a.x, x20, s0);
    s1 = fmaf(a.y, x21, s1);
    s2 = fmaf(a.z, x22, s2);
    s3 = fmaf(a.w, x23, s3);
    a = *(const LAS f32x4*)(Am + 3696);
    s0 = fmaf(a.x, x24, s0);
    s1 = fmaf(a.y, x25, s1);
    s2 = fmaf(a.z, x26, s2);
    s3 = fmaf(a.w, x27, s3);
    a = *(const LAS f32x4*)(Am + 3700);
    s0 = fmaf(a.x, x28, s0);
    s1 = fmaf(a.y, x29, s1);
    s2 = fmaf(a.z, x30, s2);
    s3 = fmaf(a.w, x31, s3);
    a = *(const LAS f32x4*)(Am + 3704);
    s0 = fmaf(a.x, x32, s0);
    s1 = fmaf(a.y, x33, s1);
    s2 = fmaf(a.z, x34, s2);
    s3 = fmaf(a.w, x35, s3);
    a = *(const LAS f32x4*)(Am + 3708);
    s0 = fmaf(a.x, x36, s0);
    s1 = fmaf(a.y, x37, s1);
    s2 = fmaf(a.z, x38, s2);
    s3 = fmaf(a.w, x39, s3);
    a = *(const LAS f32x4*)(Am + 3712);
    s0 = fmaf(a.x, x40, s0);
    s1 = fmaf(a.y, x41, s1);
    s2 = fmaf(a.z, x42, s2);
    s3 = fmaf(a.w, x43, s3);
    a = *(const LAS f32x4*)(Am + 3716);
    s0 = fmaf(a.x, x44, s0);
    s1 = fmaf(a.y, x45, s1);
    s2 = fmaf(a.z, x46, s2);
    s3 = fmaf(a.w, x47, s3);
    a = *(const LAS f32x4*)(Am + 3720);
    s0 = fmaf(a.x, x48, s0);
    s1 = fmaf(a.y, x49, s1);
    s2 = fmaf(a.z, x50, s2);
    s3 = fmaf(a.w, x51, s3);
    a = *(const LAS f32x4*)(Am + 3724);
    s0 = fmaf(a.x, x52, s0);
    const float al54 = a.y;
    x54 = (x54 - ((s0 + s1) + (s2 + s3))) - al54 * x53;
    Tu[7344 + c] = f2bf(x54 * su); Tw[7344 + c] = f2bf(x54 * sw); asm volatile("" ::: "memory");
    float x55 = fmaxf(0.0f, 1.0f - fabsf(cf - 55.0f));
    s0 = 0.f; s1 = 0.f; s2 = 0.f; s3 = 0.f;
    a = *(const LAS f32x4*)(Am + 3740);
    s0 = fmaf(a.x, x0, s0);
    s1 = fmaf(a.y, x1, s1);
    s2 = fmaf(a.z, x2, s2);
    s3 = fmaf(a.w, x3, s3);
    a = *(const LAS f32x4*)(Am + 3744);
    s0 = fmaf(a.x, x4, s0);
    s1 = fmaf(a.y, x5, s1);
    s2 = fmaf(a.z, x6, s2);
    s3 = fmaf(a.w, x7, s3);
    a = *(const LAS f32x4*)(Am + 3748);
    s0 = fmaf(a.x, x8, s0);
    s1 = fmaf(a.y, x9, s1);
    s2 = fmaf(a.z, x10, s2);
    s3 = fmaf(a.w, x11, s3);
    a = *(const LAS f32x4*)(Am + 3752);
    s0 = fmaf(a.x, x12, s0);
    s1 = fmaf(a.y, x13, s1);
    s2 = fmaf(a.z, x14, s2);
    s3 = fmaf(a.w, x15, s3);
    a = *(const LAS f32x4*)(Am + 3756);
    s0 = fmaf(a.x, x16, s0);
    s1 = fmaf(a.y, x17, s1);
    s2 = fmaf(a.z, x18, s2);
    s3 = fmaf(a.w, x19, s3);
    a = *(const LAS f32x4*)(Am + 3760);
    s0 = fmaf(a.x, x20, s0);
    s1 = fmaf(a.y, x21, s1);
    s2 = fmaf(a.z, x22, s2);
    s3 = fmaf(a.w, x23, s3);
    a = *(const LAS f32x4*)(Am + 3764);
    s0 = fmaf(a.x, x24, s0);
    s1 = fmaf(a.y, x25, s1);
    s2 = fmaf(a.z, x26, s2);
    s3 = fmaf(a.w, x27, s3);
    a = *(const LAS f32x4*)(Am + 3768);
    s0 = fmaf(a.x, x28, s0);
    s1 = fmaf(a.y, x29, s1);
    s2 = fmaf(a.z, x30, s2);
    s3 = fmaf(a.w, x31, s3);
    a = *(const LAS f32x4*)(Am + 3772);
    s0 = fmaf(a.x, x32, s0);
    s1 = fmaf(a.y, x33, s1);
    s2 = fmaf(a.z, x34, s2);
    s3 = fmaf(a.w, x35, s3);
    a = *(const LAS f32x4*)(Am + 3776);
    s0 = fmaf(a.x, x36, s0);
    s1 = fmaf(a.y, x37, s1);
    s2 = fmaf(a.z, x38, s2);
    s3 = fmaf(a.w, x39, s3);
    a = *(const LAS f32x4*)(Am + 3780);
    s0 = fmaf(a.x, x40, s0);
    s1 = fmaf(a.y, x41, s1);
    s2 = fmaf(a.z, x42, s2);
    s3 = fmaf(a.w, x43, s3);
    a = *(const LAS f32x4*)(Am + 3784);
    s0 = fmaf(a.x, x44, s0);
    s1 = fmaf(a.y, x45, s1);
    s2 = fmaf(a.z, x46, s2);
    s3 = fmaf(a.w, x47, s3);
    a = *(const LAS f32x4*)(Am + 3788);
    s0 = fmaf(a.x, x48, s0);
    s1 = fmaf(a.y, x49, s1);
    s2 = fmaf(a.z, x50, s2);
    s3 = fmaf(a.w, x51, s3);
    a = *(const LAS f32x4*)(Am + 3792);
    s0 = fmaf(a.x, x52, s0);
    s1 = fmaf(a.y, x53, s1);
    const float al55 = a.z;
    x55 = (x55 - ((s0 + s1) + (s2 + s3))) - al55 * x54;
    Tu[7480 + c] = f2bf(x55 * su); Tw[7480 + c] = f2bf(x55 * sw); asm volatile("" ::: "memory");
    float x56 = fmaxf(0.0f, 1.0f - fabsf(cf - 56.0f));
    s0 = 0.f; s1 = 0.f; s2 = 0.f; s3 = 0.f;
    a = *(const LAS f32x4*)(Am + 3808);
    s0 = fmaf(a.x, x0, s0);
    s1 = fmaf(a.y, x1, s1);
    s2 = fmaf(a.z, x2, s2);
    s3 = fmaf(a.w, x3, s3);
    a = *(const LAS f32x4*)(Am + 3812);
    s0 = fmaf(a.x, x4, s0);
    s1 = fmaf(a.y, x5, s1);
    s2 = fmaf(a.z, x6, s2);
    s3 = fmaf(a.w, x7, s3);
    a = *(const LAS f32x4*)(Am + 3816);
    s0 = fmaf(a.x, x8, s0);
    s1 = fmaf(a.y, x9, s1);
    s2 = fmaf(a.z, x10, s2);
    s3 = fmaf(a.w, x11, s3);
    a = *(const LAS f32x4*)(Am + 3820);
    s0 = fmaf(a.x, x12, s0);
    s1 = fmaf(a.y, x13, s1);
    s2 = fmaf(a.z, x14, s2);
    s3 = fmaf(a.w, x15, s3);
    a = *(const LAS f32x4*)(Am + 3824);
    s0 = fmaf(a.x, x16, s0);
    s1 = fmaf(a.y, x17, s1);
    s2 = fmaf(a.z, x18, s2);
    s3 = fmaf(a.w, x19, s3);
    a = *(const LAS f32x4*)(Am + 3828);
    s0 = fmaf(a.x, x20, s0);
    s1 = fmaf(a.y, x21, s1);
    s2 = fmaf(a.z, x22, s2);
    s3 = fmaf(a.w, x23, s3);
    a = *(const LAS f32x4*)(Am + 3832);
    s0 = fmaf(a.x, x24, s0);
    s1 = fmaf(a.y, x25, s1);
    s2 = fmaf(a.z, x26, s2);
    s3 = fmaf(a.w, x27, s3);
    a = *(const LAS f32x4*)(Am + 3836);
    s0 = fmaf(a.x, x28, s0);
    s1 = fmaf(a.y, x29, s1);
    s2 = fmaf(a.z, x30, s2);
    s3 = fmaf(a.w, x31, s3);
    a = *(const LAS f32x4*)(Am + 3840);
    s0 = fmaf(a.x, x32, s0);
    s1 = fmaf(a.y, x33, s1);
    s2 = fmaf(a.z, x34, s2);
    s3 = fmaf(a.w, x35, s3);
    a = *(const LAS f32x4*)(Am + 3844);
    s0 = fmaf(a.x, x36, s0);
    s1 = fmaf(a.y, x37, s1);
    s2 = fmaf(a.z, x38, s2);
    s3 = fmaf(a.w, x39, s3);
    a = *(const LAS f32x4*)(Am + 3848);
    s0 = fmaf(a.x, x40, s0);
    s1 = fmaf(a.y, x41, s1);
    s2 = fmaf(a.z, x42, s2);
    s3 = fmaf(a.w, x43, s3);
    a = *(const LAS f32x4*)(Am + 3852);
    s0 = fmaf(a.x, x44, s0);
    s1 = fmaf(a.y, x45, s1);
    s2 = fmaf(a.z, x46, s2);
    s3 = fmaf(a.w, x47, s3);
    a = *(const LAS f32x4*)(Am + 3856);
    s0 = fmaf(a.x, x48, s0);
    s1 = fmaf(a.y, x49, s1);
    s2 = fmaf(a.z, x50, s2);
    s3 = fmaf(a.w, x51, s3);
    a = *(const LAS f32x4*)(Am + 3860);
    s0 = fmaf(a.x, x52, s0);
    s1 = fmaf(a.y, x53, s1);
    s2 = fmaf(a.z, x54, s2);
    const float al56 = a.w;
    x56 = (x56 - ((s0 + s1) + (s2 + s3))) - al56 * x55;
    Tu[7616 + c] = f2bf(x56 * su); Tw[7616 + c] = f2bf(x56 * sw); asm volatile("" ::: "memory");
    float x57 = fmaxf(0.0f, 1.0f - fabsf(cf - 57.0f));
    s0 = 0.f; s1 = 0.f; s2 = 0.f; s3 = 0.f;
    a = *(const LAS f32x4*)(Am + 3876);
    s0 = fmaf(a.x, x0, s0);
    s1 = fmaf(a.y, x1, s1);
    s2 = fmaf(a.z, x2, s2);
    s3 = fmaf(a.w, x3, s3);
    a = *(const LAS f32x4*)(Am + 3880);
    s0 = fmaf(a.x, x4, s0);
    s1 = fmaf(a.y, x5, s1);
    s2 = fmaf(a.z, x6, s2);
    s3 = fmaf(a.w, x7, s3);
    a = *(const LAS f32x4*)(Am + 3884);
    s0 = fmaf(a.x, x8, s0);
    s1 = fmaf(a.y, x9, s1);
    s2 = fmaf(a.z, x10, s2);
    s3 = fmaf(a.w, x11, s3);
    a = *(const LAS f32x4*)(Am + 3888);
    s0 = fmaf(a.x, x12, s0);
    s1 = fmaf(a.y, x13, s1);
    s2 = fmaf(a.z, x14, s2);
    s3 = fmaf(a.w, x15, s3);
    a = *(const LAS f32x4*)(Am + 3892);
    s0 = fmaf(a.x, x16, s0);
    s1 = fmaf(a.y, x17, s1);
    s2 = fmaf(a.z, x18, s2);
    s3 = fmaf(a.w, x19, s3);
    a = *(const LAS f32x4*)(Am + 3896);
    s0 = fmaf(a.x, x20, s0);
    s1 = fmaf(a.y, x21, s1);
    s2 = fmaf(a.z, x22, s2);
    s3 = fmaf(a.w, x23, s3);
    a = *(const LAS f32x4*)(Am + 3900);
    s0 = fmaf(a.x, x24, s0);
    s1 = fmaf(a.y, x25, s1);
    s2 = fmaf(a.z, x26, s2);
    s3 = fmaf(a.w, x27, s3);
    a = *(const LAS f32x4*)(Am + 3904);
    s0 = fmaf(a.x, x28, s0);
    s1 = fmaf(a.y, x29, s1);
    s2 = fmaf(a.z, x30, s2);
    s3 = fmaf(a.w, x31, s3);
    a = *(const LAS f32x4*)(Am + 3908);
    s0 = fmaf(a.x, x32, s0);
    s1 = fmaf(a.y, x33, s1);
    s2 = fmaf(a.z, x34, s2);
    s3 = fmaf(a.w, x35, s3);
    a = *(const LAS f32x4*)(Am + 3912);
    s0 = fmaf(a.x, x36, s0);
    s1 = fmaf(a.y, x37, s1);
    s2 = fmaf(a.z, x38, s2);
    s3 = fmaf(a.w, x39, s3);
    a = *(const LAS f32x4*)(Am + 3916);
    s0 = fmaf(a.x, x40, s0);
    s1 = fmaf(a.y, x41, s1);
    s2 = fmaf(a.z, x42, s2);
    s3 = fmaf(a.w, x43, s3);
    a = *(const LAS f32x4*)(Am + 3920);
    s0 = fmaf(a.x, x44, s0);
    s1 = fmaf(a.y, x45, s1);
    s2 = fmaf(a.z, x46, s2);
    s3 = fmaf(a.w, x47, s3);
    a = *(const LAS f32x4*)(Am + 3924);
    s0 = fmaf(a.x, x48, s0);
    s1 = fmaf(a.y, x49, s1);
    s2 = fmaf(a.z, x50, s2);
    s3 = fmaf(a.w, x51, s3);
    a = *(const LAS f32x4*)(Am + 3928);
    s0 = fmaf(a.x, x52, s0);
    s1 = fmaf(a.y, x53, s1);
    s2 = fmaf(a.z, x54, s2);
    s3 = fmaf(a.w, x55, s3);
    a = *(const LAS f32x4*)(Am + 3932);
    const float al57 = a.x;
    x57 = (x57 - ((s0 + s1) + (s2 + s3))) - al57 * x56;
    Tu[7752 + c] = f2bf(x57 * su); Tw[7752 + c] = f2bf(x57 * sw); asm volatile("" ::: "memory");
    float x58 = fmaxf(0.0f, 1.0f - fabsf(cf - 58.0f));
    s0 = 0.f; s1 = 0.f; s2 = 0.f; s3 = 0.f;
    a = *(const LAS f32x4*)(Am + 3944);
    s0 = fmaf(a.x, x0, s0);
    s1 = fmaf(a.y, x1, s1);
    s2 = fmaf(a.z, x2, s2);
    s3 = fmaf(a.w, x3, s3);
    a = *(const LAS f32x4*)(Am + 3948);
    s0 = fmaf(a.x, x4, s0);
    s1 = fmaf(a.y, x5, s1);
    s2 = fmaf(a.z, x6, s2);
    s3 = fmaf(a.w, x7, s3);
    a = *(const LAS f32x4*)(Am + 3952);
    s0 = fmaf(a.x, x8, s0);
    s1 = fmaf(a.y, x9, s1);
    s2 = fmaf(a.z, x10, s2);
    s3 = fmaf(a.w, x11, s3);
    a = *(const LAS f32x4*)(Am + 3956);
    s0 = fmaf(a.x, x12, s0);
    s1 = fmaf(a.y, x13, s1);
    s2 = fmaf(a.z, x14, s2);
    s3 = fmaf(a.w, x15, s3);
    a = *(const LAS f32x4*)(Am + 3960);
    s0 = fmaf(a.x, x16, s0);
    s1 = fmaf(a.y, x17, s1);
    s2 = fmaf(a.z, x18, s2);
    s3 = fmaf(a.w, x19, s3);
    a = *(const LAS f32x4*)(Am + 3964);
    s0 = fmaf(a.x, x20, s0);
    s1 = fmaf(a.y, x21, s1);
    s2 = fmaf(a.z, x22, s2);
    s3 = fmaf(a.w, x23, s3);
    a = *(const LAS f32x4*)(Am + 3968);
    s0 = fmaf(a.x, x24, s0);
    s1 = fmaf(a.y, x25, s1);
    s2 = fmaf(a.z, x26, s2);
    s3 = fmaf(a.w, x27, s3);
    a = *(const LAS f32x4*)(Am + 3972);
    s0 = fmaf(a.x, x28, s0);
    s1 = fmaf(a.y, x29, s1);
    s2 = fmaf(a.z, x30, s2);
    s3 = fmaf(a.w, x31, s3);
    a = *(const LAS f32x4*)(Am + 3976);
    s0 = fmaf(a.x, x32, s0);
    s1 = fmaf(a.y, x33, s1);
    s2 = fmaf(a.z, x34, s2);
    s3 = fmaf(a.w, x35, s3);
    a = *(const LAS f32x4*)(Am + 3980);
    s0 = fmaf(a.x, x36, s0);
    s1 = fmaf(a.y, x37, s1);
    s2 = fmaf(a.z, x38, s2);
    s3 = fmaf(a.w, x39, s3);
    a = *(const LAS f32x4*)(Am + 3984);
    s0 = fmaf(a.x, x40, s0);
    s1 = fmaf(a.y, x41, s1);
    s2 = fmaf(a.z, x42, s2);
    s3 = fmaf(a.w, x43, s3);
    a = *(const LAS f32x4*)(Am + 3988);
    s0 = fmaf(a.x, x44, s0);
    s1 = fmaf(a.y, x45, s1);
    s2 = fmaf(a.z, x46, s2);
    s3 = fmaf(a.w, x47, s3);
    a = *(const LAS f32x4*)(Am + 3992);
    s0 = fmaf(a.x, x48, s0);
    s1 = fmaf(a.y, x49, s1);
    s2 = fmaf(a.z, x50, s2);
    s3 = fmaf(a.w, x51, s3);
    a = *(const LAS f32x4*)(Am + 3996);
    s0 = fmaf(a.x, x52, s0);
    s1 = fmaf(a.y, x53, s1);
    s2 = fmaf(a.z, x54, s2);
    s3 = fmaf(a.w, x55, s3);
    a = *(const LAS f32x4*)(Am + 4000);
    s0 = fmaf(a.x, x56, s0);
    const float al58 = a.y;
    x58 = (x58 - ((s0 + s1) + (s2 + s3))) - al58 * x57;
    Tu[7888 + c] = f2bf(x58 * su); Tw[7888 + c] = f2bf(x58 * sw); asm volatile("" ::: "memory");
    float x59 = fmaxf(0.0f, 1.0f - fabsf(cf - 59.0f));
    s0 = 0.f; s1 = 0.f; s2 = 0.f; s3 = 0.f;
    a = *(const LAS f32x4*)(Am + 4012);
    s0 = fmaf(a.x, x0, s0);
    s1 = fmaf(a.y, x1, s1);
    s2 = fmaf(a.z, x2, s2);
    s3 = fmaf(a.w, x3, s3);
    a = *(const LAS f32x4*)(Am + 4016);
    s0 = fmaf(a.x, x4, s0);
    s1 = fmaf(a.y, x5, s1);
    s2 = fmaf(a.z, x6, s2);
    s3 = fmaf(a.w, x7, s3);
    a = *(const LAS f32x4*)(Am + 4020);
    s0 = fmaf(a.x, x8, s0);
    s1 = fmaf(a.y, x9, s1);
    s2 = fmaf(a.z, x10, s2);
    s3 = fmaf(a.w, x11, s3);
    a = *(const LAS f32x4*)(Am + 4024);
    s0 = fmaf(a.x, x12, s0);
    s1 = fmaf(a.y, x13, s1);
    s2 = fmaf(a.z, x14, s2);
    s3 = fmaf(a.w, x15, s3);
    a = *(const LAS f32x4*)(Am + 4028);
    s0 = fmaf(a.x, x16, s0);
    s1 = fmaf(a.y, x17, s1);
    s2 = fmaf(a.z, x18, s2);
    s3 = fmaf(a.w, x19, s3);
    a = *(const LAS f32x4*)(Am + 4032);
    s0 = fmaf(a.x, x20, s0);
    s1 = fmaf(a.y, x21, s1);
    s2 = fmaf(a.z, x22, s2);
    s3 = fmaf(a.w, x23, s3);
    a = *(const LAS f32x4*)(Am + 4036);
    s0 = fmaf(a.x, x24, s0);
    s1 = fmaf(a.y, x25, s1);
    s2 = fmaf(a.z, x26, s2);
    s3 = fmaf(a.w, x27, s3);
    a = *(const LAS f32x4*)(Am + 4040);
    s0 = fmaf(a.x, x28, s0);
    s1 = fmaf(a.y, x29, s1);
    s2 = fmaf(a.z, x30, s2);
    s3 = fmaf(a.w, x31, s3);
    a = *(const LAS f32x4*)(Am + 4044);
    s0 = fmaf(a.x, x32, s0);
    s1 = fmaf(a.y, x33, s1);
    s2 = fmaf(a.z, x34, s2);
    s3 = fmaf(a.w, x35, s3);
    a = *(const LAS f32x4*)(Am + 4048);
    s0 = fmaf(a.x, x36, s0);
    s1 = fmaf(a.y, x37, s1);
    s2 = fmaf(a.z, x38, s2);
    s3 = fmaf(a.w, x39, s3);
    a = *(const LAS f32x4*)(Am + 4052);
    s0 = fmaf(a.x, x40, s0);
    s1 = fmaf(a.y, x41, s1);
    s2 = fmaf(a.z, x42, s2);
    s3 = fmaf(a.w, x43, s3);
    a = *(const LAS f32x4*)(Am + 4056);
    s0 = fmaf(a.x, x44, s0);
    s1 = fmaf(a.y, x45, s1);
    s2 = fmaf(a.z, x46, s2);
    s3 = fmaf(a.w, x47, s3);
    a = *(const LAS f32x4*)(Am + 4060);
    s0 = fmaf(a.x, x48, s0);
    s1 = fmaf(a.y, x49, s1);
    s2 = fmaf(a.z, x50, s2);
    s3 = fmaf(a.w, x51, s3);
    a = *(const LAS f32x4*)(Am + 4064);
    s0 = fmaf(a.x, x52, s0);
    s1 = fmaf(a.y, x53, s1);
    s2 = fmaf(a.z, x54, s2);
    s3 = fmaf(a.w, x55, s3);
    a = *(const LAS f32x4*)(Am + 4068);
    s0 = fmaf(a.x, x56, s0);
    s1 = fmaf(a.y, x57, s1);
    const float al59 = a.z;
    x59 = (x59 - ((s0 + s1) + (s2 + s3))) - al59 * x58;
    Tu[8024 + c] = f2bf(x59 * su); Tw[8024 + c] = f2bf(x59 * sw); asm volatile("" ::: "memory");
    float x60 = fmaxf(0.0f, 1.0f - fabsf(cf - 60.0f));
    s0 = 0.f; s1 = 0.f; s2 = 0.f; s3 = 0.f;
    a = *(const LAS f32x4*)(Am + 4080);
    s0 = fmaf(a.x, x0, s0);
    s1 = fmaf(a.y, x1, s1);
    s2 = fmaf(a.z, x2, s2);
    s3 = fmaf(a.w, x3, s3);
    a = *(const LAS f32x4*)(Am + 4084);
    s0 = fmaf(a.x, x4, s0);
    s1 = fmaf(a.y, x5, s1);
    s2 = fmaf(a.z, x6, s2);
    s3 = fmaf(a.w, x7, s3);
    a = *(const LAS f32x4*)(Am + 4088);
    s0 = fmaf(a.x, x8, s0);
    s1 = fmaf(a.y, x9, s1);
    s2 = fmaf(a.z, x10, s2);
    s3 = fmaf(a.w, x11, s3);
    a = *(const LAS f32x4*)(Am + 4092);
    s0 = fmaf(a.x, x12, s0);
    s1 = fmaf(a.y, x13, s1);
    s2 = fmaf(a.z, x14, s2);
    s3 = fmaf(a.w, x15, s3);
    a = *(const LAS f32x4*)(Am + 4096);
    s0 = fmaf(a.x, x16, s0);
    s1 = fmaf(a.y, x17, s1);
    s2 = fmaf(a.z, x18, s2);
    s3 = fmaf(a.w, x19, s3);
    a = *(const LAS f32x4*)(Am + 4100);
    s0 = fmaf(a.x, x20, s0);
    s1 = fmaf(a.y, x21, s1);
    s2 = fmaf(a.z, x22, s2);
    s3 = fmaf(a.w, x23, s3);
    a = *(const LAS f32x4*)(Am + 4104);
    s0 = fmaf(a.x, x24, s0);
    s1 = fmaf(a.y, x25, s1);
    s2 = fmaf(a.z, x26, s2);
    s3 = fmaf(a.w, x27, s3);
    a = *(const LAS f32x4*)(Am + 4108);
    s0 = fmaf(a.x, x28, s0);
    s1 = fmaf(a.y, x29, s1);
    s2 = fmaf(a.z, x30, s2);
    s3 = fmaf(a.w, x31, s3);
    a = *(const LAS f32x4*)(Am + 4112);
    s0 = fmaf(a.x, x32, s0);
    s1 = fmaf(a.y, x33, s1);
    s2 = fmaf(a.z, x34, s2);
    s3 = fmaf(a.w, x35, s3);
    a = *(const LAS f32x4*)(Am + 4116);
    s0 = fmaf(a.x, x36, s0);
    s1 = fmaf(a.y, x37, s1);
    s2 = fmaf(a.z, x38, s2);
    s3 = fmaf(a.w, x39, s3);
    a = *(const LAS f32x4*)(Am + 4120);
    s0 = fmaf(a.x, x40, s0);
    s1 = fmaf(a.y, x41, s1);
    s2 = fmaf(a.z, x42, s2);
    s3 = fmaf(a.w, x43, s3);
    a = *(const LAS f32x4*)(Am + 4124);
    s0 = fmaf(a.x, x44, s0);
    s1 = fmaf(a.y, x45, s1);
    s2 = fmaf(a.z, x46, s2);
    s3 = fmaf(a.w, x47, s3);
    a = *(const LAS f32x4*)(Am + 4128);
    s0 = fmaf(a.x, x48, s0);
    s1 = fmaf(a.y, x49, s1);
    s2 = fmaf(a.z, x50, s2);
    s3 = fmaf(a.w, x51, s3);
    a = *(const LAS f32x4*)(Am + 4132);
    s0 = fmaf(a.x, x52, s0);
    s1 = fmaf(a.y, x53, s1);
    s2 = fmaf(a.z, x54, s2);
    s3 = fmaf(a.w, x55, s3);
    a = *(const LAS f32x4*)(Am + 4136);
    s0 = fmaf(a.x, x56, s0);
    s1 = fmaf(a.y, x57, s1);
    s2 = fmaf(a.z, x58, s2);
    const float al60 = a.w;
    x60 = (x60 - ((s0 + s1) + (s2 + s3))) - al60 * x59;
    Tu[8160 + c] = f2bf(x60 * su); Tw[8160 + c] = f2bf(x60 * sw); asm volatile("" ::: "memory");
    float x61 = fmaxf(0.0f, 1.0f - fabsf(cf - 61.0f));
    s0 = 0.f; s1 = 0.f; s2 = 0.f; s3 = 0.f;
    a = *(const LAS f32x4*)(Am + 4148);
    s0 = fmaf(a.x, x0, s0);
    s1 = fmaf(a.y, x1, s1);
    s2 = fmaf(a.z, x2, s2);
    s3 = fmaf(a.w, x3, s3);
    a = *(const LAS f32x4*)(Am + 4152);
    s0 = fmaf(a.x, x4, s0);
    s1 = fmaf(a.y, x5, s1);
    s2 = fmaf(a.z, x6, s2);
    s3 = fmaf(a.w, x7, s3);
    a = *(const LAS f32x4*)(Am + 4156);
    s0 = fmaf(a.x, x8, s0);
    s1 = fmaf(a.y, x9, s1);
    s2 = fmaf(a.z, x10, s2);
    s3 = fmaf(a.w, x11, s3);
    a = *(const LAS f32x4*)(Am + 4160);
    s0 = fmaf(a.x, x12, s0);
    s1 = fmaf(a.y, x13, s1);
    s2 = fmaf(a.z, x14, s2);
    s3 = fmaf(a.w, x15, s3);
    a = *(const LAS f32x4*)(Am + 4164);
    s0 = fmaf(a.x, x16, s0);
    s1 = fmaf(a.y, x17, s1);
    s2 = fmaf(a.z, x18, s2);
    s3 = fmaf(a.w, x19, s3);
    a = *(const LAS f32x4*)(Am + 4168);
    s0 = fmaf(a.x, x20, s0);
    s1 = fmaf(a.y, x21, s1);
    s2 = fmaf(a.z, x22, s2);
    s3 = fmaf(a.w, x23, s3);
    a = *(const LAS f32x4*)(Am + 4172);
    s0 = fmaf(a.x, x24, s0);
    s1 = fmaf(a.y, x25, s1);
    s2 = fmaf(a.z, x26, s2);
    s3 = fmaf(a.w, x27, s3);
    a = *(const LAS f32x4*)(Am + 4176);
    s0 = fmaf(a.x, x28, s0);
    s1 = fmaf(a.y, x29, s1);
    s2 = fmaf(a.z, x30, s2);
    s3 = fmaf(a.w, x31, s3);
    a = *(const LAS f32x4*)(Am + 4180);
    s0 = fmaf(a.x, x32, s0);
    s1 = fmaf(a.y, x33, s1);
    s2 = fmaf(a.z, x34, s2);
    s3 = fmaf(a.w, x35, s3);
    a = *(const LAS f32x4*)(Am + 4184);
    s0 = fmaf(a.x, x36, s0);
    s1 = fmaf(a.y, x37, s1);
    s2 = fmaf(a.z, x38, s2);
    s3 = fmaf(a.w, x39, s3);
    a = *(const LAS f32x4*)(Am + 4188);
    s0 = fmaf(a.x, x40, s0);
    s1 = fmaf(a.y, x41, s1);
    s2 = fmaf(a.z, x42, s2);
    s3 = fmaf(a.w, x43, s3);
    a = *(const LAS f32x4*)(Am + 4192);
    s0 = fmaf(a.x, x44, s0);
    s1 = fmaf(a.y, x45, s1);
    s2 = fmaf(a.z, x46, s2);
    s3 = fmaf(a.w, x47, s3);
    a = *(const LAS f32x4*)(Am + 4196);
    s0 = fmaf(a.x, x48, s0);
    s1 = fmaf(a.y, x49, s1);
    s2 = fmaf(a.z, x50, s2);
    s3 = fmaf(a.w, x51, s3);
    a = *(const LAS f32x4*)(Am + 4200);
    s0 = fmaf(a.x, x52, s0);
    s1 = fmaf(a.y, x53, s1);
    s2 = fmaf(a.z, x54, s2);
    s3 = fmaf(a.w, x55, s3);
    a = *(const LAS f32x4*)(Am + 4204);
    s0 = fmaf(a.x, x56, s0);
    s1 = fmaf(a.y, x57, s1);
    s2 = fmaf(a.z, x58, s2);
    s3 = fmaf(a.w, x59, s3);
    a = *(const LAS f32x4*)(Am + 4208);
    const float al61 = a.x;
    x61 = (x61 - ((s0 + s1) + (s2 + s3))) - al61 * x60;
    Tu[8296 + c] = f2bf(x61 * su); Tw[8296 + c] = f2bf(x61 * sw); asm volatile("" ::: "memory");
    float x62 = fmaxf(0.0f, 1.0f - fabsf(cf - 62.0f));
    s0 = 0.f; s1 = 0.f; s2 = 0.f; s3 = 0.f;
    a = *(const LAS f32x4*)(Am + 4216);
    s0 = fmaf(a.x, x0, s0);
    s1 = fmaf(a.y, x1, s1);
    s2 = fmaf(a.z, x2, s2);
    s3 = fmaf(a.w, x3, s3);
    a = *(const LAS f32x4*)(Am + 4220);
    s0 = fmaf(a.x, x4, s0);
    s1 = fmaf(a.y, x5, s1);
    s2 = fmaf(a.z, x6, s2);
    s3 = fmaf(a.w, x7, s3);
    a = *(const LAS f32x4*)(Am + 4224);
    s0 = fmaf(a.x, x8, s0);
    s1 = fmaf(a.y, x9, s1);
    s2 = fmaf(a.z, x10, s2);
    s3 = fmaf(a.w, x11, s3);
    a = *(const LAS f32x4*)(Am + 4228);
    s0 = fmaf(a.x, x12, s0);
    s1 = fmaf(a.y, x13, s1);
    s2 = fmaf(a.z, x14, s2);
    s3 = fmaf(a.w, x15, s3);
    a = *(const LAS f32x4*)(Am + 4232);
    s0 = fmaf(a.x, x16, s0);
    s1 = fmaf(a.y, x17, s1);
    s2 = fmaf(a.z, x18, s2);
    s3 = fmaf(a.w, x19, s3);
    a = *(const LAS f32x4*)(Am + 4236);
    s0 = fmaf(a.x, x20, s0);
    s1 = fmaf(a.y, x21, s1);
    s2 = fmaf(a.z, x22, s2);
    s3 = fmaf(a.w, x23, s3);
    a = *(const LAS f32x4*)(Am + 4240);
    s0 = fmaf(a.x, x24, s0);
    s1 = fmaf(a.y, x25, s1);
    s2 = fmaf(a.z, x26, s2);
    s3 = fmaf(a.w, x27, s3);
    a = *(const LAS f32x4*)(Am + 4244);
    s0 = fmaf(a.x, x28, s0);
    s1 = fmaf(a.y, x29, s1);
    s2 = fmaf(a.z, x30, s2);
    s3 = fmaf(a.w, x31, s3);
    a = *(const LAS f32x4*)(Am + 4248);
    s0 = fmaf(a.x, x32, s0);
    s1 = fmaf(a.y, x33, s1);
    s2 = fmaf(a.z, x34, s2);
    s3 = fmaf(a.w, x35, s3);
    a = *(const LAS f32x4*)(Am + 4252);
    s0 = fmaf(a.x, x36, s0);
    s1 = fmaf(a.y, x37, s1);
    s2 = fmaf(a.z, x38, s2);
    s3 = fmaf(a.w, x39, s3);
    a = *(const LAS f32x4*)(Am + 4256);
    s0 = fmaf(a.x, x40, s0);
    s1 = fmaf(a.y, x41, s1);
    s2 = fmaf(a.z, x42, s2);
    s3 = fmaf(a.w, x43, s3);
    a = *(const LAS f32x4*)(Am + 4260);
    s0 = fmaf(a.x, x44, s0);
    s1 = fmaf(a.y, x45, s1);
    s2 = fmaf(a.z, x46, s2);
    s3 = fmaf(a.w, x47, s3);
    a = *(const LAS f32x4*)(Am + 4264);
    s0 = fmaf(a.x, x48, s0);
    s1 = fmaf(a.y, x49, s1);
    s2 = fmaf(a.z, x50, s2);
    s3 = fmaf(a.w, x51, s3);
    a = *(const LAS f32x4*)(Am + 4268);
    s0 = fmaf(a.x, x52, s0);
    s1 = fmaf(a.y, x53, s1);
    s2 = fmaf(a.z, x54, s2);
    s3 = fmaf(a.w, x55, s3);
    a = *(const LAS f32x4*)(Am + 4272);
    s0 = fmaf(a.x, x56, s0);
    s1 = fmaf(a.y, x57, s1);
    s2 = fmaf(a.z, x58, s2);
    s3 = fmaf(a.w, x59, s3);
    a = *(const LAS f32x4*)(Am + 4276);
    s0 = fmaf(a.x, x60, s0);
    const float al62 = a.y;
    x62 = (x62 - ((s0 + s1) + (s2 + s3))) - al62 * x61;
    Tu[8432 + c] = f2bf(x62 * su); Tw[8432 + c] = f2bf(x62 * sw); asm volatile("" ::: "memory");
    float x63 = fmaxf(0.0f, 1.0f - fabsf(cf - 63.0f));
    s0 = 0.f; s1 = 0.f; s2 = 0.f; s3 = 0.f;
    a = *(const LAS f32x4*)(Am + 4284);
    s0 = fmaf(a.x, x0, s0);
    s1 = fmaf(a.y, x1, s1);
    s2 = fmaf(a.z, x2, s2);
    s3 = fmaf(a.w, x3, s3);
    a = *(const LAS f32x4*)(Am + 4288);
    s0 = fmaf(a.x, x4, s0);
    s1 = fmaf(a.y, x5, s1);
    s2 = fmaf(a.z, x6, s2);
    s3 = fmaf(a.w, x7, s3);
    a = *(const LAS f32x4*)(Am + 4292);
    s0 = fmaf(a.x, x8, s0);
    s1 = fmaf(a.y, x9, s1);
    s2 = fmaf(a.z, x10, s2);
    s3 = fmaf(a.w, x11, s3);
    a = *(const LAS f32x4*)(Am + 4296);
    s0 = fmaf(a.x, x12, s0);
    s1 = fmaf(a.y, x13, s1);
    s2 = fmaf(a.z, x14, s2);
    s3 = fmaf(a.w, x15, s3);
    a = *(const LAS f32x4*)(Am + 4300);
    s0 = fmaf(a.x, x16, s0);
    s1 = fmaf(a.y, x17, s1);
    s2 = fmaf(a.z, x18, s2);
    s3 = fmaf(a.w, x19, s3);
    a = *(const LAS f32x4*)(Am + 4304);
    s0 = fmaf(a.x, x20, s0);
    s1 = fmaf(a.y, x21, s1);
    s2 = fmaf(a.z, x22, s2);
    s3 = fmaf(a.w, x23, s3);
    a = *(const LAS f32x4*)(Am + 4308);
    s0 = fmaf(a.x, x24, s0);
    s1 = fmaf(a.y, x25, s1);
    s2 = fmaf(a.z, x26, s2);
    s3 = fmaf(a.w, x27, s3);
    a = *(const LAS f32x4*)(Am + 4312);
    s0 = fmaf(a.x, x28, s0);
    s1 = fmaf(a.y, x29, s1);
    s2 = fmaf(a.z, x30, s2);
    s3 = fmaf(a.w, x31, s3);
    a = *(const LAS f32x4*)(Am + 4316);
    s0 = fmaf(a.x, x32, s0);
    s1 = fmaf(a.y, x33, s1);
    s2 = fmaf(a.z, x34, s2);
    s3 = fmaf(a.w, x35, s3);
    a = *(const LAS f32x4*)(Am + 4320);
    s0 = fmaf(a.x, x36, s0);
    s1 = fmaf(a.y, x37, s1);
    s2 = fmaf(a.z, x38, s2);
    s3 = fmaf(a.w, x39, s3);
    a = *(const LAS f32x4*)(Am + 4324);
    s0 = fmaf(a.x, x40, s0);
    s1 = fmaf(a.y, x41, s1);
    s2 = fmaf(a.z, x42, s2);
    s3 = fmaf(a.w, x43, s3);
    a = *(const LAS f32x4*)(Am + 4328);
    s0 = fmaf(a.x, x44, s0);
    s1 = fmaf(a.y, x45, s1);
    s2 = fmaf(a.z, x46, s2);
    s3 = fmaf(a.w, x47, s3);
    a = *(const LAS f32x4*)(Am + 4332);
    s0 = fmaf(a.x, x48, s0);
    s1 = fmaf(a.y, x49, s1);
    s2 = fmaf(a.z, x50, s2);
    s3 = fmaf(a.w, x51, s3);
    a = *(const LAS f32x4*)(Am + 4336);
    s0 = fmaf(a.x, x52, s0);
    s1 = fmaf(a.y, x53, s1);
    s2 = fmaf(a.z, x54, s2);
    s3 = fmaf(a.w, x55, s3);
    a = *(const LAS f32x4*)(Am + 4340);
    s0 = fmaf(a.x, x56, s0);
    s1 = fmaf(a.y, x57, s1);
    s2 = fmaf(a.z, x58, s2);
    s3 = fmaf(a.w, x59, s3);
    a = *(const LAS f32x4*)(Am + 4344);
    s0 = fmaf(a.x, x60, s0);
    s1 = fmaf(a.y, x61, s1);
    const float al63 = a.z;
    x63 = (x63 - ((s0 + s1) + (s2 + s3))) - al63 * x62;
    Tu[8568 + c] = f2bf(x63 * su); Tw[8568 + c] = f2bf(x63 * sw); asm volatile("" ::: "memory");
}
typedef short bf16x8_t __attribute__((ext_vector_type(8)));
template <int K> __device__ __forceinline__ f32x4 mma_tile(const LAS unsigned short* A, int lda, const LAS unsigned short* Bt, int ldb, f32x4 acc) {
    const int lane = threadIdx.x & 63, r = lane & 15, q = lane >> 4;
#pragma unroll
    for (int ks = 0; ks < K / 32; ++ks) {
        const bf16x8_t a = *(const LAS bf16x8_t*)(A + r * lda + ks * 32 + q * 8);
        const bf16x8_t b = *(const LAS bf16x8_t*)(Bt + r * ldb + ks * 32 + q * 8);
        acc = __builtin_amdgcn_mfma_f32_16x16x32_bf16(a, b, acc, 0, 0, 0);
    }
    return acc;
}

typedef unsigned short u16x4_t __attribute__((ext_vector_type(4)));
__device__ __forceinline__ void tr_frag2(unsigned base_addr, int pitch, int c, bf16x8_t& f0, bf16x8_t& f1) {
    const int lane = threadIdx.x & 63, g = lane >> 4, qq = (lane & 15) >> 2, pp = lane & 3;
    const unsigned a00 = base_addr + (unsigned)((8 * g + qq) * pitch + 32 * c + 8 * pp);
    const unsigned a01 = a00 + 4u * (unsigned)pitch, a10 = a00 + 32u * (unsigned)pitch, a11 = a10 + 4u * (unsigned)pitch;
    u16x4_t r00, r01, r10, r11;
    asm volatile("ds_read_b64_tr_b16 %0, %4\n\tds_read_b64_tr_b16 %1, %5\n\tds_read_b64_tr_b16 %2, %6\n\tds_read_b64_tr_b16 %3, %7\n\ts_waitcnt lgkmcnt(0)"
                 : "=&v"(r00), "=&v"(r01), "=&v"(r10), "=&v"(r11) : "v"(a00), "v"(a01), "v"(a10), "v"(a11) : "memory");
    f0 = (bf16x8_t){(short)r00.x, (short)r00.y, (short)r00.z, (short)r00.w, (short)r01.x, (short)r01.y, (short)r01.z, (short)r01.w};
    f1 = (bf16x8_t){(short)r10.x, (short)r10.y, (short)r10.z, (short)r10.w, (short)r11.x, (short)r11.y, (short)r11.z, (short)r11.w};
}
constexpr size_t WS_G = 235 * MiB;

__device__ __forceinline__ void delta_prep(LDSp lds, const Params& p) {
    const bf16_t* QKVN = (const bf16_t*)(p.ws + WS_QKV); const float* BETA = (const float*)(p.ws + WS_BETA); const float* LA = (const float*)(p.ws + WS_LA);
    bf16_t* Z = (bf16_t*)(p.ws + WS_Z); float* GB = (float*)(p.ws + WS_G);
    LAS unsigned short* Qb = (LAS unsigned short*)lds;
    LAS unsigned short* Kb = (LAS unsigned short*)(lds + 17408);
    LAS unsigned short* Ast = (LAS unsigned short*)(lds + 107776);
    const int tid = threadIdx.x, lane = tid & 63, wid = tid >> 6, r = lane & 15, q = lane >> 4;
    const int G = gridDim.x;
    u32x4 pq[4]; float pla = 0.f, pbe = 0.f;
#define DPL(u_, vmode) do { const int dir_ = (u_) >> 10, b_ = ((u_) >> 8) & 3, h_ = ((u_) >> 6) & 3, n_ = (u_) & 63; \
        const long tk0_ = (long)b_ * S_ + (dir_ ? (S_ - 1 - n_ * 64) : n_ * 64); const long ts_ = dir_ ? -1 : 1; \
        _Pragma("unroll") for (int i = 0; i < 4; ++i) { const int pi = tid + NTHR * i, which = pi >> 10, l = (pi >> 4) & 63, c8 = pi & 15; \
            pq[i] = *(const u32x4*)(QKVN + (tk0_ + l * ts_) * 1536 + ((vmode) ? (which ? 512 : 1024) : which * 512) + h_ * 128 + c8 * 8); } \
        if (!(vmode) && tid < 64) { const long tk = tk0_ + tid * ts_; pla = LA[tk * 8 + dir_ * 4 + h_]; pbe = BETA[tk * 8 + dir_ * 4 + h_]; } } while (0)
#define DPS() do { _Pragma("unroll") for (int i = 0; i < 4; ++i) { const int pi = tid + NTHR * i, which = pi >> 10, l = (pi >> 4) & 63, c8 = pi & 15; *(LAS u32x4*)(lds + which * 17408 + l * 272 + c8 * 16) = pq[i]; } } while (0)
    if ((int)blockIdx.x < 2048) DPL((int)blockIdx.x, 0);
    for (int ub = blockIdx.x; ub < 2048; ub += 4 * G) {
#pragma unroll 1
        for (int j = 0; j < 4; ++j) { const int unit = ub + j * G; if (unit >= 2048) break;
            const int dir = unit >> 10, b = (unit >> 8) & 3, h = (unit >> 6) & 3, n = unit & 63;
            const long tok0 = (long)b * S_ + (dir ? (S_ - 1 - n * 64) : n * 64); const long tstep = dir ? -1 : 1;
            LAS float* Am = (LAS float*)(lds + 34816 + j * 17408); LAS float* gl = (LAS float*)(lds + 104448 + j * 768); LAS float* be = gl + 64; LAS float* beg = gl + 128; LAS float* la = (LAS float*)(lds + 107520);
            DPS();
            if (tid < 64) { la[tid] = pla; be[tid] = pbe; }
            __syncthreads();
            { const int un = ub + (j + 1) * G; if (j < 3 && un < 2048) DPL(un, 0); else DPL(ub, 1); }
            if (tid < 64) { const float g = wave_scan_sum(la[tid], true); gl[tid] = g; beg[tid] = be[tid] * __expf(g); GB[((size_t)dir * T_ + (tok0 + tid * tstep)) * 4 + h] = g; }
            __syncthreads();
#pragma unroll
            for (int tt = 0; tt < 2; ++tt) { const int idx = wid * 2 + tt, mt = idx >> 2, nt = idx & 3;
                f32x4 kk = {0.f, 0.f, 0.f, 0.f}, qk = {0.f, 0.f, 0.f, 0.f};
                if (mt >= nt) { kk = mma_tile<128>(Kb + mt * 16 * 136, 136, Kb + nt * 16 * 136, 136, kk); qk = mma_tile<128>(Qb + mt * 16 * 136, 136, Kb + nt * 16 * 136, 136, qk); }
                const int jj = nt * 16 + r; const float gj = gl[jj];
#pragma unroll
                for (int i4 = 0; i4 < 4; ++i4) { const int i = mt * 16 + q * 4 + i4; const float dec = (i >= jj) ? __expf(gl[i] - gj) : 0.f;
                    Am[i * 68 + jj] = (i > jj) ? be[i] * kk[i4] * dec : 0.f;
                    Ast[i * 72 + jj] = f2bf(qk[i4] * dec); }
            }
            __syncthreads();
            { const int l = tid >> 3, c8 = tid & 7;
              *(u32x4*)(Z + (tok0 + l * tstep) * 3072 + 2048 + dir * 256 + h * 64 + c8 * 8) = *(const LAS u32x4*)(Ast + l * 72 + c8 * 8); }
        }
        if (wid < 4 && ub + wid * G < 2048) { int cc = lane; asm volatile("" : "+v"(cc));
            LAS float* Am = (LAS float*)(lds + 34816 + wid * 17408); LAS float* gl = (LAS float*)(lds + 104448 + wid * 768);
            tri_inv64(Am, cc, gl[64 + lane], gl[128 + lane], (LAS unsigned short*)Am, (LAS unsigned short*)Am + 64); }
        __syncthreads();
#pragma unroll 1
        for (int j = 0; j < 4; ++j) { const int unit = ub + j * G; if (unit >= 2048) break;
            const int dir = unit >> 10, b = (unit >> 8) & 3, h = (unit >> 6) & 3, n = unit & 63;
            const long tok0 = (long)b * S_ + (dir ? (S_ - 1 - n * 64) : n * 64); const long tstep = dir ? -1 : 1;
            const LAS unsigned short* Tu = (const LAS unsigned short*)(lds + 34816 + j * 17408);
            DPS();
            __syncthreads();
            { const int un = ub + (j + 1) * G; if (j < 3 && un < 2048) DPL(un, 1); else if (ub + 4 * G < 2048) DPL(ub + 4 * G, 0); }
            {   bf16x8_t vb0, vb1, kb0, kb1; tr_frag2((unsigned)(unsigned long long)Qb, 272, wid, vb0, vb1); tr_frag2((unsigned)(unsigned long long)Kb, 272, wid, kb0, kb1);
                __syncthreads();
#pragma unroll
                for (int mt = 0; mt < 4; ++mt) {
                    const bf16x8_t tu0 = *(const LAS bf16x8_t*)(Tu + (mt * 16 + r) * 136 + q * 8), tu1 = *(const LAS bf16x8_t*)(Tu + (mt * 16 + r) * 136 + 32 + q * 8);
                    const bf16x8_t tw0 = *(const LAS bf16x8_t*)(Tu + (mt * 16 + r) * 136 + 64 + q * 8), tw1 = *(const LAS bf16x8_t*)(Tu + (mt * 16 + r) * 136 + 96 + q * 8);
                    f32x4 au = {0.f, 0.f, 0.f, 0.f}, aw = {0.f, 0.f, 0.f, 0.f};
                    au = __builtin_amdgcn_mfma_f32_16x16x32_bf16(tu0, vb0, au, 0, 0, 0); au = __builtin_amdgcn_mfma_f32_16x16x32_bf16(tu1, vb1, au, 0, 0, 0);
                    aw = __builtin_amdgcn_mfma_f32_16x16x32_bf16(tw0, kb0, aw, 0, 0, 0); aw = __builtin_amdgcn_mfma_f32_16x16x32_bf16(tw1, kb1, aw, 0, 0, 0);
#pragma unroll
                    for (int i4 = 0; i4 < 4; ++i4) { const int l = mt * 16 + q * 4 + i4; Qb[l * 136 + wid * 16 + r] = f2bf(au[i4]); Kb[l * 136 + wid * 16 + r] = f2bf(aw[i4]); }
                }
            }
            __syncthreads();
#pragma unroll
            for (int i = 0; i < 4; ++i) { const int pi = tid + NTHR * i, which = pi >> 10, l = (pi >> 4) & 63, c8 = pi & 15;
                *(u32x4*)(Z + (tok0 + l * tstep) * 3072 + which * 1024 + dir * 512 + h * 128 + c8 * 8) = *(const LAS u32x4*)(lds + which * 17408 + l * 272 + c8 * 16); }
            __syncthreads();
        }
    }
}
#undef DPL
#undef DPS

__device__ __forceinline__ void delta_scan2(LDSp lds, const Params& p) {
    const bf16_t* QKVN = (const bf16_t*)(p.ws + WS_QKV); const bf16_t* Z = (const bf16_t*)(p.ws + WS_Z); const float* GB = (const float*)(p.ws + WS_G);
    LAS unsigned short* Wb  = (LAS unsigned short*)lds;
    LAS unsigned short* Qg  = (LAS unsigned short*)(lds + 17408);
    LAS unsigned short* Kg  = (LAS unsigned short*)(lds + 34816);
    LAS unsigned short* At  = (LAS unsigned short*)(lds + 53248);
    LAS unsigned short* Ub  = (LAS unsigned short*)(lds + 62464);
    LAS unsigned short* St  = (LAS unsigned short*)(lds + 66560);
    LAS unsigned short* Vt  = (LAS unsigned short*)(lds + 75264);
    const int tid = threadIdx.x, lane = tid & 63, wid = tid >> 6, r = lane & 15, q = lane >> 4;
    for (int unit = blockIdx.x; unit < 128; unit += gridDim.x) {
        const int dir = unit >> 6, b = (unit >> 4) & 3, h = (unit >> 2) & 3, sl = unit & 3;
        bf16_t* O = (bf16_t*)(p.ws + (dir ? WS_OB : WS_OF));
        const long tstep = dir ? -1 : 1;
        f32x4 S0 = {0.f, 0.f, 0.f, 0.f}, S1 = {0.f, 0.f, 0.f, 0.f};
        u32x4 rwA[2], rqA[2], rkA[2], raA, ruA = {0u, 0u, 0u, 0u}; float g0A = 0.f, g1A = 0.f, gLA = 0.f;
        u32x4 rwB[2], rqB[2], rkB[2], raB, ruB = {0u, 0u, 0u, 0u}; float g0B = 0.f, g1B = 0.f, gLB = 0.f;
#define D2_TOK0(n) ((long)b * S_ + (dir ? (S_ - 1 - (n) * 64) : (n) * 64))
#define D2_LOAD(n, X) do { const long t0_ = D2_TOK0(n); \
        _Pragma("unroll") for (int i = 0; i < 2; ++i) { const int pi = tid + NTHR * i, l = pi >> 4, c8 = pi & 15; const long tk = t0_ + l * tstep; \
            rw##X[i] = *(const u32x4*)(Z + tk * 3072 + 1024 + dir * 512 + h * 128 + c8 * 8); \
            rq##X[i] = *(const u32x4*)(QKVN + tk * 1536 + h * 128 + c8 * 8); rk##X[i] = *(const u32x4*)(QKVN + tk * 1536 + 512 + h * 128 + c8 * 8); } \
        { const int l = tid >> 3, c8 = tid & 7; ra##X = *(const u32x4*)(Z + (t0_ + l * tstep) * 3072 + 2048 + dir * 256 + h * 64 + c8 * 8); } \
        if (tid < 256) { const int l = tid >> 2, c8 = tid & 3; ru##X = *(const u32x4*)(Z + (t0_ + l * tstep) * 3072 + dir * 512 + h * 128 + sl * 32 + c8 * 8); } \
        g0##X = GB[((size_t)dir * T_ + (t0_ + (tid >> 4) * tstep)) * 4 + h]; g1##X = GB[((size_t)dir * T_ + (t0_ + ((tid >> 4) + 32) * tstep)) * 4 + h]; \
        gL##X = GB[((size_t)dir * T_ + (t0_ + 63 * tstep)) * 4 + h]; } while (0)
#define D2_ITER(n, X) do { \
            const float egL = __expf(gL##X); \
            _Pragma("unroll") for (int i = 0; i < 2; ++i) { const int pi = tid + NTHR * i, l = pi >> 4, c8 = pi & 15; const float gl_ = i == 0 ? g0##X : g1##X; \
                *(LAS u32x4*)(Wb + l * 136 + c8 * 8) = rw##X[i]; \
                float f[8]; unpack8(rq##X[i], f); const float eg = __expf(gl_); \
                u32x4 o; o.x = pk2(f[0] * eg, f[1] * eg); o.y = pk2(f[2] * eg, f[3] * eg); o.z = pk2(f[4] * eg, f[5] * eg); o.w = pk2(f[6] * eg, f[7] * eg); \
                *(LAS u32x4*)(Qg + l * 136 + c8 * 8) = o; \
                unpack8(rk##X[i], f); const float ek = __expf(gL##X - gl_); \
                o.x = pk2(f[0] * ek, f[1] * ek); o.y = pk2(f[2] * ek, f[3] * ek); o.z = pk2(f[4] * ek, f[5] * ek); o.w = pk2(f[6] * ek, f[7] * ek); \
                *(LAS u32x4*)(Kg + l * 144 + c8 * 8) = o; } \
            { const int l = tid >> 3, c8 = tid & 7; *(LAS u32x4*)(At + l * 72 + c8 * 8) = ra##X; } \
            if (tid < 256) { const int l = tid >> 2, c8 = tid & 3; *(LAS u32x4*)(Ub + l * 32 + c8 * 8) = ru##X; } \
            { u32x2 w0; w0.x = pk2(S0.x, S0.y); w0.y = pk2(S0.z, S0.w); *(LAS u32x2*)(St + r * 136 + wid * 16 + q * 4) = w0; \
              u32x2 w1; w1.x = pk2(S1.x, S1.y); w1.y = pk2(S1.z, S1.w); *(LAS u32x2*)(St + (16 + r) * 136 + wid * 16 + q * 4) = w1; } \
            __syncthreads(); \
            if ((n) + 2 < 64) D2_LOAD((n) + 2, X); \
            const int mt = wid >> 1, nt = wid & 1; \
            f32x4 p1 = {0.f, 0.f, 0.f, 0.f}, p2 = {0.f, 0.f, 0.f, 0.f}; \
            p1 = mma_tile<128>(Wb + mt * 16 * 136, 136, St + nt * 16 * 136, 136, p1); \
            p2 = mma_tile<128>(Qg + mt * 16 * 136, 136, St + nt * 16 * 136, 136, p2); \
            { const int l0 = mt * 16 + q * 4, v = nt * 16 + r; float vn[4]; \
              _Pragma("unroll") for (int i = 0; i < 4; ++i) vn[i] = bf2f(Ub[(l0 + i) * 32 + v]) - p1[i]; \
              u32x2 w; w.x = pk2(vn[0], vn[1]); w.y = pk2(vn[2], vn[3]); *(LAS u32x2*)(Vt + v * 72 + l0) = w; } \
            __syncthreads(); \
            p2 = mma_tile<64>(At + mt * 16 * 72, 72, Vt + nt * 16 * 72, 72, p2); \
            { const long t0_ = D2_TOK0(n); \
              _Pragma("unroll") for (int i = 0; i < 4; ++i) O[(t0_ + (mt * 16 + q * 4 + i) * tstep) * 512 + h * 128 + sl * 32 + nt * 16 + r] = f2bf(p2[i]); } \
            S0 = S0 * egL; S1 = S1 * egL; \
            { bf16x8_t ka0, ka1; tr_frag2((unsigned)(unsigned long long)Kg, 288, wid, ka0, ka1); \
              const bf16x8_t vb00 = *(const LAS bf16x8_t*)(Vt + r * 72 + q * 8), vb01 = *(const LAS bf16x8_t*)(Vt + r * 72 + 32 + q * 8); \
              const bf16x8_t vb10 = *(const LAS bf16x8_t*)(Vt + (16 + r) * 72 + q * 8), vb11 = *(const LAS bf16x8_t*)(Vt + (16 + r) * 72 + 32 + q * 8); \
              S0 = __builtin_amdgcn_mfma_f32_16x16x32_bf16(ka0, vb00, S0, 0, 0, 0); S0 = __builtin_amdgcn_mfma_f32_16x16x32_bf16(ka1, vb01, S0, 0, 0, 0); \
              S1 = __builtin_amdgcn_mfma_f32_16x16x32_bf16(ka0, vb10, S1, 0, 0, 0); S1 = __builtin_amdgcn_mfma_f32_16x16x32_bf16(ka1, vb11, S1, 0, 0, 0); } \
            __syncthreads(); } while (0)
        D2_LOAD(0, A); D2_LOAD(1, B);
#pragma unroll 1
        for (int n = 0; n < 64; n += 2) { D2_ITER(n, A); D2_ITER(n + 1, B); }
#undef D2_ITER
#undef D2_LOAD
#undef D2_TOK0
    }
}
constexpr size_t WS_CT = WS_OF, WS_NV = 235 * MiB, WS_MS = 235 * MiB + 524288, WS_CT2 = 169 * MiB, WS_NV2 = 236 * MiB;
__device__ __forceinline__ void mlstm_a(LDSp lds, const Params& p) {
    const bf16_t* Z = (const bf16_t*)(p.ws + WS_Z); const float* LI = (const float*)(p.ws + WS_BETA); const float* LF = (const float*)(p.ws + WS_LA);
    bf16_t* CT = (bf16_t*)(p.ws + WS_CT); float* NV = (float*)(p.ws + WS_NV); float* MS = (float*)(p.ws + WS_MS);
    LAS unsigned short* Ks = (LAS unsigned short*)lds;
    LAS unsigned short* Vr = (LAS unsigned short*)(lds + 9216);
    LAS float* lf = (LAS float*)(lds + 27648); LAS float* li = lf + 64; LAS float* sw = lf + 128; LAS float* red = lf + 192  ;
    const int tid = threadIdx.x, lane = tid & 63, wid = tid >> 6, r = lane & 15, q = lane >> 4;
    for (int unit = blockIdx.x; unit < 2048; unit += gridDim.x) {
        const int dir = unit >> 10, b = (unit >> 8) & 3, h = (unit >> 6) & 3, n = unit & 63, pc = dir ? 63 - n : n;
        const size_t tok0 = (size_t)b * S_ + pc * 64;
        if (tid < 64) { lf[tid] = LF[(tok0 + tid) * 8 + dir * 4 + h]; li[tid] = LI[(tok0 + tid) * 8 + dir * 4 + h]; }
        __syncthreads();
        if (tid < 64) { const float bc = wave_scan_sum(lf[tid], dir == 0);
            const float tot = __shfl(bc, dir ? 0 : 63);
            const float we = tot - bc + li[tid]; float mx = we;
#pragma unroll
            for (int o = 32; o; o >>= 1) mx = fmaxf(mx, __shfl_xor(mx, o));
            sw[tid] = __expf(we - mx);
            if (tid == 0) { MS[unit * 32] = tot; MS[unit * 32 + 1] = mx; } }
        __syncthreads();
        { const int pp = tid >> 3, c8 = tid & 7; const u32x4 kv = *(const u32x4*)(Z + (tok0 + pp) * 2560 + 1280 + h * 64 + c8 * 8); float f[8]; unpack8(kv, f); const float s = sw[pp];
          u32x4 o; o.x = pk2(f[0] * s, f[1] * s); o.y = pk2(f[2] * s, f[3] * s); o.z = pk2(f[4] * s, f[5] * s); o.w = pk2(f[6] * s, f[7] * s);
          *(LAS u32x4*)(Ks + pp * 72 + c8 * 8) = o; }
#pragma unroll
        for (int i = 0; i < 2; ++i) { const int pi = tid + NTHR * i, pp = pi >> 4, c8 = pi & 15;
            *(LAS u32x4*)(Vr + pp * 144 + c8 * 8) = *(const u32x4*)(Z + (tok0 + pp) * 2560 + 1536 + h * 128 + c8 * 8); }
        __syncthreads();
        { bf16x8_t vb0, vb1; tr_frag2((unsigned)(unsigned long long)Vr, 288, wid, vb0, vb1);
#pragma unroll
          for (int dt = 0; dt < 4; ++dt) { bf16x8_t ka0, ka1; tr_frag2((unsigned)(unsigned long long)Ks, 144, dt, ka0, ka1);
            f32x4 acc = {0.f, 0.f, 0.f, 0.f};
            acc = __builtin_amdgcn_mfma_f32_16x16x32_bf16(ka0, vb0, acc, 0, 0, 0); acc = __builtin_amdgcn_mfma_f32_16x16x32_bf16(ka1, vb1, acc, 0, 0, 0);
            u32x2 w; w.x = pk2(acc.x, acc.y); w.y = pk2(acc.z, acc.w);
            *(u32x2*)(CT + (size_t)unit * 8192 + (wid * 16 + r) * 64 + dt * 16 + q * 4) = w; } }
        { const int d = tid & 63; float a = 0.f;
#pragma unroll
          for (int j = 0; j < 8; ++j) a += bf2f(Ks[(wid * 8 + j) * 72 + d]);
          red[wid * 64 + d] = a; }
        __syncthreads();
        if (tid < 64) { float a = 0.f;
#pragma unroll
            for (int w = 0; w < 8; ++w) a += red[w * 64 + tid];
            NV[(size_t)unit * 64 + tid] = a; }
        __syncthreads();
    }
}
__device__ __forceinline__ void mlstm_b(const Params& p) {
    const bf16_t* CT = (const bf16_t*)(p.ws + WS_CT); const float* NV = (const float*)(p.ws + WS_NV); float* MS = (float*)(p.ws + WS_MS); bf16_t* CT2 = (bf16_t*)(p.ws + WS_CT2); float* NV2 = (float*)(p.ws + WS_NV2);
    const int tid = threadIdx.x;
    for (int wgi = blockIdx.x; wgi < 128; wgi += gridDim.x) {
        const int scan = wgi >> 2, part = wgi & 3; const size_t e = (size_t)(part * NTHR + tid) * 4;
        const bool nvw = (part == 0 && tid < 64);
        float m = 0.f, c0 = 0.f, c1 = 0.f, c2 = 0.f, c3 = 0.f, nn = 0.f;
#pragma unroll 1
        for (int hf = 0; hf < 4; ++hf) {
        u32x2 dc[16]; float dn[16], blv[16], mlv[16];
#pragma unroll
        for (int n = 0; n < 16; ++n) { blv[n] = MS[(scan * 64 + hf * 16 + n) * 32]; mlv[n] = MS[(scan * 64 + hf * 16 + n) * 32 + 1]; dc[n] = (EXPC == 2) ? (u32x2){0u, 0u} : *(const u32x2*)(CT + (size_t)(scan * 64 + hf * 16 + n) * 8192 + e); dn[n] = nvw ? NV[(size_t)(scan * 64 + hf * 16 + n) * 64 + tid] : 0.f; }
#pragma unroll
        for (int n = 0; n < 16; ++n) { const int unit = scan * 64 + hf * 16 + n;
            const float bl = blv[n], ml = mlv[n];
            u32x2 w; w.x = pk2(c0, c1); w.y = pk2(c2, c3); *(u32x2*)(CT2 + (size_t)unit * 8192 + e) = w;
            if (nvw) NV2[(size_t)unit * 64 + tid] = nn;
            if (part == 0 && tid == 0) MS[65536 + unit] = m;
            const float mn = fmaxf(bl + m, ml), a = __expf(bl + m - mn), bb = __expf(ml - mn);
            c0 = a * c0 + bb * bflo(dc[n].x); c1 = a * c1 + bb * bfhi(dc[n].x); c2 = a * c2 + bb * bflo(dc[n].y); c3 = a * c3 + bb * bfhi(dc[n].y);
            nn = a * nn + bb * dn[n]; m = mn; }
        }
    }
}
__device__ __forceinline__ void mlstm_c(LDSp lds, const Params& p) {
    const bf16_t* Z = (const bf16_t*)(p.ws + WS_Z); const float* LI = (const float*)(p.ws + WS_BETA); const float* LF = (const float*)(p.ws + WS_LA);
    const bf16_t* CT = (const bf16_t*)(p.ws + WS_CT2); const float* NV = (const float*)(p.ws + WS_NV2); const float* MS = (const float*)(p.ws + WS_MS);
    bf16_t* Y = (bf16_t*)(p.ws + WS_HN); const float* gn = p.in[19];
    LAS unsigned short* Qb = (LAS unsigned short*)lds;
    LAS unsigned short* Kb = (LAS unsigned short*)(lds + 9216);
    LAS unsigned short* Vr = (LAS unsigned short*)(lds + 18432);
    LAS float* ssp = (LAS float*)(lds + 100352);
#define MC_CB(d) ((LAS unsigned short*)(lds + 36864 + (d) * 18432))
#define MC_PB(d) ((LAS unsigned short*)(lds + 73728 + (d) * 9216))
#define MC_SC(d) ((LAS float*)(lds + 92160 + (d) * 4096))
    const int tid = threadIdx.x, wid = tid >> 6;
    for (int unit = blockIdx.x; unit < 1024; unit += gridDim.x) {
        int lane = tid & 63; asm volatile("" : "+v"(lane));
        const int r = lane & 15, q = lane >> 4;
        const int b = unit >> 8, h = (unit >> 6) & 3, pc = unit & 63; const size_t tok0 = (size_t)b * S_ + pc * 64;
        const size_t ua = (size_t)(((0 * 4 + b) * 4 + h) * 64 + pc), ub = (size_t)(((1 * 4 + b) * 4 + h) * 64 + (63 - pc));
        { const int pp = tid >> 3, c8 = tid & 7;
          *(LAS u32x4*)(Qb + pp * 72 + c8 * 8) = *(const u32x4*)(Z + (tok0 + pp) * 2560 + 1024 + h * 64 + c8 * 8);
          *(LAS u32x4*)(Kb + pp * 72 + c8 * 8) = *(const u32x4*)(Z + (tok0 + pp) * 2560 + 1280 + h * 64 + c8 * 8); }
#pragma unroll
        for (int i = 0; i < 2; ++i) { const int pi = tid + NTHR * i, pp = pi >> 4, c8 = pi & 15; *(LAS u32x4*)(Vr + pp * 144 + c8 * 8) = *(const u32x4*)(Z + (tok0 + pp) * 2560 + 1536 + h * 128 + c8 * 8); }
#pragma unroll
        for (int i = 0; i < 2; ++i) { const int pi = tid + NTHR * i, v = pi >> 3, c8 = pi & 7;
            *(LAS u32x4*)(MC_CB(0) + v * 72 + c8 * 8) = *(const u32x4*)(CT + ua * 8192 + v * 64 + c8 * 8); *(LAS u32x4*)(MC_CB(1) + v * 72 + c8 * 8) = *(const u32x4*)(CT + ub * 8192 + v * 64 + c8 * 8); }
        float mst = 0.f;
        if (tid < 128) { const int d = tid >> 6; const size_t ud = d ? ub : ua; LAS float* sc = MC_SC(d);
            sc[lane] = LF[(tok0 + lane) * 8 + d * 4 + h]; sc[64 + lane] = LI[(tok0 + lane) * 8 + d * 4 + h]; sc[384 + lane] = NV[ud * 64 + lane]; mst = MS[65536 + ud]; }
        __syncthreads();
        bf16x8_t vb0, vb1; tr_frag2((unsigned)(unsigned long long)Vr, 288, wid, vb0, vb1);
        {
            const int t = tid >> 3, part = tid & 7; const u32x4 qv = *(const LAS u32x4*)(Qb + t * 72 + part * 8); float f[8]; unpack8(qv, f);
#pragma unroll
            for (int d = 0; d < 2; ++d) { LAS float* sc = MC_SC(d);
                const f32x4 n0 = *(const LAS f32x4*)(sc + 384 + part * 8), n1 = *(const LAS f32x4*)(sc + 384 + part * 8 + 4);
                float a = f[0] * n0.x; a = fmaf(f[1], n0.y, a); a = fmaf(f[2], n0.z, a); a = fmaf(f[3], n0.w, a); a = fmaf(f[4], n1.x, a); a = fmaf(f[5], n1.y, a); a = fmaf(f[6], n1.z, a); a = fmaf(f[7], n1.w, a);
                a += dppf<0xB1>(a); a += dppf<0x4E>(a); a += dppf<0x141>(a);
                if (part == 0) sc[320 + t] = a; } }
        if (tid < 128) {
            const int d = tid >> 6; LAS float* sc = MC_SC(d);
            const float bt = wave_scan_sum(sc[lane], d == 0);
            const float dmax = bt + wave_scan_max(sc[64 + lane] - bt, d == 0);
            const float m = fmaxf(bt + mst, dmax), w = __expf(bt + mst - m);
            sc[128 + lane] = bt; sc[192 + lane] = m; sc[256 + lane] = w * 0.125f; sc[448 + lane] = __expf(-m); }
        __syncthreads();
#pragma unroll 1
        for (int tt = 0; tt < 2; ++tt) { const int idx = wid * 2 + tt, mt = idx >> 2, nt = idx & 3;
            f32x4 scv = {0.f, 0.f, 0.f, 0.f};
            scv = mma_tile<64>(Qb + mt * 16 * 72, 72, Kb + nt * 16 * 72, 72, scv);
            const int s_ = nt * 16 + r;
#pragma unroll 1
            for (int d = 0; d < 2; ++d) { LAS float* sc = MC_SC(d); LAS unsigned short* Pb = MC_PB(d); const float bs = sc[128 + s_] - sc[64 + s_];
#pragma unroll
                for (int i = 0; i < 4; ++i) { const int t = mt * 16 + q * 4 + i; const bool ok = d ? (s_ >= t) : (s_ <= t);
                    const float pv = ok ? __expf(sc[128 + t] - bs - sc[192 + t]) * scv[i] * 0.125f : 0.f;
                    const unsigned short pb = f2bf(pv); Pb[t * 72 + s_] = pb;
                    const float rs = row16_sum(bf2f(pb));
                    if (r == 0) sc[512 + nt * 64 + t] = rs; } }
        }
        __syncthreads();
        f32x4 hacc[4];
#pragma unroll
        for (int mt = 0; mt < 4; ++mt) { hacc[mt] = (f32x4){0.f, 0.f, 0.f, 0.f};
            const bf16x8_t qa0 = *(const LAS bf16x8_t*)(Qb + (mt * 16 + r) * 72 + q * 8), qa1 = *(const LAS bf16x8_t*)(Qb + (mt * 16 + r) * 72 + 32 + q * 8);
#pragma unroll 1
            for (int d = 0; d < 2; ++d) { const LAS float* sc = MC_SC(d); const LAS unsigned short* Pb = MC_PB(d); const LAS unsigned short* Cb = MC_CB(d);
                f32x4 a1 = {0.f, 0.f, 0.f, 0.f}, a2 = {0.f, 0.f, 0.f, 0.f};
                const bf16x8_t cb0 = *(const LAS bf16x8_t*)(Cb + (wid * 16 + r) * 72 + q * 8), cb1 = *(const LAS bf16x8_t*)(Cb + (wid * 16 + r) * 72 + 32 + q * 8);
                a1 = __builtin_amdgcn_mfma_f32_16x16x32_bf16(qa0, cb0, a1, 0, 0, 0); a1 = __builtin_amdgcn_mfma_f32_16x16x32_bf16(qa1, cb1, a1, 0, 0, 0);
                const bf16x8_t pa0 = *(const LAS bf16x8_t*)(Pb + (mt * 16 + r) * 72 + q * 8), pa1 = *(const LAS bf16x8_t*)(Pb + (mt * 16 + r) * 72 + 32 + q * 8);
                a2 = __builtin_amdgcn_mfma_f32_16x16x32_bf16(pa0, vb0, a2, 0, 0, 0); a2 = __builtin_amdgcn_mfma_f32_16x16x32_bf16(pa1, vb1, a2, 0, 0, 0);
#pragma unroll
                for (int i = 0; i < 4; ++i) { const int t = mt * 16 + q * 4 + i;
                    const float den = sc[256 + t] * sc[320 + t] + ((sc[512 + t] + sc[576 + t]) + (sc[640 + t] + sc[704 + t]));
                    hacc[mt][i] += (sc[256 + t] * a1[i] + a2[i]) * __builtin_amdgcn_rcpf(fmaxf(fabsf(den), sc[448 + t])); }
            }
        }
#pragma unroll
        for (int mt = 0; mt < 4; ++mt)
#pragma unroll
            for (int i = 0; i < 4; ++i) { const float s = row16_sum(hacc[mt][i] * hacc[mt][i]); if (r == 0) ssp[wid * 64 + mt * 16 + q * 4 + i] = s; }
        __syncthreads();
        { const int v = wid * 16 + r; const float g = gn[v]; LAS unsigned short* Yt = MC_CB(0);
#pragma unroll
          for (int mt = 0; mt < 4; ++mt)
#pragma unroll
              for (int i = 0; i < 4; ++i) { const int t = mt * 16 + q * 4 + i;
                  float ss = 0.f;
#pragma unroll
                  for (int w = 0; w < 8; ++w) ss += ssp[w * 64 + t];
                  const float rstd = rsqrtf(ss * (1.0f / 128.0f) + 1e-6f);
                  Yt[t * 136 + v] = f2bf(hacc[mt][i] * rstd * g); } }
        __syncthreads();
#pragma unroll
        for (int i = 0; i < 2; ++i) { const int pi = tid + NTHR * i, t = pi >> 4, c8 = (pi & 15) * 8;
            const u32x4 yv = *(const LAS u32x4*)(MC_CB(0) + t * 136 + c8); const u32x4 ov = *(const u32x4*)(Z + (tok0 + t) * 2560 + 2048 + h * 128 + c8);
            float y[8], o[8]; unpack8(yv, y); unpack8(ov, o);
            u32x4 w; w.x = pk2(y[0] * sigm_f(o[0]), y[1] * sigm_f(o[1])); w.y = pk2(y[2] * sigm_f(o[2]), y[3] * sigm_f(o[3])); w.z = pk2(y[4] * sigm_f(o[4]), y[5] * sigm_f(o[5])); w.w = pk2(y[6] * sigm_f(o[6]), y[7] * sigm_f(o[7]));
            *(u32x4*)(Y + (tok0 + t) * 1024 + 512 + h * 128 + c8) = w; }
        __syncthreads();
    }
#undef MC_CB
#undef MC_PB
#undef MC_SC
}
__device__ __forceinline__ void headnorm_phase(const Params& p, const float* __restrict__ g, int zld, int zcol, int act) {
    const bf16_t* OF = (const bf16_t*)(p.ws + WS_OF); const bf16_t* OB = (const bf16_t*)(p.ws + WS_OB); const bf16_t* Z = (const bf16_t*)(p.ws + WS_Z); bf16_t* Y = (bf16_t*)(p.ws + WS_HN);
    const int tid = threadIdx.x, lane = tid & 63, wid = tid >> 6, c = lane * 8;
    const f32x4 g0 = *(const f32x4*)(g + (c & 127)), g1 = *(const f32x4*)(g + (c & 127) + 4);
    for (int tok = blockIdx.x * 8 + wid; tok < T_; tok += gridDim.x * 8) {
        const u32x4 a = *(const u32x4*)(OF + (size_t)tok * 512 + c), bq = *(const u32x4*)(OB + (size_t)tok * 512 + c), gz = *(const u32x4*)(Z + (size_t)tok * zld + zcol + c);
        float fa[8], fb[8], fg[8], o[8]; unpack8(a, fa); unpack8(bq, fb); unpack8(gz, fg);
        float ss = 0.f;
#pragma unroll
        for (int i = 0; i < 8; ++i) { o[i] = fa[i] + fb[i]; ss = fmaf(o[i], o[i], ss); }
        ss = row16_sum(ss);
        const float rstd = rsqrtf(ss * (1.0f / 128.0f) + 1e-6f);
        const float gg[8] = {g0.x, g0.y, g0.z, g0.w, g1.x, g1.y, g1.z, g1.w};
        float y[8];
#pragma unroll
        for (int i = 0; i < 8; ++i) y[i] = o[i] * rstd * gg[i] * (act == 0 ? fg[i] * sigm_f(fg[i]) : sigm_f(fg[i]));
        u32x4 w; w.x = pk2(y[0], y[1]); w.y = pk2(y[2], y[3]); w.z = pk2(y[4], y[5]); w.w = pk2(y[6], y[7]);
        *(u32x4*)(Y + (size_t)tok * 1024 + 512 + c) = w;
    }
}

__device__ __forceinline__ void odd_prep(const Params& p) {
    const bf16_t* Z = (const bf16_t*)(p.ws + WS_Z); bf16_t* VV = (bf16_t*)(p.ws + WS_QKV);
    const float* gates = (const float*)(p.ws + WS_GATES); float* LI = (float*)(p.ws + WS_BETA); float* LF = (float*)(p.ws + WS_LA);
    const float* ln_g = p.in[13]; const float* ln_b = p.in[14]; const float* ib = p.in[17]; const float* fb = p.in[18];
    const int tid = threadIdx.x, lane = tid & 63, wid = tid >> 6, c = lane * 8;
    const f32x4 g0 = *(const f32x4*)(ln_g + c), g1 = *(const f32x4*)(ln_g + c + 4), b0 = *(const f32x4*)(ln_b + c), b1 = *(const f32x4*)(ln_b + c + 4);
    const float gg[8] = {g0.x, g0.y, g0.z, g0.w, g1.x, g1.y, g1.z, g1.w}, bb[8] = {b0.x, b0.y, b0.z, b0.w, b1.x, b1.y, b1.z, b1.w};
    for (int tok = blockIdx.x * 8 + wid; tok < T_; tok += gridDim.x * 8) {
        const u32x4 v = *(const u32x4*)(Z + (size_t)tok * 2560 + 512 + c);
        float x[8]; unpack8(v, x); float sm = 0.f;
#pragma unroll
        for (int i = 0; i < 8; ++i) { x[i] = gelu_t(x[i]); sm += x[i]; }
        const float mean = wave_sum(sm) * (1.0f / 512.0f); float sq = 0.f;
#pragma unroll
        for (int i = 0; i < 8; ++i) { x[i] -= mean; sq = fmaf(x[i], x[i], sq); }
        const float rstd = rsqrtf(wave_sum(sq) * (1.0f / 512.0f) + 1e-5f);
        float y[8];
#pragma unroll
        for (int i = 0; i < 8; ++i) y[i] = x[i] * rstd * gg[i] + bb[i];
        u32x4 w; w.x = pk2(y[0], y[1]); w.y = pk2(y[2], y[3]); w.z = pk2(y[4], y[5]); w.w = pk2(y[6], y[7]);
        *(u32x4*)(VV + (size_t)tok * 512 + c) = w;
        if (lane < 8) { LI[(size_t)tok * 8 + lane] = gates[(size_t)tok * 16 + lane] + ib[lane];
                        LF[(size_t)tok * 8 + lane] = -softplus_(-(gates[(size_t)tok * 16 + 8 + lane] + fb[lane])); }
    }
}

__device__ __forceinline__ void sg_phase(LDSp lds, const Params& p, int sgId, int sgG) {
    typedef short bf16x8 __attribute__((ext_vector_type(8)));
    const bf16_t* Z = (const bf16_t*)(p.ws + WS_Z); const bf16_t* VV = (const bf16_t*)(p.ws + WS_QKV); bf16_t* Y = (bf16_t*)(p.ws + WS_HN);
    const float* sgw = p.in[15]; const float* sgb = p.in[16];
    LAS unsigned short* Wb = (LAS unsigned short*)lds;
    LAS unsigned short* Vt = (LAS unsigned short*)(lds + 34816);
    const int tid = threadIdx.x, lane = tid & 63, wid = tid >> 6;
    for (int unit = sgId; unit < 512; unit += sgG) {
        const int g = unit & 3, n = (unit >> 2) & 31, b = unit >> 7; const size_t tok0 = (size_t)b * S_ + n * 128;
#pragma unroll
        for (int i = 0; i < 8; ++i) { const int i4 = tid + NTHR * i, t = i4 >> 5, s4 = (i4 & 31) << 2; const f32x4 w = *(const f32x4*)(sgw + (size_t)g * 16384 + t * 128 + s4);
            u32x2 o; o.x = pk2(w.x, w.y); o.y = pk2(w.z, w.w); *(LAS u32x2*)(Wb + t * 136 + s4) = o; }
#pragma unroll
        for (int i = 0; i < 4; ++i) { const int pi = tid + NTHR * i, s = pi >> 4, c8 = (pi & 15) << 3; const u32x4 v = *(const u32x4*)(VV + (tok0 + s) * 512 + g * 128 + c8);
            Vt[(c8 + 0) * 136 + s] = (unsigned short)(v.x & 0xffffu); Vt[(c8 + 1) * 136 + s] = (unsigned short)(v.x >> 16);
            Vt[(c8 + 2) * 136 + s] = (unsigned short)(v.y & 0xffffu); Vt[(c8 + 3) * 136 + s] = (unsigned short)(v.y >> 16);
            Vt[(c8 + 4) * 136 + s] = (unsigned short)(v.z & 0xffffu); Vt[(c8 + 5) * 136 + s] = (unsigned short)(v.z >> 16);
            Vt[(c8 + 6) * 136 + s] = (unsigned short)(v.w & 0xffffu); Vt[(c8 + 7) * 136 + s] = (unsigned short)(v.w >> 16); }
        __syncthreads();
        bf16x8 af[4];
#pragma unroll
        for (int ks = 0; ks < 4; ++ks) af[ks] = *(const LAS bf16x8*)(Wb + (16 * wid + (lane & 15)) * 136 + ks * 32 + (lane >> 4) * 8);
        f32x4 accs[8];
#pragma unroll
        for (int nn = 0; nn < 8; ++nn) {
            f32x4 acc = {0.f, 0.f, 0.f, 0.f};
#pragma unroll
            for (int ks = 0; ks < 4; ++ks) { const bf16x8 bfrag = *(const LAS bf16x8*)(Vt + (16 * nn + (lane & 15)) * 136 + ks * 32 + (lane >> 4) * 8);
                acc = __builtin_amdgcn_mfma_f32_16x16x32_bf16(af[ks], bfrag, acc, 0, 0, 0); }
            accs[nn] = acc; }
        __syncthreads();
#pragma unroll
        for (int nn = 0; nn < 8; ++nn)
#pragma unroll
            for (int i = 0; i < 4; ++i) { const int t = 16 * wid + (lane >> 4) * 4 + i; Wb[t * 136 + 16 * nn + (lane & 15)] = f2bf(accs[nn][i] + sgb[g * 128 + t]); }
        __syncthreads();
#pragma unroll
        for (int i = 0; i < 4; ++i) { const int pi = tid + NTHR * i, t = pi >> 4, c8 = (pi & 15) << 3; const size_t tok = tok0 + t;
            const u32x4 mv = *(const LAS u32x4*)(Wb + t * 136 + c8); const u32x4 uv = *(const u32x4*)(Z + tok * 2560 + g * 128 + c8);
            float m[8], u[8]; unpack8(mv, m); unpack8(uv, u);
            u32x4 w; w.x = pk2(gelu_t(u[0]) * m[0], gelu_t(u[1]) * m[1]); w.y = pk2(gelu_t(u[2]) * m[2], gelu_t(u[3]) * m[3]); w.z = pk2(gelu_t(u[4]) * m[4], gelu_t(u[5]) * m[5]); w.w = pk2(gelu_t(u[6]) * m[6], gelu_t(u[7]) * m[7]);
            *(u32x4*)(Y + tok * 1024 + g * 128 + c8) = w; }
        __syncthreads();
    }
}

#define XB_TMO      128
#define XB_XCNT(j)  (256  + 64 * (j))
#define XB_XSUB(j)  (1280 + 64 * (j))
#define XB_XGEN(j)  (2304 + 64 * (j))
#define XB_TOP      3328
#define XB_TOPGEN   3392
#define XCD_BAR_WORDS 3456
#define XB_SPIN_CAP (1u << 18)

__device__ __forceinline__ unsigned xb_ld(unsigned* p)              { return __hip_atomic_load(p, __ATOMIC_RELAXED, __HIP_MEMORY_SCOPE_AGENT); }
__device__ __forceinline__ unsigned xb_add(unsigned* p, unsigned v) { return __hip_atomic_fetch_add(p, v, __ATOMIC_RELAXED, __HIP_MEMORY_SCOPE_AGENT); }
__device__ __forceinline__ unsigned xb_xcc_id() { return (unsigned)__builtin_amdgcn_s_getreg((3 << 11) | 20) & 0xFu; }
#define XB_SPIN(cond, bar) do { unsigned _sp = 0; while (cond) { __builtin_amdgcn_s_sleep(1); \
    if ((++_sp & 255u) == 0u) { if (xb_ld(&(bar)[XB_TMO])) break; if (_sp > XB_SPIN_CAP) { atomicAdd(&(bar)[XB_TMO], 1u); break; } } } } while (0)

struct XcdBarrier {
    unsigned* bar; unsigned x;
    volatile LAS unsigned* st;
};

__device__ __forceinline__ XcdBarrier xcd_barrier_post(unsigned* bar, volatile LAS unsigned* st) {
    XcdBarrier b; b.bar = bar; b.x = xb_xcc_id(); b.st = st;
    if (threadIdx.x == 0) (void)xb_add(&bar[XB_XCNT(b.x)], 1u);
    return b;
}
__device__ __forceinline__ void xcd_barrier_complete(unsigned* bar, unsigned x, unsigned& nloc, unsigned& nx) {
    const unsigned G = gridDim.x * gridDim.y * gridDim.z;
    unsigned sum, cnt, mine, sp = 0u;
    for (;;) {
        sum = 0u; cnt = 0u; mine = 0u;
#pragma unroll
        for (unsigned j = 0; j < 16; ++j) { const unsigned c = xb_ld(&bar[XB_XCNT(j)]); sum += c; cnt += (c > 0u) ? 1u : 0u; mine = (j == x) ? c : mine; }
        if (sum == G) break;
        __builtin_amdgcn_s_sleep(1);
        if ((++sp & 255u) == 0u) { if (xb_ld(&bar[XB_TMO])) break; if (sp > XB_SPIN_CAP) { atomicAdd(&bar[XB_TMO], 1u); break; } }
    }
    nloc = mine > 0u ? mine : 1u; nx = cnt > 0u ? cnt : 1u;
}

__device__ __forceinline__ void xcd_barrier(const XcdBarrier& b) {
    asm volatile("s_waitcnt vmcnt(0)" ::: "memory");
    __syncthreads();
    if (threadIdx.x == 0) {
        unsigned* bar = b.bar;
        __builtin_amdgcn_s_waitcnt(0);
        unsigned nloc = b.st[0], nx = b.st[1];
        if (nloc == 0u) { xcd_barrier_complete(bar, b.x, nloc, nx); b.st[0] = nloc; b.st[1] = nx; }
        const unsigned old = xb_add(&bar[XB_XSUB(b.x)], 1u);
        const unsigned gen = old / nloc;
        if (old + 1u == (gen + 1u) * nloc) {
            __builtin_amdgcn_fence(__ATOMIC_RELEASE, "agent");
            asm volatile("s_waitcnt vmcnt(0)" ::: "memory");
            const unsigned og = xb_add(&bar[XB_TOP], 1u);
            const unsigned tg = og / nx;
            if (og + 1u == (tg + 1u) * nx) xb_add(&bar[XB_TOPGEN], 1u);
            else XB_SPIN(xb_ld(&bar[XB_TOPGEN]) == tg, bar);
            __builtin_amdgcn_fence(__ATOMIC_ACQUIRE, "agent");
            xb_add(&bar[XB_XGEN(b.x)], 1u);
            asm volatile("s_waitcnt vmcnt(0)" ::: "memory");
        } else {
            XB_SPIN(xb_ld(&bar[XB_XGEN(b.x)]) == gen, bar);
            __builtin_amdgcn_fence(__ATOMIC_ACQUIRE, "agent");
            asm volatile("s_waitcnt vmcnt(0)" ::: "memory");
        }
    }
    __syncthreads();
}
constexpr size_t WS_BAR = 238 * MiB;
#ifndef N_PHASES
#define N_PHASES 21
#endif
template <int L, int SUB> __device__ __forceinline__ void run_phase(LDSp lds, const Params& p) {
    unsigned char* ws = p.ws;
    bf16_t* HN = (bf16_t*)(ws + WS_HN); bf16_t* Zb = (bf16_t*)(ws + WS_Z); float* h = p.out; float* gates = (float*)(ws + WS_GATES);
    const bf16_t* W_IN = (const bf16_t*)(ws + WS_WB + WB_IN); const bf16_t* W_OUT = (const bf16_t*)(ws + WS_WB + WB_OUT);
    const bf16_t* W_UP = (const bf16_t*)(ws + WS_WB + WB_UP); const bf16_t* W_DN = (const bf16_t*)(ws + WS_WB + WB_DN);
    const int G = gridDim.x;
    if constexpr (L == 2) { rms_phase(lds, h, p.in[25], nullptr, nullptr, h, nullptr, 0, 0, nullptr); }
    else if constexpr (SUB == 0) {
        convert_layer(lds, p, L);
        if constexpr (L == 0) rms_phase(lds, p.in[0], p.in[1], HN, nullptr, nullptr, p.in[2], 3088, 3072, gates);
        else                  rms_phase(lds, h, p.in[1] + 1024, HN, nullptr, nullptr, p.in[12], 2576, 2560, gates);
    } else if constexpr (SUB == 1) { constexpr int N = L == 0 ? 3072 : 2560;
        pg8::Gemm g{HN, W_IN, T_, N, 1024}; pg8::StaticOrder S; S.init(T_, N, G, (int)blockIdx.x);
        if constexpr (L == 0) { pg8::EpiInEven E{Zb, N}; pg8::gemm_phase_sp2<pg8::EpiInEven, pg8::StaticOrder, true, true>(lds, g, S, E); }
        else { pg8::EpiBf16<0> E{Zb, N, nullptr, 0, 0};
        pg8::gemm_phase_sp2<pg8::EpiBf16<0>, pg8::StaticOrder, true, true>(lds, g, S, E); }
    } else if constexpr (SUB == 2) { if constexpr (L == 0) even_prep(lds, p); else odd_prep(p); }
    else if constexpr (SUB == 9) { delta_prep(lds, p); }
    else if constexpr (SUB == 10) { mlstm_b(p); }
    else if constexpr (SUB == 11) { mlstm_c(lds, p); }
    else if constexpr (SUB == 3) {
        if constexpr (L == 0) delta_scan2(lds, p);
        else { mlstm_a(lds, p); sg_phase(lds, p, (int)blockIdx.x, G); }
    } else if constexpr (SUB == 4) { if constexpr (L == 0) headnorm_phase(p, p.in[10], 3072, 2560, 0); else headnorm_phase(p, p.in[19], 2560, 2048, 1); }
    else if constexpr (SUB == 5) { pg8::Gemm g{HN, W_OUT, T_, 1024, 1024}; pg8::StaticOrder S; S.init(T_, 1024, G, (int)blockIdx.x);
        pg8::EpiAddF32 E{h, 1024, L == 0 ? p.in[0] : (const float*)h};
        pg8::gemm_phase_sp2<pg8::EpiAddF32, pg8::StaticOrder, false, true>(lds, g, S, E);
    } else if constexpr (SUB == 6) { rms_phase(lds, h, p.in[21] + L * 1024, HN, nullptr, nullptr, nullptr, 0, 0, nullptr); }
    else if constexpr (SUB == 7) { pg8::Gemm g{HN, W_UP, T_, 2 * DFF, 1024}; pg8::StaticOrder S; S.init(T_, 2 * DFF, G, (int)blockIdx.x);
        pg8::EpiSwiGLU E{Zb, DFF};
        pg8::gemm_phase_sp2<pg8::EpiSwiGLU, pg8::StaticOrder, true, true>(lds, g, S, E);
    } else if constexpr (SUB == 8) { pg8::Gemm g{Zb, W_DN, T_, 1024, DFF}; pg8::StaticOrder S; S.init(T_, 1024, G, (int)blockIdx.x);
        pg8::EpiAddF32 E{h, 1024, (const float*)h};
        pg8::gemm_phase_sp2<pg8::EpiAddF32, pg8::StaticOrder, false, true>(lds, g, S, E);
    }
}
__global__ void __launch_bounds__(NTHR, 2) mega(Params p, int ph_lo, int ph_hi) {
    extern __shared__ __attribute__((aligned(16))) unsigned char lds_raw[];
    LDSp lds = (LDSp)lds_raw;
    cg::grid_group grid = cg::this_grid();
    volatile LAS unsigned* xst = (volatile LAS unsigned*)(lds + LDS_BYTES - 16);
    if (threadIdx.x == 0) { xst[0] = 0u; xst[1] = 0u; }
    __syncthreads();
    XcdBarrier xbar; xbar.bar = (unsigned*)(p.ws + WS_BAR); xbar.x = 0; xbar.st = xst;
    if (ph_hi - ph_lo > 1) xbar = xcd_barrier_post((unsigned*)(p.ws + WS_BAR), xst);
#ifndef REP_MASK
#define REP_MASK 0
#endif
#define PH(k, L, SUB) if (ph_lo <= (k) && (k) < ph_hi) { run_phase<L, SUB>(lds, p); if ((REP_MASK >> (k)) & 1) { __syncthreads(); run_phase<L, SUB>(lds, p); } if ((k) + 1 < ph_hi) { if (ph_lo < 0) grid.sync(); else xcd_barrier(xbar); } }
    PH(0, 0, 0) PH(1, 0, 1) PH(2, 0, 2) PH(3, 0, 9) PH(4, 0, 3) PH(5, 0, 4) PH(6, 0, 5) PH(7, 0, 6) PH(8, 0, 7) PH(9, 0, 8)
    PH(10, 1, 0) PH(11, 1, 1) PH(12, 1, 2) PH(13, 1, 3) PH(14, 1, 10) PH(15, 1, 11)
    PH(16, 1, 5) PH(17, 1, 6) PH(18, 1, 7) PH(19, 1, 8)
    PH(20, 2, 0)
#ifdef EXTRA_SYNCS
    for (int i_ = 0; i_ < EXTRA_SYNCS; ++i_) grid.sync();
#endif
#undef PH
}

extern "C" void kernel_launch(void* const* d_in, const int* in_sizes, int n_in, void* d_out, int out_size, void* d_ws, size_t ws_size, hipStream_t stream) {
    static int grid = 0;
    if (grid == 0) {
        int dev = 0, cus = 0, per_cu = 0;
        (void)hipGetDevice(&dev);
        (void)hipDeviceGetAttribute(&cus, hipDeviceAttributeMultiprocessorCount, dev);
        (void)hipFuncSetAttribute((const void*)mega, hipFuncAttributeMaxDynamicSharedMemorySize, LDS_BYTES);
        if (hipOccupancyMaxActiveBlocksPerMultiprocessor(&per_cu, (const void*)mega, NTHR, LDS_BYTES) != hipSuccess || per_cu < 1) per_cu = 1;
        (void)hipGetLastError();
        if (cus <= 0) cus = 256;
        grid = cus * per_cu;
    }
    if (ws_size < 239 * MiB) { fprintf(stderr, "workspace too small: %zu\n", ws_size); return; }
    Params p{};
    for (int i = 0; i < 26; ++i) p.in[i] = (const float*)d_in[i];
    p.out = (float*)d_out; p.ws = (unsigned char*)d_ws;
#if defined(MULTI_LAUNCH)
    for (int ph = 0; ph < N_PHASES; ++ph) hipLaunchKernelGGL(mega, dim3(grid), dim3(NTHR), LDS_BYTES, stream, p, ph, ph + 1);
#else
    (void)hipMemsetAsync((char*)d_ws + WS_BAR, 0, XCD_BAR_WORDS * 4, stream);
    int lo = 0, hi = N_PHASES;
    void* args[] = {(void*)&p, (void*)&lo, (void*)&hi};
    hipError_t e = hipLaunchCooperativeKernel((const void*)mega, dim3(grid), dim3(NTHR), args, LDS_BYTES, stream);
    if (e != hipSuccess) fprintf(stderr, "cooperative launch failed: %s (grid %d)\n", hipGetErrorString(e), grid);
#endif
}
```

```cpp
#include <hip/hip_runtime.h>
#include <hip/hip_cooperative_groups.h>
#include <cstdio>
namespace cg = cooperative_groups;
namespace pg8 {
#define PG8_LAS __attribute__((address_space(3)))
typedef unsigned short bf16_t;
typedef short bf16x8 __attribute__((ext_vector_type(8)));
typedef float f32x4 __attribute__((ext_vector_type(4)));
typedef unsigned u32x4 __attribute__((ext_vector_type(4)));
constexpr int BM = 256, BK = 64, HALF = 128, HTB = HALF * BK * 2  , STAGE_BYTES = 8 * HTB, NXCD = 8, WGM = 8;

__host__ __device__ __forceinline__ int lds_byte(int r, int c) { const int st = (r >> 4) * 2 + (c >> 5), rr = r & 15, cc = c & 31, ob = rr * 64 + cc * 2; return st * 1024 + (ob ^ (((ob >> 9) & 1) << 5)); }
__host__ __device__ __forceinline__ void stage_rc(int b, int& R, int& C) { const int st = b / 1024, sb = b % 1024, swz = sb ^ (((sb >> 9) & 1) << 5); R = (st >> 1) * 16 + swz / 64; C = (st & 1) * 32 + (swz % 64) / 2; }
__host__ __device__ __forceinline__ int perm32(int rho) { const int n = rho >> 4, i = rho & 15; return 8 * (i >> 2) + 4 * n + (i & 3); }

struct Unit { int pm, pn; };
struct Gemm { const bf16_t* A; const bf16_t* Bt; int M, N, K; };

struct StaticOrder {
    int nM, nN, nwg, G, c;
    __host__ __device__ void init(int M, int N, int G_, int c_) { nM = M / BM; nN = N / BM; nwg = nM * nN; G = G_; c = c_; }
    __host__ __device__ bool next(int i, Unit& u) const {
        const long L = (long)i * G + c; if (L >= nwg) return false;
        int wgid = (int)L; { const int q = nwg / NXCD, r = nwg % NXCD, xcd = wgid % NXCD, off = wgid / NXCD; wgid = (xcd < r ? xcd * (q + 1) : r * (q + 1) + (xcd - r) * q) + off; }
        const int nig = WGM * nN, gid = wgid / nig, fm = gid * WGM, gsz = (nM - fm) < WGM ? (nM - fm) : WGM;
        u.pm = fm + ((wgid % nig) % gsz); u.pn = (wgid % nig) / gsz; return true;
    }
    __device__ __forceinline__ void a_ready(const Unit&) const {}
    __device__ __forceinline__ void done(const Unit&) const {}
};
__device__ __forceinline__ unsigned cvt_pk_bf16(float lo, float hi) { unsigned r; asm volatile("v_cvt_pk_bf16_f32 %0, %1, %2" : "=v"(r) : "v"(lo), "v"(hi)); return r; }
typedef float f32x2 __attribute__((ext_vector_type(2)));
__device__ __forceinline__ f32x2 gelu_pk(f32x2 v) {
    const f32x2 av = __builtin_elementwise_abs(v), d = av * 0.2316418882f + 1.0f;
    f32x2 t; t.x = __builtin_amdgcn_rcpf(d.x); t.y = __builtin_amdgcn_rcpf(d.y);
    f32x2 q = t * 0.5307027145f + (-0.7265760135f); q = q * t + 0.7107068705f; q = q * t + (-0.142248368f); q = q * t + 0.127414796f; q = q * t;
    const f32x2 s = (v * v) * (-0.72134752044f);
    f32x2 e; e.x = __builtin_amdgcn_exp2f(s.x); e.y = __builtin_amdgcn_exp2f(s.y);
    const f32x2 m = v * (q * e), r = v - m;
    f32x2 o; o.x = v.x < 0.f ? m.x : r.x; o.y = v.y < 0.f ? m.y : r.y; return o;
}
template <int ACT  > struct EpiBf16 {
    static constexpr bool PERM = true, AFTER_DRAIN = false;
    bf16_t* O; int ldc; const float* bias; int split_cols; size_t split_stride;
    __device__ __forceinline__ void operator()(const f32x4 (&acc)[2][2][4][2], const Unit& u, int wr, int wc, int fr, int fq) const {
        const int row0 = u.pm * BM + wr * 64 + fr; int colt = u.pn * BM; bf16_t* base = O;
        if (split_cols) { const int t = colt / split_cols; base += (size_t)t * split_stride; colt -= t * split_cols; }
        const int col0 = colt + wc * 32 + 8 * fq, bcol0 = u.pn * BM + wc * 32 + 8 * fq;
        f32x4 bv[2][2];
#pragma unroll
        for (int bj = 0; bj < 2; ++bj)
#pragma unroll
            for (int n = 0; n < 2; ++n) bv[bj][n] = bias ? *(const f32x4*)(bias + bcol0 + bj * HALF + 4 * n) : (f32x4){0.f, 0.f, 0.f, 0.f};
#pragma unroll
        for (int ai = 0; ai < 2; ++ai)
#pragma unroll
            for (int m = 0; m < 4; ++m) { bf16_t* rowp = base + (size_t)(row0 + ai * HALF + m * 16) * ldc + col0;
#pragma unroll
                for (int bj = 0; bj < 2; ++bj) { f32x4 v0 = acc[ai][bj][m][0] + bv[bj][0], v1 = acc[ai][bj][m][1] + bv[bj][1];
                    if (ACT == 1) { f32x2 a = gelu_pk((f32x2){v0[0], v0[1]}), b = gelu_pk((f32x2){v0[2], v0[3]}), c = gelu_pk((f32x2){v1[0], v1[1]}), d = gelu_pk((f32x2){v1[2], v1[3]});
                        v0 = (f32x4){a.x, a.y, b.x, b.y}; v1 = (f32x4){c.x, c.y, d.x, d.y}; }
                    if (ACT == 2) {
#pragma unroll
                        for (int j = 0; j < 4; ++j) { v0[j] = 0.5f * v0[j] * (1.0f + erff(v0[j] * 0.70710678f)); v1[j] = 0.5f * v1[j] * (1.0f + erff(v1[j] * 0.70710678f)); } }
                    u32x4 w; w.x = cvt_pk_bf16(v0[0], v0[1]); w.y = cvt_pk_bf16(v0[2], v0[3]); w.z = cvt_pk_bf16(v1[0], v1[1]); w.w = cvt_pk_bf16(v1[2], v1[3]);
                    *(u32x4*)(rowp + bj * HALF) = w; } }
    }
};
struct EpiAddF32 {
    static constexpr bool PERM = false, AFTER_DRAIN = false;
    float* C; int ldc; const float* R;
    __device__ __forceinline__ void operator()(const f32x4 (&acc)[2][2][4][2], const Unit& u, int wr, int wc, int fr, int fq) const {
        const int row0 = u.pm * BM + wr * 64 + fr, col0 = u.pn * BM + wc * 32 + 4 * fq;
#pragma unroll
        for (int ai = 0; ai < 2; ++ai)
#pragma unroll
            for (int m = 0; m < 4; ++m) { const size_t ro = (size_t)(row0 + ai * HALF + m * 16) * ldc + col0; float* rowp = C + ro; const float* srcp = R + ro;
#pragma unroll
                for (int bj = 0; bj < 2; ++bj)
#pragma unroll
                    for (int n = 0; n < 2; ++n) { const f32x4 o = *(const f32x4*)(srcp + bj * HALF + n * 16); *(f32x4*)(rowp + bj * HALF + n * 16) = o + acc[ai][bj][m][n]; } }
    }
};
struct EpiSwiGLU {
    static constexpr bool PERM = true, AFTER_DRAIN = false;
    bf16_t* H; int ldh;
    __device__ __forceinline__ void operator()(const f32x4 (&acc)[2][2][4][2], const Unit& u, int wr, int wc, int fr, int fq) const {
        const int row0 = u.pm * BM + wr * 64 + fr, hcol = u.pn * HALF + wc * 32 + 8 * fq;
#pragma unroll
        for (int ai = 0; ai < 2; ++ai)
#pragma unroll
            for (int m = 0; m < 4; ++m) { bf16_t* rowp = H + (size_t)(row0 + ai * HALF + m * 16) * ldh + hcol;
                float h[8];
#pragma unroll
                for (int n = 0; n < 2; ++n) { const f32x4 a = acc[ai][0][m][n], b = acc[ai][1][m][n];
#pragma unroll
                    for (int j = 0; j < 4; ++j) h[4 * n + j] = a[j] * __builtin_amdgcn_rcpf(1.0f + __expf(-a[j])) * b[j]; }
                u32x4 w; w.x = cvt_pk_bf16(h[0], h[1]); w.y = cvt_pk_bf16(h[2], h[3]); w.z = cvt_pk_bf16(h[4], h[5]); w.w = cvt_pk_bf16(h[6], h[7]);
                *(u32x4*)rowp = w; }
    }
};

struct EpiInEven {
    static constexpr bool PERM = true, AFTER_DRAIN = false;
    bf16_t* O; int ldc;
    __device__ __forceinline__ void operator()(const f32x4 (&acc)[2][2][4][2], const Unit& u, int wr, int wc, int fr, int fq) const {
        const int row0 = u.pm * BM + wr * 64 + fr;
        if (u.pn < 4) {
            const int hcol = u.pn * HALF + wc * 32 + 8 * fq;
#pragma unroll
            for (int ai = 0; ai < 2; ++ai)
#pragma unroll
                for (int m = 0; m < 4; ++m) { bf16_t* rowp = O + (size_t)(row0 + ai * HALF + m * 16) * ldc + hcol; float h[8];
#pragma unroll
                    for (int n = 0; n < 2; ++n) { const f32x4 a = acc[ai][0][m][n], g = acc[ai][1][m][n];
#pragma unroll
                        for (int j = 0; j < 4; ++j) h[4 * n + j] = a[j] * __builtin_amdgcn_rcpf(1.0f + __expf(-g[j])); }
                    u32x4 w; w.x = cvt_pk_bf16(h[0], h[1]); w.y = cvt_pk_bf16(h[2], h[3]); w.z = cvt_pk_bf16(h[4], h[5]); w.w = cvt_pk_bf16(h[6], h[7]);
                    *(u32x4*)rowp = w; }
        } else {
            const int col0 = u.pn * BM + wc * 32 + 8 * fq;
#pragma unroll
            for (int ai = 0; ai < 2; ++ai)
#pragma unroll
                for (int m = 0; m < 4; ++m) { bf16_t* rowp = O + (size_t)(row0 + ai * HALF + m * 16) * ldc + col0;
#pragma unroll
                    for (int bj = 0; bj < 2; ++bj) { const f32x4 v0 = acc[ai][bj][m][0], v1 = acc[ai][bj][m][1];
                        u32x4 w; w.x = cvt_pk_bf16(v0[0], v0[1]); w.y = cvt_pk_bf16(v0[2], v0[3]); w.z = cvt_pk_bf16(v1[0], v1[1]); w.w = cvt_pk_bf16(v1[2], v1[3]);
                        *(u32x4*)(rowp + bj * HALF) = w; } }
        }
    }
};
template <class Epi, class Sched, bool STAMP = false>
__device__ __forceinline__ void gemm_phase(PG8_LAS unsigned char* lds, const Gemm g, const Sched& S, const Epi& E, unsigned long long* stamps) {
    const int tid = threadIdx.x, wid = __builtin_amdgcn_readfirstlane(tid >> 6), lane = tid & 63, wr = wid >> 2, wc = wid & 3, fr = lane & 15, fq = lane >> 4;
    const int K = g.K, nt = K / BK;
    int ts_lo = 0, ts_hi = 0, nts = 0; const unsigned long long rt_entry = STAMP ? (unsigned long long)wall_clock64() : 0ull;
#define PG8_STAMP() do { if (STAMP && wid == 0 && nts < 64) { const unsigned long long _c = (unsigned long long)clock64(); \
        ts_lo = (lane == nts) ? (int)(unsigned)_c : ts_lo; ts_hi = (lane == nts) ? (int)(unsigned)(_c >> 32) : ts_hi; ++nts; } } while (0)
    PG8_STAMP();
    unsigned voffA[2], voffB[2];
#pragma unroll
    for (int i = 0; i < 2; ++i) { int R, C; stage_rc(tid * 16 + i * 8192, R, C); const int Rb = Epi::PERM ? ((R & ~31) + perm32(R & 31)) : R;
        voffA[i] = (unsigned)(R * K + C) * 2u; voffB[i] = (unsigned)(Rb * K + C) * 2u; }
    const size_t kstep = (size_t)(BK * 2);
    const size_t hstep = (size_t)HALF * K * 2;
    const size_t tstep = 2 * hstep;
    const unsigned ldsw = (unsigned)wid * 1024u;
    const int aoff = lds_byte(wr * 64 + fr, fq * 8), boff = lds_byte(wc * 32 + fr, fq * 8);
#define PG8_SA(b, h) (((b) * 2 + (h)) * HTB)
#define PG8_SB(b, h) ((4 + (b) * 2 + (h)) * HTB)
#define PG8_STAGE(bufoff, gbase, voff) do { _Pragma("unroll") for (int _i = 0; _i < 2; ++_i) \
        __builtin_amdgcn_global_load_lds((const unsigned*)((const char*)(gbase) + (voff)[_i]), (PG8_LAS unsigned*)(lds + (bufoff) + ldsw + _i * 8192), 16, 0, 0); } while (0)
#define PG8_LDA(dst, b, h) do { _Pragma("unroll") for (int m = 0; m < 4; ++m) _Pragma("unroll") for (int k = 0; k < 2; ++k) dst[m][k] = *(const PG8_LAS bf16x8*)(lds + PG8_SA(b, h) + aoff + m * 2048 + k * 1024); } while (0)
#define PG8_LDB(dst, b, h) do { _Pragma("unroll") for (int n = 0; n < 2; ++n) _Pragma("unroll") for (int k = 0; k < 2; ++k) dst[n][k] = *(const PG8_LAS bf16x8*)(lds + PG8_SB(b, h) + boff + n * 2048 + k * 1024); } while (0)
#define PG8_MMA(ai, bj, At, Bt) do { __builtin_amdgcn_s_setprio(1); _Pragma("unroll") for (int m = 0; m < 4; ++m) _Pragma("unroll") for (int n = 0; n < 2; ++n) _Pragma("unroll") for (int k = 0; k < 2; ++k) \
        acc[ai][bj][m][n] = __builtin_amdgcn_mfma_f32_16x16x32_bf16(Bt[n][k], At[m][k], acc[ai][bj][m][n], 0, 0, 0); __builtin_amdgcn_s_setprio(0); } while (0)
#define PG8_WAIT_V(n) asm volatile("s_waitcnt vmcnt(" #n ")" ::: "memory")
#define PG8_WAIT_L(n) asm volatile("s_waitcnt lgkmcnt(" #n ")" ::: "memory")
#define PG8_BAR __builtin_amdgcn_s_barrier()
#define PG8_SCHED __builtin_amdgcn_sched_barrier(0)
    Unit cur, nxt; int ui = 0;
    if (!S.next(0, cur)) return;
    f32x4 acc[2][2][4][2];
#pragma unroll
    for (int a = 0; a < 2; ++a)
#pragma unroll
        for (int b = 0; b < 2; ++b)
#pragma unroll
            for (int m = 0; m < 4; ++m)
#pragma unroll
                for (int n = 0; n < 2; ++n) acc[a][b][m][n] = (f32x4){0.f, 0.f, 0.f, 0.f};
    bf16x8 At[4][2], B0[2][2], B1[2][2];
    const char* cA = (const char*)g.A + (size_t)cur.pm * tstep; const char* cB = (const char*)g.Bt + (size_t)cur.pn * tstep;
    S.a_ready(cur);
    PG8_STAGE(PG8_SB(0, 0), cB, voffB); PG8_STAGE(PG8_SA(0, 0), cA, voffA); PG8_STAGE(PG8_SB(0, 1), cB + hstep, voffB); PG8_STAGE(PG8_SA(0, 1), cA + hstep, voffA);
    if (wr == 1) PG8_BAR;
    PG8_WAIT_V(4); PG8_BAR;
    PG8_STAGE(PG8_SB(1, 0), cB + kstep, voffB); PG8_STAGE(PG8_SA(1, 0), cA + kstep, voffA); PG8_STAGE(PG8_SB(1, 1), cB + hstep + kstep, voffB);
    PG8_WAIT_V(6); PG8_BAR;
    PG8_STAMP();
    for (;;) {
        const bool has_next = S.next(ui + 1, nxt);
        const char* nA = has_next ? (const char*)g.A + (size_t)nxt.pm * tstep : cA; const char* nB = has_next ? (const char*)g.Bt + (size_t)nxt.pn * tstep : cB;
        for (int t = 0; t < nt; t += 2) {
            const bool last = (t == nt - 2);
            const char* a1 = cA + (size_t)(t + 1) * kstep;
            const char* a2 = last ? nA : cA + (size_t)(t + 2) * kstep; const char* b2 = last ? nB : cB + (size_t)(t + 2) * kstep;
            const char* a3 = a2 + kstep; const char* b3 = b2 + kstep;
            if (last && has_next) S.a_ready(nxt);
            PG8_LDB(B0, 0, 0); PG8_SCHED; PG8_LDA(At, 0, 0); PG8_STAGE(PG8_SA(1, 1), a1 + hstep, voffA);
            PG8_WAIT_L(8); PG8_BAR; PG8_WAIT_L(0); PG8_MMA(0, 0, At, B0); PG8_BAR; PG8_SCHED;
            PG8_LDB(B1, 0, 1); PG8_STAGE(PG8_SB(0, 0), b2, voffB);
            PG8_BAR; PG8_WAIT_L(0); PG8_MMA(0, 1, At, B1); PG8_BAR;
            PG8_LDA(At, 0, 1); PG8_STAGE(PG8_SA(0, 0), a2, voffA);
            PG8_BAR; PG8_WAIT_L(0); PG8_MMA(1, 0, At, B0); PG8_BAR; PG8_SCHED;
            PG8_STAGE(PG8_SB(0, 1), b2 + hstep, voffB);
            PG8_WAIT_V(6); PG8_BAR; PG8_MMA(1, 1, At, B1); PG8_BAR;
            PG8_LDB(B0, 1, 0); PG8_SCHED; PG8_LDA(At, 1, 0); PG8_STAGE(PG8_SA(0, 1), a2 + hstep, voffA);
            PG8_WAIT_L(8); PG8_BAR; PG8_WAIT_L(0); PG8_MMA(0, 0, At, B0); PG8_BAR; PG8_SCHED;
            PG8_LDB(B1, 1, 1); PG8_STAGE(PG8_SB(1, 0), b3, voffB);
            PG8_BAR; PG8_WAIT_L(0); PG8_MMA(0, 1, At, B1); PG8_BAR;
            PG8_LDA(At, 1, 1); PG8_STAGE(PG8_SA(1, 0), a3, voffA);
            PG8_BAR; PG8_WAIT_L(0); PG8_MMA(1, 0, At, B0); PG8_BAR; PG8_SCHED;
            PG8_STAGE(PG8_SB(1, 1), b3 + hstep, voffB);
            PG8_WAIT_V(6); PG8_BAR; PG8_MMA(1, 1, At, B1); PG8_BAR;
        }
        PG8_STAMP();
        if constexpr (!Epi::AFTER_DRAIN) { E(acc, cur, wr, wc, fr, fq); S.done(cur); }
        PG8_STAMP();
        if (!has_next) break;
#pragma unroll
        for (int a = 0; a < 2; ++a)
#pragma unroll
            for (int b = 0; b < 2; ++b)
#pragma unroll
                for (int m = 0; m < 4; ++m)
#pragma unroll
                    for (int n = 0; n < 2; ++n) acc[a][b][m][n] = (f32x4){0.f, 0.f, 0.f, 0.f};
        cur = nxt; cA = nA; cB = nB; ++ui;
    }
    PG8_WAIT_V(0);
    if (wr == 0) PG8_BAR;
    PG8_BAR;
    if constexpr (Epi::AFTER_DRAIN) { E.fused(acc, cur, wr, wc, fr, fq, lds, wid, lane); S.done(cur); }
    PG8_STAMP();
    if (STAMP && wid == 0) { stamps[lane] = lane < nts ? (((unsigned long long)(unsigned)ts_hi << 32) | (unsigned)ts_lo) : 0ull;
        if (lane == 62) stamps[62] = rt_entry; if (lane == 63) stamps[63] = (unsigned long long)wall_clock64(); }
#undef PG8_STAMP
#undef PG8_SA
#undef PG8_SB
#undef PG8_STAGE
#undef PG8_LDA
#undef PG8_LDB
#undef PG8_MMA
#undef PG8_WAIT_V
#undef PG8_WAIT_L
#undef PG8_BAR
#undef PG8_SCHED
}
template <class Epi, class Sched, bool ALIGN_EPI = false, bool SP2 = false>
__device__ __forceinline__ void gemm_phase_sp2(PG8_LAS unsigned char* lds, const Gemm g, const Sched& S, const Epi& E) {
    const int tid = threadIdx.x, wid = __builtin_amdgcn_readfirstlane(tid >> 6), lane = tid & 63, wr = wid >> 2, wc = wid & 3, fr = lane & 15, fq = lane >> 4;
    const int K = g.K, nt = K / BK;
    unsigned voffA[2], voffB[2];
#pragma unroll
    for (int i = 0; i < 2; ++i) { int R, C; stage_rc(tid * 16 + i * 8192, R, C); const int Rb = Epi::PERM ? ((R & ~31) + perm32(R & 31)) : R;
        voffA[i] = (unsigned)(R * K + C) * 2u; voffB[i] = (unsigned)(Rb * K + C) * 2u; }
    const size_t kstep = (size_t)(BK * 2);
    const size_t hstep = (size_t)HALF * K * 2;
    const size_t tstep = 2 * hstep;
    const unsigned ldsw = (unsigned)wid * 1024u;
    const int aoff = lds_byte(wr * 64 + fr, fq * 8), boff = lds_byte(wc * 32 + fr, fq * 8);
#define PG8_SA(b, h) (((b) * 2 + (h)) * HTB)
#define PG8_SB(b, h) ((4 + (b) * 2 + (h)) * HTB)
#define PG8_STAGE(bufoff, gbase, voff) do { _Pragma("unroll") for (int _i = 0; _i < 2; ++_i) \
        __builtin_amdgcn_global_load_lds((const unsigned*)((const char*)(gbase) + (voff)[_i]), (PG8_LAS unsigned*)(lds + (bufoff) + ldsw + _i * 8192), 16, 0, 0); } while (0)
#define PG8_LDA(dst, b, h) do { _Pragma("unroll") for (int m = 0; m < 4; ++m) _Pragma("unroll") for (int k = 0; k < 2; ++k) dst[m][k] = *(const PG8_LAS bf16x8*)(lds + PG8_SA(b, h) + aoff + m * 2048 + k * 1024); } while (0)
#define PG8_LDB(dst, b, h) do { _Pragma("unroll") for (int n = 0; n < 2; ++n) _Pragma("unroll") for (int k = 0; k < 2; ++k) dst[n][k] = *(const PG8_LAS bf16x8*)(lds + PG8_SB(b, h) + boff + n * 2048 + k * 1024); } while (0)
#define PG8_MMA(ai, bj, At, Bt) do { __builtin_amdgcn_s_setprio(1); _Pragma("unroll") for (int m = 0; m < 4; ++m) _Pragma("unroll") for (int n = 0; n < 2; ++n) _Pragma("unroll") for (int k = 0; k < 2; ++k) \
        acc[ai][bj][m][n] = __builtin_amdgcn_mfma_f32_16x16x32_bf16(Bt[n][k], At[m][k], acc[ai][bj][m][n], 0, 0, 0); __builtin_amdgcn_s_setprio(0); } while (0)
#define PG8_WAIT_V(n) asm volatile("s_waitcnt vmcnt(" #n ")" ::: "memory")
#define PG8_WAIT_L(n) asm volatile("s_waitcnt lgkmcnt(" #n ")" ::: "memory")
#define PG8_BAR __builtin_amdgcn_s_barrier()
#define PG8_SCHED __builtin_amdgcn_sched_barrier(0)
    Unit cur, nxt; int ui = 0;
    if (!S.next(0, cur)) return;
    f32x4 acc[2][2][4][2];
#pragma unroll
    for (int a = 0; a < 2; ++a)
#pragma unroll
        for (int b = 0; b < 2; ++b)
#pragma unroll
            for (int m = 0; m < 4; ++m)
#pragma unroll
                for (int n = 0; n < 2; ++n) acc[a][b][m][n] = (f32x4){0.f, 0.f, 0.f, 0.f};
    bf16x8 At[4][2], B0[2][2], B1[2][2];
    const char* cA = (const char*)g.A + (size_t)cur.pm * tstep; const char* cB = (const char*)g.Bt + (size_t)cur.pn * tstep;
    S.a_ready(cur);
    if constexpr (SP2) {
        PG8_STAGE(PG8_SB(0, 0), cB, voffB); PG8_STAGE(PG8_SB(0, 1), cB + hstep, voffB); PG8_STAGE(PG8_SA(0, 0), cA, voffA); PG8_STAGE(PG8_SA(0, 1), cA + hstep, voffA);
        if (wr == 1) PG8_BAR;
        PG8_WAIT_V(2); PG8_BAR;
        PG8_STAGE(PG8_SB(1, 0), cB + kstep, voffB); PG8_STAGE(PG8_SA(1, 0), cA + kstep, voffA); PG8_STAGE(PG8_SB(1, 1), cB + hstep + kstep, voffB);
        PG8_WAIT_V(6); PG8_BAR;
    } else {
        PG8_STAGE(PG8_SB(0, 0), cB, voffB); PG8_STAGE(PG8_SA(0, 0), cA, voffA); PG8_STAGE(PG8_SB(0, 1), cB + hstep, voffB); PG8_STAGE(PG8_SA(0, 1), cA + hstep, voffA);
        if (wr == 1) PG8_BAR;
        PG8_WAIT_V(4); PG8_BAR;
        PG8_STAGE(PG8_SB(1, 0), cB + kstep, voffB); PG8_STAGE(PG8_SA(1, 0), cA + kstep, voffA); PG8_STAGE(PG8_SB(1, 1), cB + hstep + kstep, voffB);
        PG8_WAIT_V(6); PG8_BAR;
    }
    for (;;) {
        const bool has_next = S.next(ui + 1, nxt);
        const char* nA = has_next ? (const char*)g.A + (size_t)nxt.pm * tstep : cA; const char* nB = has_next ? (const char*)g.Bt + (size_t)nxt.pn * tstep : cB;
        for (int t = 0; t < nt; t += 2) {
            const bool last = (t == nt - 2);
            const char* a1 = cA + (size_t)(t + 1) * kstep;
            const char* a2 = last ? nA : cA + (size_t)(t + 2) * kstep; const char* b2 = last ? nB : cB + (size_t)(t + 2) * kstep;
            const char* a3 = a2 + kstep; const char* b3 = b2 + kstep;
            if (last && has_next) S.a_ready(nxt);
            if constexpr (SP2) {
            PG8_LDB(B0, 0, 0); PG8_LDB(B1, 0, 1); PG8_SCHED; PG8_LDA(At, 0, 0); PG8_STAGE(PG8_SA(1, 1), a1 + hstep, voffA);
            PG8_WAIT_V(8); PG8_WAIT_L(0); PG8_BAR; PG8_MMA(0, 0, At, B0); PG8_MMA(0, 1, At, B1); PG8_BAR; PG8_SCHED;
            PG8_LDA(At, 0, 1); PG8_STAGE(PG8_SB(0, 0), b2, voffB); PG8_STAGE(PG8_SB(0, 1), b2 + hstep, voffB); PG8_STAGE(PG8_SA(0, 0), a2, voffA);
            PG8_WAIT_V(8); PG8_WAIT_L(0); PG8_BAR; PG8_MMA(1, 0, At, B0); PG8_MMA(1, 1, At, B1); PG8_BAR; PG8_SCHED;
            PG8_LDB(B0, 1, 0); PG8_LDB(B1, 1, 1); PG8_SCHED; PG8_LDA(At, 1, 0); PG8_STAGE(PG8_SA(0, 1), a2 + hstep, voffA);
            PG8_WAIT_V(8); PG8_WAIT_L(0); PG8_BAR; PG8_MMA(0, 0, At, B0); PG8_MMA(0, 1, At, B1); PG8_BAR; PG8_SCHED;
            PG8_LDA(At, 1, 1); PG8_STAGE(PG8_SB(1, 0), b3, voffB); PG8_STAGE(PG8_SB(1, 1), b3 + hstep, voffB); PG8_STAGE(PG8_SA(1, 0), a3, voffA);
            PG8_WAIT_V(8); PG8_WAIT_L(0); PG8_BAR; PG8_MMA(1, 0, At, B0); PG8_MMA(1, 1, At, B1); PG8_BAR; PG8_SCHED;
            } else {
            PG8_LDB(B0, 0, 0); PG8_SCHED; PG8_LDA(At, 0, 0); PG8_STAGE(PG8_SA(1, 1), a1 + hstep, voffA);
            PG8_WAIT_L(8); PG8_BAR; PG8_WAIT_L(0); PG8_MMA(0, 0, At, B0); PG8_BAR; PG8_SCHED;
            PG8_LDB(B1, 0, 1); PG8_STAGE(PG8_SB(0, 0), b2, voffB);
            PG8_BAR; PG8_WAIT_L(0); PG8_MMA(0, 1, At, B1); PG8_BAR;
            PG8_LDA(At, 0, 1); PG8_STAGE(PG8_SA(0, 0), a2, voffA);
            PG8_BAR; PG8_WAIT_L(0); PG8_MMA(1, 0, At, B0); PG8_BAR; PG8_SCHED;
            PG8_STAGE(PG8_SB(0, 1), b2 + hstep, voffB);
            PG8_WAIT_V(6); PG8_BAR; PG8_MMA(1, 1, At, B1); PG8_BAR;
            PG8_LDB(B0, 1, 0); PG8_SCHED; PG8_LDA(At, 1, 0); PG8_STAGE(PG8_SA(0, 1), a2 + hstep, voffA);
            PG8_WAIT_L(8); PG8_BAR; PG8_WAIT_L(0); PG8_MMA(0, 0, At, B0); PG8_BAR; PG8_SCHED;
            PG8_LDB(B1, 1, 1); PG8_STAGE(PG8_SB(1, 0), b3, voffB);
            PG8_BAR; PG8_WAIT_L(0); PG8_MMA(0, 1, At, B1); PG8_BAR;
            PG8_LDA(At, 1, 1); PG8_STAGE(PG8_SA(1, 0), a3, voffA);
            PG8_BAR; PG8_WAIT_L(0); PG8_MMA(1, 0, At, B0); PG8_BAR; PG8_SCHED;
            PG8_STAGE(PG8_SB(1, 1), b3 + hstep, voffB);
            PG8_WAIT_V(6); PG8_BAR; PG8_MMA(1, 1, At, B1); PG8_BAR;
            }
        }
        if constexpr (ALIGN_EPI) { if (wr == 0) PG8_BAR; }
        if constexpr (!Epi::AFTER_DRAIN) { E(acc, cur, wr, wc, fr, fq); S.done(cur); }
        if (!has_next) break;
#pragma unroll
        for (int a = 0; a < 2; ++a)
#pragma unroll
            for (int b = 0; b < 2; ++b)
#pragma unroll
                for (int m = 0; m < 4; ++m)
#pragma unroll
                    for (int n = 0; n < 2; ++n) acc[a][b][m][n] = (f32x4){0.f, 0.f, 0.f, 0.f};
        cur = nxt; cA = nA; cB = nB; ++ui;
        if constexpr (ALIGN_EPI) { if (wr == 1) PG8_BAR; }
    }
    PG8_WAIT_V(0);
    if constexpr (!ALIGN_EPI) { if (wr == 0) PG8_BAR; }
    PG8_BAR;
    if constexpr (Epi::AFTER_DRAIN) { E.fused(acc, cur, wr, wc, fr, fq, lds, wid, lane); S.done(cur); }
#undef PG8_SA
#undef PG8_SB
#undef PG8_STAGE
#undef PG8_LDA
#undef PG8_LDB
#undef PG8_MMA
#undef PG8_WAIT_V
#undef PG8_WAIT_L
#undef PG8_BAR
#undef PG8_SCHED
}
}
#define LAS __attribute__((address_space(3)))
typedef LAS unsigned char* LDSp;
typedef pg8::bf16_t bf16_t;
typedef unsigned u32x4 __attribute__((ext_vector_type(4)));
typedef unsigned u32x2 __attribute__((ext_vector_type(2)));
typedef float f32x4 __attribute__((ext_vector_type(4)));
typedef float f32x2 __attribute__((ext_vector_type(2)));

#ifndef EXPC
#define EXPC 0
#endif
#ifndef EVP_SKIP
#define EVP_SKIP 0
#endif
constexpr int T_ = 16384, D_ = 1024, S_ = 4096, NTHR = 512;
constexpr int LDS_BYTES = 147456;
constexpr size_t MiB = 1048576;
constexpr size_t WS_WB = 0, WS_HN = 25 * MiB, WS_Z = 57 * MiB, WS_QKV = 153 * MiB, WS_OF = 201 * MiB, WS_OB = 217 * MiB,
                 WS_GATES = 233 * MiB, WS_BETA = 234 * MiB, WS_LA = 234 * MiB + 524288;
constexpr size_t WB_IN = 0, WB_OUT = 6291456, WB_UP = 8388608, WB_DN = 19922944;
constexpr int DFF = 2816;

struct Params { const float* in[26]; float* out; unsigned char* ws; };

__device__ __forceinline__ float bf2f(unsigned short b) { return __uint_as_float(((unsigned)b) << 16); }
__device__ __forceinline__ float bflo(unsigned u) { return __uint_as_float(u << 16); }
__device__ __forceinline__ float bfhi(unsigned u) { return __uint_as_float(u & 0xffff0000u); }
__device__ __forceinline__ unsigned short f2bf(float f) { return __builtin_bit_cast(unsigned short, (__bf16)f); }
typedef __bf16 bf16x2_v __attribute__((ext_vector_type(2)));
__device__ __forceinline__ unsigned pk2(float lo, float hi) { const f32x2 v = {lo, hi}; const bf16x2_v b = __builtin_convertvector(v, bf16x2_v); return __builtin_bit_cast(unsigned, b); }
__device__ __forceinline__ float sigm(float x) { return __builtin_amdgcn_rcpf(1.0f + __expf(-x)); }
__device__ __forceinline__ float sigm_f(float x) { return __builtin_amdgcn_rcpf(1.0f + __expf(-x)); }
__device__ __forceinline__ float silu_(float x) { return x * sigm(x); }
__device__ __forceinline__ float gelu_t(float x) { const float u = 0.7978845608028654f * (x + 0.044715f * x * x * x); const float t = 1.0f - 2.0f * __builtin_amdgcn_rcpf(1.0f + __expf(2.0f * u)); return 0.5f * x * (1.0f + t); }
__device__ __forceinline__ float softplus_(float x) { return x > 20.0f ? x : log1pf(expf(x)); }
__device__ __forceinline__ float wave_sum(float v) {
#pragma unroll
    for (int o = 32; o; o >>= 1) v += __shfl_xor(v, o);
    return v; }
template <int CTRL> __device__ __forceinline__ float dppf(float v) { return __int_as_float(__builtin_amdgcn_update_dpp(0, __float_as_int(v), CTRL, 0xf, 0xf, true)); }
__device__ __forceinline__ float row16_sum(float v) { v += dppf<0xB1>(v); v += dppf<0x4E>(v); v += dppf<0x141>(v); v += dppf<0x140>(v); return v; }
__device__ __forceinline__ void unpack8(const u32x4 w, float (&f)[8]) { f[0] = bflo(w.x); f[1] = bfhi(w.x); f[2] = bflo(w.y); f[3] = bfhi(w.y); f[4] = bflo(w.z); f[5] = bfhi(w.z); f[6] = bflo(w.w); f[7] = bfhi(w.w); }


__device__ __forceinline__ float wave_scan_sum(float x, bool fwd) {
    const int lane = threadIdx.x & 63;
#pragma unroll
    for (int o = 1; o < 64; o <<= 1) { const float y = fwd ? __shfl_up(x, o) : __shfl_down(x, o); if (fwd ? (lane >= o) : (lane + o < 64)) x += y; }
    return x; }
__device__ __forceinline__ float wave_scan_max(float x, bool fwd) {
    const int lane = threadIdx.x & 63;
#pragma unroll
    for (int o = 1; o < 64; o <<= 1) { const float y = fwd ? __shfl_up(x, o) : __shfl_down(x, o); if (fwd ? (lane >= o) : (lane + o < 64)) x = fmaxf(x, y); }
    return x; }
__device__ __forceinline__ void conv_job(LDSp lds, const float* __restrict__ src, int ldn, int K, int col0, int ncols, bf16_t* __restrict__ dst, int mode, int off) {
    LAS float* tl = (LAS float*)lds;
    const int tid = threadIdx.x, nnt = ncols >> 6, ntl = (K >> 6) * nnt;
    const int r = tid >> 4, c4 = (tid & 15) << 2;
    f32x4 pv[2];
    if ((int)blockIdx.x < ntl) { const int kt = (int)blockIdx.x / nnt, nt = (int)blockIdx.x - kt * nnt;
#pragma unroll
        for (int i = 0; i < 2; ++i) pv[i] = __builtin_nontemporal_load((const f32x4*)(src + (size_t)(kt * 64 + r + 32 * i) * ldn + col0 + nt * 64 + c4)); }
    for (int tile = blockIdx.x; tile < ntl; tile += gridDim.x) {
        const int kt = tile / nnt, nt = tile - kt * nnt;
#pragma unroll
        for (int i = 0; i < 2; ++i) { const int k = r + 32 * i; const f32x4 v = pv[i];
            tl[k * 65 + c4 + 0] = v.x; tl[k * 65 + c4 + 1] = v.y; tl[k * 65 + c4 + 2] = v.z; tl[k * 65 + c4 + 3] = v.w; }
        { const int tn = tile + (int)gridDim.x; if (tn < ntl) { const int kt2 = tn / nnt, nt2 = tn - kt2 * nnt;
#pragma unroll
            for (int i = 0; i < 2; ++i) pv[i] = __builtin_nontemporal_load((const f32x4*)(src + (size_t)(kt2 * 64 + r + 32 * i) * ldn + col0 + nt2 * 64 + c4)); } }
        __syncthreads();
        const int n = tid >> 3, k8 = (tid & 7) << 3; float f[8];
#pragma unroll
        for (int j = 0; j < 8; ++j) f[j] = tl[(k8 + j) * 65 + n];
        u32x4 w; w.x = pk2(f[0], f[1]); w.y = pk2(f[2], f[3]); w.z = pk2(f[4], f[5]); w.w = pk2(f[6], f[7]);
        const int ncol = nt * 64 + n;
        const int row = mode == 0 ? off + ncol : mode == 1 ? ((ncol >> 7) << 8) + (ncol & 127) + off
                      : (ncol < 512 ? ((ncol >> 7) << 8) + (ncol & 127) : ncol < 1024 ? (((ncol - 512) >> 7) << 8) + 128 + ((ncol - 512) & 127) : ncol);
        *(u32x4*)(dst + (size_t)row * K + kt * 64 + k8) = w;
        __syncthreads();
    }
}
__device__ __forceinline__ void convert_layer(LDSp lds, const Params& p, int L) {
    bf16_t* wb = (bf16_t*)(p.ws + WS_WB);
    if (L == 0) { conv_job(lds, p.in[2], 3088, 1024, 0, 3072, (bf16_t*)((char*)wb + WB_IN), 2, 0);
                  conv_job(lds, p.in[11], 1024, 1024, 0, 1024, (bf16_t*)((char*)wb + WB_OUT), 0, 0); }
    else        { conv_job(lds, p.in[12], 2576, 1024, 0, 2560, (bf16_t*)((char*)wb + WB_IN), 0, 0);
                  conv_job(lds, p.in[20], 1024, 1024, 0, 1024, (bf16_t*)((char*)wb + WB_OUT), 0, 0); }
    conv_job(lds, p.in[22] + (size_t)L * 1024 * DFF, DFF, 1024, 0, DFF, (bf16_t*)((char*)wb + WB_UP), 1, 0);
    conv_job(lds, p.in[23] + (size_t)L * 1024 * DFF, DFF, 1024, 0, DFF, (bf16_t*)((char*)wb + WB_UP), 1, 128);
    conv_job(lds, p.in[24] + (size_t)L * DFF * 1024, 1024, DFF, 0, 1024, (bf16_t*)((char*)wb + WB_DN), 0, 0);
}

__device__ __forceinline__ void rms_phase(LDSp lds, const float* src, const float* __restrict__ g, bf16_t* hn, float* copy_out, float* final_out,
                                          const float* __restrict__ gw, int gw_ld, int gw_col0, float* gates) {
    LAS float* wg = (LAS float*)lds;
    const int tid = threadIdx.x, lane = tid & 63, wid = tid >> 6;
    if (gw) { for (int idx = tid; idx < 16384; idx += NTHR) { const int k = idx >> 4, j = idx & 15; wg[j * 1024 + k] = gw[(size_t)k * gw_ld + gw_col0 + j]; } __syncthreads(); }
    f32x4 gv[4];
#pragma unroll
    for (int i = 0; i < 4; ++i) gv[i] = *(const f32x4*)(g + 4 * lane + 256 * i);
    f32x4 xn[4];
    { const int row0 = blockIdx.x * 8 + wid;
#pragma unroll
      for (int i = 0; i < 4; ++i) xn[i] = *(const f32x4*)(src + (size_t)row0 * D_ + 4 * lane + 256 * i); }
    for (int row = blockIdx.x * 8 + wid; row < T_; row += gridDim.x * 8) {
        f32x4 x[4]; float ss = 0.f;
#pragma unroll
        for (int i = 0; i < 4; ++i) { x[i] = xn[i]; ss += x[i].x * x[i].x + x[i].y * x[i].y + x[i].z * x[i].z + x[i].w * x[i].w; }
        { const int rn = row + (int)gridDim.x * 8; if (rn < T_) {
#pragma unroll
            for (int i = 0; i < 4; ++i) xn[i] = *(const f32x4*)(src + (size_t)rn * D_ + 4 * lane + 256 * i); } }
        if (copy_out) {
#pragma unroll
            for (int i = 0; i < 4; ++i) *(f32x4*)(copy_out + (size_t)row * D_ + 4 * lane + 256 * i) = x[i]; }
        ss = wave_sum(ss);
        const float rstd = rsqrtf(ss * (1.0f / 1024.0f) + 1e-6f);
        f32x4 y[4];
#pragma unroll
        for (int i = 0; i < 4; ++i) y[i] = x[i] * rstd * gv[i];
        if (final_out) {
#pragma unroll
            for (int i = 0; i < 4; ++i) __builtin_nontemporal_store(y[i], (f32x4*)(final_out + (size_t)row * D_ + 4 * lane + 256 * i));
        } else {
#pragma unroll
            for (int i = 0; i < 4; ++i) { u32x2 w; w.x = pk2(y[i].x, y[i].y); w.y = pk2(y[i].z, y[i].w); *(u32x2*)(hn + (size_t)row * D_ + 4 * lane + 256 * i) = w; }
        }
        if (gw) {
            float s[16];
#pragma unroll
            for (int j = 0; j < 16; ++j) { float a = 0.f;
#pragma unroll
                for (int i = 0; i < 4; ++i) { const f32x4 w = *(const LAS f32x4*)(wg + j * 1024 + 4 * lane + 256 * i); a += y[i].x * w.x + y[i].y * w.y + y[i].z * w.z + y[i].w * w.w; }
                s[j] = a; }
            const bool h5 = (lane & 32) != 0, h4 = (lane & 16) != 0, h3 = (lane & 8) != 0, h2 = (lane & 4) != 0;
            float r8[8], r4[4], r2[2], r1;
#pragma unroll
            for (int j = 0; j < 8; ++j) { const float keep = h5 ? s[j + 8] : s[j], send = h5 ? s[j] : s[j + 8]; r8[j] = keep + __shfl_xor(send, 32); }
#pragma unroll
            for (int j = 0; j < 4; ++j) { const float keep = h4 ? r8[j + 4] : r8[j], send = h4 ? r8[j] : r8[j + 4]; r4[j] = keep + __shfl_xor(send, 16); }
#pragma unroll
            for (int j = 0; j < 2; ++j) { const float keep = h3 ? r4[j + 2] : r4[j], send = h3 ? r4[j] : r4[j + 2]; r2[j] = keep + __shfl_xor(send, 8); }
            { const float keep = h2 ? r2[1] : r2[0], send = h2 ? r2[0] : r2[1]; r1 = keep + __shfl_xor(send, 4); }
            r1 += __shfl_xor(r1, 2); r1 += __shfl_xor(r1, 1);
            if ((lane & 3) == 0) gates[(size_t)row * 16 + (h5 ? 8 : 0) + (h4 ? 4 : 0) + (h3 ? 2 : 0) + (h2 ? 1 : 0)] = r1;
        }
    }
    __syncthreads();
}

__device__ __forceinline__ void even_prep(LDSp lds, const Params& p) {
    const bf16_t* Z = (const bf16_t*)(p.ws + WS_Z); bf16_t* Y = (bf16_t*)(p.ws + WS_HN); bf16_t* QKVN = (bf16_t*)(p.ws + WS_QKV);
    const float* gates = (const float*)(p.ws + WS_GATES); float* BETA = (float*)(p.ws + WS_BETA); float* LA = (float*)(p.ws + WS_LA);
    const float* conv_w = p.in[3]; const float* conv_b = p.in[4]; const float* ln_g = p.in[5]; const float* ln_b = p.in[6];
    const float* dn_w = p.in[7]; const float* a_log = p.in[8]; const float* dt_bias = p.in[9];
    LAS float* glu = (LAS float*)lds;
    const int tid = threadIdx.x, lane = tid & 63, wid = tid >> 6, c = tid;
    for (int tile = blockIdx.x; tile < T_ / 32; tile += gridDim.x) {
        const int t0 = tile * 32, b = t0 >> 12, s0 = t0 & 4095;
#if !(EVP_SKIP & 1)
        for (int it = tid; it < 62 * 64; it += NTHR) { const int r = it >> 6, c8 = (it & 63) << 3, sp = s0 - 15 + r;
            f32x4 o0 = {0.f, 0.f, 0.f, 0.f}, o1 = {0.f, 0.f, 0.f, 0.f};
            if (sp >= 0 && sp < S_) { const size_t tok = (size_t)b * S_ + sp; const u32x4 av = *(const u32x4*)(Z + tok * 3072 + c8);
                float a[8]; unpack8(av, a);
                o0 = (f32x4){a[0], a[1], a[2], a[3]}; o1 = (f32x4){a[4], a[5], a[6], a[7]}; }
            *(LAS f32x4*)(glu + r * 512 + c8) = o0; *(LAS f32x4*)(glu + r * 512 + c8 + 4) = o1; }
        __syncthreads();
        {
            float cw[31];
#pragma unroll
            for (int w = 0; w < 31; ++w) cw[w] = conv_w[w * 512 + c];
            const float cb = conv_b[c];
            f32x4 res[8];
#pragma unroll
            for (int t4 = 0; t4 < 8; ++t4) {
                float x[34];
#pragma unroll
                for (int i = 0; i < 34; ++i) x[i] = glu[(t4 * 4 + i) * 512 + c];
                float a0 = cb, a1 = cb, a2 = cb, a3 = cb;
#pragma unroll
                for (int w = 0; w < 31; ++w) { a0 = fmaf(x[w], cw[w], a0); a1 = fmaf(x[w + 1], cw[w], a1); a2 = fmaf(x[w + 2], cw[w], a2); a3 = fmaf(x[w + 3], cw[w], a3); }
                res[t4] = (f32x4){a0, a1, a2, a3};
            }
            __syncthreads();
#pragma unroll
            for (int t4 = 0; t4 < 8; ++t4) { glu[(t4 * 4 + 0) * 512 + c] = res[t4].x; glu[(t4 * 4 + 1) * 512 + c] = res[t4].y; glu[(t4 * 4 + 2) * 512 + c] = res[t4].z; glu[(t4 * 4 + 3) * 512 + c] = res[t4].w; }
        }
        __syncthreads();
        {
            const f32x4 g0 = *(const f32x4*)(ln_g + 4 * lane), g1 = *(const f32x4*)(ln_g + 256 + 4 * lane), b0 = *(const f32x4*)(ln_b + 4 * lane), b1 = *(const f32x4*)(ln_b + 256 + 4 * lane);
#pragma unroll
            for (int tt = 0; tt < 4; ++tt) { const int t = wid * 4 + tt;
                const f32x4 x0 = *(const LAS f32x4*)(glu + t * 512 + 4 * lane), x1 = *(const LAS f32x4*)(glu + t * 512 + 256 + 4 * lane);
                const float mean = wave_sum((x0.x + x0.y) + (x0.z + x0.w) + (x1.x + x1.y) + (x1.z + x1.w)) * (1.0f / 512.0f);
                const f32x4 d0 = x0 - mean, d1 = x1 - mean;
                const float var = wave_sum(d0.x * d0.x + d0.y * d0.y + d0.z * d0.z + d0.w * d0.w + d1.x * d1.x + d1.y * d1.y + d1.z * d1.z + d1.w * d1.w) * (1.0f / 512.0f);
                const float rstd = rsqrtf(var + 1e-5f);
                const f32x4 y0 = d0 * rstd * g0 + b0, y1 = d1 * rstd * g1 + b1;
                u32x2 w0, w1; w0.x = pk2(silu_(y0.x), silu_(y0.y)); w0.y = pk2(silu_(y0.z), silu_(y0.w)); w1.x = pk2(silu_(y1.x), silu_(y1.y)); w1.y = pk2(silu_(y1.z), silu_(y1.w));
                *(u32x2*)(Y + (size_t)(t0 + t) * 1024 + 4 * lane) = w0; *(u32x2*)(Y + (size_t)(t0 + t) * 1024 + 256 + 4 * lane) = w1; }
        }
        __syncthreads();
#endif
#if !(EVP_SKIP & 2)
        LAS unsigned short* xin = (LAS unsigned short*)(glu + 32 * 512);
#pragma unroll 1
        for (int gi = 0; gi < 3; ++gi) {
            float w5[5];
#pragma unroll
            for (int w = 0; w < 5; ++w) w5[w] = dn_w[w * 1536 + gi * 512 + c];
            for (int it = tid; it < 36 * 64; it += NTHR) { const int rr = it >> 6, c8 = (it & 63) << 3, sp = s0 - 2 + rr;
                u32x4 v = {0u, 0u, 0u, 0u};
                if (sp >= 0 && sp < S_) v = *(const u32x4*)(Z + ((size_t)b * S_ + sp) * 3072 + 1024 + gi * 512 + c8);
                *(LAS u32x4*)(xin + rr * 512 + c8) = v; }
            __syncthreads();
            float x0 = bf2f(xin[c]), x1 = bf2f(xin[512 + c]), x2 = bf2f(xin[1024 + c]), x3 = bf2f(xin[1536 + c]);
#pragma unroll 8
            for (int t = 0; t < 32; ++t) { const float x4 = bf2f(xin[(t + 4) * 512 + c]);
                float v = x0 * w5[0]; v = fmaf(x1, w5[1], v); v = fmaf(x2, w5[2], v); v = fmaf(x3, w5[3], v); v = fmaf(x4, w5[4], v);
                glu[t * 512 + c] = silu_(v);
                x0 = x1; x1 = x2; x2 = x3; x3 = x4; }
            __syncthreads();
            const float qs = gi == 0 ? 0.08838834764831845f : 1.0f;
#pragma unroll
            for (int pp = 0; pp < 4; ++pp) { const int pr = wid * 16 + pp * 4 + (lane >> 4), t = pr >> 2, hd = pr & 3, c8 = (lane & 15) * 8;
                const f32x4 y0 = *(const LAS f32x4*)(glu + t * 512 + hd * 128 + c8), y1 = *(const LAS f32x4*)(glu + t * 512 + hd * 128 + c8 + 4);
                const float ss = row16_sum(y0.x * y0.x + y0.y * y0.y + y0.z * y0.z + y0.w * y0.w + y1.x * y1.x + y1.y * y1.y + y1.z * y1.z + y1.w * y1.w);
                const float sc = gi == 2 ? 1.0f : rsqrtf(ss + 1e-6f) * qs;
                u32x4 w; w.x = pk2(y0.x * sc, y0.y * sc); w.y = pk2(y0.z * sc, y0.w * sc); w.z = pk2(y1.x * sc, y1.y * sc); w.w = pk2(y1.z * sc, y1.w * sc);
                *(u32x4*)(QKVN + (size_t)(t0 + t) * 1536 + gi * 512 + hd * 128 + c8) = w; }
            __syncthreads();
        }
#endif
#if !(EVP_SKIP & 4)
        if (tid < 256) { const int t = tid >> 3, j = tid & 7; const size_t tok = (size_t)(t0 + t);
            const float bp = gates[tok * 16 + j], ap = gates[tok * 16 + 8 + j];
            BETA[tok * 8 + j] = sigm(bp); LA[tok * 8 + j] = -expf(a_log[j]) * softplus_(ap + dt_bias[j]); }
#endif
        __syncthreads();
    }
}

__device__ __forceinline__ void tri_inv64(const LAS float* Am, int c, float su, float sw, LAS unsigned short* Tu, LAS unsigned short* Tw) {
    f32x4 a; float s0, s1, s2, s3; const float cf = (float)c;
    float x0 = fmaxf(0.0f, 1.0f - fabsf(cf - 0.0f));
    Tu[0 + c] = f2bf(x0 * su); Tw[0 + c] = f2bf(x0 * sw); asm volatile("" ::: "memory");
    float x1 = fmaxf(0.0f, 1.0f - fabsf(cf - 1.0f));
    s0 = 0.f; s1 = 0.f; s2 = 0.f; s3 = 0.f;
    a = *(const LAS f32x4*)(Am + 68);
    const float al1 = a.x;
    x1 = (x1 - ((s0 + s1) + (s2 + s3))) - al1 * x0;
    Tu[136 + c] = f2bf(x1 * su); Tw[136 + c] = f2bf(x1 * sw); asm volatile("" ::: "memory");
    float x2 = fmaxf(0.0f, 1.0f - fabsf(cf - 2.0f));
    s0 = 0.f; s1 = 0.f; s2 = 0.f; s3 = 0.f;
    a = *(const LAS f32x4*)(Am + 136);
    s0 = fmaf(a.x, x0, s0);
    const float al2 = a.y;
    x2 = (x2 - ((s0 + s1) + (s2 + s3))) - al2 * x1;
    Tu[272 + c] = f2bf(x2 * su); Tw[272 + c] = f2bf(x2 * sw); asm volatile("" ::: "memory");
    float x3 = fmaxf(0.0f, 1.0f - fabsf(cf - 3.0f));
    s0 = 0.f; s1 = 0.f; s2 = 0.f; s3 = 0.f;
    a = *(const LAS f32x4*)(Am + 204);
    s0 = fmaf(a.x, x0, s0);
    s1 = fmaf(a.y, x1, s1);
    const float al3 = a.z;
    x3 = (x3 - ((s0 + s1) + (s2 + s3))) - al3 * x2;
    Tu[408 + c] = f2bf(x3 * su); Tw[408 + c] = f2bf(x3 * sw); asm volatile("" ::: "memory");
    float x4 = fmaxf(0.0f, 1.0f - fabsf(cf - 4.0f));
    s0 = 0.f; s1 = 0.f; s2 = 0.f; s3 = 0.f;
    a = *(const LAS f32x4*)(Am + 272);
    s0 = fmaf(a.x, x0, s0);
    s1 = fmaf(a.y, x1, s1);
    s2 = fmaf(a.z, x2, s2);
    const float al4 = a.w;
    x4 = (x4 - ((s0 + s1) + (s2 + s3))) - al4 * x3;
    Tu[544 + c] = f2bf(x4 * su); Tw[544 + c] = f2bf(x4 * sw); asm volatile("" ::: "memory");
    float x5 = fmaxf(0.0f, 1.0f - fabsf(cf - 5.0f));
    s0 = 0.f; s1 = 0.f; s2 = 0.f; s3 = 0.f;
    a = *(const LAS f32x4*)(Am + 340);
    s0 = fmaf(a.x, x0, s0);
    s1 = fmaf(a.y, x1, s1);
    s2 = fmaf(a.z, x2, s2);
    s3 = fmaf(a.w, x3, s3);
    a = *(const LAS f32x4*)(Am + 344);
    const float al5 = a.x;
    x5 = (x5 - ((s0 + s1) + (s2 + s3))) - al5 * x4;
    Tu[680 + c] = f2bf(x5 * su); Tw[680 + c] = f2bf(x5 * sw); asm volatile("" ::: "memory");
    float x6 = fmaxf(0.0f, 1.0f - fabsf(cf - 6.0f));
    s0 = 0.f; s1 = 0.f; s2 = 0.f; s3 = 0.f;
    a = *(const LAS f32x4*)(Am + 408);
    s0 = fmaf(a.x, x0, s0);
    s1 = fmaf(a.y, x1, s1);
    s2 = fmaf(a.z, x2, s2);
    s3 = fmaf(a.w, x3, s3);
    a = *(const LAS f32x4*)(Am + 412);
    s0 = fmaf(a.x, x4, s0);
    const float al6 = a.y;
    x6 = (x6 - ((s0 + s1) + (s2 + s3))) - al6 * x5;
    Tu[816 + c] = f2bf(x6 * su); Tw[816 + c] = f2bf(x6 * sw); asm volatile("" ::: "memory");
    float x7 = fmaxf(0.0f, 1.0f - fabsf(cf - 7.0f));
    s0 = 0.f; s1 = 0.f; s2 = 0.f; s3 = 0.f;
    a = *(const LAS f32x4*)(Am + 476);
    s0 = fmaf(a.x, x0, s0);
    s1 = fmaf(a.y, x1, s1);
    s2 = fmaf(a.z, x2, s2);
    s3 = fmaf(a.w, x3, s3);
    a = *(const LAS f32x4*)(Am + 480);
    s0 = fmaf(a.x, x4, s0);
    s1 = fmaf(a.y, x5, s1);
    const float al7 = a.z;
    x7 = (x7 - ((s0 + s1) + (s2 + s3))) - al7 * x6;
    Tu[952 + c] = f2bf(x7 * su); Tw[952 + c] = f2bf(x7 * sw); asm volatile("" ::: "memory");
    float x8 = fmaxf(0.0f, 1.0f - fabsf(cf - 8.0f));
    s0 = 0.f; s1 = 0.f; s2 = 0.f; s3 = 0.f;
    a = *(const LAS f32x4*)(Am + 544);
    s0 = fmaf(a.x, x0, s0);
    s1 = fmaf(a.y, x1, s1);
    s2 = fmaf(a.z, x2, s2);
    s3 = fmaf(a.w, x3, s3);
    a = *(const LAS f32x4*)(Am + 548);
    s0 = fmaf(a.x, x4, s0);
    s1 = fmaf(a.y, x5, s1);
    s2 = fmaf(a.z, x6, s2);
    const float al8 = a.w;
    x8 = (x8 - ((s0 + s1) + (s2 + s3))) - al8 * x7;
    Tu[1088 + c] = f2bf(x8 * su); Tw[1088 + c] = f2bf(x8 * sw); asm volatile("" ::: "memory");
    float x9 = fmaxf(0.0f, 1.0f - fabsf(cf - 9.0f));
    s0 = 0.f; s1 = 0.f; s2 = 0.f; s3 = 0.f;
    a = *(const LAS f32x4*)(Am + 612);
    s0 = fmaf(a.x, x0, s0);
    s1 = fmaf(a.y, x1, s1);
    s2 = fmaf(a.z, x2, s2);
    s3 = fmaf(a.w, x3, s3);
    a = *(const LAS f32x4*)(Am + 616);
    s0 = fmaf(a.x, x4, s0);
    s1 = fmaf(a.y, x5, s1);
    s2 = fmaf(a.z, x6, s2);
    s3 = fmaf(a.w, x7, s3);
    a = *(const LAS f32x4*)(Am + 620);
    const float al9 = a.x;
    x9 = (x9 - ((s0 + s1) + (s2 + s3))) - al9 * x8;
    Tu[1224 + c] = f2bf(x9 * su); Tw[1224 + c] = f2bf(x9 * sw); asm volatile("" ::: "memory");
    float x10 = fmaxf(0.0f, 1.0f - fabsf(cf - 10.0f));
    s0 = 0.f; s1 = 0.f; s2 = 0.f; s3 = 0.f;
    a = *(const LAS f32x4*)(Am + 680);
    s0 = fmaf(a.x, x0, s0);
    s1 = fmaf(a.y, x1, s1);
    s2 = fmaf(a.z, x2, s2);
    s3 = fmaf(a.w, x3, s3);
    a = *(const LAS f32x4*)(Am + 684);
    s0 = fmaf(a.x, x4, s0);
    s1 = fmaf(a.y, x5, s1);
    s2 = fmaf(a.z, x6, s2);
    s3 = fmaf(a.w, x7, s3);
    a = *(const LAS f32x4*)(Am + 688);
    s0 = fmaf(a.x, x8, s0);
    const float al10 = a.y;
    x10 = (x10 - ((s0 + s1) + (s2 + s3))) - al10 * x9;
    Tu[1360 + c] = f2bf(x10 * su); Tw[1360 + c] = f2bf(x10 * sw); asm volatile("" ::: "memory");
    float x11 = fmaxf(0.0f, 1.0f - fabsf(cf - 11.0f));
    s0 = 0.f; s1 = 0.f; s2 = 0.f; s3 = 0.f;
    a = *(const LAS f32x4*)(Am + 748);
    s0 = fmaf(a.x, x0, s0);
    s1 = fmaf(a.y, x1, s1);
    s2 = fmaf(a.z, x2, s2);
    s3 = fmaf(a.w, x3, s3);
    a = *(const LAS f32x4*)(Am + 752);
    s0 = fmaf(a.x, x4, s0);
    s1 = fmaf(a.y, x5, s1);
    s2 = fmaf(a.z, x6, s2);
    s3 = fmaf(a.w, x7, s3);
    a = *(const LAS f32x4*)(Am + 756);
    s0 = fmaf(a.x, x8, s0);
    s1 = fmaf(a.y, x9, s1);
    const float al11 = a.z;
    x11 = (x11 - ((s0 + s1) + (s2 + s3))) - al11 * x10;
    Tu[1496 + c] = f2bf(x11 * su); Tw[1496 + c] = f2bf(x11 * sw); asm volatile("" ::: "memory");
    float x12 = fmaxf(0.0f, 1.0f - fabsf(cf - 12.0f));
    s0 = 0.f; s1 = 0.f; s2 = 0.f; s3 = 0.f;
    a = *(const LAS f32x4*)(Am + 816);
    s0 = fmaf(a.x, x0, s0);
    s1 = fmaf(a.y, x1, s1);
    s2 = fmaf(a.z, x2, s2);
    s3 = fmaf(a.w, x3, s3);
    a = *(const LAS f32x4*)(Am + 820);
    s0 = fmaf(a.x, x4, s0);
    s1 = fmaf(a.y, x5, s1);
    s2 = fmaf(a.z, x6, s2);
    s3 = fmaf(a.w, x7, s3);
    a = *(const LAS f32x4*)(Am + 824);
    s0 = fmaf(a.x, x8, s0);
    s1 = fmaf(a.y, x9, s1);
    s2 = fmaf(a.z, x10, s2);
    const float al12 = a.w;
    x12 = (x12 - ((s0 + s1) + (s2 + s3))) - al12 * x11;
    Tu[1632 + c] = f2bf(x12 * su); Tw[1632 + c] = f2bf(x12 * sw); asm volatile("" ::: "memory");
    float x13 = fmaxf(0.0f, 1.0f - fabsf(cf - 13.0f));
    s0 = 0.f; s1 = 0.f; s2 = 0.f; s3 = 0.f;
    a = *(const LAS f32x4*)(Am + 884);
    s0 = fmaf(a.x, x0, s0);
    s1 = fmaf(a.y, x1, s1);
    s2 = fmaf(a.z, x2, s2);
    s3 = fmaf(a.w, x3, s3);
    a = *(const LAS f32x4*)(Am + 888);
    s0 = fmaf(a.x, x4, s0);
    s1 = fmaf(a.y, x5, s1);
    s2 = fmaf(a.z, x6, s2);
    s3 = fmaf(a.w, x7, s3);
    a = *(const LAS f32x4*)(Am + 892);
    s0 = fmaf(a.x, x8, s0);
    s1 = fmaf(a.y, x9, s1);
    s2 = fmaf(a.z, x10, s2);
    s3 = fmaf(a.w, x11, s3);
    a = *(const LAS f32x4*)(Am + 896);
    const float al13 = a.x;
    x13 = (x13 - ((s0 + s1) + (s2 + s3))) - al13 * x12;
    Tu[1768 + c] = f2bf(x13 * su); Tw[1768 + c] = f2bf(x13 * sw); asm volatile("" ::: "memory");
    float x14 = fmaxf(0.0f, 1.0f - fabsf(cf - 14.0f));
    s0 = 0.f; s1 = 0.f; s2 = 0.f; s3 = 0.f;
    a = *(const LAS f32x4*)(Am + 952);
    s0 = fmaf(a.x, x0, s0);
    s1 = fmaf(a.y, x1, s1);
    s2 = fmaf(a.z, x2, s2);
    s3 = fmaf(a.w, x3, s3);
    a = *(const LAS f32x4*)(Am + 956);
    s0 = fmaf(a.x, x4, s0);
    s1 = fmaf(a.y, x5, s1);
    s2 = fmaf(a.z, x6, s2);
    s3 = fmaf(a.w, x7, s3);
    a = *(const LAS f32x4*)(Am + 960);
    s0 = fmaf(a.x, x8, s0);
    s1 = fmaf(a.y, x9, s1);
    s2 = fmaf(a.z, x10, s2);
    s3 = fmaf(a.w, x11, s3);
    a = *(const LAS f32x4*)(Am + 964);
    s0 = fmaf(a.x, x12, s0);
    const float al14 = a.y;
    x14 = (x14 - ((s0 + s1) + (s2 + s3))) - al14 * x13;
    Tu[1904 + c] = f2bf(x14 * su); Tw[1904 + c] = f2bf(x14 * sw); asm volatile("" ::: "memory");
    float x15 = fmaxf(0.0f, 1.0f - fabsf(cf - 15.0f));
    s0 = 0.f; s1 = 0.f; s2 = 0.f; s3 = 0.f;
    a = *(const LAS f32x4*)(Am + 1020);
    s0 = fmaf(a.x, x0, s0);
    s1 = fmaf(a.y, x1, s1);
    s2 = fmaf(a.z, x2, s2);
    s3 = fmaf(a.w, x3, s3);
    a = *(const LAS f32x4*)(Am + 1024);
    s0 = fmaf(a.x, x4, s0);
    s1 = fmaf(a.y, x5, s1);
    s2 = fmaf(a.z, x6, s2);
    s3 = fmaf(a.w, x7, s3);
    a = *(const LAS f32x4*)(Am + 1028);
    s0 = fmaf(a.x, x8, s0);
    s1 = fmaf(a.y, x9, s1);
    s2 = fmaf(a.z, x10, s2);
    s3 = fmaf(a.w, x11, s3);
    a = *(const LAS f32x4*)(Am + 1032);
    s0 = fmaf(a.x, x12, s0);
    s1 = fmaf(a.y, x13, s1);
    const float al15 = a.z;
    x15 = (x15 - ((s0 + s1) + (s2 + s3))) - al15 * x14;
    Tu[2040 + c] = f2bf(x15 * su); Tw[2040 + c] = f2bf(x15 * sw); asm volatile("" ::: "memory");
    float x16 = fmaxf(0.0f, 1.0f - fabsf(cf - 16.0f));
    s0 = 0.f; s1 = 0.f; s2 = 0.f; s3 = 0.f;
    a = *(const LAS f32x4*)(Am + 1088);
    s0 = fmaf(a.x, x0, s0);
    s1 = fmaf(a.y, x1, s1);
    s2 = fmaf(a.z, x2, s2);
    s3 = fmaf(a.w, x3, s3);
    a = *(const LAS f32x4*)(Am + 1092);
    s0 = fmaf(a.x, x4, s0);
    s1 = fmaf(a.y, x5, s1);
    s2 = fmaf(a.z, x6, s2);
    s3 = fmaf(a.w, x7, s3);
    a = *(const LAS f32x4*)(Am + 1096);
    s0 = fmaf(a.x, x8, s0);
    s1 = fmaf(a.y, x9, s1);
    s2 = fmaf(a.z, x10, s2);
    s3 = fmaf(a.w, x11, s3);
    a = *(const LAS f32x4*)(Am + 1100);
    s0 = fmaf(a.x, x12, s0);
    s1 = fmaf(a.y, x13, s1);
    s2 = fmaf(a.z, x14, s2);
    const float al16 = a.w;
    x16 = (x16 - ((s0 + s1) + (s2 + s3))) - al16 * x15;
    Tu[2176 + c] = f2bf(x16 * su); Tw[2176 + c] = f2bf(x16 * sw); asm volatile("" ::: "memory");
    float x17 = fmaxf(0.0f, 1.0f - fabsf(cf - 17.0f));
    s0 = 0.f; s1 = 0.f; s2 = 0.f; s3 = 0.f;
    a = *(const LAS f32x4*)(Am + 1156);
    s0 = fmaf(a.x, x0, s0);
    s1 = fmaf(a.y, x1, s1);
    s2 = fmaf(a.z, x2, s2);
    s3 = fmaf(a.w, x3, s3);
    a = *(const LAS f32x4*)(Am + 1160);
    s0 = fmaf(a.x, x4, s0);
    s1 = fmaf(a.y, x5, s1);
    s2 = fmaf(a.z, x6, s2);
    s3 = fmaf(a.w, x7, s3);
    a = *(const LAS f32x4*)(Am + 1164);
    s0 = fmaf(a.x, x8, s0);
    s1 = fmaf(a.y, x9, s1);
    s2 = fmaf(a.z, x10, s2);
    s3 = fmaf(a.w, x11, s3);
    a = *(const LAS f32x4*)(Am + 1168);
    s0 = fmaf(a.x, x12, s0);
    s1 = fmaf(a.y, x13, s1);
    s2 = fmaf(a.z, x14, s2);
    s3 = fmaf(a.w, x15, s3);
    a = *(const LAS f32x4*)(Am + 1172);
    const float al17 = a.x;
    x17 = (x17 - ((s0 + s1) + (s2 + s3))) - al17 * x16;
    Tu[2312 + c] = f2bf(x17 * su); Tw[2312 + c] = f2bf(x17 * sw); asm volatile("" ::: "memory");
    float x18 = fmaxf(0.0f, 1.0f - fabsf(cf - 18.0f));
    s0 = 0.f; s1 = 0.f; s2 = 0.f; s3 = 0.f;
    a = *(const LAS f32x4*)(Am + 1224);
    s0 = fmaf(a.x, x0, s0);
    s1 = fmaf(a.y, x1, s1);
    s2 = fmaf(a.z, x2, s2);
    s3 = fmaf(a.w, x3, s3);
    a = *(const LAS f32x4*)(Am + 1228);
    s0 = fmaf(a.x, x4, s0);
    s1 = fmaf(a.y, x5, s1);
    s2 = fmaf(a.z, x6, s2);
    s3 = fmaf(a.w, x7, s3);
    a = *(const LAS f32x4*)(Am + 1232);
    s0 = fmaf(a.x, x8, s0);
    s1 = fmaf(a.y, x9, s1);
    s2 = fmaf(a.z, x10, s2);
    s3 = fmaf(a.w, x11, s3);
    a = *(const LAS f32x4*)(Am + 1236);
    s0 = fmaf(a.x, x12, s0);
    s1 = fmaf(a.y, x13, s1);
    s2 = fmaf(a.z, x14, s2);
    s3 = fmaf(a.w, x15, s3);
    a = *(const LAS f32x4*)(Am + 1240);
    s0 = fmaf(a.x, x16, s0);
    const float al18 = a.y;
    x18 = (x18 - ((s0 + s1) + (s2 + s3))) - al18 * x17;
    Tu[2448 + c] = f2bf(x18 * su); Tw[2448 + c] = f2bf(x18 * sw); asm volatile("" ::: "memory");
    float x19 = fmaxf(0.0f, 1.0f - fabsf(cf - 19.0f));
    s0 = 0.f; s1 = 0.f; s2 = 0.f; s3 = 0.f;
    a = *(const LAS f32x4*)(Am + 1292);
    s0 = fmaf(a.x, x0, s0);
    s1 = fmaf(a.y, x1, s1);
    s2 = fmaf(a.z, x2, s2);
    s3 = fmaf(a.w, x3, s3);
    a = *(const LAS f32x4*)(Am + 1296);
    s0 = fmaf(a.x, x4, s0);
    s1 = fmaf(a.y, x5, s1);
    s2 = fmaf(a.z, x6, s2);
    s3 = fmaf(a.w, x7, s3);
    a = *(const LAS f32x4*)(Am + 1300);
    s0 = fmaf(a.x, x8, s0);
    s1 = fmaf(a.y, x9, s1);
    s2 = fmaf(a.z, x10, s2);
    s3 = fmaf(a.w, x11, s3);
    a = *(const LAS f32x4*)(Am + 1304);
    s0 = fmaf(a.x, x12, s0);
    s1 = fmaf(a.y, x13, s1);
    s2 = fmaf(a.z, x14, s2);
    s3 = fmaf(a.w, x15, s3);
    a = *(const LAS f32x4*)(Am + 1308);
    s0 = fmaf(a.x, x16, s0);
    s1 = fmaf(a.y, x17, s1);
    const float al19 = a.z;
    x19 = (x19 - ((s0 + s1) + (s2 + s3))) - al19 * x18;
    Tu[2584 + c] = f2bf(x19 * su); Tw[2584 + c] = f2bf(x19 * sw); asm volatile("" ::: "memory");
    float x20 = fmaxf(0.0f, 1.0f - fabsf(cf - 20.0f));
    s0 = 0.f; s1 = 0.f; s2 = 0.f; s3 = 0.f;
    a = *(const LAS f32x4*)(Am + 1360);
    s0 = fmaf(a.x, x0, s0);
    s1 = fmaf(a.y, x1, s1);
    s2 = fmaf(a.z, x2, s2);
    s3 = fmaf(a.w, x3, s3);
    a = *(const LAS f32x4*)(Am + 1364);
    s0 = fmaf(a.x, x4, s0);
    s1 = fmaf(a.y, x5, s1);
    s2 = fmaf(a.z, x6, s2);
    s3 = fmaf(a.w, x7, s3);
    a = *(const LAS f32x4*)(Am + 1368);
    s0 = fmaf(a.x, x8, s0);
    s1 = fmaf(a.y, x9, s1);
    s2 = fmaf(a.z, x10, s2);
    s3 = fmaf(a.w, x11, s3);
    a = *(const LAS f32x4*)(Am + 1372);
    s0 = fmaf(a.x, x12, s0);
    s1 = fmaf(a.y, x13, s1);
    s2 = fmaf(a.z, x14, s2);
    s3 = fmaf(a.w, x15, s3);
    a = *(const LAS f32x4*)(Am + 1376);
    s0 = fmaf(a.x, x16, s0);
    s1 = fmaf(a.y, x17, s1);
    s2 = fmaf(a.z, x18, s2);
    const float al20 = a.w;
    x20 = (x20 - ((s0 + s1) + (s2 + s3))) - al20 * x19;
    Tu[2720 + c] = f2bf(x20 * su); Tw[2720 + c] = f2bf(x20 * sw); asm volatile("" ::: "memory");
    float x21 = fmaxf(0.0f, 1.0f - fabsf(cf - 21.0f));
    s0 = 0.f; s1 = 0.f; s2 = 0.f; s3 = 0.f;
    a = *(const LAS f32x4*)(Am + 1428);
    s0 = fmaf(a.x, x0, s0);
    s1 = fmaf(a.y, x1, s1);
    s2 = fmaf(a.z, x2, s2);
    s3 = fmaf(a.w, x3, s3);
    a = *(const LAS f32x4*)(Am + 1432);
    s0 = fmaf(a.x, x4, s0);
    s1 = fmaf(a.y, x5, s1);
    s2 = fmaf(a.z, x6, s2);
    s3 = fmaf(a.w, x7, s3);
    a = *(const LAS f32x4*)(Am + 1436);
    s0 = fmaf(a.x, x8, s0);
    s1 = fmaf(a.y, x9, s1);
    s2 = fmaf(a.z, x10, s2);
    s3 = fmaf(a.w, x11, s3);
    a = *(const LAS f32x4*)(Am + 1440);
    s0 = fmaf(a.x, x12, s0);
    s1 = fmaf(a.y, x13, s1);
    s2 = fmaf(a.z, x14, s2);
    s3 = fmaf(a.w, x15, s3);
    a = *(const LAS f32x4*)(Am + 1444);
    s0 = fmaf(a.x, x16, s0);
    s1 = fmaf(a.y, x17, s1);
    s2 = fmaf(a.z, x18, s2);
    s3 = fmaf(a.w, x19, s3);
    a = *(const LAS f32x4*)(Am + 1448);
    const float al21 = a.x;
    x21 = (x21 - ((s0 + s1) + (s2 + s3))) - al21 * x20;
    Tu[2856 + c] = f2bf(x21 * su); Tw[2856 + c] = f2bf(x21 * sw); asm volatile("" ::: "memory");
    float x22 = fmaxf(0.0f, 1.0f - fabsf(cf - 22.0f));
    s0 = 0.f; s1 = 0.f; s2 = 0.f; s3 = 0.f;
    a = *(const LAS f32x4*)(Am + 1496);
    s0 = fmaf(a.x, x0, s0);
    s1 = fmaf(a.y, x1, s1);
    s2 = fmaf(a.z, x2, s2);
    s3 = fmaf(a.w, x3, s3);
    a = *(const LAS f32x4*)(Am + 1500);
    s0 = fmaf(a.x, x4, s0);
    s1 = fmaf(a.y, x5, s1);
    s2 = fmaf(a.z, x6, s2);
    s3 = fmaf(a.w, x7, s3);
    a = *(const LAS f32x4*)(Am + 1504);
    s0 = fmaf(a.x, x8, s0);
    s1 = fmaf(a.y, x9, s1);
    s2 = fmaf(a.z, x10, s2);
    s3 = fmaf(a.w, x11, s3);
    a = *(const LAS f32x4*)(Am + 1508);
    s0 = fmaf(a.x, x12, s0);
    s1 = fmaf(a.y, x13, s1);
    s2 = fmaf(a.z, x14, s2);
    s3 = fmaf(a.w, x15, s3);
    a = *(const LAS f32x4*)(Am + 1512);
    s0 = fmaf(a.x, x16, s0);
    s1 = fmaf(a.y, x17, s1);
    s2 = fmaf(a.z, x18, s2);
    s3 = fmaf(a.w, x19, s3);
    a = *(const LAS f32x4*)(Am + 1516);
    s0 = fmaf(a.x, x20, s0);
    const float al22 = a.y;
    x22 = (x22 - ((s0 + s1) + (s2 + s3))) - al22 * x21;
    Tu[2992 + c] = f2bf(x22 * su); Tw[2992 + c] = f2bf(x22 * sw); asm volatile("" ::: "memory");
    float x23 = fmaxf(0.0f, 1.0f - fabsf(cf - 23.0f));
    s0 = 0.f; s1 = 0.f; s2 = 0.f; s3 = 0.f;
    a = *(const LAS f32x4*)(Am + 1564);
    s0 = fmaf(a.x, x0, s0);
    s1 = fmaf(a.y, x1, s1);
    s2 = fmaf(a.z, x2, s2);
    s3 = fmaf(a.w, x3, s3);
    a = *(const LAS f32x4*)(Am + 1568);
    s0 = fmaf(a.x, x4, s0);
    s1 = fmaf(a.y, x5, s1);
    s2 = fmaf(a.z, x6, s2);
    s3 = fmaf(a.w, x7, s3);
    a = *(const LAS f32x4*)(Am + 1572);
    s0 = fmaf(a.x, x8, s0);
    s1 = fmaf(a.y, x9, s1);
    s2 = fmaf(a.z, x10, s2);
    s3 = fmaf(a.w, x11, s3);
    a = *(const LAS f32x4*)(Am + 1576);
    s0 = fmaf(a.x, x12, s0);
    s1 = fmaf(a.y, x13, s1);
    s2 = fmaf(a.z, x14, s2);
    s3 = fmaf(a.w, x15, s3);
    a = *(const LAS f32x4*)(Am + 1580);
    s0 = fmaf(a.x, x16, s0);
    s1 = fmaf(a.y, x17, s1);
    s2 = fmaf(a.z, x18, s2);
    s3 = fmaf(a.w, x19, s3);
    a = *(const LAS f32x4*)(Am + 1584);
    s0 = fmaf(a.x, x20, s0);
    s1 = fmaf(a.y, x21, s1);
    const float al23 = a.z;
    x23 = (x23 - ((s0 + s1) + (s2 + s3))) - al23 * x22;
    Tu[3128 + c] = f2bf(x23 * su); Tw[3128 + c] = f2bf(x23 * sw); asm volatile("" ::: "memory");
    float x24 = fmaxf(0.0f, 1.0f - fabsf(cf - 24.0f));
    s0 = 0.f; s1 = 0.f; s2 = 0.f; s3 = 0.f;
    a = *(const LAS f32x4*)(Am + 1632);
    s0 = fmaf(a.x, x0, s0);
    s1 = fmaf(a.y, x1, s1);
    s2 = fmaf(a.z, x2, s2);
    s3 = fmaf(a.w, x3, s3);
    a = *(const LAS f32x4*)(Am + 1636);
    s0 = fmaf(a.x, x4, s0);
    s1 = fmaf(a.y, x5, s1);
    s2 = fmaf(a.z, x6, s2);
    s3 = fmaf(a.w, x7, s3);
    a = *(const LAS f32x4*)(Am + 1640);
    s0 = fmaf(a.x, x8, s0);
    s1 = fmaf(a.y, x9, s1);
    s2 = fmaf(a.z, x10, s2);
    s3 = fmaf(a.w, x11, s3);
    a = *(const LAS f32x4*)(Am + 1644);
    s0 = fmaf(a.x, x12, s0);
    s1 = fmaf(a.y, x13, s1);
    s2 = fmaf(a.z, x14, s2);
    s3 = fmaf(a.w, x15, s3);
    a = *(const LAS f32x4*)(Am + 1648);
    s0 = fmaf(a.x, x16, s0);
    s1 = fmaf(a.y, x17, s1);
    s2 = fmaf(a.z, x18, s2);
    s3 = fmaf(a.w, x19, s3);
    a = *(const LAS f32x4*)(Am + 1652);
    s0 = fmaf(a.x, x20, s0);
    s1 = fmaf(a.y, x21, s1);
    s2 = fmaf(a.z, x22, s2);
    const float al24 = a.w;
    x24 = (x24 - ((s0 + s1) + (s2 + s3))) - al24 * x23;
    Tu[3264 + c] = f2bf(x24 * su); Tw[3264 + c] = f2bf(x24 * sw); asm volatile("" ::: "memory");
    float x25 = fmaxf(0.0f, 1.0f - fabsf(cf - 25.0f));
    s0 = 0.f; s1 = 0.f; s2 = 0.f; s3 = 0.f;
    a = *(const LAS f32x4*)(Am + 1700);
    s0 = fmaf(a.x, x0, s0);
    s1 = fmaf(a.y, x1, s1);
    s2 = fmaf(a.z, x2, s2);
    s3 = fmaf(a.w, x3, s3);
    a = *(const LAS f32x4*)(Am + 1704);
    s0 = fmaf(a.x, x4, s0);
    s1 = fmaf(a.y, x5, s1);
    s2 = fmaf(a.z, x6, s2);
    s3 = fmaf(a.w, x7, s3);
    a = *(const LAS f32x4*)(Am + 1708);
    s0 = fmaf(a.x, x8, s0);
    s1 = fmaf(a.y, x9, s1);
    s2 = fmaf(a.z, x10, s2);
    s3 = fmaf(a.w, x11, s3);
    a = *(const LAS f32x4*)(Am + 1712);
    s0 = fmaf(a.x, x12, s0);
    s1 = fmaf(a.y, x13, s1);
    s2 = fmaf(a.z, x14, s2);
    s3 = fmaf(a.w, x15, s3);
    a = *(const LAS f32x4*)(Am + 1716);
    s0 = fmaf(a.x, x16, s0);
    s1 = fmaf(a.y, x17, s1);
    s2 = fmaf(a.z, x18, s2);
    s3 = fmaf(a.w, x19, s3);
    a = *(const LAS f32x4*)(Am + 1720);
    s0 = fmaf(a.x, x20, s0);
    s1 = fmaf(a.y, x21, s1);
    s2 = fmaf(a.z, x22, s2);
    s3 = fmaf(a.w, x23, s3);
    a = *(const LAS f32x4*)(Am + 1724);
    const float al25 = a.x;
    x25 = (x25 - ((s0 + s1) + (s2 + s3))) - al25 * x24;
    Tu[3400 + c] = f2bf(x25 * su); Tw[3400 + c] = f2bf(x25 * sw); asm volatile("" ::: "memory");
    float x26 = fmaxf(0.0f, 1.0f - fabsf(cf - 26.0f));
    s0 = 0.f; s1 = 0.f; s2 = 0.f; s3 = 0.f;
    a = *(const LAS f32x4*)(Am + 1768);
    s0 = fmaf(a.x, x0, s0);
    s1 = fmaf(a.y, x1, s1);
    s2 = fmaf(a.z, x2, s2);
    s3 = fmaf(a.w, x3, s3);
    a = *(const LAS f32x4*)(Am + 1772);
    s0 = fmaf(a.x, x4, s0);
    s1 = fmaf(a.y, x5, s1);
    s2 = fmaf(a.z, x6, s2);
    s3 = fmaf(a.w, x7, s3);
    a = *(const LAS f32x4*)(Am + 1776);
    s0 = fmaf(a.x, x8, s0);
    s1 = fmaf(a.y, x9, s1);
    s2 = fmaf(a.z, x10, s2);
    s3 = fmaf(a.w, x11, s3);
    a = *(const LAS f32x4*)(Am + 1780);
    s0 = fmaf(a.x, x12, s0);
    s1 = fmaf(a.y, x13, s1);
    s2 = fmaf(a.z, x14, s2);
    s3 = fmaf(a.w, x15, s3);
    a = *(const LAS f32x4*)(Am + 1784);
    s0 = fmaf(a.x, x16, s0);
    s1 = fmaf(a.y, x17, s1);
    s2 = fmaf(a.z, x18, s2);
    s3 = fmaf(a.w, x19, s3);
    a = *(const LAS f32x4*)(Am + 1788);
    s0 = fmaf(a.x, x20, s0);
    s1 = fmaf(a.y, x21, s1);
    s2 = fmaf(a.z, x22, s2);
    s3 = fmaf(a.w, x23, s3);
    a = *(const LAS f32x4*)(Am + 1792);
    s0 = fmaf(a.x, x24, s0);
    const float al26 = a.y;
    x26 = (x26 - ((s0 + s1) + (s2 + s3))) - al26 * x25;
    Tu[3536 + c] = f2bf(x26 * su); Tw[3536 + c] = f2bf(x26 * sw); asm volatile("" ::: "memory");
    float x27 = fmaxf(0.0f, 1.0f - fabsf(cf - 27.0f));
    s0 = 0.f; s1 = 0.f; s2 = 0.f; s3 = 0.f;
    a = *(const LAS f32x4*)(Am + 1836);
    s0 = fmaf(a.x, x0, s0);
    s1 = fmaf(a.y, x1, s1);
    s2 = fmaf(a.z, x2, s2);
    s3 = fmaf(a.w, x3, s3);
    a = *(const LAS f32x4*)(Am + 1840);
    s0 = fmaf(a.x, x4, s0);
    s1 = fmaf(a.y, x5, s1);
    s2 = fmaf(a.z, x6, s2);
    s3 = fmaf(a.w, x7, s3);
    a = *(const LAS f32x4*)(Am + 1844);
    s0 = fmaf(a.x, x8, s0);
    s1 = fmaf(a.y, x9, s1);
    s2 = fmaf(a.z, x10, s2);
    s3 = fmaf(a.w, x11, s3);
    a = *(const LAS f32x4*)(Am + 1848);
    s0 = fmaf(a.x, x12, s0);
    s1 = fmaf(a.y, x13, s1);
    s2 = fmaf(a.z, x14, s2);
    s3 = fmaf(a.w, x15, s3);
    a = *(const LAS f32x4*)(Am + 1852);
    s0 = fmaf(a.x, x16, s0);
    s1 = fmaf(a.y, x17, s1);
    s2 = fmaf(a.z, x18, s2);
    s3 = fmaf(a.w, x19, s3);
    a = *(const LAS f32x4*)(Am + 1856);
    s0 = fmaf(a.x, x20, s0);
    s1 = fmaf(a.y, x21, s1);
    s2 = fmaf(a.z, x22, s2);
    s3 = fmaf(a.w, x23, s3);
    a = *(const LAS f32x4*)(Am + 1860);
    s0 = fmaf(a.x, x24, s0);
    s1 = fmaf(a.y, x25, s1);
    const float al27 = a.z;
    x27 = (x27 - ((s0 + s1) + (s2 + s3))) - al27 * x26;
    Tu[3672 + c] = f2bf(x27 * su); Tw[3672 + c] = f2bf(x27 * sw); asm volatile("" ::: "memory");
    float x28 = fmaxf(0.0f, 1.0f - fabsf(cf - 28.0f));
    s0 = 0.f; s1 = 0.f; s2 = 0.f; s3 = 0.f;
    a = *(const LAS f32x4*)(Am + 1904);
    s0 = fmaf(a.x, x0, s0);
    s1 = fmaf(a.y, x1, s1);
    s2 = fmaf(a.z, x2, s2);
    s3 = fmaf(a.w, x3, s3);
    a = *(const LAS f32x4*)(Am + 1908);
    s0 = fmaf(a.x, x4, s0);
    s1 = fmaf(a.y, x5, s1);
    s2 = fmaf(a.z, x6, s2);
    s3 = fmaf(a.w, x7, s3);
    a = *(const LAS f32x4*)(Am + 1912);
    s0 = fmaf(a.x, x8, s0);
    s1 = fmaf(a.y, x9, s1);
    s2 = fmaf(a.z, x10, s2);
    s3 = fmaf(a.w, x11, s3);
    a = *(const LAS f32x4*)(Am + 1916);
    s0 = fmaf(a.x, x12, s0);
    s1 = fmaf(a.y, x13, s1);
    s2 = fmaf(a.z, x14, s2);
    s3 = fmaf(a.w, x15, s3);
    a = *(const LAS f32x4*)(Am + 1920);
    s0 = fmaf(a.x, x16, s0);
    s1 = fmaf(a.y, x17, s1);
    s2 = fmaf(a.z, x18, s2);
    s3 = fmaf(a.w, x19, s3);
    a = *(const LAS f32x4*)(Am + 1924);
    s0 = fmaf(a.x, x20, s0);
    s1 = fmaf(a.y, x21, s1);
    s2 = fmaf(a.z, x22, s2);
    s3 = fmaf(a.w, x23, s3);
    a = *(const LAS f32x4*)(Am + 1928);
    s0 = fmaf(a.x, x24, s0);
    s1 = fmaf(a.y, x25, s1);
    s2 = fmaf(a.z, x26, s2);
    const float al28 = a.w;
    x28 = (x28 - ((s0 + s1) + (s2 + s3))) - al28 * x27;
    Tu[3808 + c] = f2bf(x28 * su); Tw[3808 + c] = f2bf(x28 * sw); asm volatile("" ::: "memory");
    float x29 = fmaxf(0.0f, 1.0f - fabsf(cf - 29.0f));
    s0 = 0.f; s1 = 0.f; s2 = 0.f; s3 = 0.f;
    a = *(const LAS f32x4*)(Am + 1972);
    s0 = fmaf(a.x, x0, s0);
    s1 = fmaf(a.y, x1, s1);
    s2 = fmaf(a.z, x2, s2);
    s3 = fmaf(a.w, x3, s3);
    a = *(const LAS f32x4*)(Am + 1976);
    s0 = fmaf(a.x, x4, s0);
    s1 = fmaf(a.y, x5, s1);
    s2 = fmaf(a.z, x6, s2);
    s3 = fmaf(a.w, x7, s3);
    a = *(const LAS f32x4*)(Am + 1980);
    s0 = fmaf(a.x, x8, s0);
    s1 = fmaf(a.y, x9, s1);
    s2 = fmaf(a.z, x10, s2);
    s3 = fmaf(a.w, x11, s3);
    a = *(const LAS f32x4*)(Am + 1984);
    s0 = fmaf(a.x, x12, s0);
    s1 = fmaf(a.y, x13, s1);
    s2 = fmaf(a.z, x14, s2);
    s3 = fmaf(a.w, x15, s3);
    a = *(const LAS f32x4*)(Am + 1988);
    s0 = fmaf(a.x, x16, s0);
    s1 = fmaf(a.y, x17, s1);
    s2 = fmaf(a.z, x18, s2);
    s3 = fmaf(a.w, x19, s3);
    a = *(const LAS f32x4*)(Am + 1992);
    s0 = fmaf(a.x, x20, s0);
    s1 = fmaf(a.y, x21, s1);
    s2 = fmaf(a.z, x22, s2);
    s3 = fmaf(a.w, x23, s3);
    a = *(const LAS f32x4*)(Am + 1996);
    s0 = fmaf(a.x, x24, s0);
    s1 = fmaf(a.y, x25, s1);
    s2 = fmaf(a.z, x26, s2);
    s3 = fmaf(a.w, x27, s3);
    a = *(const LAS f32x4*)(Am + 2000);
    const float al29 = a.x;
    x29 = (x29 - ((s0 + s1) + (s2 + s3))) - al29 * x28;
    Tu[3944 + c] = f2bf(x29 * su); Tw[3944 + c] = f2bf(x29 * sw); asm volatile("" ::: "memory");
    float x30 = fmaxf(0.0f, 1.0f - fabsf(cf - 30.0f));
    s0 = 0.f; s1 = 0.f; s2 = 0.f; s3 = 0.f;
    a = *(const LAS f32x4*)(Am + 2040);
    s0 = fmaf(a.x, x0, s0);
    s1 = fmaf(a.y, x1, s1);
    s2 = fmaf(a.z, x2, s2);
    s3 = fmaf(a.w, x3, s3);
    a = *(const LAS f32x4*)(Am + 2044);
    s0 = fmaf(a.x, x4, s0);
    s1 = fmaf(a.y, x5, s1);
    s2 = fmaf(a.z, x6, s2);
    s3 = fmaf(a.w, x7, s3);
    a = *(const LAS f32x4*)(Am + 2048);
    s0 = fmaf(a.x, x8, s0);
    s1 = fmaf(a.y, x9, s1);
    s2 = fmaf(a.z, x10, s2);
    s3 = fmaf(a.w, x11, s3);
    a = *(const LAS f32x4*)(Am + 2052);
    s0 = fmaf(a.x, x12, s0);
    s1 = fmaf(a.y, x13, s1);
    s2 = fmaf(a.z, x14, s2);
    s3 = fmaf(a.w, x15, s3);
    a = *(const LAS f32x4*)(Am + 2056);
    s0 = fmaf(a.x, x16, s0);
    s1 = fmaf(a.y, x17, s1);
    s2 = fmaf(a.z, x18, s2);
    s3 = fmaf(a.w, x19, s3);
    a = *(const LAS f32x4*)(Am + 2060);
    s0 = fmaf(a.x, x20, s0);
    s1 = fmaf(a.y, x21, s1);
    s2 = fmaf(a.z, x22, s2);
    s3 = fmaf(a.w, x23, s3);
    a = *(const LAS f32x4*)(Am + 2064);
    s0 = fmaf(a.x, x24, s0);
    s1 = fmaf(a.y, x25, s1);
    s2 = fmaf(a.z, x26, s2);
    s3 = fmaf(a.w, x27, s3);
    a = *(const LAS f32x4*)(Am + 2068);
    s0 = fmaf(a.x, x28, s0);
    const float al30 = a.y;
    x30 = (x30 - ((s0 + s1) + (s2 + s3))) - al30 * x29;
    Tu[4080 + c] = f2bf(x30 * su); Tw[4080 + c] = f2bf(x30 * sw); asm volatile("" ::: "memory");
    float x31 = fmaxf(0.0f, 1.0f - fabsf(cf - 31.0f));
    s0 = 0.f; s1 = 0.f; s2 = 0.f; s3 = 0.f;
    a = *(const LAS f32x4*)(Am + 2108);
    s0 = fmaf(a.x, x0, s0);
    s1 = fmaf(a.y, x1, s1);
    s2 = fmaf(a.z, x2, s2);
    s3 = fmaf(a.w, x3, s3);
    a = *(const LAS f32x4*)(Am + 2112);
    s0 = fmaf(a.x, x4, s0);
    s1 = fmaf(a.y, x5, s1);
    s2 = fmaf(a.z, x6, s2);
    s3 = fmaf(a.w, x7, s3);
    a = *(const LAS f32x4*)(Am + 2116);
    s0 = fmaf(a.x, x8, s0);
    s1 = fmaf(a.y, x9, s1);
    s2 = fmaf(a.z, x10, s2);
    s3 = fmaf(a.w, x11, s3);
    a = *(const LAS f32x4*)(Am + 2120);
    s0 = fmaf(a.x, x12, s0);
    s1 = fmaf(a.y, x13, s1);
    s2 = fmaf(a.z, x14, s2);
    s3 = fmaf(a.w, x15, s3);
    a = *(const LAS f32x4*)(Am + 2124);
    s0 = fmaf(a.x, x16, s0);
    s1 = fmaf(a.y, x17, s1);
    s2 = fmaf(a.z, x18, s2);
    s3 = fmaf(a.w, x19, s3);
    a = *(const LAS f32x4*)(Am + 2128);
    s0 = fmaf(a.x, x20, s0);
    s1 = fmaf(a.y, x21, s1);
    s2 = fmaf(a.z, x22, s2);
    s3 = fmaf(a.w, x23, s3);
    a = *(const LAS f32x4*)(Am + 2132);
    s0 = fmaf(a.x, x24, s0);
    s1 = fmaf(a.y, x25, s1);
    s2 = fmaf(a.z, x26, s2);
    s3 = fmaf(a.w, x27, s3);
    a = *(const LAS f32x4*)(Am + 2136);
    s0 = fmaf(a.x, x28, s0);
    s1 = fmaf(a.y, x29, s1);
    const float al31 = a.z;
    x31 = (x31 - ((s0 + s1) + (s2 + s3))) - al31 * x30;
    Tu[4216 + c] = f2bf(x31 * su); Tw[4216 + c] = f2bf(x31 * sw); asm volatile("" ::: "memory");
    float x32 = fmaxf(0.0f, 1.0f - fabsf(cf - 32.0f));
    s0 = 0.f; s1 = 0.f; s2 = 0.f; s3 = 0.f;
    a = *(const LAS f32x4*)(Am + 2176);
    s0 = fmaf(a.x, x0, s0);
    s1 = fmaf(a.y, x1, s1);
    s2 = fmaf(a.z, x2, s2);
    s3 = fmaf(a.w, x3, s3);
    a = *(const LAS f32x4*)(Am + 2180);
    s0 = fmaf(a.x, x4, s0);
    s1 = fmaf(a.y, x5, s1);
    s2 = fmaf(a.z, x6, s2);
    s3 = fmaf(a.w, x7, s3);
    a = *(const LAS f32x4*)(Am + 2184);
    s0 = fmaf(a.x, x8, s0);
    s1 = fmaf(a.y, x9, s1);
    s2 = fmaf(a.z, x10, s2);
    s3 = fmaf(a.w, x11, s3);
    a = *(const LAS f32x4*)(Am + 2188);
    s0 = fmaf(a.x, x12, s0);
    s1 = fmaf(a.y, x13, s1);
    s2 = fmaf(a.z, x14, s2);
    s3 = fmaf(a.w, x15, s3);
    a = *(const LAS f32x4*)(Am + 2192);
    s0 = fmaf(a.x, x16, s0);
    s1 = fmaf(a.y, x17, s1);
    s2 = fmaf(a.z, x18, s2);
    s3 = fmaf(a.w, x19, s3);
    a = *(const LAS f32x4*)(Am + 2196);
    s0 = fmaf(a.x, x20, s0);
    s1 = fmaf(a.y, x21, s1);
    s2 = fmaf(a.z, x22, s2);
    s3 = fmaf(a.w, x23, s3);
    a = *(const LAS f32x4*)(Am + 2200);
    s0 = fmaf(a.x, x24, s0);
    s1 = fmaf(a.y, x25, s1);
    s2 = fmaf(a.z, x26, s2);
    s3 = fmaf(a.w, x27, s3);
    a = *(const LAS f32x4*)(Am + 2204);
    s0 = fmaf(a.x, x28, s0);
    s1 = fmaf(a.y, x29, s1);
    s2 = fmaf(a.z, x30, s2);
    const float al32 = a.w;
    x32 = (x32 - ((s0 + s1) + (s2 + s3))) - al32 * x31;
    Tu[4352 + c] = f2bf(x32 * su); Tw[4352 + c] = f2bf(x32 * sw); asm volatile("" ::: "memory");
    float x33 = fmaxf(0.0f, 1.0f - fabsf(cf - 33.0f));
    s0 = 0.f; s1 = 0.f; s2 = 0.f; s3 = 0.f;
    a = *(const LAS f32x4*)(Am + 2244);
    s0 = fmaf(a.x, x0, s0);
    s1 = fmaf(a.y, x1, s1);
    s2 = fmaf(a.z, x2, s2);
    s3 = fmaf(a.w, x3, s3);
    a = *(const LAS f32x4*)(Am + 2248);
    s0 = fmaf(a.x, x4, s0);
    s1 = fmaf(a.y, x5, s1);
    s2 = fmaf(a.z, x6, s2);
    s3 = fmaf(a.w, x7, s3);
    a = *(const LAS f32x4*)(Am + 2252);
    s0 = fmaf(a.x, x8, s0);
    s1 = fmaf(a.y, x9, s1);
    s2 = fmaf(a.z, x10, s2);
    s3 = fmaf(a.w, x11, s3);
    a = *(const LAS f32x4*)(Am + 2256);
    s0 = fmaf(a.x, x12, s0);
    s1 = fmaf(a.y, x13, s1);
    s2 = fmaf(a.z, x14, s2);
    s3 = fmaf(a.w, x15, s3);
    a = *(const LAS f32x4*)(Am + 2260);
    s0 = fmaf(a.x, x16, s0);
    s1 = fmaf(a.y, x17, s1);
    s2 = fmaf(a.z, x18, s2);
    s3 = fmaf(a.w, x19, s3);
    a = *(const LAS f32x4*)(Am + 2264);
    s0 = fmaf(a.x, x20, s0);
    s1 = fmaf(a.y, x21, s1);
    s2 = fmaf(a.z, x22, s2);
    s3 = fmaf(a.w, x23, s3);
    a = *(const LAS f32x4*)(Am + 2268);
    s0 = fmaf(a.x, x24, s0);
    s1 = fmaf(a.y, x25, s1);
    s2 = fmaf(a.z, x26, s2);
    s3 = fmaf(a.w, x27, s3);
    a = *(const LAS f32x4*)(Am + 2272);
    s0 = fmaf(a.x, x28, s0);
    s1 = fmaf(a.y, x29, s1);
    s2 = fmaf(a.z, x30, s2);
    s3 = fmaf(a.w, x31, s3);
    a = *(const LAS f32x4*)(Am + 2276);
    const float al33 = a.x;
    x33 = (x33 - ((s0 + s1) + (s2 + s3))) - al33 * x32;
    Tu[4488 + c] = f2bf(x33 * su); Tw[4488 + c] = f2bf(x33 * sw); asm volatile("" ::: "memory");
    float x34 = fmaxf(0.0f, 1.0f - fabsf(cf - 34.0f));
    s0 = 0.f; s1 = 0.f; s2 = 0.f; s3 = 0.f;
    a = *(const LAS f32x4*)(Am + 2312);
    s0 = fmaf(a.x, x0, s0);
    s1 = fmaf(a.y, x1, s1);
    s2 = fmaf(a.z, x2, s2);
    s3 = fmaf(a.w, x3, s3);
    a = *(const LAS f32x4*)(Am + 2316);
    s0 = fmaf(a.x, x4, s0);
    s1 = fmaf(a.y, x5, s1);
    s2 = fmaf(a.z, x6, s2);
    s3 = fmaf(a.w, x7, s3);
    a = *(const LAS f32x4*)(Am + 2320);
    s0 = fmaf(a.x, x8, s0);
    s1 = fmaf(a.y, x9, s1);
    s2 = fmaf(a.z, x10, s2);
    s3 = fmaf(a.w, x11, s3);
    a = *(const LAS f32x4*)(Am + 2324);
    s0 = fmaf(a.x, x12, s0);
    s1 = fmaf(a.y, x13, s1);
    s2 = fmaf(a.z, x14, s2);
    s3 = fmaf(a.w, x15, s3);
    a = *(const LAS f32x4*)(Am + 2328);
    s0 = fmaf(a.x, x16, s0);
    s1 = fmaf(a.y, x17, s1);
    s2 = fmaf(a.z, x18, s2);
    s3 = fmaf(a.w, x19, s3);
    a = *(const LAS f32x4*)(Am + 2332);
    s0 = fmaf(a.x, x20, s0);
    s1 = fmaf(a.y, x21, s1);
    s2 = fmaf(a.z, x22, s2);
    s3 = fmaf(a.w, x23, s3);
    a = *(const LAS f32x4*)(Am + 2336);
    s0 = fmaf(a.x, x24, s0);
    s1 = fmaf(a.y, x25, s1);
    s2 = fmaf(a.z, x26, s2);
    s3 = fmaf(a.w, x27, s3);
    a = *(const LAS f32x4*)(Am + 2340);
    s0 = fmaf(a.x, x28, s0);
    s1 = fmaf(a.y, x29, s1);
    s2 = fmaf(a.z, x30, s2);
    s3 = fmaf(a.w, x31, s3);
    a = *(const LAS f32x4*)(Am + 2344);
    s0 = fmaf(a.x, x32, s0);
    const float al34 = a.y;
    x34 = (x34 - ((s0 + s1) + (s2 + s3))) - al34 * x33;
    Tu[4624 + c] = f2bf(x34 * su); Tw[4624 + c] = f2bf(x34 * sw); asm volatile("" ::: "memory");
    float x35 = fmaxf(0.0f, 1.0f - fabsf(cf - 35.0f));
    s0 = 0.f; s1 = 0.f; s2 = 0.f; s3 = 0.f;
    a = *(const LAS f32x4*)(Am + 2380);
    s0 = fmaf(a.x, x0, s0);
    s1 = fmaf(a.y, x1, s1);
    s2 = fmaf(a.z, x2, s2);
    s3 = fmaf(a.w, x3, s3);
    a = *(const LAS f32x4*)(Am + 2384);
    s0 = fmaf(a.x, x4, s0);
    s1 = fmaf(a.y, x5, s1);
    s2 = fmaf(a.z, x6, s2);
    s3 = fmaf(a.w, x7, s3);
    a = *(const LAS f32x4*)(Am + 2388);
    s0 = fmaf(a.x, x8, s0);
    s1 = fmaf(a.y, x9, s1);
    s2 = fmaf(a.z, x10, s2);
    s3 = fmaf(a.w, x11, s3);
    a = *(const LAS f32x4*)(Am + 2392);
    s0 = fmaf(a.x, x12, s0);
    s1 = fmaf(a.y, x13, s1);
    s2 = fmaf(a.z, x14, s2);
    s3 = fmaf(a.w, x15, s3);
    a = *(const LAS f32x4*)(Am + 2396);
    s0 = fmaf(a.x, x16, s0);
    s1 = fmaf(a.y, x17, s1);
    s2 = fmaf(a.z, x18, s2);
    s3 = fmaf(a.w, x19, s3);
    a = *(const LAS f32x4*)(Am + 2400);
    s0 = fmaf(a.x, x20, s0);
    s1 = fmaf(a.y, x21, s1);
    s2 = fmaf(a.z, x22, s2);
    s3 = fmaf(a.w, x23, s3);
    a = *(const LAS f32x4*)(Am + 2404);
    s0 = fmaf(a.x, x24, s0);
    s1 = fmaf(a.y, x25, s1);
    s2 = fmaf(a.z, x26, s2);
    s3 = fmaf(a.w, x27, s3);
    a = *(const LAS f32x4*)(Am + 2408);
    s0 = fmaf(a.x, x28, s0);
    s1 = fmaf(a.y, x29, s1);
    s2 = fmaf(a.z, x30, s2);
    s3 = fmaf(a.w, x31, s3);
    a = *(const LAS f32x4*)(Am + 2412);
    s0 = fmaf(a.x, x32, s0);
    s1 = fmaf(a.y, x33, s1);
    const float al35 = a.z;
    x35 = (x35 - ((s0 + s1) + (s2 + s3))) - al35 * x34;
    Tu[4760 + c] = f2bf(x35 * su); Tw[4760 + c] = f2bf(x35 * sw); asm volatile("" ::: "memory");
    float x36 = fmaxf(0.0f, 1.0f - fabsf(cf - 36.0f));
    s0 = 0.f; s1 = 0.f; s2 = 0.f; s3 = 0.f;
    a = *(const LAS f32x4*)(Am + 2448);
    s0 = fmaf(a.x, x0, s0);
    s1 = fmaf(a.y, x1, s1);
    s2 = fmaf(a.z, x2, s2);
    s3 = fmaf(a.w, x3, s3);
    a = *(const LAS f32x4*)(Am + 2452);
    s0 = fmaf(a.x, x4, s0);
    s1 = fmaf(a.y, x5, s1);
    s2 = fmaf(a.z, x6, s2);
    s3 = fmaf(a.w, x7, s3);
    a = *(const LAS f32x4*)(Am + 2456);
    s0 = fmaf(a.x, x8, s0);
    s1 = fmaf(a.y, x9, s1);
    s2 = fmaf(a.z, x10, s2);
    s3 = fmaf(a.w, x11, s3);
    a = *(const LAS f32x4*)(Am + 2460);
    s0 = fmaf(a.x, x12, s0);
    s1 = fmaf(a.y, x13, s1);
    s2 = fmaf(a.z, x14, s2);
    s3 = fmaf(a.w, x15, s3);
    a = *(const LAS f32x4*)(Am + 2464);
    s0 = fmaf(a.x, x16, s0);
    s1 = fmaf(a.y, x17, s1);
    s2 = fmaf(a.z, x18, s2);
    s3 = fmaf(a.w, x19, s3);
    a = *(const LAS f32x4*)(Am + 2468);
    s0 = fmaf(a.x, x20, s0);
    s1 = fmaf(a.y, x21, s1);
    s2 = fmaf(a.z, x22, s2);
    s3 = fmaf(a.w, x23, s3);
    a = *(const LAS f32x4*)(Am + 2472);
    s0 = fmaf(a.x, x24, s0);
    s1 = fmaf(a.y, x25, s1);
    s2 = fmaf(a.z, x26, s2);
    s3 = fmaf(a.w, x27, s3);
    a = *(const LAS f32x4*)(Am + 2476);
    s0 = fmaf(a.x, x28, s0);
    s1 = fmaf(a.y, x29, s1);
    s2 = fmaf(a.z, x30, s2);
    s3 = fmaf(a.w, x31, s3);
    a = *(const LAS f32x4*)(Am + 2480);
    s0 = fmaf(a.x, x32, s0);
    s1 = fmaf(a.y, x33, s1);
    s2 = fmaf(a.z, x34, s2);
    const float al36 = a.w;
    x36 = (x36 - ((s0 + s1) + (s2 + s3))) - al36 * x35;
    Tu[4896 + c] = f2bf(x36 * su); Tw[4896 + c] = f2bf(x36 * sw); asm volatile("" ::: "memory");
    float x37 = fmaxf(0.0f, 1.0f - fabsf(cf - 37.0f));
    s0 = 0.f; s1 = 0.f; s2 = 0.f; s3 = 0.f;
    a = *(const LAS f32x4*)(Am + 2516);
    s0 = fmaf(a.x, x0, s0);
    s1 = fmaf(a.y, x1, s1);
    s2 = fmaf(a.z, x2, s2);
    s3 = fmaf(a.w, x3, s3);
    a = *(const LAS f32x4*)(Am + 2520);
    s0 = fmaf(a.x, x4, s0);
    s1 = fmaf(a.y, x5, s1);
    s2 = fmaf(a.z, x6, s2);
    s3 = fmaf(a.w, x7, s3);
    a = *(const LAS f32x4*)(Am + 2524);
    s0 = fmaf(a.x, x8, s0);
    s1 = fmaf(a.y, x9, s1);
    s2 = fmaf(a.z, x10, s2);
    s3 = fmaf(a.w, x11, s3);
    a = *(const LAS f32x4*)(Am + 2528);
    s0 = fmaf(a.x, x12, s0);
    s1 = fmaf(a.y, x13, s1);
    s2 = fmaf(a.z, x14, s2);
    s3 = fmaf(a.w, x15, s3);
    a = *(const LAS f32x4*)(Am + 2532);
    s0 = fmaf(a.x, x16, s0);
    s1 = fmaf(a.y, x17, s1);
    s2 = fmaf(a.z, x18, s2);
    s3 = fmaf(a.w, x19, s3);
    a = *(const LAS f32x4*)(Am + 2536);
    s0 = fmaf(a.x, x20, s0);
    s1 = fmaf(a.y, x21, s1);
    s2 = fmaf(a.z, x22, s2);
    s3 = fmaf(a.w, x23, s3);
    a = *(const LAS f32x4*)(Am + 2540);
    s0 = fmaf(a.x, x24, s0);
    s1 = fmaf(a.y, x25, s1);
    s2 = fmaf(a.z, x26, s2);
    s3 = fmaf(a.w, x27, s3);
    a = *(const LAS f32x4*)(Am + 2544);
    s0 = fmaf(a.x, x28, s0);
    s1 = fmaf(a.y, x29, s1);
    s2 = fmaf(a.z, x30, s2);
    s3 = fmaf(a.w, x31, s3);
    a = *(const LAS f32x4*)(Am + 2548);
    s0 = fmaf(a.x, x32, s0);
    s1 = fmaf(a.y, x33, s1);
    s2 = fmaf(a.z, x34, s2);
    s3 = fmaf(a.w, x35, s3);
    a = *(const LAS f32x4*)(Am + 2552);
    const float al37 = a.x;
    x37 = (x37 - ((s0 + s1) + (s2 + s3))) - al37 * x36;
    Tu[5032 + c] = f2bf(x37 * su); Tw[5032 + c] = f2bf(x37 * sw); asm volatile("" ::: "memory");
    float x38 = fmaxf(0.0f, 1.0f - fabsf(cf - 38.0f));
    s0 = 0.f; s1 = 0.f; s2 = 0.f; s3 = 0.f;
    a = *(const LAS f32x4*)(Am + 2584);
    s0 = fmaf(a.x, x0, s0);
    s1 = fmaf(a.y, x1, s1);
    s2 = fmaf(a.z, x2, s2);
    s3 = fmaf(a.w, x3, s3);
    a = *(const LAS f32x4*)(Am + 2588);
    s0 = fmaf(a.x, x4, s0);
    s1 = fmaf(a.y, x5, s1);
    s2 = fmaf(a.z, x6, s2);
    s3 = fmaf(a.w, x7, s3);
    a = *(const LAS f32x4*)(Am + 2592);
    s0 = fmaf(a.x, x8, s0);
    s1 = fmaf(a.y, x9, s1);
    s2 = fmaf(a.z, x10, s2);
    s3 = fmaf(a.w, x11, s3);
    a = *(const LAS f32x4*)(Am + 2596);
    s0 = fmaf(a.x, x12, s0);
    s1 = fmaf(a.y, x13, s1);
    s2 = fmaf(a.z, x14, s2);
    s3 = fmaf(a.w, x15, s3);
    a = *(const LAS f32x4*)(Am + 2600);
    s0 = fmaf(a.x, x16, s0);
    s1 = fmaf(a.y, x17, s1);
    s2 = fmaf(a.z, x18, s2);
    s3 = fmaf(a.w, x19, s3);
    a = *(const LAS f32x4*)(Am + 2604);
    s0 = fmaf(a.x, x20, s0);
    s1 = fmaf(a.y, x21, s1);
    s2 = fmaf(a.z, x22, s2);
    s3 = fmaf(a.w, x23, s3);
    a = *(const LAS f32x4*)(Am + 2608);
    s0 = fmaf(a.x, x24, s0);
    s1 = fmaf(a.y, x25, s1);
    s2 = fmaf(a.z, x26, s2);
    s3 = fmaf(a.w, x27, s3);
    a = *(const LAS f32x4*)(Am + 2612);
    s0 = fmaf(a.x, x28, s0);
    s1 = fmaf(a.y, x29, s1);
    s2 = fmaf(a.z, x30, s2);
    s3 = fmaf(a.w, x31, s3);
    a = *(const LAS f32x4*)(Am + 2616);
    s0 = fmaf(a.x, x32, s0);
    s1 = fmaf(a.y, x33, s1);
    s2 = fmaf(a.z, x34, s2);
    s3 = fmaf(a.w, x35, s3);
    a = *(const LAS f32x4*)(Am + 2620);
    s0 = fmaf(a.x, x36, s0);
    const float al38 = a.y;
    x38 = (x38 - ((s0 + s1) + (s2 + s3))) - al38 * x37;
    Tu[5168 + c] = f2bf(x38 * su); Tw[5168 + c] = f2bf(x38 * sw); asm volatile("" ::: "memory");
    float x39 = fmaxf(0.0f, 1.0f - fabsf(cf - 39.0f));
    s0 = 0.f; s1 = 0.f; s2 = 0.f; s3 = 0.f;
    a = *(const LAS f32x4*)(Am + 2652);
    s0 = fmaf(a.x, x0, s0);
    s1 = fmaf(a.y, x1, s1);
    s2 = fmaf(a.z, x2, s2);
    s3 = fmaf(a.w, x3, s3);
    a = *(const LAS f32x4*)(Am + 2656);
    s0 = fmaf(a.x, x4, s0);
    s1 = fmaf(a.y, x5, s1);
    s2 = fmaf(a.z, x6, s2);
    s3 = fmaf(a.w, x7, s3);
    a = *(const LAS f32x4*)(Am + 2660);
    s0 = fmaf(a.x, x8, s0);
    s1 = fmaf(a.y, x9, s1);
    s2 = fmaf(a.z, x10, s2);
    s3 = fmaf(a.w, x11, s3);
    a = *(const LAS f32x4*)(Am + 2664);
    s0 = fmaf(a.x, x12, s0);
    s1 = fmaf(a.y, x13, s1);
    s2 = fmaf(a.z, x14, s2);
    s3 = fmaf(a.w, x15, s3);
    a = *(const LAS f32x4*)(Am + 2668);
    s0 = fmaf(a.x, x16, s0);
    s1 = fmaf(a.y, x17, s1);
    s2 = fmaf(a.z, x18, s2);
    s3 = fmaf(a.w, x19, s3);
    a = *(const LAS f32x4*)(Am + 2672);
    s0 = fmaf(a.x, x20, s0);
    s1 = fmaf(a.y, x21, s1);
    s2 = fmaf(a.z, x22, s2);
    s3 = fmaf(a.w, x23, s3);
    a = *(const LAS f32x4*)(Am + 2676);
    s0 = fmaf(a.x, x24, s0);
    s1 = fmaf(a.y, x25, s1);
    s2 = fmaf(a.z, x26, s2);
    s3 = fmaf(a.w, x27, s3);
    a = *(const LAS f32x4*)(Am + 2680);
    s0 = fmaf(a.x, x28, s0);
    s1 = fmaf(a.y, x29, s1);
    s2 = fmaf(a.z, x30, s2);
    s3 = fmaf(a.w, x31, s3);
    a = *(const LAS f32x4*)(Am + 2684);
    s0 = fmaf(a.x, x32, s0);
    s1 = fmaf(a.y, x33, s1);
    s2 = fmaf(a.z, x34, s2);
    s3 = fmaf(a.w, x35, s3);
    a = *(const LAS f32x4*)(Am + 2688);
    s0 = fmaf(a.x, x36, s0);
    s1 = fmaf(a.y, x37, s1);
    const float al39 = a.z;
    x39 = (x39 - ((s0 + s1) + (s2 + s3))) - al39 * x38;
    Tu[5304 + c] = f2bf(x39 * su); Tw[5304 + c] = f2bf(x39 * sw); asm volatile("" ::: "memory");
    float x40 = fmaxf(0.0f, 1.0f - fabsf(cf - 40.0f));
    s0 = 0.f; s1 = 0.f; s2 = 0.f; s3 = 0.f;
    a = *(const LAS f32x4*)(Am + 2720);
    s0 = fmaf(a.x, x0, s0);
    s1 = fmaf(a.y, x1, s1);
    s2 = fmaf(a.z, x2, s2);
    s3 = fmaf(a.w, x3, s3);
    a = *(const LAS f32x4*)(Am + 2724);
    s0 = fmaf(a.x, x4, s0);
    s1 = fmaf(a.y, x5, s1);
    s2 = fmaf(a.z, x6, s2);
    s3 = fmaf(a.w, x7, s3);
    a = *(const LAS f32x4*)(Am + 2728);
    s0 = fmaf(a.x, x8, s0);
    s1 = fmaf(a.y, x9, s1);
    s2 = fmaf(a.z, x10, s2);
    s3 = fmaf(a.w, x11, s3);
    a = *(const LAS f32x4*)(Am + 2732);
    s0 = fmaf(a.x, x12, s0);
    s1 = fmaf(a.y, x13, s1);
    s2 = fmaf(a.z, x14, s2);
    s3 = fmaf(a.w, x15, s3);
    a = *(const LAS f32x4*)(Am + 2736);
    s0 = fmaf(a.x, x16, s0);
    s1 = fmaf(a.y, x17, s1);
    s2 = fmaf(a.z, x18, s2);
    s3 = fmaf(a.w, x19, s3);
    a = *(const LAS f32x4*)(Am + 2740);
    s0 = fmaf(a.x, x20, s0);
    s1 = fmaf(a.y, x21, s1);
    s2 = fmaf(a.z, x22, s2);
    s3 = fmaf(a.w, x23, s3);
    a = *(const LAS f32x4*)(Am + 2744);
    s0 = fmaf(a.x, x24, s0);
    s1 = fmaf(a.y, x25, s1);
    s2 = fmaf(a.z, x26, s2);
    s3 = fmaf(a.w, x27, s3);
    a = *(const LAS f32x4*)(Am + 2748);
    s0 = fmaf(a.x, x28, s0);
    s1 = fmaf(a.y, x29, s1);
    s2 = fmaf(a.z, x30, s2);
    s3 = fmaf(a.w, x31, s3);
    a = *(const LAS f32x4*)(Am + 2752);
    s0 = fmaf(a.x, x32, s0);
    s1 = fmaf(a.y, x33, s1);
    s2 = fmaf(a.z, x34, s2);
    s3 = fmaf(a.w, x35, s3);
    a = *(const LAS f32x4*)(Am + 2756);
    s0 = fmaf(a.x, x36, s0);
    s1 = fmaf(a.y, x37, s1);
    s2 = fmaf(a.z, x38, s2);
    const float al40 = a.w;
    x40 = (x40 - ((s0 + s1) + (s2 + s3))) - al40 * x39;
    Tu[5440 + c] = f2bf(x40 * su); Tw[5440 + c] = f2bf(x40 * sw); asm volatile("" ::: "memory");
    float x41 = fmaxf(0.0f, 1.0f - fabsf(cf - 41.0f));
    s0 = 0.f; s1 = 0.f; s2 = 0.f; s3 = 0.f;
    a = *(const LAS f32x4*)(Am + 2788);
    s0 = fmaf(a.x, x0, s0);
    s1 = fmaf(a.y, x1, s1);
    s2 = fmaf(a.z, x2, s2);
    s3 = fmaf(a.w, x3, s3);
    a = *(const LAS f32x4*)(Am + 2792);
    s0 = fmaf(a.x, x4, s0);
    s1 = fmaf(a.y, x5, s1);
    s2 = fmaf(a.z, x6, s2);
    s3 = fmaf(a.w, x7, s3);
    a = *(const LAS f32x4*)(Am + 2796);
    s0 = fmaf(a.x, x8, s0);
    s1 = fmaf(a.y, x9, s1);
    s2 = fmaf(a.z, x10, s2);
    s3 = fmaf(a.w, x11, s3);
    a = *(const LAS f32x4*)(Am + 2800);
    s0 = fmaf(a.x, x12, s0);
    s1 = fmaf(a.y, x13, s1);
    s2 = fmaf(a.z, x14, s2);
    s3 = fmaf(a.w, x15, s3);
    a = *(const LAS f32x4*)(Am + 2804);
    s0 = fmaf(a.x, x16, s0);
    s1 = fmaf(a.y, x17, s1);
    s2 = fmaf(a.z, x18, s2);
    s3 = fmaf(a.w, x19, s3);
    a = *(const LAS f32x4*)(Am + 2808);
    s0 = fmaf(a.x, x20, s0);
    s1 = fmaf(a.y, x21, s1);
    s2 = fmaf(a.z, x22, s2);
    s3 = fmaf(a.w, x23, s3);
    a = *(const LAS f32x4*)(Am + 2812);
    s0 = fmaf(a.x, x24, s0);
    s1 = fmaf(a.y, x25, s1);
    s2 = fmaf(a.z, x26, s2);
    s3 = fmaf(a.w, x27, s3);
    a = *(const LAS f32x4*)(Am + 2816);
    s0 = fmaf(a.x, x28, s0);
    s1 = fmaf(a.y, x29, s1);
    s2 = fmaf(a.z, x30, s2);
    s3 = fmaf(a.w, x31, s3);
    a = *(const LAS f32x4*)(Am + 2820);
    s0 = fmaf(a.x, x32, s0);
    s1 = fmaf(a.y, x33, s1);
    s2 = fmaf(a.z, x34, s2);
    s3 = fmaf(a.w, x35, s3);
    a = *(const LAS f32x4*)(Am + 2824);
    s0 = fmaf(a.x, x36, s0);
    s1 = fmaf(a.y, x37, s1);
    s2 = fmaf(a.z, x38, s2);
    s3 = fmaf(a.w, x39, s3);
    a = *(const LAS f32x4*)(Am + 2828);
    const float al41 = a.x;
    x41 = (x41 - ((s0 + s1) + (s2 + s3))) - al41 * x40;
    Tu[5576 + c] = f2bf(x41 * su); Tw[5576 + c] = f2bf(x41 * sw); asm volatile("" ::: "memory");
    float x42 = fmaxf(0.0f, 1.0f - fabsf(cf - 42.0f));
    s0 = 0.f; s1 = 0.f; s2 = 0.f; s3 = 0.f;
    a = *(const LAS f32x4*)(Am + 2856);
    s0 = fmaf(a.x, x0, s0);
    s1 = fmaf(a.y, x1, s1);
    s2 = fmaf(a.z, x2, s2);
    s3 = fmaf(a.w, x3, s3);
    a = *(const LAS f32x4*)(Am + 2860);
    s0 = fmaf(a.x, x4, s0);
    s1 = fmaf(a.y, x5, s1);
    s2 = fmaf(a.z, x6, s2);
    s3 = fmaf(a.w, x7, s3);
    a = *(const LAS f32x4*)(Am + 2864);
    s0 = fmaf(a.x, x8, s0);
    s1 = fmaf(a.y, x9, s1);
    s2 = fmaf(a.z, x10, s2);
    s3 = fmaf(a.w, x11, s3);
    a = *(const LAS f32x4*)(Am + 2868);
    s0 = fmaf(a.x, x12, s0);
    s1 = fmaf(a.y, x13, s1);
    s2 = fmaf(a.z, x14, s2);
    s3 = fmaf(a.w, x15, s3);
    a = *(const LAS f32x4*)(Am + 2872);
    s0 = fmaf(a.x, x16, s0);
    s1 = fmaf(a.y, x17, s1);
    s2 = fmaf(a.z, x18, s2);
    s3 = fmaf(a.w, x19, s3);
    a = *(const LAS f32x4*)(Am + 2876);
    s0 = fmaf(a.x, x20, s0);
    s1 = fmaf(a.y, x21, s1);
    s2 = fmaf(a.z, x22, s2);
    s3 = fmaf(a.w, x23, s3);
    a = *(const LAS f32x4*)(Am + 2880);
    s0 = fmaf(a.x, x24, s0);
    s1 = fmaf(a.y, x25, s1);
    s2 = fmaf(a.z, x26, s2);
    s3 = fmaf(a.w, x27, s3);
    a = *(const LAS f32x4*)(Am + 2884);
    s0 = fmaf(a.x, x28, s0);
    s1 = fmaf(a.y, x29, s1);
    s2 = fmaf(a.z, x30, s2);
    s3 = fmaf(a.w, x31, s3);
    a = *(const LAS f32x4*)(Am + 2888);
    s0 = fmaf(a.x, x32, s0);
    s1 = fmaf(a.y, x33, s1);
    s2 = fmaf(a.z, x34, s2);
    s3 = fmaf(a.w, x35, s3);
    a = *(const LAS f32x4*)(Am + 2892);
    s0 = fmaf(a.x, x36, s0);
    s1 = fmaf(a.y, x37, s1);
    s2 = fmaf(a.z, x38, s2);
    s3 = fmaf(a.w, x39, s3);
    a = *(const LAS f32x4*)(Am + 2896);
    s0 = fmaf(a.x, x40, s0);
    const float al42 = a.y;
    x42 = (x42 - ((s0 + s1) + (s2 + s3))) - al42 * x41;
    Tu[5712 + c] = f2bf(x42 * su); Tw[5712 + c] = f2bf(x42 * sw); asm volatile("" ::: "memory");
    float x43 = fmaxf(0.0f, 1.0f - fabsf(cf - 43.0f));
    s0 = 0.f; s1 = 0.f; s2 = 0.f; s3 = 0.f;
    a = *(const LAS f32x4*)(Am + 2924);
    s0 = fmaf(a.x, x0, s0);
    s1 = fmaf(a.y, x1, s1);
    s2 = fmaf(a.z, x2, s2);
    s3 = fmaf(a.w, x3, s3);
    a = *(const LAS f32x4*)(Am + 2928);
    s0 = fmaf(a.x, x4, s0);
    s1 = fmaf(a.y, x5, s1);
    s2 = fmaf(a.z, x6, s2);
    s3 = fmaf(a.w, x7, s3);
    a = *(const LAS f32x4*)(Am + 2932);
    s0 = fmaf(a.x, x8, s0);
    s1 = fmaf(a.y, x9, s1);
    s2 = fmaf(a.z, x10, s2);
    s3 = fmaf(a.w, x11, s3);
    a = *(const LAS f32x4*)(Am + 2936);
    s0 = fmaf(a.x, x12, s0);
    s1 = fmaf(a.y, x13, s1);
    s2 = fmaf(a.z, x14, s2);
    s3 = fmaf(a.w, x15, s3);
    a = *(const LAS f32x4*)(Am + 2940);
    s0 = fmaf(a.x, x16, s0);
    s1 = fmaf(a.y, x17, s1);
    s2 = fmaf(a.z, x18, s2);
    s3 = fmaf(a.w, x19, s3);
    a = *(const LAS f32x4*)(Am + 2944);
    s0 = fmaf(a.x, x20, s0);
    s1 = fmaf(a.y, x21, s1);
    s2 = fmaf(a.z, x22, s2);
    s3 = fmaf(a.w, x23, s3);
    a = *(const LAS f32x4*)(Am + 2948);
    s0 = fmaf(a.x, x24, s0);
    s1 = fmaf(a.y, x25, s1);
    s2 = fmaf(a.z, x26, s2);
    s3 = fmaf(a.w, x27, s3);
    a = *(const LAS f32x4*)(Am + 2952);
    s0 = fmaf(a.x, x28, s0);
    s1 = fmaf(a.y, x29, s1);
    s2 = fmaf(a.z, x30, s2);
    s3 = fmaf(a.w, x31, s3);
    a = *(const LAS f32x4*)(Am + 2956);
    s0 = fmaf(a.x, x32, s0);
    s1 = fmaf(a.y, x33, s1);
    s2 = fmaf(a.z, x34, s2);
    s3 = fmaf(a.w, x35, s3);
    a = *(const LAS f32x4*)(Am + 2960);
    s0 = fmaf(a.x, x36, s0);
    s1 = fmaf(a.y, x37, s1);
    s2 = fmaf(a.z, x38, s2);
    s3 = fmaf(a.w, x39, s3);
    a = *(const LAS f32x4*)(Am + 2964);
    s0 = fmaf(a.x, x40, s0);
    s1 = fmaf(a.y, x41, s1);
    const float al43 = a.z;
    x43 = (x43 - ((s0 + s1) + (s2 + s3))) - al43 * x42;
    Tu[5848 + c] = f2bf(x43 * su); Tw[5848 + c] = f2bf(x43 * sw); asm volatile("" ::: "memory");
    float x44 = fmaxf(0.0f, 1.0f - fabsf(cf - 44.0f));
    s0 = 0.f; s1 = 0.f; s2 = 0.f; s3 = 0.f;
    a = *(const LAS f32x4*)(Am + 2992);
    s0 = fmaf(a.x, x0, s0);
    s1 = fmaf(a.y, x1, s1);
    s2 = fmaf(a.z, x2, s2);
    s3 = fmaf(a.w, x3, s3);
    a = *(const LAS f32x4*)(Am + 2996);
    s0 = fmaf(a.x, x4, s0);
    s1 = fmaf(a.y, x5, s1);
    s2 = fmaf(a.z, x6, s2);
    s3 = fmaf(a.w, x7, s3);
    a = *(const LAS f32x4*)(Am + 3000);
    s0 = fmaf(a.x, x8, s0);
    s1 = fmaf(a.y, x9, s1);
    s2 = fmaf(a.z, x10, s2);
    s3 = fmaf(a.w, x11, s3);
    a = *(const LAS f32x4*)(Am + 3004);
    s0 = fmaf(a.x, x12, s0);
    s1 = fmaf(a.y, x13, s1);
    s2 = fmaf(a.z, x14, s2);
    s3 = fmaf(a.w, x15, s3);
    a = *(const LAS f32x4*)(Am + 3008);
    s0 = fmaf(a.x, x16, s0);
    s1 = fmaf(a.y, x17, s1);
    s2 = fmaf(a.z, x18, s2);
    s3 = fmaf(a.w, x19, s3);
    a = *(const LAS f32x4*)(Am + 3012);
    s0 = fmaf(a.x, x20, s0);
    s1 = fmaf(a.y, x21, s1);
    s2 = fmaf(a.z, x22, s2);
    s3 = fmaf(a.w, x23, s3);
    a = *(const LAS f32x4*)(Am + 3016);
    s0 = fmaf(a.x, x24, s0);
    s1 = fmaf(a.y, x25, s1);
    s2 = fmaf(a.z, x26, s2);
    s3 = fmaf(a.w, x27, s3);
    a = *(const LAS f32x4*)(Am + 3020);
    s0 = fmaf(a.x, x28, s0);
    s1 = fmaf(a.y, x29, s1);
    s2 = fmaf(a.z, x30, s2);
    s3 = fmaf(a.w, x31, s3);
    a = *(const LAS f32x4*)(Am + 3024);
    s0 = fmaf(a.x, x32, s0);
    s1 = fmaf(a.y, x33, s1);
    s2 = fmaf(a.z, x34, s2);
    s3 = fmaf(a.w, x35, s3);
    a = *(const LAS f32x4*)(Am + 3028);
    s0 = fmaf(a.x, x36, s0);
    s1 = fmaf(a.y, x37, s1);
    s2 = fmaf(a.z, x38, s2);
    s3 = fmaf(a.w, x39, s3);
    a = *(const LAS f32x4*)(Am + 3032);
    s0 = fmaf(a.x, x40, s0);
    s1 = fmaf(a.y, x41, s1);
    s2 = fmaf(a.z, x42, s2);
    const float al44 = a.w;
    x44 = (x44 - ((s0 + s1) + (s2 + s3))) - al44 * x43;
    Tu[5984 + c] = f2bf(x44 * su); Tw[5984 + c] = f2bf(x44 * sw); asm volatile("" ::: "memory");
    float x45 = fmaxf(0.0f, 1.0f - fabsf(cf - 45.0f));
    s0 = 0.f; s1 = 0.f; s2 = 0.f; s3 = 0.f;
    a = *(const LAS f32x4*)(Am + 3060);
    s0 = fmaf(a.x, x0, s0);
    s1 = fmaf(a.y, x1, s1);
    s2 = fmaf(a.z, x2, s2);
    s3 = fmaf(a.w, x3, s3);
    a = *(const LAS f32x4*)(Am + 3064);
    s0 = fmaf(a.x, x4, s0);
    s1 = fmaf(a.y, x5, s1);
    s2 = fmaf(a.z, x6, s2);
    s3 = fmaf(a.w, x7, s3);
    a = *(const LAS f32x4*)(Am + 3068);
    s0 = fmaf(a.x, x8, s0);
    s1 = fmaf(a.y, x9, s1);
    s2 = fmaf(a.z, x10, s2);
    s3 = fmaf(a.w, x11, s3);
    a = *(const LAS f32x4*)(Am + 3072);
    s0 = fmaf(a.x, x12, s0);
    s1 = fmaf(a.y, x13, s1);
    s2 = fmaf(a.z, x14, s2);
    s3 = fmaf(a.w, x15, s3);
    a = *(const LAS f32x4*)(Am + 3076);
    s0 = fmaf(a.x, x16, s0);
    s1 = fmaf(a.y, x17, s1);
    s2 = fmaf(a.z, x18, s2);
    s3 = fmaf(a.w, x19, s3);
    a = *(const LAS f32x4*)(Am + 3080);
    s0 = fmaf(a.x, x20, s0);
    s1 = fmaf(a.y, x21, s1);
    s2 = fmaf(a.z, x22, s2);
    s3 = fmaf(a.w, x23, s3);
    a = *(const LAS f32x4*)(Am + 3084);
    s0 = fmaf(a.x, x24, s0);
    s1 = fmaf(a.y, x25, s1);
    s2 = fmaf(a.z, x26, s2);
    s3 = fmaf(a.w, x27, s3);
    a = *(const LAS f32x4*)(Am + 3088);
    s0 = fmaf(a.x, x28, s0);
    s1 = fmaf(a.y, x29, s1);
    s2 = fmaf(a.z, x30, s2);
    s3 = fmaf(a.w, x31, s3);
    a = *(const LAS f32x4*)(Am + 3092);
    s0 = fmaf(a.x, x32, s0);
    s1 = fmaf(a.y, x33, s1);
    s2 = fmaf(a.z, x34, s2);
    s3 = fmaf(a.w, x35, s3);
    a = *(const LAS f32x4*)(Am + 3096);
    s0 = fmaf(a.x, x36, s0);
    s1 = fmaf(a.y, x37, s1);
    s2 = fmaf(a.z, x38, s2);
    s3 = fmaf(a.w, x39, s3);
    a = *(const LAS f32x4*)(Am + 3100);
    s0 = fmaf(a.x, x40, s0);
    s1 = fmaf(a.y, x41, s1);
    s2 = fmaf(a.z, x42, s2);
    s3 = fmaf(a.w, x43, s3);
    a = *(const LAS f32x4*)(Am + 3104);
    const float al45 = a.x;
    x45 = (x45 - ((s0 + s1) + (s2 + s3))) - al45 * x44;
    Tu[6120 + c] = f2bf(x45 * su); Tw[6120 + c] = f2bf(x45 * sw); asm volatile("" ::: "memory");
    float x46 = fmaxf(0.0f, 1.0f - fabsf(cf - 46.0f));
    s0 = 0.f; s1 = 0.f; s2 = 0.f; s3 = 0.f;
    a = *(const LAS f32x4*)(Am + 3128);
    s0 = fmaf(a.x, x0, s0);
    s1 = fmaf(a.y, x1, s1);
    s2 = fmaf(a.z, x2, s2);
    s3 = fmaf(a.w, x3, s3);
    a = *(const LAS f32x4*)(Am + 3132);
    s0 = fmaf(a.x, x4, s0);
    s1 = fmaf(a.y, x5, s1);
    s2 = fmaf(a.z, x6, s2);
    s3 = fmaf(a.w, x7, s3);
    a = *(const LAS f32x4*)(Am + 3136);
    s0 = fmaf(a.x, x8, s0);
    s1 = fmaf(a.y, x9, s1);
    s2 = fmaf(a.z, x10, s2);
    s3 = fmaf(a.w, x11, s3);
    a = *(const LAS f32x4*)(Am + 3140);
    s0 = fmaf(a.x, x12, s0);
    s1 = fmaf(a.y, x13, s1);
    s2 = fmaf(a.z, x14, s2);
    s3 = fmaf(a.w, x15, s3);
    a = *(const LAS f32x4*)(Am + 3144);
    s0 = fmaf(a.x, x16, s0);
    s1 = fmaf(a.y, x17, s1);
    s2 = fmaf(a.z, x18, s2);
    s3 = fmaf(a.w, x19, s3);
    a = *(const LAS f32x4*)(Am + 3148);
    s0 = fmaf(a.x, x20, s0);
    s1 = fmaf(a.y, x21, s1);
    s2 = fmaf(a.z, x22, s2);
    s3 = fmaf(a.w, x23, s3);
    a = *(const LAS f32x4*)(Am + 3152);
    s0 = fmaf(a.x, x24, s0);
    s1 = fmaf(a.y, x25, s1);
    s2 = fmaf(a.z, x26, s2);
    s3 = fmaf(a.w, x27, s3);
    a = *(const LAS f32x4*)(Am + 3156);
    s0 = fmaf(a.x, x28, s0);
    s1 = fmaf(a.y, x29, s1);
    s2 = fmaf(a.z, x30, s2);
    s3 = fmaf(a.w, x31, s3);
    a = *(const LAS f32x4*)(Am + 3160);
    s0 = fmaf(a.x, x32, s0);
    s1 = fmaf(a.y, x33, s1);
    s2 = fmaf(a.z, x34, s2);
    s3 = fmaf(a.w, x35, s3);
    a = *(const LAS f32x4*)(Am + 3164);
    s0 = fmaf(a.x, x36, s0);
    s1 = fmaf(a.y, x37, s1);
    s2 = fmaf(a.z, x38, s2);
    s3 = fmaf(a.w, x39, s3);
    a = *(const LAS f32x4*)(Am + 3168);
    s0 = fmaf(a.x, x40, s0);
    s1 = fmaf(a.y, x41, s1);
    s2 = fmaf(a.z, x42, s2);
    s3 = fmaf(a.w, x43, s3);
    a = *(const LAS f32x4*)(Am + 3172);
    s0 = fmaf(a.x, x44, s0);
    const float al46 = a.y;
    x46 = (x46 - ((s0 + s1) + (s2 + s3))) - al46 * x45;
    Tu[6256 + c] = f2bf(x46 * su); Tw[6256 + c] = f2bf(x46 * sw); asm volatile("" ::: "memory");
    float x47 = fmaxf(0.0f, 1.0f - fabsf(cf - 47.0f));
    s0 = 0.f; s1 = 0.f; s2 = 0.f; s3 = 0.f;
    a = *(const LAS f32x4*)(Am + 3196);
    s0 = fmaf(a.x, x0, s0);
    s1 = fmaf(a.y, x1, s1);
    s2 = fmaf(a.z, x2, s2);
    s3 = fmaf(a.w, x3, s3);
    a = *(const LAS f32x4*)(Am + 3200);
    s0 = fmaf(a.x, x4, s0);
    s1 = fmaf(a.y, x5, s1);
    s2 = fmaf(a.z, x6, s2);
    s3 = fmaf(a.w, x7, s3);
    a = *(const LAS f32x4*)(Am + 3204);
    s0 = fmaf(a.x, x8, s0);
    s1 = fmaf(a.y, x9, s1);
    s2 = fmaf(a.z, x10, s2);
    s3 = fmaf(a.w, x11, s3);
    a = *(const LAS f32x4*)(Am + 3208);
    s0 = fmaf(a.x, x12, s0);
    s1 = fmaf(a.y, x13, s1);
    s2 = fmaf(a.z, x14, s2);
    s3 = fmaf(a.w, x15, s3);
    a = *(const LAS f32x4*)(Am + 3212);
    s0 = fmaf(a.x, x16, s0);
    s1 = fmaf(a.y, x17, s1);
    s2 = fmaf(a.z, x18, s2);
    s3 = fmaf(a.w, x19, s3);
    a = *(const LAS f32x4*)(Am + 3216);
    s0 = fmaf(a.x, x20, s0);
    s1 = fmaf(a.y, x21, s1);
    s2 = fmaf(a.z, x22, s2);
    s3 = fmaf(a.w, x23, s3);
    a = *(const LAS f32x4*)(Am + 3220);
    s0 = fmaf(a.x, x24, s0);
    s1 = fmaf(a.y, x25, s1);
    s2 = fmaf(a.z, x26, s2);
    s3 = fmaf(a.w, x27, s3);
    a = *(const LAS f32x4*)(Am + 3224);
    s0 = fmaf(a.x, x28, s0);
    s1 = fmaf(a.y, x29, s1);
    s2 = fmaf(a.z, x30, s2);
    s3 = fmaf(a.w, x31, s3);
    a = *(const LAS f32x4*)(Am + 3228);
    s0 = fmaf(a.x, x32, s0);
    s1 = fmaf(a.y, x33, s1);
    s2 = fmaf(a.z, x34, s2);
    s3 = fmaf(a.w, x35, s3);
    a = *(const LAS f32x4*)(Am + 3232);
    s0 = fmaf(a.x, x36, s0);
    s1 = fmaf(a.y, x37, s1);
    s2 = fmaf(a.z, x38, s2);
    s3 = fmaf(a.w, x39, s3);
    a = *(const LAS f32x4*)(Am + 3236);
    s0 = fmaf(a.x, x40, s0);
    s1 = fmaf(a.y, x41, s1);
    s2 = fmaf(a.z, x42, s2);
    s3 = fmaf(a.w, x43, s3);
    a = *(const LAS f32x4*)(Am + 3240);
    s0 = fmaf(a.x, x44, s0);
    s1 = fmaf(a.y, x45, s1);
    const float al47 = a.z;
    x47 = (x47 - ((s0 + s1) + (s2 + s3))) - al47 * x46;
    Tu[6392 + c] = f2bf(x47 * su); Tw[6392 + c] = f2bf(x47 * sw); asm volatile("" ::: "memory");
    float x48 = fmaxf(0.0f, 1.0f - fabsf(cf - 48.0f));
    s0 = 0.f; s1 = 0.f; s2 = 0.f; s3 = 0.f;
    a = *(const LAS f32x4*)(Am + 3264);
    s0 = fmaf(a.x, x0, s0);
    s1 = fmaf(a.y, x1, s1);
    s2 = fmaf(a.z, x2, s2);
    s3 = fmaf(a.w, x3, s3);
    a = *(const LAS f32x4*)(Am + 3268);
    s0 = fmaf(a.x, x4, s0);
    s1 = fmaf(a.y, x5, s1);
    s2 = fmaf(a.z, x6, s2);
    s3 = fmaf(a.w, x7, s3);
    a = *(const LAS f32x4*)(Am + 3272);
    s0 = fmaf(a.x, x8, s0);
    s1 = fmaf(a.y, x9, s1);
    s2 = fmaf(a.z, x10, s2);
    s3 = fmaf(a.w, x11, s3);
    a = *(const LAS f32x4*)(Am + 3276);
    s0 = fmaf(a.x, x12, s0);
    s1 = fmaf(a.y, x13, s1);
    s2 = fmaf(a.z, x14, s2);
    s3 = fmaf(a.w, x15, s3);
    a = *(const LAS f32x4*)(Am + 3280);
    s0 = fmaf(a.x, x16, s0);
    s1 = fmaf(a.y, x17, s1);
    s2 = fmaf(a.z, x18, s2);
    s3 = fmaf(a.w, x19, s3);
    a = *(const LAS f32x4*)(Am + 3284);
    s0 = fmaf(a.x, x20, s0);
    s1 = fmaf(a.y, x21, s1);
    s2 = fmaf(a.z, x22, s2);
    s3 = fmaf(a.w, x23, s3);
    a = *(const LAS f32x4*)(Am + 3288);
    s0 = fmaf(a.x, x24, s0);
    s1 = fmaf(a.y, x25, s1);
    s2 = fmaf(a.z, x26, s2);
    s3 = fmaf(a.w, x27, s3);
    a = *(const LAS f32x4*)(Am + 3292);
    s0 = fmaf(a.x, x28, s0);
    s1 = fmaf(a.y, x29, s1);
    s2 = fmaf(a.z, x30, s2);
    s3 = fmaf(a.w, x31, s3);
    a = *(const LAS f32x4*)(Am + 3296);
    s0 = fmaf(a.x, x32, s0);
    s1 = fmaf(a.y, x33, s1);
    s2 = fmaf(a.z, x34, s2);
    s3 = fmaf(a.w, x35, s3);
    a = *(const LAS f32x4*)(Am + 3300);
    s0 = fmaf(a.x, x36, s0);
    s1 = fmaf(a.y, x37, s1);
    s2 = fmaf(a.z, x38, s2);
    s3 = fmaf(a.w, x39, s3);
    a = *(const LAS f32x4*)(Am + 3304);
    s0 = fmaf(a.x, x40, s0);
    s1 = fmaf(a.y, x41, s1);
    s2 = fmaf(a.z, x42, s2);
    s3 = fmaf(a.w, x43, s3);
    a = *(const LAS f32x4*)(Am + 3308);
    s0 = fmaf(a.x, x44, s0);
    s1 = fmaf(a.y, x45, s1);
    s2 = fmaf(a.z, x46, s2);
    const float al48 = a.w;
    x48 = (x48 - ((s0 + s1) + (s2 + s3))) - al48 * x47;
    Tu[6528 + c] = f2bf(x48 * su); Tw[6528 + c] = f2bf(x48 * sw); asm volatile("" ::: "memory");
    float x49 = fmaxf(0.0f, 1.0f - fabsf(cf - 49.0f));
    s0 = 0.f; s1 = 0.f; s2 = 0.f; s3 = 0.f;
    a = *(const LAS f32x4*)(Am + 3332);
    s0 = fmaf(a.x, x0, s0);
    s1 = fmaf(a.y, x1, s1);
    s2 = fmaf(a.z, x2, s2);
    s3 = fmaf(a.w, x3, s3);
    a = *(const LAS f32x4*)(Am + 3336);
    s0 = fmaf(a.x, x4, s0);
    s1 = fmaf(a.y, x5, s1);
    s2 = fmaf(a.z, x6, s2);
    s3 = fmaf(a.w, x7, s3);
    a = *(const LAS f32x4*)(Am + 3340);
    s0 = fmaf(a.x, x8, s0);
    s1 = fmaf(a.y, x9, s1);
    s2 = fmaf(a.z, x10, s2);
    s3 = fmaf(a.w, x11, s3);
    a = *(const LAS f32x4*)(Am + 3344);
    s0 = fmaf(a.x, x12, s0);
    s1 = fmaf(a.y, x13, s1);
    s2 = fmaf(a.z, x14, s2);
    s3 = fmaf(a.w, x15, s3);
    a = *(const LAS f32x4*)(Am + 3348);
    s0 = fmaf(a.x, x16, s0);
    s1 = fmaf(a.y, x17, s1);
    s2 = fmaf(a.z, x18, s2);
    s3 = fmaf(a.w, x19, s3);
    a = *(const LAS f32x4*)(Am + 3352);
    s0 = fmaf(a.x, x20, s0);
    s1 = fmaf(a.y, x21, s1);
    s2 = fmaf(a.z, x22, s2);
    s3 = fmaf(a.w, x23, s3);
    a = *(const LAS f32x4*)(Am + 3356);
    s0 = fmaf(a.x, x24, s0);
    s1 = fmaf(a.y, x25, s1);
    s2 = fmaf(a.z, x26, s2);
    s3 = fmaf(a.w, x27, s3);
    a = *(const LAS f32x4*)(Am + 3360);
    s0 = fmaf(a.x, x28, s0);
    s1 = fmaf(a.y, x29, s1);
    s2 = fmaf(a.z, x30, s2);
    s3 = fmaf(a.w, x31, s3);
    a = *(const LAS f32x4*)(Am + 3364);
    s0 = fmaf(a.x, x32, s0);
    s1 = fmaf(a.y, x33, s1);
    s2 = fmaf(a.z, x34, s2);
    s3 = fmaf(a.w, x35, s3);
    a = *(const LAS f32x4*)(Am + 3368);
    s0 = fmaf(a.x, x36, s0);
    s1 = fmaf(a.y, x37, s1);
    s2 = fmaf(a.z, x38, s2);
    s3 = fmaf(a.w, x39, s3);
    a = *(const LAS f32x4*)(Am + 3372);
    s0 = fmaf(a.x, x40, s0);
    s1 = fmaf(a.y, x41, s1);
    s2 = fmaf(a.z, x42, s2);
    s3 = fmaf(a.w, x43, s3);
    a = *(const LAS f32x4*)(Am + 3376);
    s0 = fmaf(a.x, x44, s0);
    s1 = fmaf(a.y, x45, s1);
    s2 = fmaf(a.z, x46, s2);
    s3 = fmaf(a.w, x47, s3);
    a = *(const LAS f32x4*)(Am + 3380);
    const float al49 = a.x;
    x49 = (x49 - ((s0 + s1) + (s2 + s3))) - al49 * x48;
    Tu[6664 + c] = f2bf(x49 * su); Tw[6664 + c] = f2bf(x49 * sw); asm volatile("" ::: "memory");
    float x50 = fmaxf(0.0f, 1.0f - fabsf(cf - 50.0f));
    s0 = 0.f; s1 = 0.f; s2 = 0.f; s3 = 0.f;
    a = *(const LAS f32x4*)(Am + 3400);
    s0 = fmaf(a.x, x0, s0);
    s1 = fmaf(a.y, x1, s1);
    s2 = fmaf(a.z, x2, s2);
    s3 = fmaf(a.w, x3, s3);
    a = *(const LAS f32x4*)(Am + 3404);
    s0 = fmaf(a.x, x4, s0);
    s1 = fmaf(a.y, x5, s1);
    s2 = fmaf(a.z, x6, s2);
    s3 = fmaf(a.w, x7, s3);
    a = *(const LAS f32x4*)(Am + 3408);
    s0 = fmaf(a.x, x8, s0);
    s1 = fmaf(a.y, x9, s1);
    s2 = fmaf(a.z, x10, s2);
    s3 = fmaf(a.w, x11, s3);
    a = *(const LAS f32x4*)(Am + 3412);
    s0 = fmaf(a.x, x12, s0);
    s1 = fmaf(a.y, x13, s1);
    s2 = fmaf(a.z, x14, s2);
    s3 = fmaf(a.w, x15, s3);
    a = *(const LAS f32x4*)(Am + 3416);
    s0 = fmaf(a.x, x16, s0);
    s1 = fmaf(a.y, x17, s1);
    s2 = fmaf(a.z, x18, s2);
    s3 = fmaf(a.w, x19, s3);
    a = *(const LAS f32x4*)(Am + 3420);
    s0 = fmaf(a.x, x20, s0);
    s1 = fmaf(a.y, x21, s1);
    s2 = fmaf(a.z, x22, s2);
    s3 = fmaf(a.w, x23, s3);
    a = *(const LAS f32x4*)(Am + 3424);
    s0 = fmaf(a.x, x24, s0);
    s1 = fmaf(a.y, x25, s1);
    s2 = fmaf(a.z, x26, s2);
    s3 = fmaf(a.w, x27, s3);
    a = *(const LAS f32x4*)(Am + 3428);
    s0 = fmaf(a.x, x28, s0);
    s1 = fmaf(a.y, x29, s1);
    s2 = fmaf(a.z, x30, s2);
    s3 = fmaf(a.w, x31, s3);
    a = *(const LAS f32x4*)(Am + 3432);
    s0 = fmaf(a.x, x32, s0);
    s1 = fmaf(a.y, x33, s1);
    s2 = fmaf(a.z, x34, s2);
    s3 = fmaf(a.w, x35, s3);
    a = *(const LAS f32x4*)(Am + 3436);
    s0 = fmaf(a.x, x36, s0);
    s1 = fmaf(a.y, x37, s1);
    s2 = fmaf(a.z, x38, s2);
    s3 = fmaf(a.w, x39, s3);
    a = *(const LAS f32x4*)(Am + 3440);
    s0 = fmaf(a.x, x40, s0);
    s1 = fmaf(a.y, x41, s1);
    s2 = fmaf(a.z, x42, s2);
    s3 = fmaf(a.w, x43, s3);
    a = *(const LAS f32x4*)(Am + 3444);
    s0 = fmaf(a.x, x44, s0);
    s1 = fmaf(a.y, x45, s1);
    s2 = fmaf(a.z, x46, s2);
    s3 = fmaf(a.w, x47, s3);
    a = *(const LAS f32x4*)(Am + 3448);
    s0 = fmaf(a.x, x48, s0);
    const float al50 = a.y;
    x50 = (x50 - ((s0 + s1) + (s2 + s3))) - al50 * x49;
    Tu[6800 + c] = f2bf(x50 * su); Tw[6800 + c] = f2bf(x50 * sw); asm volatile("" ::: "memory");
    float x51 = fmaxf(0.0f, 1.0f - fabsf(cf - 51.0f));
    s0 = 0.f; s1 = 0.f; s2 = 0.f; s3 = 0.f;
    a = *(const LAS f32x4*)(Am + 3468);
    s0 = fmaf(a.x, x0, s0);
    s1 = fmaf(a.y, x1, s1);
    s2 = fmaf(a.z, x2, s2);
    s3 = fmaf(a.w, x3, s3);
    a = *(const LAS f32x4*)(Am + 3472);
    s0 = fmaf(a.x, x4, s0);
    s1 = fmaf(a.y, x5, s1);
    s2 = fmaf(a.z, x6, s2);
    s3 = fmaf(a.w, x7, s3);
    a = *(const LAS f32x4*)(Am + 3476);
    s0 = fmaf(a.x, x8, s0);
    s1 = fmaf(a.y, x9, s1);
    s2 = fmaf(a.z, x10, s2);
    s3 = fmaf(a.w, x11, s3);
    a = *(const LAS f32x4*)(Am + 3480);
    s0 = fmaf(a.x, x12, s0);
    s1 = fmaf(a.y, x13, s1);
    s2 = fmaf(a.z, x14, s2);
    s3 = fmaf(a.w, x15, s3);
    a = *(const LAS f32x4*)(Am + 3484);
    s0 = fmaf(a.x, x16, s0);
    s1 = fmaf(a.y, x17, s1);
    s2 = fmaf(a.z, x18, s2);
    s3 = fmaf(a.w, x19, s3);
    a = *(const LAS f32x4*)(Am + 3488);
    s0 = fmaf(a.x, x20, s0);
    s1 = fmaf(a.y, x21, s1);
    s2 = fmaf(a.z, x22, s2);
    s3 = fmaf(a.w, x23, s3);
    a = *(const LAS f32x4*)(Am + 3492);
    s0 = fmaf(a.x, x24, s0);
    s1 = fmaf(a.y, x25, s1);
    s2 = fmaf(a.z, x26, s2);
    s3 = fmaf(a.w, x27, s3);
    a = *(const LAS f32x4*)(Am + 3496);
    s0 = fmaf(a.x, x28, s0);
    s1 = fmaf(a.y, x29, s1);
    s2 = fmaf(a.z, x30, s2);
    s3 = fmaf(a.w, x31, s3);
    a = *(const LAS f32x4*)(Am + 3500);
    s0 = fmaf(a.x, x32, s0);
    s1 = fmaf(a.y, x33, s1);
    s2 = fmaf(a.z, x34, s2);
    s3 = fmaf(a.w, x35, s3);
    a = *(const LAS f32x4*)(Am + 3504);
    s0 = fmaf(a.x, x36, s0);
    s1 = fmaf(a.y, x37, s1);
    s2 = fmaf(a.z, x38, s2);
    s3 = fmaf(a.w, x39, s3);
    a = *(const LAS f32x4*)(Am + 3508);
    s0 = fmaf(a.x, x40, s0);
    s1 = fmaf(a.y, x41, s1);
    s2 = fmaf(a.z, x42, s2);
    s3 = fmaf(a.w, x43, s3);
    a = *(const LAS f32x4*)(Am + 3512);
    s0 = fmaf(a.x, x44, s0);
    s1 = fmaf(a.y, x45, s1);
    s2 = fmaf(a.z, x46, s2);
    s3 = fmaf(a.w, x47, s3);
    a = *(const LAS f32x4*)(Am + 3516);
    s0 = fmaf(a.x, x48, s0);
    s1 = fmaf(a.y, x49, s1);
    const float al51 = a.z;
    x51 = (x51 - ((s0 + s1) + (s2 + s3))) - al51 * x50;
    Tu[6936 + c] = f2bf(x51 * su); Tw[6936 + c] = f2bf(x51 * sw); asm volatile("" ::: "memory");
    float x52 = fmaxf(0.0f, 1.0f - fabsf(cf - 52.0f));
    s0 = 0.f; s1 = 0.f; s2 = 0.f; s3 = 0.f;
    a = *(const LAS f32x4*)(Am + 3536);
    s0 = fmaf(a.x, x0, s0);
    s1 = fmaf(a.y, x1, s1);
    s2 = fmaf(a.z, x2, s2);
    s3 = fmaf(a.w, x3, s3);
    a = *(const LAS f32x4*)(Am + 3540);
    s0 = fmaf(a.x, x4, s0);
    s1 = fmaf(a.y, x5, s1);
    s2 = fmaf(a.z, x6, s2);
    s3 = fmaf(a.w, x7, s3);
    a = *(const LAS f32x4*)(Am + 3544);
    s0 = fmaf(a.x, x8, s0);
    s1 = fmaf(a.y, x9, s1);
    s2 = fmaf(a.z, x10, s2);
    s3 = fmaf(a.w, x11, s3);
    a = *(const LAS f32x4*)(Am + 3548);
    s0 = fmaf(a.x, x12, s0);
    s1 = fmaf(a.y, x13, s1);
    s2 = fmaf(a.z, x14, s2);
    s3 = fmaf(a.w, x15, s3);
    a = *(const LAS f32x4*)(Am + 3552);
    s0 = fmaf(a.x, x16, s0);
    s1 = fmaf(a.y, x17, s1);
    s2 = fmaf(a.z, x18, s2);
    s3 = fmaf(a.w, x19, s3);
    a = *(const LAS f32x4*)(Am + 3556);
    s0 = fmaf(a.x, x20, s0);
    s1 = fmaf(a.y, x21, s1);
    s2 = fmaf(a.z, x22, s2);
    s3 = fmaf(a.w, x23, s3);
    a = *(const LAS f32x4*)(Am + 3560);
    s0 = fmaf(a.x, x24, s0);
    s1 = fmaf(a.y, x25, s1);
    s2 = fmaf(a.z, x26, s2);
    s3 = fmaf(a.w, x27, s3);
    a = *(const LAS f32x4*)(Am + 3564);
    s0 = fmaf(a.x, x28, s0);
    s1 = fmaf(a.y, x29, s1);
    s2 = fmaf(a.z, x30, s2);
    s3 = fmaf(a.w, x31, s3);
    a = *(const LAS f32x4*)(Am + 3568);
    s0 = fmaf(a.x, x32, s0);
    s1 = fmaf(a.y, x33, s1);
    s2 = fmaf(a.z, x34, s2);
    s3 = fmaf(a.w, x35, s3);
    a = *(const LAS f32x4*)(Am + 3572);
    s0 = fmaf(a.x, x36, s0);
    s1 = fmaf(a.y, x37, s1);
    s2 = fmaf(a.z, x38, s2);
    s3 = fmaf(a.w, x39, s3);
    a = *(const LAS f32x4*)(Am + 3576);
    s0 = fmaf(a.x, x40, s0);
    s1 = fmaf(a.y, x41, s1);
    s2 = fmaf(a.z, x42, s2);
    s3 = fmaf(a.w, x43, s3);
    a = *(const LAS f32x4*)(Am + 3580);
    s0 = fmaf(a.x, x44, s0);
    s1 = fmaf(a.y, x45, s1);
    s2 = fmaf(a.z, x46, s2);
    s3 = fmaf(a.w, x47, s3);
    a = *(const LAS f32x4*)(Am + 3584);
    s0 = fmaf(a.x, x48, s0);
    s1 = fmaf(a.y, x49, s1);
    s2 = fmaf(a.z, x50, s2);
    const float al52 = a.w;
    x52 = (x52 - ((s0 + s1) + (s2 + s3))) - al52 * x51;
    Tu[7072 + c] = f2bf(x52 * su); Tw[7072 + c] = f2bf(x52 * sw); asm volatile("" ::: "memory");
    float x53 = fmaxf(0.0f, 1.0f - fabsf(cf - 53.0f));
    s0 = 0.f; s1 = 0.f; s2 = 0.f; s3 = 0.f;
    a = *(const LAS f32x4*)(Am + 3604);
    s0 = fmaf(a.x, x0, s0);
    s1 = fmaf(a.y, x1, s1);
    s2 = fmaf(a.z, x2, s2);
    s3 = fmaf(a.w, x3, s3);
    a = *(const LAS f32x4*)(Am + 3608);
    s0 = fmaf(a.x, x4, s0);
    s1 = fmaf(a.y, x5, s1);
    s2 = fmaf(a.z, x6, s2);
    s3 = fmaf(a.w, x7, s3);
    a = *(const LAS f32x4*)(Am + 3612);
    s0 = fmaf(a.x, x8, s0);
    s1 = fmaf(a.y, x9, s1);
    s2 = fmaf(a.z, x10, s2);
    s3 = fmaf(a.w, x11, s3);
    a = *(const LAS f32x4*)(Am + 3616);
    s0 = fmaf(a.x, x12, s0);
    s1 = fmaf(a.y, x13, s1);
    s2 = fmaf(a.z, x14, s2);
    s3 = fmaf(a.w, x15, s3);
    a = *(const LAS f32x4*)(Am + 3620);
    s0 = fmaf(a.x, x16, s0);
    s1 = fmaf(a.y, x17, s1);
    s2 = fmaf(a.z, x18, s2);
    s3 = fmaf(a.w, x19, s3);
    a = *(const LAS f32x4*)(Am + 3624);
    s0 = fmaf(a.x, x20, s0);
    s1 = fmaf(a.y, x21, s1);
    s2 = fmaf(a.z, x22, s2);
    s3 = fmaf(a.w, x23, s3);
    a = *(const LAS f32x4*)(Am + 3628);
    s0 = fmaf(a.x, x24, s0);
    s1 = fmaf(a.y, x25, s1);
    s2 = fmaf(a.z, x26, s2);
    s3 = fmaf(a.w, x27, s3);
    a = *(const LAS f32x4*)(Am + 3632);
    s0 = fmaf(a.x, x28, s0);
    s1 = fmaf(a.y, x29, s1);
    s2 = fmaf(a.z, x30, s2);
    s3 = fmaf(a.w, x31, s3);
    a = *(const LAS f32x4*)(Am + 3636);
    s0 = fmaf(a.x, x32, s0);
    s1 = fmaf(a.y, x33, s1);
    s2 = fmaf(a.z, x34, s2);
    s3 = fmaf(a.w, x35, s3);
    a = *(const LAS f32x4*)(Am + 3640);
    s0 = fmaf(a.x, x36, s0);
    s1 = fmaf(a.y, x37, s1);
    s2 = fmaf(a.z, x38, s2);
    s3 = fmaf(a.w, x39, s3);
    a = *(const LAS f32x4*)(Am + 3644);
    s0 = fmaf(a.x, x40, s0);
    s1 = fmaf(a.y, x41, s1);
    s2 = fmaf(a.z, x42, s2);
    s3 = fmaf(a.w, x43, s3);
    a = *(const LAS f32x4*)(Am + 3648);
    s0 = fmaf(a.x, x44, s0);
    s1 = fmaf(a.y, x45, s1);
    s2 = fmaf(a.z, x46, s2);
    s3 = fmaf(a.w, x47, s3);
    a = *(const LAS f32x4*)(Am + 3652);
    s0 = fmaf(a.x, x48, s0);
    s1 = fmaf(a.y, x49, s1);
    s2 = fmaf(a.z, x50, s2);
    s3 = fmaf(a.w, x51, s3);
    a = *(const LAS f32x4*)(Am + 3656);
    const float al53 = a.x;
    x53 = (x53 - ((s0 + s1) + (s2 + s3))) - al53 * x52;
    Tu[7208 + c] = f2bf(x53 * su); Tw[7208 + c] = f2bf(x53 * sw); asm volatile("" ::: "memory");
    float x54 = fmaxf(0.0f, 1.0f - fabsf(cf - 54.0f));
    s0 = 0.f; s1 = 0.f; s2 = 0.f; s3 = 0.f;
    a = *(const LAS f32x4*)(Am + 3672);
    s0 = fmaf(a.x, x0, s0);
    s1 = fmaf(a.y, x1, s1);
    s2 = fmaf(a.z, x2, s2);
    s3 = fmaf(a.w, x3, s3);
    a = *(const LAS f32x4*)(Am + 3676);
    s0 = fmaf(a.x, x4, s0);
    s1 = fmaf(a.y, x5, s1);
    s2 = fmaf(a.z, x6, s2);
    s3 = fmaf(a.w, x7, s3);
    a = *(const LAS f32x4*)(Am + 3680);
    s0 = fmaf(a.x, x8, s0);
    s1 = fmaf(a.y, x9, s1);
    s2 = fmaf(a.z, x10, s2);
    s3 = fmaf(a.w, x11, s3);
    a = *(const LAS f32x4*)(Am + 3684);
    s0 = fmaf(a.x, x12, s0);
    s1 = fmaf(a.y, x13, s1);
    s2 = fmaf(a.z, x14, s2);
    s3 = fmaf(a.w, x15, s3);
    a = *(const LAS f32x4*)(Am + 3688);
    s0 = fmaf(a.x, x16, s0);
    s1 = fmaf(a.y, x17, s1);
    s2 = fmaf(a.z, x18, s2);
    s3 = fmaf(a.w, x19, s3);
    a = *(const LAS f32x4*)(Am + 3692);
    s0 = fmaf(a.x, x20, s0);
    s1 = fmaf(a.y, x21, s1);
    s2 = fmaf(a.z, x22, s2);
    s3 = fmaf(a.w, x23, s3);
    a = *(const LAS f32x4*)(Am + 3696);
    s0 = fmaf(a.x, x24, s0);
    s1 = fmaf(a.y, x25, s1);
    s2 = fmaf(a.z, x26, s2);
    s3 = fmaf(a.w, x27, s3);
    a = *(const LAS f32x4*)(Am + 3700);
    s0 = fmaf(a.x, x28, s0);
    s1 = fmaf(a.y, x29, s1);
    s2 = fmaf(a.z, x30, s2);
    s3 = fmaf(a.w, x31, s3);
    a = *(const LAS f32x4*)(Am + 3704);
    s0 = fmaf(a.x, x32, s0);
    s1 = fmaf(a.y, x33, s1);
    s2 = fmaf(a.z, x34, s2);
    s3 = fmaf(a.w, x35, s3);
    a = *(const LAS f32x4*)(Am + 3708);
    s0 = fmaf(a.x, x36, s0);
    s1 = fmaf(a.y, x37, s1);
    s2 = fmaf(a.z, x38, s2);
    s3 = fmaf(a.w, x39, s3);
    a = *(const LAS f32x4*)(Am + 3712);
    s0 = fmaf(a.x, x40, s0);
    s1 = fmaf(a.y, x41, s1);
    s2 = fmaf(a.z, x42, s2);
    s3 = fmaf(a.w, x43, s3);
    a = *(const LAS f32x4*)(Am + 3716);
    s0 = fmaf(a.x, x44, s0);
    s1 = fmaf(a.y, x45, s1);
    s2 = fmaf(a.z, x46, s2);
    s3 = fmaf(a.w, x47, s3);
    a = *(const LAS f32x4*)(Am + 3720);
    s0 = fmaf(a.x, x48, s0);
    s1 = fmaf(a.y, x49, s1);
    s2 = fmaf(a.z, x50, s2);
    s3 = fmaf(a.w, x51, s3);
    a = *(const LAS f32x4*)(Am + 3724);
    s0 = fmaf(a.x, x52, s0);
    const float al54 = a.y;
    x54 = (x54 - ((s0 + s1) + (s2 + s3))) - al54 * x53;
    Tu[7344 + c] = f2bf(x54 * su); Tw[7344 + c] = f2bf(x54 * sw); asm volatile("" ::: "memory");
    float x55 = fmaxf(0.0f, 1.0f - fabsf(cf - 55.0f));
    s0 = 0.f; s1 = 0.f; s2 = 0.f; s3 = 0.f;
    a = *(const LAS f32x4*)(Am + 3740);
    s0 = fmaf(a.x, x0, s0);
    s1 = fmaf(a.y, x1, s1);
    s2 = fmaf(a.z, x2, s2);
    s3 = fmaf(a.w, x3, s3);
    a = *(const LAS f32x4*)(Am + 3744);
    s0 = fmaf(a.x, x4, s0);
    s1 = fmaf(a.y, x5, s1);
    s2 = fmaf(a.z, x6, s2);
    s3 = fmaf(a.w, x7, s3);
    a = *(const LAS f32x4*)(Am + 3748);
    s0 = fmaf(a.x, x8, s0);
    s1 = fmaf(a.y, x9, s1);
    s2 = fmaf(a.z, x10, s2);
    s3 = fmaf(a.w, x11, s3);
    a = *(const LAS f32x4*)(Am + 3752);
    s0 = fmaf(a.x, x12, s0);
    s1 = fmaf(a.y, x13, s1);
    s2 = fmaf(a.z, x14, s2);
    s3 = fmaf(a.w, x15, s3);
    a = *(const LAS f32x4*)(Am + 3756);
    s0 = fmaf(a.x, x16, s0);
    s1 = fmaf(a.y, x17, s1);
    s2 = fmaf(a.z, x18, s2);
    s3 = fmaf(a.w, x19, s3);
    a = *(const LAS f32x4*)(Am + 3760);
    s0 = fmaf(a.x, x20, s0);
    s1 = fmaf(a.y, x21, s1);
    s2 = fmaf(a.z, x22, s2);
    s3 = fmaf(a.w, x23, s3);
    a = *(const LAS f32x4*)(Am + 3764);
    s0 = fmaf(a.x, x24, s0);
    s1 = fmaf(a.y, x25, s1);
    s2 = fmaf(a.z, x26, s2);
    s3 = fmaf(a.w, x27, s3);
    a = *(const LAS f32x4*)(Am + 3768);
    s0 = fmaf(a.x, x28, s0);
    s1 = fmaf(a.y, x29, s1);
    s2 = fmaf(a.z, x30, s2);
    s3 = fmaf(a.w, x31, s3);
    a = *(const LAS f32x4*)(Am + 3772);
    s0 = fmaf(a.x, x32, s0);
    s1 = fmaf(a.y, x33, s1);
    s2 = fmaf(a.z, x34, s2);
    s3 = fmaf(a.w, x35, s3);
    a = *(const LAS f32x4*)(Am + 3776);
    s0 = fmaf(a.x, x36, s0);
    s1 = fmaf(a.y, x37, s1);
    s2 = fmaf(a.z, x38, s2);
    s3 = fmaf(a.w, x39, s3);
    a = *(const LAS f32x4*)(Am + 3780);
    s0 = fmaf(a.x, x40, s0);
    s1 = fmaf(a.y, x41, s1);
    s2 = fmaf(a.z, x42, s2);
    s3 = fmaf(a.w, x43, s3);
    a = *(const LAS f32x4*)(Am + 3784);
    s0 = fmaf(a.x, x44, s0);
    s1 = fmaf(a.y, x45, s1);
    s2 = fmaf(a.z, x46, s2);
    s3 = fmaf(a.w, x47, s3);
    a = *(const LAS f32x4*)(Am + 3788);
    s0 = fmaf(a.x, x48, s0);
    s1 = fmaf(a.y, x49, s1);
    s2 = fmaf(a.z, x50, s2);
    s3 = fmaf(a.w, x51, s3);
    a = *(const LAS f32x4*)(Am + 3792);
    s0 = fmaf(a.x, x52, s0);
    s1 = fmaf(a.y, x53, s1);
    const float al55 = a.z;
    x55 = (x55 - ((s0 + s1) + (s2 + s3))) - al55 * x54;
    Tu[7480 + c] = f2bf(x55 * su); Tw[7480 + c] = f2bf(x55 * sw); asm volatile("" ::: "memory");
    float x56 = fmaxf(0.0f, 1.0f - fabsf(cf - 56.0f));
    s0 = 0.f; s1 = 0.f; s2 = 0.f; s3 = 0.f;
    a = *(const LAS f32x4*)(Am + 3808);
    s0 = fmaf(a.x, x0, s0);
    s1 = fmaf(a.y, x1, s1);
    s2 = fmaf(a.z, x2, s2);
    s3 = fmaf(a.w, x3, s3);
    a = *(const LAS f32x4*)(Am + 3812);
    s0 = fmaf(a.x, x4, s0);
    s1 = fmaf(a.y, x5, s1);
    s2 = fmaf(a.z, x6, s2);
    s3 = fmaf(a.w, x7, s3);
    a = *(const LAS f32x4*)(Am + 3816);
    s0 = fmaf(a.x, x8, s0);
    s1 = fmaf(a.y, x9, s1);
    s2 = fmaf(a.z, x10, s2);
    s3 = fmaf(a.w, x11, s3);
    a = *(const LAS f32x4*)(Am + 3820);
    s0 = fmaf(a.x, x12, s0);
    s1 = fmaf(a.y, x13, s1);
    s2 = fmaf(a.z, x14, s2);
    s3 = fmaf(a.w, x15, s3);
    a = *(const LAS f32x4*)(Am + 3824);
    s0 = fmaf(a.x, x16, s0);
    s1 = fmaf(a.y, x17, s1);
    s2 = fmaf(a.z, x18, s2);
    s3 = fmaf(a.w, x19, s3);
    a = *(const LAS f32x4*)(Am + 3828);
    s0 = fmaf(a.x, x20, s0);
    s1 = fmaf(a.y, x21, s1);
    s2 = fmaf(a.z, x22, s2);
    s3 = fmaf(a.w, x23, s3);
    a = *(const LAS f32x4*)(Am + 3832);
    s0 = fmaf(a.x, x24, s0);
    s1 = fmaf(a.y, x25, s1);
    s2 = fmaf(a.z, x26, s2);
    s3 = fmaf(a.w, x27, s3);
    a = *(const LAS f32x4*)(Am + 3836);
    s0 = fmaf(a.x, x28, s0);
    s1 = fmaf(a.y, x29, s1);
    s2 = fmaf(a.z, x30, s2);
    s3 = fmaf(a.w, x31, s3);
    a = *(const LAS f32x4*)(Am + 3840);
    s0 = fmaf(a.x, x32, s0);
    s1 = fmaf(a.y, x33, s1);
    s2 = fmaf(a.z, x34, s2);
    s3 = fmaf(a.w, x35, s3);
    a = *(const LAS f32x4*)(Am + 3844);
    s0 = fmaf(a.x, x36, s0);
    s1 = fmaf(a.y, x37, s1);
    s2 = fmaf(a.z, x38, s2);
    s3 = fmaf(a.w, x39, s3);
    a = *(const LAS f32x4*)(Am + 3848);
    s0 = fmaf(a.x, x40, s0);
    s1 = fmaf(a.y, x41, s1);
    s2 = fmaf(a.z, x42, s2);
    s3 = fmaf(a.w, x43, s3);
    a = *(const LAS f32x4*)(Am + 3852);
    s0 = fmaf(a.x, x44, s0);
    s1 = fmaf(a.y, x45, s1);
    s2 = fmaf(a.z, x46, s2);
    s3 = fmaf(a.w, x47, s3);
    a = *(const LAS f32x4*)(Am + 3856);
    s0 = fmaf(a.x, x48, s0);
    s1 = fmaf(a.y, x49, s1);
    s2 = fmaf(a.z, x50, s2);
    s3 = fmaf(a.w, x51, s3);
    a = *(const LAS f32x4*)(Am + 3860);
    s0 = fmaf(a.x, x52, s0);
    s1 = fmaf(a.y, x53, s1);
    s2 = fmaf(a.z, x54, s2);
    const float al56 = a.w;
    x56 = (x56 - ((s0 + s1) + (s2 + s3))) - al56 * x55;
    Tu[7616 + c] = f2bf(x56 * su); Tw[7616 + c] = f2bf(x56 * sw); asm volatile("" ::: "memory");
    float x57 = fmaxf(0.0f, 1.0f - fabsf(cf - 57.0f));
    s0 = 0.f; s1 = 0.f; s2 = 0.f; s3 = 0.f;
    a = *(const LAS f32x4*)(Am + 3876);
    s0 = fmaf(a.x, x0, s0);
    s1 = fmaf(a.y, x1, s1);
    s2 = fmaf(a.z, x2, s2);
    s3 = fmaf(a.w, x3, s3);
    a = *(const LAS f32x4*)(Am + 3880);
    s0 = fmaf(a.x, x4, s0);
    s1 = fmaf(a.y, x5, s1);
    s2 = fmaf(a.z, x6, s2);
    s3 = fmaf(a.w, x7, s3);
    a = *(const LAS f32x4*)(Am + 3884);
    s0 = fmaf(a.x, x8, s0);
    s1 = fmaf(a.y, x9, s1);
    s2 = fmaf(a.z, x10, s2);
    s3 = fmaf(a.w, x11, s3);
    a = *(const LAS f32x4*)(Am + 3888);
    s0 = fmaf(a.x, x12, s0);
    s1 = fmaf(a.y, x13, s1);
    s2 = fmaf(a.z, x14, s2);
    s3 = fmaf(a.w, x15, s3);
    a = *(const LAS f32x4*)(Am + 3892);
    s0 = fmaf(a.x, x16, s0);
    s1 = fmaf(a.y, x17, s1);
    s2 = fmaf(a.z, x18, s2);
    s3 = fmaf(a.w, x19, s3);
    a = *(const LAS f32x4*)(Am + 3896);
    s0 = fmaf(a.x, x20, s0);
    s1 = fmaf(a.y, x21, s1);
    s2 = fmaf(a.z, x22, s2);
    s3 = fmaf(a.w, x23, s3);
    a = *(const LAS f32x4*)(Am + 3900);
    s0 = fmaf(a.x, x24, s0);
    s1 = fmaf(a.y, x25, s1);
    s2 = fmaf(a.z, x26, s2);
    s3 = fmaf(a.w, x27, s3);
    a = *(const LAS f32x4*)(Am + 3904);
    s0 = fmaf(a.x, x28, s0);
    s1 = fmaf(a.y, x29, s1);
    s2 = fmaf(a.z, x30, s2);
    s3 = fmaf(a.w, x31, s3);
    a = *(const LAS f32x4*)(Am + 3908);
    s0 = fmaf(a.x, x32, s0);
    s1 = fmaf(a.y, x33, s1);
    s2 = fmaf(a.z, x34, s2);
    s3 = fmaf(a.w, x35, s3);
    a = *(const LAS f32x4*)(Am + 3912);
    s0 = fmaf(a.x, x36, s0);
    s1 = fmaf(a.y, x37, s1);
    s2 = fmaf(a.z, x38, s2);
    s3 = fmaf(a.w, x39, s3);
    a = *(const LAS f32x4*)(Am + 3916);
    s0 = fmaf(a.x, x40, s0);
    s1 = fmaf(a.y, x41, s1);
    s2 = fmaf(a.z, x42, s2);
    s3 = fmaf(a.w, x43, s3);
    a = *(const LAS f32x4*)(Am + 3920);
    s0 = fmaf(a.x, x44, s0);
    s1 = fmaf(a.y, x45, s1);
    s2 = fmaf(a.z, x46, s2);
    s3 = fmaf(a.w, x47, s3);
    a = *(const LAS f32x4*)(Am + 3924);
    s0 = fmaf(a.x, x48, s0);
    s1 = fmaf(a.y, x49, s1);
    s2 = fmaf(a.z, x50, s2);
    s3 = fmaf(a.w, x51, s3);
    a = *(const LAS f32x4*)(Am + 3928);
    s0 = fmaf(a.x, x52, s0);
    s1 = fmaf(a.y, x53, s1);
    s2 = fmaf(a.z, x54, s2);
    s3 = fmaf(a.w, x55, s3);
    a = *(const LAS f32x4*)(Am + 3932);
    const float al57 = a.x;
    x57 = (x57 - ((s0 + s1) + (s2 + s3))) - al57 * x56;
    Tu[7752 + c] = f2bf(x57 * su); Tw[7752 + c] = f2bf(x57 * sw); asm volatile("" ::: "memory");
    float x58 = fmaxf(0.0f, 1.0f - fabsf(cf - 58.0f));
    s0 = 0.f; s1 = 0.f; s2 = 0.f; s3 = 0.f;
    a = *(const LAS f32x4*)(Am + 3944);
    s0 = fmaf(a.x, x0, s0);
    s1 = fmaf(a.y, x1, s1);
    s2 = fmaf(a.z, x2, s2);
    s3 = fmaf(a.w, x3, s3);
    a = *(const LAS f32x4*)(Am + 3948);
    s0 = fmaf(a.x, x4, s0);
    s1 = fmaf(a.y, x5, s1);
    s2 = fmaf(a.z, x6, s2);
    s3 = fmaf(a.w, x7, s3);
    a = *(const LAS f32x4*)(Am + 3952);
    s0 = fmaf(a.x, x8, s0);
    s1 = fmaf(a.y, x9, s1);
    s2 = fmaf(a.z, x10, s2);
    s3 = fmaf(a.w, x11, s3);
    a = *(const LAS f32x4*)(Am + 3956);
    s0 = fmaf(a.x, x12, s0);
    s1 = fmaf(a.y, x13, s1);
    s2 = fmaf(a.z, x14, s2);
    s3 = fmaf(a.w, x15, s3);
    a = *(const LAS f32x4*)(Am + 3960);
    s0 = fmaf(a.x, x16, s0);
    s1 = fmaf(a.y, x17, s1);
    s2 = fmaf(a.z, x18, s2);
    s3 = fmaf(a.w, x19, s3);
    a = *(const LAS f32x4*)(Am + 3964);
    s0 = fmaf(a.x, x20, s0);
    s1 = fmaf(a.y, x21, s1);
    s2 = fmaf(a.z, x22, s2);
    s3 = fmaf(a.w, x23, s3);
    a = *(const LAS f32x4*)(Am + 3968);
    s0 = fmaf(a.x, x24, s0);
    s1 = fmaf(a.y, x25, s1);
    s2 = fmaf(a.z, x26, s2);
    s3 = fmaf(a.w, x27, s3);
    a = *(const LAS f32x4*)(Am + 3972);
    s0 = fmaf(a.x, x28, s0);
    s1 = fmaf(a.y, x29, s1);
    s2 = fmaf(a.z, x30, s2);
    s3 = fmaf(a.w, x31, s3);
    a = *(const LAS f32x4*)(Am + 3976);
    s0 = fmaf(a.x, x32, s0);
    s1 = fmaf(a.y, x33, s1);
    s2 = fmaf(a.z, x34, s2);
    s3 = fmaf(a.w, x35, s3);
    a = *(const LAS f32x4*)(Am + 3980);
    s0 = fmaf(a.x, x36, s0);
    s1 = fmaf(a.y, x37, s1);
    s2 = fmaf(a.z, x38, s2);
    s3 = fmaf(a.w, x39, s3);
    a = *(const LAS f32x4*)(Am + 3984);
    s0 = fmaf(a.x, x40, s0);
    s1 = fmaf(a.y, x41, s1);
    s2 = fmaf(a.z, x42, s2);
    s3 = fmaf(a.w, x43, s3);
    a = *(const LAS f32x4*)(Am + 3988);
    s0 = fmaf(a.x, x44, s0);
    s1 = fmaf(a.y, x45, s1);
    s2 = fmaf(a.z, x46, s2);
    s3 = fmaf(a.w, x47, s3);
    a = *(const LAS f32x4*)(Am + 3992);
    s0 = fmaf(a.x, x48, s0);
    s1 = fmaf(a.y, x49, s1);
    s2 = fmaf(a.z, x50, s2);
    s3 = fmaf(a.w, x51, s3);
    a = *(const LAS f32x4*)(Am + 3996);
    s0 = fmaf(a.x, x52, s0);
    s1 = fmaf(a.y, x53, s1);
    s2 = fmaf(a.z, x54, s2);
    s3 = fmaf(a.w, x55, s3);
    a = *(const LAS f32x4*)(Am + 4000);
    s0 = fmaf(a.x, x56, s0);
    const float al58 = a.y;
    x58 = (x58 - ((s0 + s1) + (s2 + s3))) - al58 * x57;
    Tu[7888 + c] = f2bf(x58 * su); Tw[7888 + c] = f2bf(x58 * sw); asm volatile("" ::: "memory");
    float x59 = fmaxf(0.0f, 1.0f - fabsf(cf - 59.0f));
    s0 = 0.f; s1 = 0.f; s2 = 0.f; s3 = 0.f;
    a = *(const LAS f32x4*)(Am + 4012);
    s0 = fmaf(a.x, x0, s0);
    s1 = fmaf(a.y, x1, s1);
    s2 = fmaf(a.z, x2, s2);
    s3 = fmaf(a.w, x3, s3);
    a = *(const LAS f32x4*)(Am + 4016);
    s0 = fmaf(a.x, x4, s0);
    s1 = fmaf(a.y, x5, s1);
    s2 = fmaf(a.z, x6, s2);
    s3 = fmaf(a.w, x7, s3);
    a = *(const LAS f32x4*)(Am + 4020);
    s0 = fmaf(a.x, x8, s0);
    s1 = fmaf(a.y, x9, s1);
    s2 = fmaf(a.z, x10, s2);
    s3 = fmaf(a.w, x11, s3);
    a = *(const LAS f32x4*)(Am + 4024);
    s0 = fmaf(a.x, x12, s0);
    s1 = fmaf(a.y, x13, s1);
    s2 = fmaf(a.z, x14, s2);
    s3 = fmaf(a.w, x15, s3);
    a = *(const LAS f32x4*)(Am + 4028);
    s0 = fmaf(a.x, x16, s0);
    s1 = fmaf(a.y, x17, s1);
    s2 = fmaf(a.z, x18, s2);
    s3 = fmaf(a.w, x19, s3);
    a = *(const LAS f32x4*)(Am + 4032);
    s0 = fmaf(a.x, x20, s0);
    s1 = fmaf(a.y, x21, s1);
    s2 = fmaf(a.z, x22, s2);
    s3 = fmaf(a.w, x23, s3);
    a = *(const LAS f32x4*)(Am + 4036);
    s0 = fmaf(a.x, x24, s0);
    s1 = fmaf(a.y, x25, s1);
    s2 = fmaf(a.z, x26, s2);
    s3 = fmaf(a.w, x27, s3);
    a = *(const LAS f32x4*)(Am + 4040);
    s0 = fmaf(a.x, x28, s0);
    s1 = fmaf(a.y, x29, s1);
    s2 = fmaf(a.z, x30, s2);
    s3 = fmaf(a.w, x31, s3);
    a = *(const LAS f32x4*)(Am + 4044);
    s0 = fmaf(a.x, x32, s0);
    s1 = fmaf(a.y, x33, s1);
    s2 = fmaf(a.z, x34, s2);
    s3 = fmaf(a.w, x35, s3);
    a = *(const LAS f32x4*)(Am + 4048);
    s0 = fmaf(a.x, x36, s0);
    s1 = fmaf(a.y, x37, s1);
    s2 = fmaf(a.z, x38, s2);
    s3 = fmaf(a.w, x39, s3);
    a = *(const LAS f32x4*)(Am + 4052);
    s0 = fmaf(a.x, x40, s0);
    s1 = fmaf(a.y, x41, s1);
    s2 = fmaf(a.z, x42, s2);
    s3 = fmaf(a.w, x43, s3);
    a = *(const LAS f32x4*)(Am + 4056);
    s0 = fmaf(a.x, x44, s0);
    s1 = fmaf(a.y, x45, s1);
    s2 = fmaf(a.z, x46, s2);
    s3 = fmaf(a.w, x47, s3);
    a = *(const LAS f32x4*)(Am + 4060);
    s0 = fmaf(a.x, x48, s0);
    s1 = fmaf(a.y, x49, s1);
    s2 = fmaf(a.z, x50, s2);
    s3 = fmaf(a.w, x51, s3);
    a = *(const LAS f32x4*)(Am + 4064);
    s0 = fmaf(a.x, x52, s0);
    s1 = fmaf(a.y, x53, s1);
    s2 = fmaf(a.z, x54, s2);
    s3 = fmaf(a.w, x55, s3);
    a = *(const LAS f32x4*)(Am + 4068);
    s0 = fmaf(a.x, x56, s0);
    s1 = fmaf(a.y, x57, s1);
    const float al59 = a.z;
    x59 = (x59 - ((s0 + s1) + (s2 + s3))) - al59 * x58;
    Tu[8024 + c] = f2bf(x59 * su); Tw[8024 + c] = f2bf(x59 * sw); asm volatile("" ::: "memory");
    float x60 = fmaxf(0.0f, 1.0f - fabsf(cf - 60.0f));
    s0 = 0.f; s1 = 0.f; s2 = 0.f; s3 = 0.f;
    a = *(const LAS f32x4*)(Am + 4080);
    s0 = fmaf(a.x, x0, s0);
    s1 = fmaf(a.y, x1, s1);
    s2 = fmaf(a.z, x2, s2);
    s3 = fmaf(a.w, x3, s3);
    a = *(const LAS f32x4*)(Am + 4084);
    s0 = fmaf(a.x, x4, s0);
    s1 = fmaf(a.y, x5, s1);
    s2 = fmaf(a.z, x6, s2);
    s3 = fmaf(a.w, x7, s3);
    a = *(const LAS f32x4*)(Am + 4088);
    s0 = fmaf(a.x, x8, s0);
    s1 = fmaf(a.y, x9, s1);
    s2 = fmaf(a.z, x10, s2);
    s3 = fmaf(a.w, x11, s3);
    a = *(const LAS f32x4*)(Am + 4092);
    s0 = fmaf(a.x, x12, s0);
    s1 = fmaf(a.y, x13, s1);
    s2 = fmaf(a.z, x14, s2);
    s3 = fmaf(a.w, x15, s3);
    a = *(const LAS f32x4*)(Am + 4096);
    s0 = fmaf(a.x, x16, s0);
    s1 = fmaf(a.y, x17, s1);
    s2 = fmaf(a.z, x18, s2);
    s3 = fmaf(a.w, x19, s3);
    a = *(const LAS f32x4*)(Am + 4100);
    s0 = fmaf(a.x, x20, s0);
    s1 = fmaf(a.y, x21, s1);
    s2 = fmaf(a.z, x22, s2);
    s3 = fmaf(a.w, x23, s3);
    a = *(const LAS f32x4*)(Am + 4104);
    s0 = fmaf(a.x, x24, s0);
    s1 = fmaf(a.y, x25, s1);
    s2 = fmaf(a.z, x26, s2);
    s3 = fmaf(a.w, x27, s3);
    a = *(const LAS f32x4*)(Am + 4108);
    s0 = fmaf(a.x, x28, s0);
    s1 = fmaf(a.y, x29, s1);
    s2 = fmaf(a.z, x30, s2);
    s3 = fmaf(a.w, x31, s3);
    a = *(const LAS f32x4*)(Am + 4112);
    s0 = fmaf(a.x, x32, s0);
    s1 = fmaf(a.y, x33, s1);
    s2 = fmaf(a.z, x34, s2);
    s3 = fmaf(a.w, x35, s3);
    a = *(const LAS f32x4*)(Am + 4116);
    s0 = fmaf(a.x, x36, s0);
    s1 = fmaf(a.y, x37, s1);
    s2 = fmaf(a.z, x38, s2);
    s3 = fmaf(a.w, x39, s3);
    a = *(const LAS f32x4*)(Am + 4120);
    s0 = fmaf(a.x, x40, s0);
    s1 = fmaf(a.y, x41, s1);
    s2 = fmaf(a.z, x42, s2);
    s3 = fmaf(a.w, x43, s3);
    a = *(const LAS f32x4*)(Am + 4124);
    s0 = fmaf(a.x, x44, s0);
    s1 = fmaf(a.y, x45, s1);
    s2 = fmaf(a.z, x46, s2);
    s3 = fmaf(a.w, x47, s3);
    a = *(const LAS f32x4*)(Am + 4128);
    s0 = fmaf(a.x, x48, s0);
    s1 = fmaf(a.y, x49, s1);
    s2 = fmaf(a.z, x50, s2);
    s3 = fmaf(a.w, x51, s3);
    a = *(const LAS f32x4*)(Am + 4132);
    s0 = fmaf(a.x, x52, s0);
    s1 = fmaf(a.y, x53, s1);
    s2 = fmaf(a.z, x54, s2);
    s3 = fmaf(a.w, x55, s3);
    a = *(const LAS f32x4*)(Am + 4136);
    s0 = fmaf(a.x, x56, s0);
    s1 = fmaf(a.y, x57, s1);
    s2 = fmaf(a.z, x58, s2);
    const float al60 = a.w;
    x60 = (x60 - ((s0 + s1) + (s2 + s3))) - al60 * x59;
    Tu[8160 + c] = f2bf(x60 * su); Tw[8160 + c] = f2bf(x60 * sw); asm volatile("" ::: "memory");
    float x61 = fmaxf(0.0f, 1.0f - fabsf(cf - 61.0f));
    s0 = 0.f; s1 = 0.f; s2 = 0.f; s3 = 0.f;
    a = *(const LAS f32x4*)(Am + 4148);
    s0 = fmaf(a.x, x0, s0);
    s1 = fmaf(a.y, x1, s1);
    s2 = fmaf(a.z, x2, s2);
    s3 = fmaf(a.w, x3, s3);
    a = *(const LAS f32x4*)(Am + 4152);
    s0 = fmaf(a.x, x4, s0);
    s1 = fmaf(a.y, x5, s1);
    s2 = fmaf(a.z, x6, s2);
    s3 = fmaf(a.w, x7, s3);
    a = *(const LAS f32x4*)(Am + 4156);
    s0 = fmaf(a.x, x8, s0);
    s1 = fmaf(a.y, x9, s1);
    s2 = fmaf(a.z, x10, s2);
    s3 = fmaf(a.w, x11, s3);
    a = *(const LAS f32x4*)(Am + 4160);
    s0 = fmaf(a.x, x12, s0);
    s1 = fmaf(a.y, x13, s1);
    s2 = fmaf(a.z, x14, s2);
    s3 = fmaf(a.w, x15, s3);
    a = *(const LAS f32x4*)(Am + 4164);
    s0 = fmaf(a.x, x16, s0);
    s1 = fmaf(a.y, x17, s1);
    s2 = fmaf(a.z, x18, s2);
    s3 = fmaf(a.w, x19, s3);
    a = *(const LAS f32x4*)(Am + 4168);
    s0 = fmaf(a.x, x20, s0);
    s1 = fmaf(a.y, x21, s1);
    s2 = fmaf(a.z, x22, s2);
    s3 = fmaf(a.w, x23, s3);
    a = *(const LAS f32x4*)(Am + 4172);
    s0 = fmaf(a.x, x24, s0);
    s1 = fmaf(a.y, x25, s1);
    s2 = fmaf(a.z, x26, s2);
    s3 = fmaf(a.w, x27, s3);
    a = *(const LAS f32x4*)(Am + 4176);
    s0 = fmaf(a.x, x28, s0);
    s1 = fmaf(a.y, x29, s1);
    s2 = fmaf(a.z, x30, s2);
    s3 = fmaf(a.w, x31, s3);
    a = *(const LAS f32x4*)(Am + 4180);
    s0 = fmaf(a.x, x32, s0);
    s1 = fmaf(a.y, x33, s1);
    s2 = fmaf(a.z, x34, s2);
    s3 = fmaf(a.w, x35, s3);
    a = *(const LAS f32x4*)(Am + 4184);
    s0 = fmaf(a.x, x36, s0);
    s1 = fmaf(a.y, x37, s1);
    s2 = fmaf(a.z, x38, s2);
    s3 = fmaf(a.w, x39, s3);
    a = *(const LAS f32x4*)(Am + 4188);
    s0 = fmaf(a.x, x40, s0);
    s1 = fmaf(a.y, x41, s1);
    s2 = fmaf(a.z, x42, s2);
    s3 = fmaf(a.w, x43, s3);
    a = *(const LAS f32x4*)(Am + 4192);
    s0 = fmaf(a.x, x44, s0);
    s1 = fmaf(a.y, x45, s1);
    s2 = fmaf(a.z, x46, s2);
    s3 = fmaf(a.w, x47, s3);
    a = *(const LAS f32x4*)(Am + 4196);
    s0 = fmaf(a.x, x48, s0);
    s1 = fmaf(a.y, x49, s1);
    s2 = fmaf(a.z, x50, s2);
    s3 = fmaf(a.w, x51, s3);
    a = *(const LAS f32x4*)(Am + 4200);
    s0 = fmaf(a.x, x52, s0);
    s1 = fmaf(a.y, x53, s1);
    s2 = fmaf(a.z, x54, s2);
    s3 = fmaf(a.w, x55, s3);
    a = *(const LAS f32x4*)(Am + 4204);
    s0 = fmaf(a.x, x56, s0);
    s1 = fmaf(a.y, x57, s1);
    s2 = fmaf(a.z, x58, s2);
    s3 = fmaf(a.w, x59, s3);
    a = *(const LAS f32x4*)(Am + 4208);
    const float al61 = a.x;
    x61 = (x61 - ((s0 + s1) + (s2 + s3))) - al61 * x60;
    Tu[8296 + c] = f2bf(x61 * su); Tw[8296 + c] = f2bf(x61 * sw); asm volatile("" ::: "memory");
    float x62 = fmaxf(0.0f, 1.0f - fabsf(cf - 62.0f));
    s0 = 0.f; s1 = 0.f; s2 = 0.f; s3 = 0.f;
    a = *(const LAS f32x4*)(Am + 4216);
    s0 = fmaf(a.x, x0, s0);
    s1 = fmaf(a.y, x1, s1);
    s2 = fmaf(a.z, x2, s2);
    s3 = fmaf(a.w, x3, s3);
    a = *(const LAS f32x4*)(Am + 4220);
    s0 = fmaf(a.x, x4, s0);
    s1 = fmaf(a.y, x5, s1);
    s2 = fmaf(a.z, x6, s2);
    s3 = fmaf(a.w, x7, s3);
    a = *(const LAS f32x4*)(Am + 4224);
    s0 = fmaf(a.x, x8, s0);
    s1 = fmaf(a.y, x9, s1);
    s2 = fmaf(a.z, x10, s2);
    s3 = fmaf(a.w, x11, s3);
    a = *(const LAS f32x4*)(Am + 4228);
    s0 = fmaf(a.x, x12, s0);
    s1 = fmaf(a.y, x13, s1);
    s2 = fmaf(a.z, x14, s2);
    s3 = fmaf(a.w, x15, s3);
    a = *(const LAS f32x4*)(Am + 4232);
    s0 = fmaf(a.x, x16, s0);
    s1 = fmaf(a.y, x17, s1);
    s2 = fmaf(a.z, x18, s2);
    s3 = fmaf(a.w, x19, s3);
    a = *(const LAS f32x4*)(Am + 4236);
    s0 = fmaf(a.x, x20, s0);
    s1 = fmaf(a.y, x21, s1);
    s2 = fmaf(a.z, x22, s2);
    s3 = fmaf(a.w, x23, s3);
    a = *(const LAS f32x4*)(Am + 4240);
    s0 = fmaf(a.x, x24, s0);
    s1 = fmaf(a.y, x25, s1);
    s2 = fmaf(a.z, x26, s2);
    s3 = fmaf(a.w, x27, s3);
    a = *(const LAS f32x4*)(Am + 4244);
    s0 = fmaf(a.x, x28, s0);
    s1 = fmaf(a.y, x29, s1);
    s2 = fmaf(a.z, x30, s2);
    s3 = fmaf(a.w, x31, s3);
    a = *(const LAS f32x4*)(Am + 4248);
    s0 = fmaf(a.x, x32, s0);
    s1 = fmaf(a.y, x33, s1);
    s2 = fmaf(a.z, x34, s2);
    s3 = fmaf(a.w, x35, s3);
    a = *(const LAS f32x4*)(Am + 4252);
    s0 = fmaf(a.x, x36, s0);
    s1 = fmaf(a.y, x37, s1);
    s2 = fmaf(a.z, x38, s2);
    s3 = fmaf(a.w, x39, s3);
    a = *(const LAS f32x4*)(Am + 4256);
    s0 = fmaf(a.x, x40, s0);
    s1 = fmaf(a.y, x41, s1);
    s2 = fmaf(a.z, x42, s2);
    s3 = fmaf(a.w, x43, s3);
    a = *(const LAS f32x4*)(Am + 4260);
    s0 = fmaf(a.x, x44, s0);
    s1 = fmaf(a.y, x45, s1);
    s2 = fmaf(a.z, x46, s2);
    s3 = fmaf(a.w, x47, s3);
    a = *(const LAS f32x4*)(Am + 4264);
    s0 = fmaf(a.x, x48, s0);
    s1 = fmaf(a.y, x49, s1);
    s2 = fmaf(a.z, x50, s2);
    s3 = fmaf(a.w, x51, s3);
    a = *(const LAS f32x4*)(Am + 4268);
    s0 = fmaf(a.x, x52, s0);
    s1 = fmaf(a.y, x53, s1);
    s2 = fmaf(a.z, x54, s2);
    s3 = fmaf(a.w, x55, s3);
    a = *(const LAS f32x4*)(Am + 4272);
    s0 = fmaf(a.x, x56, s0);
    s1 = fmaf(a.y, x57, s1);
    s2 = fmaf(a.z, x58, s2);
    s3 = fmaf(a.w, x59, s3);
    a = *(const LAS f32x4*)(Am + 4276);
    s0 = fmaf(a.x, x60, s0);
    const float al62 = a.y;
    x62 = (x62 - ((s0 + s1) + (s2 + s3))) - al62 * x61;
    Tu[8432 + c] = f2bf(x62 * su); Tw[8432 + c] = f2bf(x62 * sw); asm volatile("" ::: "memory");
    float x63 = fmaxf(0.0f, 1.0f - fabsf(cf - 63.0f));
    s0 = 0.f; s1 = 0.f; s2 = 0.f; s3 = 0.f;
    a = *(const LAS f32x4*)(Am + 4284);
    s0 = fmaf(a.x, x0, s0);
    s1 = fmaf(a.y, x1, s1);
    s2 = fmaf(a.z, x2, s2);
    s3 = fmaf(a.w, x3, s3);
    a = *(const LAS f32x4*)(Am + 4288);
    s0 = fmaf(a.x, x4, s0);
    s1 = fmaf(a.y, x5, s1);
    s2 = fmaf(a.z, x6, s2);
    s3 = fmaf(a.w, x7, s3);
    a = *(const LAS f32x4*)(Am + 4292);
    s0 = fmaf(a.x, x8, s0);
    s1 = fmaf(a.y, x9, s1);
    s2 = fmaf(a.z, x10, s2);
    s3 = fmaf(a.w, x11, s3);
    a = *(const LAS f32x4*)(Am + 4296);
    s0 = fmaf(a.x, x12, s0);
    s1 = fmaf(a.y, x13, s1);
    s2 = fmaf(a.z, x14, s2);
    s3 = fmaf(a.w, x15, s3);
    a = *(const LAS f32x4*)(Am + 4300);
    s0 = fmaf(a.x, x16, s0);
    s1 = fmaf(a.y, x17, s1);
    s2 = fmaf(a.z, x18, s2);
    s3 = fmaf(a.w, x19, s3);
    a = *(const LAS f32x4*)(Am + 4304);
    s0 = fmaf(a.x, x20, s0);
    s1 = fmaf(a.y, x21, s1);
    s2 = fmaf(a.z, x22, s2);
    s3 = fmaf(a.w, x23, s3);
    a = *(const LAS f32x4*)(Am + 4308);
    s0 = fmaf(a.x, x24, s0);
    s1 = fmaf(a.y, x25, s1);
    s2 = fmaf(a.z, x26, s2);
    s3 = fmaf(a.w, x27, s3);
    a = *(const LAS f32x4*)(Am + 4312);
    s0 = fmaf(a.x, x28, s0);
    s1 = fmaf(a.y, x29, s1);
    s2 = fmaf(a.z, x30, s2);
    s3 = fmaf(a.w, x31, s3);
    a = *(const LAS f32x4*)(Am + 4316);
    s0 = fmaf(a.x, x32, s0);
    s1 = fmaf(a.y, x33, s1);
    s2 = fmaf(a.z, x34, s2);
    s3 = fmaf(a.w, x35, s3);
    a = *(const LAS f32x4*)(Am + 4320);
    s0 = fmaf(a.x, x36, s0);
    s1 = fmaf(a.y, x37, s1);
    s2 = fmaf(a.z, x38, s2);
    s3 = fmaf(a.w, x39, s3);
    a = *(const LAS f32x4*)(Am + 4324);
    s0 = fmaf(a.x, x40, s0);
    s1 = fmaf(a.y, x41, s1);
    s2 = fmaf(a.z, x42, s2);
    s3 = fmaf(a.w, x43, s3);
    a = *(const LAS f32x4*)(Am + 4328);
    s0 = fmaf(a.x, x44, s0);
    s1 = fmaf(a.y, x45, s1);
    s2 = fmaf(a.z, x46, s2);
    s3 = fmaf(a.w, x47, s3);
    a = *(const LAS f32x4*)(Am + 4332);
    s0 = fmaf(a.x, x48, s0);
    s1 = fmaf(a.y, x49, s1);
    s2 = fmaf(a.z, x50, s2);
    s3 = fmaf(a.w, x51, s3);
    a = *(const LAS f32x4*)(Am + 4336);
    s0 = fmaf(a.x, x52, s0);
    s1 = fmaf(a.y, x53, s1);
    s2 = fmaf(a.z, x54, s2);
    s3 = fmaf(a.w, x55, s3);
    a = *(const LAS f32x4*)(Am + 4340);
    s0 = fmaf(a.x, x56, s0);
    s1 = fmaf(a.y, x57, s1);
    s2 = fmaf(a.z, x58, s2);
    s3 = fmaf(a.w, x59, s3);
    a = *(const LAS f32x4*)(Am + 4344);
    s0 = fmaf(a.x, x60, s0);
    s1 = fmaf(a.y, x61, s1);
    const float al63 = a.z;
    x63 = (x63 - ((s0 + s1) + (s2 + s3))) - al63 * x62;
    Tu[8568 + c] = f2bf(x63 * su); Tw[8568 + c] = f2bf(x63 * sw); asm volatile("" ::: "memory");
}
typedef short bf16x8_t __attribute__((ext_vector_type(8)));
template <int K> __device__ __forceinline__ f32x4 mma_tile(const LAS unsigned short* A, int lda, const LAS unsigned short* Bt, int ldb, f32x4 acc) {
    const int lane = threadIdx.x & 63, r = lane & 15, q = lane >> 4;
#pragma unroll
    for (int ks = 0; ks < K / 32; ++ks) {
        const bf16x8_t a = *(const LAS bf16x8_t*)(A + r * lda + ks * 32 + q * 8);
        const bf16x8_t b = *(const LAS bf16x8_t*)(Bt + r * ldb + ks * 32 + q * 8);
        acc = __builtin_amdgcn_mfma_f32_16x16x32_bf16(a, b, acc, 0, 0, 0);
    }
    return acc;
}

typedef unsigned short u16x4_t __attribute__((ext_vector_type(4)));
__device__ __forceinline__ void tr_frag2(unsigned base_addr, int pitch, int c, bf16x8_t& f0, bf16x8_t& f1) {
    const int lane = threadIdx.x & 63, g = lane >> 4, qq = (lane & 15) >> 2, pp = lane & 3;
    const unsigned a00 = base_addr + (unsigned)((8 * g + qq) * pitch + 32 * c + 8 * pp);
    const unsigned a01 = a00 + 4u * (unsigned)pitch, a10 = a00 + 32u * (unsigned)pitch, a11 = a10 + 4u * (unsigned)pitch;
    u16x4_t r00, r01, r10, r11;
    asm volatile("ds_read_b64_tr_b16 %0, %4\n\tds_read_b64_tr_b16 %1, %5\n\tds_read_b64_tr_b16 %2, %6\n\tds_read_b64_tr_b16 %3, %7\n\ts_waitcnt lgkmcnt(0)"
                 : "=&v"(r00), "=&v"(r01), "=&v"(r10), "=&v"(r11) : "v"(a00), "v"(a01), "v"(a10), "v"(a11) : "memory");
    f0 = (bf16x8_t){(short)r00.x, (short)r00.y, (short)r00.z, (short)r00.w, (short)r01.x, (short)r01.y, (short)r01.z, (short)r01.w};
    f1 = (bf16x8_t){(short)r10.x, (short)r10.y, (short)r10.z, (short)r10.w, (short)r11.x, (short)r11.y, (short)r11.z, (short)r11.w};
}
constexpr size_t WS_G = 235 * MiB;

__device__ __forceinline__ void delta_prep(LDSp lds, const Params& p) {
    const bf16_t* QKVN = (const bf16_t*)(p.ws + WS_QKV); const float* BETA = (const float*)(p.ws + WS_BETA); const float* LA = (const float*)(p.ws + WS_LA);
    bf16_t* Z = (bf16_t*)(p.ws + WS_Z); float* GB = (float*)(p.ws + WS_G);
    LAS unsigned short* Qb = (LAS unsigned short*)lds;
    LAS unsigned short* Kb = (LAS unsigned short*)(lds + 17408);
    LAS unsigned short* Ast = (LAS unsigned short*)(lds + 107776);
    const int tid = threadIdx.x, lane = tid & 63, wid = tid >> 6, r = lane & 15, q = lane >> 4;
    const int G = gridDim.x;
    u32x4 pq[4]; float pla = 0.f, pbe = 0.f;
#define DPL(u_, vmode) do { const int dir_ = (u_) >> 10, b_ = ((u_) >> 8) & 3, h_ = ((u_) >> 6) & 3, n_ = (u_) & 63; \
        const long tk0_ = (long)b_ * S_ + (dir_ ? (S_ - 1 - n_ * 64) : n_ * 64); const long ts_ = dir_ ? -1 : 1; \
        _Pragma("unroll") for (int i = 0; i < 4; ++i) { const int pi = tid + NTHR * i, which = pi >> 10, l = (pi >> 4) & 63, c8 = pi & 15; \
            pq[i] = *(const u32x4*)(QKVN + (tk0_ + l * ts_) * 1536 + ((vmode) ? (which ? 512 : 1024) : which * 512) + h_ * 128 + c8 * 8); } \
        if (!(vmode) && tid < 64) { const long tk = tk0_ + tid * ts_; pla = LA[tk * 8 + dir_ * 4 + h_]; pbe = BETA[tk * 8 + dir_ * 4 + h_]; } } while (0)
#define DPS() do { _Pragma("unroll") for (int i = 0; i < 4; ++i) { const int pi = tid + NTHR * i, which = pi >> 10, l = (pi >> 4) & 63, c8 = pi & 15; *(LAS u32x4*)(lds + which * 17408 + l * 272 + c8 * 16) = pq[i]; } } while (0)
    if ((int)blockIdx.x < 2048) DPL((int)blockIdx.x, 0);
    for (int ub = blockIdx.x; ub < 2048; ub += 4 * G) {
#pragma unroll 1
        for (int j = 0; j < 4; ++j) { const int unit = ub + j * G; if (unit >= 2048) break;
            const int dir = unit >> 10, b = (unit >> 8) & 3, h = (unit >> 6) & 3, n = unit & 63;
            const long tok0 = (long)b * S_ + (dir ? (S_ - 1 - n * 64) : n * 64); const long tstep = dir ? -1 : 1;
            LAS float* Am = (LAS float*)(lds + 34816 + j * 17408); LAS float* gl = (LAS float*)(lds + 104448 + j * 768); LAS float* be = gl + 64; LAS float* beg = gl + 128; LAS float* la = (LAS float*)(lds + 107520);
            DPS();
            if (tid < 64) { la[tid] = pla; be[tid] = pbe; }
            __syncthreads();
            { const int un = ub + (j + 1) * G; if (j < 3 && un < 2048) DPL(un, 0); else DPL(ub, 1); }
            if (tid < 64) { const float g = wave_scan_sum(la[tid], true); gl[tid] = g; beg[tid] = be[tid] * __expf(g); GB[((size_t)dir * T_ + (tok0 + tid * tstep)) * 4 + h] = g; }
            __syncthreads();
#pragma unroll
            for (int tt = 0; tt < 2; ++tt) { const int idx = wid * 2 + tt, mt = idx >> 2, nt = idx & 3;
                f32x4 kk = {0.f, 0.f, 0.f, 0.f}, qk = {0.f, 0.f, 0.f, 0.f};
                if (mt >= nt) { kk = mma_tile<128>(Kb + mt * 16 * 136, 136, Kb + nt * 16 * 136, 136, kk); qk = mma_tile<128>(Qb + mt * 16 * 136, 136, Kb + nt * 16 * 136, 136, qk); }
                const int jj = nt * 16 + r; const float gj = gl[jj];
#pragma unroll
                for (int i4 = 0; i4 < 4; ++i4) { const int i = mt * 16 + q * 4 + i4; const float dec = (i >= jj) ? __expf(gl[i] - gj) : 0.f;
                    Am[i * 68 + jj] = (i > jj) ? be[i] * kk[i4] * dec : 0.f;
                    Ast[i * 72 + jj] = f2bf(qk[i4] * dec); }
            }
            __syncthreads();
            { const int l = tid >> 3, c8 = tid & 7;
              *(u32x4*)(Z + (tok0 + l * tstep) * 3072 + 2048 + dir * 256 + h * 64 + c8 * 8) = *(const LAS u32x4*)(Ast + l * 72 + c8 * 8); }
        }
        if (wid < 4 && ub + wid * G < 2048) { int cc = lane; asm volatile("" : "+v"(cc));
            LAS float* Am = (LAS float*)(lds + 34816 + wid * 17408); LAS float* gl = (LAS float*)(lds + 104448 + wid * 768);
            tri_inv64(Am, cc, gl[64 + lane], gl[128 + lane], (LAS unsigned short*)Am, (LAS unsigned short*)Am + 64); }
        __syncthreads();
#pragma unroll 1
        for (int j = 0; j < 4; ++j) { const int unit = ub + j * G; if (unit >= 2048) break;
            const int dir = unit >> 10, b = (unit >> 8) & 3, h = (unit >> 6) & 3, n = unit & 63;
            const long tok0 = (long)b * S_ + (dir ? (S_ - 1 - n * 64) : n * 64); const long tstep = dir ? -1 : 1;
            const LAS unsigned short* Tu = (const LAS unsigned short*)(lds + 34816 + j * 17408);
            DPS();
            __syncthreads();
            { const int un = ub + (j + 1) * G; if (j < 3 && un < 2048) DPL(un, 1); else if (ub + 4 * G < 2048) DPL(ub + 4 * G, 0); }
            {   bf16x8_t vb0, vb1, kb0, kb1; tr_frag2((unsigned)(unsigned long long)Qb, 272, wid, vb0, vb1); tr_frag2((unsigned)(unsigned long long)Kb, 272, wid, kb0, kb1);
                __syncthreads();
#pragma unroll
                for (int mt = 0; mt < 4; ++mt) {
                    const bf16x8_t tu0 = *(const LAS bf16x8_t*)(Tu + (mt * 16 + r) * 136 + q * 8), tu1 = *(const LAS bf16x8_t*)(Tu + (mt * 16 + r) * 136 + 32 + q * 8);
                    const bf16x8_t tw0 = *(const LAS bf16x8_t*)(Tu + (mt * 16 + r) * 136 + 64 + q * 8), tw1 = *(const LAS bf16x8_t*)(Tu + (mt * 16 + r) * 136 + 96 + q * 8);
                    f32x4 au = {0.f, 0.f, 0.f, 0.f}, aw = {0.f, 0.f, 0.f, 0.f};
                    au = __builtin_amdgcn_mfma_f32_16x16x32_bf16(tu0, vb0, au, 0, 0, 0); au = __builtin_amdgcn_mfma_f32_16x16x32_bf16(tu1, vb1, au, 0, 0, 0);
                    aw = __builtin_amdgcn_mfma_f32_16x16x32_bf16(tw0, kb0, aw, 0, 0, 0); aw = __builtin_amdgcn_mfma_f32_16x16x32_bf16(tw1, kb1, aw, 0, 0, 0);
#pragma unroll
                    for (int i4 = 0; i4 < 4; ++i4) { const int l = mt * 16 + q * 4 + i4; Qb[l * 136 + wid * 16 + r] = f2bf(au[i4]); Kb[l * 136 + wid * 16 + r] = f2bf(aw[i4]); }
                }
            }
            __syncthreads();
#pragma unroll
            for (int i = 0; i < 4; ++i) { const int pi = tid + NTHR * i, which = pi >> 10, l = (pi >> 4) & 63, c8 = pi & 15;
                *(u32x4*)(Z + (tok0 + l * tstep) * 3072 + which * 1024 + dir * 512 + h * 128 + c8 * 8) = *(const LAS u32x4*)(lds + which * 17408 + l * 272 + c8 * 16); }
            __syncthreads();
        }
    }
}
#undef DPL
#undef DPS

__device__ __forceinline__ void delta_scan2(LDSp lds, const Params& p) {
    const bf16_t* QKVN = (const bf16_t*)(p.ws + WS_QKV); const bf16_t* Z = (const bf16_t*)(p.ws + WS_Z); const float* GB = (const float*)(p.ws + WS_G);
    LAS unsigned short* Wb  = (LAS unsigned short*)lds;
    LAS unsigned short* Qg  = (LAS unsigned short*)(lds + 17408);
    LAS unsigned short* Kg  = (LAS unsigned short*)(lds + 34816);
    LAS unsigned short* At  = (LAS unsigned short*)(lds + 53248);
    LAS unsigned short* Ub  = (LAS unsigned short*)(lds + 62464);
    LAS unsigned short* St  = (LAS unsigned short*)(lds + 66560);
    LAS unsigned short* Vt  = (LAS unsigned short*)(lds + 75264);
    const int tid = threadIdx.x, lane = tid & 63, wid = tid >> 6, r = lane & 15, q = lane >> 4;
    for (int unit = blockIdx.x; unit < 128; unit += gridDim.x) {
        const int dir = unit >> 6, b = (unit >> 4) & 3, h = (unit >> 2) & 3, sl = unit & 3;
        bf16_t* O = (bf16_t*)(p.ws + (dir ? WS_OB : WS_OF));
        const long tstep = dir ? -1 : 1;
        f32x4 S0 = {0.f, 0.f, 0.f, 0.f}, S1 = {0.f, 0.f, 0.f, 0.f};
        u32x4 rwA[2], rqA[2], rkA[2], raA, ruA = {0u, 0u, 0u, 0u}; float g0A = 0.f, g1A = 0.f, gLA = 0.f;
        u32x4 rwB[2], rqB[2], rkB[2], raB, ruB = {0u, 0u, 0u, 0u}; float g0B = 0.f, g1B = 0.f, gLB = 0.f;
#define D2_TOK0(n) ((long)b * S_ + (dir ? (S_ - 1 - (n) * 64) : (n) * 64))
#define D2_LOAD(n, X) do { const long t0_ = D2_TOK0(n); \
        _Pragma("unroll") for (int i = 0; i < 2; ++i) { const int pi = tid + NTHR * i, l = pi >> 4, c8 = pi & 15; const long tk = t0_ + l * tstep; \
            rw##X[i] = *(const u32x4*)(Z + tk * 3072 + 1024 + dir * 512 + h * 128 + c8 * 8); \
            rq##X[i] = *(const u32x4*)(QKVN + tk * 1536 + h * 128 + c8 * 8); rk##X[i] = *(const u32x4*)(QKVN + tk * 1536 + 512 + h * 128 + c8 * 8); } \
        { const int l = tid >> 3, c8 = tid & 7; ra##X = *(const u32x4*)(Z + (t0_ + l * tstep) * 3072 + 2048 + dir * 256 + h * 64 + c8 * 8); } \
        if (tid < 256) { const int l = tid >> 2, c8 = tid & 3; ru##X = *(const u32x4*)(Z + (t0_ + l * tstep) * 3072 + dir * 512 + h * 128 + sl * 32 + c8 * 8); } \
        g0##X = GB[((size_t)dir * T_ + (t0_ + (tid >> 4) * tstep)) * 4 + h]; g1##X = GB[((size_t)dir * T_ + (t0_ + ((tid >> 4) + 32) * tstep)) * 4 + h]; \
        gL##X = GB[((size_t)dir * T_ + (t0_ + 63 * tstep)) * 4 + h]; } while (0)
#define D2_ITER(n, X) do { \
            const float egL = __expf(gL##X); \
            _Pragma("unroll") for (int i = 0; i < 2; ++i) { const int pi = tid + NTHR * i, l = pi >> 4, c8 = pi & 15; const float gl_ = i == 0 ? g0##X : g1##X; \
                *(LAS u32x4*)(Wb + l * 136 + c8 * 8) = rw##X[i]; \
                float f[8]; unpack8(rq##X[i], f); const float eg = __expf(gl_); \
                u32x4 o; o.x = pk2(f[0] * eg, f[1] * eg); o.y = pk2(f[2] * eg, f[3] * eg); o.z = pk2(f[4] * eg, f[5] * eg); o.w = pk2(f[6] * eg, f[7] * eg); \
                *(LAS u32x4*)(Qg + l * 136 + c8 * 8) = o; \
                unpack8(rk##X[i], f); const float ek = __expf(gL##X - gl_); \
                o.x = pk2(f[0] * ek, f[1] * ek); o.y = pk2(f[2] * ek, f[3] * ek); o.z = pk2(f[4] * ek, f[5] * ek); o.w = pk2(f[6] * ek, f[7] * ek); \
                *(LAS u32x4*)(Kg + l * 144 + c8 * 8) = o; } \
            { const int l = tid >> 3, c8 = tid & 7; *(LAS u32x4*)(At + l * 72 + c8 * 8) = ra##X; } \
            if (tid < 256) { const int l = tid >> 2, c8 = tid & 3; *(LAS u32x4*)(Ub + l * 32 + c8 * 8) = ru##X; } \
            { u32x2 w0; w0.x = pk2(S0.x, S0.y); w0.y = pk2(S0.z, S0.w); *(LAS u32x2*)(St + r * 136 + wid * 16 + q * 4) = w0; \
              u32x2 w1; w1.x = pk2(S1.x, S1.y); w1.y = pk2(S1.z, S1.w); *(LAS u32x2*)(St + (16 + r) * 136 + wid * 16 + q * 4) = w1; } \
            __syncthreads(); \
            if ((n) + 2 < 64) D2_LOAD((n) + 2, X); \
            const int mt = wid >> 1, nt = wid & 1; \
            f32x4 p1 = {0.f, 0.f, 0.f, 0.f}, p2 = {0.f, 0.f, 0.f, 0.f}; \
            p1 = mma_tile<128>(Wb + mt * 16 * 136, 136, St + nt * 16 * 136, 136, p1); \
            p2 = mma_tile<128>(Qg + mt * 16 * 136, 136, St + nt * 16 * 136, 136, p2); \
            { const int l0 = mt * 16 + q * 4, v = nt * 16 + r; float vn[4]; \
              _Pragma("unroll") for (int i = 0; i < 4; ++i) vn[i] = bf2f(Ub[(l0 + i) * 32 + v]) - p1[i]; \
              u32x2 w; w.x = pk2(vn[0], vn[1]); w.y = pk2(vn[2], vn[3]); *(LAS u32x2*)(Vt + v * 72 + l0) = w; } \
            __syncthreads(); \
            p2 = mma_tile<64>(At + mt * 16 * 72, 72, Vt + nt * 16 * 72, 72, p2); \
            { const long t0_ = D2_TOK0(n); \
              _Pragma("unroll") for (int i = 0; i < 4; ++i) O[(t0_ + (mt * 16 + q * 4 + i) * tstep) * 512 + h * 128 + sl * 32 + nt * 16 + r] = f2bf(p2[i]); } \
            S0 = S0 * egL; S1 = S1 * egL; \
            { bf16x8_t ka0, ka1; tr_frag2((unsigned)(unsigned long long)Kg, 288, wid, ka0, ka1); \
              const bf16x8_t vb00 = *(const LAS bf16x8_t*)(Vt + r * 72 + q * 8), vb01 = *(const LAS bf16x8_t*)(Vt + r * 72 + 32 + q * 8); \
              const bf16x8_t vb10 = *(const LAS bf16x8_t*)(Vt + (16 + r) * 72 + q * 8), vb11 = *(const LAS bf16x8_t*)(Vt + (16 + r) * 72 + 32 + q * 8); \
              S0 = __builtin_amdgcn_mfma_f32_16x16x32_bf16(ka0, vb00, S0, 0, 0, 0); S0 = __builtin_amdgcn_mfma_f32_16x16x32_bf16(ka1, vb01, S0, 0, 0, 0); \
              S1 = __builtin_amdgcn_mfma_f32_16x16x32_bf16(ka0, vb10, S1, 0, 0, 0); S1 = __builtin_amdgcn_mfma_f32_16x16x32_bf16(ka1, vb11, S1, 0, 0, 0); } \
            __syncthreads(); } while (0)
        D2_LOAD(0, A); D2_LOAD(1, B);
#pragma unroll 1
        for (int n = 0; n < 64; n += 2) { D2_ITER(n, A); D2_ITER(n + 1, B); }
#undef D2_ITER
#undef D2_LOAD
#undef D2_TOK0
    }
}
constexpr size_t WS_CT = WS_OF, WS_NV = 235 * MiB, WS_MS = 235 * MiB + 524288, WS_CT2 = 169 * MiB, WS_NV2 = 236 * MiB;
__device__ __forceinline__ void mlstm_a(LDSp lds, const Params& p) {
    const bf16_t* Z = (const bf16_t*)(p.ws + WS_Z); const float* LI = (const float*)(p.ws + WS_BETA); const float* LF = (const float*)(p.ws + WS_LA);
    bf16_t* CT = (bf16_t*)(p.ws + WS_CT); float* NV = (float*)(p.ws + WS_NV); float* MS = (float*)(p.ws + WS_MS);
    LAS unsigned short* Ks = (LAS unsigned short*)lds;
    LAS unsigned short* Vr = (LAS unsigned short*)(lds + 9216);
    LAS float* lf = (LAS float*)(lds + 27648); LAS float* li = lf + 64; LAS float* sw = lf + 128; LAS float* red = lf + 192  ;
    const int tid = threadIdx.x, lane = tid & 63, wid = tid >> 6, r = lane & 15, q = lane >> 4;
    for (int unit = blockIdx.x; unit < 2048; unit += gridDim.x) {
        const int dir = unit >> 10, b = (unit >> 8) & 3, h = (unit >> 6) & 3, n = unit & 63, pc = dir ? 63 - n : n;
        const size_t tok0 = (size_t)b * S_ + pc * 64;
        if (tid < 64) { lf[tid] = LF[(tok0 + tid) * 8 + dir * 4 + h]; li[tid] = LI[(tok0 + tid) * 8 + dir * 4 + h]; }
        __syncthreads();
        if (tid < 64) { const float bc = wave_scan_sum(lf[tid], dir == 0);
            const float tot = __shfl(bc, dir ? 0 : 63);
            const float we = tot - bc + li[tid]; float mx = we;
#pragma unroll
            for (int o = 32; o; o >>= 1) mx = fmaxf(mx, __shfl_xor(mx, o));
            sw[tid] = __expf(we - mx);
            if (tid == 0) { MS[unit * 32] = tot; MS[unit * 32 + 1] = mx; } }
        __syncthreads();
        { const int pp = tid >> 3, c8 = tid & 7; const u32x4 kv = *(const u32x4*)(Z + (tok0 + pp) * 2560 + 1280 + h * 64 + c8 * 8); float f[8]; unpack8(kv, f); const float s = sw[pp];
          u32x4 o; o.x = pk2(f[0] * s, f[1] * s); o.y = pk2(f[2] * s, f[3] * s); o.z = pk2(f[4] * s, f[5] * s); o.w = pk2(f[6] * s, f[7] * s);
          *(LAS u32x4*)(Ks + pp * 72 + c8 * 8) = o; }
#pragma unroll
        for (int i = 0; i < 2; ++i) { const int pi = tid + NTHR * i, pp = pi >> 4, c8 = pi & 15;
            *(LAS u32x4*)(Vr + pp * 144 + c8 * 8) = *(const u32x4*)(Z + (tok0 + pp) * 2560 + 1536 + h * 128 + c8 * 8); }
        __syncthreads();
        { bf16x8_t vb0, vb1; tr_frag2((unsigned)(unsigned long long)Vr, 288, wid, vb0, vb1);
#pragma unroll
          for (int dt = 0; dt < 4; ++dt) { bf16x8_t ka0, ka1; tr_frag2((unsigned)(unsigned long long)Ks, 144, dt, ka0, ka1);
            f32x4 acc = {0.f, 0.f, 0.f, 0.f};
            acc = __builtin_amdgcn_mfma_f32_16x16x32_bf16(ka0, vb0, acc, 0, 0, 0); acc = __builtin_amdgcn_mfma_f32_16x16x32_bf16(ka1, vb1, acc, 0, 0, 0);
            u32x2 w; w.x = pk2(acc.x, acc.y); w.y = pk2(acc.z, acc.w);
            *(u32x2*)(CT + (size_t)unit * 8192 + (wid * 16 + r) * 64 + dt * 16 + q * 4) = w; } }
        { const int d = tid & 63; float a = 0.f;
#pragma unroll
          for (int j = 0; j < 8; ++j) a += bf2f(Ks[(wid * 8 + j) * 72 + d]);
          red[wid * 64 + d] = a; }
        __syncthreads();
        if (tid < 64) { float a = 0.f;
#pragma unroll
            for (int w = 0; w < 8; ++w) a += red[w * 64 + tid];
            NV[(size_t)unit * 64 + tid] = a; }
        __syncthreads();
    }
}
__device__ __forceinline__ void mlstm_b(const Params& p) {
    const bf16_t* CT = (const bf16_t*)(p.ws + WS_CT); const float* NV = (const float*)(p.ws + WS_NV); float* MS = (float*)(p.ws + WS_MS); bf16_t* CT2 = (bf16_t*)(p.ws + WS_CT2); float* NV2 = (float*)(p.ws + WS_NV2);
    const int tid = threadIdx.x;
    for (int wgi = blockIdx.x; wgi < 128; wgi += gridDim.x) {
        const int scan = wgi >> 2, part = wgi & 3; const size_t e = (size_t)(part * NTHR + tid) * 4;
        const bool nvw = (part == 0 && tid < 64);
        float m = 0.f, c0 = 0.f, c1 = 0.f, c2 = 0.f, c3 = 0.f, nn = 0.f;
#pragma unroll 1
        for (int hf = 0; hf < 4; ++hf) {
        u32x2 dc[16]; float dn[16], blv[16], mlv[16];
#pragma unroll
        for (int n = 0; n < 16; ++n) { blv[n] = MS[(scan * 64 + hf * 16 + n) * 32]; mlv[n] = MS[(scan * 64 + hf * 16 + n) * 32 + 1]; dc[n] = (EXPC == 2) ? (u32x2){0u, 0u} : *(const u32x2*)(CT + (size_t)(scan * 64 + hf * 16 + n) * 8192 + e); dn[n] = nvw ? NV[(size_t)(scan * 64 + hf * 16 + n) * 64 + tid] : 0.f; }
#pragma unroll
        for (int n = 0; n < 16; ++n) { const int unit = scan * 64 + hf * 16 + n;
            const float bl = blv[n], ml = mlv[n];
            u32x2 w; w.x = pk2(c0, c1); w.y = pk2(c2, c3); *(u32x2*)(CT2 + (size_t)unit * 8192 + e) = w;
            if (nvw) NV2[(size_t)unit * 64 + tid] = nn;
            if (part == 0 && tid == 0) MS[65536 + unit] = m;
            const float mn = fmaxf(bl + m, ml), a = __expf(bl + m - mn), bb = __expf(ml - mn);
            c0 = a * c0 + bb * bflo(dc[n].x); c1 = a * c1 + bb * bfhi(dc[n].x); c2 = a * c2 + bb * bflo(dc[n].y); c3 = a * c3 + bb * bfhi(dc[n].y);
            nn = a * nn + bb * dn[n]; m = mn; }
        }
    }
}
__device__ __forceinline__ void mlstm_c(LDSp lds, const Params& p) {
    const bf16_t* Z = (const bf16_t*)(p.ws + WS_Z); const float* LI = (const float*)(p.ws + WS_BETA); const float* LF = (const float*)(p.ws + WS_LA);
    const bf16_t* CT = (const bf16_t*)(p.ws + WS_CT2); const float* NV = (const float*)(p.ws + WS_NV2); const float* MS = (const float*)(p.ws + WS_MS);
    bf16_t* Y = (bf16_t*)(p.ws + WS_HN); const float* gn = p.in[19];
    LAS unsigned short* Qb = (LAS unsigned short*)lds;
    LAS unsigned short* Kb = (LAS unsigned short*)(lds + 9216);
    LAS unsigned short* Vr = (LAS unsigned short*)(lds + 18432);
    LAS float* ssp = (LAS float*)(lds + 100352);
#define MC_CB(d) ((LAS unsigned short*)(lds + 36864 + (d) * 18432))
#define MC_PB(d) ((LAS unsigned short*)(lds + 73728 + (d) * 9216))
#define MC_SC(d) ((LAS float*)(lds + 92160 + (d) * 4096))
    const int tid = threadIdx.x, wid = tid >> 6;
    for (int unit = blockIdx.x; unit < 1024; unit += gridDim.x) {
        int lane = tid & 63; asm volatile("" : "+v"(lane));
        const int r = lane & 15, q = lane >> 4;
        const int b = unit >> 8, h = (unit >> 6) & 3, pc = unit & 63; const size_t tok0 = (size_t)b * S_ + pc * 64;
        const size_t ua = (size_t)(((0 * 4 + b) * 4 + h) * 64 + pc), ub = (size_t)(((1 * 4 + b) * 4 + h) * 64 + (63 - pc));
        { const int pp = tid >> 3, c8 = tid & 7;
          *(LAS u32x4*)(Qb + pp * 72 + c8 * 8) = *(const u32x4*)(Z + (tok0 + pp) * 2560 + 1024 + h * 64 + c8 * 8);
          *(LAS u32x4*)(Kb + pp * 72 + c8 * 8) = *(const u32x4*)(Z + (tok0 + pp) * 2560 + 1280 + h * 64 + c8 * 8); }
#pragma unroll
        for (int i = 0; i < 2; ++i) { const int pi = tid + NTHR * i, pp = pi >> 4, c8 = pi & 15; *(LAS u32x4*)(Vr + pp * 144 + c8 * 8) = *(const u32x4*)(Z + (tok0 + pp) * 2560 + 1536 + h * 128 + c8 * 8); }
#pragma unroll
        for (int i = 0; i < 2; ++i) { const int pi = tid + NTHR * i, v = pi >> 3, c8 = pi & 7;
            *(LAS u32x4*)(MC_CB(0) + v * 72 + c8 * 8) = *(const u32x4*)(CT + ua * 8192 + v * 64 + c8 * 8); *(LAS u32x4*)(MC_CB(1) + v * 72 + c8 * 8) = *(const u32x4*)(CT + ub * 8192 + v * 64 + c8 * 8); }
        float mst = 0.f;
        if (tid < 128) { const int d = tid >> 6; const size_t ud = d ? ub : ua; LAS float* sc = MC_SC(d);
            sc[lane] = LF[(tok0 + lane) * 8 + d * 4 + h]; sc[64 + lane] = LI[(tok0 + lane) * 8 + d * 4 + h]; sc[384 + lane] = NV[ud * 64 + lane]; mst = MS[65536 + ud]; }
        __syncthreads();
        bf16x8_t vb0, vb1; tr_frag2((unsigned)(unsigned long long)Vr, 288, wid, vb0, vb1);
        {
            const int t = tid >> 3, part = tid & 7; const u32x4 qv = *(const LAS u32x4*)(Qb + t * 72 + part * 8); float f[8]; unpack8(qv, f);
#pragma unroll
            for (int d = 0; d < 2; ++d) { LAS float* sc = MC_SC(d);
                const f32x4 n0 = *(const LAS f32x4*)(sc + 384 + part * 8), n1 = *(const LAS f32x4*)(sc + 384 + part * 8 + 4);
                float a = f[0] * n0.x; a = fmaf(f[1], n0.y, a); a = fmaf(f[2], n0.z, a); a = fmaf(f[3], n0.w, a); a = fmaf(f[4], n1.x, a); a = fmaf(f[5], n1.y, a); a = fmaf(f[6], n1.z, a); a = fmaf(f[7], n1.w, a);
                a += dppf<0xB1>(a); a += dppf<0x4E>(a); a += dppf<0x141>(a);
                if (part == 0) sc[320 + t] = a; } }
        if (tid < 128) {
            const int d = tid >> 6; LAS float* sc = MC_SC(d);
            const float bt = wave_scan_sum(sc[lane], d == 0);
            const float dmax = bt + wave_scan_max(sc[64 + lane] - bt, d == 0);
            const float m = fmaxf(bt + mst, dmax), w = __expf(bt + mst - m);
            sc[128 + lane] = bt; sc[192 + lane] = m; sc[256 + lane] = w * 0.125f; sc[448 + lane] = __expf(-m); }
        __syncthreads();
#pragma unroll 1
        for (int tt = 0; tt < 2; ++tt) { const int idx = wid * 2 + tt, mt = idx >> 2, nt = idx & 3;
            f32x4 scv = {0.f, 0.f, 0.f, 0.f};
            scv = mma_tile<64>(Qb + mt * 16 * 72, 72, Kb + nt * 16 * 72, 72, scv);
            const int s_ = nt * 16 + r;
#pragma unroll 1
            for (int d = 0; d < 2; ++d) { LAS float* sc = MC_SC(d); LAS unsigned short* Pb = MC_PB(d); const float bs = sc[128 + s_] - sc[64 + s_];
#pragma unroll
                for (int i = 0; i < 4; ++i) { const int t = mt * 16 + q * 4 + i; const bool ok = d ? (s_ >= t) : (s_ <= t);
                    const float pv = ok ? __expf(sc[128 + t] - bs - sc[192 + t]) * scv[i] * 0.125f : 0.f;
                    const unsigned short pb = f2bf(pv); Pb[t * 72 + s_] = pb;
                    const float rs = row16_sum(bf2f(pb));
                    if (r == 0) sc[512 + nt * 64 + t] = rs; } }
        }
        __syncthreads();
        f32x4 hacc[4];
#pragma unroll
        for (int mt = 0; mt < 4; ++mt) { hacc[mt] = (f32x4){0.f, 0.f, 0.f, 0.f};
            const bf16x8_t qa0 = *(const LAS bf16x8_t*)(Qb + (mt * 16 + r) * 72 + q * 8), qa1 = *(const LAS bf16x8_t*)(Qb + (mt * 16 + r) * 72 + 32 + q * 8);
#pragma unroll 1
            for (int d = 0; d < 2; ++d) { const LAS float* sc = MC_SC(d); const LAS unsigned short* Pb = MC_PB(d); const LAS unsigned short* Cb = MC_CB(d);
                f32x4 a1 = {0.f, 0.f, 0.f, 0.f}, a2 = {0.f, 0.f, 0.f, 0.f};
                const bf16x8_t cb0 = *(const LAS bf16x8_t*)(Cb + (wid * 16 + r) * 72 + q * 8), cb1 = *(const LAS bf16x8_t*)(Cb + (wid * 16 + r) * 72 + 32 + q * 8);
                a1 = __builtin_amdgcn_mfma_f32_16x16x32_bf16(qa0, cb0, a1, 0, 0, 0); a1 = __builtin_amdgcn_mfma_f32_16x16x32_bf16(qa1, cb1, a1, 0, 0, 0);
                const bf16x8_t pa0 = *(const LAS bf16x8_t*)(Pb + (mt * 16 + r) * 72 + q * 8), pa1 = *(const LAS bf16x8_t*)(Pb + (mt * 16 + r) * 72 + 32 + q * 8);
                a2 = __builtin_amdgcn_mfma_f32_16x16x32_bf16(pa0, vb0, a2, 0, 0, 0); a2 = __builtin_amdgcn_mfma_f32_16x16x32_bf16(pa1, vb1, a2, 0, 0, 0);
#pragma unroll
                for (int i = 0; i < 4; ++i) { const int t = mt * 16 + q * 4 + i;
                    const float den = sc[256 + t] * sc[320 + t] + ((sc[512 + t] + sc[576 + t]) + (sc[640 + t] + sc[704 + t]));
                    hacc[mt][i] += (sc[256 + t] * a1[i] + a2[i]) * __builtin_amdgcn_rcpf(fmaxf(fabsf(den), sc[448 + t])); }
            }
        }
#pragma unroll
        for (int mt = 0; mt < 4; ++mt)
#pragma unroll
            for (int i = 0; i < 4; ++i) { const float s = row16_sum(hacc[mt][i] * hacc[mt][i]); if (r == 0) ssp[wid * 64 + mt * 16 + q * 4 + i] = s; }
        __syncthreads();
        { const int v = wid * 16 + r; const float g = gn[v]; LAS unsigned short* Yt = MC_CB(0);
#pragma unroll
          for (int mt = 0; mt < 4; ++mt)
#pragma unroll
              for (int i = 0; i < 4; ++i) { const int t = mt * 16 + q * 4 + i;
                  float ss = 0.f;
#pragma unroll
                  for (int w = 0; w < 8; ++w) ss += ssp[w * 64 + t];
                  const float rstd = rsqrtf(ss * (1.0f / 128.0f) + 1e-6f);
                  Yt[t * 136 + v] = f2bf(hacc[mt][i] * rstd * g); } }
        __syncthreads();
#pragma unroll
        for (int i = 0; i < 2; ++i) { const int pi = tid + NTHR * i, t = pi >> 4, c8 = (pi & 15) * 8;
            const u32x4 yv = *(const LAS u32x4*)(MC_CB(0) + t * 136 + c8); const u32x4 ov = *(const u32x4*)(Z + (tok0 + t) * 2560 + 2048 + h * 128 + c8);
            float y[8], o[8]; unpack8(yv, y); unpack8(ov, o);
            u32x4 w; w.x = pk2(y[0] * sigm_f(o[0]), y[1] * sigm_f(o[1])); w.y = pk2(y[2] * sigm_f(o[2]), y[3] * sigm_f(o[3])); w.z = pk2(y[4] * sigm_f(o[4]), y[5] * sigm_f(o[5])); w.w = pk2(y[6] * sigm_f(o[6]), y[7] * sigm_f(o[7]));
            *(u32x4*)(Y + (tok0 + t) * 1024 + 512 + h * 128 + c8) = w; }
        __syncthreads();
    }
#undef MC_CB
#undef MC_PB
#undef MC_SC
}
__device__ __forceinline__ void headnorm_phase(const Params& p, const float* __restrict__ g, int zld, int zcol, int act) {
    const bf16_t* OF = (const bf16_t*)(p.ws + WS_OF); const bf16_t* OB = (const bf16_t*)(p.ws + WS_OB); const bf16_t* Z = (const bf16_t*)(p.ws + WS_Z); bf16_t* Y = (bf16_t*)(p.ws + WS_HN);
    const int tid = threadIdx.x, lane = tid & 63, wid = tid >> 6, c = lane * 8;
    const f32x4 g0 = *(const f32x4*)(g + (c & 127)), g1 = *(const f32x4*)(g + (c & 127) + 4);
    for (int tok = blockIdx.x * 8 + wid; tok < T_; tok += gridDim.x * 8) {
        const u32x4 a = *(const u32x4*)(OF + (size_t)tok * 512 + c), bq = *(const u32x4*)(OB + (size_t)tok * 512 + c), gz = *(const u32x4*)(Z + (size_t)tok * zld + zcol + c);
        float fa[8], fb[8], fg[8], o[8]; unpack8(a, fa); unpack8(bq, fb); unpack8(gz, fg);
        float ss = 0.f;
#pragma unroll
        for (int i = 0; i < 8; ++i) { o[i] = fa[i] + fb[i]; ss = fmaf(o[i], o[i], ss); }
        ss = row16_sum(ss);
        const float rstd = rsqrtf(ss * (1.0f / 128.0f) + 1e-6f);
        const float gg[8] = {g0.x, g0.y, g0.z, g0.w, g1.x, g1.y, g1.z, g1.w};
        float y[8];
#pragma unroll
        for (int i = 0; i < 8; ++i) y[i] = o[i] * rstd * gg[i] * (act == 0 ? fg[i] * sigm_f(fg[i]) : sigm_f(fg[i]));
        u32x4 w; w.x = pk2(y[0], y[1]); w.y = pk2(y[2], y[3]); w.z = pk2(y[4], y[5]); w.w = pk2(y[6], y[7]);
        *(u32x4*)(Y + (size_t)tok * 1024 + 512 + c) = w;
    }
}

__device__ __forceinline__ void odd_prep(const Params& p) {
    const bf16_t* Z = (const bf16_t*)(p.ws + WS_Z); bf16_t* VV = (bf16_t*)(p.ws + WS_QKV);
    const float* gates = (const float*)(p.ws + WS_GATES); float* LI = (float*)(p.ws + WS_BETA); float* LF = (float*)(p.ws + WS_LA);
    const float* ln_g = p.in[13]; const float* ln_b = p.in[14]; const float* ib = p.in[17]; const float* fb = p.in[18];
    const int tid = threadIdx.x, lane = tid & 63, wid = tid >> 6, c = lane * 8;
    const f32x4 g0 = *(const f32x4*)(ln_g + c), g1 = *(const f32x4*)(ln_g + c + 4), b0 = *(const f32x4*)(ln_b + c), b1 = *(const f32x4*)(ln_b + c + 4);
    const float gg[8] = {g0.x, g0.y, g0.z, g0.w, g1.x, g1.y, g1.z, g1.w}, bb[8] = {b0.x, b0.y, b0.z, b0.w, b1.x, b1.y, b1.z, b1.w};
    for (int tok = blockIdx.x * 8 + wid; tok < T_; tok += gridDim.x * 8) {
        const u32x4 v = *(const u32x4*)(Z + (size_t)tok * 2560 + 512 + c);
        float x[8]; unpack8(v, x); float sm = 0.f;
#pragma unroll
        for (int i = 0; i < 8; ++i) { x[i] = gelu_t(x[i]); sm += x[i]; }
        const float mean = wave_sum(sm) * (1.0f / 512.0f); float sq = 0.f;
#pragma unroll
        for (int i = 0; i < 8; ++i) { x[i] -= mean; sq = fmaf(x[i], x[i], sq); }
        const float rstd = rsqrtf(wave_sum(sq) * (1.0f / 512.0f) + 1e-5f);
        float y[8];
#pragma unroll
        for (int i = 0; i < 8; ++i) y[i] = x[i] * rstd * gg[i] + bb[i];
        u32x4 w; w.x = pk2(y[0], y[1]); w.y = pk2(y[2], y[3]); w.z = pk2(y[4], y[5]); w.w = pk2(y[6], y[7]);
        *(u32x4*)(VV + (size_t)tok * 512 + c) = w;
        if (lane < 8) { LI[(size_t)tok * 8 + lane] = gates[(size_t)tok * 16 + lane] + ib[lane];
                        LF[(size_t)tok * 8 + lane] = -softplus_(-(gates[(size_t)tok * 16 + 8 + lane] + fb[lane])); }
    }
}

__device__ __forceinline__ void sg_phase(LDSp lds, const Params& p, int sgId, int sgG) {
    typedef short bf16x8 __attribute__((ext_vector_type(8)));
    const bf16_t* Z = (const bf16_t*)(p.ws + WS_Z); const bf16_t* VV = (const bf16_t*)(p.ws + WS_QKV); bf16_t* Y = (bf16_t*)(p.ws + WS_HN);
    const float* sgw = p.in[15]; const float* sgb = p.in[16];
    LAS unsigned short* Wb = (LAS unsigned short*)lds;
    LAS unsigned short* Vt = (LAS unsigned short*)(lds + 34816);
    const int tid = threadIdx.x, lane = tid & 63, wid = tid >> 6;
    for (int unit = sgId; unit < 512; unit += sgG) {
        const int g = unit & 3, n = (unit >> 2) & 31, b = unit >> 7; const size_t tok0 = (size_t)b * S_ + n * 128;
#pragma unroll
        for (int i = 0; i < 8; ++i) { const int i4 = tid + NTHR * i, t = i4 >> 5, s4 = (i4 & 31) << 2; const f32x4 w = *(const f32x4*)(sgw + (size_t)g * 16384 + t * 128 + s4);
            u32x2 o; o.x = pk2(w.x, w.y); o.y = pk2(w.z, w.w); *(LAS u32x2*)(Wb + t * 136 + s4) = o; }
#pragma unroll
        for (int i = 0; i < 4; ++i) { const int pi = tid + NTHR * i, s = pi >> 4, c8 = (pi & 15) << 3; const u32x4 v = *(const u32x4*)(VV + (tok0 + s) * 512 + g * 128 + c8);
            Vt[(c8 + 0) * 136 + s] = (unsigned short)(v.x & 0xffffu); Vt[(c8 + 1) * 136 + s] = (unsigned short)(v.x >> 16);
            Vt[(c8 + 2) * 136 + s] = (unsigned short)(v.y & 0xffffu); Vt[(c8 + 3) * 136 + s] = (unsigned short)(v.y >> 16);
            Vt[(c8 + 4) * 136 + s] = (unsigned short)(v.z & 0xffffu); Vt[(c8 + 5) * 136 + s] = (unsigned short)(v.z >> 16);
            Vt[(c8 + 6) * 136 + s] = (unsigned short)(v.w & 0xffffu); Vt[(c8 + 7) * 136 + s] = (unsigned short)(v.w >> 16); }
        __syncthreads();
        bf16x8 af[4];
#pragma unroll
        for (int ks = 0; ks < 4; ++ks) af[ks] = *(const LAS bf16x8*)(Wb + (16 * wid + (lane & 15)) * 136 + ks * 32 + (lane >> 4) * 8);
        f32x4 accs[8];
#pragma unroll
        for (int nn = 0; nn < 8; ++nn) {
            f32x4 acc = {0.f, 0.f, 0.f, 0.f};
#pragma unroll
            for (int ks = 0; ks < 4; ++ks) { const bf16x8 bfrag = *(const LAS bf16x8*)(Vt + (16 * nn + (lane & 15)) * 136 + ks * 32 + (lane >> 4) * 8);
                acc = __builtin_amdgcn_mfma_f32_16x16x32_bf16(af[ks], bfrag, acc, 0, 0, 0); }
            accs[nn] = acc; }
        __syncthreads();
#pragma unroll
        for (int nn = 0; nn < 8; ++nn)
#pragma unroll
            for (int i = 0; i < 4; ++i) { const int t = 16 * wid + (lane >> 4) * 4 + i; Wb[t * 136 + 16 * nn + (lane & 15)] = f2bf(accs[nn][i] + sgb[g * 128 + t]); }
        __syncthreads();
#pragma unroll
        for (int i = 0; i < 4; ++i) { const int pi = tid + NTHR * i, t = pi >> 4, c8 = (pi & 15) << 3; const size_t tok = tok0 + t;
            const u32x4 mv = *(const LAS u32x4*)(Wb + t * 136 + c8); const u32x4 uv = *(const u32x4*)(Z + tok * 2560 + g * 128 + c8);
            float m[8], u[8]; unpack8(mv, m); unpack8(uv, u);
            u32x4 w; w.x = pk2(gelu_t(u[0]) * m[0], gelu_t(u[1]) * m[1]); w.y = pk2(gelu_t(u[2]) * m[2], gelu_t(u[3]) * m[3]); w.z = pk2(gelu_t(u[4]) * m[4], gelu_t(u[5]) * m[5]); w.w = pk2(gelu_t(u[6]) * m[6], gelu_t(u[7]) * m[7]);
            *(u32x4*)(Y + tok * 1024 + g * 128 + c8) = w; }
        __syncthreads();
    }
}

#define XB_TMO      128
#define XB_XCNT(j)  (256  + 64 * (j))
#define XB_XSUB(j)  (1280 + 64 * (j))
#define XB_XGEN(j)  (2304 + 64 * (j))
#define XB_TOP      3328
#define XB_TOPGEN   3392
#define XCD_BAR_WORDS 3456
#define XB_SPIN_CAP (1u << 18)

__device__ __forceinline__ unsigned xb_ld(unsigned* p)              { return __hip_atomic_load(p, __ATOMIC_RELAXED, __HIP_MEMORY_SCOPE_AGENT); }
__device__ __forceinline__ unsigned xb_add(unsigned* p, unsigned v) { return __hip_atomic_fetch_add(p, v, __ATOMIC_RELAXED, __HIP_MEMORY_SCOPE_AGENT); }
__device__ __forceinline__ unsigned xb_xcc_id() { return (unsigned)__builtin_amdgcn_s_getreg((3 << 11) | 20) & 0xFu; }
#define XB_SPIN(cond, bar) do { unsigned _sp = 0; while (cond) { __builtin_amdgcn_s_sleep(1); \
    if ((++_sp & 255u) == 0u) { if (xb_ld(&(bar)[XB_TMO])) break; if (_sp > XB_SPIN_CAP) { atomicAdd(&(bar)[XB_TMO], 1u); break; } } } } while (0)

struct XcdBarrier {
    unsigned* bar; unsigned x;
    volatile LAS unsigned* st;
};

__device__ __forceinline__ XcdBarrier xcd_barrier_post(unsigned* bar, volatile LAS unsigned* st) {
    XcdBarrier b; b.bar = bar; b.x = xb_xcc_id(); b.st = st;
    if (threadIdx.x == 0) (void)xb_add(&bar[XB_XCNT(b.x)], 1u);
    return b;
}
__device__ __forceinline__ void xcd_barrier_complete(unsigned* bar, unsigned x, unsigned& nloc, unsigned& nx) {
    const unsigned G = gridDim.x * gridDim.y * gridDim.z;
    unsigned sum, cnt, mine, sp = 0u;
    for (;;) {
        sum = 0u; cnt = 0u; mine = 0u;
#pragma unroll
        for (unsigned j = 0; j < 16; ++j) { const unsigned c = xb_ld(&bar[XB_XCNT(j)]); sum += c; cnt += (c > 0u) ? 1u : 0u; mine = (j == x) ? c : mine; }
        if (sum == G) break;
        __builtin_amdgcn_s_sleep(1);
        if ((++sp & 255u) == 0u) { if (xb_ld(&bar[XB_TMO])) break; if (sp > XB_SPIN_CAP) { atomicAdd(&bar[XB_TMO], 1u); break; } }
    }
    nloc = mine > 0u ? mine : 1u; nx = cnt > 0u ? cnt : 1u;
}

__device__ __forceinline__ void xcd_barrier(const XcdBarrier& b) {
    asm volatile("s_waitcnt vmcnt(0)" ::: "memory");
    __syncthreads();
    if (threadIdx.x == 0) {
        unsigned* bar = b.bar;
        __builtin_amdgcn_s_waitcnt(0);
        unsigned nloc = b.st[0], nx = b.st[1];
        if (nloc == 0u) { xcd_barrier_complete(bar, b.x, nloc, nx); b.st[0] = nloc; b.st[1] = nx; }
        const unsigned old = xb_add(&bar[XB_XSUB(b.x)], 1u);
        const unsigned gen = old / nloc;
        if (old + 1u == (gen + 1u) * nloc) {
            __builtin_amdgcn_fence(__ATOMIC_RELEASE, "agent");
            asm volatile("s_waitcnt vmcnt(0)" ::: "memory");
            const unsigned og = xb_add(&bar[XB_TOP], 1u);
            const unsigned tg = og / nx;
            if (og + 1u == (tg + 1u) * nx) xb_add(&bar[XB_TOPGEN], 1u);
            else XB_SPIN(xb_ld(&bar[XB_TOPGEN]) == tg, bar);
            __builtin_amdgcn_fence(__ATOMIC_ACQUIRE, "agent");
            xb_add(&bar[XB_XGEN(b.x)], 1u);
            asm volatile("s_waitcnt vmcnt(0)" ::: "memory");
        } else {
            XB_SPIN(xb_ld(&bar[XB_XGEN(b.x)]) == gen, bar);
            __builtin_amdgcn_fence(__ATOMIC_ACQUIRE, "agent");
            asm volatile("s_waitcnt vmcnt(0)" ::: "memory");
        }
    }
    __syncthreads();
}
constexpr size_t WS_BAR = 238 * MiB;
#ifndef N_PHASES
#define N_PHASES 21
#endif
template <int L, int SUB> __device__ __forceinline__ void run_phase(LDSp lds, const Params& p) {
    unsigned char* ws = p.ws;
    bf16_t* HN = (bf16_t*)(ws + WS_HN); bf16_t* Zb = (bf16_t*)(ws + WS_Z); float* h = p.out; float* gates = (float*)(ws + WS_GATES);
    const bf16_t* W_IN = (const bf16_t*)(ws + WS_WB + WB_IN); const bf16_t* W_OUT = (const bf16_t*)(ws + WS_WB + WB_OUT);
    const bf16_t* W_UP = (const bf16_t*)(ws + WS_WB + WB_UP); const bf16_t* W_DN = (const bf16_t*)(ws + WS_WB + WB_DN);
    const int G = gridDim.x;
    if constexpr (L == 2) { rms_phase(lds, h, p.in[25], nullptr, nullptr, h, nullptr, 0, 0, nullptr); }
    else if constexpr (SUB == 0) {
        convert_layer(lds, p, L);
        if constexpr (L == 0) rms_phase(lds, p.in[0], p.in[1], HN, nullptr, nullptr, p.in[2], 3088, 3072, gates);
        else                  rms_phase(lds, h, p.in[1] + 1024, HN, nullptr, nullptr, p.in[12], 2576, 2560, gates);
    } else if constexpr (SUB == 1) { constexpr int N = L == 0 ? 3072 : 2560;
        pg8::Gemm g{HN, W_IN, T_, N, 1024}; pg8::StaticOrder S; S.init(T_, N, G, (int)blockIdx.x);
        if constexpr (L == 0) { pg8::EpiInEven E{Zb, N}; pg8::gemm_phase_sp2<pg8::EpiInEven, pg8::StaticOrder, true, true>(lds, g, S, E); }
        else { pg8::EpiBf16<0> E{Zb, N, nullptr, 0, 0};
        pg8::gemm_phase_sp2<pg8::EpiBf16<0>, pg8::StaticOrder, true, true>(lds, g, S, E); }
    } else if constexpr (SUB == 2) { if constexpr (L == 0) even_prep(lds, p); else odd_prep(p); }
    else if constexpr (SUB == 9) { delta_prep(lds, p); }
    else if constexpr (SUB == 10) { mlstm_b(p); }
    else if constexpr (SUB == 11) { mlstm_c(lds, p); }
    else if constexpr (SUB == 3) {
        if constexpr (L == 0) delta_scan2(lds, p);
        else { mlstm_a(lds, p); sg_phase(lds, p, (int)blockIdx.x, G); }
    } else if constexpr (SUB == 4) { if constexpr (L == 0) headnorm_phase(p, p.in[10], 3072, 2560, 0); else headnorm_phase(p, p.in[19], 2560, 2048, 1); }
    else if constexpr (SUB == 5) { pg8::Gemm g{HN, W_OUT, T_, 1024, 1024}; pg8::StaticOrder S; S.init(T_, 1024, G, (int)blockIdx.x);
        pg8::EpiAddF32 E{h, 1024, L == 0 ? p.in[0] : (const float*)h};
        pg8::gemm_phase_sp2<pg8::EpiAddF32, pg8::StaticOrder, false, true>(lds, g, S, E);
    } else if constexpr (SUB == 6) { rms_phase(lds, h, p.in[21] + L * 1024, HN, nullptr, nullptr, nullptr, 0, 0, nullptr); }
    else if constexpr (SUB == 7) { pg8::Gemm g{HN, W_UP, T_, 2 * DFF, 1024}; pg8::StaticOrder S; S.init(T_, 2 * DFF, G, (int)blockIdx.x);
        pg8::EpiSwiGLU E{Zb, DFF};
        pg8::gemm_phase_sp2<pg8::EpiSwiGLU, pg8::StaticOrder, true, true>(lds, g, S, E);
    } else if constexpr (SUB == 8) { pg8::Gemm g{Zb, W_DN, T_, 1024, DFF}; pg8::StaticOrder S; S.init(T_, 1024, G, (int)blockIdx.x);
        pg8::EpiAddF32 E{h, 1024, (const float*)h};
        pg8::gemm_phase_sp2<pg8::EpiAddF32, pg8::StaticOrder, false, true>(lds, g, S, E);
    }
}
__global__ void __launch_bounds__(NTHR, 2) mega(Params p, int ph_lo, int ph_hi) {
    extern __shared__ __attribute__((aligned(16))) unsigned char lds_raw[];
    LDSp lds = (LDSp)lds_raw;
    cg::grid_group grid = cg::this_grid();
    volatile LAS unsigned* xst = (volatile LAS unsigned*)(lds + LDS_BYTES - 16);
    if (threadIdx.x == 0) { xst[0] = 0u; xst[1] = 0u; }
    __syncthreads();
    XcdBarrier xbar; xbar.bar = (unsigned*)(p.ws + WS_BAR); xbar.x = 0; xbar.st = xst;
    if (ph_hi - ph_lo > 1) xbar = xcd_barrier_post((unsigned*)(p.ws + WS_BAR), xst);
#ifndef REP_MASK
#define REP_MASK 0
#endif
#define PH(k, L, SUB) if (ph_lo <= (k) && (k) < ph_hi) { run_phase<L, SUB>(lds, p); if ((REP_MASK >> (k)) & 1) { __syncthreads(); run_phase<L, SUB>(lds, p); } if ((k) + 1 < ph_hi) { if (ph_lo < 0) grid.sync(); else xcd_barrier(xbar); } }
    PH(0, 0, 0) PH(1, 0, 1) PH(2, 0, 2) PH(3, 0, 9) PH(4, 0, 3) PH(5, 0, 4) PH(6, 0, 5) PH(7, 0, 6) PH(8, 0, 7) PH(9, 0, 8)
    PH(10, 1, 0) PH(11, 1, 1) PH(12, 1, 2) PH(13, 1, 3) PH(14, 1, 10) PH(15, 1, 11)
    PH(16, 1, 5) PH(17, 1, 6) PH(18, 1, 7) PH(19, 1, 8)
    PH(20, 2, 0)
#ifdef EXTRA_SYNCS
    for (int i_ = 0; i_ < EXTRA_SYNCS; ++i_) grid.sync();
#endif
#undef PH
}

extern "C" void kernel_launch(void* const* d_in, const int* in_sizes, int n_in, void* d_out, int out_size, void* d_ws, size_t ws_size, hipStream_t stream) {
    static int grid = 0;
    if (grid == 0) {
        int dev = 0, cus = 0, per_cu = 0;
        (void)hipGetDevice(&dev);
        (void)hipDeviceGetAttribute(&cus, hipDeviceAttributeMultiprocessorCount, dev);
        (void)hipFuncSetAttribute((const void*)mega, hipFuncAttributeMaxDynamicSharedMemorySize, LDS_BYTES);
        if (hipOccupancyMaxActiveBlocksPerMultiprocessor(&per_cu, (const void*)mega, NTHR, LDS_BYTES) != hipSuccess || per_cu < 1) per_cu = 1;
        (void)hipGetLastError();
        if (cus <= 0) cus = 256;
        grid = cus * per_cu;
    }
    if (ws_size < 239 * MiB) { fprintf(stderr, "workspace too small: %zu\n", ws_size); return; }
    Params p{};
    for (int i = 0; i < 26; ++i) p.in[i] = (const float*)d_in[i];
    p.out = (float*)d_out; p.ws = (unsigned char*)d_ws;
#if defined(MULTI_LAUNCH)
    for (int ph = 0; ph < N_PHASES; ++ph) hipLaunchKernelGGL(mega, dim3(grid), dim3(NTHR), LDS_BYTES, stream, p, ph, ph + 1);
#else
    (void)hipMemsetAsync((char*)d_ws + WS_BAR, 0, XCD_BAR_WORDS * 4, stream);
    int lo = 0, hi = N_PHASES;
    void* args[] = {(void*)&p, (void*)&lo, (void*)&hi};
    hipError_t e = hipLaunchCooperativeKernel((const void*)mega, dim3(grid), dim3(NTHR), args, LDS_BYTES, stream);
    if (e != hipSuccess) fprintf(stderr, "cooperative launch failed: %s (grid %d)\n", hipGetErrorString(e), grid);
#endif
}
```
